# Optimizing an MI355X kernel written in HIP

```python
import math
import jax
import jax.numpy as jnp
from jax import lax
import numpy as np

D_MODEL = 1024
BATCH = 16
SEQ = 4096
DEPTH = 4

GRID_W = 64
CTX_LEN = 256
D_MIX = D_MODEL
GROUP = D_MIX // 4

MLA_HEADS = 4
MLA_NOPE = 64
MLA_ROPE = 32
MLA_V = 64
MLA_Q_RANK = 192
MLA_KV_RANK = 128
ROPE_BASE = 10000.0
Q_BLOCK = 128

LRU_BLOCKS = 4
LRU_CONV = 4
LRU_CONV_LEFT = 2
LRU_C = 8.0

RWKV_HEADS = 4
RWKV_HEAD = GROUP // RWKV_HEADS
RWKV_DECAY_LORA = 32
RWKV_AAA_LORA = 32
RWKV_GATE_LORA = 64
RWKV_GN_EPS = 64e-5

HY_ORDER = 2
HY_SHORT = 3
HY_BANDS = 16
HY_EMB = 1 + 2 * HY_BANDS
HY_HIDDEN = 64
HY_SIN_FREQ = 1.0
HY_DECAY_MIN = math.log(1e-2) / 1.5
HY_DECAY_MAX = math.log(1e-2) / 0.3
HY_SHIFT = 0.05

FF_DENSE = 2816
N_EXPERTS = 8
TOP_K = 2
FF_EXPERT = 3584
MOE_BLOCK = 512

ALPHA = (2.0 * DEPTH) ** 0.25
BETA = (8.0 * DEPTH) ** -0.25

A_CQ = 0
A_CKV = A_CQ + MLA_Q_RANK
A_KR = A_CKV + MLA_KV_RANK
B_X = A_KR + MLA_ROPE
B_GATE = B_X + GROUP
C_OFF = B_GATE + GROUP
C_R = 0
C_K = GROUP
C_V = 2 * GROUP
C_WD = 3 * GROUP
C_AD = C_WD + 2 * RWKV_DECAY_LORA
C_GD = C_AD + 2 * RWKV_AAA_LORA
C_COLS = C_GD + RWKV_GATE_LORA
D_OFF = C_OFF + C_COLS
D_COLS = (HY_ORDER + 1) * GROUP
N_IN = D_OFF + D_COLS

kernel_name = 'hybrid_mla_rglru_rwkv7_hyena_moe_dit'


def modulate(x, shift, scale):
    return x * (1.0 + scale) + shift


def layer_norm(x, g, b, eps=1e-5):
    xf = x.astype(jnp.float32)
    mu = jnp.mean(xf, -1, keepdims=True)
    var = jnp.mean(jnp.square(xf - mu), -1, keepdims=True)
    return ((xf - mu) * lax.rsqrt(var + eps) * g + b).astype(x.dtype)


def rms_norm(x, g, eps=1e-6):
    xf = x.astype(jnp.float32)
    return (xf * lax.rsqrt(jnp.mean(jnp.square(xf), -1, keepdims=True) + eps) * g).astype(x.dtype)


def dwconv(x, w, b, left):
    K = w.shape[0]
    L = x.shape[1]
    xp = jnp.pad(x, ((0, 0), (left, K - 1 - left), (0, 0)))
    return sum(xp[:, j:j + L] * w[j] for j in range(K)) + b


def token_shift(z, mu_prev, mu_next):
    zp = jnp.pad(z, ((0, 0), (1, 1), (0, 0)))
    return z + mu_prev * (zp[:, :-2] - z) + mu_next * (zp[:, 2:] - z)


def axial_rope(rows):
    f32 = jnp.float32
    r, col = jnp.meshgrid(jnp.arange(rows, dtype=f32), jnp.arange(GRID_W, dtype=f32), indexing='ij')
    half = MLA_ROPE // 2
    inv = 1.0 / (ROPE_BASE ** (jnp.arange(0, half, 2, dtype=f32) / half))
    ang = jnp.concatenate([r.reshape(-1, 1) * inv, col.reshape(-1, 1) * inv], -1)
    return jnp.cos(ang), jnp.sin(ang)


def apply_rope(x, cos, sin):
    xf = x.astype(jnp.float32)
    h = xf.shape[-1] // 2
    x1, x2 = xf[..., :h], xf[..., h:]
    return jnp.concatenate([x1 * cos - x2 * sin, x1 * sin + x2 * cos], -1).astype(x.dtype)


def block_attention(q, k, v):
    B, Lq, H, Dh = q.shape
    nb = Lq // Q_BLOCK
    qb = jnp.moveaxis(q.reshape(B, nb, Q_BLOCK, H, Dh), 1, 0)
    scale = Dh ** -0.5

    def one(qblk):
        s = jnp.einsum('bqhd,bkhd->bhqk', qblk, k, preferred_element_type=jnp.float32) * scale
        p = jax.nn.softmax(s, axis=-1).astype(v.dtype)
        return jnp.einsum('bhqk,bkhd->bqhd', p, v)

    o = lax.map(one, qb)
    return jnp.moveaxis(o, 0, 1).reshape(B, Lq, H, v.shape[-1])


def mla_queries(P, q_norm, w_uq, cos, sin):
    B, L, _ = P.shape
    cq = rms_norm(P[..., A_CQ:A_CQ + MLA_Q_RANK], q_norm)
    q = (cq @ w_uq).reshape(B, L, MLA_HEADS, MLA_NOPE + MLA_ROPE)
    if cos is None:
        return q
    q_rope = apply_rope(q[..., MLA_NOPE:], cos[None, :, None, :], sin[None, :, None, :])
    return jnp.concatenate([q[..., :MLA_NOPE], q_rope], -1)


def mla_keys(P, kv_norm, w_ukv, cos, sin):
    B, L, _ = P.shape
    ckv = rms_norm(P[..., A_CKV:A_CKV + MLA_KV_RANK], kv_norm)
    kv = (ckv @ w_ukv).reshape(B, L, MLA_HEADS, MLA_NOPE + MLA_V)
    k_nope, v = kv[..., :MLA_NOPE], kv[..., MLA_NOPE:]
    k_rope = P[..., A_KR:A_KR + MLA_ROPE]
    if cos is not None:
        k_rope = apply_rope(k_rope, cos[None], sin[None])
    k_rope = jnp.broadcast_to(k_rope[:, :, None, :], (B, L, MLA_HEADS, MLA_ROPE))
    return jnp.concatenate([k_nope, k_rope], -1), v


def mla_mixer(Pl, Pc, q_norm, kv_norm, w_uq, w_ukv, out_norm, cos, sin, ctx_out):
    B, L, _ = Pl.shape
    kl, vl = mla_keys(Pl, kv_norm, w_ukv, cos, sin)
    kc, vc = mla_keys(Pc, kv_norm, w_ukv, None, None)
    ql = mla_queries(Pl, q_norm, w_uq, cos, sin)
    k_all = jnp.concatenate([kc, kl], 1)
    v_all = jnp.concatenate([vc, vl], 1)
    yl = rms_norm(block_attention(ql, k_all, v_all).reshape(B, L, GROUP), out_norm)
    yc = None
    if ctx_out:
        qc = mla_queries(Pc, q_norm, w_uq, None, None)
        yc = rms_norm(block_attention(qc, kc, vc).reshape(B, Pc.shape[1], GROUP), out_norm)
    return yl, yc


def block_diag(x, w, b):
    B, L, _ = x.shape
    xb = x.reshape(B, L, LRU_BLOCKS, -1)
    return jnp.einsum('blnc,ncd->blnd', xb, w).reshape(B, L, -1) + b


def linear_scan(a, b, h0, reverse):
    if reverse:
        a, b = jnp.flip(a, 1), jnp.flip(b, 1)
    b = b.at[:, 0].add(a[:, 0] * h0)
    _, h = lax.associative_scan(lambda l, r: (l[0] * r[0], r[0] * l[1] + r[1]), (a, b), axis=1)
    final = h[:, -1]
    if reverse:
        h = jnp.flip(h, 1)
    return h, final


def rglru_direction(u, w_r, b_r, w_i, b_i, lam, h0, reverse):
    r = jax.nn.sigmoid(block_diag(u, w_r, b_r))
    i = jax.nn.sigmoid(block_diag(u, w_i, b_i))
    log_a = -LRU_C * r * jax.nn.softplus(-lam)
    a = jnp.exp(log_a)
    b = jnp.sqrt(-jnp.expm1(2.0 * log_a)) * (i * u)
    return linear_scan(a, b, h0, reverse)


def rglru_mixer(Pl, Pc, conv_w, conv_b, w_r, b_r, w_i, b_i, lam, out_norm, ctx_out):
    f32 = jnp.float32
    ul = dwconv(Pl[..., B_X:B_X + GROUP], conv_w, conv_b, LRU_CONV_LEFT).astype(f32)
    uc = dwconv(Pc[..., B_X:B_X + GROUP], conv_w, conv_b, LRU_CONV_LEFT).astype(f32)
    h0 = jnp.zeros((Pc.shape[0], GROUP), f32)
    hl = 0.0
    hc = 0.0
    for d in range(2):
        rev = d == 1
        h_c, s_c = rglru_direction(uc, w_r[d], b_r[d], w_i[d], b_i[d], lam[d], h0, rev)
        h_l, _ = rglru_direction(ul, w_r[d], b_r[d], w_i[d], b_i[d], lam[d], s_c, rev)
        hl = hl + h_l
        hc = hc + h_c
    gl = jax.nn.gelu(Pl[..., B_GATE:B_GATE + GROUP].astype(f32))
    yl = rms_norm(hl * gl, out_norm).astype(Pl.dtype)
    yc = None
    if ctx_out:
        gc = jax.nn.gelu(Pc[..., B_GATE:B_GATE + GROUP].astype(f32))
        yc = rms_norm(hc * gc, out_norm).astype(Pc.dtype)
    return yl, yc


def rwkv_prepare(P, mu_prev, mu_next, w0, w_up, a0, a_up, k_k, k_a):
    z = token_shift(P[..., C_OFF:C_OFF + C_COLS], mu_prev, mu_next).astype(jnp.float32)
    B, L, _ = z.shape

    def heads(t):
        return t.reshape(B, L, RWKV_HEADS, RWKV_HEAD)

    r = heads(z[..., C_R:C_R + GROUP])
    k = heads(z[..., C_K:C_K + GROUP])
    v = heads(z[..., C_V:C_V + GROUP])
    kk = k * k_k.reshape(RWKV_HEADS, RWKV_HEAD)
    kk = kk * lax.rsqrt(jnp.maximum(jnp.sum(jnp.square(kk), -1, keepdims=True), 1e-24))
    dirs = []
    for d in range(2):
        wd = z[..., C_WD + d * RWKV_DECAY_LORA:C_WD + (d + 1) * RWKV_DECAY_LORA]
        ad = z[..., C_AD + d * RWKV_AAA_LORA:C_AD + (d + 1) * RWKV_AAA_LORA]
        log_w = -jnp.exp(-jax.nn.softplus(-(w0[d] + jnp.tanh(wd) @ w_up[d])) - 0.5)
        a = heads(jax.nn.sigmoid(a0[d] + ad @ a_up[d]))
        k_d = k * (1.0 + (a - 1.0) * k_a.reshape(RWKV_HEADS, RWKV_HEAD))
        dirs.append((heads(jnp.exp(log_w)), kk * a, k_d))
    gd = z[..., C_GD:C_GD + RWKV_GATE_LORA]
    return r, v, kk, dirs, gd


def rwkv_scan(r, decay, kk, kka, v, k, s0, reverse, emit):
    xs = tuple(jnp.moveaxis(t, 1, 0) for t in (r, decay, kk, kka, v, k))

    def step(S, inp):
        r_t, w_t, kk_t, kka_t, v_t, k_t = inp
        sa = jnp.einsum('bhvk,bhk->bhv', S, kk_t)
        S = S * w_t[:, :, None, :] - sa[..., None] * kka_t[:, :, None, :] + v_t[..., None] * k_t[:, :, None, :]
        return S, (jnp.einsum('bhvk,bhk->bhv', S, r_t) if emit else None)

    S, ys = lax.scan(step, s0, xs, reverse=reverse)
    return (jnp.moveaxis(ys, 0, 1) if emit else None), S


def rwkv_finish(y, r, v, dirs, gd, g_up, r_k, ln_g, ln_b):
    B, L = y.shape[:2]
    mu = jnp.mean(y, -1, keepdims=True)
    var = jnp.mean(jnp.square(y - mu), -1, keepdims=True)
    yn = (y - mu) * lax.rsqrt(var + RWKV_GN_EPS) * ln_g.reshape(RWKV_HEADS, RWKV_HEAD) + ln_b.reshape(RWKV_HEADS, RWKV_HEAD)
    bonus = sum(jnp.sum(r * kd * r_k, -1, keepdims=True) for (_, _, kd) in dirs) * v
    g = jax.nn.sigmoid(gd) @ g_up
    return (yn + bonus).reshape(B, L, GROUP) * g


def rwkv_mixer(Pl, Pc, mu_prev, mu_next, w0, w_up, a0, a_up, g_up, k_k, k_a, r_k, ln_g, ln_b, ctx_out):
    rl, vl, kkl, dl, gdl = rwkv_prepare(Pl, mu_prev, mu_next, w0, w_up, a0, a_up, k_k, k_a)
    rc, vc, kkc, dc, gdc = rwkv_prepare(Pc, mu_prev, mu_next, w0, w_up, a0, a_up, k_k, k_a)
    s0 = jnp.zeros((Pl.shape[0], RWKV_HEADS, RWKV_HEAD, RWKV_HEAD), jnp.float32)
    yl = 0.0
    yc = 0.0
    for d in range(2):
        rev = d == 1
        y_c, s_c = rwkv_scan(rc, dc[d][0], kkc, dc[d][1], vc, dc[d][2], s0, rev, ctx_out)
        y_l, _ = rwkv_scan(rl, dl[d][0], kkl, dl[d][1], vl, dl[d][2], s_c, rev, True)
        yl = yl + y_l
        if ctx_out:
            yc = yc + y_c
    out_l = rwkv_finish(yl, rl, vl, dl, gdl, g_up, r_k, ln_g, ln_b).astype(Pl.dtype)
    out_c = None
    if ctx_out:
        out_c = rwkv_finish(yc, rc, vc, dc, gdc, g_up, r_k, ln_g, ln_b).astype(Pc.dtype)
    return out_l, out_c


def hyena_filters(L, w1, b1, w2, b2, w3):
    f32 = jnp.float32
    t01 = jnp.linspace(0.0, 1.0, L, dtype=f32)[:, None]
    bands = jnp.linspace(1e-4, HY_BANDS - 1, HY_BANDS, dtype=f32)[None, :]
    wpos = (2.0 * math.pi / L) * jnp.arange(L, dtype=f32)[:, None]
    z = jnp.concatenate([t01, jnp.cos(bands * wpos), -jnp.sin(bands * wpos)], -1)
    h = jnp.sin(HY_SIN_FREQ * (z @ w1 + b1))
    h = jnp.sin(HY_SIN_FREQ * (h @ w2 + b2))
    h = (h @ w3).astype(f32).reshape(L, HY_ORDER, 2, GROUP)
    deltas = jnp.abs(jnp.linspace(HY_DECAY_MIN, HY_DECAY_MAX, GROUP, dtype=f32))
    window = jnp.exp(-t01 * deltas) + HY_SHIFT
    return h * window[:, None, None, :]


def two_sided_spectrum(h_fwd, h_bwd):
    L, C = h_fwd.shape
    k = jnp.concatenate([h_fwd, jnp.zeros((1, C), h_fwd.dtype), jnp.flip(h_bwd[1:], 0)], 0)
    return jnp.fft.rfft(k, axis=0)


def long_conv(u, spec, d_skip):
    L = u.shape[1]
    U = jnp.fft.rfft(u, n=2 * L, axis=1)
    y = jnp.fft.irfft(U * spec[None], n=2 * L, axis=1)[:, :L]
    return y + u * d_skip


def hyena_sequence(P, conv_w, conv_b, w1, b1, w2, b2, w3, d_skip):
    L = P.shape[1]
    z = dwconv(P[..., D_OFF:D_OFF + D_COLS], conv_w, conv_b, 1).astype(jnp.float32)
    v, x1, x2 = z[..., :GROUP], z[..., GROUP:2 * GROUP], z[..., 2 * GROUP:]
    h = hyena_filters(L, w1, b1, w2, b2, w3)
    u = x1 * long_conv(v, two_sided_spectrum(h[:, 0, 0], h[:, 0, 1]), d_skip[0])
    return x2 * long_conv(u, two_sided_spectrum(h[:, 1, 0], h[:, 1, 1]), d_skip[1])


def swiglu(x, wg, wu, wd):
    return (jax.nn.silu(x @ wg) * (x @ wu)) @ wd


def moe_swiglu(x, router, wg, wu, wd):
    N, D = x.shape
    logits = (x @ router).astype(jnp.float32)
    top_v, top_i = lax.top_k(logits, TOP_K)
    gates = jax.nn.softmax(top_v, axis=-1)
    A = N * TOP_K
    e_flat = top_i.reshape(-1)
    tok_flat = jnp.arange(A, dtype=jnp.int32) // TOP_K
    g_flat = gates.reshape(-1)
    order = jnp.argsort(e_flat)
    e_sorted = e_flat[order]
    counts = jnp.bincount(e_flat, length=N_EXPERTS)
    starts = jnp.cumsum(counts) - counts
    padded = (counts + MOE_BLOCK - 1) // MOE_BLOCK * MOE_BLOCK
    pends = jnp.cumsum(padded)
    pstarts = pends - padded
    dest = pstarts[e_sorted] + jnp.arange(A, dtype=jnp.int32) - starts[e_sorted]
    n_blocks = -(-A // MOE_BLOCK) + N_EXPERTS
    n_slots = n_blocks * MOE_BLOCK
    slot_tok = jnp.full((n_slots,), N, jnp.int32).at[dest].set(tok_flat[order])
    slot_gate = jnp.zeros((n_slots,), jnp.float32).at[dest].set(g_flat[order])
    block_expert = jnp.clip(jnp.searchsorted(pends, jnp.arange(n_blocks) * MOE_BLOCK, side='right'), 0, N_EXPERTS - 1)
    xp = jnp.concatenate([x, jnp.zeros((1, D), x.dtype)], 0)
    xs = xp[slot_tok].reshape(n_blocks, MOE_BLOCK, D)

    def expert_block(args):
        xb, e = args
        return swiglu(xb, wg[e], wu[e], wd[e])

    ys = lax.map(expert_block, (xs, block_expert)).reshape(n_slots, D)
    out = jnp.zeros((N + 1, D), jnp.float32).at[slot_tok].add(ys.astype(jnp.float32) * slot_gate[:, None])
    return out[:N].astype(x.dtype)


def setup_inputs(seed: int = 0) -> dict:
    key = jax.random.key(seed)
    keys = iter(jax.random.split(key, 80))
    f32 = jnp.float32

    def nrm(shape, std):
        return std * jax.random.normal(next(keys), shape, f32)

    def gain(shape):
        return 1.0 + nrm(shape, 0.02)

    def unif(shape, lo, hi):
        return jax.random.uniform(next(keys), shape, f32, lo, hi)

    n_dense = (DEPTH + 1) // 2
    n_moe = DEPTH // 2
    lru_s = unif((DEPTH, 2, GROUP), 0.9, 0.999) ** (1.0 / LRU_C)
    decay_base = jnp.linspace(-6.5, -1.5, GROUP, dtype=f32)
    return {
        'x': nrm((BATCH, SEQ, D_MODEL), 1.0),
        'c': nrm((BATCH, D_MODEL), 1.0),
        'ctx': nrm((BATCH, CTX_LEN, D_MODEL), 1.0),
        'c_ctx': nrm((D_MODEL,), 1.0),
        'ada_w': nrm((DEPTH, D_MODEL, 6 * D_MODEL), 0.5 * D_MODEL ** -0.5),
        'ada_b': nrm((DEPTH, 6 * D_MODEL), 0.02),
        'w_in': nrm((DEPTH, D_MODEL, N_IN), D_MODEL ** -0.5),
        'mla_q_norm': gain((DEPTH, MLA_Q_RANK)),
        'mla_kv_norm': gain((DEPTH, MLA_KV_RANK)),
        'mla_w_uq': nrm((DEPTH, MLA_Q_RANK, MLA_HEADS * (MLA_NOPE + MLA_ROPE)), MLA_Q_RANK ** -0.5),
        'mla_w_ukv': nrm((DEPTH, MLA_KV_RANK, MLA_HEADS * (MLA_NOPE + MLA_V)), MLA_KV_RANK ** -0.5),
        'mla_out_norm': gain((DEPTH, GROUP)),
        'lru_conv_w': nrm((DEPTH, LRU_CONV, GROUP), LRU_CONV ** -0.5),
        'lru_conv_b': nrm((DEPTH, GROUP), 0.02),
        'lru_w_r': nrm((DEPTH, 2, LRU_BLOCKS, GROUP // LRU_BLOCKS, GROUP // LRU_BLOCKS), (GROUP // LRU_BLOCKS) ** -0.5),
        'lru_b_r': nrm((DEPTH, 2, GROUP), 0.02),
        'lru_w_i': nrm((DEPTH, 2, LRU_BLOCKS, GROUP // LRU_BLOCKS, GROUP // LRU_BLOCKS), (GROUP // LRU_BLOCKS) ** -0.5),
        'lru_b_i': nrm((DEPTH, 2, GROUP), 0.02),
        'lru_lambda': jnp.log(lru_s) - jnp.log1p(-lru_s),
        'lru_out_norm': gain((DEPTH, GROUP)),
        'rwkv_mu_prev': unif((DEPTH, C_COLS), 0.0, 0.5),
        'rwkv_mu_next': unif((DEPTH, C_COLS), 0.0, 0.5),
        'rwkv_w0': decay_base + nrm((DEPTH, 2, GROUP), 0.1),
        'rwkv_w_up': nrm((DEPTH, 2, RWKV_DECAY_LORA, GROUP), 0.5 * RWKV_DECAY_LORA ** -0.5),
        'rwkv_a0': nrm((DEPTH, 2, GROUP), 0.1),
        'rwkv_a_up': nrm((DEPTH, 2, RWKV_AAA_LORA, GROUP), 0.5 * RWKV_AAA_LORA ** -0.5),
        'rwkv_g_up': nrm((DEPTH, RWKV_GATE_LORA, GROUP), RWKV_GATE_LORA ** -0.5),
        'rwkv_k_k': 0.85 + nrm((DEPTH, GROUP), 0.02),
        'rwkv_k_a': gain((DEPTH, GROUP)),
        'rwkv_r_k': -0.04 + nrm((DEPTH, RWKV_HEADS, RWKV_HEAD), 0.02),
        'rwkv_ln_g': gain((DEPTH, GROUP)),
        'rwkv_ln_b': nrm((DEPTH, GROUP), 0.02),
        'hy_conv_w': nrm((DEPTH, HY_SHORT, D_COLS), HY_SHORT ** -0.5),
        'hy_conv_b': nrm((DEPTH, D_COLS), 0.02),
        'hy_f_w1': nrm((DEPTH, HY_EMB, HY_HIDDEN), HY_EMB ** -0.5),
        'hy_f_b1': nrm((DEPTH, HY_HIDDEN), 0.02),
        'hy_f_w2': nrm((DEPTH, HY_HIDDEN, HY_HIDDEN), HY_HIDDEN ** -0.5),
        'hy_f_b2': nrm((DEPTH, HY_HIDDEN), 0.02),
        'hy_f_w3': nrm((DEPTH, HY_HIDDEN, HY_ORDER * 2 * GROUP), 0.02),
        'hy_d': nrm((DEPTH, HY_ORDER, GROUP), 0.1),
        'hy_out_norm': gain((DEPTH, GROUP)),
        'w_out': nrm((DEPTH, D_MIX, D_MODEL), BETA * D_MIX ** -0.5),
        'ln1_g': gain((DEPTH, D_MODEL)),
        'ln1_b': nrm((DEPTH, D_MODEL), 0.02),
        'ln2_g': gain((DEPTH, D_MODEL)),
        'ln2_b': nrm((DEPTH, D_MODEL), 0.02),
        'ffn_w_gate': nrm((n_dense, D_MODEL, FF_DENSE), D_MODEL ** -0.5),
        'ffn_w_up': nrm((n_dense, D_MODEL, FF_DENSE), D_MODEL ** -0.5),
        'ffn_w_down': nrm((n_dense, FF_DENSE, D_MODEL), BETA * FF_DENSE ** -0.5),
        'moe_router': nrm((n_moe, D_MODEL, N_EXPERTS), D_MODEL ** -0.5),
        'moe_w_gate': nrm((n_moe, N_EXPERTS, D_MODEL, FF_EXPERT), D_MODEL ** -0.5),
        'moe_w_up': nrm((n_moe, N_EXPERTS, D_MODEL, FF_EXPERT), D_MODEL ** -0.5),
        'moe_w_down': nrm((n_moe, N_EXPERTS, FF_EXPERT, D_MODEL), BETA * FF_EXPERT ** -0.5),
    }


def reference(x, c, ctx, c_ctx, ada_w, ada_b, w_in, mla_q_norm, mla_kv_norm, mla_w_uq, mla_w_ukv, mla_out_norm,
              lru_conv_w, lru_conv_b, lru_w_r, lru_b_r, lru_w_i, lru_b_i, lru_lambda, lru_out_norm,
              rwkv_mu_prev, rwkv_mu_next, rwkv_w0, rwkv_w_up, rwkv_a0, rwkv_a_up, rwkv_g_up, rwkv_k_k, rwkv_k_a,
              rwkv_r_k, rwkv_ln_g, rwkv_ln_b, hy_conv_w, hy_conv_b, hy_f_w1, hy_f_b1, hy_f_w2, hy_f_b2, hy_f_w3,
              hy_d, hy_out_norm, w_out, ln1_g, ln1_b, ln2_g, ln2_b, ffn_w_gate, ffn_w_up, ffn_w_down,
              moe_router, moe_w_gate, moe_w_up, moe_w_down):
    B, L, D = x.shape
    Lc = ctx.shape[1]
    rows = L // GRID_W
    cos, sin = axial_rope(rows)
    s_lat = jax.nn.silu(c)
    s_ctx = jax.nn.silu(c_ctx)
    xl, xc = x, ctx
    for li in range(DEPTH):
        ctx_out = li < DEPTH - 1
        mod_l = (s_lat @ ada_w[li] + ada_b[li]).reshape(B, 6, 1, D)
        mod_c = (s_ctx @ ada_w[li] + ada_b[li]).reshape(6, 1, D)

        hl = modulate(xl, mod_l[:, 0], mod_l[:, 1])
        hc = modulate(xc, mod_c[0], mod_c[1])
        w_in_l = w_in[li]
        Pl = hl @ w_in_l
        Pc = hc @ (w_in_l if ctx_out else w_in_l[:, :D_OFF])
        a_l, a_c = mla_mixer(Pl, Pc, mla_q_norm[li], mla_kv_norm[li], mla_w_uq[li], mla_w_ukv[li],
                             mla_out_norm[li], cos, sin, ctx_out)
        b_l, b_c = rglru_mixer(Pl, Pc, lru_conv_w[li], lru_conv_b[li], lru_w_r[li], lru_b_r[li], lru_w_i[li],
                               lru_b_i[li], lru_lambda[li], lru_out_norm[li], ctx_out)
        c_l, c_c = rwkv_mixer(Pl, Pc, rwkv_mu_prev[li], rwkv_mu_next[li], rwkv_w0[li], rwkv_w_up[li], rwkv_a0[li],
                              rwkv_a_up[li], rwkv_g_up[li], rwkv_k_k[li], rwkv_k_a[li], rwkv_r_k[li],
                              rwkv_ln_g[li], rwkv_ln_b[li], ctx_out)
        d_l = rms_norm(hyena_sequence(Pl, hy_conv_w[li], hy_conv_b[li], hy_f_w1[li], hy_f_b1[li], hy_f_w2[li],
                                      hy_f_b2[li], hy_f_w3[li], hy_d[li]), hy_out_norm[li]).astype(Pl.dtype)
        yl = jnp.concatenate([a_l, b_l, c_l, d_l], -1) @ w_out[li]
        xl = layer_norm(ALPHA * xl + mod_l[:, 2] * yl, ln1_g[li], ln1_b[li])
        if ctx_out:
            d_c = rms_norm(hyena_sequence(Pc, hy_conv_w[li], hy_conv_b[li], hy_f_w1[li], hy_f_b1[li], hy_f_w2[li],
                                          hy_f_b2[li], hy_f_w3[li], hy_d[li]), hy_out_norm[li]).astype(Pc.dtype)
            yc = jnp.concatenate([a_c, b_c, c_c, d_c], -1) @ w_out[li]
            xc = layer_norm(ALPHA * xc + mod_c[2] * yc, ln1_g[li], ln1_b[li])

        fl = modulate(xl, mod_l[:, 3], mod_l[:, 4]).reshape(B * L, D)
        if ctx_out:
            fc = modulate(xc, mod_c[3], mod_c[4]).reshape(B * Lc, D)
            tokens = jnp.concatenate([fl, fc], 0)
        else:
            tokens = fl
        j = li // 2
        if li % 2 == 0:
            out = swiglu(tokens, ffn_w_gate[j], ffn_w_up[j], ffn_w_down[j])
        else:
            out = moe_swiglu(tokens, moe_router[j], moe_w_gate[j], moe_w_up[j], moe_w_down[j])
        xl = layer_norm(ALPHA * xl + mod_l[:, 5] * out[:B * L].reshape(B, L, D), ln2_g[li], ln2_b[li])
        if ctx_out:
            xc = layer_norm(ALPHA * xc + mod_c[5] * out[B * L:].reshape(B, Lc, D), ln2_g[li], ln2_b[li])
    return xl
```

```cpp
#include <hip/hip_runtime.h>
#include <cstdio>
#include <cstdint>
#define GAS __attribute__((address_space(1)))
#define LAS __attribute__((address_space(3)))
namespace pg8 {
#define PG8_LAS __attribute__((address_space(3)))
typedef unsigned short bf16_t;
typedef short bf16x8 __attribute__((ext_vector_type(8)));
typedef float f32x4 __attribute__((ext_vector_type(4)));
typedef unsigned u32x4 __attribute__((ext_vector_type(4)));
constexpr int BM = 256, BK = 64, HALF = 128, HTB = HALF * BK * 2  , STAGE_BYTES = 8 * HTB, NXCD = 8, WGM = 8;

__host__ __device__ __forceinline__ int lds_byte(int r, int c) { const int st = (r >> 4) * 2 + (c >> 5), rr = r & 15, cc = c & 31, ob = rr * 64 + cc * 2; return st * 1024 + (ob ^ (((ob >> 9) & 1) << 5)); }
__host__ __device__ __forceinline__ void stage_rc(int b, int& R, int& C) { const int st = b / 1024, sb = b % 1024, swz = sb ^ (((sb >> 9) & 1) << 5); R = (st >> 1) * 16 + swz / 64; C = (st & 1) * 32 + (swz % 64) / 2; }
__host__ __device__ __forceinline__ int perm32(int rho) { const int n = rho >> 4, i = rho & 15; return 8 * (i >> 2) + 4 * n + (i & 3); }

struct Unit { int pm, pn; };
struct Gemm { const bf16_t* A; const bf16_t* Bt; int M, N, K; };

struct StaticOrder {
    int nM, nN, nwg, G, c;
    __host__ __device__ void init(int M, int N, int G_, int c_) { nM = M / BM; nN = N / BM; nwg = nM * nN; G = G_; c = c_; }
    __host__ __device__ bool next(int i, Unit& u) const {
        const long L = (long)i * G + c; if (L >= nwg) return false;
        int wgid = (int)L; { const int q = nwg / NXCD, r = nwg % NXCD, xcd = wgid % NXCD, off = wgid / NXCD; wgid = (xcd < r ? xcd * (q + 1) : r * (q + 1) + (xcd - r) * q) + off; }
        const int nig = WGM * nN, gid = wgid / nig, fm = gid * WGM, gsz = (nM - fm) < WGM ? (nM - fm) : WGM;
        u.pm = fm + ((wgid % nig) % gsz); u.pn = (wgid % nig) / gsz; return true;
    }
    __device__ __forceinline__ void a_ready(const Unit&) const {}
    __device__ __forceinline__ void done(const Unit&) const {}
};

__device__ __forceinline__ unsigned cvt_pk_bf16(float lo, float hi) { unsigned r; asm volatile("v_cvt_pk_bf16_f32 %0, %1, %2" : "=v"(r) : "v"(lo), "v"(hi)); return r; }
typedef float f32x2 __attribute__((ext_vector_type(2)));
__device__ __forceinline__ f32x2 gelu_pk(f32x2 v) {
    const f32x2 av = __builtin_elementwise_abs(v), d = av * 0.2316418882f + 1.0f;
    f32x2 t; t.x = __builtin_amdgcn_rcpf(d.x); t.y = __builtin_amdgcn_rcpf(d.y);
    f32x2 q = t * 0.5307027145f + (-0.7265760135f); q = q * t + 0.7107068705f; q = q * t + (-0.142248368f); q = q * t + 0.127414796f; q = q * t;
    const f32x2 s = (v * v) * (-0.72134752044f);
    f32x2 e; e.x = __builtin_amdgcn_exp2f(s.x); e.y = __builtin_amdgcn_exp2f(s.y);
    const f32x2 m = v * (q * e), r = v - m;
    f32x2 o; o.x = v.x < 0.f ? m.x : r.x; o.y = v.y < 0.f ? m.y : r.y; return o;
}

template <int ACT  > struct EpiBf16 {
    static constexpr bool PERM = true, AFTER_DRAIN = false; static_assert(ACT == 0 || ACT == 1, "EpiBf16: ACT is 0 (none) or 1 (gelu_pk)");
    bf16_t* O; int ldc; const float* bias; int split_cols; size_t split_stride; float scale0;
    __device__ __forceinline__ void operator()(const f32x4 (&acc)[2][2][4][2], const Unit& u, int wr, int wc, int fr, int fq) const {
        const int row0 = u.pm * BM + wr * 64 + fr; int colt = u.pn * BM; bf16_t* base = O;
        float sc = 1.f; if (split_cols) { const int t = colt / split_cols; base += (size_t)t * split_stride; colt -= t * split_cols; if (t == 0) sc = scale0; }
        const int col0 = colt + wc * 32 + 8 * fq, bcol0 = u.pn * BM + wc * 32 + 8 * fq;
        f32x4 bv[2][2];
#pragma unroll
        for (int bj = 0; bj < 2; ++bj)
#pragma unroll
            for (int n = 0; n < 2; ++n) bv[bj][n] = bias ? *(const f32x4*)(bias + bcol0 + bj * HALF + 4 * n) : (f32x4){0.f, 0.f, 0.f, 0.f};
#pragma unroll
        for (int ai = 0; ai < 2; ++ai)
#pragma unroll
            for (int m = 0; m < 4; ++m) { bf16_t* rowp = base + (size_t)(row0 + ai * HALF + m * 16) * ldc + col0;
#pragma unroll
                for (int bj = 0; bj < 2; ++bj) { f32x4 v0 = acc[ai][bj][m][0] + bv[bj][0], v1 = acc[ai][bj][m][1] + bv[bj][1];
                    if (ACT == 1) { f32x2 a = gelu_pk((f32x2){v0[0], v0[1]}), b = gelu_pk((f32x2){v0[2], v0[3]}), c = gelu_pk((f32x2){v1[0], v1[1]}), d = gelu_pk((f32x2){v1[2], v1[3]});
                        v0 = (f32x4){a.x, a.y, b.x, b.y}; v1 = (f32x4){c.x, c.y, d.x, d.y}; }
                    v0 = v0 * sc; v1 = v1 * sc; u32x4 w; w.x = cvt_pk_bf16(v0[0], v0[1]); w.y = cvt_pk_bf16(v0[2], v0[3]); w.z = cvt_pk_bf16(v1[0], v1[1]); w.w = cvt_pk_bf16(v1[2], v1[3]);
                    *(u32x4*)(rowp + bj * HALF) = w; } }
    }
};
template <class Epi, class Sched, bool ALIGN_EPI = false, bool SP2 = false>
__device__ __forceinline__ void gemm_phase(PG8_LAS unsigned char* lds, const Gemm g, const Sched& S, const Epi& E) {
    int tid_ = threadIdx.x; asm volatile("" : "+v"(tid_));
    const int tid = tid_, wid = __builtin_amdgcn_readfirstlane(tid >> 6), lane = tid & 63, wr = wid >> 2, wc = wid & 3, fr = lane & 15, fq = lane >> 4;
    const int K = g.K, nt = K / BK;
    unsigned voffA[2], voffB[2];
#pragma unroll
    for (int i = 0; i < 2; ++i) { int R, C; stage_rc(tid * 16 + i * 8192, R, C); const int Rb = Epi::PERM ? ((R & ~31) + perm32(R & 31)) : R;
        voffA[i] = (unsigned)(R * K + C) * 2u; voffB[i] = (unsigned)(Rb * K + C) * 2u; }
    const size_t kstep = (size_t)(BK * 2);
    const size_t hstep = (size_t)HALF * K * 2;
    const size_t tstep = 2 * hstep;
    const unsigned ldsw = (unsigned)wid * 1024u;
    const int aoff = lds_byte(wr * 64 + fr, fq * 8), boff = lds_byte(wc * 32 + fr, fq * 8);
#define PG8_SA(b, h) (((b) * 2 + (h)) * HTB)
#define PG8_SB(b, h) ((4 + (b) * 2 + (h)) * HTB)
#define PG8_STAGE(bufoff, gbase, voff) do { _Pragma("unroll") for (int _i = 0; _i < 2; ++_i) \
        __builtin_amdgcn_global_load_lds((const unsigned*)((const char*)(gbase) + (voff)[_i]), (PG8_LAS unsigned*)(lds + (bufoff) + ldsw + _i * 8192), 16, 0, 0); } while (0)
#define PG8_LDA(dst, b, h) do { _Pragma("unroll") for (int m = 0; m < 4; ++m) _Pragma("unroll") for (int k = 0; k < 2; ++k) dst[m][k] = *(const PG8_LAS bf16x8*)(lds + PG8_SA(b, h) + aoff + m * 2048 + k * 1024); } while (0)
#define PG8_LDB(dst, b, h) do { _Pragma("unroll") for (int n = 0; n < 2; ++n) _Pragma("unroll") for (int k = 0; k < 2; ++k) dst[n][k] = *(const PG8_LAS bf16x8*)(lds + PG8_SB(b, h) + boff + n * 2048 + k * 1024); } while (0)
#define PG8_MMA(ai, bj, At, Bt) do { __builtin_amdgcn_s_setprio(1); _Pragma("unroll") for (int m = 0; m < 4; ++m) _Pragma("unroll") for (int n = 0; n < 2; ++n) _Pragma("unroll") for (int k = 0; k < 2; ++k) \
        acc[ai][bj][m][n] = __builtin_amdgcn_mfma_f32_16x16x32_bf16(Bt[n][k], At[m][k], acc[ai][bj][m][n], 0, 0, 0); __builtin_amdgcn_s_setprio(0); } while (0)
#define PG8_WAIT_V(n) asm volatile("s_waitcnt vmcnt(" #n ")" ::: "memory")
#define PG8_WAIT_L(n) asm volatile("s_waitcnt lgkmcnt(" #n ")" ::: "memory")
#define PG8_BAR __builtin_amdgcn_s_barrier()
#define PG8_SCHED __builtin_amdgcn_sched_barrier(0)
    Unit cur, nxt; int ui = 0;
    if (!S.next(0, cur)) return;
    f32x4 acc[2][2][4][2];
#pragma unroll
    for (int a = 0; a < 2; ++a)
#pragma unroll
        for (int b = 0; b < 2; ++b)
#pragma unroll
            for (int m = 0; m < 4; ++m)
#pragma unroll
                for (int n = 0; n < 2; ++n) acc[a][b][m][n] = (f32x4){0.f, 0.f, 0.f, 0.f};
    bf16x8 At[4][2], B0[2][2], B1[2][2];
    const char* cA = (const char*)g.A + (size_t)cur.pm * tstep; const char* cB = (const char*)g.Bt + (size_t)cur.pn * tstep;
    S.a_ready(cur);
    if constexpr (SP2) {
        PG8_STAGE(PG8_SB(0, 0), cB, voffB); PG8_STAGE(PG8_SB(0, 1), cB + hstep, voffB); PG8_STAGE(PG8_SA(0, 0), cA, voffA); PG8_STAGE(PG8_SA(0, 1), cA + hstep, voffA);
        if (wr == 1) PG8_BAR;
        PG8_WAIT_V(2); PG8_BAR;
        PG8_STAGE(PG8_SB(1, 0), cB + kstep, voffB); PG8_STAGE(PG8_SA(1, 0), cA + kstep, voffA); PG8_STAGE(PG8_SB(1, 1), cB + hstep + kstep, voffB);
        PG8_WAIT_V(6); PG8_BAR;
    } else {
        PG8_STAGE(PG8_SB(0, 0), cB, voffB); PG8_STAGE(PG8_SA(0, 0), cA, voffA); PG8_STAGE(PG8_SB(0, 1), cB + hstep, voffB); PG8_STAGE(PG8_SA(0, 1), cA + hstep, voffA);
        if (wr == 1) PG8_BAR;
        PG8_WAIT_V(4); PG8_BAR;
        PG8_STAGE(PG8_SB(1, 0), cB + kstep, voffB); PG8_STAGE(PG8_SA(1, 0), cA + kstep, voffA); PG8_STAGE(PG8_SB(1, 1), cB + hstep + kstep, voffB);
        PG8_WAIT_V(6); PG8_BAR;
    }
    for (;;) {
        const bool has_next = S.next(ui + 1, nxt);
        const char* nA = has_next ? (const char*)g.A + (size_t)nxt.pm * tstep : cA; const char* nB = has_next ? (const char*)g.Bt + (size_t)nxt.pn * tstep : cB;
        for (int t = 0; t < nt; t += 2) {
            const bool last = (t == nt - 2);
            const char* a1 = cA + (size_t)(t + 1) * kstep;
            const char* a2 = last ? nA : cA + (size_t)(t + 2) * kstep; const char* b2 = last ? nB : cB + (size_t)(t + 2) * kstep;
            const char* a3 = a2 + kstep; const char* b3 = b2 + kstep;
            if (last && has_next) S.a_ready(nxt);
            if constexpr (SP2) {
            PG8_LDB(B0, 0, 0); PG8_LDB(B1, 0, 1); PG8_SCHED; PG8_LDA(At, 0, 0); PG8_STAGE(PG8_SA(1, 1), a1 + hstep, voffA);
            PG8_WAIT_V(8); PG8_WAIT_L(0); PG8_BAR; PG8_MMA(0, 0, At, B0); PG8_MMA(0, 1, At, B1); PG8_BAR; PG8_SCHED;
            PG8_LDA(At, 0, 1); PG8_STAGE(PG8_SB(0, 0), b2, voffB); PG8_STAGE(PG8_SB(0, 1), b2 + hstep, voffB); PG8_STAGE(PG8_SA(0, 0), a2, voffA);
            PG8_WAIT_V(8); PG8_WAIT_L(0); PG8_BAR; PG8_MMA(1, 0, At, B0); PG8_MMA(1, 1, At, B1); PG8_BAR; PG8_SCHED;
            PG8_LDB(B0, 1, 0); PG8_LDB(B1, 1, 1); PG8_SCHED; PG8_LDA(At, 1, 0); PG8_STAGE(PG8_SA(0, 1), a2 + hstep, voffA);
            PG8_WAIT_V(8); PG8_WAIT_L(0); PG8_BAR; PG8_MMA(0, 0, At, B0); PG8_MMA(0, 1, At, B1); PG8_BAR; PG8_SCHED;
            PG8_LDA(At, 1, 1); PG8_STAGE(PG8_SB(1, 0), b3, voffB); PG8_STAGE(PG8_SB(1, 1), b3 + hstep, voffB); PG8_STAGE(PG8_SA(1, 0), a3, voffA);
            PG8_WAIT_V(8); PG8_WAIT_L(0); PG8_BAR; PG8_MMA(1, 0, At, B0); PG8_MMA(1, 1, At, B1); PG8_BAR; PG8_SCHED;
            } else {
            PG8_LDB(B0, 0, 0); PG8_SCHED; PG8_LDA(At, 0, 0); PG8_STAGE(PG8_SA(1, 1), a1 + hstep, voffA);
            PG8_WAIT_L(8); PG8_BAR; PG8_WAIT_L(0); PG8_MMA(0, 0, At, B0); PG8_BAR; PG8_SCHED;
            PG8_LDB(B1, 0, 1); PG8_STAGE(PG8_SB(0, 0), b2, voffB);
            PG8_BAR; PG8_WAIT_L(0); PG8_MMA(0, 1, At, B1); PG8_BAR;
            PG8_LDA(At, 0, 1); PG8_STAGE(PG8_SA(0, 0), a2, voffA);
            PG8_BAR; PG8_WAIT_L(0); PG8_MMA(1, 0, At, B0); PG8_BAR; PG8_SCHED;
            PG8_STAGE(PG8_SB(0, 1), b2 + hstep, voffB);
            PG8_WAIT_V(6); PG8_BAR; PG8_MMA(1, 1, At, B1); PG8_BAR;
            PG8_LDB(B0, 1, 0); PG8_SCHED; PG8_LDA(At, 1, 0); PG8_STAGE(PG8_SA(0, 1), a2 + hstep, voffA);
            PG8_WAIT_L(8); PG8_BAR; PG8_WAIT_L(0); PG8_MMA(0, 0, At, B0); PG8_BAR; PG8_SCHED;
            PG8_LDB(B1, 1, 1); PG8_STAGE(PG8_SB(1, 0), b3, voffB);
            PG8_BAR; PG8_WAIT_L(0); PG8_MMA(0, 1, At, B1); PG8_BAR;
            PG8_LDA(At, 1, 1); PG8_STAGE(PG8_SA(1, 0), a3, voffA);
            PG8_BAR; PG8_WAIT_L(0); PG8_MMA(1, 0, At, B0); PG8_BAR; PG8_SCHED;
            PG8_STAGE(PG8_SB(1, 1), b3 + hstep, voffB);
            PG8_WAIT_V(6); PG8_BAR; PG8_MMA(1, 1, At, B1); PG8_BAR;
            }
        }
        if constexpr (ALIGN_EPI) { if (wr == 0) PG8_BAR; }
        if constexpr (!Epi::AFTER_DRAIN) { E(acc, cur, wr, wc, fr, fq); S.done(cur); }
        if (!has_next) break;
#pragma unroll
        for (int a = 0; a < 2; ++a)
#pragma unroll
            for (int b = 0; b < 2; ++b)
#pragma unroll
                for (int m = 0; m < 4; ++m)
#pragma unroll
                    for (int n = 0; n < 2; ++n) acc[a][b][m][n] = (f32x4){0.f, 0.f, 0.f, 0.f};
        cur = nxt; cA = nA; cB = nB; ++ui;
        if constexpr (ALIGN_EPI) { if (wr == 1) PG8_BAR; }
    }
    PG8_WAIT_V(0);
    if constexpr (!ALIGN_EPI) { if (wr == 0) PG8_BAR; }
    PG8_BAR;
    if constexpr (Epi::AFTER_DRAIN) { E.fused(acc, cur, wr, wc, fr, fq, lds, wid, lane); S.done(cur); }
#undef PG8_SA
#undef PG8_SB
#undef PG8_STAGE
#undef PG8_LDA
#undef PG8_LDB
#undef PG8_MMA
#undef PG8_WAIT_V
#undef PG8_WAIT_L
#undef PG8_BAR
#undef PG8_SCHED
}
}

typedef unsigned short bf16;
typedef unsigned v4u __attribute__((ext_vector_type(4)));
typedef unsigned v2u __attribute__((ext_vector_type(2)));
typedef float f32x4 __attribute__((ext_vector_type(4)));
typedef float f32x2 __attribute__((ext_vector_type(2)));
typedef float f32x16 __attribute__((ext_vector_type(16)));
typedef short bf16x8 __attribute__((ext_vector_type(8)));
typedef short s16x4 __attribute__((ext_vector_type(4)));
typedef GAS unsigned gu32;

constexpr int D = 1024, NB = 16, SEQ = 4096, LCX = 256, DEPTH = 4;
constexpr int NL = NB * SEQ, NC = NB * LCX, NT = NL + NC;
constexpr int N_IN = 2592, PCOLS = 2048, D_OFF = 1824, HYC = 768;
constexpr int FFD = 2816, FFE = 3584, NE = 8;
constexpr float ALPHA = 1.6817928305074292f;
constexpr int NWAVES = 8, NTHR = 512;
constexpr int KSEQ = SEQ + LCX;

enum { I_X = 0, I_C, I_CTX, I_CCTX, I_ADAW, I_ADAB, I_WIN, I_QNORM, I_KVNORM, I_WUQ, I_WUKV, I_MLAON, I_LCW, I_LCB, I_LWR, I_LBR, I_LWI, I_LBI, I_LLAM, I_LON,
       I_MUP, I_MUN, I_W0, I_WUP, I_A0, I_AUP, I_GUP, I_KK, I_KA, I_RK, I_LNG, I_LNB, I_HCW, I_HCB, I_HW1, I_HB1, I_HW2, I_HB2, I_HW3, I_HD, I_HON,
       I_WOUT, I_LN1G, I_LN1B, I_LN2G, I_LN2B, I_FG, I_FU, I_FD, I_ROUTER, I_MG, I_MU, I_MD, N_INPUTS };

constexpr size_t MiB = 1u << 20;
constexpr size_t WS_CTL = 0, CTL_ZERO_BYTES = 1 * MiB;
constexpr size_t WS_MOD = 1 * MiB;
constexpr size_t WS_ROPE = 3 * MiB;
constexpr size_t WS_H2L = 4 * MiB;
constexpr size_t WS_H2C = 8 * MiB;
constexpr size_t WS_LRUW = 9 * MiB;
constexpr size_t WS_WUQT = 10 * MiB;
constexpr size_t WS_WUKVT = 11 * MiB;
constexpr size_t WS_SUMM = 12 * MiB;
constexpr size_t WS_BON = 17 * MiB;
constexpr size_t WS_TOKE = 20 * MiB;
constexpr size_t WS_TOKG = 21 * MiB;
constexpr size_t WS_TOKS = 22 * MiB;
constexpr size_t WS_BLKCNT = 23 * MiB;
constexpr size_t WS_SPEC = 24 * MiB;
constexpr size_t WS_WINT = 56 * MiB;
constexpr size_t WS_WHYT = 72 * MiB;
constexpr size_t WS_WOUTT = 78 * MiB;
constexpr size_t WS_WGUT = 86 * MiB;
constexpr size_t WS_WDT = 108 * MiB;
constexpr size_t WS_XC = 120 * MiB;
constexpr size_t WS_A1 = 136 * MiB;
constexpr size_t WS_ARENA = 272 * MiB;
constexpr size_t WS_P = WS_ARENA;
constexpr size_t WS_HT = 544 * MiB;
constexpr size_t WS_QB = 646 * MiB;
constexpr size_t WS_KB = 697 * MiB;
constexpr size_t WS_VT = 748 * MiB;
constexpr size_t WS_AO = 782 * MiB;
constexpr size_t WS_HOT = 816 * MiB;
constexpr size_t WS_YR = 850 * MiB;
constexpr size_t WS_Y = 986 * MiB;
constexpr size_t WS_H = WS_ARENA;
constexpr size_t WS_MGU = WS_ARENA;
constexpr size_t WS_MD = 384 * MiB;
constexpr size_t WS_XS = 440 * MiB;
constexpr size_t WS_HM = 716 * MiB;
constexpr size_t WS_END = 1122 * MiB;
constexpr int MOE_MAX_TILES = 552, MOE_NCHUNK = 3, MOE_CHUNK_TILES = 184;
static_assert(WS_HM + (size_t)MOE_CHUNK_TILES * 256 * FFE * 2 <= WS_END, "moe hidden chunk");
static_assert(WS_H + (size_t)NT * FFD * 2 <= WS_QB + 51 * MiB, "dense hidden");

constexpr int CW_BAR = 4096;

constexpr int RING_BYTES = 131072;
constexpr int LDSCTL_OFF = RING_BYTES;
constexpr int LDS_TILEE = LDSCTL_OFF + 256;
constexpr int LDS_MOEI = LDSCTL_OFF + 1024;
constexpr int LDS_BYTES = 147456;

#define LDS_WAIT() asm volatile("s_waitcnt lgkmcnt(0)" ::: "memory")
#define VM_WAIT() asm volatile("s_waitcnt vmcnt(0)" ::: "memory")
__device__ __forceinline__ unsigned f2bf(float f) { unsigned u = __builtin_bit_cast(unsigned, f); return (u + 0x7fffu + ((u >> 16) & 1u)) >> 16; }
__device__ __forceinline__ unsigned pk2(float lo, float hi) { return f2bf(lo) | (f2bf(hi) << 16); }
__device__ __forceinline__ float bf2f(unsigned b) { return __builtin_bit_cast(float, b << 16); }
__device__ __forceinline__ float bflo(unsigned w) { return __builtin_bit_cast(float, w << 16); }
__device__ __forceinline__ float bfhi(unsigned w) { return __builtin_bit_cast(float, w & 0xffff0000u); }
__device__ __forceinline__ float wave_sum(float v) {
#pragma unroll
    for (int o = 1; o < 64; o <<= 1) v += __shfl_xor(v, o);
    return v;
}
__device__ __forceinline__ float sigmoidf_(float x) { return 1.f / (1.f + __expf(-x)); }
#define XB_TMO      128
#define XB_XCNT(j)  (256  + 64 * (j))
#define XB_XSUB(j)  (1280 + 64 * (j))
#define XB_XGEN(j)  (2304 + 64 * (j))
#define XB_TOP      3328
#define XB_TOPGEN   3392
#define XCD_BAR_WORDS 3456
#define XB_SPIN_CAP (1u << 18)

__device__ __forceinline__ unsigned xb_ld(unsigned* p)              { return __hip_atomic_load(p, __ATOMIC_RELAXED, __HIP_MEMORY_SCOPE_AGENT); }
__device__ __forceinline__ unsigned xb_add(unsigned* p, unsigned v) { return __hip_atomic_fetch_add(p, v, __ATOMIC_RELAXED, __HIP_MEMORY_SCOPE_AGENT); }
__device__ __forceinline__ unsigned xb_xcc_id() { return (unsigned)__builtin_amdgcn_s_getreg((3 << 11) | 20) & 0xFu; }
#define XB_SPIN(cond, bar) do { unsigned _sp = 0; while (cond) { __builtin_amdgcn_s_sleep(1); \
    if ((++_sp & 255u) == 0u) { if (xb_ld(&(bar)[XB_TMO])) break; if (_sp > XB_SPIN_CAP) { atomicAdd(&(bar)[XB_TMO], 1u); break; } } } } while (0)

struct XcdBarrier {
    unsigned* bar; unsigned x;
    volatile LAS unsigned* st;
};

__device__ __forceinline__ XcdBarrier xcd_barrier_post(unsigned* bar, volatile LAS unsigned* st) {
    XcdBarrier b; b.bar = bar; b.x = xb_xcc_id(); b.st = st;
    if (threadIdx.x == 0) (void)xb_add(&bar[XB_XCNT(b.x)], 1u);
    return b;
}
__device__ __forceinline__ void xcd_barrier_complete(unsigned* bar, unsigned x, unsigned& nloc, unsigned& nx) {
    const unsigned G = gridDim.x * gridDim.y * gridDim.z;
    unsigned sum, cnt, mine, sp = 0u;
    for (;;) {
        sum = 0u; cnt = 0u; mine = 0u;
#pragma unroll
        for (unsigned j = 0; j < 16; ++j) { const unsigned c = xb_ld(&bar[XB_XCNT(j)]); sum += c; cnt += (c > 0u) ? 1u : 0u; mine = (j == x) ? c : mine; }
        if (sum == G) break;
        __builtin_amdgcn_s_sleep(1);
        if ((++sp & 255u) == 0u) { if (xb_ld(&bar[XB_TMO])) break; if (sp > XB_SPIN_CAP) { atomicAdd(&bar[XB_TMO], 1u); break; } }
    }
    nloc = mine > 0u ? mine : 1u; nx = cnt > 0u ? cnt : 1u;
}

__device__ __forceinline__ void xcd_barrier(const XcdBarrier& b) {
    asm volatile("s_waitcnt vmcnt(0)" ::: "memory");
    __syncthreads();
    if (threadIdx.x == 0) {
        unsigned* bar = b.bar;
        __builtin_amdgcn_s_waitcnt(0);
        unsigned nloc = b.st[0], nx = b.st[1];
        if (nloc == 0u) { xcd_barrier_complete(bar, b.x, nloc, nx); b.st[0] = nloc; b.st[1] = nx; }
        const unsigned old = xb_add(&bar[XB_XSUB(b.x)], 1u);
        const unsigned gen = old / nloc;
        if (old + 1u == (gen + 1u) * nloc) {
            __builtin_amdgcn_fence(__ATOMIC_RELEASE, "agent");
            asm volatile("s_waitcnt vmcnt(0)" ::: "memory");
            const unsigned og = xb_add(&bar[XB_TOP], 1u);
            const unsigned tg = og / nx;
            if (og + 1u == (tg + 1u) * nx) xb_add(&bar[XB_TOPGEN], 1u);
            else XB_SPIN(xb_ld(&bar[XB_TOPGEN]) == tg, bar);
            __builtin_amdgcn_fence(__ATOMIC_ACQUIRE, "agent");
            xb_add(&bar[XB_XGEN(b.x)], 1u);
            asm volatile("s_waitcnt vmcnt(0)" ::: "memory");
        } else {
            XB_SPIN(xb_ld(&bar[XB_XGEN(b.x)]) == gen, bar);
            __builtin_amdgcn_fence(__ATOMIC_ACQUIRE, "agent");
            asm volatile("s_waitcnt vmcnt(0)" ::: "memory");
        }
    }
    __syncthreads();
}

struct Args { const float* in[N_INPUTS]; float* out; unsigned char* ws; };
struct Frame { LAS unsigned char* lds; int tid, lane, wave, G; };
__device__ __forceinline__ void frame_refresh(Frame& F) { int t = threadIdx.x; asm volatile("" : "+v"(t)); F.tid = t; F.lane = t & 63; }
#define CAS __attribute__((address_space(4)))
__device__ __forceinline__ const CAS char* karg() { const CAS char* kp = (const CAS char*)__builtin_amdgcn_kernarg_segment_ptr(); asm volatile("" : "+s"(kp)); return kp; }
__device__ __forceinline__ const float* in_ptr(int i) { return *(const float* const CAS*)(karg() + 8 * i); }
__device__ __forceinline__ float* out_ptr() { return *(float* const CAS*)(karg() + 8 * N_INPUTS); }
__device__ __forceinline__ unsigned char* ws_ptr() { return *(unsigned char* const CAS*)(karg() + 8 * N_INPUTS + 8); }
#define WSP(T, off) ((T*)(ws + (off)))
#define WS_DECL unsigned char* const ws = ws_ptr()

namespace pg8 {
struct EpiStore {
    static constexpr bool PERM = true, AFTER_DRAIN = false;
    bf16_t* O; int ldc; int pm_add; int nN;
    __device__ __forceinline__ void operator()(const f32x4 (&acc)[2][2][4][2], const Unit& u, int wr, int wc, int fr, int fq) const {
        const int row0 = (u.pm + pm_add) * BM + wr * 64 + fr; const int col0 = (u.pn % nN) * BM + wc * 32 + 8 * fq;
#pragma unroll
        for (int ai = 0; ai < 2; ++ai)
#pragma unroll
            for (int m = 0; m < 4; ++m) { bf16_t* rowp = O + (size_t)(row0 + ai * HALF + m * 16) * ldc + col0;
#pragma unroll
                for (int bj = 0; bj < 2; ++bj) { const f32x4 v0 = acc[ai][bj][m][0], v1 = acc[ai][bj][m][1];
                    u32x4 w; w.x = cvt_pk_bf16(v0[0], v0[1]); w.y = cvt_pk_bf16(v0[2], v0[3]); w.z = cvt_pk_bf16(v1[0], v1[1]); w.w = cvt_pk_bf16(v1[2], v1[3]);
                    *(u32x4*)(rowp + bj * HALF) = w; } }
    }
};
__device__ __forceinline__ float silu_mul(float g, float u) { return g * __builtin_amdgcn_rcpf(1.f + __expf(-g)) * u; }
struct EpiSwiGLU {
    static constexpr bool PERM = true, AFTER_DRAIN = false;
    bf16_t* H; int ldh; int pm_sub; int nN;
    __device__ __forceinline__ void operator()(const f32x4 (&acc)[2][2][4][2], const Unit& u, int wr, int wc, int fr, int fq) const {
        const int row0 = (u.pm - pm_sub) * BM + wr * 64 + fr; const int col0 = (u.pn % nN) * HALF + wc * 32 + 8 * fq;
#pragma unroll
        for (int ai = 0; ai < 2; ++ai)
#pragma unroll
            for (int m = 0; m < 4; ++m) { bf16_t* rowp = H + (size_t)(row0 + ai * HALF + m * 16) * ldh + col0;
                const f32x4 g0 = acc[ai][0][m][0], g1 = acc[ai][0][m][1], u0 = acc[ai][1][m][0], u1 = acc[ai][1][m][1];
                u32x4 w; w.x = cvt_pk_bf16(silu_mul(g0[0], u0[0]), silu_mul(g0[1], u0[1])); w.y = cvt_pk_bf16(silu_mul(g0[2], u0[2]), silu_mul(g0[3], u0[3]));
                w.z = cvt_pk_bf16(silu_mul(g1[0], u1[0]), silu_mul(g1[1], u1[1])); w.w = cvt_pk_bf16(silu_mul(g1[2], u1[2]), silu_mul(g1[3], u1[3]));
                *(u32x4*)rowp = w; }
    }
};
struct MoeOrder {
    int nM, nN, nwg, G, c, t0, pm_off; const PG8_LAS unsigned char* tile_e;
    __device__ void init(int nM_, int nN_, int G_, int c_, int t0_, int pm_off_, const PG8_LAS unsigned char* te) { nM = nM_; nN = nN_; nwg = nM * nN; G = G_; c = c_; t0 = t0_; pm_off = pm_off_; tile_e = te; }
    __device__ bool next(int i, Unit& u) const {
        const long L = (long)i * G + c; if (L >= nwg) return false;
        int wgid = (int)L; { const int q = nwg / NXCD, r = nwg % NXCD, xcd = wgid % NXCD, off = wgid / NXCD; wgid = (xcd < r ? xcd * (q + 1) : r * (q + 1) + (xcd - r) * q) + off; }
        const int nig = WGM * nN, gid = wgid / nig, fm = gid * WGM, gsz = (nM - fm) < WGM ? (nM - fm) : WGM;
        const int pml = fm + ((wgid % nig) % gsz), pnl = (wgid % nig) / gsz;
        const int e = tile_e[t0 + pml];
        u.pm = pm_off + pml; u.pn = e * nN + pnl; return true;
    }
    __device__ __forceinline__ void a_ready(const Unit&) const {}
    __device__ __forceinline__ void done(const Unit&) const {}
};
}

__device__ __forceinline__ void tr_item(const float* W, int ldw, int k0, int c0, bf16* WT, int K, int drow, LAS float* scr, int lane) {
#pragma unroll 8
    for (int i = 0; i < 32; ++i) { const int kk = 2 * i + (lane >> 5); scr[kk * 33 + (lane & 31)] = W[(size_t)(k0 + kk) * ldw + c0 + (lane & 31)]; }
    LDS_WAIT(); asm volatile("" ::: "memory");
    const int c = lane & 7;
#pragma unroll
    for (int j = 0; j < 4; ++j) { const int n = (lane >> 3) + 8 * j; const LAS float* s = scr + (8 * c) * 33 + n;
        v4u o; o.x = pk2(s[0 * 33], s[1 * 33]); o.y = pk2(s[2 * 33], s[3 * 33]); o.z = pk2(s[4 * 33], s[5 * 33]); o.w = pk2(s[6 * 33], s[7 * 33]);
        *(GAS v4u*)(WT + (size_t)(drow + n) * K + k0 + 8 * c) = o; }
    LDS_WAIT(); asm volatile("" ::: "memory");
}
__device__ __forceinline__ void conv_matrix(Frame& F, const float* W, int K, int ldw, int cbeg, int ncols, bf16* WT, int mode, int rowoff, int& cursor) {
    const int gw = blockIdx.x * NWAVES + F.wave, NGW = F.G * NWAVES;
    const int nblk = ncols / 32, nit = (K / 64) * nblk;
    LAS float* scr = (LAS float*)(F.lds + F.wave * 16384);
    int first = cursor + (((gw - cursor) % NGW) + NGW) % NGW;
    for (int it = first; it < cursor + nit; it += NGW) {
        const int idx = it - cursor, kb = idx / nblk, nb = idx % nblk, n = 32 * nb;
        const int drow = mode == 0 ? rowoff + n : ((n >> 7) * 256 + (n & 127) + rowoff);
        tr_item(W, ldw, 64 * kb, cbeg + n, WT, K, drow, scr, F.lane);
    }
    cursor += nit;
}

__device__ __forceinline__ void phase_mod(Frame& F) { WS_DECL; frame_refresh(F);
    LAS float* sv = (LAS float*)F.lds;
    LAS float* red = (LAS float*)(F.lds + 69632);
    float* MOD = WSP(float, WS_MOD);
    if ((int)blockIdx.x < 192) {
        const float* cl_ = in_ptr(I_C); const float* cc_ = in_ptr(I_CCTX); const float* adab = in_ptr(I_ADAB); const float* adaw = in_ptr(I_ADAW);
        for (int i = F.tid; i < 17 * 1024; i += NTHR) { const int b = i >> 10, k = i & 1023; const float c = b < 16 ? cl_[b * 1024 + k] : cc_[k]; sv[i] = c / (1.f + expf(-c)); }
        __syncthreads();
        for (int item = blockIdx.x; item < 192; item += F.G) {
            const int li = item / 48, cg = item % 48, cl = F.tid & 127, kq = F.tid >> 7;
            const float* W = adaw + (size_t)li * 1024 * 6144 + cg * 128 + cl;
            float acc[17];
#pragma unroll
            for (int b = 0; b < 17; ++b) acc[b] = 0.f;
            for (int k = kq * 256; k < kq * 256 + 256; ++k) { const float w = W[(size_t)k * 6144];
#pragma unroll
                for (int b = 0; b < 17; ++b) acc[b] += sv[b * 1024 + k] * w; }
#pragma unroll
            for (int b = 0; b < 17; ++b) red[(kq * 17 + b) * 128 + cl] = acc[b];
            __syncthreads();
            for (int o = F.tid; o < 17 * 128; o += NTHR) { const int b = o >> 7, c = o & 127;
                const float s = (red[(0 * 17 + b) * 128 + c] + red[(1 * 17 + b) * 128 + c]) + (red[(2 * 17 + b) * 128 + c] + red[(3 * 17 + b) * 128 + c]);
                MOD[((size_t)li * 17 + b) * 6144 + cg * 128 + c] = s + adab[li * 6144 + cg * 128 + c]; }
            __syncthreads();
        }
    }
}

__device__ __forceinline__ void phase_pro0(Frame& F) { WS_DECL; frame_refresh(F);
    phase_mod(F);
    __syncthreads();
    int cursor = 0;
    for (int li = 0; li < DEPTH; ++li) {
        conv_matrix(F, in_ptr(I_WIN) + (size_t)li * D * N_IN, D, N_IN, 0, D_OFF, WSP(bf16, WS_WINT) + (size_t)li * PCOLS * D, 0, 0, cursor);
        conv_matrix(F, in_ptr(I_WIN) + (size_t)li * D * N_IN, D, N_IN, D_OFF, HYC, WSP(bf16, WS_WHYT) + (size_t)li * HYC * D, 0, 0, cursor);
        conv_matrix(F, in_ptr(I_WOUT) + (size_t)li * D * D, D, D, 0, D, WSP(bf16, WS_WOUTT) + (size_t)li * D * D, 0, 0, cursor);
    }
    for (int j = 0; j < 2; ++j) {
        conv_matrix(F, in_ptr(I_FG) + (size_t)j * D * FFD, D, FFD, 0, FFD, WSP(bf16, WS_WGUT) + (size_t)j * 2 * FFD * D, 1, 0, cursor);
        conv_matrix(F, in_ptr(I_FU) + (size_t)j * D * FFD, D, FFD, 0, FFD, WSP(bf16, WS_WGUT) + (size_t)j * 2 * FFD * D, 1, 128, cursor);
        conv_matrix(F, in_ptr(I_FD) + (size_t)j * FFD * D, FFD, D, 0, D, WSP(bf16, WS_WDT) + (size_t)j * D * FFD, 0, 0, cursor);
    }
    { const int gt = blockIdx.x * NTHR + F.tid, NGT = F.G * NTHR; const int per = (PCOLS - D_OFF) * D / 8;
      for (int i = gt; i < DEPTH * per; i += NGT) { const int li = i / per, r = i % per; *(GAS v4u*)(WSP(bf16, WS_WINT) + (size_t)li * PCOLS * D + (size_t)D_OFF * D + (size_t)r * 8) = (v4u){0u, 0u, 0u, 0u}; } }
}

struct Stream { const float* inl; const float* inc; float* outl; float* outc; };
__device__ __forceinline__ Stream make_stream(unsigned char* ws, int li) { Stream s; s.outl = out_ptr(); s.outc = WSP(float, WS_XC); s.inl = li == 0 ? in_ptr(I_X) : (const float*)s.outl; s.inc = li == 0 ? in_ptr(I_CTX) : (const float*)s.outc; return s; }
__device__ __forceinline__ const float* stream_in(const Stream& s, int m) { return m < NL ? s.inl + (size_t)m * D : s.inc + (size_t)(m - NL) * D; }
__device__ __forceinline__ float* stream_out(const Stream& s, int m) { return m < NL ? s.outl + (size_t)m * D : s.outc + (size_t)(m - NL) * D; }
__device__ __forceinline__ int mod_b(int m) { return m < NL ? (m >> 12) : 16; }
__device__ __forceinline__ const float* mod_vec(unsigned char* ws, int li, int b, int j) { return WSP(float, WS_MOD) + ((size_t)li * 17 + b) * 6144 + j * 1024; }

__device__ __forceinline__ void store_modulated(const f32x4 (&x)[4], const float* shift, const float* scale, bf16* orow, int lane) {
#pragma unroll
    for (int j = 0; j < 4; ++j) { const int c = 4 * lane + 256 * j; const f32x4 sh = *(const GAS f32x4*)(shift + c), sc = *(const GAS f32x4*)(scale + c);
        const f32x4 h = x[j] * (sc + 1.f) + sh; v2u w; w.x = pk2(h.x, h.y); w.y = pk2(h.z, h.w); *(GAS v2u*)(orow + c) = w; }
}
__device__ __forceinline__ void rows_range(const Frame& F, int nrows, int& r0, int& r1) { const int per = (nrows + F.G - 1) / F.G; r0 = blockIdx.x * per; r1 = r0 + per < nrows ? r0 + per : nrows; if (r0 > nrows) r0 = nrows; }

__device__ __forceinline__ void phase_hin0(Frame& F) { WS_DECL; frame_refresh(F);
    int r0, r1; rows_range(F, NT, r0, r1); const Stream st = make_stream(ws, 0);
    for (int m = r0 + F.wave; m < r1; m += NWAVES) {
        const float* xr = stream_in(st, m); f32x4 x[4];
#pragma unroll
        for (int j = 0; j < 4; ++j) x[j] = *(const GAS f32x4*)(xr + 4 * F.lane + 256 * j);
        const int b = mod_b(m);
        store_modulated(x, mod_vec(ws, 0, b, 0), mod_vec(ws, 0, b, 1), WSP(bf16, WS_A1) + (size_t)m * D, F.lane);
    }
}

__device__ __forceinline__ void ln_rows(f32x4 (&v)[4], const float* g, const float* bta, int lane) {
    float s = 0.f;
#pragma unroll
    for (int j = 0; j < 4; ++j) s += (v[j].x + v[j].y) + (v[j].z + v[j].w);
    const float mean = wave_sum(s) * (1.f / D); float s2 = 0.f;
#pragma unroll
    for (int j = 0; j < 4; ++j) { v[j] = v[j] - mean; s2 += (v[j].x * v[j].x + v[j].y * v[j].y) + (v[j].z * v[j].z + v[j].w * v[j].w); }
    const float rstd = 1.f / sqrtf(wave_sum(s2) * (1.f / D) + 1e-5f);
#pragma unroll
    for (int j = 0; j < 4; ++j) { const int c = 4 * lane + 256 * j; v[j] = v[j] * rstd * *(const GAS f32x4*)(g + c) + *(const GAS f32x4*)(bta + c); }
}

template <bool HAVE_Y>
__device__ __forceinline__ void phase_ln1(Frame& F, int li) { WS_DECL; frame_refresh(F);
    const int nrows = li == DEPTH - 1 ? NL : NT; const bool moe = li & 1;
    LAS int* hist = (LAS int*)(F.lds + LDS_MOEI) + 56;
    if (moe) { if (F.tid < 8) hist[F.tid] = 0; __syncthreads(); }
    int r0, r1; rows_range(F, nrows, r0, r1);
    const float* g = in_ptr(I_LN1G) + li * D; const float* bt = in_ptr(I_LN1B) + li * D; const Stream st = make_stream(ws, li);
    const float* router = in_ptr(I_ROUTER) + (size_t)(li >> 1) * D * NE;
    for (int m = r0 + F.wave; m < r1; m += NWAVES) {
        const float* xr = stream_in(st, m); const int b = mod_b(m); f32x4 v[4];
        const float* m2 = mod_vec(ws, li, b, 2);
#pragma unroll
        for (int j = 0; j < 4; ++j) { const int c = 4 * F.lane + 256 * j; v[j] = *(const GAS f32x4*)(xr + c) * ALPHA;
            if (HAVE_Y) { const v2u yw = *(const GAS v2u*)(WSP(bf16, WS_Y) + (size_t)m * D + c); const f32x4 mm = *(const GAS f32x4*)(m2 + c);
                v[j].x += mm.x * bflo(yw.x); v[j].y += mm.y * bfhi(yw.x); v[j].z += mm.z * bflo(yw.y); v[j].w += mm.w * bfhi(yw.y); } }
        ln_rows(v, g, bt, F.lane);
        float* xo = stream_out(st, m);
#pragma unroll
        for (int j = 0; j < 4; ++j) *(GAS f32x4*)(xo + 4 * F.lane + 256 * j) = v[j];
        const float* sh = mod_vec(ws, li, b, 3); const float* sc = mod_vec(ws, li, b, 4);
        if (moe) {
            float lg[NE];
#pragma unroll
            for (int e = 0; e < NE; ++e) lg[e] = 0.f;
#pragma unroll
            for (int j = 0; j < 4; ++j) { const int c = 4 * F.lane + 256 * j; const f32x4 s4 = *(const GAS f32x4*)(sh + c), c4 = *(const GAS f32x4*)(sc + c); const f32x4 f = v[j] * (c4 + 1.f) + s4;
#pragma unroll
                for (int q = 0; q < 4; ++q) { const f32x4 ra = *(const GAS f32x4*)(router + (size_t)(c + q) * NE), rb = *(const GAS f32x4*)(router + (size_t)(c + q) * NE + 4); const float fq = f[q];
                    lg[0] += fq * ra.x; lg[1] += fq * ra.y; lg[2] += fq * ra.z; lg[3] += fq * ra.w; lg[4] += fq * rb.x; lg[5] += fq * rb.y; lg[6] += fq * rb.z; lg[7] += fq * rb.w; } }
#pragma unroll
            for (int e = 0; e < NE; ++e) lg[e] = wave_sum(lg[e]);
            int e0 = 0; float v0 = lg[0];
#pragma unroll
            for (int e = 1; e < NE; ++e) if (lg[e] > v0) { v0 = lg[e]; e0 = e; }
            int e1 = -1; float v1 = -3.0e38f;
#pragma unroll
            for (int e = 0; e < NE; ++e) if (e != e0 && lg[e] > v1) { v1 = lg[e]; e1 = e; }
            const float ex = __expf(v1 - v0), g0 = 1.f / (1.f + ex), g1 = ex * g0;
            if (F.lane == 0) { *(GAS v2u*)(WSP(int, WS_TOKE) + 2 * (size_t)m) = (v2u){(unsigned)e0, (unsigned)e1}; *(GAS f32x2*)(WSP(float, WS_TOKG) + 2 * (size_t)m) = (f32x2){g0, g1};
                atomicAdd((int*)(hist + e0), 1); atomicAdd((int*)(hist + e1), 1); }
        }
        store_modulated(v, sh, sc, WSP(bf16, WS_A1) + (size_t)m * D, F.lane);
    }
    if (moe) { __syncthreads(); if (F.tid < 8) WSP(int, WS_BLKCNT)[blockIdx.x * 8 + F.tid] = hist[F.tid]; }
}

template <bool HAVE_FFN>
__device__ __forceinline__ void phase_ln2(Frame& F, int li) { WS_DECL; frame_refresh(F);
    const int nrows = li == DEPTH - 1 ? NL : NT; const bool moe = li & 1;
    int r0, r1; rows_range(F, nrows, r0, r1);
    const float* g = in_ptr(I_LN2G) + li * D; const float* bt = in_ptr(I_LN2B) + li * D; const Stream st = make_stream(ws, 1);
    for (int m = r0 + F.wave; m < r1; m += NWAVES) {
        const float* xr = stream_out(st, m); const int b = mod_b(m); f32x4 v[4];
        const float* m5 = mod_vec(ws, li, b, 5);
        int s0 = 0, s1 = 0; float g0 = 0.f, g1 = 0.f;
        if (moe) { const v2u ss = *(const GAS v2u*)(WSP(int, WS_TOKS) + 2 * (size_t)m); const f32x2 gg = *(const GAS f32x2*)(WSP(float, WS_TOKG) + 2 * (size_t)m); s0 = (int)ss.x; s1 = (int)ss.y; g0 = gg.x; g1 = gg.y; }
#pragma unroll
        for (int j = 0; j < 4; ++j) { const int c = 4 * F.lane + 256 * j; v[j] = *(const GAS f32x4*)(xr + c) * ALPHA;
            if (HAVE_FFN) { const f32x4 mm = *(const GAS f32x4*)(m5 + c); f32x4 o;
                if (moe) { const v2u ya = *(const GAS v2u*)(WSP(bf16, WS_XS) + (size_t)s0 * D + c), yb = *(const GAS v2u*)(WSP(bf16, WS_XS) + (size_t)s1 * D + c);
                    o.x = g0 * bflo(ya.x) + g1 * bflo(yb.x); o.y = g0 * bfhi(ya.x) + g1 * bfhi(yb.x); o.z = g0 * bflo(ya.y) + g1 * bflo(yb.y); o.w = g0 * bfhi(ya.y) + g1 * bfhi(yb.y); }
                else { const v2u yw = *(const GAS v2u*)(WSP(bf16, WS_Y) + (size_t)m * D + c); o.x = bflo(yw.x); o.y = bfhi(yw.x); o.z = bflo(yw.y); o.w = bfhi(yw.y); }
                v[j] = v[j] + mm * o; } }
        ln_rows(v, g, bt, F.lane);
        float* xo = stream_out(st, m);
#pragma unroll
        for (int j = 0; j < 4; ++j) *(GAS f32x4*)(xo + 4 * F.lane + 256 * j) = v[j];
        if (li < DEPTH - 1) store_modulated(v, mod_vec(ws, li + 1, b, 0), mod_vec(ws, li + 1, b, 1), WSP(bf16, WS_A1) + (size_t)m * D, F.lane);
    }
}

__device__ __forceinline__ void phase_moe_weights(Frame& F, int li) { WS_DECL; frame_refresh(F);
    const int j = li >> 1; int cursor = 0;
    for (int e = 0; e < NE; ++e) {
        conv_matrix(F, in_ptr(I_MG) + ((size_t)j * NE + e) * D * FFE, D, FFE, 0, FFE, WSP(bf16, WS_MGU) + (size_t)e * 2 * FFE * D, 1, 0, cursor);
        conv_matrix(F, in_ptr(I_MU) + ((size_t)j * NE + e) * D * FFE, D, FFE, 0, FFE, WSP(bf16, WS_MGU) + (size_t)e * 2 * FFE * D, 1, 128, cursor);
        conv_matrix(F, in_ptr(I_MD) + ((size_t)j * NE + e) * FFE * D, FFE, D, 0, D, WSP(bf16, WS_MD) + (size_t)e * D * FFE, 0, 0, cursor);
    }
}

__device__ __forceinline__ void phase_moe_slots(Frame& F, int li) { WS_DECL; frame_refresh(F);
    const int nrows = li == DEPTH - 1 ? NL : NT;
    LAS int* mi = (LAS int*)(F.lds + LDS_MOEI); LAS unsigned char* tile_e = (LAS unsigned char*)(F.lds + LDS_TILEE);
    LAS int* slots = (LAS int*)F.lds;
    const int* blkcnt = WSP(int, WS_BLKCNT);
    if (F.tid < 8) { int tot = 0, pre = 0; for (int b = 0; b < F.G; ++b) { const int c = blkcnt[b * 8 + F.tid]; if (b < (int)blockIdx.x) pre += c; tot += c; } mi[16 + F.tid] = tot; mi[32 + F.tid] = pre; }
    __syncthreads();
    if (F.tid == 0) { int s = 0; for (int e = 0; e < NE; ++e) { mi[e] = s; s += (mi[16 + e] + 255) & ~255; } mi[8] = s; mi[48] = s >> 8; }
    __syncthreads();
    for (int t = F.tid; t < MOE_MAX_TILES + 8; t += NTHR) { int e = 0;
#pragma unroll
        for (int q = 1; q < NE; ++q) if (t * 256 >= mi[q]) e = q;
        tile_e[t] = (unsigned char)e; }
    int r0, r1; rows_range(F, nrows, r0, r1);
    const int na = 2 * (r1 - r0);
    if (F.wave == 0) {
        int run[NE];
#pragma unroll
        for (int e = 0; e < NE; ++e) run[e] = mi[e] + mi[32 + e];
        for (int base = 0; base < na; base += 64) { const int ai = base + F.lane; const bool ok = ai < na;
            const int e = ok ? WSP(int, WS_TOKE)[2 * (size_t)r0 + ai] : -1; int slot = 0;
#pragma unroll
            for (int q = 0; q < NE; ++q) { const unsigned long long mk = __ballot(e == q); if (e == q) slot = run[q] + __popcll(mk & ((1ull << F.lane) - 1ull)); run[q] += __popcll(mk); }
            if (ok) { slots[ai] = slot; WSP(int, WS_TOKS)[2 * (size_t)r0 + ai] = slot; } }
    }
    __syncthreads();
    for (int ai = F.wave; ai < na; ai += NWAVES) { const int m = r0 + (ai >> 1), slot = slots[ai];
        const GAS v4u* src = (const GAS v4u*)(WSP(bf16, WS_A1) + (size_t)m * D); GAS v4u* dst = (GAS v4u*)(WSP(bf16, WS_XS) + (size_t)slot * D);
        dst[F.lane] = src[F.lane]; dst[F.lane + 64] = src[F.lane + 64]; }
    { const int gw = blockIdx.x * NWAVES + F.wave, NGW = F.G * NWAVES; int cnt = 0;
      for (int e = 0; e < NE; ++e) { const int p0 = mi[e] + mi[16 + e], p1 = mi[e + 1];
          for (int s = p0; s < p1; ++s, ++cnt) if (cnt % NGW == gw) { GAS v4u* dst = (GAS v4u*)(WSP(bf16, WS_XS) + (size_t)s * D); dst[F.lane] = (v4u){0u, 0u, 0u, 0u}; dst[F.lane + 64] = (v4u){0u, 0u, 0u, 0u}; } } }
    __syncthreads();
}

constexpr float QSCALE = 0.14724319f;
constexpr int MP_CQ_LD = 200, MP_CKV_LD = 136;
__device__ __forceinline__ void phase_mla_prep(Frame& F, int li) { WS_DECL; frame_refresh(F);
    LAS bf16* CQN = (LAS bf16*)F.lds; LAS bf16* CKVN = (LAS bf16*)(F.lds + 64 * MP_CQ_LD * 2);
    const bf16* P = WSP(bf16, WS_P); bf16* QB = WSP(bf16, WS_QB); bf16* KB = WSP(bf16, WS_KB); bf16* VT = WSP(bf16, WS_VT);
    const float* qn = in_ptr(I_QNORM) + li * 192; const float* kvn = in_ptr(I_KVNORM) + li * 128;
    const bf16* WQ = WSP(bf16, WS_WUQT) + (size_t)li * 384 * 192; const bf16* WKV = WSP(bf16, WS_WUKVT) + (size_t)li * 512 * 128;
    const float* RC = WSP(float, WS_ROPE); const float* RS = RC + 4096 * 16;
    const int lane = F.lane, wave = F.wave;
    for (int item = blockIdx.x; item < NT / 64; item += F.G) {
        const int m0 = item * 64; const bool isctx = m0 >= NL; const int b = isctx ? (m0 - NL) >> 8 : m0 >> 12; const int t0 = isctx ? (m0 - NL) & 255 : m0 & 4095;
        const int ki0 = isctx ? t0 : 256 + t0;
        for (int i = 0; i < 8; ++i) { const int tl = wave * 8 + i; const bf16* pr = P + (size_t)(m0 + tl) * PCOLS;
            v4u raw = (v4u){0u, 0u, 0u, 0u}; if (lane < 40) raw = *(const GAS v4u*)(pr + 8 * lane);
            float x[8]; x[0] = bflo(raw.x); x[1] = bfhi(raw.x); x[2] = bflo(raw.y); x[3] = bfhi(raw.y); x[4] = bflo(raw.z); x[5] = bfhi(raw.z); x[6] = bflo(raw.w); x[7] = bfhi(raw.w);
            float ss = 0.f;
#pragma unroll
            for (int j = 0; j < 8; ++j) ss += x[j] * x[j];
            const float sq = wave_sum(lane < 24 ? ss : 0.f), skv = wave_sum((lane >= 24 && lane < 40) ? ss : 0.f);
            const float rq = rsqrtf(sq * (1.f / 192.f) + 1e-6f), rkv = rsqrtf(skv * (1.f / 128.f) + 1e-6f);
            if (lane < 24) { const float* g = qn + 8 * lane; v4u o; o.x = pk2(x[0] * rq * g[0], x[1] * rq * g[1]); o.y = pk2(x[2] * rq * g[2], x[3] * rq * g[3]); o.z = pk2(x[4] * rq * g[4], x[5] * rq * g[5]); o.w = pk2(x[6] * rq * g[6], x[7] * rq * g[7]);
                *(LAS v4u*)(CQN + tl * MP_CQ_LD + 8 * lane) = o; }
            else if (lane < 40) { const int c = 8 * (lane - 24); const float* g = kvn + c; v4u o; o.x = pk2(x[0] * rkv * g[0], x[1] * rkv * g[1]); o.y = pk2(x[2] * rkv * g[2], x[3] * rkv * g[3]); o.z = pk2(x[4] * rkv * g[4], x[5] * rkv * g[5]); o.w = pk2(x[6] * rkv * g[6], x[7] * rkv * g[7]);
                *(LAS v4u*)(CKVN + tl * MP_CKV_LD + c) = o; }
            if (lane < 16) { float x1 = bf2f(pr[320 + lane]), x2 = bf2f(pr[336 + lane]);
                if (!isctx) { const float c = RC[(t0 + tl) * 16 + lane], s = RS[(t0 + tl) * 16 + lane]; const float y1 = x1 * c - x2 * s, y2 = x1 * s + x2 * c; x1 = y1; x2 = y2; }
                const bf16 o1 = (bf16)f2bf(x1), o2 = (bf16)f2bf(x2);
#pragma unroll
                for (int h = 0; h < 4; ++h) { bf16* kr = KB + ((size_t)(b * 4 + h) * KSEQ + ki0 + tl) * 96; kr[64 + lane] = o1; kr[80 + lane] = o2; } }
        }
        __syncthreads();
        const int head = wave >> 1, half = wave & 1, fr = lane & 15, kg = lane >> 4;
        const size_t qrow0 = ((size_t)(b * 4 + head) * KSEQ + ki0) * 96;
        for (int qi = 0; qi < 2; ++qi) {
            const int nt = half * 3 + qi; if (half == 1 && qi == 1) break;
            f32x4 acc[4];
#pragma unroll
            for (int m = 0; m < 4; ++m) acc[m] = (f32x4){0.f, 0.f, 0.f, 0.f};
#pragma unroll
            for (int ks = 0; ks < 6; ++ks) { const bf16x8 wf = *(const GAS bf16x8*)(WQ + (size_t)(96 * head + 16 * nt + fr) * 192 + 32 * ks + 8 * kg);
#pragma unroll
                for (int m = 0; m < 4; ++m) { const bf16x8 xf = *(const LAS bf16x8*)(CQN + (16 * m + fr) * MP_CQ_LD + 32 * ks + 8 * kg); acc[m] = __builtin_amdgcn_mfma_f32_16x16x32_bf16(wf, xf, acc[m], 0, 0, 0); } }
#pragma unroll
            for (int m = 0; m < 4; ++m) { v2u o; o.x = pk2(acc[m][0] * QSCALE, acc[m][1] * QSCALE); o.y = pk2(acc[m][2] * QSCALE, acc[m][3] * QSCALE);
                *(GAS v2u*)(QB + qrow0 + (size_t)(16 * m + fr) * 96 + 16 * nt + 4 * kg) = o; }
        }
        if (half == 0) {
            f32x4 acc[4];
#pragma unroll
            for (int m = 0; m < 4; ++m) acc[m] = (f32x4){0.f, 0.f, 0.f, 0.f};
#pragma unroll
            for (int ks = 0; ks < 6; ++ks) { const bf16x8 wf = *(const GAS bf16x8*)(WQ + (size_t)(96 * head + 32 + fr) * 192 + 32 * ks + 8 * kg);
#pragma unroll
                for (int m = 0; m < 4; ++m) { const bf16x8 xf = *(const LAS bf16x8*)(CQN + (16 * m + fr) * MP_CQ_LD + 32 * ks + 8 * kg); acc[m] = __builtin_amdgcn_mfma_f32_16x16x32_bf16(wf, xf, acc[m], 0, 0, 0); } }
#pragma unroll
            for (int m = 0; m < 4; ++m) { v2u o; o.x = pk2(acc[m][0] * QSCALE, acc[m][1] * QSCALE); o.y = pk2(acc[m][2] * QSCALE, acc[m][3] * QSCALE);
                *(GAS v2u*)(QB + qrow0 + (size_t)(16 * m + fr) * 96 + 32 + 4 * kg) = o; }
        } else {
            f32x4 a1[4], a2[4];
#pragma unroll
            for (int m = 0; m < 4; ++m) { a1[m] = (f32x4){0.f, 0.f, 0.f, 0.f}; a2[m] = (f32x4){0.f, 0.f, 0.f, 0.f}; }
#pragma unroll
            for (int ks = 0; ks < 6; ++ks) { const bf16x8 w1 = *(const GAS bf16x8*)(WQ + (size_t)(96 * head + 64 + fr) * 192 + 32 * ks + 8 * kg), w2 = *(const GAS bf16x8*)(WQ + (size_t)(96 * head + 80 + fr) * 192 + 32 * ks + 8 * kg);
#pragma unroll
                for (int m = 0; m < 4; ++m) { const bf16x8 xf = *(const LAS bf16x8*)(CQN + (16 * m + fr) * MP_CQ_LD + 32 * ks + 8 * kg);
                    a1[m] = __builtin_amdgcn_mfma_f32_16x16x32_bf16(w1, xf, a1[m], 0, 0, 0); a2[m] = __builtin_amdgcn_mfma_f32_16x16x32_bf16(w2, xf, a2[m], 0, 0, 0); } }
#pragma unroll
            for (int m = 0; m < 4; ++m) { f32x4 y1 = a1[m], y2 = a2[m];
                if (!isctx) { const int t = t0 + 16 * m + fr; const f32x4 c = *(const GAS f32x4*)(RC + t * 16 + 4 * kg), s = *(const GAS f32x4*)(RS + t * 16 + 4 * kg); y1 = a1[m] * c - a2[m] * s; y2 = a1[m] * s + a2[m] * c; }
                v2u o1, o2; o1.x = pk2(y1[0] * QSCALE, y1[1] * QSCALE); o1.y = pk2(y1[2] * QSCALE, y1[3] * QSCALE); o2.x = pk2(y2[0] * QSCALE, y2[1] * QSCALE); o2.y = pk2(y2[2] * QSCALE, y2[3] * QSCALE);
                bf16* qr = QB + qrow0 + (size_t)(16 * m + fr) * 96; *(GAS v2u*)(qr + 64 + 4 * kg) = o1; *(GAS v2u*)(qr + 80 + 4 * kg) = o2; }
        }
        for (int nt = 0; nt < 4; ++nt) {
            f32x4 acc[4];
#pragma unroll
            for (int m = 0; m < 4; ++m) acc[m] = (f32x4){0.f, 0.f, 0.f, 0.f};
#pragma unroll
            for (int ks = 0; ks < 4; ++ks) { const bf16x8 wf = *(const GAS bf16x8*)(WKV + (size_t)(128 * head + 64 * half + 16 * nt + fr) * 128 + 32 * ks + 8 * kg);
#pragma unroll
                for (int m = 0; m < 4; ++m) { const bf16x8 xf = *(const LAS bf16x8*)(CKVN + (16 * m + fr) * MP_CKV_LD + 32 * ks + 8 * kg);
                    acc[m] = half == 0 ? __builtin_amdgcn_mfma_f32_16x16x32_bf16(wf, xf, acc[m], 0, 0, 0) : __builtin_amdgcn_mfma_f32_16x16x32_bf16(xf, wf, acc[m], 0, 0, 0); } }
            if (half == 0) {
#pragma unroll
                for (int m = 0; m < 4; ++m) { v2u o; o.x = pk2(acc[m][0], acc[m][1]); o.y = pk2(acc[m][2], acc[m][3]);
                    *(GAS v2u*)(KB + qrow0 + (size_t)(16 * m + fr) * 96 + 16 * nt + 4 * kg) = o; }
            } else {
#pragma unroll
                for (int m = 0; m < 4; ++m) { v2u o; o.x = pk2(acc[m][0], acc[m][1]); o.y = pk2(acc[m][2], acc[m][3]);
                    *(GAS v2u*)(VT + ((size_t)(b * 4 + head) * 64 + 16 * nt + fr) * KSEQ + ki0 + 16 * m + 4 * kg) = o; }
            }
        }
        __syncthreads();
    }
}

constexpr int AT_KLD = 104, AT_VLD = 72;
constexpr int AT_KB = 64 * AT_KLD * 2, AT_VB = 64 * AT_VLD * 2, AT_BUF = AT_KB + AT_VB;
__device__ __forceinline__ void phase_attn(Frame& F, int li) { WS_DECL; frame_refresh(F);
    const bf16* QB = WSP(bf16, WS_QB); const bf16* KB = WSP(bf16, WS_KB); const bf16* VT = WSP(bf16, WS_VT); bf16* AO = WSP(bf16, WS_AO);
    const int lane = F.lane, wave = F.wave, tid = F.tid, ql = lane & 31, h2 = lane >> 5;
    const int nunits = 1024 + (li < DEPTH - 1 ? 64 : 0);
    const int c = blockIdx.x, vc = (F.G == 256) ? (c & 7) * 32 + (c >> 3) : c;
    for (int u = vc; u < nunits; u += F.G) {
        int bh, q0, nk; bool isctx = u >= 1024;
        if (!isctx) { bh = u >> 4; q0 = 256 + 256 * (u & 15); nk = KSEQ; } else { bh = u - 1024; q0 = 0; nk = 256; }
        const bf16* Kb = KB + (size_t)bh * KSEQ * 96; const bf16* Vb = VT + (size_t)bh * 64 * KSEQ;
        bf16x8 qf[6];
        { const bf16* qr = QB + ((size_t)bh * KSEQ + q0 + 32 * wave + ql) * 96 + 8 * h2;
#pragma unroll
          for (int ks = 0; ks < 6; ++ks) qf[ks] = *(const GAS bf16x8*)(qr + 16 * ks); }
        f32x16 O0, O1;
#pragma unroll
        for (int r = 0; r < 16; ++r) { O0[r] = 0.f; O1[r] = 0.f; }
        float m_run = -1e30f, l_run = 0.f;
        const int kc0 = tid, kc1 = tid + 512; const int vr = tid >> 3, vcn = tid & 7;
        v4u pk0, pk1 = (v4u){0u, 0u, 0u, 0u}, pv;
        { const GAS v4u* ks = (const GAS v4u*)Kb; pk0 = ks[kc0]; if (kc1 < 768) pk1 = ks[kc1]; pv = *(const GAS v4u*)(Vb + (size_t)vr * KSEQ + 8 * vcn); }
        __syncthreads();
        { LAS unsigned char* buf = F.lds; *(LAS v4u*)(buf + (kc0 / 12) * (AT_KLD * 2) + (kc0 % 12) * 16) = pk0; if (kc1 < 768) *(LAS v4u*)(buf + (kc1 / 12) * (AT_KLD * 2) + (kc1 % 12) * 16) = pk1;
          *(LAS v4u*)(buf + AT_KB + vr * (AT_VLD * 2) + vcn * 16) = pv; }
        __syncthreads();
        const int ntile = nk >> 6;
        for (int kt = 0; kt < ntile; ++kt) {
            const LAS unsigned char* buf = F.lds + (kt & 1) * AT_BUF; LAS unsigned char* nbuf = F.lds + ((kt + 1) & 1) * AT_BUF;
            const bool more = kt + 1 < ntile;
            if (more) { const GAS v4u* ks = (const GAS v4u*)(Kb + (size_t)(kt + 1) * 64 * 96); pk0 = ks[kc0]; if (kc1 < 768) pk1 = ks[kc1]; pv = *(const GAS v4u*)(Vb + (size_t)vr * KSEQ + (kt + 1) * 64 + 8 * vcn); }
            f32x16 S0, S1;
#pragma unroll
            for (int r = 0; r < 16; ++r) { S0[r] = 0.f; S1[r] = 0.f; }
#pragma unroll
            for (int ks = 0; ks < 6; ++ks) { const bf16x8 k0 = *(const LAS bf16x8*)(buf + ql * (AT_KLD * 2) + 32 * ks + 16 * h2), k1 = *(const LAS bf16x8*)(buf + (32 + ql) * (AT_KLD * 2) + 32 * ks + 16 * h2);
                S0 = __builtin_amdgcn_mfma_f32_32x32x16_bf16(k0, qf[ks], S0, 0, 0, 0); S1 = __builtin_amdgcn_mfma_f32_32x32x16_bf16(k1, qf[ks], S1, 0, 0, 0); }
            float mx = S0[0];
#pragma unroll
            for (int r = 1; r < 16; ++r) mx = fmaxf(mx, S0[r]);
#pragma unroll
            for (int r = 0; r < 16; ++r) mx = fmaxf(mx, S1[r]);
            mx = fmaxf(mx, __shfl_xor(mx, 32));
            const float m_new = fmaxf(m_run, mx), alpha = __builtin_amdgcn_exp2f(m_run - m_new); m_run = m_new;
            float ps = 0.f;
#pragma unroll
            for (int r = 0; r < 16; ++r) { S0[r] = __builtin_amdgcn_exp2f(S0[r] - m_new); S1[r] = __builtin_amdgcn_exp2f(S1[r] - m_new); ps += S0[r] + S1[r]; }
            l_run = l_run * alpha + ps;
#pragma unroll
            for (int r = 0; r < 16; ++r) { O0[r] *= alpha; O1[r] *= alpha; }
            union { bf16x8 v; unsigned u[4]; } p00, p01, p10, p11;
#pragma unroll
            for (int j = 0; j < 4; ++j) { p00.u[j] = pk2(S0[2 * j], S0[2 * j + 1]); p01.u[j] = pk2(S0[8 + 2 * j], S0[8 + 2 * j + 1]); p10.u[j] = pk2(S1[2 * j], S1[2 * j + 1]); p11.u[j] = pk2(S1[8 + 2 * j], S1[8 + 2 * j + 1]); }
            const LAS unsigned char* vb = buf + AT_KB;
#pragma unroll
            for (int dvt = 0; dvt < 2; ++dvt) { const LAS unsigned char* vrow = vb + (32 * dvt + ql) * (AT_VLD * 2) + 8 * h2;
#pragma unroll
                for (int sub = 0; sub < 2; ++sub)
#pragma unroll
                    for (int s = 0; s < 2; ++s) { union { bf16x8 v; v2u h[2]; } vf; vf.h[0] = *(const LAS v2u*)(vrow + 2 * (32 * sub + 16 * s)); vf.h[1] = *(const LAS v2u*)(vrow + 2 * (32 * sub + 16 * s + 8));
                        const bf16x8 pf = sub == 0 ? (s == 0 ? p00.v : p01.v) : (s == 0 ? p10.v : p11.v);
                        if (dvt == 0) O0 = __builtin_amdgcn_mfma_f32_32x32x16_bf16(vf.v, pf, O0, 0, 0, 0); else O1 = __builtin_amdgcn_mfma_f32_32x32x16_bf16(vf.v, pf, O1, 0, 0, 0); } }
            if (more) { *(LAS v4u*)(nbuf + (kc0 / 12) * (AT_KLD * 2) + (kc0 % 12) * 16) = pk0; if (kc1 < 768) *(LAS v4u*)(nbuf + (kc1 / 12) * (AT_KLD * 2) + (kc1 % 12) * 16) = pk1;
                *(LAS v4u*)(nbuf + AT_KB + vr * (AT_VLD * 2) + vcn * 16) = pv; }
            __syncthreads();
        }
        const float inv = 1.f / (l_run + __shfl_xor(l_run, 32));
        const int b = bh >> 2, head = bh & 3, qi = q0 + 32 * wave + ql;
        const size_t row = isctx ? (size_t)NL + b * 256 + qi : (size_t)b * 4096 + (qi - 256);
        bf16* orow = AO + row * 256 + head * 64 + 4 * h2;
#pragma unroll
        for (int g = 0; g < 4; ++g) { v2u o0, o1; o0.x = pk2(O0[4 * g] * inv, O0[4 * g + 1] * inv); o0.y = pk2(O0[4 * g + 2] * inv, O0[4 * g + 3] * inv); o1.x = pk2(O1[4 * g] * inv, O1[4 * g + 1] * inv); o1.y = pk2(O1[4 * g + 2] * inv, O1[4 * g + 3] * inv);
            *(GAS v2u*)(orow + 8 * g) = o0; *(GAS v2u*)(orow + 32 + 8 * g) = o1; }
    }
}

__device__ __forceinline__ void phase_fin_mla(Frame& F, int li) { WS_DECL; frame_refresh(F);
    const int nrows = li == DEPTH - 1 ? NL : NT; const float* g = in_ptr(I_MLAON) + li * 256; const bf16* AO = WSP(bf16, WS_AO); bf16* MIX = WSP(bf16, WS_A1);
    const int gw = blockIdx.x * NWAVES + F.wave, NGW = F.G * NWAVES; const f32x4 g4 = *(const GAS f32x4*)(g + 4 * F.lane);
    for (int m = gw; m < nrows; m += NGW) { const v2u w = *(const GAS v2u*)(AO + (size_t)m * 256 + 4 * F.lane);
        f32x4 x; x.x = bflo(w.x); x.y = bfhi(w.x); x.z = bflo(w.y); x.w = bfhi(w.y);
        const float r = rsqrtf(wave_sum(x.x * x.x + x.y * x.y + x.z * x.z + x.w * x.w) * (1.f / 256.f) + 1e-6f);
        v2u o; o.x = pk2(x.x * r * g4.x, x.y * r * g4.y); o.y = pk2(x.z * r * g4.z, x.w * r * g4.w); *(GAS v2u*)(MIX + (size_t)m * D + 4 * F.lane) = o; }
}
__device__ __forceinline__ void phase_fin_zero(Frame& F, int li, int c0) { WS_DECL; frame_refresh(F);
    const int nrows = li == DEPTH - 1 ? NL : NT; bf16* MIX = WSP(bf16, WS_A1); const int gw = blockIdx.x * NWAVES + F.wave, NGW = F.G * NWAVES;
    for (int m = gw; m < nrows; m += NGW) *(GAS v2u*)(MIX + (size_t)m * D + c0 + 4 * F.lane) = (v2u){0u, 0u};
}

__device__ __forceinline__ void phase_pro0b(Frame& F) { WS_DECL; frame_refresh(F);
    const int gt = blockIdx.x * NTHR + F.tid, NGT = F.G * NTHR;
    float* RC = WSP(float, WS_ROPE); float* RS = RC + 4096 * 16;
    for (int i = gt; i < 4096 * 16; i += NGT) { const int t = i >> 4, j = i & 15; const float inv = powf(10000.f, -(float)(j & 7) / 8.f); const float pos = j < 8 ? (float)(t >> 6) : (float)(t & 63);
        const float ang = pos * inv; RC[i] = cosf(ang); RS[i] = sinf(ang); }
    const float* wuq = in_ptr(I_WUQ); const float* wukv = in_ptr(I_WUKV); bf16* WQ = WSP(bf16, WS_WUQT); bf16* WKV = WSP(bf16, WS_WUKVT);
    for (int i = gt; i < DEPTH * 384 * 192; i += NGT) { const int li = i / (384 * 192), r = i % (384 * 192), n = r / 192, k = r % 192; WQ[i] = (bf16)f2bf(wuq[(size_t)li * 192 * 384 + (size_t)k * 384 + n]); }
    for (int i = gt; i < DEPTH * 512 * 128; i += NGT) { const int li = i / (512 * 128), r = i % (512 * 128), n = r / 128, k = r % 128; WKV[i] = (bf16)f2bf(wukv[(size_t)li * 128 * 512 + (size_t)k * 512 + n]); }
}

constexpr int LR_LD = 264;
__device__ __forceinline__ float gelu_tanh(float x) { const float u = 0.7978845608028654f * (x + 0.044715f * x * x * x); const float e = __expf(2.f * u); const float t = 1.f - 2.f / (e + 1.f); return 0.5f * x * (1.f + t); }
template <int PASS>
__device__ __forceinline__ void phase_lru(Frame& F, int li) { WS_DECL; frame_refresh(F);
    LAS bf16* RAW = (LAS bf16*)F.lds; LAS bf16* U = (LAS bf16*)(F.lds + 67 * LR_LD * 2); LAS bf16* HS = (LAS bf16*)(F.lds + 71680);
    const bf16* P = WSP(bf16, WS_P); bf16* MIX = WSP(bf16, WS_A1); f32x2* SUMM = WSP(f32x2, WS_SUMM);
    const float* cw = in_ptr(I_LCW) + li * 4 * 256; const float* cb = in_ptr(I_LCB) + li * 256;
    const float* lam_ = in_ptr(I_LLAM) + li * 512; const float* br_ = in_ptr(I_LBR) + li * 512; const float* bi_ = in_ptr(I_LBI) + li * 512; const float* on_ = in_ptr(I_LON) + li * 256;
    const bf16* LW = WSP(bf16, WS_LRUW) + (size_t)li * 16 * 4096;
    const int lane = F.lane, wave = F.wave, tid = F.tid, fr = lane & 15, kg = lane >> 4;
    const int nitems = (PASS == 3 && li == DEPTH - 1) ? NL / 64 : NT / 64;
    for (int item = blockIdx.x; item < nitems; item += F.G) {
        const int m0 = item * 64; const bool isctx = m0 >= NL; const int b = isctx ? (m0 - NL) >> 8 : m0 >> 12; const int t0 = isctx ? (m0 - NL) & 255 : m0 & 4095; const int Ls = isctx ? 256 : 4096;
        const size_t seg0 = isctx ? (size_t)NL + b * 256 : (size_t)b * 4096;
        for (int c = tid; c < 67 * 32; c += NTHR) { const int r = c >> 5, cc = c & 31, t = t0 - 2 + r; v4u v = (v4u){0u, 0u, 0u, 0u};
            if (t >= 0 && t < Ls) v = *(const GAS v4u*)(P + (seg0 + t) * PCOLS + 352 + 8 * cc);
            *(LAS v4u*)(RAW + r * LR_LD + 8 * cc) = v; }
        __syncthreads();
        { const int c2 = tid & 127, tq = tid >> 7; const int ch = 2 * c2;
          float w0[4], w1[4];
#pragma unroll
          for (int j = 0; j < 4; ++j) { w0[j] = cw[j * 256 + ch]; w1[j] = cw[j * 256 + ch + 1]; }
          const float b0 = cb[ch], b1 = cb[ch + 1];
          for (int t = tq * 16; t < tq * 16 + 16; ++t) { float s0 = b0, s1 = b1;
#pragma unroll
              for (int j = 0; j < 4; ++j) { const unsigned w = *(const LAS unsigned*)(RAW + (t + j) * LR_LD + ch); s0 += w0[j] * bflo(w); s1 += w1[j] * bfhi(w); }
              *(LAS unsigned*)(U + t * LR_LD + ch) = pk2(s0, s1); } }
        __syncthreads();
#pragma unroll 1
        for (int ni = 0; ni < 2; ++ni) {
            float yv[4][4];
            const int nt = 2 * wave + ni, nb = nt >> 2, ch = 16 * nt + fr;
            float uu[4][4];
#pragma unroll
            for (int m = 0; m < 4; ++m)
#pragma unroll
                for (int r = 0; r < 4; ++r) uu[m][r] = bf2f(U[(16 * m + 4 * kg + r) * LR_LD + ch]);
#pragma unroll
            for (int d = 0; d < 2; ++d) {
                f32x4 ar[4], ai[4];
#pragma unroll
                for (int m = 0; m < 4; ++m) { ar[m] = (f32x4){0.f, 0.f, 0.f, 0.f}; ai[m] = (f32x4){0.f, 0.f, 0.f, 0.f}; }
#pragma unroll
                for (int ks = 0; ks < 2; ++ks) {
                    const bf16x8 wr = *(const GAS bf16x8*)(LW + ((size_t)((0 * 2 + d) * 4 + nb) * 64 + 16 * (nt & 3) + fr) * 64 + 32 * ks + 8 * kg);
                    const bf16x8 wi = *(const GAS bf16x8*)(LW + ((size_t)((1 * 2 + d) * 4 + nb) * 64 + 16 * (nt & 3) + fr) * 64 + 32 * ks + 8 * kg);
#pragma unroll
                    for (int m = 0; m < 4; ++m) { const bf16x8 xf = *(const LAS bf16x8*)(U + (16 * m + fr) * LR_LD + 64 * nb + 32 * ks + 8 * kg);
                        ar[m] = __builtin_amdgcn_mfma_f32_16x16x32_bf16(xf, wr, ar[m], 0, 0, 0); ai[m] = __builtin_amdgcn_mfma_f32_16x16x32_bf16(xf, wi, ai[m], 0, 0, 0); } }
                const float sp = log1pf(expf(-lam_[d * 256 + ch])), brv = br_[d * 256 + ch], biv = bi_[d * 256 + ch];
#pragma unroll
                for (int m = 0; m < 4; ++m)
#pragma unroll
                    for (int r = 0; r < 4; ++r) { const float rg = sigmoidf_(ar[m][r] + brv), ig = sigmoidf_(ai[m][r] + biv); const float la = -8.f * rg * sp;
                        ar[m][r] = __expf(la); ai[m][r] = sqrtf(fmaxf(-expm1f(2.f * la), 0.f)) * (ig * uu[m][r]); }
                float H = 0.f;
                if (PASS == 3) {
                    const int cj = t0 >> 6, cbase = 1024 + b * 4, lbase = b * 64;
                    const int np = d == 0 ? (isctx ? cj : 4 + cj) : (isctx ? 3 - cj : 4 + 63 - cj);
                    const int q = (np + 3) >> 2, p_lo = kg * q, p_hi = (p_lo + q < np) ? p_lo + q : np;
                    float Aq = 1.f, Bq = 0.f;
                    for (int p0 = p_lo; p0 < p_hi; p0 += 8) { f32x2 sv[8];
#pragma unroll
                        for (int e = 0; e < 8; ++e) { const int p = p0 + e; sv[e] = (f32x2){1.f, 0.f};
                            if (p < p_hi) { int cid; if (d == 0) cid = isctx ? cbase + p : (p < 4 ? cbase + p : lbase + (p - 4)); else cid = isctx ? cbase + 3 - p : (p < 4 ? cbase + 3 - p : lbase + 63 - (p - 4));
                                sv[e] = *(const GAS f32x2*)(SUMM + ((size_t)cid * 2 + d) * 256 + ch); } }
#pragma unroll
                        for (int e = 0; e < 8; ++e) { Bq = sv[e].x * Bq + sv[e].y; Aq = sv[e].x * Aq; } }
#pragma unroll
                    for (int g = 0; g < 4; ++g) { const float Ag_ = __shfl(Aq, fr + 16 * g), Bg_ = __shfl(Bq, fr + 16 * g); H = Ag_ * H + Bg_; }
                }
                float Ac = 1.f, Bc = 0.f;
#pragma unroll
                for (int mi = 0; mi < 4; ++mi) { const int m = d == 0 ? mi : 3 - mi;
                    float Al, Bl;
                    if (d == 0) { Al = ar[m][0] * ar[m][1] * ar[m][2] * ar[m][3]; Bl = ((ai[m][0] * ar[m][1] + ai[m][1]) * ar[m][2] + ai[m][2]) * ar[m][3] + ai[m][3]; }
                    else { Al = ar[m][0] * ar[m][1] * ar[m][2] * ar[m][3]; Bl = ((ai[m][3] * ar[m][2] + ai[m][2]) * ar[m][1] + ai[m][1]) * ar[m][0] + ai[m][0]; }
                    float Ag[4], Bg[4];
#pragma unroll
                    for (int g = 0; g < 4; ++g) { Ag[g] = __shfl(Al, fr + 16 * g); Bg[g] = __shfl(Bl, fr + 16 * g); }
                    if (PASS == 1) {
                        float At = 1.f, Bt = 0.f;
#pragma unroll
                        for (int gi = 0; gi < 4; ++gi) { const int g = d == 0 ? gi : 3 - gi; Bt = Ag[g] * Bt + Bg[g]; At = Ag[g] * At; }
                        Bc = At * Bc + Bt; Ac = At * Ac;
                    } else {
                        float s = H, sin_ = H;
#pragma unroll
                        for (int gi = 0; gi < 4; ++gi) { const int g = d == 0 ? gi : 3 - gi; if (g == kg) sin_ = s; s = Ag[g] * s + Bg[g]; }
                        H = s;
                        float x = sin_;
#pragma unroll
                        for (int ri = 0; ri < 4; ++ri) { const int r = d == 0 ? ri : 3 - ri; x = ar[m][r] * x + ai[m][r]; if (d == 0) yv[m][r] = x; else yv[m][r] += x; }
                    }
                }
                if (PASS == 1 && kg == 0) *(GAS f32x2*)(SUMM + ((size_t)item * 2 + d) * 256 + ch) = (f32x2){Ac, Bc};
            }
            if (PASS == 3) {
#pragma unroll
                for (int m = 0; m < 4; ++m)
#pragma unroll
                    for (int r = 0; r < 4; ++r) HS[(16 * m + 4 * kg + r) * LR_LD + ch] = (bf16)f2bf(yv[m][r]);
            }
        }
        if (PASS == 3) {
            __syncthreads();
            const f32x4 on4 = *(const GAS f32x4*)(on_ + 4 * lane);
            for (int i = 0; i < 8; ++i) { const int tl = wave * 8 + i; const v2u hw = *(const LAS v2u*)(HS + tl * LR_LD + 4 * lane); const v2u gw = *(const GAS v2u*)(P + (size_t)(m0 + tl) * PCOLS + 608 + 4 * lane);
                f32x4 y; y.x = bflo(hw.x) * gelu_tanh(bflo(gw.x)); y.y = bfhi(hw.x) * gelu_tanh(bfhi(gw.x)); y.z = bflo(hw.y) * gelu_tanh(bflo(gw.y)); y.w = bfhi(hw.y) * gelu_tanh(bfhi(gw.y));
                const float rs = rsqrtf(wave_sum(y.x * y.x + y.y * y.y + y.z * y.z + y.w * y.w) * (1.f / 256.f) + 1e-6f);
                v2u o; o.x = pk2(y.x * rs * on4.x, y.y * rs * on4.y); o.y = pk2(y.z * rs * on4.z, y.w * rs * on4.w);
                *(GAS v2u*)(MIX + (size_t)(m0 + tl) * D + 256 + 4 * lane) = o; }
        }
        __syncthreads();
    }
}

__device__ __forceinline__ void phase_pro0c(Frame& F) { WS_DECL; frame_refresh(F);
    const int gt = blockIdx.x * NTHR + F.tid, NGT = F.G * NTHR; const float* wr = in_ptr(I_LWR); const float* wi = in_ptr(I_LWI); bf16* LW = WSP(bf16, WS_LRUW);
    for (int i = gt; i < DEPTH * 16 * 4096; i += NGT) { const int c = i & 63, dd = (i >> 6) & 63, nb = (i >> 12) & 3, d = (i >> 14) & 1, g = (i >> 15) & 1, li = i >> 16;
        const float* src = g == 0 ? wr : wi; LW[i] = (bf16)f2bf(src[((((size_t)li * 2 + d) * 4 + nb) * 64 + c) * 64 + dd]); }
}

template <int CTRL> __device__ __forceinline__ float dpp_f(float x) { return __builtin_bit_cast(float, __builtin_amdgcn_mov_dpp(__builtin_bit_cast(int, x), CTRL, 0xf, 0xf, true)); }
__device__ __forceinline__ float rowsum16(float x) { x += dpp_f<0x128>(x); x += dpp_f<0x124>(x); x += dpp_f<0x122>(x); x += dpp_f<0x121>(x); return x; }
constexpr int RW_C0 = 864, RW_T = 32, RW_LD = 264;
constexpr int RW_RAW = 0;
constexpr int RW_MU = 18432;
constexpr int RW_WUP = 20480;
constexpr int RW_AUP = 28672;
constexpr int RW_VECS = 36864;
constexpr int RW_LORA = 38400;
constexpr int RW_VEC = 46592;
constexpr int RW_YO = 95744;
constexpr int RW_BON = 99840;
__device__ __forceinline__ void phase_rwkv_scan(Frame& F, int li) { WS_DECL; frame_refresh(F);
    LAS bf16* RAW = (LAS bf16*)(F.lds + RW_RAW); LAS float* MU = (LAS float*)(F.lds + RW_MU); LAS float* WUP = (LAS float*)(F.lds + RW_WUP); LAS float* AUP = (LAS float*)(F.lds + RW_AUP);
    LAS float* VECS = (LAS float*)(F.lds + RW_VECS); LAS float* LORA = (LAS float*)(F.lds + RW_LORA); LAS float* VEC = (LAS float*)(F.lds + RW_VEC); LAS float* YO = (LAS float*)(F.lds + RW_YO); LAS float* BONS = (LAS float*)(F.lds + RW_BON);
    const bf16* P = WSP(bf16, WS_P); float* YR = WSP(float, WS_YR); float* BON = WSP(float, WS_BON);
    const int tid = F.tid, lane = F.lane, wave = F.wave;
    for (int item = blockIdx.x; item < 256; item += F.G) {
        const int vhalf = item & 1, d = (item >> 1) & 1, h = (item >> 2) & 3, b = item >> 4;
        __syncthreads();
        { const float* mup = in_ptr(I_MUP) + li * 960; const float* mun = in_ptr(I_MUN) + li * 960;
          if (tid < 256) { int col; if (tid < 64) col = 64 * h + tid; else if (tid < 128) col = 256 + 64 * h + (tid - 64); else if (tid < 192) col = 512 + 64 * h + (tid - 128); else if (tid < 224) col = 768 + 32 * d + (tid - 192); else col = 832 + 32 * d + (tid - 224);
              MU[tid] = mup[col]; MU[256 + tid] = mun[col]; }
          const float* wup = in_ptr(I_WUP) + ((size_t)(li * 2 + d) * 32) * 256 + 64 * h; const float* aup = in_ptr(I_AUP) + ((size_t)(li * 2 + d) * 32) * 256 + 64 * h;
          for (int i = tid; i < 2048; i += NTHR) { WUP[i] = wup[(i >> 6) * 256 + (i & 63)]; AUP[i] = aup[(i >> 6) * 256 + (i & 63)]; }
          if (tid < 64) { VECS[tid] = in_ptr(I_W0)[(li * 2 + d) * 256 + 64 * h + tid]; VECS[64 + tid] = in_ptr(I_A0)[(li * 2 + d) * 256 + 64 * h + tid]; VECS[128 + tid] = in_ptr(I_KK)[li * 256 + 64 * h + tid];
              VECS[192 + tid] = in_ptr(I_KA)[li * 256 + 64 * h + tid]; VECS[256 + tid] = in_ptr(I_RK)[li * 256 + 64 * h + tid]; } }
        __syncthreads();
        f32x4 S = (f32x4){0.f, 0.f, 0.f, 0.f};
        const int srow = lane >> 4, kq = lane & 15, vloc = 4 * wave + srow;
        const int ps = tid >> 4, pq = tid & 15;
#pragma unroll 1
        for (int ck = 0; ck < (LCX + SEQ) / RW_T; ++ck) {
            const bool isctx = ck < LCX / RW_T; const int cl = isctx ? ck : ck - LCX / RW_T; const int Ls = isctx ? LCX : SEQ;
            const int tlo = d == 0 ? cl * RW_T : Ls - RW_T - cl * RW_T;
            const size_t seg0 = isctx ? (size_t)NL + b * LCX : (size_t)b * SEQ;
            for (int c = tid; c < 34 * 32; c += NTHR) { const int r = c >> 5, cc = c & 31, t = tlo - 1 + r; v4u v = (v4u){0u, 0u, 0u, 0u};
                int col; if (cc < 8) col = 64 * h + 8 * cc; else if (cc < 16) col = 256 + 64 * h + 8 * (cc - 8); else if (cc < 24) col = 512 + 64 * h + 8 * (cc - 16); else if (cc < 28) col = 768 + 32 * d + 8 * (cc - 24); else col = 832 + 32 * d + 8 * (cc - 28);
                if (t >= 0 && t < Ls) v = *(const GAS v4u*)(P + (seg0 + t) * PCOLS + RW_C0 + col);
                *(LAS v4u*)(RAW + r * RW_LD + 8 * cc) = v; }
            __syncthreads();
            const int prow = d == 0 ? ps + 1 : RW_T - ps;
            { const int j0 = 192 + 4 * pq;
#pragma unroll
              for (int i = 0; i < 4; ++i) { const int c = j0 + i; const float x = bf2f(RAW[prow * RW_LD + c]), xp = bf2f(RAW[(prow - 1) * RW_LD + c]), xn = bf2f(RAW[(prow + 1) * RW_LD + c]);
                  const float z = x + MU[c] * (xp - x) + MU[256 + c] * (xn - x); LORA[ps * 64 + 4 * pq + i] = (4 * pq + i) < 32 ? tanhf(z) : z; } }
            __syncthreads();
            { float zr[4], zk[4], zv[4], xw[4], xa[4];
#pragma unroll
              for (int i = 0; i < 4; ++i) { const int c = 4 * pq + i;
                  { const float x = bf2f(RAW[prow * RW_LD + c]), xp = bf2f(RAW[(prow - 1) * RW_LD + c]), xn = bf2f(RAW[(prow + 1) * RW_LD + c]); zr[i] = x + MU[c] * (xp - x) + MU[256 + c] * (xn - x); }
                  { const int c1 = 64 + c; const float x = bf2f(RAW[prow * RW_LD + c1]), xp = bf2f(RAW[(prow - 1) * RW_LD + c1]), xn = bf2f(RAW[(prow + 1) * RW_LD + c1]); zk[i] = x + MU[c1] * (xp - x) + MU[256 + c1] * (xn - x); }
                  { const int c2 = 128 + c; const float x = bf2f(RAW[prow * RW_LD + c2]), xp = bf2f(RAW[(prow - 1) * RW_LD + c2]), xn = bf2f(RAW[(prow + 1) * RW_LD + c2]); zv[i] = x + MU[c2] * (xp - x) + MU[256 + c2] * (xn - x); }
                  xw[i] = VECS[c]; xa[i] = VECS[64 + c]; }
              for (int j = 0; j < 32; ++j) { const float lw = LORA[ps * 64 + j], la = LORA[ps * 64 + 32 + j]; const f32x4 w4 = *(const LAS f32x4*)(WUP + j * 64 + 4 * pq), a4 = *(const LAS f32x4*)(AUP + j * 64 + 4 * pq);
                  xw[0] += lw * w4.x; xw[1] += lw * w4.y; xw[2] += lw * w4.z; xw[3] += lw * w4.w; xa[0] += la * a4.x; xa[1] += la * a4.y; xa[2] += la * a4.z; xa[3] += la * a4.w; }
              float kkr[4], kd[4], av[4], dec[4], ss = 0.f, bn = 0.f;
#pragma unroll
              for (int i = 0; i < 4; ++i) { const int c = 4 * pq + i; dec[i] = __expf(-0.6065306597126334f * sigmoidf_(xw[i])); av[i] = sigmoidf_(xa[i]);
                  kkr[i] = zk[i] * VECS[128 + c]; ss += kkr[i] * kkr[i]; kd[i] = zk[i] * (1.f + (av[i] - 1.f) * VECS[192 + c]); bn += zr[i] * kd[i] * VECS[256 + c]; }
              ss = rowsum16(ss); bn = rowsum16(bn);
              const float rn = rsqrtf(fmaxf(ss, 1e-24f));
              LAS float* vs = VEC + ps * 384 + 4 * pq;
              *(LAS f32x4*)(vs) = (f32x4){kkr[0] * rn, kkr[1] * rn, kkr[2] * rn, kkr[3] * rn};
              *(LAS f32x4*)(vs + 64) = (f32x4){dec[0], dec[1], dec[2], dec[3]};
              *(LAS f32x4*)(vs + 128) = (f32x4){kkr[0] * rn * av[0], kkr[1] * rn * av[1], kkr[2] * rn * av[2], kkr[3] * rn * av[3]};
              *(LAS f32x4*)(vs + 192) = (f32x4){kd[0], kd[1], kd[2], kd[3]};
              *(LAS f32x4*)(vs + 256) = (f32x4){zr[0], zr[1], zr[2], zr[3]};
              *(LAS f32x4*)(vs + 320) = (f32x4){zv[0], zv[1], zv[2], zv[3]};
              if (pq == 0) BONS[ps] = bn; }
            __syncthreads();
#pragma unroll 4
            for (int s = 0; s < RW_T; ++s) { const LAS float* vs = VEC + s * 384;
                const f32x4 kk4 = *(const LAS f32x4*)(vs + 4 * kq), dec4 = *(const LAS f32x4*)(vs + 64 + 4 * kq), kka4 = *(const LAS f32x4*)(vs + 128 + 4 * kq), kd4 = *(const LAS f32x4*)(vs + 192 + 4 * kq), r4 = *(const LAS f32x4*)(vs + 256 + 4 * kq);
                const float vv = vs[320 + 32 * vhalf + vloc];
                const float sa = rowsum16((S.x * kk4.x + S.y * kk4.y) + (S.z * kk4.z + S.w * kk4.w));
                S = S * dec4 + (kd4 * vv - kka4 * sa);
                const float y = rowsum16((S.x * r4.x + S.y * r4.y) + (S.z * r4.z + S.w * r4.w));
                if (kq == 0) YO[s * 32 + vloc] = y; }
            __syncthreads();
            if (!isctx || li < DEPTH - 1) {
                const int s = tid >> 4, pr = tid & 15; const int t = d == 0 ? tlo + s : tlo + RW_T - 1 - s; const size_t row = seg0 + t;
                *(GAS f32x2*)(YR + ((size_t)d * NT + row) * 256 + 64 * h + 32 * vhalf + 2 * pr) = (f32x2){YO[s * 32 + 2 * pr], YO[s * 32 + 2 * pr + 1]};
                if (vhalf == 0 && tid < 32) { const int t2 = d == 0 ? tlo + tid : tlo + RW_T - 1 - tid; BON[((size_t)d * NT + seg0 + t2) * 4 + h] = BONS[tid]; }
            }
            __syncthreads();
        }
    }
}

__device__ __forceinline__ void phase_fin_rwkv(Frame& F, int li) { WS_DECL; frame_refresh(F);
    const int nrows = li == DEPTH - 1 ? NL : NT; const int lane = F.lane, wave = F.wave, tid = F.tid;
    LAS float* GUP = (LAS float*)F.lds;
    LAS float* SG = (LAS float*)(F.lds + 65536) + wave * 64;
    const bf16* P = WSP(bf16, WS_P); const float* YR = WSP(float, WS_YR); const float* BON = WSP(float, WS_BON); bf16* MIX = WSP(bf16, WS_A1);
    { const float* gup = in_ptr(I_GUP) + (size_t)li * 64 * 256; for (int i = tid; i < 64 * 256; i += NTHR) GUP[i] = gup[i]; }
    const float* mup = in_ptr(I_MUP) + li * 960; const float* mun = in_ptr(I_MUN) + li * 960;
    const f32x4 mpv = *(const GAS f32x4*)(mup + 512 + 4 * lane), mnv = *(const GAS f32x4*)(mun + 512 + 4 * lane);
    const float mpg = mup[896 + lane], mng = mun[896 + lane];
    const f32x4 lg = *(const GAS f32x4*)(in_ptr(I_LNG) + li * 256 + 4 * lane), lb = *(const GAS f32x4*)(in_ptr(I_LNB) + li * 256 + 4 * lane);
    __syncthreads();
    const int gw = blockIdx.x * NWAVES + wave, NGW = F.G * NWAVES;
    for (int m = gw; m < nrows; m += NGW) {
        const bool isctx = m >= NL; const int t = isctx ? (m - NL) & 255 : m & 4095; const int Ls = isctx ? 256 : 4096;
        const bf16* pr = P + (size_t)m * PCOLS + RW_C0;
        const bool hp = t > 0, hn = t + 1 < Ls;
        f32x4 v;
        { const v2u w = *(const GAS v2u*)(pr + 512 + 4 * lane); v2u wp = (v2u){0u, 0u}, wn = (v2u){0u, 0u};
          if (hp) wp = *(const GAS v2u*)(pr - PCOLS + 512 + 4 * lane); if (hn) wn = *(const GAS v2u*)(pr + PCOLS + 512 + 4 * lane);
          const f32x4 x = (f32x4){bflo(w.x), bfhi(w.x), bflo(w.y), bfhi(w.y)}, xp = (f32x4){bflo(wp.x), bfhi(wp.x), bflo(wp.y), bfhi(wp.y)}, xn = (f32x4){bflo(wn.x), bfhi(wn.x), bflo(wn.y), bfhi(wn.y)};
          v = x + mpv * (xp - x) + mnv * (xn - x); }
        { const float x = bf2f(pr[896 + lane]); const float xp = hp ? bf2f(pr[896 + lane - PCOLS]) : 0.f, xn = hn ? bf2f(pr[896 + lane + PCOLS]) : 0.f;
          SG[lane] = sigmoidf_(x + mpg * (xp - x) + mng * (xn - x)); }
        LDS_WAIT();
        f32x4 g = (f32x4){0.f, 0.f, 0.f, 0.f};
#pragma unroll 8
        for (int j = 0; j < 64; ++j) { const float sj = SG[j]; const f32x4 gu = *(const LAS f32x4*)(GUP + j * 256 + 4 * lane); g = g + gu * sj; }
        const f32x4 y = *(const GAS f32x4*)(YR + (size_t)m * 256 + 4 * lane) + *(const GAS f32x4*)(YR + ((size_t)NT + m) * 256 + 4 * lane);
        const float mean = rowsum16((y.x + y.y) + (y.z + y.w)) * (1.f / 64.f);
        const f32x4 yc = y - mean; const float var = rowsum16((yc.x * yc.x + yc.y * yc.y) + (yc.z * yc.z + yc.w * yc.w)) * (1.f / 64.f);
        const f32x4 yn = yc * rsqrtf(var + 64e-5f) * lg + lb;
        const int hh = lane >> 4; const float bon = BON[(size_t)m * 4 + hh] + BON[((size_t)NT + m) * 4 + hh];
        const f32x4 o = (yn + v * bon) * g;
        v2u ow; ow.x = pk2(o.x, o.y); ow.y = pk2(o.z, o.w); *(GAS v2u*)(MIX + (size_t)m * D + 512 + 4 * lane) = ow;
        LDS_WAIT();
    }
    __syncthreads();
}

constexpr float HY_DMIN = -3.0701134573253945f, HY_DMAX = -15.350567286626973f;
constexpr int HY_X = 0, HY_TW = 65536, HY_W3 = 98304;
__device__ __forceinline__ float hy_delta(int ch) { return -(HY_DMIN + (float)ch * ((HY_DMAX - HY_DMIN) / 255.f)); }

__device__ __forceinline__ void phase_pro0d(Frame& F) { WS_DECL; frame_refresh(F);
    const int lane = F.lane; const int gw = blockIdx.x * NWAVES + F.wave, NGW = F.G * NWAVES;
    const float* w1 = in_ptr(I_HW1); const float* b1 = in_ptr(I_HB1); const float* w2 = in_ptr(I_HW2); const float* b2 = in_ptr(I_HB2);
    for (int it = gw; it < DEPTH * (SEQ + LCX); it += NGW) {
        const int li = it / (SEQ + LCX), r = it % (SEQ + LCX); const bool isctx = r >= SEQ; const int l = isctx ? r - SEQ : r; const int L = isctx ? LCX : SEQ;
        float z = 0.f;
        if (lane == 0) z = (float)l / (float)(L - 1);
        else if (lane < 33) { const int i = (lane - 1) & 15; const float band = 1e-4f + (float)i * ((15.f - 1e-4f) / 15.f); const float ang = band * (6.283185307179586f / (float)L) * (float)l; z = lane < 17 ? cosf(ang) : -sinf(ang); }
        float h1 = b1[li * 64 + lane];
        for (int i = 0; i < 33; ++i) h1 += __shfl(z, i) * w1[(li * 33 + i) * 64 + lane];
        h1 = sinf(h1);
        float h2 = b2[li * 64 + lane];
        for (int i = 0; i < 64; ++i) h2 += __shfl(h1, i) * w2[(li * 64 + i) * 64 + lane];
        h2 = sinf(h2);
        float* dst = isctx ? WSP(float, WS_H2C) + ((size_t)li * LCX + l) * 64 : WSP(float, WS_H2L) + ((size_t)li * SEQ + l) * 64;
        dst[lane] = h2;
    }
}

__device__ __forceinline__ void hy_build_tw(Frame& F) {
    LAS f32x2* TW = (LAS f32x2*)(F.lds + HY_TW);
    for (int k = F.tid; k < 4096; k += NTHR) { float s, c; sincospif((float)k * (1.f / 4096.f), &s, &c); TW[k] = (f32x2){c, -s}; }
}
template <bool INV> __device__ __forceinline__ void hy_stage(LAS f32x2* X, const LAS f32x2* TW, int s, int tid) {
    const int lm = 12 - s, m = 1 << lm;
#pragma unroll
    for (int i = 0; i < 8; ++i) { const int bf = tid + 512 * i, g = bf >> lm, j = bf & (m - 1), i0 = (g << (lm + 1)) + j, i1 = i0 + m;
        const f32x2 tw = TW[j << s], a = X[i0], b = X[i1];
        if (!INV) { const f32x2 dd = a - b; X[i0] = a + b; X[i1] = (f32x2){dd.x * tw.x - dd.y * tw.y, dd.x * tw.y + dd.y * tw.x}; }
        else { const f32x2 bb = (f32x2){b.x * tw.x + b.y * tw.y, b.y * tw.x - b.x * tw.y}; X[i0] = a + bb; X[i1] = a - bb; } }
}
__device__ __forceinline__ void hy_fft_fwd(LAS f32x2* X, const LAS f32x2* TW, int tid) {
#pragma unroll 1
    for (int s = 0; s <= 12; ++s) { hy_stage<false>(X, TW, s, tid); __syncthreads(); }
}
__device__ __forceinline__ void hy_fft_inv(LAS f32x2* X, const LAS f32x2* TW, int tid) {
#pragma unroll 1
    for (int s = 12; s >= 0; --s) { hy_stage<true>(X, TW, s, tid); __syncthreads(); }
}

__device__ __forceinline__ void phase_hy_spec(Frame& F, int li) { WS_DECL; frame_refresh(F);
    LAS f32x2* X = (LAS f32x2*)(F.lds + HY_X); const LAS f32x2* TW = (const LAS f32x2*)(F.lds + HY_TW); LAS float* W3 = (LAS float*)(F.lds + HY_W3);
    const int tid = F.tid; const float* w3 = in_ptr(I_HW3) + (size_t)li * 64 * 1024; const float* H2 = WSP(float, WS_H2L) + (size_t)li * SEQ * 64; f32x2* SPEC = WSP(f32x2, WS_SPEC);
    __syncthreads();
    hy_build_tw(F);
    for (int item = blockIdx.x; item < 512; item += F.G) {
        const int o = item >> 8, ch = item & 255;
        __syncthreads();
        if (tid < 128) { const int dir = tid >> 6, j = tid & 63; W3[tid] = w3[(size_t)j * 1024 + o * 512 + dir * 256 + ch]; }
        __syncthreads();
        const float delta = hy_delta(ch);
#pragma unroll 1
        for (int i = 0; i < 8; ++i) { const int l = tid + 512 * i; const float* hr = H2 + (size_t)l * 64; float hf = 0.f, hb = 0.f;
#pragma unroll
            for (int j4 = 0; j4 < 16; ++j4) { const f32x4 h4 = *(const GAS f32x4*)(hr + 4 * j4);
                hf += h4.x * W3[4 * j4] + h4.y * W3[4 * j4 + 1] + h4.z * W3[4 * j4 + 2] + h4.w * W3[4 * j4 + 3]; hb += h4.x * W3[64 + 4 * j4] + h4.y * W3[64 + 4 * j4 + 1] + h4.z * W3[64 + 4 * j4 + 2] + h4.w * W3[64 + 4 * j4 + 3]; }
            const float win = (expf(-((float)l * (1.f / 4095.f)) * delta) + 0.05f) * (1.f / 8192.f);
            X[l] = (f32x2){hf * win, 0.f};
            if (l == 0) X[4096] = (f32x2){0.f, 0.f}; else X[8192 - l] = (f32x2){hb * win, 0.f}; }
        __syncthreads();
        hy_fft_fwd(X, TW, tid);
        f32x2* dst = SPEC + (size_t)item * 8192;
#pragma unroll
        for (int i = 0; i < 16; ++i) *(GAS f32x2*)(dst + tid + 512 * i) = X[tid + 512 * i];
    }
    __syncthreads();
}

__device__ __forceinline__ void hy_conv8(const bf16* row, int t0, int Ls, float w0, float w1, float w2, float bias, float (&out)[8]) {
    const v4u raw = *(const GAS v4u*)(row + t0); float p[10];
    p[0] = t0 > 0 ? bf2f(row[t0 - 1]) : 0.f; p[9] = t0 + 8 < Ls ? bf2f(row[t0 + 8]) : 0.f;
    p[1] = bflo(raw.x); p[2] = bfhi(raw.x); p[3] = bflo(raw.y); p[4] = bfhi(raw.y); p[5] = bflo(raw.z); p[6] = bfhi(raw.z); p[7] = bflo(raw.w); p[8] = bfhi(raw.w);
#pragma unroll
    for (int e = 0; e < 8; ++e) out[e] = bias + w0 * p[e] + w1 * p[e + 1] + w2 * p[e + 2];
}

__device__ __forceinline__ void phase_hy_conv(Frame& F, int li) { WS_DECL; frame_refresh(F);
    LAS f32x2* X = (LAS f32x2*)(F.lds + HY_X); const LAS f32x2* TW = (const LAS f32x2*)(F.lds + HY_TW);
    const int tid = F.tid; const bf16* HT = WSP(bf16, WS_HT); bf16* HOT = WSP(bf16, WS_HOT); const f32x2* SPEC = WSP(f32x2, WS_SPEC);
    const float* cw = in_ptr(I_HCW) + li * 3 * 768; const float* cb = in_ptr(I_HCB) + li * 768; const float* dsk = in_ptr(I_HD) + li * 512;
    __syncthreads();
    hy_build_tw(F);
    for (int item = blockIdx.x; item < 2048; item += F.G) {
        const int ch = item >> 3, bp = item & 7; const int t0 = 8 * tid;
        float v[2][8], x1[2][8], x2[2][8];
#pragma unroll
        for (int q = 0; q < 2; ++q) { const size_t boff = (size_t)(2 * bp + q) * SEQ;
            hy_conv8(HT + (size_t)ch * NT + boff, t0, SEQ, cw[ch], cw[768 + ch], cw[1536 + ch], cb[ch], v[q]);
            hy_conv8(HT + (size_t)(256 + ch) * NT + boff, t0, SEQ, cw[256 + ch], cw[768 + 256 + ch], cw[1536 + 256 + ch], cb[256 + ch], x1[q]);
            hy_conv8(HT + (size_t)(512 + ch) * NT + boff, t0, SEQ, cw[512 + ch], cw[768 + 512 + ch], cw[1536 + 512 + ch], cb[512 + ch], x2[q]); }
        const float d0 = dsk[ch], d1 = dsk[256 + ch];
        __syncthreads();
#pragma unroll
        for (int e = 0; e < 8; ++e) { X[t0 + e] = (f32x2){v[0][e], v[1][e]}; X[4096 + t0 + e] = (f32x2){0.f, 0.f}; }
        __syncthreads();
        hy_fft_fwd(X, TW, tid);
        { const f32x2* sp = SPEC + (size_t)ch * 8192;
#pragma unroll
          for (int i = 0; i < 16; ++i) { const int n = tid + 512 * i; const f32x2 s = *(const GAS f32x2*)(sp + n), x = X[n]; X[n] = (f32x2){x.x * s.x - x.y * s.y, x.x * s.y + x.y * s.x}; } }
        __syncthreads();
        hy_fft_inv(X, TW, tid);
        float u[2][8];
#pragma unroll
        for (int e = 0; e < 8; ++e) { const f32x2 y = X[t0 + e]; u[0][e] = x1[0][e] * (y.x + v[0][e] * d0); u[1][e] = x1[1][e] * (y.y + v[1][e] * d0); }
        __syncthreads();
#pragma unroll
        for (int e = 0; e < 8; ++e) { X[t0 + e] = (f32x2){u[0][e], u[1][e]}; X[4096 + t0 + e] = (f32x2){0.f, 0.f}; }
        __syncthreads();
        hy_fft_fwd(X, TW, tid);
        { const f32x2* sp = SPEC + (size_t)(256 + ch) * 8192;
#pragma unroll
          for (int i = 0; i < 16; ++i) { const int n = tid + 512 * i; const f32x2 s = *(const GAS f32x2*)(sp + n), x = X[n]; X[n] = (f32x2){x.x * s.x - x.y * s.y, x.x * s.y + x.y * s.x}; } }
        __syncthreads();
        hy_fft_inv(X, TW, tid);
#pragma unroll
        for (int q = 0; q < 2; ++q) { float o[8];
#pragma unroll
            for (int e = 0; e < 8; ++e) { const f32x2 y = X[t0 + e]; o[e] = x2[q][e] * ((q == 0 ? y.x : y.y) + u[q][e] * d1); }
            v4u w; w.x = pk2(o[0], o[1]); w.y = pk2(o[2], o[3]); w.z = pk2(o[4], o[5]); w.w = pk2(o[6], o[7]);
            *(GAS v4u*)(HOT + (size_t)ch * NT + (size_t)(2 * bp + q) * SEQ + t0) = w; }
    }
    __syncthreads();
}

__device__ __forceinline__ void phase_hy_ctx(Frame& F, int li) { WS_DECL; frame_refresh(F);
    LAS float* KF = (LAS float*)F.lds;
    LAS float* SIG = KF + 1024;
    LAS float* W3 = KF + 2048;
    const int tid = F.tid; const bf16* HT = WSP(bf16, WS_HT); bf16* HOT = WSP(bf16, WS_HOT);
    const float* w3 = in_ptr(I_HW3) + (size_t)li * 64 * 1024; const float* H2 = WSP(float, WS_H2C) + (size_t)li * LCX * 64;
    const float* cw = in_ptr(I_HCW) + li * 3 * 768; const float* cb = in_ptr(I_HCB) + li * 768; const float* dsk = in_ptr(I_HD) + li * 512;
    for (int ch = blockIdx.x; ch < 256; ch += F.G) {
        __syncthreads();
        if (tid < 256) { const int od = tid >> 6, j = tid & 63; W3[tid] = w3[(size_t)j * 1024 + (od >> 1) * 512 + (od & 1) * 256 + ch]; }
        __syncthreads();
        { const int o = tid >> 8, l = tid & 255; const float* hr = H2 + (size_t)l * 64; float hf = 0.f, hb = 0.f;
          for (int j = 0; j < 64; ++j) { const float hv = hr[j]; hf += hv * W3[(2 * o) * 64 + j]; hb += hv * W3[(2 * o + 1) * 64 + j]; }
          const float win = expf(-((float)l * (1.f / 255.f)) * hy_delta(ch)) + 0.05f;
          KF[(2 * o) * 256 + l] = hf * win; KF[(2 * o + 1) * 256 + l] = hb * win; }
        __syncthreads();
        const int q = tid >> 8, t = tid & 255; const float d0 = dsk[ch], d1 = dsk[256 + ch];
        for (int bp = 0; bp < 8; ++bp) { const int b = 2 * bp + q; const size_t off = (size_t)NL + (size_t)b * LCX;
            float zz[3];
#pragma unroll
            for (int k = 0; k < 3; ++k) { const int c = 256 * k + ch; const bf16* row = HT + (size_t)c * NT + off;
                const float pm = t > 0 ? bf2f(row[t - 1]) : 0.f, p0 = bf2f(row[t]), pp = t + 1 < LCX ? bf2f(row[t + 1]) : 0.f;
                zz[k] = cb[c] + cw[c] * pm + cw[768 + c] * p0 + cw[1536 + c] * pp; }
            SIG[q * 256 + t] = zz[0];
            __syncthreads();
            float y = 0.f;
            for (int s = 0; s < 256; ++s) { const int lag = t - s; const float kv = lag >= 0 ? KF[lag] : KF[256 - lag]; y += kv * SIG[q * 256 + s]; }
            const float u = zz[1] * (y + zz[0] * d0);
            __syncthreads();
            SIG[q * 256 + t] = u;
            __syncthreads();
            float y2 = 0.f;
            for (int s = 0; s < 256; ++s) { const int lag = t - s; const float kv = lag >= 0 ? KF[512 + lag] : KF[768 - lag]; y2 += kv * SIG[q * 256 + s]; }
            HOT[(size_t)ch * NT + off + t] = (bf16)f2bf(zz[2] * (y2 + u * d1));
            __syncthreads();
        }
    }
    __syncthreads();
}

constexpr int HF_LD = 72;
__device__ __forceinline__ void phase_fin_hyena(Frame& F, int li) { WS_DECL; frame_refresh(F);
    LAS bf16* T = (LAS bf16*)F.lds;
    const int nrows = li == DEPTH - 1 ? NL : NT; const int tid = F.tid, lane = F.lane, wave = F.wave; const bf16* HOT = WSP(bf16, WS_HOT); bf16* MIX = WSP(bf16, WS_A1);
    const f32x4 g4 = *(const GAS f32x4*)(in_ptr(I_HON) + li * 256 + 4 * lane);
    for (int item = blockIdx.x; item < nrows / 64; item += F.G) { const int m0 = item * 64;
        __syncthreads();
        { const int ch = tid >> 1, hf = tid & 1; const bf16* src = HOT + (size_t)ch * NT + m0 + 32 * hf;
#pragma unroll
          for (int k = 0; k < 4; ++k) *(LAS v4u*)(T + ch * HF_LD + 32 * hf + 8 * k) = *(const GAS v4u*)(src + 8 * k); }
        __syncthreads();
        for (int i = 0; i < 8; ++i) { const int tl = wave * 8 + i;
            f32x4 x; x.x = bf2f(T[(4 * lane) * HF_LD + tl]); x.y = bf2f(T[(4 * lane + 1) * HF_LD + tl]); x.z = bf2f(T[(4 * lane + 2) * HF_LD + tl]); x.w = bf2f(T[(4 * lane + 3) * HF_LD + tl]);
            const float r = rsqrtf(wave_sum(x.x * x.x + x.y * x.y + x.z * x.z + x.w * x.w) * (1.f / 256.f) + 1e-6f);
            v2u o; o.x = pk2(x.x * r * g4.x, x.y * r * g4.y); o.y = pk2(x.z * r * g4.z, x.w * r * g4.w); *(GAS v2u*)(MIX + (size_t)(m0 + tl) * D + 768 + 4 * lane) = o; }
    }
    __syncthreads();
}
#define MIX_HYENA 1

__global__ void __launch_bounds__(NTHR, 2) mk_fwd(Args a) {
    extern __shared__ __attribute__((aligned(16))) unsigned char lds_raw[];
    Frame F; F.lds = (LAS unsigned char*)lds_raw; F.tid = threadIdx.x; F.lane = F.tid & 63; F.wave = __builtin_amdgcn_readfirstlane(F.tid >> 6); F.G = gridDim.x;
    for (int u = F.tid; u < (LDS_BYTES - LDSCTL_OFF) / 4; u += NTHR) ((LAS unsigned*)(F.lds + LDSCTL_OFF))[u] = 0u;
    __syncthreads();
    XcdBarrier bar = xcd_barrier_post((unsigned*)(ws_ptr() + WS_CTL) + CW_BAR, (volatile LAS unsigned*)(F.lds + LDSCTL_OFF) + 8);
#define GRID_BAR() xcd_barrier(bar)

    phase_pro0(F);
    phase_pro0b(F);
    phase_pro0c(F);
    phase_pro0d(F);
    GRID_BAR();
    phase_hin0(F);
    GRID_BAR();
    for (int li = 0; li < DEPTH; ++li) {
        const int nrows = li == DEPTH - 1 ? NL : NT; unsigned char* const ws = ws_ptr();
        phase_hy_spec(F, li);
        { pg8::Gemm g{WSP(bf16, WS_A1), WSP(bf16, WS_WINT) + (size_t)li * PCOLS * D, NT, PCOLS, D}; pg8::StaticOrder S; S.init(NT, PCOLS, F.G, (int)blockIdx.x);
          pg8::EpiStore E{WSP(bf16, WS_P), PCOLS, 0, PCOLS / 256};
          pg8::gemm_phase<pg8::EpiStore, pg8::StaticOrder, true, true>(F.lds, g, S, E); }
#if MIX_HYENA
        { pg8::Gemm g{WSP(bf16, WS_WHYT) + (size_t)li * HYC * D, WSP(bf16, WS_A1), HYC, NT, D}; pg8::StaticOrder S; S.init(HYC, NT, F.G, (int)blockIdx.x);
          pg8::EpiStore E{WSP(bf16, WS_HT), NT, 0, NT / 256};
          pg8::gemm_phase<pg8::EpiStore, pg8::StaticOrder, true, true>(F.lds, g, S, E); }
#endif
        GRID_BAR();
        phase_rwkv_scan(F, li);
        __syncthreads();
        phase_mla_prep(F, li);
        phase_lru<1>(F, li);
        __syncthreads();
        phase_hy_conv(F, li);
        if (li < DEPTH - 1) phase_hy_ctx(F, li);
        GRID_BAR();
        phase_attn(F, li);
        __syncthreads();
        phase_lru<3>(F, li);
        GRID_BAR();
        phase_fin_mla(F, li);
        phase_fin_rwkv(F, li); phase_fin_hyena(F, li);
        GRID_BAR();
        { pg8::Gemm g{WSP(bf16, WS_A1), WSP(bf16, WS_WOUTT) + (size_t)li * D * D, nrows, D, D}; pg8::StaticOrder S; S.init(nrows, D, F.G, (int)blockIdx.x);
          pg8::EpiStore E{WSP(bf16, WS_Y), D, 0, D / 256};
          pg8::gemm_phase<pg8::EpiStore, pg8::StaticOrder, true, true>(F.lds, g, S, E); }
        GRID_BAR();
        phase_ln1<true>(F, li);
        if (li & 1) phase_moe_weights(F, li);
        GRID_BAR();
        if (!(li & 1)) {
            const int j = li >> 1;
            { pg8::Gemm g{WSP(bf16, WS_A1), WSP(bf16, WS_WGUT) + (size_t)j * 2 * FFD * D, nrows, 2 * FFD, D}; pg8::StaticOrder S; S.init(nrows, 2 * FFD, F.G, (int)blockIdx.x);
              pg8::EpiSwiGLU E{WSP(bf16, WS_H), FFD, 0, 2 * FFD / 256};
              pg8::gemm_phase<pg8::EpiSwiGLU, pg8::StaticOrder, true, true>(F.lds, g, S, E); }
            GRID_BAR();
            { pg8::Gemm g{WSP(bf16, WS_H), WSP(bf16, WS_WDT) + (size_t)j * D * FFD, nrows, D, FFD}; pg8::StaticOrder S; S.init(nrows, D, F.G, (int)blockIdx.x);
              pg8::EpiStore E{WSP(bf16, WS_Y), D, 0, D / 256};
              pg8::gemm_phase<pg8::EpiStore, pg8::StaticOrder, true, true>(F.lds, g, S, E); }
            GRID_BAR();
        } else {
            phase_moe_slots(F, li);
            GRID_BAR();
            const int ntiles = ((LAS int*)(F.lds + LDS_MOEI))[48];
            const PG8_LAS unsigned char* tile_e = (const PG8_LAS unsigned char*)(F.lds + LDS_TILEE);
#pragma unroll 1
            for (int ch = 0; ch < MOE_NCHUNK; ++ch) {
                const int t0 = ch * MOE_CHUNK_TILES; int nM = ntiles - t0; nM = nM < 0 ? 0 : (nM > MOE_CHUNK_TILES ? MOE_CHUNK_TILES : nM);
                { pg8::Gemm g{WSP(bf16, WS_XS), WSP(bf16, WS_MGU), 0, 0, D}; pg8::MoeOrder S; S.init(nM, 2 * FFE / 256, F.G, (int)blockIdx.x, t0, t0, tile_e);
                  pg8::EpiSwiGLU E{WSP(bf16, WS_HM), FFE, t0, 2 * FFE / 256};
                  pg8::gemm_phase<pg8::EpiSwiGLU, pg8::MoeOrder, true, true>(F.lds, g, S, E); }
                GRID_BAR();
                { pg8::Gemm g{WSP(bf16, WS_HM), WSP(bf16, WS_MD), 0, 0, FFE}; pg8::MoeOrder S; S.init(nM, D / 256, F.G, (int)blockIdx.x, t0, 0, tile_e);
                  pg8::EpiStore E{WSP(bf16, WS_XS), D, t0, D / 256};
                  pg8::gemm_phase<pg8::EpiStore, pg8::MoeOrder, true, true>(F.lds, g, S, E); }
                GRID_BAR();
            }
        }
        phase_ln2<true>(F, li);
        if (li < DEPTH - 1) GRID_BAR();
    }
}

extern "C" void kernel_launch(void* const* d_in, const int* in_sizes, int n_in, void* d_out, int out_size, void* d_ws, size_t ws_size, hipStream_t stream) {
    static int grid = 0;
    if (grid == 0) {
        if (n_in != N_INPUTS || out_size != NL * D || ws_size < WS_END) { fprintf(stderr, "kernel_launch: unexpected shapes (n_in %d out %d ws %zu)\n", n_in, out_size, ws_size); grid = -1; return; }
        int dev = 0, cus = 0, per_cu = 0;
        if (hipGetDevice(&dev) != hipSuccess || hipDeviceGetAttribute(&cus, hipDeviceAttributeMultiprocessorCount, dev) != hipSuccess) { grid = -1; return; }
        if (hipFuncSetAttribute((const void*)mk_fwd, hipFuncAttributeMaxDynamicSharedMemorySize, LDS_BYTES) != hipSuccess) { fprintf(stderr, "kernel_launch: hipFuncSetAttribute failed\n"); grid = -1; return; }
        if (hipOccupancyMaxActiveBlocksPerMultiprocessor(&per_cu, (const void*)mk_fwd, NTHR, LDS_BYTES) != hipSuccess || per_cu < 1) fprintf(stderr, "kernel_launch: occupancy query reports %d\n", per_cu);
        (void)hipGetLastError();
        grid = cus > 256 ? 256 : cus;
    }
    if (grid < 0) return;
    if (hipMemsetAsync((char*)d_ws + WS_CTL, 0, CTL_ZERO_BYTES, stream) != hipSuccess) return;
    Args a{};
    for (int i = 0; i < N_INPUTS; ++i) a.in[i] = (const float*)d_in[i];
    a.out = (float*)d_out; a.ws = (unsigned char*)d_ws;
    hipLaunchKernelGGL(mk_fwd, dim3(grid), dim3(NTHR), LDS_BYTES, stream, a);
    const hipError_t le = hipPeekAtLastError();
    if (le != hipSuccess) fprintf(stderr, "kernel_launch: launch failed: %s\n", hipGetErrorName(le));
}
```

```cpp
#include <hip/hip_runtime.h>
#include <cstdio>
#include <cstdint>
#define GAS __attribute__((address_space(1)))
#define LAS __attribute__((address_space(3)))
namespace pg8 {
#define PG8_LAS __attribute__((address_space(3)))
typedef unsigned short bf16_t;
typedef short bf16x8 __attribute__((ext_vector_type(8)));
typedef float f32x4 __attribute__((ext_vector_type(4)));
typedef unsigned u32x4 __attribute__((ext_vector_type(4)));
constexpr int BM = 256, BK = 64, HALF = 128, HTB = HALF * BK * 2  , STAGE_BYTES = 8 * HTB, NXCD = 8, WGM = 8;

__host__ __device__ __forceinline__ int lds_byte(int r, int c) { const int st = (r >> 4) * 2 + (c >> 5), rr = r & 15, cc = c & 31, ob = rr * 64 + cc * 2; return st * 1024 + (ob ^ (((ob >> 9) & 1) << 5)); }
__host__ __device__ __forceinline__ void stage_rc(int b, int& R, int& C) { const int st = b / 1024, sb = b % 1024, swz = sb ^ (((sb >> 9) & 1) << 5); R = (st >> 1) * 16 + swz / 64; C = (st & 1) * 32 + (swz % 64) / 2; }
__host__ __device__ __forceinline__ int perm32(int rho) { const int n = rho >> 4, i = rho & 15; return 8 * (i >> 2) + 4 * n + (i & 3); }

struct Unit { int pm, pn; };
struct Gemm { const bf16_t* A; const bf16_t* Bt; int M, N, K; };

struct StaticOrder {
    int nM, nN, nwg, G, c;
    __host__ __device__ void init(int M, int N, int G_, int c_) { nM = M / BM; nN = N / BM; nwg = nM * nN; G = G_; c = c_; }
    __host__ __device__ bool next(int i, Unit& u) const {
        const long L = (long)i * G + c; if (L >= nwg) return false;
        int wgid = (int)L; { const int q = nwg / NXCD, r = nwg % NXCD, xcd = wgid % NXCD, off = wgid / NXCD; wgid = (xcd < r ? xcd * (q + 1) : r * (q + 1) + (xcd - r) * q) + off; }
        const int nig = WGM * nN, gid = wgid / nig, fm = gid * WGM, gsz = (nM - fm) < WGM ? (nM - fm) : WGM;
        u.pm = fm + ((wgid % nig) % gsz); u.pn = (wgid % nig) / gsz; return true;
    }
    __device__ __forceinline__ void a_ready(const Unit&) const {}
    __device__ __forceinline__ void done(const Unit&) const {}
};

__device__ __forceinline__ unsigned cvt_pk_bf16(float lo, float hi) { unsigned r; asm volatile("v_cvt_pk_bf16_f32 %0, %1, %2" : "=v"(r) : "v"(lo), "v"(hi)); return r; }
typedef float f32x2 __attribute__((ext_vector_type(2)));
__device__ __forceinline__ f32x2 gelu_pk(f32x2 v) {
    const f32x2 av = __builtin_elementwise_abs(v), d = av * 0.2316418882f + 1.0f;
    f32x2 t; t.x = __builtin_amdgcn_rcpf(d.x); t.y = __builtin_amdgcn_rcpf(d.y);
    f32x2 q = t * 0.5307027145f + (-0.7265760135f); q = q * t + 0.7107068705f; q = q * t + (-0.142248368f); q = q * t + 0.127414796f; q = q * t;
    const f32x2 s = (v * v) * (-0.72134752044f);
    f32x2 e; e.x = __builtin_amdgcn_exp2f(s.x); e.y = __builtin_amdgcn_exp2f(s.y);
    const f32x2 m = v * (q * e), r = v - m;
    f32x2 o; o.x = v.x < 0.f ? m.x : r.x; o.y = v.y < 0.f ? m.y : r.y; return o;
}

template <int ACT  > struct EpiBf16 {
    static constexpr bool PERM = true, AFTER_DRAIN = false; static_assert(ACT == 0 || ACT == 1, "EpiBf16: ACT is 0 (none) or 1 (gelu_pk)");
    bf16_t* O; int ldc; const float* bias; int split_cols; size_t split_stride; float scale0;
    __device__ __forceinline__ void operator()(const f32x4 (&acc)[2][2][4][2], const Unit& u, int wr, int wc, int fr, int fq) const {
        const int row0 = u.pm * BM + wr * 64 + fr; int colt = u.pn * BM; bf16_t* base = O;
        float sc = 1.f; if (split_cols) { const int t = colt / split_cols; base += (size_t)t * split_stride; colt -= t * split_cols; if (t == 0) sc = scale0; }
        const int col0 = colt + wc * 32 + 8 * fq, bcol0 = u.pn * BM + wc * 32 + 8 * fq;
        f32x4 bv[2][2];
#pragma unroll
        for (int bj = 0; bj < 2; ++bj)
#pragma unroll
            for (int n = 0; n < 2; ++n) bv[bj][n] = bias ? *(const f32x4*)(bias + bcol0 + bj * HALF + 4 * n) : (f32x4){0.f, 0.f, 0.f, 0.f};
#pragma unroll
        for (int ai = 0; ai < 2; ++ai)
#pragma unroll
            for (int m = 0; m < 4; ++m) { bf16_t* rowp = base + (size_t)(row0 + ai * HALF + m * 16) * ldc + col0;
#pragma unroll
                for (int bj = 0; bj < 2; ++bj) { f32x4 v0 = acc[ai][bj][m][0] + bv[bj][0], v1 = acc[ai][bj][m][1] + bv[bj][1];
                    if (ACT == 1) { f32x2 a = gelu_pk((f32x2){v0[0], v0[1]}), b = gelu_pk((f32x2){v0[2], v0[3]}), c = gelu_pk((f32x2){v1[0], v1[1]}), d = gelu_pk((f32x2){v1[2], v1[3]});
                        v0 = (f32x4){a.x, a.y, b.x, b.y}; v1 = (f32x4){c.x, c.y, d.x, d.y}; }
                    v0 = v0 * sc; v1 = v1 * sc; u32x4 w; w.x = cvt_pk_bf16(v0[0], v0[1]); w.y = cvt_pk_bf16(v0[2], v0[3]); w.z = cvt_pk_bf16(v1[0], v1[1]); w.w = cvt_pk_bf16(v1[2], v1[3]);
                    *(u32x4*)(rowp + bj * HALF) = w; } }
    }
};
template <class Epi, class Sched, bool ALIGN_EPI = false, bool SP2 = false>
__device__ __forceinline__ void gemm_phase(PG8_LAS unsigned char* lds, const Gemm g, const Sched& S, const Epi& E) {
    int tid_ = threadIdx.x; asm volatile("" : "+v"(tid_));
    const int tid = tid_, wid = __builtin_amdgcn_readfirstlane(tid >> 6), lane = tid & 63, wr = wid >> 2, wc = wid & 3, fr = lane & 15, fq = lane >> 4;
    const int K = g.K, nt = K / BK;
    unsigned voffA[2], voffB[2];
#pragma unroll
    for (int i = 0; i < 2; ++i) { int R, C; stage_rc(tid * 16 + i * 8192, R, C); const int Rb = Epi::PERM ? ((R & ~31) + perm32(R & 31)) : R;
        voffA[i] = (unsigned)(R * K + C) * 2u; voffB[i] = (unsigned)(Rb * K + C) * 2u; }
    const size_t kstep = (size_t)(BK * 2);
    const size_t hstep = (size_t)HALF * K * 2;
    const size_t tstep = 2 * hstep;
    const unsigned ldsw = (unsigned)wid * 1024u;
    const int aoff = lds_byte(wr * 64 + fr, fq * 8), boff = lds_byte(wc * 32 + fr, fq * 8);
#define PG8_SA(b, h) (((b) * 2 + (h)) * HTB)
#define PG8_SB(b, h) ((4 + (b) * 2 + (h)) * HTB)
#define PG8_STAGE(bufoff, gbase, voff) do { _Pragma("unroll") for (int _i = 0; _i < 2; ++_i) \
        __builtin_amdgcn_global_load_lds((const unsigned*)((const char*)(gbase) + (voff)[_i]), (PG8_LAS unsigned*)(lds + (bufoff) + ldsw + _i * 8192), 16, 0, 0); } while (0)
#define PG8_LDA(dst, b, h) do { _Pragma("unroll") for (int m = 0; m < 4; ++m) _Pragma("unroll") for (int k = 0; k < 2; ++k) dst[m][k] = *(const PG8_LAS bf16x8*)(lds + PG8_SA(b, h) + aoff + m * 2048 + k * 1024); } while (0)
#define PG8_LDB(dst, b, h) do { _Pragma("unroll") for (int n = 0; n < 2; ++n) _Pragma("unroll") for (int k = 0; k < 2; ++k) dst[n][k] = *(const PG8_LAS bf16x8*)(lds + PG8_SB(b, h) + boff + n * 2048 + k * 1024); } while (0)
#define PG8_MMA(ai, bj, At, Bt) do { __builtin_amdgcn_s_setprio(1); _Pragma("unroll") for (int m = 0; m < 4; ++m) _Pragma("unroll") for (int n = 0; n < 2; ++n) _Pragma("unroll") for (int k = 0; k < 2; ++k) \
        acc[ai][bj][m][n] = __builtin_amdgcn_mfma_f32_16x16x32_bf16(Bt[n][k], At[m][k], acc[ai][bj][m][n], 0, 0, 0); __builtin_amdgcn_s_setprio(0); } while (0)
#define PG8_WAIT_V(n) asm volatile("s_waitcnt vmcnt(" #n ")" ::: "memory")
#define PG8_WAIT_L(n) asm volatile("s_waitcnt lgkmcnt(" #n ")" ::: "memory")
#define PG8_BAR __builtin_amdgcn_s_barrier()
#define PG8_SCHED __builtin_amdgcn_sched_barrier(0)
    Unit cur, nxt; int ui = 0;
    if (!S.next(0, cur)) return;
    f32x4 acc[2][2][4][2];
#pragma unroll
    for (int a = 0; a < 2; ++a)
#pragma unroll
        for (int b = 0; b < 2; ++b)
#pragma unroll
            for (int m = 0; m < 4; ++m)
#pragma unroll
                for (int n = 0; n < 2; ++n) acc[a][b][m][n] = (f32x4){0.f, 0.f, 0.f, 0.f};
    bf16x8 At[4][2], B0[2][2], B1[2][2];
    const char* cA = (const char*)g.A + (size_t)cur.pm * tstep; const char* cB = (const char*)g.Bt + (size_t)cur.pn * tstep;
    S.a_ready(cur);
    if constexpr (SP2) {
        PG8_STAGE(PG8_SB(0, 0), cB, voffB); PG8_STAGE(PG8_SB(0, 1), cB + hstep, voffB); PG8_STAGE(PG8_SA(0, 0), cA, voffA); PG8_STAGE(PG8_SA(0, 1), cA + hstep, voffA);
        if (wr == 1) PG8_BAR;
        PG8_WAIT_V(2); PG8_BAR;
        PG8_STAGE(PG8_SB(1, 0), cB + kstep, voffB); PG8_STAGE(PG8_SA(1, 0), cA + kstep, voffA); PG8_STAGE(PG8_SB(1, 1), cB + hstep + kstep, voffB);
        PG8_WAIT_V(6); PG8_BAR;
    } else {
        PG8_STAGE(PG8_SB(0, 0), cB, voffB); PG8_STAGE(PG8_SA(0, 0), cA, voffA); PG8_STAGE(PG8_SB(0, 1), cB + hstep, voffB); PG8_STAGE(PG8_SA(0, 1), cA + hstep, voffA);
        if (wr == 1) PG8_BAR;
        PG8_WAIT_V(4); PG8_BAR;
        PG8_STAGE(PG8_SB(1, 0), cB + kstep, voffB); PG8_STAGE(PG8_SA(1, 0), cA + kstep, voffA); PG8_STAGE(PG8_SB(1, 1), cB + hstep + kstep, voffB);
        PG8_WAIT_V(6); PG8_BAR;
    }
    for (;;) {
        const bool has_next = S.next(ui + 1, nxt);
        const char* nA = has_next ? (const char*)g.A + (size_t)nxt.pm * tstep : cA; const char* nB = has_next ? (const char*)g.Bt + (size_t)nxt.pn * tstep : cB;
        for (int t = 0; t < nt; t += 2) {
            const bool last = (t == nt - 2);
            const char* a1 = cA + (size_t)(t + 1) * kstep;
            const char* a2 = last ? nA : cA + (size_t)(t + 2) * kstep; const char* b2 = last ? nB : cB + (size_t)(t + 2) * kstep;
            const char* a3 = a2 + kstep; const char* b3 = b2 + kstep;
            if (last && has_next) S.a_ready(nxt);
            if constexpr (SP2) {
            PG8_LDB(B0, 0, 0); PG8_LDB(B1, 0, 1); PG8_SCHED; PG8_LDA(At, 0, 0); PG8_STAGE(PG8_SA(1, 1), a1 + hstep, voffA);
            PG8_WAIT_V(8); PG8_WAIT_L(0); PG8_BAR; PG8_MMA(0, 0, At, B0); PG8_MMA(0, 1, At, B1); PG8_BAR; PG8_SCHED;
            PG8_LDA(At, 0, 1); PG8_STAGE(PG8_SB(0, 0), b2, voffB); PG8_STAGE(PG8_SB(0, 1), b2 + hstep, voffB); PG8_STAGE(PG8_SA(0, 0), a2, voffA);
            PG8_WAIT_V(8); PG8_WAIT_L(0); PG8_BAR; PG8_MMA(1, 0, At, B0); PG8_MMA(1, 1, At, B1); PG8_BAR; PG8_SCHED;
            PG8_LDB(B0, 1, 0); PG8_LDB(B1, 1, 1); PG8_SCHED; PG8_LDA(At, 1, 0); PG8_STAGE(PG8_SA(0, 1), a2 + hstep, voffA);
            PG8_WAIT_V(8); PG8_WAIT_L(0); PG8_BAR; PG8_MMA(0, 0, At, B0); PG8_MMA(0, 1, At, B1); PG8_BAR; PG8_SCHED;
            PG8_LDA(At, 1, 1); PG8_STAGE(PG8_SB(1, 0), b3, voffB); PG8_STAGE(PG8_SB(1, 1), b3 + hstep, voffB); PG8_STAGE(PG8_SA(1, 0), a3, voffA);
            PG8_WAIT_V(8); PG8_WAIT_L(0); PG8_BAR; PG8_MMA(1, 0, At, B0); PG8_MMA(1, 1, At, B1); PG8_BAR; PG8_SCHED;
            } else {
            PG8_LDB(B0, 0, 0); PG8_SCHED; PG8_LDA(At, 0, 0); PG8_STAGE(PG8_SA(1, 1), a1 + hstep, voffA);
            PG8_WAIT_L(8); PG8_BAR; PG8_WAIT_L(0); PG8_MMA(0, 0, At, B0); PG8_BAR; PG8_SCHED;
            PG8_LDB(B1, 0, 1); PG8_STAGE(PG8_SB(0, 0), b2, voffB);
            PG8_BAR; PG8_WAIT_L(0); PG8_MMA(0, 1, At, B1); PG8_BAR;
            PG8_LDA(At, 0, 1); PG8_STAGE(PG8_SA(0, 0), a2, voffA);
            PG8_BAR; PG8_WAIT_L(0); PG8_MMA(1, 0, At, B0); PG8_BAR; PG8_SCHED;
            PG8_STAGE(PG8_SB(0, 1), b2 + hstep, voffB);
            PG8_WAIT_V(6); PG8_BAR; PG8_MMA(1, 1, At, B1); PG8_BAR;
            PG8_LDB(B0, 1, 0); PG8_SCHED; PG8_LDA(At, 1, 0); PG8_STAGE(PG8_SA(0, 1), a2 + hstep, voffA);
            PG8_WAIT_L(8); PG8_BAR; PG8_WAIT_L(0); PG8_MMA(0, 0, At, B0); PG8_BAR; PG8_SCHED;
            PG8_LDB(B1, 1, 1); PG8_STAGE(PG8_SB(1, 0), b3, voffB);
            PG8_BAR; PG8_WAIT_L(0); PG8_MMA(0, 1, At, B1); PG8_BAR;
            PG8_LDA(At, 1, 1); PG8_STAGE(PG8_SA(1, 0), a3, voffA);
            PG8_BAR; PG8_WAIT_L(0); PG8_MMA(1, 0, At, B0); PG8_BAR; PG8_SCHED;
            PG8_STAGE(PG8_SB(1, 1), b3 + hstep, voffB);
            PG8_WAIT_V(6); PG8_BAR; PG8_MMA(1, 1, At, B1); PG8_BAR;
            }
        }
        if constexpr (ALIGN_EPI) { if (wr == 0) PG8_BAR; }
        if constexpr (!Epi::AFTER_DRAIN) { E(acc, cur, wr, wc, fr, fq); S.done(cur); }
        if (!has_next) break;
#pragma unroll
        for (int a = 0; a < 2; ++a)
#pragma unroll
            for (int b = 0; b < 2; ++b)
#pragma unroll
                for (int m = 0; m < 4; ++m)
#pragma unroll
                    for (int n = 0; n < 2; ++n) acc[a][b][m][n] = (f32x4){0.f, 0.f, 0.f, 0.f};
        cur = nxt; cA = nA; cB = nB; ++ui;
        if constexpr (ALIGN_EPI) { if (wr == 1) PG8_BAR; }
    }
    PG8_WAIT_V(0);
    if constexpr (!ALIGN_EPI) { if (wr == 0) PG8_BAR; }
    PG8_BAR;
    if constexpr (Epi::AFTER_DRAIN) { E.fused(acc, cur, wr, wc, fr, fq, lds, wid, lane); S.done(cur); }
#undef PG8_SA
#undef PG8_SB
#undef PG8_STAGE
#undef PG8_LDA
#undef PG8_LDB
#undef PG8_MMA
#undef PG8_WAIT_V
#undef PG8_WAIT_L
#undef PG8_BAR
#undef PG8_SCHED
}
}

typedef unsigned short bf16;
typedef unsigned v4u __attribute__((ext_vector_type(4)));
typedef unsigned v2u __attribute__((ext_vector_type(2)));
typedef float f32x4 __attribute__((ext_vector_type(4)));
typedef float f32x2 __attribute__((ext_vector_type(2)));
typedef float f32x16 __attribute__((ext_vector_type(16)));
typedef short bf16x8 __attribute__((ext_vector_type(8)));
typedef short s16x4 __attribute__((ext_vector_type(4)));
typedef GAS unsigned gu32;

constexpr int D = 1024, NB = 16, SEQ = 4096, LCX = 256, DEPTH = 4;
constexpr int NL = NB * SEQ, NC = NB * LCX, NT = NL + NC;
constexpr int N_IN = 2592, PCOLS = 2048, D_OFF = 1824, HYC = 768;
constexpr int FFD = 2816, FFE = 3584, NE = 8;
constexpr float ALPHA = 1.6817928305074292f;
constexpr int NWAVES = 8, NTHR = 512;
constexpr int KSEQ = SEQ + LCX;

enum { I_X = 0, I_C, I_CTX, I_CCTX, I_ADAW, I_ADAB, I_WIN, I_QNORM, I_KVNORM, I_WUQ, I_WUKV, I_MLAON, I_LCW, I_LCB, I_LWR, I_LBR, I_LWI, I_LBI, I_LLAM, I_LON,
       I_MUP, I_MUN, I_W0, I_WUP, I_A0, I_AUP, I_GUP, I_KK, I_KA, I_RK, I_LNG, I_LNB, I_HCW, I_HCB, I_HW1, I_HB1, I_HW2, I_HB2, I_HW3, I_HD, I_HON,
       I_WOUT, I_LN1G, I_LN1B, I_LN2G, I_LN2B, I_FG, I_FU, I_FD, I_ROUTER, I_MG, I_MU, I_MD, N_INPUTS };

constexpr size_t MiB = 1u << 20;
constexpr size_t WS_CTL = 0, CTL_ZERO_BYTES = 1 * MiB;
constexpr size_t WS_MOD = 1 * MiB;
constexpr size_t WS_ROPE = 3 * MiB;
constexpr size_t WS_H2L = 4 * MiB;
constexpr size_t WS_H2C = 8 * MiB;
constexpr size_t WS_LRUW = 9 * MiB;
constexpr size_t WS_WUQT = 10 * MiB;
constexpr size_t WS_WUKVT = 11 * MiB;
constexpr size_t WS_SUMM = 12 * MiB;
constexpr size_t WS_BON = 17 * MiB;
constexpr size_t WS_TOKE = 20 * MiB;
constexpr size_t WS_TOKG = 21 * MiB;
constexpr size_t WS_TOKS = 22 * MiB;
constexpr size_t WS_BLKCNT = 23 * MiB;
constexpr size_t WS_SPEC = 24 * MiB;
constexpr size_t WS_WINT = 56 * MiB;
constexpr size_t WS_WHYT = 72 * MiB;
constexpr size_t WS_WOUTT = 78 * MiB;
constexpr size_t WS_WGUT = 86 * MiB;
constexpr size_t WS_WDT = 108 * MiB;
constexpr size_t WS_XC = 120 * MiB;
constexpr size_t WS_A1 = 136 * MiB;
constexpr size_t WS_ARENA = 272 * MiB;
constexpr size_t WS_P = WS_ARENA;
constexpr size_t WS_HT = 544 * MiB;
constexpr size_t WS_QB = 646 * MiB;
constexpr size_t WS_KB = 697 * MiB;
constexpr size_t WS_VT = 748 * MiB;
constexpr size_t WS_AO = 782 * MiB;
constexpr size_t WS_HOT = 816 * MiB;
constexpr size_t WS_YR = 850 * MiB;
constexpr size_t WS_Y = 986 * MiB;
constexpr size_t WS_H = WS_ARENA;
constexpr size_t WS_MGU = WS_ARENA;
constexpr size_t WS_MD = 384 * MiB;
constexpr size_t WS_XS = 440 * MiB;
constexpr size_t WS_HM = 716 * MiB;
constexpr size_t WS_END = 1122 * MiB;
constexpr int MOE_MAX_TILES = 552, MOE_NCHUNK = 3, MOE_CHUNK_TILES = 184;
static_assert(WS_HM + (size_t)MOE_CHUNK_TILES * 256 * FFE * 2 <= WS_END, "moe hidden chunk");
static_assert(WS_H + (size_t)NT * FFD * 2 <= WS_QB + 51 * MiB, "dense hidden");

constexpr int CW_BAR = 4096;

constexpr int RING_BYTES = 131072;
constexpr int LDSCTL_OFF = RING_BYTES;
constexpr int LDS_TILEE = LDSCTL_OFF + 256;
constexpr int LDS_MOEI = LDSCTL_OFF + 1024;
constexpr int LDS_BYTES = 147456;

#define LDS_WAIT() asm volatile("s_waitcnt lgkmcnt(0)" ::: "memory")
#define VM_WAIT() asm volatile("s_waitcnt vmcnt(0)" ::: "memory")
__device__ __forceinline__ unsigned f2bf(float f) { unsigned u = __builtin_bit_cast(unsigned, f); return (u + 0x7fffu + ((u >> 16) & 1u)) >> 16; }
__device__ __forceinline__ unsigned pk2(float lo, float hi) { return f2bf(lo) | (f2bf(hi) << 16); }
__device__ __forceinline__ float bf2f(unsigned b) { return __builtin_bit_cast(float, b << 16); }
__device__ __forceinline__ float bflo(unsigned w) { return __builtin_bit_cast(float, w << 16); }
__device__ __forceinline__ float bfhi(unsigned w) { return __builtin_bit_cast(float, w & 0xffff0000u); }
__device__ __forceinline__ float wave_sum(float v) {
#pragma unroll
    for (int o = 1; o < 64; o <<= 1) v += __shfl_xor(v, o);
    return v;
}
__device__ __forceinline__ float sigmoidf_(float x) { return 1.f / (1.f + __expf(-x)); }
#define XB_TMO      128
#define XB_XCNT(j)  (256  + 64 * (j))
#define XB_XSUB(j)  (1280 + 64 * (j))
#define XB_XGEN(j)  (2304 + 64 * (j))
#define XB_TOP      3328
#define XB_TOPGEN   3392
#define XCD_BAR_WORDS 3456
#define XB_SPIN_CAP (1u << 18)

__device__ __forceinline__ unsigned xb_ld(unsigned* p)              { return __hip_atomic_load(p, __ATOMIC_RELAXED, __HIP_MEMORY_SCOPE_AGENT); }
__device__ __forceinline__ unsigned xb_add(unsigned* p, unsigned v) { return __hip_atomic_fetch_add(p, v, __ATOMIC_RELAXED, __HIP_MEMORY_SCOPE_AGENT); }
__device__ __forceinline__ unsigned xb_xcc_id() { return (unsigned)__builtin_amdgcn_s_getreg((3 << 11) | 20) & 0xFu; }
#define XB_SPIN(cond, bar) do { unsigned _sp = 0; while (cond) { __builtin_amdgcn_s_sleep(1); \
    if ((++_sp & 255u) == 0u) { if (xb_ld(&(bar)[XB_TMO])) break; if (_sp > XB_SPIN_CAP) { atomicAdd(&(bar)[XB_TMO], 1u); break; } } } } while (0)

struct XcdBarrier {
    unsigned* bar; unsigned x;
    volatile LAS unsigned* st;
};

__device__ __forceinline__ XcdBarrier xcd_barrier_post(unsigned* bar, volatile LAS unsigned* st) {
    XcdBarrier b; b.bar = bar; b.x = xb_xcc_id(); b.st = st;
    if (threadIdx.x == 0) (void)xb_add(&bar[XB_XCNT(b.x)], 1u);
    return b;
}
__device__ __forceinline__ void xcd_barrier_complete(unsigned* bar, unsigned x, unsigned& nloc, unsigned& nx) {
    const unsigned G = gridDim.x * gridDim.y * gridDim.z;
    unsigned sum, cnt, mine, sp = 0u;
    for (;;) {
        sum = 0u; cnt = 0u; mine = 0u;
#pragma unroll
        for (unsigned j = 0; j < 16; ++j) { const unsigned c = xb_ld(&bar[XB_XCNT(j)]); sum += c; cnt += (c > 0u) ? 1u : 0u; mine = (j == x) ? c : mine; }
        if (sum == G) break;
        __builtin_amdgcn_s_sleep(1);
        if ((++sp & 255u) == 0u) { if (xb_ld(&bar[XB_TMO])) break; if (sp > XB_SPIN_CAP) { atomicAdd(&bar[XB_TMO], 1u); break; } }
    }
    nloc = mine > 0u ? mine : 1u; nx = cnt > 0u ? cnt : 1u;
}

__device__ __forceinline__ void xcd_barrier(const XcdBarrier& b) {
    asm volatile("s_waitcnt vmcnt(0)" ::: "memory");
    __syncthreads();
    if (threadIdx.x == 0) {
        unsigned* bar = b.bar;
        __builtin_amdgcn_s_waitcnt(0);
        unsigned nloc = b.st[0], nx = b.st[1];
        if (nloc == 0u) { xcd_barrier_complete(bar, b.x, nloc, nx); b.st[0] = nloc; b.st[1] = nx; }
        const unsigned old = xb_add(&bar[XB_XSUB(b.x)], 1u);
        const unsigned gen = old / nloc;
        if (old + 1u == (gen + 1u) * nloc) {
            __builtin_amdgcn_fence(__ATOMIC_RELEASE, "agent");
            asm volatile("s_waitcnt vmcnt(0)" ::: "memory");
            const unsigned og = xb_add(&bar[XB_TOP], 1u);
            const unsigned tg = og / nx;
            if (og + 1u == (tg + 1u) * nx) xb_add(&bar[XB_TOPGEN], 1u);
            else XB_SPIN(xb_ld(&bar[XB_TOPGEN]) == tg, bar);
            __builtin_amdgcn_fence(__ATOMIC_ACQUIRE, "agent");
            xb_add(&bar[XB_XGEN(b.x)], 1u);
            asm volatile("s_waitcnt vmcnt(0)" ::: "memory");
        } else {
            XB_SPIN(xb_ld(&bar[XB_XGEN(b.x)]) == gen, bar);
            __builtin_amdgcn_fence(__ATOMIC_ACQUIRE, "agent");
            asm volatile("s_waitcnt vmcnt(0)" ::: "memory");
        }
    }
    __syncthreads();
}

struct Args { const float* in[N_INPUTS]; float* out; unsigned char* ws; };
struct Frame { LAS unsigned char* lds; int tid, lane, wave, G; };
__device__ __forceinline__ void frame_refresh(Frame& F) { int t = threadIdx.x; asm volatile("" : "+v"(t)); F.tid = t; F.lane = t & 63; }
#define CAS __attribute__((address_space(4)))
__device__ __forceinline__ const CAS char* karg() { const CAS char* kp = (const CAS char*)__builtin_amdgcn_kernarg_segment_ptr(); asm volatile("" : "+s"(kp)); return kp; }
__device__ __forceinline__ const float* in_ptr(int i) { return *(const float* const CAS*)(karg() + 8 * i); }
__device__ __forceinline__ float* out_ptr() { return *(float* const CAS*)(karg() + 8 * N_INPUTS); }
__device__ __forceinline__ unsigned char* ws_ptr() { return *(unsigned char* const CAS*)(karg() + 8 * N_INPUTS + 8); }
#define WSP(T, off) ((T*)(ws + (off)))
#define WS_DECL unsigned char* const ws = ws_ptr()

namespace pg8 {
struct EpiStore {
    static constexpr bool PERM = true, AFTER_DRAIN = false;
    bf16_t* O; int ldc; int pm_add; int nN;
    __device__ __forceinline__ void operator()(const f32x4 (&acc)[2][2][4][2], const Unit& u, int wr, int wc, int fr, int fq) const {
        const int row0 = (u.pm + pm_add) * BM + wr * 64 + fr; const int col0 = (u.pn % nN) * BM + wc * 32 + 8 * fq;
#pragma unroll
        for (int ai = 0; ai < 2; ++ai)
#pragma unroll
            for (int m = 0; m < 4; ++m) { bf16_t* rowp = O + (size_t)(row0 + ai * HALF + m * 16) * ldc + col0;
#pragma unroll
                for (int bj = 0; bj < 2; ++bj) { const f32x4 v0 = acc[ai][bj][m][0], v1 = acc[ai][bj][m][1];
                    u32x4 w; w.x = cvt_pk_bf16(v0[0], v0[1]); w.y = cvt_pk_bf16(v0[2], v0[3]); w.z = cvt_pk_bf16(v1[0], v1[1]); w.w = cvt_pk_bf16(v1[2], v1[3]);
                    *(u32x4*)(rowp + bj * HALF) = w; } }
    }
};
__device__ __forceinline__ float silu_mul(float g, float u) { return g * __builtin_amdgcn_rcpf(1.f + __expf(-g)) * u; }
struct EpiSwiGLU {
    static constexpr bool PERM = true, AFTER_DRAIN = false;
    bf16_t* H; int ldh; int pm_sub; int nN;
    __device__ __forceinline__ void operator()(const f32x4 (&acc)[2][2][4][2], const Unit& u, int wr, int wc, int fr, int fq) const {
        const int row0 = (u.pm - pm_sub) * BM + wr * 64 + fr; const int col0 = (u.pn % nN) * HALF + wc * 32 + 8 * fq;
#pragma unroll
        for (int ai = 0; ai < 2; ++ai)
#pragma unroll
            for (int m = 0; m < 4; ++m) { bf16_t* rowp = H + (size_t)(row0 + ai * HALF + m * 16) * ldh + col0;
                const f32x4 g0 = acc[ai][0][m][0], g1 = acc[ai][0][m][1], u0 = acc[ai][1][m][0], u1 = acc[ai][1][m][1];
                u32x4 w; w.x = cvt_pk_bf16(silu_mul(g0[0], u0[0]), silu_mul(g0[1], u0[1])); w.y = cvt_pk_bf16(silu_mul(g0[2], u0[2]), silu_mul(g0[3], u0[3]));
                w.z = cvt_pk_bf16(silu_mul(g1[0], u1[0]), silu_mul(g1[1], u1[1])); w.w = cvt_pk_bf16(silu_mul(g1[2], u1[2]), silu_mul(g1[3], u1[3]));
                *(u32x4*)rowp = w; }
    }
};
struct MoeOrder {
    int nM, nN, nwg, G, c, t0, pm_off; const PG8_LAS unsigned char* tile_e;
    __device__ void init(int nM_, int nN_, int G_, int c_, int t0_, int pm_off_, const PG8_LAS unsigned char* te) { nM = nM_; nN = nN_; nwg = nM * nN; G = G_; c = c_; t0 = t0_; pm_off = pm_off_; tile_e = te; }
    __device__ bool next(int i, Unit& u) const {
        const long L = (long)i * G + c; if (L >= nwg) return false;
        int wgid = (int)L; { const int q = nwg / NXCD, r = nwg % NXCD, xcd = wgid % NXCD, off = wgid / NXCD; wgid = (xcd < r ? xcd * (q + 1) : r * (q + 1) + (xcd - r) * q) + off; }
        const int nig = WGM * nN, gid = wgid / nig, fm = gid * WGM, gsz = (nM - fm) < WGM ? (nM - fm) : WGM;
        const int pml = fm + ((wgid % nig) % gsz), pnl = (wgid % nig) / gsz;
        const int e = tile_e[t0 + pml];
        u.pm = pm_off + pml; u.pn = e * nN + pnl; return true;
    }
    __device__ __forceinline__ void a_ready(const Unit&) const {}
    __device__ __forceinline__ void done(const Unit&) const {}
};
}

__device__ __forceinline__ void tr_item(const float* W, int ldw, int k0, int c0, bf16* WT, int K, int drow, LAS float* scr, int lane) {
#pragma unroll 8
    for (int i = 0; i < 32; ++i) { const int kk = 2 * i + (lane >> 5); scr[kk * 33 + (lane & 31)] = W[(size_t)(k0 + kk) * ldw + c0 + (lane & 31)]; }
    LDS_WAIT(); asm volatile("" ::: "memory");
    const int c = lane & 7;
#pragma unroll
    for (int j = 0; j < 4; ++j) { const int n = (lane >> 3) + 8 * j; const LAS float* s = scr + (8 * c) * 33 + n;
        v4u o; o.x = pk2(s[0 * 33], s[1 * 33]); o.y = pk2(s[2 * 33], s[3 * 33]); o.z = pk2(s[4 * 33], s[5 * 33]); o.w = pk2(s[6 * 33], s[7 * 33]);
        *(GAS v4u*)(WT + (size_t)(drow + n) * K + k0 + 8 * c) = o; }
    LDS_WAIT(); asm volatile("" ::: "memory");
}
__device__ __forceinline__ void conv_matrix(Frame& F, const float* W, int K, int ldw, int cbeg, int ncols, bf16* WT, int mode, int rowoff, int& cursor) {
    const int gw = blockIdx.x * NWAVES + F.wave, NGW = F.G * NWAVES;
    const int nblk = ncols / 32, nit = (K / 64) * nblk;
    LAS float* scr = (LAS float*)(F.lds + F.wave * 16384);
    int first = cursor + (((gw - cursor) % NGW) + NGW) % NGW;
    for (int it = first; it < cursor + nit; it += NGW) {
        const int idx = it - cursor, kb = idx / nblk, nb = idx % nblk, n = 32 * nb;
        const int drow = mode == 0 ? rowoff + n : ((n >> 7) * 256 + (n & 127) + rowoff);
        tr_item(W, ldw, 64 * kb, cbeg + n, WT, K, drow, scr, F.lane);
    }
    cursor += nit;
}

__device__ __forceinline__ void phase_mod(Frame& F) { WS_DECL; frame_refresh(F);
    LAS float* sv = (LAS float*)F.lds;
    LAS float* red = (LAS float*)(F.lds + 69632);
    float* MOD = WSP(float, WS_MOD);
    if ((int)blockIdx.x < 192) {
        const float* cl_ = in_ptr(I_C); const float* cc_ = in_ptr(I_CCTX); const float* adab = in_ptr(I_ADAB); const float* adaw = in_ptr(I_ADAW);
        for (int i = F.tid; i < 17 * 1024; i += NTHR) { const int b = i >> 10, k = i & 1023; const float c = b < 16 ? cl_[b * 1024 + k] : cc_[k]; sv[i] = c / (1.f + expf(-c)); }
        __syncthreads();
        for (int item = blockIdx.x; item < 192; item += F.G) {
            const int li = item / 48, cg = item % 48, cl = F.tid & 127, kq = F.tid >> 7;
            const float* W = adaw + (size_t)li * 1024 * 6144 + cg * 128 + cl;
            float acc[17];
#pragma unroll
            for (int b = 0; b < 17; ++b) acc[b] = 0.f;
            for (int k = kq * 256; k < kq * 256 + 256; ++k) { const float w = W[(size_t)k * 6144];
#pragma unroll
                for (int b = 0; b < 17; ++b) acc[b] += sv[b * 1024 + k] * w; }
#pragma unroll
            for (int b = 0; b < 17; ++b) red[(kq * 17 + b) * 128 + cl] = acc[b];
            __syncthreads();
            for (int o = F.tid; o < 17 * 128; o += NTHR) { const int b = o >> 7, c = o & 127;
                const float s = (red[(0 * 17 + b) * 128 + c] + red[(1 * 17 + b) * 128 + c]) + (red[(2 * 17 + b) * 128 + c] + red[(3 * 17 + b) * 128 + c]);
                MOD[((size_t)li * 17 + b) * 6144 + cg * 128 + c] = s + adab[li * 6144 + cg * 128 + c]; }
            __syncthreads();
        }
    }
}

__device__ __forceinline__ void phase_pro0(Frame& F) { WS_DECL; frame_refresh(F);
    phase_mod(F);
    __syncthreads();
    int cursor = 0;
    for (int li = 0; li < DEPTH; ++li) {
        conv_matrix(F, in_ptr(I_WIN) + (size_t)li * D * N_IN, D, N_IN, 0, D_OFF, WSP(bf16, WS_WINT) + (size_t)li * PCOLS * D, 0, 0, cursor);
        conv_matrix(F, in_ptr(I_WIN) + (size_t)li * D * N_IN, D, N_IN, D_OFF, HYC, WSP(bf16, WS_WHYT) + (size_t)li * HYC * D, 0, 0, cursor);
        conv_matrix(F, in_ptr(I_WOUT) + (size_t)li * D * D, D, D, 0, D, WSP(bf16, WS_WOUTT) + (size_t)li * D * D, 0, 0, cursor);
    }
    for (int j = 0; j < 2; ++j) {
        conv_matrix(F, in_ptr(I_FG) + (size_t)j * D * FFD, D, FFD, 0, FFD, WSP(bf16, WS_WGUT) + (size_t)j * 2 * FFD * D, 1, 0, cursor);
        conv_matrix(F, in_ptr(I_FU) + (size_t)j * D * FFD, D, FFD, 0, FFD, WSP(bf16, WS_WGUT) + (size_t)j * 2 * FFD * D, 1, 128, cursor);
        conv_matrix(F, in_ptr(I_FD) + (size_t)j * FFD * D, FFD, D, 0, D, WSP(bf16, WS_WDT) + (size_t)j * D * FFD, 0, 0, cursor);
    }
    { const int gt = blockIdx.x * NTHR + F.tid, NGT = F.G * NTHR; const int per = (PCOLS - D_OFF) * D / 8;
      for (int i = gt; i < DEPTH * per; i += NGT) { const int li = i / per, r = i % per; *(GAS v4u*)(WSP(bf16, WS_WINT) + (size_t)li * PCOLS * D + (size_t)D_OFF * D + (size_t)r * 8) = (v4u){0u, 0u, 0u, 0u}; } }
}

struct Stream { const float* inl; const float* inc; float* outl; float* outc; };
__device__ __forceinline__ Stream make_stream(unsigned char* ws, int li) { Stream s; s.outl = out_ptr(); s.outc = WSP(float, WS_XC); s.inl = li == 0 ? in_ptr(I_X) : (const float*)s.outl; s.inc = li == 0 ? in_ptr(I_CTX) : (const float*)s.outc; return s; }
__device__ __forceinline__ const float* stream_in(const Stream& s, int m) { return m < NL ? s.inl + (size_t)m * D : s.inc + (size_t)(m - NL) * D; }
__device__ __forceinline__ float* stream_out(const Stream& s, int m) { return m < NL ? s.outl + (size_t)m * D : s.outc + (size_t)(m - NL) * D; }
__device__ __forceinline__ int mod_b(int m) { return m < NL ? (m >> 12) : 16; }
__device__ __forceinline__ const float* mod_vec(unsigned char* ws, int li, int b, int j) { return WSP(float, WS_MOD) + ((size_t)li * 17 + b) * 6144 + j * 1024; }

__device__ __forceinline__ void store_modulated(const f32x4 (&x)[4], const float* shift, const float* scale, bf16* orow, int lane) {
#pragma unroll
    for (int j = 0; j < 4; ++j) { const int c = 4 * lane + 256 * j; const f32x4 sh = *(const GAS f32x4*)(shift + c), sc = *(const GAS f32x4*)(scale + c);
        const f32x4 h = x[j] * (sc + 1.f) + sh; v2u w; w.x = pk2(h.x, h.y); w.y = pk2(h.z, h.w); *(GAS v2u*)(orow + c) = w; }
}
__device__ __forceinline__ void rows_range(const Frame& F, int nrows, int& r0, int& r1) { const int per = (nrows + F.G - 1) / F.G; r0 = blockIdx.x * per; r1 = r0 + per < nrows ? r0 + per : nrows; if (r0 > nrows) r0 = nrows; }

__device__ __forceinline__ void phase_hin0(Frame& F) { WS_DECL; frame_refresh(F);
    int r0, r1; rows_range(F, NT, r0, r1); const Stream st = make_stream(ws, 0);
    for (int m = r0 + F.wave; m < r1; m += NWAVES) {
        const float* xr = stream_in(st, m); f32x4 x[4];
#pragma unroll
        for (int j = 0; j < 4; ++j) x[j] = *(const GAS f32x4*)(xr + 4 * F.lane + 256 * j);
        const int b = mod_b(m);
        store_modulated(x, mod_vec(ws, 0, b, 0), mod_vec(ws, 0, b, 1), WSP(bf16, WS_A1) + (size_t)m * D, F.lane);
    }
}

__device__ __forceinline__ void ln_rows(f32x4 (&v)[4], const float* g, const float* bta, int lane) {
    float s = 0.f;
#pragma unroll
    for (int j = 0; j < 4; ++j) s += (v[j].x + v[j].y) + (v[j].z + v[j].w);
    const float mean = wave_sum(s) * (1.f / D); float s2 = 0.f;
#pragma unroll
    for (int j = 0; j < 4; ++j) { v[j] = v[j] - mean; s2 += (v[j].x * v[j].x + v[j].y * v[j].y) + (v[j].z * v[j].z + v[j].w * v[j].w); }
    const float rstd = 1.f / sqrtf(wave_sum(s2) * (1.f / D) + 1e-5f);
#pragma unroll
    for (int j = 0; j < 4; ++j) { const int c = 4 * lane + 256 * j; v[j] = v[j] * rstd * *(const GAS f32x4*)(g + c) + *(const GAS f32x4*)(bta + c); }
}

template <bool HAVE_Y>
__device__ __forceinline__ void phase_ln1(Frame& F, int li) { WS_DECL; frame_refresh(F);
    const int nrows = li == DEPTH - 1 ? NL : NT; const bool moe = li & 1;
    LAS int* hist = (LAS int*)(F.lds + LDS_MOEI) + 56;
    if (moe) { if (F.tid < 8) hist[F.tid] = 0; __syncthreads(); }
    int r0, r1; rows_range(F, nrows, r0, r1);
    const float* g = in_ptr(I_LN1G) + li * D; const float* bt = in_ptr(I_LN1B) + li * D; const Stream st = make_stream(ws, li);
    const float* router = in_ptr(I_ROUTER) + (size_t)(li >> 1) * D * NE;
    for (int m = r0 + F.wave; m < r1; m += NWAVES) {
        const float* xr = stream_in(st, m); const int b = mod_b(m); f32x4 v[4];
        const float* m2 = mod_vec(ws, li, b, 2);
#pragma unroll
        for (int j = 0; j < 4; ++j) { const int c = 4 * F.lane + 256 * j; v[j] = *(const GAS f32x4*)(xr + c) * ALPHA;
            if (HAVE_Y) { const v2u yw = *(const GAS v2u*)(WSP(bf16, WS_Y) + (size_t)m * D + c); const f32x4 mm = *(const GAS f32x4*)(m2 + c);
                v[j].x += mm.x * bflo(yw.x); v[j].y += mm.y * bfhi(yw.x); v[j].z += mm.z * bflo(yw.y); v[j].w += mm.w * bfhi(yw.y); } }
        ln_rows(v, g, bt, F.lane);
        float* xo = stream_out(st, m);
#pragma unroll
        for (int j = 0; j < 4; ++j) *(GAS f32x4*)(xo + 4 * F.lane + 256 * j) = v[j];
        const float* sh = mod_vec(ws, li, b, 3); const float* sc = mod_vec(ws, li, b, 4);
        if (moe) {
            float lg[NE];
#pragma unroll
            for (int e = 0; e < NE; ++e) lg[e] = 0.f;
#pragma unroll
            for (int j = 0; j < 4; ++j) { const int c = 4 * F.lane + 256 * j; const f32x4 s4 = *(const GAS f32x4*)(sh + c), c4 = *(const GAS f32x4*)(sc + c); const f32x4 f = v[j] * (c4 + 1.f) + s4;
#pragma unroll
                for (int q = 0; q < 4; ++q) { const f32x4 ra = *(const GAS f32x4*)(router + (size_t)(c + q) * NE), rb = *(const GAS f32x4*)(router + (size_t)(c + q) * NE + 4); const float fq = f[q];
                    lg[0] += fq * ra.x; lg[1] += fq * ra.y; lg[2] += fq * ra.z; lg[3] += fq * ra.w; lg[4] += fq * rb.x; lg[5] += fq * rb.y; lg[6] += fq * rb.z; lg[7] += fq * rb.w; } }
#pragma unroll
            for (int e = 0; e < NE; ++e) lg[e] = wave_sum(lg[e]);
            int e0 = 0; float v0 = lg[0];
#pragma unroll
            for (int e = 1; e < NE; ++e) if (lg[e] > v0) { v0 = lg[e]; e0 = e; }
            int e1 = -1; float v1 = -3.0e38f;
#pragma unroll
            for (int e = 0; e < NE; ++e) if (e != e0 && lg[e] > v1) { v1 = lg[e]; e1 = e; }
            const float ex = __expf(v1 - v0), g0 = 1.f / (1.f + ex), g1 = ex * g0;
            if (F.lane == 0) { *(GAS v2u*)(WSP(int, WS_TOKE) + 2 * (size_t)m) = (v2u){(unsigned)e0, (unsigned)e1}; *(GAS f32x2*)(WSP(float, WS_TOKG) + 2 * (size_t)m) = (f32x2){g0, g1};
                atomicAdd((int*)(hist + e0), 1); atomicAdd((int*)(hist + e1), 1); }
        }
        store_modulated(v, sh, sc, WSP(bf16, WS_A1) + (size_t)m * D, F.lane);
    }
    if (moe) { __syncthreads(); if (F.tid < 8) WSP(int, WS_BLKCNT)[blockIdx.x * 8 + F.tid] = hist[F.tid]; }
}

template <bool HAVE_FFN>
__device__ __forceinline__ void phase_ln2(Frame& F, int li) { WS_DECL; frame_refresh(F);
    const int nrows = li == DEPTH - 1 ? NL : NT; const bool moe = li & 1;
    int r0, r1; rows_range(F, nrows, r0, r1);
    const float* g = in_ptr(I_LN2G) + li * D; const float* bt = in_ptr(I_LN2B) + li * D; const Stream st = make_stream(ws, 1);
    for (int m = r0 + F.wave; m < r1; m += NWAVES) {
        const float* xr = stream_out(st, m); const int b = mod_b(m); f32x4 v[4];
        const float* m5 = mod_vec(ws, li, b, 5);
        int s0 = 0, s1 = 0; float g0 = 0.f, g1 = 0.f;
        if (moe) { const v2u ss = *(const GAS v2u*)(WSP(int, WS_TOKS) + 2 * (size_t)m); const f32x2 gg = *(const GAS f32x2*)(WSP(float, WS_TOKG) + 2 * (size_t)m); s0 = (int)ss.x; s1 = (int)ss.y; g0 = gg.x; g1 = gg.y; }
#pragma unroll
        for (int j = 0; j < 4; ++j) { const int c = 4 * F.lane + 256 * j; v[j] = *(const GAS f32x4*)(xr + c) * ALPHA;
            if (HAVE_FFN) { const f32x4 mm = *(const GAS f32x4*)(m5 + c); f32x4 o;
                if (moe) { const v2u ya = *(const GAS v2u*)(WSP(bf16, WS_XS) + (size_t)s0 * D + c), yb = *(const GAS v2u*)(WSP(bf16, WS_XS) + (size_t)s1 * D + c);
                    o.x = g0 * bflo(ya.x) + g1 * bflo(yb.x); o.y = g0 * bfhi(ya.x) + g1 * bfhi(yb.x); o.z = g0 * bflo(ya.y) + g1 * bflo(yb.y); o.w = g0 * bfhi(ya.y) + g1 * bfhi(yb.y); }
                else { const v2u yw = *(const GAS v2u*)(WSP(bf16, WS_Y) + (size_t)m * D + c); o.x = bflo(yw.x); o.y = bfhi(yw.x); o.z = bflo(yw.y); o.w = bfhi(yw.y); }
                v[j] = v[j] + mm * o; } }
        ln_rows(v, g, bt, F.lane);
        float* xo = stream_out(st, m);
#pragma unroll
        for (int j = 0; j < 4; ++j) *(GAS f32x4*)(xo + 4 * F.lane + 256 * j) = v[j];
        if (li < DEPTH - 1) store_modulated(v, mod_vec(ws, li + 1, b, 0), mod_vec(ws, li + 1, b, 1), WSP(bf16, WS_A1) + (size_t)m * D, F.lane);
    }
}

__device__ __forceinline__ void phase_moe_weights(Frame& F, int li) { WS_DECL; frame_refresh(F);
    const int j = li >> 1; int cursor = 0;
    for (int e = 0; e < NE; ++e) {
        conv_matrix(F, in_ptr(I_MG) + ((size_t)j * NE + e) * D * FFE, D, FFE, 0, FFE, WSP(bf16, WS_MGU) + (size_t)e * 2 * FFE * D, 1, 0, cursor);
        conv_matrix(F, in_ptr(I_MU) + ((size_t)j * NE + e) * D * FFE, D, FFE, 0, FFE, WSP(bf16, WS_MGU) + (size_t)e * 2 * FFE * D, 1, 128, cursor);
        conv_matrix(F, in_ptr(I_MD) + ((size_t)j * NE + e) * FFE * D, FFE, D, 0, D, WSP(bf16, WS_MD) + (size_t)e * D * FFE, 0, 0, cursor);
    }
}

__device__ __forceinline__ void phase_moe_slots(Frame& F, int li) { WS_DECL; frame_refresh(F);
    const int nrows = li == DEPTH - 1 ? NL : NT;
    LAS int* mi = (LAS int*)(F.lds + LDS_MOEI); LAS unsigned char* tile_e = (LAS unsigned char*)(F.lds + LDS_TILEE);
    LAS int* slots = (LAS int*)F.lds;
    const int* blkcnt = WSP(int, WS_BLKCNT);
    if (F.tid < 8) { int tot = 0, pre = 0; for (int b = 0; b < F.G; ++b) { const int c = blkcnt[b * 8 + F.tid]; if (b < (int)blockIdx.x) pre += c; tot += c; } mi[16 + F.tid] = tot; mi[32 + F.tid] = pre; }
    __syncthreads();
    if (F.tid == 0) { int s = 0; for (int e = 0; e < NE; ++e) { mi[e] = s; s += (mi[16 + e] + 255) & ~255; } mi[8] = s; mi[48] = s >> 8; }
    __syncthreads();
    for (int t = F.tid; t < MOE_MAX_TILES + 8; t += NTHR) { int e = 0;
#pragma unroll
        for (int q = 1; q < NE; ++q) if (t * 256 >= mi[q]) e = q;
        tile_e[t] = (unsigned char)e; }
    int r0, r1; rows_range(F, nrows, r0, r1);
    const int na = 2 * (r1 - r0);
    if (F.wave == 0) {
        int run[NE];
#pragma unroll
        for (int e = 0; e < NE; ++e) run[e] = mi[e] + mi[32 + e];
        for (int base = 0; base < na; base += 64) { const int ai = base + F.lane; const bool ok = ai < na;
            const int e = ok ? WSP(int, WS_TOKE)[2 * (size_t)r0 + ai] : -1; int slot = 0;
#pragma unroll
            for (int q = 0; q < NE; ++q) { const unsigned long long mk = __ballot(e == q); if (e == q) slot = run[q] + __popcll(mk & ((1ull << F.lane) - 1ull)); run[q] += __popcll(mk); }
            if (ok) { slots[ai] = slot; WSP(int, WS_TOKS)[2 * (size_t)r0 + ai] = slot; } }
    }
    __syncthreads();
    for (int ai = F.wave; ai < na; ai += NWAVES) { const int m = r0 + (ai >> 1), slot = slots[ai];
        const GAS v4u* src = (const GAS v4u*)(WSP(bf16, WS_A1) + (size_t)m * D); GAS v4u* dst = (GAS v4u*)(WSP(bf16, WS_XS) + (size_t)slot * D);
        dst[F.lane] = src[F.lane]; dst[F.lane + 64] = src[F.lane + 64]; }
    { const int gw = blockIdx.x * NWAVES + F.wave, NGW = F.G * NWAVES; int cnt = 0;
      for (int e = 0; e < NE; ++e) { const int p0 = mi[e] + mi[16 + e], p1 = mi[e + 1];
          for (int s = p0; s < p1; ++s, ++cnt) if (cnt % NGW == gw) { GAS v4u* dst = (GAS v4u*)(WSP(bf16, WS_XS) + (size_t)s * D); dst[F.lane] = (v4u){0u, 0u, 0u, 0u}; dst[F.lane + 64] = (v4u){0u, 0u, 0u, 0u}; } } }
    __syncthreads();
}

constexpr float QSCALE = 0.14724319f;
constexpr int MP_CQ_LD = 200, MP_CKV_LD = 136;
__device__ __forceinline__ void phase_mla_prep(Frame& F, int li) { WS_DECL; frame_refresh(F);
    LAS bf16* CQN = (LAS bf16*)F.lds; LAS bf16* CKVN = (LAS bf16*)(F.lds + 64 * MP_CQ_LD * 2);
    const bf16* P = WSP(bf16, WS_P); bf16* QB = WSP(bf16, WS_QB); bf16* KB = WSP(bf16, WS_KB); bf16* VT = WSP(bf16, WS_VT);
    const float* qn = in_ptr(I_QNORM) + li * 192; const float* kvn = in_ptr(I_KVNORM) + li * 128;
    const bf16* WQ = WSP(bf16, WS_WUQT) + (size_t)li * 384 * 192; const bf16* WKV = WSP(bf16, WS_WUKVT) + (size_t)li * 512 * 128;
    const float* RC = WSP(float, WS_ROPE); const float* RS = RC + 4096 * 16;
    const int lane = F.lane, wave = F.wave;
    for (int item = blockIdx.x; item < NT / 64; item += F.G) {
        const int m0 = item * 64; const bool isctx = m0 >= NL; const int b = isctx ? (m0 - NL) >> 8 : m0 >> 12; const int t0 = isctx ? (m0 - NL) & 255 : m0 & 4095;
        const int ki0 = isctx ? t0 : 256 + t0;
        for (int i = 0; i < 8; ++i) { const int tl = wave * 8 + i; const bf16* pr = P + (size_t)(m0 + tl) * PCOLS;
            v4u raw = (v4u){0u, 0u, 0u, 0u}; if (lane < 40) raw = *(const GAS v4u*)(pr + 8 * lane);
            float x[8]; x[0] = bflo(raw.x); x[1] = bfhi(raw.x); x[2] = bflo(raw.y); x[3] = bfhi(raw.y); x[4] = bflo(raw.z); x[5] = bfhi(raw.z); x[6] = bflo(raw.w); x[7] = bfhi(raw.w);
            float ss = 0.f;
#pragma unroll
            for (int j = 0; j < 8; ++j) ss += x[j] * x[j];
            const float sq = wave_sum(lane < 24 ? ss : 0.f), skv = wave_sum((lane >= 24 && lane < 40) ? ss : 0.f);
            const float rq = rsqrtf(sq * (1.f / 192.f) + 1e-6f), rkv = rsqrtf(skv * (1.f / 128.f) + 1e-6f);
            if (lane < 24) { const float* g = qn + 8 * lane; v4u o; o.x = pk2(x[0] * rq * g[0], x[1] * rq * g[1]); o.y = pk2(x[2] * rq * g[2], x[3] * rq * g[3]); o.z = pk2(x[4] * rq * g[4], x[5] * rq * g[5]); o.w = pk2(x[6] * rq * g[6], x[7] * rq * g[7]);
                *(LAS v4u*)(CQN + tl * MP_CQ_LD + 8 * lane) = o; }
            else if (lane < 40) { const int c = 8 * (lane - 24); const float* g = kvn + c; v4u o; o.x = pk2(x[0] * rkv * g[0], x[1] * rkv * g[1]); o.y = pk2(x[2] * rkv * g[2], x[3] * rkv * g[3]); o.z = pk2(x[4] * rkv * g[4], x[5] * rkv * g[5]); o.w = pk2(x[6] * rkv * g[6], x[7] * rkv * g[7]);
                *(LAS v4u*)(CKVN + tl * MP_CKV_LD + c) = o; }
            if (lane < 16) { float x1 = bf2f(pr[320 + lane]), x2 = bf2f(pr[336 + lane]);
                if (!isctx) { const float c = RC[(t0 + tl) * 16 + lane], s = RS[(t0 + tl) * 16 + lane]; const float y1 = x1 * c - x2 * s, y2 = x1 * s + x2 * c; x1 = y1; x2 = y2; }
                const bf16 o1 = (bf16)f2bf(x1), o2 = (bf16)f2bf(x2);
#pragma unroll
                for (int h = 0; h < 4; ++h) { bf16* kr = KB + ((size_t)(b * 4 + h) * KSEQ + ki0 + tl) * 96; kr[64 + lane] = o1; kr[80 + lane] = o2; } }
        }
        __syncthreads();
        const int head = wave >> 1, half = wave & 1, fr = lane & 15, kg = lane >> 4;
        const size_t qrow0 = ((size_t)(b * 4 + head) * KSEQ + ki0) * 96;
        for (int qi = 0; qi < 2; ++qi) {
            const int nt = half * 3 + qi; if (half == 1 && qi == 1) break;
            f32x4 acc[4];
#pragma unroll
            for (int m = 0; m < 4; ++m) acc[m] = (f32x4){0.f, 0.f, 0.f, 0.f};
#pragma unroll
            for (int ks = 0; ks < 6; ++ks) { const bf16x8 wf = *(const GAS bf16x8*)(WQ + (size_t)(96 * head + 16 * nt + fr) * 192 + 32 * ks + 8 * kg);
#pragma unroll
                for (int m = 0; m < 4; ++m) { const bf16x8 xf = *(const LAS bf16x8*)(CQN + (16 * m + fr) * MP_CQ_LD + 32 * ks + 8 * kg); acc[m] = __builtin_amdgcn_mfma_f32_16x16x32_bf16(wf, xf, acc[m], 0, 0, 0); } }
#pragma unroll
            for (int m = 0; m < 4; ++m) { v2u o; o.x = pk2(acc[m][0] * QSCALE, acc[m][1] * QSCALE); o.y = pk2(acc[m][2] * QSCALE, acc[m][3] * QSCALE);
                *(GAS v2u*)(QB + qrow0 + (size_t)(16 * m + fr) * 96 + 16 * nt + 4 * kg) = o; }
        }
        if (half == 0) {
            f32x4 acc[4];
#pragma unroll
            for (int m = 0; m < 4; ++m) acc[m] = (f32x4){0.f, 0.f, 0.f, 0.f};
#pragma unroll
            for (int ks = 0; ks < 6; ++ks) { const bf16x8 wf = *(const GAS bf16x8*)(WQ + (size_t)(96 * head + 32 + fr) * 192 + 32 * ks + 8 * kg);
#pragma unroll
                for (int m = 0; m < 4; ++m) { const bf16x8 xf = *(const LAS bf16x8*)(CQN + (16 * m + fr) * MP_CQ_LD + 32 * ks + 8 * kg); acc[m] = __builtin_amdgcn_mfma_f32_16x16x32_bf16(wf, xf, acc[m], 0, 0, 0); } }
#pragma unroll
            for (int m = 0; m < 4; ++m) { v2u o; o.x = pk2(acc[m][0] * QSCALE, acc[m][1] * QSCALE); o.y = pk2(acc[m][2] * QSCALE, acc[m][3] * QSCALE);
                *(GAS v2u*)(QB + qrow0 + (size_t)(16 * m + fr) * 96 + 32 + 4 * kg) = o; }
        } else {
            f32x4 a1[4], a2[4];
#pragma unroll
            for (int m = 0; m < 4; ++m) { a1[m] = (f32x4){0.f, 0.f, 0.f, 0.f}; a2[m] = (f32x4){0.f, 0.f, 0.f, 0.f}; }
#pragma unroll
            for (int ks = 0; ks < 6; ++ks) { const bf16x8 w1 = *(const GAS bf16x8*)(WQ + (size_t)(96 * head + 64 + fr) * 192 + 32 * ks + 8 * kg), w2 = *(const GAS bf16x8*)(WQ + (size_t)(96 * head + 80 + fr) * 192 + 32 * ks + 8 * kg);
#pragma unroll
                for (int m = 0; m < 4; ++m) { const bf16x8 xf = *(const LAS bf16x8*)(CQN + (16 * m + fr) * MP_CQ_LD + 32 * ks + 8 * kg);
                    a1[m] = __builtin_amdgcn_mfma_f32_16x16x32_bf16(w1, xf, a1[m], 0, 0, 0); a2[m] = __builtin_amdgcn_mfma_f32_16x16x32_bf16(w2, xf, a2[m], 0, 0, 0); } }
#pragma unroll
            for (int m = 0; m < 4; ++m) { f32x4 y1 = a1[m], y2 = a2[m];
                if (!isctx) { const int t = t0 + 16 * m + fr; const f32x4 c = *(const GAS f32x4*)(RC + t * 16 + 4 * kg), s = *(const GAS f32x4*)(RS + t * 16 + 4 * kg); y1 = a1[m] * c - a2[m] * s; y2 = a1[m] * s + a2[m] * c; }
                v2u o1, o2; o1.x = pk2(y1[0] * QSCALE, y1[1] * QSCALE); o1.y = pk2(y1[2] * QSCALE, y1[3] * QSCALE); o2.x = pk2(y2[0] * QSCALE, y2[1] * QSCALE); o2.y = pk2(y2[2] * QSCALE, y2[3] * QSCALE);
                bf16* qr = QB + qrow0 + (size_t)(16 * m + fr) * 96; *(GAS v2u*)(qr + 64 + 4 * kg) = o1; *(GAS v2u*)(qr + 80 + 4 * kg) = o2; }
        }
        for (int nt = 0; nt < 4; ++nt) {
            f32x4 acc[4];
#pragma unroll
            for (int m = 0; m < 4; ++m) acc[m] = (f32x4){0.f, 0.f, 0.f, 0.f};
#pragma unroll
            for (int ks = 0; ks < 4; ++ks) { const bf16x8 wf = *(const GAS bf16x8*)(WKV + (size_t)(128 * head + 64 * half + 16 * nt + fr) * 128 + 32 * ks + 8 * kg);
#pragma unroll
                for (int m = 0; m < 4; ++m) { const bf16x8 xf = *(const LAS bf16x8*)(CKVN + (16 * m + fr) * MP_CKV_LD + 32 * ks + 8 * kg);
                    acc[m] = half == 0 ? __builtin_amdgcn_mfma_f32_16x16x32_bf16(wf, xf, acc[m], 0, 0, 0) : __builtin_amdgcn_mfma_f32_16x16x32_bf16(xf, wf, acc[m], 0, 0, 0); } }
            if (half == 0) {
#pragma unroll
                for (int m = 0; m < 4; ++m) { v2u o; o.x = pk2(acc[m][0], acc[m][1]); o.y = pk2(acc[m][2], acc[m][3]);
                    *(GAS v2u*)(KB + qrow0 + (size_t)(16 * m + fr) * 96 + 16 * nt + 4 * kg) = o; }
            } else {
#pragma unroll
                for (int m = 0; m < 4; ++m) { v2u o; o.x = pk2(acc[m][0], acc[m][1]); o.y = pk2(acc[m][2], acc[m][3]);
                    *(GAS v2u*)(VT + ((size_t)(b * 4 + head) * 64 + 16 * nt + fr) * KSEQ + ki0 + 16 * m + 4 * kg) = o; }
            }
        }
        __syncthreads();
    }
}

constexpr int AT_KLD = 104, AT_VLD = 72;
constexpr int AT_KB = 64 * AT_KLD * 2, AT_VB = 64 * AT_VLD * 2, AT_BUF = AT_KB + AT_VB;
__device__ __forceinline__ void phase_attn(Frame& F, int li) { WS_DECL; frame_refresh(F);
    const bf16* QB = WSP(bf16, WS_QB); const bf16* KB = WSP(bf16, WS_KB); const bf16* VT = WSP(bf16, WS_VT); bf16* AO = WSP(bf16, WS_AO);
    const int lane = F.lane, wave = F.wave, tid = F.tid, ql = lane & 31, h2 = lane >> 5;
    const int nunits = 1024 + (li < DEPTH - 1 ? 64 : 0);
    const int c = blockIdx.x, vc = (F.G == 256) ? (c & 7) * 32 + (c >> 3) : c;
    for (int u = vc; u < nunits; u += F.G) {
        int bh, q0, nk; bool isctx = u >= 1024;
        if (!isctx) { bh = u >> 4; q0 = 256 + 256 * (u & 15); nk = KSEQ; } else { bh = u - 1024; q0 = 0; nk = 256; }
        const bf16* Kb = KB + (size_t)bh * KSEQ * 96; const bf16* Vb = VT + (size_t)bh * 64 * KSEQ;
        bf16x8 qf[6];
        { const bf16* qr = QB + ((size_t)bh * KSEQ + q0 + 32 * wave + ql) * 96 + 8 * h2;
#pragma unroll
          for (int ks = 0; ks < 6; ++ks) qf[ks] = *(const GAS bf16x8*)(qr + 16 * ks); }
        f32x16 O0, O1;
#pragma unroll
        for (int r = 0; r < 16; ++r) { O0[r] = 0.f; O1[r] = 0.f; }
        float m_run = -1e30f, l_run = 0.f;
        const int kc0 = tid, kc1 = tid + 512; const int vr = tid >> 3, vcn = tid & 7;
        v4u pk0, pk1 = (v4u){0u, 0u, 0u, 0u}, pv;
        { const GAS v4u* ks = (const GAS v4u*)Kb; pk0 = ks[kc0]; if (kc1 < 768) pk1 = ks[kc1]; pv = *(const GAS v4u*)(Vb + (size_t)vr * KSEQ + 8 * vcn); }
        __syncthreads();
        { LAS unsigned char* buf = F.lds; *(LAS v4u*)(buf + (kc0 / 12) * (AT_KLD * 2) + (kc0 % 12) * 16) = pk0; if (kc1 < 768) *(LAS v4u*)(buf + (kc1 / 12) * (AT_KLD * 2) + (kc1 % 12) * 16) = pk1;
          *(LAS v4u*)(buf + AT_KB + vr * (AT_VLD * 2) + vcn * 16) = pv; }
        __syncthreads();
        const int ntile = nk >> 6;
        for (int kt = 0; kt < ntile; ++kt) {
            const LAS unsigned char* buf = F.lds + (kt & 1) * AT_BUF; LAS unsigned char* nbuf = F.lds + ((kt + 1) & 1) * AT_BUF;
            const bool more = kt + 1 < ntile;
            if (more) { const GAS v4u* ks = (const GAS v4u*)(Kb + (size_t)(kt + 1) * 64 * 96); pk0 = ks[kc0]; if (kc1 < 768) pk1 = ks[kc1]; pv = *(const GAS v4u*)(Vb + (size_t)vr * KSEQ + (kt + 1) * 64 + 8 * vcn); }
            f32x16 S0, S1;
#pragma unroll
            for (int r = 0; r < 16; ++r) { S0[r] = 0.f; S1[r] = 0.f; }
#pragma unroll
            for (int ks = 0; ks < 6; ++ks) { const bf16x8 k0 = *(const LAS bf16x8*)(buf + ql * (AT_KLD * 2) + 32 * ks + 16 * h2), k1 = *(const LAS bf16x8*)(buf + (32 + ql) * (AT_KLD * 2) + 32 * ks + 16 * h2);
                S0 = __builtin_amdgcn_mfma_f32_32x32x16_bf16(k0, qf[ks], S0, 0, 0, 0); S1 = __builtin_amdgcn_mfma_f32_32x32x16_bf16(k1, qf[ks], S1, 0, 0, 0); }
            float mx = S0[0];
#pragma unroll
            for (int r = 1; r < 16; ++r) mx = fmaxf(mx, S0[r]);
#pragma unroll
            for (int r = 0; r < 16; ++r) mx = fmaxf(mx, S1[r]);
            mx = fmaxf(mx, __shfl_xor(mx, 32));
            const float m_new = fmaxf(m_run, mx), alpha = __builtin_amdgcn_exp2f(m_run - m_new); m_run = m_new;
            float ps = 0.f;
#pragma unroll
            for (int r = 0; r < 16; ++r) { S0[r] = __builtin_amdgcn_exp2f(S0[r] - m_new); S1[r] = __builtin_amdgcn_exp2f(S1[r] - m_new); ps += S0[r] + S1[r]; }
            l_run = l_run * alpha + ps;
#pragma unroll
            for (int r = 0; r < 16; ++r) { O0[r] *= alpha; O1[r] *= alpha; }
            union { bf16x8 v; unsigned u[4]; } p00, p01, p10, p11;
#pragma unroll
            for (int j = 0; j < 4; ++j) { p00.u[j] = pk2(S0[2 * j], S0[2 * j + 1]); p01.u[j] = pk2(S0[8 + 2 * j], S0[8 + 2 * j + 1]); p10.u[j] = pk2(S1[2 * j], S1[2 * j + 1]); p11.u[j] = pk2(S1[8 + 2 * j], S1[8 + 2 * j + 1]); }
            const LAS unsigned char* vb = buf + AT_KB;
#pragma unroll
            for (int dvt = 0; dvt < 2; ++dvt) { const LAS unsigned char* vrow = vb + (32 * dvt + ql) * (AT_VLD * 2) + 8 * h2;
#pragma unroll
                for (int sub = 0; sub < 2; ++sub)
#pragma unroll
                    for (int s = 0; s < 2; ++s) { union { bf16x8 v; v2u h[2]; } vf; vf.h[0] = *(const LAS v2u*)(vrow + 2 * (32 * sub + 16 * s)); vf.h[1] = *(const LAS v2u*)(vrow + 2 * (32 * sub + 16 * s + 8));
                        const bf16x8 pf = sub == 0 ? (s == 0 ? p00.v : p01.v) : (s == 0 ? p10.v : p11.v);
                        if (dvt == 0) O0 = __builtin_amdgcn_mfma_f32_32x32x16_bf16(vf.v, pf, O0, 0, 0, 0); else O1 = __builtin_amdgcn_mfma_f32_32x32x16_bf16(vf.v, pf, O1, 0, 0, 0); } }
            if (more) { *(LAS v4u*)(nbuf + (kc0 / 12) * (AT_KLD * 2) + (kc0 % 12) * 16) = pk0; if (kc1 < 768) *(LAS v4u*)(nbuf + (kc1 / 12) * (AT_KLD * 2) + (kc1 % 12) * 16) = pk1;
                *(LAS v4u*)(nbuf + AT_KB + vr * (AT_VLD * 2) + vcn * 16) = pv; }
            __syncthreads();
        }
        const float inv = 1.f / (l_run + __shfl_xor(l_run, 32));
        const int b = bh >> 2, head = bh & 3, qi = q0 + 32 * wave + ql;
        const size_t row = isctx ? (size_t)NL + b * 256 + qi : (size_t)b * 4096 + (qi - 256);
        bf16* orow = AO + row * 256 + head * 64 + 4 * h2;
#pragma unroll
        for (int g = 0; g < 4; ++g) { v2u o0, o1; o0.x = pk2(O0[4 * g] * inv, O0[4 * g + 1] * inv); o0.y = pk2(O0[4 * g + 2] * inv, O0[4 * g + 3] * inv); o1.x = pk2(O1[4 * g] * inv, O1[4 * g + 1] * inv); o1.y = pk2(O1[4 * g + 2] * inv, O1[4 * g + 3] * inv);
            *(GAS v2u*)(orow + 8 * g) = o0; *(GAS v2u*)(orow + 32 + 8 * g) = o1; }
    }
}

__device__ __forceinline__ void phase_fin_mla(Frame& F, int li) { WS_DECL; frame_refresh(F);
    const int nrows = li == DEPTH - 1 ? NL : NT; const float* g = in_ptr(I_MLAON) + li * 256; const bf16* AO = WSP(bf16, WS_AO); bf16* MIX = WSP(bf16, WS_A1);
    const int gw = blockIdx.x * NWAVES + F.wave, NGW = F.G * NWAVES; const f32x4 g4 = *(const GAS f32x4*)(g + 4 * F.lane);
    for (int m = gw; m < nrows; m += NGW) { const v2u w = *(const GAS v2u*)(AO + (size_t)m * 256 + 4 * F.lane);
        f32x4 x; x.x = bflo(w.x); x.y = bfhi(w.x); x.z = bflo(w.y); x.w = bfhi(w.y);
        const float r = rsqrtf(wave_sum(x.x * x.x + x.y * x.y + x.z * x.z + x.w * x.w) * (1.f / 256.f) + 1e-6f);
        v2u o; o.x = pk2(x.x * r * g4.x, x.y * r * g4.y); o.y = pk2(x.z * r * g4.z, x.w * r * g4.w); *(GAS v2u*)(MIX + (size_t)m * D + 4 * F.lane) = o; }
}
__device__ __forceinline__ void phase_fin_zero(Frame& F, int li, int c0) { WS_DECL; frame_refresh(F);
    const int nrows = li == DEPTH - 1 ? NL : NT; bf16* MIX = WSP(bf16, WS_A1); const int gw = blockIdx.x * NWAVES + F.wave, NGW = F.G * NWAVES;
    for (int m = gw; m < nrows; m += NGW) *(GAS v2u*)(MIX + (size_t)m * D + c0 + 4 * F.lane) = (v2u){0u, 0u};
}

__device__ __forceinline__ void phase_pro0b(Frame& F) { WS_DECL; frame_refresh(F);
    const int gt = blockIdx.x * NTHR + F.tid, NGT = F.G * NTHR;
    float* RC = WSP(float, WS_ROPE); float* RS = RC + 4096 * 16;
    for (int i = gt; i < 4096 * 16; i += NGT) { const int t = i >> 4, j = i & 15; const float inv = powf(10000.f, -(float)(j & 7) / 8.f); const float pos = j < 8 ? (float)(t >> 6) : (float)(t & 63);
        const float ang = pos * inv; RC[i] = cosf(ang); RS[i] = sinf(ang); }
    const float* wuq = in_ptr(I_WUQ); const float* wukv = in_ptr(I_WUKV); bf16* WQ = WSP(bf16, WS_WUQT); bf16* WKV = WSP(bf16, WS_WUKVT);
    for (int i = gt; i < DEPTH * 384 * 192; i += NGT) { const int li = i / (384 * 192), r = i % (384 * 192), n = r / 192, k = r % 192; WQ[i] = (bf16)f2bf(wuq[(size_t)li * 192 * 384 + (size_t)k * 384 + n]); }
    for (int i = gt; i < DEPTH * 512 * 128; i += NGT) { const int li = i / (512 * 128), r = i % (512 * 128), n = r / 128, k = r % 128; WKV[i] = (bf16)f2bf(wukv[(size_t)li * 128 * 512 + (size_t)k * 512 + n]); }
}

constexpr int LR_LD = 264;
__device__ __forceinline__ float gelu_tanh(float x) { const float u = 0.7978845608028654f * (x + 0.044715f * x * x * x); const float e = __expf(2.f * u); const float t = 1.f - 2.f / (e + 1.f); return 0.5f * x * (1.f + t); }
template <int PASS>
__device__ __forceinline__ void phase_lru(Frame& F, int li) { WS_DECL; frame_refresh(F);
    LAS bf16* RAW = (LAS bf16*)F.lds; LAS bf16* U = (LAS bf16*)(F.lds + 67 * LR_LD * 2); LAS bf16* HS = (LAS bf16*)(F.lds + 71680);
    const bf16* P = WSP(bf16, WS_P); bf16* MIX = WSP(bf16, WS_A1); f32x2* SUMM = WSP(f32x2, WS_SUMM);
    const float* cw = in_ptr(I_LCW) + li * 4 * 256; const float* cb = in_ptr(I_LCB) + li * 256;
    const float* lam_ = in_ptr(I_LLAM) + li * 512; const float* br_ = in_ptr(I_LBR) + li * 512; const float* bi_ = in_ptr(I_LBI) + li * 512; const float* on_ = in_ptr(I_LON) + li * 256;
    const bf16* LW = WSP(bf16, WS_LRUW) + (size_t)li * 16 * 4096;
    const int lane = F.lane, wave = F.wave, tid = F.tid, fr = lane & 15, kg = lane >> 4;
    const int nitems = (PASS == 3 && li == DEPTH - 1) ? NL / 64 : NT / 64;
    for (int item = blockIdx.x; item < nitems; item += F.G) {
        const int m0 = item * 64; const bool isctx = m0 >= NL; const int b = isctx ? (m0 - NL) >> 8 : m0 >> 12; const int t0 = isctx ? (m0 - NL) & 255 : m0 & 4095; const int Ls = isctx ? 256 : 4096;
        const size_t seg0 = isctx ? (size_t)NL + b * 256 : (size_t)b * 4096;
        for (int c = tid; c < 67 * 32; c += NTHR) { const int r = c >> 5, cc = c & 31, t = t0 - 2 + r; v4u v = (v4u){0u, 0u, 0u, 0u};
            if (t >= 0 && t < Ls) v = *(const GAS v4u*)(P + (seg0 + t) * PCOLS + 352 + 8 * cc);
            *(LAS v4u*)(RAW + r * LR_LD + 8 * cc) = v; }
        __syncthreads();
        { const int c2 = tid & 127, tq = tid >> 7; const int ch = 2 * c2;
          float w0[4], w1[4];
#pragma unroll
          for (int j = 0; j < 4; ++j) { w0[j] = cw[j * 256 + ch]; w1[j] = cw[j * 256 + ch + 1]; }
          const float b0 = cb[ch], b1 = cb[ch + 1];
          for (int t = tq * 16; t < tq * 16 + 16; ++t) { float s0 = b0, s1 = b1;
#pragma unroll
              for (int j = 0; j < 4; ++j) { const unsigned w = *(const LAS unsigned*)(RAW + (t + j) * LR_LD + ch); s0 += w0[j] * bflo(w); s1 += w1[j] * bfhi(w); }
              *(LAS unsigned*)(U + t * LR_LD + ch) = pk2(s0, s1); } }
        __syncthreads();
#pragma unroll 1
        for (int ni = 0; ni < 2; ++ni) {
            float yv[4][4];
            const int nt = 2 * wave + ni, nb = nt >> 2, ch = 16 * nt + fr;
            float uu[4][4];
#pragma unroll
            for (int m = 0; m < 4; ++m)
#pragma unroll
                for (int r = 0; r < 4; ++r) uu[m][r] = bf2f(U[(16 * m + 4 * kg + r) * LR_LD + ch]);
#pragma unroll
            for (int d = 0; d < 2; ++d) {
                f32x4 ar[4], ai[4];
#pragma unroll
                for (int m = 0; m < 4; ++m) { ar[m] = (f32x4){0.f, 0.f, 0.f, 0.f}; ai[m] = (f32x4){0.f, 0.f, 0.f, 0.f}; }
#pragma unroll
                for (int ks = 0; ks < 2; ++ks) {
                    const bf16x8 wr = *(const GAS bf16x8*)(LW + ((size_t)((0 * 2 + d) * 4 + nb) * 64 + 16 * (nt & 3) + fr) * 64 + 32 * ks + 8 * kg);
                    const bf16x8 wi = *(const GAS bf16x8*)(LW + ((size_t)((1 * 2 + d) * 4 + nb) * 64 + 16 * (nt & 3) + fr) * 64 + 32 * ks + 8 * kg);
#pragma unroll
                    for (int m = 0; m < 4; ++m) { const bf16x8 xf = *(const LAS bf16x8*)(U + (16 * m + fr) * LR_LD + 64 * nb + 32 * ks + 8 * kg);
                        ar[m] = __builtin_amdgcn_mfma_f32_16x16x32_bf16(xf, wr, ar[m], 0, 0, 0); ai[m] = __builtin_amdgcn_mfma_f32_16x16x32_bf16(xf, wi, ai[m], 0, 0, 0); } }
                const float sp = log1pf(expf(-lam_[d * 256 + ch])), brv = br_[d * 256 + ch], biv = bi_[d * 256 + ch];
#pragma unroll
                for (int m = 0; m < 4; ++m)
#pragma unroll
                    for (int r = 0; r < 4; ++r) { const float rg = sigmoidf_(ar[m][r] + brv), ig = sigmoidf_(ai[m][r] + biv); const float la = -8.f * rg * sp;
                        ar[m][r] = __expf(la); ai[m][r] = sqrtf(fmaxf(-expm1f(2.f * la), 0.f)) * (ig * uu[m][r]); }
                float H = 0.f;
                if (PASS == 3) {
                    const int cj = t0 >> 6, cbase = 1024 + b * 4, lbase = b * 64;
                    const int np = d == 0 ? (isctx ? cj : 4 + cj) : (isctx ? 3 - cj : 4 + 63 - cj);
                    const int q = (np + 3) >> 2, p_lo = kg * q, p_hi = (p_lo + q < np) ? p_lo + q : np;
                    float Aq = 1.f, Bq = 0.f;
                    for (int p0 = p_lo; p0 < p_hi; p0 += 8) { f32x2 sv[8];
#pragma unroll
                        for (int e = 0; e < 8; ++e) { const int p = p0 + e; sv[e] = (f32x2){1.f, 0.f};
                            if (p < p_hi) { int cid; if (d == 0) cid = isctx ? cbase + p : (p < 4 ? cbase + p : lbase + (p - 4)); else cid = isctx ? cbase + 3 - p : (p < 4 ? cbase + 3 - p : lbase + 63 - (p - 4));
                                sv[e] = *(const GAS f32x2*)(SUMM + ((size_t)cid * 2 + d) * 256 + ch); } }
#pragma unroll
                        for (int e = 0; e < 8; ++e) { Bq = sv[e].x * Bq + sv[e].y; Aq = sv[e].x * Aq; } }
#pragma unroll
                    for (int g = 0; g < 4; ++g) { const float Ag_ = __shfl(Aq, fr + 16 * g), Bg_ = __shfl(Bq, fr + 16 * g); H = Ag_ * H + Bg_; }
                }
                float Ac = 1.f, Bc = 0.f;
#pragma unroll
                for (int mi = 0; mi < 4; ++mi) { const int m = d == 0 ? mi : 3 - mi;
                    float Al, Bl;
                    if (d == 0) { Al = ar[m][0] * ar[m][1] * ar[m][2] * ar[m][3]; Bl = ((ai[m][0] * ar[m][1] + ai[m][1]) * ar[m][2] + ai[m][2]) * ar[m][3] + ai[m][3]; }
                    else { Al = ar[m][0] * ar[m][1] * ar[m][2] * ar[m][3]; Bl = ((ai[m][3] * ar[m][2] + ai[m][2]) * ar[m][1] + ai[m][1]) * ar[m][0] + ai[m][0]; }
                    float Ag[4], Bg[4];
#pragma unroll
                    for (int g = 0; g < 4; ++g) { Ag[g] = __shfl(Al, fr + 16 * g); Bg[g] = __shfl(Bl, fr + 16 * g); }
                    if (PASS == 1) {
                        float At = 1.f, Bt = 0.f;
#pragma unroll
                        for (int gi = 0; gi < 4; ++gi) { const int g = d == 0 ? gi : 3 - gi; Bt = Ag[g] * Bt + Bg[g]; At = Ag[g] * At; }
                        Bc = At * Bc + Bt; Ac = At * Ac;
                    } else {
                        float s = H, sin_ = H;
#pragma unroll
                        for (int gi = 0; gi < 4; ++gi) { const int g = d == 0 ? gi : 3 - gi; if (g == kg) sin_ = s; s = Ag[g] * s + Bg[g]; }
                        H = s;
                        float x = sin_;
#pragma unroll
                        for (int ri = 0; ri < 4; ++ri) { const int r = d == 0 ? ri : 3 - ri; x = ar[m][r] * x + ai[m][r]; if (d == 0) yv[m][r] = x; else yv[m][r] += x; }
                    }
                }
                if (PASS == 1 && kg == 0) *(GAS f32x2*)(SUMM + ((size_t)item * 2 + d) * 256 + ch) = (f32x2){Ac, Bc};
            }
            if (PASS == 3) {
#pragma unroll
                for (int m = 0; m < 4; ++m)
#pragma unroll
                    for (int r = 0; r < 4; ++r) HS[(16 * m + 4 * kg + r) * LR_LD + ch] = (bf16)f2bf(yv[m][r]);
            }
        }
        if (PASS == 3) {
            __syncthreads();
            const f32x4 on4 = *(const GAS f32x4*)(on_ + 4 * lane);
            for (int i = 0; i < 8; ++i) { const int tl = wave * 8 + i; const v2u hw = *(const LAS v2u*)(HS + tl * LR_LD + 4 * lane); const v2u gw = *(const GAS v2u*)(P + (size_t)(m0 + tl) * PCOLS + 608 + 4 * lane);
                f32x4 y; y.x = bflo(hw.x) * gelu_tanh(bflo(gw.x)); y.y = bfhi(hw.x) * gelu_tanh(bfhi(gw.x)); y.z = bflo(hw.y) * gelu_tanh(bflo(gw.y)); y.w = bfhi(hw.y) * gelu_tanh(bfhi(gw.y));
                const float rs = rsqrtf(wave_sum(y.x * y.x + y.y * y.y + y.z * y.z + y.w * y.w) * (1.f / 256.f) + 1e-6f);
                v2u o; o.x = pk2(y.x * rs * on4.x, y.y * rs * on4.y); o.y = pk2(y.z * rs * on4.z, y.w * rs * on4.w);
                *(GAS v2u*)(MIX + (size_t)(m0 + tl) * D + 256 + 4 * lane) = o; }
        }
        __syncthreads();
    }
}

__device__ __forceinline__ void phase_pro0c(Frame& F) { WS_DECL; frame_refresh(F);
    const int gt = blockIdx.x * NTHR + F.tid, NGT = F.G * NTHR; const float* wr = in_ptr(I_LWR); const float* wi = in_ptr(I_LWI); bf16* LW = WSP(bf16, WS_LRUW);
    for (int i = gt; i < DEPTH * 16 * 4096; i += NGT) { const int c = i & 63, dd = (i >> 6) & 63, nb = (i >> 12) & 3, d = (i >> 14) & 1, g = (i >> 15) & 1, li = i >> 16;
        const float* src = g == 0 ? wr : wi; LW[i] = (bf16)f2bf(src[((((size_t)li * 2 + d) * 4 + nb) * 64 + c) * 64 + dd]); }
}

template <int CTRL> __device__ __forceinline__ float dpp_f(float x) { return __builtin_bit_cast(float, __builtin_amdgcn_mov_dpp(__builtin_bit_cast(int, x), CTRL, 0xf, 0xf, true)); }
__device__ __forceinline__ float rowsum16(float x) { x += dpp_f<0x128>(x); x += dpp_f<0x124>(x); x += dpp_f<0x122>(x); x += dpp_f<0x121>(x); return x; }
constexpr int RW_C0 = 864;
constexpr size_t WS_RWUP = WS_LRUW + 512 * 1024;
constexpr size_t WS_EA = WS_Y;

__device__ __forceinline__ void phase_pro0e(Frame& F) { WS_DECL; frame_refresh(F);
    const int gt = blockIdx.x * NTHR + F.tid, NGT = F.G * NTHR; const float* wup = in_ptr(I_WUP); const float* aup = in_ptr(I_AUP); bf16* W = WSP(bf16, WS_RWUP);
    for (int i = gt; i < DEPTH * 2 * 2 * 256 * 32; i += NGT) { const int k = i & 31, n = (i >> 5) & 255, wa = (i >> 13) & 1, d = (i >> 14) & 1, li = i >> 15;
        const float* src = wa == 0 ? wup : aup; W[i] = (bf16)f2bf(src[(((size_t)li * 2 + d) * 32 + k) * 256 + n]); }
}

constexpr int R0_LD = 136, R0_ZLD = 72;
__device__ __forceinline__ void phase_rwkv_r0(Frame& F, int li) { WS_DECL; frame_refresh(F);
    LAS bf16* RAWL = (LAS bf16*)F.lds;
    LAS bf16* ZW = (LAS bf16*)(F.lds + 66 * R0_LD * 2);
    LAS bf16* ZA = ZW + 64 * R0_ZLD;
    const bf16* P = WSP(bf16, WS_P); bf16* EA = WSP(bf16, WS_EA); const bf16* W = WSP(bf16, WS_RWUP) + (size_t)li * 2 * 2 * 256 * 32;
    const float* mup = in_ptr(I_MUP) + li * 960 + 768; const float* mun = in_ptr(I_MUN) + li * 960 + 768; const float* w0 = in_ptr(I_W0) + li * 512; const float* a0 = in_ptr(I_A0) + li * 512;
    const int tid = F.tid, lane = F.lane, wave = F.wave, fr = lane & 15, kg = lane >> 4;
    for (int item = blockIdx.x; item < NT / 64; item += F.G) {
        const int m0 = item * 64; const bool isctx = m0 >= NL; const int t0 = isctx ? (m0 - NL) & 255 : m0 & 4095; const int Ls = isctx ? 256 : 4096; const size_t seg0 = (size_t)m0 - t0;
        __syncthreads();
        for (int c = tid; c < 66 * 16; c += NTHR) { const int r = c >> 4, cc = c & 15, t = t0 - 1 + r; v4u v = (v4u){0u, 0u, 0u, 0u};
            if (t >= 0 && t < Ls) v = *(const GAS v4u*)(P + (seg0 + t) * PCOLS + RW_C0 + 768 + 8 * cc);
            *(LAS v4u*)(RAWL + r * R0_LD + 8 * cc) = v; }
        __syncthreads();
        { const int c = tid & 127, tq = tid >> 7; const float mp = mup[c], mn = mun[c];
          for (int tl = tq * 16; tl < tq * 16 + 16; ++tl) { const float x = bf2f(RAWL[(tl + 1) * R0_LD + c]), xp = bf2f(RAWL[tl * R0_LD + c]), xn = bf2f(RAWL[(tl + 2) * R0_LD + c]);
              const float z = x + mp * (xp - x) + mn * (xn - x);
              if (c < 64) { const float e2 = __expf(2.f * z); ZW[tl * R0_ZLD + c] = (bf16)f2bf(1.f - 2.f * __builtin_amdgcn_rcpf(e2 + 1.f)); } else ZA[tl * R0_ZLD + (c - 64)] = (bf16)f2bf(z); } }
        __syncthreads();
        const int d = wave >> 2, hh = wave & 3;
#pragma unroll 1
        for (int nt = 0; nt < 4; ++nt) { const int ch0 = 64 * hh + 16 * nt;
            const bf16x8 wf = *(const GAS bf16x8*)(W + ((size_t)(d * 2 + 0) * 256 + ch0 + fr) * 32 + 8 * kg), af = *(const GAS bf16x8*)(W + ((size_t)(d * 2 + 1) * 256 + ch0 + fr) * 32 + 8 * kg);
            const f32x4 w04 = *(const GAS f32x4*)(w0 + d * 256 + ch0 + 4 * kg), a04 = *(const GAS f32x4*)(a0 + d * 256 + ch0 + 4 * kg);
#pragma unroll
            for (int m = 0; m < 4; ++m) { const bf16x8 zw = *(const LAS bf16x8*)(ZW + (16 * m + fr) * R0_ZLD + 32 * d + 8 * kg), za = *(const LAS bf16x8*)(ZA + (16 * m + fr) * R0_ZLD + 32 * d + 8 * kg);
                f32x4 xw = __builtin_amdgcn_mfma_f32_16x16x32_bf16(wf, zw, (f32x4){0.f, 0.f, 0.f, 0.f}, 0, 0, 0), xa = __builtin_amdgcn_mfma_f32_16x16x32_bf16(af, za, (f32x4){0.f, 0.f, 0.f, 0.f}, 0, 0, 0);
                xw = xw + w04; xa = xa + a04; float e[4], av[4];
#pragma unroll
                for (int r = 0; r < 4; ++r) { const float sg = __builtin_amdgcn_rcpf(1.f + __expf(-xw[r])); e[r] = -expm1f(-0.6065306597126334f * sg); av[r] = __builtin_amdgcn_rcpf(1.f + __expf(-xa[r])); }
                const size_t tok = (size_t)m0 + 16 * m + fr; v2u oe, oa; oe.x = pk2(e[0], e[1]); oe.y = pk2(e[2], e[3]); oa.x = pk2(av[0], av[1]); oa.y = pk2(av[2], av[3]);
                *(GAS v2u*)(EA + (tok * 4 + d) * 256 + ch0 + 4 * kg) = oe; *(GAS v2u*)(EA + (tok * 4 + 2 + d) * 256 + ch0 + 4 * kg) = oa; } }
    }
    __syncthreads();
}

constexpr int RW_T = 16, RW_NCH = (LCX + SEQ) / RW_T, RW_ROWS = RW_T + 2, RW_LD = 200;
constexpr int RW_RAW = 0, RW_RAWB = RW_ROWS * RW_LD * 2;
constexpr int RW_EAB = 14848, RW_EABB = RW_T * 128 * 2;
constexpr int RW_VEC = 24576, RW_VECB = RW_T * 384 * 4;
constexpr int RW_YO = RW_VEC + 2 * RW_VECB, RW_YOB = RW_T * 32 * 4;
constexpr int RW_BON = RW_YO + 2 * RW_YOB;
static_assert(2 * RW_RAWB <= RW_EAB && RW_EAB + 2 * RW_EABB <= RW_VEC, "rwkv lds map");
__device__ __forceinline__ void phase_rwkv_scan(Frame& F, int li) { WS_DECL; frame_refresh(F);
    const bf16* P = WSP(bf16, WS_P); const bf16* EA = WSP(bf16, WS_EA); float* YR = WSP(float, WS_YR); float* BON = WSP(float, WS_BON);
    const int tid = F.tid, lane = F.lane, wave = F.wave;
    for (int item = blockIdx.x; item < 256; item += F.G) {
        const int vhalf = item & 1, d = (item >> 1) & 1, h = (item >> 2) & 3, b = item >> 4;
        __syncthreads();
        const int rp = lane >> 4, kq = lane & 15, vl = 8 * wave + 2 * rp;
        const int pt = tid - 256, ps = (pt >> 4) & 15, pq = tid & 15;
        f32x4 mpr, mpk, mpv, mnr, mnk, mnv, kk_c, ka_c, rk_c;
        { const float* mup = in_ptr(I_MUP) + li * 960; const float* mun = in_ptr(I_MUN) + li * 960; const int c = 64 * h + 4 * pq;
          mpr = *(const GAS f32x4*)(mup + c); mpk = *(const GAS f32x4*)(mup + 256 + c); mpv = *(const GAS f32x4*)(mup + 512 + c);
          mnr = *(const GAS f32x4*)(mun + c); mnk = *(const GAS f32x4*)(mun + 256 + c); mnv = *(const GAS f32x4*)(mun + 512 + c);
          kk_c = *(const GAS f32x4*)(in_ptr(I_KK) + li * 256 + c); ka_c = *(const GAS f32x4*)(in_ptr(I_KA) + li * 256 + c); rk_c = *(const GAS f32x4*)(in_ptr(I_RK) + li * 256 + c); }
        f32x2 A01 = (f32x2){0.f, 0.f}, A23 = (f32x2){0.f, 0.f}, B01 = (f32x2){0.f, 0.f}, B23 = (f32x2){0.f, 0.f};
#pragma unroll 1
        for (int it = -2; it <= RW_NCH; ++it) {
            const int ca = it + 2; const bool doA = wave >= 4 && ca < RW_NCH; v4u ra[3]; int ra_c[3];
            if (doA) { const bool isctx = ca < LCX / RW_T; const int cl = isctx ? ca : ca - LCX / RW_T; const int Ls = isctx ? LCX : SEQ; const int tlo = d == 0 ? cl * RW_T : Ls - RW_T - cl * RW_T;
                const size_t seg0 = isctx ? (size_t)NL + b * LCX : (size_t)b * SEQ;
#pragma unroll
                for (int q = 0; q < 3; ++q) { const int c = pt + 256 * q; ra[q] = (v4u){0u, 0u, 0u, 0u}; ra_c[q] = c;
                    if (c < RW_ROWS * 24) { const int r = c / 24, cc = c % 24, t = tlo - 1 + r; const int col = 256 * (cc >> 3) + 64 * h + 8 * (cc & 7);
                        if (t >= 0 && t < Ls) ra[q] = *(const GAS v4u*)(P + (seg0 + t) * PCOLS + RW_C0 + col); }
                    else if (c < RW_ROWS * 24 + RW_T * 16) { const int e = c - RW_ROWS * 24, s = e >> 4, cc = e & 15; const int t = d == 0 ? tlo + s : tlo + RW_T - 1 - s;
                        ra[q] = *(const GAS v4u*)(EA + ((seg0 + t) * 4 + (cc >> 3) * 2 + d) * 256 + 64 * h + 8 * (cc & 7)); } } }
            if (wave < 4 && it >= 0 && it < RW_NCH) {
                const LAS float* VEC = (const LAS float*)(F.lds + RW_VEC + (it & 1) * RW_VECB); LAS float* YO = (LAS float*)(F.lds + RW_YO + (it & 1) * RW_YOB);
#pragma unroll 1
                for (int g = 0; g < RW_T / 4; ++g) { f32x4 kk4[4], dec4[4], kka4[4], kd4[4], r4[4]; f32x2 vv[4], yo[4];
#pragma unroll
                    for (int j = 0; j < 4; ++j) { const LAS float* vs = VEC + (4 * g + j) * 384 + 4 * kq;
                        kk4[j] = *(const LAS f32x4*)(vs); dec4[j] = *(const LAS f32x4*)(vs + 64); kka4[j] = *(const LAS f32x4*)(vs + 128); kd4[j] = *(const LAS f32x4*)(vs + 192); r4[j] = *(const LAS f32x4*)(vs + 256);
                        vv[j] = *(const LAS f32x2*)(VEC + (4 * g + j) * 384 + 320 + 32 * vhalf + vl); }
#pragma unroll
                    for (int j = 0; j < 4; ++j) {
                        const f32x2 kk01 = (f32x2){kk4[j].x, kk4[j].y}, kk23 = (f32x2){kk4[j].z, kk4[j].w}, de01 = (f32x2){dec4[j].x, dec4[j].y}, de23 = (f32x2){dec4[j].z, dec4[j].w};
                        const f32x2 ka01 = (f32x2){kka4[j].x, kka4[j].y}, ka23 = (f32x2){kka4[j].z, kka4[j].w}, kd01 = (f32x2){kd4[j].x, kd4[j].y}, kd23 = (f32x2){kd4[j].z, kd4[j].w}, r01 = (f32x2){r4[j].x, r4[j].y}, r23 = (f32x2){r4[j].z, r4[j].w};
                        const f32x2 pa = A01 * kk01 + A23 * kk23, pb = B01 * kk01 + B23 * kk23;
                        const float sa = rowsum16(pa.x + pa.y), sb = rowsum16(pb.x + pb.y);
                        A01 = A01 * de01 + (kd01 * vv[j].x - ka01 * sa); A23 = A23 * de23 + (kd23 * vv[j].x - ka23 * sa);
                        B01 = B01 * de01 + (kd01 * vv[j].y - ka01 * sb); B23 = B23 * de23 + (kd23 * vv[j].y - ka23 * sb);
                        const f32x2 ya = A01 * r01 + A23 * r23, yb = B01 * r01 + B23 * r23;
                        yo[j] = (f32x2){rowsum16(ya.x + ya.y), rowsum16(yb.x + yb.y)}; }
                    if (kq == 0) {
#pragma unroll
                        for (int j = 0; j < 4; ++j) *(LAS f32x2*)(YO + (4 * g + j) * 32 + vl) = yo[j]; } }
            }
            const int cb = it + 1;
            if (wave >= 4 && cb >= 0 && cb < RW_NCH) {
                const LAS bf16* RAW = (const LAS bf16*)(F.lds + RW_RAW + (cb & 1) * RW_RAWB); const LAS bf16* EAB = (const LAS bf16*)(F.lds + RW_EAB + (cb & 1) * RW_EABB);
                LAS float* VEC = (LAS float*)(F.lds + RW_VEC + (cb & 1) * RW_VECB); LAS float* BONS = (LAS float*)(F.lds + RW_BON) + (cb & 3) * RW_T;
                const int prow = d == 0 ? ps + 1 : RW_T - ps;
                f32x4 zr, zk, zv;
                { const LAS bf16* r0 = RAW + prow * RW_LD + 4 * pq;
#define RW_LD4(p) ({ const v2u w_ = *(const LAS v2u*)(p); (f32x4){bflo(w_.x), bfhi(w_.x), bflo(w_.y), bfhi(w_.y)}; })
                  { const f32x4 x = RW_LD4(r0), xp = RW_LD4(r0 - RW_LD), xn = RW_LD4(r0 + RW_LD); zr = x + mpr * (xp - x) + mnr * (xn - x); }
                  { const f32x4 x = RW_LD4(r0 + 64), xp = RW_LD4(r0 + 64 - RW_LD), xn = RW_LD4(r0 + 64 + RW_LD); zk = x + mpk * (xp - x) + mnk * (xn - x); }
                  { const f32x4 x = RW_LD4(r0 + 128), xp = RW_LD4(r0 + 128 - RW_LD), xn = RW_LD4(r0 + 128 + RW_LD); zv = x + mpv * (xp - x) + mnv * (xn - x); } }
                const f32x4 e4 = RW_LD4(EAB + ps * 128 + 4 * pq), a4 = RW_LD4(EAB + ps * 128 + 64 + 4 * pq);
                const f32x4 kkr = zk * kk_c; const float ss = rowsum16((kkr.x * kkr.x + kkr.y * kkr.y) + (kkr.z * kkr.z + kkr.w * kkr.w));
                const f32x4 kd = zk * ((a4 - 1.f) * ka_c + 1.f); const f32x4 bq = zr * kd * rk_c; const float bn = rowsum16((bq.x + bq.y) + (bq.z + bq.w));
                const f32x4 kkn = kkr * rsqrtf(fmaxf(ss, 1e-24f));
                LAS float* vs = VEC + ps * 384 + 4 * pq;
                *(LAS f32x4*)(vs) = kkn; *(LAS f32x4*)(vs + 64) = 1.f - e4; *(LAS f32x4*)(vs + 128) = kkn * a4; *(LAS f32x4*)(vs + 192) = kd; *(LAS f32x4*)(vs + 256) = zr; *(LAS f32x4*)(vs + 320) = zv;
                if (pq == 0) BONS[ps] = bn;
            }
            if (wave >= 4) {
                const int ce = it - 1;
                if (ce >= 0 && ce < RW_NCH) { const bool isctx = ce < LCX / RW_T;
                    if (!isctx || li < DEPTH - 1) { const int cl = isctx ? ce : ce - LCX / RW_T; const int Ls = isctx ? LCX : SEQ; const int tlo = d == 0 ? cl * RW_T : Ls - RW_T - cl * RW_T; const size_t seg0 = isctx ? (size_t)NL + b * LCX : (size_t)b * SEQ;
                        const LAS float* YO = (const LAS float*)(F.lds + RW_YO + (ce & 1) * RW_YOB); const LAS float* BONS = (const LAS float*)(F.lds + RW_BON) + (ce & 3) * RW_T;
                        const int s = pt >> 4, pr = pt & 15; const int t = d == 0 ? tlo + s : tlo + RW_T - 1 - s; const size_t row = seg0 + t;
                        *(GAS f32x2*)(YR + ((size_t)d * NT + row) * 256 + 64 * h + 32 * vhalf + 2 * pr) = *(const LAS f32x2*)(YO + s * 32 + 2 * pr);
                        if (vhalf == 0 && pr == 0) BON[((size_t)d * NT + row) * 4 + h] = BONS[s]; } }
                if (doA) { LAS bf16* RAWW = (LAS bf16*)(F.lds + RW_RAW + (ca & 1) * RW_RAWB); LAS bf16* EAW = (LAS bf16*)(F.lds + RW_EAB + (ca & 1) * RW_EABB);
#pragma unroll
                    for (int q = 0; q < 3; ++q) { const int c = ra_c[q];
                        if (c < RW_ROWS * 24) *(LAS v4u*)(RAWW + (c / 24) * RW_LD + 8 * (c % 24)) = ra[q];
                        else if (c < RW_ROWS * 24 + RW_T * 16) { const int e = c - RW_ROWS * 24; *(LAS v4u*)(EAW + 8 * e) = ra[q]; } } }
            }
            __syncthreads();
        }
    }
}

__device__ __forceinline__ void phase_fin_rwkv(Frame& F, int li) { WS_DECL; frame_refresh(F);
    const int nrows = li == DEPTH - 1 ? NL : NT; const int lane = F.lane, wave = F.wave, tid = F.tid;
    LAS float* GUP = (LAS float*)F.lds;
    LAS float* SG = (LAS float*)(F.lds + 65536) + wave * 64;
    const bf16* P = WSP(bf16, WS_P); const float* YR = WSP(float, WS_YR); const float* BON = WSP(float, WS_BON); bf16* MIX = WSP(bf16, WS_A1);
    { const float* gup = in_ptr(I_GUP) + (size_t)li * 64 * 256; for (int i = tid; i < 64 * 256; i += NTHR) GUP[i] = gup[i]; }
    const float* mup = in_ptr(I_MUP) + li * 960; const float* mun = in_ptr(I_MUN) + li * 960;
    const f32x4 mpv = *(const GAS f32x4*)(mup + 512 + 4 * lane), mnv = *(const GAS f32x4*)(mun + 512 + 4 * lane);
    const float mpg = mup[896 + lane], mng = mun[896 + lane];
    const f32x4 lg = *(const GAS f32x4*)(in_ptr(I_LNG) + li * 256 + 4 * lane), lb = *(const GAS f32x4*)(in_ptr(I_LNB) + li * 256 + 4 * lane);
    __syncthreads();
    const int gw = blockIdx.x * NWAVES + wave, NGW = F.G * NWAVES;
    for (int m = gw; m < nrows; m += NGW) {
        const bool isctx = m >= NL; const int t = isctx ? (m - NL) & 255 : m & 4095; const int Ls = isctx ? 256 : 4096;
        const bf16* pr = P + (size_t)m * PCOLS + RW_C0;
        const bool hp = t > 0, hn = t + 1 < Ls;
        f32x4 v;
        { const v2u w = *(const GAS v2u*)(pr + 512 + 4 * lane); v2u wp = (v2u){0u, 0u}, wn = (v2u){0u, 0u};
          if (hp) wp = *(const GAS v2u*)(pr - PCOLS + 512 + 4 * lane); if (hn) wn = *(const GAS v2u*)(pr + PCOLS + 512 + 4 * lane);
          const f32x4 x = (f32x4){bflo(w.x), bfhi(w.x), bflo(w.y), bfhi(w.y)}, xp = (f32x4){bflo(wp.x), bfhi(wp.x), bflo(wp.y), bfhi(wp.y)}, xn = (f32x4){bflo(wn.x), bfhi(wn.x), bflo(wn.y), bfhi(wn.y)};
          v = x + mpv * (xp - x) + mnv * (xn - x); }
        { const float x = bf2f(pr[896 + lane]); const float xp = hp ? bf2f(pr[896 + lane - PCOLS]) : 0.f, xn = hn ? bf2f(pr[896 + lane + PCOLS]) : 0.f;
          SG[lane] = sigmoidf_(x + mpg * (xp - x) + mng * (xn - x)); }
        LDS_WAIT();
        f32x4 g = (f32x4){0.f, 0.f, 0.f, 0.f};
#pragma unroll 8
        for (int j = 0; j < 64; ++j) { const float sj = SG[j]; const f32x4 gu = *(const LAS f32x4*)(GUP + j * 256 + 4 * lane); g = g + gu * sj; }
        const f32x4 y = *(const GAS f32x4*)(YR + (size_t)m * 256 + 4 * lane) + *(const GAS f32x4*)(YR + ((size_t)NT + m) * 256 + 4 * lane);
        const float mean = rowsum16((y.x + y.y) + (y.z + y.w)) * (1.f / 64.f);
        const f32x4 yc = y - mean; const float var = rowsum16((yc.x * yc.x + yc.y * yc.y) + (yc.z * yc.z + yc.w * yc.w)) * (1.f / 64.f);
        const f32x4 yn = yc * rsqrtf(var + 64e-5f) * lg + lb;
        const int hh = lane >> 4; const float bon = BON[(size_t)m * 4 + hh] + BON[((size_t)NT + m) * 4 + hh];
        const f32x4 o = (yn + v * bon) * g;
        v2u ow; ow.x = pk2(o.x, o.y); ow.y = pk2(o.z, o.w); *(GAS v2u*)(MIX + (size_t)m * D + 512 + 4 * lane) = ow;
        LDS_WAIT();
    }
    __syncthreads();
}

constexpr float HY_DMIN = -3.0701134573253945f, HY_DMAX = -15.350567286626973f;
constexpr int HY_X = 0, HY_TW = 65536, HY_W3 = 98304;
__device__ __forceinline__ float hy_delta(int ch) { return -(HY_DMIN + (float)ch * ((HY_DMAX - HY_DMIN) / 255.f)); }

__device__ __forceinline__ void phase_pro0d(Frame& F) { WS_DECL; frame_refresh(F);
    const int lane = F.lane; const int gw = blockIdx.x * NWAVES + F.wave, NGW = F.G * NWAVES;
    const float* w1 = in_ptr(I_HW1); const float* b1 = in_ptr(I_HB1); const float* w2 = in_ptr(I_HW2); const float* b2 = in_ptr(I_HB2);
    for (int it = gw; it < DEPTH * (SEQ + LCX); it += NGW) {
        const int li = it / (SEQ + LCX), r = it % (SEQ + LCX); const bool isctx = r >= SEQ; const int l = isctx ? r - SEQ : r; const int L = isctx ? LCX : SEQ;
        float z = 0.f;
        if (lane == 0) z = (float)l / (float)(L - 1);
        else if (lane < 33) { const int i = (lane - 1) & 15; const float band = 1e-4f + (float)i * ((15.f - 1e-4f) / 15.f); const float ang = band * (6.283185307179586f / (float)L) * (float)l; z = lane < 17 ? cosf(ang) : -sinf(ang); }
        float h1 = b1[li * 64 + lane];
        for (int i = 0; i < 33; ++i) h1 += __shfl(z, i) * w1[(li * 33 + i) * 64 + lane];
        h1 = sinf(h1);
        float h2 = b2[li * 64 + lane];
        for (int i = 0; i < 64; ++i) h2 += __shfl(h1, i) * w2[(li * 64 + i) * 64 + lane];
        h2 = sinf(h2);
        float* dst = isctx ? WSP(float, WS_H2C) + ((size_t)li * LCX + l) * 64 : WSP(float, WS_H2L) + ((size_t)li * SEQ + l) * 64;
        dst[lane] = h2;
    }
}

typedef f32x2 cpx;
__device__ __forceinline__ cpx cmul(cpx a, cpx b) { return (cpx){a.x * b.x - a.y * b.y, a.x * b.y + a.y * b.x}; }
__device__ __forceinline__ cpx cmulc(cpx a, cpx b) { return (cpx){a.x * b.x + a.y * b.y, a.y * b.x - a.x * b.y}; }
__device__ __forceinline__ cpx cmi(cpx z) { return (cpx){z.y, -z.x}; }
__device__ __forceinline__ int hy_p(int n) { return n ^ ((n >> 5) & 7) ^ (((n >> 6) & 3) << 3); }
__device__ __forceinline__ void hy_build_tw(Frame& F) {
    LAS cpx* TW = (LAS cpx*)(F.lds + HY_TW);
    for (int k = F.tid; k < 4096; k += NTHR) { float sn, cs; sincospif((float)k * (1.f / 4096.f), &sn, &cs); TW[k] = (cpx){cs, -sn}; }
}
__device__ __forceinline__ void dft4(cpx x0, cpx x1, cpx x2, cpx x3, cpx& X0, cpx& X1, cpx& X2, cpx& X3) {
    const cpx t0 = x0 + x2, t1 = x0 - x2, t2 = x1 + x3, t3 = cmi(x1 - x3); X0 = t0 + t2; X1 = t1 + t3; X2 = t0 - t2; X3 = t1 - t3; }
__device__ __forceinline__ void dft8(cpx (&a)[8]) {
    const float R2 = 0.7071067811865476f; cpx e[4], o[4];
    dft4(a[0] + a[4], a[1] + a[5], a[2] + a[6], a[3] + a[7], e[0], e[1], e[2], e[3]);
    const cpx d1 = a[1] - a[5], d3 = a[3] - a[7];
    dft4(a[0] - a[4], (cpx){(d1.x + d1.y) * R2, (d1.y - d1.x) * R2}, cmi(a[2] - a[6]), (cpx){(d3.y - d3.x) * R2, -(d3.x + d3.y) * R2}, o[0], o[1], o[2], o[3]);
#pragma unroll
    for (int m = 0; m < 4; ++m) { a[2 * m] = e[m]; a[2 * m + 1] = o[m]; }
}
__device__ __forceinline__ void dft16(cpx (&a)[16]) {
    const float C1 = 0.9238795325112867f, S1 = 0.3826834323650898f, R2 = 0.7071067811865476f;
    cpx e[8], o[8];
#pragma unroll
    for (int k = 0; k < 8; ++k) { e[k] = a[k] + a[k + 8]; o[k] = a[k] - a[k + 8]; }
    o[1] = cmul(o[1], (cpx){C1, -S1}); o[2] = cmul(o[2], (cpx){R2, -R2}); o[3] = cmul(o[3], (cpx){S1, -C1}); o[4] = cmi(o[4]);
    o[5] = cmul(o[5], (cpx){-S1, -C1}); o[6] = cmul(o[6], (cpx){-R2, -R2}); o[7] = cmul(o[7], (cpx){-C1, -S1});
    dft8(e); dft8(o);
#pragma unroll
    for (int m = 0; m < 8; ++m) { a[2 * m] = e[m]; a[2 * m + 1] = o[m]; }
}
template <int R> __device__ __forceinline__ void cconj(cpx (&a)[R]) {
#pragma unroll
    for (int k = 0; k < R; ++k) a[k].y = -a[k].y; }
template <bool INV, bool ZU> __device__ __forceinline__ void hy_pass1(LAS cpx* X, const LAS cpx* TW, int tid) {
    cpx a[16]; const cpx w1 = TW[tid];
#pragma unroll
    for (int k = 0; k < 16; ++k) a[k] = (!INV && ZU && k >= 8) ? (cpx){0.f, 0.f} : X[hy_p(tid + 512 * k)];
    if (!INV) { dft16(a); cpx w = w1;
#pragma unroll
        for (int q = 1; q < 16; ++q) { a[q] = cmul(a[q], w); w = cmul(w, w1); }
    } else { cpx w = w1;
#pragma unroll
        for (int q = 1; q < 16; ++q) { a[q] = cmulc(a[q], w); w = cmul(w, w1); }
        cconj<16>(a); dft16(a); cconj<16>(a); }
#pragma unroll
    for (int k = 0; k < 16; ++k) if (!(INV && ZU && k >= 8)) X[hy_p(tid + 512 * k)] = a[k];
}
template <bool INV, int S, int MUL> __device__ __forceinline__ void hy_pass8(LAS cpx* X, const LAS cpx* TW, int tid) {
#pragma unroll
    for (int h = 0; h < 2; ++h) { const int bf = tid + 512 * h, sub = bf / S, j = bf % S, base = 8 * S * sub + j; cpx a[8]; const cpx w1 = TW[MUL * j];
#pragma unroll
        for (int k = 0; k < 8; ++k) a[k] = X[hy_p(base + S * k)];
        if (!INV) { dft8(a); cpx w = w1;
#pragma unroll
            for (int q = 1; q < 8; ++q) { a[q] = cmul(a[q], w); w = cmul(w, w1); }
        } else { cpx w = w1;
#pragma unroll
            for (int q = 1; q < 8; ++q) { a[q] = cmulc(a[q], w); w = cmul(w, w1); }
            cconj<8>(a); dft8(a); cconj<8>(a); }
#pragma unroll
        for (int k = 0; k < 8; ++k) X[hy_p(base + S * k)] = a[k]; }
}
__device__ __forceinline__ void hy_pass4(LAS cpx* X, int tid, const cpx* spec) {
#pragma unroll
    for (int h = 0; h < 2; ++h) { const int g = tid + 512 * h; cpx a[8];
#pragma unroll
        for (int k = 0; k < 8; ++k) a[k] = X[hy_p(8 * g + k)];
        dft8(a);
        if (spec) {
#pragma unroll
            for (int k2 = 0; k2 < 4; ++k2) { const f32x4 s4 = *(const GAS f32x4*)(spec + 8 * g + 2 * k2); a[2 * k2] = cmul(a[2 * k2], (cpx){s4.x, s4.y}); a[2 * k2 + 1] = cmul(a[2 * k2 + 1], (cpx){s4.z, s4.w}); }
            cconj<8>(a); dft8(a); cconj<8>(a); }
#pragma unroll
        for (int k = 0; k < 8; ++k) X[hy_p(8 * g + k)] = a[k]; }
}
__device__ __forceinline__ void hy_conv_fft(LAS cpx* X, const LAS cpx* TW, int tid, const cpx* spec) {
    hy_pass1<false, true>(X, TW, tid); __syncthreads();
    hy_pass8<false, 64, 16>(X, TW, tid); __syncthreads();
    hy_pass8<false, 8, 128>(X, TW, tid); __syncthreads();
    hy_pass4(X, tid, spec); __syncthreads();
    hy_pass8<true, 8, 128>(X, TW, tid); __syncthreads();
    hy_pass8<true, 64, 16>(X, TW, tid); __syncthreads();
    hy_pass1<true, true>(X, TW, tid); __syncthreads();
}

__device__ __forceinline__ void phase_hy_spec(Frame& F, int li) { WS_DECL; frame_refresh(F);
    LAS cpx* X = (LAS cpx*)(F.lds + HY_X); const LAS cpx* TW = (const LAS cpx*)(F.lds + HY_TW); LAS float* W3 = (LAS float*)(F.lds + HY_W3);
    const int tid = F.tid; const float* w3 = in_ptr(I_HW3) + (size_t)li * 64 * 1024; const float* H2 = WSP(float, WS_H2L) + (size_t)li * SEQ * 64; cpx* SPEC = WSP(cpx, WS_SPEC);
    __syncthreads();
    hy_build_tw(F);
    for (int item = blockIdx.x; item < 512; item += F.G) {
        const int o = item >> 8, ch = item & 255;
        __syncthreads();
        if (tid < 128) { const int dir = tid >> 6, j = tid & 63; W3[tid] = w3[(size_t)j * 1024 + o * 512 + dir * 256 + ch]; }
        __syncthreads();
        const float delta = hy_delta(ch);
#pragma unroll 1
        for (int i = 0; i < 8; ++i) { const int l = tid + 512 * i; const float* hr = H2 + (size_t)l * 64; float hf = 0.f, hb = 0.f;
#pragma unroll
            for (int j4 = 0; j4 < 16; ++j4) { const f32x4 h4 = *(const GAS f32x4*)(hr + 4 * j4);
                hf += h4.x * W3[4 * j4] + h4.y * W3[4 * j4 + 1] + h4.z * W3[4 * j4 + 2] + h4.w * W3[4 * j4 + 3]; hb += h4.x * W3[64 + 4 * j4] + h4.y * W3[64 + 4 * j4 + 1] + h4.z * W3[64 + 4 * j4 + 2] + h4.w * W3[64 + 4 * j4 + 3]; }
            const float win = (expf(-((float)l * (1.f / 4095.f)) * delta) + 0.05f) * (1.f / 8192.f);
            X[hy_p(l)] = (cpx){hf * win, 0.f};
            if (l == 0) X[hy_p(4096)] = (cpx){0.f, 0.f}; else X[hy_p(8192 - l)] = (cpx){hb * win, 0.f}; }
        __syncthreads();
        hy_pass1<false, false>(X, TW, tid); __syncthreads();
        hy_pass8<false, 64, 16>(X, TW, tid); __syncthreads();
        hy_pass8<false, 8, 128>(X, TW, tid); __syncthreads();
        hy_pass4(X, tid, nullptr); __syncthreads();
        cpx* dst = SPEC + (size_t)item * 8192;
#pragma unroll
        for (int i = 0; i < 16; ++i) *(GAS cpx*)(dst + tid + 512 * i) = X[hy_p(tid + 512 * i)];
    }
    __syncthreads();
}

__device__ __forceinline__ void hy_conv8(const bf16* row, int t0, int Ls, float w0, float w1, float w2, float bias, float (&out)[8]) {
    const v4u raw = *(const GAS v4u*)(row + t0); float p[10];
    p[0] = t0 > 0 ? bf2f(row[t0 - 1]) : 0.f; p[9] = t0 + 8 < Ls ? bf2f(row[t0 + 8]) : 0.f;
    p[1] = bflo(raw.x); p[2] = bfhi(raw.x); p[3] = bflo(raw.y); p[4] = bfhi(raw.y); p[5] = bflo(raw.z); p[6] = bfhi(raw.z); p[7] = bflo(raw.w); p[8] = bfhi(raw.w);
#pragma unroll
    for (int e = 0; e < 8; ++e) out[e] = bias + w0 * p[e] + w1 * p[e + 1] + w2 * p[e + 2];
}

__device__ __forceinline__ void phase_hy_conv(Frame& F, int li) { WS_DECL; frame_refresh(F);
    LAS cpx* X = (LAS cpx*)(F.lds + HY_X); const LAS cpx* TW = (const LAS cpx*)(F.lds + HY_TW);
    const int tid = F.tid; const bf16* HT = WSP(bf16, WS_HT); bf16* HOT = WSP(bf16, WS_HOT); const cpx* SPEC = WSP(cpx, WS_SPEC);
    const float* cw = in_ptr(I_HCW) + li * 3 * 768; const float* cb = in_ptr(I_HCB) + li * 768; const float* dsk = in_ptr(I_HD) + li * 512;
    __syncthreads();
    hy_build_tw(F);
    for (int item = blockIdx.x; item < 2048; item += F.G) {
        const int ch = item >> 3, bp = item & 7; const int t0 = 8 * tid;
        float v[2][8], x1[2][8], x2[2][8];
#pragma unroll
        for (int q = 0; q < 2; ++q) { const size_t boff = (size_t)(2 * bp + q) * SEQ;
            hy_conv8(HT + (size_t)ch * NT + boff, t0, SEQ, cw[ch], cw[768 + ch], cw[1536 + ch], cb[ch], v[q]);
            hy_conv8(HT + (size_t)(256 + ch) * NT + boff, t0, SEQ, cw[256 + ch], cw[768 + 256 + ch], cw[1536 + 256 + ch], cb[256 + ch], x1[q]);
            hy_conv8(HT + (size_t)(512 + ch) * NT + boff, t0, SEQ, cw[512 + ch], cw[768 + 512 + ch], cw[1536 + 512 + ch], cb[512 + ch], x2[q]); }
        const float d0 = dsk[ch], d1 = dsk[256 + ch];
        __syncthreads();
#pragma unroll
        for (int e = 0; e < 8; ++e) X[hy_p(t0 + e)] = (cpx){v[0][e], v[1][e]};
        __syncthreads();
        hy_conv_fft(X, TW, tid, SPEC + (size_t)ch * 8192);
        float u[2][8];
#pragma unroll
        for (int e = 0; e < 8; ++e) { const cpx y = X[hy_p(t0 + e)]; u[0][e] = x1[0][e] * (y.x + v[0][e] * d0); u[1][e] = x1[1][e] * (y.y + v[1][e] * d0); X[hy_p(t0 + e)] = (cpx){u[0][e], u[1][e]}; }
        __syncthreads();
        hy_conv_fft(X, TW, tid, SPEC + (size_t)(256 + ch) * 8192);
#pragma unroll
        for (int q = 0; q < 2; ++q) { float o[8];
#pragma unroll
            for (int e = 0; e < 8; ++e) { const cpx y = X[hy_p(t0 + e)]; o[e] = x2[q][e] * ((q == 0 ? y.x : y.y) + u[q][e] * d1); }
            v4u w; w.x = pk2(o[0], o[1]); w.y = pk2(o[2], o[3]); w.z = pk2(o[4], o[5]); w.w = pk2(o[6], o[7]);
            *(GAS v4u*)(HOT + (size_t)ch * NT + (size_t)(2 * bp + q) * SEQ + t0) = w; }
    }
    __syncthreads();
}

__device__ __forceinline__ void phase_hy_ctx(Frame& F, int li) { WS_DECL; frame_refresh(F);
    LAS float* KF = (LAS float*)F.lds;
    LAS float* SIG = KF + 1024;
    LAS float* W3 = KF + 2048;
    const int tid = F.tid; const bf16* HT = WSP(bf16, WS_HT); bf16* HOT = WSP(bf16, WS_HOT);
    const float* w3 = in_ptr(I_HW3) + (size_t)li * 64 * 1024; const float* H2 = WSP(float, WS_H2C) + (size_t)li * LCX * 64;
    const float* cw = in_ptr(I_HCW) + li * 3 * 768; const float* cb = in_ptr(I_HCB) + li * 768; const float* dsk = in_ptr(I_HD) + li * 512;
    for (int ch = blockIdx.x; ch < 256; ch += F.G) {
        __syncthreads();
        if (tid < 256) { const int od = tid >> 6, j = tid & 63; W3[tid] = w3[(size_t)j * 1024 + (od >> 1) * 512 + (od & 1) * 256 + ch]; }
        __syncthreads();
        { const int o = tid >> 8, l = tid & 255; const float* hr = H2 + (size_t)l * 64; float hf = 0.f, hb = 0.f;
          for (int j = 0; j < 64; ++j) { const float hv = hr[j]; hf += hv * W3[(2 * o) * 64 + j]; hb += hv * W3[(2 * o + 1) * 64 + j]; }
          const float win = expf(-((float)l * (1.f / 255.f)) * hy_delta(ch)) + 0.05f;
          KF[(2 * o) * 256 + l] = hf * win; KF[(2 * o + 1) * 256 + l] = hb * win; }
        __syncthreads();
        const int q = tid >> 8, t = tid & 255; const float d0 = dsk[ch], d1 = dsk[256 + ch];
        for (int bp = 0; bp < 8; ++bp) { const int b = 2 * bp + q; const size_t off = (size_t)NL + (size_t)b * LCX;
            float zz[3];
#pragma unroll
            for (int k = 0; k < 3; ++k) { const int c = 256 * k + ch; const bf16* row = HT + (size_t)c * NT + off;
                const float pm = t > 0 ? bf2f(row[t - 1]) : 0.f, p0 = bf2f(row[t]), pp = t + 1 < LCX ? bf2f(row[t + 1]) : 0.f;
                zz[k] = cb[c] + cw[c] * pm + cw[768 + c] * p0 + cw[1536 + c] * pp; }
            SIG[q * 256 + t] = zz[0];
            __syncthreads();
            float y = 0.f;
            for (int s = 0; s < 256; ++s) { const int lag = t - s; const float kv = lag >= 0 ? KF[lag] : KF[256 - lag]; y += kv * SIG[q * 256 + s]; }
            const float u = zz[1] * (y + zz[0] * d0);
            __syncthreads();
            SIG[q * 256 + t] = u;
            __syncthreads();
            float y2 = 0.f;
            for (int s = 0; s < 256; ++s) { const int lag = t - s; const float kv = lag >= 0 ? KF[512 + lag] : KF[768 - lag]; y2 += kv * SIG[q * 256 + s]; }
            HOT[(size_t)ch * NT + off + t] = (bf16)f2bf(zz[2] * (y2 + u * d1));
            __syncthreads();
        }
    }
    __syncthreads();
}

constexpr int HF_LD = 72;
__device__ __forceinline__ void phase_fin_hyena(Frame& F, int li) { WS_DECL; frame_refresh(F);
    LAS bf16* T = (LAS bf16*)F.lds;
    const int nrows = li == DEPTH - 1 ? NL : NT; const int tid = F.tid, lane = F.lane, wave = F.wave; const bf16* HOT = WSP(bf16, WS_HOT); bf16* MIX = WSP(bf16, WS_A1);
    const f32x4 g4 = *(const GAS f32x4*)(in_ptr(I_HON) + li * 256 + 4 * lane);
    for (int item = blockIdx.x; item < nrows / 64; item += F.G) { const int m0 = item * 64;
        __syncthreads();
        { const int ch = tid >> 1, hf = tid & 1; const bf16* src = HOT + (size_t)ch * NT + m0 + 32 * hf;
#pragma unroll
          for (int k = 0; k < 4; ++k) *(LAS v4u*)(T + ch * HF_LD + 32 * hf + 8 * k) = *(const GAS v4u*)(src + 8 * k); }
        __syncthreads();
        for (int i = 0; i < 8; ++i) { const int tl = wave * 8 + i;
            f32x4 x; x.x = bf2f(T[(4 * lane) * HF_LD + tl]); x.y = bf2f(T[(4 * lane + 1) * HF_LD + tl]); x.z = bf2f(T[(4 * lane + 2) * HF_LD + tl]); x.w = bf2f(T[(4 * lane + 3) * HF_LD + tl]);
            const float r = rsqrtf(wave_sum(x.x * x.x + x.y * x.y + x.z * x.z + x.w * x.w) * (1.f / 256.f) + 1e-6f);
            v2u o; o.x = pk2(x.x * r * g4.x, x.y * r * g4.y); o.y = pk2(x.z * r * g4.z, x.w * r * g4.w); *(GAS v2u*)(MIX + (size_t)(m0 + tl) * D + 768 + 4 * lane) = o; }
    }
    __syncthreads();
}
#define MIX_HYENA 1

__global__ void __launch_bounds__(NTHR, 2) mk_fwd(Args a) {
    extern __shared__ __attribute__((aligned(16))) unsigned char lds_raw[];
    Frame F; F.lds = (LAS unsigned char*)lds_raw; F.tid = threadIdx.x; F.lane = F.tid & 63; F.wave = __builtin_amdgcn_readfirstlane(F.tid >> 6); F.G = gridDim.x;
    for (int u = F.tid; u < (LDS_BYTES - LDSCTL_OFF) / 4; u += NTHR) ((LAS unsigned*)(F.lds + LDSCTL_OFF))[u] = 0u;
    __syncthreads();
    XcdBarrier bar = xcd_barrier_post((unsigned*)(ws_ptr() + WS_CTL) + CW_BAR, (volatile LAS unsigned*)(F.lds + LDSCTL_OFF) + 8);
#define GRID_BAR() xcd_barrier(bar)

    phase_pro0(F);
    phase_pro0b(F);
    phase_pro0c(F);
    phase_pro0d(F);
    phase_pro0e(F);
    GRID_BAR();
    phase_hin0(F);
    GRID_BAR();
    for (int li = 0; li < DEPTH; ++li) {
        const int nrows = li == DEPTH - 1 ? NL : NT; unsigned char* const ws = ws_ptr();
        phase_hy_spec(F, li);
        { pg8::Gemm g{WSP(bf16, WS_A1), WSP(bf16, WS_WINT) + (size_t)li * PCOLS * D, NT, PCOLS, D}; pg8::StaticOrder S; S.init(NT, PCOLS, F.G, (int)blockIdx.x);
          pg8::EpiStore E{WSP(bf16, WS_P), PCOLS, 0, PCOLS / 256};
          pg8::gemm_phase<pg8::EpiStore, pg8::StaticOrder, true, true>(F.lds, g, S, E); }
#if MIX_HYENA
        { pg8::Gemm g{WSP(bf16, WS_WHYT) + (size_t)li * HYC * D, WSP(bf16, WS_A1), HYC, NT, D}; pg8::StaticOrder S; S.init(HYC, NT, F.G, (int)blockIdx.x);
          pg8::EpiStore E{WSP(bf16, WS_HT), NT, 0, NT / 256};
          pg8::gemm_phase<pg8::EpiStore, pg8::StaticOrder, true, true>(F.lds, g, S, E); }
#endif
        GRID_BAR();
        phase_rwkv_r0(F, li);
        phase_mla_prep(F, li);
        phase_lru<1>(F, li);
        __syncthreads();
        phase_hy_conv(F, li);
        if (li < DEPTH - 1) phase_hy_ctx(F, li);
        GRID_BAR();
        phase_rwkv_scan(F, li);
        __syncthreads();
        phase_attn(F, li);
        __syncthreads();
        phase_lru<3>(F, li);
        GRID_BAR();
        phase_fin_mla(F, li);
        phase_fin_rwkv(F, li); phase_fin_hyena(F, li);
        GRID_BAR();
        { pg8::Gemm g{WSP(bf16, WS_A1), WSP(bf16, WS_WOUTT) + (size_t)li * D * D, nrows, D, D}; pg8::StaticOrder S; S.init(nrows, D, F.G, (int)blockIdx.x);
          pg8::EpiStore E{WSP(bf16, WS_Y), D, 0, D / 256};
          pg8::gemm_phase<pg8::EpiStore, pg8::StaticOrder, true, true>(F.lds, g, S, E); }
        GRID_BAR();
        phase_ln1<true>(F, li);
        if (li & 1) phase_moe_weights(F, li);
        GRID_BAR();
        if (!(li & 1)) {
            const int j = li >> 1;
            { pg8::Gemm g{WSP(bf16, WS_A1), WSP(bf16, WS_WGUT) + (size_t)j * 2 * FFD * D, nrows, 2 * FFD, D}; pg8::StaticOrder S; S.init(nrows, 2 * FFD, F.G, (int)blockIdx.x);
              pg8::EpiSwiGLU E{WSP(bf16, WS_H), FFD, 0, 2 * FFD / 256};
              pg8::gemm_phase<pg8::EpiSwiGLU, pg8::StaticOrder, true, true>(F.lds, g, S, E); }
            GRID_BAR();
            { pg8::Gemm g{WSP(bf16, WS_H), WSP(bf16, WS_WDT) + (size_t)j * D * FFD, nrows, D, FFD}; pg8::StaticOrder S; S.init(nrows, D, F.G, (int)blockIdx.x);
              pg8::EpiStore E{WSP(bf16, WS_Y), D, 0, D / 256};
              pg8::gemm_phase<pg8::EpiStore, pg8::StaticOrder, true, true>(F.lds, g, S, E); }
            GRID_BAR();
        } else {
            phase_moe_slots(F, li);
            GRID_BAR();
            const int ntiles = ((LAS int*)(F.lds + LDS_MOEI))[48];
            const PG8_LAS unsigned char* tile_e = (const PG8_LAS unsigned char*)(F.lds + LDS_TILEE);
#pragma unroll 1
            for (int ch = 0; ch < MOE_NCHUNK; ++ch) {
                const int t0 = ch * MOE_CHUNK_TILES; int nM = ntiles - t0; nM = nM < 0 ? 0 : (nM > MOE_CHUNK_TILES ? MOE_CHUNK_TILES : nM);
                { pg8::Gemm g{WSP(bf16, WS_XS), WSP(bf16, WS_MGU), 0, 0, D}; pg8::MoeOrder S; S.init(nM, 2 * FFE / 256, F.G, (int)blockIdx.x, t0, t0, tile_e);
                  pg8::EpiSwiGLU E{WSP(bf16, WS_HM), FFE, t0, 2 * FFE / 256};
                  pg8::gemm_phase<pg8::EpiSwiGLU, pg8::MoeOrder, true, true>(F.lds, g, S, E); }
                GRID_BAR();
                { pg8::Gemm g{WSP(bf16, WS_HM), WSP(bf16, WS_MD), 0, 0, FFE}; pg8::MoeOrder S; S.init(nM, D / 256, F.G, (int)blockIdx.x, t0, 0, tile_e);
                  pg8::EpiStore E{WSP(bf16, WS_XS), D, t0, D / 256};
                  pg8::gemm_phase<pg8::EpiStore, pg8::MoeOrder, true, true>(F.lds, g, S, E); }
                GRID_BAR();
            }
        }
        phase_ln2<true>(F, li);
        if (li < DEPTH - 1) GRID_BAR();
    }
}

extern "C" void kernel_launch(void* const* d_in, const int* in_sizes, int n_in, void* d_out, int out_size, void* d_ws, size_t ws_size, hipStream_t stream) {
    static int grid = 0;
    if (grid == 0) {
        if (n_in != N_INPUTS || out_size != NL * D || ws_size < WS_END) { fprintf(stderr, "kernel_launch: unexpected shapes (n_in %d out %d ws %zu)\n", n_in, out_size, ws_size); grid = -1; return; }
        int dev = 0, cus = 0, per_cu = 0;
        if (hipGetDevice(&dev) != hipSuccess || hipDeviceGetAttribute(&cus, hipDeviceAttributeMultiprocessorCount, dev) != hipSuccess) { grid = -1; return; }
        if (hipFuncSetAttribute((const void*)mk_fwd, hipFuncAttributeMaxDynamicSharedMemorySize, LDS_BYTES) != hipSuccess) { fprintf(stderr, "kernel_launch: hipFuncSetAttribute failed\n"); grid = -1; return; }
        if (hipOccupancyMaxActiveBlocksPerMultiprocessor(&per_cu, (const void*)mk_fwd, NTHR, LDS_BYTES) != hipSuccess || per_cu < 1) fprintf(stderr, "kernel_launch: occupancy query reports %d\n", per_cu);
        (void)hipGetLastError();
        grid = cus > 256 ? 256 : cus;
    }
    if (grid < 0) return;
    if (hipMemsetAsync((char*)d_ws + WS_CTL, 0, CTL_ZERO_BYTES, stream) != hipSuccess) return;
    Args a{};
    for (int i = 0; i < N_INPUTS; ++i) a.in[i] = (const float*)d_in[i];
    a.out = (float*)d_out; a.ws = (unsigned char*)d_ws;
    hipLaunchKernelGGL(mk_fwd, dim3(grid), dim3(NTHR), LDS_BYTES, stream, a);
    const hipError_t le = hipPeekAtLastError();
    if (le != hipSuccess) fprintf(stderr, "kernel_launch: launch failed: %s\n", hipGetErrorName(le));
}
```

```cpp
#include <hip/hip_runtime.h>
#include <cstdio>
#include <cstdint>
#define GAS __attribute__((address_space(1)))
#define LAS __attribute__((address_space(3)))
namespace pg8 {
#define PG8_LAS __attribute__((address_space(3)))
typedef unsigned short bf16_t;
typedef short bf16x8 __attribute__((ext_vector_type(8)));
typedef float f32x4 __attribute__((ext_vector_type(4)));
typedef unsigned u32x4 __attribute__((ext_vector_type(4)));
constexpr int BM = 256, BK = 64, HALF = 128, HTB = HALF * BK * 2  , STAGE_BYTES = 8 * HTB, NXCD = 8, WGM = 8;

__host__ __device__ __forceinline__ int lds_byte(int r, int c) { const int st = (r >> 4) * 2 + (c >> 5), rr = r & 15, cc = c & 31, ob = rr * 64 + cc * 2; return st * 1024 + (ob ^ (((ob >> 9) & 1) << 5)); }
__host__ __device__ __forceinline__ void stage_rc(int b, int& R, int& C) { const int st = b / 1024, sb = b % 1024, swz = sb ^ (((sb >> 9) & 1) << 5); R = (st >> 1) * 16 + swz / 64; C = (st & 1) * 32 + (swz % 64) / 2; }
__host__ __device__ __forceinline__ int perm32(int rho) { const int n = rho >> 4, i = rho & 15; return 8 * (i >> 2) + 4 * n + (i & 3); }

struct Unit { int pm, pn; };
struct Gemm { const bf16_t* A; const bf16_t* Bt; int M, N, K; };

struct StaticOrder {
    int nM, nN, nwg, G, c;
    __host__ __device__ void init(int M, int N, int G_, int c_) { nM = M / BM; nN = N / BM; nwg = nM * nN; G = G_; c = c_; }
    __host__ __device__ bool next(int i, Unit& u) const {
        const long L = (long)i * G + c; if (L >= nwg) return false;
        int wgid = (int)L; { const int q = nwg / NXCD, r = nwg % NXCD, xcd = wgid % NXCD, off = wgid / NXCD; wgid = (xcd < r ? xcd * (q + 1) : r * (q + 1) + (xcd - r) * q) + off; }
        const int nig = WGM * nN, gid = wgid / nig, fm = gid * WGM, gsz = (nM - fm) < WGM ? (nM - fm) : WGM;
        u.pm = fm + ((wgid % nig) % gsz); u.pn = (wgid % nig) / gsz; return true;
    }
    __device__ __forceinline__ void a_ready(const Unit&) const {}
    __device__ __forceinline__ void done(const Unit&) const {}
};

__device__ __forceinline__ unsigned cvt_pk_bf16(float lo, float hi) { unsigned r; asm volatile("v_cvt_pk_bf16_f32 %0, %1, %2" : "=v"(r) : "v"(lo), "v"(hi)); return r; }
typedef float f32x2 __attribute__((ext_vector_type(2)));
__device__ __forceinline__ f32x2 gelu_pk(f32x2 v) {
    const f32x2 av = __builtin_elementwise_abs(v), d = av * 0.2316418882f + 1.0f;
    f32x2 t; t.x = __builtin_amdgcn_rcpf(d.x); t.y = __builtin_amdgcn_rcpf(d.y);
    f32x2 q = t * 0.5307027145f + (-0.7265760135f); q = q * t + 0.7107068705f; q = q * t + (-0.142248368f); q = q * t + 0.127414796f; q = q * t;
    const f32x2 s = (v * v) * (-0.72134752044f);
    f32x2 e; e.x = __builtin_amdgcn_exp2f(s.x); e.y = __builtin_amdgcn_exp2f(s.y);
    const f32x2 m = v * (q * e), r = v - m;
    f32x2 o; o.x = v.x < 0.f ? m.x : r.x; o.y = v.y < 0.f ? m.y : r.y; return o;
}

template <int ACT  > struct EpiBf16 {
    static constexpr bool PERM = true, AFTER_DRAIN = false; static_assert(ACT == 0 || ACT == 1, "EpiBf16: ACT is 0 (none) or 1 (gelu_pk)");
    bf16_t* O; int ldc; const float* bias; int split_cols; size_t split_stride; float scale0;
    __device__ __forceinline__ void operator()(const f32x4 (&acc)[2][2][4][2], const Unit& u, int wr, int wc, int fr, int fq) const {
        const int row0 = u.pm * BM + wr * 64 + fr; int colt = u.pn * BM; bf16_t* base = O;
        float sc = 1.f; if (split_cols) { const int t = colt / split_cols; base += (size_t)t * split_stride; colt -= t * split_cols; if (t == 0) sc = scale0; }
        const int col0 = colt + wc * 32 + 8 * fq, bcol0 = u.pn * BM + wc * 32 + 8 * fq;
        f32x4 bv[2][2];
#pragma unroll
        for (int bj = 0; bj < 2; ++bj)
#pragma unroll
            for (int n = 0; n < 2; ++n) bv[bj][n] = bias ? *(const f32x4*)(bias + bcol0 + bj * HALF + 4 * n) : (f32x4){0.f, 0.f, 0.f, 0.f};
#pragma unroll
        for (int ai = 0; ai < 2; ++ai)
#pragma unroll
            for (int m = 0; m < 4; ++m) { bf16_t* rowp = base + (size_t)(row0 + ai * HALF + m * 16) * ldc + col0;
#pragma unroll
                for (int bj = 0; bj < 2; ++bj) { f32x4 v0 = acc[ai][bj][m][0] + bv[bj][0], v1 = acc[ai][bj][m][1] + bv[bj][1];
                    if (ACT == 1) { f32x2 a = gelu_pk((f32x2){v0[0], v0[1]}), b = gelu_pk((f32x2){v0[2], v0[3]}), c = gelu_pk((f32x2){v1[0], v1[1]}), d = gelu_pk((f32x2){v1[2], v1[3]});
                        v0 = (f32x4){a.x, a.y, b.x, b.y}; v1 = (f32x4){c.x, c.y, d.x, d.y}; }
                    v0 = v0 * sc; v1 = v1 * sc; u32x4 w; w.x = cvt_pk_bf16(v0[0], v0[1]); w.y = cvt_pk_bf16(v0[2], v0[3]); w.z = cvt_pk_bf16(v1[0], v1[1]); w.w = cvt_pk_bf16(v1[2], v1[3]);
                    *(u32x4*)(rowp + bj * HALF) = w; } }
    }
};
template <class Epi, class Sched, bool ALIGN_EPI = false, bool SP2 = false>
__device__ __forceinline__ void gemm_phase(PG8_LAS unsigned char* lds, const Gemm g, const Sched& S, const Epi& E) {
    int tid_ = threadIdx.x; asm volatile("" : "+v"(tid_));
    const int tid = tid_, wid = __builtin_amdgcn_readfirstlane(tid >> 6), lane = tid & 63, wr = wid >> 2, wc = wid & 3, fr = lane & 15, fq = lane >> 4;
    const int K = g.K, nt = K / BK;
    unsigned voffA[2], voffB[2];
#pragma unroll
    for (int i = 0; i < 2; ++i) { int R, C; stage_rc(tid * 16 + i * 8192, R, C); const int Rb = Epi::PERM ? ((R & ~31) + perm32(R & 31)) : R;
        voffA[i] = (unsigned)(R * K + C) * 2u; voffB[i] = (unsigned)(Rb * K + C) * 2u; }
    const size_t kstep = (size_t)(BK * 2);
    const size_t hstep = (size_t)HALF * K * 2;
    const size_t tstep = 2 * hstep;
    const unsigned ldsw = (unsigned)wid * 1024u;
    const int aoff = lds_byte(wr * 64 + fr, fq * 8), boff = lds_byte(wc * 32 + fr, fq * 8);
#define PG8_SA(b, h) (((b) * 2 + (h)) * HTB)
#define PG8_SB(b, h) ((4 + (b) * 2 + (h)) * HTB)
#define PG8_STAGE(bufoff, gbase, voff) do { _Pragma("unroll") for (int _i = 0; _i < 2; ++_i) \
        __builtin_amdgcn_global_load_lds((const unsigned*)((const char*)(gbase) + (voff)[_i]), (PG8_LAS unsigned*)(lds + (bufoff) + ldsw + _i * 8192), 16, 0, 0); } while (0)
#define PG8_LDA(dst, b, h) do { _Pragma("unroll") for (int m = 0; m < 4; ++m) _Pragma("unroll") for (int k = 0; k < 2; ++k) dst[m][k] = *(const PG8_LAS bf16x8*)(lds + PG8_SA(b, h) + aoff + m * 2048 + k * 1024); } while (0)
#define PG8_LDB(dst, b, h) do { _Pragma("unroll") for (int n = 0; n < 2; ++n) _Pragma("unroll") for (int k = 0; k < 2; ++k) dst[n][k] = *(const PG8_LAS bf16x8*)(lds + PG8_SB(b, h) + boff + n * 2048 + k * 1024); } while (0)
#define PG8_MMA(ai, bj, At, Bt) do { __builtin_amdgcn_s_setprio(1); _Pragma("unroll") for (int m = 0; m < 4; ++m) _Pragma("unroll") for (int n = 0; n < 2; ++n) _Pragma("unroll") for (int k = 0; k < 2; ++k) \
        acc[ai][bj][m][n] = __builtin_amdgcn_mfma_f32_16x16x32_bf16(Bt[n][k], At[m][k], acc[ai][bj][m][n], 0, 0, 0); __builtin_amdgcn_s_setprio(0); } while (0)
#define PG8_WAIT_V(n) asm volatile("s_waitcnt vmcnt(" #n ")" ::: "memory")
#define PG8_WAIT_L(n) asm volatile("s_waitcnt lgkmcnt(" #n ")" ::: "memory")
#define PG8_BAR __builtin_amdgcn_s_barrier()
#define PG8_SCHED __builtin_amdgcn_sched_barrier(0)
    Unit cur, nxt; int ui = 0;
    if (!S.next(0, cur)) return;
    f32x4 acc[2][2][4][2];
#pragma unroll
    for (int a = 0; a < 2; ++a)
#pragma unroll
        for (int b = 0; b < 2; ++b)
#pragma unroll
            for (int m = 0; m < 4; ++m)
#pragma unroll
                for (int n = 0; n < 2; ++n) acc[a][b][m][n] = (f32x4){0.f, 0.f, 0.f, 0.f};
    bf16x8 At[4][2], B0[2][2], B1[2][2];
    const char* cA = (const char*)g.A + (size_t)cur.pm * tstep; const char* cB = (const char*)g.Bt + (size_t)cur.pn * tstep;
    S.a_ready(cur);
    if constexpr (SP2) {
        PG8_STAGE(PG8_SB(0, 0), cB, voffB); PG8_STAGE(PG8_SB(0, 1), cB + hstep, voffB); PG8_STAGE(PG8_SA(0, 0), cA, voffA); PG8_STAGE(PG8_SA(0, 1), cA + hstep, voffA);
        if (wr == 1) PG8_BAR;
        PG8_WAIT_V(2); PG8_BAR;
        PG8_STAGE(PG8_SB(1, 0), cB + kstep, voffB); PG8_STAGE(PG8_SA(1, 0), cA + kstep, voffA); PG8_STAGE(PG8_SB(1, 1), cB + hstep + kstep, voffB);
        PG8_WAIT_V(6); PG8_BAR;
    } else {
        PG8_STAGE(PG8_SB(0, 0), cB, voffB); PG8_STAGE(PG8_SA(0, 0), cA, voffA); PG8_STAGE(PG8_SB(0, 1), cB + hstep, voffB); PG8_STAGE(PG8_SA(0, 1), cA + hstep, voffA);
        if (wr == 1) PG8_BAR;
        PG8_WAIT_V(4); PG8_BAR;
        PG8_STAGE(PG8_SB(1, 0), cB + kstep, voffB); PG8_STAGE(PG8_SA(1, 0), cA + kstep, voffA); PG8_STAGE(PG8_SB(1, 1), cB + hstep + kstep, voffB);
        PG8_WAIT_V(6); PG8_BAR;
    }
    for (;;) {
        const bool has_next = S.next(ui + 1, nxt);
        const char* nA = has_next ? (const char*)g.A + (size_t)nxt.pm * tstep : cA; const char* nB = has_next ? (const char*)g.Bt + (size_t)nxt.pn * tstep : cB;
        for (int t = 0; t < nt; t += 2) {
            const bool last = (t == nt - 2);
            const char* a1 = cA + (size_t)(t + 1) * kstep;
            const char* a2 = last ? nA : cA + (size_t)(t + 2) * kstep; const char* b2 = last ? nB : cB + (size_t)(t + 2) * kstep;
            const char* a3 = a2 + kstep; const char* b3 = b2 + kstep;
            if (last && has_next) S.a_ready(nxt);
            if constexpr (SP2) {
            PG8_LDB(B0, 0, 0); PG8_LDB(B1, 0, 1); PG8_SCHED; PG8_LDA(At, 0, 0); PG8_STAGE(PG8_SA(1, 1), a1 + hstep, voffA);
            PG8_WAIT_V(8); PG8_WAIT_L(0); PG8_BAR; PG8_MMA(0, 0, At, B0); PG8_MMA(0, 1, At, B1); PG8_BAR; PG8_SCHED;
            PG8_LDA(At, 0, 1); PG8_STAGE(PG8_SB(0, 0), b2, voffB); PG8_STAGE(PG8_SB(0, 1), b2 + hstep, voffB); PG8_STAGE(PG8_SA(0, 0), a2, voffA);
            PG8_WAIT_V(8); PG8_WAIT_L(0); PG8_BAR; PG8_MMA(1, 0, At, B0); PG8_MMA(1, 1, At, B1); PG8_BAR; PG8_SCHED;
            PG8_LDB(B0, 1, 0); PG8_LDB(B1, 1, 1); PG8_SCHED; PG8_LDA(At, 1, 0); PG8_STAGE(PG8_SA(0, 1), a2 + hstep, voffA);
            PG8_WAIT_V(8); PG8_WAIT_L(0); PG8_BAR; PG8_MMA(0, 0, At, B0); PG8_MMA(0, 1, At, B1); PG8_BAR; PG8_SCHED;
            PG8_LDA(At, 1, 1); PG8_STAGE(PG8_SB(1, 0), b3, voffB); PG8_STAGE(PG8_SB(1, 1), b3 + hstep, voffB); PG8_STAGE(PG8_SA(1, 0), a3, voffA);
            PG8_WAIT_V(8); PG8_WAIT_L(0); PG8_BAR; PG8_MMA(1, 0, At, B0); PG8_MMA(1, 1, At, B1); PG8_BAR; PG8_SCHED;
            } else {
            PG8_LDB(B0, 0, 0); PG8_SCHED; PG8_LDA(At, 0, 0); PG8_STAGE(PG8_SA(1, 1), a1 + hstep, voffA);
            PG8_WAIT_L(8); PG8_BAR; PG8_WAIT_L(0); PG8_MMA(0, 0, At, B0); PG8_BAR; PG8_SCHED;
            PG8_LDB(B1, 0, 1); PG8_STAGE(PG8_SB(0, 0), b2, voffB);
            PG8_BAR; PG8_WAIT_L(0); PG8_MMA(0, 1, At, B1); PG8_BAR;
            PG8_LDA(At, 0, 1); PG8_STAGE(PG8_SA(0, 0), a2, voffA);
            PG8_BAR; PG8_WAIT_L(0); PG8_MMA(1, 0, At, B0); PG8_BAR; PG8_SCHED;
            PG8_STAGE(PG8_SB(0, 1), b2 + hstep, voffB);
            PG8_WAIT_V(6); PG8_BAR; PG8_MMA(1, 1, At, B1); PG8_BAR;
            PG8_LDB(B0, 1, 0); PG8_SCHED; PG8_LDA(At, 1, 0); PG8_STAGE(PG8_SA(0, 1), a2 + hstep, voffA);
            PG8_WAIT_L(8); PG8_BAR; PG8_WAIT_L(0); PG8_MMA(0, 0, At, B0); PG8_BAR; PG8_SCHED;
            PG8_LDB(B1, 1, 1); PG8_STAGE(PG8_SB(1, 0), b3, voffB);
            PG8_BAR; PG8_WAIT_L(0); PG8_MMA(0, 1, At, B1); PG8_BAR;
            PG8_LDA(At, 1, 1); PG8_STAGE(PG8_SA(1, 0), a3, voffA);
            PG8_BAR; PG8_WAIT_L(0); PG8_MMA(1, 0, At, B0); PG8_BAR; PG8_SCHED;
            PG8_STAGE(PG8_SB(1, 1), b3 + hstep, voffB);
            PG8_WAIT_V(6); PG8_BAR; PG8_MMA(1, 1, At, B1); PG8_BAR;
            }
        }
        if constexpr (ALIGN_EPI) { if (wr == 0) PG8_BAR; }
        if constexpr (!Epi::AFTER_DRAIN) { E(acc, cur, wr, wc, fr, fq); S.done(cur); }
        if (!has_next) break;
#pragma unroll
        for (int a = 0; a < 2; ++a)
#pragma unroll
            for (int b = 0; b < 2; ++b)
#pragma unroll
                for (int m = 0; m < 4; ++m)
#pragma unroll
                    for (int n = 0; n < 2; ++n) acc[a][b][m][n] = (f32x4){0.f, 0.f, 0.f, 0.f};
        cur = nxt; cA = nA; cB = nB; ++ui;
        if constexpr (ALIGN_EPI) { if (wr == 1) PG8_BAR; }
    }
    PG8_WAIT_V(0);
    if constexpr (!ALIGN_EPI) { if (wr == 0) PG8_BAR; }
    PG8_BAR;
    if constexpr (Epi::AFTER_DRAIN) { E.fused(acc, cur, wr, wc, fr, fq, lds, wid, lane); S.done(cur); }
#undef PG8_SA
#undef PG8_SB
#undef PG8_STAGE
#undef PG8_LDA
#undef PG8_LDB
#undef PG8_MMA
#undef PG8_WAIT_V
#undef PG8_WAIT_L
#undef PG8_BAR
#undef PG8_SCHED
}
}

typedef unsigned short bf16;
typedef unsigned v4u __attribute__((ext_vector_type(4)));
typedef unsigned v2u __attribute__((ext_vector_type(2)));
typedef float f32x4 __attribute__((ext_vector_type(4)));
typedef float f32x2 __attribute__((ext_vector_type(2)));
typedef float f32x16 __attribute__((ext_vector_type(16)));
typedef short bf16x8 __attribute__((ext_vector_type(8)));
typedef short s16x4 __attribute__((ext_vector_type(4)));
typedef GAS unsigned gu32;

constexpr int D = 1024, NB = 16, SEQ = 4096, LCX = 256, DEPTH = 4;
constexpr int NL = NB * SEQ, NC = NB * LCX, NT = NL + NC;
constexpr int N_IN = 2592, PCOLS = 2048, D_OFF = 1824, HYC = 768;
constexpr int FFD = 2816, FFE = 3584, NE = 8;
constexpr float ALPHA = 1.6817928305074292f;
constexpr int NWAVES = 8, NTHR = 512;
constexpr int KSEQ = SEQ + LCX;

enum { I_X = 0, I_C, I_CTX, I_CCTX, I_ADAW, I_ADAB, I_WIN, I_QNORM, I_KVNORM, I_WUQ, I_WUKV, I_MLAON, I_LCW, I_LCB, I_LWR, I_LBR, I_LWI, I_LBI, I_LLAM, I_LON,
       I_MUP, I_MUN, I_W0, I_WUP, I_A0, I_AUP, I_GUP, I_KK, I_KA, I_RK, I_LNG, I_LNB, I_HCW, I_HCB, I_HW1, I_HB1, I_HW2, I_HB2, I_HW3, I_HD, I_HON,
       I_WOUT, I_LN1G, I_LN1B, I_LN2G, I_LN2B, I_FG, I_FU, I_FD, I_ROUTER, I_MG, I_MU, I_MD, N_INPUTS };

constexpr size_t MiB = 1u << 20;
constexpr size_t WS_CTL = 0, CTL_ZERO_BYTES = 1 * MiB;
constexpr size_t WS_MOD = 1 * MiB;
constexpr size_t WS_ROPE = 3 * MiB;
constexpr size_t WS_H2L = 4 * MiB;
constexpr size_t WS_H2C = 8 * MiB;
constexpr size_t WS_LRUW = 9 * MiB;
constexpr size_t WS_WUQT = 10 * MiB;
constexpr size_t WS_WUKVT = 11 * MiB;
constexpr size_t WS_SUMM = 12 * MiB;
constexpr size_t WS_BON = 17 * MiB;
constexpr size_t WS_TOKE = 20 * MiB;
constexpr size_t WS_TOKG = 21 * MiB;
constexpr size_t WS_TOKS = 22 * MiB;
constexpr size_t WS_BLKCNT = 23 * MiB;
constexpr size_t WS_SPEC = 24 * MiB;
constexpr size_t WS_WINT = 56 * MiB;
constexpr size_t WS_WHYT = 72 * MiB;
constexpr size_t WS_WOUTT = 78 * MiB;
constexpr size_t WS_WGUT = 86 * MiB;
constexpr size_t WS_WDT = 108 * MiB;
constexpr size_t WS_XC = 120 * MiB;
constexpr size_t WS_A1 = 136 * MiB;
constexpr size_t WS_ARENA = 272 * MiB;
constexpr size_t WS_P = WS_ARENA;
constexpr size_t WS_HT = 544 * MiB;
constexpr size_t WS_QB = 646 * MiB;
constexpr size_t WS_KB = 697 * MiB;
constexpr size_t WS_VT = 748 * MiB;
constexpr size_t WS_AO = 782 * MiB;
constexpr size_t WS_HOT = 816 * MiB;
constexpr size_t WS_YR = 850 * MiB;
constexpr size_t WS_Y = 986 * MiB;
constexpr size_t WS_H = WS_ARENA;
constexpr size_t WS_MGU = WS_ARENA;
constexpr size_t WS_MD = 384 * MiB;
constexpr size_t WS_XS = 440 * MiB;
constexpr size_t WS_HM = 716 * MiB;
constexpr size_t WS_END = 1122 * MiB;
constexpr int MOE_MAX_TILES = 552, MOE_NCHUNK = 3, MOE_CHUNK_TILES = 184;
static_assert(WS_HM + (size_t)MOE_CHUNK_TILES * 256 * FFE * 2 <= WS_END, "moe hidden chunk");
static_assert(WS_H + (size_t)NT * FFD * 2 <= WS_QB + 51 * MiB, "dense hidden");

constexpr int CW_BAR = 4096;

constexpr int RING_BYTES = 131072;
constexpr int LDSCTL_OFF = RING_BYTES;
constexpr int LDS_TILEE = LDSCTL_OFF + 256;
constexpr int LDS_MOEI = LDSCTL_OFF + 1024;
constexpr int LDS_BYTES = 147456;

#define LDS_WAIT() asm volatile("s_waitcnt lgkmcnt(0)" ::: "memory")
#define VM_WAIT() asm volatile("s_waitcnt vmcnt(0)" ::: "memory")
__device__ __forceinline__ unsigned f2bf(float f) { unsigned u = __builtin_bit_cast(unsigned, f); return (u + 0x7fffu + ((u >> 16) & 1u)) >> 16; }
__device__ __forceinline__ unsigned pk2(float lo, float hi) { return f2bf(lo) | (f2bf(hi) << 16); }
__device__ __forceinline__ float bf2f(unsigned b) { return __builtin_bit_cast(float, b << 16); }
__device__ __forceinline__ float bflo(unsigned w) { return __builtin_bit_cast(float, w << 16); }
__device__ __forceinline__ float bfhi(unsigned w) { return __builtin_bit_cast(float, w & 0xffff0000u); }
__device__ __forceinline__ float wave_sum(float v) {
#pragma unroll
    for (int o = 1; o < 64; o <<= 1) v += __shfl_xor(v, o);
    return v;
}
__device__ __forceinline__ float sigmoidf_(float x) { return 1.f / (1.f + __expf(-x)); }
#define XB_TMO      128
#define XB_XCNT(j)  (256  + 64 * (j))
#define XB_XSUB(j)  (1280 + 64 * (j))
#define XB_XGEN(j)  (2304 + 64 * (j))
#define XB_TOP      3328
#define XB_TOPGEN   3392
#define XCD_BAR_WORDS 3456
#define XB_SPIN_CAP (1u << 18)

__device__ __forceinline__ unsigned xb_ld(unsigned* p)              { return __hip_atomic_load(p, __ATOMIC_RELAXED, __HIP_MEMORY_SCOPE_AGENT); }
__device__ __forceinline__ unsigned xb_add(unsigned* p, unsigned v) { return __hip_atomic_fetch_add(p, v, __ATOMIC_RELAXED, __HIP_MEMORY_SCOPE_AGENT); }
__device__ __forceinline__ unsigned xb_xcc_id() { return (unsigned)__builtin_amdgcn_s_getreg((3 << 11) | 20) & 0xFu; }
#define XB_SPIN(cond, bar) do { unsigned _sp = 0; while (cond) { __builtin_amdgcn_s_sleep(1); \
    if ((++_sp & 255u) == 0u) { if (xb_ld(&(bar)[XB_TMO])) break; if (_sp > XB_SPIN_CAP) { atomicAdd(&(bar)[XB_TMO], 1u); break; } } } } while (0)

struct XcdBarrier {
    unsigned* bar; unsigned x;
    volatile LAS unsigned* st;
};

__device__ __forceinline__ XcdBarrier xcd_barrier_post(unsigned* bar, volatile LAS unsigned* st) {
    XcdBarrier b; b.bar = bar; b.x = xb_xcc_id(); b.st = st;
    if (threadIdx.x == 0) (void)xb_add(&bar[XB_XCNT(b.x)], 1u);
    return b;
}
__device__ __forceinline__ void xcd_barrier_complete(unsigned* bar, unsigned x, unsigned& nloc, unsigned& nx) {
    const unsigned G = gridDim.x * gridDim.y * gridDim.z;
    unsigned sum, cnt, mine, sp = 0u;
    for (;;) {
        sum = 0u; cnt = 0u; mine = 0u;
#pragma unroll
        for (unsigned j = 0; j < 16; ++j) { const unsigned c = xb_ld(&bar[XB_XCNT(j)]); sum += c; cnt += (c > 0u) ? 1u : 0u; mine = (j == x) ? c : mine; }
        if (sum == G) break;
        __builtin_amdgcn_s_sleep(1);
        if ((++sp & 255u) == 0u) { if (xb_ld(&bar[XB_TMO])) break; if (sp > XB_SPIN_CAP) { atomicAdd(&bar[XB_TMO], 1u); break; } }
    }
    nloc = mine > 0u ? mine : 1u; nx = cnt > 0u ? cnt : 1u;
}

__device__ __forceinline__ void xcd_barrier(const XcdBarrier& b) {
    asm volatile("s_waitcnt vmcnt(0)" ::: "memory");
    __syncthreads();
    if (threadIdx.x == 0) {
        unsigned* bar = b.bar;
        __builtin_amdgcn_s_waitcnt(0);
        unsigned nloc = b.st[0], nx = b.st[1];
        if (nloc == 0u) { xcd_barrier_complete(bar, b.x, nloc, nx); b.st[0] = nloc; b.st[1] = nx; }
        const unsigned old = xb_add(&bar[XB_XSUB(b.x)], 1u);
        const unsigned gen = old / nloc;
        if (old + 1u == (gen + 1u) * nloc) {
            __builtin_amdgcn_fence(__ATOMIC_RELEASE, "agent");
            asm volatile("s_waitcnt vmcnt(0)" ::: "memory");
            const unsigned og = xb_add(&bar[XB_TOP], 1u);
            const unsigned tg = og / nx;
            if (og + 1u == (tg + 1u) * nx) xb_add(&bar[XB_TOPGEN], 1u);
            else XB_SPIN(xb_ld(&bar[XB_TOPGEN]) == tg, bar);
            __builtin_amdgcn_fence(__ATOMIC_ACQUIRE, "agent");
            xb_add(&bar[XB_XGEN(b.x)], 1u);
            asm volatile("s_waitcnt vmcnt(0)" ::: "memory");
        } else {
            XB_SPIN(xb_ld(&bar[XB_XGEN(b.x)]) == gen, bar);
            __builtin_amdgcn_fence(__ATOMIC_ACQUIRE, "agent");
            asm volatile("s_waitcnt vmcnt(0)" ::: "memory");
        }
    }
    __syncthreads();
}

struct Args { const float* in[N_INPUTS]; float* out; unsigned char* ws; };
struct Frame { LAS unsigned char* lds; int tid, lane, wave, G; };
__device__ __forceinline__ void frame_refresh(Frame& F) { int t = threadIdx.x; asm volatile("" : "+v"(t)); F.tid = t; F.lane = t & 63; }
#define CAS __attribute__((address_space(4)))
__device__ __forceinline__ const CAS char* karg() { const CAS char* kp = (const CAS char*)__builtin_amdgcn_kernarg_segment_ptr(); asm volatile("" : "+s"(kp)); return kp; }
__device__ __forceinline__ const float* in_ptr(int i) { return *(const float* const CAS*)(karg() + 8 * i); }
__device__ __forceinline__ float* out_ptr() { return *(float* const CAS*)(karg() + 8 * N_INPUTS); }
__device__ __forceinline__ unsigned char* ws_ptr() { return *(unsigned char* const CAS*)(karg() + 8 * N_INPUTS + 8); }
#define WSP(T, off) ((T*)(ws + (off)))
#define WS_DECL unsigned char* const ws = ws_ptr()

namespace pg8 {
struct EpiStore {
    static constexpr bool PERM = true, AFTER_DRAIN = false;
    bf16_t* O; int ldc; int pm_add; int nN;
    __device__ __forceinline__ void operator()(const f32x4 (&acc)[2][2][4][2], const Unit& u, int wr, int wc, int fr, int fq) const {
        const int row0 = (u.pm + pm_add) * BM + wr * 64 + fr; const int col0 = (u.pn % nN) * BM + wc * 32 + 8 * fq;
#pragma unroll
        for (int ai = 0; ai < 2; ++ai)
#pragma unroll
            for (int m = 0; m < 4; ++m) { bf16_t* rowp = O + (size_t)(row0 + ai * HALF + m * 16) * ldc + col0;
#pragma unroll
                for (int bj = 0; bj < 2; ++bj) { const f32x4 v0 = acc[ai][bj][m][0], v1 = acc[ai][bj][m][1];
                    u32x4 w; w.x = cvt_pk_bf16(v0[0], v0[1]); w.y = cvt_pk_bf16(v0[2], v0[3]); w.z = cvt_pk_bf16(v1[0], v1[1]); w.w = cvt_pk_bf16(v1[2], v1[3]);
                    *(u32x4*)(rowp + bj * HALF) = w; } }
    }
};
__device__ __forceinline__ float silu_mul(float g, float u) { return g * __builtin_amdgcn_rcpf(1.f + __expf(-g)) * u; }
struct EpiSwiGLU {
    static constexpr bool PERM = true, AFTER_DRAIN = false;
    bf16_t* H; int ldh; int pm_sub; int nN;
    __device__ __forceinline__ void operator()(const f32x4 (&acc)[2][2][4][2], const Unit& u, int wr, int wc, int fr, int fq) const {
        const int row0 = (u.pm - pm_sub) * BM + wr * 64 + fr; const int col0 = (u.pn % nN) * HALF + wc * 32 + 8 * fq;
#pragma unroll
        for (int ai = 0; ai < 2; ++ai)
#pragma unroll
            for (int m = 0; m < 4; ++m) { bf16_t* rowp = H + (size_t)(row0 + ai * HALF + m * 16) * ldh + col0;
                const f32x4 g0 = acc[ai][0][m][0], g1 = acc[ai][0][m][1], u0 = acc[ai][1][m][0], u1 = acc[ai][1][m][1];
                u32x4 w; w.x = cvt_pk_bf16(silu_mul(g0[0], u0[0]), silu_mul(g0[1], u0[1])); w.y = cvt_pk_bf16(silu_mul(g0[2], u0[2]), silu_mul(g0[3], u0[3]));
                w.z = cvt_pk_bf16(silu_mul(g1[0], u1[0]), silu_mul(g1[1], u1[1])); w.w = cvt_pk_bf16(silu_mul(g1[2], u1[2]), silu_mul(g1[3], u1[3]));
                *(u32x4*)rowp = w; }
    }
};
struct MoeOrder {
    int nM, nN, nwg, G, c, t0, pm_off; const PG8_LAS unsigned char* tile_e;
    __device__ void init(int nM_, int nN_, int G_, int c_, int t0_, int pm_off_, const PG8_LAS unsigned char* te) { nM = nM_; nN = nN_; nwg = nM * nN; G = G_; c = c_; t0 = t0_; pm_off = pm_off_; tile_e = te; }
    __device__ bool next(int i, Unit& u) const {
        const long L = (long)i * G + c; if (L >= nwg) return false;
        int wgid = (int)L; { const int q = nwg / NXCD, r = nwg % NXCD, xcd = wgid % NXCD, off = wgid / NXCD; wgid = (xcd < r ? xcd * (q + 1) : r * (q + 1) + (xcd - r) * q) + off; }
        const int nig = WGM * nN, gid = wgid / nig, fm = gid * WGM, gsz = (nM - fm) < WGM ? (nM - fm) : WGM;
        const int pml = fm + ((wgid % nig) % gsz), pnl = (wgid % nig) / gsz;
        const int e = tile_e[t0 + pml];
        u.pm = pm_off + pml; u.pn = e * nN + pnl; return true;
    }
    __device__ __forceinline__ void a_ready(const Unit&) const {}
    __device__ __forceinline__ void done(const Unit&) const {}
};
}

__device__ __forceinline__ void tr_item(const float* W, int ldw, int k0, int c0, bf16* WT, int K, int drow, LAS float* scr, int lane) {
#pragma unroll 8
    for (int i = 0; i < 32; ++i) { const int kk = 2 * i + (lane >> 5); scr[kk * 33 + (lane & 31)] = W[(size_t)(k0 + kk) * ldw + c0 + (lane & 31)]; }
    LDS_WAIT(); asm volatile("" ::: "memory");
    const int c = lane & 7;
#pragma unroll
    for (int j = 0; j < 4; ++j) { const int n = (lane >> 3) + 8 * j; const LAS float* s = scr + (8 * c) * 33 + n;
        v4u o; o.x = pk2(s[0 * 33], s[1 * 33]); o.y = pk2(s[2 * 33], s[3 * 33]); o.z = pk2(s[4 * 33], s[5 * 33]); o.w = pk2(s[6 * 33], s[7 * 33]);
        *(GAS v4u*)(WT + (size_t)(drow + n) * K + k0 + 8 * c) = o; }
    LDS_WAIT(); asm volatile("" ::: "memory");
}
__device__ __forceinline__ void conv_matrix(Frame& F, const float* W, int K, int ldw, int cbeg, int ncols, bf16* WT, int mode, int rowoff, int& cursor) {
    const int gw = blockIdx.x * NWAVES + F.wave, NGW = F.G * NWAVES;
    const int nblk = ncols / 32, nit = (K / 64) * nblk;
    LAS float* scr = (LAS float*)(F.lds + F.wave * 16384);
    int first = cursor + (((gw - cursor) % NGW) + NGW) % NGW;
    for (int it = first; it < cursor + nit; it += NGW) {
        const int idx = it - cursor, kb = idx / nblk, nb = idx % nblk, n = 32 * nb;
        const int drow = mode == 0 ? rowoff + n : ((n >> 7) * 256 + (n & 127) + rowoff);
        tr_item(W, ldw, 64 * kb, cbeg + n, WT, K, drow, scr, F.lane);
    }
    cursor += nit;
}

__device__ __forceinline__ void phase_mod(Frame& F) { WS_DECL; frame_refresh(F);
    LAS float* sv = (LAS float*)F.lds;
    LAS float* red = (LAS float*)(F.lds + 69632);
    float* MOD = WSP(float, WS_MOD);
    if ((int)blockIdx.x < 192) {
        const float* cl_ = in_ptr(I_C); const float* cc_ = in_ptr(I_CCTX); const float* adab = in_ptr(I_ADAB); const float* adaw = in_ptr(I_ADAW);
        for (int i = F.tid; i < 17 * 1024; i += NTHR) { const int b = i >> 10, k = i & 1023; const float c = b < 16 ? cl_[b * 1024 + k] : cc_[k]; sv[i] = c / (1.f + expf(-c)); }
        __syncthreads();
        for (int item = blockIdx.x; item < 192; item += F.G) {
            const int li = item / 48, cg = item % 48, cl = F.tid & 127, kq = F.tid >> 7;
            const float* W = adaw + (size_t)li * 1024 * 6144 + cg * 128 + cl;
            float acc[17];
#pragma unroll
            for (int b = 0; b < 17; ++b) acc[b] = 0.f;
            for (int k = kq * 256; k < kq * 256 + 256; ++k) { const float w = W[(size_t)k * 6144];
#pragma unroll
                for (int b = 0; b < 17; ++b) acc[b] += sv[b * 1024 + k] * w; }
#pragma unroll
            for (int b = 0; b < 17; ++b) red[(kq * 17 + b) * 128 + cl] = acc[b];
            __syncthreads();
            for (int o = F.tid; o < 17 * 128; o += NTHR) { const int b = o >> 7, c = o & 127;
                const float s = (red[(0 * 17 + b) * 128 + c] + red[(1 * 17 + b) * 128 + c]) + (red[(2 * 17 + b) * 128 + c] + red[(3 * 17 + b) * 128 + c]);
                MOD[((size_t)li * 17 + b) * 6144 + cg * 128 + c] = s + adab[li * 6144 + cg * 128 + c]; }
            __syncthreads();
        }
    }
}

__device__ __forceinline__ void phase_pro0(Frame& F) { WS_DECL; frame_refresh(F);
    phase_mod(F);
    __syncthreads();
    int cursor = 0;
    for (int li = 0; li < DEPTH; ++li) {
        conv_matrix(F, in_ptr(I_WIN) + (size_t)li * D * N_IN, D, N_IN, 0, D_OFF, WSP(bf16, WS_WINT) + (size_t)li * PCOLS * D, 0, 0, cursor);
        conv_matrix(F, in_ptr(I_WIN) + (size_t)li * D * N_IN, D, N_IN, D_OFF, HYC, WSP(bf16, WS_WHYT) + (size_t)li * HYC * D, 0, 0, cursor);
        conv_matrix(F, in_ptr(I_WOUT) + (size_t)li * D * D, D, D, 0, D, WSP(bf16, WS_WOUTT) + (size_t)li * D * D, 0, 0, cursor);
    }
    for (int j = 0; j < 2; ++j) {
        conv_matrix(F, in_ptr(I_FG) + (size_t)j * D * FFD, D, FFD, 0, FFD, WSP(bf16, WS_WGUT) + (size_t)j * 2 * FFD * D, 1, 0, cursor);
        conv_matrix(F, in_ptr(I_FU) + (size_t)j * D * FFD, D, FFD, 0, FFD, WSP(bf16, WS_WGUT) + (size_t)j * 2 * FFD * D, 1, 128, cursor);
        conv_matrix(F, in_ptr(I_FD) + (size_t)j * FFD * D, FFD, D, 0, D, WSP(bf16, WS_WDT) + (size_t)j * D * FFD, 0, 0, cursor);
    }
    { const int gt = blockIdx.x * NTHR + F.tid, NGT = F.G * NTHR; const int per = (PCOLS - D_OFF) * D / 8;
      for (int i = gt; i < DEPTH * per; i += NGT) { const int li = i / per, r = i % per; *(GAS v4u*)(WSP(bf16, WS_WINT) + (size_t)li * PCOLS * D + (size_t)D_OFF * D + (size_t)r * 8) = (v4u){0u, 0u, 0u, 0u}; } }
}

struct Stream { const float* inl; const float* inc; float* outl; float* outc; };
__device__ __forceinline__ Stream make_stream(unsigned char* ws, int li) { Stream s; s.outl = out_ptr(); s.outc = WSP(float, WS_XC); s.inl = li == 0 ? in_ptr(I_X) : (const float*)s.outl; s.inc = li == 0 ? in_ptr(I_CTX) : (const float*)s.outc; return s; }
__device__ __forceinline__ const float* stream_in(const Stream& s, int m) { return m < NL ? s.inl + (size_t)m * D : s.inc + (size_t)(m - NL) * D; }
__device__ __forceinline__ float* stream_out(const Stream& s, int m) { return m < NL ? s.outl + (size_t)m * D : s.outc + (size_t)(m - NL) * D; }
__device__ __forceinline__ int mod_b(int m) { return m < NL ? (m >> 12) : 16; }
__device__ __forceinline__ const float* mod_vec(unsigned char* ws, int li, int b, int j) { return WSP(float, WS_MOD) + ((size_t)li * 17 + b) * 6144 + j * 1024; }

__device__ __forceinline__ void store_modulated(const f32x4 (&x)[4], const float* shift, const float* scale, bf16* orow, int lane) {
#pragma unroll
    for (int j = 0; j < 4; ++j) { const int c = 4 * lane + 256 * j; const f32x4 sh = *(const GAS f32x4*)(shift + c), sc = *(const GAS f32x4*)(scale + c);
        const f32x4 h = x[j] * (sc + 1.f) + sh; v2u w; w.x = pk2(h.x, h.y); w.y = pk2(h.z, h.w); *(GAS v2u*)(orow + c) = w; }
}
__device__ __forceinline__ void rows_range(const Frame& F, int nrows, int& r0, int& r1) { const int per = (nrows + F.G - 1) / F.G; r0 = blockIdx.x * per; r1 = r0 + per < nrows ? r0 + per : nrows; if (r0 > nrows) r0 = nrows; }

__device__ __forceinline__ void phase_hin0(Frame& F) { WS_DECL; frame_refresh(F);
    int r0, r1; rows_range(F, NT, r0, r1); const Stream st = make_stream(ws, 0);
    for (int m = r0 + F.wave; m < r1; m += NWAVES) {
        const float* xr = stream_in(st, m); f32x4 x[4];
#pragma unroll
        for (int j = 0; j < 4; ++j) x[j] = *(const GAS f32x4*)(xr + 4 * F.lane + 256 * j);
        const int b = mod_b(m);
        store_modulated(x, mod_vec(ws, 0, b, 0), mod_vec(ws, 0, b, 1), WSP(bf16, WS_A1) + (size_t)m * D, F.lane);
    }
}

__device__ __forceinline__ void ln_rows(f32x4 (&v)[4], const float* g, const float* bta, int lane) {
    float s = 0.f;
#pragma unroll
    for (int j = 0; j < 4; ++j) s += (v[j].x + v[j].y) + (v[j].z + v[j].w);
    const float mean = wave_sum(s) * (1.f / D); float s2 = 0.f;
#pragma unroll
    for (int j = 0; j < 4; ++j) { v[j] = v[j] - mean; s2 += (v[j].x * v[j].x + v[j].y * v[j].y) + (v[j].z * v[j].z + v[j].w * v[j].w); }
    const float rstd = 1.f / sqrtf(wave_sum(s2) * (1.f / D) + 1e-5f);
#pragma unroll
    for (int j = 0; j < 4; ++j) { const int c = 4 * lane + 256 * j; v[j] = v[j] * rstd * *(const GAS f32x4*)(g + c) + *(const GAS f32x4*)(bta + c); }
}

template <bool HAVE_Y>
__device__ __forceinline__ void phase_ln1(Frame& F, int li) { WS_DECL; frame_refresh(F);
    const int nrows = li == DEPTH - 1 ? NL : NT; const bool moe = li & 1; const int lane = F.lane;
    LAS int* hist = (LAS int*)(F.lds + LDS_MOEI) + 56; LAS float* ROUT = (LAS float*)F.lds;
    if (moe) { if (F.tid < 8) hist[F.tid] = 0; const float* router = in_ptr(I_ROUTER) + (size_t)(li >> 1) * D * NE; for (int i = F.tid; i < D * NE / 4; i += NTHR) *(LAS f32x4*)(ROUT + 4 * i) = *(const GAS f32x4*)(router + 4 * i); __syncthreads(); }
    int r0, r1; rows_range(F, nrows, r0, r1);
    const float* g = in_ptr(I_LN1G) + li * D; const float* bt = in_ptr(I_LN1B) + li * D; const Stream st = make_stream(ws, li); const bf16* Y = WSP(bf16, WS_Y);
    f32x4 xn[4]; v2u yn[4];
    { const int m = r0 + F.wave; if (m < r1) { const float* xr = stream_in(st, m);
#pragma unroll
        for (int j = 0; j < 4; ++j) { const int c = 4 * lane + 256 * j; xn[j] = *(const GAS f32x4*)(xr + c); if (HAVE_Y) yn[j] = *(const GAS v2u*)(Y + (size_t)m * D + c); } } }
    for (int m = r0 + F.wave; m < r1; m += NWAVES) {
        const int b = mod_b(m); f32x4 v[4]; v2u yw[4];
#pragma unroll
        for (int j = 0; j < 4; ++j) { v[j] = xn[j]; if (HAVE_Y) yw[j] = yn[j]; }
        if (m + NWAVES < r1) { const float* xr = stream_in(st, m + NWAVES);
#pragma unroll
            for (int j = 0; j < 4; ++j) { const int c = 4 * lane + 256 * j; xn[j] = *(const GAS f32x4*)(xr + c); if (HAVE_Y) yn[j] = *(const GAS v2u*)(Y + (size_t)(m + NWAVES) * D + c); } }
        const float* m2 = mod_vec(ws, li, b, 2);
#pragma unroll
        for (int j = 0; j < 4; ++j) { const int c = 4 * lane + 256 * j; v[j] = v[j] * ALPHA;
            if (HAVE_Y) { const f32x4 mm = *(const GAS f32x4*)(m2 + c); v[j].x += mm.x * bflo(yw[j].x); v[j].y += mm.y * bfhi(yw[j].x); v[j].z += mm.z * bflo(yw[j].y); v[j].w += mm.w * bfhi(yw[j].y); } }
        ln_rows(v, g, bt, lane);
        float* xo = stream_out(st, m);
#pragma unroll
        for (int j = 0; j < 4; ++j) *(GAS f32x4*)(xo + 4 * lane + 256 * j) = v[j];
        const float* sh = mod_vec(ws, li, b, 3); const float* sc = mod_vec(ws, li, b, 4);
        if (moe) {
            float lg[NE];
#pragma unroll
            for (int e = 0; e < NE; ++e) lg[e] = 0.f;
#pragma unroll
            for (int j = 0; j < 4; ++j) { const int c = 4 * lane + 256 * j; const f32x4 s4 = *(const GAS f32x4*)(sh + c), c4 = *(const GAS f32x4*)(sc + c); const f32x4 f = v[j] * (c4 + 1.f) + s4;
#pragma unroll
                for (int q = 0; q < 4; ++q) { const f32x4 ra = *(const LAS f32x4*)(ROUT + (c + q) * NE), rb = *(const LAS f32x4*)(ROUT + (c + q) * NE + 4); const float fq = f[q];
                    lg[0] += fq * ra.x; lg[1] += fq * ra.y; lg[2] += fq * ra.z; lg[3] += fq * ra.w; lg[4] += fq * rb.x; lg[5] += fq * rb.y; lg[6] += fq * rb.z; lg[7] += fq * rb.w; } }
#pragma unroll
            for (int e = 0; e < NE; ++e) lg[e] = wave_sum(lg[e]);
            int e0 = 0; float v0 = lg[0];
#pragma unroll
            for (int e = 1; e < NE; ++e) if (lg[e] > v0) { v0 = lg[e]; e0 = e; }
            int e1 = -1; float v1 = -3.0e38f;
#pragma unroll
            for (int e = 0; e < NE; ++e) if (e != e0 && lg[e] > v1) { v1 = lg[e]; e1 = e; }
            const float ex = __expf(v1 - v0), g0 = 1.f / (1.f + ex), g1 = ex * g0;
            if (lane == 0) { *(GAS v2u*)(WSP(int, WS_TOKE) + 2 * (size_t)m) = (v2u){(unsigned)e0, (unsigned)e1}; *(GAS f32x2*)(WSP(float, WS_TOKG) + 2 * (size_t)m) = (f32x2){g0, g1};
                atomicAdd((int*)(hist + e0), 1); atomicAdd((int*)(hist + e1), 1); }
        }
        store_modulated(v, sh, sc, WSP(bf16, WS_A1) + (size_t)m * D, lane);
    }
    if (moe) { __syncthreads(); if (F.tid < 8) WSP(int, WS_BLKCNT)[blockIdx.x * 8 + F.tid] = hist[F.tid]; }
}

template <bool HAVE_FFN>
__device__ __forceinline__ void phase_ln2(Frame& F, int li) { WS_DECL; frame_refresh(F);
    const int nrows = li == DEPTH - 1 ? NL : NT; const bool moe = li & 1; const int lane = F.lane;
    int r0, r1; rows_range(F, nrows, r0, r1);
    const float* g = in_ptr(I_LN2G) + li * D; const float* bt = in_ptr(I_LN2B) + li * D; const Stream st = make_stream(ws, 1);
    const bf16* Y = WSP(bf16, WS_Y); const bf16* XS = WSP(bf16, WS_XS); const int* TOKS = WSP(int, WS_TOKS); const float* TOKG = WSP(float, WS_TOKG);
    f32x4 xn[4]; v2u ya[4], yb[4]; v2u sn = (v2u){0u, 0u}; f32x2 gn = (f32x2){0.f, 0.f}, gc = (f32x2){0.f, 0.f};
    const int mf = r0 + F.wave;
    if (mf < r1) { const float* xr = stream_out(st, mf); v2u s0 = (v2u){0u, 0u};
        if (moe) { s0 = *(const GAS v2u*)(TOKS + 2 * (size_t)mf); gc = *(const GAS f32x2*)(TOKG + 2 * (size_t)mf); if (mf + NWAVES < r1) { sn = *(const GAS v2u*)(TOKS + 2 * (size_t)(mf + NWAVES)); gn = *(const GAS f32x2*)(TOKG + 2 * (size_t)(mf + NWAVES)); } }
#pragma unroll
        for (int j = 0; j < 4; ++j) { const int c = 4 * lane + 256 * j; xn[j] = *(const GAS f32x4*)(xr + c);
            if (HAVE_FFN) { if (moe) { ya[j] = *(const GAS v2u*)(XS + (size_t)s0.x * D + c); yb[j] = *(const GAS v2u*)(XS + (size_t)s0.y * D + c); } else ya[j] = *(const GAS v2u*)(Y + (size_t)mf * D + c); } } }
    for (int m = mf; m < r1; m += NWAVES) {
        const int b = mod_b(m); f32x4 v[4]; v2u wa[4], wb[4]; const f32x2 gg = gc;
#pragma unroll
        for (int j = 0; j < 4; ++j) { v[j] = xn[j]; wa[j] = ya[j]; wb[j] = yb[j]; }
        const int mn = m + NWAVES;
        if (mn < r1) { const float* xr = stream_out(st, mn); const v2u s1 = sn; gc = gn;
            if (moe && mn + NWAVES < r1) { sn = *(const GAS v2u*)(TOKS + 2 * (size_t)(mn + NWAVES)); gn = *(const GAS f32x2*)(TOKG + 2 * (size_t)(mn + NWAVES)); }
#pragma unroll
            for (int j = 0; j < 4; ++j) { const int c = 4 * lane + 256 * j; xn[j] = *(const GAS f32x4*)(xr + c);
                if (HAVE_FFN) { if (moe) { ya[j] = *(const GAS v2u*)(XS + (size_t)s1.x * D + c); yb[j] = *(const GAS v2u*)(XS + (size_t)s1.y * D + c); } else ya[j] = *(const GAS v2u*)(Y + (size_t)mn * D + c); } } }
        const float* m5 = mod_vec(ws, li, b, 5);
#pragma unroll
        for (int j = 0; j < 4; ++j) { const int c = 4 * lane + 256 * j; v[j] = v[j] * ALPHA;
            if (HAVE_FFN) { const f32x4 mm = *(const GAS f32x4*)(m5 + c); f32x4 o;
                if (moe) { o.x = gg.x * bflo(wa[j].x) + gg.y * bflo(wb[j].x); o.y = gg.x * bfhi(wa[j].x) + gg.y * bfhi(wb[j].x); o.z = gg.x * bflo(wa[j].y) + gg.y * bflo(wb[j].y); o.w = gg.x * bfhi(wa[j].y) + gg.y * bfhi(wb[j].y); }
                else { o.x = bflo(wa[j].x); o.y = bfhi(wa[j].x); o.z = bflo(wa[j].y); o.w = bfhi(wa[j].y); }
                v[j] = v[j] + mm * o; } }
        ln_rows(v, g, bt, lane);
        float* xo = stream_out(st, m);
#pragma unroll
        for (int j = 0; j < 4; ++j) *(GAS f32x4*)(xo + 4 * lane + 256 * j) = v[j];
        if (li < DEPTH - 1) store_modulated(v, mod_vec(ws, li + 1, b, 0), mod_vec(ws, li + 1, b, 1), WSP(bf16, WS_A1) + (size_t)m * D, lane);
    }
}

__device__ __forceinline__ void phase_moe_weights(Frame& F, int li) { WS_DECL; frame_refresh(F);
    const int j = li >> 1; int cursor = 0;
    for (int e = 0; e < NE; ++e) {
        conv_matrix(F, in_ptr(I_MG) + ((size_t)j * NE + e) * D * FFE, D, FFE, 0, FFE, WSP(bf16, WS_MGU) + (size_t)e * 2 * FFE * D, 1, 0, cursor);
        conv_matrix(F, in_ptr(I_MU) + ((size_t)j * NE + e) * D * FFE, D, FFE, 0, FFE, WSP(bf16, WS_MGU) + (size_t)e * 2 * FFE * D, 1, 128, cursor);
        conv_matrix(F, in_ptr(I_MD) + ((size_t)j * NE + e) * FFE * D, FFE, D, 0, D, WSP(bf16, WS_MD) + (size_t)e * D * FFE, 0, 0, cursor);
    }
}

__device__ __forceinline__ void phase_moe_slots(Frame& F, int li) { WS_DECL; frame_refresh(F);
    const int nrows = li == DEPTH - 1 ? NL : NT;
    LAS int* mi = (LAS int*)(F.lds + LDS_MOEI); LAS unsigned char* tile_e = (LAS unsigned char*)(F.lds + LDS_TILEE);
    LAS int* slots = (LAS int*)F.lds;
    const int* blkcnt = WSP(int, WS_BLKCNT);
    if (F.tid < 8) { int tot = 0, pre = 0; for (int b = 0; b < F.G; ++b) { const int c = blkcnt[b * 8 + F.tid]; if (b < (int)blockIdx.x) pre += c; tot += c; } mi[16 + F.tid] = tot; mi[32 + F.tid] = pre; }
    __syncthreads();
    if (F.tid == 0) { int s = 0; for (int e = 0; e < NE; ++e) { mi[e] = s; s += (mi[16 + e] + 255) & ~255; } mi[8] = s; mi[48] = s >> 8; }
    __syncthreads();
    for (int t = F.tid; t < MOE_MAX_TILES + 8; t += NTHR) { int e = 0;
#pragma unroll
        for (int q = 1; q < NE; ++q) if (t * 256 >= mi[q]) e = q;
        tile_e[t] = (unsigned char)e; }
    int r0, r1; rows_range(F, nrows, r0, r1);
    const int na = 2 * (r1 - r0);
    if (F.wave == 0) {
        int run[NE];
#pragma unroll
        for (int e = 0; e < NE; ++e) run[e] = mi[e] + mi[32 + e];
        for (int base = 0; base < na; base += 64) { const int ai = base + F.lane; const bool ok = ai < na;
            const int e = ok ? WSP(int, WS_TOKE)[2 * (size_t)r0 + ai] : -1; int slot = 0;
#pragma unroll
            for (int q = 0; q < NE; ++q) { const unsigned long long mk = __ballot(e == q); if (e == q) slot = run[q] + __popcll(mk & ((1ull << F.lane) - 1ull)); run[q] += __popcll(mk); }
            if (ok) { slots[ai] = slot; WSP(int, WS_TOKS)[2 * (size_t)r0 + ai] = slot; } }
    }
    __syncthreads();
    for (int ai = F.wave; ai < na; ai += NWAVES) { const int m = r0 + (ai >> 1), slot = slots[ai];
        const GAS v4u* src = (const GAS v4u*)(WSP(bf16, WS_A1) + (size_t)m * D); GAS v4u* dst = (GAS v4u*)(WSP(bf16, WS_XS) + (size_t)slot * D);
        dst[F.lane] = src[F.lane]; dst[F.lane + 64] = src[F.lane + 64]; }
    { const int gw = blockIdx.x * NWAVES + F.wave, NGW = F.G * NWAVES; int cnt = 0;
      for (int e = 0; e < NE; ++e) { const int p0 = mi[e] + mi[16 + e], p1 = mi[e + 1];
          for (int s = p0; s < p1; ++s, ++cnt) if (cnt % NGW == gw) { GAS v4u* dst = (GAS v4u*)(WSP(bf16, WS_XS) + (size_t)s * D); dst[F.lane] = (v4u){0u, 0u, 0u, 0u}; dst[F.lane + 64] = (v4u){0u, 0u, 0u, 0u}; } } }
    __syncthreads();
}

constexpr float QSCALE = 0.14724319f;
constexpr int MP_CQ_LD = 200, MP_CKV_LD = 136;
__device__ __forceinline__ void phase_mla_prep(Frame& F, int li) { WS_DECL; frame_refresh(F);
    LAS bf16* CQN = (LAS bf16*)F.lds; LAS bf16* CKVN = (LAS bf16*)(F.lds + 64 * MP_CQ_LD * 2);
    const bf16* P = WSP(bf16, WS_P); bf16* QB = WSP(bf16, WS_QB); bf16* KB = WSP(bf16, WS_KB); bf16* VT = WSP(bf16, WS_VT);
    const float* qn = in_ptr(I_QNORM) + li * 192; const float* kvn = in_ptr(I_KVNORM) + li * 128;
    const bf16* WQ = WSP(bf16, WS_WUQT) + (size_t)li * 384 * 192; const bf16* WKV = WSP(bf16, WS_WUKVT) + (size_t)li * 512 * 128;
    const float* RC = WSP(float, WS_ROPE); const float* RS = RC + 4096 * 16;
    const int lane = F.lane, wave = F.wave;
    for (int item = blockIdx.x; item < NT / 64; item += F.G) {
        const int m0 = item * 64; const bool isctx = m0 >= NL; const int b = isctx ? (m0 - NL) >> 8 : m0 >> 12; const int t0 = isctx ? (m0 - NL) & 255 : m0 & 4095;
        const int ki0 = isctx ? t0 : 256 + t0;
        for (int i = 0; i < 8; ++i) { const int tl = wave * 8 + i; const bf16* pr = P + (size_t)(m0 + tl) * PCOLS;
            v4u raw = (v4u){0u, 0u, 0u, 0u}; if (lane < 40) raw = *(const GAS v4u*)(pr + 8 * lane);
            float x[8]; x[0] = bflo(raw.x); x[1] = bfhi(raw.x); x[2] = bflo(raw.y); x[3] = bfhi(raw.y); x[4] = bflo(raw.z); x[5] = bfhi(raw.z); x[6] = bflo(raw.w); x[7] = bfhi(raw.w);
            float ss = 0.f;
#pragma unroll
            for (int j = 0; j < 8; ++j) ss += x[j] * x[j];
            const float sq = wave_sum(lane < 24 ? ss : 0.f), skv = wave_sum((lane >= 24 && lane < 40) ? ss : 0.f);
            const float rq = rsqrtf(sq * (1.f / 192.f) + 1e-6f), rkv = rsqrtf(skv * (1.f / 128.f) + 1e-6f);
            if (lane < 24) { const float* g = qn + 8 * lane; v4u o; o.x = pk2(x[0] * rq * g[0], x[1] * rq * g[1]); o.y = pk2(x[2] * rq * g[2], x[3] * rq * g[3]); o.z = pk2(x[4] * rq * g[4], x[5] * rq * g[5]); o.w = pk2(x[6] * rq * g[6], x[7] * rq * g[7]);
                *(LAS v4u*)(CQN + tl * MP_CQ_LD + 8 * lane) = o; }
            else if (lane < 40) { const int c = 8 * (lane - 24); const float* g = kvn + c; v4u o; o.x = pk2(x[0] * rkv * g[0], x[1] * rkv * g[1]); o.y = pk2(x[2] * rkv * g[2], x[3] * rkv * g[3]); o.z = pk2(x[4] * rkv * g[4], x[5] * rkv * g[5]); o.w = pk2(x[6] * rkv * g[6], x[7] * rkv * g[7]);
                *(LAS v4u*)(CKVN + tl * MP_CKV_LD + c) = o; }
            if (lane < 16) { float x1 = bf2f(pr[320 + lane]), x2 = bf2f(pr[336 + lane]);
                if (!isctx) { const float c = RC[(t0 + tl) * 16 + lane], s = RS[(t0 + tl) * 16 + lane]; const float y1 = x1 * c - x2 * s, y2 = x1 * s + x2 * c; x1 = y1; x2 = y2; }
                const bf16 o1 = (bf16)f2bf(x1), o2 = (bf16)f2bf(x2);
#pragma unroll
                for (int h = 0; h < 4; ++h) { bf16* kr = KB + ((size_t)(b * 4 + h) * KSEQ + ki0 + tl) * 96; kr[64 + lane] = o1; kr[80 + lane] = o2; } }
        }
        __syncthreads();
        const int head = wave >> 1, half = wave & 1, fr = lane & 15, kg = lane >> 4;
        const size_t qrow0 = ((size_t)(b * 4 + head) * KSEQ + ki0) * 96;
        for (int qi = 0; qi < 2; ++qi) {
            const int nt = half * 3 + qi; if (half == 1 && qi == 1) break;
            f32x4 acc[4];
#pragma unroll
            for (int m = 0; m < 4; ++m) acc[m] = (f32x4){0.f, 0.f, 0.f, 0.f};
#pragma unroll
            for (int ks = 0; ks < 6; ++ks) { const bf16x8 wf = *(const GAS bf16x8*)(WQ + (size_t)(96 * head + 16 * nt + fr) * 192 + 32 * ks + 8 * kg);
#pragma unroll
                for (int m = 0; m < 4; ++m) { const bf16x8 xf = *(const LAS bf16x8*)(CQN + (16 * m + fr) * MP_CQ_LD + 32 * ks + 8 * kg); acc[m] = __builtin_amdgcn_mfma_f32_16x16x32_bf16(wf, xf, acc[m], 0, 0, 0); } }
#pragma unroll
            for (int m = 0; m < 4; ++m) { v2u o; o.x = pk2(acc[m][0] * QSCALE, acc[m][1] * QSCALE); o.y = pk2(acc[m][2] * QSCALE, acc[m][3] * QSCALE);
                *(GAS v2u*)(QB + qrow0 + (size_t)(16 * m + fr) * 96 + 16 * nt + 4 * kg) = o; }
        }
        if (half == 0) {
            f32x4 acc[4];
#pragma unroll
            for (int m = 0; m < 4; ++m) acc[m] = (f32x4){0.f, 0.f, 0.f, 0.f};
#pragma unroll
            for (int ks = 0; ks < 6; ++ks) { const bf16x8 wf = *(const GAS bf16x8*)(WQ + (size_t)(96 * head + 32 + fr) * 192 + 32 * ks + 8 * kg);
#pragma unroll
                for (int m = 0; m < 4; ++m) { const bf16x8 xf = *(const LAS bf16x8*)(CQN + (16 * m + fr) * MP_CQ_LD + 32 * ks + 8 * kg); acc[m] = __builtin_amdgcn_mfma_f32_16x16x32_bf16(wf, xf, acc[m], 0, 0, 0); } }
#pragma unroll
            for (int m = 0; m < 4; ++m) { v2u o; o.x = pk2(acc[m][0] * QSCALE, acc[m][1] * QSCALE); o.y = pk2(acc[m][2] * QSCALE, acc[m][3] * QSCALE);
                *(GAS v2u*)(QB + qrow0 + (size_t)(16 * m + fr) * 96 + 32 + 4 * kg) = o; }
        } else {
            f32x4 a1[4], a2[4];
#pragma unroll
            for (int m = 0; m < 4; ++m) { a1[m] = (f32x4){0.f, 0.f, 0.f, 0.f}; a2[m] = (f32x4){0.f, 0.f, 0.f, 0.f}; }
#pragma unroll
            for (int ks = 0; ks < 6; ++ks) { const bf16x8 w1 = *(const GAS bf16x8*)(WQ + (size_t)(96 * head + 64 + fr) * 192 + 32 * ks + 8 * kg), w2 = *(const GAS bf16x8*)(WQ + (size_t)(96 * head + 80 + fr) * 192 + 32 * ks + 8 * kg);
#pragma unroll
                for (int m = 0; m < 4; ++m) { const bf16x8 xf = *(const LAS bf16x8*)(CQN + (16 * m + fr) * MP_CQ_LD + 32 * ks + 8 * kg);
                    a1[m] = __builtin_amdgcn_mfma_f32_16x16x32_bf16(w1, xf, a1[m], 0, 0, 0); a2[m] = __builtin_amdgcn_mfma_f32_16x16x32_bf16(w2, xf, a2[m], 0, 0, 0); } }
#pragma unroll
            for (int m = 0; m < 4; ++m) { f32x4 y1 = a1[m], y2 = a2[m];
                if (!isctx) { const int t = t0 + 16 * m + fr; const f32x4 c = *(const GAS f32x4*)(RC + t * 16 + 4 * kg), s = *(const GAS f32x4*)(RS + t * 16 + 4 * kg); y1 = a1[m] * c - a2[m] * s; y2 = a1[m] * s + a2[m] * c; }
                v2u o1, o2; o1.x = pk2(y1[0] * QSCALE, y1[1] * QSCALE); o1.y = pk2(y1[2] * QSCALE, y1[3] * QSCALE); o2.x = pk2(y2[0] * QSCALE, y2[1] * QSCALE); o2.y = pk2(y2[2] * QSCALE, y2[3] * QSCALE);
                bf16* qr = QB + qrow0 + (size_t)(16 * m + fr) * 96; *(GAS v2u*)(qr + 64 + 4 * kg) = o1; *(GAS v2u*)(qr + 80 + 4 * kg) = o2; }
        }
        for (int nt = 0; nt < 4; ++nt) {
            f32x4 acc[4];
#pragma unroll
            for (int m = 0; m < 4; ++m) acc[m] = (f32x4){0.f, 0.f, 0.f, 0.f};
#pragma unroll
            for (int ks = 0; ks < 4; ++ks) { const bf16x8 wf = *(const GAS bf16x8*)(WKV + (size_t)(128 * head + 64 * half + 16 * nt + fr) * 128 + 32 * ks + 8 * kg);
#pragma unroll
                for (int m = 0; m < 4; ++m) { const bf16x8 xf = *(const LAS bf16x8*)(CKVN + (16 * m + fr) * MP_CKV_LD + 32 * ks + 8 * kg);
                    acc[m] = half == 0 ? __builtin_amdgcn_mfma_f32_16x16x32_bf16(wf, xf, acc[m], 0, 0, 0) : __builtin_amdgcn_mfma_f32_16x16x32_bf16(xf, wf, acc[m], 0, 0, 0); } }
            if (half == 0) {
#pragma unroll
                for (int m = 0; m < 4; ++m) { v2u o; o.x = pk2(acc[m][0], acc[m][1]); o.y = pk2(acc[m][2], acc[m][3]);
                    *(GAS v2u*)(KB + qrow0 + (size_t)(16 * m + fr) * 96 + 16 * nt + 4 * kg) = o; }
            } else {
#pragma unroll
                for (int m = 0; m < 4; ++m) { v2u o; o.x = pk2(acc[m][0], acc[m][1]); o.y = pk2(acc[m][2], acc[m][3]);
                    *(GAS v2u*)(VT + ((size_t)(b * 4 + head) * 64 + 16 * nt + fr) * KSEQ + ki0 + 16 * m + 4 * kg) = o; }
            }
        }
        __syncthreads();
    }
}

constexpr int AT_KLD = 104, AT_VLD = 72;
constexpr int AT_KB = 64 * AT_KLD * 2, AT_VB = 64 * AT_VLD * 2, AT_BUF = AT_KB + AT_VB;
__device__ __forceinline__ void phase_attn(Frame& F, int li) { WS_DECL; frame_refresh(F);
    const bf16* QB = WSP(bf16, WS_QB); const bf16* KB = WSP(bf16, WS_KB); const bf16* VT = WSP(bf16, WS_VT); bf16* AO = WSP(bf16, WS_AO);
    const int lane = F.lane, wave = F.wave, tid = F.tid, ql = lane & 31, h2 = lane >> 5;
    const int nunits = 1024 + (li < DEPTH - 1 ? 64 : 0);
    const int c = blockIdx.x, vc = (F.G == 256) ? (c & 7) * 32 + (c >> 3) : c;
    for (int u = vc; u < nunits; u += F.G) {
        int bh, q0, nk; bool isctx = u >= 1024;
        if (!isctx) { bh = u >> 4; q0 = 256 + 256 * (u & 15); nk = KSEQ; } else { bh = u - 1024; q0 = 0; nk = 256; }
        const bf16* Kb = KB + (size_t)bh * KSEQ * 96; const bf16* Vb = VT + (size_t)bh * 64 * KSEQ;
        bf16x8 qf[6];
        { const bf16* qr = QB + ((size_t)bh * KSEQ + q0 + 32 * wave + ql) * 96 + 8 * h2;
#pragma unroll
          for (int ks = 0; ks < 6; ++ks) qf[ks] = *(const GAS bf16x8*)(qr + 16 * ks); }
        f32x16 O0, O1;
#pragma unroll
        for (int r = 0; r < 16; ++r) { O0[r] = 0.f; O1[r] = 0.f; }
        float m_run = -1e30f, l_run = 0.f;
        const int kc0 = tid, kc1 = tid + 512; const int vr = tid >> 3, vcn = tid & 7;
        v4u pk0, pk1 = (v4u){0u, 0u, 0u, 0u}, pv;
        { const GAS v4u* ks = (const GAS v4u*)Kb; pk0 = ks[kc0]; if (kc1 < 768) pk1 = ks[kc1]; pv = *(const GAS v4u*)(Vb + (size_t)vr * KSEQ + 8 * vcn); }
        __syncthreads();
        { LAS unsigned char* buf = F.lds; *(LAS v4u*)(buf + (kc0 / 12) * (AT_KLD * 2) + (kc0 % 12) * 16) = pk0; if (kc1 < 768) *(LAS v4u*)(buf + (kc1 / 12) * (AT_KLD * 2) + (kc1 % 12) * 16) = pk1;
          *(LAS v4u*)(buf + AT_KB + vr * (AT_VLD * 2) + vcn * 16) = pv; }
        __syncthreads();
        const int ntile = nk >> 6;
        for (int kt = 0; kt < ntile; ++kt) {
            const LAS unsigned char* buf = F.lds + (kt & 1) * AT_BUF; LAS unsigned char* nbuf = F.lds + ((kt + 1) & 1) * AT_BUF;
            const bool more = kt + 1 < ntile;
            if (more) { const GAS v4u* ks = (const GAS v4u*)(Kb + (size_t)(kt + 1) * 64 * 96); pk0 = ks[kc0]; if (kc1 < 768) pk1 = ks[kc1]; pv = *(const GAS v4u*)(Vb + (size_t)vr * KSEQ + (kt + 1) * 64 + 8 * vcn); }
            f32x16 S0, S1;
#pragma unroll
            for (int r = 0; r < 16; ++r) { S0[r] = 0.f; S1[r] = 0.f; }
#pragma unroll
            for (int ks = 0; ks < 6; ++ks) { const bf16x8 k0 = *(const LAS bf16x8*)(buf + ql * (AT_KLD * 2) + 32 * ks + 16 * h2), k1 = *(const LAS bf16x8*)(buf + (32 + ql) * (AT_KLD * 2) + 32 * ks + 16 * h2);
                S0 = __builtin_amdgcn_mfma_f32_32x32x16_bf16(k0, qf[ks], S0, 0, 0, 0); S1 = __builtin_amdgcn_mfma_f32_32x32x16_bf16(k1, qf[ks], S1, 0, 0, 0); }
            float mx = S0[0];
#pragma unroll
            for (int r = 1; r < 16; ++r) mx = fmaxf(mx, S0[r]);
#pragma unroll
            for (int r = 0; r < 16; ++r) mx = fmaxf(mx, S1[r]);
            mx = fmaxf(mx, __shfl_xor(mx, 32));
            const float m_new = fmaxf(m_run, mx), alpha = __builtin_amdgcn_exp2f(m_run - m_new); m_run = m_new;
            float ps = 0.f;
#pragma unroll
            for (int r = 0; r < 16; ++r) { S0[r] = __builtin_amdgcn_exp2f(S0[r] - m_new); S1[r] = __builtin_amdgcn_exp2f(S1[r] - m_new); ps += S0[r] + S1[r]; }
            l_run = l_run * alpha + ps;
#pragma unroll
            for (int r = 0; r < 16; ++r) { O0[r] *= alpha; O1[r] *= alpha; }
            union { bf16x8 v; unsigned u[4]; } p00, p01, p10, p11;
#pragma unroll
            for (int j = 0; j < 4; ++j) { p00.u[j] = pk2(S0[2 * j], S0[2 * j + 1]); p01.u[j] = pk2(S0[8 + 2 * j], S0[8 + 2 * j + 1]); p10.u[j] = pk2(S1[2 * j], S1[2 * j + 1]); p11.u[j] = pk2(S1[8 + 2 * j], S1[8 + 2 * j + 1]); }
            const LAS unsigned char* vb = buf + AT_KB;
#pragma unroll
            for (int dvt = 0; dvt < 2; ++dvt) { const LAS unsigned char* vrow = vb + (32 * dvt + ql) * (AT_VLD * 2) + 8 * h2;
#pragma unroll
                for (int sub = 0; sub < 2; ++sub)
#pragma unroll
                    for (int s = 0; s < 2; ++s) { union { bf16x8 v; v2u h[2]; } vf; vf.h[0] = *(const LAS v2u*)(vrow + 2 * (32 * sub + 16 * s)); vf.h[1] = *(const LAS v2u*)(vrow + 2 * (32 * sub + 16 * s + 8));
                        const bf16x8 pf = sub == 0 ? (s == 0 ? p00.v : p01.v) : (s == 0 ? p10.v : p11.v);
                        if (dvt == 0) O0 = __builtin_amdgcn_mfma_f32_32x32x16_bf16(vf.v, pf, O0, 0, 0, 0); else O1 = __builtin_amdgcn_mfma_f32_32x32x16_bf16(vf.v, pf, O1, 0, 0, 0); } }
            if (more) { *(LAS v4u*)(nbuf + (kc0 / 12) * (AT_KLD * 2) + (kc0 % 12) * 16) = pk0; if (kc1 < 768) *(LAS v4u*)(nbuf + (kc1 / 12) * (AT_KLD * 2) + (kc1 % 12) * 16) = pk1;
                *(LAS v4u*)(nbuf + AT_KB + vr * (AT_VLD * 2) + vcn * 16) = pv; }
            __syncthreads();
        }
        const float inv = 1.f / (l_run + __shfl_xor(l_run, 32));
        const int b = bh >> 2, head = bh & 3, qi = q0 + 32 * wave + ql;
        const size_t row = isctx ? (size_t)NL + b * 256 + qi : (size_t)b * 4096 + (qi - 256);
        bf16* orow = AO + row * 256 + head * 64 + 4 * h2;
#pragma unroll
        for (int g = 0; g < 4; ++g) { v2u o0, o1; o0.x = pk2(O0[4 * g] * inv, O0[4 * g + 1] * inv); o0.y = pk2(O0[4 * g + 2] * inv, O0[4 * g + 3] * inv); o1.x = pk2(O1[4 * g] * inv, O1[4 * g + 1] * inv); o1.y = pk2(O1[4 * g + 2] * inv, O1[4 * g + 3] * inv);
            *(GAS v2u*)(orow + 8 * g) = o0; *(GAS v2u*)(orow + 32 + 8 * g) = o1; }
    }
}

__device__ __forceinline__ void phase_fin_mla(Frame& F, int li) { WS_DECL; frame_refresh(F);
    const int nrows = li == DEPTH - 1 ? NL : NT; const float* g = in_ptr(I_MLAON) + li * 256; const bf16* AO = WSP(bf16, WS_AO); bf16* MIX = WSP(bf16, WS_A1);
    const int gw = blockIdx.x * NWAVES + F.wave, NGW = F.G * NWAVES; const f32x4 g4 = *(const GAS f32x4*)(g + 4 * F.lane);
    for (int m = gw; m < nrows; m += NGW) { const v2u w = *(const GAS v2u*)(AO + (size_t)m * 256 + 4 * F.lane);
        f32x4 x; x.x = bflo(w.x); x.y = bfhi(w.x); x.z = bflo(w.y); x.w = bfhi(w.y);
        const float r = rsqrtf(wave_sum(x.x * x.x + x.y * x.y + x.z * x.z + x.w * x.w) * (1.f / 256.f) + 1e-6f);
        v2u o; o.x = pk2(x.x * r * g4.x, x.y * r * g4.y); o.y = pk2(x.z * r * g4.z, x.w * r * g4.w); *(GAS v2u*)(MIX + (size_t)m * D + 4 * F.lane) = o; }
}
__device__ __forceinline__ void phase_fin_zero(Frame& F, int li, int c0) { WS_DECL; frame_refresh(F);
    const int nrows = li == DEPTH - 1 ? NL : NT; bf16* MIX = WSP(bf16, WS_A1); const int gw = blockIdx.x * NWAVES + F.wave, NGW = F.G * NWAVES;
    for (int m = gw; m < nrows; m += NGW) *(GAS v2u*)(MIX + (size_t)m * D + c0 + 4 * F.lane) = (v2u){0u, 0u};
}

__device__ __forceinline__ void phase_pro0b(Frame& F) { WS_DECL; frame_refresh(F);
    const int gt = blockIdx.x * NTHR + F.tid, NGT = F.G * NTHR;
    float* RC = WSP(float, WS_ROPE); float* RS = RC + 4096 * 16;
    for (int i = gt; i < 4096 * 16; i += NGT) { const int t = i >> 4, j = i & 15; const float inv = powf(10000.f, -(float)(j & 7) / 8.f); const float pos = j < 8 ? (float)(t >> 6) : (float)(t & 63);
        const float ang = pos * inv; RC[i] = cosf(ang); RS[i] = sinf(ang); }
    const float* wuq = in_ptr(I_WUQ); const float* wukv = in_ptr(I_WUKV); bf16* WQ = WSP(bf16, WS_WUQT); bf16* WKV = WSP(bf16, WS_WUKVT);
    for (int i = gt; i < DEPTH * 384 * 192; i += NGT) { const int li = i / (384 * 192), r = i % (384 * 192), n = r / 192, k = r % 192; WQ[i] = (bf16)f2bf(wuq[(size_t)li * 192 * 384 + (size_t)k * 384 + n]); }
    for (int i = gt; i < DEPTH * 512 * 128; i += NGT) { const int li = i / (512 * 128), r = i % (512 * 128), n = r / 128, k = r % 128; WKV[i] = (bf16)f2bf(wukv[(size_t)li * 128 * 512 + (size_t)k * 512 + n]); }
}

constexpr int LR_LD = 264;
__device__ __forceinline__ float gelu_tanh(float x) { const float u = 0.7978845608028654f * (x + 0.044715f * x * x * x); const float e = __expf(2.f * u); const float t = 1.f - 2.f / (e + 1.f); return 0.5f * x * (1.f + t); }
template <int PASS>
__device__ __forceinline__ void phase_lru(Frame& F, int li) { WS_DECL; frame_refresh(F);
    LAS bf16* RAW = (LAS bf16*)F.lds; LAS bf16* U = (LAS bf16*)(F.lds + 67 * LR_LD * 2); LAS bf16* HS = (LAS bf16*)(F.lds + 71680);
    const bf16* P = WSP(bf16, WS_P); bf16* MIX = WSP(bf16, WS_A1); f32x2* SUMM = WSP(f32x2, WS_SUMM);
    const float* cw = in_ptr(I_LCW) + li * 4 * 256; const float* cb = in_ptr(I_LCB) + li * 256;
    const float* lam_ = in_ptr(I_LLAM) + li * 512; const float* br_ = in_ptr(I_LBR) + li * 512; const float* bi_ = in_ptr(I_LBI) + li * 512; const float* on_ = in_ptr(I_LON) + li * 256;
    const bf16* LW = WSP(bf16, WS_LRUW) + (size_t)li * 16 * 4096;
    const int lane = F.lane, wave = F.wave, tid = F.tid, fr = lane & 15, kg = lane >> 4;
    const int nitems = (PASS == 3 && li == DEPTH - 1) ? NL / 64 : NT / 64;
    for (int item = blockIdx.x; item < nitems; item += F.G) {
        const int m0 = item * 64; const bool isctx = m0 >= NL; const int b = isctx ? (m0 - NL) >> 8 : m0 >> 12; const int t0 = isctx ? (m0 - NL) & 255 : m0 & 4095; const int Ls = isctx ? 256 : 4096;
        const size_t seg0 = isctx ? (size_t)NL + b * 256 : (size_t)b * 4096;
        for (int c = tid; c < 67 * 32; c += NTHR) { const int r = c >> 5, cc = c & 31, t = t0 - 2 + r; v4u v = (v4u){0u, 0u, 0u, 0u};
            if (t >= 0 && t < Ls) v = *(const GAS v4u*)(P + (seg0 + t) * PCOLS + 352 + 8 * cc);
            *(LAS v4u*)(RAW + r * LR_LD + 8 * cc) = v; }
        __syncthreads();
        { const int c2 = tid & 127, tq = tid >> 7; const int ch = 2 * c2;
          float w0[4], w1[4];
#pragma unroll
          for (int j = 0; j < 4; ++j) { w0[j] = cw[j * 256 + ch]; w1[j] = cw[j * 256 + ch + 1]; }
          const float b0 = cb[ch], b1 = cb[ch + 1];
          for (int t = tq * 16; t < tq * 16 + 16; ++t) { float s0 = b0, s1 = b1;
#pragma unroll
              for (int j = 0; j < 4; ++j) { const unsigned w = *(const LAS unsigned*)(RAW + (t + j) * LR_LD + ch); s0 += w0[j] * bflo(w); s1 += w1[j] * bfhi(w); }
              *(LAS unsigned*)(U + t * LR_LD + ch) = pk2(s0, s1); } }
        __syncthreads();
#pragma unroll 1
        for (int ni = 0; ni < 2; ++ni) {
            float yv[4][4];
            const int nt = 2 * wave + ni, nb = nt >> 2, ch = 16 * nt + fr;
            float uu[4][4];
#pragma unroll
            for (int m = 0; m < 4; ++m)
#pragma unroll
                for (int r = 0; r < 4; ++r) uu[m][r] = bf2f(U[(16 * m + 4 * kg + r) * LR_LD + ch]);
#pragma unroll
            for (int d = 0; d < 2; ++d) {
                f32x4 ar[4], ai[4];
#pragma unroll
                for (int m = 0; m < 4; ++m) { ar[m] = (f32x4){0.f, 0.f, 0.f, 0.f}; ai[m] = (f32x4){0.f, 0.f, 0.f, 0.f}; }
#pragma unroll
                for (int ks = 0; ks < 2; ++ks) {
                    const bf16x8 wr = *(const GAS bf16x8*)(LW + ((size_t)((0 * 2 + d) * 4 + nb) * 64 + 16 * (nt & 3) + fr) * 64 + 32 * ks + 8 * kg);
                    const bf16x8 wi = *(const GAS bf16x8*)(LW + ((size_t)((1 * 2 + d) * 4 + nb) * 64 + 16 * (nt & 3) + fr) * 64 + 32 * ks + 8 * kg);
#pragma unroll
                    for (int m = 0; m < 4; ++m) { const bf16x8 xf = *(const LAS bf16x8*)(U + (16 * m + fr) * LR_LD + 64 * nb + 32 * ks + 8 * kg);
                        ar[m] = __builtin_amdgcn_mfma_f32_16x16x32_bf16(xf, wr, ar[m], 0, 0, 0); ai[m] = __builtin_amdgcn_mfma_f32_16x16x32_bf16(xf, wi, ai[m], 0, 0, 0); } }
                const float sp = log1pf(expf(-lam_[d * 256 + ch])), brv = br_[d * 256 + ch], biv = bi_[d * 256 + ch];
#pragma unroll
                for (int m = 0; m < 4; ++m)
#pragma unroll
                    for (int r = 0; r < 4; ++r) { const float rg = sigmoidf_(ar[m][r] + brv), ig = sigmoidf_(ai[m][r] + biv); const float la = -8.f * rg * sp;
                        ar[m][r] = __expf(la); ai[m][r] = sqrtf(fmaxf(-expm1f(2.f * la), 0.f)) * (ig * uu[m][r]); }
                float H = 0.f;
                if (PASS == 3) {
                    const int cj = t0 >> 6, cbase = 1024 + b * 4, lbase = b * 64;
                    const int np = d == 0 ? (isctx ? cj : 4 + cj) : (isctx ? 3 - cj : 4 + 63 - cj);
                    const int q = (np + 3) >> 2, p_lo = kg * q, p_hi = (p_lo + q < np) ? p_lo + q : np;
                    float Aq = 1.f, Bq = 0.f;
                    for (int p0 = p_lo; p0 < p_hi; p0 += 8) { f32x2 sv[8];
#pragma unroll
                        for (int e = 0; e < 8; ++e) { const int p = p0 + e; sv[e] = (f32x2){1.f, 0.f};
                            if (p < p_hi) { int cid; if (d == 0) cid = isctx ? cbase + p : (p < 4 ? cbase + p : lbase + (p - 4)); else cid = isctx ? cbase + 3 - p : (p < 4 ? cbase + 3 - p : lbase + 63 - (p - 4));
                                sv[e] = *(const GAS f32x2*)(SUMM + ((size_t)cid * 2 + d) * 256 + ch); } }
#pragma unroll
                        for (int e = 0; e < 8; ++e) { Bq = sv[e].x * Bq + sv[e].y; Aq = sv[e].x * Aq; } }
#pragma unroll
                    for (int g = 0; g < 4; ++g) { const float Ag_ = __shfl(Aq, fr + 16 * g), Bg_ = __shfl(Bq, fr + 16 * g); H = Ag_ * H + Bg_; }
                }
                float Ac = 1.f, Bc = 0.f;
#pragma unroll
                for (int mi = 0; mi < 4; ++mi) { const int m = d == 0 ? mi : 3 - mi;
                    float Al, Bl;
                    if (d == 0) { Al = ar[m][0] * ar[m][1] * ar[m][2] * ar[m][3]; Bl = ((ai[m][0] * ar[m][1] + ai[m][1]) * ar[m][2] + ai[m][2]) * ar[m][3] + ai[m][3]; }
                    else { Al = ar[m][0] * ar[m][1] * ar[m][2] * ar[m][3]; Bl = ((ai[m][3] * ar[m][2] + ai[m][2]) * ar[m][1] + ai[m][1]) * ar[m][0] + ai[m][0]; }
                    float Ag[4], Bg[4];
#pragma unroll
                    for (int g = 0; g < 4; ++g) { Ag[g] = __shfl(Al, fr + 16 * g); Bg[g] = __shfl(Bl, fr + 16 * g); }
                    if (PASS == 1) {
                        float At = 1.f, Bt = 0.f;
#pragma unroll
                        for (int gi = 0; gi < 4; ++gi) { const int g = d == 0 ? gi : 3 - gi; Bt = Ag[g] * Bt + Bg[g]; At = Ag[g] * At; }
                        Bc = At * Bc + Bt; Ac = At * Ac;
                    } else {
                        float s = H, sin_ = H;
#pragma unroll
                        for (int gi = 0; gi < 4; ++gi) { const int g = d == 0 ? gi : 3 - gi; if (g == kg) sin_ = s; s = Ag[g] * s + Bg[g]; }
                        H = s;
                        float x = sin_;
#pragma unroll
                        for (int ri = 0; ri < 4; ++ri) { const int r = d == 0 ? ri : 3 - ri; x = ar[m][r] * x + ai[m][r]; if (d == 0) yv[m][r] = x; else yv[m][r] += x; }
                    }
                }
                if (PASS == 1 && kg == 0) *(GAS f32x2*)(SUMM + ((size_t)item * 2 + d) * 256 + ch) = (f32x2){Ac, Bc};
            }
            if (PASS == 3) {
#pragma unroll
                for (int m = 0; m < 4; ++m)
#pragma unroll
                    for (int r = 0; r < 4; ++r) HS[(16 * m + 4 * kg + r) * LR_LD + ch] = (bf16)f2bf(yv[m][r]);
            }
        }
        if (PASS == 3) {
            __syncthreads();
            const f32x4 on4 = *(const GAS f32x4*)(on_ + 4 * lane);
            for (int i = 0; i < 8; ++i) { const int tl = wave * 8 + i; const v2u hw = *(const LAS v2u*)(HS + tl * LR_LD + 4 * lane); const v2u gw = *(const GAS v2u*)(P + (size_t)(m0 + tl) * PCOLS + 608 + 4 * lane);
                f32x4 y; y.x = bflo(hw.x) * gelu_tanh(bflo(gw.x)); y.y = bfhi(hw.x) * gelu_tanh(bfhi(gw.x)); y.z = bflo(hw.y) * gelu_tanh(bflo(gw.y)); y.w = bfhi(hw.y) * gelu_tanh(bfhi(gw.y));
                const float rs = rsqrtf(wave_sum(y.x * y.x + y.y * y.y + y.z * y.z + y.w * y.w) * (1.f / 256.f) + 1e-6f);
                v2u o; o.x = pk2(y.x * rs * on4.x, y.y * rs * on4.y); o.y = pk2(y.z * rs * on4.z, y.w * rs * on4.w);
                *(GAS v2u*)(MIX + (size_t)(m0 + tl) * D + 256 + 4 * lane) = o; }
        }
        __syncthreads();
    }
}

__device__ __forceinline__ void phase_pro0c(Frame& F) { WS_DECL; frame_refresh(F);
    const int gt = blockIdx.x * NTHR + F.tid, NGT = F.G * NTHR; const float* wr = in_ptr(I_LWR); const float* wi = in_ptr(I_LWI); bf16* LW = WSP(bf16, WS_LRUW);
    for (int i = gt; i < DEPTH * 16 * 4096; i += NGT) { const int c = i & 63, dd = (i >> 6) & 63, nb = (i >> 12) & 3, d = (i >> 14) & 1, g = (i >> 15) & 1, li = i >> 16;
        const float* src = g == 0 ? wr : wi; LW[i] = (bf16)f2bf(src[((((size_t)li * 2 + d) * 4 + nb) * 64 + c) * 64 + dd]); }
}

template <int CTRL> __device__ __forceinline__ float dpp_f(float x) { return __builtin_bit_cast(float, __builtin_amdgcn_mov_dpp(__builtin_bit_cast(int, x), CTRL, 0xf, 0xf, true)); }
__device__ __forceinline__ float rowsum16(float x) { x += dpp_f<0x128>(x); x += dpp_f<0x124>(x); x += dpp_f<0x122>(x); x += dpp_f<0x121>(x); return x; }
constexpr int RW_C0 = 864;
constexpr size_t WS_RWUP = WS_LRUW + 512 * 1024;
constexpr size_t WS_EA = WS_Y;

__device__ __forceinline__ void phase_pro0e(Frame& F) { WS_DECL; frame_refresh(F);
    const int gt = blockIdx.x * NTHR + F.tid, NGT = F.G * NTHR; const float* wup = in_ptr(I_WUP); const float* aup = in_ptr(I_AUP); bf16* W = WSP(bf16, WS_RWUP);
    for (int i = gt; i < DEPTH * 2 * 2 * 256 * 32; i += NGT) { const int k = i & 31, n = (i >> 5) & 255, wa = (i >> 13) & 1, d = (i >> 14) & 1, li = i >> 15;
        const float* src = wa == 0 ? wup : aup; W[i] = (bf16)f2bf(src[(((size_t)li * 2 + d) * 32 + k) * 256 + n]); }
}

constexpr int R0_LD = 136, R0_ZLD = 72;
__device__ __forceinline__ void phase_rwkv_r0(Frame& F, int li) { WS_DECL; frame_refresh(F);
    LAS bf16* RAWL = (LAS bf16*)F.lds;
    LAS bf16* ZW = (LAS bf16*)(F.lds + 66 * R0_LD * 2);
    LAS bf16* ZA = ZW + 64 * R0_ZLD;
    const bf16* P = WSP(bf16, WS_P); bf16* EA = WSP(bf16, WS_EA); const bf16* W = WSP(bf16, WS_RWUP) + (size_t)li * 2 * 2 * 256 * 32;
    const float* mup = in_ptr(I_MUP) + li * 960 + 768; const float* mun = in_ptr(I_MUN) + li * 960 + 768; const float* w0 = in_ptr(I_W0) + li * 512; const float* a0 = in_ptr(I_A0) + li * 512;
    const int tid = F.tid, lane = F.lane, wave = F.wave, fr = lane & 15, kg = lane >> 4;
    for (int item = blockIdx.x; item < NT / 64; item += F.G) {
        const int m0 = item * 64; const bool isctx = m0 >= NL; const int t0 = isctx ? (m0 - NL) & 255 : m0 & 4095; const int Ls = isctx ? 256 : 4096; const size_t seg0 = (size_t)m0 - t0;
        __syncthreads();
        for (int c = tid; c < 66 * 16; c += NTHR) { const int r = c >> 4, cc = c & 15, t = t0 - 1 + r; v4u v = (v4u){0u, 0u, 0u, 0u};
            if (t >= 0 && t < Ls) v = *(const GAS v4u*)(P + (seg0 + t) * PCOLS + RW_C0 + 768 + 8 * cc);
            *(LAS v4u*)(RAWL + r * R0_LD + 8 * cc) = v; }
        __syncthreads();
        { const int c = tid & 127, tq = tid >> 7; const float mp = mup[c], mn = mun[c];
          for (int tl = tq * 16; tl < tq * 16 + 16; ++tl) { const float x = bf2f(RAWL[(tl + 1) * R0_LD + c]), xp = bf2f(RAWL[tl * R0_LD + c]), xn = bf2f(RAWL[(tl + 2) * R0_LD + c]);
              const float z = x + mp * (xp - x) + mn * (xn - x);
              if (c < 64) { const float e2 = __expf(2.f * z); ZW[tl * R0_ZLD + c] = (bf16)f2bf(1.f - 2.f * __builtin_amdgcn_rcpf(e2 + 1.f)); } else ZA[tl * R0_ZLD + (c - 64)] = (bf16)f2bf(z); } }
        __syncthreads();
        const int d = wave >> 2, hh = wave & 3;
#pragma unroll 1
        for (int nt = 0; nt < 4; ++nt) { const int ch0 = 64 * hh + 16 * nt;
            const bf16x8 wf = *(const GAS bf16x8*)(W + ((size_t)(d * 2 + 0) * 256 + ch0 + fr) * 32 + 8 * kg), af = *(const GAS bf16x8*)(W + ((size_t)(d * 2 + 1) * 256 + ch0 + fr) * 32 + 8 * kg);
            const f32x4 w04 = *(const GAS f32x4*)(w0 + d * 256 + ch0 + 4 * kg), a04 = *(const GAS f32x4*)(a0 + d * 256 + ch0 + 4 * kg);
#pragma unroll
            for (int m = 0; m < 4; ++m) { const bf16x8 zw = *(const LAS bf16x8*)(ZW + (16 * m + fr) * R0_ZLD + 32 * d + 8 * kg), za = *(const LAS bf16x8*)(ZA + (16 * m + fr) * R0_ZLD + 32 * d + 8 * kg);
                f32x4 xw = __builtin_amdgcn_mfma_f32_16x16x32_bf16(wf, zw, (f32x4){0.f, 0.f, 0.f, 0.f}, 0, 0, 0), xa = __builtin_amdgcn_mfma_f32_16x16x32_bf16(af, za, (f32x4){0.f, 0.f, 0.f, 0.f}, 0, 0, 0);
                xw = xw + w04; xa = xa + a04; float e[4], av[4];
#pragma unroll
                for (int r = 0; r < 4; ++r) { const float sg = __builtin_amdgcn_rcpf(1.f + __expf(-xw[r])); e[r] = -expm1f(-0.6065306597126334f * sg); av[r] = __builtin_amdgcn_rcpf(1.f + __expf(-xa[r])); }
                const size_t tok = (size_t)m0 + 16 * m + fr; v2u oe, oa; oe.x = pk2(e[0], e[1]); oe.y = pk2(e[2], e[3]); oa.x = pk2(av[0], av[1]); oa.y = pk2(av[2], av[3]);
                *(GAS v2u*)(EA + (tok * 4 + d) * 256 + ch0 + 4 * kg) = oe; *(GAS v2u*)(EA + (tok * 4 + 2 + d) * 256 + ch0 + 4 * kg) = oa; } }
    }
    __syncthreads();
}

constexpr int RW_T = 16, RW_NCH = (LCX + SEQ) / RW_T, RW_ROWS = RW_T + 2, RW_LD = 200;
constexpr int RW_RAW = 0, RW_RAWB = RW_ROWS * RW_LD * 2;
constexpr int RW_EAB = 14848, RW_EABB = RW_T * 128 * 2;
constexpr int RW_VEC = 24576, RW_VECB = RW_T * 384 * 4;
constexpr int RW_YO = RW_VEC + 2 * RW_VECB, RW_YOB = RW_T * 32 * 4;
constexpr int RW_BON = RW_YO + 2 * RW_YOB;
static_assert(2 * RW_RAWB <= RW_EAB && RW_EAB + 2 * RW_EABB <= RW_VEC, "rwkv lds map");
__device__ __forceinline__ void phase_rwkv_scan(Frame& F, int li) { WS_DECL; frame_refresh(F);
    const bf16* P = WSP(bf16, WS_P); const bf16* EA = WSP(bf16, WS_EA); float* YR = WSP(float, WS_YR); float* BON = WSP(float, WS_BON);
    const int tid = F.tid, lane = F.lane, wave = F.wave;
    for (int item = blockIdx.x; item < 256; item += F.G) {
        const int vhalf = item & 1, d = (item >> 1) & 1, h = (item >> 2) & 3, b = item >> 4;
        __syncthreads();
        const int rp = lane >> 4, kq = lane & 15, vl = 8 * wave + 2 * rp;
        const int pt = tid - 256, ps = (pt >> 4) & 15, pq = tid & 15;
        f32x4 mpr, mpk, mpv, mnr, mnk, mnv, kk_c, ka_c, rk_c;
        { const float* mup = in_ptr(I_MUP) + li * 960; const float* mun = in_ptr(I_MUN) + li * 960; const int c = 64 * h + 4 * pq;
          mpr = *(const GAS f32x4*)(mup + c); mpk = *(const GAS f32x4*)(mup + 256 + c); mpv = *(const GAS f32x4*)(mup + 512 + c);
          mnr = *(const GAS f32x4*)(mun + c); mnk = *(const GAS f32x4*)(mun + 256 + c); mnv = *(const GAS f32x4*)(mun + 512 + c);
          kk_c = *(const GAS f32x4*)(in_ptr(I_KK) + li * 256 + c); ka_c = *(const GAS f32x4*)(in_ptr(I_KA) + li * 256 + c); rk_c = *(const GAS f32x4*)(in_ptr(I_RK) + li * 256 + c); }
        f32x2 A01 = (f32x2){0.f, 0.f}, A23 = (f32x2){0.f, 0.f}, B01 = (f32x2){0.f, 0.f}, B23 = (f32x2){0.f, 0.f};
#pragma unroll 1
        for (int it = -2; it <= RW_NCH; ++it) {
            const int ca = it + 2; const bool doA = wave >= 4 && ca < RW_NCH; v4u ra[3]; int ra_c[3];
            if (doA) { const bool isctx = ca < LCX / RW_T; const int cl = isctx ? ca : ca - LCX / RW_T; const int Ls = isctx ? LCX : SEQ; const int tlo = d == 0 ? cl * RW_T : Ls - RW_T - cl * RW_T;
                const size_t seg0 = isctx ? (size_t)NL + b * LCX : (size_t)b * SEQ;
#pragma unroll
                for (int q = 0; q < 3; ++q) { const int c = pt + 256 * q; ra[q] = (v4u){0u, 0u, 0u, 0u}; ra_c[q] = c;
                    if (c < RW_ROWS * 24) { const int r = c / 24, cc = c % 24, t = tlo - 1 + r; const int col = 256 * (cc >> 3) + 64 * h + 8 * (cc & 7);
                        if (t >= 0 && t < Ls) ra[q] = *(const GAS v4u*)(P + (seg0 + t) * PCOLS + RW_C0 + col); }
                    else if (c < RW_ROWS * 24 + RW_T * 16) { const int e = c - RW_ROWS * 24, s = e >> 4, cc = e & 15; const int t = d == 0 ? tlo + s : tlo + RW_T - 1 - s;
                        ra[q] = *(const GAS v4u*)(EA + ((seg0 + t) * 4 + (cc >> 3) * 2 + d) * 256 + 64 * h + 8 * (cc & 7)); } } }
            if (wave < 4 && it >= 0 && it < RW_NCH) {
                const LAS float* VEC = (const LAS float*)(F.lds + RW_VEC + (it & 1) * RW_VECB); LAS float* YO = (LAS float*)(F.lds + RW_YO + (it & 1) * RW_YOB);
#pragma unroll 1
                for (int g = 0; g < RW_T / 4; ++g) { f32x4 kk4[4], dec4[4], kka4[4], kd4[4], r4[4]; f32x2 vv[4], yo[4];
#pragma unroll
                    for (int j = 0; j < 4; ++j) { const LAS float* vs = VEC + (4 * g + j) * 384 + 4 * kq;
                        kk4[j] = *(const LAS f32x4*)(vs); dec4[j] = *(const LAS f32x4*)(vs + 64); kka4[j] = *(const LAS f32x4*)(vs + 128); kd4[j] = *(const LAS f32x4*)(vs + 192); r4[j] = *(const LAS f32x4*)(vs + 256);
                        vv[j] = *(const LAS f32x2*)(VEC + (4 * g + j) * 384 + 320 + 32 * vhalf + vl); }
#pragma unroll
                    for (int j = 0; j < 4; ++j) {
                        const f32x2 kk01 = (f32x2){kk4[j].x, kk4[j].y}, kk23 = (f32x2){kk4[j].z, kk4[j].w}, de01 = (f32x2){dec4[j].x, dec4[j].y}, de23 = (f32x2){dec4[j].z, dec4[j].w};
                        const f32x2 ka01 = (f32x2){kka4[j].x, kka4[j].y}, ka23 = (f32x2){kka4[j].z, kka4[j].w}, kd01 = (f32x2){kd4[j].x, kd4[j].y}, kd23 = (f32x2){kd4[j].z, kd4[j].w}, r01 = (f32x2){r4[j].x, r4[j].y}, r23 = (f32x2){r4[j].z, r4[j].w};
                        const f32x2 pa = A01 * kk01 + A23 * kk23, pb = B01 * kk01 + B23 * kk23;
                        const float sa = rowsum16(pa.x + pa.y), sb = rowsum16(pb.x + pb.y);
                        A01 = A01 * de01 + (kd01 * vv[j].x - ka01 * sa); A23 = A23 * de23 + (kd23 * vv[j].x - ka23 * sa);
                        B01 = B01 * de01 + (kd01 * vv[j].y - ka01 * sb); B23 = B23 * de23 + (kd23 * vv[j].y - ka23 * sb);
                        const f32x2 ya = A01 * r01 + A23 * r23, yb = B01 * r01 + B23 * r23;
                        yo[j] = (f32x2){rowsum16(ya.x + ya.y), rowsum16(yb.x + yb.y)}; }
                    if (kq == 0) {
#pragma unroll
                        for (int j = 0; j < 4; ++j) *(LAS f32x2*)(YO + (4 * g + j) * 32 + vl) = yo[j]; } }
            }
            const int cb = it + 1;
            if (wave >= 4 && cb >= 0 && cb < RW_NCH) {
                const LAS bf16* RAW = (const LAS bf16*)(F.lds + RW_RAW + (cb & 1) * RW_RAWB); const LAS bf16* EAB = (const LAS bf16*)(F.lds + RW_EAB + (cb & 1) * RW_EABB);
                LAS float* VEC = (LAS float*)(F.lds + RW_VEC + (cb & 1) * RW_VECB); LAS float* BONS = (LAS float*)(F.lds + RW_BON) + (cb & 3) * RW_T;
                const int prow = d == 0 ? ps + 1 : RW_T - ps;
                f32x4 zr, zk, zv;
                { const LAS bf16* r0 = RAW + prow * RW_LD + 4 * pq;
#define RW_LD4(p) ({ const v2u w_ = *(const LAS v2u*)(p); (f32x4){bflo(w_.x), bfhi(w_.x), bflo(w_.y), bfhi(w_.y)}; })
                  { const f32x4 x = RW_LD4(r0), xp = RW_LD4(r0 - RW_LD), xn = RW_LD4(r0 + RW_LD); zr = x + mpr * (xp - x) + mnr * (xn - x); }
                  { const f32x4 x = RW_LD4(r0 + 64), xp = RW_LD4(r0 + 64 - RW_LD), xn = RW_LD4(r0 + 64 + RW_LD); zk = x + mpk * (xp - x) + mnk * (xn - x); }
                  { const f32x4 x = RW_LD4(r0 + 128), xp = RW_LD4(r0 + 128 - RW_LD), xn = RW_LD4(r0 + 128 + RW_LD); zv = x + mpv * (xp - x) + mnv * (xn - x); } }
                const f32x4 e4 = RW_LD4(EAB + ps * 128 + 4 * pq), a4 = RW_LD4(EAB + ps * 128 + 64 + 4 * pq);
                const f32x4 kkr = zk * kk_c; const float ss = rowsum16((kkr.x * kkr.x + kkr.y * kkr.y) + (kkr.z * kkr.z + kkr.w * kkr.w));
                const f32x4 kd = zk * ((a4 - 1.f) * ka_c + 1.f); const f32x4 bq = zr * kd * rk_c; const float bn = rowsum16((bq.x + bq.y) + (bq.z + bq.w));
                const f32x4 kkn = kkr * rsqrtf(fmaxf(ss, 1e-24f));
                LAS float* vs = VEC + ps * 384 + 4 * pq;
                *(LAS f32x4*)(vs) = kkn; *(LAS f32x4*)(vs + 64) = 1.f - e4; *(LAS f32x4*)(vs + 128) = kkn * a4; *(LAS f32x4*)(vs + 192) = kd; *(LAS f32x4*)(vs + 256) = zr; *(LAS f32x4*)(vs + 320) = zv;
                if (pq == 0) BONS[ps] = bn;
            }
            if (wave >= 4) {
                const int ce = it - 1;
                if (ce >= 0 && ce < RW_NCH) { const bool isctx = ce < LCX / RW_T;
                    if (!isctx || li < DEPTH - 1) { const int cl = isctx ? ce : ce - LCX / RW_T; const int Ls = isctx ? LCX : SEQ; const int tlo = d == 0 ? cl * RW_T : Ls - RW_T - cl * RW_T; const size_t seg0 = isctx ? (size_t)NL + b * LCX : (size_t)b * SEQ;
                        const LAS float* YO = (const LAS float*)(F.lds + RW_YO + (ce & 1) * RW_YOB); const LAS float* BONS = (const LAS float*)(F.lds + RW_BON) + (ce & 3) * RW_T;
                        const int s = pt >> 4, pr = pt & 15; const int t = d == 0 ? tlo + s : tlo + RW_T - 1 - s; const size_t row = seg0 + t;
                        *(GAS f32x2*)(YR + ((size_t)d * NT + row) * 256 + 64 * h + 32 * vhalf + 2 * pr) = *(const LAS f32x2*)(YO + s * 32 + 2 * pr);
                        if (vhalf == 0 && pr == 0) BON[((size_t)d * NT + row) * 4 + h] = BONS[s]; } }
                if (doA) { LAS bf16* RAWW = (LAS bf16*)(F.lds + RW_RAW + (ca & 1) * RW_RAWB); LAS bf16* EAW = (LAS bf16*)(F.lds + RW_EAB + (ca & 1) * RW_EABB);
#pragma unroll
                    for (int q = 0; q < 3; ++q) { const int c = ra_c[q];
                        if (c < RW_ROWS * 24) *(LAS v4u*)(RAWW + (c / 24) * RW_LD + 8 * (c % 24)) = ra[q];
                        else if (c < RW_ROWS * 24 + RW_T * 16) { const int e = c - RW_ROWS * 24; *(LAS v4u*)(EAW + 8 * e) = ra[q]; } } }
            }
            __syncthreads();
        }
    }
}

__device__ __forceinline__ void phase_fin_rwkv(Frame& F, int li) { WS_DECL; frame_refresh(F);
    const int nrows = li == DEPTH - 1 ? NL : NT; const int lane = F.lane, wave = F.wave, tid = F.tid;
    LAS float* GUP = (LAS float*)F.lds;
    LAS float* SG = (LAS float*)(F.lds + 65536) + wave * 64;
    const bf16* P = WSP(bf16, WS_P); const float* YR = WSP(float, WS_YR); const float* BON = WSP(float, WS_BON); bf16* MIX = WSP(bf16, WS_A1);
    { const float* gup = in_ptr(I_GUP) + (size_t)li * 64 * 256; for (int i = tid; i < 64 * 256; i += NTHR) GUP[i] = gup[i]; }
    const float* mup = in_ptr(I_MUP) + li * 960; const float* mun = in_ptr(I_MUN) + li * 960;
    const f32x4 mpv = *(const GAS f32x4*)(mup + 512 + 4 * lane), mnv = *(const GAS f32x4*)(mun + 512 + 4 * lane);
    const float mpg = mup[896 + lane], mng = mun[896 + lane];
    const f32x4 lg = *(const GAS f32x4*)(in_ptr(I_LNG) + li * 256 + 4 * lane), lb = *(const GAS f32x4*)(in_ptr(I_LNB) + li * 256 + 4 * lane);
    __syncthreads();
    const int gw = blockIdx.x * NWAVES + wave, NGW = F.G * NWAVES;
    for (int m = gw; m < nrows; m += NGW) {
        const bool isctx = m >= NL; const int t = isctx ? (m - NL) & 255 : m & 4095; const int Ls = isctx ? 256 : 4096;
        const bf16* pr = P + (size_t)m * PCOLS + RW_C0;
        const bool hp = t > 0, hn = t + 1 < Ls;
        f32x4 v;
        { const v2u w = *(const GAS v2u*)(pr + 512 + 4 * lane); v2u wp = (v2u){0u, 0u}, wn = (v2u){0u, 0u};
          if (hp) wp = *(const GAS v2u*)(pr - PCOLS + 512 + 4 * lane); if (hn) wn = *(const GAS v2u*)(pr + PCOLS + 512 + 4 * lane);
          const f32x4 x = (f32x4){bflo(w.x), bfhi(w.x), bflo(w.y), bfhi(w.y)}, xp = (f32x4){bflo(wp.x), bfhi(wp.x), bflo(wp.y), bfhi(wp.y)}, xn = (f32x4){bflo(wn.x), bfhi(wn.x), bflo(wn.y), bfhi(wn.y)};
          v = x + mpv * (xp - x) + mnv * (xn - x); }
        { const float x = bf2f(pr[896 + lane]); const float xp = hp ? bf2f(pr[896 + lane - PCOLS]) : 0.f, xn = hn ? bf2f(pr[896 + lane + PCOLS]) : 0.f;
          SG[lane] = sigmoidf_(x + mpg * (xp - x) + mng * (xn - x)); }
        LDS_WAIT();
        f32x4 g = (f32x4){0.f, 0.f, 0.f, 0.f};
#pragma unroll 8
        for (int j = 0; j < 64; ++j) { const float sj = SG[j]; const f32x4 gu = *(const LAS f32x4*)(GUP + j * 256 + 4 * lane); g = g + gu * sj; }
        const f32x4 y = *(const GAS f32x4*)(YR + (size_t)m * 256 + 4 * lane) + *(const GAS f32x4*)(YR + ((size_t)NT + m) * 256 + 4 * lane);
        const float mean = rowsum16((y.x + y.y) + (y.z + y.w)) * (1.f / 64.f);
        const f32x4 yc = y - mean; const float var = rowsum16((yc.x * yc.x + yc.y * yc.y) + (yc.z * yc.z + yc.w * yc.w)) * (1.f / 64.f);
        const f32x4 yn = yc * rsqrtf(var + 64e-5f) * lg + lb;
        const int hh = lane >> 4; const float bon = BON[(size_t)m * 4 + hh] + BON[((size_t)NT + m) * 4 + hh];
        const f32x4 o = (yn + v * bon) * g;
        v2u ow; ow.x = pk2(o.x, o.y); ow.y = pk2(o.z, o.w); *(GAS v2u*)(MIX + (size_t)m * D + 512 + 4 * lane) = ow;
        LDS_WAIT();
    }
    __syncthreads();
}

constexpr float HY_DMIN = -3.0701134573253945f, HY_DMAX = -15.350567286626973f;
constexpr int HY_X = 0, HY_TW = 65536, HY_W3 = 98304;
__device__ __forceinline__ float hy_delta(int ch) { return -(HY_DMIN + (float)ch * ((HY_DMAX - HY_DMIN) / 255.f)); }

__device__ __forceinline__ void phase_pro0d(Frame& F) { WS_DECL; frame_refresh(F);
    const int lane = F.lane; const int gw = blockIdx.x * NWAVES + F.wave, NGW = F.G * NWAVES;
    const float* w1 = in_ptr(I_HW1); const float* b1 = in_ptr(I_HB1); const float* w2 = in_ptr(I_HW2); const float* b2 = in_ptr(I_HB2);
    for (int it = gw; it < DEPTH * (SEQ + LCX); it += NGW) {
        const int li = it / (SEQ + LCX), r = it % (SEQ + LCX); const bool isctx = r >= SEQ; const int l = isctx ? r - SEQ : r; const int L = isctx ? LCX : SEQ;
        float z = 0.f;
        if (lane == 0) z = (float)l / (float)(L - 1);
        else if (lane < 33) { const int i = (lane - 1) & 15; const float band = 1e-4f + (float)i * ((15.f - 1e-4f) / 15.f); const float ang = band * (6.283185307179586f / (float)L) * (float)l; z = lane < 17 ? cosf(ang) : -sinf(ang); }
        float h1 = b1[li * 64 + lane];
        for (int i = 0; i < 33; ++i) h1 += __shfl(z, i) * w1[(li * 33 + i) * 64 + lane];
        h1 = sinf(h1);
        float h2 = b2[li * 64 + lane];
        for (int i = 0; i < 64; ++i) h2 += __shfl(h1, i) * w2[(li * 64 + i) * 64 + lane];
        h2 = sinf(h2);
        float* dst = isctx ? WSP(float, WS_H2C) + ((size_t)li * LCX + l) * 64 : WSP(float, WS_H2L) + ((size_t)li * SEQ + l) * 64;
        dst[lane] = h2;
    }
}

typedef f32x2 cpx;
__device__ __forceinline__ cpx cmul(cpx a, cpx b) { return (cpx){a.x * b.x - a.y * b.y, a.x * b.y + a.y * b.x}; }
__device__ __forceinline__ cpx cmulc(cpx a, cpx b) { return (cpx){a.x * b.x + a.y * b.y, a.y * b.x - a.x * b.y}; }
__device__ __forceinline__ cpx cmi(cpx z) { return (cpx){z.y, -z.x}; }
__device__ __forceinline__ int hy_p(int n) { return n ^ ((n >> 5) & 7) ^ (((n >> 6) & 3) << 3); }
__device__ __forceinline__ void hy_build_tw(Frame& F) {
    LAS cpx* TW = (LAS cpx*)(F.lds + HY_TW);
    for (int k = F.tid; k < 4096; k += NTHR) { float sn, cs; sincospif((float)k * (1.f / 4096.f), &sn, &cs); TW[k] = (cpx){cs, -sn}; }
}
__device__ __forceinline__ void dft4(cpx x0, cpx x1, cpx x2, cpx x3, cpx& X0, cpx& X1, cpx& X2, cpx& X3) {
    const cpx t0 = x0 + x2, t1 = x0 - x2, t2 = x1 + x3, t3 = cmi(x1 - x3); X0 = t0 + t2; X1 = t1 + t3; X2 = t0 - t2; X3 = t1 - t3; }
__device__ __forceinline__ void dft8(cpx (&a)[8]) {
    const float R2 = 0.7071067811865476f; cpx e[4], o[4];
    dft4(a[0] + a[4], a[1] + a[5], a[2] + a[6], a[3] + a[7], e[0], e[1], e[2], e[3]);
    const cpx d1 = a[1] - a[5], d3 = a[3] - a[7];
    dft4(a[0] - a[4], (cpx){(d1.x + d1.y) * R2, (d1.y - d1.x) * R2}, cmi(a[2] - a[6]), (cpx){(d3.y - d3.x) * R2, -(d3.x + d3.y) * R2}, o[0], o[1], o[2], o[3]);
#pragma unroll
    for (int m = 0; m < 4; ++m) { a[2 * m] = e[m]; a[2 * m + 1] = o[m]; }
}
__device__ __forceinline__ void dft16(cpx (&a)[16]) {
    const float C1 = 0.9238795325112867f, S1 = 0.3826834323650898f, R2 = 0.7071067811865476f;
    cpx e[8], o[8];
#pragma unroll
    for (int k = 0; k < 8; ++k) { e[k] = a[k] + a[k + 8]; o[k] = a[k] - a[k + 8]; }
    o[1] = cmul(o[1], (cpx){C1, -S1}); o[2] = cmul(o[2], (cpx){R2, -R2}); o[3] = cmul(o[3], (cpx){S1, -C1}); o[4] = cmi(o[4]);
    o[5] = cmul(o[5], (cpx){-S1, -C1}); o[6] = cmul(o[6], (cpx){-R2, -R2}); o[7] = cmul(o[7], (cpx){-C1, -S1});
    dft8(e); dft8(o);
#pragma unroll
    for (int m = 0; m < 8; ++m) { a[2 * m] = e[m]; a[2 * m + 1] = o[m]; }
}
template <int R> __device__ __forceinline__ void cconj(cpx (&a)[R]) {
#pragma unroll
    for (int k = 0; k < R; ++k) a[k].y = -a[k].y; }
template <bool INV, bool ZU> __device__ __forceinline__ void hy_pass1(LAS cpx* X, const LAS cpx* TW, int tid) {
    cpx a[16]; const cpx w1 = TW[tid];
#pragma unroll
    for (int k = 0; k < 16; ++k) a[k] = (!INV && ZU && k >= 8) ? (cpx){0.f, 0.f} : X[hy_p(tid + 512 * k)];
    if (!INV) { dft16(a); cpx w = w1;
#pragma unroll
        for (int q = 1; q < 16; ++q) { a[q] = cmul(a[q], w); w = cmul(w, w1); }
    } else { cpx w = w1;
#pragma unroll
        for (int q = 1; q < 16; ++q) { a[q] = cmulc(a[q], w); w = cmul(w, w1); }
        cconj<16>(a); dft16(a); cconj<16>(a); }
#pragma unroll
    for (int k = 0; k < 16; ++k) if (!(INV && ZU && k >= 8)) X[hy_p(tid + 512 * k)] = a[k];
}
template <bool INV, int S, int MUL> __device__ __forceinline__ void hy_pass8(LAS cpx* X, const LAS cpx* TW, int tid) {
#pragma unroll
    for (int h = 0; h < 2; ++h) { const int bf = tid + 512 * h, sub = bf / S, j = bf % S, base = 8 * S * sub + j; cpx a[8]; const cpx w1 = TW[MUL * j];
#pragma unroll
        for (int k = 0; k < 8; ++k) a[k] = X[hy_p(base + S * k)];
        if (!INV) { dft8(a); cpx w = w1;
#pragma unroll
            for (int q = 1; q < 8; ++q) { a[q] = cmul(a[q], w); w = cmul(w, w1); }
        } else { cpx w = w1;
#pragma unroll
            for (int q = 1; q < 8; ++q) { a[q] = cmulc(a[q], w); w = cmul(w, w1); }
            cconj<8>(a); dft8(a); cconj<8>(a); }
#pragma unroll
        for (int k = 0; k < 8; ++k) X[hy_p(base + S * k)] = a[k]; }
}
__device__ __forceinline__ void hy_pass4(LAS cpx* X, int tid, const cpx* spec) {
#pragma unroll
    for (int h = 0; h < 2; ++h) { const int g = tid + 512 * h; cpx a[8];
#pragma unroll
        for (int k = 0; k < 8; ++k) a[k] = X[hy_p(8 * g + k)];
        dft8(a);
        if (spec) {
#pragma unroll
            for (int k2 = 0; k2 < 4; ++k2) { const f32x4 s4 = *(const GAS f32x4*)(spec + 8 * g + 2 * k2); a[2 * k2] = cmul(a[2 * k2], (cpx){s4.x, s4.y}); a[2 * k2 + 1] = cmul(a[2 * k2 + 1], (cpx){s4.z, s4.w}); }
            cconj<8>(a); dft8(a); cconj<8>(a); }
#pragma unroll
        for (int k = 0; k < 8; ++k) X[hy_p(8 * g + k)] = a[k]; }
}
__device__ __forceinline__ void hy_conv_fft(LAS cpx* X, const LAS cpx* TW, int tid, const cpx* spec) {
    hy_pass1<false, true>(X, TW, tid); __syncthreads();
    hy_pass8<false, 64, 16>(X, TW, tid); __syncthreads();
    hy_pass8<false, 8, 128>(X, TW, tid); __syncthreads();
    hy_pass4(X, tid, spec); __syncthreads();
    hy_pass8<true, 8, 128>(X, TW, tid); __syncthreads();
    hy_pass8<true, 64, 16>(X, TW, tid); __syncthreads();
    hy_pass1<true, true>(X, TW, tid); __syncthreads();
}

__device__ __forceinline__ void phase_hy_spec(Frame& F, int li) { WS_DECL; frame_refresh(F);
    LAS cpx* X = (LAS cpx*)(F.lds + HY_X); const LAS cpx* TW = (const LAS cpx*)(F.lds + HY_TW); LAS float* W3 = (LAS float*)(F.lds + HY_W3);
    const int tid = F.tid; const float* w3 = in_ptr(I_HW3) + (size_t)li * 64 * 1024; const float* H2 = WSP(float, WS_H2L) + (size_t)li * SEQ * 64; cpx* SPEC = WSP(cpx, WS_SPEC);
    __syncthreads();
    hy_build_tw(F);
    for (int item = blockIdx.x; item < 512; item += F.G) {
        const int o = item >> 8, ch = item & 255;
        __syncthreads();
        if (tid < 128) { const int dir = tid >> 6, j = tid & 63; W3[tid] = w3[(size_t)j * 1024 + o * 512 + dir * 256 + ch]; }
        __syncthreads();
        const float delta = hy_delta(ch);
#pragma unroll 1
        for (int i = 0; i < 8; ++i) { const int l = tid + 512 * i; const float* hr = H2 + (size_t)l * 64; float hf = 0.f, hb = 0.f;
#pragma unroll
            for (int j4 = 0; j4 < 16; ++j4) { const f32x4 h4 = *(const GAS f32x4*)(hr + 4 * j4);
                hf += h4.x * W3[4 * j4] + h4.y * W3[4 * j4 + 1] + h4.z * W3[4 * j4 + 2] + h4.w * W3[4 * j4 + 3]; hb += h4.x * W3[64 + 4 * j4] + h4.y * W3[64 + 4 * j4 + 1] + h4.z * W3[64 + 4 * j4 + 2] + h4.w * W3[64 + 4 * j4 + 3]; }
            const float win = (expf(-((float)l * (1.f / 4095.f)) * delta) + 0.05f) * (1.f / 8192.f);
            X[hy_p(l)] = (cpx){hf * win, 0.f};
            if (l == 0) X[hy_p(4096)] = (cpx){0.f, 0.f}; else X[hy_p(8192 - l)] = (cpx){hb * win, 0.f}; }
        __syncthreads();
        hy_pass1<false, false>(X, TW, tid); __syncthreads();
        hy_pass8<false, 64, 16>(X, TW, tid); __syncthreads();
        hy_pass8<false, 8, 128>(X, TW, tid); __syncthreads();
        hy_pass4(X, tid, nullptr); __syncthreads();
        cpx* dst = SPEC + (size_t)item * 8192;
#pragma unroll
        for (int i = 0; i < 16; ++i) *(GAS cpx*)(dst + tid + 512 * i) = X[hy_p(tid + 512 * i)];
    }
    __syncthreads();
}

__device__ __forceinline__ void hy_conv8(const bf16* row, int t0, int Ls, float w0, float w1, float w2, float bias, float (&out)[8]) {
    const v4u raw = *(const GAS v4u*)(row + t0); float p[10];
    p[0] = t0 > 0 ? bf2f(row[t0 - 1]) : 0.f; p[9] = t0 + 8 < Ls ? bf2f(row[t0 + 8]) : 0.f;
    p[1] = bflo(raw.x); p[2] = bfhi(raw.x); p[3] = bflo(raw.y); p[4] = bfhi(raw.y); p[5] = bflo(raw.z); p[6] = bfhi(raw.z); p[7] = bflo(raw.w); p[8] = bfhi(raw.w);
#pragma unroll
    for (int e = 0; e < 8; ++e) out[e] = bias + w0 * p[e] + w1 * p[e + 1] + w2 * p[e + 2];
}

__device__ __forceinline__ void phase_hy_conv(Frame& F, int li) { WS_DECL; frame_refresh(F);
    LAS cpx* X = (LAS cpx*)(F.lds + HY_X); const LAS cpx* TW = (const LAS cpx*)(F.lds + HY_TW);
    const int tid = F.tid; const bf16* HT = WSP(bf16, WS_HT); bf16* HOT = WSP(bf16, WS_HOT); const cpx* SPEC = WSP(cpx, WS_SPEC);
    const float* cw = in_ptr(I_HCW) + li * 3 * 768; const float* cb = in_ptr(I_HCB) + li * 768; const float* dsk = in_ptr(I_HD) + li * 512;
    __syncthreads();
    hy_build_tw(F);
    for (int item = blockIdx.x; item < 2048; item += F.G) {
        const int ch = item >> 3, bp = item & 7; const int t0 = 8 * tid;
        float v[2][8], x1[2][8], x2[2][8];
#pragma unroll
        for (int q = 0; q < 2; ++q) { const size_t boff = (size_t)(2 * bp + q) * SEQ;
            hy_conv8(HT + (size_t)ch * NT + boff, t0, SEQ, cw[ch], cw[768 + ch], cw[1536 + ch], cb[ch], v[q]);
            hy_conv8(HT + (size_t)(256 + ch) * NT + boff, t0, SEQ, cw[256 + ch], cw[768 + 256 + ch], cw[1536 + 256 + ch], cb[256 + ch], x1[q]);
            hy_conv8(HT + (size_t)(512 + ch) * NT + boff, t0, SEQ, cw[512 + ch], cw[768 + 512 + ch], cw[1536 + 512 + ch], cb[512 + ch], x2[q]); }
        const float d0 = dsk[ch], d1 = dsk[256 + ch];
        __syncthreads();
#pragma unroll
        for (int e = 0; e < 8; ++e) X[hy_p(t0 + e)] = (cpx){v[0][e], v[1][e]};
        __syncthreads();
        hy_conv_fft(X, TW, tid, SPEC + (size_t)ch * 8192);
        float u[2][8];
#pragma unroll
        for (int e = 0; e < 8; ++e) { const cpx y = X[hy_p(t0 + e)]; u[0][e] = x1[0][e] * (y.x + v[0][e] * d0); u[1][e] = x1[1][e] * (y.y + v[1][e] * d0); X[hy_p(t0 + e)] = (cpx){u[0][e], u[1][e]}; }
        __syncthreads();
        hy_conv_fft(X, TW, tid, SPEC + (size_t)(256 + ch) * 8192);
#pragma unroll
        for (int q = 0; q < 2; ++q) { float o[8];
#pragma unroll
            for (int e = 0; e < 8; ++e) { const cpx y = X[hy_p(t0 + e)]; o[e] = x2[q][e] * ((q == 0 ? y.x : y.y) + u[q][e] * d1); }
            v4u w; w.x = pk2(o[0], o[1]); w.y = pk2(o[2], o[3]); w.z = pk2(o[4], o[5]); w.w = pk2(o[6], o[7]);
            *(GAS v4u*)(HOT + (size_t)ch * NT + (size_t)(2 * bp + q) * SEQ + t0) = w; }
    }
    __syncthreads();
}

__device__ __forceinline__ void phase_hy_ctx(Frame& F, int li) { WS_DECL; frame_refresh(F);
    LAS float* KF = (LAS float*)F.lds;
    LAS float* SIG = KF + 1024;
    LAS float* W3 = KF + 2048;
    const int tid = F.tid; const bf16* HT = WSP(bf16, WS_HT); bf16* HOT = WSP(bf16, WS_HOT);
    const float* w3 = in_ptr(I_HW3) + (size_t)li * 64 * 1024; const float* H2 = WSP(float, WS_H2C) + (size_t)li * LCX * 64;
    const float* cw = in_ptr(I_HCW) + li * 3 * 768; const float* cb = in_ptr(I_HCB) + li * 768; const float* dsk = in_ptr(I_HD) + li * 512;
    for (int ch = blockIdx.x; ch < 256; ch += F.G) {
        __syncthreads();
        if (tid < 256) { const int od = tid >> 6, j = tid & 63; W3[tid] = w3[(size_t)j * 1024 + (od >> 1) * 512 + (od & 1) * 256 + ch]; }
        __syncthreads();
        { const int o = tid >> 8, l = tid & 255; const float* hr = H2 + (size_t)l * 64; float hf = 0.f, hb = 0.f;
          for (int j = 0; j < 64; ++j) { const float hv = hr[j]; hf += hv * W3[(2 * o) * 64 + j]; hb += hv * W3[(2 * o + 1) * 64 + j]; }
          const float win = expf(-((float)l * (1.f / 255.f)) * hy_delta(ch)) + 0.05f;
          KF[(2 * o) * 256 + l] = hf * win; KF[(2 * o + 1) * 256 + l] = hb * win; }
        __syncthreads();
        const int q = tid >> 8, t = tid & 255; const float d0 = dsk[ch], d1 = dsk[256 + ch];
        for (int bp = 0; bp < 8; ++bp) { const int b = 2 * bp + q; const size_t off = (size_t)NL + (size_t)b * LCX;
            float zz[3];
#pragma unroll
            for (int k = 0; k < 3; ++k) { const int c = 256 * k + ch; const bf16* row = HT + (size_t)c * NT + off;
                const float pm = t > 0 ? bf2f(row[t - 1]) : 0.f, p0 = bf2f(row[t]), pp = t + 1 < LCX ? bf2f(row[t + 1]) : 0.f;
                zz[k] = cb[c] + cw[c] * pm + cw[768 + c] * p0 + cw[1536 + c] * pp; }
            SIG[q * 256 + t] = zz[0];
            __syncthreads();
            float y = 0.f;
            for (int s = 0; s < 256; ++s) { const int lag = t - s; const float kv = lag >= 0 ? KF[lag] : KF[256 - lag]; y += kv * SIG[q * 256 + s]; }
            const float u = zz[1] * (y + zz[0] * d0);
            __syncthreads();
            SIG[q * 256 + t] = u;
            __syncthreads();
            float y2 = 0.f;
            for (int s = 0; s < 256; ++s) { const int lag = t - s; const float kv = lag >= 0 ? KF[512 + lag] : KF[768 - lag]; y2 += kv * SIG[q * 256 + s]; }
            HOT[(size_t)ch * NT + off + t] = (bf16)f2bf(zz[2] * (y2 + u * d1));
            __syncthreads();
        }
    }
    __syncthreads();
}

constexpr int HF_LD = 72;
__device__ __forceinline__ void phase_fin_hyena(Frame& F, int li) { WS_DECL; frame_refresh(F);
    LAS bf16* T = (LAS bf16*)F.lds;
    const int nrows = li == DEPTH - 1 ? NL : NT; const int tid = F.tid, lane = F.lane, wave = F.wave; const bf16* HOT = WSP(bf16, WS_HOT); bf16* MIX = WSP(bf16, WS_A1);
    const f32x4 g4 = *(const GAS f32x4*)(in_ptr(I_HON) + li * 256 + 4 * lane);
    for (int item = blockIdx.x; item < nrows / 64; item += F.G) { const int m0 = item * 64;
        __syncthreads();
        { const int ch = tid >> 1, hf = tid & 1; const bf16* src = HOT + (size_t)ch * NT + m0 + 32 * hf;
#pragma unroll
          for (int k = 0; k < 4; ++k) *(LAS v4u*)(T + ch * HF_LD + 32 * hf + 8 * k) = *(const GAS v4u*)(src + 8 * k); }
        __syncthreads();
        for (int i = 0; i < 8; ++i) { const int tl = wave * 8 + i;
            f32x4 x; x.x = bf2f(T[(4 * lane) * HF_LD + tl]); x.y = bf2f(T[(4 * lane + 1) * HF_LD + tl]); x.z = bf2f(T[(4 * lane + 2) * HF_LD + tl]); x.w = bf2f(T[(4 * lane + 3) * HF_LD + tl]);
            const float r = rsqrtf(wave_sum(x.x * x.x + x.y * x.y + x.z * x.z + x.w * x.w) * (1.f / 256.f) + 1e-6f);
            v2u o; o.x = pk2(x.x * r * g4.x, x.y * r * g4.y); o.y = pk2(x.z * r * g4.z, x.w * r * g4.w); *(GAS v2u*)(MIX + (size_t)(m0 + tl) * D + 768 + 4 * lane) = o; }
    }
    __syncthreads();
}
#define MIX_HYENA 1

__global__ void __launch_bounds__(NTHR, 2) mk_fwd(Args a) {
    extern __shared__ __attribute__((aligned(16))) unsigned char lds_raw[];
    Frame F; F.lds = (LAS unsigned char*)lds_raw; F.tid = threadIdx.x; F.lane = F.tid & 63; F.wave = __builtin_amdgcn_readfirstlane(F.tid >> 6); F.G = gridDim.x;
    for (int u = F.tid; u < (LDS_BYTES - LDSCTL_OFF) / 4; u += NTHR) ((LAS unsigned*)(F.lds + LDSCTL_OFF))[u] = 0u;
    __syncthreads();
    XcdBarrier bar = xcd_barrier_post((unsigned*)(ws_ptr() + WS_CTL) + CW_BAR, (volatile LAS unsigned*)(F.lds + LDSCTL_OFF) + 8);
#define GRID_BAR() xcd_barrier(bar)

    phase_pro0(F);
    phase_pro0b(F);
    phase_pro0c(F);
    phase_pro0d(F);
    phase_pro0e(F);
    GRID_BAR();
    phase_hin0(F);
    GRID_BAR();
    for (int li = 0; li < DEPTH; ++li) {
        const int nrows = li == DEPTH - 1 ? NL : NT; unsigned char* const ws = ws_ptr();
        phase_hy_spec(F, li);
        { pg8::Gemm g{WSP(bf16, WS_A1), WSP(bf16, WS_WINT) + (size_t)li * PCOLS * D, NT, PCOLS, D}; pg8::StaticOrder S; S.init(NT, PCOLS, F.G, (int)blockIdx.x);
          pg8::EpiStore E{WSP(bf16, WS_P), PCOLS, 0, PCOLS / 256};
          pg8::gemm_phase<pg8::EpiStore, pg8::StaticOrder, true, true>(F.lds, g, S, E); }
#if MIX_HYENA
        { pg8::Gemm g{WSP(bf16, WS_WHYT) + (size_t)li * HYC * D, WSP(bf16, WS_A1), HYC, NT, D}; pg8::StaticOrder S; S.init(HYC, NT, F.G, (int)blockIdx.x);
          pg8::EpiStore E{WSP(bf16, WS_HT), NT, 0, NT / 256};
          pg8::gemm_phase<pg8::EpiStore, pg8::StaticOrder, true, true>(F.lds, g, S, E); }
#endif
        GRID_BAR();
        phase_rwkv_r0(F, li);
        phase_mla_prep(F, li);
        phase_lru<1>(F, li);
        __syncthreads();
        phase_hy_conv(F, li);
        if (li < DEPTH - 1) phase_hy_ctx(F, li);
        GRID_BAR();
        phase_rwkv_scan(F, li);
        __syncthreads();
        phase_attn(F, li);
        __syncthreads();
        phase_lru<3>(F, li);
        GRID_BAR();
        phase_fin_mla(F, li);
        phase_fin_rwkv(F, li); phase_fin_hyena(F, li);
        GRID_BAR();
        { pg8::Gemm g{WSP(bf16, WS_A1), WSP(bf16, WS_WOUTT) + (size_t)li * D * D, nrows, D, D}; pg8::StaticOrder S; S.init(nrows, D, F.G, (int)blockIdx.x);
          pg8::EpiStore E{WSP(bf16, WS_Y), D, 0, D / 256};
          pg8::gemm_phase<pg8::EpiStore, pg8::StaticOrder, true, true>(F.lds, g, S, E); }
        GRID_BAR();
        phase_ln1<true>(F, li);
        if (li & 1) phase_moe_weights(F, li);
        GRID_BAR();
        if (!(li & 1)) {
            const int j = li >> 1;
            { pg8::Gemm g{WSP(bf16, WS_A1), WSP(bf16, WS_WGUT) + (size_t)j * 2 * FFD * D, nrows, 2 * FFD, D}; pg8::StaticOrder S; S.init(nrows, 2 * FFD, F.G, (int)blockIdx.x);
              pg8::EpiSwiGLU E{WSP(bf16, WS_H), FFD, 0, 2 * FFD / 256};
              pg8::gemm_phase<pg8::EpiSwiGLU, pg8::StaticOrder, true, true>(F.lds, g, S, E); }
            GRID_BAR();
            { pg8::Gemm g{WSP(bf16, WS_H), WSP(bf16, WS_WDT) + (size_t)j * D * FFD, nrows, D, FFD}; pg8::StaticOrder S; S.init(nrows, D, F.G, (int)blockIdx.x);
              pg8::EpiStore E{WSP(bf16, WS_Y), D, 0, D / 256};
              pg8::gemm_phase<pg8::EpiStore, pg8::StaticOrder, true, true>(F.lds, g, S, E); }
            GRID_BAR();
        } else {
            phase_moe_slots(F, li);
            GRID_BAR();
            const int ntiles = ((LAS int*)(F.lds + LDS_MOEI))[48];
            const PG8_LAS unsigned char* tile_e = (const PG8_LAS unsigned char*)(F.lds + LDS_TILEE);
#pragma unroll 1
            for (int ch = 0; ch < MOE_NCHUNK; ++ch) {
                const int t0 = ch * MOE_CHUNK_TILES; int nM = ntiles - t0; nM = nM < 0 ? 0 : (nM > MOE_CHUNK_TILES ? MOE_CHUNK_TILES : nM);
                { pg8::Gemm g{WSP(bf16, WS_XS), WSP(bf16, WS_MGU), 0, 0, D}; pg8::MoeOrder S; S.init(nM, 2 * FFE / 256, F.G, (int)blockIdx.x, t0, t0, tile_e);
                  pg8::EpiSwiGLU E{WSP(bf16, WS_HM), FFE, t0, 2 * FFE / 256};
                  pg8::gemm_phase<pg8::EpiSwiGLU, pg8::MoeOrder, true, true>(F.lds, g, S, E); }
                GRID_BAR();
                { pg8::Gemm g{WSP(bf16, WS_HM), WSP(bf16, WS_MD), 0, 0, FFE}; pg8::MoeOrder S; S.init(nM, D / 256, F.G, (int)blockIdx.x, t0, 0, tile_e);
                  pg8::EpiStore E{WSP(bf16, WS_XS), D, t0, D / 256};
                  pg8::gemm_phase<pg8::EpiStore, pg8::MoeOrder, true, true>(F.lds, g, S, E); }
                GRID_BAR();
            }
        }
        phase_ln2<true>(F, li);
        if (li < DEPTH - 1) GRID_BAR();
    }
}

extern "C" void kernel_launch(void* const* d_in, const int* in_sizes, int n_in, void* d_out, int out_size, void* d_ws, size_t ws_size, hipStream_t stream) {
    static int grid = 0;
    if (grid == 0) {
        if (n_in != N_INPUTS || out_size != NL * D || ws_size < WS_END) { fprintf(stderr, "kernel_launch: unexpected shapes (n_in %d out %d ws %zu)\n", n_in, out_size, ws_size); grid = -1; return; }
        int dev = 0, cus = 0, per_cu = 0;
        if (hipGetDevice(&dev) != hipSuccess || hipDeviceGetAttribute(&cus, hipDeviceAttributeMultiprocessorCount, dev) != hipSuccess) { grid = -1; return; }
        if (hipFuncSetAttribute((const void*)mk_fwd, hipFuncAttributeMaxDynamicSharedMemorySize, LDS_BYTES) != hipSuccess) { fprintf(stderr, "kernel_launch: hipFuncSetAttribute failed\n"); grid = -1; return; }
        if (hipOccupancyMaxActiveBlocksPerMultiprocessor(&per_cu, (const void*)mk_fwd, NTHR, LDS_BYTES) != hipSuccess || per_cu < 1) fprintf(stderr, "kernel_launch: occupancy query reports %d\n", per_cu);
        (void)hipGetLastError();
        grid = cus > 256 ? 256 : cus;
    }
    if (grid < 0) return;
    if (hipMemsetAsync((char*)d_ws + WS_CTL, 0, CTL_ZERO_BYTES, stream) != hipSuccess) return;
    Args a{};
    for (int i = 0; i < N_INPUTS; ++i) a.in[i] = (const float*)d_in[i];
    a.out = (float*)d_out; a.ws = (unsigned char*)d_ws;
    hipLaunchKernelGGL(mk_fwd, dim3(grid), dim3(NTHR), LDS_BYTES, stream, a);
    const hipError_t le = hipPeekAtLastError();
    if (le != hipSuccess) fprintf(stderr, "kernel_launch: launch failed: %s\n", hipGetErrorName(le));
}
```

```cpp
#include <hip/hip_runtime.h>
#include <cstdio>
#include <cstdint>
#define GAS __attribute__((address_space(1)))
#define LAS __attribute__((address_space(3)))
namespace pg8 {
#define PG8_LAS __attribute__((address_space(3)))
typedef unsigned short bf16_t;
typedef short bf16x8 __attribute__((ext_vector_type(8)));
typedef float f32x4 __attribute__((ext_vector_type(4)));
typedef unsigned u32x4 __attribute__((ext_vector_type(4)));
constexpr int BM = 256, BK = 64, HALF = 128, HTB = HALF * BK * 2  , STAGE_BYTES = 8 * HTB, NXCD = 8, WGM = 8;

__host__ __device__ __forceinline__ int lds_byte(int r, int c) { const int st = (r >> 4) * 2 + (c >> 5), rr = r & 15, cc = c & 31, ob = rr * 64 + cc * 2; return st * 1024 + (ob ^ (((ob >> 9) & 1) << 5)); }
__host__ __device__ __forceinline__ void stage_rc(int b, int& R, int& C) { const int st = b / 1024, sb = b % 1024, swz = sb ^ (((sb >> 9) & 1) << 5); R = (st >> 1) * 16 + swz / 64; C = (st & 1) * 32 + (swz % 64) / 2; }
__host__ __device__ __forceinline__ int perm32(int rho) { const int n = rho >> 4, i = rho & 15; return 8 * (i >> 2) + 4 * n + (i & 3); }

struct Unit { int pm, pn; };
struct Gemm { const bf16_t* A; const bf16_t* Bt; int M, N, K; };

struct StaticOrder {
    int nM, nN, nwg, G, c;
    __host__ __device__ void init(int M, int N, int G_, int c_) { nM = M / BM; nN = N / BM; nwg = nM * nN; G = G_; c = c_; }
    __host__ __device__ bool next(int i, Unit& u) const {
        const long L = (long)i * G + c; if (L >= nwg) return false;
        int wgid = (int)L; { const int q = nwg / NXCD, r = nwg % NXCD, xcd = wgid % NXCD, off = wgid / NXCD; wgid = (xcd < r ? xcd * (q + 1) : r * (q + 1) + (xcd - r) * q) + off; }
        const int nig = WGM * nN, gid = wgid / nig, fm = gid * WGM, gsz = (nM - fm) < WGM ? (nM - fm) : WGM;
        u.pm = fm + ((wgid % nig) % gsz); u.pn = (wgid % nig) / gsz; return true;
    }
    __device__ __forceinline__ void a_ready(const Unit&) const {}
    __device__ __forceinline__ void done(const Unit&) const {}
};

__device__ __forceinline__ unsigned cvt_pk_bf16(float lo, float hi) { unsigned r; asm volatile("v_cvt_pk_bf16_f32 %0, %1, %2" : "=v"(r) : "v"(lo), "v"(hi)); return r; }
typedef float f32x2 __attribute__((ext_vector_type(2)));
__device__ __forceinline__ f32x2 gelu_pk(f32x2 v) {
    const f32x2 av = __builtin_elementwise_abs(v), d = av * 0.2316418882f + 1.0f;
    f32x2 t; t.x = __builtin_amdgcn_rcpf(d.x); t.y = __builtin_amdgcn_rcpf(d.y);
    f32x2 q = t * 0.5307027145f + (-0.7265760135f); q = q * t + 0.7107068705f; q = q * t + (-0.142248368f); q = q * t + 0.127414796f; q = q * t;
    const f32x2 s = (v * v) * (-0.72134752044f);
    f32x2 e; e.x = __builtin_amdgcn_exp2f(s.x); e.y = __builtin_amdgcn_exp2f(s.y);
    const f32x2 m = v * (q * e), r = v - m;
    f32x2 o; o.x = v.x < 0.f ? m.x : r.x; o.y = v.y < 0.f ? m.y : r.y; return o;
}

template <int ACT  > struct EpiBf16 {
    static constexpr bool PERM = true, AFTER_DRAIN = false; static_assert(ACT == 0 || ACT == 1, "EpiBf16: ACT is 0 (none) or 1 (gelu_pk)");
    bf16_t* O; int ldc; const float* bias; int split_cols; size_t split_stride; float scale0;
    __device__ __forceinline__ void operator()(const f32x4 (&acc)[2][2][4][2], const Unit& u, int wr, int wc, int fr, int fq) const {
        const int row0 = u.pm * BM + wr * 64 + fr; int colt = u.pn * BM; bf16_t* base = O;
        float sc = 1.f; if (split_cols) { const int t = colt / split_cols; base += (size_t)t * split_stride; colt -= t * split_cols; if (t == 0) sc = scale0; }
        const int col0 = colt + wc * 32 + 8 * fq, bcol0 = u.pn * BM + wc * 32 + 8 * fq;
        f32x4 bv[2][2];
#pragma unroll
        for (int bj = 0; bj < 2; ++bj)
#pragma unroll
            for (int n = 0; n < 2; ++n) bv[bj][n] = bias ? *(const f32x4*)(bias + bcol0 + bj * HALF + 4 * n) : (f32x4){0.f, 0.f, 0.f, 0.f};
#pragma unroll
        for (int ai = 0; ai < 2; ++ai)
#pragma unroll
            for (int m = 0; m < 4; ++m) { bf16_t* rowp = base + (size_t)(row0 + ai * HALF + m * 16) * ldc + col0;
#pragma unroll
                for (int bj = 0; bj < 2; ++bj) { f32x4 v0 = acc[ai][bj][m][0] + bv[bj][0], v1 = acc[ai][bj][m][1] + bv[bj][1];
                    if (ACT == 1) { f32x2 a = gelu_pk((f32x2){v0[0], v0[1]}), b = gelu_pk((f32x2){v0[2], v0[3]}), c = gelu_pk((f32x2){v1[0], v1[1]}), d = gelu_pk((f32x2){v1[2], v1[3]});
                        v0 = (f32x4){a.x, a.y, b.x, b.y}; v1 = (f32x4){c.x, c.y, d.x, d.y}; }
                    v0 = v0 * sc; v1 = v1 * sc; u32x4 w; w.x = cvt_pk_bf16(v0[0], v0[1]); w.y = cvt_pk_bf16(v0[2], v0[3]); w.z = cvt_pk_bf16(v1[0], v1[1]); w.w = cvt_pk_bf16(v1[2], v1[3]);
                    *(u32x4*)(rowp + bj * HALF) = w; } }
    }
};
template <class Epi, class Sched, bool ALIGN_EPI = false, bool SP2 = false>
__device__ __forceinline__ void gemm_phase(PG8_LAS unsigned char* lds, const Gemm g, const Sched& S, const Epi& E) {
    int tid_ = threadIdx.x; asm volatile("" : "+v"(tid_));
    const int tid = tid_, wid = __builtin_amdgcn_readfirstlane(tid >> 6), lane = tid & 63, wr = wid >> 2, wc = wid & 3, fr = lane & 15, fq = lane >> 4;
    const int K = g.K, nt = K / BK;
    unsigned voffA[2], voffB[2];
#pragma unroll
    for (int i = 0; i < 2; ++i) { int R, C; stage_rc(tid * 16 + i * 8192, R, C); const int Rb = Epi::PERM ? ((R & ~31) + perm32(R & 31)) : R;
        voffA[i] = (unsigned)(R * K + C) * 2u; voffB[i] = (unsigned)(Rb * K + C) * 2u; }
    const size_t kstep = (size_t)(BK * 2);
    const size_t hstep = (size_t)HALF * K * 2;
    const size_t tstep = 2 * hstep;
    const unsigned ldsw = (unsigned)wid * 1024u;
    const int aoff = lds_byte(wr * 64 + fr, fq * 8), boff = lds_byte(wc * 32 + fr, fq * 8);
#define PG8_SA(b, h) (((b) * 2 + (h)) * HTB)
#define PG8_SB(b, h) ((4 + (b) * 2 + (h)) * HTB)
#define PG8_STAGE(bufoff, gbase, voff) do { _Pragma("unroll") for (int _i = 0; _i < 2; ++_i) \
        __builtin_amdgcn_global_load_lds((const unsigned*)((const char*)(gbase) + (voff)[_i]), (PG8_LAS unsigned*)(lds + (bufoff) + ldsw + _i * 8192), 16, 0, 0); } while (0)
#define PG8_LDA(dst, b, h) do { _Pragma("unroll") for (int m = 0; m < 4; ++m) _Pragma("unroll") for (int k = 0; k < 2; ++k) dst[m][k] = *(const PG8_LAS bf16x8*)(lds + PG8_SA(b, h) + aoff + m * 2048 + k * 1024); } while (0)
#define PG8_LDB(dst, b, h) do { _Pragma("unroll") for (int n = 0; n < 2; ++n) _Pragma("unroll") for (int k = 0; k < 2; ++k) dst[n][k] = *(const PG8_LAS bf16x8*)(lds + PG8_SB(b, h) + boff + n * 2048 + k * 1024); } while (0)
#define PG8_MMA(ai, bj, At, Bt) do { __builtin_amdgcn_s_setprio(1); _Pragma("unroll") for (int m = 0; m < 4; ++m) _Pragma("unroll") for (int n = 0; n < 2; ++n) _Pragma("unroll") for (int k = 0; k < 2; ++k) \
        acc[ai][bj][m][n] = __builtin_amdgcn_mfma_f32_16x16x32_bf16(Bt[n][k], At[m][k], acc[ai][bj][m][n], 0, 0, 0); __builtin_amdgcn_s_setprio(0); } while (0)
#define PG8_WAIT_V(n) asm volatile("s_waitcnt vmcnt(" #n ")" ::: "memory")
#define PG8_WAIT_L(n) asm volatile("s_waitcnt lgkmcnt(" #n ")" ::: "memory")
#define PG8_BAR __builtin_amdgcn_s_barrier()
#define PG8_SCHED __builtin_amdgcn_sched_barrier(0)
    Unit cur, nxt; int ui = 0;
    if (!S.next(0, cur)) return;
    f32x4 acc[2][2][4][2];
#pragma unroll
    for (int a = 0; a < 2; ++a)
#pragma unroll
        for (int b = 0; b < 2; ++b)
#pragma unroll
            for (int m = 0; m < 4; ++m)
#pragma unroll
                for (int n = 0; n < 2; ++n) acc[a][b][m][n] = (f32x4){0.f, 0.f, 0.f, 0.f};
    bf16x8 At[4][2], B0[2][2], B1[2][2];
    const char* cA = (const char*)g.A + (size_t)cur.pm * tstep; const char* cB = (const char*)g.Bt + (size_t)cur.pn * tstep;
    S.a_ready(cur);
    if constexpr (SP2) {
        PG8_STAGE(PG8_SB(0, 0), cB, voffB); PG8_STAGE(PG8_SB(0, 1), cB + hstep, voffB); PG8_STAGE(PG8_SA(0, 0), cA, voffA); PG8_STAGE(PG8_SA(0, 1), cA + hstep, voffA);
        if (wr == 1) PG8_BAR;
        PG8_WAIT_V(2); PG8_BAR;
        PG8_STAGE(PG8_SB(1, 0), cB + kstep, voffB); PG8_STAGE(PG8_SA(1, 0), cA + kstep, voffA); PG8_STAGE(PG8_SB(1, 1), cB + hstep + kstep, voffB);
        PG8_WAIT_V(6); PG8_BAR;
    } else {
        PG8_STAGE(PG8_SB(0, 0), cB, voffB); PG8_STAGE(PG8_SA(0, 0), cA, voffA); PG8_STAGE(PG8_SB(0, 1), cB + hstep, voffB); PG8_STAGE(PG8_SA(0, 1), cA + hstep, voffA);
        if (wr == 1) PG8_BAR;
        PG8_WAIT_V(4); PG8_BAR;
        PG8_STAGE(PG8_SB(1, 0), cB + kstep, voffB); PG8_STAGE(PG8_SA(1, 0), cA + kstep, voffA); PG8_STAGE(PG8_SB(1, 1), cB + hstep + kstep, voffB);
        PG8_WAIT_V(6); PG8_BAR;
    }
    for (;;) {
        const bool has_next = S.next(ui + 1, nxt);
        const char* nA = has_next ? (const char*)g.A + (size_t)nxt.pm * tstep : cA; const char* nB = has_next ? (const char*)g.Bt + (size_t)nxt.pn * tstep : cB;
        for (int t = 0; t < nt; t += 2) {
            const bool last = (t == nt - 2);
            const char* a1 = cA + (size_t)(t + 1) * kstep;
            const char* a2 = last ? nA : cA + (size_t)(t + 2) * kstep; const char* b2 = last ? nB : cB + (size_t)(t + 2) * kstep;
            const char* a3 = a2 + kstep; const char* b3 = b2 + kstep;
            if (last && has_next) S.a_ready(nxt);
            if constexpr (SP2) {
            PG8_LDB(B0, 0, 0); PG8_LDB(B1, 0, 1); PG8_SCHED; PG8_LDA(At, 0, 0); PG8_STAGE(PG8_SA(1, 1), a1 + hstep, voffA);
            PG8_WAIT_V(8); PG8_WAIT_L(0); PG8_BAR; PG8_MMA(0, 0, At, B0); PG8_MMA(0, 1, At, B1); PG8_BAR; PG8_SCHED;
            PG8_LDA(At, 0, 1); PG8_STAGE(PG8_SB(0, 0), b2, voffB); PG8_STAGE(PG8_SB(0, 1), b2 + hstep, voffB); PG8_STAGE(PG8_SA(0, 0), a2, voffA);
            PG8_WAIT_V(8); PG8_WAIT_L(0); PG8_BAR; PG8_MMA(1, 0, At, B0); PG8_MMA(1, 1, At, B1); PG8_BAR; PG8_SCHED;
            PG8_LDB(B0, 1, 0); PG8_LDB(B1, 1, 1); PG8_SCHED; PG8_LDA(At, 1, 0); PG8_STAGE(PG8_SA(0, 1), a2 + hstep, voffA);
            PG8_WAIT_V(8); PG8_WAIT_L(0); PG8_BAR; PG8_MMA(0, 0, At, B0); PG8_MMA(0, 1, At, B1); PG8_BAR; PG8_SCHED;
            PG8_LDA(At, 1, 1); PG8_STAGE(PG8_SB(1, 0), b3, voffB); PG8_STAGE(PG8_SB(1, 1), b3 + hstep, voffB); PG8_STAGE(PG8_SA(1, 0), a3, voffA);
            PG8_WAIT_V(8); PG8_WAIT_L(0); PG8_BAR; PG8_MMA(1, 0, At, B0); PG8_MMA(1, 1, At, B1); PG8_BAR; PG8_SCHED;
            } else {
            PG8_LDB(B0, 0, 0); PG8_SCHED; PG8_LDA(At, 0, 0); PG8_STAGE(PG8_SA(1, 1), a1 + hstep, voffA);
            PG8_WAIT_L(8); PG8_BAR; PG8_WAIT_L(0); PG8_MMA(0, 0, At, B0); PG8_BAR; PG8_SCHED;
            PG8_LDB(B1, 0, 1); PG8_STAGE(PG8_SB(0, 0), b2, voffB);
            PG8_BAR; PG8_WAIT_L(0); PG8_MMA(0, 1, At, B1); PG8_BAR;
            PG8_LDA(At, 0, 1); PG8_STAGE(PG8_SA(0, 0), a2, voffA);
            PG8_BAR; PG8_WAIT_L(0); PG8_MMA(1, 0, At, B0); PG8_BAR; PG8_SCHED;
            PG8_STAGE(PG8_SB(0, 1), b2 + hstep, voffB);
            PG8_WAIT_V(6); PG8_BAR; PG8_MMA(1, 1, At, B1); PG8_BAR;
            PG8_LDB(B0, 1, 0); PG8_SCHED; PG8_LDA(At, 1, 0); PG8_STAGE(PG8_SA(0, 1), a2 + hstep, voffA);
            PG8_WAIT_L(8); PG8_BAR; PG8_WAIT_L(0); PG8_MMA(0, 0, At, B0); PG8_BAR; PG8_SCHED;
            PG8_LDB(B1, 1, 1); PG8_STAGE(PG8_SB(1, 0), b3, voffB);
            PG8_BAR; PG8_WAIT_L(0); PG8_MMA(0, 1, At, B1); PG8_BAR;
            PG8_LDA(At, 1, 1); PG8_STAGE(PG8_SA(1, 0), a3, voffA);
            PG8_BAR; PG8_WAIT_L(0); PG8_MMA(1, 0, At, B0); PG8_BAR; PG8_SCHED;
            PG8_STAGE(PG8_SB(1, 1), b3 + hstep, voffB);
            PG8_WAIT_V(6); PG8_BAR; PG8_MMA(1, 1, At, B1); PG8_BAR;
            }
        }
        if constexpr (ALIGN_EPI) { if (wr == 0) PG8_BAR; }
        if constexpr (!Epi::AFTER_DRAIN) { E(acc, cur, wr, wc, fr, fq); S.done(cur); }
        if (!has_next) break;
#pragma unroll
        for (int a = 0; a < 2; ++a)
#pragma unroll
            for (int b = 0; b < 2; ++b)
#pragma unroll
                for (int m = 0; m < 4; ++m)
#pragma unroll
                    for (int n = 0; n < 2; ++n) acc[a][b][m][n] = (f32x4){0.f, 0.f, 0.f, 0.f};
        cur = nxt; cA = nA; cB = nB; ++ui;
        if constexpr (ALIGN_EPI) { if (wr == 1) PG8_BAR; }
    }
    PG8_WAIT_V(0);
    if constexpr (!ALIGN_EPI) { if (wr == 0) PG8_BAR; }
    PG8_BAR;
    if constexpr (Epi::AFTER_DRAIN) { E.fused(acc, cur, wr, wc, fr, fq, lds, wid, lane); S.done(cur); }
#undef PG8_SA
#undef PG8_SB
#undef PG8_STAGE
#undef PG8_LDA
#undef PG8_LDB
#undef PG8_MMA
#undef PG8_WAIT_V
#undef PG8_WAIT_L
#undef PG8_BAR
#undef PG8_SCHED
}
}

typedef unsigned short bf16;
typedef unsigned v4u __attribute__((ext_vector_type(4)));
typedef unsigned v2u __attribute__((ext_vector_type(2)));
typedef float f32x4 __attribute__((ext_vector_type(4)));
typedef float f32x2 __attribute__((ext_vector_type(2)));
typedef float f32x16 __attribute__((ext_vector_type(16)));
typedef short bf16x8 __attribute__((ext_vector_type(8)));
typedef short s16x4 __attribute__((ext_vector_type(4)));
typedef GAS unsigned gu32;

constexpr int D = 1024, NB = 16, SEQ = 4096, LCX = 256, DEPTH = 4;
constexpr int NL = NB * SEQ, NC = NB * LCX, NT = NL + NC;
constexpr int N_IN = 2592, PCOLS = 2048, D_OFF = 1824, HYC = 768;
constexpr int FFD = 2816, FFE = 3584, NE = 8;
constexpr float ALPHA = 1.6817928305074292f;
constexpr int NWAVES = 8, NTHR = 512;
constexpr int KSEQ = SEQ + LCX;

enum { I_X = 0, I_C, I_CTX, I_CCTX, I_ADAW, I_ADAB, I_WIN, I_QNORM, I_KVNORM, I_WUQ, I_WUKV, I_MLAON, I_LCW, I_LCB, I_LWR, I_LBR, I_LWI, I_LBI, I_LLAM, I_LON,
       I_MUP, I_MUN, I_W0, I_WUP, I_A0, I_AUP, I_GUP, I_KK, I_KA, I_RK, I_LNG, I_LNB, I_HCW, I_HCB, I_HW1, I_HB1, I_HW2, I_HB2, I_HW3, I_HD, I_HON,
       I_WOUT, I_LN1G, I_LN1B, I_LN2G, I_LN2B, I_FG, I_FU, I_FD, I_ROUTER, I_MG, I_MU, I_MD, N_INPUTS };

constexpr size_t MiB = 1u << 20;
constexpr size_t WS_CTL = 0, CTL_ZERO_BYTES = 1 * MiB;
constexpr size_t WS_MOD = 1 * MiB;
constexpr size_t WS_ROPE = 3 * MiB;
constexpr size_t WS_H2L = 4 * MiB;
constexpr size_t WS_H2C = 8 * MiB;
constexpr size_t WS_LRUW = 9 * MiB;
constexpr size_t WS_WUQT = 10 * MiB;
constexpr size_t WS_WUKVT = 11 * MiB;
constexpr size_t WS_SUMM = 12 * MiB;
constexpr size_t WS_BON = 17 * MiB;
constexpr size_t WS_TOKE = 20 * MiB;
constexpr size_t WS_TOKG = 21 * MiB;
constexpr size_t WS_TOKS = 22 * MiB;
constexpr size_t WS_BLKCNT = 23 * MiB;
constexpr size_t WS_SPEC = 24 * MiB;
constexpr size_t WS_WINT = 56 * MiB;
constexpr size_t WS_WHYT = 72 * MiB;
constexpr size_t WS_WOUTT = 78 * MiB;
constexpr size_t WS_WGUT = 86 * MiB;
constexpr size_t WS_WDT = 108 * MiB;
constexpr size_t WS_XC = 120 * MiB;
constexpr size_t WS_A1 = 136 * MiB;
constexpr size_t WS_ARENA = 272 * MiB;
constexpr size_t WS_P = WS_ARENA;
constexpr size_t WS_HT = 544 * MiB;
constexpr size_t WS_QB = 646 * MiB;
constexpr size_t WS_KB = 697 * MiB;
constexpr size_t WS_VT = 748 * MiB;
constexpr size_t WS_AO = 782 * MiB;
constexpr size_t WS_HOT = 816 * MiB;
constexpr size_t WS_YR = 850 * MiB;
constexpr size_t WS_Y = 986 * MiB;
constexpr size_t WS_H = WS_ARENA;
constexpr size_t WS_MGU = WS_ARENA;
constexpr size_t WS_MD = 384 * MiB;
constexpr size_t WS_XS = 440 * MiB;
constexpr size_t WS_HM = 716 * MiB;
constexpr size_t WS_END = 1122 * MiB;
constexpr int MOE_MAX_TILES = 552, MOE_NCHUNK = 3, MOE_CHUNK_TILES = 184;
static_assert(WS_HM + (size_t)MOE_CHUNK_TILES * 256 * FFE * 2 <= WS_END, "moe hidden chunk");
static_assert(WS_H + (size_t)NT * FFD * 2 <= WS_QB + 51 * MiB, "dense hidden");

constexpr int CW_BAR = 4096;

constexpr int RING_BYTES = 131072;
constexpr int LDSCTL_OFF = RING_BYTES;
constexpr int LDS_TILEE = LDSCTL_OFF + 256;
constexpr int LDS_MOEI = LDSCTL_OFF + 1024;
constexpr int LDS_BYTES = 147456;

#define LDS_WAIT() asm volatile("s_waitcnt lgkmcnt(0)" ::: "memory")
#define VM_WAIT() asm volatile("s_waitcnt vmcnt(0)" ::: "memory")
__device__ __forceinline__ unsigned f2bf(float f) { unsigned u = __builtin_bit_cast(unsigned, f); return (u + 0x7fffu + ((u >> 16) & 1u)) >> 16; }
__device__ __forceinline__ unsigned pk2(float lo, float hi) { return f2bf(lo) | (f2bf(hi) << 16); }
__device__ __forceinline__ float bf2f(unsigned b) { return __builtin_bit_cast(float, b << 16); }
__device__ __forceinline__ float bflo(unsigned w) { return __builtin_bit_cast(float, w << 16); }
__device__ __forceinline__ float bfhi(unsigned w) { return __builtin_bit_cast(float, w & 0xffff0000u); }
__device__ __forceinline__ float wave_sum(float v) {
#pragma unroll
    for (int o = 1; o < 64; o <<= 1) v += __shfl_xor(v, o);
    return v;
}
__device__ __forceinline__ float sigmoidf_(float x) { return 1.f / (1.f + __expf(-x)); }
#define XB_TMO      128
#define XB_XCNT(j)  (256  + 64 * (j))
#define XB_XSUB(j)  (1280 + 64 * (j))
#define XB_XGEN(j)  (2304 + 64 * (j))
#define XB_TOP      3328
#define XB_TOPGEN   3392
#define XCD_BAR_WORDS 3456
#define XB_SPIN_CAP (1u << 18)

__device__ __forceinline__ unsigned xb_ld(unsigned* p)              { return __hip_atomic_load(p, __ATOMIC_RELAXED, __HIP_MEMORY_SCOPE_AGENT); }
__device__ __forceinline__ unsigned xb_add(unsigned* p, unsigned v) { return __hip_atomic_fetch_add(p, v, __ATOMIC_RELAXED, __HIP_MEMORY_SCOPE_AGENT); }
__device__ __forceinline__ unsigned xb_xcc_id() { return (unsigned)__builtin_amdgcn_s_getreg((3 << 11) | 20) & 0xFu; }
#define XB_SPIN(cond, bar) do { unsigned _sp = 0; while (cond) { __builtin_amdgcn_s_sleep(1); \
    if ((++_sp & 255u) == 0u) { if (xb_ld(&(bar)[XB_TMO])) break; if (_sp > XB_SPIN_CAP) { atomicAdd(&(bar)[XB_TMO], 1u); break; } } } } while (0)

struct XcdBarrier {
    unsigned* bar; unsigned x;
    volatile LAS unsigned* st;
};

__device__ __forceinline__ XcdBarrier xcd_barrier_post(unsigned* bar, volatile LAS unsigned* st) {
    XcdBarrier b; b.bar = bar; b.x = xb_xcc_id(); b.st = st;
    if (threadIdx.x == 0) (void)xb_add(&bar[XB_XCNT(b.x)], 1u);
    return b;
}
__device__ __forceinline__ void xcd_barrier_complete(unsigned* bar, unsigned x, unsigned& nloc, unsigned& nx) {
    const unsigned G = gridDim.x * gridDim.y * gridDim.z;
    unsigned sum, cnt, mine, sp = 0u;
    for (;;) {
        sum = 0u; cnt = 0u; mine = 0u;
#pragma unroll
        for (unsigned j = 0; j < 16; ++j) { const unsigned c = xb_ld(&bar[XB_XCNT(j)]); sum += c; cnt += (c > 0u) ? 1u : 0u; mine = (j == x) ? c : mine; }
        if (sum == G) break;
        __builtin_amdgcn_s_sleep(1);
        if ((++sp & 255u) == 0u) { if (xb_ld(&bar[XB_TMO])) break; if (sp > XB_SPIN_CAP) { atomicAdd(&bar[XB_TMO], 1u); break; } }
    }
    nloc = mine > 0u ? mine : 1u; nx = cnt > 0u ? cnt : 1u;
}

__device__ __forceinline__ void xcd_barrier(const XcdBarrier& b) {
    asm volatile("s_waitcnt vmcnt(0)" ::: "memory");
    __syncthreads();
    if (threadIdx.x == 0) {
        unsigned* bar = b.bar;
        __builtin_amdgcn_s_waitcnt(0);
        unsigned nloc = b.st[0], nx = b.st[1];
        if (nloc == 0u) { xcd_barrier_complete(bar, b.x, nloc, nx); b.st[0] = nloc; b.st[1] = nx; }
        const unsigned old = xb_add(&bar[XB_XSUB(b.x)], 1u);
        const unsigned gen = old / nloc;
        if (old + 1u == (gen + 1u) * nloc) {
            __builtin_amdgcn_fence(__ATOMIC_RELEASE, "agent");
            asm volatile("s_waitcnt vmcnt(0)" ::: "memory");
            const unsigned og = xb_add(&bar[XB_TOP], 1u);
            const unsigned tg = og / nx;
            if (og + 1u == (tg + 1u) * nx) xb_add(&bar[XB_TOPGEN], 1u);
            else XB_SPIN(xb_ld(&bar[XB_TOPGEN]) == tg, bar);
            __builtin_amdgcn_fence(__ATOMIC_ACQUIRE, "agent");
            xb_add(&bar[XB_XGEN(b.x)], 1u);
            asm volatile("s_waitcnt vmcnt(0)" ::: "memory");
        } else {
            XB_SPIN(xb_ld(&bar[XB_XGEN(b.x)]) == gen, bar);
            __builtin_amdgcn_fence(__ATOMIC_ACQUIRE, "agent");
            asm volatile("s_waitcnt vmcnt(0)" ::: "memory");
        }
    }
    __syncthreads();
}

struct Args { const float* in[N_INPUTS]; float* out; unsigned char* ws; };
struct Frame { LAS unsigned char* lds; int tid, lane, wave, G; };
__device__ __forceinline__ void frame_refresh(Frame& F) { int t = threadIdx.x; asm volatile("" : "+v"(t)); F.tid = t; F.lane = t & 63; }
#define CAS __attribute__((address_space(4)))
__device__ __forceinline__ const CAS char* karg() { const CAS char* kp = (const CAS char*)__builtin_amdgcn_kernarg_segment_ptr(); asm volatile("" : "+s"(kp)); return kp; }
__device__ __forceinline__ const float* in_ptr(int i) { return *(const float* const CAS*)(karg() + 8 * i); }
__device__ __forceinline__ float* out_ptr() { return *(float* const CAS*)(karg() + 8 * N_INPUTS); }
__device__ __forceinline__ unsigned char* ws_ptr() { return *(unsigned char* const CAS*)(karg() + 8 * N_INPUTS + 8); }
#define WSP(T, off) ((T*)(ws + (off)))
#define WS_DECL unsigned char* const ws = ws_ptr()

namespace pg8 {
struct EpiStore {
    static constexpr bool PERM = true, AFTER_DRAIN = false;
    bf16_t* O; int ldc; int pm_add; int nN;
    __device__ __forceinline__ void operator()(const f32x4 (&acc)[2][2][4][2], const Unit& u, int wr, int wc, int fr, int fq) const {
        const int row0 = (u.pm + pm_add) * BM + wr * 64 + fr; const int col0 = (u.pn % nN) * BM + wc * 32 + 8 * fq;
#pragma unroll
        for (int ai = 0; ai < 2; ++ai)
#pragma unroll
            for (int m = 0; m < 4; ++m) { bf16_t* rowp = O + (size_t)(row0 + ai * HALF + m * 16) * ldc + col0;
#pragma unroll
                for (int bj = 0; bj < 2; ++bj) { const f32x4 v0 = acc[ai][bj][m][0], v1 = acc[ai][bj][m][1];
                    u32x4 w; w.x = cvt_pk_bf16(v0[0], v0[1]); w.y = cvt_pk_bf16(v0[2], v0[3]); w.z = cvt_pk_bf16(v1[0], v1[1]); w.w = cvt_pk_bf16(v1[2], v1[3]);
                    *(u32x4*)(rowp + bj * HALF) = w; } }
    }
};
__device__ __forceinline__ float silu_mul(float g, float u) { return g * __builtin_amdgcn_rcpf(1.f + __expf(-g)) * u; }
struct EpiSwiGLU {
    static constexpr bool PERM = true, AFTER_DRAIN = false;
    bf16_t* H; int ldh; int pm_sub; int nN;
    __device__ __forceinline__ void operator()(const f32x4 (&acc)[2][2][4][2], const Unit& u, int wr, int wc, int fr, int fq) const {
        const int row0 = (u.pm - pm_sub) * BM + wr * 64 + fr; const int col0 = (u.pn % nN) * HALF + wc * 32 + 8 * fq;
#pragma unroll
        for (int ai = 0; ai < 2; ++ai)
#pragma unroll
            for (int m = 0; m < 4; ++m) { bf16_t* rowp = H + (size_t)(row0 + ai * HALF + m * 16) * ldh + col0;
                const f32x4 g0 = acc[ai][0][m][0], g1 = acc[ai][0][m][1], u0 = acc[ai][1][m][0], u1 = acc[ai][1][m][1];
                u32x4 w; w.x = cvt_pk_bf16(silu_mul(g0[0], u0[0]), silu_mul(g0[1], u0[1])); w.y = cvt_pk_bf16(silu_mul(g0[2], u0[2]), silu_mul(g0[3], u0[3]));
                w.z = cvt_pk_bf16(silu_mul(g1[0], u1[0]), silu_mul(g1[1], u1[1])); w.w = cvt_pk_bf16(silu_mul(g1[2], u1[2]), silu_mul(g1[3], u1[3]));
                *(u32x4*)rowp = w; }
    }
};
struct MoeOrder {
    int nM, nN, nwg, G, c, t0, pm_off; const PG8_LAS unsigned char* tile_e;
    __device__ void init(int nM_, int nN_, int G_, int c_, int t0_, int pm_off_, const PG8_LAS unsigned char* te) { nM = nM_; nN = nN_; nwg = nM * nN; G = G_; c = c_; t0 = t0_; pm_off = pm_off_; tile_e = te; }
    __device__ bool next(int i, Unit& u) const {
        const long L = (long)i * G + c; if (L >= nwg) return false;
        int wgid = (int)L; { const int q = nwg / NXCD, r = nwg % NXCD, xcd = wgid % NXCD, off = wgid / NXCD; wgid = (xcd < r ? xcd * (q + 1) : r * (q + 1) + (xcd - r) * q) + off; }
        const int nig = WGM * nN, gid = wgid / nig, fm = gid * WGM, gsz = (nM - fm) < WGM ? (nM - fm) : WGM;
        const int pml = fm + ((wgid % nig) % gsz), pnl = (wgid % nig) / gsz;
        const int e = tile_e[t0 + pml];
        u.pm = pm_off + pml; u.pn = e * nN + pnl; return true;
    }
    __device__ __forceinline__ void a_ready(const Unit&) const {}
    __device__ __forceinline__ void done(const Unit&) const {}
};
}

__device__ __forceinline__ void tr_item(const float* W, int ldw, int k0, int c0, bf16* WT, int K, int drow, LAS float* scr, int lane) {
#pragma unroll 8
    for (int i = 0; i < 32; ++i) { const int kk = 2 * i + (lane >> 5); scr[kk * 33 + (lane & 31)] = W[(size_t)(k0 + kk) * ldw + c0 + (lane & 31)]; }
    LDS_WAIT(); asm volatile("" ::: "memory");
    const int c = lane & 7;
#pragma unroll
    for (int j = 0; j < 4; ++j) { const int n = (lane >> 3) + 8 * j; const LAS float* s = scr + (8 * c) * 33 + n;
        v4u o; o.x = pk2(s[0 * 33], s[1 * 33]); o.y = pk2(s[2 * 33], s[3 * 33]); o.z = pk2(s[4 * 33], s[5 * 33]); o.w = pk2(s[6 * 33], s[7 * 33]);
        *(GAS v4u*)(WT + (size_t)(drow + n) * K + k0 + 8 * c) = o; }
    LDS_WAIT(); asm volatile("" ::: "memory");
}
__device__ __forceinline__ void conv_matrix(Frame& F, const float* W, int K, int ldw, int cbeg, int ncols, bf16* WT, int mode, int rowoff, int& cursor) {
    const int gw = blockIdx.x * NWAVES + F.wave, NGW = F.G * NWAVES;
    const int nblk = ncols / 32, nit = (K / 64) * nblk;
    LAS float* scr = (LAS float*)(F.lds + F.wave * 16384);
    int first = cursor + (((gw - cursor) % NGW) + NGW) % NGW;
    for (int it = first; it < cursor + nit; it += NGW) {
        const int idx = it - cursor, kb = idx / nblk, nb = idx % nblk, n = 32 * nb;
        const int drow = mode == 0 ? rowoff + n : ((n >> 7) * 256 + (n & 127) + rowoff);
        tr_item(W, ldw, 64 * kb, cbeg + n, WT, K, drow, scr, F.lane);
    }
    cursor += nit;
}

__device__ __forceinline__ void phase_mod(Frame& F) { WS_DECL; frame_refresh(F);
    LAS float* sv = (LAS float*)F.lds;
    LAS float* red = (LAS float*)(F.lds + 69632);
    float* MOD = WSP(float, WS_MOD);
    if ((int)blockIdx.x < 192) {
        const float* cl_ = in_ptr(I_C); const float* cc_ = in_ptr(I_CCTX); const float* adab = in_ptr(I_ADAB); const float* adaw = in_ptr(I_ADAW);
        for (int i = F.tid; i < 17 * 1024; i += NTHR) { const int b = i >> 10, k = i & 1023; const float c = b < 16 ? cl_[b * 1024 + k] : cc_[k]; sv[i] = c / (1.f + expf(-c)); }
        __syncthreads();
        for (int item = blockIdx.x; item < 192; item += F.G) {
            const int li = item / 48, cg = item % 48, cl = F.tid & 127, kq = F.tid >> 7;
            const float* W = adaw + (size_t)li * 1024 * 6144 + cg * 128 + cl;
            float acc[17];
#pragma unroll
            for (int b = 0; b < 17; ++b) acc[b] = 0.f;
            for (int k = kq * 256; k < kq * 256 + 256; ++k) { const float w = W[(size_t)k * 6144];
#pragma unroll
                for (int b = 0; b < 17; ++b) acc[b] += sv[b * 1024 + k] * w; }
#pragma unroll
            for (int b = 0; b < 17; ++b) red[(kq * 17 + b) * 128 + cl] = acc[b];
            __syncthreads();
            for (int o = F.tid; o < 17 * 128; o += NTHR) { const int b = o >> 7, c = o & 127;
                const float s = (red[(0 * 17 + b) * 128 + c] + red[(1 * 17 + b) * 128 + c]) + (red[(2 * 17 + b) * 128 + c] + red[(3 * 17 + b) * 128 + c]);
                MOD[((size_t)li * 17 + b) * 6144 + cg * 128 + c] = s + adab[li * 6144 + cg * 128 + c]; }
            __syncthreads();
        }
    }
}

__device__ __forceinline__ void phase_pro0(Frame& F) { WS_DECL; frame_refresh(F);
    phase_mod(F);
    __syncthreads();
    int cursor = 0;
    for (int li = 0; li < DEPTH; ++li) {
        conv_matrix(F, in_ptr(I_WIN) + (size_t)li * D * N_IN, D, N_IN, 0, D_OFF, WSP(bf16, WS_WINT) + (size_t)li * PCOLS * D, 0, 0, cursor);
        conv_matrix(F, in_ptr(I_WIN) + (size_t)li * D * N_IN, D, N_IN, D_OFF, HYC, WSP(bf16, WS_WHYT) + (size_t)li * HYC * D, 0, 0, cursor);
        conv_matrix(F, in_ptr(I_WOUT) + (size_t)li * D * D, D, D, 0, D, WSP(bf16, WS_WOUTT) + (size_t)li * D * D, 0, 0, cursor);
    }
    for (int j = 0; j < 2; ++j) {
        conv_matrix(F, in_ptr(I_FG) + (size_t)j * D * FFD, D, FFD, 0, FFD, WSP(bf16, WS_WGUT) + (size_t)j * 2 * FFD * D, 1, 0, cursor);
        conv_matrix(F, in_ptr(I_FU) + (size_t)j * D * FFD, D, FFD, 0, FFD, WSP(bf16, WS_WGUT) + (size_t)j * 2 * FFD * D, 1, 128, cursor);
        conv_matrix(F, in_ptr(I_FD) + (size_t)j * FFD * D, FFD, D, 0, D, WSP(bf16, WS_WDT) + (size_t)j * D * FFD, 0, 0, cursor);
    }
    { const int gt = blockIdx.x * NTHR + F.tid, NGT = F.G * NTHR; const int per = (PCOLS - D_OFF) * D / 8;
      for (int i = gt; i < DEPTH * per; i += NGT) { const int li = i / per, r = i % per; *(GAS v4u*)(WSP(bf16, WS_WINT) + (size_t)li * PCOLS * D + (size_t)D_OFF * D + (size_t)r * 8) = (v4u){0u, 0u, 0u, 0u}; } }
}

struct Stream { const float* inl; const float* inc; float* outl; float* outc; };
__device__ __forceinline__ Stream make_stream(unsigned char* ws, int li) { Stream s; s.outl = out_ptr(); s.outc = WSP(float, WS_XC); s.inl = li == 0 ? in_ptr(I_X) : (const float*)s.outl; s.inc = li == 0 ? in_ptr(I_CTX) : (const float*)s.outc; return s; }
__device__ __forceinline__ const float* stream_in(const Stream& s, int m) { return m < NL ? s.inl + (size_t)m * D : s.inc + (size_t)(m - NL) * D; }
__device__ __forceinline__ float* stream_out(const Stream& s, int m) { return m < NL ? s.outl + (size_t)m * D : s.outc + (size_t)(m - NL) * D; }
__device__ __forceinline__ int mod_b(int m) { return m < NL ? (m >> 12) : 16; }
__device__ __forceinline__ const float* mod_vec(unsigned char* ws, int li, int b, int j) { return WSP(float, WS_MOD) + ((size_t)li * 17 + b) * 6144 + j * 1024; }

__device__ __forceinline__ void store_modulated(const f32x4 (&x)[4], const float* shift, const float* scale, bf16* orow, int lane) {
#pragma unroll
    for (int j = 0; j < 4; ++j) { const int c = 4 * lane + 256 * j; const f32x4 sh = *(const GAS f32x4*)(shift + c), sc = *(const GAS f32x4*)(scale + c);
        const f32x4 h = x[j] * (sc + 1.f) + sh; v2u w; w.x = pk2(h.x, h.y); w.y = pk2(h.z, h.w); *(GAS v2u*)(orow + c) = w; }
}
__device__ __forceinline__ void rows_range(const Frame& F, int nrows, int& r0, int& r1) { const int per = (nrows + F.G - 1) / F.G; r0 = blockIdx.x * per; r1 = r0 + per < nrows ? r0 + per : nrows; if (r0 > nrows) r0 = nrows; }

__device__ __forceinline__ void phase_hin0(Frame& F) { WS_DECL; frame_refresh(F);
    int r0, r1; rows_range(F, NT, r0, r1); const Stream st = make_stream(ws, 0);
    for (int m = r0 + F.wave; m < r1; m += NWAVES) {
        const float* xr = stream_in(st, m); f32x4 x[4];
#pragma unroll
        for (int j = 0; j < 4; ++j) x[j] = *(const GAS f32x4*)(xr + 4 * F.lane + 256 * j);
        const int b = mod_b(m);
        store_modulated(x, mod_vec(ws, 0, b, 0), mod_vec(ws, 0, b, 1), WSP(bf16, WS_A1) + (size_t)m * D, F.lane);
    }
}

__device__ __forceinline__ void ln_rows(f32x4 (&v)[4], const float* g, const float* bta, int lane) {
    float s = 0.f;
#pragma unroll
    for (int j = 0; j < 4; ++j) s += (v[j].x + v[j].y) + (v[j].z + v[j].w);
    const float mean = wave_sum(s) * (1.f / D); float s2 = 0.f;
#pragma unroll
    for (int j = 0; j < 4; ++j) { v[j] = v[j] - mean; s2 += (v[j].x * v[j].x + v[j].y * v[j].y) + (v[j].z * v[j].z + v[j].w * v[j].w); }
    const float rstd = 1.f / sqrtf(wave_sum(s2) * (1.f / D) + 1e-5f);
#pragma unroll
    for (int j = 0; j < 4; ++j) { const int c = 4 * lane + 256 * j; v[j] = v[j] * rstd * *(const GAS f32x4*)(g + c) + *(const GAS f32x4*)(bta + c); }
}

template <bool HAVE_Y>
__device__ __forceinline__ void phase_ln1(Frame& F, int li) { WS_DECL; frame_refresh(F);
    const int nrows = li == DEPTH - 1 ? NL : NT; const bool moe = li & 1; const int lane = F.lane;
    LAS int* hist = (LAS int*)(F.lds + LDS_MOEI) + 56; LAS float* ROUT = (LAS float*)F.lds;
    if (moe) { if (F.tid < 8) hist[F.tid] = 0; const float* router = in_ptr(I_ROUTER) + (size_t)(li >> 1) * D * NE; for (int i = F.tid; i < D * NE / 4; i += NTHR) *(LAS f32x4*)(ROUT + 4 * i) = *(const GAS f32x4*)(router + 4 * i); __syncthreads(); }
    int r0, r1; rows_range(F, nrows, r0, r1);
    const float* g = in_ptr(I_LN1G) + li * D; const float* bt = in_ptr(I_LN1B) + li * D; const Stream st = make_stream(ws, li); const bf16* Y = WSP(bf16, WS_Y);
    f32x4 xn[4]; v2u yn[4];
    { const int m = r0 + F.wave; if (m < r1) { const float* xr = stream_in(st, m);
#pragma unroll
        for (int j = 0; j < 4; ++j) { const int c = 4 * lane + 256 * j; xn[j] = *(const GAS f32x4*)(xr + c); if (HAVE_Y) yn[j] = *(const GAS v2u*)(Y + (size_t)m * D + c); } } }
    for (int m = r0 + F.wave; m < r1; m += NWAVES) {
        const int b = mod_b(m); f32x4 v[4]; v2u yw[4];
#pragma unroll
        for (int j = 0; j < 4; ++j) { v[j] = xn[j]; if (HAVE_Y) yw[j] = yn[j]; }
        if (m + NWAVES < r1) { const float* xr = stream_in(st, m + NWAVES);
#pragma unroll
            for (int j = 0; j < 4; ++j) { const int c = 4 * lane + 256 * j; xn[j] = *(const GAS f32x4*)(xr + c); if (HAVE_Y) yn[j] = *(const GAS v2u*)(Y + (size_t)(m + NWAVES) * D + c); } }
        const float* m2 = mod_vec(ws, li, b, 2);
#pragma unroll
        for (int j = 0; j < 4; ++j) { const int c = 4 * lane + 256 * j; v[j] = v[j] * ALPHA;
            if (HAVE_Y) { const f32x4 mm = *(const GAS f32x4*)(m2 + c); v[j].x += mm.x * bflo(yw[j].x); v[j].y += mm.y * bfhi(yw[j].x); v[j].z += mm.z * bflo(yw[j].y); v[j].w += mm.w * bfhi(yw[j].y); } }
        ln_rows(v, g, bt, lane);
        float* xo = stream_out(st, m);
#pragma unroll
        for (int j = 0; j < 4; ++j) *(GAS f32x4*)(xo + 4 * lane + 256 * j) = v[j];
        const float* sh = mod_vec(ws, li, b, 3); const float* sc = mod_vec(ws, li, b, 4);
        if (moe) {
            float lg[NE];
#pragma unroll
            for (int e = 0; e < NE; ++e) lg[e] = 0.f;
#pragma unroll
            for (int j = 0; j < 4; ++j) { const int c = 4 * lane + 256 * j; const f32x4 s4 = *(const GAS f32x4*)(sh + c), c4 = *(const GAS f32x4*)(sc + c); const f32x4 f = v[j] * (c4 + 1.f) + s4;
#pragma unroll
                for (int q = 0; q < 4; ++q) { const f32x4 ra = *(const LAS f32x4*)(ROUT + (c + q) * NE), rb = *(const LAS f32x4*)(ROUT + (c + q) * NE + 4); const float fq = f[q];
                    lg[0] += fq * ra.x; lg[1] += fq * ra.y; lg[2] += fq * ra.z; lg[3] += fq * ra.w; lg[4] += fq * rb.x; lg[5] += fq * rb.y; lg[6] += fq * rb.z; lg[7] += fq * rb.w; } }
#pragma unroll
            for (int e = 0; e < NE; ++e) lg[e] = wave_sum(lg[e]);
            int e0 = 0; float v0 = lg[0];
#pragma unroll
            for (int e = 1; e < NE; ++e) if (lg[e] > v0) { v0 = lg[e]; e0 = e; }
            int e1 = -1; float v1 = -3.0e38f;
#pragma unroll
            for (int e = 0; e < NE; ++e) if (e != e0 && lg[e] > v1) { v1 = lg[e]; e1 = e; }
            const float ex = __expf(v1 - v0), g0 = 1.f / (1.f + ex), g1 = ex * g0;
            if (lane == 0) { *(GAS v2u*)(WSP(int, WS_TOKE) + 2 * (size_t)m) = (v2u){(unsigned)e0, (unsigned)e1}; *(GAS f32x2*)(WSP(float, WS_TOKG) + 2 * (size_t)m) = (f32x2){g0, g1};
                atomicAdd((int*)(hist + e0), 1); atomicAdd((int*)(hist + e1), 1); }
        }
        store_modulated(v, sh, sc, WSP(bf16, WS_A1) + (size_t)m * D, lane);
    }
    if (moe) { __syncthreads(); if (F.tid < 8) WSP(int, WS_BLKCNT)[blockIdx.x * 8 + F.tid] = hist[F.tid]; }
}

template <bool HAVE_FFN>
__device__ __forceinline__ void phase_ln2(Frame& F, int li) { WS_DECL; frame_refresh(F);
    const int nrows = li == DEPTH - 1 ? NL : NT; const bool moe = li & 1; const int lane = F.lane;
    int r0, r1; rows_range(F, nrows, r0, r1);
    const float* g = in_ptr(I_LN2G) + li * D; const float* bt = in_ptr(I_LN2B) + li * D; const Stream st = make_stream(ws, 1);
    const bf16* Y = WSP(bf16, WS_Y); const bf16* XS = WSP(bf16, WS_XS); const int* TOKS = WSP(int, WS_TOKS); const float* TOKG = WSP(float, WS_TOKG);
    f32x4 xn[4]; v2u ya[4], yb[4]; v2u sn = (v2u){0u, 0u}; f32x2 gn = (f32x2){0.f, 0.f}, gc = (f32x2){0.f, 0.f};
    const int mf = r0 + F.wave;
    if (mf < r1) { const float* xr = stream_out(st, mf); v2u s0 = (v2u){0u, 0u};
        if (moe) { s0 = *(const GAS v2u*)(TOKS + 2 * (size_t)mf); gc = *(const GAS f32x2*)(TOKG + 2 * (size_t)mf); if (mf + NWAVES < r1) { sn = *(const GAS v2u*)(TOKS + 2 * (size_t)(mf + NWAVES)); gn = *(const GAS f32x2*)(TOKG + 2 * (size_t)(mf + NWAVES)); } }
#pragma unroll
        for (int j = 0; j < 4; ++j) { const int c = 4 * lane + 256 * j; xn[j] = *(const GAS f32x4*)(xr + c);
            if (HAVE_FFN) { if (moe) { ya[j] = *(const GAS v2u*)(XS + (size_t)s0.x * D + c); yb[j] = *(const GAS v2u*)(XS + (size_t)s0.y * D + c); } else ya[j] = *(const GAS v2u*)(Y + (size_t)mf * D + c); } } }
    for (int m = mf; m < r1; m += NWAVES) {
        const int b = mod_b(m); f32x4 v[4]; v2u wa[4], wb[4]; const f32x2 gg = gc;
#pragma unroll
        for (int j = 0; j < 4; ++j) { v[j] = xn[j]; wa[j] = ya[j]; wb[j] = yb[j]; }
        const int mn = m + NWAVES;
        if (mn < r1) { const float* xr = stream_out(st, mn); const v2u s1 = sn; gc = gn;
            if (moe && mn + NWAVES < r1) { sn = *(const GAS v2u*)(TOKS + 2 * (size_t)(mn + NWAVES)); gn = *(const GAS f32x2*)(TOKG + 2 * (size_t)(mn + NWAVES)); }
#pragma unroll
            for (int j = 0; j < 4; ++j) { const int c = 4 * lane + 256 * j; xn[j] = *(const GAS f32x4*)(xr + c);
                if (HAVE_FFN) { if (moe) { ya[j] = *(const GAS v2u*)(XS + (size_t)s1.x * D + c); yb[j] = *(const GAS v2u*)(XS + (size_t)s1.y * D + c); } else ya[j] = *(const GAS v2u*)(Y + (size_t)mn * D + c); } } }
        const float* m5 = mod_vec(ws, li, b, 5);
#pragma unroll
        for (int j = 0; j < 4; ++j) { const int c = 4 * lane + 256 * j; v[j] = v[j] * ALPHA;
            if (HAVE_FFN) { const f32x4 mm = *(const GAS f32x4*)(m5 + c); f32x4 o;
                if (moe) { o.x = gg.x * bflo(wa[j].x) + gg.y * bflo(wb[j].x); o.y = gg.x * bfhi(wa[j].x) + gg.y * bfhi(wb[j].x); o.z = gg.x * bflo(wa[j].y) + gg.y * bflo(wb[j].y); o.w = gg.x * bfhi(wa[j].y) + gg.y * bfhi(wb[j].y); }
                else { o.x = bflo(wa[j].x); o.y = bfhi(wa[j].x); o.z = bflo(wa[j].y); o.w = bfhi(wa[j].y); }
                v[j] = v[j] + mm * o; } }
        ln_rows(v, g, bt, lane);
        float* xo = stream_out(st, m);
#pragma unroll
        for (int j = 0; j < 4; ++j) *(GAS f32x4*)(xo + 4 * lane + 256 * j) = v[j];
        if (li < DEPTH - 1) store_modulated(v, mod_vec(ws, li + 1, b, 0), mod_vec(ws, li + 1, b, 1), WSP(bf16, WS_A1) + (size_t)m * D, lane);
    }
}

__device__ __forceinline__ void phase_moe_weights(Frame& F, int li) { WS_DECL; frame_refresh(F);
    const int j = li >> 1; int cursor = 0;
    for (int e = 0; e < NE; ++e) {
        conv_matrix(F, in_ptr(I_MG) + ((size_t)j * NE + e) * D * FFE, D, FFE, 0, FFE, WSP(bf16, WS_MGU) + (size_t)e * 2 * FFE * D, 1, 0, cursor);
        conv_matrix(F, in_ptr(I_MU) + ((size_t)j * NE + e) * D * FFE, D, FFE, 0, FFE, WSP(bf16, WS_MGU) + (size_t)e * 2 * FFE * D, 1, 128, cursor);
        conv_matrix(F, in_ptr(I_MD) + ((size_t)j * NE + e) * FFE * D, FFE, D, 0, D, WSP(bf16, WS_MD) + (size_t)e * D * FFE, 0, 0, cursor);
    }
}

__device__ __forceinline__ void phase_moe_slots(Frame& F, int li) { WS_DECL; frame_refresh(F);
    const int nrows = li == DEPTH - 1 ? NL : NT;
    LAS int* mi = (LAS int*)(F.lds + LDS_MOEI); LAS unsigned char* tile_e = (LAS unsigned char*)(F.lds + LDS_TILEE);
    LAS int* slots = (LAS int*)F.lds;
    const int* blkcnt = WSP(int, WS_BLKCNT);
    if (F.tid < 8) { int tot = 0, pre = 0; for (int b = 0; b < F.G; ++b) { const int c = blkcnt[b * 8 + F.tid]; if (b < (int)blockIdx.x) pre += c; tot += c; } mi[16 + F.tid] = tot; mi[32 + F.tid] = pre; }
    __syncthreads();
    if (F.tid == 0) { int s = 0; for (int e = 0; e < NE; ++e) { mi[e] = s; s += (mi[16 + e] + 255) & ~255; } mi[8] = s; mi[48] = s >> 8; }
    __syncthreads();
    for (int t = F.tid; t < MOE_MAX_TILES + 8; t += NTHR) { int e = 0;
#pragma unroll
        for (int q = 1; q < NE; ++q) if (t * 256 >= mi[q]) e = q;
        tile_e[t] = (unsigned char)e; }
    int r0, r1; rows_range(F, nrows, r0, r1);
    const int na = 2 * (r1 - r0);
    if (F.wave == 0) {
        int run[NE];
#pragma unroll
        for (int e = 0; e < NE; ++e) run[e] = mi[e] + mi[32 + e];
        for (int base = 0; base < na; base += 64) { const int ai = base + F.lane; const bool ok = ai < na;
            const int e = ok ? WSP(int, WS_TOKE)[2 * (size_t)r0 + ai] : -1; int slot = 0;
#pragma unroll
            for (int q = 0; q < NE; ++q) { const unsigned long long mk = __ballot(e == q); if (e == q) slot = run[q] + __popcll(mk & ((1ull << F.lane) - 1ull)); run[q] += __popcll(mk); }
            if (ok) { slots[ai] = slot; WSP(int, WS_TOKS)[2 * (size_t)r0 + ai] = slot; } }
    }
    __syncthreads();
    for (int ai = F.wave; ai < na; ai += NWAVES) { const int m = r0 + (ai >> 1), slot = slots[ai];
        const GAS v4u* src = (const GAS v4u*)(WSP(bf16, WS_A1) + (size_t)m * D); GAS v4u* dst = (GAS v4u*)(WSP(bf16, WS_XS) + (size_t)slot * D);
        dst[F.lane] = src[F.lane]; dst[F.lane + 64] = src[F.lane + 64]; }
    { const int gw = blockIdx.x * NWAVES + F.wave, NGW = F.G * NWAVES; int cnt = 0;
      for (int e = 0; e < NE; ++e) { const int p0 = mi[e] + mi[16 + e], p1 = mi[e + 1];
          for (int s = p0; s < p1; ++s, ++cnt) if (cnt % NGW == gw) { GAS v4u* dst = (GAS v4u*)(WSP(bf16, WS_XS) + (size_t)s * D); dst[F.lane] = (v4u){0u, 0u, 0u, 0u}; dst[F.lane + 64] = (v4u){0u, 0u, 0u, 0u}; } } }
    __syncthreads();
}

constexpr float QSCALE = 0.14724319f;
constexpr int MP_CQ_LD = 200, MP_CKV_LD = 136;
__device__ __forceinline__ void phase_mla_prep(Frame& F, int li) { WS_DECL; frame_refresh(F);
    LAS bf16* CQN = (LAS bf16*)F.lds; LAS bf16* CKVN = (LAS bf16*)(F.lds + 64 * MP_CQ_LD * 2);
    const bf16* P = WSP(bf16, WS_P); bf16* QB = WSP(bf16, WS_QB); bf16* KB = WSP(bf16, WS_KB); bf16* VT = WSP(bf16, WS_VT);
    const float* qn = in_ptr(I_QNORM) + li * 192; const float* kvn = in_ptr(I_KVNORM) + li * 128;
    const bf16* WQ = WSP(bf16, WS_WUQT) + (size_t)li * 384 * 192; const bf16* WKV = WSP(bf16, WS_WUKVT) + (size_t)li * 512 * 128;
    const float* RC = WSP(float, WS_ROPE); const float* RS = RC + 4096 * 16;
    const int lane = F.lane, wave = F.wave;
    const int head = wave >> 1, half = wave & 1, fr = lane & 15, kg = lane >> 4;
    for (int item = blockIdx.x; item < NT / 64; item += F.G) {
        const int m0 = item * 64; const bool isctx = m0 >= NL; const int b = isctx ? (m0 - NL) >> 8 : m0 >> 12; const int t0 = isctx ? (m0 - NL) & 255 : m0 & 4095;
        const int ki0 = isctx ? t0 : 256 + t0;
        bf16x8 wq[3][6];
#pragma unroll
        for (int i = 0; i < 3; ++i)
#pragma unroll
            for (int ks = 0; ks < 6; ++ks) wq[i][ks] = *(const GAS bf16x8*)(WQ + (size_t)(96 * head + 16 * (3 * half + i) + fr) * 192 + 32 * ks + 8 * kg);
        v4u rawv[8]; unsigned short kr1[8], kr2[8];
#pragma unroll
        for (int i = 0; i < 8; ++i) { const bf16* pr = P + (size_t)(m0 + wave * 8 + i) * PCOLS; rawv[i] = (v4u){0u, 0u, 0u, 0u}; if (lane < 40) rawv[i] = *(const GAS v4u*)(pr + 8 * lane);
            kr1[i] = 0; kr2[i] = 0; if (lane < 16) { kr1[i] = pr[320 + lane]; kr2[i] = pr[336 + lane]; } }
#pragma unroll
        for (int i = 0; i < 8; ++i) { const int tl = wave * 8 + i; const v4u raw = rawv[i];
            float x[8]; x[0] = bflo(raw.x); x[1] = bfhi(raw.x); x[2] = bflo(raw.y); x[3] = bfhi(raw.y); x[4] = bflo(raw.z); x[5] = bfhi(raw.z); x[6] = bflo(raw.w); x[7] = bfhi(raw.w);
            float ss = 0.f;
#pragma unroll
            for (int j = 0; j < 8; ++j) ss += x[j] * x[j];
            const float sq = wave_sum(lane < 24 ? ss : 0.f), skv = wave_sum((lane >= 24 && lane < 40) ? ss : 0.f);
            const float rq = rsqrtf(sq * (1.f / 192.f) + 1e-6f), rkv = rsqrtf(skv * (1.f / 128.f) + 1e-6f);
            if (lane < 24) { const float* g = qn + 8 * lane; v4u o; o.x = pk2(x[0] * rq * g[0], x[1] * rq * g[1]); o.y = pk2(x[2] * rq * g[2], x[3] * rq * g[3]); o.z = pk2(x[4] * rq * g[4], x[5] * rq * g[5]); o.w = pk2(x[6] * rq * g[6], x[7] * rq * g[7]);
                *(LAS v4u*)(CQN + tl * MP_CQ_LD + 8 * lane) = o; }
            else if (lane < 40) { const int c = 8 * (lane - 24); const float* g = kvn + c; v4u o; o.x = pk2(x[0] * rkv * g[0], x[1] * rkv * g[1]); o.y = pk2(x[2] * rkv * g[2], x[3] * rkv * g[3]); o.z = pk2(x[4] * rkv * g[4], x[5] * rkv * g[5]); o.w = pk2(x[6] * rkv * g[6], x[7] * rkv * g[7]);
                *(LAS v4u*)(CKVN + tl * MP_CKV_LD + c) = o; }
            if (lane < 16) { float x1 = bf2f(kr1[i]), x2 = bf2f(kr2[i]);
                if (!isctx) { const float c = RC[(t0 + tl) * 16 + lane], s = RS[(t0 + tl) * 16 + lane]; const float y1 = x1 * c - x2 * s, y2 = x1 * s + x2 * c; x1 = y1; x2 = y2; }
                const bf16 o1 = (bf16)f2bf(x1), o2 = (bf16)f2bf(x2);
#pragma unroll
                for (int h = 0; h < 4; ++h) { bf16* kr = KB + ((size_t)(b * 4 + h) * KSEQ + ki0 + tl) * 96; kr[64 + lane] = o1; kr[80 + lane] = o2; } }
        }
        __syncthreads();
        const size_t qrow0 = ((size_t)(b * 4 + head) * KSEQ + ki0) * 96;
        { f32x4 acc[3][4];
#pragma unroll
          for (int i = 0; i < 3; ++i)
#pragma unroll
              for (int m = 0; m < 4; ++m) acc[i][m] = (f32x4){0.f, 0.f, 0.f, 0.f};
#pragma unroll
          for (int ks = 0; ks < 6; ++ks)
#pragma unroll
              for (int m = 0; m < 4; ++m) { const bf16x8 xf = *(const LAS bf16x8*)(CQN + (16 * m + fr) * MP_CQ_LD + 32 * ks + 8 * kg);
#pragma unroll
                  for (int i = 0; i < 3; ++i) acc[i][m] = __builtin_amdgcn_mfma_f32_16x16x32_bf16(wq[i][ks], xf, acc[i][m], 0, 0, 0); }
#pragma unroll
          for (int m = 0; m < 4; ++m) { bf16* qr = QB + qrow0 + (size_t)(16 * m + fr) * 96;
              { v2u o; o.x = pk2(acc[0][m][0] * QSCALE, acc[0][m][1] * QSCALE); o.y = pk2(acc[0][m][2] * QSCALE, acc[0][m][3] * QSCALE); *(GAS v2u*)(qr + 48 * half + 4 * kg) = o; }
              f32x4 y1 = acc[1][m], y2 = acc[2][m];
              if (half == 1 && !isctx) { const int t = t0 + 16 * m + fr; const f32x4 c = *(const GAS f32x4*)(RC + t * 16 + 4 * kg), sn = *(const GAS f32x4*)(RS + t * 16 + 4 * kg); y1 = acc[1][m] * c - acc[2][m] * sn; y2 = acc[1][m] * sn + acc[2][m] * c; }
              v2u o1, o2; o1.x = pk2(y1[0] * QSCALE, y1[1] * QSCALE); o1.y = pk2(y1[2] * QSCALE, y1[3] * QSCALE); o2.x = pk2(y2[0] * QSCALE, y2[1] * QSCALE); o2.y = pk2(y2[2] * QSCALE, y2[3] * QSCALE);
              *(GAS v2u*)(qr + 48 * half + 16 + 4 * kg) = o1; *(GAS v2u*)(qr + 48 * half + 32 + 4 * kg) = o2; } }
        bf16x8 wkv[4][4];
#pragma unroll
        for (int nt = 0; nt < 4; ++nt)
#pragma unroll
            for (int ks = 0; ks < 4; ++ks) wkv[nt][ks] = *(const GAS bf16x8*)(WKV + (size_t)(128 * head + 64 * half + 16 * nt + fr) * 128 + 32 * ks + 8 * kg);
        { f32x4 acc[4][4];
#pragma unroll
          for (int nt = 0; nt < 4; ++nt)
#pragma unroll
              for (int m = 0; m < 4; ++m) acc[nt][m] = (f32x4){0.f, 0.f, 0.f, 0.f};
#pragma unroll
          for (int ks = 0; ks < 4; ++ks)
#pragma unroll
              for (int m = 0; m < 4; ++m) { const bf16x8 xf = *(const LAS bf16x8*)(CKVN + (16 * m + fr) * MP_CKV_LD + 32 * ks + 8 * kg);
#pragma unroll
                  for (int nt = 0; nt < 4; ++nt) acc[nt][m] = half == 0 ? __builtin_amdgcn_mfma_f32_16x16x32_bf16(wkv[nt][ks], xf, acc[nt][m], 0, 0, 0) : __builtin_amdgcn_mfma_f32_16x16x32_bf16(xf, wkv[nt][ks], acc[nt][m], 0, 0, 0); }
#pragma unroll
          for (int nt = 0; nt < 4; ++nt)
#pragma unroll
              for (int m = 0; m < 4; ++m) { v2u o; o.x = pk2(acc[nt][m][0], acc[nt][m][1]); o.y = pk2(acc[nt][m][2], acc[nt][m][3]);
                  if (half == 0) *(GAS v2u*)(KB + qrow0 + (size_t)(16 * m + fr) * 96 + 16 * nt + 4 * kg) = o;
                  else *(GAS v2u*)(VT + ((size_t)(b * 4 + head) * 64 + 16 * nt + fr) * KSEQ + ki0 + 16 * m + 4 * kg) = o; } }
        __syncthreads();
    }
}

constexpr int AT_KLD = 104, AT_VLD = 72;
constexpr int AT_KB = 64 * AT_KLD * 2, AT_VB = 64 * AT_VLD * 2, AT_BUF = AT_KB + AT_VB;
__device__ __forceinline__ void phase_attn(Frame& F, int li) { WS_DECL; frame_refresh(F);
    const bf16* QB = WSP(bf16, WS_QB); const bf16* KB = WSP(bf16, WS_KB); const bf16* VT = WSP(bf16, WS_VT); bf16* AO = WSP(bf16, WS_AO);
    const int lane = F.lane, wave = F.wave, tid = F.tid, ql = lane & 31, h2 = lane >> 5;
    const int nunits = 1024 + (li < DEPTH - 1 ? 64 : 0);
    const int c = blockIdx.x, vc = (F.G == 256) ? (c & 7) * 32 + (c >> 3) : c;
    for (int u = vc; u < nunits; u += F.G) {
        int bh, q0, nk; bool isctx = u >= 1024;
        if (!isctx) { bh = u >> 4; q0 = 256 + 256 * (u & 15); nk = KSEQ; } else { bh = u - 1024; q0 = 0; nk = 256; }
        const bf16* Kb = KB + (size_t)bh * KSEQ * 96; const bf16* Vb = VT + (size_t)bh * 64 * KSEQ;
        bf16x8 qf[6];
        { const bf16* qr = QB + ((size_t)bh * KSEQ + q0 + 32 * wave + ql) * 96 + 8 * h2;
#pragma unroll
          for (int ks = 0; ks < 6; ++ks) qf[ks] = *(const GAS bf16x8*)(qr + 16 * ks); }
        f32x16 O0, O1;
#pragma unroll
        for (int r = 0; r < 16; ++r) { O0[r] = 0.f; O1[r] = 0.f; }
        float m_run = -1e30f, l_run = 0.f;
        const int kc0 = tid, kc1 = tid + 512; const int vr = tid >> 3, vcn = tid & 7;
        v4u pk0, pk1 = (v4u){0u, 0u, 0u, 0u}, pv;
        { const GAS v4u* ks = (const GAS v4u*)Kb; pk0 = ks[kc0]; if (kc1 < 768) pk1 = ks[kc1]; pv = *(const GAS v4u*)(Vb + (size_t)vr * KSEQ + 8 * vcn); }
        __syncthreads();
        { LAS unsigned char* buf = F.lds; *(LAS v4u*)(buf + (kc0 / 12) * (AT_KLD * 2) + (kc0 % 12) * 16) = pk0; if (kc1 < 768) *(LAS v4u*)(buf + (kc1 / 12) * (AT_KLD * 2) + (kc1 % 12) * 16) = pk1;
          *(LAS v4u*)(buf + AT_KB + vr * (AT_VLD * 2) + vcn * 16) = pv; }
        __syncthreads();
        const int ntile = nk >> 6;
        for (int kt = 0; kt < ntile; ++kt) {
            const LAS unsigned char* buf = F.lds + (kt & 1) * AT_BUF; LAS unsigned char* nbuf = F.lds + ((kt + 1) & 1) * AT_BUF;
            const bool more = kt + 1 < ntile;
            if (more) { const GAS v4u* ks = (const GAS v4u*)(Kb + (size_t)(kt + 1) * 64 * 96); pk0 = ks[kc0]; if (kc1 < 768) pk1 = ks[kc1]; pv = *(const GAS v4u*)(Vb + (size_t)vr * KSEQ + (kt + 1) * 64 + 8 * vcn); }
            f32x16 S0, S1;
#pragma unroll
            for (int r = 0; r < 16; ++r) { S0[r] = 0.f; S1[r] = 0.f; }
#pragma unroll
            for (int ks = 0; ks < 6; ++ks) { const bf16x8 k0 = *(const LAS bf16x8*)(buf + ql * (AT_KLD * 2) + 32 * ks + 16 * h2), k1 = *(const LAS bf16x8*)(buf + (32 + ql) * (AT_KLD * 2) + 32 * ks + 16 * h2);
                S0 = __builtin_amdgcn_mfma_f32_32x32x16_bf16(k0, qf[ks], S0, 0, 0, 0); S1 = __builtin_amdgcn_mfma_f32_32x32x16_bf16(k1, qf[ks], S1, 0, 0, 0); }
            float mx = S0[0];
#pragma unroll
            for (int r = 1; r < 16; ++r) mx = fmaxf(mx, S0[r]);
#pragma unroll
            for (int r = 0; r < 16; ++r) mx = fmaxf(mx, S1[r]);
            mx = fmaxf(mx, __shfl_xor(mx, 32));
            const float m_new = fmaxf(m_run, mx), alpha = __builtin_amdgcn_exp2f(m_run - m_new); m_run = m_new;
            float ps = 0.f;
#pragma unroll
            for (int r = 0; r < 16; ++r) { S0[r] = __builtin_amdgcn_exp2f(S0[r] - m_new); S1[r] = __builtin_amdgcn_exp2f(S1[r] - m_new); ps += S0[r] + S1[r]; }
            l_run = l_run * alpha + ps;
#pragma unroll
            for (int r = 0; r < 16; ++r) { O0[r] *= alpha; O1[r] *= alpha; }
            union { bf16x8 v; unsigned u[4]; } p00, p01, p10, p11;
#pragma unroll
            for (int j = 0; j < 4; ++j) { p00.u[j] = pk2(S0[2 * j], S0[2 * j + 1]); p01.u[j] = pk2(S0[8 + 2 * j], S0[8 + 2 * j + 1]); p10.u[j] = pk2(S1[2 * j], S1[2 * j + 1]); p11.u[j] = pk2(S1[8 + 2 * j], S1[8 + 2 * j + 1]); }
            const LAS unsigned char* vb = buf + AT_KB;
#pragma unroll
            for (int dvt = 0; dvt < 2; ++dvt) { const LAS unsigned char* vrow = vb + (32 * dvt + ql) * (AT_VLD * 2) + 8 * h2;
#pragma unroll
                for (int sub = 0; sub < 2; ++sub)
#pragma unroll
                    for (int s = 0; s < 2; ++s) { union { bf16x8 v; v2u h[2]; } vf; vf.h[0] = *(const LAS v2u*)(vrow + 2 * (32 * sub + 16 * s)); vf.h[1] = *(const LAS v2u*)(vrow + 2 * (32 * sub + 16 * s + 8));
                        const bf16x8 pf = sub == 0 ? (s == 0 ? p00.v : p01.v) : (s == 0 ? p10.v : p11.v);
                        if (dvt == 0) O0 = __builtin_amdgcn_mfma_f32_32x32x16_bf16(vf.v, pf, O0, 0, 0, 0); else O1 = __builtin_amdgcn_mfma_f32_32x32x16_bf16(vf.v, pf, O1, 0, 0, 0); } }
            if (more) { *(LAS v4u*)(nbuf + (kc0 / 12) * (AT_KLD * 2) + (kc0 % 12) * 16) = pk0; if (kc1 < 768) *(LAS v4u*)(nbuf + (kc1 / 12) * (AT_KLD * 2) + (kc1 % 12) * 16) = pk1;
                *(LAS v4u*)(nbuf + AT_KB + vr * (AT_VLD * 2) + vcn * 16) = pv; }
            __syncthreads();
        }
        const float inv = 1.f / (l_run + __shfl_xor(l_run, 32));
        const int b = bh >> 2, head = bh & 3, qi = q0 + 32 * wave + ql;
        const size_t row = isctx ? (size_t)NL + b * 256 + qi : (size_t)b * 4096 + (qi - 256);
        bf16* orow = AO + row * 256 + head * 64 + 4 * h2;
#pragma unroll
        for (int g = 0; g < 4; ++g) { v2u o0, o1; o0.x = pk2(O0[4 * g] * inv, O0[4 * g + 1] * inv); o0.y = pk2(O0[4 * g + 2] * inv, O0[4 * g + 3] * inv); o1.x = pk2(O1[4 * g] * inv, O1[4 * g + 1] * inv); o1.y = pk2(O1[4 * g + 2] * inv, O1[4 * g + 3] * inv);
            *(GAS v2u*)(orow + 8 * g) = o0; *(GAS v2u*)(orow + 32 + 8 * g) = o1; }
    }
}

__device__ __forceinline__ void phase_fin_mla(Frame& F, int li) { WS_DECL; frame_refresh(F);
    const int nrows = li == DEPTH - 1 ? NL : NT; const float* g = in_ptr(I_MLAON) + li * 256; const bf16* AO = WSP(bf16, WS_AO); bf16* MIX = WSP(bf16, WS_A1);
    const int gw = blockIdx.x * NWAVES + F.wave, NGW = F.G * NWAVES; const f32x4 g4 = *(const GAS f32x4*)(g + 4 * F.lane);
    for (int m = gw; m < nrows; m += NGW) { const v2u w = *(const GAS v2u*)(AO + (size_t)m * 256 + 4 * F.lane);
        f32x4 x; x.x = bflo(w.x); x.y = bfhi(w.x); x.z = bflo(w.y); x.w = bfhi(w.y);
        const float r = rsqrtf(wave_sum(x.x * x.x + x.y * x.y + x.z * x.z + x.w * x.w) * (1.f / 256.f) + 1e-6f);
        v2u o; o.x = pk2(x.x * r * g4.x, x.y * r * g4.y); o.y = pk2(x.z * r * g4.z, x.w * r * g4.w); *(GAS v2u*)(MIX + (size_t)m * D + 4 * F.lane) = o; }
}
__device__ __forceinline__ void phase_fin_zero(Frame& F, int li, int c0) { WS_DECL; frame_refresh(F);
    const int nrows = li == DEPTH - 1 ? NL : NT; bf16* MIX = WSP(bf16, WS_A1); const int gw = blockIdx.x * NWAVES + F.wave, NGW = F.G * NWAVES;
    for (int m = gw; m < nrows; m += NGW) *(GAS v2u*)(MIX + (size_t)m * D + c0 + 4 * F.lane) = (v2u){0u, 0u};
}

__device__ __forceinline__ void phase_pro0b(Frame& F) { WS_DECL; frame_refresh(F);
    const int gt = blockIdx.x * NTHR + F.tid, NGT = F.G * NTHR;
    float* RC = WSP(float, WS_ROPE); float* RS = RC + 4096 * 16;
    for (int i = gt; i < 4096 * 16; i += NGT) { const int t = i >> 4, j = i & 15; const float inv = powf(10000.f, -(float)(j & 7) / 8.f); const float pos = j < 8 ? (float)(t >> 6) : (float)(t & 63);
        const float ang = pos * inv; RC[i] = cosf(ang); RS[i] = sinf(ang); }
    const float* wuq = in_ptr(I_WUQ); const float* wukv = in_ptr(I_WUKV); bf16* WQ = WSP(bf16, WS_WUQT); bf16* WKV = WSP(bf16, WS_WUKVT);
    for (int i = gt; i < DEPTH * 384 * 192; i += NGT) { const int li = i / (384 * 192), r = i % (384 * 192), n = r / 192, k = r % 192; WQ[i] = (bf16)f2bf(wuq[(size_t)li * 192 * 384 + (size_t)k * 384 + n]); }
    for (int i = gt; i < DEPTH * 512 * 128; i += NGT) { const int li = i / (512 * 128), r = i % (512 * 128), n = r / 128, k = r % 128; WKV[i] = (bf16)f2bf(wukv[(size_t)li * 128 * 512 + (size_t)k * 512 + n]); }
}

constexpr int LR_LD = 264;
__device__ __forceinline__ float gelu_tanh(float x) { const float u = 0.7978845608028654f * (x + 0.044715f * x * x * x); const float e = __expf(2.f * u); const float t = 1.f - 2.f / (e + 1.f); return 0.5f * x * (1.f + t); }
template <int PASS>
__device__ __forceinline__ void phase_lru(Frame& F, int li) { WS_DECL; frame_refresh(F);
    LAS bf16* RAW = (LAS bf16*)F.lds; LAS bf16* U = (LAS bf16*)(F.lds + 67 * LR_LD * 2); LAS bf16* HS = (LAS bf16*)(F.lds + 71680);
    const bf16* P = WSP(bf16, WS_P); bf16* MIX = WSP(bf16, WS_A1); f32x2* SUMM = WSP(f32x2, WS_SUMM);
    const float* cw = in_ptr(I_LCW) + li * 4 * 256; const float* cb = in_ptr(I_LCB) + li * 256;
    const float* lam_ = in_ptr(I_LLAM) + li * 512; const float* br_ = in_ptr(I_LBR) + li * 512; const float* bi_ = in_ptr(I_LBI) + li * 512; const float* on_ = in_ptr(I_LON) + li * 256;
    const bf16* LW = WSP(bf16, WS_LRUW) + (size_t)li * 16 * 4096;
    const int lane = F.lane, wave = F.wave, tid = F.tid, fr = lane & 15, kg = lane >> 4;
    const int nitems = (PASS == 3 && li == DEPTH - 1) ? NL / 64 : NT / 64;
    for (int item = blockIdx.x; item < nitems; item += F.G) {
        const int m0 = item * 64; const bool isctx = m0 >= NL; const int b = isctx ? (m0 - NL) >> 8 : m0 >> 12; const int t0 = isctx ? (m0 - NL) & 255 : m0 & 4095; const int Ls = isctx ? 256 : 4096;
        const size_t seg0 = isctx ? (size_t)NL + b * 256 : (size_t)b * 4096;
        for (int c = tid; c < 67 * 32; c += NTHR) { const int r = c >> 5, cc = c & 31, t = t0 - 2 + r; v4u v = (v4u){0u, 0u, 0u, 0u};
            if (t >= 0 && t < Ls) v = *(const GAS v4u*)(P + (seg0 + t) * PCOLS + 352 + 8 * cc);
            *(LAS v4u*)(RAW + r * LR_LD + 8 * cc) = v; }
        __syncthreads();
        { const int c2 = tid & 127, tq = tid >> 7; const int ch = 2 * c2;
          float w0[4], w1[4];
#pragma unroll
          for (int j = 0; j < 4; ++j) { w0[j] = cw[j * 256 + ch]; w1[j] = cw[j * 256 + ch + 1]; }
          const float b0 = cb[ch], b1 = cb[ch + 1];
          for (int t = tq * 16; t < tq * 16 + 16; ++t) { float s0 = b0, s1 = b1;
#pragma unroll
              for (int j = 0; j < 4; ++j) { const unsigned w = *(const LAS unsigned*)(RAW + (t + j) * LR_LD + ch); s0 += w0[j] * bflo(w); s1 += w1[j] * bfhi(w); }
              *(LAS unsigned*)(U + t * LR_LD + ch) = pk2(s0, s1); } }
        __syncthreads();
#pragma unroll 1
        for (int ni = 0; ni < 2; ++ni) {
            float yv[4][4];
            const int nt = 2 * wave + ni, nb = nt >> 2, ch = 16 * nt + fr;
            bf16x8 wfr[2][2][2]; float spc[2], brc[2], bic[2];
#pragma unroll
            for (int d = 0; d < 2; ++d) { spc[d] = lam_[d * 256 + ch]; brc[d] = br_[d * 256 + ch]; bic[d] = bi_[d * 256 + ch];
#pragma unroll
                for (int g = 0; g < 2; ++g)
#pragma unroll
                    for (int ks = 0; ks < 2; ++ks) wfr[d][g][ks] = *(const GAS bf16x8*)(LW + ((size_t)((g * 2 + d) * 4 + nb) * 64 + 16 * (nt & 3) + fr) * 64 + 32 * ks + 8 * kg); }
            float uu[4][4];
#pragma unroll
            for (int m = 0; m < 4; ++m)
#pragma unroll
                for (int r = 0; r < 4; ++r) uu[m][r] = bf2f(U[(16 * m + 4 * kg + r) * LR_LD + ch]);
#pragma unroll
            for (int d = 0; d < 2; ++d) {
                f32x4 ar[4], ai[4];
#pragma unroll
                for (int m = 0; m < 4; ++m) { ar[m] = (f32x4){0.f, 0.f, 0.f, 0.f}; ai[m] = (f32x4){0.f, 0.f, 0.f, 0.f}; }
#pragma unroll
                for (int ks = 0; ks < 2; ++ks) {
                    const bf16x8 wr = wfr[d][0][ks], wi = wfr[d][1][ks];
#pragma unroll
                    for (int m = 0; m < 4; ++m) { const bf16x8 xf = *(const LAS bf16x8*)(U + (16 * m + fr) * LR_LD + 64 * nb + 32 * ks + 8 * kg);
                        ar[m] = __builtin_amdgcn_mfma_f32_16x16x32_bf16(xf, wr, ar[m], 0, 0, 0); ai[m] = __builtin_amdgcn_mfma_f32_16x16x32_bf16(xf, wi, ai[m], 0, 0, 0); } }
                const float sp = log1pf(__expf(-spc[d])), brv = brc[d], biv = bic[d];
#pragma unroll
                for (int m = 0; m < 4; ++m)
#pragma unroll
                    for (int r = 0; r < 4; ++r) { const float rg = __builtin_amdgcn_rcpf(1.f + __expf(-(ar[m][r] + brv))), ig = __builtin_amdgcn_rcpf(1.f + __expf(-(ai[m][r] + biv))); const float av = __expf(-8.f * rg * sp);
                        ar[m][r] = av; ai[m][r] = __builtin_amdgcn_sqrtf(fmaxf(1.f - av * av, 0.f)) * (ig * uu[m][r]); }
                float H = 0.f;
                if (PASS == 3) {
                    const int cj = t0 >> 6, cbase = 1024 + b * 4, lbase = b * 64;
                    const int np = d == 0 ? (isctx ? cj : 4 + cj) : (isctx ? 3 - cj : 4 + 63 - cj);
                    const int q = (np + 3) >> 2, p_lo = kg * q, p_hi = (p_lo + q < np) ? p_lo + q : np;
                    float Aq = 1.f, Bq = 0.f;
                    for (int p0 = p_lo; p0 < p_hi; p0 += 8) { f32x2 sv[8];
#pragma unroll
                        for (int e = 0; e < 8; ++e) { const int p = p0 + e; sv[e] = (f32x2){1.f, 0.f};
                            if (p < p_hi) { int cid; if (d == 0) cid = isctx ? cbase + p : (p < 4 ? cbase + p : lbase + (p - 4)); else cid = isctx ? cbase + 3 - p : (p < 4 ? cbase + 3 - p : lbase + 63 - (p - 4));
                                sv[e] = *(const GAS f32x2*)(SUMM + ((size_t)cid * 2 + d) * 256 + ch); } }
#pragma unroll
                        for (int e = 0; e < 8; ++e) { Bq = sv[e].x * Bq + sv[e].y; Aq = sv[e].x * Aq; } }
#pragma unroll
                    for (int g = 0; g < 4; ++g) { const float Ag_ = __shfl(Aq, fr + 16 * g), Bg_ = __shfl(Bq, fr + 16 * g); H = Ag_ * H + Bg_; }
                }
                float Ac = 1.f, Bc = 0.f;
#pragma unroll
                for (int mi = 0; mi < 4; ++mi) { const int m = d == 0 ? mi : 3 - mi;
                    float Al, Bl;
                    if (d == 0) { Al = ar[m][0] * ar[m][1] * ar[m][2] * ar[m][3]; Bl = ((ai[m][0] * ar[m][1] + ai[m][1]) * ar[m][2] + ai[m][2]) * ar[m][3] + ai[m][3]; }
                    else { Al = ar[m][0] * ar[m][1] * ar[m][2] * ar[m][3]; Bl = ((ai[m][3] * ar[m][2] + ai[m][2]) * ar[m][1] + ai[m][1]) * ar[m][0] + ai[m][0]; }
                    float Ag[4], Bg[4];
#pragma unroll
                    for (int g = 0; g < 4; ++g) { Ag[g] = __shfl(Al, fr + 16 * g); Bg[g] = __shfl(Bl, fr + 16 * g); }
                    if (PASS == 1) {
                        float At = 1.f, Bt = 0.f;
#pragma unroll
                        for (int gi = 0; gi < 4; ++gi) { const int g = d == 0 ? gi : 3 - gi; Bt = Ag[g] * Bt + Bg[g]; At = Ag[g] * At; }
                        Bc = At * Bc + Bt; Ac = At * Ac;
                    } else {
                        float s = H, sin_ = H;
#pragma unroll
                        for (int gi = 0; gi < 4; ++gi) { const int g = d == 0 ? gi : 3 - gi; if (g == kg) sin_ = s; s = Ag[g] * s + Bg[g]; }
                        H = s;
                        float x = sin_;
#pragma unroll
                        for (int ri = 0; ri < 4; ++ri) { const int r = d == 0 ? ri : 3 - ri; x = ar[m][r] * x + ai[m][r]; if (d == 0) yv[m][r] = x; else yv[m][r] += x; }
                    }
                }
                if (PASS == 1 && kg == 0) *(GAS f32x2*)(SUMM + ((size_t)item * 2 + d) * 256 + ch) = (f32x2){Ac, Bc};
            }
            if (PASS == 3) {
#pragma unroll
                for (int m = 0; m < 4; ++m)
#pragma unroll
                    for (int r = 0; r < 4; ++r) HS[(16 * m + 4 * kg + r) * LR_LD + ch] = (bf16)f2bf(yv[m][r]);
            }
        }
        if (PASS == 3) {
            __syncthreads();
            const f32x4 on4 = *(const GAS f32x4*)(on_ + 4 * lane);
            for (int i = 0; i < 8; ++i) { const int tl = wave * 8 + i; const v2u hw = *(const LAS v2u*)(HS + tl * LR_LD + 4 * lane); const v2u gw = *(const GAS v2u*)(P + (size_t)(m0 + tl) * PCOLS + 608 + 4 * lane);
                f32x4 y; y.x = bflo(hw.x) * gelu_tanh(bflo(gw.x)); y.y = bfhi(hw.x) * gelu_tanh(bfhi(gw.x)); y.z = bflo(hw.y) * gelu_tanh(bflo(gw.y)); y.w = bfhi(hw.y) * gelu_tanh(bfhi(gw.y));
                const float rs = rsqrtf(wave_sum(y.x * y.x + y.y * y.y + y.z * y.z + y.w * y.w) * (1.f / 256.f) + 1e-6f);
                v2u o; o.x = pk2(y.x * rs * on4.x, y.y * rs * on4.y); o.y = pk2(y.z * rs * on4.z, y.w * rs * on4.w);
                *(GAS v2u*)(MIX + (size_t)(m0 + tl) * D + 256 + 4 * lane) = o; }
        }
        __syncthreads();
    }
}

__device__ __forceinline__ void phase_pro0c(Frame& F) { WS_DECL; frame_refresh(F);
    const int gt = blockIdx.x * NTHR + F.tid, NGT = F.G * NTHR; const float* wr = in_ptr(I_LWR); const float* wi = in_ptr(I_LWI); bf16* LW = WSP(bf16, WS_LRUW);
    for (int i = gt; i < DEPTH * 16 * 4096; i += NGT) { const int c = i & 63, dd = (i >> 6) & 63, nb = (i >> 12) & 3, d = (i >> 14) & 1, g = (i >> 15) & 1, li = i >> 16;
        const float* src = g == 0 ? wr : wi; LW[i] = (bf16)f2bf(src[((((size_t)li * 2 + d) * 4 + nb) * 64 + c) * 64 + dd]); }
}

template <int CTRL> __device__ __forceinline__ float dpp_f(float x) { return __builtin_bit_cast(float, __builtin_amdgcn_mov_dpp(__builtin_bit_cast(int, x), CTRL, 0xf, 0xf, true)); }
__device__ __forceinline__ float rowsum16(float x) { x += dpp_f<0x128>(x); x += dpp_f<0x124>(x); x += dpp_f<0x122>(x); x += dpp_f<0x121>(x); return x; }
constexpr int RW_C0 = 864;
constexpr size_t WS_RWUP = WS_LRUW + 512 * 1024;
constexpr size_t WS_EA = WS_Y;

__device__ __forceinline__ void phase_pro0e(Frame& F) { WS_DECL; frame_refresh(F);
    const int gt = blockIdx.x * NTHR + F.tid, NGT = F.G * NTHR; const float* wup = in_ptr(I_WUP); const float* aup = in_ptr(I_AUP); bf16* W = WSP(bf16, WS_RWUP);
    for (int i = gt; i < DEPTH * 2 * 2 * 256 * 32; i += NGT) { const int k = i & 31, n = (i >> 5) & 255, wa = (i >> 13) & 1, d = (i >> 14) & 1, li = i >> 15;
        const float* src = wa == 0 ? wup : aup; W[i] = (bf16)f2bf(src[(((size_t)li * 2 + d) * 32 + k) * 256 + n]); }
}

constexpr int R0_LD = 136, R0_ZLD = 72;
__device__ __forceinline__ void phase_rwkv_r0(Frame& F, int li) { WS_DECL; frame_refresh(F);
    LAS bf16* RAWL = (LAS bf16*)F.lds;
    LAS bf16* ZW = (LAS bf16*)(F.lds + 66 * R0_LD * 2);
    LAS bf16* ZA = ZW + 64 * R0_ZLD;
    const bf16* P = WSP(bf16, WS_P); bf16* EA = WSP(bf16, WS_EA); const bf16* W = WSP(bf16, WS_RWUP) + (size_t)li * 2 * 2 * 256 * 32;
    const float* mup = in_ptr(I_MUP) + li * 960 + 768; const float* mun = in_ptr(I_MUN) + li * 960 + 768; const float* w0 = in_ptr(I_W0) + li * 512; const float* a0 = in_ptr(I_A0) + li * 512;
    const int tid = F.tid, lane = F.lane, wave = F.wave, fr = lane & 15, kg = lane >> 4;
    for (int item = blockIdx.x; item < NT / 64; item += F.G) {
        const int m0 = item * 64; const bool isctx = m0 >= NL; const int t0 = isctx ? (m0 - NL) & 255 : m0 & 4095; const int Ls = isctx ? 256 : 4096; const size_t seg0 = (size_t)m0 - t0;
        __syncthreads();
        for (int c = tid; c < 66 * 16; c += NTHR) { const int r = c >> 4, cc = c & 15, t = t0 - 1 + r; v4u v = (v4u){0u, 0u, 0u, 0u};
            if (t >= 0 && t < Ls) v = *(const GAS v4u*)(P + (seg0 + t) * PCOLS + RW_C0 + 768 + 8 * cc);
            *(LAS v4u*)(RAWL + r * R0_LD + 8 * cc) = v; }
        __syncthreads();
        { const int c = tid & 127, tq = tid >> 7; const float mp = mup[c], mn = mun[c];
          for (int tl = tq * 16; tl < tq * 16 + 16; ++tl) { const float x = bf2f(RAWL[(tl + 1) * R0_LD + c]), xp = bf2f(RAWL[tl * R0_LD + c]), xn = bf2f(RAWL[(tl + 2) * R0_LD + c]);
              const float z = x + mp * (xp - x) + mn * (xn - x);
              if (c < 64) { const float e2 = __expf(2.f * z); ZW[tl * R0_ZLD + c] = (bf16)f2bf(1.f - 2.f * __builtin_amdgcn_rcpf(e2 + 1.f)); } else ZA[tl * R0_ZLD + (c - 64)] = (bf16)f2bf(z); } }
        __syncthreads();
        const int d = wave >> 2, hh = wave & 3;
#pragma unroll 1
        for (int nt = 0; nt < 4; ++nt) { const int ch0 = 64 * hh + 16 * nt;
            const bf16x8 wf = *(const GAS bf16x8*)(W + ((size_t)(d * 2 + 0) * 256 + ch0 + fr) * 32 + 8 * kg), af = *(const GAS bf16x8*)(W + ((size_t)(d * 2 + 1) * 256 + ch0 + fr) * 32 + 8 * kg);
            const f32x4 w04 = *(const GAS f32x4*)(w0 + d * 256 + ch0 + 4 * kg), a04 = *(const GAS f32x4*)(a0 + d * 256 + ch0 + 4 * kg);
#pragma unroll
            for (int m = 0; m < 4; ++m) { const bf16x8 zw = *(const LAS bf16x8*)(ZW + (16 * m + fr) * R0_ZLD + 32 * d + 8 * kg), za = *(const LAS bf16x8*)(ZA + (16 * m + fr) * R0_ZLD + 32 * d + 8 * kg);
                f32x4 xw = __builtin_amdgcn_mfma_f32_16x16x32_bf16(wf, zw, (f32x4){0.f, 0.f, 0.f, 0.f}, 0, 0, 0), xa = __builtin_amdgcn_mfma_f32_16x16x32_bf16(af, za, (f32x4){0.f, 0.f, 0.f, 0.f}, 0, 0, 0);
                xw = xw + w04; xa = xa + a04; float e[4], av[4];
#pragma unroll
                for (int r = 0; r < 4; ++r) { const float sg = __builtin_amdgcn_rcpf(1.f + __expf(-xw[r])); e[r] = -expm1f(-0.6065306597126334f * sg); av[r] = __builtin_amdgcn_rcpf(1.f + __expf(-xa[r])); }
                const size_t tok = (size_t)m0 + 16 * m + fr; v2u oe, oa; oe.x = pk2(e[0], e[1]); oe.y = pk2(e[2], e[3]); oa.x = pk2(av[0], av[1]); oa.y = pk2(av[2], av[3]);
                *(GAS v2u*)(EA + (tok * 4 + d) * 256 + ch0 + 4 * kg) = oe; *(GAS v2u*)(EA + (tok * 4 + 2 + d) * 256 + ch0 + 4 * kg) = oa; } }
    }
    __syncthreads();
}

constexpr int RW_T = 16, RW_NCH = (LCX + SEQ) / RW_T, RW_ROWS = RW_T + 2, RW_LD = 200;
constexpr int RW_RAW = 0, RW_RAWB = RW_ROWS * RW_LD * 2;
constexpr int RW_EAB = 14848, RW_EABB = RW_T * 128 * 2;
constexpr int RW_VEC = 24576, RW_VECB = RW_T * 384 * 4;
constexpr int RW_YO = RW_VEC + 2 * RW_VECB, RW_YOB = RW_T * 32 * 4;
constexpr int RW_BON = RW_YO + 2 * RW_YOB;
static_assert(2 * RW_RAWB <= RW_EAB && RW_EAB + 2 * RW_EABB <= RW_VEC, "rwkv lds map");
__device__ __forceinline__ void phase_rwkv_scan(Frame& F, int li) { WS_DECL; frame_refresh(F);
    const bf16* P = WSP(bf16, WS_P); const bf16* EA = WSP(bf16, WS_EA); float* YR = WSP(float, WS_YR); float* BON = WSP(float, WS_BON);
    const int tid = F.tid, lane = F.lane, wave = F.wave;
    for (int item = blockIdx.x; item < 256; item += F.G) {
        const int vhalf = item & 1, d = (item >> 1) & 1, h = (item >> 2) & 3, b = item >> 4;
        __syncthreads();
        const int rp = lane >> 4, kq = lane & 15, vl = 8 * wave + 2 * rp;
        const int pt = tid - 256, ps = (pt >> 4) & 15, pq = tid & 15;
        f32x4 mpr, mpk, mpv, mnr, mnk, mnv, kk_c, ka_c, rk_c;
        { const float* mup = in_ptr(I_MUP) + li * 960; const float* mun = in_ptr(I_MUN) + li * 960; const int c = 64 * h + 4 * pq;
          mpr = *(const GAS f32x4*)(mup + c); mpk = *(const GAS f32x4*)(mup + 256 + c); mpv = *(const GAS f32x4*)(mup + 512 + c);
          mnr = *(const GAS f32x4*)(mun + c); mnk = *(const GAS f32x4*)(mun + 256 + c); mnv = *(const GAS f32x4*)(mun + 512 + c);
          kk_c = *(const GAS f32x4*)(in_ptr(I_KK) + li * 256 + c); ka_c = *(const GAS f32x4*)(in_ptr(I_KA) + li * 256 + c); rk_c = *(const GAS f32x4*)(in_ptr(I_RK) + li * 256 + c); }
        f32x2 A01 = (f32x2){0.f, 0.f}, A23 = (f32x2){0.f, 0.f}, B01 = (f32x2){0.f, 0.f}, B23 = (f32x2){0.f, 0.f};
#pragma unroll 1
        for (int it = -2; it <= RW_NCH; ++it) {
            const int ca = it + 2; const bool doA = wave >= 4 && ca < RW_NCH; v4u ra[3]; int ra_c[3];
            if (doA) { const bool isctx = ca < LCX / RW_T; const int cl = isctx ? ca : ca - LCX / RW_T; const int Ls = isctx ? LCX : SEQ; const int tlo = d == 0 ? cl * RW_T : Ls - RW_T - cl * RW_T;
                const size_t seg0 = isctx ? (size_t)NL + b * LCX : (size_t)b * SEQ;
#pragma unroll
                for (int q = 0; q < 3; ++q) { const int c = pt + 256 * q; ra[q] = (v4u){0u, 0u, 0u, 0u}; ra_c[q] = c;
                    if (c < RW_ROWS * 24) { const int r = c / 24, cc = c % 24, t = tlo - 1 + r; const int col = 256 * (cc >> 3) + 64 * h + 8 * (cc & 7);
                        if (t >= 0 && t < Ls) ra[q] = *(const GAS v4u*)(P + (seg0 + t) * PCOLS + RW_C0 + col); }
                    else if (c < RW_ROWS * 24 + RW_T * 16) { const int e = c - RW_ROWS * 24, s = e >> 4, cc = e & 15; const int t = d == 0 ? tlo + s : tlo + RW_T - 1 - s;
                        ra[q] = *(const GAS v4u*)(EA + ((seg0 + t) * 4 + (cc >> 3) * 2 + d) * 256 + 64 * h + 8 * (cc & 7)); } } }
            if (wave < 4 && it >= 0 && it < RW_NCH) {
                const LAS float* VEC = (const LAS float*)(F.lds + RW_VEC + (it & 1) * RW_VECB); LAS float* YO = (LAS float*)(F.lds + RW_YO + (it & 1) * RW_YOB);
#pragma unroll 1
                for (int g = 0; g < RW_T / 4; ++g) { f32x4 kk4[4], dec4[4], kka4[4], kd4[4], r4[4]; f32x2 vv[4], yo[4];
#pragma unroll
                    for (int j = 0; j < 4; ++j) { const LAS float* vs = VEC + (4 * g + j) * 384 + 4 * kq;
                        kk4[j] = *(const LAS f32x4*)(vs); dec4[j] = *(const LAS f32x4*)(vs + 64); kka4[j] = *(const LAS f32x4*)(vs + 128); kd4[j] = *(const LAS f32x4*)(vs + 192); r4[j] = *(const LAS f32x4*)(vs + 256);
                        vv[j] = *(const LAS f32x2*)(VEC + (4 * g + j) * 384 + 320 + 32 * vhalf + vl); }
#pragma unroll
                    for (int j = 0; j < 4; ++j) {
                        const f32x2 kk01 = (f32x2){kk4[j].x, kk4[j].y}, kk23 = (f32x2){kk4[j].z, kk4[j].w}, de01 = (f32x2){dec4[j].x, dec4[j].y}, de23 = (f32x2){dec4[j].z, dec4[j].w};
                        const f32x2 ka01 = (f32x2){kka4[j].x, kka4[j].y}, ka23 = (f32x2){kka4[j].z, kka4[j].w}, kd01 = (f32x2){kd4[j].x, kd4[j].y}, kd23 = (f32x2){kd4[j].z, kd4[j].w}, r01 = (f32x2){r4[j].x, r4[j].y}, r23 = (f32x2){r4[j].z, r4[j].w};
                        const f32x2 pa = A01 * kk01 + A23 * kk23, pb = B01 * kk01 + B23 * kk23;
                        const float sa = rowsum16(pa.x + pa.y), sb = rowsum16(pb.x + pb.y);
                        A01 = A01 * de01 + (kd01 * vv[j].x - ka01 * sa); A23 = A23 * de23 + (kd23 * vv[j].x - ka23 * sa);
                        B01 = B01 * de01 + (kd01 * vv[j].y - ka01 * sb); B23 = B23 * de23 + (kd23 * vv[j].y - ka23 * sb);
                        const f32x2 ya = A01 * r01 + A23 * r23, yb = B01 * r01 + B23 * r23;
                        yo[j] = (f32x2){rowsum16(ya.x + ya.y), rowsum16(yb.x + yb.y)}; }
                    if (kq == 0) {
#pragma unroll
                        for (int j = 0; j < 4; ++j) *(LAS f32x2*)(YO + (4 * g + j) * 32 + vl) = yo[j]; } }
            }
            const int cb = it + 1;
            if (wave >= 4 && cb >= 0 && cb < RW_NCH) {
                const LAS bf16* RAW = (const LAS bf16*)(F.lds + RW_RAW + (cb & 1) * RW_RAWB); const LAS bf16* EAB = (const LAS bf16*)(F.lds + RW_EAB + (cb & 1) * RW_EABB);
                LAS float* VEC = (LAS float*)(F.lds + RW_VEC + (cb & 1) * RW_VECB); LAS float* BONS = (LAS float*)(F.lds + RW_BON) + (cb & 3) * RW_T;
                const int prow = d == 0 ? ps + 1 : RW_T - ps;
                f32x4 zr, zk, zv;
                { const LAS bf16* r0 = RAW + prow * RW_LD + 4 * pq;
#define RW_LD4(p) ({ const v2u w_ = *(const LAS v2u*)(p); (f32x4){bflo(w_.x), bfhi(w_.x), bflo(w_.y), bfhi(w_.y)}; })
                  { const f32x4 x = RW_LD4(r0), xp = RW_LD4(r0 - RW_LD), xn = RW_LD4(r0 + RW_LD); zr = x + mpr * (xp - x) + mnr * (xn - x); }
                  { const f32x4 x = RW_LD4(r0 + 64), xp = RW_LD4(r0 + 64 - RW_LD), xn = RW_LD4(r0 + 64 + RW_LD); zk = x + mpk * (xp - x) + mnk * (xn - x); }
                  { const f32x4 x = RW_LD4(r0 + 128), xp = RW_LD4(r0 + 128 - RW_LD), xn = RW_LD4(r0 + 128 + RW_LD); zv = x + mpv * (xp - x) + mnv * (xn - x); } }
                const f32x4 e4 = RW_LD4(EAB + ps * 128 + 4 * pq), a4 = RW_LD4(EAB + ps * 128 + 64 + 4 * pq);
                const f32x4 kkr = zk * kk_c; const float ss = rowsum16((kkr.x * kkr.x + kkr.y * kkr.y) + (kkr.z * kkr.z + kkr.w * kkr.w));
                const f32x4 kd = zk * ((a4 - 1.f) * ka_c + 1.f); const f32x4 bq = zr * kd * rk_c; const float bn = rowsum16((bq.x + bq.y) + (bq.z + bq.w));
                const f32x4 kkn = kkr * rsqrtf(fmaxf(ss, 1e-24f));
                LAS float* vs = VEC + ps * 384 + 4 * pq;
                *(LAS f32x4*)(vs) = kkn; *(LAS f32x4*)(vs + 64) = 1.f - e4; *(LAS f32x4*)(vs + 128) = kkn * a4; *(LAS f32x4*)(vs + 192) = kd; *(LAS f32x4*)(vs + 256) = zr; *(LAS f32x4*)(vs + 320) = zv;
                if (pq == 0) BONS[ps] = bn;
            }
            if (wave >= 4) {
                const int ce = it - 1;
                if (ce >= 0 && ce < RW_NCH) { const bool isctx = ce < LCX / RW_T;
                    if (!isctx || li < DEPTH - 1) { const int cl = isctx ? ce : ce - LCX / RW_T; const int Ls = isctx ? LCX : SEQ; const int tlo = d == 0 ? cl * RW_T : Ls - RW_T - cl * RW_T; const size_t seg0 = isctx ? (size_t)NL + b * LCX : (size_t)b * SEQ;
                        const LAS float* YO = (const LAS float*)(F.lds + RW_YO + (ce & 1) * RW_YOB); const LAS float* BONS = (const LAS float*)(F.lds + RW_BON) + (ce & 3) * RW_T;
                        const int s = pt >> 4, pr = pt & 15; const int t = d == 0 ? tlo + s : tlo + RW_T - 1 - s; const size_t row = seg0 + t;
                        *(GAS f32x2*)(YR + ((size_t)d * NT + row) * 256 + 64 * h + 32 * vhalf + 2 * pr) = *(const LAS f32x2*)(YO + s * 32 + 2 * pr);
                        if (vhalf == 0 && pr == 0) BON[((size_t)d * NT + row) * 4 + h] = BONS[s]; } }
                if (doA) { LAS bf16* RAWW = (LAS bf16*)(F.lds + RW_RAW + (ca & 1) * RW_RAWB); LAS bf16* EAW = (LAS bf16*)(F.lds + RW_EAB + (ca & 1) * RW_EABB);
#pragma unroll
                    for (int q = 0; q < 3; ++q) { const int c = ra_c[q];
                        if (c < RW_ROWS * 24) *(LAS v4u*)(RAWW + (c / 24) * RW_LD + 8 * (c % 24)) = ra[q];
                        else if (c < RW_ROWS * 24 + RW_T * 16) { const int e = c - RW_ROWS * 24; *(LAS v4u*)(EAW + 8 * e) = ra[q]; } } }
            }
            __syncthreads();
        }
    }
}

__device__ __forceinline__ void phase_fin_rwkv(Frame& F, int li) { WS_DECL; frame_refresh(F);
    const int nrows = li == DEPTH - 1 ? NL : NT; const int lane = F.lane, wave = F.wave, tid = F.tid;
    LAS float* GUP = (LAS float*)F.lds;
    LAS float* SG = (LAS float*)(F.lds + 65536) + wave * 64;
    const bf16* P = WSP(bf16, WS_P); const float* YR = WSP(float, WS_YR); const float* BON = WSP(float, WS_BON); bf16* MIX = WSP(bf16, WS_A1);
    { const float* gup = in_ptr(I_GUP) + (size_t)li * 64 * 256; for (int i = tid; i < 64 * 256; i += NTHR) GUP[i] = gup[i]; }
    const float* mup = in_ptr(I_MUP) + li * 960; const float* mun = in_ptr(I_MUN) + li * 960;
    const f32x4 mpv = *(const GAS f32x4*)(mup + 512 + 4 * lane), mnv = *(const GAS f32x4*)(mun + 512 + 4 * lane);
    const float mpg = mup[896 + lane], mng = mun[896 + lane];
    const f32x4 lg = *(const GAS f32x4*)(in_ptr(I_LNG) + li * 256 + 4 * lane), lb = *(const GAS f32x4*)(in_ptr(I_LNB) + li * 256 + 4 * lane);
    __syncthreads();
    const int gw = blockIdx.x * NWAVES + wave, NGW = F.G * NWAVES;
    for (int m = gw; m < nrows; m += NGW) {
        const bool isctx = m >= NL; const int t = isctx ? (m - NL) & 255 : m & 4095; const int Ls = isctx ? 256 : 4096;
        const bf16* pr = P + (size_t)m * PCOLS + RW_C0;
        const bool hp = t > 0, hn = t + 1 < Ls;
        f32x4 v;
        { const v2u w = *(const GAS v2u*)(pr + 512 + 4 * lane); v2u wp = (v2u){0u, 0u}, wn = (v2u){0u, 0u};
          if (hp) wp = *(const GAS v2u*)(pr - PCOLS + 512 + 4 * lane); if (hn) wn = *(const GAS v2u*)(pr + PCOLS + 512 + 4 * lane);
          const f32x4 x = (f32x4){bflo(w.x), bfhi(w.x), bflo(w.y), bfhi(w.y)}, xp = (f32x4){bflo(wp.x), bfhi(wp.x), bflo(wp.y), bfhi(wp.y)}, xn = (f32x4){bflo(wn.x), bfhi(wn.x), bflo(wn.y), bfhi(wn.y)};
          v = x + mpv * (xp - x) + mnv * (xn - x); }
        { const float x = bf2f(pr[896 + lane]); const float xp = hp ? bf2f(pr[896 + lane - PCOLS]) : 0.f, xn = hn ? bf2f(pr[896 + lane + PCOLS]) : 0.f;
          SG[lane] = sigmoidf_(x + mpg * (xp - x) + mng * (xn - x)); }
        LDS_WAIT();
        f32x4 g = (f32x4){0.f, 0.f, 0.f, 0.f};
#pragma unroll 8
        for (int j = 0; j < 64; ++j) { const float sj = SG[j]; const f32x4 gu = *(const LAS f32x4*)(GUP + j * 256 + 4 * lane); g = g + gu * sj; }
        const f32x4 y = *(const GAS f32x4*)(YR + (size_t)m * 256 + 4 * lane) + *(const GAS f32x4*)(YR + ((size_t)NT + m) * 256 + 4 * lane);
        const float mean = rowsum16((y.x + y.y) + (y.z + y.w)) * (1.f / 64.f);
        const f32x4 yc = y - mean; const float var = rowsum16((yc.x * yc.x + yc.y * yc.y) + (yc.z * yc.z + yc.w * yc.w)) * (1.f / 64.f);
        const f32x4 yn = yc * rsqrtf(var + 64e-5f) * lg + lb;
        const int hh = lane >> 4; const float bon = BON[(size_t)m * 4 + hh] + BON[((size_t)NT + m) * 4 + hh];
        const f32x4 o = (yn + v * bon) * g;
        v2u ow; ow.x = pk2(o.x, o.y); ow.y = pk2(o.z, o.w); *(GAS v2u*)(MIX + (size_t)m * D + 512 + 4 * lane) = ow;
        LDS_WAIT();
    }
    __syncthreads();
}

constexpr float HY_DMIN = -3.0701134573253945f, HY_DMAX = -15.350567286626973f;
constexpr int HY_X = 0, HY_TW = 65536, HY_W3 = 98304;
__device__ __forceinline__ float hy_delta(int ch) { return -(HY_DMIN + (float)ch * ((HY_DMAX - HY_DMIN) / 255.f)); }

__device__ __forceinline__ void phase_pro0d(Frame& F) { WS_DECL; frame_refresh(F);
    const int lane = F.lane; const int gw = blockIdx.x * NWAVES + F.wave, NGW = F.G * NWAVES;
    const float* w1 = in_ptr(I_HW1); const float* b1 = in_ptr(I_HB1); const float* w2 = in_ptr(I_HW2); const float* b2 = in_ptr(I_HB2);
    for (int it = gw; it < DEPTH * (SEQ + LCX); it += NGW) {
        const int li = it / (SEQ + LCX), r = it % (SEQ + LCX); const bool isctx = r >= SEQ; const int l = isctx ? r - SEQ : r; const int L = isctx ? LCX : SEQ;
        float z = 0.f;
        if (lane == 0) z = (float)l / (float)(L - 1);
        else if (lane < 33) { const int i = (lane - 1) & 15; const float band = 1e-4f + (float)i * ((15.f - 1e-4f) / 15.f); const float ang = band * (6.283185307179586f / (float)L) * (float)l; z = lane < 17 ? cosf(ang) : -sinf(ang); }
        float h1 = b1[li * 64 + lane];
        for (int i = 0; i < 33; ++i) h1 += __shfl(z, i) * w1[(li * 33 + i) * 64 + lane];
        h1 = sinf(h1);
        float h2 = b2[li * 64 + lane];
        for (int i = 0; i < 64; ++i) h2 += __shfl(h1, i) * w2[(li * 64 + i) * 64 + lane];
        h2 = sinf(h2);
        float* dst = isctx ? WSP(float, WS_H2C) + ((size_t)li * LCX + l) * 64 : WSP(float, WS_H2L) + ((size_t)li * SEQ + l) * 64;
        dst[lane] = h2;
    }
}

typedef f32x2 cpx;
__device__ __forceinline__ cpx cmul(cpx a, cpx b) { return (cpx){a.x * b.x - a.y * b.y, a.x * b.y + a.y * b.x}; }
__device__ __forceinline__ cpx cmulc(cpx a, cpx b) { return (cpx){a.x * b.x + a.y * b.y, a.y * b.x - a.x * b.y}; }
__device__ __forceinline__ cpx cmi(cpx z) { return (cpx){z.y, -z.x}; }
__device__ __forceinline__ int hy_p(int n) { return n ^ ((n >> 5) & 7) ^ (((n >> 6) & 3) << 3); }
__device__ __forceinline__ void hy_build_tw(Frame& F) {
    LAS cpx* TW = (LAS cpx*)(F.lds + HY_TW);
    for (int k = F.tid; k < 4096; k += NTHR) { float sn, cs; sincospif((float)k * (1.f / 4096.f), &sn, &cs); TW[k] = (cpx){cs, -sn}; }
}
__device__ __forceinline__ void dft4(cpx x0, cpx x1, cpx x2, cpx x3, cpx& X0, cpx& X1, cpx& X2, cpx& X3) {
    const cpx t0 = x0 + x2, t1 = x0 - x2, t2 = x1 + x3, t3 = cmi(x1 - x3); X0 = t0 + t2; X1 = t1 + t3; X2 = t0 - t2; X3 = t1 - t3; }
__device__ __forceinline__ void dft8(cpx (&a)[8]) {
    const float R2 = 0.7071067811865476f; cpx e[4], o[4];
    dft4(a[0] + a[4], a[1] + a[5], a[2] + a[6], a[3] + a[7], e[0], e[1], e[2], e[3]);
    const cpx d1 = a[1] - a[5], d3 = a[3] - a[7];
    dft4(a[0] - a[4], (cpx){(d1.x + d1.y) * R2, (d1.y - d1.x) * R2}, cmi(a[2] - a[6]), (cpx){(d3.y - d3.x) * R2, -(d3.x + d3.y) * R2}, o[0], o[1], o[2], o[3]);
#pragma unroll
    for (int m = 0; m < 4; ++m) { a[2 * m] = e[m]; a[2 * m + 1] = o[m]; }
}
__device__ __forceinline__ void dft16(cpx (&a)[16]) {
    const float C1 = 0.9238795325112867f, S1 = 0.3826834323650898f, R2 = 0.7071067811865476f;
    cpx e[8], o[8];
#pragma unroll
    for (int k = 0; k < 8; ++k) { e[k] = a[k] + a[k + 8]; o[k] = a[k] - a[k + 8]; }
    o[1] = cmul(o[1], (cpx){C1, -S1}); o[2] = cmul(o[2], (cpx){R2, -R2}); o[3] = cmul(o[3], (cpx){S1, -C1}); o[4] = cmi(o[4]);
    o[5] = cmul(o[5], (cpx){-S1, -C1}); o[6] = cmul(o[6], (cpx){-R2, -R2}); o[7] = cmul(o[7], (cpx){-C1, -S1});
    dft8(e); dft8(o);
#pragma unroll
    for (int m = 0; m < 8; ++m) { a[2 * m] = e[m]; a[2 * m + 1] = o[m]; }
}
template <int R> __device__ __forceinline__ void cconj(cpx (&a)[R]) {
#pragma unroll
    for (int k = 0; k < R; ++k) a[k].y = -a[k].y; }
template <bool INV, bool ZU> __device__ __forceinline__ void hy_pass1(LAS cpx* X, const LAS cpx* TW, int tid) {
    cpx a[16]; const cpx w1 = TW[tid];
#pragma unroll
    for (int k = 0; k < 16; ++k) a[k] = (!INV && ZU && k >= 8) ? (cpx){0.f, 0.f} : X[hy_p(tid + 512 * k)];
    if (!INV) { dft16(a); cpx w = w1;
#pragma unroll
        for (int q = 1; q < 16; ++q) { a[q] = cmul(a[q], w); w = cmul(w, w1); }
    } else { cpx w = w1;
#pragma unroll
        for (int q = 1; q < 16; ++q) { a[q] = cmulc(a[q], w); w = cmul(w, w1); }
        cconj<16>(a); dft16(a); cconj<16>(a); }
#pragma unroll
    for (int k = 0; k < 16; ++k) if (!(INV && ZU && k >= 8)) X[hy_p(tid + 512 * k)] = a[k];
}
template <bool INV, int S, int MUL> __device__ __forceinline__ void hy_pass8(LAS cpx* X, const LAS cpx* TW, int tid) {
#pragma unroll
    for (int h = 0; h < 2; ++h) { const int bf = tid + 512 * h, sub = bf / S, j = bf % S, base = 8 * S * sub + j; cpx a[8]; const cpx w1 = TW[MUL * j];
#pragma unroll
        for (int k = 0; k < 8; ++k) a[k] = X[hy_p(base + S * k)];
        if (!INV) { dft8(a); cpx w = w1;
#pragma unroll
            for (int q = 1; q < 8; ++q) { a[q] = cmul(a[q], w); w = cmul(w, w1); }
        } else { cpx w = w1;
#pragma unroll
            for (int q = 1; q < 8; ++q) { a[q] = cmulc(a[q], w); w = cmul(w, w1); }
            cconj<8>(a); dft8(a); cconj<8>(a); }
#pragma unroll
        for (int k = 0; k < 8; ++k) X[hy_p(base + S * k)] = a[k]; }
}
__device__ __forceinline__ void hy_pass4(LAS cpx* X, int tid, const cpx* spec) {
#pragma unroll
    for (int h = 0; h < 2; ++h) { const int g = tid + 512 * h; cpx a[8];
#pragma unroll
        for (int k = 0; k < 8; ++k) a[k] = X[hy_p(8 * g + k)];
        dft8(a);
        if (spec) {
#pragma unroll
            for (int k2 = 0; k2 < 4; ++k2) { const f32x4 s4 = *(const GAS f32x4*)(spec + 8 * g + 2 * k2); a[2 * k2] = cmul(a[2 * k2], (cpx){s4.x, s4.y}); a[2 * k2 + 1] = cmul(a[2 * k2 + 1], (cpx){s4.z, s4.w}); }
            cconj<8>(a); dft8(a); cconj<8>(a); }
#pragma unroll
        for (int k = 0; k < 8; ++k) X[hy_p(8 * g + k)] = a[k]; }
}
__device__ __forceinline__ void hy_conv_fft(LAS cpx* X, const LAS cpx* TW, int tid, const cpx* spec) {
    hy_pass1<false, true>(X, TW, tid); __syncthreads();
    hy_pass8<false, 64, 16>(X, TW, tid); __syncthreads();
    hy_pass8<false, 8, 128>(X, TW, tid); __syncthreads();
    hy_pass4(X, tid, spec); __syncthreads();
    hy_pass8<true, 8, 128>(X, TW, tid); __syncthreads();
    hy_pass8<true, 64, 16>(X, TW, tid); __syncthreads();
    hy_pass1<true, true>(X, TW, tid); __syncthreads();
}

__device__ __forceinline__ void phase_hy_spec(Frame& F, int li) { WS_DECL; frame_refresh(F);
    LAS cpx* X = (LAS cpx*)(F.lds + HY_X); const LAS cpx* TW = (const LAS cpx*)(F.lds + HY_TW); LAS float* W3 = (LAS float*)(F.lds + HY_W3);
    const int tid = F.tid; const float* w3 = in_ptr(I_HW3) + (size_t)li * 64 * 1024; const float* H2 = WSP(float, WS_H2L) + (size_t)li * SEQ * 64; cpx* SPEC = WSP(cpx, WS_SPEC);
    __syncthreads();
    hy_build_tw(F);
    for (int item = blockIdx.x; item < 512; item += F.G) {
        const int o = item >> 8, ch = item & 255;
        __syncthreads();
        if (tid < 128) { const int dir = tid >> 6, j = tid & 63; W3[tid] = w3[(size_t)j * 1024 + o * 512 + dir * 256 + ch]; }
        __syncthreads();
        const float delta = hy_delta(ch);
#pragma unroll 1
        for (int i = 0; i < 8; ++i) { const int l = tid + 512 * i; const float* hr = H2 + (size_t)l * 64; float hf = 0.f, hb = 0.f;
#pragma unroll
            for (int j4 = 0; j4 < 16; ++j4) { const f32x4 h4 = *(const GAS f32x4*)(hr + 4 * j4);
                hf += h4.x * W3[4 * j4] + h4.y * W3[4 * j4 + 1] + h4.z * W3[4 * j4 + 2] + h4.w * W3[4 * j4 + 3]; hb += h4.x * W3[64 + 4 * j4] + h4.y * W3[64 + 4 * j4 + 1] + h4.z * W3[64 + 4 * j4 + 2] + h4.w * W3[64 + 4 * j4 + 3]; }
            const float win = (expf(-((float)l * (1.f / 4095.f)) * delta) + 0.05f) * (1.f / 8192.f);
            X[hy_p(l)] = (cpx){hf * win, 0.f};
            if (l == 0) X[hy_p(4096)] = (cpx){0.f, 0.f}; else X[hy_p(8192 - l)] = (cpx){hb * win, 0.f}; }
        __syncthreads();
        hy_pass1<false, false>(X, TW, tid); __syncthreads();
        hy_pass8<false, 64, 16>(X, TW, tid); __syncthreads();
        hy_pass8<false, 8, 128>(X, TW, tid); __syncthreads();
        hy_pass4(X, tid, nullptr); __syncthreads();
        cpx* dst = SPEC + (size_t)item * 8192;
#pragma unroll
        for (int i = 0; i < 16; ++i) *(GAS cpx*)(dst + tid + 512 * i) = X[hy_p(tid + 512 * i)];
    }
    __syncthreads();
}

__device__ __forceinline__ void hy_conv8(const bf16* row, int t0, int Ls, float w0, float w1, float w2, float bias, float (&out)[8]) {
    const v4u raw = *(const GAS v4u*)(row + t0); float p[10];
    p[0] = t0 > 0 ? bf2f(row[t0 - 1]) : 0.f; p[9] = t0 + 8 < Ls ? bf2f(row[t0 + 8]) : 0.f;
    p[1] = bflo(raw.x); p[2] = bfhi(raw.x); p[3] = bflo(raw.y); p[4] = bfhi(raw.y); p[5] = bflo(raw.z); p[6] = bfhi(raw.z); p[7] = bflo(raw.w); p[8] = bfhi(raw.w);
#pragma unroll
    for (int e = 0; e < 8; ++e) out[e] = bias + w0 * p[e] + w1 * p[e + 1] + w2 * p[e + 2];
}

__device__ __forceinline__ void phase_hy_conv(Frame& F, int li) { WS_DECL; frame_refresh(F);
    LAS cpx* X = (LAS cpx*)(F.lds + HY_X); const LAS cpx* TW = (const LAS cpx*)(F.lds + HY_TW);
    const int tid = F.tid; const bf16* HT = WSP(bf16, WS_HT); bf16* HOT = WSP(bf16, WS_HOT); const cpx* SPEC = WSP(cpx, WS_SPEC);
    const float* cw = in_ptr(I_HCW) + li * 3 * 768; const float* cb = in_ptr(I_HCB) + li * 768; const float* dsk = in_ptr(I_HD) + li * 512;
    __syncthreads();
    hy_build_tw(F);
    for (int item = blockIdx.x; item < 2048; item += F.G) {
        const int ch = item >> 3, bp = item & 7; const int t0 = 8 * tid;
        float v[2][8], x1[2][8], x2[2][8];
#pragma unroll
        for (int q = 0; q < 2; ++q) { const size_t boff = (size_t)(2 * bp + q) * SEQ;
            hy_conv8(HT + (size_t)ch * NT + boff, t0, SEQ, cw[ch], cw[768 + ch], cw[1536 + ch], cb[ch], v[q]);
            hy_conv8(HT + (size_t)(256 + ch) * NT + boff, t0, SEQ, cw[256 + ch], cw[768 + 256 + ch], cw[1536 + 256 + ch], cb[256 + ch], x1[q]);
            hy_conv8(HT + (size_t)(512 + ch) * NT + boff, t0, SEQ, cw[512 + ch], cw[768 + 512 + ch], cw[1536 + 512 + ch], cb[512 + ch], x2[q]); }
        const float d0 = dsk[ch], d1 = dsk[256 + ch];
        __syncthreads();
#pragma unroll
        for (int e = 0; e < 8; ++e) X[hy_p(t0 + e)] = (cpx){v[0][e], v[1][e]};
        __syncthreads();
        hy_conv_fft(X, TW, tid, SPEC + (size_t)ch * 8192);
        float u[2][8];
#pragma unroll
        for (int e = 0; e < 8; ++e) { const cpx y = X[hy_p(t0 + e)]; u[0][e] = x1[0][e] * (y.x + v[0][e] * d0); u[1][e] = x1[1][e] * (y.y + v[1][e] * d0); X[hy_p(t0 + e)] = (cpx){u[0][e], u[1][e]}; }
        __syncthreads();
        hy_conv_fft(X, TW, tid, SPEC + (size_t)(256 + ch) * 8192);
#pragma unroll
        for (int q = 0; q < 2; ++q) { float o[8];
#pragma unroll
            for (int e = 0; e < 8; ++e) { const cpx y = X[hy_p(t0 + e)]; o[e] = x2[q][e] * ((q == 0 ? y.x : y.y) + u[q][e] * d1); }
            v4u w; w.x = pk2(o[0], o[1]); w.y = pk2(o[2], o[3]); w.z = pk2(o[4], o[5]); w.w = pk2(o[6], o[7]);
            *(GAS v4u*)(HOT + (size_t)ch * NT + (size_t)(2 * bp + q) * SEQ + t0) = w; }
    }
    __syncthreads();
}

__device__ __forceinline__ void phase_hy_ctx(Frame& F, int li) { WS_DECL; frame_refresh(F);
    LAS float* KF = (LAS float*)F.lds;
    LAS float* SIG = KF + 1024;
    LAS float* W3 = KF + 2048;
    const int tid = F.tid; const bf16* HT = WSP(bf16, WS_HT); bf16* HOT = WSP(bf16, WS_HOT);
    const float* w3 = in_ptr(I_HW3) + (size_t)li * 64 * 1024; const float* H2 = WSP(float, WS_H2C) + (size_t)li * LCX * 64;
    const float* cw = in_ptr(I_HCW) + li * 3 * 768; const float* cb = in_ptr(I_HCB) + li * 768; const float* dsk = in_ptr(I_HD) + li * 512;
    for (int ch = blockIdx.x; ch < 256; ch += F.G) {
        __syncthreads();
        if (tid < 256) { const int od = tid >> 6, j = tid & 63; W3[tid] = w3[(size_t)j * 1024 + (od >> 1) * 512 + (od & 1) * 256 + ch]; }
        __syncthreads();
        { const int o = tid >> 8, l = tid & 255; const float* hr = H2 + (size_t)l * 64; float hf = 0.f, hb = 0.f;
          for (int j = 0; j < 64; ++j) { const float hv = hr[j]; hf += hv * W3[(2 * o) * 64 + j]; hb += hv * W3[(2 * o + 1) * 64 + j]; }
          const float win = expf(-((float)l * (1.f / 255.f)) * hy_delta(ch)) + 0.05f;
          KF[(2 * o) * 256 + l] = hf * win; KF[(2 * o + 1) * 256 + l] = hb * win; }
        __syncthreads();
        const int q = tid >> 8, t = tid & 255; const float d0 = dsk[ch], d1 = dsk[256 + ch];
        for (int bp = 0; bp < 8; ++bp) { const int b = 2 * bp + q; const size_t off = (size_t)NL + (size_t)b * LCX;
            float zz[3];
#pragma unroll
            for (int k = 0; k < 3; ++k) { const int c = 256 * k + ch; const bf16* row = HT + (size_t)c * NT + off;
                const float pm = t > 0 ? bf2f(row[t - 1]) : 0.f, p0 = bf2f(row[t]), pp = t + 1 < LCX ? bf2f(row[t + 1]) : 0.f;
                zz[k] = cb[c] + cw[c] * pm + cw[768 + c] * p0 + cw[1536 + c] * pp; }
            SIG[q * 256 + t] = zz[0];
            __syncthreads();
            float y = 0.f;
            for (int s = 0; s < 256; ++s) { const int lag = t - s; const float kv = lag >= 0 ? KF[lag] : KF[256 - lag]; y += kv * SIG[q * 256 + s]; }
            const float u = zz[1] * (y + zz[0] * d0);
            __syncthreads();
            SIG[q * 256 + t] = u;
            __syncthreads();
            float y2 = 0.f;
            for (int s = 0; s < 256; ++s) { const int lag = t - s; const float kv = lag >= 0 ? KF[512 + lag] : KF[768 - lag]; y2 += kv * SIG[q * 256 + s]; }
            HOT[(size_t)ch * NT + off + t] = (bf16)f2bf(zz[2] * (y2 + u * d1));
            __syncthreads();
        }
    }
    __syncthreads();
}

constexpr int HF_LD = 72;
__device__ __forceinline__ void phase_fin_hyena(Frame& F, int li) { WS_DECL; frame_refresh(F);
    LAS bf16* T = (LAS bf16*)F.lds;
    const int nrows = li == DEPTH - 1 ? NL : NT; const int tid = F.tid, lane = F.lane, wave = F.wave; const bf16* HOT = WSP(bf16, WS_HOT); bf16* MIX = WSP(bf16, WS_A1);
    const f32x4 g4 = *(const GAS f32x4*)(in_ptr(I_HON) + li * 256 + 4 * lane);
    for (int item = blockIdx.x; item < nrows / 64; item += F.G) { const int m0 = item * 64;
        __syncthreads();
        { const int ch = tid >> 1, hf = tid & 1; const bf16* src = HOT + (size_t)ch * NT + m0 + 32 * hf;
#pragma unroll
          for (int k = 0; k < 4; ++k) *(LAS v4u*)(T + ch * HF_LD + 32 * hf + 8 * k) = *(const GAS v4u*)(src + 8 * k); }
        __syncthreads();
        for (int i = 0; i < 8; ++i) { const int tl = wave * 8 + i;
            f32x4 x; x.x = bf2f(T[(4 * lane) * HF_LD + tl]); x.y = bf2f(T[(4 * lane + 1) * HF_LD + tl]); x.z = bf2f(T[(4 * lane + 2) * HF_LD + tl]); x.w = bf2f(T[(4 * lane + 3) * HF_LD + tl]);
            const float r = rsqrtf(wave_sum(x.x * x.x + x.y * x.y + x.z * x.z + x.w * x.w) * (1.f / 256.f) + 1e-6f);
            v2u o; o.x = pk2(x.x * r * g4.x, x.y * r * g4.y); o.y = pk2(x.z * r * g4.z, x.w * r * g4.w); *(GAS v2u*)(MIX + (size_t)(m0 + tl) * D + 768 + 4 * lane) = o; }
    }
    __syncthreads();
}
#define MIX_HYENA 1

__global__ void __launch_bounds__(NTHR, 2) mk_fwd(Args a) {
    extern __shared__ __attribute__((aligned(16))) unsigned char lds_raw[];
    Frame F; F.lds = (LAS unsigned char*)lds_raw; F.tid = threadIdx.x; F.lane = F.tid & 63; F.wave = __builtin_amdgcn_readfirstlane(F.tid >> 6); F.G = gridDim.x;
    for (int u = F.tid; u < (LDS_BYTES - LDSCTL_OFF) / 4; u += NTHR) ((LAS unsigned*)(F.lds + LDSCTL_OFF))[u] = 0u;
    __syncthreads();
    XcdBarrier bar = xcd_barrier_post((unsigned*)(ws_ptr() + WS_CTL) + CW_BAR, (volatile LAS unsigned*)(F.lds + LDSCTL_OFF) + 8);
#define GRID_BAR() xcd_barrier(bar)

    phase_pro0(F);
    phase_pro0b(F);
    phase_pro0c(F);
    phase_pro0d(F);
    phase_pro0e(F);
    GRID_BAR();
    phase_hin0(F);
    GRID_BAR();
    for (int li = 0; li < DEPTH; ++li) {
        const int nrows = li == DEPTH - 1 ? NL : NT; unsigned char* const ws = ws_ptr();
        phase_hy_spec(F, li);
        { pg8::Gemm g{WSP(bf16, WS_A1), WSP(bf16, WS_WINT) + (size_t)li * PCOLS * D, NT, PCOLS, D}; pg8::StaticOrder S; S.init(NT, PCOLS, F.G, (int)blockIdx.x);
          pg8::EpiStore E{WSP(bf16, WS_P), PCOLS, 0, PCOLS / 256};
          pg8::gemm_phase<pg8::EpiStore, pg8::StaticOrder, true, true>(F.lds, g, S, E); }
#if MIX_HYENA
        { pg8::Gemm g{WSP(bf16, WS_WHYT) + (size_t)li * HYC * D, WSP(bf16, WS_A1), HYC, NT, D}; pg8::StaticOrder S; S.init(HYC, NT, F.G, (int)blockIdx.x);
          pg8::EpiStore E{WSP(bf16, WS_HT), NT, 0, NT / 256};
          pg8::gemm_phase<pg8::EpiStore, pg8::StaticOrder, true, true>(F.lds, g, S, E); }
#endif
        GRID_BAR();
        phase_rwkv_r0(F, li);
        phase_mla_prep(F, li);
        phase_lru<1>(F, li);
        __syncthreads();
        phase_hy_conv(F, li);
        if (li < DEPTH - 1) phase_hy_ctx(F, li);
        GRID_BAR();
        phase_rwkv_scan(F, li);
        __syncthreads();
        phase_attn(F, li);
        __syncthreads();
        phase_lru<3>(F, li);
        GRID_BAR();
        phase_fin_mla(F, li);
        phase_fin_rwkv(F, li); phase_fin_hyena(F, li);
        GRID_BAR();
        { pg8::Gemm g{WSP(bf16, WS_A1), WSP(bf16, WS_WOUTT) + (size_t)li * D * D, nrows, D, D}; pg8::StaticOrder S; S.init(nrows, D, F.G, (int)blockIdx.x);
          pg8::EpiStore E{WSP(bf16, WS_Y), D, 0, D / 256};
          pg8::gemm_phase<pg8::EpiStore, pg8::StaticOrder, true, true>(F.lds, g, S, E); }
        GRID_BAR();
        phase_ln1<true>(F, li);
        if (li & 1) phase_moe_weights(F, li);
        GRID_BAR();
        if (!(li & 1)) {
            const int j = li >> 1;
            { pg8::Gemm g{WSP(bf16, WS_A1), WSP(bf16, WS_WGUT) + (size_t)j * 2 * FFD * D, nrows, 2 * FFD, D}; pg8::StaticOrder S; S.init(nrows, 2 * FFD, F.G, (int)blockIdx.x);
              pg8::EpiSwiGLU E{WSP(bf16, WS_H), FFD, 0, 2 * FFD / 256};
              pg8::gemm_phase<pg8::EpiSwiGLU, pg8::StaticOrder, true, true>(F.lds, g, S, E); }
            GRID_BAR();
            { pg8::Gemm g{WSP(bf16, WS_H), WSP(bf16, WS_WDT) + (size_t)j * D * FFD, nrows, D, FFD}; pg8::StaticOrder S; S.init(nrows, D, F.G, (int)blockIdx.x);
              pg8::EpiStore E{WSP(bf16, WS_Y), D, 0, D / 256};
              pg8::gemm_phase<pg8::EpiStore, pg8::StaticOrder, true, true>(F.lds, g, S, E); }
            GRID_BAR();
        } else {
            phase_moe_slots(F, li);
            GRID_BAR();
            const int ntiles = ((LAS int*)(F.lds + LDS_MOEI))[48];
            const PG8_LAS unsigned char* tile_e = (const PG8_LAS unsigned char*)(F.lds + LDS_TILEE);
#pragma unroll 1
            for (int ch = 0; ch < MOE_NCHUNK; ++ch) {
                const int t0 = ch * MOE_CHUNK_TILES; int nM = ntiles - t0; nM = nM < 0 ? 0 : (nM > MOE_CHUNK_TILES ? MOE_CHUNK_TILES : nM);
                { pg8::Gemm g{WSP(bf16, WS_XS), WSP(bf16, WS_MGU), 0, 0, D}; pg8::MoeOrder S; S.init(nM, 2 * FFE / 256, F.G, (int)blockIdx.x, t0, t0, tile_e);
                  pg8::EpiSwiGLU E{WSP(bf16, WS_HM), FFE, t0, 2 * FFE / 256};
                  pg8::gemm_phase<pg8::EpiSwiGLU, pg8::MoeOrder, true, true>(F.lds, g, S, E); }
                GRID_BAR();
                { pg8::Gemm g{WSP(bf16, WS_HM), WSP(bf16, WS_MD), 0, 0, FFE}; pg8::MoeOrder S; S.init(nM, D / 256, F.G, (int)blockIdx.x, t0, 0, tile_e);
                  pg8::EpiStore E{WSP(bf16, WS_XS), D, t0, D / 256};
                  pg8::gemm_phase<pg8::EpiStore, pg8::MoeOrder, true, true>(F.lds, g, S, E); }
                GRID_BAR();
            }
        }
        phase_ln2<true>(F, li);
        if (li < DEPTH - 1) GRID_BAR();
    }
}

extern "C" void kernel_launch(void* const* d_in, const int* in_sizes, int n_in, void* d_out, int out_size, void* d_ws, size_t ws_size, hipStream_t stream) {
    static int grid = 0;
    if (grid == 0) {
        if (n_in != N_INPUTS || out_size != NL * D || ws_size < WS_END) { fprintf(stderr, "kernel_launch: unexpected shapes (n_in %d out %d ws %zu)\n", n_in, out_size, ws_size); grid = -1; return; }
        int dev = 0, cus = 0, per_cu = 0;
        if (hipGetDevice(&dev) != hipSuccess || hipDeviceGetAttribute(&cus, hipDeviceAttributeMultiprocessorCount, dev) != hipSuccess) { grid = -1; return; }
        if (hipFuncSetAttribute((const void*)mk_fwd, hipFuncAttributeMaxDynamicSharedMemorySize, LDS_BYTES) != hipSuccess) { fprintf(stderr, "kernel_launch: hipFuncSetAttribute failed\n"); grid = -1; return; }
        if (hipOccupancyMaxActiveBlocksPerMultiprocessor(&per_cu, (const void*)mk_fwd, NTHR, LDS_BYTES) != hipSuccess || per_cu < 1) fprintf(stderr, "kernel_launch: occupancy query reports %d\n", per_cu);
        (void)hipGetLastError();
        grid = cus > 256 ? 256 : cus;
    }
    if (grid < 0) return;
    if (hipMemsetAsync((char*)d_ws + WS_CTL, 0, CTL_ZERO_BYTES, stream) != hipSuccess) return;
    Args a{};
    for (int i = 0; i < N_INPUTS; ++i) a.in[i] = (const float*)d_in[i];
    a.out = (float*)d_out; a.ws = (unsigned char*)d_ws;
    hipLaunchKernelGGL(mk_fwd, dim3(grid), dim3(NTHR), LDS_BYTES, stream, a);
    const hipError_t le = hipPeekAtLastError();
    if (le != hipSuccess) fprintf(stderr, "kernel_launch: launch failed: %s\n", hipGetErrorName(le));
}
```

```cpp
#include <hip/hip_runtime.h>
#include <cstdio>
#include <cstdint>
#define GAS __attribute__((address_space(1)))
#define LAS __attribute__((address_space(3)))
namespace pg8 {
#define PG8_LAS __attribute__((address_space(3)))
typedef unsigned short bf16_t;
typedef short bf16x8 __attribute__((ext_vector_type(8)));
typedef float f32x4 __attribute__((ext_vector_type(4)));
typedef unsigned u32x4 __attribute__((ext_vector_type(4)));
constexpr int BM = 256, BK = 64, HALF = 128, HTB = HALF * BK * 2  , STAGE_BYTES = 8 * HTB, NXCD = 8, WGM = 8;

__host__ __device__ __forceinline__ int lds_byte(int r, int c) { const int st = (r >> 4) * 2 + (c >> 5), rr = r & 15, cc = c & 31, ob = rr * 64 + cc * 2; return st * 1024 + (ob ^ (((ob >> 9) & 1) << 5)); }
__host__ __device__ __forceinline__ void stage_rc(int b, int& R, int& C) { const int st = b / 1024, sb = b % 1024, swz = sb ^ (((sb >> 9) & 1) << 5); R = (st >> 1) * 16 + swz / 64; C = (st & 1) * 32 + (swz % 64) / 2; }
__host__ __device__ __forceinline__ int perm32(int rho) { const int n = rho >> 4, i = rho & 15; return 8 * (i >> 2) + 4 * n + (i & 3); }

struct Unit { int pm, pn; };
struct Gemm { const bf16_t* A; const bf16_t* Bt; int M, N, K; };

struct StaticOrder {
    int nM, nN, nwg, G, c;
    __host__ __device__ void init(int M, int N, int G_, int c_) { nM = M / BM; nN = N / BM; nwg = nM * nN; G = G_; c = c_; }
    __host__ __device__ bool next(int i, Unit& u) const {
        const long L = (long)i * G + c; if (L >= nwg) return false;
        int wgid = (int)L; { const int q = nwg / NXCD, r = nwg % NXCD, xcd = wgid % NXCD, off = wgid / NXCD; wgid = (xcd < r ? xcd * (q + 1) : r * (q + 1) + (xcd - r) * q) + off; }
        const int nig = WGM * nN, gid = wgid / nig, fm = gid * WGM, gsz = (nM - fm) < WGM ? (nM - fm) : WGM;
        u.pm = fm + ((wgid % nig) % gsz); u.pn = (wgid % nig) / gsz; return true;
    }
    __device__ __forceinline__ void a_ready(const Unit&) const {}
    __device__ __forceinline__ void done(const Unit&) const {}
};

__device__ __forceinline__ unsigned cvt_pk_bf16(float lo, float hi) { unsigned r; asm volatile("v_cvt_pk_bf16_f32 %0, %1, %2" : "=v"(r) : "v"(lo), "v"(hi)); return r; }
typedef float f32x2 __attribute__((ext_vector_type(2)));
__device__ __forceinline__ f32x2 gelu_pk(f32x2 v) {
    const f32x2 av = __builtin_elementwise_abs(v), d = av * 0.2316418882f + 1.0f;
    f32x2 t; t.x = __builtin_amdgcn_rcpf(d.x); t.y = __builtin_amdgcn_rcpf(d.y);
    f32x2 q = t * 0.5307027145f + (-0.7265760135f); q = q * t + 0.7107068705f; q = q * t + (-0.142248368f); q = q * t + 0.127414796f; q = q * t;
    const f32x2 s = (v * v) * (-0.72134752044f);
    f32x2 e; e.x = __builtin_amdgcn_exp2f(s.x); e.y = __builtin_amdgcn_exp2f(s.y);
    const f32x2 m = v * (q * e), r = v - m;
    f32x2 o; o.x = v.x < 0.f ? m.x : r.x; o.y = v.y < 0.f ? m.y : r.y; return o;
}

template <int ACT  > struct EpiBf16 {
    static constexpr bool PERM = true, AFTER_DRAIN = false; static_assert(ACT == 0 || ACT == 1, "EpiBf16: ACT is 0 (none) or 1 (gelu_pk)");
    bf16_t* O; int ldc; const float* bias; int split_cols; size_t split_stride; float scale0;
    __device__ __forceinline__ void operator()(const f32x4 (&acc)[2][2][4][2], const Unit& u, int wr, int wc, int fr, int fq) const {
        const int row0 = u.pm * BM + wr * 64 + fr; int colt = u.pn * BM; bf16_t* base = O;
        float sc = 1.f; if (split_cols) { const int t = colt / split_cols; base += (size_t)t * split_stride; colt -= t * split_cols; if (t == 0) sc = scale0; }
        const int col0 = colt + wc * 32 + 8 * fq, bcol0 = u.pn * BM + wc * 32 + 8 * fq;
        f32x4 bv[2][2];
#pragma unroll
        for (int bj = 0; bj < 2; ++bj)
#pragma unroll
            for (int n = 0; n < 2; ++n) bv[bj][n] = bias ? *(const f32x4*)(bias + bcol0 + bj * HALF + 4 * n) : (f32x4){0.f, 0.f, 0.f, 0.f};
#pragma unroll
        for (int ai = 0; ai < 2; ++ai)
#pragma unroll
            for (int m = 0; m < 4; ++m) { bf16_t* rowp = base + (size_t)(row0 + ai * HALF + m * 16) * ldc + col0;
#pragma unroll
                for (int bj = 0; bj < 2; ++bj) { f32x4 v0 = acc[ai][bj][m][0] + bv[bj][0], v1 = acc[ai][bj][m][1] + bv[bj][1];
                    if (ACT == 1) { f32x2 a = gelu_pk((f32x2){v0[0], v0[1]}), b = gelu_pk((f32x2){v0[2], v0[3]}), c = gelu_pk((f32x2){v1[0], v1[1]}), d = gelu_pk((f32x2){v1[2], v1[3]});
                        v0 = (f32x4){a.x, a.y, b.x, b.y}; v1 = (f32x4){c.x, c.y, d.x, d.y}; }
                    v0 = v0 * sc; v1 = v1 * sc; u32x4 w; w.x = cvt_pk_bf16(v0[0], v0[1]); w.y = cvt_pk_bf16(v0[2], v0[3]); w.z = cvt_pk_bf16(v1[0], v1[1]); w.w = cvt_pk_bf16(v1[2], v1[3]);
                    *(u32x4*)(rowp + bj * HALF) = w; } }
    }
};
template <class Epi, class Sched, bool ALIGN_EPI = false, bool SP2 = false>
__device__ __forceinline__ void gemm_phase(PG8_LAS unsigned char* lds, const Gemm g, const Sched& S, const Epi& E) {
    int tid_ = threadIdx.x; asm volatile("" : "+v"(tid_));
    const int tid = tid_, wid = __builtin_amdgcn_readfirstlane(tid >> 6), lane = tid & 63, wr = wid >> 2, wc = wid & 3, fr = lane & 15, fq = lane >> 4;
    const int K = g.K, nt = K / BK;
    unsigned voffA[2], voffB[2];
#pragma unroll
    for (int i = 0; i < 2; ++i) { int R, C; stage_rc(tid * 16 + i * 8192, R, C); const int Rb = Epi::PERM ? ((R & ~31) + perm32(R & 31)) : R;
        voffA[i] = (unsigned)(R * K + C) * 2u; voffB[i] = (unsigned)(Rb * K + C) * 2u; }
    const size_t kstep = (size_t)(BK * 2);
    const size_t hstep = (size_t)HALF * K * 2;
    const size_t tstep = 2 * hstep;
    const unsigned ldsw = (unsigned)wid * 1024u;
    const int aoff = lds_byte(wr * 64 + fr, fq * 8), boff = lds_byte(wc * 32 + fr, fq * 8);
#define PG8_SA(b, h) (((b) * 2 + (h)) * HTB)
#define PG8_SB(b, h) ((4 + (b) * 2 + (h)) * HTB)
#define PG8_STAGE(bufoff, gbase, voff) do { _Pragma("unroll") for (int _i = 0; _i < 2; ++_i) \
        __builtin_amdgcn_global_load_lds((const unsigned*)((const char*)(gbase) + (voff)[_i]), (PG8_LAS unsigned*)(lds + (bufoff) + ldsw + _i * 8192), 16, 0, 0); } while (0)
#define PG8_LDA(dst, b, h) do { _Pragma("unroll") for (int m = 0; m < 4; ++m) _Pragma("unroll") for (int k = 0; k < 2; ++k) dst[m][k] = *(const PG8_LAS bf16x8*)(lds + PG8_SA(b, h) + aoff + m * 2048 + k * 1024); } while (0)
#define PG8_LDB(dst, b, h) do { _Pragma("unroll") for (int n = 0; n < 2; ++n) _Pragma("unroll") for (int k = 0; k < 2; ++k) dst[n][k] = *(const PG8_LAS bf16x8*)(lds + PG8_SB(b, h) + boff + n * 2048 + k * 1024); } while (0)
#define PG8_MMA(ai, bj, At, Bt) do { __builtin_amdgcn_s_setprio(1); _Pragma("unroll") for (int m = 0; m < 4; ++m) _Pragma("unroll") for (int n = 0; n < 2; ++n) _Pragma("unroll") for (int k = 0; k < 2; ++k) \
        acc[ai][bj][m][n] = __builtin_amdgcn_mfma_f32_16x16x32_bf16(Bt[n][k], At[m][k], acc[ai][bj][m][n], 0, 0, 0); __builtin_amdgcn_s_setprio(0); } while (0)
#define PG8_WAIT_V(n) asm volatile("s_waitcnt vmcnt(" #n ")" ::: "memory")
#define PG8_WAIT_L(n) asm volatile("s_waitcnt lgkmcnt(" #n ")" ::: "memory")
#define PG8_BAR __builtin_amdgcn_s_barrier()
#define PG8_SCHED __builtin_amdgcn_sched_barrier(0)
    Unit cur, nxt; int ui = 0;
    if (!S.next(0, cur)) return;
    f32x4 acc[2][2][4][2];
#pragma unroll
    for (int a = 0; a < 2; ++a)
#pragma unroll
        for (int b = 0; b < 2; ++b)
#pragma unroll
            for (int m = 0; m < 4; ++m)
#pragma unroll
                for (int n = 0; n < 2; ++n) acc[a][b][m][n] = (f32x4){0.f, 0.f, 0.f, 0.f};
    bf16x8 At[4][2], B0[2][2], B1[2][2];
    const char* cA = (const char*)g.A + (size_t)cur.pm * tstep; const char* cB = (const char*)g.Bt + (size_t)cur.pn * tstep;
    S.a_ready(cur);
    if constexpr (SP2) {
        PG8_STAGE(PG8_SB(0, 0), cB, voffB); PG8_STAGE(PG8_SB(0, 1), cB + hstep, voffB); PG8_STAGE(PG8_SA(0, 0), cA, voffA); PG8_STAGE(PG8_SA(0, 1), cA + hstep, voffA);
        if (wr == 1) PG8_BAR;
        PG8_WAIT_V(2); PG8_BAR;
        PG8_STAGE(PG8_SB(1, 0), cB + kstep, voffB); PG8_STAGE(PG8_SA(1, 0), cA + kstep, voffA); PG8_STAGE(PG8_SB(1, 1), cB + hstep + kstep, voffB);
        PG8_WAIT_V(6); PG8_BAR;
    } else {
        PG8_STAGE(PG8_SB(0, 0), cB, voffB); PG8_STAGE(PG8_SA(0, 0), cA, voffA); PG8_STAGE(PG8_SB(0, 1), cB + hstep, voffB); PG8_STAGE(PG8_SA(0, 1), cA + hstep, voffA);
        if (wr == 1) PG8_BAR;
        PG8_WAIT_V(4); PG8_BAR;
        PG8_STAGE(PG8_SB(1, 0), cB + kstep, voffB); PG8_STAGE(PG8_SA(1, 0), cA + kstep, voffA); PG8_STAGE(PG8_SB(1, 1), cB + hstep + kstep, voffB);
        PG8_WAIT_V(6); PG8_BAR;
    }
    for (;;) {
        const bool has_next = S.next(ui + 1, nxt);
        const char* nA = has_next ? (const char*)g.A + (size_t)nxt.pm * tstep : cA; const char* nB = has_next ? (const char*)g.Bt + (size_t)nxt.pn * tstep : cB;
        for (int t = 0; t < nt; t += 2) {
            const bool last = (t == nt - 2);
            const char* a1 = cA + (size_t)(t + 1) * kstep;
            const char* a2 = last ? nA : cA + (size_t)(t + 2) * kstep; const char* b2 = last ? nB : cB + (size_t)(t + 2) * kstep;
            const char* a3 = a2 + kstep; const char* b3 = b2 + kstep;
            if (last && has_next) S.a_ready(nxt);
            if constexpr (SP2) {
            PG8_LDB(B0, 0, 0); PG8_LDB(B1, 0, 1); PG8_SCHED; PG8_LDA(At, 0, 0); PG8_STAGE(PG8_SA(1, 1), a1 + hstep, voffA);
            PG8_WAIT_V(8); PG8_WAIT_L(0); PG8_BAR; PG8_MMA(0, 0, At, B0); PG8_MMA(0, 1, At, B1); PG8_BAR; PG8_SCHED;
            PG8_LDA(At, 0, 1); PG8_STAGE(PG8_SB(0, 0), b2, voffB); PG8_STAGE(PG8_SB(0, 1), b2 + hstep, voffB); PG8_STAGE(PG8_SA(0, 0), a2, voffA);
            PG8_WAIT_V(8); PG8_WAIT_L(0); PG8_BAR; PG8_MMA(1, 0, At, B0); PG8_MMA(1, 1, At, B1); PG8_BAR; PG8_SCHED;
            PG8_LDB(B0, 1, 0); PG8_LDB(B1, 1, 1); PG8_SCHED; PG8_LDA(At, 1, 0); PG8_STAGE(PG8_SA(0, 1), a2 + hstep, voffA);
            PG8_WAIT_V(8); PG8_WAIT_L(0); PG8_BAR; PG8_MMA(0, 0, At, B0); PG8_MMA(0, 1, At, B1); PG8_BAR; PG8_SCHED;
            PG8_LDA(At, 1, 1); PG8_STAGE(PG8_SB(1, 0), b3, voffB); PG8_STAGE(PG8_SB(1, 1), b3 + hstep, voffB); PG8_STAGE(PG8_SA(1, 0), a3, voffA);
            PG8_WAIT_V(8); PG8_WAIT_L(0); PG8_BAR; PG8_MMA(1, 0, At, B0); PG8_MMA(1, 1, At, B1); PG8_BAR; PG8_SCHED;
            } else {
            PG8_LDB(B0, 0, 0); PG8_SCHED; PG8_LDA(At, 0, 0); PG8_STAGE(PG8_SA(1, 1), a1 + hstep, voffA);
            PG8_WAIT_L(8); PG8_BAR; PG8_WAIT_L(0); PG8_MMA(0, 0, At, B0); PG8_BAR; PG8_SCHED;
            PG8_LDB(B1, 0, 1); PG8_STAGE(PG8_SB(0, 0), b2, voffB);
            PG8_BAR; PG8_WAIT_L(0); PG8_MMA(0, 1, At, B1); PG8_BAR;
            PG8_LDA(At, 0, 1); PG8_STAGE(PG8_SA(0, 0), a2, voffA);
            PG8_BAR; PG8_WAIT_L(0); PG8_MMA(1, 0, At, B0); PG8_BAR; PG8_SCHED;
            PG8_STAGE(PG8_SB(0, 1), b2 + hstep, voffB);
            PG8_WAIT_V(6); PG8_BAR; PG8_MMA(1, 1, At, B1); PG8_BAR;
            PG8_LDB(B0, 1, 0); PG8_SCHED; PG8_LDA(At, 1, 0); PG8_STAGE(PG8_SA(0, 1), a2 + hstep, voffA);
            PG8_WAIT_L(8); PG8_BAR; PG8_WAIT_L(0); PG8_MMA(0, 0, At, B0); PG8_BAR; PG8_SCHED;
            PG8_LDB(B1, 1, 1); PG8_STAGE(PG8_SB(1, 0), b3, voffB);
            PG8_BAR; PG8_WAIT_L(0); PG8_MMA(0, 1, At, B1); PG8_BAR;
            PG8_LDA(At, 1, 1); PG8_STAGE(PG8_SA(1, 0), a3, voffA);
            PG8_BAR; PG8_WAIT_L(0); PG8_MMA(1, 0, At, B0); PG8_BAR; PG8_SCHED;
            PG8_STAGE(PG8_SB(1, 1), b3 + hstep, voffB);
            PG8_WAIT_V(6); PG8_BAR; PG8_MMA(1, 1, At, B1); PG8_BAR;
            }
        }
        if constexpr (ALIGN_EPI) { if (wr == 0) PG8_BAR; }
        if constexpr (!Epi::AFTER_DRAIN) { E(acc, cur, wr, wc, fr, fq); S.done(cur); }
        if (!has_next) break;
#pragma unroll
        for (int a = 0; a < 2; ++a)
#pragma unroll
            for (int b = 0; b < 2; ++b)
#pragma unroll
                for (int m = 0; m < 4; ++m)
#pragma unroll
                    for (int n = 0; n < 2; ++n) acc[a][b][m][n] = (f32x4){0.f, 0.f, 0.f, 0.f};
        cur = nxt; cA = nA; cB = nB; ++ui;
        if constexpr (ALIGN_EPI) { if (wr == 1) PG8_BAR; }
    }
    PG8_WAIT_V(0);
    if constexpr (!ALIGN_EPI) { if (wr == 0) PG8_BAR; }
    PG8_BAR;
    if constexpr (Epi::AFTER_DRAIN) { E.fused(acc, cur, wr, wc, fr, fq, lds, wid, lane); S.done(cur); }
#undef PG8_SA
#undef PG8_SB
#undef PG8_STAGE
#undef PG8_LDA
#undef PG8_LDB
#undef PG8_MMA
#undef PG8_WAIT_V
#undef PG8_WAIT_L
#undef PG8_BAR
#undef PG8_SCHED
}
}

typedef unsigned short bf16;
typedef unsigned v4u __attribute__((ext_vector_type(4)));
typedef unsigned v2u __attribute__((ext_vector_type(2)));
typedef float f32x4 __attribute__((ext_vector_type(4)));
typedef float f32x2 __attribute__((ext_vector_type(2)));
typedef float f32x16 __attribute__((ext_vector_type(16)));
typedef short bf16x8 __attribute__((ext_vector_type(8)));
typedef short s16x4 __attribute__((ext_vector_type(4)));
typedef GAS unsigned gu32;

constexpr int D = 1024, NB = 16, SEQ = 4096, LCX = 256, DEPTH = 4;
constexpr int NL = NB * SEQ, NC = NB * LCX, NT = NL + NC;
constexpr int N_IN = 2592, PCOLS = 2048, D_OFF = 1824, HYC = 768;
constexpr int FFD = 2816, FFE = 3584, NE = 8;
constexpr float ALPHA = 1.6817928305074292f;
constexpr int NWAVES = 8, NTHR = 512;
constexpr int KSEQ = SEQ + LCX;

enum { I_X = 0, I_C, I_CTX, I_CCTX, I_ADAW, I_ADAB, I_WIN, I_QNORM, I_KVNORM, I_WUQ, I_WUKV, I_MLAON, I_LCW, I_LCB, I_LWR, I_LBR, I_LWI, I_LBI, I_LLAM, I_LON,
       I_MUP, I_MUN, I_W0, I_WUP, I_A0, I_AUP, I_GUP, I_KK, I_KA, I_RK, I_LNG, I_LNB, I_HCW, I_HCB, I_HW1, I_HB1, I_HW2, I_HB2, I_HW3, I_HD, I_HON,
       I_WOUT, I_LN1G, I_LN1B, I_LN2G, I_LN2B, I_FG, I_FU, I_FD, I_ROUTER, I_MG, I_MU, I_MD, N_INPUTS };

constexpr size_t MiB = 1u << 20;
constexpr size_t WS_CTL = 0, CTL_ZERO_BYTES = 1 * MiB;
constexpr size_t WS_MOD = 1 * MiB;
constexpr size_t WS_ROPE = 3 * MiB;
constexpr size_t WS_H2L = 4 * MiB;
constexpr size_t WS_H2C = 8 * MiB;
constexpr size_t WS_LRUW = 9 * MiB;
constexpr size_t WS_WUQT = 10 * MiB;
constexpr size_t WS_WUKVT = 11 * MiB;
constexpr size_t WS_SUMM = 12 * MiB;
constexpr size_t WS_BON = 17 * MiB;
constexpr size_t WS_TOKE = 20 * MiB;
constexpr size_t WS_TOKG = 21 * MiB;
constexpr size_t WS_TOKS = 22 * MiB;
constexpr size_t WS_BLKCNT = 23 * MiB;
constexpr size_t WS_SPEC = 24 * MiB;
constexpr size_t WS_WINT = 56 * MiB;
constexpr size_t WS_WHYT = 72 * MiB;
constexpr size_t WS_WOUTT = 78 * MiB;
constexpr size_t WS_WGUT = 86 * MiB;
constexpr size_t WS_WDT = 108 * MiB;
constexpr size_t WS_XC = 120 * MiB;
constexpr size_t WS_A1 = 136 * MiB;
constexpr size_t WS_ARENA = 272 * MiB;
constexpr size_t WS_P = WS_ARENA;
constexpr size_t WS_HT = 544 * MiB;
constexpr size_t WS_QB = 646 * MiB;
constexpr size_t WS_KB = 697 * MiB;
constexpr size_t WS_VT = 748 * MiB;
constexpr size_t WS_AO = 782 * MiB;
constexpr size_t WS_HOT = 816 * MiB;
constexpr size_t WS_YR = 850 * MiB;
constexpr size_t WS_Y = 986 * MiB;
constexpr size_t WS_H = WS_ARENA;
constexpr size_t WS_MGU = WS_ARENA;
constexpr size_t WS_MD = 384 * MiB;
constexpr size_t WS_XS = 440 * MiB;
constexpr size_t WS_HM = 716 * MiB;
constexpr size_t WS_END = 1122 * MiB;
constexpr int MOE_MAX_TILES = 552, MOE_NCHUNK = 3, MOE_CHUNK_TILES = 184;
static_assert(WS_HM + (size_t)MOE_CHUNK_TILES * 256 * FFE * 2 <= WS_END, "moe hidden chunk");
static_assert(WS_H + (size_t)NT * FFD * 2 <= WS_QB + 51 * MiB, "dense hidden");

constexpr int CW_BAR = 4096;

constexpr int RING_BYTES = 131072;
constexpr int LDSCTL_OFF = RING_BYTES;
constexpr int LDS_TILEE = LDSCTL_OFF + 256;
constexpr int LDS_MOEI = LDSCTL_OFF + 1024;
constexpr int LDS_BYTES = 147456;

#define LDS_WAIT() asm volatile("s_waitcnt lgkmcnt(0)" ::: "memory")
#define VM_WAIT() asm volatile("s_waitcnt vmcnt(0)" ::: "memory")
typedef __bf16 hwbf16x2 __attribute__((ext_vector_type(2)));
__device__ __forceinline__ unsigned pk2(float lo, float hi) { const f32x2 v = {lo, hi}; const hwbf16x2 b = __builtin_convertvector(v, hwbf16x2); return __builtin_bit_cast(unsigned, b); }
__device__ __forceinline__ unsigned f2bf(float f) { return pk2(f, 0.f) & 0xffffu; }
__device__ __forceinline__ float bf2f(unsigned b) { return __builtin_bit_cast(float, b << 16); }
__device__ __forceinline__ float bflo(unsigned w) { return __builtin_bit_cast(float, w << 16); }
__device__ __forceinline__ float bfhi(unsigned w) { return __builtin_bit_cast(float, w & 0xffff0000u); }
__device__ __forceinline__ float wave_sum(float v) {
#pragma unroll
    for (int o = 1; o < 64; o <<= 1) v += __shfl_xor(v, o);
    return v;
}
__device__ __forceinline__ float sigmoidf_(float x) { return 1.f / (1.f + __expf(-x)); }
#define XB_TMO      128
#define XB_XCNT(j)  (256  + 64 * (j))
#define XB_XSUB(j)  (1280 + 64 * (j))
#define XB_XGEN(j)  (2304 + 64 * (j))
#define XB_TOP      3328
#define XB_TOPGEN   3392
#define XCD_BAR_WORDS 3456
#define XB_SPIN_CAP (1u << 18)

__device__ __forceinline__ unsigned xb_ld(unsigned* p)              { return __hip_atomic_load(p, __ATOMIC_RELAXED, __HIP_MEMORY_SCOPE_AGENT); }
__device__ __forceinline__ unsigned xb_add(unsigned* p, unsigned v) { return __hip_atomic_fetch_add(p, v, __ATOMIC_RELAXED, __HIP_MEMORY_SCOPE_AGENT); }
__device__ __forceinline__ unsigned xb_xcc_id() { return (unsigned)__builtin_amdgcn_s_getreg((3 << 11) | 20) & 0xFu; }
#define XB_SPIN(cond, bar) do { unsigned _sp = 0; while (cond) { __builtin_amdgcn_s_sleep(1); \
    if ((++_sp & 255u) == 0u) { if (xb_ld(&(bar)[XB_TMO])) break; if (_sp > XB_SPIN_CAP) { atomicAdd(&(bar)[XB_TMO], 1u); break; } } } } while (0)

struct XcdBarrier {
    unsigned* bar; unsigned x;
    volatile LAS unsigned* st;
};

__device__ __forceinline__ XcdBarrier xcd_barrier_post(unsigned* bar, volatile LAS unsigned* st) {
    XcdBarrier b; b.bar = bar; b.x = xb_xcc_id(); b.st = st;
    if (threadIdx.x == 0) (void)xb_add(&bar[XB_XCNT(b.x)], 1u);
    return b;
}
__device__ __forceinline__ void xcd_barrier_complete(unsigned* bar, unsigned x, unsigned& nloc, unsigned& nx) {
    const unsigned G = gridDim.x * gridDim.y * gridDim.z;
    unsigned sum, cnt, mine, sp = 0u;
    for (;;) {
        sum = 0u; cnt = 0u; mine = 0u;
#pragma unroll
        for (unsigned j = 0; j < 16; ++j) { const unsigned c = xb_ld(&bar[XB_XCNT(j)]); sum += c; cnt += (c > 0u) ? 1u : 0u; mine = (j == x) ? c : mine; }
        if (sum == G) break;
        __builtin_amdgcn_s_sleep(1);
        if ((++sp & 255u) == 0u) { if (xb_ld(&bar[XB_TMO])) break; if (sp > XB_SPIN_CAP) { atomicAdd(&bar[XB_TMO], 1u); break; } }
    }
    nloc = mine > 0u ? mine : 1u; nx = cnt > 0u ? cnt : 1u;
}

__device__ __forceinline__ void xcd_barrier(const XcdBarrier& b) {
    asm volatile("s_waitcnt vmcnt(0)" ::: "memory");
    __syncthreads();
    if (threadIdx.x == 0) {
        unsigned* bar = b.bar;
        __builtin_amdgcn_s_waitcnt(0);
        unsigned nloc = b.st[0], nx = b.st[1];
        if (nloc == 0u) { xcd_barrier_complete(bar, b.x, nloc, nx); b.st[0] = nloc; b.st[1] = nx; }
        const unsigned old = xb_add(&bar[XB_XSUB(b.x)], 1u);
        const unsigned gen = old / nloc;
        if (old + 1u == (gen + 1u) * nloc) {
            __builtin_amdgcn_fence(__ATOMIC_RELEASE, "agent");
            asm volatile("s_waitcnt vmcnt(0)" ::: "memory");
            const unsigned og = xb_add(&bar[XB_TOP], 1u);
            const unsigned tg = og / nx;
            if (og + 1u == (tg + 1u) * nx) xb_add(&bar[XB_TOPGEN], 1u);
            else XB_SPIN(xb_ld(&bar[XB_TOPGEN]) == tg, bar);
            __builtin_amdgcn_fence(__ATOMIC_ACQUIRE, "agent");
            xb_add(&bar[XB_XGEN(b.x)], 1u);
            asm volatile("s_waitcnt vmcnt(0)" ::: "memory");
        } else {
            XB_SPIN(xb_ld(&bar[XB_XGEN(b.x)]) == gen, bar);
            __builtin_amdgcn_fence(__ATOMIC_ACQUIRE, "agent");
            asm volatile("s_waitcnt vmcnt(0)" ::: "memory");
        }
    }
    __syncthreads();
}

struct Args { const float* in[N_INPUTS]; float* out; unsigned char* ws; };
struct Frame { LAS unsigned char* lds; int tid, lane, wave, G; };
__device__ __forceinline__ void frame_refresh(Frame& F) { int t = threadIdx.x; asm volatile("" : "+v"(t)); F.tid = t; F.lane = t & 63; }
#define CAS __attribute__((address_space(4)))
__device__ __forceinline__ const CAS char* karg() { const CAS char* kp = (const CAS char*)__builtin_amdgcn_kernarg_segment_ptr(); asm volatile("" : "+s"(kp)); return kp; }
__device__ __forceinline__ const float* in_ptr(int i) { return *(const float* const CAS*)(karg() + 8 * i); }
__device__ __forceinline__ float* out_ptr() { return *(float* const CAS*)(karg() + 8 * N_INPUTS); }
__device__ __forceinline__ unsigned char* ws_ptr() { return *(unsigned char* const CAS*)(karg() + 8 * N_INPUTS + 8); }
#define WSP(T, off) ((T*)(ws + (off)))
#define WS_DECL unsigned char* const ws = ws_ptr()

namespace pg8 {
struct EpiStore {
    static constexpr bool PERM = true, AFTER_DRAIN = false;
    bf16_t* O; int ldc; int pm_add; int nN;
    __device__ __forceinline__ void operator()(const f32x4 (&acc)[2][2][4][2], const Unit& u, int wr, int wc, int fr, int fq) const {
        const int row0 = (u.pm + pm_add) * BM + wr * 64 + fr; const int col0 = (u.pn % nN) * BM + wc * 32 + 8 * fq;
#pragma unroll
        for (int ai = 0; ai < 2; ++ai)
#pragma unroll
            for (int m = 0; m < 4; ++m) { bf16_t* rowp = O + (size_t)(row0 + ai * HALF + m * 16) * ldc + col0;
#pragma unroll
                for (int bj = 0; bj < 2; ++bj) { const f32x4 v0 = acc[ai][bj][m][0], v1 = acc[ai][bj][m][1];
                    u32x4 w; w.x = cvt_pk_bf16(v0[0], v0[1]); w.y = cvt_pk_bf16(v0[2], v0[3]); w.z = cvt_pk_bf16(v1[0], v1[1]); w.w = cvt_pk_bf16(v1[2], v1[3]);
                    *(u32x4*)(rowp + bj * HALF) = w; } }
    }
};
__device__ __forceinline__ float silu_mul(float g, float u) { return g * __builtin_amdgcn_rcpf(1.f + __expf(-g)) * u; }
struct EpiSwiGLU {
    static constexpr bool PERM = true, AFTER_DRAIN = false;
    bf16_t* H; int ldh; int pm_sub; int nN;
    __device__ __forceinline__ void operator()(const f32x4 (&acc)[2][2][4][2], const Unit& u, int wr, int wc, int fr, int fq) const {
        const int row0 = (u.pm - pm_sub) * BM + wr * 64 + fr; const int col0 = (u.pn % nN) * HALF + wc * 32 + 8 * fq;
#pragma unroll
        for (int ai = 0; ai < 2; ++ai)
#pragma unroll
            for (int m = 0; m < 4; ++m) { bf16_t* rowp = H + (size_t)(row0 + ai * HALF + m * 16) * ldh + col0;
                const f32x4 g0 = acc[ai][0][m][0], g1 = acc[ai][0][m][1], u0 = acc[ai][1][m][0], u1 = acc[ai][1][m][1];
                u32x4 w; w.x = cvt_pk_bf16(silu_mul(g0[0], u0[0]), silu_mul(g0[1], u0[1])); w.y = cvt_pk_bf16(silu_mul(g0[2], u0[2]), silu_mul(g0[3], u0[3]));
                w.z = cvt_pk_bf16(silu_mul(g1[0], u1[0]), silu_mul(g1[1], u1[1])); w.w = cvt_pk_bf16(silu_mul(g1[2], u1[2]), silu_mul(g1[3], u1[3]));
                *(u32x4*)rowp = w; }
    }
};
struct MoeOrder {
    int nM, nN, nwg, G, c, t0, pm_off; const PG8_LAS unsigned char* tile_e;
    __device__ void init(int nM_, int nN_, int G_, int c_, int t0_, int pm_off_, const PG8_LAS unsigned char* te) { nM = nM_; nN = nN_; nwg = nM * nN; G = G_; c = c_; t0 = t0_; pm_off = pm_off_; tile_e = te; }
    __device__ bool next(int i, Unit& u) const {
        const long L = (long)i * G + c; if (L >= nwg) return false;
        int wgid = (int)L; { const int q = nwg / NXCD, r = nwg % NXCD, xcd = wgid % NXCD, off = wgid / NXCD; wgid = (xcd < r ? xcd * (q + 1) : r * (q + 1) + (xcd - r) * q) + off; }
        const int nig = WGM * nN, gid = wgid / nig, fm = gid * WGM, gsz = (nM - fm) < WGM ? (nM - fm) : WGM;
        const int pml = fm + ((wgid % nig) % gsz), pnl = (wgid % nig) / gsz;
        const int e = tile_e[t0 + pml];
        u.pm = pm_off + pml; u.pn = e * nN + pnl; return true;
    }
    __device__ __forceinline__ void a_ready(const Unit&) const {}
    __device__ __forceinline__ void done(const Unit&) const {}
};
}

__device__ __forceinline__ void tr_item(const float* W, int ldw, int k0, int c0, bf16* WT, int K, int drow, LAS float* scr, int lane) {
#pragma unroll 8
    for (int i = 0; i < 32; ++i) { const int kk = 2 * i + (lane >> 5); scr[kk * 33 + (lane & 31)] = W[(size_t)(k0 + kk) * ldw + c0 + (lane & 31)]; }
    LDS_WAIT(); asm volatile("" ::: "memory");
    const int c = lane & 7;
#pragma unroll
    for (int j = 0; j < 4; ++j) { const int n = (lane >> 3) + 8 * j; const LAS float* s = scr + (8 * c) * 33 + n;
        v4u o; o.x = pk2(s[0 * 33], s[1 * 33]); o.y = pk2(s[2 * 33], s[3 * 33]); o.z = pk2(s[4 * 33], s[5 * 33]); o.w = pk2(s[6 * 33], s[7 * 33]);
        *(GAS v4u*)(WT + (size_t)(drow + n) * K + k0 + 8 * c) = o; }
    LDS_WAIT(); asm volatile("" ::: "memory");
}
__device__ __forceinline__ void conv_matrix(Frame& F, const float* W, int K, int ldw, int cbeg, int ncols, bf16* WT, int mode, int rowoff, int& cursor) {
    const int gw = blockIdx.x * NWAVES + F.wave, NGW = F.G * NWAVES;
    const int nblk = ncols / 32, nit = (K / 64) * nblk;
    LAS float* scr = (LAS float*)(F.lds + F.wave * 16384);
    int first = cursor + (((gw - cursor) % NGW) + NGW) % NGW;
    for (int it = first; it < cursor + nit; it += NGW) {
        const int idx = it - cursor, kb = idx / nblk, nb = idx % nblk, n = 32 * nb;
        const int drow = mode == 0 ? rowoff + n : ((n >> 7) * 256 + (n & 127) + rowoff);
        tr_item(W, ldw, 64 * kb, cbeg + n, WT, K, drow, scr, F.lane);
    }
    cursor += nit;
}

__device__ __forceinline__ void phase_mod(Frame& F) { WS_DECL; frame_refresh(F);
    LAS float* sv = (LAS float*)F.lds;
    LAS float* red = (LAS float*)(F.lds + 69632);
    float* MOD = WSP(float, WS_MOD);
    if ((int)blockIdx.x < 192) {
        const float* cl_ = in_ptr(I_C); const float* cc_ = in_ptr(I_CCTX); const float* adab = in_ptr(I_ADAB); const float* adaw = in_ptr(I_ADAW);
        for (int i = F.tid; i < 17 * 1024; i += NTHR) { const int b = i >> 10, k = i & 1023; const float c = b < 16 ? cl_[b * 1024 + k] : cc_[k]; sv[i] = c / (1.f + expf(-c)); }
        __syncthreads();
        for (int item = blockIdx.x; item < 192; item += F.G) {
            const int li = item / 48, cg = item % 48, cl = F.tid & 127, kq = F.tid >> 7;
            const float* W = adaw + (size_t)li * 1024 * 6144 + cg * 128 + cl;
            float acc[17];
#pragma unroll
            for (int b = 0; b < 17; ++b) acc[b] = 0.f;
            for (int k = kq * 256; k < kq * 256 + 256; ++k) { const float w = W[(size_t)k * 6144];
#pragma unroll
                for (int b = 0; b < 17; ++b) acc[b] += sv[b * 1024 + k] * w; }
#pragma unroll
            for (int b = 0; b < 17; ++b) red[(kq * 17 + b) * 128 + cl] = acc[b];
            __syncthreads();
            for (int o = F.tid; o < 17 * 128; o += NTHR) { const int b = o >> 7, c = o & 127;
                const float s = (red[(0 * 17 + b) * 128 + c] + red[(1 * 17 + b) * 128 + c]) + (red[(2 * 17 + b) * 128 + c] + red[(3 * 17 + b) * 128 + c]);
                MOD[((size_t)li * 17 + b) * 6144 + cg * 128 + c] = s + adab[li * 6144 + cg * 128 + c]; }
            __syncthreads();
        }
    }
}

__device__ __forceinline__ void phase_pro0(Frame& F) { WS_DECL; frame_refresh(F);
    phase_mod(F);
    __syncthreads();
    int cursor = 0;
    for (int li = 0; li < DEPTH; ++li) {
        conv_matrix(F, in_ptr(I_WIN) + (size_t)li * D * N_IN, D, N_IN, 0, D_OFF, WSP(bf16, WS_WINT) + (size_t)li * PCOLS * D, 0, 0, cursor);
        conv_matrix(F, in_ptr(I_WIN) + (size_t)li * D * N_IN, D, N_IN, D_OFF, HYC, WSP(bf16, WS_WHYT) + (size_t)li * HYC * D, 0, 0, cursor);
        conv_matrix(F, in_ptr(I_WOUT) + (size_t)li * D * D, D, D, 0, D, WSP(bf16, WS_WOUTT) + (size_t)li * D * D, 0, 0, cursor);
    }
    for (int j = 0; j < 2; ++j) {
        conv_matrix(F, in_ptr(I_FG) + (size_t)j * D * FFD, D, FFD, 0, FFD, WSP(bf16, WS_WGUT) + (size_t)j * 2 * FFD * D, 1, 0, cursor);
        conv_matrix(F, in_ptr(I_FU) + (size_t)j * D * FFD, D, FFD, 0, FFD, WSP(bf16, WS_WGUT) + (size_t)j * 2 * FFD * D, 1, 128, cursor);
        conv_matrix(F, in_ptr(I_FD) + (size_t)j * FFD * D, FFD, D, 0, D, WSP(bf16, WS_WDT) + (size_t)j * D * FFD, 0, 0, cursor);
    }
    { const int gt = blockIdx.x * NTHR + F.tid, NGT = F.G * NTHR; const int per = (PCOLS - D_OFF) * D / 8;
      for (int i = gt; i < DEPTH * per; i += NGT) { const int li = i / per, r = i % per; *(GAS v4u*)(WSP(bf16, WS_WINT) + (size_t)li * PCOLS * D + (size_t)D_OFF * D + (size_t)r * 8) = (v4u){0u, 0u, 0u, 0u}; } }
}

struct Stream { const float* inl; const float* inc; float* outl; float* outc; };
__device__ __forceinline__ Stream make_stream(unsigned char* ws, int li) { Stream s; s.outl = out_ptr(); s.outc = WSP(float, WS_XC); s.inl = li == 0 ? in_ptr(I_X) : (const float*)s.outl; s.inc = li == 0 ? in_ptr(I_CTX) : (const float*)s.outc; return s; }
__device__ __forceinline__ const float* stream_in(const Stream& s, int m) { return m < NL ? s.inl + (size_t)m * D : s.inc + (size_t)(m - NL) * D; }
__device__ __forceinline__ float* stream_out(const Stream& s, int m) { return m < NL ? s.outl + (size_t)m * D : s.outc + (size_t)(m - NL) * D; }
__device__ __forceinline__ int mod_b(int m) { return m < NL ? (m >> 12) : 16; }
__device__ __forceinline__ const float* mod_vec(unsigned char* ws, int li, int b, int j) { return WSP(float, WS_MOD) + ((size_t)li * 17 + b) * 6144 + j * 1024; }

__device__ __forceinline__ void store_modulated(const f32x4 (&x)[4], const float* shift, const float* scale, bf16* orow, int lane) {
#pragma unroll
    for (int j = 0; j < 4; ++j) { const int c = 4 * lane + 256 * j; const f32x4 sh = *(const GAS f32x4*)(shift + c), sc = *(const GAS f32x4*)(scale + c);
        const f32x4 h = x[j] * (sc + 1.f) + sh; v2u w; w.x = pk2(h.x, h.y); w.y = pk2(h.z, h.w); *(GAS v2u*)(orow + c) = w; }
}
__device__ __forceinline__ void rows_range(const Frame& F, int nrows, int& r0, int& r1) { const int per = (nrows + F.G - 1) / F.G; r0 = blockIdx.x * per; r1 = r0 + per < nrows ? r0 + per : nrows; if (r0 > nrows) r0 = nrows; }

__device__ __forceinline__ void phase_hin0(Frame& F) { WS_DECL; frame_refresh(F);
    int r0, r1; rows_range(F, NT, r0, r1); const Stream st = make_stream(ws, 0);
    for (int m = r0 + F.wave; m < r1; m += NWAVES) {
        const float* xr = stream_in(st, m); f32x4 x[4];
#pragma unroll
        for (int j = 0; j < 4; ++j) x[j] = *(const GAS f32x4*)(xr + 4 * F.lane + 256 * j);
        const int b = mod_b(m);
        store_modulated(x, mod_vec(ws, 0, b, 0), mod_vec(ws, 0, b, 1), WSP(bf16, WS_A1) + (size_t)m * D, F.lane);
    }
}

__device__ __forceinline__ void ln_rows(f32x4 (&v)[4], const float* g, const float* bta, int lane) {
    float s = 0.f;
#pragma unroll
    for (int j = 0; j < 4; ++j) s += (v[j].x + v[j].y) + (v[j].z + v[j].w);
    const float mean = wave_sum(s) * (1.f / D); float s2 = 0.f;
#pragma unroll
    for (int j = 0; j < 4; ++j) { v[j] = v[j] - mean; s2 += (v[j].x * v[j].x + v[j].y * v[j].y) + (v[j].z * v[j].z + v[j].w * v[j].w); }
    const float rstd = 1.f / sqrtf(wave_sum(s2) * (1.f / D) + 1e-5f);
#pragma unroll
    for (int j = 0; j < 4; ++j) { const int c = 4 * lane + 256 * j; v[j] = v[j] * rstd * *(const GAS f32x4*)(g + c) + *(const GAS f32x4*)(bta + c); }
}

template <bool HAVE_Y>
__device__ __forceinline__ void phase_ln1(Frame& F, int li) { WS_DECL; frame_refresh(F);
    const int nrows = li == DEPTH - 1 ? NL : NT; const bool moe = li & 1; const int lane = F.lane;
    LAS int* hist = (LAS int*)(F.lds + LDS_MOEI) + 56; LAS float* ROUT = (LAS float*)F.lds;
    if (moe) { if (F.tid < 8) hist[F.tid] = 0; const float* router = in_ptr(I_ROUTER) + (size_t)(li >> 1) * D * NE; for (int i = F.tid; i < D * NE / 4; i += NTHR) *(LAS f32x4*)(ROUT + 4 * i) = *(const GAS f32x4*)(router + 4 * i); __syncthreads(); }
    int r0, r1; rows_range(F, nrows, r0, r1);
    const float* g = in_ptr(I_LN1G) + li * D; const float* bt = in_ptr(I_LN1B) + li * D; const Stream st = make_stream(ws, li); const bf16* Y = WSP(bf16, WS_Y);
    f32x4 xn[4]; v2u yn[4];
    { const int m = r0 + F.wave; if (m < r1) { const float* xr = stream_in(st, m);
#pragma unroll
        for (int j = 0; j < 4; ++j) { const int c = 4 * lane + 256 * j; xn[j] = *(const GAS f32x4*)(xr + c); if (HAVE_Y) yn[j] = *(const GAS v2u*)(Y + (size_t)m * D + c); } } }
    for (int m = r0 + F.wave; m < r1; m += NWAVES) {
        const int b = mod_b(m); f32x4 v[4]; v2u yw[4];
#pragma unroll
        for (int j = 0; j < 4; ++j) { v[j] = xn[j]; if (HAVE_Y) yw[j] = yn[j]; }
        if (m + NWAVES < r1) { const float* xr = stream_in(st, m + NWAVES);
#pragma unroll
            for (int j = 0; j < 4; ++j) { const int c = 4 * lane + 256 * j; xn[j] = *(const GAS f32x4*)(xr + c); if (HAVE_Y) yn[j] = *(const GAS v2u*)(Y + (size_t)(m + NWAVES) * D + c); } }
        const float* m2 = mod_vec(ws, li, b, 2);
#pragma unroll
        for (int j = 0; j < 4; ++j) { const int c = 4 * lane + 256 * j; v[j] = v[j] * ALPHA;
            if (HAVE_Y) { const f32x4 mm = *(const GAS f32x4*)(m2 + c); v[j].x += mm.x * bflo(yw[j].x); v[j].y += mm.y * bfhi(yw[j].x); v[j].z += mm.z * bflo(yw[j].y); v[j].w += mm.w * bfhi(yw[j].y); } }
        ln_rows(v, g, bt, lane);
        float* xo = stream_out(st, m);
#pragma unroll
        for (int j = 0; j < 4; ++j) *(GAS f32x4*)(xo + 4 * lane + 256 * j) = v[j];
        const float* sh = mod_vec(ws, li, b, 3); const float* sc = mod_vec(ws, li, b, 4);
        if (moe) {
            float lg[NE];
#pragma unroll
            for (int e = 0; e < NE; ++e) lg[e] = 0.f;
#pragma unroll
            for (int j = 0; j < 4; ++j) { const int c = 4 * lane + 256 * j; const f32x4 s4 = *(const GAS f32x4*)(sh + c), c4 = *(const GAS f32x4*)(sc + c); const f32x4 f = v[j] * (c4 + 1.f) + s4;
#pragma unroll
                for (int q = 0; q < 4; ++q) { const f32x4 ra = *(const LAS f32x4*)(ROUT + (c + q) * NE), rb = *(const LAS f32x4*)(ROUT + (c + q) * NE + 4); const float fq = f[q];
                    lg[0] += fq * ra.x; lg[1] += fq * ra.y; lg[2] += fq * ra.z; lg[3] += fq * ra.w; lg[4] += fq * rb.x; lg[5] += fq * rb.y; lg[6] += fq * rb.z; lg[7] += fq * rb.w; } }
#pragma unroll
            for (int e = 0; e < NE; ++e) lg[e] = wave_sum(lg[e]);
            int e0 = 0; float v0 = lg[0];
#pragma unroll
            for (int e = 1; e < NE; ++e) if (lg[e] > v0) { v0 = lg[e]; e0 = e; }
            int e1 = -1; float v1 = -3.0e38f;
#pragma unroll
            for (int e = 0; e < NE; ++e) if (e != e0 && lg[e] > v1) { v1 = lg[e]; e1 = e; }
            const float ex = __expf(v1 - v0), g0 = 1.f / (1.f + ex), g1 = ex * g0;
            if (lane == 0) { *(GAS v2u*)(WSP(int, WS_TOKE) + 2 * (size_t)m) = (v2u){(unsigned)e0, (unsigned)e1}; *(GAS f32x2*)(WSP(float, WS_TOKG) + 2 * (size_t)m) = (f32x2){g0, g1};
                atomicAdd((int*)(hist + e0), 1); atomicAdd((int*)(hist + e1), 1); }
        }
        store_modulated(v, sh, sc, WSP(bf16, WS_A1) + (size_t)m * D, lane);
    }
    if (moe) { __syncthreads(); if (F.tid < 8) WSP(int, WS_BLKCNT)[blockIdx.x * 8 + F.tid] = hist[F.tid]; }
}

template <bool HAVE_FFN>
__device__ __forceinline__ void phase_ln2(Frame& F, int li) { WS_DECL; frame_refresh(F);
    const int nrows = li == DEPTH - 1 ? NL : NT; const bool moe = li & 1; const int lane = F.lane;
    int r0, r1; rows_range(F, nrows, r0, r1);
    const float* g = in_ptr(I_LN2G) + li * D; const float* bt = in_ptr(I_LN2B) + li * D; const Stream st = make_stream(ws, 1);
    const bf16* Y = WSP(bf16, WS_Y); const bf16* XS = WSP(bf16, WS_XS); const int* TOKS = WSP(int, WS_TOKS); const float* TOKG = WSP(float, WS_TOKG);
    f32x4 xn[4]; v2u ya[4], yb[4]; v2u sn = (v2u){0u, 0u}; f32x2 gn = (f32x2){0.f, 0.f}, gc = (f32x2){0.f, 0.f};
    const int mf = r0 + F.wave;
    if (mf < r1) { const float* xr = stream_out(st, mf); v2u s0 = (v2u){0u, 0u};
        if (moe) { s0 = *(const GAS v2u*)(TOKS + 2 * (size_t)mf); gc = *(const GAS f32x2*)(TOKG + 2 * (size_t)mf); if (mf + NWAVES < r1) { sn = *(const GAS v2u*)(TOKS + 2 * (size_t)(mf + NWAVES)); gn = *(const GAS f32x2*)(TOKG + 2 * (size_t)(mf + NWAVES)); } }
#pragma unroll
        for (int j = 0; j < 4; ++j) { const int c = 4 * lane + 256 * j; xn[j] = *(const GAS f32x4*)(xr + c);
            if (HAVE_FFN) { if (moe) { ya[j] = *(const GAS v2u*)(XS + (size_t)s0.x * D + c); yb[j] = *(const GAS v2u*)(XS + (size_t)s0.y * D + c); } else ya[j] = *(const GAS v2u*)(Y + (size_t)mf * D + c); } } }
    for (int m = mf; m < r1; m += NWAVES) {
        const int b = mod_b(m); f32x4 v[4]; v2u wa[4], wb[4]; const f32x2 gg = gc;
#pragma unroll
        for (int j = 0; j < 4; ++j) { v[j] = xn[j]; wa[j] = ya[j]; wb[j] = yb[j]; }
        const int mn = m + NWAVES;
        if (mn < r1) { const float* xr = stream_out(st, mn); const v2u s1 = sn; gc = gn;
            if (moe && mn + NWAVES < r1) { sn = *(const GAS v2u*)(TOKS + 2 * (size_t)(mn + NWAVES)); gn = *(const GAS f32x2*)(TOKG + 2 * (size_t)(mn + NWAVES)); }
#pragma unroll
            for (int j = 0; j < 4; ++j) { const int c = 4 * lane + 256 * j; xn[j] = *(const GAS f32x4*)(xr + c);
                if (HAVE_FFN) { if (moe) { ya[j] = *(const GAS v2u*)(XS + (size_t)s1.x * D + c); yb[j] = *(const GAS v2u*)(XS + (size_t)s1.y * D + c); } else ya[j] = *(const GAS v2u*)(Y + (size_t)mn * D + c); } } }
        const float* m5 = mod_vec(ws, li, b, 5);
#pragma unroll
        for (int j = 0; j < 4; ++j) { const int c = 4 * lane + 256 * j; v[j] = v[j] * ALPHA;
            if (HAVE_FFN) { const f32x4 mm = *(const GAS f32x4*)(m5 + c); f32x4 o;
                if (moe) { o.x = gg.x * bflo(wa[j].x) + gg.y * bflo(wb[j].x); o.y = gg.x * bfhi(wa[j].x) + gg.y * bfhi(wb[j].x); o.z = gg.x * bflo(wa[j].y) + gg.y * bflo(wb[j].y); o.w = gg.x * bfhi(wa[j].y) + gg.y * bfhi(wb[j].y); }
                else { o.x = bflo(wa[j].x); o.y = bfhi(wa[j].x); o.z = bflo(wa[j].y); o.w = bfhi(wa[j].y); }
                v[j] = v[j] + mm * o; } }
        ln_rows(v, g, bt, lane);
        float* xo = stream_out(st, m);
#pragma unroll
        for (int j = 0; j < 4; ++j) *(GAS f32x4*)(xo + 4 * lane + 256 * j) = v[j];
        if (li < DEPTH - 1) store_modulated(v, mod_vec(ws, li + 1, b, 0), mod_vec(ws, li + 1, b, 1), WSP(bf16, WS_A1) + (size_t)m * D, lane);
    }
}

__device__ __forceinline__ void phase_moe_weights(Frame& F, int li) { WS_DECL; frame_refresh(F);
    const int j = li >> 1; int cursor = 0;
    for (int e = 0; e < NE; ++e) {
        conv_matrix(F, in_ptr(I_MG) + ((size_t)j * NE + e) * D * FFE, D, FFE, 0, FFE, WSP(bf16, WS_MGU) + (size_t)e * 2 * FFE * D, 1, 0, cursor);
        conv_matrix(F, in_ptr(I_MU) + ((size_t)j * NE + e) * D * FFE, D, FFE, 0, FFE, WSP(bf16, WS_MGU) + (size_t)e * 2 * FFE * D, 1, 128, cursor);
        conv_matrix(F, in_ptr(I_MD) + ((size_t)j * NE + e) * FFE * D, FFE, D, 0, D, WSP(bf16, WS_MD) + (size_t)e * D * FFE, 0, 0, cursor);
    }
}

__device__ __forceinline__ void phase_moe_slots(Frame& F, int li) { WS_DECL; frame_refresh(F);
    const int nrows = li == DEPTH - 1 ? NL : NT;
    LAS int* mi = (LAS int*)(F.lds + LDS_MOEI); LAS unsigned char* tile_e = (LAS unsigned char*)(F.lds + LDS_TILEE);
    LAS int* slots = (LAS int*)F.lds;
    const int* blkcnt = WSP(int, WS_BLKCNT);
    if (F.tid < 8) { int tot = 0, pre = 0; for (int b = 0; b < F.G; ++b) { const int c = blkcnt[b * 8 + F.tid]; if (b < (int)blockIdx.x) pre += c; tot += c; } mi[16 + F.tid] = tot; mi[32 + F.tid] = pre; }
    __syncthreads();
    if (F.tid == 0) { int s = 0; for (int e = 0; e < NE; ++e) { mi[e] = s; s += (mi[16 + e] + 255) & ~255; } mi[8] = s; mi[48] = s >> 8; }
    __syncthreads();
    for (int t = F.tid; t < MOE_MAX_TILES + 8; t += NTHR) { int e = 0;
#pragma unroll
        for (int q = 1; q < NE; ++q) if (t * 256 >= mi[q]) e = q;
        tile_e[t] = (unsigned char)e; }
    int r0, r1; rows_range(F, nrows, r0, r1);
    const int na = 2 * (r1 - r0);
    if (F.wave == 0) {
        int run[NE];
#pragma unroll
        for (int e = 0; e < NE; ++e) run[e] = mi[e] + mi[32 + e];
        for (int base = 0; base < na; base += 64) { const int ai = base + F.lane; const bool ok = ai < na;
            const int e = ok ? WSP(int, WS_TOKE)[2 * (size_t)r0 + ai] : -1; int slot = 0;
#pragma unroll
            for (int q = 0; q < NE; ++q) { const unsigned long long mk = __ballot(e == q); if (e == q) slot = run[q] + __popcll(mk & ((1ull << F.lane) - 1ull)); run[q] += __popcll(mk); }
            if (ok) { slots[ai] = slot; WSP(int, WS_TOKS)[2 * (size_t)r0 + ai] = slot; } }
    }
    __syncthreads();
    for (int ai = F.wave; ai < na; ai += NWAVES) { const int m = r0 + (ai >> 1), slot = slots[ai];
        const GAS v4u* src = (const GAS v4u*)(WSP(bf16, WS_A1) + (size_t)m * D); GAS v4u* dst = (GAS v4u*)(WSP(bf16, WS_XS) + (size_t)slot * D);
        dst[F.lane] = src[F.lane]; dst[F.lane + 64] = src[F.lane + 64]; }
    { const int gw = blockIdx.x * NWAVES + F.wave, NGW = F.G * NWAVES; int cnt = 0;
      for (int e = 0; e < NE; ++e) { const int p0 = mi[e] + mi[16 + e], p1 = mi[e + 1];
          for (int s = p0; s < p1; ++s, ++cnt) if (cnt % NGW == gw) { GAS v4u* dst = (GAS v4u*)(WSP(bf16, WS_XS) + (size_t)s * D); dst[F.lane] = (v4u){0u, 0u, 0u, 0u}; dst[F.lane + 64] = (v4u){0u, 0u, 0u, 0u}; } } }
    __syncthreads();
}

constexpr float QSCALE = 0.14724319f;
constexpr int MP_CQ_LD = 200, MP_CKV_LD = 136;
__device__ __forceinline__ void phase_mla_prep(Frame& F, int li) { WS_DECL; frame_refresh(F);
    LAS bf16* CQN = (LAS bf16*)F.lds; LAS bf16* CKVN = (LAS bf16*)(F.lds + 64 * MP_CQ_LD * 2);
    const bf16* P = WSP(bf16, WS_P); bf16* QB = WSP(bf16, WS_QB); bf16* KB = WSP(bf16, WS_KB); bf16* VT = WSP(bf16, WS_VT);
    const float* qn = in_ptr(I_QNORM) + li * 192; const float* kvn = in_ptr(I_KVNORM) + li * 128;
    const bf16* WQ = WSP(bf16, WS_WUQT) + (size_t)li * 384 * 192; const bf16* WKV = WSP(bf16, WS_WUKVT) + (size_t)li * 512 * 128;
    const float* RC = WSP(float, WS_ROPE); const float* RS = RC + 4096 * 16;
    const int lane = F.lane, wave = F.wave;
    const int head = wave >> 1, half = wave & 1, fr = lane & 15, kg = lane >> 4;
    for (int item = blockIdx.x; item < NT / 64; item += F.G) {
        const int m0 = item * 64; const bool isctx = m0 >= NL; const int b = isctx ? (m0 - NL) >> 8 : m0 >> 12; const int t0 = isctx ? (m0 - NL) & 255 : m0 & 4095;
        const int ki0 = isctx ? t0 : 256 + t0;
        bf16x8 wq[3][6];
#pragma unroll
        for (int i = 0; i < 3; ++i)
#pragma unroll
            for (int ks = 0; ks < 6; ++ks) wq[i][ks] = *(const GAS bf16x8*)(WQ + (size_t)(96 * head + 16 * (3 * half + i) + fr) * 192 + 32 * ks + 8 * kg);
        v4u rawv[8]; unsigned short kr1[8], kr2[8];
#pragma unroll
        for (int i = 0; i < 8; ++i) { const bf16* pr = P + (size_t)(m0 + wave * 8 + i) * PCOLS; rawv[i] = (v4u){0u, 0u, 0u, 0u}; if (lane < 40) rawv[i] = *(const GAS v4u*)(pr + 8 * lane);
            kr1[i] = 0; kr2[i] = 0; if (lane < 16) { kr1[i] = pr[320 + lane]; kr2[i] = pr[336 + lane]; } }
#pragma unroll
        for (int i = 0; i < 8; ++i) { const int tl = wave * 8 + i; const v4u raw = rawv[i];
            float x[8]; x[0] = bflo(raw.x); x[1] = bfhi(raw.x); x[2] = bflo(raw.y); x[3] = bfhi(raw.y); x[4] = bflo(raw.z); x[5] = bfhi(raw.z); x[6] = bflo(raw.w); x[7] = bfhi(raw.w);
            float ss = 0.f;
#pragma unroll
            for (int j = 0; j < 8; ++j) ss += x[j] * x[j];
            const float sq = wave_sum(lane < 24 ? ss : 0.f), skv = wave_sum((lane >= 24 && lane < 40) ? ss : 0.f);
            const float rq = rsqrtf(sq * (1.f / 192.f) + 1e-6f), rkv = rsqrtf(skv * (1.f / 128.f) + 1e-6f);
            if (lane < 24) { const float* g = qn + 8 * lane; v4u o; o.x = pk2(x[0] * rq * g[0], x[1] * rq * g[1]); o.y = pk2(x[2] * rq * g[2], x[3] * rq * g[3]); o.z = pk2(x[4] * rq * g[4], x[5] * rq * g[5]); o.w = pk2(x[6] * rq * g[6], x[7] * rq * g[7]);
                *(LAS v4u*)(CQN + tl * MP_CQ_LD + 8 * lane) = o; }
            else if (lane < 40) { const int c = 8 * (lane - 24); const float* g = kvn + c; v4u o; o.x = pk2(x[0] * rkv * g[0], x[1] * rkv * g[1]); o.y = pk2(x[2] * rkv * g[2], x[3] * rkv * g[3]); o.z = pk2(x[4] * rkv * g[4], x[5] * rkv * g[5]); o.w = pk2(x[6] * rkv * g[6], x[7] * rkv * g[7]);
                *(LAS v4u*)(CKVN + tl * MP_CKV_LD + c) = o; }
            if (lane < 16) { float x1 = bf2f(kr1[i]), x2 = bf2f(kr2[i]);
                if (!isctx) { const float c = RC[(t0 + tl) * 16 + lane], s = RS[(t0 + tl) * 16 + lane]; const float y1 = x1 * c - x2 * s, y2 = x1 * s + x2 * c; x1 = y1; x2 = y2; }
                const bf16 o1 = (bf16)f2bf(x1), o2 = (bf16)f2bf(x2);
#pragma unroll
                for (int h = 0; h < 4; ++h) { bf16* kr = KB + ((size_t)(b * 4 + h) * KSEQ + ki0 + tl) * 96; kr[64 + lane] = o1; kr[80 + lane] = o2; } }
        }
        __syncthreads();
        const size_t qrow0 = ((size_t)(b * 4 + head) * KSEQ + ki0) * 96;
        { f32x4 acc[3][4];
#pragma unroll
          for (int i = 0; i < 3; ++i)
#pragma unroll
              for (int m = 0; m < 4; ++m) acc[i][m] = (f32x4){0.f, 0.f, 0.f, 0.f};
#pragma unroll
          for (int ks = 0; ks < 6; ++ks)
#pragma unroll
              for (int m = 0; m < 4; ++m) { const bf16x8 xf = *(const LAS bf16x8*)(CQN + (16 * m + fr) * MP_CQ_LD + 32 * ks + 8 * kg);
#pragma unroll
                  for (int i = 0; i < 3; ++i) acc[i][m] = __builtin_amdgcn_mfma_f32_16x16x32_bf16(wq[i][ks], xf, acc[i][m], 0, 0, 0); }
#pragma unroll
          for (int m = 0; m < 4; ++m) { bf16* qr = QB + qrow0 + (size_t)(16 * m + fr) * 96;
              { v2u o; o.x = pk2(acc[0][m][0] * QSCALE, acc[0][m][1] * QSCALE); o.y = pk2(acc[0][m][2] * QSCALE, acc[0][m][3] * QSCALE); *(GAS v2u*)(qr + 48 * half + 4 * kg) = o; }
              f32x4 y1 = acc[1][m], y2 = acc[2][m];
              if (half == 1 && !isctx) { const int t = t0 + 16 * m + fr; const f32x4 c = *(const GAS f32x4*)(RC + t * 16 + 4 * kg), sn = *(const GAS f32x4*)(RS + t * 16 + 4 * kg); y1 = acc[1][m] * c - acc[2][m] * sn; y2 = acc[1][m] * sn + acc[2][m] * c; }
              v2u o1, o2; o1.x = pk2(y1[0] * QSCALE, y1[1] * QSCALE); o1.y = pk2(y1[2] * QSCALE, y1[3] * QSCALE); o2.x = pk2(y2[0] * QSCALE, y2[1] * QSCALE); o2.y = pk2(y2[2] * QSCALE, y2[3] * QSCALE);
              *(GAS v2u*)(qr + 48 * half + 16 + 4 * kg) = o1; *(GAS v2u*)(qr + 48 * half + 32 + 4 * kg) = o2; } }
        bf16x8 wkv[4][4];
#pragma unroll
        for (int nt = 0; nt < 4; ++nt)
#pragma unroll
            for (int ks = 0; ks < 4; ++ks) wkv[nt][ks] = *(const GAS bf16x8*)(WKV + (size_t)(128 * head + 64 * half + 16 * nt + fr) * 128 + 32 * ks + 8 * kg);
        { f32x4 acc[4][4];
#pragma unroll
          for (int nt = 0; nt < 4; ++nt)
#pragma unroll
              for (int m = 0; m < 4; ++m) acc[nt][m] = (f32x4){0.f, 0.f, 0.f, 0.f};
#pragma unroll
          for (int ks = 0; ks < 4; ++ks)
#pragma unroll
              for (int m = 0; m < 4; ++m) { const bf16x8 xf = *(const LAS bf16x8*)(CKVN + (16 * m + fr) * MP_CKV_LD + 32 * ks + 8 * kg);
#pragma unroll
                  for (int nt = 0; nt < 4; ++nt) acc[nt][m] = half == 0 ? __builtin_amdgcn_mfma_f32_16x16x32_bf16(wkv[nt][ks], xf, acc[nt][m], 0, 0, 0) : __builtin_amdgcn_mfma_f32_16x16x32_bf16(xf, wkv[nt][ks], acc[nt][m], 0, 0, 0); }
#pragma unroll
          for (int nt = 0; nt < 4; ++nt)
#pragma unroll
              for (int m = 0; m < 4; ++m) { v2u o; o.x = pk2(acc[nt][m][0], acc[nt][m][1]); o.y = pk2(acc[nt][m][2], acc[nt][m][3]);
                  if (half == 0) *(GAS v2u*)(KB + qrow0 + (size_t)(16 * m + fr) * 96 + 16 * nt + 4 * kg) = o;
                  else *(GAS v2u*)(VT + ((size_t)(b * 4 + head) * 64 + 16 * nt + fr) * KSEQ + ki0 + 16 * m + 4 * kg) = o; } }
        __syncthreads();
    }
}

constexpr int AT_KLD = 104, AT_VLD = 72;
constexpr int AT_KB = 64 * AT_KLD * 2, AT_VB = 64 * AT_VLD * 2, AT_BUF = AT_KB + AT_VB;
__device__ __forceinline__ void phase_attn(Frame& F, int li) { WS_DECL; frame_refresh(F);
    const bf16* QB = WSP(bf16, WS_QB); const bf16* KB = WSP(bf16, WS_KB); const bf16* VT = WSP(bf16, WS_VT); bf16* AO = WSP(bf16, WS_AO);
    const int lane = F.lane, wave = F.wave, tid = F.tid, ql = lane & 31, h2 = lane >> 5;
    const int nunits = 1024 + (li < DEPTH - 1 ? 64 : 0);
    const int c = blockIdx.x, vc = (F.G == 256) ? (c & 7) * 32 + (c >> 3) : c;
    for (int u = vc; u < nunits; u += F.G) {
        int bh, q0, nk; bool isctx = u >= 1024;
        if (!isctx) { bh = u >> 4; q0 = 256 + 256 * (u & 15); nk = KSEQ; } else { bh = u - 1024; q0 = 0; nk = 256; }
        const bf16* Kb = KB + (size_t)bh * KSEQ * 96; const bf16* Vb = VT + (size_t)bh * 64 * KSEQ;
        bf16x8 qf[6];
        { const bf16* qr = QB + ((size_t)bh * KSEQ + q0 + 32 * wave + ql) * 96 + 8 * h2;
#pragma unroll
          for (int ks = 0; ks < 6; ++ks) qf[ks] = *(const GAS bf16x8*)(qr + 16 * ks); }
        f32x16 O0, O1;
#pragma unroll
        for (int r = 0; r < 16; ++r) { O0[r] = 0.f; O1[r] = 0.f; }
        float m_run = -1e30f, l_run = 0.f;
        const int kc0 = tid, kc1 = tid + 512; const int vr = tid >> 3, vcn = tid & 7;
        v4u pk0, pk1 = (v4u){0u, 0u, 0u, 0u}, pv;
        { const GAS v4u* ks = (const GAS v4u*)Kb; pk0 = ks[kc0]; if (kc1 < 768) pk1 = ks[kc1]; pv = *(const GAS v4u*)(Vb + (size_t)vr * KSEQ + 8 * vcn); }
        __syncthreads();
        { LAS unsigned char* buf = F.lds; *(LAS v4u*)(buf + (kc0 / 12) * (AT_KLD * 2) + (kc0 % 12) * 16) = pk0; if (kc1 < 768) *(LAS v4u*)(buf + (kc1 / 12) * (AT_KLD * 2) + (kc1 % 12) * 16) = pk1;
          *(LAS v4u*)(buf + AT_KB + vr * (AT_VLD * 2) + vcn * 16) = pv; }
        __syncthreads();
        const int ntile = nk >> 6;
        for (int kt = 0; kt < ntile; ++kt) {
            const LAS unsigned char* buf = F.lds + (kt & 1) * AT_BUF; LAS unsigned char* nbuf = F.lds + ((kt + 1) & 1) * AT_BUF;
            const bool more = kt + 1 < ntile;
            if (more) { const GAS v4u* ks = (const GAS v4u*)(Kb + (size_t)(kt + 1) * 64 * 96); pk0 = ks[kc0]; if (kc1 < 768) pk1 = ks[kc1]; pv = *(const GAS v4u*)(Vb + (size_t)vr * KSEQ + (kt + 1) * 64 + 8 * vcn); }
            f32x16 S0, S1;
#pragma unroll
            for (int r = 0; r < 16; ++r) { S0[r] = 0.f; S1[r] = 0.f; }
#pragma unroll
            for (int ks = 0; ks < 6; ++ks) { const bf16x8 k0 = *(const LAS bf16x8*)(buf + ql * (AT_KLD * 2) + 32 * ks + 16 * h2), k1 = *(const LAS bf16x8*)(buf + (32 + ql) * (AT_KLD * 2) + 32 * ks + 16 * h2);
                S0 = __builtin_amdgcn_mfma_f32_32x32x16_bf16(k0, qf[ks], S0, 0, 0, 0); S1 = __builtin_amdgcn_mfma_f32_32x32x16_bf16(k1, qf[ks], S1, 0, 0, 0); }
            float mx = S0[0];
#pragma unroll
            for (int r = 1; r < 16; ++r) mx = fmaxf(mx, S0[r]);
#pragma unroll
            for (int r = 0; r < 16; ++r) mx = fmaxf(mx, S1[r]);
            mx = fmaxf(mx, __shfl_xor(mx, 32));
            const float m_new = fmaxf(m_run, mx), alpha = __builtin_amdgcn_exp2f(m_run - m_new); m_run = m_new;
            float ps = 0.f;
#pragma unroll
            for (int r = 0; r < 16; ++r) { S0[r] = __builtin_amdgcn_exp2f(S0[r] - m_new); S1[r] = __builtin_amdgcn_exp2f(S1[r] - m_new); ps += S0[r] + S1[r]; }
            l_run = l_run * alpha + ps;
#pragma unroll
            for (int r = 0; r < 16; ++r) { O0[r] *= alpha; O1[r] *= alpha; }
            union { bf16x8 v; unsigned u[4]; } p00, p01, p10, p11;
#pragma unroll
            for (int j = 0; j < 4; ++j) { p00.u[j] = pk2(S0[2 * j], S0[2 * j + 1]); p01.u[j] = pk2(S0[8 + 2 * j], S0[8 + 2 * j + 1]); p10.u[j] = pk2(S1[2 * j], S1[2 * j + 1]); p11.u[j] = pk2(S1[8 + 2 * j], S1[8 + 2 * j + 1]); }
            const LAS unsigned char* vb = buf + AT_KB;
#pragma unroll
            for (int dvt = 0; dvt < 2; ++dvt) { const LAS unsigned char* vrow = vb + (32 * dvt + ql) * (AT_VLD * 2) + 8 * h2;
#pragma unroll
                for (int sub = 0; sub < 2; ++sub)
#pragma unroll
                    for (int s = 0; s < 2; ++s) { union { bf16x8 v; v2u h[2]; } vf; vf.h[0] = *(const LAS v2u*)(vrow + 2 * (32 * sub + 16 * s)); vf.h[1] = *(const LAS v2u*)(vrow + 2 * (32 * sub + 16 * s + 8));
                        const bf16x8 pf = sub == 0 ? (s == 0 ? p00.v : p01.v) : (s == 0 ? p10.v : p11.v);
                        if (dvt == 0) O0 = __builtin_amdgcn_mfma_f32_32x32x16_bf16(vf.v, pf, O0, 0, 0, 0); else O1 = __builtin_amdgcn_mfma_f32_32x32x16_bf16(vf.v, pf, O1, 0, 0, 0); } }
            if (more) { *(LAS v4u*)(nbuf + (kc0 / 12) * (AT_KLD * 2) + (kc0 % 12) * 16) = pk0; if (kc1 < 768) *(LAS v4u*)(nbuf + (kc1 / 12) * (AT_KLD * 2) + (kc1 % 12) * 16) = pk1;
                *(LAS v4u*)(nbuf + AT_KB + vr * (AT_VLD * 2) + vcn * 16) = pv; }
            __syncthreads();
        }
        const float inv = 1.f / (l_run + __shfl_xor(l_run, 32));
        const int b = bh >> 2, head = bh & 3, qi = q0 + 32 * wave + ql;
        const size_t row = isctx ? (size_t)NL + b * 256 + qi : (size_t)b * 4096 + (qi - 256);
        bf16* orow = AO + row * 256 + head * 64 + 4 * h2;
#pragma unroll
        for (int g = 0; g < 4; ++g) { v2u o0, o1; o0.x = pk2(O0[4 * g] * inv, O0[4 * g + 1] * inv); o0.y = pk2(O0[4 * g + 2] * inv, O0[4 * g + 3] * inv); o1.x = pk2(O1[4 * g] * inv, O1[4 * g + 1] * inv); o1.y = pk2(O1[4 * g + 2] * inv, O1[4 * g + 3] * inv);
            *(GAS v2u*)(orow + 8 * g) = o0; *(GAS v2u*)(orow + 32 + 8 * g) = o1; }
    }
}

__device__ __forceinline__ void phase_fin_mla(Frame& F, int li) { WS_DECL; frame_refresh(F);
    const int nrows = li == DEPTH - 1 ? NL : NT; const float* g = in_ptr(I_MLAON) + li * 256; const bf16* AO = WSP(bf16, WS_AO); bf16* MIX = WSP(bf16, WS_A1);
    const int gw = blockIdx.x * NWAVES + F.wave, NGW = F.G * NWAVES; const f32x4 g4 = *(const GAS f32x4*)(g + 4 * F.lane);
    for (int m = gw; m < nrows; m += NGW) { const v2u w = *(const GAS v2u*)(AO + (size_t)m * 256 + 4 * F.lane);
        f32x4 x; x.x = bflo(w.x); x.y = bfhi(w.x); x.z = bflo(w.y); x.w = bfhi(w.y);
        const float r = rsqrtf(wave_sum(x.x * x.x + x.y * x.y + x.z * x.z + x.w * x.w) * (1.f / 256.f) + 1e-6f);
        v2u o; o.x = pk2(x.x * r * g4.x, x.y * r * g4.y); o.y = pk2(x.z * r * g4.z, x.w * r * g4.w); *(GAS v2u*)(MIX + (size_t)m * D + 4 * F.lane) = o; }
}
__device__ __forceinline__ void phase_fin_zero(Frame& F, int li, int c0) { WS_DECL; frame_refresh(F);
    const int nrows = li == DEPTH - 1 ? NL : NT; bf16* MIX = WSP(bf16, WS_A1); const int gw = blockIdx.x * NWAVES + F.wave, NGW = F.G * NWAVES;
    for (int m = gw; m < nrows; m += NGW) *(GAS v2u*)(MIX + (size_t)m * D + c0 + 4 * F.lane) = (v2u){0u, 0u};
}

__device__ __forceinline__ void phase_pro0b(Frame& F) { WS_DECL; frame_refresh(F);
    const int gt = blockIdx.x * NTHR + F.tid, NGT = F.G * NTHR;
    float* RC = WSP(float, WS_ROPE); float* RS = RC + 4096 * 16;
    for (int i = gt; i < 4096 * 16; i += NGT) { const int t = i >> 4, j = i & 15; const float inv = powf(10000.f, -(float)(j & 7) / 8.f); const float pos = j < 8 ? (float)(t >> 6) : (float)(t & 63);
        const float ang = pos * inv; RC[i] = cosf(ang); RS[i] = sinf(ang); }
    const float* wuq = in_ptr(I_WUQ); const float* wukv = in_ptr(I_WUKV); bf16* WQ = WSP(bf16, WS_WUQT); bf16* WKV = WSP(bf16, WS_WUKVT);
    for (int i = gt; i < DEPTH * 384 * 192; i += NGT) { const int li = i / (384 * 192), r = i % (384 * 192), n = r / 192, k = r % 192; WQ[i] = (bf16)f2bf(wuq[(size_t)li * 192 * 384 + (size_t)k * 384 + n]); }
    for (int i = gt; i < DEPTH * 512 * 128; i += NGT) { const int li = i / (512 * 128), r = i % (512 * 128), n = r / 128, k = r % 128; WKV[i] = (bf16)f2bf(wukv[(size_t)li * 128 * 512 + (size_t)k * 512 + n]); }
}

constexpr int LR_LD = 264;
__device__ __forceinline__ float gelu_tanh(float x) { const float u = 0.7978845608028654f * (x + 0.044715f * x * x * x); const float e = __expf(2.f * u); const float t = 1.f - 2.f / (e + 1.f); return 0.5f * x * (1.f + t); }
template <int PASS>
__device__ __forceinline__ void phase_lru(Frame& F, int li) { WS_DECL; frame_refresh(F);
    LAS bf16* RAW = (LAS bf16*)F.lds; LAS bf16* U = (LAS bf16*)(F.lds + 67 * LR_LD * 2); LAS bf16* HS = (LAS bf16*)(F.lds + 71680);
    const bf16* P = WSP(bf16, WS_P); bf16* MIX = WSP(bf16, WS_A1); f32x2* SUMM = WSP(f32x2, WS_SUMM);
    const float* cw = in_ptr(I_LCW) + li * 4 * 256; const float* cb = in_ptr(I_LCB) + li * 256;
    const float* lam_ = in_ptr(I_LLAM) + li * 512; const float* br_ = in_ptr(I_LBR) + li * 512; const float* bi_ = in_ptr(I_LBI) + li * 512; const float* on_ = in_ptr(I_LON) + li * 256;
    const bf16* LW = WSP(bf16, WS_LRUW) + (size_t)li * 16 * 4096;
    const int lane = F.lane, wave = F.wave, tid = F.tid, fr = lane & 15, kg = lane >> 4;
    const int nitems = (PASS == 3 && li == DEPTH - 1) ? NL / 64 : NT / 64;
    for (int item = blockIdx.x; item < nitems; item += F.G) {
        const int m0 = item * 64; const bool isctx = m0 >= NL; const int b = isctx ? (m0 - NL) >> 8 : m0 >> 12; const int t0 = isctx ? (m0 - NL) & 255 : m0 & 4095; const int Ls = isctx ? 256 : 4096;
        const size_t seg0 = isctx ? (size_t)NL + b * 256 : (size_t)b * 4096;
        for (int c = tid; c < 67 * 32; c += NTHR) { const int r = c >> 5, cc = c & 31, t = t0 - 2 + r; v4u v = (v4u){0u, 0u, 0u, 0u};
            if (t >= 0 && t < Ls) v = *(const GAS v4u*)(P + (seg0 + t) * PCOLS + 352 + 8 * cc);
            *(LAS v4u*)(RAW + r * LR_LD + 8 * cc) = v; }
        __syncthreads();
        { const int c2 = tid & 127, tq = tid >> 7; const int ch = 2 * c2;
          float w0[4], w1[4];
#pragma unroll
          for (int j = 0; j < 4; ++j) { w0[j] = cw[j * 256 + ch]; w1[j] = cw[j * 256 + ch + 1]; }
          const float b0 = cb[ch], b1 = cb[ch + 1];
          for (int t = tq * 16; t < tq * 16 + 16; ++t) { float s0 = b0, s1 = b1;
#pragma unroll
              for (int j = 0; j < 4; ++j) { const unsigned w = *(const LAS unsigned*)(RAW + (t + j) * LR_LD + ch); s0 += w0[j] * bflo(w); s1 += w1[j] * bfhi(w); }
              *(LAS unsigned*)(U + t * LR_LD + ch) = pk2(s0, s1); } }
        __syncthreads();
#pragma unroll 1
        for (int ni = 0; ni < 2; ++ni) {
            float yv[4][4];
            const int nt = 2 * wave + ni, nb = nt >> 2, ch = 16 * nt + fr;
            bf16x8 wfr[2][2][2]; float spc[2], brc[2], bic[2];
#pragma unroll
            for (int d = 0; d < 2; ++d) { spc[d] = lam_[d * 256 + ch]; brc[d] = br_[d * 256 + ch]; bic[d] = bi_[d * 256 + ch];
#pragma unroll
                for (int g = 0; g < 2; ++g)
#pragma unroll
                    for (int ks = 0; ks < 2; ++ks) wfr[d][g][ks] = *(const GAS bf16x8*)(LW + ((size_t)((g * 2 + d) * 4 + nb) * 64 + 16 * (nt & 3) + fr) * 64 + 32 * ks + 8 * kg); }
            float uu[4][4];
#pragma unroll
            for (int m = 0; m < 4; ++m)
#pragma unroll
                for (int r = 0; r < 4; ++r) uu[m][r] = bf2f(U[(16 * m + 4 * kg + r) * LR_LD + ch]);
#pragma unroll
            for (int d = 0; d < 2; ++d) {
                f32x4 ar[4], ai[4];
#pragma unroll
                for (int m = 0; m < 4; ++m) { ar[m] = (f32x4){0.f, 0.f, 0.f, 0.f}; ai[m] = (f32x4){0.f, 0.f, 0.f, 0.f}; }
#pragma unroll
                for (int ks = 0; ks < 2; ++ks) {
                    const bf16x8 wr = wfr[d][0][ks], wi = wfr[d][1][ks];
#pragma unroll
                    for (int m = 0; m < 4; ++m) { const bf16x8 xf = *(const LAS bf16x8*)(U + (16 * m + fr) * LR_LD + 64 * nb + 32 * ks + 8 * kg);
                        ar[m] = __builtin_amdgcn_mfma_f32_16x16x32_bf16(xf, wr, ar[m], 0, 0, 0); ai[m] = __builtin_amdgcn_mfma_f32_16x16x32_bf16(xf, wi, ai[m], 0, 0, 0); } }
                const float sp = log1pf(__expf(-spc[d])), brv = brc[d], biv = bic[d];
#pragma unroll
                for (int m = 0; m < 4; ++m)
#pragma unroll
                    for (int r = 0; r < 4; ++r) { const float rg = __builtin_amdgcn_rcpf(1.f + __expf(-(ar[m][r] + brv))), ig = __builtin_amdgcn_rcpf(1.f + __expf(-(ai[m][r] + biv))); const float av = __expf(-8.f * rg * sp);
                        ar[m][r] = av; ai[m][r] = __builtin_amdgcn_sqrtf(fmaxf(1.f - av * av, 0.f)) * (ig * uu[m][r]); }
                float H = 0.f;
                if (PASS == 3) {
                    const int cj = t0 >> 6, cbase = 1024 + b * 4, lbase = b * 64;
                    const int np = d == 0 ? (isctx ? cj : 4 + cj) : (isctx ? 3 - cj : 4 + 63 - cj);
                    const int q = (np + 3) >> 2, p_lo = kg * q, p_hi = (p_lo + q < np) ? p_lo + q : np;
                    float Aq = 1.f, Bq = 0.f;
                    for (int p0 = p_lo; p0 < p_hi; p0 += 8) { f32x2 sv[8];
#pragma unroll
                        for (int e = 0; e < 8; ++e) { const int p = p0 + e; sv[e] = (f32x2){1.f, 0.f};
                            if (p < p_hi) { int cid; if (d == 0) cid = isctx ? cbase + p : (p < 4 ? cbase + p : lbase + (p - 4)); else cid = isctx ? cbase + 3 - p : (p < 4 ? cbase + 3 - p : lbase + 63 - (p - 4));
                                sv[e] = *(const GAS f32x2*)(SUMM + ((size_t)cid * 2 + d) * 256 + ch); } }
#pragma unroll
                        for (int e = 0; e < 8; ++e) { Bq = sv[e].x * Bq + sv[e].y; Aq = sv[e].x * Aq; } }
#pragma unroll
                    for (int g = 0; g < 4; ++g) { const float Ag_ = __shfl(Aq, fr + 16 * g), Bg_ = __shfl(Bq, fr + 16 * g); H = Ag_ * H + Bg_; }
                }
                float Ac = 1.f, Bc = 0.f;
#pragma unroll
                for (int mi = 0; mi < 4; ++mi) { const int m = d == 0 ? mi : 3 - mi;
                    float Al, Bl;
                    if (d == 0) { Al = ar[m][0] * ar[m][1] * ar[m][2] * ar[m][3]; Bl = ((ai[m][0] * ar[m][1] + ai[m][1]) * ar[m][2] + ai[m][2]) * ar[m][3] + ai[m][3]; }
                    else { Al = ar[m][0] * ar[m][1] * ar[m][2] * ar[m][3]; Bl = ((ai[m][3] * ar[m][2] + ai[m][2]) * ar[m][1] + ai[m][1]) * ar[m][0] + ai[m][0]; }
                    float Ag[4], Bg[4];
#pragma unroll
                    for (int g = 0; g < 4; ++g) { Ag[g] = __shfl(Al, fr + 16 * g); Bg[g] = __shfl(Bl, fr + 16 * g); }
                    if (PASS == 1) {
                        float At = 1.f, Bt = 0.f;
#pragma unroll
                        for (int gi = 0; gi < 4; ++gi) { const int g = d == 0 ? gi : 3 - gi; Bt = Ag[g] * Bt + Bg[g]; At = Ag[g] * At; }
                        Bc = At * Bc + Bt; Ac = At * Ac;
                    } else {
                        float s = H, sin_ = H;
#pragma unroll
                        for (int gi = 0; gi < 4; ++gi) { const int g = d == 0 ? gi : 3 - gi; if (g == kg) sin_ = s; s = Ag[g] * s + Bg[g]; }
                        H = s;
                        float x = sin_;
#pragma unroll
                        for (int ri = 0; ri < 4; ++ri) { const int r = d == 0 ? ri : 3 - ri; x = ar[m][r] * x + ai[m][r]; if (d == 0) yv[m][r] = x; else yv[m][r] += x; }
                    }
                }
                if (PASS == 1 && kg == 0) *(GAS f32x2*)(SUMM + ((size_t)item * 2 + d) * 256 + ch) = (f32x2){Ac, Bc};
            }
            if (PASS == 3) {
#pragma unroll
                for (int m = 0; m < 4; ++m)
#pragma unroll
                    for (int r = 0; r < 4; ++r) HS[(16 * m + 4 * kg + r) * LR_LD + ch] = (bf16)f2bf(yv[m][r]);
            }
        }
        if (PASS == 3) {
            __syncthreads();
            const f32x4 on4 = *(const GAS f32x4*)(on_ + 4 * lane);
            for (int i = 0; i < 8; ++i) { const int tl = wave * 8 + i; const v2u hw = *(const LAS v2u*)(HS + tl * LR_LD + 4 * lane); const v2u gw = *(const GAS v2u*)(P + (size_t)(m0 + tl) * PCOLS + 608 + 4 * lane);
                f32x4 y; y.x = bflo(hw.x) * gelu_tanh(bflo(gw.x)); y.y = bfhi(hw.x) * gelu_tanh(bfhi(gw.x)); y.z = bflo(hw.y) * gelu_tanh(bflo(gw.y)); y.w = bfhi(hw.y) * gelu_tanh(bfhi(gw.y));
                const float rs = rsqrtf(wave_sum(y.x * y.x + y.y * y.y + y.z * y.z + y.w * y.w) * (1.f / 256.f) + 1e-6f);
                v2u o; o.x = pk2(y.x * rs * on4.x, y.y * rs * on4.y); o.y = pk2(y.z * rs * on4.z, y.w * rs * on4.w);
                *(GAS v2u*)(MIX + (size_t)(m0 + tl) * D + 256 + 4 * lane) = o; }
        }
        __syncthreads();
    }
}

__device__ __forceinline__ void phase_pro0c(Frame& F) { WS_DECL; frame_refresh(F);
    const int gt = blockIdx.x * NTHR + F.tid, NGT = F.G * NTHR; const float* wr = in_ptr(I_LWR); const float* wi = in_ptr(I_LWI); bf16* LW = WSP(bf16, WS_LRUW);
    for (int i = gt; i < DEPTH * 16 * 4096; i += NGT) { const int c = i & 63, dd = (i >> 6) & 63, nb = (i >> 12) & 3, d = (i >> 14) & 1, g = (i >> 15) & 1, li = i >> 16;
        const float* src = g == 0 ? wr : wi; LW[i] = (bf16)f2bf(src[((((size_t)li * 2 + d) * 4 + nb) * 64 + c) * 64 + dd]); }
}

template <int CTRL> __device__ __forceinline__ float dpp_f(float x) { return __builtin_bit_cast(float, __builtin_amdgcn_mov_dpp(__builtin_bit_cast(int, x), CTRL, 0xf, 0xf, true)); }
__device__ __forceinline__ float rowsum16(float x) { x += dpp_f<0x128>(x); x += dpp_f<0x124>(x); x += dpp_f<0x122>(x); x += dpp_f<0x121>(x); return x; }
constexpr int RW_C0 = 864;
constexpr size_t WS_RWUP = WS_LRUW + 512 * 1024;
constexpr size_t WS_EA = WS_Y;

__device__ __forceinline__ void phase_pro0e(Frame& F) { WS_DECL; frame_refresh(F);
    const int gt = blockIdx.x * NTHR + F.tid, NGT = F.G * NTHR; const float* wup = in_ptr(I_WUP); const float* aup = in_ptr(I_AUP); bf16* W = WSP(bf16, WS_RWUP);
    for (int i = gt; i < DEPTH * 2 * 2 * 256 * 32; i += NGT) { const int k = i & 31, n = (i >> 5) & 255, wa = (i >> 13) & 1, d = (i >> 14) & 1, li = i >> 15;
        const float* src = wa == 0 ? wup : aup; W[i] = (bf16)f2bf(src[(((size_t)li * 2 + d) * 32 + k) * 256 + n]); }
}

constexpr int R0_LD = 136, R0_ZLD = 72;
__device__ __forceinline__ void phase_rwkv_r0(Frame& F, int li) { WS_DECL; frame_refresh(F);
    LAS bf16* RAWL = (LAS bf16*)F.lds;
    LAS bf16* ZW = (LAS bf16*)(F.lds + 66 * R0_LD * 2);
    LAS bf16* ZA = ZW + 64 * R0_ZLD;
    const bf16* P = WSP(bf16, WS_P); bf16* EA = WSP(bf16, WS_EA); const bf16* W = WSP(bf16, WS_RWUP) + (size_t)li * 2 * 2 * 256 * 32;
    const float* mup = in_ptr(I_MUP) + li * 960 + 768; const float* mun = in_ptr(I_MUN) + li * 960 + 768; const float* w0 = in_ptr(I_W0) + li * 512; const float* a0 = in_ptr(I_A0) + li * 512;
    const int tid = F.tid, lane = F.lane, wave = F.wave, fr = lane & 15, kg = lane >> 4;
    for (int item = blockIdx.x; item < NT / 64; item += F.G) {
        const int m0 = item * 64; const bool isctx = m0 >= NL; const int t0 = isctx ? (m0 - NL) & 255 : m0 & 4095; const int Ls = isctx ? 256 : 4096; const size_t seg0 = (size_t)m0 - t0;
        __syncthreads();
        for (int c = tid; c < 66 * 16; c += NTHR) { const int r = c >> 4, cc = c & 15, t = t0 - 1 + r; v4u v = (v4u){0u, 0u, 0u, 0u};
            if (t >= 0 && t < Ls) v = *(const GAS v4u*)(P + (seg0 + t) * PCOLS + RW_C0 + 768 + 8 * cc);
            *(LAS v4u*)(RAWL + r * R0_LD + 8 * cc) = v; }
        __syncthreads();
        { const int c = tid & 127, tq = tid >> 7; const float mp = mup[c], mn = mun[c];
          for (int tl = tq * 16; tl < tq * 16 + 16; ++tl) { const float x = bf2f(RAWL[(tl + 1) * R0_LD + c]), xp = bf2f(RAWL[tl * R0_LD + c]), xn = bf2f(RAWL[(tl + 2) * R0_LD + c]);
              const float z = x + mp * (xp - x) + mn * (xn - x);
              if (c < 64) { const float e2 = __expf(2.f * z); ZW[tl * R0_ZLD + c] = (bf16)f2bf(1.f - 2.f * __builtin_amdgcn_rcpf(e2 + 1.f)); } else ZA[tl * R0_ZLD + (c - 64)] = (bf16)f2bf(z); } }
        __syncthreads();
        const int d = wave >> 2, hh = wave & 3;
#pragma unroll 1
        for (int nt = 0; nt < 4; ++nt) { const int ch0 = 64 * hh + 16 * nt;
            const bf16x8 wf = *(const GAS bf16x8*)(W + ((size_t)(d * 2 + 0) * 256 + ch0 + fr) * 32 + 8 * kg), af = *(const GAS bf16x8*)(W + ((size_t)(d * 2 + 1) * 256 + ch0 + fr) * 32 + 8 * kg);
            const f32x4 w04 = *(const GAS f32x4*)(w0 + d * 256 + ch0 + 4 * kg), a04 = *(const GAS f32x4*)(a0 + d * 256 + ch0 + 4 * kg);
#pragma unroll
            for (int m = 0; m < 4; ++m) { const bf16x8 zw = *(const LAS bf16x8*)(ZW + (16 * m + fr) * R0_ZLD + 32 * d + 8 * kg), za = *(const LAS bf16x8*)(ZA + (16 * m + fr) * R0_ZLD + 32 * d + 8 * kg);
                f32x4 xw = __builtin_amdgcn_mfma_f32_16x16x32_bf16(wf, zw, (f32x4){0.f, 0.f, 0.f, 0.f}, 0, 0, 0), xa = __builtin_amdgcn_mfma_f32_16x16x32_bf16(af, za, (f32x4){0.f, 0.f, 0.f, 0.f}, 0, 0, 0);
                xw = xw + w04; xa = xa + a04; float e[4], av[4];
#pragma unroll
                for (int r = 0; r < 4; ++r) { e[r] = -0.6065306597126334f * __builtin_amdgcn_rcpf(1.f + __expf(-xw[r])); av[r] = __builtin_amdgcn_rcpf(1.f + __expf(-xa[r])); }
                const size_t tok = (size_t)m0 + 16 * m + fr; v2u oe, oa; oe.x = pk2(e[0], e[1]); oe.y = pk2(e[2], e[3]); oa.x = pk2(av[0], av[1]); oa.y = pk2(av[2], av[3]);
                *(GAS v2u*)(EA + (tok * 4 + d) * 256 + ch0 + 4 * kg) = oe; *(GAS v2u*)(EA + (tok * 4 + 2 + d) * 256 + ch0 + 4 * kg) = oa; } }
    }
    __syncthreads();
}

constexpr int RW_T = 16, RW_NCH = (LCX + SEQ) / RW_T, RW_ROWS = RW_T + 2, RW_LD = 200, RW_P = 72;
constexpr int RW_RAW = 0, RW_RAWB = RW_ROWS * RW_LD * 2;
constexpr int RW_EAB = RW_RAW + 2 * RW_RAWB, RW_EABB = RW_T * 128 * 2;
constexpr int RW_VEC = RW_EAB + 2 * RW_EABB, RW_VECB = RW_T * 4 * 64 * 2 + RW_T * 64 * 4;
constexpr int RW_VV = RW_VEC + 2 * RW_VECB;
constexpr int RW_BON = RW_VV + 8 * 1024;
constexpr int RW_ARA = RW_BON + 8 * 64;
constexpr int RW_KB2 = RW_ARA + 2 * 16 * RW_P * 2;
constexpr int RW_AT2 = RW_KB2 + 2 * 32 * RW_P * 2;
constexpr int RW_ARR = RW_AT2 + 4 * 2048;
constexpr int RW_KT = RW_ARR + 4 * 16 * RW_P * 2;
constexpr int RW_BTN = RW_KT + 4 * 2048;
constexpr int RW_CWT = RW_BTN + 4 * 2048;
constexpr int RW_DO = RW_CWT + 4 * 256;
constexpr int RW_DOB = 16 * RW_P * 2 + 3 * 512;
constexpr int RW_BC = RW_DO + 4 * RW_DOB;
constexpr int RW_END = RW_BC + 9 * 256;
static_assert(RW_END <= RING_BYTES, "rwkv lds map");
typedef LAS bf16* lbf;
__device__ __forceinline__ bf16x8 rw_zero8() { return (bf16x8){0, 0, 0, 0, 0, 0, 0, 0}; }
__device__ __forceinline__ bf16x8 rw_k16(const LAS bf16* rowp, int kg) { bf16x8 r = rw_zero8(); if (kg < 2) r = *(const LAS bf16x8*)(rowp + 8 * kg); return r; }
__device__ __forceinline__ bf16x8 rw_perm4(const LAS bf16* rowp, int kg) { union { bf16x8 v; v2u h[2]; } u; u.h[0] = *(const LAS v2u*)(rowp + 4 * kg); u.h[1] = (v2u){0u, 0u}; return u.v; }
__device__ __forceinline__ bf16x8 rw_permK(const LAS bf16* rowp, int kg, int sp) { union { bf16x8 v; v2u h[2]; } u; u.h[0] = *(const LAS v2u*)(rowp + 32 * sp + 4 * kg); u.h[1] = *(const LAS v2u*)(rowp + 32 * sp + 16 + 4 * kg); return u.v; }
__device__ __forceinline__ bf16x8 rw_c4(f32x4 c) { union { bf16x8 v; unsigned u[4]; } x; x.u[0] = pk2(c[0], c[1]); x.u[1] = pk2(c[2], c[3]); x.u[2] = 0u; x.u[3] = 0u; return x.v; }
__device__ __forceinline__ bf16x8 rw_c8(f32x4 c0, f32x4 c1) { union { bf16x8 v; unsigned u[4]; } x; x.u[0] = pk2(c0[0], c0[1]); x.u[1] = pk2(c0[2], c0[3]); x.u[2] = pk2(c1[0], c1[1]); x.u[3] = pk2(c1[2], c1[3]); return x.v; }
__device__ __forceinline__ void rw_st_rows(lbf M, f32x4 c, int fr, int kg) {
#pragma unroll
    for (int r = 0; r < 4; ++r) M[(4 * kg + r) * 16 + fr] = (bf16)f2bf(c[r]); }
__device__ __forceinline__ void rw_st_cols(lbf M, f32x4 c, int fr, int kg, int pitch) {
    v2u o; o.x = pk2(c[0], c[1]); o.y = pk2(c[2], c[3]); *(LAS v2u*)(M + fr * pitch + 4 * kg) = o; }
#define RW_MFMA(a, b, c) __builtin_amdgcn_mfma_f32_16x16x32_bf16(a, b, c, 0, 0, 0)

__device__ __forceinline__ void phase_rwkv_scan(Frame& F, int li) { WS_DECL; frame_refresh(F);
    const bf16* P = WSP(bf16, WS_P); const bf16* EA = WSP(bf16, WS_EA); float* YR = WSP(float, WS_YR); float* BON = WSP(float, WS_BON);
    const bf16* zsrc = (const bf16*)(ws + WS_CTL + 65536);
    const int tid = F.tid, lane = F.lane, wave = F.wave, fr = lane & 15, kg = lane >> 4;
    LAS unsigned char* L = F.lds;
    for (int item = blockIdx.x; item < 256; item += F.G) {
        const int vhalf = item & 1, d = (item >> 1) & 1, h = (item >> 2) & 3, b = item >> 4;
        __syncthreads();
        const int pt = (tid - 128) & 255, ps = pt >> 4, pq = pt & 15;
        const int sk = pt & 63, sq = pt >> 6;
        { LAS float* BC = (LAS float*)(L + RW_BC); const float* mup = in_ptr(I_MUP) + li * 960; const float* mun = in_ptr(I_MUN) + li * 960;
          if (tid < 64) { const int c = 64 * h + tid; BC[tid] = mup[c]; BC[64 + tid] = mup[256 + c]; BC[128 + tid] = mup[512 + c]; BC[192 + tid] = mun[c]; BC[256 + tid] = mun[256 + c]; BC[320 + tid] = mun[512 + c];
              BC[384 + tid] = in_ptr(I_KK)[li * 256 + c]; BC[448 + tid] = in_ptr(I_KA)[li * 256 + c]; BC[512 + tid] = in_ptr(I_RK)[li * 256 + c]; } }
        __syncthreads();
        f32x4 S0 = (f32x4){0.f, 0.f, 0.f, 0.f}, S1 = S0, S2 = S0, S3 = S0;
        v4u ra[11];
#pragma unroll
        for (int q = 0; q < 11; ++q) ra[q] = (v4u){0u, 0u, 0u, 0u};
        if (wave < 2) {
#pragma unroll 1
            for (int it = -8; it <= RW_NCH; ++it) {
                if (it >= 0 && it < RW_NCH) {
                    const lbf VV = (lbf)(L + RW_VV + (it & 7) * 1024), ARR = (lbf)(L + RW_ARR + (it & 3) * (16 * RW_P * 2)), KT = (lbf)(L + RW_KT + (it & 3) * 2048), BTN = (lbf)(L + RW_BTN + (it & 3) * 2048);
                    const LAS float* CWT = (const LAS float*)(L + RW_CWT + (it & 3) * 256);
                    const lbf APT = (lbf)(L + RW_DO + (it & 3) * RW_DOB), AMT = APT + 16 * RW_P, ARKT = AMT + 256, ARBTN = ARKT + 256;
                    const f32x4 Z = (f32x4){0.f, 0.f, 0.f, 0.f};
                    const bf16x8 bvv = rw_k16(VV + (16 * wave + fr) * 16, kg);
                    const bf16x8 sb0 = rw_c8(S0, S1), sb1 = rw_c8(S2, S3);
                    f32x4 UT = RW_MFMA(rw_k16(AMT + fr * 16, kg), bvv, Z);
                    UT = RW_MFMA(rw_permK(APT + fr * RW_P, kg, 0), sb0, UT); UT = RW_MFMA(rw_permK(APT + fr * RW_P, kg, 1), sb1, UT);
                    f32x4 YT = RW_MFMA(rw_k16(ARKT + fr * 16, kg), bvv, Z);
                    YT = RW_MFMA(rw_permK(ARR + fr * RW_P, kg, 0), sb0, YT); YT = RW_MFMA(rw_permK(ARR + fr * RW_P, kg, 1), sb1, YT);
                    const bf16x8 ub = rw_c4(UT);
                    YT = RW_MFMA(rw_perm4(ARBTN + fr * 16, kg), ub, YT);
                    { const bool isctx = it < LCX / RW_T;
                      if (!isctx || li < DEPTH - 1) { const int cl = isctx ? it : it - LCX / RW_T; const int Ls = isctx ? LCX : SEQ; const int tlo = d == 0 ? cl * RW_T : Ls - RW_T - cl * RW_T; const size_t seg0 = isctx ? (size_t)NL + b * LCX : (size_t)b * SEQ;
#pragma unroll
                          for (int r = 0; r < 4; ++r) { const int sidx = 4 * kg + r; const int t = d == 0 ? tlo + sidx : tlo + RW_T - 1 - sidx;
                              YR[((size_t)d * NT + seg0 + t) * 256 + 64 * h + 32 * vhalf + 16 * wave + fr] = YT[r]; }
                          if (vhalf == 0 && wave == 0 && lane < RW_T) { const LAS float* BONS = (const LAS float*)(L + RW_BON) + (it & 7) * RW_T; const int t = d == 0 ? tlo + lane : tlo + RW_T - 1 - lane;
                              BON[((size_t)d * NT + seg0 + t) * 4 + h] = BONS[lane]; } } }
                    { f32x4 q = RW_MFMA(rw_k16(KT + (0 + fr) * 16, kg), bvv, S0); q = RW_MFMA(rw_perm4(BTN + (0 + fr) * 16, kg), ub, q); S0 = q * *(const LAS f32x4*)(CWT + 0 + 4 * kg); }
                    { f32x4 q = RW_MFMA(rw_k16(KT + (16 + fr) * 16, kg), bvv, S1); q = RW_MFMA(rw_perm4(BTN + (16 + fr) * 16, kg), ub, q); S1 = q * *(const LAS f32x4*)(CWT + 16 + 4 * kg); }
                    { f32x4 q = RW_MFMA(rw_k16(KT + (32 + fr) * 16, kg), bvv, S2); q = RW_MFMA(rw_perm4(BTN + (32 + fr) * 16, kg), ub, q); S2 = q * *(const LAS f32x4*)(CWT + 32 + 4 * kg); }
                    { f32x4 q = RW_MFMA(rw_k16(KT + (48 + fr) * 16, kg), bvv, S3); q = RW_MFMA(rw_perm4(BTN + (48 + fr) * 16, kg), ub, q); S3 = q * *(const LAS f32x4*)(CWT + 48 + 4 * kg); }
                }
                __syncthreads();
            }
        } else if (wave < 6) {
#pragma unroll 1
            for (int it = -8; it <= RW_NCH; ++it) {
                { const int ca = it + 5;
                  if (ca >= 0 && ca < RW_NCH && ((ca & 3) == wave - 2)) { LAS bf16* RAWW = (LAS bf16*)(L + RW_RAW + (ca & 1) * RW_RAWB); LAS bf16* EAW = (LAS bf16*)(L + RW_EAB + (ca & 1) * RW_EABB);
#pragma unroll
                      for (int q = 0; q < 11; ++q) { const int c = lane + 64 * q;
                          if (c < RW_ROWS * 24) *(LAS v4u*)(RAWW + (c / 24) * RW_LD + 8 * (c % 24)) = ra[q];
                          else if (c < RW_ROWS * 24 + RW_T * 16) { const int e = c - RW_ROWS * 24; *(LAS v4u*)(EAW + 8 * e) = ra[q]; } } }
                  const int cn = it + 8;
                  if (cn < RW_NCH && ((cn & 3) == wave - 2)) { const bool isctx = cn < LCX / RW_T; const int cl = isctx ? cn : cn - LCX / RW_T; const int Ls = isctx ? LCX : SEQ; const int tlo = d == 0 ? cl * RW_T : Ls - RW_T - cl * RW_T;
                      const size_t seg0 = isctx ? (size_t)NL + b * LCX : (size_t)b * SEQ;
#pragma unroll
                      for (int q = 0; q < 11; ++q) { const int c = lane + 64 * q; const bf16* src = zsrc;
                          if (c < RW_ROWS * 24) { const int r = c / 24, cc = c % 24, t = tlo - 1 + r; const int col = 256 * (cc >> 3) + 64 * h + 8 * (cc & 7);
                              if (t >= 0 && t < Ls) src = P + (seg0 + t) * PCOLS + RW_C0 + col; }
                          else if (c < RW_ROWS * 24 + RW_T * 16) { const int e = c - RW_ROWS * 24, s = e >> 4, cc = e & 15; const int t = d == 0 ? tlo + s : tlo + RW_T - 1 - s;
                              src = EA + ((seg0 + t) * 4 + (cc >> 3) * 2 + d) * 256 + 64 * h + 8 * (cc & 7); }
                          ra[q] = *(const GAS v4u*)src; } } }
                const int cb = it + 4;
                if (cb >= 0 && cb < RW_NCH) {
                    const LAS bf16* RAW = (const LAS bf16*)(L + RW_RAW + (cb & 1) * RW_RAWB); const LAS bf16* EAB = (const LAS bf16*)(L + RW_EAB + (cb & 1) * RW_EABB);
                    const lbf VEC = (lbf)(L + RW_VEC + (cb & 1) * RW_VECB); LAS float* LWF = (LAS float*)(L + RW_VEC + (cb & 1) * RW_VECB + RW_T * 4 * 64 * 2);
                    const lbf VV = (lbf)(L + RW_VV + (cb & 7) * 1024); LAS float* BONS = (LAS float*)(L + RW_BON) + (cb & 7) * RW_T;
                    const int prow = d == 0 ? ps + 1 : RW_T - ps;
                    const LAS float* BC = (const LAS float*)(L + RW_BC) + 4 * pq;
                    const f32x4 mpr = *(const LAS f32x4*)(BC), mpk = *(const LAS f32x4*)(BC + 64), mpv = *(const LAS f32x4*)(BC + 128), mnr = *(const LAS f32x4*)(BC + 192), mnk = *(const LAS f32x4*)(BC + 256), mnv = *(const LAS f32x4*)(BC + 320);
                    const f32x4 kk_c = *(const LAS f32x4*)(BC + 384), ka_c = *(const LAS f32x4*)(BC + 448), rk_c = *(const LAS f32x4*)(BC + 512);
                    f32x4 zr, zk, zv;
                    { const LAS bf16* r0 = RAW + prow * RW_LD + 4 * pq;
#define RW_LD4(p) ({ const v2u w_ = *(const LAS v2u*)(p); (f32x4){bflo(w_.x), bfhi(w_.x), bflo(w_.y), bfhi(w_.y)}; })
                      { const f32x4 x = RW_LD4(r0), xp = RW_LD4(r0 - RW_LD), xn = RW_LD4(r0 + RW_LD); zr = x + mpr * (xp - x) + mnr * (xn - x); }
                      { const f32x4 x = RW_LD4(r0 + 64), xp = RW_LD4(r0 + 64 - RW_LD), xn = RW_LD4(r0 + 64 + RW_LD); zk = x + mpk * (xp - x) + mnk * (xn - x); }
                      { const f32x4 x = RW_LD4(r0 + 128), xp = RW_LD4(r0 + 128 - RW_LD), xn = RW_LD4(r0 + 128 + RW_LD); zv = x + mpv * (xp - x) + mnv * (xn - x); } }
                    const f32x4 lw4 = RW_LD4(EAB + ps * 128 + 4 * pq), a4 = RW_LD4(EAB + ps * 128 + 64 + 4 * pq);
                    const f32x4 kkr = zk * kk_c; const float ss = rowsum16((kkr.x * kkr.x + kkr.y * kkr.y) + (kkr.z * kkr.z + kkr.w * kkr.w));
                    const f32x4 kd = zk * ((a4 - 1.f) * ka_c + 1.f); const f32x4 bq = zr * kd * rk_c; const float bn = rowsum16((bq.x + bq.y) + (bq.z + bq.w));
                    const f32x4 kkn = kkr * rsqrtf(fmaxf(ss, 1e-24f)), kka = kkn * a4;
                    { v2u o; lbf vp = VEC + ps * 256 + 4 * pq;
                      o.x = pk2(kkn.x, kkn.y); o.y = pk2(kkn.z, kkn.w); *(LAS v2u*)(vp) = o; o.x = pk2(kka.x, kka.y); o.y = pk2(kka.z, kka.w); *(LAS v2u*)(vp + 64) = o;
                      o.x = pk2(kd.x, kd.y); o.y = pk2(kd.z, kd.w); *(LAS v2u*)(vp + 128) = o; o.x = pk2(zr.x, zr.y); o.y = pk2(zr.z, zr.w); *(LAS v2u*)(vp + 192) = o; }
                    *(LAS f32x4*)(LWF + ps * 64 + 4 * pq) = lw4;
                    if ((pq >> 3) == vhalf) { const int v0 = 4 * (pq & 7); VV[(v0 + 0) * 16 + ps] = (bf16)f2bf(zv.x); VV[(v0 + 1) * 16 + ps] = (bf16)f2bf(zv.y); VV[(v0 + 2) * 16 + ps] = (bf16)f2bf(zv.z); VV[(v0 + 3) * 16 + ps] = (bf16)f2bf(zv.w); }
                    if (pq == 0) BONS[ps] = bn;
                }
                const int cc3 = it + 3;
                if (cc3 >= 0 && cc3 < RW_NCH) {
                    const LAS bf16* VEC = (const LAS bf16*)(L + RW_VEC + (cc3 & 1) * RW_VECB); const LAS float* LWF = (const LAS float*)(L + RW_VEC + (cc3 & 1) * RW_VECB + RW_T * 4 * 64 * 2);
                    const lbf ARA = (lbf)(L + RW_ARA + (cc3 & 1) * (16 * RW_P * 2)), KB2 = (lbf)(L + RW_KB2 + (cc3 & 1) * (32 * RW_P * 2)), AT2 = (lbf)(L + RW_AT2 + (cc3 & 3) * 2048);
                    const lbf ARR = (lbf)(L + RW_ARR + (cc3 & 3) * (16 * RW_P * 2)), KT = (lbf)(L + RW_KT + (cc3 & 3) * 2048), BTN = (lbf)(L + RW_BTN + (cc3 & 3) * 2048); LAS float* CWT = (LAS float*)(L + RW_CWT + (cc3 & 3) * 256);
                    float cl = 0.f;
                    for (int s = 0; s < 4 * sq; ++s) cl += LWF[s * 64 + sk];
                    float cwm = __expf(cl);
#pragma unroll
                    for (int j = 0; j < 4; ++j) { const int s = 4 * sq + j; cl += LWF[s * 64 + sk]; const float cw = __expf(cl), icw = __builtin_amdgcn_rcpf(cw);
                        const float kkv = bf2f(VEC[s * 256 + sk]), kkav = bf2f(VEC[s * 256 + 64 + sk]), kdv = bf2f(VEC[s * 256 + 128 + sk]), rv = bf2f(VEC[s * 256 + 192 + sk]);
                        const bf16 at = (bf16)f2bf(kkv * cwm), rt = (bf16)f2bf(rv * cw), kt = (bf16)f2bf(kdv * icw), btv = (bf16)f2bf(kkav * icw), btn = (bf16)f2bf(-kkav * icw);
                        ARA[s * RW_P + sk] = at; AT2[sk * 16 + s] = at; ARR[s * RW_P + sk] = rt; KB2[s * RW_P + sk] = kt; KT[sk * 16 + s] = kt; KB2[(16 + s) * RW_P + sk] = btv; BTN[sk * 16 + s] = btn;
                        if (s == RW_T - 1) CWT[sk] = cw;
                        cwm = cw; }
                }
                __syncthreads();
            }
        } else {
#pragma unroll 1
            for (int it = -8; it <= RW_NCH; ++it) {
                const int c = it + 2;
                if (c >= 0 && c < RW_NCH && ((c & 1) == (wave & 1))) {
                    const LAS bf16* ARA = (const LAS bf16*)(L + RW_ARA + (c & 1) * (16 * RW_P * 2)); const LAS bf16* KB2 = (const LAS bf16*)(L + RW_KB2 + (c & 1) * (32 * RW_P * 2));
                    const LAS bf16* ARR = (const LAS bf16*)(L + RW_ARR + (c & 3) * (16 * RW_P * 2)); const LAS bf16* AT2 = (const LAS bf16*)(L + RW_AT2 + (c & 3) * 2048);
                    const lbf APT = (lbf)(L + RW_DO + (c & 3) * RW_DOB), AMT = APT + 16 * RW_P, ARKT = AMT + 256, ARBTN = ARKT + 256;
                    const f32x4 Z = (f32x4){0.f, 0.f, 0.f, 0.f};
                    f32x4 gkk = Z, gkkT = Z, grk = Z, gn = Z, gnT = Z, grb = Z;
#pragma unroll
                    for (int ks = 0; ks < 2; ++ks) { const bf16x8 ak = *(const LAS bf16x8*)(KB2 + fr * RW_P + 32 * ks + 8 * kg), ab = *(const LAS bf16x8*)(KB2 + (16 + fr) * RW_P + 32 * ks + 8 * kg);
                        const bf16x8 ba = *(const LAS bf16x8*)(ARA + fr * RW_P + 32 * ks + 8 * kg), br = *(const LAS bf16x8*)(ARR + fr * RW_P + 32 * ks + 8 * kg);
                        gkk = RW_MFMA(ak, ba, gkk); gkkT = RW_MFMA(ba, ak, gkkT); grk = RW_MFMA(ak, br, grk); gn = RW_MFMA(ab, ba, gn); gnT = RW_MFMA(ba, ab, gnT); grb = RW_MFMA(ab, br, grb); }
                    f32x4 w1, w1T;
#pragma unroll
                    for (int r = 0; r < 4; ++r) { const int row = 4 * kg + r;
                        if (!(row < fr)) { gkk[r] = 0.f; gn[r] = 0.f; } if (!(fr < row)) { gkkT[r] = 0.f; gnT[r] = 0.f; } if (!(row <= fr)) { grk[r] = 0.f; grb[r] = 0.f; }
                        const float idt = row == fr ? 1.f : 0.f; w1[r] = idt - gn[r]; w1T[r] = idt - gnT[r]; }
                    const bf16x8 bn = rw_c4(gn), bnT = rw_c4(gnT);
                    const f32x4 n2 = RW_MFMA(bnT, bn, Z), n2T = RW_MFMA(bn, bnT, Z);
                    const bf16x8 b2 = rw_c4(n2), b2T = rw_c4(n2T);
                    const f32x4 n4 = RW_MFMA(b2T, b2, Z), n4T = RW_MFMA(b2, b2T, Z);
                    const bf16x8 b4 = rw_c4(n4), b4T = rw_c4(n4T);
                    const f32x4 n8 = RW_MFMA(b4T, b4, Z);
                    const bf16x8 bw1T = rw_c4(w1T);
                    const f32x4 w2 = RW_MFMA(bw1T, b2, w1), w2T = RW_MFMA(b2, bw1T, w1T);
                    const bf16x8 bw2T = rw_c4(w2T);
                    const f32x4 w3 = RW_MFMA(bw2T, b4, w2), w3T = RW_MFMA(b4, bw2T, w2T);
                    const f32x4 xi = RW_MFMA(rw_c4(w3T), rw_c4(n8), w3);
                    const bf16x8 bx = rw_c4(xi);
                    const f32x4 am = RW_MFMA(rw_c4(gkkT), bx, Z);
                    rw_st_cols(AMT, am, fr, kg, 16); rw_st_cols(ARKT, grk, fr, kg, 16); { f32x4 nb = Z - grb; rw_st_cols(ARBTN, nb, fr, kg, 16); }
#pragma unroll
                    for (int m = 0; m < 4; ++m) { const f32x4 ap = RW_MFMA(rw_perm4(AT2 + (16 * m + fr) * 16, kg), bx, Z);
                        rw_st_cols(APT + 16 * m, ap, fr, kg, RW_P); }
                }
                __syncthreads();
            }
        }
    }
}

__device__ __forceinline__ void phase_fin_rwkv(Frame& F, int li) { WS_DECL; frame_refresh(F);
    const int nrows = li == DEPTH - 1 ? NL : NT; const int lane = F.lane, wave = F.wave, tid = F.tid;
    LAS float* GUP = (LAS float*)F.lds;
    LAS float* SG = (LAS float*)(F.lds + 65536) + wave * 64;
    const bf16* P = WSP(bf16, WS_P); const float* YR = WSP(float, WS_YR); const float* BON = WSP(float, WS_BON); bf16* MIX = WSP(bf16, WS_A1);
    { const float* gup = in_ptr(I_GUP) + (size_t)li * 64 * 256; for (int i = tid; i < 64 * 256; i += NTHR) GUP[i] = gup[i]; }
    const float* mup = in_ptr(I_MUP) + li * 960; const float* mun = in_ptr(I_MUN) + li * 960;
    const f32x4 mpv = *(const GAS f32x4*)(mup + 512 + 4 * lane), mnv = *(const GAS f32x4*)(mun + 512 + 4 * lane);
    const float mpg = mup[896 + lane], mng = mun[896 + lane];
    const f32x4 lg = *(const GAS f32x4*)(in_ptr(I_LNG) + li * 256 + 4 * lane), lb = *(const GAS f32x4*)(in_ptr(I_LNB) + li * 256 + 4 * lane);
    __syncthreads();
    const int gw = blockIdx.x * NWAVES + wave, NGW = F.G * NWAVES;
    for (int m = gw; m < nrows; m += NGW) {
        const bool isctx = m >= NL; const int t = isctx ? (m - NL) & 255 : m & 4095; const int Ls = isctx ? 256 : 4096;
        const bf16* pr = P + (size_t)m * PCOLS + RW_C0;
        const bool hp = t > 0, hn = t + 1 < Ls;
        f32x4 v;
        { const v2u w = *(const GAS v2u*)(pr + 512 + 4 * lane); v2u wp = (v2u){0u, 0u}, wn = (v2u){0u, 0u};
          if (hp) wp = *(const GAS v2u*)(pr - PCOLS + 512 + 4 * lane); if (hn) wn = *(const GAS v2u*)(pr + PCOLS + 512 + 4 * lane);
          const f32x4 x = (f32x4){bflo(w.x), bfhi(w.x), bflo(w.y), bfhi(w.y)}, xp = (f32x4){bflo(wp.x), bfhi(wp.x), bflo(wp.y), bfhi(wp.y)}, xn = (f32x4){bflo(wn.x), bfhi(wn.x), bflo(wn.y), bfhi(wn.y)};
          v = x + mpv * (xp - x) + mnv * (xn - x); }
        { const float x = bf2f(pr[896 + lane]); const float xp = hp ? bf2f(pr[896 + lane - PCOLS]) : 0.f, xn = hn ? bf2f(pr[896 + lane + PCOLS]) : 0.f;
          SG[lane] = sigmoidf_(x + mpg * (xp - x) + mng * (xn - x)); }
        LDS_WAIT();
        f32x4 g = (f32x4){0.f, 0.f, 0.f, 0.f};
#pragma unroll 8
        for (int j = 0; j < 64; ++j) { const float sj = SG[j]; const f32x4 gu = *(const LAS f32x4*)(GUP + j * 256 + 4 * lane); g = g + gu * sj; }
        const f32x4 y = *(const GAS f32x4*)(YR + (size_t)m * 256 + 4 * lane) + *(const GAS f32x4*)(YR + ((size_t)NT + m) * 256 + 4 * lane);
        const float mean = rowsum16((y.x + y.y) + (y.z + y.w)) * (1.f / 64.f);
        const f32x4 yc = y - mean; const float var = rowsum16((yc.x * yc.x + yc.y * yc.y) + (yc.z * yc.z + yc.w * yc.w)) * (1.f / 64.f);
        const f32x4 yn = yc * rsqrtf(var + 64e-5f) * lg + lb;
        const int hh = lane >> 4; const float bon = BON[(size_t)m * 4 + hh] + BON[((size_t)NT + m) * 4 + hh];
        const f32x4 o = (yn + v * bon) * g;
        v2u ow; ow.x = pk2(o.x, o.y); ow.y = pk2(o.z, o.w); *(GAS v2u*)(MIX + (size_t)m * D + 512 + 4 * lane) = ow;
        LDS_WAIT();
    }
    __syncthreads();
}

constexpr float HY_DMIN = -3.0701134573253945f, HY_DMAX = -15.350567286626973f;
constexpr int HY_X = 0, HY_TW = 65536, HY_W3 = 98304;
__device__ __forceinline__ float hy_delta(int ch) { return -(HY_DMIN + (float)ch * ((HY_DMAX - HY_DMIN) / 255.f)); }

__device__ __forceinline__ void phase_pro0d(Frame& F) { WS_DECL; frame_refresh(F);
    const int lane = F.lane; const int gw = blockIdx.x * NWAVES + F.wave, NGW = F.G * NWAVES;
    const float* w1 = in_ptr(I_HW1); const float* b1 = in_ptr(I_HB1); const float* w2 = in_ptr(I_HW2); const float* b2 = in_ptr(I_HB2);
    for (int it = gw; it < DEPTH * (SEQ + LCX); it += NGW) {
        const int li = it / (SEQ + LCX), r = it % (SEQ + LCX); const bool isctx = r >= SEQ; const int l = isctx ? r - SEQ : r; const int L = isctx ? LCX : SEQ;
        float z = 0.f;
        if (lane == 0) z = (float)l / (float)(L - 1);
        else if (lane < 33) { const int i = (lane - 1) & 15; const float band = 1e-4f + (float)i * ((15.f - 1e-4f) / 15.f); const float ang = band * (6.283185307179586f / (float)L) * (float)l; z = lane < 17 ? cosf(ang) : -sinf(ang); }
        float h1 = b1[li * 64 + lane];
        for (int i = 0; i < 33; ++i) h1 += __shfl(z, i) * w1[(li * 33 + i) * 64 + lane];
        h1 = sinf(h1);
        float h2 = b2[li * 64 + lane];
        for (int i = 0; i < 64; ++i) h2 += __shfl(h1, i) * w2[(li * 64 + i) * 64 + lane];
        h2 = sinf(h2);
        float* dst = isctx ? WSP(float, WS_H2C) + ((size_t)li * LCX + l) * 64 : WSP(float, WS_H2L) + ((size_t)li * SEQ + l) * 64;
        dst[lane] = h2;
    }
}

typedef f32x2 cpx;
__device__ __forceinline__ cpx cmul(cpx a, cpx b) { return (cpx){a.x * b.x - a.y * b.y, a.x * b.y + a.y * b.x}; }
__device__ __forceinline__ cpx cmulc(cpx a, cpx b) { return (cpx){a.x * b.x + a.y * b.y, a.y * b.x - a.x * b.y}; }
__device__ __forceinline__ cpx cmi(cpx z) { return (cpx){z.y, -z.x}; }
__device__ __forceinline__ int hy_p(int n) { return n ^ ((n >> 5) & 7) ^ (((n >> 6) & 3) << 3); }
__device__ __forceinline__ void hy_build_tw(Frame& F) {
    LAS cpx* TW = (LAS cpx*)(F.lds + HY_TW);
    for (int k = F.tid; k < 4096; k += NTHR) { float sn, cs; sincospif((float)k * (1.f / 4096.f), &sn, &cs); TW[k] = (cpx){cs, -sn}; }
}
__device__ __forceinline__ void dft4(cpx x0, cpx x1, cpx x2, cpx x3, cpx& X0, cpx& X1, cpx& X2, cpx& X3) {
    const cpx t0 = x0 + x2, t1 = x0 - x2, t2 = x1 + x3, t3 = cmi(x1 - x3); X0 = t0 + t2; X1 = t1 + t3; X2 = t0 - t2; X3 = t1 - t3; }
__device__ __forceinline__ void dft8(cpx (&a)[8]) {
    const float R2 = 0.7071067811865476f; cpx e[4], o[4];
    dft4(a[0] + a[4], a[1] + a[5], a[2] + a[6], a[3] + a[7], e[0], e[1], e[2], e[3]);
    const cpx d1 = a[1] - a[5], d3 = a[3] - a[7];
    dft4(a[0] - a[4], (cpx){(d1.x + d1.y) * R2, (d1.y - d1.x) * R2}, cmi(a[2] - a[6]), (cpx){(d3.y - d3.x) * R2, -(d3.x + d3.y) * R2}, o[0], o[1], o[2], o[3]);
#pragma unroll
    for (int m = 0; m < 4; ++m) { a[2 * m] = e[m]; a[2 * m + 1] = o[m]; }
}
__device__ __forceinline__ void dft16(cpx (&a)[16]) {
    const float C1 = 0.9238795325112867f, S1 = 0.3826834323650898f, R2 = 0.7071067811865476f;
    cpx e[8], o[8];
#pragma unroll
    for (int k = 0; k < 8; ++k) { e[k] = a[k] + a[k + 8]; o[k] = a[k] - a[k + 8]; }
    o[1] = cmul(o[1], (cpx){C1, -S1}); o[2] = cmul(o[2], (cpx){R2, -R2}); o[3] = cmul(o[3], (cpx){S1, -C1}); o[4] = cmi(o[4]);
    o[5] = cmul(o[5], (cpx){-S1, -C1}); o[6] = cmul(o[6], (cpx){-R2, -R2}); o[7] = cmul(o[7], (cpx){-C1, -S1});
    dft8(e); dft8(o);
#pragma unroll
    for (int m = 0; m < 8; ++m) { a[2 * m] = e[m]; a[2 * m + 1] = o[m]; }
}
template <int R> __device__ __forceinline__ void cconj(cpx (&a)[R]) {
#pragma unroll
    for (int k = 0; k < R; ++k) a[k].y = -a[k].y; }
template <bool INV, bool ZU> __device__ __forceinline__ void hy_pass1(LAS cpx* X, const LAS cpx* TW, int tid) {
    cpx a[16]; const cpx w1 = TW[tid];
#pragma unroll
    for (int k = 0; k < 16; ++k) a[k] = (!INV && ZU && k >= 8) ? (cpx){0.f, 0.f} : X[hy_p(tid + 512 * k)];
    if (!INV) { dft16(a); cpx w = w1;
#pragma unroll
        for (int q = 1; q < 16; ++q) { a[q] = cmul(a[q], w); w = cmul(w, w1); }
    } else { cpx w = w1;
#pragma unroll
        for (int q = 1; q < 16; ++q) { a[q] = cmulc(a[q], w); w = cmul(w, w1); }
        cconj<16>(a); dft16(a); cconj<16>(a); }
#pragma unroll
    for (int k = 0; k < 16; ++k) if (!(INV && ZU && k >= 8)) X[hy_p(tid + 512 * k)] = a[k];
}
template <bool INV, int S, int MUL> __device__ __forceinline__ void hy_pass8(LAS cpx* X, const LAS cpx* TW, int tid) {
#pragma unroll
    for (int h = 0; h < 2; ++h) { const int bf = tid + 512 * h, sub = bf / S, j = bf % S, base = 8 * S * sub + j; cpx a[8]; const cpx w1 = TW[MUL * j];
#pragma unroll
        for (int k = 0; k < 8; ++k) a[k] = X[hy_p(base + S * k)];
        if (!INV) { dft8(a); cpx w = w1;
#pragma unroll
            for (int q = 1; q < 8; ++q) { a[q] = cmul(a[q], w); w = cmul(w, w1); }
        } else { cpx w = w1;
#pragma unroll
            for (int q = 1; q < 8; ++q) { a[q] = cmulc(a[q], w); w = cmul(w, w1); }
            cconj<8>(a); dft8(a); cconj<8>(a); }
#pragma unroll
        for (int k = 0; k < 8; ++k) X[hy_p(base + S * k)] = a[k]; }
}
__device__ __forceinline__ void hy_pass4(LAS cpx* X, int tid, const cpx* spec) {
#pragma unroll
    for (int h = 0; h < 2; ++h) { const int g = tid + 512 * h; cpx a[8];
#pragma unroll
        for (int k = 0; k < 8; ++k) a[k] = X[hy_p(8 * g + k)];
        dft8(a);
        if (spec) {
#pragma unroll
            for (int k2 = 0; k2 < 4; ++k2) { const f32x4 s4 = *(const GAS f32x4*)(spec + 8 * g + 2 * k2); a[2 * k2] = cmul(a[2 * k2], (cpx){s4.x, s4.y}); a[2 * k2 + 1] = cmul(a[2 * k2 + 1], (cpx){s4.z, s4.w}); }
            cconj<8>(a); dft8(a); cconj<8>(a); }
#pragma unroll
        for (int k = 0; k < 8; ++k) X[hy_p(8 * g + k)] = a[k]; }
}
__device__ __forceinline__ void hy_conv_fft(LAS cpx* X, const LAS cpx* TW, int tid, const cpx* spec) {
    hy_pass1<false, true>(X, TW, tid); __syncthreads();
    hy_pass8<false, 64, 16>(X, TW, tid); __syncthreads();
    hy_pass8<false, 8, 128>(X, TW, tid); __syncthreads();
    hy_pass4(X, tid, spec); __syncthreads();
    hy_pass8<true, 8, 128>(X, TW, tid); __syncthreads();
    hy_pass8<true, 64, 16>(X, TW, tid); __syncthreads();
    hy_pass1<true, true>(X, TW, tid); __syncthreads();
}

__device__ __forceinline__ void phase_hy_spec(Frame& F, int li) { WS_DECL; frame_refresh(F);
    LAS cpx* X = (LAS cpx*)(F.lds + HY_X); const LAS cpx* TW = (const LAS cpx*)(F.lds + HY_TW); LAS float* W3 = (LAS float*)(F.lds + HY_W3);
    const int tid = F.tid; const float* w3 = in_ptr(I_HW3) + (size_t)li * 64 * 1024; const float* H2 = WSP(float, WS_H2L) + (size_t)li * SEQ * 64; cpx* SPEC = WSP(cpx, WS_SPEC);
    __syncthreads();
    hy_build_tw(F);
    for (int item = blockIdx.x; item < 512; item += F.G) {
        const int o = item >> 8, ch = item & 255;
        __syncthreads();
        if (tid < 128) { const int dir = tid >> 6, j = tid & 63; W3[tid] = w3[(size_t)j * 1024 + o * 512 + dir * 256 + ch]; }
        __syncthreads();
        const float delta = hy_delta(ch);
#pragma unroll 1
        for (int i = 0; i < 8; ++i) { const int l = tid + 512 * i; const float* hr = H2 + (size_t)l * 64; float hf = 0.f, hb = 0.f;
#pragma unroll
            for (int j4 = 0; j4 < 16; ++j4) { const f32x4 h4 = *(const GAS f32x4*)(hr + 4 * j4);
                hf += h4.x * W3[4 * j4] + h4.y * W3[4 * j4 + 1] + h4.z * W3[4 * j4 + 2] + h4.w * W3[4 * j4 + 3]; hb += h4.x * W3[64 + 4 * j4] + h4.y * W3[64 + 4 * j4 + 1] + h4.z * W3[64 + 4 * j4 + 2] + h4.w * W3[64 + 4 * j4 + 3]; }
            const float win = (expf(-((float)l * (1.f / 4095.f)) * delta) + 0.05f) * (1.f / 8192.f);
            X[hy_p(l)] = (cpx){hf * win, 0.f};
            if (l == 0) X[hy_p(4096)] = (cpx){0.f, 0.f}; else X[hy_p(8192 - l)] = (cpx){hb * win, 0.f}; }
        __syncthreads();
        hy_pass1<false, false>(X, TW, tid); __syncthreads();
        hy_pass8<false, 64, 16>(X, TW, tid); __syncthreads();
        hy_pass8<false, 8, 128>(X, TW, tid); __syncthreads();
        hy_pass4(X, tid, nullptr); __syncthreads();
        cpx* dst = SPEC + (size_t)item * 8192;
#pragma unroll
        for (int i = 0; i < 16; ++i) *(GAS cpx*)(dst + tid + 512 * i) = X[hy_p(tid + 512 * i)];
    }
    __syncthreads();
}

__device__ __forceinline__ void hy_conv8(const bf16* row, int t0, int Ls, float w0, float w1, float w2, float bias, float (&out)[8]) {
    const v4u raw = *(const GAS v4u*)(row + t0); float p[10];
    p[0] = t0 > 0 ? bf2f(row[t0 - 1]) : 0.f; p[9] = t0 + 8 < Ls ? bf2f(row[t0 + 8]) : 0.f;
    p[1] = bflo(raw.x); p[2] = bfhi(raw.x); p[3] = bflo(raw.y); p[4] = bfhi(raw.y); p[5] = bflo(raw.z); p[6] = bfhi(raw.z); p[7] = bflo(raw.w); p[8] = bfhi(raw.w);
#pragma unroll
    for (int e = 0; e < 8; ++e) out[e] = bias + w0 * p[e] + w1 * p[e + 1] + w2 * p[e + 2];
}

__device__ __forceinline__ void phase_hy_conv(Frame& F, int li) { WS_DECL; frame_refresh(F);
    LAS cpx* X = (LAS cpx*)(F.lds + HY_X); const LAS cpx* TW = (const LAS cpx*)(F.lds + HY_TW);
    const int tid = F.tid; const bf16* HT = WSP(bf16, WS_HT); bf16* HOT = WSP(bf16, WS_HOT); const cpx* SPEC = WSP(cpx, WS_SPEC);
    const float* cw = in_ptr(I_HCW) + li * 3 * 768; const float* cb = in_ptr(I_HCB) + li * 768; const float* dsk = in_ptr(I_HD) + li * 512;
    __syncthreads();
    hy_build_tw(F);
    for (int item = blockIdx.x; item < 2048; item += F.G) {
        const int ch = item >> 3, bp = item & 7; const int t0 = 8 * tid;
        float v[2][8], x1[2][8], x2[2][8];
#pragma unroll
        for (int q = 0; q < 2; ++q) { const size_t boff = (size_t)(2 * bp + q) * SEQ;
            hy_conv8(HT + (size_t)ch * NT + boff, t0, SEQ, cw[ch], cw[768 + ch], cw[1536 + ch], cb[ch], v[q]);
            hy_conv8(HT + (size_t)(256 + ch) * NT + boff, t0, SEQ, cw[256 + ch], cw[768 + 256 + ch], cw[1536 + 256 + ch], cb[256 + ch], x1[q]);
            hy_conv8(HT + (size_t)(512 + ch) * NT + boff, t0, SEQ, cw[512 + ch], cw[768 + 512 + ch], cw[1536 + 512 + ch], cb[512 + ch], x2[q]); }
        const float d0 = dsk[ch], d1 = dsk[256 + ch];
        __syncthreads();
#pragma unroll
        for (int e = 0; e < 8; ++e) X[hy_p(t0 + e)] = (cpx){v[0][e], v[1][e]};
        __syncthreads();
        hy_conv_fft(X, TW, tid, SPEC + (size_t)ch * 8192);
        float u[2][8];
#pragma unroll
        for (int e = 0; e < 8; ++e) { const cpx y = X[hy_p(t0 + e)]; u[0][e] = x1[0][e] * (y.x + v[0][e] * d0); u[1][e] = x1[1][e] * (y.y + v[1][e] * d0); X[hy_p(t0 + e)] = (cpx){u[0][e], u[1][e]}; }
        __syncthreads();
        hy_conv_fft(X, TW, tid, SPEC + (size_t)(256 + ch) * 8192);
#pragma unroll
        for (int q = 0; q < 2; ++q) { float o[8];
#pragma unroll
            for (int e = 0; e < 8; ++e) { const cpx y = X[hy_p(t0 + e)]; o[e] = x2[q][e] * ((q == 0 ? y.x : y.y) + u[q][e] * d1); }
            v4u w; w.x = pk2(o[0], o[1]); w.y = pk2(o[2], o[3]); w.z = pk2(o[4], o[5]); w.w = pk2(o[6], o[7]);
            *(GAS v4u*)(HOT + (size_t)ch * NT + (size_t)(2 * bp + q) * SEQ + t0) = w; }
    }
    __syncthreads();
}

__device__ __forceinline__ void phase_hy_ctx(Frame& F, int li) { WS_DECL; frame_refresh(F);
    LAS float* KF = (LAS float*)F.lds;
    LAS float* SIG = KF + 1024;
    LAS float* W3 = KF + 2048;
    const int tid = F.tid; const bf16* HT = WSP(bf16, WS_HT); bf16* HOT = WSP(bf16, WS_HOT);
    const float* w3 = in_ptr(I_HW3) + (size_t)li * 64 * 1024; const float* H2 = WSP(float, WS_H2C) + (size_t)li * LCX * 64;
    const float* cw = in_ptr(I_HCW) + li * 3 * 768; const float* cb = in_ptr(I_HCB) + li * 768; const float* dsk = in_ptr(I_HD) + li * 512;
    for (int ch = blockIdx.x; ch < 256; ch += F.G) {
        __syncthreads();
        if (tid < 256) { const int od = tid >> 6, j = tid & 63; W3[tid] = w3[(size_t)j * 1024 + (od >> 1) * 512 + (od & 1) * 256 + ch]; }
        __syncthreads();
        { const int o = tid >> 8, l = tid & 255; const float* hr = H2 + (size_t)l * 64; float hf = 0.f, hb = 0.f;
          for (int j = 0; j < 64; ++j) { const float hv = hr[j]; hf += hv * W3[(2 * o) * 64 + j]; hb += hv * W3[(2 * o + 1) * 64 + j]; }
          const float win = expf(-((float)l * (1.f / 255.f)) * hy_delta(ch)) + 0.05f;
          KF[(2 * o) * 256 + l] = hf * win; KF[(2 * o + 1) * 256 + l] = hb * win; }
        __syncthreads();
        const int q = tid >> 8, t = tid & 255; const float d0 = dsk[ch], d1 = dsk[256 + ch];
        for (int bp = 0; bp < 8; ++bp) { const int b = 2 * bp + q; const size_t off = (size_t)NL + (size_t)b * LCX;
            float zz[3];
#pragma unroll
            for (int k = 0; k < 3; ++k) { const int c = 256 * k + ch; const bf16* row = HT + (size_t)c * NT + off;
                const float pm = t > 0 ? bf2f(row[t - 1]) : 0.f, p0 = bf2f(row[t]), pp = t + 1 < LCX ? bf2f(row[t + 1]) : 0.f;
                zz[k] = cb[c] + cw[c] * pm + cw[768 + c] * p0 + cw[1536 + c] * pp; }
            SIG[q * 256 + t] = zz[0];
            __syncthreads();
            float y = 0.f;
            for (int s = 0; s < 256; ++s) { const int lag = t - s; const float kv = lag >= 0 ? KF[lag] : KF[256 - lag]; y += kv * SIG[q * 256 + s]; }
            const float u = zz[1] * (y + zz[0] * d0);
            __syncthreads();
            SIG[q * 256 + t] = u;
            __syncthreads();
            float y2 = 0.f;
            for (int s = 0; s < 256; ++s) { const int lag = t - s; const float kv = lag >= 0 ? KF[512 + lag] : KF[768 - lag]; y2 += kv * SIG[q * 256 + s]; }
            HOT[(size_t)ch * NT + off + t] = (bf16)f2bf(zz[2] * (y2 + u * d1));
            __syncthreads();
        }
    }
    __syncthreads();
}

constexpr int HF_LD = 72;
__device__ __forceinline__ void phase_fin_hyena(Frame& F, int li) { WS_DECL; frame_refresh(F);
    LAS bf16* T = (LAS bf16*)F.lds;
    const int nrows = li == DEPTH - 1 ? NL : NT; const int tid = F.tid, lane = F.lane, wave = F.wave; const bf16* HOT = WSP(bf16, WS_HOT); bf16* MIX = WSP(bf16, WS_A1);
    const f32x4 g4 = *(const GAS f32x4*)(in_ptr(I_HON) + li * 256 + 4 * lane);
    for (int item = blockIdx.x; item < nrows / 64; item += F.G) { const int m0 = item * 64;
        __syncthreads();
        { const int ch = tid >> 1, hf = tid & 1; const bf16* src = HOT + (size_t)ch * NT + m0 + 32 * hf;
#pragma unroll
          for (int k = 0; k < 4; ++k) *(LAS v4u*)(T + ch * HF_LD + 32 * hf + 8 * k) = *(const GAS v4u*)(src + 8 * k); }
        __syncthreads();
        for (int i = 0; i < 8; ++i) { const int tl = wave * 8 + i;
            f32x4 x; x.x = bf2f(T[(4 * lane) * HF_LD + tl]); x.y = bf2f(T[(4 * lane + 1) * HF_LD + tl]); x.z = bf2f(T[(4 * lane + 2) * HF_LD + tl]); x.w = bf2f(T[(4 * lane + 3) * HF_LD + tl]);
            const float r = rsqrtf(wave_sum(x.x * x.x + x.y * x.y + x.z * x.z + x.w * x.w) * (1.f / 256.f) + 1e-6f);
            v2u o; o.x = pk2(x.x * r * g4.x, x.y * r * g4.y); o.y = pk2(x.z * r * g4.z, x.w * r * g4.w); *(GAS v2u*)(MIX + (size_t)(m0 + tl) * D + 768 + 4 * lane) = o; }
    }
    __syncthreads();
}
#define MIX_HYENA 1

__global__ void __launch_bounds__(NTHR, 2) mk_fwd(Args a) {
    extern __shared__ __attribute__((aligned(16))) unsigned char lds_raw[];
    Frame F; F.lds = (LAS unsigned char*)lds_raw; F.tid = threadIdx.x; F.lane = F.tid & 63; F.wave = __builtin_amdgcn_readfirstlane(F.tid >> 6); F.G = gridDim.x;
    for (int u = F.tid; u < (LDS_BYTES - LDSCTL_OFF) / 4; u += NTHR) ((LAS unsigned*)(F.lds + LDSCTL_OFF))[u] = 0u;
    __syncthreads();
    (void)xcd_barrier_post((unsigned*)(ws_ptr() + WS_CTL) + CW_BAR, (volatile LAS unsigned*)(F.lds + LDSCTL_OFF) + 8);
#define GRID_BAR() do { XcdBarrier bar_; bar_.bar = (unsigned*)(ws_ptr() + WS_CTL) + CW_BAR; bar_.x = xb_xcc_id(); bar_.st = (volatile LAS unsigned*)(F.lds + LDSCTL_OFF) + 8; xcd_barrier(bar_); } while (0)

    phase_pro0(F);
    phase_pro0b(F);
    phase_pro0c(F);
    phase_pro0d(F);
    phase_pro0e(F);
    GRID_BAR();
    phase_hin0(F);
    GRID_BAR();
    for (int li = 0; li < DEPTH; ++li) {
        const int nrows = li == DEPTH - 1 ? NL : NT; unsigned char* const ws = ws_ptr();
        phase_hy_spec(F, li);
        { pg8::Gemm g{WSP(bf16, WS_A1), WSP(bf16, WS_WINT) + (size_t)li * PCOLS * D, NT, PCOLS, D}; pg8::StaticOrder S; S.init(NT, PCOLS, F.G, (int)blockIdx.x);
          pg8::EpiStore E{WSP(bf16, WS_P), PCOLS, 0, PCOLS / 256};
          pg8::gemm_phase<pg8::EpiStore, pg8::StaticOrder, true, true>(F.lds, g, S, E); }
#if MIX_HYENA
        { pg8::Gemm g{WSP(bf16, WS_WHYT) + (size_t)li * HYC * D, WSP(bf16, WS_A1), HYC, NT, D}; pg8::StaticOrder S; S.init(HYC, NT, F.G, (int)blockIdx.x);
          pg8::EpiStore E{WSP(bf16, WS_HT), NT, 0, NT / 256};
          pg8::gemm_phase<pg8::EpiStore, pg8::StaticOrder, true, true>(F.lds, g, S, E); }
#endif
        GRID_BAR();
        phase_rwkv_r0(F, li);
        phase_mla_prep(F, li);
        phase_lru<1>(F, li);
        __syncthreads();
        phase_hy_conv(F, li);
        if (li < DEPTH - 1) phase_hy_ctx(F, li);
        GRID_BAR();
        phase_rwkv_scan(F, li);
        __syncthreads();
        phase_attn(F, li);
        __syncthreads();
        phase_lru<3>(F, li);
        GRID_BAR();
        phase_fin_mla(F, li);
        phase_fin_rwkv(F, li); phase_fin_hyena(F, li);
        GRID_BAR();
        { pg8::Gemm g{WSP(bf16, WS_A1), WSP(bf16, WS_WOUTT) + (size_t)li * D * D, nrows, D, D}; pg8::StaticOrder S; S.init(nrows, D, F.G, (int)blockIdx.x);
          pg8::EpiStore E{WSP(bf16, WS_Y), D, 0, D / 256};
          pg8::gemm_phase<pg8::EpiStore, pg8::StaticOrder, true, true>(F.lds, g, S, E); }
        GRID_BAR();
        phase_ln1<true>(F, li);
        if (li & 1) phase_moe_weights(F, li);
        GRID_BAR();
        if (!(li & 1)) {
            const int j = li >> 1;
            { pg8::Gemm g{WSP(bf16, WS_A1), WSP(bf16, WS_WGUT) + (size_t)j * 2 * FFD * D, nrows, 2 * FFD, D}; pg8::StaticOrder S; S.init(nrows, 2 * FFD, F.G, (int)blockIdx.x);
              pg8::EpiSwiGLU E{WSP(bf16, WS_H), FFD, 0, 2 * FFD / 256};
              pg8::gemm_phase<pg8::EpiSwiGLU, pg8::StaticOrder, true, true>(F.lds, g, S, E); }
            GRID_BAR();
            { pg8::Gemm g{WSP(bf16, WS_H), WSP(bf16, WS_WDT) + (size_t)j * D * FFD, nrows, D, FFD}; pg8::StaticOrder S; S.init(nrows, D, F.G, (int)blockIdx.x);
              pg8::EpiStore E{WSP(bf16, WS_Y), D, 0, D / 256};
              pg8::gemm_phase<pg8::EpiStore, pg8::StaticOrder, true, true>(F.lds, g, S, E); }
            GRID_BAR();
        } else {
            phase_moe_slots(F, li);
            GRID_BAR();
            const int ntiles = ((LAS int*)(F.lds + LDS_MOEI))[48];
            const PG8_LAS unsigned char* tile_e = (const PG8_LAS unsigned char*)(F.lds + LDS_TILEE);
#pragma unroll 1
            for (int ch = 0; ch < MOE_NCHUNK; ++ch) {
                const int t0 = ch * MOE_CHUNK_TILES; int nM = ntiles - t0; nM = nM < 0 ? 0 : (nM > MOE_CHUNK_TILES ? MOE_CHUNK_TILES : nM);
                { pg8::Gemm g{WSP(bf16, WS_XS), WSP(bf16, WS_MGU), 0, 0, D}; pg8::MoeOrder S; S.init(nM, 2 * FFE / 256, F.G, (int)blockIdx.x, t0, t0, tile_e);
                  pg8::EpiSwiGLU E{WSP(bf16, WS_HM), FFE, t0, 2 * FFE / 256};
                  pg8::gemm_phase<pg8::EpiSwiGLU, pg8::MoeOrder, true, true>(F.lds, g, S, E); }
                GRID_BAR();
                { pg8::Gemm g{WSP(bf16, WS_HM), WSP(bf16, WS_MD), 0, 0, FFE}; pg8::MoeOrder S; S.init(nM, D / 256, F.G, (int)blockIdx.x, t0, 0, tile_e);
                  pg8::EpiStore E{WSP(bf16, WS_XS), D, t0, D / 256};
                  pg8::gemm_phase<pg8::EpiStore, pg8::MoeOrder, true, true>(F.lds, g, S, E); }
                GRID_BAR();
            }
        }
        phase_ln2<true>(F, li);
        if (li < DEPTH - 1) GRID_BAR();
    }
}

extern "C" void kernel_launch(void* const* d_in, const int* in_sizes, int n_in, void* d_out, int out_size, void* d_ws, size_t ws_size, hipStream_t stream) {
    static int grid = 0;
    if (grid == 0) {
        if (n_in != N_INPUTS || out_size != NL * D || ws_size < WS_END) { fprintf(stderr, "kernel_launch: unexpected shapes (n_in %d out %d ws %zu)\n", n_in, out_size, ws_size); grid = -1; return; }
        int dev = 0, cus = 0, per_cu = 0;
        if (hipGetDevice(&dev) != hipSuccess || hipDeviceGetAttribute(&cus, hipDeviceAttributeMultiprocessorCount, dev) != hipSuccess) { grid = -1; return; }
        if (hipFuncSetAttribute((const void*)mk_fwd, hipFuncAttributeMaxDynamicSharedMemorySize, LDS_BYTES) != hipSuccess) { fprintf(stderr, "kernel_launch: hipFuncSetAttribute failed\n"); grid = -1; return; }
        if (hipOccupancyMaxActiveBlocksPerMultiprocessor(&per_cu, (const void*)mk_fwd, NTHR, LDS_BYTES) != hipSuccess || per_cu < 1) fprintf(stderr, "kernel_launch: occupancy query reports %d\n", per_cu);
        (void)hipGetLastError();
        grid = cus > 256 ? 256 : cus;
    }
    if (grid < 0) return;
    if (hipMemsetAsync((char*)d_ws + WS_CTL, 0, CTL_ZERO_BYTES, stream) != hipSuccess) return;
    Args a{};
    for (int i = 0; i < N_INPUTS; ++i) a.in[i] = (const float*)d_in[i];
    a.out = (float*)d_out; a.ws = (unsigned char*)d_ws;
    hipLaunchKernelGGL(mk_fwd, dim3(grid), dim3(NTHR), LDS_BYTES, stream, a);
    const hipError_t le = hipPeekAtLastError();
    if (le != hipSuccess) fprintf(stderr, "kernel_launch: launch failed: %s\n", hipGetErrorName(le));
}
```

```cpp
#include <hip/hip_runtime.h>
#include <cstdio>
#include <cstdint>
#define GAS __attribute__((address_space(1)))
#define LAS __attribute__((address_space(3)))
__device__ __forceinline__ int mk_lane() { int l; asm volatile("v_mbcnt_lo_u32_b32 %0, -1, 0\n\tv_mbcnt_hi_u32_b32 %0, -1, %0" : "=v"(l)); return l; }
namespace pg8 {
#define PG8_LAS __attribute__((address_space(3)))
typedef unsigned short bf16_t;
typedef short bf16x8 __attribute__((ext_vector_type(8)));
typedef float f32x4 __attribute__((ext_vector_type(4)));
typedef unsigned u32x4 __attribute__((ext_vector_type(4)));
constexpr int BM = 256, BK = 64, HALF = 128, HTB = HALF * BK * 2  , STAGE_BYTES = 8 * HTB, NXCD = 8, WGM = 8;

__host__ __device__ __forceinline__ int lds_byte(int r, int c) { const int st = (r >> 4) * 2 + (c >> 5), rr = r & 15, cc = c & 31, ob = rr * 64 + cc * 2; return st * 1024 + (ob ^ (((ob >> 9) & 1) << 5)); }
__host__ __device__ __forceinline__ void stage_rc(int b, int& R, int& C) { const int st = b / 1024, sb = b % 1024, swz = sb ^ (((sb >> 9) & 1) << 5); R = (st >> 1) * 16 + swz / 64; C = (st & 1) * 32 + (swz % 64) / 2; }
__host__ __device__ __forceinline__ int perm32(int rho) { const int n = rho >> 4, i = rho & 15; return 8 * (i >> 2) + 4 * n + (i & 3); }

struct Unit { int pm, pn; };
struct Gemm { const bf16_t* A; const bf16_t* Bt; int M, N, K; };

struct StaticOrder {
    int nM, nN, nwg, G, c;
    __host__ __device__ void init(int M, int N, int G_, int c_) { nM = M / BM; nN = N / BM; nwg = nM * nN; G = G_; c = c_; }
    __host__ __device__ bool next(int i, Unit& u) const {
        const long L = (long)i * G + c; if (L >= nwg) return false;
        int wgid = (int)L; { const int q = nwg / NXCD, r = nwg % NXCD, xcd = wgid % NXCD, off = wgid / NXCD; wgid = (xcd < r ? xcd * (q + 1) : r * (q + 1) + (xcd - r) * q) + off; }
        const int nig = WGM * nN, gid = wgid / nig, fm = gid * WGM, gsz = (nM - fm) < WGM ? (nM - fm) : WGM;
        u.pm = fm + ((wgid % nig) % gsz); u.pn = (wgid % nig) / gsz; return true;
    }
    __device__ __forceinline__ void a_ready(const Unit&) const {}
    __device__ __forceinline__ void done(const Unit&) const {}
};

__device__ __forceinline__ unsigned cvt_pk_bf16(float lo, float hi) { unsigned r; asm volatile("v_cvt_pk_bf16_f32 %0, %1, %2" : "=v"(r) : "v"(lo), "v"(hi)); return r; }
typedef float f32x2 __attribute__((ext_vector_type(2)));
__device__ __forceinline__ f32x2 gelu_pk(f32x2 v) {
    const f32x2 av = __builtin_elementwise_abs(v), d = av * 0.2316418882f + 1.0f;
    f32x2 t; t.x = __builtin_amdgcn_rcpf(d.x); t.y = __builtin_amdgcn_rcpf(d.y);
    f32x2 q = t * 0.5307027145f + (-0.7265760135f); q = q * t + 0.7107068705f; q = q * t + (-0.142248368f); q = q * t + 0.127414796f; q = q * t;
    const f32x2 s = (v * v) * (-0.72134752044f);
    f32x2 e; e.x = __builtin_amdgcn_exp2f(s.x); e.y = __builtin_amdgcn_exp2f(s.y);
    const f32x2 m = v * (q * e), r = v - m;
    f32x2 o; o.x = v.x < 0.f ? m.x : r.x; o.y = v.y < 0.f ? m.y : r.y; return o;
}

template <int ACT  > struct EpiBf16 {
    static constexpr bool PERM = true, AFTER_DRAIN = false; static_assert(ACT == 0 || ACT == 1, "EpiBf16: ACT is 0 (none) or 1 (gelu_pk)");
    bf16_t* O; int ldc; const float* bias; int split_cols; size_t split_stride; float scale0;
    __device__ __forceinline__ void operator()(const f32x4 (&acc)[2][2][4][2], const Unit& u, int wr, int wc, int fr, int fq) const {
        const int row0 = u.pm * BM + wr * 64 + fr; int colt = u.pn * BM; bf16_t* base = O;
        float sc = 1.f; if (split_cols) { const int t = colt / split_cols; base += (size_t)t * split_stride; colt -= t * split_cols; if (t == 0) sc = scale0; }
        const int col0 = colt + wc * 32 + 8 * fq, bcol0 = u.pn * BM + wc * 32 + 8 * fq;
        f32x4 bv[2][2];
#pragma unroll
        for (int bj = 0; bj < 2; ++bj)
#pragma unroll
            for (int n = 0; n < 2; ++n) bv[bj][n] = bias ? *(const f32x4*)(bias + bcol0 + bj * HALF + 4 * n) : (f32x4){0.f, 0.f, 0.f, 0.f};
#pragma unroll
        for (int ai = 0; ai < 2; ++ai)
#pragma unroll
            for (int m = 0; m < 4; ++m) { bf16_t* rowp = base + (size_t)(row0 + ai * HALF + m * 16) * ldc + col0;
#pragma unroll
                for (int bj = 0; bj < 2; ++bj) { f32x4 v0 = acc[ai][bj][m][0] + bv[bj][0], v1 = acc[ai][bj][m][1] + bv[bj][1];
                    if (ACT == 1) { f32x2 a = gelu_pk((f32x2){v0[0], v0[1]}), b = gelu_pk((f32x2){v0[2], v0[3]}), c = gelu_pk((f32x2){v1[0], v1[1]}), d = gelu_pk((f32x2){v1[2], v1[3]});
                        v0 = (f32x4){a.x, a.y, b.x, b.y}; v1 = (f32x4){c.x, c.y, d.x, d.y}; }
                    v0 = v0 * sc; v1 = v1 * sc; u32x4 w; w.x = cvt_pk_bf16(v0[0], v0[1]); w.y = cvt_pk_bf16(v0[2], v0[3]); w.z = cvt_pk_bf16(v1[0], v1[1]); w.w = cvt_pk_bf16(v1[2], v1[3]);
                    *(u32x4*)(rowp + bj * HALF) = w; } }
    }
};
typedef int pg8_v8i __attribute__((ext_vector_type(8))); typedef int pg8_v4i __attribute__((ext_vector_type(4)));
__device__ __forceinline__ pg8_v8i pg8_cat8(bf16x8 a, bf16x8 b) { return __builtin_shufflevector(__builtin_bit_cast(pg8_v4i, a), __builtin_bit_cast(pg8_v4i, b), 0, 1, 2, 3, 4, 5, 6, 7); }
template <class Epi, class Sched, bool ALIGN_EPI = false, bool SP2 = false, bool F8 = false, int WSCALE = 127>
__device__ __forceinline__ void gemm_phase(PG8_LAS unsigned char* lds, const Gemm g, const Sched& S, const Epi& E, int wave_idx) {
    int tid_ = wave_idx * 64 + mk_lane(); asm volatile("" : "+v"(tid_));
    const int tid = tid_, wid = __builtin_amdgcn_readfirstlane(tid >> 6), lane = tid & 63, wr = wid >> 2, wc = wid & 3, fr = lane & 15, fq = lane >> 4;
    const int K = g.K, nt = K / BK;
    unsigned voffA[2], voffB[2];
#pragma unroll
    for (int i = 0; i < 2; ++i) { int R, C; stage_rc(tid * 16 + i * 8192, R, C); const int Rb = Epi::PERM ? ((R & ~31) + perm32(R & 31)) : R;
        voffA[i] = (unsigned)(R * K + C) * 2u; voffB[i] = (unsigned)(Rb * K + C) * 2u; }
    const size_t kstep = (size_t)(BK * 2);
    const size_t hstep = (size_t)HALF * K * 2;
    const size_t tstep = 2 * hstep;
    const unsigned ldsw = (unsigned)wid * 1024u;
    int aoffk[2], boffk[2];
    if constexpr (F8) { aoffk[0] = lds_byte(wr * 64 + fr, (2 * (fq & 1)) * 8) + (fq >> 1) * 1024; aoffk[1] = lds_byte(wr * 64 + fr, (2 * (fq & 1) + 1) * 8) + (fq >> 1) * 1024;
        boffk[0] = lds_byte(wc * 32 + fr, (2 * (fq & 1)) * 8) + (fq >> 1) * 1024; boffk[1] = lds_byte(wc * 32 + fr, (2 * (fq & 1) + 1) * 8) + (fq >> 1) * 1024; }
    else { aoffk[0] = lds_byte(wr * 64 + fr, fq * 8); aoffk[1] = aoffk[0] + 1024; boffk[0] = lds_byte(wc * 32 + fr, fq * 8); boffk[1] = boffk[0] + 1024; }
#define PG8_SA(b, h) (((b) * 2 + (h)) * HTB)
#define PG8_SB(b, h) ((4 + (b) * 2 + (h)) * HTB)
#define PG8_STAGE(bufoff, gbase, voff) do { const char* gb_ = (const char*)(gbase); _Pragma("unroll") for (int _i = 0; _i < 2; ++_i) { unsigned keep_; \
        asm volatile("s_mov_b32 %0, m0\n\ts_mov_b32 m0, %2\n\ts_nop 0\n\tglobal_load_lds_dwordx4 %1, %3\n\ts_mov_b32 m0, %0" : "=&s"(keep_) : "v"((voff)[_i]), "s"((unsigned)(size_t)(lds + (bufoff) + ldsw + _i * 8192)), "s"(gb_) : "memory"); } } while (0)
#define PG8_LDA(dst, b, h) do { if constexpr (F8) { _Pragma("unroll") for (int m = 0; m < 4; ++m) dst##8[m] = *(const PG8_LAS pg8_v8i*)(lds + PG8_SA(b, h) + aoffk[0] + m * 2048); } else { _Pragma("unroll") for (int m = 0; m < 4; ++m) _Pragma("unroll") for (int k = 0; k < 2; ++k) dst[m][k] = *(const PG8_LAS bf16x8*)(lds + PG8_SA(b, h) + aoffk[k] + m * 2048); } } while (0)
#define PG8_LDB(dst, b, h) do { if constexpr (F8) { _Pragma("unroll") for (int n = 0; n < 2; ++n) dst##8[n] = *(const PG8_LAS pg8_v8i*)(lds + PG8_SB(b, h) + boffk[0] + n * 2048); } else { _Pragma("unroll") for (int n = 0; n < 2; ++n) _Pragma("unroll") for (int k = 0; k < 2; ++k) dst[n][k] = *(const PG8_LAS bf16x8*)(lds + PG8_SB(b, h) + boffk[k] + n * 2048); } } while (0)
#define PG8_MMA(ai, bj, At, Bt) do { __builtin_amdgcn_s_setprio(1); _Pragma("unroll") for (int m = 0; m < 4; ++m) _Pragma("unroll") for (int n = 0; n < 2; ++n) { \
        if constexpr (F8) acc[ai][bj][m][n] = __builtin_amdgcn_mfma_scale_f32_16x16x128_f8f6f4(Bt##8[n], At##8[m], acc[ai][bj][m][n], 0, 0, 0, wsc_, 0, wsc_);     \
        else { _Pragma("unroll") for (int k = 0; k < 2; ++k) acc[ai][bj][m][n] = __builtin_amdgcn_mfma_f32_16x16x32_bf16(Bt[n][k], At[m][k], acc[ai][bj][m][n], 0, 0, 0); } } __builtin_amdgcn_s_setprio(0); } while (0)
#define PG8_WAIT_V(n) asm volatile("s_waitcnt vmcnt(" #n ")" ::: "memory")
#define PG8_WAIT_L(n) asm volatile("s_waitcnt lgkmcnt(" #n ")" ::: "memory")
#define PG8_BAR __builtin_amdgcn_s_barrier()
#define PG8_SCHED __builtin_amdgcn_sched_barrier(0)
    int wsc_ = WSCALE; asm volatile("" : "+v"(wsc_));
    Unit cur, nxt; int ui = 0;
    if (!S.next(0, cur)) return;
    f32x4 acc[2][2][4][2];
#pragma unroll
    for (int a = 0; a < 2; ++a)
#pragma unroll
        for (int b = 0; b < 2; ++b)
#pragma unroll
            for (int m = 0; m < 4; ++m)
#pragma unroll
                for (int n = 0; n < 2; ++n) acc[a][b][m][n] = (f32x4){0.f, 0.f, 0.f, 0.f};
    bf16x8 At[4][2], B0[2][2], B1[2][2];
    pg8_v8i At8[4], B08[2], B18[2];
    const char* cA = (const char*)g.A + (size_t)cur.pm * tstep; const char* cB = (const char*)g.Bt + (size_t)cur.pn * tstep;
    S.a_ready(cur);
    if constexpr (SP2) {
        PG8_STAGE(PG8_SB(0, 0), cB, voffB); PG8_STAGE(PG8_SB(0, 1), cB + hstep, voffB); PG8_STAGE(PG8_SA(0, 0), cA, voffA); PG8_STAGE(PG8_SA(0, 1), cA + hstep, voffA);
        if (wr == 1) PG8_BAR;
        PG8_WAIT_V(2); PG8_BAR;
        PG8_STAGE(PG8_SB(1, 0), cB + kstep, voffB); PG8_STAGE(PG8_SA(1, 0), cA + kstep, voffA); PG8_STAGE(PG8_SB(1, 1), cB + hstep + kstep, voffB);
        PG8_WAIT_V(6); PG8_BAR;
    } else {
        PG8_STAGE(PG8_SB(0, 0), cB, voffB); PG8_STAGE(PG8_SA(0, 0), cA, voffA); PG8_STAGE(PG8_SB(0, 1), cB + hstep, voffB); PG8_STAGE(PG8_SA(0, 1), cA + hstep, voffA);
        if (wr == 1) PG8_BAR;
        PG8_WAIT_V(4); PG8_BAR;
        PG8_STAGE(PG8_SB(1, 0), cB + kstep, voffB); PG8_STAGE(PG8_SA(1, 0), cA + kstep, voffA); PG8_STAGE(PG8_SB(1, 1), cB + hstep + kstep, voffB);
        PG8_WAIT_V(6); PG8_BAR;
    }
    for (;;) {
        const bool has_next = S.next(ui + 1, nxt);
        const char* nA = has_next ? (const char*)g.A + (size_t)nxt.pm * tstep : cA; const char* nB = has_next ? (const char*)g.Bt + (size_t)nxt.pn * tstep : cB;
#pragma unroll 1
        for (int t = 0; t < nt; t += 2) {
            const bool last = (t == nt - 2);
            const char* a1 = cA + (size_t)(t + 1) * kstep;
            const char* a2 = last ? nA : cA + (size_t)(t + 2) * kstep; const char* b2 = last ? nB : cB + (size_t)(t + 2) * kstep;
            const char* a3 = a2 + kstep; const char* b3 = b2 + kstep;
            if (last && has_next) S.a_ready(nxt);
            if constexpr (SP2) {
            PG8_LDB(B0, 0, 0); PG8_LDB(B1, 0, 1); PG8_SCHED; PG8_LDA(At, 0, 0); PG8_STAGE(PG8_SA(1, 1), a1 + hstep, voffA);
            PG8_WAIT_V(8); PG8_WAIT_L(0); PG8_BAR; PG8_MMA(0, 0, At, B0); PG8_MMA(0, 1, At, B1); PG8_BAR; PG8_SCHED;
            PG8_LDA(At, 0, 1); PG8_STAGE(PG8_SB(0, 0), b2, voffB); PG8_STAGE(PG8_SB(0, 1), b2 + hstep, voffB); PG8_STAGE(PG8_SA(0, 0), a2, voffA);
            PG8_WAIT_V(8); PG8_WAIT_L(0); PG8_BAR; PG8_MMA(1, 0, At, B0); PG8_MMA(1, 1, At, B1); PG8_BAR; PG8_SCHED;
            PG8_LDB(B0, 1, 0); PG8_LDB(B1, 1, 1); PG8_SCHED; PG8_LDA(At, 1, 0); PG8_STAGE(PG8_SA(0, 1), a2 + hstep, voffA);
            PG8_WAIT_V(8); PG8_WAIT_L(0); PG8_BAR; PG8_MMA(0, 0, At, B0); PG8_MMA(0, 1, At, B1); PG8_BAR; PG8_SCHED;
            PG8_LDA(At, 1, 1); PG8_STAGE(PG8_SB(1, 0), b3, voffB); PG8_STAGE(PG8_SB(1, 1), b3 + hstep, voffB); PG8_STAGE(PG8_SA(1, 0), a3, voffA);
            PG8_WAIT_V(8); PG8_WAIT_L(0); PG8_BAR; PG8_MMA(1, 0, At, B0); PG8_MMA(1, 1, At, B1); PG8_BAR; PG8_SCHED;
            } else {
            PG8_LDB(B0, 0, 0); PG8_SCHED; PG8_LDA(At, 0, 0); PG8_STAGE(PG8_SA(1, 1), a1 + hstep, voffA);
            PG8_WAIT_L(8); PG8_BAR; PG8_WAIT_L(0); PG8_MMA(0, 0, At, B0); PG8_BAR; PG8_SCHED;
            PG8_LDB(B1, 0, 1); PG8_STAGE(PG8_SB(0, 0), b2, voffB);
            PG8_BAR; PG8_WAIT_L(0); PG8_MMA(0, 1, At, B1); PG8_BAR;
            PG8_LDA(At, 0, 1); PG8_STAGE(PG8_SA(0, 0), a2, voffA);
            PG8_BAR; PG8_WAIT_L(0); PG8_MMA(1, 0, At, B0); PG8_BAR; PG8_SCHED;
            PG8_STAGE(PG8_SB(0, 1), b2 + hstep, voffB);
            PG8_WAIT_V(6); PG8_BAR; PG8_MMA(1, 1, At, B1); PG8_BAR;
            PG8_LDB(B0, 1, 0); PG8_SCHED; PG8_LDA(At, 1, 0); PG8_STAGE(PG8_SA(0, 1), a2 + hstep, voffA);
            PG8_WAIT_L(8); PG8_BAR; PG8_WAIT_L(0); PG8_MMA(0, 0, At, B0); PG8_BAR; PG8_SCHED;
            PG8_LDB(B1, 1, 1); PG8_STAGE(PG8_SB(1, 0), b3, voffB);
            PG8_BAR; PG8_WAIT_L(0); PG8_MMA(0, 1, At, B1); PG8_BAR;
            PG8_LDA(At, 1, 1); PG8_STAGE(PG8_SA(1, 0), a3, voffA);
            PG8_BAR; PG8_WAIT_L(0); PG8_MMA(1, 0, At, B0); PG8_BAR; PG8_SCHED;
            PG8_STAGE(PG8_SB(1, 1), b3 + hstep, voffB);
            PG8_WAIT_V(6); PG8_BAR; PG8_MMA(1, 1, At, B1); PG8_BAR;
            }
        }
        if constexpr (ALIGN_EPI) { if (wr == 0) PG8_BAR; }
        if constexpr (!Epi::AFTER_DRAIN) { { int pm_ = cur.pm, pn_ = cur.pn; asm volatile("" : "+s"(pm_), "+s"(pn_)); cur.pm = pm_; cur.pn = pn_; }
            { int t2_ = mk_lane(); asm volatile("" : "+v"(t2_)); E(acc, cur, wr, wc, t2_ & 15, (t2_ & 63) >> 4); }
            S.done(cur); }
        if (!has_next) break;
#pragma unroll
        for (int a = 0; a < 2; ++a)
#pragma unroll
            for (int b = 0; b < 2; ++b)
#pragma unroll
                for (int m = 0; m < 4; ++m)
#pragma unroll
                    for (int n = 0; n < 2; ++n) acc[a][b][m][n] = (f32x4){0.f, 0.f, 0.f, 0.f};
        cur = nxt; cA = nA; cB = nB; ++ui;
        if constexpr (ALIGN_EPI) { if (wr == 1) PG8_BAR; }
    }
    PG8_WAIT_V(0);
    if constexpr (!ALIGN_EPI) { if (wr == 0) PG8_BAR; }
    PG8_BAR;
    if constexpr (Epi::AFTER_DRAIN) { E.fused(acc, cur, wr, wc, fr, fq, lds, wid, lane); S.done(cur); }
#undef PG8_SA
#undef PG8_SB
#undef PG8_STAGE
#undef PG8_LDA
#undef PG8_LDB
#undef PG8_MMA
#undef PG8_WAIT_V
#undef PG8_WAIT_L
#undef PG8_BAR
#undef PG8_SCHED
}
}

typedef unsigned short bf16;
typedef unsigned v4u __attribute__((ext_vector_type(4)));
typedef unsigned v2u __attribute__((ext_vector_type(2)));
typedef float f32x4 __attribute__((ext_vector_type(4)));
typedef float f32x2 __attribute__((ext_vector_type(2)));
typedef float f32x16 __attribute__((ext_vector_type(16)));
typedef short bf16x8 __attribute__((ext_vector_type(8)));
typedef short s16x4 __attribute__((ext_vector_type(4)));
typedef GAS unsigned gu32;

constexpr int D = 1024, NB = 16, SEQ = 4096, LCX = 256, DEPTH = 4;
constexpr int NL = NB * SEQ, NC = NB * LCX, NT = NL + NC;
constexpr int N_IN = 2592, PCOLS = 2048, D_OFF = 1824, HYC = 768;
constexpr int FFD = 2816, FFE = 3584, NE = 8;
constexpr float ALPHA = 1.6817928305074292f;
constexpr int NWAVES = 8, NTHR = 512;
constexpr int KSEQ = SEQ + LCX;

enum { I_X = 0, I_C, I_CTX, I_CCTX, I_ADAW, I_ADAB, I_WIN, I_QNORM, I_KVNORM, I_WUQ, I_WUKV, I_MLAON, I_LCW, I_LCB, I_LWR, I_LBR, I_LWI, I_LBI, I_LLAM, I_LON,
       I_MUP, I_MUN, I_W0, I_WUP, I_A0, I_AUP, I_GUP, I_KK, I_KA, I_RK, I_LNG, I_LNB, I_HCW, I_HCB, I_HW1, I_HB1, I_HW2, I_HB2, I_HW3, I_HD, I_HON,
       I_WOUT, I_LN1G, I_LN1B, I_LN2G, I_LN2B, I_FG, I_FU, I_FD, I_ROUTER, I_MG, I_MU, I_MD, N_INPUTS };

constexpr size_t MiB = 1u << 20;
constexpr size_t WS_CTL = 0, CTL_ZERO_BYTES = 1 * MiB;
constexpr size_t WS_MOD = 1 * MiB;
constexpr size_t WS_ROPE = 3 * MiB;
constexpr size_t WS_H2L = 4 * MiB;
constexpr size_t WS_H2C = 8 * MiB;
constexpr size_t WS_LRUW = 9 * MiB;
constexpr size_t WS_WUQT = 10 * MiB;
constexpr size_t WS_WUKVT = 11 * MiB;
constexpr size_t WS_SUMM = 12 * MiB;
constexpr size_t WS_BON = 17 * MiB;
constexpr size_t WS_TOKE = 20 * MiB;
constexpr size_t WS_TOKG = 21 * MiB;
constexpr size_t WS_TOKS = 22 * MiB;
constexpr size_t WS_BLKCNT = 23 * MiB;
constexpr size_t WS_SPEC = 24 * MiB;
constexpr size_t WS_WINT = 56 * MiB;
constexpr size_t WS_WHYT = 72 * MiB;
constexpr size_t WS_WOUTT = 78 * MiB;
constexpr size_t WS_WGUT = 86 * MiB;
constexpr size_t WS_WDT = 108 * MiB;
constexpr size_t WS_XC = 120 * MiB;
constexpr size_t WS_A1 = 136 * MiB;
constexpr size_t WS_ARENA = 272 * MiB;
constexpr size_t WS_P = WS_ARENA;
constexpr size_t WS_HT = 544 * MiB;
constexpr size_t WS_QB = 646 * MiB;
constexpr size_t WS_KB = 697 * MiB;
constexpr size_t WS_VT = 748 * MiB;
constexpr size_t WS_AO = 782 * MiB;
constexpr size_t WS_HOT = 816 * MiB;
constexpr size_t WS_YR = 850 * MiB;
constexpr size_t WS_Y = 986 * MiB;
constexpr size_t WS_H = WS_ARENA;
constexpr size_t WS_MGU = WS_ARENA;
constexpr size_t WS_MD = 384 * MiB;
constexpr size_t WS_XS = 440 * MiB;
constexpr size_t WS_HM = 716 * MiB;
constexpr size_t WS_END = 1122 * MiB;
constexpr size_t WS_M8GU = WS_ARENA;
constexpr size_t WS_M8D = 328 * MiB;
constexpr size_t WS_XS8 = 356 * MiB;
constexpr size_t WS_Y2 = 494 * MiB;
constexpr size_t WS_HM8 = 770 * MiB;
constexpr int MOE_MAX_TILES = 552, MOE_NCHUNK = 2, MOE_CHUNK_TILES = 276;
static_assert(WS_HM8 + (size_t)MOE_CHUNK_TILES * 256 * FFE <= WS_END && WS_M8GU + (size_t)8 * 2 * FFE * D <= WS_M8D && WS_M8D + (size_t)8 * D * FFE <= WS_XS8 && WS_XS8 + (size_t)141312 * D <= WS_Y2 && WS_Y2 + (size_t)141312 * D * 2 <= WS_HM8, "moe fp8 map");
static_assert(WS_H + (size_t)NT * FFD * 2 <= WS_QB + 51 * MiB, "dense hidden");

constexpr int CW_BAR = 4096;

constexpr int RING_BYTES = 131072;
constexpr int LDSCTL_OFF = RING_BYTES;
constexpr int LDS_TILEE = LDSCTL_OFF + 256;
constexpr int LDS_MOEI = LDSCTL_OFF + 1024;
constexpr int LDS_BYTES = 147456;

#define LDS_WAIT() asm volatile("s_waitcnt lgkmcnt(0)" ::: "memory")
#define VM_WAIT() asm volatile("s_waitcnt vmcnt(0)" ::: "memory")
typedef __bf16 hwbf16x2 __attribute__((ext_vector_type(2)));
__device__ __forceinline__ unsigned pk2(float lo, float hi) { const f32x2 v = {lo, hi}; const hwbf16x2 b = __builtin_convertvector(v, hwbf16x2); return __builtin_bit_cast(unsigned, b); }
__device__ __forceinline__ unsigned f2bf(float f) { return pk2(f, 0.f) & 0xffffu; }
__device__ __forceinline__ unsigned pk4_fp8(float a, float b, float c, float d) { int w = __builtin_amdgcn_cvt_pk_fp8_f32(a, b, 0, false); w = __builtin_amdgcn_cvt_pk_fp8_f32(c, d, w, true); return (unsigned)w; }
__device__ __forceinline__ float bf2f(unsigned b) { return __builtin_bit_cast(float, b << 16); }
__device__ __forceinline__ float bflo(unsigned w) { return __builtin_bit_cast(float, w << 16); }
__device__ __forceinline__ float bfhi(unsigned w) { return __builtin_bit_cast(float, w & 0xffff0000u); }
__device__ __forceinline__ float wave_sum(float v) {
#pragma unroll
    for (int o = 1; o < 64; o <<= 1) v += __shfl_xor(v, o);
    return v;
}
__device__ __forceinline__ float sigmoidf_(float x) { return 1.f / (1.f + __expf(-x)); }
#define XB_TMO      128
#define XB_XCNT(j)  (256  + 64 * (j))
#define XB_XSUB(j)  (1280 + 64 * (j))
#define XB_XGEN(j)  (2304 + 64 * (j))
#define XB_TOP      3328
#define XB_TOPGEN   3392
#define XCD_BAR_WORDS 3456
#define XB_SPIN_CAP (1u << 18)

__device__ __forceinline__ unsigned xb_ld(unsigned* p)              { return __hip_atomic_load(p, __ATOMIC_RELAXED, __HIP_MEMORY_SCOPE_AGENT); }
__device__ __forceinline__ unsigned xb_add(unsigned* p, unsigned v) { return __hip_atomic_fetch_add(p, v, __ATOMIC_RELAXED, __HIP_MEMORY_SCOPE_AGENT); }
__device__ __forceinline__ unsigned xb_xcc_id() { return (unsigned)__builtin_amdgcn_s_getreg((3 << 11) | 20) & 0xFu; }
#define XB_SPIN(cond, bar) do { unsigned _sp = 0; while (cond) { __builtin_amdgcn_s_sleep(1); \
    if ((++_sp & 255u) == 0u) { if (xb_ld(&(bar)[XB_TMO])) break; if (_sp > XB_SPIN_CAP) { atomicAdd(&(bar)[XB_TMO], 1u); break; } } } } while (0)

struct XcdBarrier {
    int leader; unsigned* bar; unsigned x;
    volatile LAS unsigned* st;
};

__device__ __forceinline__ XcdBarrier xcd_barrier_post(unsigned* bar, volatile LAS unsigned* st, int leader) {
    XcdBarrier b; b.leader = leader; b.bar = bar; b.x = xb_xcc_id(); b.st = st;
    if (leader) (void)xb_add(&bar[XB_XCNT(b.x)], 1u);
    return b;
}
__device__ __forceinline__ void xcd_barrier_complete(unsigned* bar, unsigned x, unsigned& nloc, unsigned& nx) {
    const unsigned G = gridDim.x * gridDim.y * gridDim.z;
    unsigned sum, cnt, mine, sp = 0u;
    for (;;) {
        sum = 0u; cnt = 0u; mine = 0u;
#pragma unroll
        for (unsigned j = 0; j < 16; ++j) { const unsigned c = xb_ld(&bar[XB_XCNT(j)]); sum += c; cnt += (c > 0u) ? 1u : 0u; mine = (j == x) ? c : mine; }
        if (sum == G) break;
        __builtin_amdgcn_s_sleep(1);
        if ((++sp & 255u) == 0u) { if (xb_ld(&bar[XB_TMO])) break; if (sp > XB_SPIN_CAP) { atomicAdd(&bar[XB_TMO], 1u); break; } }
    }
    nloc = mine > 0u ? mine : 1u; nx = cnt > 0u ? cnt : 1u;
}

__device__ __forceinline__ void xcd_barrier(const XcdBarrier& b) {
    asm volatile("s_waitcnt vmcnt(0)" ::: "memory");
    __syncthreads();
    if (b.leader) {
        unsigned* bar = b.bar;
        __builtin_amdgcn_s_waitcnt(0);
        unsigned nloc = b.st[0], nx = b.st[1];
        if (nloc == 0u) { xcd_barrier_complete(bar, b.x, nloc, nx); b.st[0] = nloc; b.st[1] = nx; }
        const unsigned old = xb_add(&bar[XB_XSUB(b.x)], 1u);
        const unsigned gen = old / nloc;
        if (old + 1u == (gen + 1u) * nloc) {
            __builtin_amdgcn_fence(__ATOMIC_RELEASE, "agent");
            asm volatile("s_waitcnt vmcnt(0)" ::: "memory");
            const unsigned og = xb_add(&bar[XB_TOP], 1u);
            const unsigned tg = og / nx;
            if (og + 1u == (tg + 1u) * nx) xb_add(&bar[XB_TOPGEN], 1u);
            else XB_SPIN(xb_ld(&bar[XB_TOPGEN]) == tg, bar);
            __builtin_amdgcn_fence(__ATOMIC_ACQUIRE, "agent");
            xb_add(&bar[XB_XGEN(b.x)], 1u);
            asm volatile("s_waitcnt vmcnt(0)" ::: "memory");
        } else {
            XB_SPIN(xb_ld(&bar[XB_XGEN(b.x)]) == gen, bar);
            __builtin_amdgcn_fence(__ATOMIC_ACQUIRE, "agent");
            asm volatile("s_waitcnt vmcnt(0)" ::: "memory");
        }
    }
    __syncthreads();
}

struct Args { const float* in[N_INPUTS]; float* out; unsigned char* ws; };
struct Frame { LAS unsigned char* lds; int tid, lane, wave, G; };
__device__ __forceinline__ void frame_refresh(Frame& F) { int t = F.wave * 64 + mk_lane(); asm volatile("" : "+v"(t)); F.tid = t; F.lane = t & 63; }
#define CAS __attribute__((address_space(4)))
__device__ __forceinline__ const CAS char* karg() { const CAS char* kp = (const CAS char*)__builtin_amdgcn_kernarg_segment_ptr(); asm volatile("" : "+s"(kp)); return kp; }
__device__ __forceinline__ const float* in_ptr(int i) { return *(const float* const CAS*)(karg() + 8 * i); }
__device__ __forceinline__ float* out_ptr() { return *(float* const CAS*)(karg() + 8 * N_INPUTS); }
__device__ __forceinline__ unsigned char* ws_ptr() { return *(unsigned char* const CAS*)(karg() + 8 * N_INPUTS + 8); }
#define WSP(T, off) ((T*)(ws + (off)))
#define WS_DECL unsigned char* const ws = ws_ptr()

namespace pg8 {
struct EpiStore {
    static constexpr bool PERM = true, AFTER_DRAIN = false;
    bf16_t* O; int ldc; int pm_add; int nN;
    __device__ __forceinline__ void operator()(const f32x4 (&acc)[2][2][4][2], const Unit& u, int wr, int wc, int fr, int fq) const {
        const int row0 = (u.pm + pm_add) * BM + wr * 64 + fr; const int col0 = (u.pn % nN) * BM + wc * 32 + 8 * fq;
#pragma unroll
        for (int ai = 0; ai < 2; ++ai)
#pragma unroll
            for (int m = 0; m < 4; ++m) { bf16_t* rowp = O + (size_t)(row0 + ai * HALF + m * 16) * ldc + col0;
#pragma unroll
                for (int bj = 0; bj < 2; ++bj) { const f32x4 v0 = acc[ai][bj][m][0], v1 = acc[ai][bj][m][1];
                    u32x4 w; w.x = cvt_pk_bf16(v0[0], v0[1]); w.y = cvt_pk_bf16(v0[2], v0[3]); w.z = cvt_pk_bf16(v1[0], v1[1]); w.w = cvt_pk_bf16(v1[2], v1[3]);
                    *(u32x4*)(rowp + bj * HALF) = w; } }
    }
};
__device__ __forceinline__ float silu_mul(float g, float u) { return g * __builtin_amdgcn_rcpf(1.f + __expf(-g)) * u; }
struct EpiSwiGLU {
    static constexpr bool PERM = true, AFTER_DRAIN = false;
    bf16_t* H; int ldh; int pm_sub; int nN;
    __device__ __forceinline__ void operator()(const f32x4 (&acc)[2][2][4][2], const Unit& u, int wr, int wc, int fr, int fq) const {
        const int row0 = (u.pm - pm_sub) * BM + wr * 64 + fr; const int col0 = (u.pn % nN) * HALF + wc * 32 + 8 * fq;
#pragma unroll
        for (int ai = 0; ai < 2; ++ai)
#pragma unroll
            for (int m = 0; m < 4; ++m) { bf16_t* rowp = H + (size_t)(row0 + ai * HALF + m * 16) * ldh + col0;
                const f32x4 g0 = acc[ai][0][m][0], g1 = acc[ai][0][m][1], u0 = acc[ai][1][m][0], u1 = acc[ai][1][m][1];
                u32x4 w; w.x = cvt_pk_bf16(silu_mul(g0[0], u0[0]), silu_mul(g0[1], u0[1])); w.y = cvt_pk_bf16(silu_mul(g0[2], u0[2]), silu_mul(g0[3], u0[3]));
                w.z = cvt_pk_bf16(silu_mul(g1[0], u1[0]), silu_mul(g1[1], u1[1])); w.w = cvt_pk_bf16(silu_mul(g1[2], u1[2]), silu_mul(g1[3], u1[3]));
                *(u32x4*)rowp = w; }
    }
};
struct EpiSwiGLU8 {
    static constexpr bool PERM = true, AFTER_DRAIN = false;
    unsigned char* H; int ldh; int pm_sub; int nN;
    __device__ __forceinline__ void operator()(const f32x4 (&acc)[2][2][4][2], const Unit& u, int wr, int wc, int fr, int fq) const {
        const int row0 = (u.pm - pm_sub) * BM + wr * 64 + fr; const int col0 = (u.pn % nN) * HALF + wc * 32 + 8 * fq;
#pragma unroll
        for (int ai = 0; ai < 2; ++ai)
#pragma unroll
            for (int m = 0; m < 4; ++m) { unsigned char* rowp = H + (size_t)(row0 + ai * HALF + m * 16) * ldh + col0;
                const f32x4 g0 = acc[ai][0][m][0], g1 = acc[ai][0][m][1], u0 = acc[ai][1][m][0], u1 = acc[ai][1][m][1];
                ::v2u w; w.x = ::pk4_fp8(silu_mul(g0[0], u0[0]), silu_mul(g0[1], u0[1]), silu_mul(g0[2], u0[2]), silu_mul(g0[3], u0[3]));
                w.y = ::pk4_fp8(silu_mul(g1[0], u1[0]), silu_mul(g1[1], u1[1]), silu_mul(g1[2], u1[2]), silu_mul(g1[3], u1[3]));
                *(::v2u*)rowp = w; }
    }
};
struct MoeOrder {
    int nM, nN, nwg, G, c, t0, pm_off; const PG8_LAS unsigned char* tile_e;
    __device__ void init(int nM_, int nN_, int G_, int c_, int t0_, int pm_off_, const PG8_LAS unsigned char* te) { nM = nM_; nN = nN_; nwg = nM * nN; G = G_; c = c_; t0 = t0_; pm_off = pm_off_; tile_e = te; }
    __device__ bool next(int i, Unit& u) const {
        const long L = (long)i * G + c; if (L >= nwg) return false;
        int wgid = (int)L; { const int q = nwg / NXCD, r = nwg % NXCD, xcd = wgid % NXCD, off = wgid / NXCD; wgid = (xcd < r ? xcd * (q + 1) : r * (q + 1) + (xcd - r) * q) + off; }
        const int nig = WGM * nN, gid = wgid / nig, fm = gid * WGM, gsz = (nM - fm) < WGM ? (nM - fm) : WGM;
        const int pml = fm + ((wgid % nig) % gsz), pnl = (wgid % nig) / gsz;
        const int e = tile_e[t0 + pml];
        u.pm = pm_off + pml; u.pn = e * nN + pnl; return true;
    }
    __device__ __forceinline__ void a_ready(const Unit&) const {}
    __device__ __forceinline__ void done(const Unit&) const {}
};
}

__device__ __forceinline__ void tr_item(const float* W, int ldw, int k0, int c0, bf16* WT, int K, int drow, LAS float* scr, int lane) {
#pragma unroll 8
    for (int i = 0; i < 32; ++i) { const int kk = 2 * i + (lane >> 5); scr[kk * 33 + (lane & 31)] = W[(size_t)(k0 + kk) * ldw + c0 + (lane & 31)]; }
    LDS_WAIT(); asm volatile("" ::: "memory");
    const int c = lane & 7;
#pragma unroll
    for (int j = 0; j < 4; ++j) { const int n = (lane >> 3) + 8 * j; const LAS float* s = scr + (8 * c) * 33 + n;
        v4u o; o.x = pk2(s[0 * 33], s[1 * 33]); o.y = pk2(s[2 * 33], s[3 * 33]); o.z = pk2(s[4 * 33], s[5 * 33]); o.w = pk2(s[6 * 33], s[7 * 33]);
        *(GAS v4u*)(WT + (size_t)(drow + n) * K + k0 + 8 * c) = o; }
    LDS_WAIT(); asm volatile("" ::: "memory");
}
__device__ __forceinline__ void tr_item8(const float* W, int ldw, int k0, int c0, unsigned char* WT, int K, int drow, LAS float* scr, int lane, float scale) {
#pragma unroll 8
    for (int i = 0; i < 32; ++i) { const int kk = 2 * i + (lane >> 5); scr[kk * 33 + (lane & 31)] = W[(size_t)(k0 + kk) * ldw + c0 + (lane & 31)]; }
    LDS_WAIT(); asm volatile("" ::: "memory");
    const int c = lane & 7;
#pragma unroll
    for (int j = 0; j < 4; ++j) { const int n = (lane >> 3) + 8 * j; const LAS float* s = scr + (8 * c) * 33 + n;
        v2u o; o.x = pk4_fp8(s[0 * 33] * scale, s[1 * 33] * scale, s[2 * 33] * scale, s[3 * 33] * scale); o.y = pk4_fp8(s[4 * 33] * scale, s[5 * 33] * scale, s[6 * 33] * scale, s[7 * 33] * scale);
        *(GAS v2u*)(WT + (size_t)(drow + n) * K + k0 + 8 * c) = o; }
    LDS_WAIT(); asm volatile("" ::: "memory");
}
__device__ __forceinline__ void conv_matrix(Frame& F, const float* W, int K, int ldw, int cbeg, int ncols, bf16* WT, int mode, int rowoff, int& cursor, float f8scale = 0.f) {
    const int gw = blockIdx.x * NWAVES + F.wave, NGW = F.G * NWAVES;
    const int nblk = ncols / 32, nit = (K / 64) * nblk;
    LAS float* scr = (LAS float*)(F.lds + F.wave * 16384);
    int first = cursor + (((gw - cursor) % NGW) + NGW) % NGW;
    for (int it = first; it < cursor + nit; it += NGW) {
        const int idx = it - cursor, kb = idx / nblk, nb = idx % nblk, n = 32 * nb;
        const int drow = mode == 0 ? rowoff + n : ((n >> 7) * 256 + (n & 127) + rowoff);
        if (f8scale != 0.f) tr_item8(W, ldw, 64 * kb, cbeg + n, (unsigned char*)WT, K, drow, scr, F.lane, f8scale); else tr_item(W, ldw, 64 * kb, cbeg + n, WT, K, drow, scr, F.lane);
    }
    cursor += nit;
}

__device__ __forceinline__ void phase_mod(Frame& F) { WS_DECL; frame_refresh(F);
    LAS float* sv = (LAS float*)F.lds;
    LAS float* red = (LAS float*)(F.lds + 69632);
    float* MOD = WSP(float, WS_MOD);
    if ((int)blockIdx.x < 192) {
        const float* cl_ = in_ptr(I_C); const float* cc_ = in_ptr(I_CCTX); const float* adab = in_ptr(I_ADAB); const float* adaw = in_ptr(I_ADAW);
        for (int i = F.tid; i < 17 * 1024; i += NTHR) { const int b = i >> 10, k = i & 1023; const float c = b < 16 ? cl_[b * 1024 + k] : cc_[k]; sv[i] = c / (1.f + expf(-c)); }
        __syncthreads();
        for (int item = blockIdx.x; item < 192; item += F.G) {
            const int li = item / 48, cg = item % 48, cl = F.tid & 127, kq = F.tid >> 7;
            const float* W = adaw + (size_t)li * 1024 * 6144 + cg * 128 + cl;
            float acc[17];
#pragma unroll
            for (int b = 0; b < 17; ++b) acc[b] = 0.f;
            for (int k = kq * 256; k < kq * 256 + 256; ++k) { const float w = W[(size_t)k * 6144];
#pragma unroll
                for (int b = 0; b < 17; ++b) acc[b] += sv[b * 1024 + k] * w; }
#pragma unroll
            for (int b = 0; b < 17; ++b) red[(kq * 17 + b) * 128 + cl] = acc[b];
            __syncthreads();
            for (int o = F.tid; o < 17 * 128; o += NTHR) { const int b = o >> 7, c = o & 127;
                const float s = (red[(0 * 17 + b) * 128 + c] + red[(1 * 17 + b) * 128 + c]) + (red[(2 * 17 + b) * 128 + c] + red[(3 * 17 + b) * 128 + c]);
                MOD[((size_t)li * 17 + b) * 6144 + cg * 128 + c] = s + adab[li * 6144 + cg * 128 + c]; }
            __syncthreads();
        }
    }
}

__device__ __forceinline__ void phase_pro0(Frame& F) { WS_DECL; frame_refresh(F);
    phase_mod(F);
    __syncthreads();
    int cursor = 0;
    for (int li = 0; li < DEPTH; ++li) {
        conv_matrix(F, in_ptr(I_WIN) + (size_t)li * D * N_IN, D, N_IN, 0, D_OFF, WSP(bf16, WS_WINT) + (size_t)li * PCOLS * D, 0, 0, cursor);
        conv_matrix(F, in_ptr(I_WIN) + (size_t)li * D * N_IN, D, N_IN, D_OFF, HYC, WSP(bf16, WS_WHYT) + (size_t)li * HYC * D, 0, 0, cursor);
        conv_matrix(F, in_ptr(I_WOUT) + (size_t)li * D * D, D, D, 0, D, WSP(bf16, WS_WOUTT) + (size_t)li * D * D, 0, 0, cursor);
    }
    for (int j = 0; j < 2; ++j) {
        conv_matrix(F, in_ptr(I_FG) + (size_t)j * D * FFD, D, FFD, 0, FFD, WSP(bf16, WS_WGUT) + (size_t)j * 2 * FFD * D, 1, 0, cursor);
        conv_matrix(F, in_ptr(I_FU) + (size_t)j * D * FFD, D, FFD, 0, FFD, WSP(bf16, WS_WGUT) + (size_t)j * 2 * FFD * D, 1, 128, cursor);
        conv_matrix(F, in_ptr(I_FD) + (size_t)j * FFD * D, FFD, D, 0, D, WSP(bf16, WS_WDT) + (size_t)j * D * FFD, 0, 0, cursor);
    }
    { const int gt = blockIdx.x * NTHR + F.tid, NGT = F.G * NTHR; const int per = (PCOLS - D_OFF) * D / 8;
      for (int i = gt; i < DEPTH * per; i += NGT) { const int li = i / per, r = i % per; *(GAS v4u*)(WSP(bf16, WS_WINT) + (size_t)li * PCOLS * D + (size_t)D_OFF * D + (size_t)r * 8) = (v4u){0u, 0u, 0u, 0u}; } }
}

struct Stream { const float* inl; const float* inc; float* outl; float* outc; };
__device__ __forceinline__ Stream make_stream(unsigned char* ws, int li) { Stream s; s.outl = out_ptr(); s.outc = WSP(float, WS_XC); s.inl = li == 0 ? in_ptr(I_X) : (const float*)s.outl; s.inc = li == 0 ? in_ptr(I_CTX) : (const float*)s.outc; return s; }
__device__ __forceinline__ const float* stream_in(const Stream& s, int m) { return m < NL ? s.inl + (size_t)m * D : s.inc + (size_t)(m - NL) * D; }
__device__ __forceinline__ float* stream_out(const Stream& s, int m) { return m < NL ? s.outl + (size_t)m * D : s.outc + (size_t)(m - NL) * D; }
__device__ __forceinline__ int mod_b(int m) { return m < NL ? (m >> 12) : 16; }
__device__ __forceinline__ const float* mod_vec(unsigned char* ws, int li, int b, int j) { return WSP(float, WS_MOD) + ((size_t)li * 17 + b) * 6144 + j * 1024; }

__device__ __forceinline__ void store_modulated(const f32x4 (&x)[4], const float* shift, const float* scale, bf16* orow, int lane) {
#pragma unroll
    for (int j = 0; j < 4; ++j) { const int c = 4 * lane + 256 * j; const f32x4 sh = *(const GAS f32x4*)(shift + c), sc = *(const GAS f32x4*)(scale + c);
        const f32x4 h = x[j] * (sc + 1.f) + sh; v2u w; w.x = pk2(h.x, h.y); w.y = pk2(h.z, h.w); *(GAS v2u*)(orow + c) = w; }
}
__device__ __forceinline__ void rows_range(const Frame& F, int nrows, int& r0, int& r1) { const int per = (nrows + F.G - 1) / F.G; r0 = blockIdx.x * per; r1 = r0 + per < nrows ? r0 + per : nrows; if (r0 > nrows) r0 = nrows; }

__device__ __forceinline__ void phase_hin0(Frame& F) { WS_DECL; frame_refresh(F);
    int r0, r1; rows_range(F, NT, r0, r1); const Stream st = make_stream(ws, 0);
    for (int m = r0 + F.wave; m < r1; m += NWAVES) {
        const float* xr = stream_in(st, m); f32x4 x[4];
#pragma unroll
        for (int j = 0; j < 4; ++j) x[j] = *(const GAS f32x4*)(xr + 4 * F.lane + 256 * j);
        const int b = mod_b(m);
        store_modulated(x, mod_vec(ws, 0, b, 0), mod_vec(ws, 0, b, 1), WSP(bf16, WS_A1) + (size_t)m * D, F.lane);
    }
}

__device__ __forceinline__ void ln_rows(f32x4 (&v)[4], const float* g, const float* bta, int lane) {
    float s = 0.f;
#pragma unroll
    for (int j = 0; j < 4; ++j) s += (v[j].x + v[j].y) + (v[j].z + v[j].w);
    const float mean = wave_sum(s) * (1.f / D); float s2 = 0.f;
#pragma unroll
    for (int j = 0; j < 4; ++j) { v[j] = v[j] - mean; s2 += (v[j].x * v[j].x + v[j].y * v[j].y) + (v[j].z * v[j].z + v[j].w * v[j].w); }
    const float rstd = __builtin_amdgcn_rsqf(wave_sum(s2) * (1.f / D) + 1e-5f);
#pragma unroll
    for (int j = 0; j < 4; ++j) { const int c = 4 * lane + 256 * j; v[j] = v[j] * rstd * *(const GAS f32x4*)(g + c) + *(const GAS f32x4*)(bta + c); }
}

template <bool HAVE_Y>
__device__ __forceinline__ void phase_ln1(Frame& F, int li) { WS_DECL; frame_refresh(F);
    const int nrows = li == DEPTH - 1 ? NL : NT; const bool moe = li & 1; const int lane = F.lane;
    LAS int* hist = (LAS int*)(F.lds + LDS_MOEI) + 56; LAS float* ROUT = (LAS float*)F.lds;
    if (moe) { if (F.tid < 8) hist[F.tid] = 0; const float* router = in_ptr(I_ROUTER) + (size_t)(li >> 1) * D * NE; for (int i = F.tid; i < D * NE / 4; i += NTHR) *(LAS f32x4*)(ROUT + 4 * i) = *(const GAS f32x4*)(router + 4 * i); __syncthreads(); }
    int r0, r1; rows_range(F, nrows, r0, r1);
    const float* g = in_ptr(I_LN1G) + li * D; const float* bt = in_ptr(I_LN1B) + li * D; const Stream st = make_stream(ws, li); const bf16* Y = WSP(bf16, WS_Y);
    f32x4 xn[4]; v2u yn[4];
    { const int m = r0 + F.wave; if (m < r1) { const float* xr = stream_in(st, m);
#pragma unroll
        for (int j = 0; j < 4; ++j) { const int c = 4 * lane + 256 * j; xn[j] = *(const GAS f32x4*)(xr + c); if (HAVE_Y) yn[j] = *(const GAS v2u*)(Y + (size_t)m * D + c); } } }
    for (int m = r0 + F.wave; m < r1; m += NWAVES) {
        const int b = mod_b(m); f32x4 v[4]; v2u yw[4];
#pragma unroll
        for (int j = 0; j < 4; ++j) { v[j] = xn[j]; if (HAVE_Y) yw[j] = yn[j]; }
        if (m + NWAVES < r1) { const float* xr = stream_in(st, m + NWAVES);
#pragma unroll
            for (int j = 0; j < 4; ++j) { const int c = 4 * lane + 256 * j; xn[j] = *(const GAS f32x4*)(xr + c); if (HAVE_Y) yn[j] = *(const GAS v2u*)(Y + (size_t)(m + NWAVES) * D + c); } }
        const float* m2 = mod_vec(ws, li, b, 2);
#pragma unroll
        for (int j = 0; j < 4; ++j) { const int c = 4 * lane + 256 * j; v[j] = v[j] * ALPHA;
            if (HAVE_Y) { const f32x4 mm = *(const GAS f32x4*)(m2 + c); v[j].x += mm.x * bflo(yw[j].x); v[j].y += mm.y * bfhi(yw[j].x); v[j].z += mm.z * bflo(yw[j].y); v[j].w += mm.w * bfhi(yw[j].y); } }
        ln_rows(v, g, bt, lane);
        float* xo = stream_out(st, m);
#pragma unroll
        for (int j = 0; j < 4; ++j) *(GAS f32x4*)(xo + 4 * lane + 256 * j) = v[j];
        const float* sh = mod_vec(ws, li, b, 3); const float* sc = mod_vec(ws, li, b, 4);
        if (moe) {
            float lg[NE];
#pragma unroll
            for (int e = 0; e < NE; ++e) lg[e] = 0.f;
#pragma unroll
            for (int j = 0; j < 4; ++j) { const int c = 4 * lane + 256 * j; const f32x4 s4 = *(const GAS f32x4*)(sh + c), c4 = *(const GAS f32x4*)(sc + c); const f32x4 f = v[j] * (c4 + 1.f) + s4;
#pragma unroll
                for (int q = 0; q < 4; ++q) { const f32x4 ra = *(const LAS f32x4*)(ROUT + (c + q) * NE), rb = *(const LAS f32x4*)(ROUT + (c + q) * NE + 4); const float fq = f[q];
                    lg[0] += fq * ra.x; lg[1] += fq * ra.y; lg[2] += fq * ra.z; lg[3] += fq * ra.w; lg[4] += fq * rb.x; lg[5] += fq * rb.y; lg[6] += fq * rb.z; lg[7] += fq * rb.w; } }
#pragma unroll
            for (int e = 0; e < NE; ++e) lg[e] = wave_sum(lg[e]);
            int e0 = 0; float v0 = lg[0];
#pragma unroll
            for (int e = 1; e < NE; ++e) if (lg[e] > v0) { v0 = lg[e]; e0 = e; }
            int e1 = -1; float v1 = -3.0e38f;
#pragma unroll
            for (int e = 0; e < NE; ++e) if (e != e0 && lg[e] > v1) { v1 = lg[e]; e1 = e; }
            const float ex = __expf(v1 - v0), g0 = 1.f / (1.f + ex), g1 = ex * g0;
            if (lane == 0) { *(GAS v2u*)(WSP(int, WS_TOKE) + 2 * (size_t)m) = (v2u){(unsigned)e0, (unsigned)e1}; *(GAS f32x2*)(WSP(float, WS_TOKG) + 2 * (size_t)m) = (f32x2){g0, g1};
                atomicAdd((int*)(hist + e0), 1); atomicAdd((int*)(hist + e1), 1); }
        }
        if (moe) {
            unsigned char* orow = WSP(unsigned char, WS_A1) + (size_t)m * D;
#pragma unroll
            for (int j = 0; j < 4; ++j) { const int c = 4 * lane + 256 * j; const f32x4 s4 = *(const GAS f32x4*)(sh + c), c4 = *(const GAS f32x4*)(sc + c); const f32x4 f = v[j] * (c4 + 1.f) + s4;
                *(GAS unsigned*)(orow + c) = pk4_fp8(f.x, f.y, f.z, f.w); }
        } else store_modulated(v, sh, sc, WSP(bf16, WS_A1) + (size_t)m * D, lane);
    }
    if (moe) { __syncthreads(); if (F.tid < 8) WSP(int, WS_BLKCNT)[blockIdx.x * 8 + F.tid] = hist[F.tid]; }
}

template <bool HAVE_FFN>
__device__ __forceinline__ void phase_ln2(Frame& F, int li) { WS_DECL; frame_refresh(F);
    const int nrows = li == DEPTH - 1 ? NL : NT; const bool moe = li & 1; const int lane = F.lane;
    int r0, r1; rows_range(F, nrows, r0, r1);
    const float* g = in_ptr(I_LN2G) + li * D; const float* bt = in_ptr(I_LN2B) + li * D; const Stream st = make_stream(ws, 1);
    const bf16* Y = WSP(bf16, WS_Y); const bf16* XS = WSP(bf16, WS_Y2); const int* TOKS = WSP(int, WS_TOKS); const float* TOKG = WSP(float, WS_TOKG);
    f32x4 xn[4]; v2u ya[4], yb[4]; v2u sn = (v2u){0u, 0u}; f32x2 gn = (f32x2){0.f, 0.f}, gc = (f32x2){0.f, 0.f};
    const int mf = r0 + F.wave;
    if (mf < r1) { const float* xr = stream_out(st, mf); v2u s0 = (v2u){0u, 0u};
        if (moe) { s0 = *(const GAS v2u*)(TOKS + 2 * (size_t)mf); gc = *(const GAS f32x2*)(TOKG + 2 * (size_t)mf); if (mf + NWAVES < r1) { sn = *(const GAS v2u*)(TOKS + 2 * (size_t)(mf + NWAVES)); gn = *(const GAS f32x2*)(TOKG + 2 * (size_t)(mf + NWAVES)); } }
#pragma unroll
        for (int j = 0; j < 4; ++j) { const int c = 4 * lane + 256 * j; xn[j] = *(const GAS f32x4*)(xr + c);
            if (HAVE_FFN) { if (moe) { ya[j] = *(const GAS v2u*)(XS + (size_t)s0.x * D + c); yb[j] = *(const GAS v2u*)(XS + (size_t)s0.y * D + c); } else ya[j] = *(const GAS v2u*)(Y + (size_t)mf * D + c); } } }
    for (int m = mf; m < r1; m += NWAVES) {
        const int b = mod_b(m); f32x4 v[4]; v2u wa[4], wb[4]; const f32x2 gg = gc;
#pragma unroll
        for (int j = 0; j < 4; ++j) { v[j] = xn[j]; wa[j] = ya[j]; wb[j] = yb[j]; }
        const int mn = m + NWAVES;
        if (mn < r1) { const float* xr = stream_out(st, mn); const v2u s1 = sn; gc = gn;
            if (moe && mn + NWAVES < r1) { sn = *(const GAS v2u*)(TOKS + 2 * (size_t)(mn + NWAVES)); gn = *(const GAS f32x2*)(TOKG + 2 * (size_t)(mn + NWAVES)); }
#pragma unroll
            for (int j = 0; j < 4; ++j) { const int c = 4 * lane + 256 * j; xn[j] = *(const GAS f32x4*)(xr + c);
                if (HAVE_FFN) { if (moe) { ya[j] = *(const GAS v2u*)(XS + (size_t)s1.x * D + c); yb[j] = *(const GAS v2u*)(XS + (size_t)s1.y * D + c); } else ya[j] = *(const GAS v2u*)(Y + (size_t)mn * D + c); } } }
        const float* m5 = mod_vec(ws, li, b, 5);
#pragma unroll
        for (int j = 0; j < 4; ++j) { const int c = 4 * lane + 256 * j; v[j] = v[j] * ALPHA;
            if (HAVE_FFN) { const f32x4 mm = *(const GAS f32x4*)(m5 + c); f32x4 o;
                if (moe) { o.x = gg.x * bflo(wa[j].x) + gg.y * bflo(wb[j].x); o.y = gg.x * bfhi(wa[j].x) + gg.y * bfhi(wb[j].x); o.z = gg.x * bflo(wa[j].y) + gg.y * bflo(wb[j].y); o.w = gg.x * bfhi(wa[j].y) + gg.y * bfhi(wb[j].y); }
                else { o.x = bflo(wa[j].x); o.y = bfhi(wa[j].x); o.z = bflo(wa[j].y); o.w = bfhi(wa[j].y); }
                v[j] = v[j] + mm * o; } }
        ln_rows(v, g, bt, lane);
        float* xo = stream_out(st, m);
#pragma unroll
        for (int j = 0; j < 4; ++j) *(GAS f32x4*)(xo + 4 * lane + 256 * j) = v[j];
        if (li < DEPTH - 1) store_modulated(v, mod_vec(ws, li + 1, b, 0), mod_vec(ws, li + 1, b, 1), WSP(bf16, WS_A1) + (size_t)m * D, lane);
    }
}

__device__ __forceinline__ void phase_moe_weights(Frame& F, int li) { WS_DECL; frame_refresh(F);
    const int j = li >> 1; int cursor = 0;
    for (int e = 0; e < NE; ++e) {
        conv_matrix(F, in_ptr(I_MG) + ((size_t)j * NE + e) * D * FFE, D, FFE, 0, FFE, (bf16*)(WSP(unsigned char, WS_M8GU) + (size_t)e * 2 * FFE * D), 1, 0, cursor, 64.f);
        conv_matrix(F, in_ptr(I_MU) + ((size_t)j * NE + e) * D * FFE, D, FFE, 0, FFE, (bf16*)(WSP(unsigned char, WS_M8GU) + (size_t)e * 2 * FFE * D), 1, 128, cursor, 64.f);
        conv_matrix(F, in_ptr(I_MD) + ((size_t)j * NE + e) * FFE * D, FFE, D, 0, D, (bf16*)(WSP(unsigned char, WS_M8D) + (size_t)e * D * FFE), 0, 0, cursor, 256.f);
    }
}

__device__ __forceinline__ void phase_moe_slots(Frame& F, int li) { WS_DECL; frame_refresh(F);
    const int nrows = li == DEPTH - 1 ? NL : NT;
    LAS int* mi = (LAS int*)(F.lds + LDS_MOEI); LAS unsigned char* tile_e = (LAS unsigned char*)(F.lds + LDS_TILEE);
    LAS int* slots = (LAS int*)F.lds;
    const int* blkcnt = WSP(int, WS_BLKCNT);
    if (F.tid < 8) { int tot = 0, pre = 0; for (int b = 0; b < F.G; ++b) { const int c = blkcnt[b * 8 + F.tid]; if (b < (int)blockIdx.x) pre += c; tot += c; } mi[16 + F.tid] = tot; mi[32 + F.tid] = pre; }
    __syncthreads();
    if (F.tid == 0) { int s = 0; for (int e = 0; e < NE; ++e) { mi[e] = s; s += (mi[16 + e] + 255) & ~255; } mi[8] = s; mi[48] = s >> 8; }
    __syncthreads();
    for (int t = F.tid; t < MOE_MAX_TILES + 8; t += NTHR) { int e = 0;
#pragma unroll
        for (int q = 1; q < NE; ++q) if (t * 256 >= mi[q]) e = q;
        tile_e[t] = (unsigned char)e; }
    int r0, r1; rows_range(F, nrows, r0, r1);
    const int na = 2 * (r1 - r0);
    if (F.wave == 0) {
        int run[NE];
#pragma unroll
        for (int e = 0; e < NE; ++e) run[e] = mi[e] + mi[32 + e];
        for (int base = 0; base < na; base += 64) { const int ai = base + F.lane; const bool ok = ai < na;
            const int e = ok ? WSP(int, WS_TOKE)[2 * (size_t)r0 + ai] : -1; int slot = 0;
#pragma unroll
            for (int q = 0; q < NE; ++q) { const unsigned long long mk = __ballot(e == q); if (e == q) slot = run[q] + __popcll(mk & ((1ull << F.lane) - 1ull)); run[q] += __popcll(mk); }
            if (ok) { slots[ai] = slot; WSP(int, WS_TOKS)[2 * (size_t)r0 + ai] = slot; } }
    }
    __syncthreads();
    for (int ai = F.wave; ai < na; ai += NWAVES) { const int m = r0 + (ai >> 1), slot = slots[ai];
        const GAS v4u* src = (const GAS v4u*)(WSP(unsigned char, WS_A1) + (size_t)m * D); GAS v4u* dst = (GAS v4u*)(WSP(unsigned char, WS_XS8) + (size_t)slot * D);
        dst[F.lane] = src[F.lane]; }
    { const int gw = blockIdx.x * NWAVES + F.wave, NGW = F.G * NWAVES; int cnt = 0;
      for (int e = 0; e < NE; ++e) { const int p0 = mi[e] + mi[16 + e], p1 = mi[e + 1];
          for (int s = p0; s < p1; ++s, ++cnt) if (cnt % NGW == gw) { GAS v4u* dst = (GAS v4u*)(WSP(unsigned char, WS_XS8) + (size_t)s * D); dst[F.lane] = (v4u){0u, 0u, 0u, 0u}; } } }
    __syncthreads();
}

constexpr float QSCALE = 0.14724319f;
constexpr int MP_CQ_LD = 200, MP_CKV_LD = 136;
__device__ __forceinline__ void phase_mla_prep(Frame& F, int li) { WS_DECL; frame_refresh(F);
    LAS bf16* CQN = (LAS bf16*)F.lds; LAS bf16* CKVN = (LAS bf16*)(F.lds + 64 * MP_CQ_LD * 2);
    const bf16* P = WSP(bf16, WS_P); bf16* QB = WSP(bf16, WS_QB); bf16* KB = WSP(bf16, WS_KB); bf16* VT = WSP(bf16, WS_VT);
    const float* qn = in_ptr(I_QNORM) + li * 192; const float* kvn = in_ptr(I_KVNORM) + li * 128;
    const bf16* WQ = WSP(bf16, WS_WUQT) + (size_t)li * 384 * 192; const bf16* WKV = WSP(bf16, WS_WUKVT) + (size_t)li * 512 * 128;
    const float* RC = WSP(float, WS_ROPE); const float* RS = RC + 4096 * 16;
    const int lane = F.lane, wave = F.wave;
    const int head = wave >> 1, half = wave & 1, fr = lane & 15, kg = lane >> 4;
    for (int item = blockIdx.x; item < NT / 64; item += F.G) {
        const int m0 = item * 64; const bool isctx = m0 >= NL; const int b = isctx ? (m0 - NL) >> 8 : m0 >> 12; const int t0 = isctx ? (m0 - NL) & 255 : m0 & 4095;
        const int ki0 = isctx ? t0 : 256 + t0;
        bf16x8 wq[3][6];
#pragma unroll
        for (int i = 0; i < 3; ++i)
#pragma unroll
            for (int ks = 0; ks < 6; ++ks) wq[i][ks] = *(const GAS bf16x8*)(WQ + (size_t)(96 * head + 16 * (3 * half + i) + fr) * 192 + 32 * ks + 8 * kg);
        v4u rawv[8]; unsigned short kr1[8], kr2[8];
#pragma unroll
        for (int i = 0; i < 8; ++i) { const bf16* pr = P + (size_t)(m0 + wave * 8 + i) * PCOLS; rawv[i] = (v4u){0u, 0u, 0u, 0u}; if (lane < 40) rawv[i] = *(const GAS v4u*)(pr + 8 * lane);
            kr1[i] = 0; kr2[i] = 0; if (lane < 16) { kr1[i] = pr[320 + lane]; kr2[i] = pr[336 + lane]; } }
#pragma unroll
        for (int i = 0; i < 8; ++i) { const int tl = wave * 8 + i; const v4u raw = rawv[i];
            float x[8]; x[0] = bflo(raw.x); x[1] = bfhi(raw.x); x[2] = bflo(raw.y); x[3] = bfhi(raw.y); x[4] = bflo(raw.z); x[5] = bfhi(raw.z); x[6] = bflo(raw.w); x[7] = bfhi(raw.w);
            float ss = 0.f;
#pragma unroll
            for (int j = 0; j < 8; ++j) ss += x[j] * x[j];
            const float sq = wave_sum(lane < 24 ? ss : 0.f), skv = wave_sum((lane >= 24 && lane < 40) ? ss : 0.f);
            const float rq = __builtin_amdgcn_rsqf(sq * (1.f / 192.f) + 1e-6f), rkv = __builtin_amdgcn_rsqf(skv * (1.f / 128.f) + 1e-6f);
            if (lane < 24) { const float* g = qn + 8 * lane; v4u o; o.x = pk2(x[0] * rq * g[0], x[1] * rq * g[1]); o.y = pk2(x[2] * rq * g[2], x[3] * rq * g[3]); o.z = pk2(x[4] * rq * g[4], x[5] * rq * g[5]); o.w = pk2(x[6] * rq * g[6], x[7] * rq * g[7]);
                *(LAS v4u*)(CQN + tl * MP_CQ_LD + 8 * lane) = o; }
            else if (lane < 40) { const int c = 8 * (lane - 24); const float* g = kvn + c; v4u o; o.x = pk2(x[0] * rkv * g[0], x[1] * rkv * g[1]); o.y = pk2(x[2] * rkv * g[2], x[3] * rkv * g[3]); o.z = pk2(x[4] * rkv * g[4], x[5] * rkv * g[5]); o.w = pk2(x[6] * rkv * g[6], x[7] * rkv * g[7]);
                *(LAS v4u*)(CKVN + tl * MP_CKV_LD + c) = o; }
            if (lane < 16) { float x1 = bf2f(kr1[i]), x2 = bf2f(kr2[i]);
                if (!isctx) { const float c = RC[(t0 + tl) * 16 + lane], s = RS[(t0 + tl) * 16 + lane]; const float y1 = x1 * c - x2 * s, y2 = x1 * s + x2 * c; x1 = y1; x2 = y2; }
                const bf16 o1 = (bf16)f2bf(x1), o2 = (bf16)f2bf(x2);
#pragma unroll
                for (int h = 0; h < 4; ++h) { bf16* kr = KB + ((size_t)(b * 4 + h) * KSEQ + ki0 + tl) * 96; kr[64 + lane] = o1; kr[80 + lane] = o2; } }
        }
        __syncthreads();
        const size_t qrow0 = ((size_t)(b * 4 + head) * KSEQ + ki0) * 96;
        { f32x4 acc[3][4];
#pragma unroll
          for (int i = 0; i < 3; ++i)
#pragma unroll
              for (int m = 0; m < 4; ++m) acc[i][m] = (f32x4){0.f, 0.f, 0.f, 0.f};
#pragma unroll
          for (int ks = 0; ks < 6; ++ks)
#pragma unroll
              for (int m = 0; m < 4; ++m) { const bf16x8 xf = *(const LAS bf16x8*)(CQN + (16 * m + fr) * MP_CQ_LD + 32 * ks + 8 * kg);
#pragma unroll
                  for (int i = 0; i < 3; ++i) acc[i][m] = __builtin_amdgcn_mfma_f32_16x16x32_bf16(wq[i][ks], xf, acc[i][m], 0, 0, 0); }
#pragma unroll
          for (int m = 0; m < 4; ++m) { bf16* qr = QB + qrow0 + (size_t)(16 * m + fr) * 96;
              { v2u o; o.x = pk2(acc[0][m][0] * QSCALE, acc[0][m][1] * QSCALE); o.y = pk2(acc[0][m][2] * QSCALE, acc[0][m][3] * QSCALE); *(GAS v2u*)(qr + 48 * half + 4 * kg) = o; }
              f32x4 y1 = acc[1][m], y2 = acc[2][m];
              if (half == 1 && !isctx) { const int t = t0 + 16 * m + fr; const f32x4 c = *(const GAS f32x4*)(RC + t * 16 + 4 * kg), sn = *(const GAS f32x4*)(RS + t * 16 + 4 * kg); y1 = acc[1][m] * c - acc[2][m] * sn; y2 = acc[1][m] * sn + acc[2][m] * c; }
              v2u o1, o2; o1.x = pk2(y1[0] * QSCALE, y1[1] * QSCALE); o1.y = pk2(y1[2] * QSCALE, y1[3] * QSCALE); o2.x = pk2(y2[0] * QSCALE, y2[1] * QSCALE); o2.y = pk2(y2[2] * QSCALE, y2[3] * QSCALE);
              *(GAS v2u*)(qr + 48 * half + 16 + 4 * kg) = o1; *(GAS v2u*)(qr + 48 * half + 32 + 4 * kg) = o2; } }
        bf16x8 wkv[4][4];
#pragma unroll
        for (int nt = 0; nt < 4; ++nt)
#pragma unroll
            for (int ks = 0; ks < 4; ++ks) wkv[nt][ks] = *(const GAS bf16x8*)(WKV + (size_t)(128 * head + 64 * half + 16 * nt + fr) * 128 + 32 * ks + 8 * kg);
        { f32x4 acc[4][4];
#pragma unroll
          for (int nt = 0; nt < 4; ++nt)
#pragma unroll
              for (int m = 0; m < 4; ++m) acc[nt][m] = (f32x4){0.f, 0.f, 0.f, 0.f};
#pragma unroll
          for (int ks = 0; ks < 4; ++ks)
#pragma unroll
              for (int m = 0; m < 4; ++m) { const bf16x8 xf = *(const LAS bf16x8*)(CKVN + (16 * m + fr) * MP_CKV_LD + 32 * ks + 8 * kg);
#pragma unroll
                  for (int nt = 0; nt < 4; ++nt) acc[nt][m] = half == 0 ? __builtin_amdgcn_mfma_f32_16x16x32_bf16(wkv[nt][ks], xf, acc[nt][m], 0, 0, 0) : __builtin_amdgcn_mfma_f32_16x16x32_bf16(xf, wkv[nt][ks], acc[nt][m], 0, 0, 0); }
#pragma unroll
          for (int nt = 0; nt < 4; ++nt)
#pragma unroll
              for (int m = 0; m < 4; ++m) { v2u o; o.x = pk2(acc[nt][m][0], acc[nt][m][1]); o.y = pk2(acc[nt][m][2], acc[nt][m][3]);
                  if (half == 0) *(GAS v2u*)(KB + qrow0 + (size_t)(16 * m + fr) * 96 + 16 * nt + 4 * kg) = o;
                  else *(GAS v2u*)(VT + ((size_t)(b * 4 + head) * 64 + 16 * nt + fr) * KSEQ + ki0 + 16 * m + 4 * kg) = o; } }
        __syncthreads();
    }
}

constexpr int AT_KLD = 104, AT_VLD = 72;
constexpr int AT_KB = 64 * AT_KLD * 2, AT_VB = 64 * AT_VLD * 2, AT_BUF = AT_KB + AT_VB;
__device__ __forceinline__ void phase_attn(Frame& F, int li) { WS_DECL; frame_refresh(F);
    const bf16* QB = WSP(bf16, WS_QB); const bf16* KB = WSP(bf16, WS_KB); const bf16* VT = WSP(bf16, WS_VT); bf16* AO = WSP(bf16, WS_AO);
    const int lane = F.lane, wave = F.wave, tid = F.tid, ql = lane & 31, h2 = lane >> 5;
    const int nunits = 1024 + (li < DEPTH - 1 ? 64 : 0);
    const int c = blockIdx.x, vc = (F.G == 256) ? (c & 7) * 32 + (c >> 3) : c;
    for (int u = vc; u < nunits; u += F.G) {
        int bh, q0, nk; bool isctx = u >= 1024;
        if (!isctx) { bh = u >> 4; q0 = 256 + 256 * (u & 15); nk = KSEQ; } else { bh = u - 1024; q0 = 0; nk = 256; }
        const bf16* Kb = KB + (size_t)bh * KSEQ * 96; const bf16* Vb = VT + (size_t)bh * 64 * KSEQ;
        bf16x8 qf[6];
        { const bf16* qr = QB + ((size_t)bh * KSEQ + q0 + 32 * wave + ql) * 96 + 8 * h2;
#pragma unroll
          for (int ks = 0; ks < 6; ++ks) qf[ks] = *(const GAS bf16x8*)(qr + 16 * ks); }
        f32x16 O0, O1;
#pragma unroll
        for (int r = 0; r < 16; ++r) { O0[r] = 0.f; O1[r] = 0.f; }
        float l_run = 0.f;
        const int kc0 = tid, kc1 = tid + 512; const int vr = tid >> 3, vcn = tid & 7;
        const int ko0 = (kc0 / 12) * (AT_KLD * 2) + (kc0 % 12) * 16, ko1 = (kc1 / 12) * (AT_KLD * 2) + (kc1 % 12) * 16, vo = AT_KB + vr * (AT_VLD * 2) + vcn * 16;
        v4u pk0, pk1 = (v4u){0u, 0u, 0u, 0u}, pv;
#define AT_LOAD(t) do { const GAS v4u* ks_ = (const GAS v4u*)(Kb + (size_t)(t) * 64 * 96); pk0 = ks_[kc0]; if (kc1 < 768) pk1 = ks_[kc1]; pv = *(const GAS v4u*)(Vb + (size_t)vr * KSEQ + (t) * 64 + 8 * vcn); } while (0)
#define AT_STORE(bo) do { LAS unsigned char* b_ = F.lds + (bo); *(LAS v4u*)(b_ + ko0) = pk0; if (kc1 < 768) *(LAS v4u*)(b_ + ko1) = pk1; *(LAS v4u*)(b_ + vo) = pv; } while (0)
#define AT_QK(bo, A0, A1, INIT) do { const LAS unsigned char* b_ = F.lds + (bo); _Pragma("unroll") for (int r = 0; r < 16; ++r) { A0[r] = (INIT); A1[r] = (INIT); } \
            _Pragma("unroll") for (int kh = 0; kh < 2; ++kh) { bf16x8 kf0[3], kf1[3]; \
                _Pragma("unroll") for (int k3 = 0; k3 < 3; ++k3) { const int ks = 3 * kh + k3; kf0[k3] = *(const LAS bf16x8*)(b_ + ql * (AT_KLD * 2) + 32 * ks + 16 * h2); kf1[k3] = *(const LAS bf16x8*)(b_ + (32 + ql) * (AT_KLD * 2) + 32 * ks + 16 * h2); } \
                __builtin_amdgcn_sched_barrier(0); \
                _Pragma("unroll") for (int k3 = 0; k3 < 3; ++k3) { const int ks = 3 * kh + k3; A0 = __builtin_amdgcn_mfma_f32_32x32x16_bf16(kf0[k3], qf[ks], A0, 0, 0, 0); A1 = __builtin_amdgcn_mfma_f32_32x32x16_bf16(kf1[k3], qf[ks], A1, 0, 0, 0); } \
                __builtin_amdgcn_sched_barrier(0); } } while (0)
        const int ntile = nk >> 6;
        v4u qk0, qk1 = (v4u){0u, 0u, 0u, 0u}, qv;
#define AT_LOADB(t) do { const GAS v4u* ks_ = (const GAS v4u*)(Kb + (size_t)(t) * 64 * 96); qk0 = ks_[kc0]; if (kc1 < 768) qk1 = ks_[kc1]; qv = *(const GAS v4u*)(Vb + (size_t)vr * KSEQ + (t) * 64 + 8 * vcn); } while (0)
#define AT_STOREB(bo) do { LAS unsigned char* b_ = F.lds + (bo); *(LAS v4u*)(b_ + ko0) = qk0; if (kc1 < 768) *(LAS v4u*)(b_ + ko1) = qk1; *(LAS v4u*)(b_ + vo) = qv; } while (0)
        AT_LOAD(0); AT_LOADB(1);
        __syncthreads();
        AT_STORE(0); AT_STOREB(AT_BUF);
        AT_LOAD(2); AT_LOADB(3);
        __syncthreads();
        int bo0 = 0, bo1 = AT_BUF, bo2 = 2 * AT_BUF;
        float m_ref = 0.f;
#define AT_BODY(KT, STOREX, LOADX) do { const int kt_ = (KT); \
            if (kt_ + 2 < ntile) STOREX(bo2); if (kt_ + 4 < ntile) LOADX(kt_ + 4); \
            f32x16 S0, S1; AT_QK(bo0, S0, S1, -m_ref); \
            float mxa = fmaxf(fmaxf(S0[0], S0[1]), S0[2]), mxb = fmaxf(fmaxf(S0[3], S0[4]), S0[5]), mxc = fmaxf(fmaxf(S1[0], S1[1]), S1[2]), mxd = fmaxf(fmaxf(S1[3], S1[4]), S1[5]); \
            _Pragma("unroll") for (int r = 6; r < 16; r += 2) { mxa = fmaxf(mxa, S0[r]); mxb = fmaxf(mxb, S0[r + 1]); mxc = fmaxf(mxc, S1[r]); mxd = fmaxf(mxd, S1[r + 1]); } \
            float mx = fmaxf(fmaxf(mxa, mxb), fmaxf(mxc, mxd)); \
            mx = fmaxf(mx, __shfl_xor(mx, 32)); \
            if (__any(mx > 8.f) || kt_ == 0) { const float delta = kt_ == 0 ? mx : fmaxf(mx, 0.f); const float alpha = __builtin_amdgcn_exp2f(-delta); m_ref += delta; l_run *= alpha; \
                _Pragma("unroll") for (int r = 0; r < 16; ++r) { O0[r] *= alpha; O1[r] *= alpha; S0[r] -= delta; S1[r] -= delta; } } \
            float ps0 = 0.f, ps1 = 0.f, ps2 = 0.f, ps3 = 0.f; \
            _Pragma("unroll") for (int r = 0; r < 16; r += 2) { S0[r] = __builtin_amdgcn_exp2f(S0[r]); S1[r] = __builtin_amdgcn_exp2f(S1[r]); S0[r + 1] = __builtin_amdgcn_exp2f(S0[r + 1]); S1[r + 1] = __builtin_amdgcn_exp2f(S1[r + 1]); ps0 += S0[r]; ps1 += S1[r]; ps2 += S0[r + 1]; ps3 += S1[r + 1]; } \
            l_run += (ps0 + ps1) + (ps2 + ps3); \
            union { bf16x8 v; unsigned u[4]; } p00, p01, p10, p11; \
            _Pragma("unroll") for (int j = 0; j < 4; ++j) { p00.u[j] = pk2(S0[2 * j], S0[2 * j + 1]); p01.u[j] = pk2(S0[8 + 2 * j], S0[8 + 2 * j + 1]); p10.u[j] = pk2(S1[2 * j], S1[2 * j + 1]); p11.u[j] = pk2(S1[8 + 2 * j], S1[8 + 2 * j + 1]); } \
            const LAS unsigned char* vb = F.lds + bo0 + AT_KB; \
            _Pragma("unroll") for (int dvt = 0; dvt < 2; ++dvt) { const LAS unsigned char* vrow = vb + (32 * dvt + ql) * (AT_VLD * 2) + 8 * h2; union { bf16x8 v; v2u h[2]; } vf[4]; \
                _Pragma("unroll") for (int ss = 0; ss < 4; ++ss) { vf[ss].h[0] = *(const LAS v2u*)(vrow + 2 * (16 * ss)); vf[ss].h[1] = *(const LAS v2u*)(vrow + 2 * (16 * ss + 8)); } \
                __builtin_amdgcn_sched_barrier(0); \
                if (dvt == 0) { O0 = __builtin_amdgcn_mfma_f32_32x32x16_bf16(vf[0].v, p00.v, O0, 0, 0, 0); O0 = __builtin_amdgcn_mfma_f32_32x32x16_bf16(vf[1].v, p01.v, O0, 0, 0, 0); O0 = __builtin_amdgcn_mfma_f32_32x32x16_bf16(vf[2].v, p10.v, O0, 0, 0, 0); O0 = __builtin_amdgcn_mfma_f32_32x32x16_bf16(vf[3].v, p11.v, O0, 0, 0, 0); } \
                else { O1 = __builtin_amdgcn_mfma_f32_32x32x16_bf16(vf[0].v, p00.v, O1, 0, 0, 0); O1 = __builtin_amdgcn_mfma_f32_32x32x16_bf16(vf[1].v, p01.v, O1, 0, 0, 0); O1 = __builtin_amdgcn_mfma_f32_32x32x16_bf16(vf[2].v, p10.v, O1, 0, 0, 0); O1 = __builtin_amdgcn_mfma_f32_32x32x16_bf16(vf[3].v, p11.v, O1, 0, 0, 0); } \
                __builtin_amdgcn_sched_barrier(0); } \
            __syncthreads(); \
            { const int t_ = bo0; bo0 = bo1; bo1 = bo2; bo2 = t_; } } while (0)
        for (int kt = 0; kt < ntile; kt += 2) {
            AT_BODY(kt, AT_STORE, AT_LOAD);
            AT_BODY(kt + 1, AT_STOREB, AT_LOADB);
        }
#undef AT_BODY
#undef AT_LOADB
#undef AT_STOREB
#undef AT_LOAD
#undef AT_STORE
#undef AT_QK
        const float inv = 1.f / (l_run + __shfl_xor(l_run, 32));
        const int b = bh >> 2, head = bh & 3, qi = q0 + 32 * wave + ql;
        const size_t row = isctx ? (size_t)NL + b * 256 + qi : (size_t)b * 4096 + (qi - 256);
        bf16* orow = AO + row * 256 + head * 64 + 4 * h2;
#pragma unroll
        for (int g = 0; g < 4; ++g) { v2u o0, o1; o0.x = pk2(O0[4 * g] * inv, O0[4 * g + 1] * inv); o0.y = pk2(O0[4 * g + 2] * inv, O0[4 * g + 3] * inv); o1.x = pk2(O1[4 * g] * inv, O1[4 * g + 1] * inv); o1.y = pk2(O1[4 * g + 2] * inv, O1[4 * g + 3] * inv);
            *(GAS v2u*)(orow + 8 * g) = o0; *(GAS v2u*)(orow + 32 + 8 * g) = o1; }
    }
}

__device__ __forceinline__ void phase_fin_mla(Frame& F, int li) { WS_DECL; frame_refresh(F);
    const int nrows = li == DEPTH - 1 ? NL : NT; const float* g = in_ptr(I_MLAON) + li * 256; const bf16* AO = WSP(bf16, WS_AO); bf16* MIX = WSP(bf16, WS_A1);
    const int gw = blockIdx.x * NWAVES + F.wave, NGW = F.G * NWAVES; const f32x4 g4 = *(const GAS f32x4*)(g + 4 * F.lane);
    for (int m = gw; m < nrows; m += NGW) { const v2u w = *(const GAS v2u*)(AO + (size_t)m * 256 + 4 * F.lane);
        f32x4 x; x.x = bflo(w.x); x.y = bfhi(w.x); x.z = bflo(w.y); x.w = bfhi(w.y);
        const float r = __builtin_amdgcn_rsqf(wave_sum(x.x * x.x + x.y * x.y + x.z * x.z + x.w * x.w) * (1.f / 256.f) + 1e-6f);
        v2u o; o.x = pk2(x.x * r * g4.x, x.y * r * g4.y); o.y = pk2(x.z * r * g4.z, x.w * r * g4.w); *(GAS v2u*)(MIX + (size_t)m * D + 4 * F.lane) = o; }
}
__device__ __forceinline__ void phase_fin_zero(Frame& F, int li, int c0) { WS_DECL; frame_refresh(F);
    const int nrows = li == DEPTH - 1 ? NL : NT; bf16* MIX = WSP(bf16, WS_A1); const int gw = blockIdx.x * NWAVES + F.wave, NGW = F.G * NWAVES;
    for (int m = gw; m < nrows; m += NGW) *(GAS v2u*)(MIX + (size_t)m * D + c0 + 4 * F.lane) = (v2u){0u, 0u};
}

__device__ __forceinline__ void phase_pro0b(Frame& F) { WS_DECL; frame_refresh(F);
    const int gt = blockIdx.x * NTHR + F.tid, NGT = F.G * NTHR;
    float* RC = WSP(float, WS_ROPE); float* RS = RC + 4096 * 16;
    for (int i = gt; i < 4096 * 16; i += NGT) { const int t = i >> 4, j = i & 15; const float inv = powf(10000.f, -(float)(j & 7) / 8.f); const float pos = j < 8 ? (float)(t >> 6) : (float)(t & 63);
        const float ang = pos * inv; RC[i] = cosf(ang); RS[i] = sinf(ang); }
    const float* wuq = in_ptr(I_WUQ); const float* wukv = in_ptr(I_WUKV); bf16* WQ = WSP(bf16, WS_WUQT); bf16* WKV = WSP(bf16, WS_WUKVT);
    for (int i = gt; i < DEPTH * 384 * 192; i += NGT) { const int li = i / (384 * 192), r = i % (384 * 192), n = r / 192, k = r % 192; WQ[i] = (bf16)f2bf(wuq[(size_t)li * 192 * 384 + (size_t)k * 384 + n]); }
    for (int i = gt; i < DEPTH * 512 * 128; i += NGT) { const int li = i / (512 * 128), r = i % (512 * 128), n = r / 128, k = r % 128; WKV[i] = (bf16)f2bf(wukv[(size_t)li * 128 * 512 + (size_t)k * 512 + n]); }
}

constexpr int LR_LD = 264;
__device__ __forceinline__ float gelu_tanh(float x) { const float u = 0.7978845608028654f * (x + 0.044715f * x * x * x); const float e = __expf(2.f * u); const float t = 1.f - 2.f / (e + 1.f); return 0.5f * x * (1.f + t); }
template <int PASS>
__device__ __forceinline__ void phase_lru(Frame& F, int li) { WS_DECL; frame_refresh(F);
    LAS bf16* RAW = (LAS bf16*)F.lds; LAS bf16* U = (LAS bf16*)(F.lds + 67 * LR_LD * 2); LAS bf16* HS = (LAS bf16*)(F.lds + 71680);
    const bf16* P = WSP(bf16, WS_P); bf16* MIX = WSP(bf16, WS_A1); f32x2* SUMM = WSP(f32x2, WS_SUMM);
    const float* cw = in_ptr(I_LCW) + li * 4 * 256; const float* cb = in_ptr(I_LCB) + li * 256;
    const float* lam_ = in_ptr(I_LLAM) + li * 512; const float* br_ = in_ptr(I_LBR) + li * 512; const float* bi_ = in_ptr(I_LBI) + li * 512; const float* on_ = in_ptr(I_LON) + li * 256;
    const bf16* LW = WSP(bf16, WS_LRUW) + (size_t)li * 16 * 4096;
    const int lane = F.lane, wave = F.wave, tid = F.tid, fr = lane & 15, kg = lane >> 4;
    const int nitems = (PASS == 3 && li == DEPTH - 1) ? NL / 64 : NT / 64;
    for (int item = blockIdx.x; item < nitems; item += F.G) {
        const int m0 = item * 64; const bool isctx = m0 >= NL; const int b = isctx ? (m0 - NL) >> 8 : m0 >> 12; const int t0 = isctx ? (m0 - NL) & 255 : m0 & 4095; const int Ls = isctx ? 256 : 4096;
        const size_t seg0 = isctx ? (size_t)NL + b * 256 : (size_t)b * 4096;
        for (int c = tid; c < 67 * 32; c += NTHR) { const int r = c >> 5, cc = c & 31, t = t0 - 2 + r; v4u v = (v4u){0u, 0u, 0u, 0u};
            if (t >= 0 && t < Ls) v = *(const GAS v4u*)(P + (seg0 + t) * PCOLS + 352 + 8 * cc);
            *(LAS v4u*)(RAW + r * LR_LD + 8 * cc) = v; }
        __syncthreads();
        { const int c2 = tid & 127, tq = tid >> 7; const int ch = 2 * c2;
          float w0[4], w1[4];
#pragma unroll
          for (int j = 0; j < 4; ++j) { w0[j] = cw[j * 256 + ch]; w1[j] = cw[j * 256 + ch + 1]; }
          const float b0 = cb[ch], b1 = cb[ch + 1];
          for (int t = tq * 16; t < tq * 16 + 16; ++t) { float s0 = b0, s1 = b1;
#pragma unroll
              for (int j = 0; j < 4; ++j) { const unsigned w = *(const LAS unsigned*)(RAW + (t + j) * LR_LD + ch); s0 += w0[j] * bflo(w); s1 += w1[j] * bfhi(w); }
              *(LAS unsigned*)(U + t * LR_LD + ch) = pk2(s0, s1); } }
        __syncthreads();
#pragma unroll 1
        for (int ni = 0; ni < 2; ++ni) {
            float yv[4][4];
            const int nt = 2 * wave + ni, nb = nt >> 2, ch = 16 * nt + fr;
            bf16x8 wfr[2][2][2]; float spc[2], brc[2], bic[2];
#pragma unroll
            for (int d = 0; d < 2; ++d) { spc[d] = lam_[d * 256 + ch]; brc[d] = br_[d * 256 + ch]; bic[d] = bi_[d * 256 + ch];
#pragma unroll
                for (int g = 0; g < 2; ++g)
#pragma unroll
                    for (int ks = 0; ks < 2; ++ks) wfr[d][g][ks] = *(const GAS bf16x8*)(LW + ((size_t)((g * 2 + d) * 4 + nb) * 64 + 16 * (nt & 3) + fr) * 64 + 32 * ks + 8 * kg); }
            float uu[4][4];
#pragma unroll
            for (int m = 0; m < 4; ++m)
#pragma unroll
                for (int r = 0; r < 4; ++r) uu[m][r] = bf2f(U[(16 * m + 4 * kg + r) * LR_LD + ch]);
#pragma unroll
            for (int d = 0; d < 2; ++d) {
                f32x4 ar[4], ai[4];
#pragma unroll
                for (int m = 0; m < 4; ++m) { ar[m] = (f32x4){0.f, 0.f, 0.f, 0.f}; ai[m] = (f32x4){0.f, 0.f, 0.f, 0.f}; }
#pragma unroll
                for (int ks = 0; ks < 2; ++ks) {
                    const bf16x8 wr = wfr[d][0][ks], wi = wfr[d][1][ks];
#pragma unroll
                    for (int m = 0; m < 4; ++m) { const bf16x8 xf = *(const LAS bf16x8*)(U + (16 * m + fr) * LR_LD + 64 * nb + 32 * ks + 8 * kg);
                        ar[m] = __builtin_amdgcn_mfma_f32_16x16x32_bf16(xf, wr, ar[m], 0, 0, 0); ai[m] = __builtin_amdgcn_mfma_f32_16x16x32_bf16(xf, wi, ai[m], 0, 0, 0); } }
                const float sp = __logf(1.f + __expf(-spc[d])), brv = brc[d], biv = bic[d];
#pragma unroll
                for (int m = 0; m < 4; ++m)
#pragma unroll
                    for (int r = 0; r < 4; ++r) { const float rg = __builtin_amdgcn_rcpf(1.f + __expf(-(ar[m][r] + brv))), ig = __builtin_amdgcn_rcpf(1.f + __expf(-(ai[m][r] + biv))); const float av = __expf(-8.f * rg * sp);
                        ar[m][r] = av; ai[m][r] = __builtin_amdgcn_sqrtf(fmaxf(1.f - av * av, 0.f)) * (ig * uu[m][r]); }
                float H = 0.f;
                if (PASS == 3) {
                    const int cj = t0 >> 6, cbase = 1024 + b * 4, lbase = b * 64;
                    const int np = d == 0 ? (isctx ? cj : 4 + cj) : (isctx ? 3 - cj : 4 + 63 - cj);
                    const int q = (np + 3) >> 2, p_lo = kg * q, p_hi = (p_lo + q < np) ? p_lo + q : np;
                    float Aq = 1.f, Bq = 0.f;
                    for (int p0 = p_lo; p0 < p_hi; p0 += 8) { f32x2 sv[8];
#pragma unroll
                        for (int e = 0; e < 8; ++e) { const int p = p0 + e; sv[e] = (f32x2){1.f, 0.f};
                            if (p < p_hi) { int cid; if (d == 0) cid = isctx ? cbase + p : (p < 4 ? cbase + p : lbase + (p - 4)); else cid = isctx ? cbase + 3 - p : (p < 4 ? cbase + 3 - p : lbase + 63 - (p - 4));
                                sv[e] = *(const GAS f32x2*)(SUMM + ((size_t)cid * 2 + d) * 256 + ch); } }
#pragma unroll
                        for (int e = 0; e < 8; ++e) { Bq = sv[e].x * Bq + sv[e].y; Aq = sv[e].x * Aq; } }
#pragma unroll
                    for (int g = 0; g < 4; ++g) { const float Ag_ = __shfl(Aq, fr + 16 * g), Bg_ = __shfl(Bq, fr + 16 * g); H = Ag_ * H + Bg_; }
                }
                float Ac = 1.f, Bc = 0.f;
#pragma unroll
                for (int mi = 0; mi < 4; ++mi) { const int m = d == 0 ? mi : 3 - mi;
                    float Al, Bl;
                    if (d == 0) { Al = ar[m][0] * ar[m][1] * ar[m][2] * ar[m][3]; Bl = ((ai[m][0] * ar[m][1] + ai[m][1]) * ar[m][2] + ai[m][2]) * ar[m][3] + ai[m][3]; }
                    else { Al = ar[m][0] * ar[m][1] * ar[m][2] * ar[m][3]; Bl = ((ai[m][3] * ar[m][2] + ai[m][2]) * ar[m][1] + ai[m][1]) * ar[m][0] + ai[m][0]; }
                    float Ag[4], Bg[4];
#pragma unroll
                    for (int g = 0; g < 4; ++g) { Ag[g] = __shfl(Al, fr + 16 * g); Bg[g] = __shfl(Bl, fr + 16 * g); }
                    if (PASS == 1) {
                        float At = 1.f, Bt = 0.f;
#pragma unroll
                        for (int gi = 0; gi < 4; ++gi) { const int g = d == 0 ? gi : 3 - gi; Bt = Ag[g] * Bt + Bg[g]; At = Ag[g] * At; }
                        Bc = At * Bc + Bt; Ac = At * Ac;
                    } else {
                        float s = H, sin_ = H;
#pragma unroll
                        for (int gi = 0; gi < 4; ++gi) { const int g = d == 0 ? gi : 3 - gi; if (g == kg) sin_ = s; s = Ag[g] * s + Bg[g]; }
                        H = s;
                        float x = sin_;
#pragma unroll
                        for (int ri = 0; ri < 4; ++ri) { const int r = d == 0 ? ri : 3 - ri; x = ar[m][r] * x + ai[m][r]; if (d == 0) yv[m][r] = x; else yv[m][r] += x; }
                    }
                }
                if (PASS == 1 && kg == 0) *(GAS f32x2*)(SUMM + ((size_t)item * 2 + d) * 256 + ch) = (f32x2){Ac, Bc};
            }
            if (PASS == 3) {
#pragma unroll
                for (int m = 0; m < 4; ++m)
#pragma unroll
                    for (int r = 0; r < 4; ++r) HS[(16 * m + 4 * kg + r) * LR_LD + ch] = (bf16)f2bf(yv[m][r]);
            }
        }
        if (PASS == 3) {
            __syncthreads();
            const f32x4 on4 = *(const GAS f32x4*)(on_ + 4 * lane);
            for (int i = 0; i < 8; ++i) { const int tl = wave * 8 + i; const v2u hw = *(const LAS v2u*)(HS + tl * LR_LD + 4 * lane); const v2u gw = *(const GAS v2u*)(P + (size_t)(m0 + tl) * PCOLS + 608 + 4 * lane);
                f32x4 y; y.x = bflo(hw.x) * gelu_tanh(bflo(gw.x)); y.y = bfhi(hw.x) * gelu_tanh(bfhi(gw.x)); y.z = bflo(hw.y) * gelu_tanh(bflo(gw.y)); y.w = bfhi(hw.y) * gelu_tanh(bfhi(gw.y));
                const float rs = __builtin_amdgcn_rsqf(wave_sum(y.x * y.x + y.y * y.y + y.z * y.z + y.w * y.w) * (1.f / 256.f) + 1e-6f);
                v2u o; o.x = pk2(y.x * rs * on4.x, y.y * rs * on4.y); o.y = pk2(y.z * rs * on4.z, y.w * rs * on4.w);
                *(GAS v2u*)(MIX + (size_t)(m0 + tl) * D + 256 + 4 * lane) = o; }
        }
        __syncthreads();
    }
}

__device__ __forceinline__ void phase_pro0c(Frame& F) { WS_DECL; frame_refresh(F);
    const int gt = blockIdx.x * NTHR + F.tid, NGT = F.G * NTHR; const float* wr = in_ptr(I_LWR); const float* wi = in_ptr(I_LWI); bf16* LW = WSP(bf16, WS_LRUW);
    for (int i = gt; i < DEPTH * 16 * 4096; i += NGT) { const int c = i & 63, dd = (i >> 6) & 63, nb = (i >> 12) & 3, d = (i >> 14) & 1, g = (i >> 15) & 1, li = i >> 16;
        const float* src = g == 0 ? wr : wi; LW[i] = (bf16)f2bf(src[((((size_t)li * 2 + d) * 4 + nb) * 64 + c) * 64 + dd]); }
}

template <int CTRL> __device__ __forceinline__ float dpp_f(float x) { return __builtin_bit_cast(float, __builtin_amdgcn_mov_dpp(__builtin_bit_cast(int, x), CTRL, 0xf, 0xf, true)); }
__device__ __forceinline__ float rowsum16(float x) { x += dpp_f<0x128>(x); x += dpp_f<0x124>(x); x += dpp_f<0x122>(x); x += dpp_f<0x121>(x); return x; }
constexpr int RW_C0 = 864;
constexpr size_t WS_RWUP = WS_LRUW + 512 * 1024;
constexpr size_t WS_EA = WS_Y;

__device__ __forceinline__ void phase_pro0e(Frame& F) { WS_DECL; frame_refresh(F);
    const int gt = blockIdx.x * NTHR + F.tid, NGT = F.G * NTHR; const float* wup = in_ptr(I_WUP); const float* aup = in_ptr(I_AUP); bf16* W = WSP(bf16, WS_RWUP);
    for (int i = gt; i < DEPTH * 2 * 2 * 256 * 32; i += NGT) { const int k = i & 31, n = (i >> 5) & 255, wa = (i >> 13) & 1, d = (i >> 14) & 1, li = i >> 15;
        const float* src = wa == 0 ? wup : aup; W[i] = (bf16)f2bf(src[(((size_t)li * 2 + d) * 32 + k) * 256 + n]); }
}

constexpr int R0_LD = 136, R0_ZLD = 72;
__device__ __forceinline__ void phase_rwkv_r0(Frame& F, int li) { WS_DECL; frame_refresh(F);
    LAS bf16* RAWL = (LAS bf16*)F.lds;
    LAS bf16* ZW = (LAS bf16*)(F.lds + 66 * R0_LD * 2);
    LAS bf16* ZA = ZW + 64 * R0_ZLD;
    const bf16* P = WSP(bf16, WS_P); bf16* EA = WSP(bf16, WS_EA); const bf16* W = WSP(bf16, WS_RWUP) + (size_t)li * 2 * 2 * 256 * 32;
    const float* mup = in_ptr(I_MUP) + li * 960 + 768; const float* mun = in_ptr(I_MUN) + li * 960 + 768; const float* w0 = in_ptr(I_W0) + li * 512; const float* a0 = in_ptr(I_A0) + li * 512;
    const int tid = F.tid, lane = F.lane, wave = F.wave, fr = lane & 15, kg = lane >> 4;
    for (int item = blockIdx.x; item < NT / 64; item += F.G) {
        const int m0 = item * 64; const bool isctx = m0 >= NL; const int t0 = isctx ? (m0 - NL) & 255 : m0 & 4095; const int Ls = isctx ? 256 : 4096; const size_t seg0 = (size_t)m0 - t0;
        __syncthreads();
        for (int c = tid; c < 66 * 16; c += NTHR) { const int r = c >> 4, cc = c & 15, t = t0 - 1 + r; v4u v = (v4u){0u, 0u, 0u, 0u};
            if (t >= 0 && t < Ls) v = *(const GAS v4u*)(P + (seg0 + t) * PCOLS + RW_C0 + 768 + 8 * cc);
            *(LAS v4u*)(RAWL + r * R0_LD + 8 * cc) = v; }
        __syncthreads();
        { const int c = tid & 127, tq = tid >> 7; const float mp = mup[c], mn = mun[c];
          for (int tl = tq * 16; tl < tq * 16 + 16; ++tl) { const float x = bf2f(RAWL[(tl + 1) * R0_LD + c]), xp = bf2f(RAWL[tl * R0_LD + c]), xn = bf2f(RAWL[(tl + 2) * R0_LD + c]);
              const float z = x + mp * (xp - x) + mn * (xn - x);
              if (c < 64) { const float e2 = __expf(2.f * z); ZW[tl * R0_ZLD + c] = (bf16)f2bf(1.f - 2.f * __builtin_amdgcn_rcpf(e2 + 1.f)); } else ZA[tl * R0_ZLD + (c - 64)] = (bf16)f2bf(z); } }
        __syncthreads();
        const int d = wave >> 2, hh = wave & 3;
#pragma unroll 1
        for (int nt = 0; nt < 4; ++nt) { const int ch0 = 64 * hh + 16 * nt;
            const bf16x8 wf = *(const GAS bf16x8*)(W + ((size_t)(d * 2 + 0) * 256 + ch0 + fr) * 32 + 8 * kg), af = *(const GAS bf16x8*)(W + ((size_t)(d * 2 + 1) * 256 + ch0 + fr) * 32 + 8 * kg);
            const f32x4 w04 = *(const GAS f32x4*)(w0 + d * 256 + ch0 + 4 * kg), a04 = *(const GAS f32x4*)(a0 + d * 256 + ch0 + 4 * kg);
#pragma unroll
            for (int m = 0; m < 4; ++m) { const bf16x8 zw = *(const LAS bf16x8*)(ZW + (16 * m + fr) * R0_ZLD + 32 * d + 8 * kg), za = *(const LAS bf16x8*)(ZA + (16 * m + fr) * R0_ZLD + 32 * d + 8 * kg);
                f32x4 xw = __builtin_amdgcn_mfma_f32_16x16x32_bf16(wf, zw, (f32x4){0.f, 0.f, 0.f, 0.f}, 0, 0, 0), xa = __builtin_amdgcn_mfma_f32_16x16x32_bf16(af, za, (f32x4){0.f, 0.f, 0.f, 0.f}, 0, 0, 0);
                xw = xw + w04; xa = xa + a04; float e[4], av[4];
#pragma unroll
                for (int r = 0; r < 4; ++r) { e[r] = -0.6065306597126334f * __builtin_amdgcn_rcpf(1.f + __expf(-xw[r])); av[r] = __builtin_amdgcn_rcpf(1.f + __expf(-xa[r])); }
                const size_t tok = (size_t)m0 + 16 * m + fr; v2u oe, oa; oe.x = pk2(e[0], e[1]); oe.y = pk2(e[2], e[3]); oa.x = pk2(av[0], av[1]); oa.y = pk2(av[2], av[3]);
                *(GAS v2u*)(EA + (tok * 4 + d) * 256 + ch0 + 4 * kg) = oe; *(GAS v2u*)(EA + (tok * 4 + 2 + d) * 256 + ch0 + 4 * kg) = oa; } }
    }
    __syncthreads();
}

constexpr int RW_T = 16, RW_NCH = (LCX + SEQ) / RW_T, RW_ROWS = RW_T + 2, RW_LD = 200, RW_P = 72;
constexpr int RW_RAW = 0, RW_RAWB = RW_ROWS * RW_LD * 2;
constexpr int RW_EAB = RW_RAW + 2 * RW_RAWB, RW_EABB = RW_T * 128 * 2;
constexpr int RW_VEC = RW_EAB + 2 * RW_EABB, RW_VECB = RW_T * 4 * 64 * 2 + RW_T * 64 * 4;
constexpr int RW_VV = RW_VEC + 2 * RW_VECB;
constexpr int RW_BON = RW_VV + 8 * 1024;
constexpr int RW_ARA = RW_BON + 8 * 64;
constexpr int RW_KB2 = RW_ARA + 2 * 16 * RW_P * 2;
constexpr int RW_AT2 = RW_KB2 + 2 * 32 * RW_P * 2;
constexpr int RW_ARR = RW_AT2 + 4 * 2048;
constexpr int RW_KT = RW_ARR + 4 * 16 * RW_P * 2;
constexpr int RW_BTN = RW_KT + 4 * 2048;
constexpr int RW_CWT = RW_BTN + 4 * 2048;
constexpr int RW_DO = RW_CWT + 4 * 256;
constexpr int RW_DOB = 16 * RW_P * 2 + 3 * 512;
constexpr int RW_BC = RW_DO + 4 * RW_DOB;
constexpr int RW_END = RW_BC + 9 * 256;
static_assert(RW_END <= RING_BYTES, "rwkv lds map");
typedef LAS bf16* lbf;
__device__ __forceinline__ bf16x8 rw_zero8() { return (bf16x8){0, 0, 0, 0, 0, 0, 0, 0}; }
__device__ __forceinline__ bf16x8 rw_k16(const LAS bf16* rowp, int kg) { bf16x8 r = rw_zero8(); if (kg < 2) r = *(const LAS bf16x8*)(rowp + 8 * kg); return r; }
__device__ __forceinline__ bf16x8 rw_perm4(const LAS bf16* rowp, int kg) { union { bf16x8 v; v2u h[2]; } u; u.h[0] = *(const LAS v2u*)(rowp + 4 * kg); u.h[1] = (v2u){0u, 0u}; return u.v; }
__device__ __forceinline__ bf16x8 rw_permK(const LAS bf16* rowp, int kg, int sp) { union { bf16x8 v; v2u h[2]; } u; u.h[0] = *(const LAS v2u*)(rowp + 32 * sp + 4 * kg); u.h[1] = *(const LAS v2u*)(rowp + 32 * sp + 16 + 4 * kg); return u.v; }
__device__ __forceinline__ bf16x8 rw_c4(f32x4 c) { union { bf16x8 v; unsigned u[4]; } x; x.u[0] = pk2(c[0], c[1]); x.u[1] = pk2(c[2], c[3]); x.u[2] = 0u; x.u[3] = 0u; return x.v; }
__device__ __forceinline__ bf16x8 rw_c8(f32x4 c0, f32x4 c1) { union { bf16x8 v; unsigned u[4]; } x; x.u[0] = pk2(c0[0], c0[1]); x.u[1] = pk2(c0[2], c0[3]); x.u[2] = pk2(c1[0], c1[1]); x.u[3] = pk2(c1[2], c1[3]); return x.v; }
__device__ __forceinline__ void rw_st_rows(lbf M, f32x4 c, int fr, int kg) {
#pragma unroll
    for (int r = 0; r < 4; ++r) M[(4 * kg + r) * 16 + fr] = (bf16)f2bf(c[r]); }
__device__ __forceinline__ void rw_st_cols(lbf M, f32x4 c, int fr, int kg, int pitch) {
    v2u o; o.x = pk2(c[0], c[1]); o.y = pk2(c[2], c[3]); *(LAS v2u*)(M + fr * pitch + 4 * kg) = o; }
#define RW_MFMA(a, b, c) __builtin_amdgcn_mfma_f32_16x16x32_bf16(a, b, c, 0, 0, 0)

__device__ __forceinline__ void phase_rwkv_scan(Frame& F, int li) { WS_DECL; frame_refresh(F);
    const bf16* P = WSP(bf16, WS_P); const bf16* EA = WSP(bf16, WS_EA); float* YR = WSP(float, WS_YR); float* BON = WSP(float, WS_BON);
    const bf16* zsrc = (const bf16*)(ws + WS_CTL + 65536);
    const int tid = F.tid, lane = F.lane, wave = F.wave, fr = lane & 15, kg = lane >> 4;
    LAS unsigned char* L = F.lds;
    for (int item = blockIdx.x; item < 256; item += F.G) {
        const int vhalf = item & 1, d = (item >> 1) & 1, h = (item >> 2) & 3, b = item >> 4;
        __syncthreads();
        const int pt = (tid - 128) & 255, ps = pt >> 4, pq = pt & 15;
        const int sk = pt & 63, sq = pt >> 6;
        { LAS float* BC = (LAS float*)(L + RW_BC); const float* mup = in_ptr(I_MUP) + li * 960; const float* mun = in_ptr(I_MUN) + li * 960;
          if (tid < 64) { const int c = 64 * h + tid; BC[tid] = mup[c]; BC[64 + tid] = mup[256 + c]; BC[128 + tid] = mup[512 + c]; BC[192 + tid] = mun[c]; BC[256 + tid] = mun[256 + c]; BC[320 + tid] = mun[512 + c];
              BC[384 + tid] = in_ptr(I_KK)[li * 256 + c]; BC[448 + tid] = in_ptr(I_KA)[li * 256 + c]; BC[512 + tid] = in_ptr(I_RK)[li * 256 + c]; } }
        __syncthreads();
        f32x4 S0 = (f32x4){0.f, 0.f, 0.f, 0.f}, S1 = S0, S2 = S0, S3 = S0;
        v4u ra[11];
#pragma unroll
        for (int q = 0; q < 11; ++q) ra[q] = (v4u){0u, 0u, 0u, 0u};
        if (wave < 2) {
#pragma unroll 1
            for (int it = -8; it <= RW_NCH; ++it) {
                if (it >= 0 && it < RW_NCH) {
                    const lbf VV = (lbf)(L + RW_VV + (it & 7) * 1024), ARR = (lbf)(L + RW_ARR + (it & 3) * (16 * RW_P * 2)), KT = (lbf)(L + RW_KT + (it & 3) * 2048), BTN = (lbf)(L + RW_BTN + (it & 3) * 2048);
                    const LAS float* CWT = (const LAS float*)(L + RW_CWT + (it & 3) * 256);
                    const lbf APT = (lbf)(L + RW_DO + (it & 3) * RW_DOB), AMT = APT + 16 * RW_P, ARKT = AMT + 256, ARBTN = ARKT + 256;
                    const f32x4 Z = (f32x4){0.f, 0.f, 0.f, 0.f};
                    const bf16x8 bvv = rw_k16(VV + (16 * wave + fr) * 16, kg);
                    const bf16x8 sb0 = rw_c8(S0, S1), sb1 = rw_c8(S2, S3);
                    f32x4 UT = RW_MFMA(rw_k16(AMT + fr * 16, kg), bvv, Z);
                    UT = RW_MFMA(rw_permK(APT + fr * RW_P, kg, 0), sb0, UT); UT = RW_MFMA(rw_permK(APT + fr * RW_P, kg, 1), sb1, UT);
                    f32x4 YT = RW_MFMA(rw_k16(ARKT + fr * 16, kg), bvv, Z);
                    YT = RW_MFMA(rw_permK(ARR + fr * RW_P, kg, 0), sb0, YT); YT = RW_MFMA(rw_permK(ARR + fr * RW_P, kg, 1), sb1, YT);
                    const bf16x8 ub = rw_c4(UT);
                    YT = RW_MFMA(rw_perm4(ARBTN + fr * 16, kg), ub, YT);
                    { const bool isctx = it < LCX / RW_T;
                      if (!isctx || li < DEPTH - 1) { const int cl = isctx ? it : it - LCX / RW_T; const int Ls = isctx ? LCX : SEQ; const int tlo = d == 0 ? cl * RW_T : Ls - RW_T - cl * RW_T; const size_t seg0 = isctx ? (size_t)NL + b * LCX : (size_t)b * SEQ;
#pragma unroll
                          for (int r = 0; r < 4; ++r) { const int sidx = 4 * kg + r; const int t = d == 0 ? tlo + sidx : tlo + RW_T - 1 - sidx;
                              YR[((size_t)d * NT + seg0 + t) * 256 + 64 * h + 32 * vhalf + 16 * wave + fr] = YT[r]; }
                          if (vhalf == 0 && wave == 0 && lane < RW_T) { const LAS float* BONS = (const LAS float*)(L + RW_BON) + (it & 7) * RW_T; const int t = d == 0 ? tlo + lane : tlo + RW_T - 1 - lane;
                              BON[((size_t)d * NT + seg0 + t) * 4 + h] = BONS[lane]; } } }
                    { f32x4 q = RW_MFMA(rw_k16(KT + (0 + fr) * 16, kg), bvv, S0); q = RW_MFMA(rw_perm4(BTN + (0 + fr) * 16, kg), ub, q); S0 = q * *(const LAS f32x4*)(CWT + 0 + 4 * kg); }
                    { f32x4 q = RW_MFMA(rw_k16(KT + (16 + fr) * 16, kg), bvv, S1); q = RW_MFMA(rw_perm4(BTN + (16 + fr) * 16, kg), ub, q); S1 = q * *(const LAS f32x4*)(CWT + 16 + 4 * kg); }
                    { f32x4 q = RW_MFMA(rw_k16(KT + (32 + fr) * 16, kg), bvv, S2); q = RW_MFMA(rw_perm4(BTN + (32 + fr) * 16, kg), ub, q); S2 = q * *(const LAS f32x4*)(CWT + 32 + 4 * kg); }
                    { f32x4 q = RW_MFMA(rw_k16(KT + (48 + fr) * 16, kg), bvv, S3); q = RW_MFMA(rw_perm4(BTN + (48 + fr) * 16, kg), ub, q); S3 = q * *(const LAS f32x4*)(CWT + 48 + 4 * kg); }
                }
                __syncthreads();
            }
        } else if (wave < 6) {
#pragma unroll 1
            for (int it = -8; it <= RW_NCH; ++it) {
                { const int ca = it + 5;
                  if (ca >= 0 && ca < RW_NCH && ((ca & 3) == wave - 2)) { LAS bf16* RAWW = (LAS bf16*)(L + RW_RAW + (ca & 1) * RW_RAWB); LAS bf16* EAW = (LAS bf16*)(L + RW_EAB + (ca & 1) * RW_EABB);
#pragma unroll
                      for (int q = 0; q < 11; ++q) { const int c = lane + 64 * q;
                          if (c < RW_ROWS * 24) *(LAS v4u*)(RAWW + (c / 24) * RW_LD + 8 * (c % 24)) = ra[q];
                          else if (c < RW_ROWS * 24 + RW_T * 16) { const int e = c - RW_ROWS * 24; *(LAS v4u*)(EAW + 8 * e) = ra[q]; } } }
                  const int cn = it + 8;
                  if (cn < RW_NCH && ((cn & 3) == wave - 2)) { const bool isctx = cn < LCX / RW_T; const int cl = isctx ? cn : cn - LCX / RW_T; const int Ls = isctx ? LCX : SEQ; const int tlo = d == 0 ? cl * RW_T : Ls - RW_T - cl * RW_T;
                      const size_t seg0 = isctx ? (size_t)NL + b * LCX : (size_t)b * SEQ;
#pragma unroll
                      for (int q = 0; q < 11; ++q) { const int c = lane + 64 * q; const bf16* src = zsrc;
                          if (c < RW_ROWS * 24) { const int r = c / 24, cc = c % 24, t = tlo - 1 + r; const int col = 256 * (cc >> 3) + 64 * h + 8 * (cc & 7);
                              if (t >= 0 && t < Ls) src = P + (seg0 + t) * PCOLS + RW_C0 + col; }
                          else if (c < RW_ROWS * 24 + RW_T * 16) { const int e = c - RW_ROWS * 24, s = e >> 4, cc = e & 15; const int t = d == 0 ? tlo + s : tlo + RW_T - 1 - s;
                              src = EA + ((seg0 + t) * 4 + (cc >> 3) * 2 + d) * 256 + 64 * h + 8 * (cc & 7); }
                          ra[q] = *(const GAS v4u*)src; } } }
                const int cb = it + 4;
                if (cb >= 0 && cb < RW_NCH) {
                    const LAS bf16* RAW = (const LAS bf16*)(L + RW_RAW + (cb & 1) * RW_RAWB); const LAS bf16* EAB = (const LAS bf16*)(L + RW_EAB + (cb & 1) * RW_EABB);
                    const lbf VEC = (lbf)(L + RW_VEC + (cb & 1) * RW_VECB); LAS float* LWF = (LAS float*)(L + RW_VEC + (cb & 1) * RW_VECB + RW_T * 4 * 64 * 2);
                    const lbf VV = (lbf)(L + RW_VV + (cb & 7) * 1024); LAS float* BONS = (LAS float*)(L + RW_BON) + (cb & 7) * RW_T;
                    const int prow = d == 0 ? ps + 1 : RW_T - ps;
                    const LAS float* BC = (const LAS float*)(L + RW_BC) + 4 * pq;
                    const f32x4 mpr = *(const LAS f32x4*)(BC), mpk = *(const LAS f32x4*)(BC + 64), mpv = *(const LAS f32x4*)(BC + 128), mnr = *(const LAS f32x4*)(BC + 192), mnk = *(const LAS f32x4*)(BC + 256), mnv = *(const LAS f32x4*)(BC + 320);
                    const f32x4 kk_c = *(const LAS f32x4*)(BC + 384), ka_c = *(const LAS f32x4*)(BC + 448), rk_c = *(const LAS f32x4*)(BC + 512);
                    f32x4 zr, zk, zv;
                    { const LAS bf16* r0 = RAW + prow * RW_LD + 4 * pq;
#define RW_LD4(p) ({ const v2u w_ = *(const LAS v2u*)(p); (f32x4){bflo(w_.x), bfhi(w_.x), bflo(w_.y), bfhi(w_.y)}; })
                      { const f32x4 x = RW_LD4(r0), xp = RW_LD4(r0 - RW_LD), xn = RW_LD4(r0 + RW_LD); zr = x + mpr * (xp - x) + mnr * (xn - x); }
                      { const f32x4 x = RW_LD4(r0 + 64), xp = RW_LD4(r0 + 64 - RW_LD), xn = RW_LD4(r0 + 64 + RW_LD); zk = x + mpk * (xp - x) + mnk * (xn - x); }
                      { const f32x4 x = RW_LD4(r0 + 128), xp = RW_LD4(r0 + 128 - RW_LD), xn = RW_LD4(r0 + 128 + RW_LD); zv = x + mpv * (xp - x) + mnv * (xn - x); } }
                    const f32x4 lw4 = RW_LD4(EAB + ps * 128 + 4 * pq), a4 = RW_LD4(EAB + ps * 128 + 64 + 4 * pq);
                    const f32x4 kkr = zk * kk_c; const float ss = rowsum16((kkr.x * kkr.x + kkr.y * kkr.y) + (kkr.z * kkr.z + kkr.w * kkr.w));
                    const f32x4 kd = zk * ((a4 - 1.f) * ka_c + 1.f); const f32x4 bq = zr * kd * rk_c; const float bn = rowsum16((bq.x + bq.y) + (bq.z + bq.w));
                    const f32x4 kkn = kkr * __builtin_amdgcn_rsqf(fmaxf(ss, 1e-24f)), kka = kkn * a4;
                    { v2u o; lbf vp = VEC + ps * 256 + 4 * pq;
                      o.x = pk2(kkn.x, kkn.y); o.y = pk2(kkn.z, kkn.w); *(LAS v2u*)(vp) = o; o.x = pk2(kka.x, kka.y); o.y = pk2(kka.z, kka.w); *(LAS v2u*)(vp + 64) = o;
                      o.x = pk2(kd.x, kd.y); o.y = pk2(kd.z, kd.w); *(LAS v2u*)(vp + 128) = o; o.x = pk2(zr.x, zr.y); o.y = pk2(zr.z, zr.w); *(LAS v2u*)(vp + 192) = o; }
                    *(LAS f32x4*)(LWF + ps * 64 + 4 * pq) = lw4;
                    if ((pq >> 3) == vhalf) { const int v0 = 4 * (pq & 7); VV[(v0 + 0) * 16 + ps] = (bf16)f2bf(zv.x); VV[(v0 + 1) * 16 + ps] = (bf16)f2bf(zv.y); VV[(v0 + 2) * 16 + ps] = (bf16)f2bf(zv.z); VV[(v0 + 3) * 16 + ps] = (bf16)f2bf(zv.w); }
                    if (pq == 0) BONS[ps] = bn;
                }
                const int cc3 = it + 3;
                if (cc3 >= 0 && cc3 < RW_NCH) {
                    const LAS bf16* VEC = (const LAS bf16*)(L + RW_VEC + (cc3 & 1) * RW_VECB); const LAS float* LWF = (const LAS float*)(L + RW_VEC + (cc3 & 1) * RW_VECB + RW_T * 4 * 64 * 2);
                    const lbf ARA = (lbf)(L + RW_ARA + (cc3 & 1) * (16 * RW_P * 2)), KB2 = (lbf)(L + RW_KB2 + (cc3 & 1) * (32 * RW_P * 2)), AT2 = (lbf)(L + RW_AT2 + (cc3 & 3) * 2048);
                    const lbf ARR = (lbf)(L + RW_ARR + (cc3 & 3) * (16 * RW_P * 2)), KT = (lbf)(L + RW_KT + (cc3 & 3) * 2048), BTN = (lbf)(L + RW_BTN + (cc3 & 3) * 2048); LAS float* CWT = (LAS float*)(L + RW_CWT + (cc3 & 3) * 256);
                    float cl = 0.f;
                    for (int s = 0; s < 4 * sq; ++s) cl += LWF[s * 64 + sk];
                    float cwm = __expf(cl);
#pragma unroll
                    for (int j = 0; j < 4; ++j) { const int s = 4 * sq + j; cl += LWF[s * 64 + sk]; const float cw = __expf(cl), icw = __builtin_amdgcn_rcpf(cw);
                        const float kkv = bf2f(VEC[s * 256 + sk]), kkav = bf2f(VEC[s * 256 + 64 + sk]), kdv = bf2f(VEC[s * 256 + 128 + sk]), rv = bf2f(VEC[s * 256 + 192 + sk]);
                        const bf16 at = (bf16)f2bf(kkv * cwm), rt = (bf16)f2bf(rv * cw), kt = (bf16)f2bf(kdv * icw), btv = (bf16)f2bf(kkav * icw), btn = (bf16)f2bf(-kkav * icw);
                        ARA[s * RW_P + sk] = at; AT2[sk * 16 + s] = at; ARR[s * RW_P + sk] = rt; KB2[s * RW_P + sk] = kt; KT[sk * 16 + s] = kt; KB2[(16 + s) * RW_P + sk] = btv; BTN[sk * 16 + s] = btn;
                        if (s == RW_T - 1) CWT[sk] = cw;
                        cwm = cw; }
                }
                __syncthreads();
            }
        } else {
#pragma unroll 1
            for (int it = -8; it <= RW_NCH; ++it) {
                const int c = it + 2;
                if (c >= 0 && c < RW_NCH && ((c & 1) == (wave & 1))) {
                    const LAS bf16* ARA = (const LAS bf16*)(L + RW_ARA + (c & 1) * (16 * RW_P * 2)); const LAS bf16* KB2 = (const LAS bf16*)(L + RW_KB2 + (c & 1) * (32 * RW_P * 2));
                    const LAS bf16* ARR = (const LAS bf16*)(L + RW_ARR + (c & 3) * (16 * RW_P * 2)); const LAS bf16* AT2 = (const LAS bf16*)(L + RW_AT2 + (c & 3) * 2048);
                    const lbf APT = (lbf)(L + RW_DO + (c & 3) * RW_DOB), AMT = APT + 16 * RW_P, ARKT = AMT + 256, ARBTN = ARKT + 256;
                    const f32x4 Z = (f32x4){0.f, 0.f, 0.f, 0.f};
                    f32x4 gkk = Z, gkkT = Z, grk = Z, gn = Z, gnT = Z, grb = Z;
#pragma unroll
                    for (int ks = 0; ks < 2; ++ks) { const bf16x8 ak = *(const LAS bf16x8*)(KB2 + fr * RW_P + 32 * ks + 8 * kg), ab = *(const LAS bf16x8*)(KB2 + (16 + fr) * RW_P + 32 * ks + 8 * kg);
                        const bf16x8 ba = *(const LAS bf16x8*)(ARA + fr * RW_P + 32 * ks + 8 * kg), br = *(const LAS bf16x8*)(ARR + fr * RW_P + 32 * ks + 8 * kg);
                        gkk = RW_MFMA(ak, ba, gkk); gkkT = RW_MFMA(ba, ak, gkkT); grk = RW_MFMA(ak, br, grk); gn = RW_MFMA(ab, ba, gn); gnT = RW_MFMA(ba, ab, gnT); grb = RW_MFMA(ab, br, grb); }
                    f32x4 w1, w1T;
#pragma unroll
                    for (int r = 0; r < 4; ++r) { const int row = 4 * kg + r;
                        if (!(row < fr)) { gkk[r] = 0.f; gn[r] = 0.f; } if (!(fr < row)) { gkkT[r] = 0.f; gnT[r] = 0.f; } if (!(row <= fr)) { grk[r] = 0.f; grb[r] = 0.f; }
                        const float idt = row == fr ? 1.f : 0.f; w1[r] = idt - gn[r]; w1T[r] = idt - gnT[r]; }
                    const bf16x8 bn = rw_c4(gn), bnT = rw_c4(gnT);
                    const f32x4 n2 = RW_MFMA(bnT, bn, Z), n2T = RW_MFMA(bn, bnT, Z);
                    const bf16x8 b2 = rw_c4(n2), b2T = rw_c4(n2T);
                    const f32x4 n4 = RW_MFMA(b2T, b2, Z), n4T = RW_MFMA(b2, b2T, Z);
                    const bf16x8 b4 = rw_c4(n4), b4T = rw_c4(n4T);
                    const f32x4 n8 = RW_MFMA(b4T, b4, Z);
                    const bf16x8 bw1T = rw_c4(w1T);
                    const f32x4 w2 = RW_MFMA(bw1T, b2, w1), w2T = RW_MFMA(b2, bw1T, w1T);
                    const bf16x8 bw2T = rw_c4(w2T);
                    const f32x4 w3 = RW_MFMA(bw2T, b4, w2), w3T = RW_MFMA(b4, bw2T, w2T);
                    const f32x4 xi = RW_MFMA(rw_c4(w3T), rw_c4(n8), w3);
                    const bf16x8 bx = rw_c4(xi);
                    const f32x4 am = RW_MFMA(rw_c4(gkkT), bx, Z);
                    rw_st_cols(AMT, am, fr, kg, 16); rw_st_cols(ARKT, grk, fr, kg, 16); { f32x4 nb = Z - grb; rw_st_cols(ARBTN, nb, fr, kg, 16); }
#pragma unroll
                    for (int m = 0; m < 4; ++m) { const f32x4 ap = RW_MFMA(rw_perm4(AT2 + (16 * m + fr) * 16, kg), bx, Z);
                        rw_st_cols(APT + 16 * m, ap, fr, kg, RW_P); }
                }
                __syncthreads();
            }
        }
    }
}

__device__ __forceinline__ void phase_fin_rwkv(Frame& F, int li) { WS_DECL; frame_refresh(F);
    const int nrows = li == DEPTH - 1 ? NL : NT; const int lane = F.lane, wave = F.wave, tid = F.tid;
    LAS float* GUP = (LAS float*)F.lds;
    LAS float* SG = (LAS float*)(F.lds + 65536) + wave * 64;
    const bf16* P = WSP(bf16, WS_P); const float* YR = WSP(float, WS_YR); const float* BON = WSP(float, WS_BON); bf16* MIX = WSP(bf16, WS_A1);
    { const float* gup = in_ptr(I_GUP) + (size_t)li * 64 * 256; for (int i = tid; i < 64 * 256; i += NTHR) GUP[i] = gup[i]; }
    const float* mup = in_ptr(I_MUP) + li * 960; const float* mun = in_ptr(I_MUN) + li * 960;
    const f32x4 mpv = *(const GAS f32x4*)(mup + 512 + 4 * lane), mnv = *(const GAS f32x4*)(mun + 512 + 4 * lane);
    const float mpg = mup[896 + lane], mng = mun[896 + lane];
    const f32x4 lg = *(const GAS f32x4*)(in_ptr(I_LNG) + li * 256 + 4 * lane), lb = *(const GAS f32x4*)(in_ptr(I_LNB) + li * 256 + 4 * lane);
    __syncthreads();
    const int gw = blockIdx.x * NWAVES + wave, NGW = F.G * NWAVES;
    for (int m = gw; m < nrows; m += NGW) {
        const bool isctx = m >= NL; const int t = isctx ? (m - NL) & 255 : m & 4095; const int Ls = isctx ? 256 : 4096;
        const bf16* pr = P + (size_t)m * PCOLS + RW_C0;
        const bool hp = t > 0, hn = t + 1 < Ls;
        f32x4 v;
        { const v2u w = *(const GAS v2u*)(pr + 512 + 4 * lane); v2u wp = (v2u){0u, 0u}, wn = (v2u){0u, 0u};
          if (hp) wp = *(const GAS v2u*)(pr - PCOLS + 512 + 4 * lane); if (hn) wn = *(const GAS v2u*)(pr + PCOLS + 512 + 4 * lane);
          const f32x4 x = (f32x4){bflo(w.x), bfhi(w.x), bflo(w.y), bfhi(w.y)}, xp = (f32x4){bflo(wp.x), bfhi(wp.x), bflo(wp.y), bfhi(wp.y)}, xn = (f32x4){bflo(wn.x), bfhi(wn.x), bflo(wn.y), bfhi(wn.y)};
          v = x + mpv * (xp - x) + mnv * (xn - x); }
        { const float x = bf2f(pr[896 + lane]); const float xp = hp ? bf2f(pr[896 + lane - PCOLS]) : 0.f, xn = hn ? bf2f(pr[896 + lane + PCOLS]) : 0.f;
          SG[lane] = sigmoidf_(x + mpg * (xp - x) + mng * (xn - x)); }
        LDS_WAIT();
        f32x4 g = (f32x4){0.f, 0.f, 0.f, 0.f};
#pragma unroll 8
        for (int j = 0; j < 64; ++j) { const float sj = SG[j]; const f32x4 gu = *(const LAS f32x4*)(GUP + j * 256 + 4 * lane); g = g + gu * sj; }
        const f32x4 y = *(const GAS f32x4*)(YR + (size_t)m * 256 + 4 * lane) + *(const GAS f32x4*)(YR + ((size_t)NT + m) * 256 + 4 * lane);
        const float mean = rowsum16((y.x + y.y) + (y.z + y.w)) * (1.f / 64.f);
        const f32x4 yc = y - mean; const float var = rowsum16((yc.x * yc.x + yc.y * yc.y) + (yc.z * yc.z + yc.w * yc.w)) * (1.f / 64.f);
        const f32x4 yn = yc * __builtin_amdgcn_rsqf(var + 64e-5f) * lg + lb;
        const int hh = lane >> 4; const float bon = BON[(size_t)m * 4 + hh] + BON[((size_t)NT + m) * 4 + hh];
        const f32x4 o = (yn + v * bon) * g;
        v2u ow; ow.x = pk2(o.x, o.y); ow.y = pk2(o.z, o.w); *(GAS v2u*)(MIX + (size_t)m * D + 512 + 4 * lane) = ow;
        LDS_WAIT();
    }
    __syncthreads();
}

constexpr float HY_DMIN = -3.0701134573253945f, HY_DMAX = -15.350567286626973f;
constexpr int HY_X = 0, HY_TW = 65536, HY_W3 = 98304;
__device__ __forceinline__ float hy_delta(int ch) { return -(HY_DMIN + (float)ch * ((HY_DMAX - HY_DMIN) / 255.f)); }

__device__ __forceinline__ void phase_pro0d(Frame& F) { WS_DECL; frame_refresh(F);
    const int lane = F.lane; const int gw = blockIdx.x * NWAVES + F.wave, NGW = F.G * NWAVES;
    const float* w1 = in_ptr(I_HW1); const float* b1 = in_ptr(I_HB1); const float* w2 = in_ptr(I_HW2); const float* b2 = in_ptr(I_HB2);
    for (int it = gw; it < DEPTH * (SEQ + LCX); it += NGW) {
        const int li = it / (SEQ + LCX), r = it % (SEQ + LCX); const bool isctx = r >= SEQ; const int l = isctx ? r - SEQ : r; const int L = isctx ? LCX : SEQ;
        float z = 0.f;
        if (lane == 0) z = (float)l / (float)(L - 1);
        else if (lane < 33) { const int i = (lane - 1) & 15; const float band = 1e-4f + (float)i * ((15.f - 1e-4f) / 15.f); const float ang = band * (6.283185307179586f / (float)L) * (float)l; z = lane < 17 ? cosf(ang) : -sinf(ang); }
        float h1 = b1[li * 64 + lane];
        for (int i = 0; i < 33; ++i) h1 += __shfl(z, i) * w1[(li * 33 + i) * 64 + lane];
        h1 = sinf(h1);
        float h2 = b2[li * 64 + lane];
        for (int i = 0; i < 64; ++i) h2 += __shfl(h1, i) * w2[(li * 64 + i) * 64 + lane];
        h2 = sinf(h2);
        float* dst = isctx ? WSP(float, WS_H2C) + ((size_t)li * LCX + l) * 64 : WSP(float, WS_H2L) + ((size_t)li * SEQ + l) * 64;
        dst[lane] = h2;
    }
}

typedef f32x2 cpx;
__device__ __forceinline__ cpx cmul(cpx a, cpx b) { return (cpx){a.x * b.x - a.y * b.y, a.x * b.y + a.y * b.x}; }
__device__ __forceinline__ cpx cmulc(cpx a, cpx b) { return (cpx){a.x * b.x + a.y * b.y, a.y * b.x - a.x * b.y}; }
__device__ __forceinline__ cpx cmi(cpx z) { return (cpx){z.y, -z.x}; }
__device__ __forceinline__ int hy_p(int n) { return n ^ ((n >> 5) & 7) ^ (((n >> 6) & 3) << 3); }
__device__ __forceinline__ void hy_build_tw(Frame& F) {
    LAS cpx* TW = (LAS cpx*)(F.lds + HY_TW);
    for (int k = F.tid; k < 4096; k += NTHR) { const float rev = (float)k * (1.f / 8192.f); TW[k] = (cpx){__builtin_amdgcn_cosf(rev), -__builtin_amdgcn_sinf(rev)};     }
}
__device__ __forceinline__ void dft4(cpx x0, cpx x1, cpx x2, cpx x3, cpx& X0, cpx& X1, cpx& X2, cpx& X3) {
    const cpx t0 = x0 + x2, t1 = x0 - x2, t2 = x1 + x3, t3 = cmi(x1 - x3); X0 = t0 + t2; X1 = t1 + t3; X2 = t0 - t2; X3 = t1 - t3; }
__device__ __forceinline__ void dft8(cpx (&a)[8]) {
    const float R2 = 0.7071067811865476f; cpx e[4], o[4];
    dft4(a[0] + a[4], a[1] + a[5], a[2] + a[6], a[3] + a[7], e[0], e[1], e[2], e[3]);
    const cpx d1 = a[1] - a[5], d3 = a[3] - a[7];
    dft4(a[0] - a[4], (cpx){(d1.x + d1.y) * R2, (d1.y - d1.x) * R2}, cmi(a[2] - a[6]), (cpx){(d3.y - d3.x) * R2, -(d3.x + d3.y) * R2}, o[0], o[1], o[2], o[3]);
#pragma unroll
    for (int m = 0; m < 4; ++m) { a[2 * m] = e[m]; a[2 * m + 1] = o[m]; }
}
__device__ __forceinline__ void dft16(cpx (&a)[16]) {
    const float C1 = 0.9238795325112867f, S1 = 0.3826834323650898f, R2 = 0.7071067811865476f;
    cpx e[8], o[8];
#pragma unroll
    for (int k = 0; k < 8; ++k) { e[k] = a[k] + a[k + 8]; o[k] = a[k] - a[k + 8]; }
    o[1] = cmul(o[1], (cpx){C1, -S1}); o[2] = cmul(o[2], (cpx){R2, -R2}); o[3] = cmul(o[3], (cpx){S1, -C1}); o[4] = cmi(o[4]);
    o[5] = cmul(o[5], (cpx){-S1, -C1}); o[6] = cmul(o[6], (cpx){-R2, -R2}); o[7] = cmul(o[7], (cpx){-C1, -S1});
    dft8(e); dft8(o);
#pragma unroll
    for (int m = 0; m < 8; ++m) { a[2 * m] = e[m]; a[2 * m + 1] = o[m]; }
}
template <int R> __device__ __forceinline__ void cconj(cpx (&a)[R]) {
#pragma unroll
    for (int k = 0; k < R; ++k) a[k].y = -a[k].y; }
template <bool INV, bool ZU> __device__ __forceinline__ void hy_pass1(LAS cpx* X, const LAS cpx* TW, int tid) {
    cpx a[16]; const cpx w1 = TW[tid];
#pragma unroll
    for (int k = 0; k < 16; ++k) a[k] = (!INV && ZU && k >= 8) ? (cpx){0.f, 0.f} : X[hy_p(tid + 512 * k)];
    if (!INV) { dft16(a); cpx w = w1;
#pragma unroll
        for (int q = 1; q < 16; ++q) { a[q] = cmul(a[q], w); w = cmul(w, w1); }
    } else { cpx w = w1;
#pragma unroll
        for (int q = 1; q < 16; ++q) { a[q] = cmulc(a[q], w); w = cmul(w, w1); }
        cconj<16>(a); dft16(a); cconj<16>(a); }
#pragma unroll
    for (int k = 0; k < 16; ++k) if (!(INV && ZU && k >= 8)) X[hy_p(tid + 512 * k)] = a[k];
}
template <bool INV, int S, int MUL> __device__ __forceinline__ void hy_pass8(LAS cpx* X, const LAS cpx* TW, int tid) {
#pragma unroll
    for (int h = 0; h < 2; ++h) { const int bf = tid + 512 * h, sub = bf / S, j = bf % S, base = 8 * S * sub + j; cpx a[8]; const cpx w1 = TW[MUL * j];
#pragma unroll
        for (int k = 0; k < 8; ++k) a[k] = X[hy_p(base + S * k)];
        if (!INV) { dft8(a); cpx w = w1;
#pragma unroll
            for (int q = 1; q < 8; ++q) { a[q] = cmul(a[q], w); w = cmul(w, w1); }
        } else { cpx w = w1;
#pragma unroll
            for (int q = 1; q < 8; ++q) { a[q] = cmulc(a[q], w); w = cmul(w, w1); }
            cconj<8>(a); dft8(a); cconj<8>(a); }
#pragma unroll
        for (int k = 0; k < 8; ++k) X[hy_p(base + S * k)] = a[k]; }
}
__device__ __forceinline__ void hy_pass4(LAS cpx* X, int tid, const cpx* spec) {
#pragma unroll
    for (int h = 0; h < 2; ++h) { const int g = tid + 512 * h; cpx a[8];
#pragma unroll
        for (int k = 0; k < 8; ++k) a[k] = X[hy_p(8 * g + k)];
        dft8(a);
        if (spec) {
#pragma unroll
            for (int k2 = 0; k2 < 4; ++k2) { const f32x4 s4 = *(const GAS f32x4*)(spec + 8 * g + 2 * k2); a[2 * k2] = cmul(a[2 * k2], (cpx){s4.x, s4.y}); a[2 * k2 + 1] = cmul(a[2 * k2 + 1], (cpx){s4.z, s4.w}); }
            cconj<8>(a); dft8(a); cconj<8>(a); }
#pragma unroll
        for (int k = 0; k < 8; ++k) X[hy_p(8 * g + k)] = a[k]; }
}
__device__ __forceinline__ void hy_conv_fft(LAS cpx* X, const LAS cpx* TW, int tid, const cpx* spec) {
    hy_pass1<false, true>(X, TW, tid); __syncthreads();
    hy_pass8<false, 64, 16>(X, TW, tid); __syncthreads();
    hy_pass8<false, 8, 128>(X, TW, tid); __syncthreads();
    hy_pass4(X, tid, spec); __syncthreads();
    hy_pass8<true, 8, 128>(X, TW, tid); __syncthreads();
    hy_pass8<true, 64, 16>(X, TW, tid); __syncthreads();
    hy_pass1<true, true>(X, TW, tid); __syncthreads();
}

__device__ __forceinline__ void phase_hy_spec(Frame& F, int li) { WS_DECL; frame_refresh(F);
    LAS cpx* X = (LAS cpx*)(F.lds + HY_X); const LAS cpx* TW = (const LAS cpx*)(F.lds + HY_TW); LAS float* W3 = (LAS float*)(F.lds + HY_W3);
    const int tid = F.tid; const float* w3 = in_ptr(I_HW3) + (size_t)li * 64 * 1024; const float* H2 = WSP(float, WS_H2L) + (size_t)li * SEQ * 64; cpx* SPEC = WSP(cpx, WS_SPEC);
    __syncthreads();
    hy_build_tw(F);
    for (int item = blockIdx.x; item < 512; item += F.G) {
        const int o = item >> 8, ch = item & 255;
        __syncthreads();
        if (tid < 128) { const int dir = tid >> 6, j = tid & 63; W3[tid] = w3[(size_t)j * 1024 + o * 512 + dir * 256 + ch]; }
        __syncthreads();
        const float delta = hy_delta(ch);
#pragma unroll 1
        for (int i = 0; i < 8; ++i) { const int l = tid + 512 * i; const float* hr = H2 + (size_t)l * 64; float hf = 0.f, hb = 0.f;
#pragma unroll
            for (int j4 = 0; j4 < 16; ++j4) { const f32x4 h4 = *(const GAS f32x4*)(hr + 4 * j4);
                hf += h4.x * W3[4 * j4] + h4.y * W3[4 * j4 + 1] + h4.z * W3[4 * j4 + 2] + h4.w * W3[4 * j4 + 3]; hb += h4.x * W3[64 + 4 * j4] + h4.y * W3[64 + 4 * j4 + 1] + h4.z * W3[64 + 4 * j4 + 2] + h4.w * W3[64 + 4 * j4 + 3]; }
            const float win = (__expf(-((float)l * (1.f / 4095.f)) * delta) + 0.05f) * (1.f / 8192.f);
            X[hy_p(l)] = (cpx){hf * win, 0.f};
            if (l == 0) X[hy_p(4096)] = (cpx){0.f, 0.f}; else X[hy_p(8192 - l)] = (cpx){hb * win, 0.f}; }
        __syncthreads();
        hy_pass1<false, false>(X, TW, tid); __syncthreads();
        hy_pass8<false, 64, 16>(X, TW, tid); __syncthreads();
        hy_pass8<false, 8, 128>(X, TW, tid); __syncthreads();
        hy_pass4(X, tid, nullptr); __syncthreads();
        cpx* dst = SPEC + (size_t)item * 8192;
#pragma unroll
        for (int i = 0; i < 16; ++i) *(GAS cpx*)(dst + tid + 512 * i) = X[hy_p(tid + 512 * i)];
    }
    __syncthreads();
}

__device__ __forceinline__ void hy_conv8(const bf16* row, int t0, int Ls, float w0, float w1, float w2, float bias, float (&out)[8]) {
    const v4u raw = *(const GAS v4u*)(row + t0); float p[10];
    p[0] = t0 > 0 ? bf2f(row[t0 - 1]) : 0.f; p[9] = t0 + 8 < Ls ? bf2f(row[t0 + 8]) : 0.f;
    p[1] = bflo(raw.x); p[2] = bfhi(raw.x); p[3] = bflo(raw.y); p[4] = bfhi(raw.y); p[5] = bflo(raw.z); p[6] = bfhi(raw.z); p[7] = bflo(raw.w); p[8] = bfhi(raw.w);
#pragma unroll
    for (int e = 0; e < 8; ++e) out[e] = bias + w0 * p[e] + w1 * p[e + 1] + w2 * p[e + 2];
}

__device__ __forceinline__ void phase_hy_conv(Frame& F, int li) { WS_DECL; frame_refresh(F);
    LAS cpx* X = (LAS cpx*)(F.lds + HY_X); const LAS cpx* TW = (const LAS cpx*)(F.lds + HY_TW);
    const int tid = F.tid; const bf16* HT = WSP(bf16, WS_HT); bf16* HOT = WSP(bf16, WS_HOT); const cpx* SPEC = WSP(cpx, WS_SPEC);
    const float* cw = in_ptr(I_HCW) + li * 3 * 768; const float* cb = in_ptr(I_HCB) + li * 768; const float* dsk = in_ptr(I_HD) + li * 512;
    __syncthreads();
    hy_build_tw(F);
    for (int item = blockIdx.x; item < 2048; item += F.G) {
        const int ch = item >> 3, bp = item & 7; const int t0 = 8 * tid;
        float v[2][8], x1[2][8], x2[2][8];
#pragma unroll
        for (int q = 0; q < 2; ++q) { const size_t boff = (size_t)(2 * bp + q) * SEQ;
            hy_conv8(HT + (size_t)ch * NT + boff, t0, SEQ, cw[ch], cw[768 + ch], cw[1536 + ch], cb[ch], v[q]);
            hy_conv8(HT + (size_t)(256 + ch) * NT + boff, t0, SEQ, cw[256 + ch], cw[768 + 256 + ch], cw[1536 + 256 + ch], cb[256 + ch], x1[q]);
            hy_conv8(HT + (size_t)(512 + ch) * NT + boff, t0, SEQ, cw[512 + ch], cw[768 + 512 + ch], cw[1536 + 512 + ch], cb[512 + ch], x2[q]); }
        const float d0 = dsk[ch], d1 = dsk[256 + ch];
        __syncthreads();
#pragma unroll
        for (int e = 0; e < 8; ++e) X[hy_p(t0 + e)] = (cpx){v[0][e], v[1][e]};
        __syncthreads();
        hy_conv_fft(X, TW, tid, SPEC + (size_t)ch * 8192);
        float u[2][8];
#pragma unroll
        for (int e = 0; e < 8; ++e) { const cpx y = X[hy_p(t0 + e)]; u[0][e] = x1[0][e] * (y.x + v[0][e] * d0); u[1][e] = x1[1][e] * (y.y + v[1][e] * d0); X[hy_p(t0 + e)] = (cpx){u[0][e], u[1][e]}; }
        __syncthreads();
        hy_conv_fft(X, TW, tid, SPEC + (size_t)(256 + ch) * 8192);
#pragma unroll
        for (int q = 0; q < 2; ++q) { float o[8];
#pragma unroll
            for (int e = 0; e < 8; ++e) { const cpx y = X[hy_p(t0 + e)]; o[e] = x2[q][e] * ((q == 0 ? y.x : y.y) + u[q][e] * d1); }
            v4u w; w.x = pk2(o[0], o[1]); w.y = pk2(o[2], o[3]); w.z = pk2(o[4], o[5]); w.w = pk2(o[6], o[7]);
            *(GAS v4u*)(HOT + (size_t)ch * NT + (size_t)(2 * bp + q) * SEQ + t0) = w; }
    }
    __syncthreads();
}

__device__ __forceinline__ void phase_hy_ctx(Frame& F, int li) { WS_DECL; frame_refresh(F);
    LAS float* KF = (LAS float*)F.lds;
    LAS float* SIG = KF + 1024;
    LAS float* W3 = KF + 2048;
    const int tid = F.tid; const bf16* HT = WSP(bf16, WS_HT); bf16* HOT = WSP(bf16, WS_HOT);
    const float* w3 = in_ptr(I_HW3) + (size_t)li * 64 * 1024; const float* H2 = WSP(float, WS_H2C) + (size_t)li * LCX * 64;
    const float* cw = in_ptr(I_HCW) + li * 3 * 768; const float* cb = in_ptr(I_HCB) + li * 768; const float* dsk = in_ptr(I_HD) + li * 512;
    for (int ch = blockIdx.x; ch < 256; ch += F.G) {
        __syncthreads();
        if (tid < 256) { const int od = tid >> 6, j = tid & 63; W3[tid] = w3[(size_t)j * 1024 + (od >> 1) * 512 + (od & 1) * 256 + ch]; }
        __syncthreads();
        { const int o = tid >> 8, l = tid & 255; const float* hr = H2 + (size_t)l * 64; float hf = 0.f, hb = 0.f;
          for (int j = 0; j < 64; ++j) { const float hv = hr[j]; hf += hv * W3[(2 * o) * 64 + j]; hb += hv * W3[(2 * o + 1) * 64 + j]; }
          const float win = __expf(-((float)l * (1.f / 255.f)) * hy_delta(ch)) + 0.05f;
          KF[(2 * o) * 256 + l] = hf * win; KF[(2 * o + 1) * 256 + l] = hb * win; }
        __syncthreads();
        const int q = tid >> 8, t = tid & 255; const float d0 = dsk[ch], d1 = dsk[256 + ch];
        for (int bp = 0; bp < 8; ++bp) { const int b = 2 * bp + q; const size_t off = (size_t)NL + (size_t)b * LCX;
            float zz[3];
#pragma unroll
            for (int k = 0; k < 3; ++k) { const int c = 256 * k + ch; const bf16* row = HT + (size_t)c * NT + off;
                const float pm = t > 0 ? bf2f(row[t - 1]) : 0.f, p0 = bf2f(row[t]), pp = t + 1 < LCX ? bf2f(row[t + 1]) : 0.f;
                zz[k] = cb[c] + cw[c] * pm + cw[768 + c] * p0 + cw[1536 + c] * pp; }
            SIG[q * 256 + t] = zz[0];
            __syncthreads();
            float y = 0.f;
            for (int s = 0; s < 256; ++s) { const int lag = t - s; const float kv = lag >= 0 ? KF[lag] : KF[256 - lag]; y += kv * SIG[q * 256 + s]; }
            const float u = zz[1] * (y + zz[0] * d0);
            __syncthreads();
            SIG[q * 256 + t] = u;
            __syncthreads();
            float y2 = 0.f;
            for (int s = 0; s < 256; ++s) { const int lag = t - s; const float kv = lag >= 0 ? KF[512 + lag] : KF[768 - lag]; y2 += kv * SIG[q * 256 + s]; }
            HOT[(size_t)ch * NT + off + t] = (bf16)f2bf(zz[2] * (y2 + u * d1));
            __syncthreads();
        }
    }
    __syncthreads();
}

constexpr int HF_LD = 72;
__device__ __forceinline__ void phase_fin_hyena(Frame& F, int li) { WS_DECL; frame_refresh(F);
    LAS bf16* T = (LAS bf16*)F.lds;
    const int nrows = li == DEPTH - 1 ? NL : NT; const int tid = F.tid, lane = F.lane, wave = F.wave; const bf16* HOT = WSP(bf16, WS_HOT); bf16* MIX = WSP(bf16, WS_A1);
    const f32x4 g4 = *(const GAS f32x4*)(in_ptr(I_HON) + li * 256 + 4 * lane);
    for (int item = blockIdx.x; item < nrows / 64; item += F.G) { const int m0 = item * 64;
        __syncthreads();
        { const int ch = tid >> 1, hf = tid & 1; const bf16* src = HOT + (size_t)ch * NT + m0 + 32 * hf;
#pragma unroll
          for (int k = 0; k < 4; ++k) *(LAS v4u*)(T + ch * HF_LD + 32 * hf + 8 * k) = *(const GAS v4u*)(src + 8 * k); }
        __syncthreads();
        for (int i = 0; i < 8; ++i) { const int tl = wave * 8 + i;
            f32x4 x; x.x = bf2f(T[(4 * lane) * HF_LD + tl]); x.y = bf2f(T[(4 * lane + 1) * HF_LD + tl]); x.z = bf2f(T[(4 * lane + 2) * HF_LD + tl]); x.w = bf2f(T[(4 * lane + 3) * HF_LD + tl]);
            const float r = __builtin_amdgcn_rsqf(wave_sum(x.x * x.x + x.y * x.y + x.z * x.z + x.w * x.w) * (1.f / 256.f) + 1e-6f);
            v2u o; o.x = pk2(x.x * r * g4.x, x.y * r * g4.y); o.y = pk2(x.z * r * g4.z, x.w * r * g4.w); *(GAS v2u*)(MIX + (size_t)(m0 + tl) * D + 768 + 4 * lane) = o; }
    }
    __syncthreads();
}
#define MIX_HYENA 1

#define GRID_BAR() do { XcdBarrier bar_; bar_.leader = (F.wave == 0 && mk_lane() == 0); bar_.bar = (unsigned*)(ws_ptr() + WS_CTL) + CW_BAR; bar_.x = xb_xcc_id(); bar_.st = (volatile LAS unsigned*)(F.lds + LDSCTL_OFF) + 8; xcd_barrier(bar_); } while (0)

template <int li>
__device__ __forceinline__ void layer_fwd(Frame& F) {
        const int nrows = li == DEPTH - 1 ? NL : NT; unsigned char* const ws = ws_ptr();
        phase_hy_spec(F, li);
        { pg8::Gemm g{WSP(bf16, WS_A1), WSP(bf16, WS_WINT) + (size_t)li * PCOLS * D, NT, PCOLS, D}; pg8::StaticOrder S; S.init(NT, PCOLS, F.G, (int)blockIdx.x);
          pg8::EpiStore E{WSP(bf16, WS_P), PCOLS, 0, PCOLS / 256};
          pg8::gemm_phase<pg8::EpiStore, pg8::StaticOrder, true, true>(F.lds, g, S, E, F.wave); }
#if MIX_HYENA
        { pg8::Gemm g{WSP(bf16, WS_WHYT) + (size_t)li * HYC * D, WSP(bf16, WS_A1), HYC, NT, D}; pg8::StaticOrder S; S.init(HYC, NT, F.G, (int)blockIdx.x);
          pg8::EpiStore E{WSP(bf16, WS_HT), NT, 0, NT / 256};
          pg8::gemm_phase<pg8::EpiStore, pg8::StaticOrder, true, true>(F.lds, g, S, E, F.wave); }
#endif
        GRID_BAR();
        phase_rwkv_r0(F, li);
        phase_mla_prep(F, li);
        phase_lru<1>(F, li);
        __syncthreads();
        phase_hy_conv(F, li);
        if (li < DEPTH - 1) phase_hy_ctx(F, li);
        GRID_BAR();
        phase_rwkv_scan(F, li);
        __syncthreads();
        phase_attn(F, li);
        __syncthreads();
        phase_lru<3>(F, li);
        GRID_BAR();
        phase_fin_mla(F, li);
        phase_fin_rwkv(F, li); phase_fin_hyena(F, li);
        GRID_BAR();
        { pg8::Gemm g{WSP(bf16, WS_A1), WSP(bf16, WS_WOUTT) + (size_t)li * D * D, nrows, D, D}; pg8::StaticOrder S; S.init(nrows, D, F.G, (int)blockIdx.x);
          pg8::EpiStore E{WSP(bf16, WS_Y), D, 0, D / 256};
          pg8::gemm_phase<pg8::EpiStore, pg8::StaticOrder, true, true>(F.lds, g, S, E, F.wave); }
        GRID_BAR();
        phase_ln1<true>(F, li);
        if (li & 1) phase_moe_weights(F, li);
        GRID_BAR();
        if (!(li & 1)) {
            const int j = li >> 1;
            { pg8::Gemm g{WSP(bf16, WS_A1), WSP(bf16, WS_WGUT) + (size_t)j * 2 * FFD * D, nrows, 2 * FFD, D}; pg8::StaticOrder S; S.init(nrows, 2 * FFD, F.G, (int)blockIdx.x);
              pg8::EpiSwiGLU E{WSP(bf16, WS_H), FFD, 0, 2 * FFD / 256};
              pg8::gemm_phase<pg8::EpiSwiGLU, pg8::StaticOrder, true, true>(F.lds, g, S, E, F.wave); }
            GRID_BAR();
            { pg8::Gemm g{WSP(bf16, WS_H), WSP(bf16, WS_WDT) + (size_t)j * D * FFD, nrows, D, FFD}; pg8::StaticOrder S; S.init(nrows, D, F.G, (int)blockIdx.x);
              pg8::EpiStore E{WSP(bf16, WS_Y), D, 0, D / 256};
              pg8::gemm_phase<pg8::EpiStore, pg8::StaticOrder, true, true>(F.lds, g, S, E, F.wave); }
            GRID_BAR();
        } else {
            phase_moe_slots(F, li);
            GRID_BAR();
            const int ntiles = __builtin_amdgcn_readfirstlane(((LAS int*)(F.lds + LDS_MOEI))[48]);
            const PG8_LAS unsigned char* tile_e = (const PG8_LAS unsigned char*)(F.lds + LDS_TILEE);
#pragma unroll 1
            for (int ch = 0; ch < MOE_NCHUNK; ++ch) {
                const int t0 = ch * MOE_CHUNK_TILES; int nM = ntiles - t0; nM = nM < 0 ? 0 : (nM > MOE_CHUNK_TILES ? MOE_CHUNK_TILES : nM);
                { pg8::Gemm g{(const pg8::bf16_t*)WSP(unsigned char, WS_XS8), (const pg8::bf16_t*)WSP(unsigned char, WS_M8GU), 0, 0, D / 2}; pg8::MoeOrder S; S.init(nM, 2 * FFE / 256, F.G, (int)blockIdx.x, t0, t0, tile_e);
                  pg8::EpiSwiGLU8 E{WSP(unsigned char, WS_HM8), FFE, t0, 2 * FFE / 256};
                  pg8::gemm_phase<pg8::EpiSwiGLU8, pg8::MoeOrder, true, true, true, 124>(F.lds, g, S, E, F.wave); }
                GRID_BAR();
                { pg8::Gemm g{(const pg8::bf16_t*)WSP(unsigned char, WS_HM8), (const pg8::bf16_t*)WSP(unsigned char, WS_M8D), 0, 0, FFE / 2}; pg8::MoeOrder S; S.init(nM, D / 256, F.G, (int)blockIdx.x, t0, 0, tile_e);
                  pg8::EpiStore E{WSP(bf16, WS_Y2), D, t0, D / 256};
                  pg8::gemm_phase<pg8::EpiStore, pg8::MoeOrder, true, true, true, 123>(F.lds, g, S, E, F.wave); }
                GRID_BAR();
            }
        }
        phase_ln2<true>(F, li);
        if (li < DEPTH - 1) GRID_BAR();
}

__global__ void __launch_bounds__(NTHR, 2) mk_fwd(Args a) {
    extern __shared__ __attribute__((aligned(16))) unsigned char lds_raw[];
    Frame F; F.lds = (LAS unsigned char*)lds_raw; F.tid = threadIdx.x; F.lane = F.tid & 63; F.wave = __builtin_amdgcn_readfirstlane(F.tid >> 6); F.G = gridDim.x;
    for (int u = F.tid; u < (LDS_BYTES - LDSCTL_OFF) / 4; u += NTHR) ((LAS unsigned*)(F.lds + LDSCTL_OFF))[u] = 0u;
    __syncthreads();
    (void)xcd_barrier_post((unsigned*)(ws_ptr() + WS_CTL) + CW_BAR, (volatile LAS unsigned*)(F.lds + LDSCTL_OFF) + 8, F.tid == 0);

    phase_pro0(F);
    phase_pro0b(F);
    phase_pro0c(F);
    phase_pro0d(F);
    phase_pro0e(F);
    GRID_BAR();
    phase_hin0(F);
    GRID_BAR();
    layer_fwd<0>(F); layer_fwd<1>(F); layer_fwd<2>(F); layer_fwd<3>(F);
}

extern "C" void kernel_launch(void* const* d_in, const int* in_sizes, int n_in, void* d_out, int out_size, void* d_ws, size_t ws_size, hipStream_t stream) {
    static int grid = 0;
    if (grid == 0) {
        if (n_in != N_INPUTS || out_size != NL * D || ws_size < WS_END) { fprintf(stderr, "kernel_launch: unexpected shapes (n_in %d out %d ws %zu)\n", n_in, out_size, ws_size); grid = -1; return; }
        int dev = 0, cus = 0, per_cu = 0;
        if (hipGetDevice(&dev) != hipSuccess || hipDeviceGetAttribute(&cus, hipDeviceAttributeMultiprocessorCount, dev) != hipSuccess) { grid = -1; return; }
        if (hipFuncSetAttribute((const void*)mk_fwd, hipFuncAttributeMaxDynamicSharedMemorySize, LDS_BYTES) != hipSuccess) { fprintf(stderr, "kernel_launch: hipFuncSetAttribute failed\n"); grid = -1; return; }
        if (hipOccupancyMaxActiveBlocksPerMultiprocessor(&per_cu, (const void*)mk_fwd, NTHR, LDS_BYTES) != hipSuccess || per_cu < 1) fprintf(stderr, "kernel_launch: occupancy query reports %d\n", per_cu);
        (void)hipGetLastError();
        grid = cus > 256 ? 256 : cus;
    }
    if (grid < 0) return;
    if (hipMemsetAsync((char*)d_ws + WS_CTL, 0, CTL_ZERO_BYTES, stream) != hipSuccess) return;
    Args a{};
    for (int i = 0; i < N_INPUTS; ++i) a.in[i] = (const float*)d_in[i];
    a.out = (float*)d_out; a.ws = (unsigned char*)d_ws;
    hipLaunchKernelGGL(mk_fwd, dim3(grid), dim3(NTHR), LDS_BYTES, stream, a);
    const hipError_t le = hipPeekAtLastError();
    if (le != hipSuccess) fprintf(stderr, "kernel_launch: launch failed: %s\n", hipGetErrorName(le));
}
```

```cpp
#include <hip/hip_runtime.h>
#include <cstdio>
#include <cstdint>
#define GAS __attribute__((address_space(1)))
#define LAS __attribute__((address_space(3)))
__device__ __forceinline__ int mk_lane() { int l; asm volatile("v_mbcnt_lo_u32_b32 %0, -1, 0\n\tv_mbcnt_hi_u32_b32 %0, -1, %0" : "=v"(l)); return l; }
namespace pg8 {
#define PG8_LAS __attribute__((address_space(3)))
typedef unsigned short bf16_t;
typedef short bf16x8 __attribute__((ext_vector_type(8)));
typedef float f32x4 __attribute__((ext_vector_type(4)));
typedef unsigned u32x4 __attribute__((ext_vector_type(4)));
constexpr int BM = 256, BK = 64, HALF = 128, HTB = HALF * BK * 2  , STAGE_BYTES = 8 * HTB, NXCD = 8, WGM = 8;

__host__ __device__ __forceinline__ int lds_byte(int r, int c) { const int st = (r >> 4) * 2 + (c >> 5), rr = r & 15, cc = c & 31, ob = rr * 64 + cc * 2; return st * 1024 + (ob ^ (((ob >> 9) & 1) << 5)); }
__host__ __device__ __forceinline__ void stage_rc(int b, int& R, int& C) { const int st = b / 1024, sb = b % 1024, swz = sb ^ (((sb >> 9) & 1) << 5); R = (st >> 1) * 16 + swz / 64; C = (st & 1) * 32 + (swz % 64) / 2; }
__host__ __device__ __forceinline__ int perm32(int rho) { const int n = rho >> 4, i = rho & 15; return 8 * (i >> 2) + 4 * n + (i & 3); }

struct Unit { int pm, pn; };
struct Gemm { const bf16_t* A; const bf16_t* Bt; int M, N, K; };

struct StaticOrder {
    int nM, nN, nwg, G, c;
    __host__ __device__ void init(int M, int N, int G_, int c_) { nM = M / BM; nN = N / BM; nwg = nM * nN; G = G_; c = c_; }
    __host__ __device__ bool next(int i, Unit& u) const {
        const long L = (long)i * G + c; if (L >= nwg) return false;
        int wgid = (int)L; { const int q = nwg / NXCD, r = nwg % NXCD, xcd = wgid % NXCD, off = wgid / NXCD; wgid = (xcd < r ? xcd * (q + 1) : r * (q + 1) + (xcd - r) * q) + off; }
        const int nig = WGM * nN, gid = wgid / nig, fm = gid * WGM, gsz = (nM - fm) < WGM ? (nM - fm) : WGM;
        u.pm = fm + ((wgid % nig) % gsz); u.pn = (wgid % nig) / gsz; return true;
    }
    __device__ __forceinline__ void a_ready(const Unit&) const {}
    __device__ __forceinline__ void done(const Unit&) const {}
};

__device__ __forceinline__ unsigned cvt_pk_bf16(float lo, float hi) { unsigned r; asm volatile("v_cvt_pk_bf16_f32 %0, %1, %2" : "=v"(r) : "v"(lo), "v"(hi)); return r; }
typedef float f32x2 __attribute__((ext_vector_type(2)));
__device__ __forceinline__ f32x2 gelu_pk(f32x2 v) {
    const f32x2 av = __builtin_elementwise_abs(v), d = av * 0.2316418882f + 1.0f;
    f32x2 t; t.x = __builtin_amdgcn_rcpf(d.x); t.y = __builtin_amdgcn_rcpf(d.y);
    f32x2 q = t * 0.5307027145f + (-0.7265760135f); q = q * t + 0.7107068705f; q = q * t + (-0.142248368f); q = q * t + 0.127414796f; q = q * t;
    const f32x2 s = (v * v) * (-0.72134752044f);
    f32x2 e; e.x = __builtin_amdgcn_exp2f(s.x); e.y = __builtin_amdgcn_exp2f(s.y);
    const f32x2 m = v * (q * e), r = v - m;
    f32x2 o; o.x = v.x < 0.f ? m.x : r.x; o.y = v.y < 0.f ? m.y : r.y; return o;
}

template <int ACT  > struct EpiBf16 {
    static constexpr bool PERM = true, AFTER_DRAIN = false; static_assert(ACT == 0 || ACT == 1, "EpiBf16: ACT is 0 (none) or 1 (gelu_pk)");
    bf16_t* O; int ldc; const float* bias; int split_cols; size_t split_stride; float scale0;
    __device__ __forceinline__ void operator()(const f32x4 (&acc)[2][2][4][2], const Unit& u, int wr, int wc, int fr, int fq) const {
        const int row0 = u.pm * BM + wr * 64 + fr; int colt = u.pn * BM; bf16_t* base = O;
        float sc = 1.f; if (split_cols) { const int t = colt / split_cols; base += (size_t)t * split_stride; colt -= t * split_cols; if (t == 0) sc = scale0; }
        const int col0 = colt + wc * 32 + 8 * fq, bcol0 = u.pn * BM + wc * 32 + 8 * fq;
        f32x4 bv[2][2];
#pragma unroll
        for (int bj = 0; bj < 2; ++bj)
#pragma unroll
            for (int n = 0; n < 2; ++n) bv[bj][n] = bias ? *(const f32x4*)(bias + bcol0 + bj * HALF + 4 * n) : (f32x4){0.f, 0.f, 0.f, 0.f};
#pragma unroll
        for (int ai = 0; ai < 2; ++ai)
#pragma unroll
            for (int m = 0; m < 4; ++m) { bf16_t* rowp = base + (size_t)(row0 + ai * HALF + m * 16) * ldc + col0;
#pragma unroll
                for (int bj = 0; bj < 2; ++bj) { f32x4 v0 = acc[ai][bj][m][0] + bv[bj][0], v1 = acc[ai][bj][m][1] + bv[bj][1];
                    if (ACT == 1) { f32x2 a = gelu_pk((f32x2){v0[0], v0[1]}), b = gelu_pk((f32x2){v0[2], v0[3]}), c = gelu_pk((f32x2){v1[0], v1[1]}), d = gelu_pk((f32x2){v1[2], v1[3]});
                        v0 = (f32x4){a.x, a.y, b.x, b.y}; v1 = (f32x4){c.x, c.y, d.x, d.y}; }
                    v0 = v0 * sc; v1 = v1 * sc; u32x4 w; w.x = cvt_pk_bf16(v0[0], v0[1]); w.y = cvt_pk_bf16(v0[2], v0[3]); w.z = cvt_pk_bf16(v1[0], v1[1]); w.w = cvt_pk_bf16(v1[2], v1[3]);
                    *(u32x4*)(rowp + bj * HALF) = w; } }
    }
};
typedef int pg8_v8i __attribute__((ext_vector_type(8))); typedef int pg8_v4i __attribute__((ext_vector_type(4)));
__device__ __forceinline__ pg8_v8i pg8_cat8(bf16x8 a, bf16x8 b) { return __builtin_shufflevector(__builtin_bit_cast(pg8_v4i, a), __builtin_bit_cast(pg8_v4i, b), 0, 1, 2, 3, 4, 5, 6, 7); }
template <class Epi, class Sched, bool ALIGN_EPI = false, bool SP2 = false, bool F8 = false, int WSCALE = 127>
__device__ __forceinline__ void gemm_phase(PG8_LAS unsigned char* lds, const Gemm g, const Sched& S, const Epi& E, int wave_idx) {
    int tid_ = wave_idx * 64 + mk_lane(); asm volatile("" : "+v"(tid_));
    const int tid = tid_, wid = __builtin_amdgcn_readfirstlane(tid >> 6), lane = tid & 63, wr = wid >> 2, wc = wid & 3, fr = lane & 15, fq = lane >> 4;
    const int K = g.K, nt = K / BK;
    unsigned voffA[2], voffB[2];
#pragma unroll
    for (int i = 0; i < 2; ++i) { int R, C; stage_rc(tid * 16 + i * 8192, R, C); const int Rb = Epi::PERM ? ((R & ~31) + perm32(R & 31)) : R;
        voffA[i] = (unsigned)(R * K + C) * 2u; voffB[i] = (unsigned)(Rb * K + C) * 2u; }
    const size_t kstep = (size_t)(BK * 2);
    const size_t hstep = (size_t)HALF * K * 2;
    const size_t tstep = 2 * hstep;
    const unsigned ldsw = (unsigned)wid * 1024u;
    int aoffk[2], boffk[2];
    if constexpr (F8) { aoffk[0] = lds_byte(wr * 64 + fr, (2 * (fq & 1)) * 8) + (fq >> 1) * 1024; aoffk[1] = lds_byte(wr * 64 + fr, (2 * (fq & 1) + 1) * 8) + (fq >> 1) * 1024;
        boffk[0] = lds_byte(wc * 32 + fr, (2 * (fq & 1)) * 8) + (fq >> 1) * 1024; boffk[1] = lds_byte(wc * 32 + fr, (2 * (fq & 1) + 1) * 8) + (fq >> 1) * 1024; }
    else { aoffk[0] = lds_byte(wr * 64 + fr, fq * 8); aoffk[1] = aoffk[0] + 1024; boffk[0] = lds_byte(wc * 32 + fr, fq * 8); boffk[1] = boffk[0] + 1024; }
#define PG8_SA(b, h) (((b) * 2 + (h)) * HTB)
#define PG8_SB(b, h) ((4 + (b) * 2 + (h)) * HTB)
#define PG8_STAGE(bufoff, gbase, voff) do { const char* gb_ = (const char*)(gbase); _Pragma("unroll") for (int _i = 0; _i < 2; ++_i) { unsigned keep_; \
        asm volatile("s_mov_b32 %0, m0\n\ts_mov_b32 m0, %2\n\ts_nop 0\n\tglobal_load_lds_dwordx4 %1, %3\n\ts_mov_b32 m0, %0" : "=&s"(keep_) : "v"((voff)[_i]), "s"((unsigned)(size_t)(lds + (bufoff) + ldsw + _i * 8192)), "s"(gb_) : "memory"); } } while (0)
#define PG8_LDA(dst, b, h) do { if constexpr (F8) { _Pragma("unroll") for (int m = 0; m < 4; ++m) dst##8[m] = *(const PG8_LAS pg8_v8i*)(lds + PG8_SA(b, h) + aoffk[0] + m * 2048); } else { _Pragma("unroll") for (int m = 0; m < 4; ++m) _Pragma("unroll") for (int k = 0; k < 2; ++k) dst[m][k] = *(const PG8_LAS bf16x8*)(lds + PG8_SA(b, h) + aoffk[k] + m * 2048); } } while (0)
#define PG8_LDB(dst, b, h) do { if constexpr (F8) { _Pragma("unroll") for (int n = 0; n < 2; ++n) dst##8[n] = *(const PG8_LAS pg8_v8i*)(lds + PG8_SB(b, h) + boffk[0] + n * 2048); } else { _Pragma("unroll") for (int n = 0; n < 2; ++n) _Pragma("unroll") for (int k = 0; k < 2; ++k) dst[n][k] = *(const PG8_LAS bf16x8*)(lds + PG8_SB(b, h) + boffk[k] + n * 2048); } } while (0)
#define PG8_MMA(ai, bj, At, Bt) do { __builtin_amdgcn_s_setprio(1); _Pragma("unroll") for (int m = 0; m < 4; ++m) _Pragma("unroll") for (int n = 0; n < 2; ++n) { \
        if constexpr (F8) acc[ai][bj][m][n] = __builtin_amdgcn_mfma_scale_f32_16x16x128_f8f6f4(Bt##8[n], At##8[m], acc[ai][bj][m][n], 0, 0, 0, wsc_, 0, wsc_);     \
        else { _Pragma("unroll") for (int k = 0; k < 2; ++k) acc[ai][bj][m][n] = __builtin_amdgcn_mfma_f32_16x16x32_bf16(Bt[n][k], At[m][k], acc[ai][bj][m][n], 0, 0, 0); } } __builtin_amdgcn_s_setprio(0); } while (0)
#define PG8_WAIT_V(n) asm volatile("s_waitcnt vmcnt(" #n ")" ::: "memory")
#define PG8_WAIT_L(n) asm volatile("s_waitcnt lgkmcnt(" #n ")" ::: "memory")
#define PG8_BAR __builtin_amdgcn_s_barrier()
#define PG8_SCHED __builtin_amdgcn_sched_barrier(0)
    int wsc_ = WSCALE; asm volatile("" : "+v"(wsc_));
    Unit cur, nxt; int ui = 0;
    if (!S.next(0, cur)) return;
    f32x4 acc[2][2][4][2];
#pragma unroll
    for (int a = 0; a < 2; ++a)
#pragma unroll
        for (int b = 0; b < 2; ++b)
#pragma unroll
            for (int m = 0; m < 4; ++m)
#pragma unroll
                for (int n = 0; n < 2; ++n) acc[a][b][m][n] = (f32x4){0.f, 0.f, 0.f, 0.f};
    bf16x8 At[4][2], B0[2][2], B1[2][2];
    pg8_v8i At8[4], B08[2], B18[2];
    const char* cA = (const char*)g.A + (size_t)cur.pm * tstep; const char* cB = (const char*)g.Bt + (size_t)cur.pn * tstep;
    S.a_ready(cur);
    if constexpr (SP2) {
        PG8_STAGE(PG8_SB(0, 0), cB, voffB); PG8_STAGE(PG8_SB(0, 1), cB + hstep, voffB); PG8_STAGE(PG8_SA(0, 0), cA, voffA); PG8_STAGE(PG8_SA(0, 1), cA + hstep, voffA);
        if (wr == 1) PG8_BAR;
        PG8_WAIT_V(2); PG8_BAR;
        PG8_STAGE(PG8_SB(1, 0), cB + kstep, voffB); PG8_STAGE(PG8_SA(1, 0), cA + kstep, voffA); PG8_STAGE(PG8_SB(1, 1), cB + hstep + kstep, voffB);
        PG8_WAIT_V(6); PG8_BAR;
    } else {
        PG8_STAGE(PG8_SB(0, 0), cB, voffB); PG8_STAGE(PG8_SA(0, 0), cA, voffA); PG8_STAGE(PG8_SB(0, 1), cB + hstep, voffB); PG8_STAGE(PG8_SA(0, 1), cA + hstep, voffA);
        if (wr == 1) PG8_BAR;
        PG8_WAIT_V(4); PG8_BAR;
        PG8_STAGE(PG8_SB(1, 0), cB + kstep, voffB); PG8_STAGE(PG8_SA(1, 0), cA + kstep, voffA); PG8_STAGE(PG8_SB(1, 1), cB + hstep + kstep, voffB);
        PG8_WAIT_V(6); PG8_BAR;
    }
    for (;;) {
        const bool has_next = S.next(ui + 1, nxt);
        const char* nA = has_next ? (const char*)g.A + (size_t)nxt.pm * tstep : cA; const char* nB = has_next ? (const char*)g.Bt + (size_t)nxt.pn * tstep : cB;
#pragma unroll 1
        for (int t = 0; t < nt; t += 2) {
            const bool last = (t == nt - 2);
            const char* a1 = cA + (size_t)(t + 1) * kstep;
            const char* a2 = last ? nA : cA + (size_t)(t + 2) * kstep; const char* b2 = last ? nB : cB + (size_t)(t + 2) * kstep;
            const char* a3 = a2 + kstep; const char* b3 = b2 + kstep;
            if (last && has_next) S.a_ready(nxt);
            if constexpr (SP2) {
            PG8_LDB(B0, 0, 0); PG8_LDB(B1, 0, 1); PG8_SCHED; PG8_LDA(At, 0, 0); PG8_STAGE(PG8_SA(1, 1), a1 + hstep, voffA);
            PG8_WAIT_V(8); PG8_WAIT_L(0); PG8_BAR; PG8_MMA(0, 0, At, B0); PG8_MMA(0, 1, At, B1); PG8_BAR; PG8_SCHED;
            PG8_LDA(At, 0, 1); PG8_STAGE(PG8_SB(0, 0), b2, voffB); PG8_STAGE(PG8_SB(0, 1), b2 + hstep, voffB); PG8_STAGE(PG8_SA(0, 0), a2, voffA);
            PG8_WAIT_V(8); PG8_WAIT_L(0); PG8_BAR; PG8_MMA(1, 0, At, B0); PG8_MMA(1, 1, At, B1); PG8_BAR; PG8_SCHED;
            PG8_LDB(B0, 1, 0); PG8_LDB(B1, 1, 1); PG8_SCHED; PG8_LDA(At, 1, 0); PG8_STAGE(PG8_SA(0, 1), a2 + hstep, voffA);
            PG8_WAIT_V(8); PG8_WAIT_L(0); PG8_BAR; PG8_MMA(0, 0, At, B0); PG8_MMA(0, 1, At, B1); PG8_BAR; PG8_SCHED;
            PG8_LDA(At, 1, 1); PG8_STAGE(PG8_SB(1, 0), b3, voffB); PG8_STAGE(PG8_SB(1, 1), b3 + hstep, voffB); PG8_STAGE(PG8_SA(1, 0), a3, voffA);
            PG8_WAIT_V(8); PG8_WAIT_L(0); PG8_BAR; PG8_MMA(1, 0, At, B0); PG8_MMA(1, 1, At, B1); PG8_BAR; PG8_SCHED;
            } else {
            PG8_LDB(B0, 0, 0); PG8_SCHED; PG8_LDA(At, 0, 0); PG8_STAGE(PG8_SA(1, 1), a1 + hstep, voffA);
            PG8_WAIT_L(8); PG8_BAR; PG8_WAIT_L(0); PG8_MMA(0, 0, At, B0); PG8_BAR; PG8_SCHED;
            PG8_LDB(B1, 0, 1); PG8_STAGE(PG8_SB(0, 0), b2, voffB);
            PG8_BAR; PG8_WAIT_L(0); PG8_MMA(0, 1, At, B1); PG8_BAR;
            PG8_LDA(At, 0, 1); PG8_STAGE(PG8_SA(0, 0), a2, voffA);
            PG8_BAR; PG8_WAIT_L(0); PG8_MMA(1, 0, At, B0); PG8_BAR; PG8_SCHED;
            PG8_STAGE(PG8_SB(0, 1), b2 + hstep, voffB);
            PG8_WAIT_V(6); PG8_BAR; PG8_MMA(1, 1, At, B1); PG8_BAR;
            PG8_LDB(B0, 1, 0); PG8_SCHED; PG8_LDA(At, 1, 0); PG8_STAGE(PG8_SA(0, 1), a2 + hstep, voffA);
            PG8_WAIT_L(8); PG8_BAR; PG8_WAIT_L(0); PG8_MMA(0, 0, At, B0); PG8_BAR; PG8_SCHED;
            PG8_LDB(B1, 1, 1); PG8_STAGE(PG8_SB(1, 0), b3, voffB);
            PG8_BAR; PG8_WAIT_L(0); PG8_MMA(0, 1, At, B1); PG8_BAR;
            PG8_LDA(At, 1, 1); PG8_STAGE(PG8_SA(1, 0), a3, voffA);
            PG8_BAR; PG8_WAIT_L(0); PG8_MMA(1, 0, At, B0); PG8_BAR; PG8_SCHED;
            PG8_STAGE(PG8_SB(1, 1), b3 + hstep, voffB);
            PG8_WAIT_V(6); PG8_BAR; PG8_MMA(1, 1, At, B1); PG8_BAR;
            }
        }
        if constexpr (ALIGN_EPI) { if (wr == 0) PG8_BAR; }
        if constexpr (!Epi::AFTER_DRAIN) { { int pm_ = cur.pm, pn_ = cur.pn; asm volatile("" : "+s"(pm_), "+s"(pn_)); cur.pm = pm_; cur.pn = pn_; }
            { int t2_ = mk_lane(); asm volatile("" : "+v"(t2_)); E(acc, cur, wr, wc, t2_ & 15, (t2_ & 63) >> 4); }
            S.done(cur); }
        if (!has_next) break;
#pragma unroll
        for (int a = 0; a < 2; ++a)
#pragma unroll
            for (int b = 0; b < 2; ++b)
#pragma unroll
                for (int m = 0; m < 4; ++m)
#pragma unroll
                    for (int n = 0; n < 2; ++n) acc[a][b][m][n] = (f32x4){0.f, 0.f, 0.f, 0.f};
        cur = nxt; cA = nA; cB = nB; ++ui;
        if constexpr (ALIGN_EPI) { if (wr == 1) PG8_BAR; }
    }
    PG8_WAIT_V(0);
    if constexpr (!ALIGN_EPI) { if (wr == 0) PG8_BAR; }
    PG8_BAR;
    if constexpr (Epi::AFTER_DRAIN) { E.fused(acc, cur, wr, wc, fr, fq, lds, wid, lane); S.done(cur); }
#undef PG8_SA
#undef PG8_SB
#undef PG8_STAGE
#undef PG8_LDA
#undef PG8_LDB
#undef PG8_MMA
#undef PG8_WAIT_V
#undef PG8_WAIT_L
#undef PG8_BAR
#undef PG8_SCHED
}
}

typedef unsigned short bf16;
typedef unsigned v4u __attribute__((ext_vector_type(4)));
typedef unsigned v2u __attribute__((ext_vector_type(2)));
typedef float f32x4 __attribute__((ext_vector_type(4)));
typedef float f32x2 __attribute__((ext_vector_type(2)));
typedef float f32x16 __attribute__((ext_vector_type(16)));
typedef short bf16x8 __attribute__((ext_vector_type(8)));
typedef short s16x4 __attribute__((ext_vector_type(4)));
typedef GAS unsigned gu32;

constexpr int D = 1024, NB = 16, SEQ = 4096, LCX = 256, DEPTH = 4;
constexpr int NL = NB * SEQ, NC = NB * LCX, NT = NL + NC;
constexpr int N_IN = 2592, PCOLS = 2048, D_OFF = 1824, HYC = 768;
constexpr int FFD = 2816, FFE = 3584, NE = 8;
constexpr float ALPHA = 1.6817928305074292f;
constexpr int NWAVES = 8, NTHR = 512;
constexpr int KSEQ = SEQ + LCX;

enum { I_X = 0, I_C, I_CTX, I_CCTX, I_ADAW, I_ADAB, I_WIN, I_QNORM, I_KVNORM, I_WUQ, I_WUKV, I_MLAON, I_LCW, I_LCB, I_LWR, I_LBR, I_LWI, I_LBI, I_LLAM, I_LON,
       I_MUP, I_MUN, I_W0, I_WUP, I_A0, I_AUP, I_GUP, I_KK, I_KA, I_RK, I_LNG, I_LNB, I_HCW, I_HCB, I_HW1, I_HB1, I_HW2, I_HB2, I_HW3, I_HD, I_HON,
       I_WOUT, I_LN1G, I_LN1B, I_LN2G, I_LN2B, I_FG, I_FU, I_FD, I_ROUTER, I_MG, I_MU, I_MD, N_INPUTS };

constexpr size_t MiB = 1u << 20;
constexpr size_t WS_CTL = 0, CTL_ZERO_BYTES = 1 * MiB;
constexpr size_t WS_MOD = 1 * MiB;
constexpr size_t WS_ROPE = 3 * MiB;
constexpr size_t WS_H2L = 4 * MiB;
constexpr size_t WS_H2C = 8 * MiB;
constexpr size_t WS_LRUW = 9 * MiB;
constexpr size_t WS_WUQT = 10 * MiB;
constexpr size_t WS_WUKVT = 11 * MiB;
constexpr size_t WS_SUMM = 12 * MiB;
constexpr size_t WS_BON = 17 * MiB;
constexpr size_t WS_TOKE = 20 * MiB;
constexpr size_t WS_TOKG = 21 * MiB;
constexpr size_t WS_TOKS = 22 * MiB;
constexpr size_t WS_BLKCNT = 23 * MiB;
constexpr size_t WS_SPEC = 24 * MiB;
constexpr size_t WS_WINT = 56 * MiB;
constexpr size_t WS_WHYT = 72 * MiB;
constexpr size_t WS_WOUTT = 78 * MiB;
constexpr size_t WS_WGUT = 86 * MiB;
constexpr size_t WS_WDT = 108 * MiB;
constexpr size_t WS_XC = 120 * MiB;
constexpr size_t WS_A1 = 136 * MiB;
constexpr size_t WS_ARENA = 272 * MiB;
constexpr size_t WS_P = WS_ARENA;
constexpr size_t WS_HT = 544 * MiB;
constexpr size_t WS_QB = 646 * MiB;
constexpr size_t WS_KB = 697 * MiB;
constexpr size_t WS_VT = 748 * MiB;
constexpr size_t WS_AO = 782 * MiB;
constexpr size_t WS_HOT = 816 * MiB;
constexpr size_t WS_YR = 850 * MiB;
constexpr size_t WS_Y = 986 * MiB;
constexpr size_t WS_H = WS_ARENA;
constexpr size_t WS_MGU = WS_ARENA;
constexpr size_t WS_MD = 384 * MiB;
constexpr size_t WS_XS = 440 * MiB;
constexpr size_t WS_HM = 716 * MiB;
constexpr size_t WS_END = 1122 * MiB;
constexpr size_t WS_M8GU = WS_ARENA;
constexpr size_t WS_M8D = 328 * MiB;
constexpr size_t WS_XS8 = 356 * MiB;
constexpr size_t WS_Y2 = 494 * MiB;
constexpr size_t WS_HM8 = 770 * MiB;
constexpr int MOE_MAX_TILES = 552, MOE_NCHUNK = 2, MOE_CHUNK_TILES = 276;
static_assert(WS_HM8 + (size_t)MOE_CHUNK_TILES * 256 * FFE <= WS_END && WS_M8GU + (size_t)8 * 2 * FFE * D <= WS_M8D && WS_M8D + (size_t)8 * D * FFE <= WS_XS8 && WS_XS8 + (size_t)141312 * D <= WS_Y2 && WS_Y2 + (size_t)141312 * D * 2 <= WS_HM8, "moe fp8 map");
static_assert(WS_H + (size_t)NT * FFD * 2 <= WS_QB + 51 * MiB, "dense hidden");

constexpr int CW_BAR = 4096;

constexpr int RING_BYTES = 131072;
constexpr int LDSCTL_OFF = RING_BYTES;
constexpr int LDS_TILEE = LDSCTL_OFF + 256;
constexpr int LDS_MOEI = LDSCTL_OFF + 1024;
constexpr int LDS_BYTES = 147456;

#define LDS_WAIT() asm volatile("s_waitcnt lgkmcnt(0)" ::: "memory")
#define VM_WAIT() asm volatile("s_waitcnt vmcnt(0)" ::: "memory")
typedef __bf16 hwbf16x2 __attribute__((ext_vector_type(2)));
__device__ __forceinline__ unsigned pk2(float lo, float hi) { const f32x2 v = {lo, hi}; const hwbf16x2 b = __builtin_convertvector(v, hwbf16x2); return __builtin_bit_cast(unsigned, b); }
__device__ __forceinline__ unsigned f2bf(float f) { return pk2(f, 0.f) & 0xffffu; }
__device__ __forceinline__ unsigned pk4_fp8(float a, float b, float c, float d) { int w = __builtin_amdgcn_cvt_pk_fp8_f32(a, b, 0, false); w = __builtin_amdgcn_cvt_pk_fp8_f32(c, d, w, true); return (unsigned)w; }
__device__ __forceinline__ float bf2f(unsigned b) { return __builtin_bit_cast(float, b << 16); }
__device__ __forceinline__ float bflo(unsigned w) { return __builtin_bit_cast(float, w << 16); }
__device__ __forceinline__ float bfhi(unsigned w) { return __builtin_bit_cast(float, w & 0xffff0000u); }
__device__ __forceinline__ float wave_sum(float v) {
#pragma unroll
    for (int o = 1; o < 64; o <<= 1) v += __shfl_xor(v, o);
    return v;
}
__device__ __forceinline__ float sigmoidf_(float x) { return 1.f / (1.f + __expf(-x)); }
#define XB_TMO      128
#define XB_XCNT(j)  (256  + 64 * (j))
#define XB_XSUB(j)  (1280 + 64 * (j))
#define XB_XGEN(j)  (2304 + 64 * (j))
#define XB_TOP      3328
#define XB_TOPGEN   3392
#define XCD_BAR_WORDS 3456
#define XB_SPIN_CAP (1u << 18)

__device__ __forceinline__ unsigned xb_ld(unsigned* p)              { return __hip_atomic_load(p, __ATOMIC_RELAXED, __HIP_MEMORY_SCOPE_AGENT); }
__device__ __forceinline__ unsigned xb_add(unsigned* p, unsigned v) { return __hip_atomic_fetch_add(p, v, __ATOMIC_RELAXED, __HIP_MEMORY_SCOPE_AGENT); }
__device__ __forceinline__ unsigned xb_xcc_id() { return (unsigned)__builtin_amdgcn_s_getreg((3 << 11) | 20) & 0xFu; }
#define XB_SPIN(cond, bar) do { unsigned _sp = 0; while (cond) { __builtin_amdgcn_s_sleep(1); \
    if ((++_sp & 255u) == 0u) { if (xb_ld(&(bar)[XB_TMO])) break; if (_sp > XB_SPIN_CAP) { atomicAdd(&(bar)[XB_TMO], 1u); break; } } } } while (0)

struct XcdBarrier {
    int leader; unsigned* bar; unsigned x;
    volatile LAS unsigned* st;
};

__device__ __forceinline__ XcdBarrier xcd_barrier_post(unsigned* bar, volatile LAS unsigned* st, int leader) {
    XcdBarrier b; b.leader = leader; b.bar = bar; b.x = xb_xcc_id(); b.st = st;
    if (leader) (void)xb_add(&bar[XB_XCNT(b.x)], 1u);
    return b;
}
__device__ __forceinline__ void xcd_barrier_complete(unsigned* bar, unsigned x, unsigned& nloc, unsigned& nx) {
    const unsigned G = gridDim.x * gridDim.y * gridDim.z;
    unsigned sum, cnt, mine, sp = 0u;
    for (;;) {
        sum = 0u; cnt = 0u; mine = 0u;
#pragma unroll
        for (unsigned j = 0; j < 16; ++j) { const unsigned c = xb_ld(&bar[XB_XCNT(j)]); sum += c; cnt += (c > 0u) ? 1u : 0u; mine = (j == x) ? c : mine; }
        if (sum == G) break;
        __builtin_amdgcn_s_sleep(1);
        if ((++sp & 255u) == 0u) { if (xb_ld(&bar[XB_TMO])) break; if (sp > XB_SPIN_CAP) { atomicAdd(&bar[XB_TMO], 1u); break; } }
    }
    nloc = mine > 0u ? mine : 1u; nx = cnt > 0u ? cnt : 1u;
}

__device__ __forceinline__ void xcd_barrier(const XcdBarrier& b) {
    asm volatile("s_waitcnt vmcnt(0)" ::: "memory");
    __syncthreads();
    if (b.leader) {
        unsigned* bar = b.bar;
        __builtin_amdgcn_s_waitcnt(0);
        unsigned nloc = b.st[0], nx = b.st[1];
        if (nloc == 0u) { xcd_barrier_complete(bar, b.x, nloc, nx); b.st[0] = nloc; b.st[1] = nx; }
        const unsigned old = xb_add(&bar[XB_XSUB(b.x)], 1u);
        const unsigned gen = old / nloc;
        if (old + 1u == (gen + 1u) * nloc) {
            __builtin_amdgcn_fence(__ATOMIC_RELEASE, "agent");
            asm volatile("s_waitcnt vmcnt(0)" ::: "memory");
            const unsigned og = xb_add(&bar[XB_TOP], 1u);
            const unsigned tg = og / nx;
            if (og + 1u == (tg + 1u) * nx) xb_add(&bar[XB_TOPGEN], 1u);
            else XB_SPIN(xb_ld(&bar[XB_TOPGEN]) == tg, bar);
            __builtin_amdgcn_fence(__ATOMIC_ACQUIRE, "agent");
            xb_add(&bar[XB_XGEN(b.x)], 1u);
            asm volatile("s_waitcnt vmcnt(0)" ::: "memory");
        } else {
            XB_SPIN(xb_ld(&bar[XB_XGEN(b.x)]) == gen, bar);
            __builtin_amdgcn_fence(__ATOMIC_ACQUIRE, "agent");
            asm volatile("s_waitcnt vmcnt(0)" ::: "memory");
        }
    }
    __syncthreads();
}

struct Args { const float* in[N_INPUTS]; float* out; unsigned char* ws; };
struct Frame { LAS unsigned char* lds; int tid, lane, wave, G; };
__device__ __forceinline__ void frame_refresh(Frame& F) { int t = F.wave * 64 + mk_lane(); asm volatile("" : "+v"(t)); F.tid = t; F.lane = t & 63; }
#define CAS __attribute__((address_space(4)))
__device__ __forceinline__ const CAS char* karg() { const CAS char* kp = (const CAS char*)__builtin_amdgcn_kernarg_segment_ptr(); asm volatile("" : "+s"(kp)); return kp; }
__device__ __forceinline__ const float* in_ptr(int i) { return *(const float* const CAS*)(karg() + 8 * i); }
__device__ __forceinline__ float* out_ptr() { return *(float* const CAS*)(karg() + 8 * N_INPUTS); }
__device__ __forceinline__ unsigned char* ws_ptr() { return *(unsigned char* const CAS*)(karg() + 8 * N_INPUTS + 8); }
#define WSP(T, off) ((T*)(ws + (off)))
#define WS_DECL unsigned char* const ws = ws_ptr()

namespace pg8 {
struct EpiStore {
    static constexpr bool PERM = true, AFTER_DRAIN = false;
    bf16_t* O; int ldc; int pm_add; int nN;
    __device__ __forceinline__ void operator()(const f32x4 (&acc)[2][2][4][2], const Unit& u, int wr, int wc, int fr, int fq) const {
        const int row0 = (u.pm + pm_add) * BM + wr * 64 + fr; const int col0 = (u.pn % nN) * BM + wc * 32 + 8 * fq;
#pragma unroll
        for (int ai = 0; ai < 2; ++ai)
#pragma unroll
            for (int m = 0; m < 4; ++m) { bf16_t* rowp = O + (size_t)(row0 + ai * HALF + m * 16) * ldc + col0;
#pragma unroll
                for (int bj = 0; bj < 2; ++bj) { const f32x4 v0 = acc[ai][bj][m][0], v1 = acc[ai][bj][m][1];
                    u32x4 w; w.x = cvt_pk_bf16(v0[0], v0[1]); w.y = cvt_pk_bf16(v0[2], v0[3]); w.z = cvt_pk_bf16(v1[0], v1[1]); w.w = cvt_pk_bf16(v1[2], v1[3]);
                    *(u32x4*)(rowp + bj * HALF) = w; } }
    }
};
__device__ __forceinline__ float silu_mul(float g, float u) { return g * __builtin_amdgcn_rcpf(1.f + __expf(-g)) * u; }
struct EpiSwiGLU {
    static constexpr bool PERM = true, AFTER_DRAIN = false;
    bf16_t* H; int ldh; int pm_sub; int nN;
    __device__ __forceinline__ void operator()(const f32x4 (&acc)[2][2][4][2], const Unit& u, int wr, int wc, int fr, int fq) const {
        const int row0 = (u.pm - pm_sub) * BM + wr * 64 + fr; const int col0 = (u.pn % nN) * HALF + wc * 32 + 8 * fq;
#pragma unroll
        for (int ai = 0; ai < 2; ++ai)
#pragma unroll
            for (int m = 0; m < 4; ++m) { bf16_t* rowp = H + (size_t)(row0 + ai * HALF + m * 16) * ldh + col0;
                const f32x4 g0 = acc[ai][0][m][0], g1 = acc[ai][0][m][1], u0 = acc[ai][1][m][0], u1 = acc[ai][1][m][1];
                u32x4 w; w.x = cvt_pk_bf16(silu_mul(g0[0], u0[0]), silu_mul(g0[1], u0[1])); w.y = cvt_pk_bf16(silu_mul(g0[2], u0[2]), silu_mul(g0[3], u0[3]));
                w.z = cvt_pk_bf16(silu_mul(g1[0], u1[0]), silu_mul(g1[1], u1[1])); w.w = cvt_pk_bf16(silu_mul(g1[2], u1[2]), silu_mul(g1[3], u1[3]));
                *(u32x4*)rowp = w; }
    }
};
struct EpiSwiGLU8 {
    static constexpr bool PERM = true, AFTER_DRAIN = false;
    unsigned char* H; int ldh; int pm_sub; int nN;
    __device__ __forceinline__ void operator()(const f32x4 (&acc)[2][2][4][2], const Unit& u, int wr, int wc, int fr, int fq) const {
        const int row0 = (u.pm - pm_sub) * BM + wr * 64 + fr; const int col0 = (u.pn % nN) * HALF + wc * 32 + 8 * fq;
#pragma unroll
        for (int ai = 0; ai < 2; ++ai)
#pragma unroll
            for (int m = 0; m < 4; ++m) { unsigned char* rowp = H + (size_t)(row0 + ai * HALF + m * 16) * ldh + col0;
                const f32x4 g0 = acc[ai][0][m][0], g1 = acc[ai][0][m][1], u0 = acc[ai][1][m][0], u1 = acc[ai][1][m][1];
                ::v2u w; w.x = ::pk4_fp8(silu_mul(g0[0], u0[0]), silu_mul(g0[1], u0[1]), silu_mul(g0[2], u0[2]), silu_mul(g0[3], u0[3]));
                w.y = ::pk4_fp8(silu_mul(g1[0], u1[0]), silu_mul(g1[1], u1[1]), silu_mul(g1[2], u1[2]), silu_mul(g1[3], u1[3]));
                *(::v2u*)rowp = w; }
    }
};
struct MoeOrder {
    int nM, nN, nwg, G, c, t0, pm_off; const PG8_LAS unsigned char* tile_e;
    __device__ void init(int nM_, int nN_, int G_, int c_, int t0_, int pm_off_, const PG8_LAS unsigned char* te) { nM = nM_; nN = nN_; nwg = nM * nN; G = G_; c = c_; t0 = t0_; pm_off = pm_off_; tile_e = te; }
    __device__ bool next(int i, Unit& u) const {
        const long L = (long)i * G + c; if (L >= nwg) return false;
        int wgid = (int)L; { const int q = nwg / NXCD, r = nwg % NXCD, xcd = wgid % NXCD, off = wgid / NXCD; wgid = (xcd < r ? xcd * (q + 1) : r * (q + 1) + (xcd - r) * q) + off; }
        const int nig = WGM * nN, gid = wgid / nig, fm = gid * WGM, gsz = (nM - fm) < WGM ? (nM - fm) : WGM;
        const int pml = fm + ((wgid % nig) % gsz), pnl = (wgid % nig) / gsz;
        const int e = tile_e[t0 + pml];
        u.pm = pm_off + pml; u.pn = e * nN + pnl; return true;
    }
    __device__ __forceinline__ void a_ready(const Unit&) const {}
    __device__ __forceinline__ void done(const Unit&) const {}
};
}

__device__ __forceinline__ void tr_item(const float* W, int ldw, int k0, int c0, bf16* WT, int K, int drow, LAS float* scr, int lane) {
#pragma unroll 8
    for (int i = 0; i < 32; ++i) { const int kk = 2 * i + (lane >> 5); scr[kk * 33 + (lane & 31)] = W[(size_t)(k0 + kk) * ldw + c0 + (lane & 31)]; }
    LDS_WAIT(); asm volatile("" ::: "memory");
    const int c = lane & 7;
#pragma unroll
    for (int j = 0; j < 4; ++j) { const int n = (lane >> 3) + 8 * j; const LAS float* s = scr + (8 * c) * 33 + n;
        v4u o; o.x = pk2(s[0 * 33], s[1 * 33]); o.y = pk2(s[2 * 33], s[3 * 33]); o.z = pk2(s[4 * 33], s[5 * 33]); o.w = pk2(s[6 * 33], s[7 * 33]);
        *(GAS v4u*)(WT + (size_t)(drow + n) * K + k0 + 8 * c) = o; }
    LDS_WAIT(); asm volatile("" ::: "memory");
}
__device__ __forceinline__ void tr_item8(const float* W, int ldw, int k0, int c0, unsigned char* WT, int K, int drow, LAS float* scr, int lane, float scale) {
#pragma unroll 8
    for (int i = 0; i < 32; ++i) { const int kk = 2 * i + (lane >> 5); scr[kk * 33 + (lane & 31)] = W[(size_t)(k0 + kk) * ldw + c0 + (lane & 31)]; }
    LDS_WAIT(); asm volatile("" ::: "memory");
    const int c = lane & 7;
#pragma unroll
    for (int j = 0; j < 4; ++j) { const int n = (lane >> 3) + 8 * j; const LAS float* s = scr + (8 * c) * 33 + n;
        v2u o; o.x = pk4_fp8(s[0 * 33] * scale, s[1 * 33] * scale, s[2 * 33] * scale, s[3 * 33] * scale); o.y = pk4_fp8(s[4 * 33] * scale, s[5 * 33] * scale, s[6 * 33] * scale, s[7 * 33] * scale);
        *(GAS v2u*)(WT + (size_t)(drow + n) * K + k0 + 8 * c) = o; }
    LDS_WAIT(); asm volatile("" ::: "memory");
}
__device__ __forceinline__ void conv_matrix(Frame& F, const float* W, int K, int ldw, int cbeg, int ncols, bf16* WT, int mode, int rowoff, int& cursor, float f8scale = 0.f) {
    const int gw = blockIdx.x * NWAVES + F.wave, NGW = F.G * NWAVES;
    const int nblk = ncols / 32, nit = (K / 64) * nblk;
    LAS float* scr = (LAS float*)(F.lds + F.wave * 16384);
    int first = cursor + (((gw - cursor) % NGW) + NGW) % NGW;
    for (int it = first; it < cursor + nit; it += NGW) {
        const int idx = it - cursor, kb = idx / nblk, nb = idx % nblk, n = 32 * nb;
        const int drow = mode == 0 ? rowoff + n : ((n >> 7) * 256 + (n & 127) + rowoff);
        if (f8scale != 0.f) tr_item8(W, ldw, 64 * kb, cbeg + n, (unsigned char*)WT, K, drow, scr, F.lane, f8scale); else tr_item(W, ldw, 64 * kb, cbeg + n, WT, K, drow, scr, F.lane);
    }
    cursor += nit;
}

__device__ __forceinline__ void phase_mod(Frame& F) { WS_DECL; frame_refresh(F);
    LAS float* sv = (LAS float*)F.lds;
    LAS float* red = (LAS float*)(F.lds + 69632);
    float* MOD = WSP(float, WS_MOD);
    if ((int)blockIdx.x < 192) {
        const float* cl_ = in_ptr(I_C); const float* cc_ = in_ptr(I_CCTX); const float* adab = in_ptr(I_ADAB); const float* adaw = in_ptr(I_ADAW);
        for (int i = F.tid; i < 17 * 1024; i += NTHR) { const int b = i >> 10, k = i & 1023; const float c = b < 16 ? cl_[b * 1024 + k] : cc_[k]; sv[i] = c / (1.f + expf(-c)); }
        __syncthreads();
        for (int item = blockIdx.x; item < 192; item += F.G) {
            const int li = item / 48, cg = item % 48, cl = F.tid & 127, kq = F.tid >> 7;
            const float* W = adaw + (size_t)li * 1024 * 6144 + cg * 128 + cl;
            float acc[17];
#pragma unroll
            for (int b = 0; b < 17; ++b) acc[b] = 0.f;
            for (int k = kq * 256; k < kq * 256 + 256; ++k) { const float w = W[(size_t)k * 6144];
#pragma unroll
                for (int b = 0; b < 17; ++b) acc[b] += sv[b * 1024 + k] * w; }
#pragma unroll
            for (int b = 0; b < 17; ++b) red[(kq * 17 + b) * 128 + cl] = acc[b];
            __syncthreads();
            for (int o = F.tid; o < 17 * 128; o += NTHR) { const int b = o >> 7, c = o & 127;
                const float s = (red[(0 * 17 + b) * 128 + c] + red[(1 * 17 + b) * 128 + c]) + (red[(2 * 17 + b) * 128 + c] + red[(3 * 17 + b) * 128 + c]);
                MOD[((size_t)li * 17 + b) * 6144 + cg * 128 + c] = s + adab[li * 6144 + cg * 128 + c]; }
            __syncthreads();
        }
    }
}

__device__ __forceinline__ void phase_pro0(Frame& F) { WS_DECL; frame_refresh(F);
    phase_mod(F);
    __syncthreads();
    int cursor = 0;
    for (int li = 0; li < DEPTH; ++li) {
        conv_matrix(F, in_ptr(I_WIN) + (size_t)li * D * N_IN, D, N_IN, 0, D_OFF, WSP(bf16, WS_WINT) + (size_t)li * PCOLS * D, 0, 0, cursor);
        conv_matrix(F, in_ptr(I_WIN) + (size_t)li * D * N_IN, D, N_IN, D_OFF, HYC, WSP(bf16, WS_WHYT) + (size_t)li * HYC * D, 0, 0, cursor);
        conv_matrix(F, in_ptr(I_WOUT) + (size_t)li * D * D, D, D, 0, D, WSP(bf16, WS_WOUTT) + (size_t)li * D * D, 0, 0, cursor);
    }
    for (int j = 0; j < 2; ++j) {
        conv_matrix(F, in_ptr(I_FG) + (size_t)j * D * FFD, D, FFD, 0, FFD, (bf16*)(WSP(unsigned char, WS_WGUT) + (size_t)j * 2 * FFD * D), 1, 0, cursor, 64.f);
        conv_matrix(F, in_ptr(I_FU) + (size_t)j * D * FFD, D, FFD, 0, FFD, (bf16*)(WSP(unsigned char, WS_WGUT) + (size_t)j * 2 * FFD * D), 1, 128, cursor, 64.f);
        conv_matrix(F, in_ptr(I_FD) + (size_t)j * FFD * D, FFD, D, 0, D, WSP(bf16, WS_WDT) + (size_t)j * D * FFD, 0, 0, cursor);
    }
    { const int gt = blockIdx.x * NTHR + F.tid, NGT = F.G * NTHR; const int per = (PCOLS - D_OFF) * D / 8;
      for (int i = gt; i < DEPTH * per; i += NGT) { const int li = i / per, r = i % per; *(GAS v4u*)(WSP(bf16, WS_WINT) + (size_t)li * PCOLS * D + (size_t)D_OFF * D + (size_t)r * 8) = (v4u){0u, 0u, 0u, 0u}; } }
}

struct Stream { const float* inl; const float* inc; float* outl; float* outc; };
__device__ __forceinline__ Stream make_stream(unsigned char* ws, int li) { Stream s; s.outl = out_ptr(); s.outc = WSP(float, WS_XC); s.inl = li == 0 ? in_ptr(I_X) : (const float*)s.outl; s.inc = li == 0 ? in_ptr(I_CTX) : (const float*)s.outc; return s; }
__device__ __forceinline__ const float* stream_in(const Stream& s, int m) { return m < NL ? s.inl + (size_t)m * D : s.inc + (size_t)(m - NL) * D; }
__device__ __forceinline__ float* stream_out(const Stream& s, int m) { return m < NL ? s.outl + (size_t)m * D : s.outc + (size_t)(m - NL) * D; }
__device__ __forceinline__ int mod_b(int m) { return m < NL ? (m >> 12) : 16; }
__device__ __forceinline__ const float* mod_vec(unsigned char* ws, int li, int b, int j) { return WSP(float, WS_MOD) + ((size_t)li * 17 + b) * 6144 + j * 1024; }

__device__ __forceinline__ void store_modulated(const f32x4 (&x)[4], const float* shift, const float* scale, bf16* orow, int lane) {
#pragma unroll
    for (int j = 0; j < 4; ++j) { const int c = 4 * lane + 256 * j; const f32x4 sh = *(const GAS f32x4*)(shift + c), sc = *(const GAS f32x4*)(scale + c);
        const f32x4 h = x[j] * (sc + 1.f) + sh; v2u w; w.x = pk2(h.x, h.y); w.y = pk2(h.z, h.w); *(GAS v2u*)(orow + c) = w; }
}
__device__ __forceinline__ void rows_range(const Frame& F, int nrows, int& r0, int& r1) { const int per = (nrows + F.G - 1) / F.G; r0 = blockIdx.x * per; r1 = r0 + per < nrows ? r0 + per : nrows; if (r0 > nrows) r0 = nrows; }

__device__ __forceinline__ void phase_hin0(Frame& F) { WS_DECL; frame_refresh(F);
    int r0, r1; rows_range(F, NT, r0, r1); const Stream st = make_stream(ws, 0);
    for (int m = r0 + F.wave; m < r1; m += NWAVES) {
        const float* xr = stream_in(st, m); f32x4 x[4];
#pragma unroll
        for (int j = 0; j < 4; ++j) x[j] = *(const GAS f32x4*)(xr + 4 * F.lane + 256 * j);
        const int b = mod_b(m);
        store_modulated(x, mod_vec(ws, 0, b, 0), mod_vec(ws, 0, b, 1), WSP(bf16, WS_A1) + (size_t)m * D, F.lane);
    }
}

__device__ __forceinline__ void ln_rows(f32x4 (&v)[4], const float* g, const float* bta, int lane) {
    float s = 0.f;
#pragma unroll
    for (int j = 0; j < 4; ++j) s += (v[j].x + v[j].y) + (v[j].z + v[j].w);
    const float mean = wave_sum(s) * (1.f / D); float s2 = 0.f;
#pragma unroll
    for (int j = 0; j < 4; ++j) { v[j] = v[j] - mean; s2 += (v[j].x * v[j].x + v[j].y * v[j].y) + (v[j].z * v[j].z + v[j].w * v[j].w); }
    const float rstd = __builtin_amdgcn_rsqf(wave_sum(s2) * (1.f / D) + 1e-5f);
#pragma unroll
    for (int j = 0; j < 4; ++j) { const int c = 4 * lane + 256 * j; v[j] = v[j] * rstd * *(const GAS f32x4*)(g + c) + *(const GAS f32x4*)(bta + c); }
}

template <bool HAVE_Y>
__device__ __forceinline__ void phase_ln1(Frame& F, int li) { WS_DECL; frame_refresh(F); constexpr bool DRY_OR_BF16 = false;
    const int nrows = li == DEPTH - 1 ? NL : NT; const bool moe = li & 1; const int lane = F.lane;
    LAS int* hist = (LAS int*)(F.lds + LDS_MOEI) + 56; LAS float* ROUT = (LAS float*)F.lds;
    if (moe) { if (F.tid < 8) hist[F.tid] = 0; const float* router = in_ptr(I_ROUTER) + (size_t)(li >> 1) * D * NE; for (int i = F.tid; i < D * NE / 4; i += NTHR) *(LAS f32x4*)(ROUT + 4 * i) = *(const GAS f32x4*)(router + 4 * i); __syncthreads(); }
    int r0, r1; rows_range(F, nrows, r0, r1);
    const float* g = in_ptr(I_LN1G) + li * D; const float* bt = in_ptr(I_LN1B) + li * D; const Stream st = make_stream(ws, li); const bf16* Y = WSP(bf16, WS_Y);
    f32x4 xn[4]; v2u yn[4];
    { const int m = r0 + F.wave; if (m < r1) { const float* xr = stream_in(st, m);
#pragma unroll
        for (int j = 0; j < 4; ++j) { const int c = 4 * lane + 256 * j; xn[j] = *(const GAS f32x4*)(xr + c); if (HAVE_Y) yn[j] = *(const GAS v2u*)(Y + (size_t)m * D + c); } } }
    for (int m = r0 + F.wave; m < r1; m += NWAVES) {
        const int b = mod_b(m); f32x4 v[4]; v2u yw[4];
#pragma unroll
        for (int j = 0; j < 4; ++j) { v[j] = xn[j]; if (HAVE_Y) yw[j] = yn[j]; }
        if (m + NWAVES < r1) { const float* xr = stream_in(st, m + NWAVES);
#pragma unroll
            for (int j = 0; j < 4; ++j) { const int c = 4 * lane + 256 * j; xn[j] = *(const GAS f32x4*)(xr + c); if (HAVE_Y) yn[j] = *(const GAS v2u*)(Y + (size_t)(m + NWAVES) * D + c); } }
        const float* m2 = mod_vec(ws, li, b, 2);
#pragma unroll
        for (int j = 0; j < 4; ++j) { const int c = 4 * lane + 256 * j; v[j] = v[j] * ALPHA;
            if (HAVE_Y) { const f32x4 mm = *(const GAS f32x4*)(m2 + c); v[j].x += mm.x * bflo(yw[j].x); v[j].y += mm.y * bfhi(yw[j].x); v[j].z += mm.z * bflo(yw[j].y); v[j].w += mm.w * bfhi(yw[j].y); } }
        ln_rows(v, g, bt, lane);
        float* xo = stream_out(st, m);
#pragma unroll
        for (int j = 0; j < 4; ++j) *(GAS f32x4*)(xo + 4 * lane + 256 * j) = v[j];
        const float* sh = mod_vec(ws, li, b, 3); const float* sc = mod_vec(ws, li, b, 4);
        if (moe) {
            float lg[NE];
#pragma unroll
            for (int e = 0; e < NE; ++e) lg[e] = 0.f;
#pragma unroll
            for (int j = 0; j < 4; ++j) { const int c = 4 * lane + 256 * j; const f32x4 s4 = *(const GAS f32x4*)(sh + c), c4 = *(const GAS f32x4*)(sc + c); const f32x4 f = v[j] * (c4 + 1.f) + s4;
#pragma unroll
                for (int q = 0; q < 4; ++q) { const f32x4 ra = *(const LAS f32x4*)(ROUT + (c + q) * NE), rb = *(const LAS f32x4*)(ROUT + (c + q) * NE + 4); const float fq = f[q];
                    lg[0] += fq * ra.x; lg[1] += fq * ra.y; lg[2] += fq * ra.z; lg[3] += fq * ra.w; lg[4] += fq * rb.x; lg[5] += fq * rb.y; lg[6] += fq * rb.z; lg[7] += fq * rb.w; } }
#pragma unroll
            for (int e = 0; e < NE; ++e) lg[e] = wave_sum(lg[e]);
            int e0 = 0; float v0 = lg[0];
#pragma unroll
            for (int e = 1; e < NE; ++e) if (lg[e] > v0) { v0 = lg[e]; e0 = e; }
            int e1 = -1; float v1 = -3.0e38f;
#pragma unroll
            for (int e = 0; e < NE; ++e) if (e != e0 && lg[e] > v1) { v1 = lg[e]; e1 = e; }
            const float ex = __expf(v1 - v0), g0 = 1.f / (1.f + ex), g1 = ex * g0;
            if (lane == 0) { *(GAS v2u*)(WSP(int, WS_TOKE) + 2 * (size_t)m) = (v2u){(unsigned)e0, (unsigned)e1}; *(GAS f32x2*)(WSP(float, WS_TOKG) + 2 * (size_t)m) = (f32x2){g0, g1};
                atomicAdd((int*)(hist + e0), 1); atomicAdd((int*)(hist + e1), 1); }
        }
        if (!DRY_OR_BF16) {
            unsigned char* orow = WSP(unsigned char, WS_A1) + (size_t)m * D;
#pragma unroll
            for (int j = 0; j < 4; ++j) { const int c = 4 * lane + 256 * j; const f32x4 s4 = *(const GAS f32x4*)(sh + c), c4 = *(const GAS f32x4*)(sc + c); const f32x4 f = v[j] * (c4 + 1.f) + s4;
                *(GAS unsigned*)(orow + c) = pk4_fp8(f.x, f.y, f.z, f.w); }
        } else store_modulated(v, sh, sc, WSP(bf16, WS_A1) + (size_t)m * D, lane);
    }
    if (moe) { __syncthreads(); if (F.tid < 8) WSP(int, WS_BLKCNT)[blockIdx.x * 8 + F.tid] = hist[F.tid]; }
}

template <bool HAVE_FFN>
__device__ __forceinline__ void phase_ln2(Frame& F, int li) { WS_DECL; frame_refresh(F);
    const int nrows = li == DEPTH - 1 ? NL : NT; const bool moe = li & 1; const int lane = F.lane;
    int r0, r1; rows_range(F, nrows, r0, r1);
    const float* g = in_ptr(I_LN2G) + li * D; const float* bt = in_ptr(I_LN2B) + li * D; const Stream st = make_stream(ws, 1);
    const bf16* Y = WSP(bf16, WS_Y); const bf16* XS = WSP(bf16, WS_Y2); const int* TOKS = WSP(int, WS_TOKS); const float* TOKG = WSP(float, WS_TOKG);
    f32x4 xn[4]; v2u ya[4], yb[4]; v2u sn = (v2u){0u, 0u}; f32x2 gn = (f32x2){0.f, 0.f}, gc = (f32x2){0.f, 0.f};
    const int mf = r0 + F.wave;
    if (mf < r1) { const float* xr = stream_out(st, mf); v2u s0 = (v2u){0u, 0u};
        if (moe) { s0 = *(const GAS v2u*)(TOKS + 2 * (size_t)mf); gc = *(const GAS f32x2*)(TOKG + 2 * (size_t)mf); if (mf + NWAVES < r1) { sn = *(const GAS v2u*)(TOKS + 2 * (size_t)(mf + NWAVES)); gn = *(const GAS f32x2*)(TOKG + 2 * (size_t)(mf + NWAVES)); } }
#pragma unroll
        for (int j = 0; j < 4; ++j) { const int c = 4 * lane + 256 * j; xn[j] = *(const GAS f32x4*)(xr + c);
            if (HAVE_FFN) { if (moe) { ya[j] = *(const GAS v2u*)(XS + (size_t)s0.x * D + c); yb[j] = *(const GAS v2u*)(XS + (size_t)s0.y * D + c); } else ya[j] = *(const GAS v2u*)(Y + (size_t)mf * D + c); } } }
    for (int m = mf; m < r1; m += NWAVES) {
        const int b = mod_b(m); f32x4 v[4]; v2u wa[4], wb[4]; const f32x2 gg = gc;
#pragma unroll
        for (int j = 0; j < 4; ++j) { v[j] = xn[j]; wa[j] = ya[j]; wb[j] = yb[j]; }
        const int mn = m + NWAVES;
        if (mn < r1) { const float* xr = stream_out(st, mn); const v2u s1 = sn; gc = gn;
            if (moe && mn + NWAVES < r1) { sn = *(const GAS v2u*)(TOKS + 2 * (size_t)(mn + NWAVES)); gn = *(const GAS f32x2*)(TOKG + 2 * (size_t)(mn + NWAVES)); }
#pragma unroll
            for (int j = 0; j < 4; ++j) { const int c = 4 * lane + 256 * j; xn[j] = *(const GAS f32x4*)(xr + c);
                if (HAVE_FFN) { if (moe) { ya[j] = *(const GAS v2u*)(XS + (size_t)s1.x * D + c); yb[j] = *(const GAS v2u*)(XS + (size_t)s1.y * D + c); } else ya[j] = *(const GAS v2u*)(Y + (size_t)mn * D + c); } } }
        const float* m5 = mod_vec(ws, li, b, 5);
#pragma unroll
        for (int j = 0; j < 4; ++j) { const int c = 4 * lane + 256 * j; v[j] = v[j] * ALPHA;
            if (HAVE_FFN) { const f32x4 mm = *(const GAS f32x4*)(m5 + c); f32x4 o;
                if (moe) { o.x = gg.x * bflo(wa[j].x) + gg.y * bflo(wb[j].x); o.y = gg.x * bfhi(wa[j].x) + gg.y * bfhi(wb[j].x); o.z = gg.x * bflo(wa[j].y) + gg.y * bflo(wb[j].y); o.w = gg.x * bfhi(wa[j].y) + gg.y * bfhi(wb[j].y); }
                else { o.x = bflo(wa[j].x); o.y = bfhi(wa[j].x); o.z = bflo(wa[j].y); o.w = bfhi(wa[j].y); }
                v[j] = v[j] + mm * o; } }
        ln_rows(v, g, bt, lane);
        float* xo = stream_out(st, m);
#pragma unroll
        for (int j = 0; j < 4; ++j) *(GAS f32x4*)(xo + 4 * lane + 256 * j) = v[j];
        if (li < DEPTH - 1) store_modulated(v, mod_vec(ws, li + 1, b, 0), mod_vec(ws, li + 1, b, 1), WSP(bf16, WS_A1) + (size_t)m * D, lane);
    }
}

__device__ __forceinline__ void phase_moe_weights(Frame& F, int li) { WS_DECL; frame_refresh(F);
    const int j = li >> 1; int cursor = 0;
    for (int e = 0; e < NE; ++e) {
        conv_matrix(F, in_ptr(I_MG) + ((size_t)j * NE + e) * D * FFE, D, FFE, 0, FFE, (bf16*)(WSP(unsigned char, WS_M8GU) + (size_t)e * 2 * FFE * D), 1, 0, cursor, 64.f);
        conv_matrix(F, in_ptr(I_MU) + ((size_t)j * NE + e) * D * FFE, D, FFE, 0, FFE, (bf16*)(WSP(unsigned char, WS_M8GU) + (size_t)e * 2 * FFE * D), 1, 128, cursor, 64.f);
        conv_matrix(F, in_ptr(I_MD) + ((size_t)j * NE + e) * FFE * D, FFE, D, 0, D, (bf16*)(WSP(unsigned char, WS_M8D) + (size_t)e * D * FFE), 0, 0, cursor, 256.f);
    }
}

__device__ __forceinline__ void phase_moe_slots(Frame& F, int li) { WS_DECL; frame_refresh(F);
    const int nrows = li == DEPTH - 1 ? NL : NT;
    LAS int* mi = (LAS int*)(F.lds + LDS_MOEI); LAS unsigned char* tile_e = (LAS unsigned char*)(F.lds + LDS_TILEE);
    LAS int* slots = (LAS int*)F.lds;
    const int* blkcnt = WSP(int, WS_BLKCNT);
    if (F.tid < 8) { int tot = 0, pre = 0; for (int b = 0; b < F.G; ++b) { const int c = blkcnt[b * 8 + F.tid]; if (b < (int)blockIdx.x) pre += c; tot += c; } mi[16 + F.tid] = tot; mi[32 + F.tid] = pre; }
    __syncthreads();
    if (F.tid == 0) { int s = 0; for (int e = 0; e < NE; ++e) { mi[e] = s; s += (mi[16 + e] + 255) & ~255; } mi[8] = s; mi[48] = s >> 8; }
    __syncthreads();
    for (int t = F.tid; t < MOE_MAX_TILES + 8; t += NTHR) { int e = 0;
#pragma unroll
        for (int q = 1; q < NE; ++q) if (t * 256 >= mi[q]) e = q;
        tile_e[t] = (unsigned char)e; }
    int r0, r1; rows_range(F, nrows, r0, r1);
    const int na = 2 * (r1 - r0);
    if (F.wave == 0) {
        int run[NE];
#pragma unroll
        for (int e = 0; e < NE; ++e) run[e] = mi[e] + mi[32 + e];
        for (int base = 0; base < na; base += 64) { const int ai = base + F.lane; const bool ok = ai < na;
            const int e = ok ? WSP(int, WS_TOKE)[2 * (size_t)r0 + ai] : -1; int slot = 0;
#pragma unroll
            for (int q = 0; q < NE; ++q) { const unsigned long long mk = __ballot(e == q); if (e == q) slot = run[q] + __popcll(mk & ((1ull << F.lane) - 1ull)); run[q] += __popcll(mk); }
            if (ok) { slots[ai] = slot; WSP(int, WS_TOKS)[2 * (size_t)r0 + ai] = slot; } }
    }
    __syncthreads();
    for (int ai = F.wave; ai < na; ai += NWAVES) { const int m = r0 + (ai >> 1), slot = slots[ai];
        const GAS v4u* src = (const GAS v4u*)(WSP(unsigned char, WS_A1) + (size_t)m * D); GAS v4u* dst = (GAS v4u*)(WSP(unsigned char, WS_XS8) + (size_t)slot * D);
        dst[F.lane] = src[F.lane]; }
    { const int gw = blockIdx.x * NWAVES + F.wave, NGW = F.G * NWAVES; int cnt = 0;
      for (int e = 0; e < NE; ++e) { const int p0 = mi[e] + mi[16 + e], p1 = mi[e + 1];
          for (int s = p0; s < p1; ++s, ++cnt) if (cnt % NGW == gw) { GAS v4u* dst = (GAS v4u*)(WSP(unsigned char, WS_XS8) + (size_t)s * D); dst[F.lane] = (v4u){0u, 0u, 0u, 0u}; } } }
    __syncthreads();
}

constexpr float QSCALE = 0.14724319f;
constexpr int MP_CQ_LD = 200, MP_CKV_LD = 136;
__device__ __forceinline__ void phase_mla_prep(Frame& F, int li) { WS_DECL; frame_refresh(F);
    LAS bf16* CQN = (LAS bf16*)F.lds; LAS bf16* CKVN = (LAS bf16*)(F.lds + 64 * MP_CQ_LD * 2);
    const bf16* P = WSP(bf16, WS_P); bf16* QB = WSP(bf16, WS_QB); bf16* KB = WSP(bf16, WS_KB); bf16* VT = WSP(bf16, WS_VT);
    const float* qn = in_ptr(I_QNORM) + li * 192; const float* kvn = in_ptr(I_KVNORM) + li * 128;
    const bf16* WQ = WSP(bf16, WS_WUQT) + (size_t)li * 384 * 192; const bf16* WKV = WSP(bf16, WS_WUKVT) + (size_t)li * 512 * 128;
    const float* RC = WSP(float, WS_ROPE); const float* RS = RC + 4096 * 16;
    const int lane = F.lane, wave = F.wave;
    const int head = wave >> 1, half = wave & 1, fr = lane & 15, kg = lane >> 4;
    for (int item = blockIdx.x; item < NT / 64; item += F.G) {
        const int m0 = item * 64; const bool isctx = m0 >= NL; const int b = isctx ? (m0 - NL) >> 8 : m0 >> 12; const int t0 = isctx ? (m0 - NL) & 255 : m0 & 4095;
        const int ki0 = isctx ? t0 : 256 + t0;
        bf16x8 wq[3][6];
#pragma unroll
        for (int i = 0; i < 3; ++i)
#pragma unroll
            for (int ks = 0; ks < 6; ++ks) wq[i][ks] = *(const GAS bf16x8*)(WQ + (size_t)(96 * head + 16 * (3 * half + i) + fr) * 192 + 32 * ks + 8 * kg);
        v4u rawv[8]; unsigned short kr1[8], kr2[8];
#pragma unroll
        for (int i = 0; i < 8; ++i) { const bf16* pr = P + (size_t)(m0 + wave * 8 + i) * PCOLS; rawv[i] = (v4u){0u, 0u, 0u, 0u}; if (lane < 40) rawv[i] = *(const GAS v4u*)(pr + 8 * lane);
            kr1[i] = 0; kr2[i] = 0; if (lane < 16) { kr1[i] = pr[320 + lane]; kr2[i] = pr[336 + lane]; } }
#pragma unroll
        for (int i = 0; i < 8; ++i) { const int tl = wave * 8 + i; const v4u raw = rawv[i];
            float x[8]; x[0] = bflo(raw.x); x[1] = bfhi(raw.x); x[2] = bflo(raw.y); x[3] = bfhi(raw.y); x[4] = bflo(raw.z); x[5] = bfhi(raw.z); x[6] = bflo(raw.w); x[7] = bfhi(raw.w);
            float ss = 0.f;
#pragma unroll
            for (int j = 0; j < 8; ++j) ss += x[j] * x[j];
            const float sq = wave_sum(lane < 24 ? ss : 0.f), skv = wave_sum((lane >= 24 && lane < 40) ? ss : 0.f);
            const float rq = __builtin_amdgcn_rsqf(sq * (1.f / 192.f) + 1e-6f), rkv = __builtin_amdgcn_rsqf(skv * (1.f / 128.f) + 1e-6f);
            if (lane < 24) { const float* g = qn + 8 * lane; v4u o; o.x = pk2(x[0] * rq * g[0], x[1] * rq * g[1]); o.y = pk2(x[2] * rq * g[2], x[3] * rq * g[3]); o.z = pk2(x[4] * rq * g[4], x[5] * rq * g[5]); o.w = pk2(x[6] * rq * g[6], x[7] * rq * g[7]);
                *(LAS v4u*)(CQN + tl * MP_CQ_LD + 8 * lane) = o; }
            else if (lane < 40) { const int c = 8 * (lane - 24); const float* g = kvn + c; v4u o; o.x = pk2(x[0] * rkv * g[0], x[1] * rkv * g[1]); o.y = pk2(x[2] * rkv * g[2], x[3] * rkv * g[3]); o.z = pk2(x[4] * rkv * g[4], x[5] * rkv * g[5]); o.w = pk2(x[6] * rkv * g[6], x[7] * rkv * g[7]);
                *(LAS v4u*)(CKVN + tl * MP_CKV_LD + c) = o; }
            if (lane < 16) { float x1 = bf2f(kr1[i]), x2 = bf2f(kr2[i]);
                if (!isctx) { const float c = RC[(t0 + tl) * 16 + lane], s = RS[(t0 + tl) * 16 + lane]; const float y1 = x1 * c - x2 * s, y2 = x1 * s + x2 * c; x1 = y1; x2 = y2; }
                const bf16 o1 = (bf16)f2bf(x1), o2 = (bf16)f2bf(x2);
#pragma unroll
                for (int h = 0; h < 4; ++h) { bf16* kr = KB + ((size_t)(b * 4 + h) * KSEQ + ki0 + tl) * 96; kr[64 + lane] = o1; kr[80 + lane] = o2; } }
        }
        __syncthreads();
        const size_t qrow0 = ((size_t)(b * 4 + head) * KSEQ + ki0) * 96;
        { f32x4 acc[3][4];
#pragma unroll
          for (int i = 0; i < 3; ++i)
#pragma unroll
              for (int m = 0; m < 4; ++m) acc[i][m] = (f32x4){0.f, 0.f, 0.f, 0.f};
#pragma unroll
          for (int ks = 0; ks < 6; ++ks)
#pragma unroll
              for (int m = 0; m < 4; ++m) { const bf16x8 xf = *(const LAS bf16x8*)(CQN + (16 * m + fr) * MP_CQ_LD + 32 * ks + 8 * kg);
#pragma unroll
                  for (int i = 0; i < 3; ++i) acc[i][m] = __builtin_amdgcn_mfma_f32_16x16x32_bf16(wq[i][ks], xf, acc[i][m], 0, 0, 0); }
#pragma unroll
          for (int m = 0; m < 4; ++m) { bf16* qr = QB + qrow0 + (size_t)(16 * m + fr) * 96;
              { v2u o; o.x = pk2(acc[0][m][0] * QSCALE, acc[0][m][1] * QSCALE); o.y = pk2(acc[0][m][2] * QSCALE, acc[0][m][3] * QSCALE); *(GAS v2u*)(qr + 48 * half + 4 * kg) = o; }
              f32x4 y1 = acc[1][m], y2 = acc[2][m];
              if (half == 1 && !isctx) { const int t = t0 + 16 * m + fr; const f32x4 c = *(const GAS f32x4*)(RC + t * 16 + 4 * kg), sn = *(const GAS f32x4*)(RS + t * 16 + 4 * kg); y1 = acc[1][m] * c - acc[2][m] * sn; y2 = acc[1][m] * sn + acc[2][m] * c; }
              v2u o1, o2; o1.x = pk2(y1[0] * QSCALE, y1[1] * QSCALE); o1.y = pk2(y1[2] * QSCALE, y1[3] * QSCALE); o2.x = pk2(y2[0] * QSCALE, y2[1] * QSCALE); o2.y = pk2(y2[2] * QSCALE, y2[3] * QSCALE);
              *(GAS v2u*)(qr + 48 * half + 16 + 4 * kg) = o1; *(GAS v2u*)(qr + 48 * half + 32 + 4 * kg) = o2; } }
        bf16x8 wkv[4][4];
#pragma unroll
        for (int nt = 0; nt < 4; ++nt)
#pragma unroll
            for (int ks = 0; ks < 4; ++ks) wkv[nt][ks] = *(const GAS bf16x8*)(WKV + (size_t)(128 * head + 64 * half + 16 * nt + fr) * 128 + 32 * ks + 8 * kg);
        { f32x4 acc[4][4];
#pragma unroll
          for (int nt = 0; nt < 4; ++nt)
#pragma unroll
              for (int m = 0; m < 4; ++m) acc[nt][m] = (f32x4){0.f, 0.f, 0.f, 0.f};
#pragma unroll
          for (int ks = 0; ks < 4; ++ks)
#pragma unroll
              for (int m = 0; m < 4; ++m) { const bf16x8 xf = *(const LAS bf16x8*)(CKVN + (16 * m + fr) * MP_CKV_LD + 32 * ks + 8 * kg);
#pragma unroll
                  for (int nt = 0; nt < 4; ++nt) acc[nt][m] = half == 0 ? __builtin_amdgcn_mfma_f32_16x16x32_bf16(wkv[nt][ks], xf, acc[nt][m], 0, 0, 0) : __builtin_amdgcn_mfma_f32_16x16x32_bf16(xf, wkv[nt][ks], acc[nt][m], 0, 0, 0); }
#pragma unroll
          for (int nt = 0; nt < 4; ++nt)
#pragma unroll
              for (int m = 0; m < 4; ++m) { v2u o; o.x = pk2(acc[nt][m][0], acc[nt][m][1]); o.y = pk2(acc[nt][m][2], acc[nt][m][3]);
                  if (half == 0) *(GAS v2u*)(KB + qrow0 + (size_t)(16 * m + fr) * 96 + 16 * nt + 4 * kg) = o;
                  else *(GAS v2u*)(VT + ((size_t)(b * 4 + head) * 64 + 16 * nt + fr) * KSEQ + ki0 + 16 * m + 4 * kg) = o; } }
        __syncthreads();
    }
}

constexpr int AT_KLD = 104, AT_VLD = 72;
constexpr int AT_KB = 64 * AT_KLD * 2, AT_VB = 64 * AT_VLD * 2, AT_BUF = AT_KB + AT_VB;
__device__ __forceinline__ void phase_attn(Frame& F, int li) { WS_DECL; frame_refresh(F);
    const bf16* QB = WSP(bf16, WS_QB); const bf16* KB = WSP(bf16, WS_KB); const bf16* VT = WSP(bf16, WS_VT); bf16* AO = WSP(bf16, WS_AO);
    const int lane = F.lane, wave = F.wave, tid = F.tid, ql = lane & 31, h2 = lane >> 5;
    const int nunits = 1024 + (li < DEPTH - 1 ? 64 : 0);
    const int c = blockIdx.x, vc = (F.G == 256) ? (c & 7) * 32 + (c >> 3) : c;
    for (int u = vc; u < nunits; u += F.G) {
        int bh, q0, nk; bool isctx = u >= 1024;
        if (!isctx) { bh = u >> 4; q0 = 256 + 256 * (u & 15); nk = KSEQ; } else { bh = u - 1024; q0 = 0; nk = 256; }
        const bf16* Kb = KB + (size_t)bh * KSEQ * 96; const bf16* Vb = VT + (size_t)bh * 64 * KSEQ;
        bf16x8 qf[6];
        { const bf16* qr = QB + ((size_t)bh * KSEQ + q0 + 32 * wave + ql) * 96 + 8 * h2;
#pragma unroll
          for (int ks = 0; ks < 6; ++ks) qf[ks] = *(const GAS bf16x8*)(qr + 16 * ks); }
        f32x16 O0, O1;
#pragma unroll
        for (int r = 0; r < 16; ++r) { O0[r] = 0.f; O1[r] = 0.f; }
        float l_run = 0.f;
        const int kc0 = tid, kc1 = tid + 512; const int vr = tid >> 3, vcn = tid & 7;
        const int ko0 = (kc0 / 12) * (AT_KLD * 2) + (kc0 % 12) * 16, ko1 = (kc1 / 12) * (AT_KLD * 2) + (kc1 % 12) * 16, vo = AT_KB + vr * (AT_VLD * 2) + vcn * 16;
        v4u pk0, pk1 = (v4u){0u, 0u, 0u, 0u}, pv;
#define AT_LOAD(t) do { const GAS v4u* ks_ = (const GAS v4u*)(Kb + (size_t)(t) * 64 * 96); pk0 = ks_[kc0]; if (kc1 < 768) pk1 = ks_[kc1]; pv = *(const GAS v4u*)(Vb + (size_t)vr * KSEQ + (t) * 64 + 8 * vcn); } while (0)
#define AT_STORE(bo) do { LAS unsigned char* b_ = F.lds + (bo); *(LAS v4u*)(b_ + ko0) = pk0; if (kc1 < 768) *(LAS v4u*)(b_ + ko1) = pk1; *(LAS v4u*)(b_ + vo) = pv; } while (0)
#define AT_QK(bo, A0, A1, INIT) do { const LAS unsigned char* b_ = F.lds + (bo); _Pragma("unroll") for (int r = 0; r < 16; ++r) { A0[r] = (INIT); A1[r] = (INIT); } \
            _Pragma("unroll") for (int kh = 0; kh < 2; ++kh) { bf16x8 kf0[3], kf1[3]; \
                _Pragma("unroll") for (int k3 = 0; k3 < 3; ++k3) { const int ks = 3 * kh + k3; kf0[k3] = *(const LAS bf16x8*)(b_ + ql * (AT_KLD * 2) + 32 * ks + 16 * h2); kf1[k3] = *(const LAS bf16x8*)(b_ + (32 + ql) * (AT_KLD * 2) + 32 * ks + 16 * h2); } \
                __builtin_amdgcn_sched_barrier(0); \
                _Pragma("unroll") for (int k3 = 0; k3 < 3; ++k3) { const int ks = 3 * kh + k3; A0 = __builtin_amdgcn_mfma_f32_32x32x16_bf16(kf0[k3], qf[ks], A0, 0, 0, 0); A1 = __builtin_amdgcn_mfma_f32_32x32x16_bf16(kf1[k3], qf[ks], A1, 0, 0, 0); } \
                __builtin_amdgcn_sched_barrier(0); } } while (0)
        const int ntile = nk >> 6;
        v4u qk0, qk1 = (v4u){0u, 0u, 0u, 0u}, qv;
#define AT_LOADB(t) do { const GAS v4u* ks_ = (const GAS v4u*)(Kb + (size_t)(t) * 64 * 96); qk0 = ks_[kc0]; if (kc1 < 768) qk1 = ks_[kc1]; qv = *(const GAS v4u*)(Vb + (size_t)vr * KSEQ + (t) * 64 + 8 * vcn); } while (0)
#define AT_STOREB(bo) do { LAS unsigned char* b_ = F.lds + (bo); *(LAS v4u*)(b_ + ko0) = qk0; if (kc1 < 768) *(LAS v4u*)(b_ + ko1) = qk1; *(LAS v4u*)(b_ + vo) = qv; } while (0)
        AT_LOAD(0); AT_LOADB(1);
        __syncthreads();
        AT_STORE(0); AT_STOREB(AT_BUF);
        AT_LOAD(2); AT_LOADB(3);
        __syncthreads();
        int bo0 = 0, bo1 = AT_BUF, bo2 = 2 * AT_BUF;
        float m_ref = 0.f;
#define AT_BODY(KT, STOREX, LOADX) do { const int kt_ = (KT); \
            if (kt_ + 2 < ntile) STOREX(bo2); if (kt_ + 4 < ntile) LOADX(kt_ + 4); \
            f32x16 S0, S1; AT_QK(bo0, S0, S1, -m_ref); \
            float mxa = fmaxf(fmaxf(S0[0], S0[1]), S0[2]), mxb = fmaxf(fmaxf(S0[3], S0[4]), S0[5]), mxc = fmaxf(fmaxf(S1[0], S1[1]), S1[2]), mxd = fmaxf(fmaxf(S1[3], S1[4]), S1[5]); \
            _Pragma("unroll") for (int r = 6; r < 16; r += 2) { mxa = fmaxf(mxa, S0[r]); mxb = fmaxf(mxb, S0[r + 1]); mxc = fmaxf(mxc, S1[r]); mxd = fmaxf(mxd, S1[r + 1]); } \
            float mx = fmaxf(fmaxf(mxa, mxb), fmaxf(mxc, mxd)); \
            mx = fmaxf(mx, __shfl_xor(mx, 32)); \
            if (__any(mx > 8.f) || kt_ == 0) { const float delta = kt_ == 0 ? mx : fmaxf(mx, 0.f); const float alpha = __builtin_amdgcn_exp2f(-delta); m_ref += delta; l_run *= alpha; \
                _Pragma("unroll") for (int r = 0; r < 16; ++r) { O0[r] *= alpha; O1[r] *= alpha; S0[r] -= delta; S1[r] -= delta; } } \
            float ps0 = 0.f, ps1 = 0.f, ps2 = 0.f, ps3 = 0.f; \
            _Pragma("unroll") for (int r = 0; r < 16; r += 2) { S0[r] = __builtin_amdgcn_exp2f(S0[r]); S1[r] = __builtin_amdgcn_exp2f(S1[r]); S0[r + 1] = __builtin_amdgcn_exp2f(S0[r + 1]); S1[r + 1] = __builtin_amdgcn_exp2f(S1[r + 1]); ps0 += S0[r]; ps1 += S1[r]; ps2 += S0[r + 1]; ps3 += S1[r + 1]; } \
            l_run += (ps0 + ps1) + (ps2 + ps3); \
            union { bf16x8 v; unsigned u[4]; } p00, p01, p10, p11; \
            _Pragma("unroll") for (int j = 0; j < 4; ++j) { p00.u[j] = pk2(S0[2 * j], S0[2 * j + 1]); p01.u[j] = pk2(S0[8 + 2 * j], S0[8 + 2 * j + 1]); p10.u[j] = pk2(S1[2 * j], S1[2 * j + 1]); p11.u[j] = pk2(S1[8 + 2 * j], S1[8 + 2 * j + 1]); } \
            const LAS unsigned char* vb = F.lds + bo0 + AT_KB; \
            _Pragma("unroll") for (int dvt = 0; dvt < 2; ++dvt) { const LAS unsigned char* vrow = vb + (32 * dvt + ql) * (AT_VLD * 2) + 8 * h2; union { bf16x8 v; v2u h[2]; } vf[4]; \
                _Pragma("unroll") for (int ss = 0; ss < 4; ++ss) { vf[ss].h[0] = *(const LAS v2u*)(vrow + 2 * (16 * ss)); vf[ss].h[1] = *(const LAS v2u*)(vrow + 2 * (16 * ss + 8)); } \
                __builtin_amdgcn_sched_barrier(0); \
                if (dvt == 0) { O0 = __builtin_amdgcn_mfma_f32_32x32x16_bf16(vf[0].v, p00.v, O0, 0, 0, 0); O0 = __builtin_amdgcn_mfma_f32_32x32x16_bf16(vf[1].v, p01.v, O0, 0, 0, 0); O0 = __builtin_amdgcn_mfma_f32_32x32x16_bf16(vf[2].v, p10.v, O0, 0, 0, 0); O0 = __builtin_amdgcn_mfma_f32_32x32x16_bf16(vf[3].v, p11.v, O0, 0, 0, 0); } \
                else { O1 = __builtin_amdgcn_mfma_f32_32x32x16_bf16(vf[0].v, p00.v, O1, 0, 0, 0); O1 = __builtin_amdgcn_mfma_f32_32x32x16_bf16(vf[1].v, p01.v, O1, 0, 0, 0); O1 = __builtin_amdgcn_mfma_f32_32x32x16_bf16(vf[2].v, p10.v, O1, 0, 0, 0); O1 = __builtin_amdgcn_mfma_f32_32x32x16_bf16(vf[3].v, p11.v, O1, 0, 0, 0); } \
                __builtin_amdgcn_sched_barrier(0); } \
            __syncthreads(); \
            { const int t_ = bo0; bo0 = bo1; bo1 = bo2; bo2 = t_; } } while (0)
        for (int kt = 0; kt < ntile; kt += 2) {
            AT_BODY(kt, AT_STORE, AT_LOAD);
            AT_BODY(kt + 1, AT_STOREB, AT_LOADB);
        }
#undef AT_BODY
#undef AT_LOADB
#undef AT_STOREB
#undef AT_LOAD
#undef AT_STORE
#undef AT_QK
        const float inv = 1.f / (l_run + __shfl_xor(l_run, 32));
        const int b = bh >> 2, head = bh & 3, qi = q0 + 32 * wave + ql;
        const size_t row = isctx ? (size_t)NL + b * 256 + qi : (size_t)b * 4096 + (qi - 256);
        bf16* orow = AO + row * 256 + head * 64 + 4 * h2;
#pragma unroll
        for (int g = 0; g < 4; ++g) { v2u o0, o1; o0.x = pk2(O0[4 * g] * inv, O0[4 * g + 1] * inv); o0.y = pk2(O0[4 * g + 2] * inv, O0[4 * g + 3] * inv); o1.x = pk2(O1[4 * g] * inv, O1[4 * g + 1] * inv); o1.y = pk2(O1[4 * g + 2] * inv, O1[4 * g + 3] * inv);
            *(GAS v2u*)(orow + 8 * g) = o0; *(GAS v2u*)(orow + 32 + 8 * g) = o1; }
    }
}

__device__ __forceinline__ void phase_fin_mla(Frame& F, int li) { WS_DECL; frame_refresh(F);
    const int nrows = li == DEPTH - 1 ? NL : NT; const float* g = in_ptr(I_MLAON) + li * 256; const bf16* AO = WSP(bf16, WS_AO); bf16* MIX = WSP(bf16, WS_A1);
    const int gw = blockIdx.x * NWAVES + F.wave, NGW = F.G * NWAVES; const f32x4 g4 = *(const GAS f32x4*)(g + 4 * F.lane);
    for (int m = gw; m < nrows; m += NGW) { const v2u w = *(const GAS v2u*)(AO + (size_t)m * 256 + 4 * F.lane);
        f32x4 x; x.x = bflo(w.x); x.y = bfhi(w.x); x.z = bflo(w.y); x.w = bfhi(w.y);
        const float r = __builtin_amdgcn_rsqf(wave_sum(x.x * x.x + x.y * x.y + x.z * x.z + x.w * x.w) * (1.f / 256.f) + 1e-6f);
        v2u o; o.x = pk2(x.x * r * g4.x, x.y * r * g4.y); o.y = pk2(x.z * r * g4.z, x.w * r * g4.w); *(GAS v2u*)(MIX + (size_t)m * D + 4 * F.lane) = o; }
}
__device__ __forceinline__ void phase_fin_zero(Frame& F, int li, int c0) { WS_DECL; frame_refresh(F);
    const int nrows = li == DEPTH - 1 ? NL : NT; bf16* MIX = WSP(bf16, WS_A1); const int gw = blockIdx.x * NWAVES + F.wave, NGW = F.G * NWAVES;
    for (int m = gw; m < nrows; m += NGW) *(GAS v2u*)(MIX + (size_t)m * D + c0 + 4 * F.lane) = (v2u){0u, 0u};
}

__device__ __forceinline__ void phase_pro0b(Frame& F) { WS_DECL; frame_refresh(F);
    const int gt = blockIdx.x * NTHR + F.tid, NGT = F.G * NTHR;
    float* RC = WSP(float, WS_ROPE); float* RS = RC + 4096 * 16;
    for (int i = gt; i < 4096 * 16; i += NGT) { const int t = i >> 4, j = i & 15; const float inv = powf(10000.f, -(float)(j & 7) / 8.f); const float pos = j < 8 ? (float)(t >> 6) : (float)(t & 63);
        const float ang = pos * inv; RC[i] = cosf(ang); RS[i] = sinf(ang); }
    const float* wuq = in_ptr(I_WUQ); const float* wukv = in_ptr(I_WUKV); bf16* WQ = WSP(bf16, WS_WUQT); bf16* WKV = WSP(bf16, WS_WUKVT);
    for (int i = gt; i < DEPTH * 384 * 192; i += NGT) { const int li = i / (384 * 192), r = i % (384 * 192), n = r / 192, k = r % 192; WQ[i] = (bf16)f2bf(wuq[(size_t)li * 192 * 384 + (size_t)k * 384 + n]); }
    for (int i = gt; i < DEPTH * 512 * 128; i += NGT) { const int li = i / (512 * 128), r = i % (512 * 128), n = r / 128, k = r % 128; WKV[i] = (bf16)f2bf(wukv[(size_t)li * 128 * 512 + (size_t)k * 512 + n]); }
}

constexpr int LR_LD = 264;
__device__ __forceinline__ float gelu_tanh(float x) { const float u = 0.7978845608028654f * (x + 0.044715f * x * x * x); const float e = __expf(2.f * u); const float t = 1.f - 2.f / (e + 1.f); return 0.5f * x * (1.f + t); }
template <int PASS>
__device__ __forceinline__ void phase_lru(Frame& F, int li) { WS_DECL; frame_refresh(F);
    LAS bf16* RAW = (LAS bf16*)F.lds; LAS bf16* U = (LAS bf16*)(F.lds + 67 * LR_LD * 2); LAS bf16* HS = (LAS bf16*)(F.lds + 71680);
    const bf16* P = WSP(bf16, WS_P); bf16* MIX = WSP(bf16, WS_A1); f32x2* SUMM = WSP(f32x2, WS_SUMM);
    const float* cw = in_ptr(I_LCW) + li * 4 * 256; const float* cb = in_ptr(I_LCB) + li * 256;
    const float* lam_ = in_ptr(I_LLAM) + li * 512; const float* br_ = in_ptr(I_LBR) + li * 512; const float* bi_ = in_ptr(I_LBI) + li * 512; const float* on_ = in_ptr(I_LON) + li * 256;
    const bf16* LW = WSP(bf16, WS_LRUW) + (size_t)li * 16 * 4096;
    const int lane = F.lane, wave = F.wave, tid = F.tid, fr = lane & 15, kg = lane >> 4;
    const int nitems = (PASS == 3 && li == DEPTH - 1) ? NL / 64 : NT / 64;
    for (int item = blockIdx.x; item < nitems; item += F.G) {
        const int m0 = item * 64; const bool isctx = m0 >= NL; const int b = isctx ? (m0 - NL) >> 8 : m0 >> 12; const int t0 = isctx ? (m0 - NL) & 255 : m0 & 4095; const int Ls = isctx ? 256 : 4096;
        const size_t seg0 = isctx ? (size_t)NL + b * 256 : (size_t)b * 4096;
        for (int c = tid; c < 67 * 32; c += NTHR) { const int r = c >> 5, cc = c & 31, t = t0 - 2 + r; v4u v = (v4u){0u, 0u, 0u, 0u};
            if (t >= 0 && t < Ls) v = *(const GAS v4u*)(P + (seg0 + t) * PCOLS + 352 + 8 * cc);
            *(LAS v4u*)(RAW + r * LR_LD + 8 * cc) = v; }
        __syncthreads();
        { const int c2 = tid & 127, tq = tid >> 7; const int ch = 2 * c2;
          float w0[4], w1[4];
#pragma unroll
          for (int j = 0; j < 4; ++j) { w0[j] = cw[j * 256 + ch]; w1[j] = cw[j * 256 + ch + 1]; }
          const float b0 = cb[ch], b1 = cb[ch + 1];
          for (int t = tq * 16; t < tq * 16 + 16; ++t) { float s0 = b0, s1 = b1;
#pragma unroll
              for (int j = 0; j < 4; ++j) { const unsigned w = *(const LAS unsigned*)(RAW + (t + j) * LR_LD + ch); s0 += w0[j] * bflo(w); s1 += w1[j] * bfhi(w); }
              *(LAS unsigned*)(U + t * LR_LD + ch) = pk2(s0, s1); } }
        __syncthreads();
#pragma unroll 1
        for (int ni = 0; ni < 2; ++ni) {
            float yv[4][4];
            const int nt = 2 * wave + ni, nb = nt >> 2, ch = 16 * nt + fr;
            bf16x8 wfr[2][2][2]; float spc[2], brc[2], bic[2];
#pragma unroll
            for (int d = 0; d < 2; ++d) { spc[d] = lam_[d * 256 + ch]; brc[d] = br_[d * 256 + ch]; bic[d] = bi_[d * 256 + ch];
#pragma unroll
                for (int g = 0; g < 2; ++g)
#pragma unroll
                    for (int ks = 0; ks < 2; ++ks) wfr[d][g][ks] = *(const GAS bf16x8*)(LW + ((size_t)((g * 2 + d) * 4 + nb) * 64 + 16 * (nt & 3) + fr) * 64 + 32 * ks + 8 * kg); }
            float uu[4][4];
#pragma unroll
            for (int m = 0; m < 4; ++m)
#pragma unroll
                for (int r = 0; r < 4; ++r) uu[m][r] = bf2f(U[(16 * m + 4 * kg + r) * LR_LD + ch]);
#pragma unroll
            for (int d = 0; d < 2; ++d) {
                f32x4 ar[4], ai[4];
#pragma unroll
                for (int m = 0; m < 4; ++m) { ar[m] = (f32x4){0.f, 0.f, 0.f, 0.f}; ai[m] = (f32x4){0.f, 0.f, 0.f, 0.f}; }
#pragma unroll
                for (int ks = 0; ks < 2; ++ks) {
                    const bf16x8 wr = wfr[d][0][ks], wi = wfr[d][1][ks];
#pragma unroll
                    for (int m = 0; m < 4; ++m) { const bf16x8 xf = *(const LAS bf16x8*)(U + (16 * m + fr) * LR_LD + 64 * nb + 32 * ks + 8 * kg);
                        ar[m] = __builtin_amdgcn_mfma_f32_16x16x32_bf16(xf, wr, ar[m], 0, 0, 0); ai[m] = __builtin_amdgcn_mfma_f32_16x16x32_bf16(xf, wi, ai[m], 0, 0, 0); } }
                const float sp = __logf(1.f + __expf(-spc[d])), brv = brc[d], biv = bic[d];
#pragma unroll
                for (int m = 0; m < 4; ++m)
#pragma unroll
                    for (int r = 0; r < 4; ++r) { const float rg = __builtin_amdgcn_rcpf(1.f + __expf(-(ar[m][r] + brv))), ig = __builtin_amdgcn_rcpf(1.f + __expf(-(ai[m][r] + biv))); const float av = __expf(-8.f * rg * sp);
                        ar[m][r] = av; ai[m][r] = __builtin_amdgcn_sqrtf(fmaxf(1.f - av * av, 0.f)) * (ig * uu[m][r]); }
                float H = 0.f;
                if (PASS == 3) {
                    const int cj = t0 >> 6, cbase = 1024 + b * 4, lbase = b * 64;
                    const int np = d == 0 ? (isctx ? cj : 4 + cj) : (isctx ? 3 - cj : 4 + 63 - cj);
                    const int q = (np + 3) >> 2, p_lo = kg * q, p_hi = (p_lo + q < np) ? p_lo + q : np;
                    float Aq = 1.f, Bq = 0.f;
                    for (int p0 = p_lo; p0 < p_hi; p0 += 8) { f32x2 sv[8];
#pragma unroll
                        for (int e = 0; e < 8; ++e) { const int p = p0 + e; sv[e] = (f32x2){1.f, 0.f};
                            if (p < p_hi) { int cid; if (d == 0) cid = isctx ? cbase + p : (p < 4 ? cbase + p : lbase + (p - 4)); else cid = isctx ? cbase + 3 - p : (p < 4 ? cbase + 3 - p : lbase + 63 - (p - 4));
                                sv[e] = *(const GAS f32x2*)(SUMM + ((size_t)cid * 2 + d) * 256 + ch); } }
#pragma unroll
                        for (int e = 0; e < 8; ++e) { Bq = sv[e].x * Bq + sv[e].y; Aq = sv[e].x * Aq; } }
#pragma unroll
                    for (int g = 0; g < 4; ++g) { const float Ag_ = __shfl(Aq, fr + 16 * g), Bg_ = __shfl(Bq, fr + 16 * g); H = Ag_ * H + Bg_; }
                }
                float Ac = 1.f, Bc = 0.f;
#pragma unroll
                for (int mi = 0; mi < 4; ++mi) { const int m = d == 0 ? mi : 3 - mi;
                    float Al, Bl;
                    if (d == 0) { Al = ar[m][0] * ar[m][1] * ar[m][2] * ar[m][3]; Bl = ((ai[m][0] * ar[m][1] + ai[m][1]) * ar[m][2] + ai[m][2]) * ar[m][3] + ai[m][3]; }
                    else { Al = ar[m][0] * ar[m][1] * ar[m][2] * ar[m][3]; Bl = ((ai[m][3] * ar[m][2] + ai[m][2]) * ar[m][1] + ai[m][1]) * ar[m][0] + ai[m][0]; }
                    float Ag[4], Bg[4];
#pragma unroll
                    for (int g = 0; g < 4; ++g) { Ag[g] = __shfl(Al, fr + 16 * g); Bg[g] = __shfl(Bl, fr + 16 * g); }
                    if (PASS == 1) {
                        float At = 1.f, Bt = 0.f;
#pragma unroll
                        for (int gi = 0; gi < 4; ++gi) { const int g = d == 0 ? gi : 3 - gi; Bt = Ag[g] * Bt + Bg[g]; At = Ag[g] * At; }
                        Bc = At * Bc + Bt; Ac = At * Ac;
                    } else {
                        float s = H, sin_ = H;
#pragma unroll
                        for (int gi = 0; gi < 4; ++gi) { const int g = d == 0 ? gi : 3 - gi; if (g == kg) sin_ = s; s = Ag[g] * s + Bg[g]; }
                        H = s;
                        float x = sin_;
#pragma unroll
                        for (int ri = 0; ri < 4; ++ri) { const int r = d == 0 ? ri : 3 - ri; x = ar[m][r] * x + ai[m][r]; if (d == 0) yv[m][r] = x; else yv[m][r] += x; }
                    }
                }
                if (PASS == 1 && kg == 0) *(GAS f32x2*)(SUMM + ((size_t)item * 2 + d) * 256 + ch) = (f32x2){Ac, Bc};
            }
            if (PASS == 3) {
#pragma unroll
                for (int m = 0; m < 4; ++m)
#pragma unroll
                    for (int r = 0; r < 4; ++r) HS[(16 * m + 4 * kg + r) * LR_LD + ch] = (bf16)f2bf(yv[m][r]);
            }
        }
        if (PASS == 3) {
            __syncthreads();
            const f32x4 on4 = *(const GAS f32x4*)(on_ + 4 * lane);
            for (int i = 0; i < 8; ++i) { const int tl = wave * 8 + i; const v2u hw = *(const LAS v2u*)(HS + tl * LR_LD + 4 * lane); const v2u gw = *(const GAS v2u*)(P + (size_t)(m0 + tl) * PCOLS + 608 + 4 * lane);
                f32x4 y; y.x = bflo(hw.x) * gelu_tanh(bflo(gw.x)); y.y = bfhi(hw.x) * gelu_tanh(bfhi(gw.x)); y.z = bflo(hw.y) * gelu_tanh(bflo(gw.y)); y.w = bfhi(hw.y) * gelu_tanh(bfhi(gw.y));
                const float rs = __builtin_amdgcn_rsqf(wave_sum(y.x * y.x + y.y * y.y + y.z * y.z + y.w * y.w) * (1.f / 256.f) + 1e-6f);
                v2u o; o.x = pk2(y.x * rs * on4.x, y.y * rs * on4.y); o.y = pk2(y.z * rs * on4.z, y.w * rs * on4.w);
                *(GAS v2u*)(MIX + (size_t)(m0 + tl) * D + 256 + 4 * lane) = o; }
        }
        __syncthreads();
    }
}

__device__ __forceinline__ void phase_pro0c(Frame& F) { WS_DECL; frame_refresh(F);
    const int gt = blockIdx.x * NTHR + F.tid, NGT = F.G * NTHR; const float* wr = in_ptr(I_LWR); const float* wi = in_ptr(I_LWI); bf16* LW = WSP(bf16, WS_LRUW);
    for (int i = gt; i < DEPTH * 16 * 4096; i += NGT) { const int c = i & 63, dd = (i >> 6) & 63, nb = (i >> 12) & 3, d = (i >> 14) & 1, g = (i >> 15) & 1, li = i >> 16;
        const float* src = g == 0 ? wr : wi; LW[i] = (bf16)f2bf(src[((((size_t)li * 2 + d) * 4 + nb) * 64 + c) * 64 + dd]); }
}

template <int CTRL> __device__ __forceinline__ float dpp_f(float x) { return __builtin_bit_cast(float, __builtin_amdgcn_mov_dpp(__builtin_bit_cast(int, x), CTRL, 0xf, 0xf, true)); }
__device__ __forceinline__ float rowsum16(float x) { x += dpp_f<0x128>(x); x += dpp_f<0x124>(x); x += dpp_f<0x122>(x); x += dpp_f<0x121>(x); return x; }
constexpr int RW_C0 = 864;
constexpr size_t WS_RWUP = WS_LRUW + 512 * 1024;
constexpr size_t WS_EA = WS_Y;

__device__ __forceinline__ void phase_pro0e(Frame& F) { WS_DECL; frame_refresh(F);
    const int gt = blockIdx.x * NTHR + F.tid, NGT = F.G * NTHR; const float* wup = in_ptr(I_WUP); const float* aup = in_ptr(I_AUP); bf16* W = WSP(bf16, WS_RWUP);
    for (int i = gt; i < DEPTH * 2 * 2 * 256 * 32; i += NGT) { const int k = i & 31, n = (i >> 5) & 255, wa = (i >> 13) & 1, d = (i >> 14) & 1, li = i >> 15;
        const float* src = wa == 0 ? wup : aup; W[i] = (bf16)f2bf(src[(((size_t)li * 2 + d) * 32 + k) * 256 + n]); }
}

constexpr int R0_LD = 136, R0_ZLD = 72;
__device__ __forceinline__ void phase_rwkv_r0(Frame& F, int li) { WS_DECL; frame_refresh(F);
    LAS bf16* RAWL = (LAS bf16*)F.lds;
    LAS bf16* ZW = (LAS bf16*)(F.lds + 66 * R0_LD * 2);
    LAS bf16* ZA = ZW + 64 * R0_ZLD;
    const bf16* P = WSP(bf16, WS_P); bf16* EA = WSP(bf16, WS_EA); const bf16* W = WSP(bf16, WS_RWUP) + (size_t)li * 2 * 2 * 256 * 32;
    const float* mup = in_ptr(I_MUP) + li * 960 + 768; const float* mun = in_ptr(I_MUN) + li * 960 + 768; const float* w0 = in_ptr(I_W0) + li * 512; const float* a0 = in_ptr(I_A0) + li * 512;
    const int tid = F.tid, lane = F.lane, wave = F.wave, fr = lane & 15, kg = lane >> 4;
    for (int item = blockIdx.x; item < NT / 64; item += F.G) {
        const int m0 = item * 64; const bool isctx = m0 >= NL; const int t0 = isctx ? (m0 - NL) & 255 : m0 & 4095; const int Ls = isctx ? 256 : 4096; const size_t seg0 = (size_t)m0 - t0;
        __syncthreads();
        for (int c = tid; c < 66 * 16; c += NTHR) { const int r = c >> 4, cc = c & 15, t = t0 - 1 + r; v4u v = (v4u){0u, 0u, 0u, 0u};
            if (t >= 0 && t < Ls) v = *(const GAS v4u*)(P + (seg0 + t) * PCOLS + RW_C0 + 768 + 8 * cc);
            *(LAS v4u*)(RAWL + r * R0_LD + 8 * cc) = v; }
        __syncthreads();
        { const int c = tid & 127, tq = tid >> 7; const float mp = mup[c], mn = mun[c];
          for (int tl = tq * 16; tl < tq * 16 + 16; ++tl) { const float x = bf2f(RAWL[(tl + 1) * R0_LD + c]), xp = bf2f(RAWL[tl * R0_LD + c]), xn = bf2f(RAWL[(tl + 2) * R0_LD + c]);
              const float z = x + mp * (xp - x) + mn * (xn - x);
              if (c < 64) { const float e2 = __expf(2.f * z); ZW[tl * R0_ZLD + c] = (bf16)f2bf(1.f - 2.f * __builtin_amdgcn_rcpf(e2 + 1.f)); } else ZA[tl * R0_ZLD + (c - 64)] = (bf16)f2bf(z); } }
        __syncthreads();
        const int d = wave >> 2, hh = wave & 3;
#pragma unroll 1
        for (int nt = 0; nt < 4; ++nt) { const int ch0 = 64 * hh + 16 * nt;
            const bf16x8 wf = *(const GAS bf16x8*)(W + ((size_t)(d * 2 + 0) * 256 + ch0 + fr) * 32 + 8 * kg), af = *(const GAS bf16x8*)(W + ((size_t)(d * 2 + 1) * 256 + ch0 + fr) * 32 + 8 * kg);
            const f32x4 w04 = *(const GAS f32x4*)(w0 + d * 256 + ch0 + 4 * kg), a04 = *(const GAS f32x4*)(a0 + d * 256 + ch0 + 4 * kg);
#pragma unroll
            for (int m = 0; m < 4; ++m) { const bf16x8 zw = *(const LAS bf16x8*)(ZW + (16 * m + fr) * R0_ZLD + 32 * d + 8 * kg), za = *(const LAS bf16x8*)(ZA + (16 * m + fr) * R0_ZLD + 32 * d + 8 * kg);
                f32x4 xw = __builtin_amdgcn_mfma_f32_16x16x32_bf16(wf, zw, (f32x4){0.f, 0.f, 0.f, 0.f}, 0, 0, 0), xa = __builtin_amdgcn_mfma_f32_16x16x32_bf16(af, za, (f32x4){0.f, 0.f, 0.f, 0.f}, 0, 0, 0);
                xw = xw + w04; xa = xa + a04; float e[4], av[4];
#pragma unroll
                for (int r = 0; r < 4; ++r) { e[r] = -0.6065306597126334f * __builtin_amdgcn_rcpf(1.f + __expf(-xw[r])); av[r] = __builtin_amdgcn_rcpf(1.f + __expf(-xa[r])); }
                const size_t tok = (size_t)m0 + 16 * m + fr; v2u oe, oa; oe.x = pk2(e[0], e[1]); oe.y = pk2(e[2], e[3]); oa.x = pk2(av[0], av[1]); oa.y = pk2(av[2], av[3]);
                *(GAS v2u*)(EA + (tok * 4 + d) * 256 + ch0 + 4 * kg) = oe; *(GAS v2u*)(EA + (tok * 4 + 2 + d) * 256 + ch0 + 4 * kg) = oa; } }
    }
    __syncthreads();
}

constexpr int RW_T = 16, RW_NCH = (LCX + SEQ) / RW_T, RW_ROWS = RW_T + 2, RW_LD = 200, RW_P = 72;
constexpr int RW_RAW = 0, RW_RAWB = RW_ROWS * RW_LD * 2;
constexpr int RW_EAB = RW_RAW + 2 * RW_RAWB, RW_EABB = RW_T * 128 * 2;
constexpr int RW_VEC = RW_EAB + 2 * RW_EABB, RW_VECB = RW_T * 4 * 64 * 2 + RW_T * 64 * 4;
constexpr int RW_VV = RW_VEC + 2 * RW_VECB;
constexpr int RW_BON = RW_VV + 8 * 1024;
constexpr int RW_ARA = RW_BON + 8 * 64;
constexpr int RW_KB2 = RW_ARA + 2 * 16 * RW_P * 2;
constexpr int RW_AT2 = RW_KB2 + 2 * 32 * RW_P * 2;
constexpr int RW_ARR = RW_AT2 + 4 * 2048;
constexpr int RW_KT = RW_ARR + 4 * 16 * RW_P * 2;
constexpr int RW_BTN = RW_KT + 4 * 2048;
constexpr int RW_CWT = RW_BTN + 4 * 2048;
constexpr int RW_DO = RW_CWT + 4 * 256;
constexpr int RW_DOB = 16 * RW_P * 2 + 3 * 512;
constexpr int RW_BC = RW_DO + 4 * RW_DOB;
constexpr int RW_END = RW_BC + 9 * 256;
static_assert(RW_END <= RING_BYTES, "rwkv lds map");
typedef LAS bf16* lbf;
__device__ __forceinline__ bf16x8 rw_zero8() { return (bf16x8){0, 0, 0, 0, 0, 0, 0, 0}; }
__device__ __forceinline__ bf16x8 rw_k16(const LAS bf16* rowp, int kg) { bf16x8 r = rw_zero8(); if (kg < 2) r = *(const LAS bf16x8*)(rowp + 8 * kg); return r; }
__device__ __forceinline__ bf16x8 rw_perm4(const LAS bf16* rowp, int kg) { union { bf16x8 v; v2u h[2]; } u; u.h[0] = *(const LAS v2u*)(rowp + 4 * kg); u.h[1] = (v2u){0u, 0u}; return u.v; }
__device__ __forceinline__ bf16x8 rw_permK(const LAS bf16* rowp, int kg, int sp) { union { bf16x8 v; v2u h[2]; } u; u.h[0] = *(const LAS v2u*)(rowp + 32 * sp + 4 * kg); u.h[1] = *(const LAS v2u*)(rowp + 32 * sp + 16 + 4 * kg); return u.v; }
__device__ __forceinline__ bf16x8 rw_c4(f32x4 c) { union { bf16x8 v; unsigned u[4]; } x; x.u[0] = pk2(c[0], c[1]); x.u[1] = pk2(c[2], c[3]); x.u[2] = 0u; x.u[3] = 0u; return x.v; }
__device__ __forceinline__ bf16x8 rw_c8(f32x4 c0, f32x4 c1) { union { bf16x8 v; unsigned u[4]; } x; x.u[0] = pk2(c0[0], c0[1]); x.u[1] = pk2(c0[2], c0[3]); x.u[2] = pk2(c1[0], c1[1]); x.u[3] = pk2(c1[2], c1[3]); return x.v; }
__device__ __forceinline__ void rw_st_rows(lbf M, f32x4 c, int fr, int kg) {
#pragma unroll
    for (int r = 0; r < 4; ++r) M[(4 * kg + r) * 16 + fr] = (bf16)f2bf(c[r]); }
__device__ __forceinline__ void rw_st_cols(lbf M, f32x4 c, int fr, int kg, int pitch) {
    v2u o; o.x = pk2(c[0], c[1]); o.y = pk2(c[2], c[3]); *(LAS v2u*)(M + fr * pitch + 4 * kg) = o; }
#define RW_MFMA(a, b, c) __builtin_amdgcn_mfma_f32_16x16x32_bf16(a, b, c, 0, 0, 0)

__device__ __forceinline__ void phase_rwkv_scan(Frame& F, int li) { WS_DECL; frame_refresh(F);
    const bf16* P = WSP(bf16, WS_P); const bf16* EA = WSP(bf16, WS_EA); float* YR = WSP(float, WS_YR); float* BON = WSP(float, WS_BON);
    const bf16* zsrc = (const bf16*)(ws + WS_CTL + 65536);
    const int tid = F.tid, lane = F.lane, wave = F.wave, fr = lane & 15, kg = lane >> 4;
    LAS unsigned char* L = F.lds;
    for (int item = blockIdx.x; item < 256; item += F.G) {
        const int vhalf = item & 1, d = (item >> 1) & 1, h = (item >> 2) & 3, b = item >> 4;
        __syncthreads();
        const int pt = (tid - 128) & 255, ps = pt >> 4, pq = pt & 15;
        const int sk = pt & 63, sq = pt >> 6;
        { LAS float* BC = (LAS float*)(L + RW_BC); const float* mup = in_ptr(I_MUP) + li * 960; const float* mun = in_ptr(I_MUN) + li * 960;
          if (tid < 64) { const int c = 64 * h + tid; BC[tid] = mup[c]; BC[64 + tid] = mup[256 + c]; BC[128 + tid] = mup[512 + c]; BC[192 + tid] = mun[c]; BC[256 + tid] = mun[256 + c]; BC[320 + tid] = mun[512 + c];
              BC[384 + tid] = in_ptr(I_KK)[li * 256 + c]; BC[448 + tid] = in_ptr(I_KA)[li * 256 + c]; BC[512 + tid] = in_ptr(I_RK)[li * 256 + c]; } }
        __syncthreads();
        f32x4 S0 = (f32x4){0.f, 0.f, 0.f, 0.f}, S1 = S0, S2 = S0, S3 = S0;
        v4u ra[11];
#pragma unroll
        for (int q = 0; q < 11; ++q) ra[q] = (v4u){0u, 0u, 0u, 0u};
        if (wave < 2) {
#pragma unroll 1
            for (int it = -8; it <= RW_NCH; ++it) {
                if (it >= 0 && it < RW_NCH) {
                    const lbf VV = (lbf)(L + RW_VV + (it & 7) * 1024), ARR = (lbf)(L + RW_ARR + (it & 3) * (16 * RW_P * 2)), KT = (lbf)(L + RW_KT + (it & 3) * 2048), BTN = (lbf)(L + RW_BTN + (it & 3) * 2048);
                    const LAS float* CWT = (const LAS float*)(L + RW_CWT + (it & 3) * 256);
                    const lbf APT = (lbf)(L + RW_DO + (it & 3) * RW_DOB), AMT = APT + 16 * RW_P, ARKT = AMT + 256, ARBTN = ARKT + 256;
                    const f32x4 Z = (f32x4){0.f, 0.f, 0.f, 0.f};
                    const bf16x8 bvv = rw_k16(VV + (16 * wave + fr) * 16, kg);
                    const bf16x8 sb0 = rw_c8(S0, S1), sb1 = rw_c8(S2, S3);
                    f32x4 UT = RW_MFMA(rw_k16(AMT + fr * 16, kg), bvv, Z);
                    UT = RW_MFMA(rw_permK(APT + fr * RW_P, kg, 0), sb0, UT); UT = RW_MFMA(rw_permK(APT + fr * RW_P, kg, 1), sb1, UT);
                    f32x4 YT = RW_MFMA(rw_k16(ARKT + fr * 16, kg), bvv, Z);
                    YT = RW_MFMA(rw_permK(ARR + fr * RW_P, kg, 0), sb0, YT); YT = RW_MFMA(rw_permK(ARR + fr * RW_P, kg, 1), sb1, YT);
                    const bf16x8 ub = rw_c4(UT);
                    YT = RW_MFMA(rw_perm4(ARBTN + fr * 16, kg), ub, YT);
                    { const bool isctx = it < LCX / RW_T;
                      if (!isctx || li < DEPTH - 1) { const int cl = isctx ? it : it - LCX / RW_T; const int Ls = isctx ? LCX : SEQ; const int tlo = d == 0 ? cl * RW_T : Ls - RW_T - cl * RW_T; const size_t seg0 = isctx ? (size_t)NL + b * LCX : (size_t)b * SEQ;
#pragma unroll
                          for (int r = 0; r < 4; ++r) { const int sidx = 4 * kg + r; const int t = d == 0 ? tlo + sidx : tlo + RW_T - 1 - sidx;
                              YR[((size_t)d * NT + seg0 + t) * 256 + 64 * h + 32 * vhalf + 16 * wave + fr] = YT[r]; }
                          if (vhalf == 0 && wave == 0 && lane < RW_T) { const LAS float* BONS = (const LAS float*)(L + RW_BON) + (it & 7) * RW_T; const int t = d == 0 ? tlo + lane : tlo + RW_T - 1 - lane;
                              BON[((size_t)d * NT + seg0 + t) * 4 + h] = BONS[lane]; } } }
                    { f32x4 q = RW_MFMA(rw_k16(KT + (0 + fr) * 16, kg), bvv, S0); q = RW_MFMA(rw_perm4(BTN + (0 + fr) * 16, kg), ub, q); S0 = q * *(const LAS f32x4*)(CWT + 0 + 4 * kg); }
                    { f32x4 q = RW_MFMA(rw_k16(KT + (16 + fr) * 16, kg), bvv, S1); q = RW_MFMA(rw_perm4(BTN + (16 + fr) * 16, kg), ub, q); S1 = q * *(const LAS f32x4*)(CWT + 16 + 4 * kg); }
                    { f32x4 q = RW_MFMA(rw_k16(KT + (32 + fr) * 16, kg), bvv, S2); q = RW_MFMA(rw_perm4(BTN + (32 + fr) * 16, kg), ub, q); S2 = q * *(const LAS f32x4*)(CWT + 32 + 4 * kg); }
                    { f32x4 q = RW_MFMA(rw_k16(KT + (48 + fr) * 16, kg), bvv, S3); q = RW_MFMA(rw_perm4(BTN + (48 + fr) * 16, kg), ub, q); S3 = q * *(const LAS f32x4*)(CWT + 48 + 4 * kg); }
                }
                __syncthreads();
            }
        } else if (wave < 6) {
#pragma unroll 1
            for (int it = -8; it <= RW_NCH; ++it) {
                { const int ca = it + 5;
                  if (ca >= 0 && ca < RW_NCH && ((ca & 3) == wave - 2)) { LAS bf16* RAWW = (LAS bf16*)(L + RW_RAW + (ca & 1) * RW_RAWB); LAS bf16* EAW = (LAS bf16*)(L + RW_EAB + (ca & 1) * RW_EABB);
#pragma unroll
                      for (int q = 0; q < 11; ++q) { const int c = lane + 64 * q;
                          if (c < RW_ROWS * 24) *(LAS v4u*)(RAWW + (c / 24) * RW_LD + 8 * (c % 24)) = ra[q];
                          else if (c < RW_ROWS * 24 + RW_T * 16) { const int e = c - RW_ROWS * 24; *(LAS v4u*)(EAW + 8 * e) = ra[q]; } } }
                  const int cn = it + 8;
                  if (cn < RW_NCH && ((cn & 3) == wave - 2)) { const bool isctx = cn < LCX / RW_T; const int cl = isctx ? cn : cn - LCX / RW_T; const int Ls = isctx ? LCX : SEQ; const int tlo = d == 0 ? cl * RW_T : Ls - RW_T - cl * RW_T;
                      const size_t seg0 = isctx ? (size_t)NL + b * LCX : (size_t)b * SEQ;
#pragma unroll
                      for (int q = 0; q < 11; ++q) { const int c = lane + 64 * q; const bf16* src = zsrc;
                          if (c < RW_ROWS * 24) { const int r = c / 24, cc = c % 24, t = tlo - 1 + r; const int col = 256 * (cc >> 3) + 64 * h + 8 * (cc & 7);
                              if (t >= 0 && t < Ls) src = P + (seg0 + t) * PCOLS + RW_C0 + col; }
                          else if (c < RW_ROWS * 24 + RW_T * 16) { const int e = c - RW_ROWS * 24, s = e >> 4, cc = e & 15; const int t = d == 0 ? tlo + s : tlo + RW_T - 1 - s;
                              src = EA + ((seg0 + t) * 4 + (cc >> 3) * 2 + d) * 256 + 64 * h + 8 * (cc & 7); }
                          ra[q] = *(const GAS v4u*)src; } } }
                const int cb = it + 4;
                if (cb >= 0 && cb < RW_NCH) {
                    const LAS bf16* RAW = (const LAS bf16*)(L + RW_RAW + (cb & 1) * RW_RAWB); const LAS bf16* EAB = (const LAS bf16*)(L + RW_EAB + (cb & 1) * RW_EABB);
                    const lbf VEC = (lbf)(L + RW_VEC + (cb & 1) * RW_VECB); LAS float* LWF = (LAS float*)(L + RW_VEC + (cb & 1) * RW_VECB + RW_T * 4 * 64 * 2);
                    const lbf VV = (lbf)(L + RW_VV + (cb & 7) * 1024); LAS float* BONS = (LAS float*)(L + RW_BON) + (cb & 7) * RW_T;
                    const int prow = d == 0 ? ps + 1 : RW_T - ps;
                    const LAS float* BC = (const LAS float*)(L + RW_BC) + 4 * pq;
                    const f32x4 mpr = *(const LAS f32x4*)(BC), mpk = *(const LAS f32x4*)(BC + 64), mpv = *(const LAS f32x4*)(BC + 128), mnr = *(const LAS f32x4*)(BC + 192), mnk = *(const LAS f32x4*)(BC + 256), mnv = *(const LAS f32x4*)(BC + 320);
                    const f32x4 kk_c = *(const LAS f32x4*)(BC + 384), ka_c = *(const LAS f32x4*)(BC + 448), rk_c = *(const LAS f32x4*)(BC + 512);
                    f32x4 zr, zk, zv;
                    { const LAS bf16* r0 = RAW + prow * RW_LD + 4 * pq;
#define RW_LD4(p) ({ const v2u w_ = *(const LAS v2u*)(p); (f32x4){bflo(w_.x), bfhi(w_.x), bflo(w_.y), bfhi(w_.y)}; })
                      { const f32x4 x = RW_LD4(r0), xp = RW_LD4(r0 - RW_LD), xn = RW_LD4(r0 + RW_LD); zr = x + mpr * (xp - x) + mnr * (xn - x); }
                      { const f32x4 x = RW_LD4(r0 + 64), xp = RW_LD4(r0 + 64 - RW_LD), xn = RW_LD4(r0 + 64 + RW_LD); zk = x + mpk * (xp - x) + mnk * (xn - x); }
                      { const f32x4 x = RW_LD4(r0 + 128), xp = RW_LD4(r0 + 128 - RW_LD), xn = RW_LD4(r0 + 128 + RW_LD); zv = x + mpv * (xp - x) + mnv * (xn - x); } }
                    const f32x4 lw4 = RW_LD4(EAB + ps * 128 + 4 * pq), a4 = RW_LD4(EAB + ps * 128 + 64 + 4 * pq);
                    const f32x4 kkr = zk * kk_c; const float ss = rowsum16((kkr.x * kkr.x + kkr.y * kkr.y) + (kkr.z * kkr.z + kkr.w * kkr.w));
                    const f32x4 kd = zk * ((a4 - 1.f) * ka_c + 1.f); const f32x4 bq = zr * kd * rk_c; const float bn = rowsum16((bq.x + bq.y) + (bq.z + bq.w));
                    const f32x4 kkn = kkr * __builtin_amdgcn_rsqf(fmaxf(ss, 1e-24f)), kka = kkn * a4;
                    { v2u o; lbf vp = VEC + ps * 256 + 4 * pq;
                      o.x = pk2(kkn.x, kkn.y); o.y = pk2(kkn.z, kkn.w); *(LAS v2u*)(vp) = o; o.x = pk2(kka.x, kka.y); o.y = pk2(kka.z, kka.w); *(LAS v2u*)(vp + 64) = o;
                      o.x = pk2(kd.x, kd.y); o.y = pk2(kd.z, kd.w); *(LAS v2u*)(vp + 128) = o; o.x = pk2(zr.x, zr.y); o.y = pk2(zr.z, zr.w); *(LAS v2u*)(vp + 192) = o; }
                    *(LAS f32x4*)(LWF + ps * 64 + 4 * pq) = lw4;
                    if ((pq >> 3) == vhalf) { const int v0 = 4 * (pq & 7); VV[(v0 + 0) * 16 + ps] = (bf16)f2bf(zv.x); VV[(v0 + 1) * 16 + ps] = (bf16)f2bf(zv.y); VV[(v0 + 2) * 16 + ps] = (bf16)f2bf(zv.z); VV[(v0 + 3) * 16 + ps] = (bf16)f2bf(zv.w); }
                    if (pq == 0) BONS[ps] = bn;
                }
                const int cc3 = it + 3;
                if (cc3 >= 0 && cc3 < RW_NCH) {
                    const LAS bf16* VEC = (const LAS bf16*)(L + RW_VEC + (cc3 & 1) * RW_VECB); const LAS float* LWF = (const LAS float*)(L + RW_VEC + (cc3 & 1) * RW_VECB + RW_T * 4 * 64 * 2);
                    const lbf ARA = (lbf)(L + RW_ARA + (cc3 & 1) * (16 * RW_P * 2)), KB2 = (lbf)(L + RW_KB2 + (cc3 & 1) * (32 * RW_P * 2)), AT2 = (lbf)(L + RW_AT2 + (cc3 & 3) * 2048);
                    const lbf ARR = (lbf)(L + RW_ARR + (cc3 & 3) * (16 * RW_P * 2)), KT = (lbf)(L + RW_KT + (cc3 & 3) * 2048), BTN = (lbf)(L + RW_BTN + (cc3 & 3) * 2048); LAS float* CWT = (LAS float*)(L + RW_CWT + (cc3 & 3) * 256);
                    float cl = 0.f;
                    for (int s = 0; s < 4 * sq; ++s) cl += LWF[s * 64 + sk];
                    float cwm = __expf(cl);
#pragma unroll
                    for (int j = 0; j < 4; ++j) { const int s = 4 * sq + j; cl += LWF[s * 64 + sk]; const float cw = __expf(cl), icw = __builtin_amdgcn_rcpf(cw);
                        const float kkv = bf2f(VEC[s * 256 + sk]), kkav = bf2f(VEC[s * 256 + 64 + sk]), kdv = bf2f(VEC[s * 256 + 128 + sk]), rv = bf2f(VEC[s * 256 + 192 + sk]);
                        const bf16 at = (bf16)f2bf(kkv * cwm), rt = (bf16)f2bf(rv * cw), kt = (bf16)f2bf(kdv * icw), btv = (bf16)f2bf(kkav * icw), btn = (bf16)f2bf(-kkav * icw);
                        ARA[s * RW_P + sk] = at; AT2[sk * 16 + s] = at; ARR[s * RW_P + sk] = rt; KB2[s * RW_P + sk] = kt; KT[sk * 16 + s] = kt; KB2[(16 + s) * RW_P + sk] = btv; BTN[sk * 16 + s] = btn;
                        if (s == RW_T - 1) CWT[sk] = cw;
                        cwm = cw; }
                }
                __syncthreads();
            }
        } else {
#pragma unroll 1
            for (int it = -8; it <= RW_NCH; ++it) {
                const int c = it + 2;
                if (c >= 0 && c < RW_NCH && ((c & 1) == (wave & 1))) {
                    const LAS bf16* ARA = (const LAS bf16*)(L + RW_ARA + (c & 1) * (16 * RW_P * 2)); const LAS bf16* KB2 = (const LAS bf16*)(L + RW_KB2 + (c & 1) * (32 * RW_P * 2));
                    const LAS bf16* ARR = (const LAS bf16*)(L + RW_ARR + (c & 3) * (16 * RW_P * 2)); const LAS bf16* AT2 = (const LAS bf16*)(L + RW_AT2 + (c & 3) * 2048);
                    const lbf APT = (lbf)(L + RW_DO + (c & 3) * RW_DOB), AMT = APT + 16 * RW_P, ARKT = AMT + 256, ARBTN = ARKT + 256;
                    const f32x4 Z = (f32x4){0.f, 0.f, 0.f, 0.f};
                    f32x4 gkk = Z, gkkT = Z, grk = Z, gn = Z, gnT = Z, grb = Z;
#pragma unroll
                    for (int ks = 0; ks < 2; ++ks) { const bf16x8 ak = *(const LAS bf16x8*)(KB2 + fr * RW_P + 32 * ks + 8 * kg), ab = *(const LAS bf16x8*)(KB2 + (16 + fr) * RW_P + 32 * ks + 8 * kg);
                        const bf16x8 ba = *(const LAS bf16x8*)(ARA + fr * RW_P + 32 * ks + 8 * kg), br = *(const LAS bf16x8*)(ARR + fr * RW_P + 32 * ks + 8 * kg);
                        gkk = RW_MFMA(ak, ba, gkk); gkkT = RW_MFMA(ba, ak, gkkT); grk = RW_MFMA(ak, br, grk); gn = RW_MFMA(ab, ba, gn); gnT = RW_MFMA(ba, ab, gnT); grb = RW_MFMA(ab, br, grb); }
                    f32x4 w1, w1T;
#pragma unroll
                    for (int r = 0; r < 4; ++r) { const int row = 4 * kg + r;
                        if (!(row < fr)) { gkk[r] = 0.f; gn[r] = 0.f; } if (!(fr < row)) { gkkT[r] = 0.f; gnT[r] = 0.f; } if (!(row <= fr)) { grk[r] = 0.f; grb[r] = 0.f; }
                        const float idt = row == fr ? 1.f : 0.f; w1[r] = idt - gn[r]; w1T[r] = idt - gnT[r]; }
                    const bf16x8 bn = rw_c4(gn), bnT = rw_c4(gnT);
                    const f32x4 n2 = RW_MFMA(bnT, bn, Z), n2T = RW_MFMA(bn, bnT, Z);
                    const bf16x8 b2 = rw_c4(n2), b2T = rw_c4(n2T);
                    const f32x4 n4 = RW_MFMA(b2T, b2, Z), n4T = RW_MFMA(b2, b2T, Z);
                    const bf16x8 b4 = rw_c4(n4), b4T = rw_c4(n4T);
                    const f32x4 n8 = RW_MFMA(b4T, b4, Z);
                    const bf16x8 bw1T = rw_c4(w1T);
                    const f32x4 w2 = RW_MFMA(bw1T, b2, w1), w2T = RW_MFMA(b2, bw1T, w1T);
                    const bf16x8 bw2T = rw_c4(w2T);
                    const f32x4 w3 = RW_MFMA(bw2T, b4, w2), w3T = RW_MFMA(b4, bw2T, w2T);
                    const f32x4 xi = RW_MFMA(rw_c4(w3T), rw_c4(n8), w3);
                    const bf16x8 bx = rw_c4(xi);
                    const f32x4 am = RW_MFMA(rw_c4(gkkT), bx, Z);
                    rw_st_cols(AMT, am, fr, kg, 16); rw_st_cols(ARKT, grk, fr, kg, 16); { f32x4 nb = Z - grb; rw_st_cols(ARBTN, nb, fr, kg, 16); }
#pragma unroll
                    for (int m = 0; m < 4; ++m) { const f32x4 ap = RW_MFMA(rw_perm4(AT2 + (16 * m + fr) * 16, kg), bx, Z);
                        rw_st_cols(APT + 16 * m, ap, fr, kg, RW_P); }
                }
                __syncthreads();
            }
        }
    }
}

__device__ __forceinline__ void phase_fin_rwkv(Frame& F, int li) { WS_DECL; frame_refresh(F);
    const int nrows = li == DEPTH - 1 ? NL : NT; const int lane = F.lane, wave = F.wave, tid = F.tid;
    LAS float* GUP = (LAS float*)F.lds;
    LAS float* SG = (LAS float*)(F.lds + 65536) + wave * 64;
    const bf16* P = WSP(bf16, WS_P); const float* YR = WSP(float, WS_YR); const float* BON = WSP(float, WS_BON); bf16* MIX = WSP(bf16, WS_A1);
    { const float* gup = in_ptr(I_GUP) + (size_t)li * 64 * 256; for (int i = tid; i < 64 * 256; i += NTHR) GUP[i] = gup[i]; }
    const float* mup = in_ptr(I_MUP) + li * 960; const float* mun = in_ptr(I_MUN) + li * 960;
    const f32x4 mpv = *(const GAS f32x4*)(mup + 512 + 4 * lane), mnv = *(const GAS f32x4*)(mun + 512 + 4 * lane);
    const float mpg = mup[896 + lane], mng = mun[896 + lane];
    const f32x4 lg = *(const GAS f32x4*)(in_ptr(I_LNG) + li * 256 + 4 * lane), lb = *(const GAS f32x4*)(in_ptr(I_LNB) + li * 256 + 4 * lane);
    __syncthreads();
    const int gw = blockIdx.x * NWAVES + wave, NGW = F.G * NWAVES;
    for (int m = gw; m < nrows; m += NGW) {
        const bool isctx = m >= NL; const int t = isctx ? (m - NL) & 255 : m & 4095; const int Ls = isctx ? 256 : 4096;
        const bf16* pr = P + (size_t)m * PCOLS + RW_C0;
        const bool hp = t > 0, hn = t + 1 < Ls;
        f32x4 v;
        { const v2u w = *(const GAS v2u*)(pr + 512 + 4 * lane); v2u wp = (v2u){0u, 0u}, wn = (v2u){0u, 0u};
          if (hp) wp = *(const GAS v2u*)(pr - PCOLS + 512 + 4 * lane); if (hn) wn = *(const GAS v2u*)(pr + PCOLS + 512 + 4 * lane);
          const f32x4 x = (f32x4){bflo(w.x), bfhi(w.x), bflo(w.y), bfhi(w.y)}, xp = (f32x4){bflo(wp.x), bfhi(wp.x), bflo(wp.y), bfhi(wp.y)}, xn = (f32x4){bflo(wn.x), bfhi(wn.x), bflo(wn.y), bfhi(wn.y)};
          v = x + mpv * (xp - x) + mnv * (xn - x); }
        { const float x = bf2f(pr[896 + lane]); const float xp = hp ? bf2f(pr[896 + lane - PCOLS]) : 0.f, xn = hn ? bf2f(pr[896 + lane + PCOLS]) : 0.f;
          SG[lane] = sigmoidf_(x + mpg * (xp - x) + mng * (xn - x)); }
        LDS_WAIT();
        f32x4 g = (f32x4){0.f, 0.f, 0.f, 0.f};
#pragma unroll 8
        for (int j = 0; j < 64; ++j) { const float sj = SG[j]; const f32x4 gu = *(const LAS f32x4*)(GUP + j * 256 + 4 * lane); g = g + gu * sj; }
        const f32x4 y = *(const GAS f32x4*)(YR + (size_t)m * 256 + 4 * lane) + *(const GAS f32x4*)(YR + ((size_t)NT + m) * 256 + 4 * lane);
        const float mean = rowsum16((y.x + y.y) + (y.z + y.w)) * (1.f / 64.f);
        const f32x4 yc = y - mean; const float var = rowsum16((yc.x * yc.x + yc.y * yc.y) + (yc.z * yc.z + yc.w * yc.w)) * (1.f / 64.f);
        const f32x4 yn = yc * __builtin_amdgcn_rsqf(var + 64e-5f) * lg + lb;
        const int hh = lane >> 4; const float bon = BON[(size_t)m * 4 + hh] + BON[((size_t)NT + m) * 4 + hh];
        const f32x4 o = (yn + v * bon) * g;
        v2u ow; ow.x = pk2(o.x, o.y); ow.y = pk2(o.z, o.w); *(GAS v2u*)(MIX + (size_t)m * D + 512 + 4 * lane) = ow;
        LDS_WAIT();
    }
    __syncthreads();
}

constexpr float HY_DMIN = -3.0701134573253945f, HY_DMAX = -15.350567286626973f;
constexpr int HY_X = 0, HY_TW = 65536, HY_W3 = 98304;
__device__ __forceinline__ float hy_delta(int ch) { return -(HY_DMIN + (float)ch * ((HY_DMAX - HY_DMIN) / 255.f)); }

__device__ __forceinline__ void phase_pro0d(Frame& F) { WS_DECL; frame_refresh(F);
    const int lane = F.lane; const int gw = blockIdx.x * NWAVES + F.wave, NGW = F.G * NWAVES;
    const float* w1 = in_ptr(I_HW1); const float* b1 = in_ptr(I_HB1); const float* w2 = in_ptr(I_HW2); const float* b2 = in_ptr(I_HB2);
    for (int it = gw; it < DEPTH * (SEQ + LCX); it += NGW) {
        const int li = it / (SEQ + LCX), r = it % (SEQ + LCX); const bool isctx = r >= SEQ; const int l = isctx ? r - SEQ : r; const int L = isctx ? LCX : SEQ;
        float z = 0.f;
        if (lane == 0) z = (float)l / (float)(L - 1);
        else if (lane < 33) { const int i = (lane - 1) & 15; const float band = 1e-4f + (float)i * ((15.f - 1e-4f) / 15.f); const float ang = band * (6.283185307179586f / (float)L) * (float)l; z = lane < 17 ? cosf(ang) : -sinf(ang); }
        float h1 = b1[li * 64 + lane];
        for (int i = 0; i < 33; ++i) h1 += __shfl(z, i) * w1[(li * 33 + i) * 64 + lane];
        h1 = sinf(h1);
        float h2 = b2[li * 64 + lane];
        for (int i = 0; i < 64; ++i) h2 += __shfl(h1, i) * w2[(li * 64 + i) * 64 + lane];
        h2 = sinf(h2);
        float* dst = isctx ? WSP(float, WS_H2C) + ((size_t)li * LCX + l) * 64 : WSP(float, WS_H2L) + ((size_t)li * SEQ + l) * 64;
        dst[lane] = h2;
    }
}

typedef f32x2 cpx;
__device__ __forceinline__ cpx cmul(cpx a, cpx b) { return (cpx){a.x * b.x - a.y * b.y, a.x * b.y + a.y * b.x}; }
__device__ __forceinline__ cpx cmulc(cpx a, cpx b) { return (cpx){a.x * b.x + a.y * b.y, a.y * b.x - a.x * b.y}; }
__device__ __forceinline__ cpx cmi(cpx z) { return (cpx){z.y, -z.x}; }
__device__ __forceinline__ int hy_p(int n) { return n ^ ((n >> 5) & 7) ^ (((n >> 6) & 3) << 3); }
__device__ __forceinline__ void hy_build_tw(Frame& F) {
    LAS cpx* TW = (LAS cpx*)(F.lds + HY_TW);
    for (int k = F.tid; k < 4096; k += NTHR) { const float rev = (float)k * (1.f / 8192.f); TW[k] = (cpx){__builtin_amdgcn_cosf(rev), -__builtin_amdgcn_sinf(rev)};     }
}
__device__ __forceinline__ void dft4(cpx x0, cpx x1, cpx x2, cpx x3, cpx& X0, cpx& X1, cpx& X2, cpx& X3) {
    const cpx t0 = x0 + x2, t1 = x0 - x2, t2 = x1 + x3, t3 = cmi(x1 - x3); X0 = t0 + t2; X1 = t1 + t3; X2 = t0 - t2; X3 = t1 - t3; }
__device__ __forceinline__ void dft8(cpx (&a)[8]) {
    const float R2 = 0.7071067811865476f; cpx e[4], o[4];
    dft4(a[0] + a[4], a[1] + a[5], a[2] + a[6], a[3] + a[7], e[0], e[1], e[2], e[3]);
    const cpx d1 = a[1] - a[5], d3 = a[3] - a[7];
    dft4(a[0] - a[4], (cpx){(d1.x + d1.y) * R2, (d1.y - d1.x) * R2}, cmi(a[2] - a[6]), (cpx){(d3.y - d3.x) * R2, -(d3.x + d3.y) * R2}, o[0], o[1], o[2], o[3]);
#pragma unroll
    for (int m = 0; m < 4; ++m) { a[2 * m] = e[m]; a[2 * m + 1] = o[m]; }
}
__device__ __forceinline__ void dft16(cpx (&a)[16]) {
    const float C1 = 0.9238795325112867f, S1 = 0.3826834323650898f, R2 = 0.7071067811865476f;
    cpx e[8], o[8];
#pragma unroll
    for (int k = 0; k < 8; ++k) { e[k] = a[k] + a[k + 8]; o[k] = a[k] - a[k + 8]; }
    o[1] = cmul(o[1], (cpx){C1, -S1}); o[2] = cmul(o[2], (cpx){R2, -R2}); o[3] = cmul(o[3], (cpx){S1, -C1}); o[4] = cmi(o[4]);
    o[5] = cmul(o[5], (cpx){-S1, -C1}); o[6] = cmul(o[6], (cpx){-R2, -R2}); o[7] = cmul(o[7], (cpx){-C1, -S1});
    dft8(e); dft8(o);
#pragma unroll
    for (int m = 0; m < 8; ++m) { a[2 * m] = e[m]; a[2 * m + 1] = o[m]; }
}
template <int R> __device__ __forceinline__ void cconj(cpx (&a)[R]) {
#pragma unroll
    for (int k = 0; k < R; ++k) a[k].y = -a[k].y; }
template <bool INV, bool ZU> __device__ __forceinline__ void hy_pass1(LAS cpx* X, const LAS cpx* TW, int tid) {
    cpx a[16]; const cpx w1 = TW[tid];
#pragma unroll
    for (int k = 0; k < 16; ++k) a[k] = (!INV && ZU && k >= 8) ? (cpx){0.f, 0.f} : X[hy_p(tid + 512 * k)];
    if (!INV) { dft16(a); cpx w = w1;
#pragma unroll
        for (int q = 1; q < 16; ++q) { a[q] = cmul(a[q], w); w = cmul(w, w1); }
    } else { cpx w = w1;
#pragma unroll
        for (int q = 1; q < 16; ++q) { a[q] = cmulc(a[q], w); w = cmul(w, w1); }
        cconj<16>(a); dft16(a); cconj<16>(a); }
#pragma unroll
    for (int k = 0; k < 16; ++k) if (!(INV && ZU && k >= 8)) X[hy_p(tid + 512 * k)] = a[k];
}
template <bool INV, int S, int MUL> __device__ __forceinline__ void hy_pass8(LAS cpx* X, const LAS cpx* TW, int tid) {
#pragma unroll
    for (int h = 0; h < 2; ++h) { const int bf = tid + 512 * h, sub = bf / S, j = bf % S, base = 8 * S * sub + j; cpx a[8]; const cpx w1 = TW[MUL * j];
#pragma unroll
        for (int k = 0; k < 8; ++k) a[k] = X[hy_p(base + S * k)];
        if (!INV) { dft8(a); cpx w = w1;
#pragma unroll
            for (int q = 1; q < 8; ++q) { a[q] = cmul(a[q], w); w = cmul(w, w1); }
        } else { cpx w = w1;
#pragma unroll
            for (int q = 1; q < 8; ++q) { a[q] = cmulc(a[q], w); w = cmul(w, w1); }
            cconj<8>(a); dft8(a); cconj<8>(a); }
#pragma unroll
        for (int k = 0; k < 8; ++k) X[hy_p(base + S * k)] = a[k]; }
}
__device__ __forceinline__ void hy_pass4(LAS cpx* X, int tid, const cpx* spec) {
#pragma unroll
    for (int h = 0; h < 2; ++h) { const int g = tid + 512 * h; cpx a[8];
#pragma unroll
        for (int k = 0; k < 8; ++k) a[k] = X[hy_p(8 * g + k)];
        dft8(a);
        if (spec) {
#pragma unroll
            for (int k2 = 0; k2 < 4; ++k2) { const f32x4 s4 = *(const GAS f32x4*)(spec + 8 * g + 2 * k2); a[2 * k2] = cmul(a[2 * k2], (cpx){s4.x, s4.y}); a[2 * k2 + 1] = cmul(a[2 * k2 + 1], (cpx){s4.z, s4.w}); }
            cconj<8>(a); dft8(a); cconj<8>(a); }
#pragma unroll
        for (int k = 0; k < 8; ++k) X[hy_p(8 * g + k)] = a[k]; }
}
__device__ __forceinline__ void hy_conv_fft(LAS cpx* X, const LAS cpx* TW, int tid, const cpx* spec) {
    hy_pass1<false, true>(X, TW, tid); __syncthreads();
    hy_pass8<false, 64, 16>(X, TW, tid); __syncthreads();
    hy_pass8<false, 8, 128>(X, TW, tid); __syncthreads();
    hy_pass4(X, tid, spec); __syncthreads();
    hy_pass8<true, 8, 128>(X, TW, tid); __syncthreads();
    hy_pass8<true, 64, 16>(X, TW, tid); __syncthreads();
    hy_pass1<true, true>(X, TW, tid); __syncthreads();
}

__device__ __forceinline__ void phase_hy_spec(Frame& F, int li) { WS_DECL; frame_refresh(F);
    LAS cpx* X = (LAS cpx*)(F.lds + HY_X); const LAS cpx* TW = (const LAS cpx*)(F.lds + HY_TW); LAS float* W3 = (LAS float*)(F.lds + HY_W3);
    const int tid = F.tid; const float* w3 = in_ptr(I_HW3) + (size_t)li * 64 * 1024; const float* H2 = WSP(float, WS_H2L) + (size_t)li * SEQ * 64; cpx* SPEC = WSP(cpx, WS_SPEC);
    __syncthreads();
    hy_build_tw(F);
    for (int item = blockIdx.x; item < 512; item += F.G) {
        const int o = item >> 8, ch = item & 255;
        __syncthreads();
        if (tid < 128) { const int dir = tid >> 6, j = tid & 63; W3[tid] = w3[(size_t)j * 1024 + o * 512 + dir * 256 + ch]; }
        __syncthreads();
        const float delta = hy_delta(ch);
#pragma unroll 1
        for (int i = 0; i < 8; ++i) { const int l = tid + 512 * i; const float* hr = H2 + (size_t)l * 64; float hf = 0.f, hb = 0.f;
#pragma unroll
            for (int j4 = 0; j4 < 16; ++j4) { const f32x4 h4 = *(const GAS f32x4*)(hr + 4 * j4);
                hf += h4.x * W3[4 * j4] + h4.y * W3[4 * j4 + 1] + h4.z * W3[4 * j4 + 2] + h4.w * W3[4 * j4 + 3]; hb += h4.x * W3[64 + 4 * j4] + h4.y * W3[64 + 4 * j4 + 1] + h4.z * W3[64 + 4 * j4 + 2] + h4.w * W3[64 + 4 * j4 + 3]; }
            const float win = (__expf(-((float)l * (1.f / 4095.f)) * delta) + 0.05f) * (1.f / 8192.f);
            X[hy_p(l)] = (cpx){hf * win, 0.f};
            if (l == 0) X[hy_p(4096)] = (cpx){0.f, 0.f}; else X[hy_p(8192 - l)] = (cpx){hb * win, 0.f}; }
        __syncthreads();
        hy_pass1<false, false>(X, TW, tid); __syncthreads();
        hy_pass8<false, 64, 16>(X, TW, tid); __syncthreads();
        hy_pass8<false, 8, 128>(X, TW, tid); __syncthreads();
        hy_pass4(X, tid, nullptr); __syncthreads();
        cpx* dst = SPEC + (size_t)item * 8192;
#pragma unroll
        for (int i = 0; i < 16; ++i) *(GAS cpx*)(dst + tid + 512 * i) = X[hy_p(tid + 512 * i)];
    }
    __syncthreads();
}

__device__ __forceinline__ void hy_conv8(const bf16* row, int t0, int Ls, float w0, float w1, float w2, float bias, float (&out)[8]) {
    const v4u raw = *(const GAS v4u*)(row + t0); float p[10];
    p[0] = t0 > 0 ? bf2f(row[t0 - 1]) : 0.f; p[9] = t0 + 8 < Ls ? bf2f(row[t0 + 8]) : 0.f;
    p[1] = bflo(raw.x); p[2] = bfhi(raw.x); p[3] = bflo(raw.y); p[4] = bfhi(raw.y); p[5] = bflo(raw.z); p[6] = bfhi(raw.z); p[7] = bflo(raw.w); p[8] = bfhi(raw.w);
#pragma unroll
    for (int e = 0; e < 8; ++e) out[e] = bias + w0 * p[e] + w1 * p[e + 1] + w2 * p[e + 2];
}

__device__ __forceinline__ void phase_hy_conv(Frame& F, int li) { WS_DECL; frame_refresh(F);
    LAS cpx* X = (LAS cpx*)(F.lds + HY_X); const LAS cpx* TW = (const LAS cpx*)(F.lds + HY_TW);
    const int tid = F.tid; const bf16* HT = WSP(bf16, WS_HT); bf16* HOT = WSP(bf16, WS_HOT); const cpx* SPEC = WSP(cpx, WS_SPEC);
    const float* cw = in_ptr(I_HCW) + li * 3 * 768; const float* cb = in_ptr(I_HCB) + li * 768; const float* dsk = in_ptr(I_HD) + li * 512;
    __syncthreads();
    hy_build_tw(F);
    for (int item = blockIdx.x; item < 2048; item += F.G) {
        const int ch = item >> 3, bp = item & 7; const int t0 = 8 * tid;
        float v[2][8], x1[2][8], x2[2][8];
#pragma unroll
        for (int q = 0; q < 2; ++q) { const size_t boff = (size_t)(2 * bp + q) * SEQ;
            hy_conv8(HT + (size_t)ch * NT + boff, t0, SEQ, cw[ch], cw[768 + ch], cw[1536 + ch], cb[ch], v[q]);
            hy_conv8(HT + (size_t)(256 + ch) * NT + boff, t0, SEQ, cw[256 + ch], cw[768 + 256 + ch], cw[1536 + 256 + ch], cb[256 + ch], x1[q]);
            hy_conv8(HT + (size_t)(512 + ch) * NT + boff, t0, SEQ, cw[512 + ch], cw[768 + 512 + ch], cw[1536 + 512 + ch], cb[512 + ch], x2[q]); }
        const float d0 = dsk[ch], d1 = dsk[256 + ch];
        __syncthreads();
#pragma unroll
        for (int e = 0; e < 8; ++e) X[hy_p(t0 + e)] = (cpx){v[0][e], v[1][e]};
        __syncthreads();
        hy_conv_fft(X, TW, tid, SPEC + (size_t)ch * 8192);
        float u[2][8];
#pragma unroll
        for (int e = 0; e < 8; ++e) { const cpx y = X[hy_p(t0 + e)]; u[0][e] = x1[0][e] * (y.x + v[0][e] * d0); u[1][e] = x1[1][e] * (y.y + v[1][e] * d0); X[hy_p(t0 + e)] = (cpx){u[0][e], u[1][e]}; }
        __syncthreads();
        hy_conv_fft(X, TW, tid, SPEC + (size_t)(256 + ch) * 8192);
#pragma unroll
        for (int q = 0; q < 2; ++q) { float o[8];
#pragma unroll
            for (int e = 0; e < 8; ++e) { const cpx y = X[hy_p(t0 + e)]; o[e] = x2[q][e] * ((q == 0 ? y.x : y.y) + u[q][e] * d1); }
            v4u w; w.x = pk2(o[0], o[1]); w.y = pk2(o[2], o[3]); w.z = pk2(o[4], o[5]); w.w = pk2(o[6], o[7]);
            *(GAS v4u*)(HOT + (size_t)ch * NT + (size_t)(2 * bp + q) * SEQ + t0) = w; }
    }
    __syncthreads();
}

__device__ __forceinline__ void phase_hy_ctx(Frame& F, int li) { WS_DECL; frame_refresh(F);
    LAS float* KF = (LAS float*)F.lds;
    LAS float* SIG = KF + 1024;
    LAS float* W3 = KF + 2048;
    const int tid = F.tid; const bf16* HT = WSP(bf16, WS_HT); bf16* HOT = WSP(bf16, WS_HOT);
    const float* w3 = in_ptr(I_HW3) + (size_t)li * 64 * 1024; const float* H2 = WSP(float, WS_H2C) + (size_t)li * LCX * 64;
    const float* cw = in_ptr(I_HCW) + li * 3 * 768; const float* cb = in_ptr(I_HCB) + li * 768; const float* dsk = in_ptr(I_HD) + li * 512;
    for (int ch = blockIdx.x; ch < 256; ch += F.G) {
        __syncthreads();
        if (tid < 256) { const int od = tid >> 6, j = tid & 63; W3[tid] = w3[(size_t)j * 1024 + (od >> 1) * 512 + (od & 1) * 256 + ch]; }
        __syncthreads();
        { const int o = tid >> 8, l = tid & 255; const float* hr = H2 + (size_t)l * 64; float hf = 0.f, hb = 0.f;
          for (int j = 0; j < 64; ++j) { const float hv = hr[j]; hf += hv * W3[(2 * o) * 64 + j]; hb += hv * W3[(2 * o + 1) * 64 + j]; }
          const float win = __expf(-((float)l * (1.f / 255.f)) * hy_delta(ch)) + 0.05f;
          KF[(2 * o) * 256 + l] = hf * win; KF[(2 * o + 1) * 256 + l] = hb * win; }
        __syncthreads();
        const int q = tid >> 8, t = tid & 255; const float d0 = dsk[ch], d1 = dsk[256 + ch];
        for (int bp = 0; bp < 8; ++bp) { const int b = 2 * bp + q; const size_t off = (size_t)NL + (size_t)b * LCX;
            float zz[3];
#pragma unroll
            for (int k = 0; k < 3; ++k) { const int c = 256 * k + ch; const bf16* row = HT + (size_t)c * NT + off;
                const float pm = t > 0 ? bf2f(row[t - 1]) : 0.f, p0 = bf2f(row[t]), pp = t + 1 < LCX ? bf2f(row[t + 1]) : 0.f;
                zz[k] = cb[c] + cw[c] * pm + cw[768 + c] * p0 + cw[1536 + c] * pp; }
            SIG[q * 256 + t] = zz[0];
            __syncthreads();
            float y = 0.f;
            for (int s = 0; s < 256; ++s) { const int lag = t - s; const float kv = lag >= 0 ? KF[lag] : KF[256 - lag]; y += kv * SIG[q * 256 + s]; }
            const float u = zz[1] * (y + zz[0] * d0);
            __syncthreads();
            SIG[q * 256 + t] = u;
            __syncthreads();
            float y2 = 0.f;
            for (int s = 0; s < 256; ++s) { const int lag = t - s; const float kv = lag >= 0 ? KF[512 + lag] : KF[768 - lag]; y2 += kv * SIG[q * 256 + s]; }
            HOT[(size_t)ch * NT + off + t] = (bf16)f2bf(zz[2] * (y2 + u * d1));
            __syncthreads();
        }
    }
    __syncthreads();
}

constexpr int HF_LD = 72;
__device__ __forceinline__ void phase_fin_hyena(Frame& F, int li) { WS_DECL; frame_refresh(F);
    LAS bf16* T = (LAS bf16*)F.lds;
    const int nrows = li == DEPTH - 1 ? NL : NT; const int tid = F.tid, lane = F.lane, wave = F.wave; const bf16* HOT = WSP(bf16, WS_HOT); bf16* MIX = WSP(bf16, WS_A1);
    const f32x4 g4 = *(const GAS f32x4*)(in_ptr(I_HON) + li * 256 + 4 * lane);
    for (int item = blockIdx.x; item < nrows / 64; item += F.G) { const int m0 = item * 64;
        __syncthreads();
        { const int ch = tid >> 1, hf = tid & 1; const bf16* src = HOT + (size_t)ch * NT + m0 + 32 * hf;
#pragma unroll
          for (int k = 0; k < 4; ++k) *(LAS v4u*)(T + ch * HF_LD + 32 * hf + 8 * k) = *(const GAS v4u*)(src + 8 * k); }
        __syncthreads();
        for (int i = 0; i < 8; ++i) { const int tl = wave * 8 + i;
            f32x4 x; x.x = bf2f(T[(4 * lane) * HF_LD + tl]); x.y = bf2f(T[(4 * lane + 1) * HF_LD + tl]); x.z = bf2f(T[(4 * lane + 2) * HF_LD + tl]); x.w = bf2f(T[(4 * lane + 3) * HF_LD + tl]);
            const float r = __builtin_amdgcn_rsqf(wave_sum(x.x * x.x + x.y * x.y + x.z * x.z + x.w * x.w) * (1.f / 256.f) + 1e-6f);
            v2u o; o.x = pk2(x.x * r * g4.x, x.y * r * g4.y); o.y = pk2(x.z * r * g4.z, x.w * r * g4.w); *(GAS v2u*)(MIX + (size_t)(m0 + tl) * D + 768 + 4 * lane) = o; }
    }
    __syncthreads();
}
#define MIX_HYENA 1

#define GRID_BAR() do { XcdBarrier bar_; bar_.leader = (F.wave == 0 && mk_lane() == 0); bar_.bar = (unsigned*)(ws_ptr() + WS_CTL) + CW_BAR; bar_.x = xb_xcc_id(); bar_.st = (volatile LAS unsigned*)(F.lds + LDSCTL_OFF) + 8; xcd_barrier(bar_); } while (0)

template <int li>
__device__ __forceinline__ void layer_fwd(Frame& F) {
        const int nrows = li == DEPTH - 1 ? NL : NT; unsigned char* const ws = ws_ptr();
        phase_hy_spec(F, li);
        { pg8::Gemm g{WSP(bf16, WS_A1), WSP(bf16, WS_WINT) + (size_t)li * PCOLS * D, NT, PCOLS, D}; pg8::StaticOrder S; S.init(NT, PCOLS, F.G, (int)blockIdx.x);
          pg8::EpiStore E{WSP(bf16, WS_P), PCOLS, 0, PCOLS / 256};
          pg8::gemm_phase<pg8::EpiStore, pg8::StaticOrder, true, true>(F.lds, g, S, E, F.wave); }
#if MIX_HYENA
        { pg8::Gemm g{WSP(bf16, WS_WHYT) + (size_t)li * HYC * D, WSP(bf16, WS_A1), HYC, NT, D}; pg8::StaticOrder S; S.init(HYC, NT, F.G, (int)blockIdx.x);
          pg8::EpiStore E{WSP(bf16, WS_HT), NT, 0, NT / 256};
          pg8::gemm_phase<pg8::EpiStore, pg8::StaticOrder, true, true>(F.lds, g, S, E, F.wave); }
#endif
        GRID_BAR();
        phase_rwkv_r0(F, li);
        phase_mla_prep(F, li);
        phase_lru<1>(F, li);
        __syncthreads();
        phase_hy_conv(F, li);
        if (li < DEPTH - 1) phase_hy_ctx(F, li);
        GRID_BAR();
        phase_rwkv_scan(F, li);
        __syncthreads();
        phase_attn(F, li);
        __syncthreads();
        phase_lru<3>(F, li);
        GRID_BAR();
        phase_fin_mla(F, li);
        phase_fin_rwkv(F, li); phase_fin_hyena(F, li);
        GRID_BAR();
        { pg8::Gemm g{WSP(bf16, WS_A1), WSP(bf16, WS_WOUTT) + (size_t)li * D * D, nrows, D, D}; pg8::StaticOrder S; S.init(nrows, D, F.G, (int)blockIdx.x);
          pg8::EpiStore E{WSP(bf16, WS_Y), D, 0, D / 256};
          pg8::gemm_phase<pg8::EpiStore, pg8::StaticOrder, true, true>(F.lds, g, S, E, F.wave); }
        GRID_BAR();
        phase_ln1<true>(F, li);
        if (li & 1) phase_moe_weights(F, li);
        GRID_BAR();
        if (!(li & 1)) {
            const int j = li >> 1;
            { pg8::Gemm g{(const pg8::bf16_t*)WSP(unsigned char, WS_A1), (const pg8::bf16_t*)(WSP(unsigned char, WS_WGUT) + (size_t)j * 2 * FFD * D), nrows, 2 * FFD, D / 2}; pg8::StaticOrder S; S.init(nrows, 2 * FFD, F.G, (int)blockIdx.x);
              pg8::EpiSwiGLU E{WSP(bf16, WS_H), FFD, 0, 2 * FFD / 256};
              pg8::gemm_phase<pg8::EpiSwiGLU, pg8::StaticOrder, true, true, true, 124>(F.lds, g, S, E, F.wave); }
            GRID_BAR();
            { pg8::Gemm g{WSP(bf16, WS_H), WSP(bf16, WS_WDT) + (size_t)j * D * FFD, nrows, D, FFD}; pg8::StaticOrder S; S.init(nrows, D, F.G, (int)blockIdx.x);
              pg8::EpiStore E{WSP(bf16, WS_Y), D, 0, D / 256};
              pg8::gemm_phase<pg8::EpiStore, pg8::StaticOrder, true, true>(F.lds, g, S, E, F.wave); }
            GRID_BAR();
        } else {
            phase_moe_slots(F, li);
            GRID_BAR();
            const int ntiles = __builtin_amdgcn_readfirstlane(((LAS int*)(F.lds + LDS_MOEI))[48]);
            const PG8_LAS unsigned char* tile_e = (const PG8_LAS unsigned char*)(F.lds + LDS_TILEE);
#pragma unroll 1
            for (int ch = 0; ch < MOE_NCHUNK; ++ch) {
                const int t0 = ch * MOE_CHUNK_TILES; int nM = ntiles - t0; nM = nM < 0 ? 0 : (nM > MOE_CHUNK_TILES ? MOE_CHUNK_TILES : nM);
                { pg8::Gemm g{(const pg8::bf16_t*)WSP(unsigned char, WS_XS8), (const pg8::bf16_t*)WSP(unsigned char, WS_M8GU), 0, 0, D / 2}; pg8::MoeOrder S; S.init(nM, 2 * FFE / 256, F.G, (int)blockIdx.x, t0, t0, tile_e);
                  pg8::EpiSwiGLU8 E{WSP(unsigned char, WS_HM8), FFE, t0, 2 * FFE / 256};
                  pg8::gemm_phase<pg8::EpiSwiGLU8, pg8::MoeOrder, true, true, true, 124>(F.lds, g, S, E, F.wave); }
                GRID_BAR();
                { pg8::Gemm g{(const pg8::bf16_t*)WSP(unsigned char, WS_HM8), (const pg8::bf16_t*)WSP(unsigned char, WS_M8D), 0, 0, FFE / 2}; pg8::MoeOrder S; S.init(nM, D / 256, F.G, (int)blockIdx.x, t0, 0, tile_e);
                  pg8::EpiStore E{WSP(bf16, WS_Y2), D, t0, D / 256};
                  pg8::gemm_phase<pg8::EpiStore, pg8::MoeOrder, true, true, true, 123>(F.lds, g, S, E, F.wave); }
                GRID_BAR();
            }
        }
        phase_ln2<true>(F, li);
        if (li < DEPTH - 1) GRID_BAR();
}

__global__ void __launch_bounds__(NTHR, 2) mk_fwd(Args a) {
    extern __shared__ __attribute__((aligned(16))) unsigned char lds_raw[];
    Frame F; F.lds = (LAS unsigned char*)lds_raw; F.tid = threadIdx.x; F.lane = F.tid & 63; F.wave = __builtin_amdgcn_readfirstlane(F.tid >> 6); F.G = gridDim.x;
    for (int u = F.tid; u < (LDS_BYTES - LDSCTL_OFF) / 4; u += NTHR) ((LAS unsigned*)(F.lds + LDSCTL_OFF))[u] = 0u;
    __syncthreads();
    (void)xcd_barrier_post((unsigned*)(ws_ptr() + WS_CTL) + CW_BAR, (volatile LAS unsigned*)(F.lds + LDSCTL_OFF) + 8, F.tid == 0);

    phase_pro0(F);
    phase_pro0b(F);
    phase_pro0c(F);
    phase_pro0d(F);
    phase_pro0e(F);
    GRID_BAR();
    phase_hin0(F);
    GRID_BAR();
    layer_fwd<0>(F); layer_fwd<1>(F); layer_fwd<2>(F); layer_fwd<3>(F);
}

extern "C" void kernel_launch(void* const* d_in, const int* in_sizes, int n_in, void* d_out, int out_size, void* d_ws, size_t ws_size, hipStream_t stream) {
    static int grid = 0;
    if (grid == 0) {
        if (n_in != N_INPUTS || out_size != NL * D || ws_size < WS_END) { fprintf(stderr, "kernel_launch: unexpected shapes (n_in %d out %d ws %zu)\n", n_in, out_size, ws_size); grid = -1; return; }
        int dev = 0, cus = 0, per_cu = 0;
        if (hipGetDevice(&dev) != hipSuccess || hipDeviceGetAttribute(&cus, hipDeviceAttributeMultiprocessorCount, dev) != hipSuccess) { grid = -1; return; }
        if (hipFuncSetAttribute((const void*)mk_fwd, hipFuncAttributeMaxDynamicSharedMemorySize, LDS_BYTES) != hipSuccess) { fprintf(stderr, "kernel_launch: hipFuncSetAttribute failed\n"); grid = -1; return; }
        if (hipOccupancyMaxActiveBlocksPerMultiprocessor(&per_cu, (const void*)mk_fwd, NTHR, LDS_BYTES) != hipSuccess || per_cu < 1) fprintf(stderr, "kernel_launch: occupancy query reports %d\n", per_cu);
        (void)hipGetLastError();
        grid = cus > 256 ? 256 : cus;
    }
    if (grid < 0) return;
    if (hipMemsetAsync((char*)d_ws + WS_CTL, 0, CTL_ZERO_BYTES, stream) != hipSuccess) return;
    Args a{};
    for (int i = 0; i < N_INPUTS; ++i) a.in[i] = (const float*)d_in[i];
    a.out = (float*)d_out; a.ws = (unsigned char*)d_ws;
    hipLaunchKernelGGL(mk_fwd, dim3(grid), dim3(NTHR), LDS_BYTES, stream, a);
    const hipError_t le = hipPeekAtLastError();
    if (le != hipSuccess) fprintf(stderr, "kernel_launch: launch failed: %s\n", hipGetErrorName(le));
}
```

```cpp
#include <hip/hip_runtime.h>
#include <cstdio>
#include <cstdint>
#define GAS __attribute__((address_space(1)))
#define LAS __attribute__((address_space(3)))
__device__ __forceinline__ int mk_lane() { int l; asm volatile("v_mbcnt_lo_u32_b32 %0, -1, 0\n\tv_mbcnt_hi_u32_b32 %0, -1, %0" : "=v"(l)); return l; }
namespace pg8 {
#define PG8_LAS __attribute__((address_space(3)))
typedef unsigned short bf16_t;
typedef short bf16x8 __attribute__((ext_vector_type(8)));
typedef float f32x4 __attribute__((ext_vector_type(4)));
typedef unsigned u32x4 __attribute__((ext_vector_type(4)));
constexpr int BM = 256, BK = 64, HALF = 128, HTB = HALF * BK * 2  , STAGE_BYTES = 8 * HTB, NXCD = 8, WGM = 8;

__host__ __device__ __forceinline__ int lds_byte(int r, int c) { const int st = (r >> 4) * 2 + (c >> 5), rr = r & 15, cc = c & 31, ob = rr * 64 + cc * 2; return st * 1024 + (ob ^ (((ob >> 9) & 1) << 5)); }
__host__ __device__ __forceinline__ void stage_rc(int b, int& R, int& C) { const int st = b / 1024, sb = b % 1024, swz = sb ^ (((sb >> 9) & 1) << 5); R = (st >> 1) * 16 + swz / 64; C = (st & 1) * 32 + (swz % 64) / 2; }
__host__ __device__ __forceinline__ int perm32(int rho) { const int n = rho >> 4, i = rho & 15; return 8 * (i >> 2) + 4 * n + (i & 3); }

struct Unit { int pm, pn, g; };
struct Gemm { const bf16_t* A; const bf16_t* Bt; int M, N, K; const bf16_t* A2 = nullptr; const bf16_t* Bt2 = nullptr; };

struct StaticOrder {
    int nM, nN, nwg, G, c;
    __host__ __device__ void init(int M, int N, int G_, int c_) { nM = M / BM; nN = N / BM; nwg = nM * nN; G = G_; c = c_; }
    __host__ __device__ bool next(int i, Unit& u) const {
        const long L = (long)i * G + c; if (L >= nwg) return false;
        int wgid = (int)L; { const int q = nwg / NXCD, r = nwg % NXCD, xcd = wgid % NXCD, off = wgid / NXCD; wgid = (xcd < r ? xcd * (q + 1) : r * (q + 1) + (xcd - r) * q) + off; }
        const int nig = WGM * nN, gid = wgid / nig, fm = gid * WGM, gsz = (nM - fm) < WGM ? (nM - fm) : WGM;
        u.pm = fm + ((wgid % nig) % gsz); u.pn = (wgid % nig) / gsz; u.g = 0; return true;
    }
    __device__ __forceinline__ void a_ready(const Unit&) const {}
    __device__ __forceinline__ void done(const Unit&) const {}
};

__device__ __forceinline__ unsigned cvt_pk_bf16(float lo, float hi) { unsigned r; asm volatile("v_cvt_pk_bf16_f32 %0, %1, %2" : "=v"(r) : "v"(lo), "v"(hi)); return r; }
typedef float f32x2 __attribute__((ext_vector_type(2)));
__device__ __forceinline__ f32x2 gelu_pk(f32x2 v) {
    const f32x2 av = __builtin_elementwise_abs(v), d = av * 0.2316418882f + 1.0f;
    f32x2 t; t.x = __builtin_amdgcn_rcpf(d.x); t.y = __builtin_amdgcn_rcpf(d.y);
    f32x2 q = t * 0.5307027145f + (-0.7265760135f); q = q * t + 0.7107068705f; q = q * t + (-0.142248368f); q = q * t + 0.127414796f; q = q * t;
    const f32x2 s = (v * v) * (-0.72134752044f);
    f32x2 e; e.x = __builtin_amdgcn_exp2f(s.x); e.y = __builtin_amdgcn_exp2f(s.y);
    const f32x2 m = v * (q * e), r = v - m;
    f32x2 o; o.x = v.x < 0.f ? m.x : r.x; o.y = v.y < 0.f ? m.y : r.y; return o;
}

template <int ACT  > struct EpiBf16 {
    static constexpr bool PERM = true, AFTER_DRAIN = false; static_assert(ACT == 0 || ACT == 1, "EpiBf16: ACT is 0 (none) or 1 (gelu_pk)");
    bf16_t* O; int ldc; const float* bias; int split_cols; size_t split_stride; float scale0;
    __device__ __forceinline__ void operator()(const f32x4 (&acc)[2][2][4][2], const Unit& u, int wr, int wc, int fr, int fq) const {
        const int row0 = u.pm * BM + wr * 64 + fr; int colt = u.pn * BM; bf16_t* base = O;
        float sc = 1.f; if (split_cols) { const int t = colt / split_cols; base += (size_t)t * split_stride; colt -= t * split_cols; if (t == 0) sc = scale0; }
        const int col0 = colt + wc * 32 + 8 * fq, bcol0 = u.pn * BM + wc * 32 + 8 * fq;
        f32x4 bv[2][2];
#pragma unroll
        for (int bj = 0; bj < 2; ++bj)
#pragma unroll
            for (int n = 0; n < 2; ++n) bv[bj][n] = bias ? *(const f32x4*)(bias + bcol0 + bj * HALF + 4 * n) : (f32x4){0.f, 0.f, 0.f, 0.f};
#pragma unroll
        for (int ai = 0; ai < 2; ++ai)
#pragma unroll
            for (int m = 0; m < 4; ++m) { bf16_t* rowp = base + (size_t)(row0 + ai * HALF + m * 16) * ldc + col0;
#pragma unroll
                for (int bj = 0; bj < 2; ++bj) { f32x4 v0 = acc[ai][bj][m][0] + bv[bj][0], v1 = acc[ai][bj][m][1] + bv[bj][1];
                    if (ACT == 1) { f32x2 a = gelu_pk((f32x2){v0[0], v0[1]}), b = gelu_pk((f32x2){v0[2], v0[3]}), c = gelu_pk((f32x2){v1[0], v1[1]}), d = gelu_pk((f32x2){v1[2], v1[3]});
                        v0 = (f32x4){a.x, a.y, b.x, b.y}; v1 = (f32x4){c.x, c.y, d.x, d.y}; }
                    v0 = v0 * sc; v1 = v1 * sc; u32x4 w; w.x = cvt_pk_bf16(v0[0], v0[1]); w.y = cvt_pk_bf16(v0[2], v0[3]); w.z = cvt_pk_bf16(v1[0], v1[1]); w.w = cvt_pk_bf16(v1[2], v1[3]);
                    *(u32x4*)(rowp + bj * HALF) = w; } }
    }
};
typedef int pg8_v8i __attribute__((ext_vector_type(8))); typedef int pg8_v4i __attribute__((ext_vector_type(4)));
__device__ __forceinline__ pg8_v8i pg8_cat8(bf16x8 a, bf16x8 b) { return __builtin_shufflevector(__builtin_bit_cast(pg8_v4i, a), __builtin_bit_cast(pg8_v4i, b), 0, 1, 2, 3, 4, 5, 6, 7); }
template <class Epi, class Sched, bool ALIGN_EPI = false, bool SP2 = false, bool F8 = false, int WSCALE = 127>
__device__ __forceinline__ void gemm_phase(PG8_LAS unsigned char* lds, const Gemm g, const Sched& S, const Epi& E, int wave_idx) {
    int tid_ = wave_idx * 64 + mk_lane(); asm volatile("" : "+v"(tid_));
    const int tid = tid_, wid = __builtin_amdgcn_readfirstlane(tid >> 6), lane = tid & 63, wr = wid >> 2, wc = wid & 3, fr = lane & 15, fq = lane >> 4;
    const int K = g.K, nt = K / BK;
    unsigned voffA[2], voffB[2];
#pragma unroll
    for (int i = 0; i < 2; ++i) { int R, C; stage_rc(tid * 16 + i * 8192, R, C); const int Rb = Epi::PERM ? ((R & ~31) + perm32(R & 31)) : R;
        voffA[i] = (unsigned)(R * K + C) * 2u; voffB[i] = (unsigned)(Rb * K + C) * 2u; }
    const size_t kstep = (size_t)(BK * 2);
    const size_t hstep = (size_t)HALF * K * 2;
    const size_t tstep = 2 * hstep;
    const unsigned ldsw = (unsigned)wid * 1024u;
    int aoffk[2], boffk[2];
    if constexpr (F8) { aoffk[0] = lds_byte(wr * 64 + fr, (2 * (fq & 1)) * 8) + (fq >> 1) * 1024; aoffk[1] = lds_byte(wr * 64 + fr, (2 * (fq & 1) + 1) * 8) + (fq >> 1) * 1024;
        boffk[0] = lds_byte(wc * 32 + fr, (2 * (fq & 1)) * 8) + (fq >> 1) * 1024; boffk[1] = lds_byte(wc * 32 + fr, (2 * (fq & 1) + 1) * 8) + (fq >> 1) * 1024; }
    else { aoffk[0] = lds_byte(wr * 64 + fr, fq * 8); aoffk[1] = aoffk[0] + 1024; boffk[0] = lds_byte(wc * 32 + fr, fq * 8); boffk[1] = boffk[0] + 1024; }
#define PG8_SA(b, h) (((b) * 2 + (h)) * HTB)
#define PG8_SB(b, h) ((4 + (b) * 2 + (h)) * HTB)
#define PG8_STAGE(bufoff, gbase, voff) do { const char* gb_ = (const char*)(gbase); _Pragma("unroll") for (int _i = 0; _i < 2; ++_i) { unsigned keep_; \
        asm volatile("s_mov_b32 %0, m0\n\ts_mov_b32 m0, %2\n\ts_nop 0\n\tglobal_load_lds_dwordx4 %1, %3\n\ts_mov_b32 m0, %0" : "=&s"(keep_) : "v"((voff)[_i]), "s"((unsigned)(size_t)(lds + (bufoff) + ldsw + _i * 8192)), "s"(gb_) : "memory"); } } while (0)
#define PG8_LDA(dst, b, h) do { if constexpr (F8) { _Pragma("unroll") for (int m = 0; m < 4; ++m) dst##8[m] = *(const PG8_LAS pg8_v8i*)(lds + PG8_SA(b, h) + aoffk[0] + m * 2048); } else { _Pragma("unroll") for (int m = 0; m < 4; ++m) _Pragma("unroll") for (int k = 0; k < 2; ++k) dst[m][k] = *(const PG8_LAS bf16x8*)(lds + PG8_SA(b, h) + aoffk[k] + m * 2048); } } while (0)
#define PG8_LDB(dst, b, h) do { if constexpr (F8) { _Pragma("unroll") for (int n = 0; n < 2; ++n) dst##8[n] = *(const PG8_LAS pg8_v8i*)(lds + PG8_SB(b, h) + boffk[0] + n * 2048); } else { _Pragma("unroll") for (int n = 0; n < 2; ++n) _Pragma("unroll") for (int k = 0; k < 2; ++k) dst[n][k] = *(const PG8_LAS bf16x8*)(lds + PG8_SB(b, h) + boffk[k] + n * 2048); } } while (0)
#define PG8_MMA(ai, bj, At, Bt) do { __builtin_amdgcn_s_setprio(1); _Pragma("unroll") for (int m = 0; m < 4; ++m) _Pragma("unroll") for (int n = 0; n < 2; ++n) { \
        if constexpr (F8) acc[ai][bj][m][n] = __builtin_amdgcn_mfma_scale_f32_16x16x128_f8f6f4(Bt##8[n], At##8[m], acc[ai][bj][m][n], 0, 0, 0, wsc_, 0, wsc_);     \
        else { _Pragma("unroll") for (int k = 0; k < 2; ++k) acc[ai][bj][m][n] = __builtin_amdgcn_mfma_f32_16x16x32_bf16(Bt[n][k], At[m][k], acc[ai][bj][m][n], 0, 0, 0); } } __builtin_amdgcn_s_setprio(0); } while (0)
#define PG8_WAIT_V(n) asm volatile("s_waitcnt vmcnt(" #n ")" ::: "memory")
#define PG8_WAIT_L(n) asm volatile("s_waitcnt lgkmcnt(" #n ")" ::: "memory")
#define PG8_BAR __builtin_amdgcn_s_barrier()
#define PG8_SCHED __builtin_amdgcn_sched_barrier(0)
    int wsc_ = WSCALE; asm volatile("" : "+v"(wsc_));
    Unit cur, nxt; int ui = 0;
    if (!S.next(0, cur)) return;
    f32x4 acc[2][2][4][2];
#pragma unroll
    for (int a = 0; a < 2; ++a)
#pragma unroll
        for (int b = 0; b < 2; ++b)
#pragma unroll
            for (int m = 0; m < 4; ++m)
#pragma unroll
                for (int n = 0; n < 2; ++n) acc[a][b][m][n] = (f32x4){0.f, 0.f, 0.f, 0.f};
    bf16x8 At[4][2], B0[2][2], B1[2][2];
    pg8_v8i At8[4], B08[2], B18[2];
    const char* cA = (const char*)(cur.g ? g.A2 : g.A) + (size_t)cur.pm * tstep; const char* cB = (const char*)(cur.g ? g.Bt2 : g.Bt) + (size_t)cur.pn * tstep;
    S.a_ready(cur);
    if constexpr (SP2) {
        PG8_STAGE(PG8_SB(0, 0), cB, voffB); PG8_STAGE(PG8_SB(0, 1), cB + hstep, voffB); PG8_STAGE(PG8_SA(0, 0), cA, voffA); PG8_STAGE(PG8_SA(0, 1), cA + hstep, voffA);
        if (wr == 1) PG8_BAR;
        PG8_WAIT_V(2); PG8_BAR;
        PG8_STAGE(PG8_SB(1, 0), cB + kstep, voffB); PG8_STAGE(PG8_SA(1, 0), cA + kstep, voffA); PG8_STAGE(PG8_SB(1, 1), cB + hstep + kstep, voffB);
        PG8_WAIT_V(6); PG8_BAR;
    } else {
        PG8_STAGE(PG8_SB(0, 0), cB, voffB); PG8_STAGE(PG8_SA(0, 0), cA, voffA); PG8_STAGE(PG8_SB(0, 1), cB + hstep, voffB); PG8_STAGE(PG8_SA(0, 1), cA + hstep, voffA);
        if (wr == 1) PG8_BAR;
        PG8_WAIT_V(4); PG8_BAR;
        PG8_STAGE(PG8_SB(1, 0), cB + kstep, voffB); PG8_STAGE(PG8_SA(1, 0), cA + kstep, voffA); PG8_STAGE(PG8_SB(1, 1), cB + hstep + kstep, voffB);
        PG8_WAIT_V(6); PG8_BAR;
    }
    for (;;) {
        const bool has_next = S.next(ui + 1, nxt);
        const char* nA = has_next ? (const char*)(nxt.g ? g.A2 : g.A) + (size_t)nxt.pm * tstep : cA; const char* nB = has_next ? (const char*)(nxt.g ? g.Bt2 : g.Bt) + (size_t)nxt.pn * tstep : cB;
#pragma unroll 1
        for (int t = 0; t < nt; t += 2) {
            const bool last = (t == nt - 2);
            const char* a1 = cA + (size_t)(t + 1) * kstep;
            const char* a2 = last ? nA : cA + (size_t)(t + 2) * kstep; const char* b2 = last ? nB : cB + (size_t)(t + 2) * kstep;
            const char* a3 = a2 + kstep; const char* b3 = b2 + kstep;
            if (last && has_next) S.a_ready(nxt);
            if constexpr (SP2) {
            PG8_LDB(B0, 0, 0); PG8_LDB(B1, 0, 1); PG8_SCHED; PG8_LDA(At, 0, 0); PG8_STAGE(PG8_SA(1, 1), a1 + hstep, voffA);
            PG8_WAIT_V(8); PG8_WAIT_L(0); PG8_BAR; PG8_MMA(0, 0, At, B0); PG8_MMA(0, 1, At, B1); PG8_BAR; PG8_SCHED;
            PG8_LDA(At, 0, 1); PG8_STAGE(PG8_SB(0, 0), b2, voffB); PG8_STAGE(PG8_SB(0, 1), b2 + hstep, voffB); PG8_STAGE(PG8_SA(0, 0), a2, voffA);
            PG8_WAIT_V(8); PG8_WAIT_L(0); PG8_BAR; PG8_MMA(1, 0, At, B0); PG8_MMA(1, 1, At, B1); PG8_BAR; PG8_SCHED;
            PG8_LDB(B0, 1, 0); PG8_LDB(B1, 1, 1); PG8_SCHED; PG8_LDA(At, 1, 0); PG8_STAGE(PG8_SA(0, 1), a2 + hstep, voffA);
            PG8_WAIT_V(8); PG8_WAIT_L(0); PG8_BAR; PG8_MMA(0, 0, At, B0); PG8_MMA(0, 1, At, B1); PG8_BAR; PG8_SCHED;
            PG8_LDA(At, 1, 1); PG8_STAGE(PG8_SB(1, 0), b3, voffB); PG8_STAGE(PG8_SB(1, 1), b3 + hstep, voffB); PG8_STAGE(PG8_SA(1, 0), a3, voffA);
            PG8_WAIT_V(8); PG8_WAIT_L(0); PG8_BAR; PG8_MMA(1, 0, At, B0); PG8_MMA(1, 1, At, B1); PG8_BAR; PG8_SCHED;
            } else {
            PG8_LDB(B0, 0, 0); PG8_SCHED; PG8_LDA(At, 0, 0); PG8_STAGE(PG8_SA(1, 1), a1 + hstep, voffA);
            PG8_WAIT_L(8); PG8_BAR; PG8_WAIT_L(0); PG8_MMA(0, 0, At, B0); PG8_BAR; PG8_SCHED;
            PG8_LDB(B1, 0, 1); PG8_STAGE(PG8_SB(0, 0), b2, voffB);
            PG8_BAR; PG8_WAIT_L(0); PG8_MMA(0, 1, At, B1); PG8_BAR;
            PG8_LDA(At, 0, 1); PG8_STAGE(PG8_SA(0, 0), a2, voffA);
            PG8_BAR; PG8_WAIT_L(0); PG8_MMA(1, 0, At, B0); PG8_BAR; PG8_SCHED;
            PG8_STAGE(PG8_SB(0, 1), b2 + hstep, voffB);
            PG8_WAIT_V(6); PG8_BAR; PG8_MMA(1, 1, At, B1); PG8_BAR;
            PG8_LDB(B0, 1, 0); PG8_SCHED; PG8_LDA(At, 1, 0); PG8_STAGE(PG8_SA(0, 1), a2 + hstep, voffA);
            PG8_WAIT_L(8); PG8_BAR; PG8_WAIT_L(0); PG8_MMA(0, 0, At, B0); PG8_BAR; PG8_SCHED;
            PG8_LDB(B1, 1, 1); PG8_STAGE(PG8_SB(1, 0), b3, voffB);
            PG8_BAR; PG8_WAIT_L(0); PG8_MMA(0, 1, At, B1); PG8_BAR;
            PG8_LDA(At, 1, 1); PG8_STAGE(PG8_SA(1, 0), a3, voffA);
            PG8_BAR; PG8_WAIT_L(0); PG8_MMA(1, 0, At, B0); PG8_BAR; PG8_SCHED;
            PG8_STAGE(PG8_SB(1, 1), b3 + hstep, voffB);
            PG8_WAIT_V(6); PG8_BAR; PG8_MMA(1, 1, At, B1); PG8_BAR;
            }
        }
        if constexpr (ALIGN_EPI) { if (wr == 0) PG8_BAR; }
        if constexpr (!Epi::AFTER_DRAIN) { { int pm_ = cur.pm, pn_ = cur.pn; asm volatile("" : "+s"(pm_), "+s"(pn_)); cur.pm = pm_; cur.pn = pn_; }
            { int t2_ = mk_lane(); asm volatile("" : "+v"(t2_)); E(acc, cur, wr, wc, t2_ & 15, (t2_ & 63) >> 4); }
            S.done(cur); }
        if (!has_next) break;
#pragma unroll
        for (int a = 0; a < 2; ++a)
#pragma unroll
            for (int b = 0; b < 2; ++b)
#pragma unroll
                for (int m = 0; m < 4; ++m)
#pragma unroll
                    for (int n = 0; n < 2; ++n) acc[a][b][m][n] = (f32x4){0.f, 0.f, 0.f, 0.f};
        cur = nxt; cA = nA; cB = nB; ++ui;
        if constexpr (ALIGN_EPI) { if (wr == 1) PG8_BAR; }
    }
    PG8_WAIT_V(0);
    if constexpr (!ALIGN_EPI) { if (wr == 0) PG8_BAR; }
    PG8_BAR;
    if constexpr (Epi::AFTER_DRAIN) { E.fused(acc, cur, wr, wc, fr, fq, lds, wid, lane); S.done(cur); }
#undef PG8_SA
#undef PG8_SB
#undef PG8_STAGE
#undef PG8_LDA
#undef PG8_LDB
#undef PG8_MMA
#undef PG8_WAIT_V
#undef PG8_WAIT_L
#undef PG8_BAR
#undef PG8_SCHED
}
}

typedef unsigned short bf16;
typedef unsigned v4u __attribute__((ext_vector_type(4)));
typedef unsigned v2u __attribute__((ext_vector_type(2)));
typedef float f32x4 __attribute__((ext_vector_type(4)));
typedef float f32x2 __attribute__((ext_vector_type(2)));
typedef float f32x16 __attribute__((ext_vector_type(16)));
typedef short bf16x8 __attribute__((ext_vector_type(8)));
typedef short s16x4 __attribute__((ext_vector_type(4)));
typedef GAS unsigned gu32;

constexpr int D = 1024, NB = 16, SEQ = 4096, LCX = 256, DEPTH = 4;
constexpr int NL = NB * SEQ, NC = NB * LCX, NT = NL + NC;
constexpr int N_IN = 2592, PCOLS = 2048, D_OFF = 1824, HYC = 768;
constexpr int FFD = 2816, FFE = 3584, NE = 8;
constexpr float ALPHA = 1.6817928305074292f;
constexpr int NWAVES = 8, NTHR = 512;
constexpr int KSEQ = SEQ + LCX;

enum { I_X = 0, I_C, I_CTX, I_CCTX, I_ADAW, I_ADAB, I_WIN, I_QNORM, I_KVNORM, I_WUQ, I_WUKV, I_MLAON, I_LCW, I_LCB, I_LWR, I_LBR, I_LWI, I_LBI, I_LLAM, I_LON,
       I_MUP, I_MUN, I_W0, I_WUP, I_A0, I_AUP, I_GUP, I_KK, I_KA, I_RK, I_LNG, I_LNB, I_HCW, I_HCB, I_HW1, I_HB1, I_HW2, I_HB2, I_HW3, I_HD, I_HON,
       I_WOUT, I_LN1G, I_LN1B, I_LN2G, I_LN2B, I_FG, I_FU, I_FD, I_ROUTER, I_MG, I_MU, I_MD, N_INPUTS };

constexpr size_t MiB = 1u << 20;
constexpr size_t WS_CTL = 0, CTL_ZERO_BYTES = 1 * MiB;
constexpr size_t WS_MOD = 1 * MiB;
constexpr size_t WS_ROPE = 3 * MiB;
constexpr size_t WS_H2L = 4 * MiB;
constexpr size_t WS_H2C = 8 * MiB;
constexpr size_t WS_LRUW = 9 * MiB;
constexpr size_t WS_WUQT = 10 * MiB;
constexpr size_t WS_WUKVT = 11 * MiB;
constexpr size_t WS_SUMM = 12 * MiB;
constexpr size_t WS_BON = 17 * MiB;
constexpr size_t WS_TOKE = 20 * MiB;
constexpr size_t WS_TOKG = 21 * MiB;
constexpr size_t WS_TOKS = 22 * MiB;
constexpr size_t WS_BLKCNT = 23 * MiB;
constexpr size_t WS_SPEC = 24 * MiB;
constexpr size_t WS_WINT = 56 * MiB;
constexpr size_t WS_WHYT = 72 * MiB;
constexpr size_t WS_WOUTT = 78 * MiB;
constexpr size_t WS_WGUT = 86 * MiB;
constexpr size_t WS_WDT = 108 * MiB;
constexpr size_t WS_XC = 120 * MiB;
constexpr size_t WS_A1 = 136 * MiB;
constexpr size_t WS_ARENA = 272 * MiB;
constexpr size_t WS_P = WS_ARENA;
constexpr size_t WS_HT = 544 * MiB;
constexpr size_t WS_QB = 646 * MiB;
constexpr size_t WS_KB = 697 * MiB;
constexpr size_t WS_VT = 748 * MiB;
constexpr size_t WS_AO = 782 * MiB;
constexpr size_t WS_HOT = 816 * MiB;
constexpr size_t WS_YR = 850 * MiB;
constexpr size_t WS_Y = 986 * MiB;
constexpr size_t WS_H = WS_ARENA;
constexpr size_t WS_MGU = WS_ARENA;
constexpr size_t WS_MD = 384 * MiB;
constexpr size_t WS_XS = 440 * MiB;
constexpr size_t WS_HM = 716 * MiB;
constexpr size_t WS_END = 1122 * MiB;
constexpr size_t WS_M8GU = WS_ARENA;
constexpr size_t WS_M8D = 328 * MiB;
constexpr size_t WS_XS8 = 356 * MiB;
constexpr size_t WS_Y2 = 494 * MiB;
constexpr size_t WS_HM8 = 770 * MiB;
constexpr int MOE_MAX_TILES = 552, MOE_NCHUNK = 2, MOE_CHUNK_TILES = 276;
static_assert(WS_HM8 + (size_t)MOE_CHUNK_TILES * 256 * FFE <= WS_END && WS_M8GU + (size_t)8 * 2 * FFE * D <= WS_M8D && WS_M8D + (size_t)8 * D * FFE <= WS_XS8 && WS_XS8 + (size_t)141312 * D <= WS_Y2 && WS_Y2 + (size_t)141312 * D * 2 <= WS_HM8, "moe fp8 map");
static_assert(WS_H + (size_t)NT * FFD * 2 <= WS_QB + 51 * MiB, "dense hidden");

constexpr int CW_BAR = 4096;

constexpr int RING_BYTES = 131072;
constexpr int LDSCTL_OFF = RING_BYTES;
constexpr int LDS_TILEE = LDSCTL_OFF + 256;
constexpr int LDS_MOEI = LDSCTL_OFF + 1024;
constexpr int LDS_BYTES = 147456;

#define LDS_WAIT() asm volatile("s_waitcnt lgkmcnt(0)" ::: "memory")
#define VM_WAIT() asm volatile("s_waitcnt vmcnt(0)" ::: "memory")
typedef __bf16 hwbf16x2 __attribute__((ext_vector_type(2)));
__device__ __forceinline__ unsigned pk2(float lo, float hi) { const f32x2 v = {lo, hi}; const hwbf16x2 b = __builtin_convertvector(v, hwbf16x2); return __builtin_bit_cast(unsigned, b); }
__device__ __forceinline__ unsigned f2bf(float f) { return pk2(f, 0.f) & 0xffffu; }
__device__ __forceinline__ unsigned pk4_fp8(float a, float b, float c, float d) { int w = __builtin_amdgcn_cvt_pk_fp8_f32(a, b, 0, false); w = __builtin_amdgcn_cvt_pk_fp8_f32(c, d, w, true); return (unsigned)w; }
__device__ __forceinline__ float bf2f(unsigned b) { return __builtin_bit_cast(float, b << 16); }
__device__ __forceinline__ float bflo(unsigned w) { return __builtin_bit_cast(float, w << 16); }
__device__ __forceinline__ float bfhi(unsigned w) { return __builtin_bit_cast(float, w & 0xffff0000u); }
__device__ __forceinline__ float wave_sum(float v) {
#pragma unroll
    for (int o = 1; o < 64; o <<= 1) v += __shfl_xor(v, o);
    return v;
}
__device__ __forceinline__ float sigmoidf_(float x) { return 1.f / (1.f + __expf(-x)); }
#define XB_TMO      128
#define XB_XCNT(j)  (256  + 64 * (j))
#define XB_XSUB(j)  (1280 + 64 * (j))
#define XB_XGEN(j)  (2304 + 64 * (j))
#define XB_TOP      3328
#define XB_TOPGEN   3392
#define XCD_BAR_WORDS 3456
#define XB_SPIN_CAP (1u << 18)

__device__ __forceinline__ unsigned xb_ld(unsigned* p)              { return __hip_atomic_load(p, __ATOMIC_RELAXED, __HIP_MEMORY_SCOPE_AGENT); }
__device__ __forceinline__ unsigned xb_add(unsigned* p, unsigned v) { return __hip_atomic_fetch_add(p, v, __ATOMIC_RELAXED, __HIP_MEMORY_SCOPE_AGENT); }
__device__ __forceinline__ unsigned xb_xcc_id() { return (unsigned)__builtin_amdgcn_s_getreg((3 << 11) | 20) & 0xFu; }
#define XB_SPIN(cond, bar) do { unsigned _sp = 0; while (cond) { __builtin_amdgcn_s_sleep(1); \
    if ((++_sp & 255u) == 0u) { if (xb_ld(&(bar)[XB_TMO])) break; if (_sp > XB_SPIN_CAP) { atomicAdd(&(bar)[XB_TMO], 1u); break; } } } } while (0)

struct XcdBarrier {
    int leader; unsigned* bar; unsigned x;
    volatile LAS unsigned* st;
};

__device__ __forceinline__ XcdBarrier xcd_barrier_post(unsigned* bar, volatile LAS unsigned* st, int leader) {
    XcdBarrier b; b.leader = leader; b.bar = bar; b.x = xb_xcc_id(); b.st = st;
    if (leader) (void)xb_add(&bar[XB_XCNT(b.x)], 1u);
    return b;
}
__device__ __forceinline__ void xcd_barrier_complete(unsigned* bar, unsigned x, unsigned& nloc, unsigned& nx) {
    const unsigned G = gridDim.x * gridDim.y * gridDim.z;
    unsigned sum, cnt, mine, sp = 0u;
    for (;;) {
        sum = 0u; cnt = 0u; mine = 0u;
#pragma unroll
        for (unsigned j = 0; j < 16; ++j) { const unsigned c = xb_ld(&bar[XB_XCNT(j)]); sum += c; cnt += (c > 0u) ? 1u : 0u; mine = (j == x) ? c : mine; }
        if (sum == G) break;
        __builtin_amdgcn_s_sleep(1);
        if ((++sp & 255u) == 0u) { if (xb_ld(&bar[XB_TMO])) break; if (sp > XB_SPIN_CAP) { atomicAdd(&bar[XB_TMO], 1u); break; } }
    }
    nloc = mine > 0u ? mine : 1u; nx = cnt > 0u ? cnt : 1u;
}

__device__ __forceinline__ void xcd_barrier(const XcdBarrier& b) {
    asm volatile("s_waitcnt vmcnt(0)" ::: "memory");
    __syncthreads();
    if (b.leader) {
        unsigned* bar = b.bar;
        __builtin_amdgcn_s_waitcnt(0);
        unsigned nloc = b.st[0], nx = b.st[1];
        if (nloc == 0u) { xcd_barrier_complete(bar, b.x, nloc, nx); b.st[0] = nloc; b.st[1] = nx; }
        const unsigned old = xb_add(&bar[XB_XSUB(b.x)], 1u);
        const unsigned gen = old / nloc;
        if (old + 1u == (gen + 1u) * nloc) {
            __builtin_amdgcn_fence(__ATOMIC_RELEASE, "agent");
            asm volatile("s_waitcnt vmcnt(0)" ::: "memory");
            const unsigned og = xb_add(&bar[XB_TOP], 1u);
            const unsigned tg = og / nx;
            if (og + 1u == (tg + 1u) * nx) xb_add(&bar[XB_TOPGEN], 1u);
            else XB_SPIN(xb_ld(&bar[XB_TOPGEN]) == tg, bar);
            __builtin_amdgcn_fence(__ATOMIC_ACQUIRE, "agent");
            xb_add(&bar[XB_XGEN(b.x)], 1u);
            asm volatile("s_waitcnt vmcnt(0)" ::: "memory");
        } else {
            XB_SPIN(xb_ld(&bar[XB_XGEN(b.x)]) == gen, bar);
            __builtin_amdgcn_fence(__ATOMIC_ACQUIRE, "agent");
            asm volatile("s_waitcnt vmcnt(0)" ::: "memory");
        }
    }
    __syncthreads();
}

struct Args { const float* in[N_INPUTS]; float* out; unsigned char* ws; };
struct Frame { LAS unsigned char* lds; int tid, lane, wave, G; };
__device__ __forceinline__ void frame_refresh(Frame& F) { int t = F.wave * 64 + mk_lane(); asm volatile("" : "+v"(t)); F.tid = t; F.lane = t & 63; }
#define CAS __attribute__((address_space(4)))
__device__ __forceinline__ const CAS char* karg() { const CAS char* kp = (const CAS char*)__builtin_amdgcn_kernarg_segment_ptr(); asm volatile("" : "+s"(kp)); return kp; }
__device__ __forceinline__ const float* in_ptr(int i) { return *(const float* const CAS*)(karg() + 8 * i); }
__device__ __forceinline__ float* out_ptr() { return *(float* const CAS*)(karg() + 8 * N_INPUTS); }
__device__ __forceinline__ unsigned char* ws_ptr() { return *(unsigned char* const CAS*)(karg() + 8 * N_INPUTS + 8); }
#define WSP(T, off) ((T*)(ws + (off)))
#define WS_DECL unsigned char* const ws = ws_ptr()

namespace pg8 {
struct EpiStore {
    static constexpr bool PERM = true, AFTER_DRAIN = false;
    bf16_t* O; int ldc; int pm_add; int nN;
    __device__ __forceinline__ void operator()(const f32x4 (&acc)[2][2][4][2], const Unit& u, int wr, int wc, int fr, int fq) const {
        const int row0 = (u.pm + pm_add) * BM + wr * 64 + fr; const int col0 = (u.pn % nN) * BM + wc * 32 + 8 * fq;
#pragma unroll
        for (int ai = 0; ai < 2; ++ai)
#pragma unroll
            for (int m = 0; m < 4; ++m) { bf16_t* rowp = O + (size_t)(row0 + ai * HALF + m * 16) * ldc + col0;
#pragma unroll
                for (int bj = 0; bj < 2; ++bj) { const f32x4 v0 = acc[ai][bj][m][0], v1 = acc[ai][bj][m][1];
                    u32x4 w; w.x = cvt_pk_bf16(v0[0], v0[1]); w.y = cvt_pk_bf16(v0[2], v0[3]); w.z = cvt_pk_bf16(v1[0], v1[1]); w.w = cvt_pk_bf16(v1[2], v1[3]);
                    *(u32x4*)(rowp + bj * HALF) = w; } }
    }
};
__device__ __forceinline__ float silu_mul(float g, float u) { return g * __builtin_amdgcn_rcpf(1.f + __expf(-g)) * u; }
struct EpiSwiGLU {
    static constexpr bool PERM = true, AFTER_DRAIN = false;
    bf16_t* H; int ldh; int pm_sub; int nN;
    __device__ __forceinline__ void operator()(const f32x4 (&acc)[2][2][4][2], const Unit& u, int wr, int wc, int fr, int fq) const {
        const int row0 = (u.pm - pm_sub) * BM + wr * 64 + fr; const int col0 = (u.pn % nN) * HALF + wc * 32 + 8 * fq;
#pragma unroll
        for (int ai = 0; ai < 2; ++ai)
#pragma unroll
            for (int m = 0; m < 4; ++m) { bf16_t* rowp = H + (size_t)(row0 + ai * HALF + m * 16) * ldh + col0;
                const f32x4 g0 = acc[ai][0][m][0], g1 = acc[ai][0][m][1], u0 = acc[ai][1][m][0], u1 = acc[ai][1][m][1];
                u32x4 w; w.x = cvt_pk_bf16(silu_mul(g0[0], u0[0]), silu_mul(g0[1], u0[1])); w.y = cvt_pk_bf16(silu_mul(g0[2], u0[2]), silu_mul(g0[3], u0[3]));
                w.z = cvt_pk_bf16(silu_mul(g1[0], u1[0]), silu_mul(g1[1], u1[1])); w.w = cvt_pk_bf16(silu_mul(g1[2], u1[2]), silu_mul(g1[3], u1[3]));
                *(u32x4*)rowp = w; }
    }
};
struct EpiSwiGLU8 {
    static constexpr bool PERM = true, AFTER_DRAIN = false;
    unsigned char* H; int ldh; int pm_sub; int nN;
    __device__ __forceinline__ void operator()(const f32x4 (&acc)[2][2][4][2], const Unit& u, int wr, int wc, int fr, int fq) const {
        const int row0 = (u.pm - pm_sub) * BM + wr * 64 + fr; const int col0 = (u.pn % nN) * HALF + wc * 32 + 8 * fq;
#pragma unroll
        for (int ai = 0; ai < 2; ++ai)
#pragma unroll
            for (int m = 0; m < 4; ++m) { unsigned char* rowp = H + (size_t)(row0 + ai * HALF + m * 16) * ldh + col0;
                const f32x4 g0 = acc[ai][0][m][0], g1 = acc[ai][0][m][1], u0 = acc[ai][1][m][0], u1 = acc[ai][1][m][1];
                ::v2u w; w.x = ::pk4_fp8(silu_mul(g0[0], u0[0]), silu_mul(g0[1], u0[1]), silu_mul(g0[2], u0[2]), silu_mul(g0[3], u0[3]));
                w.y = ::pk4_fp8(silu_mul(g1[0], u1[0]), silu_mul(g1[1], u1[1]), silu_mul(g1[2], u1[2]), silu_mul(g1[3], u1[3]));
                *(::v2u*)rowp = w; }
    }
};
struct MoeOrder {
    int nM, nN, nwg, G, c, t0, pm_off; const PG8_LAS unsigned char* tile_e;
    __device__ void init(int nM_, int nN_, int G_, int c_, int t0_, int pm_off_, const PG8_LAS unsigned char* te) { nM = nM_; nN = nN_; nwg = nM * nN; G = G_; c = c_; t0 = t0_; pm_off = pm_off_; tile_e = te; }
    __device__ bool next(int i, Unit& u) const {
        const long L = (long)i * G + c; if (L >= nwg) return false;
        int wgid = (int)L; { const int q = nwg / NXCD, r = nwg % NXCD, xcd = wgid % NXCD, off = wgid / NXCD; wgid = (xcd < r ? xcd * (q + 1) : r * (q + 1) + (xcd - r) * q) + off; }
        const int nig = WGM * nN, gid = wgid / nig, fm = gid * WGM, gsz = (nM - fm) < WGM ? (nM - fm) : WGM;
        const int pml = fm + ((wgid % nig) % gsz), pnl = (wgid % nig) / gsz;
        const int e = tile_e[t0 + pml];
        u.pm = pm_off + pml; u.pn = e * nN + pnl; u.g = 0; return true;
    }
    __device__ __forceinline__ void a_ready(const Unit&) const {}
    __device__ __forceinline__ void done(const Unit&) const {}
};
struct DualOrder {
    StaticOrder s0, s1; int G, c;
    __device__ void init(int M0, int N0, int M1, int N1, int G_, int c_) { s0.init(M0, N0, 1, 0); s1.init(M1, N1, 1, 0); G = G_; c = c_; }
    __device__ bool next(int i, Unit& u) const { const long L = (long)i * G + c;
        if (L < s0.nwg) { const bool ok = s0.next((int)L, u); u.g = 0; return ok; }
        const long L1 = L - s0.nwg; if (L1 >= s1.nwg) return false; const bool ok = s1.next((int)L1, u); u.g = 1; return ok; }
    __device__ __forceinline__ void a_ready(const Unit&) const {}
    __device__ __forceinline__ void done(const Unit&) const {}
};
struct EpiStore2 {
    static constexpr bool PERM = true, AFTER_DRAIN = false;
    bf16_t* O0; int ldc0; bf16_t* O1; int ldc1;
    __device__ __forceinline__ void operator()(const f32x4 (&acc)[2][2][4][2], const Unit& u, int wr, int wc, int fr, int fq) const {
        bf16_t* O = u.g ? O1 : O0; const int ldc = u.g ? ldc1 : ldc0;
        const int row0 = u.pm * BM + wr * 64 + fr; const int col0 = u.pn * BM + wc * 32 + 8 * fq;
#pragma unroll
        for (int ai = 0; ai < 2; ++ai)
#pragma unroll
            for (int m = 0; m < 4; ++m) { bf16_t* rowp = O + (size_t)(row0 + ai * HALF + m * 16) * ldc + col0;
#pragma unroll
                for (int bj = 0; bj < 2; ++bj) { const f32x4 v0 = acc[ai][bj][m][0], v1 = acc[ai][bj][m][1];
                    u32x4 w; w.x = cvt_pk_bf16(v0[0], v0[1]); w.y = cvt_pk_bf16(v0[2], v0[3]); w.z = cvt_pk_bf16(v1[0], v1[1]); w.w = cvt_pk_bf16(v1[2], v1[3]);
                    *(u32x4*)(rowp + bj * HALF) = w; } }
    }
};
}

__device__ __forceinline__ void tr_item(const float* W, int ldw, int k0, int c0, bf16* WT, int K, int drow, LAS float* scr, int lane) {
#pragma unroll 8
    for (int i = 0; i < 32; ++i) { const int kk = 2 * i + (lane >> 5); scr[kk * 33 + (lane & 31)] = W[(size_t)(k0 + kk) * ldw + c0 + (lane & 31)]; }
    LDS_WAIT(); asm volatile("" ::: "memory");
    const int c = lane & 7;
#pragma unroll
    for (int j = 0; j < 4; ++j) { const int n = (lane >> 3) + 8 * j; const LAS float* s = scr + (8 * c) * 33 + n;
        v4u o; o.x = pk2(s[0 * 33], s[1 * 33]); o.y = pk2(s[2 * 33], s[3 * 33]); o.z = pk2(s[4 * 33], s[5 * 33]); o.w = pk2(s[6 * 33], s[7 * 33]);
        *(GAS v4u*)(WT + (size_t)(drow + n) * K + k0 + 8 * c) = o; }
    LDS_WAIT(); asm volatile("" ::: "memory");
}
__device__ __forceinline__ void tr_item8(const float* W, int ldw, int k0, int c0, unsigned char* WT, int K, int drow, LAS float* scr, int lane, float scale) {
#pragma unroll 8
    for (int i = 0; i < 32; ++i) { const int kk = 2 * i + (lane >> 5); scr[kk * 33 + (lane & 31)] = W[(size_t)(k0 + kk) * ldw + c0 + (lane & 31)]; }
    LDS_WAIT(); asm volatile("" ::: "memory");
    const int c = lane & 7;
#pragma unroll
    for (int j = 0; j < 4; ++j) { const int n = (lane >> 3) + 8 * j; const LAS float* s = scr + (8 * c) * 33 + n;
        v2u o; o.x = pk4_fp8(s[0 * 33] * scale, s[1 * 33] * scale, s[2 * 33] * scale, s[3 * 33] * scale); o.y = pk4_fp8(s[4 * 33] * scale, s[5 * 33] * scale, s[6 * 33] * scale, s[7 * 33] * scale);
        *(GAS v2u*)(WT + (size_t)(drow + n) * K + k0 + 8 * c) = o; }
    LDS_WAIT(); asm volatile("" ::: "memory");
}
__device__ __forceinline__ void conv_matrix(Frame& F, const float* W, int K, int ldw, int cbeg, int ncols, bf16* WT, int mode, int rowoff, int& cursor, float f8scale = 0.f) {
    const int gw = blockIdx.x * NWAVES + F.wave, NGW = F.G * NWAVES;
    const int nblk = ncols / 32, nit = (K / 64) * nblk;
    LAS float* scr = (LAS float*)(F.lds + F.wave * 16384);
    int first = cursor + (((gw - cursor) % NGW) + NGW) % NGW;
    for (int it = first; it < cursor + nit; it += NGW) {
        const int idx = it - cursor, kb = idx / nblk, nb = idx % nblk, n = 32 * nb;
        const int drow = mode == 0 ? rowoff + n : ((n >> 7) * 256 + (n & 127) + rowoff);
        if (f8scale != 0.f) tr_item8(W, ldw, 64 * kb, cbeg + n, (unsigned char*)WT, K, drow, scr, F.lane, f8scale); else tr_item(W, ldw, 64 * kb, cbeg + n, WT, K, drow, scr, F.lane);
    }
    cursor += nit;
}

__device__ __forceinline__ void phase_mod(Frame& F) { WS_DECL; frame_refresh(F);
    LAS float* sv = (LAS float*)F.lds;
    LAS float* red = (LAS float*)(F.lds + 69632);
    float* MOD = WSP(float, WS_MOD);
    if ((int)blockIdx.x < 192) {
        const float* cl_ = in_ptr(I_C); const float* cc_ = in_ptr(I_CCTX); const float* adab = in_ptr(I_ADAB); const float* adaw = in_ptr(I_ADAW);
        for (int i = F.tid; i < 17 * 1024; i += NTHR) { const int b = i >> 10, k = i & 1023; const float c = b < 16 ? cl_[b * 1024 + k] : cc_[k]; sv[i] = c / (1.f + expf(-c)); }
        __syncthreads();
        for (int item = blockIdx.x; item < 192; item += F.G) {
            const int li = item / 48, cg = item % 48, cl = F.tid & 127, kq = F.tid >> 7;
            const float* W = adaw + (size_t)li * 1024 * 6144 + cg * 128 + cl;
            float acc[17];
#pragma unroll
            for (int b = 0; b < 17; ++b) acc[b] = 0.f;
            for (int k = kq * 256; k < kq * 256 + 256; ++k) { const float w = W[(size_t)k * 6144];
#pragma unroll
                for (int b = 0; b < 17; ++b) acc[b] += sv[b * 1024 + k] * w; }
#pragma unroll
            for (int b = 0; b < 17; ++b) red[(kq * 17 + b) * 128 + cl] = acc[b];
            __syncthreads();
            for (int o = F.tid; o < 17 * 128; o += NTHR) { const int b = o >> 7, c = o & 127;
                const float s = (red[(0 * 17 + b) * 128 + c] + red[(1 * 17 + b) * 128 + c]) + (red[(2 * 17 + b) * 128 + c] + red[(3 * 17 + b) * 128 + c]);
                MOD[((size_t)li * 17 + b) * 6144 + cg * 128 + c] = s + adab[li * 6144 + cg * 128 + c]; }
            __syncthreads();
        }
    }
}

__device__ __forceinline__ void phase_pro0(Frame& F) { WS_DECL; frame_refresh(F);
    phase_mod(F);
    __syncthreads();
    int cursor = 0;
    for (int li = 0; li < DEPTH; ++li) {
        conv_matrix(F, in_ptr(I_WIN) + (size_t)li * D * N_IN, D, N_IN, 0, D_OFF, WSP(bf16, WS_WINT) + (size_t)li * PCOLS * D, 0, 0, cursor);
        conv_matrix(F, in_ptr(I_WIN) + (size_t)li * D * N_IN, D, N_IN, D_OFF, HYC, WSP(bf16, WS_WHYT) + (size_t)li * HYC * D, 0, 0, cursor);
        conv_matrix(F, in_ptr(I_WOUT) + (size_t)li * D * D, D, D, 0, D, WSP(bf16, WS_WOUTT) + (size_t)li * D * D, 0, 0, cursor);
    }
    for (int j = 0; j < 2; ++j) {
        conv_matrix(F, in_ptr(I_FG) + (size_t)j * D * FFD, D, FFD, 0, FFD, (bf16*)(WSP(unsigned char, WS_WGUT) + (size_t)j * 2 * FFD * D), 1, 0, cursor, 64.f);
        conv_matrix(F, in_ptr(I_FU) + (size_t)j * D * FFD, D, FFD, 0, FFD, (bf16*)(WSP(unsigned char, WS_WGUT) + (size_t)j * 2 * FFD * D), 1, 128, cursor, 64.f);
        conv_matrix(F, in_ptr(I_FD) + (size_t)j * FFD * D, FFD, D, 0, D, WSP(bf16, WS_WDT) + (size_t)j * D * FFD, 0, 0, cursor);
    }
    { const int gt = blockIdx.x * NTHR + F.tid, NGT = F.G * NTHR; const int per = (PCOLS - D_OFF) * D / 8;
      for (int i = gt; i < DEPTH * per; i += NGT) { const int li = i / per, r = i % per; *(GAS v4u*)(WSP(bf16, WS_WINT) + (size_t)li * PCOLS * D + (size_t)D_OFF * D + (size_t)r * 8) = (v4u){0u, 0u, 0u, 0u}; } }
}

struct Stream { const float* inl; const float* inc; float* outl; float* outc; };
__device__ __forceinline__ Stream make_stream(unsigned char* ws, int li) { Stream s; s.outl = out_ptr(); s.outc = WSP(float, WS_XC); s.inl = li == 0 ? in_ptr(I_X) : (const float*)s.outl; s.inc = li == 0 ? in_ptr(I_CTX) : (const float*)s.outc; return s; }
__device__ __forceinline__ const float* stream_in(const Stream& s, int m) { return m < NL ? s.inl + (size_t)m * D : s.inc + (size_t)(m - NL) * D; }
__device__ __forceinline__ float* stream_out(const Stream& s, int m) { return m < NL ? s.outl + (size_t)m * D : s.outc + (size_t)(m - NL) * D; }
__device__ __forceinline__ int mod_b(int m) { return m < NL ? (m >> 12) : 16; }
__device__ __forceinline__ const float* mod_vec(unsigned char* ws, int li, int b, int j) { return WSP(float, WS_MOD) + ((size_t)li * 17 + b) * 6144 + j * 1024; }

__device__ __forceinline__ void store_modulated(const f32x4 (&x)[4], const float* shift, const float* scale, bf16* orow, int lane) {
#pragma unroll
    for (int j = 0; j < 4; ++j) { const int c = 4 * lane + 256 * j; const f32x4 sh = *(const GAS f32x4*)(shift + c), sc = *(const GAS f32x4*)(scale + c);
        const f32x4 h = x[j] * (sc + 1.f) + sh; v2u w; w.x = pk2(h.x, h.y); w.y = pk2(h.z, h.w); *(GAS v2u*)(orow + c) = w; }
}
__device__ __forceinline__ void rows_range(const Frame& F, int nrows, int& r0, int& r1) { const int per = (nrows + F.G - 1) / F.G; r0 = blockIdx.x * per; r1 = r0 + per < nrows ? r0 + per : nrows; if (r0 > nrows) r0 = nrows; }

__device__ __forceinline__ void phase_hin0(Frame& F) { WS_DECL; frame_refresh(F);
    int r0, r1; rows_range(F, NT, r0, r1); const Stream st = make_stream(ws, 0);
    for (int m = r0 + F.wave; m < r1; m += NWAVES) {
        const float* xr = stream_in(st, m); f32x4 x[4];
#pragma unroll
        for (int j = 0; j < 4; ++j) x[j] = *(const GAS f32x4*)(xr + 4 * F.lane + 256 * j);
        const int b = mod_b(m);
        store_modulated(x, mod_vec(ws, 0, b, 0), mod_vec(ws, 0, b, 1), WSP(bf16, WS_A1) + (size_t)m * D, F.lane);
    }
}

__device__ __forceinline__ void ln_rows(f32x4 (&v)[4], const float* g, const float* bta, int lane) {
    float s = 0.f;
#pragma unroll
    for (int j = 0; j < 4; ++j) s += (v[j].x + v[j].y) + (v[j].z + v[j].w);
    const float mean = wave_sum(s) * (1.f / D); float s2 = 0.f;
#pragma unroll
    for (int j = 0; j < 4; ++j) { v[j] = v[j] - mean; s2 += (v[j].x * v[j].x + v[j].y * v[j].y) + (v[j].z * v[j].z + v[j].w * v[j].w); }
    const float rstd = __builtin_amdgcn_rsqf(wave_sum(s2) * (1.f / D) + 1e-5f);
#pragma unroll
    for (int j = 0; j < 4; ++j) { const int c = 4 * lane + 256 * j; v[j] = v[j] * rstd * *(const GAS f32x4*)(g + c) + *(const GAS f32x4*)(bta + c); }
}

template <bool HAVE_Y>
__device__ __forceinline__ void phase_ln1(Frame& F, int li) { WS_DECL; frame_refresh(F); constexpr bool DRY_OR_BF16 = false;
    const int nrows = li == DEPTH - 1 ? NL : NT; const bool moe = li & 1; const int lane = F.lane;
    LAS int* hist = (LAS int*)(F.lds + LDS_MOEI) + 56; LAS float* ROUT = (LAS float*)F.lds;
    if (moe) { if (F.tid < 8) hist[F.tid] = 0; const float* router = in_ptr(I_ROUTER) + (size_t)(li >> 1) * D * NE; for (int i = F.tid; i < D * NE / 4; i += NTHR) *(LAS f32x4*)(ROUT + 4 * i) = *(const GAS f32x4*)(router + 4 * i); __syncthreads(); }
    int r0, r1; rows_range(F, nrows, r0, r1);
    const float* g = in_ptr(I_LN1G) + li * D; const float* bt = in_ptr(I_LN1B) + li * D; const Stream st = make_stream(ws, li); const bf16* Y = WSP(bf16, WS_Y);
    f32x4 xn[4]; v2u yn[4];
    { const int m = r0 + F.wave; if (m < r1) { const float* xr = stream_in(st, m);
#pragma unroll
        for (int j = 0; j < 4; ++j) { const int c = 4 * lane + 256 * j; xn[j] = *(const GAS f32x4*)(xr + c); if (HAVE_Y) yn[j] = *(const GAS v2u*)(Y + (size_t)m * D + c); } } }
    for (int m = r0 + F.wave; m < r1; m += NWAVES) {
        const int b = mod_b(m); f32x4 v[4]; v2u yw[4];
#pragma unroll
        for (int j = 0; j < 4; ++j) { v[j] = xn[j]; if (HAVE_Y) yw[j] = yn[j]; }
        if (m + NWAVES < r1) { const float* xr = stream_in(st, m + NWAVES);
#pragma unroll
            for (int j = 0; j < 4; ++j) { const int c = 4 * lane + 256 * j; xn[j] = *(const GAS f32x4*)(xr + c); if (HAVE_Y) yn[j] = *(const GAS v2u*)(Y + (size_t)(m + NWAVES) * D + c); } }
        const float* m2 = mod_vec(ws, li, b, 2);
#pragma unroll
        for (int j = 0; j < 4; ++j) { const int c = 4 * lane + 256 * j; v[j] = v[j] * ALPHA;
            if (HAVE_Y) { const f32x4 mm = *(const GAS f32x4*)(m2 + c); v[j].x += mm.x * bflo(yw[j].x); v[j].y += mm.y * bfhi(yw[j].x); v[j].z += mm.z * bflo(yw[j].y); v[j].w += mm.w * bfhi(yw[j].y); } }
        ln_rows(v, g, bt, lane);
        float* xo = stream_out(st, m);
#pragma unroll
        for (int j = 0; j < 4; ++j) *(GAS f32x4*)(xo + 4 * lane + 256 * j) = v[j];
        const float* sh = mod_vec(ws, li, b, 3); const float* sc = mod_vec(ws, li, b, 4);
        if (moe) {
            float lg[NE];
#pragma unroll
            for (int e = 0; e < NE; ++e) lg[e] = 0.f;
#pragma unroll
            for (int j = 0; j < 4; ++j) { const int c = 4 * lane + 256 * j; const f32x4 s4 = *(const GAS f32x4*)(sh + c), c4 = *(const GAS f32x4*)(sc + c); const f32x4 f = v[j] * (c4 + 1.f) + s4;
#pragma unroll
                for (int q = 0; q < 4; ++q) { const f32x4 ra = *(const LAS f32x4*)(ROUT + (c + q) * NE), rb = *(const LAS f32x4*)(ROUT + (c + q) * NE + 4); const float fq = f[q];
                    lg[0] += fq * ra.x; lg[1] += fq * ra.y; lg[2] += fq * ra.z; lg[3] += fq * ra.w; lg[4] += fq * rb.x; lg[5] += fq * rb.y; lg[6] += fq * rb.z; lg[7] += fq * rb.w; } }
#pragma unroll
            for (int e = 0; e < NE; ++e) lg[e] = wave_sum(lg[e]);
            int e0 = 0; float v0 = lg[0];
#pragma unroll
            for (int e = 1; e < NE; ++e) if (lg[e] > v0) { v0 = lg[e]; e0 = e; }
            int e1 = -1; float v1 = -3.0e38f;
#pragma unroll
            for (int e = 0; e < NE; ++e) if (e != e0 && lg[e] > v1) { v1 = lg[e]; e1 = e; }
            const float ex = __expf(v1 - v0), g0 = 1.f / (1.f + ex), g1 = ex * g0;
            if (lane == 0) { *(GAS v2u*)(WSP(int, WS_TOKE) + 2 * (size_t)m) = (v2u){(unsigned)e0, (unsigned)e1}; *(GAS f32x2*)(WSP(float, WS_TOKG) + 2 * (size_t)m) = (f32x2){g0, g1};
                atomicAdd((int*)(hist + e0), 1); atomicAdd((int*)(hist + e1), 1); }
        }
        if (!DRY_OR_BF16) {
            unsigned char* orow = WSP(unsigned char, WS_A1) + (size_t)m * D;
#pragma unroll
            for (int j = 0; j < 4; ++j) { const int c = 4 * lane + 256 * j; const f32x4 s4 = *(const GAS f32x4*)(sh + c), c4 = *(const GAS f32x4*)(sc + c); const f32x4 f = v[j] * (c4 + 1.f) + s4;
                *(GAS unsigned*)(orow + c) = pk4_fp8(f.x, f.y, f.z, f.w); }
        } else store_modulated(v, sh, sc, WSP(bf16, WS_A1) + (size_t)m * D, lane);
    }
    if (moe) { __syncthreads(); if (F.tid < 8) WSP(int, WS_BLKCNT)[blockIdx.x * 8 + F.tid] = hist[F.tid]; }
}

template <bool HAVE_FFN>
__device__ __forceinline__ void phase_ln2(Frame& F, int li) { WS_DECL; frame_refresh(F);
    const int nrows = li == DEPTH - 1 ? NL : NT; const bool moe = li & 1; const int lane = F.lane;
    int r0, r1; rows_range(F, nrows, r0, r1);
    const float* g = in_ptr(I_LN2G) + li * D; const float* bt = in_ptr(I_LN2B) + li * D; const Stream st = make_stream(ws, 1);
    const bf16* Y = WSP(bf16, WS_Y); const bf16* XS = WSP(bf16, WS_Y2); const int* TOKS = WSP(int, WS_TOKS); const float* TOKG = WSP(float, WS_TOKG);
    f32x4 xn[4]; v2u ya[4], yb[4]; v2u sn = (v2u){0u, 0u}; f32x2 gn = (f32x2){0.f, 0.f}, gc = (f32x2){0.f, 0.f};
    const int mf = r0 + F.wave;
    if (mf < r1) { const float* xr = stream_out(st, mf); v2u s0 = (v2u){0u, 0u};
        if (moe) { s0 = *(const GAS v2u*)(TOKS + 2 * (size_t)mf); gc = *(const GAS f32x2*)(TOKG + 2 * (size_t)mf); if (mf + NWAVES < r1) { sn = *(const GAS v2u*)(TOKS + 2 * (size_t)(mf + NWAVES)); gn = *(const GAS f32x2*)(TOKG + 2 * (size_t)(mf + NWAVES)); } }
#pragma unroll
        for (int j = 0; j < 4; ++j) { const int c = 4 * lane + 256 * j; xn[j] = *(const GAS f32x4*)(xr + c);
            if (HAVE_FFN) { if (moe) { ya[j] = *(const GAS v2u*)(XS + (size_t)s0.x * D + c); yb[j] = *(const GAS v2u*)(XS + (size_t)s0.y * D + c); } else ya[j] = *(const GAS v2u*)(Y + (size_t)mf * D + c); } } }
    for (int m = mf; m < r1; m += NWAVES) {
        const int b = mod_b(m); f32x4 v[4]; v2u wa[4], wb[4]; const f32x2 gg = gc;
#pragma unroll
        for (int j = 0; j < 4; ++j) { v[j] = xn[j]; wa[j] = ya[j]; wb[j] = yb[j]; }
        const int mn = m + NWAVES;
        if (mn < r1) { const float* xr = stream_out(st, mn); const v2u s1 = sn; gc = gn;
            if (moe && mn + NWAVES < r1) { sn = *(const GAS v2u*)(TOKS + 2 * (size_t)(mn + NWAVES)); gn = *(const GAS f32x2*)(TOKG + 2 * (size_t)(mn + NWAVES)); }
#pragma unroll
            for (int j = 0; j < 4; ++j) { const int c = 4 * lane + 256 * j; xn[j] = *(const GAS f32x4*)(xr + c);
                if (HAVE_FFN) { if (moe) { ya[j] = *(const GAS v2u*)(XS + (size_t)s1.x * D + c); yb[j] = *(const GAS v2u*)(XS + (size_t)s1.y * D + c); } else ya[j] = *(const GAS v2u*)(Y + (size_t)mn * D + c); } } }
        const float* m5 = mod_vec(ws, li, b, 5);
#pragma unroll
        for (int j = 0; j < 4; ++j) { const int c = 4 * lane + 256 * j; v[j] = v[j] * ALPHA;
            if (HAVE_FFN) { const f32x4 mm = *(const GAS f32x4*)(m5 + c); f32x4 o;
                if (moe) { o.x = gg.x * bflo(wa[j].x) + gg.y * bflo(wb[j].x); o.y = gg.x * bfhi(wa[j].x) + gg.y * bfhi(wb[j].x); o.z = gg.x * bflo(wa[j].y) + gg.y * bflo(wb[j].y); o.w = gg.x * bfhi(wa[j].y) + gg.y * bfhi(wb[j].y); }
                else { o.x = bflo(wa[j].x); o.y = bfhi(wa[j].x); o.z = bflo(wa[j].y); o.w = bfhi(wa[j].y); }
                v[j] = v[j] + mm * o; } }
        ln_rows(v, g, bt, lane);
        float* xo = stream_out(st, m);
#pragma unroll
        for (int j = 0; j < 4; ++j) *(GAS f32x4*)(xo + 4 * lane + 256 * j) = v[j];
        if (li < DEPTH - 1) store_modulated(v, mod_vec(ws, li + 1, b, 0), mod_vec(ws, li + 1, b, 1), WSP(bf16, WS_A1) + (size_t)m * D, lane);
    }
}

__device__ __forceinline__ void phase_moe_weights(Frame& F, int li) { WS_DECL; frame_refresh(F);
    const int j = li >> 1; int cursor = 0;
    for (int e = 0; e < NE; ++e) {
        conv_matrix(F, in_ptr(I_MG) + ((size_t)j * NE + e) * D * FFE, D, FFE, 0, FFE, (bf16*)(WSP(unsigned char, WS_M8GU) + (size_t)e * 2 * FFE * D), 1, 0, cursor, 64.f);
        conv_matrix(F, in_ptr(I_MU) + ((size_t)j * NE + e) * D * FFE, D, FFE, 0, FFE, (bf16*)(WSP(unsigned char, WS_M8GU) + (size_t)e * 2 * FFE * D), 1, 128, cursor, 64.f);
        conv_matrix(F, in_ptr(I_MD) + ((size_t)j * NE + e) * FFE * D, FFE, D, 0, D, (bf16*)(WSP(unsigned char, WS_M8D) + (size_t)e * D * FFE), 0, 0, cursor, 256.f);
    }
}

__device__ __forceinline__ void phase_moe_slots(Frame& F, int li) { WS_DECL; frame_refresh(F);
    const int nrows = li == DEPTH - 1 ? NL : NT;
    LAS int* mi = (LAS int*)(F.lds + LDS_MOEI); LAS unsigned char* tile_e = (LAS unsigned char*)(F.lds + LDS_TILEE);
    LAS int* slots = (LAS int*)F.lds;
    const int* blkcnt = WSP(int, WS_BLKCNT);
    if (F.tid < 8) { int tot = 0, pre = 0; for (int b = 0; b < F.G; ++b) { const int c = blkcnt[b * 8 + F.tid]; if (b < (int)blockIdx.x) pre += c; tot += c; } mi[16 + F.tid] = tot; mi[32 + F.tid] = pre; }
    __syncthreads();
    if (F.tid == 0) { int s = 0; for (int e = 0; e < NE; ++e) { mi[e] = s; s += (mi[16 + e] + 255) & ~255; } mi[8] = s; mi[48] = s >> 8; }
    __syncthreads();
    for (int t = F.tid; t < MOE_MAX_TILES + 8; t += NTHR) { int e = 0;
#pragma unroll
        for (int q = 1; q < NE; ++q) if (t * 256 >= mi[q]) e = q;
        tile_e[t] = (unsigned char)e; }
    int r0, r1; rows_range(F, nrows, r0, r1);
    const int na = 2 * (r1 - r0);
    if (F.wave == 0) {
        int run[NE];
#pragma unroll
        for (int e = 0; e < NE; ++e) run[e] = mi[e] + mi[32 + e];
        for (int base = 0; base < na; base += 64) { const int ai = base + F.lane; const bool ok = ai < na;
            const int e = ok ? WSP(int, WS_TOKE)[2 * (size_t)r0 + ai] : -1; int slot = 0;
#pragma unroll
            for (int q = 0; q < NE; ++q) { const unsigned long long mk = __ballot(e == q); if (e == q) slot = run[q] + __popcll(mk & ((1ull << F.lane) - 1ull)); run[q] += __popcll(mk); }
            if (ok) { slots[ai] = slot; WSP(int, WS_TOKS)[2 * (size_t)r0 + ai] = slot; } }
    }
    __syncthreads();
    for (int ai = F.wave; ai < na; ai += NWAVES) { const int m = r0 + (ai >> 1), slot = slots[ai];
        const GAS v4u* src = (const GAS v4u*)(WSP(unsigned char, WS_A1) + (size_t)m * D); GAS v4u* dst = (GAS v4u*)(WSP(unsigned char, WS_XS8) + (size_t)slot * D);
        dst[F.lane] = src[F.lane]; }
    { const int gw = blockIdx.x * NWAVES + F.wave, NGW = F.G * NWAVES; int cnt = 0;
      for (int e = 0; e < NE; ++e) { const int p0 = mi[e] + mi[16 + e], p1 = mi[e + 1];
          for (int s = p0; s < p1; ++s, ++cnt) if (cnt % NGW == gw) { GAS v4u* dst = (GAS v4u*)(WSP(unsigned char, WS_XS8) + (size_t)s * D); dst[F.lane] = (v4u){0u, 0u, 0u, 0u}; } } }
    __syncthreads();
}

constexpr float QSCALE = 0.14724319f;
constexpr int MP_CQ_LD = 200, MP_CKV_LD = 136;
__device__ __forceinline__ void phase_mla_prep(Frame& F, int li) { WS_DECL; frame_refresh(F);
    LAS bf16* CQN = (LAS bf16*)F.lds; LAS bf16* CKVN = (LAS bf16*)(F.lds + 64 * MP_CQ_LD * 2);
    const bf16* P = WSP(bf16, WS_P); bf16* QB = WSP(bf16, WS_QB); bf16* KB = WSP(bf16, WS_KB); bf16* VT = WSP(bf16, WS_VT);
    const float* qn = in_ptr(I_QNORM) + li * 192; const float* kvn = in_ptr(I_KVNORM) + li * 128;
    const bf16* WQ = WSP(bf16, WS_WUQT) + (size_t)li * 384 * 192; const bf16* WKV = WSP(bf16, WS_WUKVT) + (size_t)li * 512 * 128;
    const float* RC = WSP(float, WS_ROPE); const float* RS = RC + 4096 * 16;
    const int lane = F.lane, wave = F.wave;
    const int head = wave >> 1, half = wave & 1, fr = lane & 15, kg = lane >> 4;
    for (int item = blockIdx.x; item < NT / 64; item += F.G) {
        const int m0 = item * 64; const bool isctx = m0 >= NL; const int b = isctx ? (m0 - NL) >> 8 : m0 >> 12; const int t0 = isctx ? (m0 - NL) & 255 : m0 & 4095;
        const int ki0 = isctx ? t0 : 256 + t0;
        bf16x8 wq[3][6];
#pragma unroll
        for (int i = 0; i < 3; ++i)
#pragma unroll
            for (int ks = 0; ks < 6; ++ks) wq[i][ks] = *(const GAS bf16x8*)(WQ + (size_t)(96 * head + 16 * (3 * half + i) + fr) * 192 + 32 * ks + 8 * kg);
        v4u rawv[8]; unsigned short kr1[8], kr2[8];
#pragma unroll
        for (int i = 0; i < 8; ++i) { const bf16* pr = P + (size_t)(m0 + wave * 8 + i) * PCOLS; rawv[i] = (v4u){0u, 0u, 0u, 0u}; if (lane < 40) rawv[i] = *(const GAS v4u*)(pr + 8 * lane);
            kr1[i] = 0; kr2[i] = 0; if (lane < 16) { kr1[i] = pr[320 + lane]; kr2[i] = pr[336 + lane]; } }
#pragma unroll
        for (int i = 0; i < 8; ++i) { const int tl = wave * 8 + i; const v4u raw = rawv[i];
            float x[8]; x[0] = bflo(raw.x); x[1] = bfhi(raw.x); x[2] = bflo(raw.y); x[3] = bfhi(raw.y); x[4] = bflo(raw.z); x[5] = bfhi(raw.z); x[6] = bflo(raw.w); x[7] = bfhi(raw.w);
            float ss = 0.f;
#pragma unroll
            for (int j = 0; j < 8; ++j) ss += x[j] * x[j];
            const float sq = wave_sum(lane < 24 ? ss : 0.f), skv = wave_sum((lane >= 24 && lane < 40) ? ss : 0.f);
            const float rq = __builtin_amdgcn_rsqf(sq * (1.f / 192.f) + 1e-6f), rkv = __builtin_amdgcn_rsqf(skv * (1.f / 128.f) + 1e-6f);
            if (lane < 24) { const float* g = qn + 8 * lane; v4u o; o.x = pk2(x[0] * rq * g[0], x[1] * rq * g[1]); o.y = pk2(x[2] * rq * g[2], x[3] * rq * g[3]); o.z = pk2(x[4] * rq * g[4], x[5] * rq * g[5]); o.w = pk2(x[6] * rq * g[6], x[7] * rq * g[7]);
                *(LAS v4u*)(CQN + tl * MP_CQ_LD + 8 * lane) = o; }
            else if (lane < 40) { const int c = 8 * (lane - 24); const float* g = kvn + c; v4u o; o.x = pk2(x[0] * rkv * g[0], x[1] * rkv * g[1]); o.y = pk2(x[2] * rkv * g[2], x[3] * rkv * g[3]); o.z = pk2(x[4] * rkv * g[4], x[5] * rkv * g[5]); o.w = pk2(x[6] * rkv * g[6], x[7] * rkv * g[7]);
                *(LAS v4u*)(CKVN + tl * MP_CKV_LD + c) = o; }
            if (lane < 16) { float x1 = bf2f(kr1[i]), x2 = bf2f(kr2[i]);
                if (!isctx) { const float c = RC[(t0 + tl) * 16 + lane], s = RS[(t0 + tl) * 16 + lane]; const float y1 = x1 * c - x2 * s, y2 = x1 * s + x2 * c; x1 = y1; x2 = y2; }
                const bf16 o1 = (bf16)f2bf(x1), o2 = (bf16)f2bf(x2);
#pragma unroll
                for (int h = 0; h < 4; ++h) { bf16* kr = KB + ((size_t)(b * 4 + h) * KSEQ + ki0 + tl) * 96; kr[64 + lane] = o1; kr[80 + lane] = o2; } }
        }
        __syncthreads();
        const size_t qrow0 = ((size_t)(b * 4 + head) * KSEQ + ki0) * 96;
        { f32x4 acc[3][4];
#pragma unroll
          for (int i = 0; i < 3; ++i)
#pragma unroll
              for (int m = 0; m < 4; ++m) acc[i][m] = (f32x4){0.f, 0.f, 0.f, 0.f};
#pragma unroll
          for (int ks = 0; ks < 6; ++ks)
#pragma unroll
              for (int m = 0; m < 4; ++m) { const bf16x8 xf = *(const LAS bf16x8*)(CQN + (16 * m + fr) * MP_CQ_LD + 32 * ks + 8 * kg);
#pragma unroll
                  for (int i = 0; i < 3; ++i) acc[i][m] = __builtin_amdgcn_mfma_f32_16x16x32_bf16(wq[i][ks], xf, acc[i][m], 0, 0, 0); }
#pragma unroll
          for (int m = 0; m < 4; ++m) { bf16* qr = QB + qrow0 + (size_t)(16 * m + fr) * 96;
              { v2u o; o.x = pk2(acc[0][m][0] * QSCALE, acc[0][m][1] * QSCALE); o.y = pk2(acc[0][m][2] * QSCALE, acc[0][m][3] * QSCALE); *(GAS v2u*)(qr + 48 * half + 4 * kg) = o; }
              f32x4 y1 = acc[1][m], y2 = acc[2][m];
              if (half == 1 && !isctx) { const int t = t0 + 16 * m + fr; const f32x4 c = *(const GAS f32x4*)(RC + t * 16 + 4 * kg), sn = *(const GAS f32x4*)(RS + t * 16 + 4 * kg); y1 = acc[1][m] * c - acc[2][m] * sn; y2 = acc[1][m] * sn + acc[2][m] * c; }
              v2u o1, o2; o1.x = pk2(y1[0] * QSCALE, y1[1] * QSCALE); o1.y = pk2(y1[2] * QSCALE, y1[3] * QSCALE); o2.x = pk2(y2[0] * QSCALE, y2[1] * QSCALE); o2.y = pk2(y2[2] * QSCALE, y2[3] * QSCALE);
              *(GAS v2u*)(qr + 48 * half + 16 + 4 * kg) = o1; *(GAS v2u*)(qr + 48 * half + 32 + 4 * kg) = o2; } }
        bf16x8 wkv[4][4];
#pragma unroll
        for (int nt = 0; nt < 4; ++nt)
#pragma unroll
            for (int ks = 0; ks < 4; ++ks) wkv[nt][ks] = *(const GAS bf16x8*)(WKV + (size_t)(128 * head + 64 * half + 16 * nt + fr) * 128 + 32 * ks + 8 * kg);
        { f32x4 acc[4][4];
#pragma unroll
          for (int nt = 0; nt < 4; ++nt)
#pragma unroll
              for (int m = 0; m < 4; ++m) acc[nt][m] = (f32x4){0.f, 0.f, 0.f, 0.f};
#pragma unroll
          for (int ks = 0; ks < 4; ++ks)
#pragma unroll
              for (int m = 0; m < 4; ++m) { const bf16x8 xf = *(const LAS bf16x8*)(CKVN + (16 * m + fr) * MP_CKV_LD + 32 * ks + 8 * kg);
#pragma unroll
                  for (int nt = 0; nt < 4; ++nt) acc[nt][m] = half == 0 ? __builtin_amdgcn_mfma_f32_16x16x32_bf16(wkv[nt][ks], xf, acc[nt][m], 0, 0, 0) : __builtin_amdgcn_mfma_f32_16x16x32_bf16(xf, wkv[nt][ks], acc[nt][m], 0, 0, 0); }
#pragma unroll
          for (int nt = 0; nt < 4; ++nt)
#pragma unroll
              for (int m = 0; m < 4; ++m) { v2u o; o.x = pk2(acc[nt][m][0], acc[nt][m][1]); o.y = pk2(acc[nt][m][2], acc[nt][m][3]);
                  if (half == 0) *(GAS v2u*)(KB + qrow0 + (size_t)(16 * m + fr) * 96 + 16 * nt + 4 * kg) = o;
                  else *(GAS v2u*)(VT + ((size_t)(b * 4 + head) * 64 + 16 * nt + fr) * KSEQ + ki0 + 16 * m + 4 * kg) = o; } }
        __syncthreads();
    }
}

constexpr int AT_KLD = 104, AT_VLD = 72;
constexpr int AT_KB = 64 * AT_KLD * 2, AT_VB = 64 * AT_VLD * 2, AT_BUF = AT_KB + AT_VB;
__device__ __forceinline__ void phase_attn(Frame& F, int li) { WS_DECL; frame_refresh(F);
    const bf16* QB = WSP(bf16, WS_QB); const bf16* KB = WSP(bf16, WS_KB); const bf16* VT = WSP(bf16, WS_VT); bf16* AO = WSP(bf16, WS_AO);
    const int lane = F.lane, wave = F.wave, tid = F.tid, ql = lane & 31, h2 = lane >> 5;
    const int nunits = 1024 + (li < DEPTH - 1 ? 64 : 0);
    const int c = blockIdx.x, vc = (F.G == 256) ? (c & 7) * 32 + (c >> 3) : c;
    for (int u = vc; u < nunits; u += F.G) {
        int bh, q0, nk; bool isctx = u >= 1024;
        if (!isctx) { bh = u >> 4; q0 = 256 + 256 * (u & 15); nk = KSEQ; } else { bh = u - 1024; q0 = 0; nk = 256; }
        const bf16* Kb = KB + (size_t)bh * KSEQ * 96; const bf16* Vb = VT + (size_t)bh * 64 * KSEQ;
        bf16x8 qf[6];
        { const bf16* qr = QB + ((size_t)bh * KSEQ + q0 + 32 * wave + ql) * 96 + 8 * h2;
#pragma unroll
          for (int ks = 0; ks < 6; ++ks) qf[ks] = *(const GAS bf16x8*)(qr + 16 * ks); }
        f32x16 O0, O1;
#pragma unroll
        for (int r = 0; r < 16; ++r) { O0[r] = 0.f; O1[r] = 0.f; }
        float l_run = 0.f;
        const int kc0 = tid, kc1 = tid + 512; const int vr = tid >> 3, vcn = tid & 7;
        const int ko0 = (kc0 / 12) * (AT_KLD * 2) + (kc0 % 12) * 16, ko1 = (kc1 / 12) * (AT_KLD * 2) + (kc1 % 12) * 16, vo = AT_KB + vr * (AT_VLD * 2) + vcn * 16;
        v4u pk0, pk1 = (v4u){0u, 0u, 0u, 0u}, pv;
#define AT_LOAD(t) do { const GAS v4u* ks_ = (const GAS v4u*)(Kb + (size_t)(t) * 64 * 96); pk0 = ks_[kc0]; if (kc1 < 768) pk1 = ks_[kc1]; pv = *(const GAS v4u*)(Vb + (size_t)vr * KSEQ + (t) * 64 + 8 * vcn); } while (0)
#define AT_STORE(bo) do { LAS unsigned char* b_ = F.lds + (bo); *(LAS v4u*)(b_ + ko0) = pk0; if (kc1 < 768) *(LAS v4u*)(b_ + ko1) = pk1; *(LAS v4u*)(b_ + vo) = pv; } while (0)
#define AT_QK(bo, A0, A1, INIT) do { const LAS unsigned char* b_ = F.lds + (bo); _Pragma("unroll") for (int r = 0; r < 16; ++r) { A0[r] = (INIT); A1[r] = (INIT); } \
            _Pragma("unroll") for (int kh = 0; kh < 2; ++kh) { bf16x8 kf0[3], kf1[3]; \
                _Pragma("unroll") for (int k3 = 0; k3 < 3; ++k3) { const int ks = 3 * kh + k3; kf0[k3] = *(const LAS bf16x8*)(b_ + ql * (AT_KLD * 2) + 32 * ks + 16 * h2); kf1[k3] = *(const LAS bf16x8*)(b_ + (32 + ql) * (AT_KLD * 2) + 32 * ks + 16 * h2); } \
                __builtin_amdgcn_sched_barrier(0); \
                _Pragma("unroll") for (int k3 = 0; k3 < 3; ++k3) { const int ks = 3 * kh + k3; A0 = __builtin_amdgcn_mfma_f32_32x32x16_bf16(kf0[k3], qf[ks], A0, 0, 0, 0); A1 = __builtin_amdgcn_mfma_f32_32x32x16_bf16(kf1[k3], qf[ks], A1, 0, 0, 0); } \
                __builtin_amdgcn_sched_barrier(0); } } while (0)
        const int ntile = nk >> 6;
        v4u qk0, qk1 = (v4u){0u, 0u, 0u, 0u}, qv;
#define AT_LOADB(t) do { const GAS v4u* ks_ = (const GAS v4u*)(Kb + (size_t)(t) * 64 * 96); qk0 = ks_[kc0]; if (kc1 < 768) qk1 = ks_[kc1]; qv = *(const GAS v4u*)(Vb + (size_t)vr * KSEQ + (t) * 64 + 8 * vcn); } while (0)
#define AT_STOREB(bo) do { LAS unsigned char* b_ = F.lds + (bo); *(LAS v4u*)(b_ + ko0) = qk0; if (kc1 < 768) *(LAS v4u*)(b_ + ko1) = qk1; *(LAS v4u*)(b_ + vo) = qv; } while (0)
        AT_LOAD(0); AT_LOADB(1);
        __syncthreads();
        AT_STORE(0); AT_STOREB(AT_BUF);
        AT_LOAD(2); AT_LOADB(3);
        __syncthreads();
        int bo0 = 0, bo1 = AT_BUF, bo2 = 2 * AT_BUF;
        float m_ref = 0.f;
#define AT_BODY(KT, STOREX, LOADX) do { const int kt_ = (KT); \
            if (kt_ + 2 < ntile) STOREX(bo2); if (kt_ + 4 < ntile) LOADX(kt_ + 4); \
            f32x16 S0, S1; AT_QK(bo0, S0, S1, -m_ref); \
            float mxa = fmaxf(fmaxf(S0[0], S0[1]), S0[2]), mxb = fmaxf(fmaxf(S0[3], S0[4]), S0[5]), mxc = fmaxf(fmaxf(S1[0], S1[1]), S1[2]), mxd = fmaxf(fmaxf(S1[3], S1[4]), S1[5]); \
            _Pragma("unroll") for (int r = 6; r < 16; r += 2) { mxa = fmaxf(mxa, S0[r]); mxb = fmaxf(mxb, S0[r + 1]); mxc = fmaxf(mxc, S1[r]); mxd = fmaxf(mxd, S1[r + 1]); } \
            float mx = fmaxf(fmaxf(mxa, mxb), fmaxf(mxc, mxd)); \
            mx = fmaxf(mx, __shfl_xor(mx, 32)); \
            if (__any(mx > 8.f) || kt_ == 0) { const float delta = kt_ == 0 ? mx : fmaxf(mx, 0.f); const float alpha = __builtin_amdgcn_exp2f(-delta); m_ref += delta; l_run *= alpha; \
                _Pragma("unroll") for (int r = 0; r < 16; ++r) { O0[r] *= alpha; O1[r] *= alpha; S0[r] -= delta; S1[r] -= delta; } } \
            float ps0 = 0.f, ps1 = 0.f, ps2 = 0.f, ps3 = 0.f; \
            _Pragma("unroll") for (int r = 0; r < 16; r += 2) { S0[r] = __builtin_amdgcn_exp2f(S0[r]); S1[r] = __builtin_amdgcn_exp2f(S1[r]); S0[r + 1] = __builtin_amdgcn_exp2f(S0[r + 1]); S1[r + 1] = __builtin_amdgcn_exp2f(S1[r + 1]); ps0 += S0[r]; ps1 += S1[r]; ps2 += S0[r + 1]; ps3 += S1[r + 1]; } \
            l_run += (ps0 + ps1) + (ps2 + ps3); \
            union { bf16x8 v; unsigned u[4]; } p00, p01, p10, p11; \
            _Pragma("unroll") for (int j = 0; j < 4; ++j) { p00.u[j] = pk2(S0[2 * j], S0[2 * j + 1]); p01.u[j] = pk2(S0[8 + 2 * j], S0[8 + 2 * j + 1]); p10.u[j] = pk2(S1[2 * j], S1[2 * j + 1]); p11.u[j] = pk2(S1[8 + 2 * j], S1[8 + 2 * j + 1]); } \
            const LAS unsigned char* vb = F.lds + bo0 + AT_KB; \
            _Pragma("unroll") for (int dvt = 0; dvt < 2; ++dvt) { const LAS unsigned char* vrow = vb + (32 * dvt + ql) * (AT_VLD * 2) + 8 * h2; union { bf16x8 v; v2u h[2]; } vf[4]; \
                _Pragma("unroll") for (int ss = 0; ss < 4; ++ss) { vf[ss].h[0] = *(const LAS v2u*)(vrow + 2 * (16 * ss)); vf[ss].h[1] = *(const LAS v2u*)(vrow + 2 * (16 * ss + 8)); } \
                __builtin_amdgcn_sched_barrier(0); \
                if (dvt == 0) { O0 = __builtin_amdgcn_mfma_f32_32x32x16_bf16(vf[0].v, p00.v, O0, 0, 0, 0); O0 = __builtin_amdgcn_mfma_f32_32x32x16_bf16(vf[1].v, p01.v, O0, 0, 0, 0); O0 = __builtin_amdgcn_mfma_f32_32x32x16_bf16(vf[2].v, p10.v, O0, 0, 0, 0); O0 = __builtin_amdgcn_mfma_f32_32x32x16_bf16(vf[3].v, p11.v, O0, 0, 0, 0); } \
                else { O1 = __builtin_amdgcn_mfma_f32_32x32x16_bf16(vf[0].v, p00.v, O1, 0, 0, 0); O1 = __builtin_amdgcn_mfma_f32_32x32x16_bf16(vf[1].v, p01.v, O1, 0, 0, 0); O1 = __builtin_amdgcn_mfma_f32_32x32x16_bf16(vf[2].v, p10.v, O1, 0, 0, 0); O1 = __builtin_amdgcn_mfma_f32_32x32x16_bf16(vf[3].v, p11.v, O1, 0, 0, 0); } \
                __builtin_amdgcn_sched_barrier(0); } \
            __syncthreads(); \
            { const int t_ = bo0; bo0 = bo1; bo1 = bo2; bo2 = t_; } } while (0)
        for (int kt = 0; kt < ntile; kt += 2) {
            AT_BODY(kt, AT_STORE, AT_LOAD);
            AT_BODY(kt + 1, AT_STOREB, AT_LOADB);
        }
#undef AT_BODY
#undef AT_LOADB
#undef AT_STOREB
#undef AT_LOAD
#undef AT_STORE
#undef AT_QK
        const float inv = 1.f / (l_run + __shfl_xor(l_run, 32));
        const int b = bh >> 2, head = bh & 3, qi = q0 + 32 * wave + ql;
        const size_t row = isctx ? (size_t)NL + b * 256 + qi : (size_t)b * 4096 + (qi - 256);
        bf16* orow = AO + row * 256 + head * 64 + 4 * h2;
#pragma unroll
        for (int g = 0; g < 4; ++g) { v2u o0, o1; o0.x = pk2(O0[4 * g] * inv, O0[4 * g + 1] * inv); o0.y = pk2(O0[4 * g + 2] * inv, O0[4 * g + 3] * inv); o1.x = pk2(O1[4 * g] * inv, O1[4 * g + 1] * inv); o1.y = pk2(O1[4 * g + 2] * inv, O1[4 * g + 3] * inv);
            *(GAS v2u*)(orow + 8 * g) = o0; *(GAS v2u*)(orow + 32 + 8 * g) = o1; }
    }
}

__device__ __forceinline__ void phase_fin_mla(Frame& F, int li) { WS_DECL; frame_refresh(F);
    const int nrows = li == DEPTH - 1 ? NL : NT; const float* g = in_ptr(I_MLAON) + li * 256; const bf16* AO = WSP(bf16, WS_AO); bf16* MIX = WSP(bf16, WS_A1);
    const int gw = blockIdx.x * NWAVES + F.wave, NGW = F.G * NWAVES; const f32x4 g4 = *(const GAS f32x4*)(g + 4 * F.lane);
    for (int m = gw; m < nrows; m += NGW) { const v2u w = *(const GAS v2u*)(AO + (size_t)m * 256 + 4 * F.lane);
        f32x4 x; x.x = bflo(w.x); x.y = bfhi(w.x); x.z = bflo(w.y); x.w = bfhi(w.y);
        const float r = __builtin_amdgcn_rsqf(wave_sum(x.x * x.x + x.y * x.y + x.z * x.z + x.w * x.w) * (1.f / 256.f) + 1e-6f);
        v2u o; o.x = pk2(x.x * r * g4.x, x.y * r * g4.y); o.y = pk2(x.z * r * g4.z, x.w * r * g4.w); *(GAS v2u*)(MIX + (size_t)m * D + 4 * F.lane) = o; }
}
__device__ __forceinline__ void phase_fin_zero(Frame& F, int li, int c0) { WS_DECL; frame_refresh(F);
    const int nrows = li == DEPTH - 1 ? NL : NT; bf16* MIX = WSP(bf16, WS_A1); const int gw = blockIdx.x * NWAVES + F.wave, NGW = F.G * NWAVES;
    for (int m = gw; m < nrows; m += NGW) *(GAS v2u*)(MIX + (size_t)m * D + c0 + 4 * F.lane) = (v2u){0u, 0u};
}

__device__ __forceinline__ void phase_pro0b(Frame& F) { WS_DECL; frame_refresh(F);
    const int gt = blockIdx.x * NTHR + F.tid, NGT = F.G * NTHR;
    float* RC = WSP(float, WS_ROPE); float* RS = RC + 4096 * 16;
    for (int i = gt; i < 4096 * 16; i += NGT) { const int t = i >> 4, j = i & 15; const float inv = powf(10000.f, -(float)(j & 7) / 8.f); const float pos = j < 8 ? (float)(t >> 6) : (float)(t & 63);
        const float ang = pos * inv; RC[i] = cosf(ang); RS[i] = sinf(ang); }
    const float* wuq = in_ptr(I_WUQ); const float* wukv = in_ptr(I_WUKV); bf16* WQ = WSP(bf16, WS_WUQT); bf16* WKV = WSP(bf16, WS_WUKVT);
    for (int i = gt; i < DEPTH * 384 * 192; i += NGT) { const int li = i / (384 * 192), r = i % (384 * 192), n = r / 192, k = r % 192; WQ[i] = (bf16)f2bf(wuq[(size_t)li * 192 * 384 + (size_t)k * 384 + n]); }
    for (int i = gt; i < DEPTH * 512 * 128; i += NGT) { const int li = i / (512 * 128), r = i % (512 * 128), n = r / 128, k = r % 128; WKV[i] = (bf16)f2bf(wukv[(size_t)li * 128 * 512 + (size_t)k * 512 + n]); }
}

constexpr int LR_LD = 264;
__device__ __forceinline__ float gelu_tanh(float x) { const float u = 0.7978845608028654f * (x + 0.044715f * x * x * x); const float e = __expf(2.f * u); const float t = 1.f - 2.f / (e + 1.f); return 0.5f * x * (1.f + t); }
template <int PASS>
__device__ __forceinline__ void phase_lru(Frame& F, int li) { WS_DECL; frame_refresh(F);
    LAS bf16* RAW = (LAS bf16*)F.lds; LAS bf16* U = (LAS bf16*)(F.lds + 67 * LR_LD * 2); LAS bf16* HS = (LAS bf16*)(F.lds + 71680);
    const bf16* P = WSP(bf16, WS_P); bf16* MIX = WSP(bf16, WS_A1); f32x2* SUMM = WSP(f32x2, WS_SUMM);
    const float* cw = in_ptr(I_LCW) + li * 4 * 256; const float* cb = in_ptr(I_LCB) + li * 256;
    const float* lam_ = in_ptr(I_LLAM) + li * 512; const float* br_ = in_ptr(I_LBR) + li * 512; const float* bi_ = in_ptr(I_LBI) + li * 512; const float* on_ = in_ptr(I_LON) + li * 256;
    const bf16* LW = WSP(bf16, WS_LRUW) + (size_t)li * 16 * 4096;
    const int lane = F.lane, wave = F.wave, tid = F.tid, fr = lane & 15, kg = lane >> 4;
    const int nitems = (PASS == 3 && li == DEPTH - 1) ? NL / 64 : NT / 64;
    for (int item = blockIdx.x; item < nitems; item += F.G) {
        const int m0 = item * 64; const bool isctx = m0 >= NL; const int b = isctx ? (m0 - NL) >> 8 : m0 >> 12; const int t0 = isctx ? (m0 - NL) & 255 : m0 & 4095; const int Ls = isctx ? 256 : 4096;
        const size_t seg0 = isctx ? (size_t)NL + b * 256 : (size_t)b * 4096;
        for (int c = tid; c < 67 * 32; c += NTHR) { const int r = c >> 5, cc = c & 31, t = t0 - 2 + r; v4u v = (v4u){0u, 0u, 0u, 0u};
            if (t >= 0 && t < Ls) v = *(const GAS v4u*)(P + (seg0 + t) * PCOLS + 352 + 8 * cc);
            *(LAS v4u*)(RAW + r * LR_LD + 8 * cc) = v; }
        __syncthreads();
        { const int c2 = tid & 127, tq = tid >> 7; const int ch = 2 * c2;
          float w0[4], w1[4];
#pragma unroll
          for (int j = 0; j < 4; ++j) { w0[j] = cw[j * 256 + ch]; w1[j] = cw[j * 256 + ch + 1]; }
          const float b0 = cb[ch], b1 = cb[ch + 1];
          for (int t = tq * 16; t < tq * 16 + 16; ++t) { float s0 = b0, s1 = b1;
#pragma unroll
              for (int j = 0; j < 4; ++j) { const unsigned w = *(const LAS unsigned*)(RAW + (t + j) * LR_LD + ch); s0 += w0[j] * bflo(w); s1 += w1[j] * bfhi(w); }
              *(LAS unsigned*)(U + t * LR_LD + ch) = pk2(s0, s1); } }
        __syncthreads();
#pragma unroll 1
        for (int ni = 0; ni < 2; ++ni) {
            float yv[4][4];
            const int nt = 2 * wave + ni, nb = nt >> 2, ch = 16 * nt + fr;
            bf16x8 wfr[2][2][2]; float spc[2], brc[2], bic[2];
#pragma unroll
            for (int d = 0; d < 2; ++d) { spc[d] = lam_[d * 256 + ch]; brc[d] = br_[d * 256 + ch]; bic[d] = bi_[d * 256 + ch];
#pragma unroll
                for (int g = 0; g < 2; ++g)
#pragma unroll
                    for (int ks = 0; ks < 2; ++ks) wfr[d][g][ks] = *(const GAS bf16x8*)(LW + ((size_t)((g * 2 + d) * 4 + nb) * 64 + 16 * (nt & 3) + fr) * 64 + 32 * ks + 8 * kg); }
            float uu[4][4];
#pragma unroll
            for (int m = 0; m < 4; ++m)
#pragma unroll
                for (int r = 0; r < 4; ++r) uu[m][r] = bf2f(U[(16 * m + 4 * kg + r) * LR_LD + ch]);
#pragma unroll
            for (int d = 0; d < 2; ++d) {
                f32x4 ar[4], ai[4];
#pragma unroll
                for (int m = 0; m < 4; ++m) { ar[m] = (f32x4){0.f, 0.f, 0.f, 0.f}; ai[m] = (f32x4){0.f, 0.f, 0.f, 0.f}; }
#pragma unroll
                for (int ks = 0; ks < 2; ++ks) {
                    const bf16x8 wr = wfr[d][0][ks], wi = wfr[d][1][ks];
#pragma unroll
                    for (int m = 0; m < 4; ++m) { const bf16x8 xf = *(const LAS bf16x8*)(U + (16 * m + fr) * LR_LD + 64 * nb + 32 * ks + 8 * kg);
                        ar[m] = __builtin_amdgcn_mfma_f32_16x16x32_bf16(xf, wr, ar[m], 0, 0, 0); ai[m] = __builtin_amdgcn_mfma_f32_16x16x32_bf16(xf, wi, ai[m], 0, 0, 0); } }
                const float sp = __logf(1.f + __expf(-spc[d])), brv = brc[d], biv = bic[d];
#pragma unroll
                for (int m = 0; m < 4; ++m)
#pragma unroll
                    for (int r = 0; r < 4; ++r) { const float rg = __builtin_amdgcn_rcpf(1.f + __expf(-(ar[m][r] + brv))), ig = __builtin_amdgcn_rcpf(1.f + __expf(-(ai[m][r] + biv))); const float av = __expf(-8.f * rg * sp);
                        ar[m][r] = av; ai[m][r] = __builtin_amdgcn_sqrtf(fmaxf(1.f - av * av, 0.f)) * (ig * uu[m][r]); }
                float H = 0.f;
                if (PASS == 3) {
                    const int cj = t0 >> 6, cbase = 1024 + b * 4, lbase = b * 64;
                    const int np = d == 0 ? (isctx ? cj : 4 + cj) : (isctx ? 3 - cj : 4 + 63 - cj);
                    const int q = (np + 3) >> 2, p_lo = kg * q, p_hi = (p_lo + q < np) ? p_lo + q : np;
                    float Aq = 1.f, Bq = 0.f;
                    for (int p0 = p_lo; p0 < p_hi; p0 += 8) { f32x2 sv[8];
#pragma unroll
                        for (int e = 0; e < 8; ++e) { const int p = p0 + e; sv[e] = (f32x2){1.f, 0.f};
                            if (p < p_hi) { int cid; if (d == 0) cid = isctx ? cbase + p : (p < 4 ? cbase + p : lbase + (p - 4)); else cid = isctx ? cbase + 3 - p : (p < 4 ? cbase + 3 - p : lbase + 63 - (p - 4));
                                sv[e] = *(const GAS f32x2*)(SUMM + ((size_t)cid * 2 + d) * 256 + ch); } }
#pragma unroll
                        for (int e = 0; e < 8; ++e) { Bq = sv[e].x * Bq + sv[e].y; Aq = sv[e].x * Aq; } }
#pragma unroll
                    for (int g = 0; g < 4; ++g) { const float Ag_ = __shfl(Aq, fr + 16 * g), Bg_ = __shfl(Bq, fr + 16 * g); H = Ag_ * H + Bg_; }
                }
                float Ac = 1.f, Bc = 0.f;
#pragma unroll
                for (int mi = 0; mi < 4; ++mi) { const int m = d == 0 ? mi : 3 - mi;
                    float Al, Bl;
                    if (d == 0) { Al = ar[m][0] * ar[m][1] * ar[m][2] * ar[m][3]; Bl = ((ai[m][0] * ar[m][1] + ai[m][1]) * ar[m][2] + ai[m][2]) * ar[m][3] + ai[m][3]; }
                    else { Al = ar[m][0] * ar[m][1] * ar[m][2] * ar[m][3]; Bl = ((ai[m][3] * ar[m][2] + ai[m][2]) * ar[m][1] + ai[m][1]) * ar[m][0] + ai[m][0]; }
                    float Ag[4], Bg[4];
#pragma unroll
                    for (int g = 0; g < 4; ++g) { Ag[g] = __shfl(Al, fr + 16 * g); Bg[g] = __shfl(Bl, fr + 16 * g); }
                    if (PASS == 1) {
                        float At = 1.f, Bt = 0.f;
#pragma unroll
                        for (int gi = 0; gi < 4; ++gi) { const int g = d == 0 ? gi : 3 - gi; Bt = Ag[g] * Bt + Bg[g]; At = Ag[g] * At; }
                        Bc = At * Bc + Bt; Ac = At * Ac;
                    } else {
                        float s = H, sin_ = H;
#pragma unroll
                        for (int gi = 0; gi < 4; ++gi) { const int g = d == 0 ? gi : 3 - gi; if (g == kg) sin_ = s; s = Ag[g] * s + Bg[g]; }
                        H = s;
                        float x = sin_;
#pragma unroll
                        for (int ri = 0; ri < 4; ++ri) { const int r = d == 0 ? ri : 3 - ri; x = ar[m][r] * x + ai[m][r]; if (d == 0) yv[m][r] = x; else yv[m][r] += x; }
                    }
                }
                if (PASS == 1 && kg == 0) *(GAS f32x2*)(SUMM + ((size_t)item * 2 + d) * 256 + ch) = (f32x2){Ac, Bc};
            }
            if (PASS == 3) {
#pragma unroll
                for (int m = 0; m < 4; ++m)
#pragma unroll
                    for (int r = 0; r < 4; ++r) HS[(16 * m + 4 * kg + r) * LR_LD + ch] = (bf16)f2bf(yv[m][r]);
            }
        }
        if (PASS == 3) {
            __syncthreads();
            const f32x4 on4 = *(const GAS f32x4*)(on_ + 4 * lane);
            for (int i = 0; i < 8; ++i) { const int tl = wave * 8 + i; const v2u hw = *(const LAS v2u*)(HS + tl * LR_LD + 4 * lane); const v2u gw = *(const GAS v2u*)(P + (size_t)(m0 + tl) * PCOLS + 608 + 4 * lane);
                f32x4 y; y.x = bflo(hw.x) * gelu_tanh(bflo(gw.x)); y.y = bfhi(hw.x) * gelu_tanh(bfhi(gw.x)); y.z = bflo(hw.y) * gelu_tanh(bflo(gw.y)); y.w = bfhi(hw.y) * gelu_tanh(bfhi(gw.y));
                const float rs = __builtin_amdgcn_rsqf(wave_sum(y.x * y.x + y.y * y.y + y.z * y.z + y.w * y.w) * (1.f / 256.f) + 1e-6f);
                v2u o; o.x = pk2(y.x * rs * on4.x, y.y * rs * on4.y); o.y = pk2(y.z * rs * on4.z, y.w * rs * on4.w);
                *(GAS v2u*)(MIX + (size_t)(m0 + tl) * D + 256 + 4 * lane) = o; }
        }
        __syncthreads();
    }
}

__device__ __forceinline__ void phase_pro0c(Frame& F) { WS_DECL; frame_refresh(F);
    const int gt = blockIdx.x * NTHR + F.tid, NGT = F.G * NTHR; const float* wr = in_ptr(I_LWR); const float* wi = in_ptr(I_LWI); bf16* LW = WSP(bf16, WS_LRUW);
    for (int i = gt; i < DEPTH * 16 * 4096; i += NGT) { const int c = i & 63, dd = (i >> 6) & 63, nb = (i >> 12) & 3, d = (i >> 14) & 1, g = (i >> 15) & 1, li = i >> 16;
        const float* src = g == 0 ? wr : wi; LW[i] = (bf16)f2bf(src[((((size_t)li * 2 + d) * 4 + nb) * 64 + c) * 64 + dd]); }
}

template <int CTRL> __device__ __forceinline__ float dpp_f(float x) { return __builtin_bit_cast(float, __builtin_amdgcn_mov_dpp(__builtin_bit_cast(int, x), CTRL, 0xf, 0xf, true)); }
__device__ __forceinline__ float rowsum16(float x) { x += dpp_f<0x128>(x); x += dpp_f<0x124>(x); x += dpp_f<0x122>(x); x += dpp_f<0x121>(x); return x; }
constexpr int RW_C0 = 864;
constexpr size_t WS_RWUP = WS_LRUW + 512 * 1024;
constexpr size_t WS_EA = WS_Y;

__device__ __forceinline__ void phase_pro0e(Frame& F) { WS_DECL; frame_refresh(F);
    const int gt = blockIdx.x * NTHR + F.tid, NGT = F.G * NTHR; const float* wup = in_ptr(I_WUP); const float* aup = in_ptr(I_AUP); bf16* W = WSP(bf16, WS_RWUP);
    for (int i = gt; i < DEPTH * 2 * 2 * 256 * 32; i += NGT) { const int k = i & 31, n = (i >> 5) & 255, wa = (i >> 13) & 1, d = (i >> 14) & 1, li = i >> 15;
        const float* src = wa == 0 ? wup : aup; W[i] = (bf16)f2bf(src[(((size_t)li * 2 + d) * 32 + k) * 256 + n]); }
}

constexpr int R0_LD = 136, R0_ZLD = 72;
__device__ __forceinline__ void phase_rwkv_r0(Frame& F, int li) { WS_DECL; frame_refresh(F);
    LAS bf16* RAWL = (LAS bf16*)F.lds;
    LAS bf16* ZW = (LAS bf16*)(F.lds + 66 * R0_LD * 2);
    LAS bf16* ZA = ZW + 64 * R0_ZLD;
    const bf16* P = WSP(bf16, WS_P); bf16* EA = WSP(bf16, WS_EA); const bf16* W = WSP(bf16, WS_RWUP) + (size_t)li * 2 * 2 * 256 * 32;
    const float* mup = in_ptr(I_MUP) + li * 960 + 768; const float* mun = in_ptr(I_MUN) + li * 960 + 768; const float* w0 = in_ptr(I_W0) + li * 512; const float* a0 = in_ptr(I_A0) + li * 512;
    const int tid = F.tid, lane = F.lane, wave = F.wave, fr = lane & 15, kg = lane >> 4;
    for (int item = blockIdx.x; item < NT / 64; item += F.G) {
        const int m0 = item * 64; const bool isctx = m0 >= NL; const int t0 = isctx ? (m0 - NL) & 255 : m0 & 4095; const int Ls = isctx ? 256 : 4096; const size_t seg0 = (size_t)m0 - t0;
        __syncthreads();
        for (int c = tid; c < 66 * 16; c += NTHR) { const int r = c >> 4, cc = c & 15, t = t0 - 1 + r; v4u v = (v4u){0u, 0u, 0u, 0u};
            if (t >= 0 && t < Ls) v = *(const GAS v4u*)(P + (seg0 + t) * PCOLS + RW_C0 + 768 + 8 * cc);
            *(LAS v4u*)(RAWL + r * R0_LD + 8 * cc) = v; }
        __syncthreads();
        { const int c = tid & 127, tq = tid >> 7; const float mp = mup[c], mn = mun[c];
          for (int tl = tq * 16; tl < tq * 16 + 16; ++tl) { const float x = bf2f(RAWL[(tl + 1) * R0_LD + c]), xp = bf2f(RAWL[tl * R0_LD + c]), xn = bf2f(RAWL[(tl + 2) * R0_LD + c]);
              const float z = x + mp * (xp - x) + mn * (xn - x);
              if (c < 64) { const float e2 = __expf(2.f * z); ZW[tl * R0_ZLD + c] = (bf16)f2bf(1.f - 2.f * __builtin_amdgcn_rcpf(e2 + 1.f)); } else ZA[tl * R0_ZLD + (c - 64)] = (bf16)f2bf(z); } }
        __syncthreads();
        const int d = wave >> 2, hh = wave & 3;
#pragma unroll 1
        for (int nt = 0; nt < 4; ++nt) { const int ch0 = 64 * hh + 16 * nt;
            const bf16x8 wf = *(const GAS bf16x8*)(W + ((size_t)(d * 2 + 0) * 256 + ch0 + fr) * 32 + 8 * kg), af = *(const GAS bf16x8*)(W + ((size_t)(d * 2 + 1) * 256 + ch0 + fr) * 32 + 8 * kg);
            const f32x4 w04 = *(const GAS f32x4*)(w0 + d * 256 + ch0 + 4 * kg), a04 = *(const GAS f32x4*)(a0 + d * 256 + ch0 + 4 * kg);
#pragma unroll
            for (int m = 0; m < 4; ++m) { const bf16x8 zw = *(const LAS bf16x8*)(ZW + (16 * m + fr) * R0_ZLD + 32 * d + 8 * kg), za = *(const LAS bf16x8*)(ZA + (16 * m + fr) * R0_ZLD + 32 * d + 8 * kg);
                f32x4 xw = __builtin_amdgcn_mfma_f32_16x16x32_bf16(wf, zw, (f32x4){0.f, 0.f, 0.f, 0.f}, 0, 0, 0), xa = __builtin_amdgcn_mfma_f32_16x16x32_bf16(af, za, (f32x4){0.f, 0.f, 0.f, 0.f}, 0, 0, 0);
                xw = xw + w04; xa = xa + a04; float e[4], av[4];
#pragma unroll
                for (int r = 0; r < 4; ++r) { e[r] = -0.6065306597126334f * __builtin_amdgcn_rcpf(1.f + __expf(-xw[r])); av[r] = __builtin_amdgcn_rcpf(1.f + __expf(-xa[r])); }
                const size_t tok = (size_t)m0 + 16 * m + fr; v2u oe, oa; oe.x = pk2(e[0], e[1]); oe.y = pk2(e[2], e[3]); oa.x = pk2(av[0], av[1]); oa.y = pk2(av[2], av[3]);
                *(GAS v2u*)(EA + (tok * 4 + d) * 256 + ch0 + 4 * kg) = oe; *(GAS v2u*)(EA + (tok * 4 + 2 + d) * 256 + ch0 + 4 * kg) = oa; } }
    }
    __syncthreads();
}

constexpr int RW_T = 16, RW_NCH = (LCX + SEQ) / RW_T, RW_ROWS = RW_T + 2, RW_LD = 200, RW_P = 72;
constexpr int RW_RAW = 0, RW_RAWB = RW_ROWS * RW_LD * 2;
constexpr int RW_EAB = RW_RAW + 2 * RW_RAWB, RW_EABB = RW_T * 128 * 2;
constexpr int RW_VEC = RW_EAB + 2 * RW_EABB, RW_VECB = RW_T * 4 * 64 * 2 + RW_T * 64 * 4;
constexpr int RW_VV = RW_VEC + 2 * RW_VECB;
constexpr int RW_BON = RW_VV + 8 * 1024;
constexpr int RW_ARA = RW_BON + 8 * 64;
constexpr int RW_KB2 = RW_ARA + 2 * 16 * RW_P * 2;
constexpr int RW_AT2 = RW_KB2 + 2 * 32 * RW_P * 2;
constexpr int RW_ARR = RW_AT2 + 4 * 2048;
constexpr int RW_KT = RW_ARR + 4 * 16 * RW_P * 2;
constexpr int RW_BTN = RW_KT + 4 * 2048;
constexpr int RW_CWT = RW_BTN + 4 * 2048;
constexpr int RW_DO = RW_CWT + 4 * 256;
constexpr int RW_DOB = 16 * RW_P * 2 + 3 * 512;
constexpr int RW_BC = RW_DO + 4 * RW_DOB;
constexpr int RW_END = RW_BC + 9 * 256;
static_assert(RW_END <= RING_BYTES, "rwkv lds map");
typedef LAS bf16* lbf;
__device__ __forceinline__ bf16x8 rw_zero8() { return (bf16x8){0, 0, 0, 0, 0, 0, 0, 0}; }
__device__ __forceinline__ bf16x8 rw_k16(const LAS bf16* rowp, int kg) { bf16x8 r = rw_zero8(); if (kg < 2) r = *(const LAS bf16x8*)(rowp + 8 * kg); return r; }
__device__ __forceinline__ bf16x8 rw_perm4(const LAS bf16* rowp, int kg) { union { bf16x8 v; v2u h[2]; } u; u.h[0] = *(const LAS v2u*)(rowp + 4 * kg); u.h[1] = (v2u){0u, 0u}; return u.v; }
__device__ __forceinline__ bf16x8 rw_permK(const LAS bf16* rowp, int kg, int sp) { union { bf16x8 v; v2u h[2]; } u; u.h[0] = *(const LAS v2u*)(rowp + 32 * sp + 4 * kg); u.h[1] = *(const LAS v2u*)(rowp + 32 * sp + 16 + 4 * kg); return u.v; }
__device__ __forceinline__ bf16x8 rw_c4(f32x4 c) { union { bf16x8 v; unsigned u[4]; } x; x.u[0] = pk2(c[0], c[1]); x.u[1] = pk2(c[2], c[3]); x.u[2] = 0u; x.u[3] = 0u; return x.v; }
__device__ __forceinline__ bf16x8 rw_c8(f32x4 c0, f32x4 c1) { union { bf16x8 v; unsigned u[4]; } x; x.u[0] = pk2(c0[0], c0[1]); x.u[1] = pk2(c0[2], c0[3]); x.u[2] = pk2(c1[0], c1[1]); x.u[3] = pk2(c1[2], c1[3]); return x.v; }
__device__ __forceinline__ void rw_st_rows(lbf M, f32x4 c, int fr, int kg) {
#pragma unroll
    for (int r = 0; r < 4; ++r) M[(4 * kg + r) * 16 + fr] = (bf16)f2bf(c[r]); }
__device__ __forceinline__ void rw_st_cols(lbf M, f32x4 c, int fr, int kg, int pitch) {
    v2u o; o.x = pk2(c[0], c[1]); o.y = pk2(c[2], c[3]); *(LAS v2u*)(M + fr * pitch + 4 * kg) = o; }
#define RW_MFMA(a, b, c) __builtin_amdgcn_mfma_f32_16x16x32_bf16(a, b, c, 0, 0, 0)

__device__ __forceinline__ void phase_rwkv_scan(Frame& F, int li) { WS_DECL; frame_refresh(F);
    const bf16* P = WSP(bf16, WS_P); const bf16* EA = WSP(bf16, WS_EA); float* YR = WSP(float, WS_YR); float* BON = WSP(float, WS_BON);
    const bf16* zsrc = (const bf16*)(ws + WS_CTL + 65536);
    const int tid = F.tid, lane = F.lane, wave = F.wave, fr = lane & 15, kg = lane >> 4;
    LAS unsigned char* L = F.lds;
    for (int item = blockIdx.x; item < 256; item += F.G) {
        const int vhalf = item & 1, d = (item >> 1) & 1, h = (item >> 2) & 3, b = item >> 4;
        __syncthreads();
        const int pt = (tid - 128) & 255, ps = pt >> 4, pq = pt & 15;
        const int sk = pt & 63, sq = pt >> 6;
        { LAS float* BC = (LAS float*)(L + RW_BC); const float* mup = in_ptr(I_MUP) + li * 960; const float* mun = in_ptr(I_MUN) + li * 960;
          if (tid < 64) { const int c = 64 * h + tid; BC[tid] = mup[c]; BC[64 + tid] = mup[256 + c]; BC[128 + tid] = mup[512 + c]; BC[192 + tid] = mun[c]; BC[256 + tid] = mun[256 + c]; BC[320 + tid] = mun[512 + c];
              BC[384 + tid] = in_ptr(I_KK)[li * 256 + c]; BC[448 + tid] = in_ptr(I_KA)[li * 256 + c]; BC[512 + tid] = in_ptr(I_RK)[li * 256 + c]; } }
        __syncthreads();
        f32x4 S0 = (f32x4){0.f, 0.f, 0.f, 0.f}, S1 = S0, S2 = S0, S3 = S0;
        v4u ra[11];
#pragma unroll
        for (int q = 0; q < 11; ++q) ra[q] = (v4u){0u, 0u, 0u, 0u};
        if (wave < 2) {
#pragma unroll 1
            for (int it = -8; it <= RW_NCH; ++it) {
                if (it >= 0 && it < RW_NCH) {
                    const lbf VV = (lbf)(L + RW_VV + (it & 7) * 1024), ARR = (lbf)(L + RW_ARR + (it & 3) * (16 * RW_P * 2)), KT = (lbf)(L + RW_KT + (it & 3) * 2048), BTN = (lbf)(L + RW_BTN + (it & 3) * 2048);
                    const LAS float* CWT = (const LAS float*)(L + RW_CWT + (it & 3) * 256);
                    const lbf APT = (lbf)(L + RW_DO + (it & 3) * RW_DOB), AMT = APT + 16 * RW_P, ARKT = AMT + 256, ARBTN = ARKT + 256;
                    const f32x4 Z = (f32x4){0.f, 0.f, 0.f, 0.f};
                    const bf16x8 bvv = rw_k16(VV + (16 * wave + fr) * 16, kg);
                    const bf16x8 sb0 = rw_c8(S0, S1), sb1 = rw_c8(S2, S3);
                    f32x4 UT = RW_MFMA(rw_k16(AMT + fr * 16, kg), bvv, Z);
                    UT = RW_MFMA(rw_permK(APT + fr * RW_P, kg, 0), sb0, UT); UT = RW_MFMA(rw_permK(APT + fr * RW_P, kg, 1), sb1, UT);
                    f32x4 YT = RW_MFMA(rw_k16(ARKT + fr * 16, kg), bvv, Z);
                    YT = RW_MFMA(rw_permK(ARR + fr * RW_P, kg, 0), sb0, YT); YT = RW_MFMA(rw_permK(ARR + fr * RW_P, kg, 1), sb1, YT);
                    const bf16x8 ub = rw_c4(UT);
                    YT = RW_MFMA(rw_perm4(ARBTN + fr * 16, kg), ub, YT);
                    { const bool isctx = it < LCX / RW_T;
                      if (!isctx || li < DEPTH - 1) { const int cl = isctx ? it : it - LCX / RW_T; const int Ls = isctx ? LCX : SEQ; const int tlo = d == 0 ? cl * RW_T : Ls - RW_T - cl * RW_T; const size_t seg0 = isctx ? (size_t)NL + b * LCX : (size_t)b * SEQ;
#pragma unroll
                          for (int r = 0; r < 4; ++r) { const int sidx = 4 * kg + r; const int t = d == 0 ? tlo + sidx : tlo + RW_T - 1 - sidx;
                              YR[((size_t)d * NT + seg0 + t) * 256 + 64 * h + 32 * vhalf + 16 * wave + fr] = YT[r]; }
                          if (vhalf == 0 && wave == 0 && lane < RW_T) { const LAS float* BONS = (const LAS float*)(L + RW_BON) + (it & 7) * RW_T; const int t = d == 0 ? tlo + lane : tlo + RW_T - 1 - lane;
                              BON[((size_t)d * NT + seg0 + t) * 4 + h] = BONS[lane]; } } }
                    { f32x4 q = RW_MFMA(rw_k16(KT + (0 + fr) * 16, kg), bvv, S0); q = RW_MFMA(rw_perm4(BTN + (0 + fr) * 16, kg), ub, q); S0 = q * *(const LAS f32x4*)(CWT + 0 + 4 * kg); }
                    { f32x4 q = RW_MFMA(rw_k16(KT + (16 + fr) * 16, kg), bvv, S1); q = RW_MFMA(rw_perm4(BTN + (16 + fr) * 16, kg), ub, q); S1 = q * *(const LAS f32x4*)(CWT + 16 + 4 * kg); }
                    { f32x4 q = RW_MFMA(rw_k16(KT + (32 + fr) * 16, kg), bvv, S2); q = RW_MFMA(rw_perm4(BTN + (32 + fr) * 16, kg), ub, q); S2 = q * *(const LAS f32x4*)(CWT + 32 + 4 * kg); }
                    { f32x4 q = RW_MFMA(rw_k16(KT + (48 + fr) * 16, kg), bvv, S3); q = RW_MFMA(rw_perm4(BTN + (48 + fr) * 16, kg), ub, q); S3 = q * *(const LAS f32x4*)(CWT + 48 + 4 * kg); }
                }
                __syncthreads();
            }
        } else if (wave < 6) {
#pragma unroll 1
            for (int it = -8; it <= RW_NCH; ++it) {
                { const int ca = it + 5;
                  if (ca >= 0 && ca < RW_NCH && ((ca & 3) == wave - 2)) { LAS bf16* RAWW = (LAS bf16*)(L + RW_RAW + (ca & 1) * RW_RAWB); LAS bf16* EAW = (LAS bf16*)(L + RW_EAB + (ca & 1) * RW_EABB);
#pragma unroll
                      for (int q = 0; q < 11; ++q) { const int c = lane + 64 * q;
                          if (c < RW_ROWS * 24) *(LAS v4u*)(RAWW + (c / 24) * RW_LD + 8 * (c % 24)) = ra[q];
                          else if (c < RW_ROWS * 24 + RW_T * 16) { const int e = c - RW_ROWS * 24; *(LAS v4u*)(EAW + 8 * e) = ra[q]; } } }
                  const int cn = it + 8;
                  if (cn < RW_NCH && ((cn & 3) == wave - 2)) { const bool isctx = cn < LCX / RW_T; const int cl = isctx ? cn : cn - LCX / RW_T; const int Ls = isctx ? LCX : SEQ; const int tlo = d == 0 ? cl * RW_T : Ls - RW_T - cl * RW_T;
                      const size_t seg0 = isctx ? (size_t)NL + b * LCX : (size_t)b * SEQ;
#pragma unroll
                      for (int q = 0; q < 11; ++q) { const int c = lane + 64 * q; const bf16* src = zsrc;
                          if (c < RW_ROWS * 24) { const int r = c / 24, cc = c % 24, t = tlo - 1 + r; const int col = 256 * (cc >> 3) + 64 * h + 8 * (cc & 7);
                              if (t >= 0 && t < Ls) src = P + (seg0 + t) * PCOLS + RW_C0 + col; }
                          else if (c < RW_ROWS * 24 + RW_T * 16) { const int e = c - RW_ROWS * 24, s = e >> 4, cc = e & 15; const int t = d == 0 ? tlo + s : tlo + RW_T - 1 - s;
                              src = EA + ((seg0 + t) * 4 + (cc >> 3) * 2 + d) * 256 + 64 * h + 8 * (cc & 7); }
                          ra[q] = *(const GAS v4u*)src; } } }
                const int cb = it + 4;
                if (cb >= 0 && cb < RW_NCH) {
                    const LAS bf16* RAW = (const LAS bf16*)(L + RW_RAW + (cb & 1) * RW_RAWB); const LAS bf16* EAB = (const LAS bf16*)(L + RW_EAB + (cb & 1) * RW_EABB);
                    const lbf VEC = (lbf)(L + RW_VEC + (cb & 1) * RW_VECB); LAS float* LWF = (LAS float*)(L + RW_VEC + (cb & 1) * RW_VECB + RW_T * 4 * 64 * 2);
                    const lbf VV = (lbf)(L + RW_VV + (cb & 7) * 1024); LAS float* BONS = (LAS float*)(L + RW_BON) + (cb & 7) * RW_T;
                    const int prow = d == 0 ? ps + 1 : RW_T - ps;
                    const LAS float* BC = (const LAS float*)(L + RW_BC) + 4 * pq;
                    const f32x4 mpr = *(const LAS f32x4*)(BC), mpk = *(const LAS f32x4*)(BC + 64), mpv = *(const LAS f32x4*)(BC + 128), mnr = *(const LAS f32x4*)(BC + 192), mnk = *(const LAS f32x4*)(BC + 256), mnv = *(const LAS f32x4*)(BC + 320);
                    const f32x4 kk_c = *(const LAS f32x4*)(BC + 384), ka_c = *(const LAS f32x4*)(BC + 448), rk_c = *(const LAS f32x4*)(BC + 512);
                    f32x4 zr, zk, zv;
                    { const LAS bf16* r0 = RAW + prow * RW_LD + 4 * pq;
#define RW_LD4(p) ({ const v2u w_ = *(const LAS v2u*)(p); (f32x4){bflo(w_.x), bfhi(w_.x), bflo(w_.y), bfhi(w_.y)}; })
                      { const f32x4 x = RW_LD4(r0), xp = RW_LD4(r0 - RW_LD), xn = RW_LD4(r0 + RW_LD); zr = x + mpr * (xp - x) + mnr * (xn - x); }
                      { const f32x4 x = RW_LD4(r0 + 64), xp = RW_LD4(r0 + 64 - RW_LD), xn = RW_LD4(r0 + 64 + RW_LD); zk = x + mpk * (xp - x) + mnk * (xn - x); }
                      { const f32x4 x = RW_LD4(r0 + 128), xp = RW_LD4(r0 + 128 - RW_LD), xn = RW_LD4(r0 + 128 + RW_LD); zv = x + mpv * (xp - x) + mnv * (xn - x); } }
                    const f32x4 lw4 = RW_LD4(EAB + ps * 128 + 4 * pq), a4 = RW_LD4(EAB + ps * 128 + 64 + 4 * pq);
                    const f32x4 kkr = zk * kk_c; const float ss = rowsum16((kkr.x * kkr.x + kkr.y * kkr.y) + (kkr.z * kkr.z + kkr.w * kkr.w));
                    const f32x4 kd = zk * ((a4 - 1.f) * ka_c + 1.f); const f32x4 bq = zr * kd * rk_c; const float bn = rowsum16((bq.x + bq.y) + (bq.z + bq.w));
                    const f32x4 kkn = kkr * __builtin_amdgcn_rsqf(fmaxf(ss, 1e-24f)), kka = kkn * a4;
                    { v2u o; lbf vp = VEC + ps * 256 + 4 * pq;
                      o.x = pk2(kkn.x, kkn.y); o.y = pk2(kkn.z, kkn.w); *(LAS v2u*)(vp) = o; o.x = pk2(kka.x, kka.y); o.y = pk2(kka.z, kka.w); *(LAS v2u*)(vp + 64) = o;
                      o.x = pk2(kd.x, kd.y); o.y = pk2(kd.z, kd.w); *(LAS v2u*)(vp + 128) = o; o.x = pk2(zr.x, zr.y); o.y = pk2(zr.z, zr.w); *(LAS v2u*)(vp + 192) = o; }
                    *(LAS f32x4*)(LWF + ps * 64 + 4 * pq) = lw4;
                    if ((pq >> 3) == vhalf) { const int v0 = 4 * (pq & 7); VV[(v0 + 0) * 16 + ps] = (bf16)f2bf(zv.x); VV[(v0 + 1) * 16 + ps] = (bf16)f2bf(zv.y); VV[(v0 + 2) * 16 + ps] = (bf16)f2bf(zv.z); VV[(v0 + 3) * 16 + ps] = (bf16)f2bf(zv.w); }
                    if (pq == 0) BONS[ps] = bn;
                }
                const int cc3 = it + 3;
                if (cc3 >= 0 && cc3 < RW_NCH) {
                    const LAS bf16* VEC = (const LAS bf16*)(L + RW_VEC + (cc3 & 1) * RW_VECB); const LAS float* LWF = (const LAS float*)(L + RW_VEC + (cc3 & 1) * RW_VECB + RW_T * 4 * 64 * 2);
                    const lbf ARA = (lbf)(L + RW_ARA + (cc3 & 1) * (16 * RW_P * 2)), KB2 = (lbf)(L + RW_KB2 + (cc3 & 1) * (32 * RW_P * 2)), AT2 = (lbf)(L + RW_AT2 + (cc3 & 3) * 2048);
                    const lbf ARR = (lbf)(L + RW_ARR + (cc3 & 3) * (16 * RW_P * 2)), KT = (lbf)(L + RW_KT + (cc3 & 3) * 2048), BTN = (lbf)(L + RW_BTN + (cc3 & 3) * 2048); LAS float* CWT = (LAS float*)(L + RW_CWT + (cc3 & 3) * 256);
                    float cl = 0.f;
                    for (int s = 0; s < 4 * sq; ++s) cl += LWF[s * 64 + sk];
                    float cwm = __expf(cl);
#pragma unroll
                    for (int j = 0; j < 4; ++j) { const int s = 4 * sq + j; cl += LWF[s * 64 + sk]; const float cw = __expf(cl), icw = __builtin_amdgcn_rcpf(cw);
                        const float kkv = bf2f(VEC[s * 256 + sk]), kkav = bf2f(VEC[s * 256 + 64 + sk]), kdv = bf2f(VEC[s * 256 + 128 + sk]), rv = bf2f(VEC[s * 256 + 192 + sk]);
                        const bf16 at = (bf16)f2bf(kkv * cwm), rt = (bf16)f2bf(rv * cw), kt = (bf16)f2bf(kdv * icw), btv = (bf16)f2bf(kkav * icw), btn = (bf16)f2bf(-kkav * icw);
                        ARA[s * RW_P + sk] = at; AT2[sk * 16 + s] = at; ARR[s * RW_P + sk] = rt; KB2[s * RW_P + sk] = kt; KT[sk * 16 + s] = kt; KB2[(16 + s) * RW_P + sk] = btv; BTN[sk * 16 + s] = btn;
                        if (s == RW_T - 1) CWT[sk] = cw;
                        cwm = cw; }
                }
                __syncthreads();
            }
        } else {
#pragma unroll 1
            for (int it = -8; it <= RW_NCH; ++it) {
                const int c = it + 2;
                if (c >= 0 && c < RW_NCH && ((c & 1) == (wave & 1))) {
                    const LAS bf16* ARA = (const LAS bf16*)(L + RW_ARA + (c & 1) * (16 * RW_P * 2)); const LAS bf16* KB2 = (const LAS bf16*)(L + RW_KB2 + (c & 1) * (32 * RW_P * 2));
                    const LAS bf16* ARR = (const LAS bf16*)(L + RW_ARR + (c & 3) * (16 * RW_P * 2)); const LAS bf16* AT2 = (const LAS bf16*)(L + RW_AT2 + (c & 3) * 2048);
                    const lbf APT = (lbf)(L + RW_DO + (c & 3) * RW_DOB), AMT = APT + 16 * RW_P, ARKT = AMT + 256, ARBTN = ARKT + 256;
                    const f32x4 Z = (f32x4){0.f, 0.f, 0.f, 0.f};
                    f32x4 gkk = Z, gkkT = Z, grk = Z, gn = Z, gnT = Z, grb = Z;
#pragma unroll
                    for (int ks = 0; ks < 2; ++ks) { const bf16x8 ak = *(const LAS bf16x8*)(KB2 + fr * RW_P + 32 * ks + 8 * kg), ab = *(const LAS bf16x8*)(KB2 + (16 + fr) * RW_P + 32 * ks + 8 * kg);
                        const bf16x8 ba = *(const LAS bf16x8*)(ARA + fr * RW_P + 32 * ks + 8 * kg), br = *(const LAS bf16x8*)(ARR + fr * RW_P + 32 * ks + 8 * kg);
                        gkk = RW_MFMA(ak, ba, gkk); gkkT = RW_MFMA(ba, ak, gkkT); grk = RW_MFMA(ak, br, grk); gn = RW_MFMA(ab, ba, gn); gnT = RW_MFMA(ba, ab, gnT); grb = RW_MFMA(ab, br, grb); }
                    f32x4 w1, w1T;
#pragma unroll
                    for (int r = 0; r < 4; ++r) { const int row = 4 * kg + r;
                        if (!(row < fr)) { gkk[r] = 0.f; gn[r] = 0.f; } if (!(fr < row)) { gkkT[r] = 0.f; gnT[r] = 0.f; } if (!(row <= fr)) { grk[r] = 0.f; grb[r] = 0.f; }
                        const float idt = row == fr ? 1.f : 0.f; w1[r] = idt - gn[r]; w1T[r] = idt - gnT[r]; }
                    const bf16x8 bn = rw_c4(gn), bnT = rw_c4(gnT);
                    const f32x4 n2 = RW_MFMA(bnT, bn, Z), n2T = RW_MFMA(bn, bnT, Z);
                    const bf16x8 b2 = rw_c4(n2), b2T = rw_c4(n2T);
                    const f32x4 n4 = RW_MFMA(b2T, b2, Z), n4T = RW_MFMA(b2, b2T, Z);
                    const bf16x8 b4 = rw_c4(n4), b4T = rw_c4(n4T);
                    const f32x4 n8 = RW_MFMA(b4T, b4, Z);
                    const bf16x8 bw1T = rw_c4(w1T);
                    const f32x4 w2 = RW_MFMA(bw1T, b2, w1), w2T = RW_MFMA(b2, bw1T, w1T);
                    const bf16x8 bw2T = rw_c4(w2T);
                    const f32x4 w3 = RW_MFMA(bw2T, b4, w2), w3T = RW_MFMA(b4, bw2T, w2T);
                    const f32x4 xi = RW_MFMA(rw_c4(w3T), rw_c4(n8), w3);
                    const bf16x8 bx = rw_c4(xi);
                    const f32x4 am = RW_MFMA(rw_c4(gkkT), bx, Z);
                    rw_st_cols(AMT, am, fr, kg, 16); rw_st_cols(ARKT, grk, fr, kg, 16); { f32x4 nb = Z - grb; rw_st_cols(ARBTN, nb, fr, kg, 16); }
#pragma unroll
                    for (int m = 0; m < 4; ++m) { const f32x4 ap = RW_MFMA(rw_perm4(AT2 + (16 * m + fr) * 16, kg), bx, Z);
                        rw_st_cols(APT + 16 * m, ap, fr, kg, RW_P); }
                }
                __syncthreads();
            }
        }
    }
}

__device__ __forceinline__ void phase_fin_rwkv(Frame& F, int li) { WS_DECL; frame_refresh(F);
    const int nrows = li == DEPTH - 1 ? NL : NT; const int lane = F.lane, wave = F.wave, tid = F.tid;
    LAS float* GUP = (LAS float*)F.lds;
    LAS float* SG = (LAS float*)(F.lds + 65536) + wave * 64;
    const bf16* P = WSP(bf16, WS_P); const float* YR = WSP(float, WS_YR); const float* BON = WSP(float, WS_BON); bf16* MIX = WSP(bf16, WS_A1);
    { const float* gup = in_ptr(I_GUP) + (size_t)li * 64 * 256; for (int i = tid; i < 64 * 256; i += NTHR) GUP[i] = gup[i]; }
    const float* mup = in_ptr(I_MUP) + li * 960; const float* mun = in_ptr(I_MUN) + li * 960;
    const f32x4 mpv = *(const GAS f32x4*)(mup + 512 + 4 * lane), mnv = *(const GAS f32x4*)(mun + 512 + 4 * lane);
    const float mpg = mup[896 + lane], mng = mun[896 + lane];
    const f32x4 lg = *(const GAS f32x4*)(in_ptr(I_LNG) + li * 256 + 4 * lane), lb = *(const GAS f32x4*)(in_ptr(I_LNB) + li * 256 + 4 * lane);
    __syncthreads();
    const int gw = blockIdx.x * NWAVES + wave, NGW = F.G * NWAVES;
    for (int m = gw; m < nrows; m += NGW) {
        const bool isctx = m >= NL; const int t = isctx ? (m - NL) & 255 : m & 4095; const int Ls = isctx ? 256 : 4096;
        const bf16* pr = P + (size_t)m * PCOLS + RW_C0;
        const bool hp = t > 0, hn = t + 1 < Ls;
        f32x4 v;
        { const v2u w = *(const GAS v2u*)(pr + 512 + 4 * lane); v2u wp = (v2u){0u, 0u}, wn = (v2u){0u, 0u};
          if (hp) wp = *(const GAS v2u*)(pr - PCOLS + 512 + 4 * lane); if (hn) wn = *(const GAS v2u*)(pr + PCOLS + 512 + 4 * lane);
          const f32x4 x = (f32x4){bflo(w.x), bfhi(w.x), bflo(w.y), bfhi(w.y)}, xp = (f32x4){bflo(wp.x), bfhi(wp.x), bflo(wp.y), bfhi(wp.y)}, xn = (f32x4){bflo(wn.x), bfhi(wn.x), bflo(wn.y), bfhi(wn.y)};
          v = x + mpv * (xp - x) + mnv * (xn - x); }
        { const float x = bf2f(pr[896 + lane]); const float xp = hp ? bf2f(pr[896 + lane - PCOLS]) : 0.f, xn = hn ? bf2f(pr[896 + lane + PCOLS]) : 0.f;
          SG[lane] = sigmoidf_(x + mpg * (xp - x) + mng * (xn - x)); }
        LDS_WAIT();
        f32x4 g = (f32x4){0.f, 0.f, 0.f, 0.f};
#pragma unroll 8
        for (int j = 0; j < 64; ++j) { const float sj = SG[j]; const f32x4 gu = *(const LAS f32x4*)(GUP + j * 256 + 4 * lane); g = g + gu * sj; }
        const f32x4 y = *(const GAS f32x4*)(YR + (size_t)m * 256 + 4 * lane) + *(const GAS f32x4*)(YR + ((size_t)NT + m) * 256 + 4 * lane);
        const float mean = rowsum16((y.x + y.y) + (y.z + y.w)) * (1.f / 64.f);
        const f32x4 yc = y - mean; const float var = rowsum16((yc.x * yc.x + yc.y * yc.y) + (yc.z * yc.z + yc.w * yc.w)) * (1.f / 64.f);
        const f32x4 yn = yc * __builtin_amdgcn_rsqf(var + 64e-5f) * lg + lb;
        const int hh = lane >> 4; const float bon = BON[(size_t)m * 4 + hh] + BON[((size_t)NT + m) * 4 + hh];
        const f32x4 o = (yn + v * bon) * g;
        v2u ow; ow.x = pk2(o.x, o.y); ow.y = pk2(o.z, o.w); *(GAS v2u*)(MIX + (size_t)m * D + 512 + 4 * lane) = ow;
        LDS_WAIT();
    }
    __syncthreads();
}

constexpr float HY_DMIN = -3.0701134573253945f, HY_DMAX = -15.350567286626973f;
constexpr int HY_X = 0, HY_TW = 65536, HY_W3 = 98304;
__device__ __forceinline__ float hy_delta(int ch) { return -(HY_DMIN + (float)ch * ((HY_DMAX - HY_DMIN) / 255.f)); }

__device__ __forceinline__ void phase_pro0d(Frame& F) { WS_DECL; frame_refresh(F);
    const int lane = F.lane; const int gw = blockIdx.x * NWAVES + F.wave, NGW = F.G * NWAVES;
    const float* w1 = in_ptr(I_HW1); const float* b1 = in_ptr(I_HB1); const float* w2 = in_ptr(I_HW2); const float* b2 = in_ptr(I_HB2);
    for (int it = gw; it < DEPTH * (SEQ + LCX); it += NGW) {
        const int li = it / (SEQ + LCX), r = it % (SEQ + LCX); const bool isctx = r >= SEQ; const int l = isctx ? r - SEQ : r; const int L = isctx ? LCX : SEQ;
        float z = 0.f;
        if (lane == 0) z = (float)l / (float)(L - 1);
        else if (lane < 33) { const int i = (lane - 1) & 15; const float band = 1e-4f + (float)i * ((15.f - 1e-4f) / 15.f); const float ang = band * (6.283185307179586f / (float)L) * (float)l; z = lane < 17 ? cosf(ang) : -sinf(ang); }
        float h1 = b1[li * 64 + lane];
        for (int i = 0; i < 33; ++i) h1 += __shfl(z, i) * w1[(li * 33 + i) * 64 + lane];
        h1 = sinf(h1);
        float h2 = b2[li * 64 + lane];
        for (int i = 0; i < 64; ++i) h2 += __shfl(h1, i) * w2[(li * 64 + i) * 64 + lane];
        h2 = sinf(h2);
        float* dst = isctx ? WSP(float, WS_H2C) + ((size_t)li * LCX + l) * 64 : WSP(float, WS_H2L) + ((size_t)li * SEQ + l) * 64;
        dst[lane] = h2;
    }
}

typedef f32x2 cpx;
__device__ __forceinline__ cpx cmul(cpx a, cpx b) { return (cpx){a.x * b.x - a.y * b.y, a.x * b.y + a.y * b.x}; }
__device__ __forceinline__ cpx cmulc(cpx a, cpx b) { return (cpx){a.x * b.x + a.y * b.y, a.y * b.x - a.x * b.y}; }
__device__ __forceinline__ cpx cmi(cpx z) { return (cpx){z.y, -z.x}; }
__device__ __forceinline__ int hy_p(int n) { return n ^ ((n >> 5) & 7) ^ (((n >> 6) & 3) << 3); }
__device__ __forceinline__ void hy_build_tw(Frame& F) {
    LAS cpx* TW = (LAS cpx*)(F.lds + HY_TW);
    for (int k = F.tid; k < 4096; k += NTHR) { const float rev = (float)k * (1.f / 8192.f); TW[k] = (cpx){__builtin_amdgcn_cosf(rev), -__builtin_amdgcn_sinf(rev)};     }
}
__device__ __forceinline__ void dft4(cpx x0, cpx x1, cpx x2, cpx x3, cpx& X0, cpx& X1, cpx& X2, cpx& X3) {
    const cpx t0 = x0 + x2, t1 = x0 - x2, t2 = x1 + x3, t3 = cmi(x1 - x3); X0 = t0 + t2; X1 = t1 + t3; X2 = t0 - t2; X3 = t1 - t3; }
__device__ __forceinline__ void dft8(cpx (&a)[8]) {
    const float R2 = 0.7071067811865476f; cpx e[4], o[4];
    dft4(a[0] + a[4], a[1] + a[5], a[2] + a[6], a[3] + a[7], e[0], e[1], e[2], e[3]);
    const cpx d1 = a[1] - a[5], d3 = a[3] - a[7];
    dft4(a[0] - a[4], (cpx){(d1.x + d1.y) * R2, (d1.y - d1.x) * R2}, cmi(a[2] - a[6]), (cpx){(d3.y - d3.x) * R2, -(d3.x + d3.y) * R2}, o[0], o[1], o[2], o[3]);
#pragma unroll
    for (int m = 0; m < 4; ++m) { a[2 * m] = e[m]; a[2 * m + 1] = o[m]; }
}
__device__ __forceinline__ void dft16(cpx (&a)[16]) {
    const float C1 = 0.9238795325112867f, S1 = 0.3826834323650898f, R2 = 0.7071067811865476f;
    cpx e[8], o[8];
#pragma unroll
    for (int k = 0; k < 8; ++k) { e[k] = a[k] + a[k + 8]; o[k] = a[k] - a[k + 8]; }
    o[1] = cmul(o[1], (cpx){C1, -S1}); o[2] = cmul(o[2], (cpx){R2, -R2}); o[3] = cmul(o[3], (cpx){S1, -C1}); o[4] = cmi(o[4]);
    o[5] = cmul(o[5], (cpx){-S1, -C1}); o[6] = cmul(o[6], (cpx){-R2, -R2}); o[7] = cmul(o[7], (cpx){-C1, -S1});
    dft8(e); dft8(o);
#pragma unroll
    for (int m = 0; m < 8; ++m) { a[2 * m] = e[m]; a[2 * m + 1] = o[m]; }
}
template <int R> __device__ __forceinline__ void cconj(cpx (&a)[R]) {
#pragma unroll
    for (int k = 0; k < R; ++k) a[k].y = -a[k].y; }
template <bool INV, bool ZU> __device__ __forceinline__ void hy_pass1(LAS cpx* X, const LAS cpx* TW, int tid) {
    cpx a[16]; const cpx w1 = TW[tid];
#pragma unroll
    for (int k = 0; k < 16; ++k) a[k] = (!INV && ZU && k >= 8) ? (cpx){0.f, 0.f} : X[hy_p(tid + 512 * k)];
    if (!INV) { dft16(a); cpx w = w1;
#pragma unroll
        for (int q = 1; q < 16; ++q) { a[q] = cmul(a[q], w); w = cmul(w, w1); }
    } else { cpx w = w1;
#pragma unroll
        for (int q = 1; q < 16; ++q) { a[q] = cmulc(a[q], w); w = cmul(w, w1); }
        cconj<16>(a); dft16(a); cconj<16>(a); }
#pragma unroll
    for (int k = 0; k < 16; ++k) if (!(INV && ZU && k >= 8)) X[hy_p(tid + 512 * k)] = a[k];
}
template <bool INV, int S, int MUL> __device__ __forceinline__ void hy_pass8(LAS cpx* X, const LAS cpx* TW, int tid) {
#pragma unroll
    for (int h = 0; h < 2; ++h) { const int bf = tid + 512 * h, sub = bf / S, j = bf % S, base = 8 * S * sub + j; cpx a[8]; const cpx w1 = TW[MUL * j];
#pragma unroll
        for (int k = 0; k < 8; ++k) a[k] = X[hy_p(base + S * k)];
        if (!INV) { dft8(a); cpx w = w1;
#pragma unroll
            for (int q = 1; q < 8; ++q) { a[q] = cmul(a[q], w); w = cmul(w, w1); }
        } else { cpx w = w1;
#pragma unroll
            for (int q = 1; q < 8; ++q) { a[q] = cmulc(a[q], w); w = cmul(w, w1); }
            cconj<8>(a); dft8(a); cconj<8>(a); }
#pragma unroll
        for (int k = 0; k < 8; ++k) X[hy_p(base + S * k)] = a[k]; }
}
__device__ __forceinline__ void hy_pass4(LAS cpx* X, int tid, const cpx* spec) {
#pragma unroll
    for (int h = 0; h < 2; ++h) { const int g = tid + 512 * h; cpx a[8];
#pragma unroll
        for (int k = 0; k < 8; ++k) a[k] = X[hy_p(8 * g + k)];
        dft8(a);
        if (spec) {
#pragma unroll
            for (int k2 = 0; k2 < 4; ++k2) { const f32x4 s4 = *(const GAS f32x4*)(spec + 8 * g + 2 * k2); a[2 * k2] = cmul(a[2 * k2], (cpx){s4.x, s4.y}); a[2 * k2 + 1] = cmul(a[2 * k2 + 1], (cpx){s4.z, s4.w}); }
            cconj<8>(a); dft8(a); cconj<8>(a); }
#pragma unroll
        for (int k = 0; k < 8; ++k) X[hy_p(8 * g + k)] = a[k]; }
}
__device__ __forceinline__ void hy_conv_fft(LAS cpx* X, const LAS cpx* TW, int tid, const cpx* spec) {
    hy_pass1<false, true>(X, TW, tid); __syncthreads();
    hy_pass8<false, 64, 16>(X, TW, tid); __syncthreads();
    hy_pass8<false, 8, 128>(X, TW, tid); __syncthreads();
    hy_pass4(X, tid, spec); __syncthreads();
    hy_pass8<true, 8, 128>(X, TW, tid); __syncthreads();
    hy_pass8<true, 64, 16>(X, TW, tid); __syncthreads();
    hy_pass1<true, true>(X, TW, tid); __syncthreads();
}

__device__ __forceinline__ void phase_hy_spec(Frame& F, int li) { WS_DECL; frame_refresh(F);
    LAS cpx* X = (LAS cpx*)(F.lds + HY_X); const LAS cpx* TW = (const LAS cpx*)(F.lds + HY_TW); LAS float* W3 = (LAS float*)(F.lds + HY_W3);
    const int tid = F.tid; const float* w3 = in_ptr(I_HW3) + (size_t)li * 64 * 1024; const float* H2 = WSP(float, WS_H2L) + (size_t)li * SEQ * 64; cpx* SPEC = WSP(cpx, WS_SPEC);
    __syncthreads();
    hy_build_tw(F);
    for (int item = blockIdx.x; item < 512; item += F.G) {
        const int o = item >> 8, ch = item & 255;
        __syncthreads();
        if (tid < 128) { const int dir = tid >> 6, j = tid & 63; W3[tid] = w3[(size_t)j * 1024 + o * 512 + dir * 256 + ch]; }
        __syncthreads();
        const float delta = hy_delta(ch);
#pragma unroll 1
        for (int i = 0; i < 8; ++i) { const int l = tid + 512 * i; const float* hr = H2 + (size_t)l * 64; float hf = 0.f, hb = 0.f;
#pragma unroll
            for (int j4 = 0; j4 < 16; ++j4) { const f32x4 h4 = *(const GAS f32x4*)(hr + 4 * j4);
                hf += h4.x * W3[4 * j4] + h4.y * W3[4 * j4 + 1] + h4.z * W3[4 * j4 + 2] + h4.w * W3[4 * j4 + 3]; hb += h4.x * W3[64 + 4 * j4] + h4.y * W3[64 + 4 * j4 + 1] + h4.z * W3[64 + 4 * j4 + 2] + h4.w * W3[64 + 4 * j4 + 3]; }
            const float win = (__expf(-((float)l * (1.f / 4095.f)) * delta) + 0.05f) * (1.f / 8192.f);
            X[hy_p(l)] = (cpx){hf * win, 0.f};
            if (l == 0) X[hy_p(4096)] = (cpx){0.f, 0.f}; else X[hy_p(8192 - l)] = (cpx){hb * win, 0.f}; }
        __syncthreads();
        hy_pass1<false, false>(X, TW, tid); __syncthreads();
        hy_pass8<false, 64, 16>(X, TW, tid); __syncthreads();
        hy_pass8<false, 8, 128>(X, TW, tid); __syncthreads();
        hy_pass4(X, tid, nullptr); __syncthreads();
        cpx* dst = SPEC + (size_t)item * 8192;
#pragma unroll
        for (int i = 0; i < 16; ++i) *(GAS cpx*)(dst + tid + 512 * i) = X[hy_p(tid + 512 * i)];
    }
    __syncthreads();
}

__device__ __forceinline__ void hy_conv8(const bf16* row, int t0, int Ls, float w0, float w1, float w2, float bias, float (&out)[8]) {
    const v4u raw = *(const GAS v4u*)(row + t0); float p[10];
    p[0] = t0 > 0 ? bf2f(row[t0 - 1]) : 0.f; p[9] = t0 + 8 < Ls ? bf2f(row[t0 + 8]) : 0.f;
    p[1] = bflo(raw.x); p[2] = bfhi(raw.x); p[3] = bflo(raw.y); p[4] = bfhi(raw.y); p[5] = bflo(raw.z); p[6] = bfhi(raw.z); p[7] = bflo(raw.w); p[8] = bfhi(raw.w);
#pragma unroll
    for (int e = 0; e < 8; ++e) out[e] = bias + w0 * p[e] + w1 * p[e + 1] + w2 * p[e + 2];
}

__device__ __forceinline__ void phase_hy_conv(Frame& F, int li) { WS_DECL; frame_refresh(F);
    LAS cpx* X = (LAS cpx*)(F.lds + HY_X); const LAS cpx* TW = (const LAS cpx*)(F.lds + HY_TW);
    const int tid = F.tid; const bf16* HT = WSP(bf16, WS_HT); bf16* HOT = WSP(bf16, WS_HOT); const cpx* SPEC = WSP(cpx, WS_SPEC);
    const float* cw = in_ptr(I_HCW) + li * 3 * 768; const float* cb = in_ptr(I_HCB) + li * 768; const float* dsk = in_ptr(I_HD) + li * 512;
    __syncthreads();
    hy_build_tw(F);
    for (int item = blockIdx.x; item < 2048; item += F.G) {
        const int ch = item >> 3, bp = item & 7; const int t0 = 8 * tid;
        float v[2][8], x1[2][8], x2[2][8];
#pragma unroll
        for (int q = 0; q < 2; ++q) { const size_t boff = (size_t)(2 * bp + q) * SEQ;
            hy_conv8(HT + (size_t)ch * NT + boff, t0, SEQ, cw[ch], cw[768 + ch], cw[1536 + ch], cb[ch], v[q]);
            hy_conv8(HT + (size_t)(256 + ch) * NT + boff, t0, SEQ, cw[256 + ch], cw[768 + 256 + ch], cw[1536 + 256 + ch], cb[256 + ch], x1[q]);
            hy_conv8(HT + (size_t)(512 + ch) * NT + boff, t0, SEQ, cw[512 + ch], cw[768 + 512 + ch], cw[1536 + 512 + ch], cb[512 + ch], x2[q]); }
        const float d0 = dsk[ch], d1 = dsk[256 + ch];
        __syncthreads();
#pragma unroll
        for (int e = 0; e < 8; ++e) X[hy_p(t0 + e)] = (cpx){v[0][e], v[1][e]};
        __syncthreads();
        hy_conv_fft(X, TW, tid, SPEC + (size_t)ch * 8192);
        float u[2][8];
#pragma unroll
        for (int e = 0; e < 8; ++e) { const cpx y = X[hy_p(t0 + e)]; u[0][e] = x1[0][e] * (y.x + v[0][e] * d0); u[1][e] = x1[1][e] * (y.y + v[1][e] * d0); X[hy_p(t0 + e)] = (cpx){u[0][e], u[1][e]}; }
        __syncthreads();
        hy_conv_fft(X, TW, tid, SPEC + (size_t)(256 + ch) * 8192);
#pragma unroll
        for (int q = 0; q < 2; ++q) { float o[8];
#pragma unroll
            for (int e = 0; e < 8; ++e) { const cpx y = X[hy_p(t0 + e)]; o[e] = x2[q][e] * ((q == 0 ? y.x : y.y) + u[q][e] * d1); }
            v4u w; w.x = pk2(o[0], o[1]); w.y = pk2(o[2], o[3]); w.z = pk2(o[4], o[5]); w.w = pk2(o[6], o[7]);
            *(GAS v4u*)(HOT + (size_t)ch * NT + (size_t)(2 * bp + q) * SEQ + t0) = w; }
    }
    __syncthreads();
}

__device__ __forceinline__ void phase_hy_ctx(Frame& F, int li) { WS_DECL; frame_refresh(F);
    LAS float* KF = (LAS float*)F.lds;
    LAS float* SIG = KF + 1024;
    LAS float* W3 = KF + 2048;
    const int tid = F.tid; const bf16* HT = WSP(bf16, WS_HT); bf16* HOT = WSP(bf16, WS_HOT);
    const float* w3 = in_ptr(I_HW3) + (size_t)li * 64 * 1024; const float* H2 = WSP(float, WS_H2C) + (size_t)li * LCX * 64;
    const float* cw = in_ptr(I_HCW) + li * 3 * 768; const float* cb = in_ptr(I_HCB) + li * 768; const float* dsk = in_ptr(I_HD) + li * 512;
    for (int ch = blockIdx.x; ch < 256; ch += F.G) {
        __syncthreads();
        if (tid < 256) { const int od = tid >> 6, j = tid & 63; W3[tid] = w3[(size_t)j * 1024 + (od >> 1) * 512 + (od & 1) * 256 + ch]; }
        __syncthreads();
        { const int o = tid >> 8, l = tid & 255; const float* hr = H2 + (size_t)l * 64; float hf = 0.f, hb = 0.f;
          for (int j = 0; j < 64; ++j) { const float hv = hr[j]; hf += hv * W3[(2 * o) * 64 + j]; hb += hv * W3[(2 * o + 1) * 64 + j]; }
          const float win = __expf(-((float)l * (1.f / 255.f)) * hy_delta(ch)) + 0.05f;
          KF[(2 * o) * 256 + l] = hf * win; KF[(2 * o + 1) * 256 + l] = hb * win; }
        __syncthreads();
        const int q = tid >> 8, t = tid & 255; const float d0 = dsk[ch], d1 = dsk[256 + ch];
        for (int bp = 0; bp < 8; ++bp) { const int b = 2 * bp + q; const size_t off = (size_t)NL + (size_t)b * LCX;
            float zz[3];
#pragma unroll
            for (int k = 0; k < 3; ++k) { const int c = 256 * k + ch; const bf16* row = HT + (size_t)c * NT + off;
                const float pm = t > 0 ? bf2f(row[t - 1]) : 0.f, p0 = bf2f(row[t]), pp = t + 1 < LCX ? bf2f(row[t + 1]) : 0.f;
                zz[k] = cb[c] + cw[c] * pm + cw[768 + c] * p0 + cw[1536 + c] * pp; }
            SIG[q * 256 + t] = zz[0];
            __syncthreads();
            float y = 0.f;
            for (int s = 0; s < 256; ++s) { const int lag = t - s; const float kv = lag >= 0 ? KF[lag] : KF[256 - lag]; y += kv * SIG[q * 256 + s]; }
            const float u = zz[1] * (y + zz[0] * d0);
            __syncthreads();
            SIG[q * 256 + t] = u;
            __syncthreads();
            float y2 = 0.f;
            for (int s = 0; s < 256; ++s) { const int lag = t - s; const float kv = lag >= 0 ? KF[512 + lag] : KF[768 - lag]; y2 += kv * SIG[q * 256 + s]; }
            HOT[(size_t)ch * NT + off + t] = (bf16)f2bf(zz[2] * (y2 + u * d1));
            __syncthreads();
        }
    }
    __syncthreads();
}

constexpr int HF_LD = 72;
__device__ __forceinline__ void phase_fin_hyena(Frame& F, int li) { WS_DECL; frame_refresh(F);
    LAS bf16* T = (LAS bf16*)F.lds;
    const int nrows = li == DEPTH - 1 ? NL : NT; const int tid = F.tid, lane = F.lane, wave = F.wave; const bf16* HOT = WSP(bf16, WS_HOT); bf16* MIX = WSP(bf16, WS_A1);
    const f32x4 g4 = *(const GAS f32x4*)(in_ptr(I_HON) + li * 256 + 4 * lane);
    for (int item = blockIdx.x; item < nrows / 64; item += F.G) { const int m0 = item * 64;
        __syncthreads();
        { const int ch = tid >> 1, hf = tid & 1; const bf16* src = HOT + (size_t)ch * NT + m0 + 32 * hf;
#pragma unroll
          for (int k = 0; k < 4; ++k) *(LAS v4u*)(T + ch * HF_LD + 32 * hf + 8 * k) = *(const GAS v4u*)(src + 8 * k); }
        __syncthreads();
        for (int i = 0; i < 8; ++i) { const int tl = wave * 8 + i;
            f32x4 x; x.x = bf2f(T[(4 * lane) * HF_LD + tl]); x.y = bf2f(T[(4 * lane + 1) * HF_LD + tl]); x.z = bf2f(T[(4 * lane + 2) * HF_LD + tl]); x.w = bf2f(T[(4 * lane + 3) * HF_LD + tl]);
            const float r = __builtin_amdgcn_rsqf(wave_sum(x.x * x.x + x.y * x.y + x.z * x.z + x.w * x.w) * (1.f / 256.f) + 1e-6f);
            v2u o; o.x = pk2(x.x * r * g4.x, x.y * r * g4.y); o.y = pk2(x.z * r * g4.z, x.w * r * g4.w); *(GAS v2u*)(MIX + (size_t)(m0 + tl) * D + 768 + 4 * lane) = o; }
    }
    __syncthreads();
}
#define MIX_HYENA 1

#define GRID_BAR() do { XcdBarrier bar_; bar_.leader = (F.wave == 0 && mk_lane() == 0); bar_.bar = (unsigned*)(ws_ptr() + WS_CTL) + CW_BAR; bar_.x = xb_xcc_id(); bar_.st = (volatile LAS unsigned*)(F.lds + LDSCTL_OFF) + 8; xcd_barrier(bar_); } while (0)

template <int li>
__device__ __forceinline__ void layer_fwd(Frame& F) {
        const int nrows = li == DEPTH - 1 ? NL : NT; unsigned char* const ws = ws_ptr();
        phase_hy_spec(F, li);
        { pg8::Gemm g{WSP(bf16, WS_A1), WSP(bf16, WS_WINT) + (size_t)li * PCOLS * D, NT, PCOLS, D, WSP(bf16, WS_WHYT) + (size_t)li * HYC * D, WSP(bf16, WS_A1)};
          pg8::DualOrder S; S.init(NT, PCOLS, HYC, NT, F.G, (int)blockIdx.x);
          pg8::EpiStore2 E{WSP(bf16, WS_P), PCOLS, WSP(bf16, WS_HT), NT};
          pg8::gemm_phase<pg8::EpiStore2, pg8::DualOrder, true, true>(F.lds, g, S, E, F.wave); }
        GRID_BAR();
        phase_rwkv_r0(F, li);
        phase_mla_prep(F, li);
        phase_lru<1>(F, li);
        __syncthreads();
        phase_hy_conv(F, li);
        if (li < DEPTH - 1) phase_hy_ctx(F, li);
        GRID_BAR();
        phase_rwkv_scan(F, li);
        __syncthreads();
        phase_attn(F, li);
        __syncthreads();
        phase_lru<3>(F, li);
        GRID_BAR();
        phase_fin_mla(F, li);
        phase_fin_rwkv(F, li); phase_fin_hyena(F, li);
        GRID_BAR();
        { pg8::Gemm g{WSP(bf16, WS_A1), WSP(bf16, WS_WOUTT) + (size_t)li * D * D, nrows, D, D}; pg8::StaticOrder S; S.init(nrows, D, F.G, (int)blockIdx.x);
          pg8::EpiStore E{WSP(bf16, WS_Y), D, 0, D / 256};
          pg8::gemm_phase<pg8::EpiStore, pg8::StaticOrder, true, true>(F.lds, g, S, E, F.wave); }
        GRID_BAR();
        phase_ln1<true>(F, li);
        if (li & 1) phase_moe_weights(F, li);
        GRID_BAR();
        if (!(li & 1)) {
            const int j = li >> 1;
            { pg8::Gemm g{(const pg8::bf16_t*)WSP(unsigned char, WS_A1), (const pg8::bf16_t*)(WSP(unsigned char, WS_WGUT) + (size_t)j * 2 * FFD * D), nrows, 2 * FFD, D / 2}; pg8::StaticOrder S; S.init(nrows, 2 * FFD, F.G, (int)blockIdx.x);
              pg8::EpiSwiGLU E{WSP(bf16, WS_H), FFD, 0, 2 * FFD / 256};
              pg8::gemm_phase<pg8::EpiSwiGLU, pg8::StaticOrder, true, true, true, 124>(F.lds, g, S, E, F.wave); }
            GRID_BAR();
            { pg8::Gemm g{WSP(bf16, WS_H), WSP(bf16, WS_WDT) + (size_t)j * D * FFD, nrows, D, FFD}; pg8::StaticOrder S; S.init(nrows, D, F.G, (int)blockIdx.x);
              pg8::EpiStore E{WSP(bf16, WS_Y), D, 0, D / 256};
              pg8::gemm_phase<pg8::EpiStore, pg8::StaticOrder, true, true>(F.lds, g, S, E, F.wave); }
            GRID_BAR();
        } else {
            phase_moe_slots(F, li);
            GRID_BAR();
            const int ntiles = __builtin_amdgcn_readfirstlane(((LAS int*)(F.lds + LDS_MOEI))[48]);
            const PG8_LAS unsigned char* tile_e = (const PG8_LAS unsigned char*)(F.lds + LDS_TILEE);
#pragma unroll 1
            for (int ch = 0; ch < MOE_NCHUNK; ++ch) {
                const int t0 = ch * MOE_CHUNK_TILES; int nM = ntiles - t0; nM = nM < 0 ? 0 : (nM > MOE_CHUNK_TILES ? MOE_CHUNK_TILES : nM);
                { pg8::Gemm g{(const pg8::bf16_t*)WSP(unsigned char, WS_XS8), (const pg8::bf16_t*)WSP(unsigned char, WS_M8GU), 0, 0, D / 2}; pg8::MoeOrder S; S.init(nM, 2 * FFE / 256, F.G, (int)blockIdx.x, t0, t0, tile_e);
                  pg8::EpiSwiGLU8 E{WSP(unsigned char, WS_HM8), FFE, t0, 2 * FFE / 256};
                  pg8::gemm_phase<pg8::EpiSwiGLU8, pg8::MoeOrder, true, true, true, 124>(F.lds, g, S, E, F.wave); }
                GRID_BAR();
                { pg8::Gemm g{(const pg8::bf16_t*)WSP(unsigned char, WS_HM8), (const pg8::bf16_t*)WSP(unsigned char, WS_M8D), 0, 0, FFE / 2}; pg8::MoeOrder S; S.init(nM, D / 256, F.G, (int)blockIdx.x, t0, 0, tile_e);
                  pg8::EpiStore E{WSP(bf16, WS_Y2), D, t0, D / 256};
                  pg8::gemm_phase<pg8::EpiStore, pg8::MoeOrder, true, true, true, 123>(F.lds, g, S, E, F.wave); }
                GRID_BAR();
            }
        }
        phase_ln2<true>(F, li);
        if (li < DEPTH - 1) GRID_BAR();
}

__global__ void __launch_bounds__(NTHR, 2) mk_fwd(Args a) {
    extern __shared__ __attribute__((aligned(16))) unsigned char lds_raw[];
    Frame F; F.lds = (LAS unsigned char*)lds_raw; F.tid = threadIdx.x; F.lane = F.tid & 63; F.wave = __builtin_amdgcn_readfirstlane(F.tid >> 6); F.G = gridDim.x;
    for (int u = F.tid; u < (LDS_BYTES - LDSCTL_OFF) / 4; u += NTHR) ((LAS unsigned*)(F.lds + LDSCTL_OFF))[u] = 0u;
    __syncthreads();
    (void)xcd_barrier_post((unsigned*)(ws_ptr() + WS_CTL) + CW_BAR, (volatile LAS unsigned*)(F.lds + LDSCTL_OFF) + 8, F.tid == 0);

    phase_pro0(F);
    phase_pro0b(F);
    phase_pro0c(F);
    phase_pro0d(F);
    phase_pro0e(F);
    GRID_BAR();
    phase_hin0(F);
    GRID_BAR();
    layer_fwd<0>(F); layer_fwd<1>(F); layer_fwd<2>(F); layer_fwd<3>(F);
}

extern "C" void kernel_launch(void* const* d_in, const int* in_sizes, int n_in, void* d_out, int out_size, void* d_ws, size_t ws_size, hipStream_t stream) {
    static int grid = 0;
    if (grid == 0) {
        if (n_in != N_INPUTS || out_size != NL * D || ws_size < WS_END) { fprintf(stderr, "kernel_launch: unexpected shapes (n_in %d out %d ws %zu)\n", n_in, out_size, ws_size); grid = -1; return; }
        int dev = 0, cus = 0, per_cu = 0;
        if (hipGetDevice(&dev) != hipSuccess || hipDeviceGetAttribute(&cus, hipDeviceAttributeMultiprocessorCount, dev) != hipSuccess) { grid = -1; return; }
        if (hipFuncSetAttribute((const void*)mk_fwd, hipFuncAttributeMaxDynamicSharedMemorySize, LDS_BYTES) != hipSuccess) { fprintf(stderr, "kernel_launch: hipFuncSetAttribute failed\n"); grid = -1; return; }
        if (hipOccupancyMaxActiveBlocksPerMultiprocessor(&per_cu, (const void*)mk_fwd, NTHR, LDS_BYTES) != hipSuccess || per_cu < 1) fprintf(stderr, "kernel_launch: occupancy query reports %d\n", per_cu);
        (void)hipGetLastError();
        grid = cus > 256 ? 256 : cus;
    }
    if (grid < 0) return;
    if (hipMemsetAsync((char*)d_ws + WS_CTL, 0, CTL_ZERO_BYTES, stream) != hipSuccess) return;
    Args a{};
    for (int i = 0; i < N_INPUTS; ++i) a.in[i] = (const float*)d_in[i];
    a.out = (float*)d_out; a.ws = (unsigned char*)d_ws;
    hipLaunchKernelGGL(mk_fwd, dim3(grid), dim3(NTHR), LDS_BYTES, stream, a);
    const hipError_t le = hipPeekAtLastError();
    if (le != hipSuccess) fprintf(stderr, "kernel_launch: launch failed: %s\n", hipGetErrorName(le));
}
```

```cpp
#include <hip/hip_runtime.h>
#include <cstdio>
#include <cstdint>
#define GAS __attribute__((address_space(1)))
#define LAS __attribute__((address_space(3)))
__device__ __forceinline__ int mk_lane() { int l; asm volatile("v_mbcnt_lo_u32_b32 %0, -1, 0\n\tv_mbcnt_hi_u32_b32 %0, -1, %0" : "=v"(l)); return l; }
namespace pg8 {
#define PG8_LAS __attribute__((address_space(3)))
typedef unsigned short bf16_t;
typedef short bf16x8 __attribute__((ext_vector_type(8)));
typedef float f32x4 __attribute__((ext_vector_type(4)));
typedef unsigned u32x4 __attribute__((ext_vector_type(4)));
constexpr int BM = 256, BK = 64, HALF = 128, HTB = HALF * BK * 2  , STAGE_BYTES = 8 * HTB, NXCD = 8, WGM = 8;

__host__ __device__ __forceinline__ int lds_byte(int r, int c) { const int st = (r >> 4) * 2 + (c >> 5), rr = r & 15, cc = c & 31, ob = rr * 64 + cc * 2; return st * 1024 + (ob ^ (((ob >> 9) & 1) << 5)); }
__host__ __device__ __forceinline__ void stage_rc(int b, int& R, int& C) { const int st = b / 1024, sb = b % 1024, swz = sb ^ (((sb >> 9) & 1) << 5); R = (st >> 1) * 16 + swz / 64; C = (st & 1) * 32 + (swz % 64) / 2; }
__host__ __device__ __forceinline__ int perm32(int rho) { const int n = rho >> 4, i = rho & 15; return 8 * (i >> 2) + 4 * n + (i & 3); }

struct Unit { int pm, pn, g; };
struct Gemm { const bf16_t* A; const bf16_t* Bt; int M, N, K; const bf16_t* A2 = nullptr; const bf16_t* Bt2 = nullptr; };

struct StaticOrder {
    int nM, nN, nwg, G, c;
    __host__ __device__ void init(int M, int N, int G_, int c_) { nM = M / BM; nN = N / BM; nwg = nM * nN; G = G_; c = c_; }
    __host__ __device__ bool next(int i, Unit& u) const {
        const long L = (long)i * G + c; if (L >= nwg) return false;
        int wgid = (int)L; { const int q = nwg / NXCD, r = nwg % NXCD, xcd = wgid % NXCD, off = wgid / NXCD; wgid = (xcd < r ? xcd * (q + 1) : r * (q + 1) + (xcd - r) * q) + off; }
        const int nig = WGM * nN, gid = wgid / nig, fm = gid * WGM, gsz = (nM - fm) < WGM ? (nM - fm) : WGM;
        u.pm = fm + ((wgid % nig) % gsz); u.pn = (wgid % nig) / gsz; u.g = 0; return true;
    }
    __device__ __forceinline__ void a_ready(const Unit&) const {}
    __device__ __forceinline__ void done(const Unit&) const {}
};

__device__ __forceinline__ unsigned cvt_pk_bf16(float lo, float hi) { unsigned r; asm volatile("v_cvt_pk_bf16_f32 %0, %1, %2" : "=v"(r) : "v"(lo), "v"(hi)); return r; }
typedef float f32x2 __attribute__((ext_vector_type(2)));
__device__ __forceinline__ f32x2 gelu_pk(f32x2 v) {
    const f32x2 av = __builtin_elementwise_abs(v), d = av * 0.2316418882f + 1.0f;
    f32x2 t; t.x = __builtin_amdgcn_rcpf(d.x); t.y = __builtin_amdgcn_rcpf(d.y);
    f32x2 q = t * 0.5307027145f + (-0.7265760135f); q = q * t + 0.7107068705f; q = q * t + (-0.142248368f); q = q * t + 0.127414796f; q = q * t;
    const f32x2 s = (v * v) * (-0.72134752044f);
    f32x2 e; e.x = __builtin_amdgcn_exp2f(s.x); e.y = __builtin_amdgcn_exp2f(s.y);
    const f32x2 m = v * (q * e), r = v - m;
    f32x2 o; o.x = v.x < 0.f ? m.x : r.x; o.y = v.y < 0.f ? m.y : r.y; return o;
}

template <int ACT  > struct EpiBf16 {
    static constexpr bool PERM = true, AFTER_DRAIN = false; static_assert(ACT == 0 || ACT == 1, "EpiBf16: ACT is 0 (none) or 1 (gelu_pk)");
    bf16_t* O; int ldc; const float* bias; int split_cols; size_t split_stride; float scale0;
    __device__ __forceinline__ void operator()(const f32x4 (&acc)[2][2][4][2], const Unit& u, int wr, int wc, int fr, int fq) const {
        const int row0 = u.pm * BM + wr * 64 + fr; int colt = u.pn * BM; bf16_t* base = O;
        float sc = 1.f; if (split_cols) { const int t = colt / split_cols; base += (size_t)t * split_stride; colt -= t * split_cols; if (t == 0) sc = scale0; }
        const int col0 = colt + wc * 32 + 8 * fq, bcol0 = u.pn * BM + wc * 32 + 8 * fq;
        f32x4 bv[2][2];
#pragma unroll
        for (int bj = 0; bj < 2; ++bj)
#pragma unroll
            for (int n = 0; n < 2; ++n) bv[bj][n] = bias ? *(const f32x4*)(bias + bcol0 + bj * HALF + 4 * n) : (f32x4){0.f, 0.f, 0.f, 0.f};
#pragma unroll
        for (int ai = 0; ai < 2; ++ai)
#pragma unroll
            for (int m = 0; m < 4; ++m) { bf16_t* rowp = base + (size_t)(row0 + ai * HALF + m * 16) * ldc + col0;
#pragma unroll
                for (int bj = 0; bj < 2; ++bj) { f32x4 v0 = acc[ai][bj][m][0] + bv[bj][0], v1 = acc[ai][bj][m][1] + bv[bj][1];
                    if (ACT == 1) { f32x2 a = gelu_pk((f32x2){v0[0], v0[1]}), b = gelu_pk((f32x2){v0[2], v0[3]}), c = gelu_pk((f32x2){v1[0], v1[1]}), d = gelu_pk((f32x2){v1[2], v1[3]});
                        v0 = (f32x4){a.x, a.y, b.x, b.y}; v1 = (f32x4){c.x, c.y, d.x, d.y}; }
                    v0 = v0 * sc; v1 = v1 * sc; u32x4 w; w.x = cvt_pk_bf16(v0[0], v0[1]); w.y = cvt_pk_bf16(v0[2], v0[3]); w.z = cvt_pk_bf16(v1[0], v1[1]); w.w = cvt_pk_bf16(v1[2], v1[3]);
                    *(u32x4*)(rowp + bj * HALF) = w; } }
    }
};
typedef int pg8_v8i __attribute__((ext_vector_type(8))); typedef int pg8_v4i __attribute__((ext_vector_type(4)));
__device__ __forceinline__ pg8_v8i pg8_cat8(bf16x8 a, bf16x8 b) { return __builtin_shufflevector(__builtin_bit_cast(pg8_v4i, a), __builtin_bit_cast(pg8_v4i, b), 0, 1, 2, 3, 4, 5, 6, 7); }
template <class Epi, class Sched, bool ALIGN_EPI = false, bool SP2 = false, bool F8 = false, int WSCALE = 127>
__device__ __forceinline__ void gemm_phase(PG8_LAS unsigned char* lds, const Gemm g, const Sched& S, const Epi& E, int wave_idx) {
    int tid_ = wave_idx * 64 + mk_lane(); asm volatile("" : "+v"(tid_));
    const int tid = tid_, wid = __builtin_amdgcn_readfirstlane(tid >> 6), lane = tid & 63, wr = wid >> 2, wc = wid & 3, fr = lane & 15, fq = lane >> 4;
    const int K = g.K, nt = K / BK;
    unsigned voffA[2], voffB[2];
#pragma unroll
    for (int i = 0; i < 2; ++i) { int R, C; stage_rc(tid * 16 + i * 8192, R, C); const int Rb = Epi::PERM ? ((R & ~31) + perm32(R & 31)) : R;
        voffA[i] = (unsigned)(R * K + C) * 2u; voffB[i] = (unsigned)(Rb * K + C) * 2u; }
    const size_t kstep = (size_t)(BK * 2);
    const size_t hstep = (size_t)HALF * K * 2;
    const size_t tstep = 2 * hstep;
    const unsigned ldsw = (unsigned)wid * 1024u;
    int aoffk[2], boffk[2];
    if constexpr (F8) { aoffk[0] = lds_byte(wr * 64 + fr, (2 * (fq & 1)) * 8) + (fq >> 1) * 1024; aoffk[1] = lds_byte(wr * 64 + fr, (2 * (fq & 1) + 1) * 8) + (fq >> 1) * 1024;
        boffk[0] = lds_byte(wc * 32 + fr, (2 * (fq & 1)) * 8) + (fq >> 1) * 1024; boffk[1] = lds_byte(wc * 32 + fr, (2 * (fq & 1) + 1) * 8) + (fq >> 1) * 1024; }
    else { aoffk[0] = lds_byte(wr * 64 + fr, fq * 8); aoffk[1] = aoffk[0] + 1024; boffk[0] = lds_byte(wc * 32 + fr, fq * 8); boffk[1] = boffk[0] + 1024; }
#define PG8_SA(b, h) (((b) * 2 + (h)) * HTB)
#define PG8_SB(b, h) ((4 + (b) * 2 + (h)) * HTB)
#define PG8_STAGE(bufoff, gbase, voff) do { const char* gb_ = (const char*)(gbase); _Pragma("unroll") for (int _i = 0; _i < 2; ++_i) { unsigned keep_; \
        asm volatile("s_mov_b32 %0, m0\n\ts_mov_b32 m0, %2\n\ts_nop 0\n\tglobal_load_lds_dwordx4 %1, %3\n\ts_mov_b32 m0, %0" : "=&s"(keep_) : "v"((voff)[_i]), "s"((unsigned)(size_t)(lds + (bufoff) + ldsw + _i * 8192)), "s"(gb_) : "memory"); } } while (0)
#define PG8_LDA(dst, b, h) do { if constexpr (F8) { _Pragma("unroll") for (int m = 0; m < 4; ++m) dst##8[m] = *(const PG8_LAS pg8_v8i*)(lds + PG8_SA(b, h) + aoffk[0] + m * 2048); } else { _Pragma("unroll") for (int m = 0; m < 4; ++m) _Pragma("unroll") for (int k = 0; k < 2; ++k) dst[m][k] = *(const PG8_LAS bf16x8*)(lds + PG8_SA(b, h) + aoffk[k] + m * 2048); } } while (0)
#define PG8_LDB(dst, b, h) do { if constexpr (F8) { _Pragma("unroll") for (int n = 0; n < 2; ++n) dst##8[n] = *(const PG8_LAS pg8_v8i*)(lds + PG8_SB(b, h) + boffk[0] + n * 2048); } else { _Pragma("unroll") for (int n = 0; n < 2; ++n) _Pragma("unroll") for (int k = 0; k < 2; ++k) dst[n][k] = *(const PG8_LAS bf16x8*)(lds + PG8_SB(b, h) + boffk[k] + n * 2048); } } while (0)
#define PG8_MMA(ai, bj, At, Bt) do { __builtin_amdgcn_s_setprio(1); _Pragma("unroll") for (int m = 0; m < 4; ++m) _Pragma("unroll") for (int n = 0; n < 2; ++n) { \
        if constexpr (F8) acc[ai][bj][m][n] = __builtin_amdgcn_mfma_scale_f32_16x16x128_f8f6f4(Bt##8[n], At##8[m], acc[ai][bj][m][n], 0, 0, 0, wsc_, 0, wsc_);     \
        else { _Pragma("unroll") for (int k = 0; k < 2; ++k) acc[ai][bj][m][n] = __builtin_amdgcn_mfma_f32_16x16x32_bf16(Bt[n][k], At[m][k], acc[ai][bj][m][n], 0, 0, 0); } } __builtin_amdgcn_s_setprio(0); } while (0)
#define PG8_WAIT_V(n) asm volatile("s_waitcnt vmcnt(" #n ")" ::: "memory")
#define PG8_WAIT_L(n) asm volatile("s_waitcnt lgkmcnt(" #n ")" ::: "memory")
#define PG8_BAR __builtin_amdgcn_s_barrier()
#define PG8_SCHED __builtin_amdgcn_sched_barrier(0)
    int wsc_ = WSCALE; asm volatile("" : "+v"(wsc_));
    Unit cur, nxt; int ui = 0;
    if (!S.next(0, cur)) return;
    f32x4 acc[2][2][4][2];
#pragma unroll
    for (int a = 0; a < 2; ++a)
#pragma unroll
        for (int b = 0; b < 2; ++b)
#pragma unroll
            for (int m = 0; m < 4; ++m)
#pragma unroll
                for (int n = 0; n < 2; ++n) acc[a][b][m][n] = (f32x4){0.f, 0.f, 0.f, 0.f};
    bf16x8 At[4][2], B0[2][2], B1[2][2];
    pg8_v8i At8[4], B08[2], B18[2];
    const char* cA = (const char*)(cur.g ? g.A2 : g.A) + (size_t)cur.pm * tstep; const char* cB = (const char*)(cur.g ? g.Bt2 : g.Bt) + (size_t)cur.pn * tstep;
    S.a_ready(cur);
    if constexpr (SP2) {
        PG8_STAGE(PG8_SB(0, 0), cB, voffB); PG8_STAGE(PG8_SB(0, 1), cB + hstep, voffB); PG8_STAGE(PG8_SA(0, 0), cA, voffA); PG8_STAGE(PG8_SA(0, 1), cA + hstep, voffA);
        if (wr == 1) PG8_BAR;
        PG8_WAIT_V(2); PG8_BAR;
        PG8_STAGE(PG8_SB(1, 0), cB + kstep, voffB); PG8_STAGE(PG8_SA(1, 0), cA + kstep, voffA); PG8_STAGE(PG8_SB(1, 1), cB + hstep + kstep, voffB);
        PG8_WAIT_V(6); PG8_BAR;
    } else {
        PG8_STAGE(PG8_SB(0, 0), cB, voffB); PG8_STAGE(PG8_SA(0, 0), cA, voffA); PG8_STAGE(PG8_SB(0, 1), cB + hstep, voffB); PG8_STAGE(PG8_SA(0, 1), cA + hstep, voffA);
        if (wr == 1) PG8_BAR;
        PG8_WAIT_V(4); PG8_BAR;
        PG8_STAGE(PG8_SB(1, 0), cB + kstep, voffB); PG8_STAGE(PG8_SA(1, 0), cA + kstep, voffA); PG8_STAGE(PG8_SB(1, 1), cB + hstep + kstep, voffB);
        PG8_WAIT_V(6); PG8_BAR;
    }
    for (;;) {
        const bool has_next = S.next(ui + 1, nxt);
        const char* nA = has_next ? (const char*)(nxt.g ? g.A2 : g.A) + (size_t)nxt.pm * tstep : cA; const char* nB = has_next ? (const char*)(nxt.g ? g.Bt2 : g.Bt) + (size_t)nxt.pn * tstep : cB;
#pragma unroll 1
        for (int t = 0; t < nt; t += 2) {
            const bool last = (t == nt - 2);
            const char* a1 = cA + (size_t)(t + 1) * kstep;
            const char* a2 = last ? nA : cA + (size_t)(t + 2) * kstep; const char* b2 = last ? nB : cB + (size_t)(t + 2) * kstep;
            const char* a3 = a2 + kstep; const char* b3 = b2 + kstep;
            if (last && has_next) S.a_ready(nxt);
            if constexpr (SP2) {
            PG8_LDB(B0, 0, 0); PG8_LDB(B1, 0, 1); PG8_SCHED; PG8_LDA(At, 0, 0); PG8_STAGE(PG8_SA(1, 1), a1 + hstep, voffA);
            PG8_WAIT_V(8); PG8_WAIT_L(0); PG8_BAR; PG8_MMA(0, 0, At, B0); PG8_MMA(0, 1, At, B1); PG8_BAR; PG8_SCHED;
            PG8_LDA(At, 0, 1); PG8_STAGE(PG8_SB(0, 0), b2, voffB); PG8_STAGE(PG8_SB(0, 1), b2 + hstep, voffB); PG8_STAGE(PG8_SA(0, 0), a2, voffA);
            PG8_WAIT_V(8); PG8_WAIT_L(0); PG8_BAR; PG8_MMA(1, 0, At, B0); PG8_MMA(1, 1, At, B1); PG8_BAR; PG8_SCHED;
            PG8_LDB(B0, 1, 0); PG8_LDB(B1, 1, 1); PG8_SCHED; PG8_LDA(At, 1, 0); PG8_STAGE(PG8_SA(0, 1), a2 + hstep, voffA);
            PG8_WAIT_V(8); PG8_WAIT_L(0); PG8_BAR; PG8_MMA(0, 0, At, B0); PG8_MMA(0, 1, At, B1); PG8_BAR; PG8_SCHED;
            PG8_LDA(At, 1, 1); PG8_STAGE(PG8_SB(1, 0), b3, voffB); PG8_STAGE(PG8_SB(1, 1), b3 + hstep, voffB); PG8_STAGE(PG8_SA(1, 0), a3, voffA);
            PG8_WAIT_V(8); PG8_WAIT_L(0); PG8_BAR; PG8_MMA(1, 0, At, B0); PG8_MMA(1, 1, At, B1); PG8_BAR; PG8_SCHED;
            } else {
            PG8_LDB(B0, 0, 0); PG8_SCHED; PG8_LDA(At, 0, 0); PG8_STAGE(PG8_SA(1, 1), a1 + hstep, voffA);
            PG8_WAIT_L(8); PG8_BAR; PG8_WAIT_L(0); PG8_MMA(0, 0, At, B0); PG8_BAR; PG8_SCHED;
            PG8_LDB(B1, 0, 1); PG8_STAGE(PG8_SB(0, 0), b2, voffB);
            PG8_BAR; PG8_WAIT_L(0); PG8_MMA(0, 1, At, B1); PG8_BAR;
            PG8_LDA(At, 0, 1); PG8_STAGE(PG8_SA(0, 0), a2, voffA);
            PG8_BAR; PG8_WAIT_L(0); PG8_MMA(1, 0, At, B0); PG8_BAR; PG8_SCHED;
            PG8_STAGE(PG8_SB(0, 1), b2 + hstep, voffB);
            PG8_WAIT_V(6); PG8_BAR; PG8_MMA(1, 1, At, B1); PG8_BAR;
            PG8_LDB(B0, 1, 0); PG8_SCHED; PG8_LDA(At, 1, 0); PG8_STAGE(PG8_SA(0, 1), a2 + hstep, voffA);
            PG8_WAIT_L(8); PG8_BAR; PG8_WAIT_L(0); PG8_MMA(0, 0, At, B0); PG8_BAR; PG8_SCHED;
            PG8_LDB(B1, 1, 1); PG8_STAGE(PG8_SB(1, 0), b3, voffB);
            PG8_BAR; PG8_WAIT_L(0); PG8_MMA(0, 1, At, B1); PG8_BAR;
            PG8_LDA(At, 1, 1); PG8_STAGE(PG8_SA(1, 0), a3, voffA);
            PG8_BAR; PG8_WAIT_L(0); PG8_MMA(1, 0, At, B0); PG8_BAR; PG8_SCHED;
            PG8_STAGE(PG8_SB(1, 1), b3 + hstep, voffB);
            PG8_WAIT_V(6); PG8_BAR; PG8_MMA(1, 1, At, B1); PG8_BAR;
            }
        }
        if constexpr (ALIGN_EPI) { if (wr == 0) PG8_BAR; }
        if constexpr (!Epi::AFTER_DRAIN) { { int pm_ = cur.pm, pn_ = cur.pn; asm volatile("" : "+s"(pm_), "+s"(pn_)); cur.pm = pm_; cur.pn = pn_; }
            { int t2_ = mk_lane(); asm volatile("" : "+v"(t2_)); E(acc, cur, wr, wc, t2_ & 15, (t2_ & 63) >> 4); }
            S.done(cur); }
        if (!has_next) break;
#pragma unroll
        for (int a = 0; a < 2; ++a)
#pragma unroll
            for (int b = 0; b < 2; ++b)
#pragma unroll
                for (int m = 0; m < 4; ++m)
#pragma unroll
                    for (int n = 0; n < 2; ++n) acc[a][b][m][n] = (f32x4){0.f, 0.f, 0.f, 0.f};
        cur = nxt; cA = nA; cB = nB; ++ui;
        if constexpr (ALIGN_EPI) { if (wr == 1) PG8_BAR; }
    }
    PG8_WAIT_V(0);
    if constexpr (!ALIGN_EPI) { if (wr == 0) PG8_BAR; }
    PG8_BAR;
    if constexpr (Epi::AFTER_DRAIN) { E.fused(acc, cur, wr, wc, fr, fq, lds, wid, lane); S.done(cur); }
#undef PG8_SA
#undef PG8_SB
#undef PG8_STAGE
#undef PG8_LDA
#undef PG8_LDB
#undef PG8_MMA
#undef PG8_WAIT_V
#undef PG8_WAIT_L
#undef PG8_BAR
#undef PG8_SCHED
}
}

typedef unsigned short bf16;
typedef unsigned v4u __attribute__((ext_vector_type(4)));
typedef unsigned v2u __attribute__((ext_vector_type(2)));
typedef float f32x4 __attribute__((ext_vector_type(4)));
typedef float f32x2 __attribute__((ext_vector_type(2)));
typedef float f32x16 __attribute__((ext_vector_type(16)));
typedef short bf16x8 __attribute__((ext_vector_type(8)));
typedef short s16x4 __attribute__((ext_vector_type(4)));
typedef GAS unsigned gu32;

constexpr int D = 1024, NB = 16, SEQ = 4096, LCX = 256, DEPTH = 4;
constexpr int NL = NB * SEQ, NC = NB * LCX, NT = NL + NC;
constexpr int N_IN = 2592, PCOLS = 2048, D_OFF = 1824, HYC = 768;
constexpr int FFD = 2816, FFE = 3584, NE = 8;
constexpr float ALPHA = 1.6817928305074292f;
constexpr int NWAVES = 8, NTHR = 512;
constexpr int KSEQ = SEQ + LCX;

enum { I_X = 0, I_C, I_CTX, I_CCTX, I_ADAW, I_ADAB, I_WIN, I_QNORM, I_KVNORM, I_WUQ, I_WUKV, I_MLAON, I_LCW, I_LCB, I_LWR, I_LBR, I_LWI, I_LBI, I_LLAM, I_LON,
       I_MUP, I_MUN, I_W0, I_WUP, I_A0, I_AUP, I_GUP, I_KK, I_KA, I_RK, I_LNG, I_LNB, I_HCW, I_HCB, I_HW1, I_HB1, I_HW2, I_HB2, I_HW3, I_HD, I_HON,
       I_WOUT, I_LN1G, I_LN1B, I_LN2G, I_LN2B, I_FG, I_FU, I_FD, I_ROUTER, I_MG, I_MU, I_MD, N_INPUTS };

constexpr size_t MiB = 1u << 20;
constexpr size_t WS_CTL = 0, CTL_ZERO_BYTES = 1 * MiB;
constexpr size_t WS_MOD = 1 * MiB;
constexpr size_t WS_ROPE = 3 * MiB;
constexpr size_t WS_H2L = 4 * MiB;
constexpr size_t WS_H2C = 8 * MiB;
constexpr size_t WS_LRUW = 9 * MiB;
constexpr size_t WS_WUQT = 10 * MiB;
constexpr size_t WS_WUKVT = 11 * MiB;
constexpr size_t WS_SUMM = 12 * MiB;
constexpr size_t WS_BON = 17 * MiB;
constexpr size_t WS_TOKE = 20 * MiB;
constexpr size_t WS_TOKG = 21 * MiB;
constexpr size_t WS_TOKS = 22 * MiB;
constexpr size_t WS_BLKCNT = 23 * MiB;
constexpr size_t WS_SPEC = 24 * MiB;
constexpr size_t WS_WINT = 56 * MiB;
constexpr size_t WS_WHYT = 72 * MiB;
constexpr size_t WS_WOUTT = 78 * MiB;
constexpr size_t WS_WGUT = 86 * MiB;
constexpr size_t WS_WDT = 108 * MiB;
constexpr size_t WS_XC = 120 * MiB;
constexpr size_t WS_A1 = 136 * MiB;
constexpr size_t WS_ARENA = 272 * MiB;
constexpr size_t WS_P = WS_ARENA;
constexpr size_t WS_HT = 544 * MiB;
constexpr size_t WS_QB = 646 * MiB;
constexpr size_t WS_KB = 697 * MiB;
constexpr size_t WS_VT = 748 * MiB;
constexpr size_t WS_AO = 782 * MiB;
constexpr size_t WS_HOT = 816 * MiB;
constexpr size_t WS_YR = 850 * MiB;
constexpr size_t WS_Y = 986 * MiB;
constexpr size_t WS_H = WS_ARENA;
constexpr size_t WS_MGU = WS_ARENA;
constexpr size_t WS_MD = 384 * MiB;
constexpr size_t WS_XS = 440 * MiB;
constexpr size_t WS_HM = 716 * MiB;
constexpr size_t WS_END = 1122 * MiB;
constexpr size_t WS_M8GU = WS_ARENA;
constexpr size_t WS_M8D = 328 * MiB;
constexpr size_t WS_XS8 = 356 * MiB;
constexpr size_t WS_Y2 = 494 * MiB;
constexpr size_t WS_HM8 = 770 * MiB;
constexpr int MOE_MAX_TILES = 552, MOE_NCHUNK = 2, MOE_CHUNK_TILES = 276;
static_assert(WS_HM8 + (size_t)MOE_CHUNK_TILES * 256 * FFE <= WS_END && WS_M8GU + (size_t)8 * 2 * FFE * D <= WS_M8D && WS_M8D + (size_t)8 * D * FFE <= WS_XS8 && WS_XS8 + (size_t)141312 * D <= WS_Y2 && WS_Y2 + (size_t)141312 * D * 2 <= WS_HM8, "moe fp8 map");
static_assert(WS_H + (size_t)NT * FFD * 2 <= WS_QB + 51 * MiB, "dense hidden");

constexpr int CW_BAR = 4096;

constexpr int RING_BYTES = 131072;
constexpr int LDSCTL_OFF = RING_BYTES;
constexpr int LDS_TILEE = LDSCTL_OFF + 256;
constexpr int LDS_MOEI = LDSCTL_OFF + 1024;
constexpr int LDS_BYTES = 147456;

#define LDS_WAIT() asm volatile("s_waitcnt lgkmcnt(0)" ::: "memory")
#define VM_WAIT() asm volatile("s_waitcnt vmcnt(0)" ::: "memory")
typedef __bf16 hwbf16x2 __attribute__((ext_vector_type(2)));
__device__ __forceinline__ unsigned pk2(float lo, float hi) { const f32x2 v = {lo, hi}; const hwbf16x2 b = __builtin_convertvector(v, hwbf16x2); return __builtin_bit_cast(unsigned, b); }
__device__ __forceinline__ unsigned f2bf(float f) { return pk2(f, 0.f) & 0xffffu; }
__device__ __forceinline__ unsigned pk4_fp8(float a, float b, float c, float d) { int w = __builtin_amdgcn_cvt_pk_fp8_f32(a, b, 0, false); w = __builtin_amdgcn_cvt_pk_fp8_f32(c, d, w, true); return (unsigned)w; }
__device__ __forceinline__ float bf2f(unsigned b) { return __builtin_bit_cast(float, b << 16); }
__device__ __forceinline__ float bflo(unsigned w) { return __builtin_bit_cast(float, w << 16); }
__device__ __forceinline__ float bfhi(unsigned w) { return __builtin_bit_cast(float, w & 0xffff0000u); }
__device__ __forceinline__ float wave_sum(float v) {
#pragma unroll
    for (int o = 1; o < 64; o <<= 1) v += __shfl_xor(v, o);
    return v;
}
__device__ __forceinline__ float sigmoidf_(float x) { return 1.f / (1.f + __expf(-x)); }
#define XB_TMO      128
#define XB_XCNT(j)  (256  + 64 * (j))
#define XB_XSUB(j)  (1280 + 64 * (j))
#define XB_XGEN(j)  (2304 + 64 * (j))
#define XB_TOP      3328
#define XB_TOPGEN   3392
#define XCD_BAR_WORDS 3456
#define XB_SPIN_CAP (1u << 18)

__device__ __forceinline__ unsigned xb_ld(unsigned* p)              { return __hip_atomic_load(p, __ATOMIC_RELAXED, __HIP_MEMORY_SCOPE_AGENT); }
__device__ __forceinline__ unsigned xb_add(unsigned* p, unsigned v) { return __hip_atomic_fetch_add(p, v, __ATOMIC_RELAXED, __HIP_MEMORY_SCOPE_AGENT); }
__device__ __forceinline__ unsigned xb_xcc_id() { return (unsigned)__builtin_amdgcn_s_getreg((3 << 11) | 20) & 0xFu; }
#define XB_SPIN(cond, bar) do { unsigned _sp = 0; while (cond) { __builtin_amdgcn_s_sleep(1); \
    if ((++_sp & 255u) == 0u) { if (xb_ld(&(bar)[XB_TMO])) break; if (_sp > XB_SPIN_CAP) { atomicAdd(&(bar)[XB_TMO], 1u); break; } } } } while (0)

struct XcdBarrier {
    int leader; unsigned* bar; unsigned x;
    volatile LAS unsigned* st;
};

__device__ __forceinline__ XcdBarrier xcd_barrier_post(unsigned* bar, volatile LAS unsigned* st, int leader) {
    XcdBarrier b; b.leader = leader; b.bar = bar; b.x = xb_xcc_id(); b.st = st;
    if (leader) (void)xb_add(&bar[XB_XCNT(b.x)], 1u);
    return b;
}
__device__ __forceinline__ void xcd_barrier_complete(unsigned* bar, unsigned x, unsigned& nloc, unsigned& nx) {
    const unsigned G = gridDim.x * gridDim.y * gridDim.z;
    unsigned sum, cnt, mine, sp = 0u;
    for (;;) {
        sum = 0u; cnt = 0u; mine = 0u;
#pragma unroll
        for (unsigned j = 0; j < 16; ++j) { const unsigned c = xb_ld(&bar[XB_XCNT(j)]); sum += c; cnt += (c > 0u) ? 1u : 0u; mine = (j == x) ? c : mine; }
        if (sum == G) break;
        __builtin_amdgcn_s_sleep(1);
        if ((++sp & 255u) == 0u) { if (xb_ld(&bar[XB_TMO])) break; if (sp > XB_SPIN_CAP) { atomicAdd(&bar[XB_TMO], 1u); break; } }
    }
    nloc = mine > 0u ? mine : 1u; nx = cnt > 0u ? cnt : 1u;
}

__device__ __forceinline__ void xcd_barrier(const XcdBarrier& b) {
    asm volatile("s_waitcnt vmcnt(0)" ::: "memory");
    __syncthreads();
    if (b.leader) {
        unsigned* bar = b.bar;
        __builtin_amdgcn_s_waitcnt(0);
        unsigned nloc = b.st[0], nx = b.st[1];
        if (nloc == 0u) { xcd_barrier_complete(bar, b.x, nloc, nx); b.st[0] = nloc; b.st[1] = nx; }
        const unsigned old = xb_add(&bar[XB_XSUB(b.x)], 1u);
        const unsigned gen = old / nloc;
        if (old + 1u == (gen + 1u) * nloc) {
            __builtin_amdgcn_fence(__ATOMIC_RELEASE, "agent");
            asm volatile("s_waitcnt vmcnt(0)" ::: "memory");
            const unsigned og = xb_add(&bar[XB_TOP], 1u);
            const unsigned tg = og / nx;
            if (og + 1u == (tg + 1u) * nx) xb_add(&bar[XB_TOPGEN], 1u);
            else XB_SPIN(xb_ld(&bar[XB_TOPGEN]) == tg, bar);
            __builtin_amdgcn_fence(__ATOMIC_ACQUIRE, "agent");
            xb_add(&bar[XB_XGEN(b.x)], 1u);
            asm volatile("s_waitcnt vmcnt(0)" ::: "memory");
        } else {
            XB_SPIN(xb_ld(&bar[XB_XGEN(b.x)]) == gen, bar);
            __builtin_amdgcn_fence(__ATOMIC_ACQUIRE, "agent");
            asm volatile("s_waitcnt vmcnt(0)" ::: "memory");
        }
    }
    __syncthreads();
}

struct Args { const float* in[N_INPUTS]; float* out; unsigned char* ws; };
struct Frame { LAS unsigned char* lds; int tid, lane, wave, G; };
__device__ __forceinline__ void frame_refresh(Frame& F) { int t = F.wave * 64 + mk_lane(); asm volatile("" : "+v"(t)); F.tid = t; F.lane = t & 63; }
#define CAS __attribute__((address_space(4)))
__device__ __forceinline__ const CAS char* karg() { const CAS char* kp = (const CAS char*)__builtin_amdgcn_kernarg_segment_ptr(); asm volatile("" : "+s"(kp)); return kp; }
__device__ __forceinline__ const float* in_ptr(int i) { return *(const float* const CAS*)(karg() + 8 * i); }
__device__ __forceinline__ float* out_ptr() { return *(float* const CAS*)(karg() + 8 * N_INPUTS); }
__device__ __forceinline__ unsigned char* ws_ptr() { return *(unsigned char* const CAS*)(karg() + 8 * N_INPUTS + 8); }
#define WSP(T, off) ((T*)(ws + (off)))
#define WS_DECL unsigned char* const ws = ws_ptr()

namespace pg8 {
struct EpiStore {
    static constexpr bool PERM = true, AFTER_DRAIN = false;
    bf16_t* O; int ldc; int pm_add; int nN;
    __device__ __forceinline__ void operator()(const f32x4 (&acc)[2][2][4][2], const Unit& u, int wr, int wc, int fr, int fq) const {
        const int row0 = (u.pm + pm_add) * BM + wr * 64 + fr; const int col0 = (u.pn % nN) * BM + wc * 32 + 8 * fq;
#pragma unroll
        for (int ai = 0; ai < 2; ++ai)
#pragma unroll
            for (int m = 0; m < 4; ++m) { bf16_t* rowp = O + (size_t)(row0 + ai * HALF + m * 16) * ldc + col0;
#pragma unroll
                for (int bj = 0; bj < 2; ++bj) { const f32x4 v0 = acc[ai][bj][m][0], v1 = acc[ai][bj][m][1];
                    u32x4 w; w.x = cvt_pk_bf16(v0[0], v0[1]); w.y = cvt_pk_bf16(v0[2], v0[3]); w.z = cvt_pk_bf16(v1[0], v1[1]); w.w = cvt_pk_bf16(v1[2], v1[3]);
                    *(u32x4*)(rowp + bj * HALF) = w; } }
    }
};
__device__ __forceinline__ float silu_mul(float g, float u) { return g * __builtin_amdgcn_rcpf(1.f + __expf(-g)) * u; }
struct EpiSwiGLU {
    static constexpr bool PERM = true, AFTER_DRAIN = false;
    bf16_t* H; int ldh; int pm_sub; int nN;
    __device__ __forceinline__ void operator()(const f32x4 (&acc)[2][2][4][2], const Unit& u, int wr, int wc, int fr, int fq) const {
        const int row0 = (u.pm - pm_sub) * BM + wr * 64 + fr; const int col0 = (u.pn % nN) * HALF + wc * 32 + 8 * fq;
#pragma unroll
        for (int ai = 0; ai < 2; ++ai)
#pragma unroll
            for (int m = 0; m < 4; ++m) { bf16_t* rowp = H + (size_t)(row0 + ai * HALF + m * 16) * ldh + col0;
                const f32x4 g0 = acc[ai][0][m][0], g1 = acc[ai][0][m][1], u0 = acc[ai][1][m][0], u1 = acc[ai][1][m][1];
                u32x4 w; w.x = cvt_pk_bf16(silu_mul(g0[0], u0[0]), silu_mul(g0[1], u0[1])); w.y = cvt_pk_bf16(silu_mul(g0[2], u0[2]), silu_mul(g0[3], u0[3]));
                w.z = cvt_pk_bf16(silu_mul(g1[0], u1[0]), silu_mul(g1[1], u1[1])); w.w = cvt_pk_bf16(silu_mul(g1[2], u1[2]), silu_mul(g1[3], u1[3]));
                *(u32x4*)rowp = w; }
    }
};
struct EpiSwiGLU8 {
    static constexpr bool PERM = true, AFTER_DRAIN = false;
    unsigned char* H; int ldh; int pm_sub; int nN;
    __device__ __forceinline__ void operator()(const f32x4 (&acc)[2][2][4][2], const Unit& u, int wr, int wc, int fr, int fq) const {
        const int row0 = (u.pm - pm_sub) * BM + wr * 64 + fr; const int col0 = (u.pn % nN) * HALF + wc * 32 + 8 * fq;
#pragma unroll
        for (int ai = 0; ai < 2; ++ai)
#pragma unroll
            for (int m = 0; m < 4; ++m) { unsigned char* rowp = H + (size_t)(row0 + ai * HALF + m * 16) * ldh + col0;
                const f32x4 g0 = acc[ai][0][m][0], g1 = acc[ai][0][m][1], u0 = acc[ai][1][m][0], u1 = acc[ai][1][m][1];
                ::v2u w; w.x = ::pk4_fp8(silu_mul(g0[0], u0[0]), silu_mul(g0[1], u0[1]), silu_mul(g0[2], u0[2]), silu_mul(g0[3], u0[3]));
                w.y = ::pk4_fp8(silu_mul(g1[0], u1[0]), silu_mul(g1[1], u1[1]), silu_mul(g1[2], u1[2]), silu_mul(g1[3], u1[3]));
                *(::v2u*)rowp = w; }
    }
};
struct MoeOrder {
    int nM, nN, nwg, G, c, t0, pm_off; const PG8_LAS unsigned char* tile_e;
    __device__ void init(int nM_, int nN_, int G_, int c_, int t0_, int pm_off_, const PG8_LAS unsigned char* te) { nM = nM_; nN = nN_; nwg = nM * nN; G = G_; c = c_; t0 = t0_; pm_off = pm_off_; tile_e = te; }
    __device__ bool next(int i, Unit& u) const {
        const long L = (long)i * G + c; if (L >= nwg) return false;
        int wgid = (int)L; { const int q = nwg / NXCD, r = nwg % NXCD, xcd = wgid % NXCD, off = wgid / NXCD; wgid = (xcd < r ? xcd * (q + 1) : r * (q + 1) + (xcd - r) * q) + off; }
        const int nig = WGM * nN, gid = wgid / nig, fm = gid * WGM, gsz = (nM - fm) < WGM ? (nM - fm) : WGM;
        const int pml = fm + ((wgid % nig) % gsz), pnl = (wgid % nig) / gsz;
        const int e = tile_e[t0 + pml];
        u.pm = pm_off + pml; u.pn = e * nN + pnl; u.g = 0; return true;
    }
    __device__ __forceinline__ void a_ready(const Unit&) const {}
    __device__ __forceinline__ void done(const Unit&) const {}
};
struct DualOrder {
    StaticOrder s0, s1; int G, c;
    __device__ void init(int M0, int N0, int M1, int N1, int G_, int c_) { s0.init(M0, N0, 1, 0); s1.init(M1, N1, 1, 0); G = G_; c = c_; }
    __device__ bool next(int i, Unit& u) const { const long L = (long)i * G + c;
        if (L < s0.nwg) { const bool ok = s0.next((int)L, u); u.g = 0; return ok; }
        const long L1 = L - s0.nwg; if (L1 >= s1.nwg) return false; const bool ok = s1.next((int)L1, u); u.g = 1; return ok; }
    __device__ __forceinline__ void a_ready(const Unit&) const {}
    __device__ __forceinline__ void done(const Unit&) const {}
};
struct EpiStore2 {
    static constexpr bool PERM = true, AFTER_DRAIN = false;
    bf16_t* O0; int ldc0; bf16_t* O1; int ldc1;
    __device__ __forceinline__ void operator()(const f32x4 (&acc)[2][2][4][2], const Unit& u, int wr, int wc, int fr, int fq) const {
        bf16_t* O = u.g ? O1 : O0; const int ldc = u.g ? ldc1 : ldc0;
        const int row0 = u.pm * BM + wr * 64 + fr; const int col0 = u.pn * BM + wc * 32 + 8 * fq;
#pragma unroll
        for (int ai = 0; ai < 2; ++ai)
#pragma unroll
            for (int m = 0; m < 4; ++m) { bf16_t* rowp = O + (size_t)(row0 + ai * HALF + m * 16) * ldc + col0;
#pragma unroll
                for (int bj = 0; bj < 2; ++bj) { const f32x4 v0 = acc[ai][bj][m][0], v1 = acc[ai][bj][m][1];
                    u32x4 w; w.x = cvt_pk_bf16(v0[0], v0[1]); w.y = cvt_pk_bf16(v0[2], v0[3]); w.z = cvt_pk_bf16(v1[0], v1[1]); w.w = cvt_pk_bf16(v1[2], v1[3]);
                    *(u32x4*)(rowp + bj * HALF) = w; } }
    }
};
}

__device__ __forceinline__ void tr_item(const float* W, int ldw, int k0, int c0, bf16* WT, int K, int drow, LAS float* scr, int lane) {
#pragma unroll 8
    for (int i = 0; i < 32; ++i) { const int kk = 2 * i + (lane >> 5); scr[kk * 33 + (lane & 31)] = W[(size_t)(k0 + kk) * ldw + c0 + (lane & 31)]; }
    LDS_WAIT(); asm volatile("" ::: "memory");
    const int c = lane & 7;
#pragma unroll
    for (int j = 0; j < 4; ++j) { const int n = (lane >> 3) + 8 * j; const LAS float* s = scr + (8 * c) * 33 + n;
        v4u o; o.x = pk2(s[0 * 33], s[1 * 33]); o.y = pk2(s[2 * 33], s[3 * 33]); o.z = pk2(s[4 * 33], s[5 * 33]); o.w = pk2(s[6 * 33], s[7 * 33]);
        *(GAS v4u*)(WT + (size_t)(drow + n) * K + k0 + 8 * c) = o; }
    LDS_WAIT(); asm volatile("" ::: "memory");
}
__device__ __forceinline__ void tr_item8(const float* W, int ldw, int k0, int c0, unsigned char* WT, int K, int drow, LAS float* scr, int lane, float scale) {
#pragma unroll 8
    for (int i = 0; i < 32; ++i) { const int kk = 2 * i + (lane >> 5); scr[kk * 33 + (lane & 31)] = W[(size_t)(k0 + kk) * ldw + c0 + (lane & 31)]; }
    LDS_WAIT(); asm volatile("" ::: "memory");
    const int c = lane & 7;
#pragma unroll
    for (int j = 0; j < 4; ++j) { const int n = (lane >> 3) + 8 * j; const LAS float* s = scr + (8 * c) * 33 + n;
        v2u o; o.x = pk4_fp8(s[0 * 33] * scale, s[1 * 33] * scale, s[2 * 33] * scale, s[3 * 33] * scale); o.y = pk4_fp8(s[4 * 33] * scale, s[5 * 33] * scale, s[6 * 33] * scale, s[7 * 33] * scale);
        *(GAS v2u*)(WT + (size_t)(drow + n) * K + k0 + 8 * c) = o; }
    LDS_WAIT(); asm volatile("" ::: "memory");
}
__device__ __forceinline__ void conv_matrix(Frame& F, const float* W, int K, int ldw, int cbeg, int ncols, bf16* WT, int mode, int rowoff, int& cursor, float f8scale = 0.f) {
    const int gw = blockIdx.x * NWAVES + F.wave, NGW = F.G * NWAVES;
    const int nblk = ncols / 32, nit = (K / 64) * nblk;
    LAS float* scr = (LAS float*)(F.lds + F.wave * 16384);
    int first = cursor + (((gw - cursor) % NGW) + NGW) % NGW;
    for (int it = first; it < cursor + nit; it += NGW) {
        const int idx = it - cursor, kb = idx / nblk, nb = idx % nblk, n = 32 * nb;
        const int drow = mode == 0 ? rowoff + n : ((n >> 7) * 256 + (n & 127) + rowoff);
        if (f8scale != 0.f) tr_item8(W, ldw, 64 * kb, cbeg + n, (unsigned char*)WT, K, drow, scr, F.lane, f8scale); else tr_item(W, ldw, 64 * kb, cbeg + n, WT, K, drow, scr, F.lane);
    }
    cursor += nit;
}

__device__ __forceinline__ void phase_mod(Frame& F) { WS_DECL; frame_refresh(F);
    LAS float* sv = (LAS float*)F.lds;
    LAS float* red = (LAS float*)(F.lds + 69632);
    float* MOD = WSP(float, WS_MOD);
    if ((int)blockIdx.x < 192) {
        const float* cl_ = in_ptr(I_C); const float* cc_ = in_ptr(I_CCTX); const float* adab = in_ptr(I_ADAB); const float* adaw = in_ptr(I_ADAW);
        for (int i = F.tid; i < 17 * 1024; i += NTHR) { const int b = i >> 10, k = i & 1023; const float c = b < 16 ? cl_[b * 1024 + k] : cc_[k]; sv[i] = c / (1.f + expf(-c)); }
        __syncthreads();
        for (int item = blockIdx.x; item < 192; item += F.G) {
            const int li = item / 48, cg = item % 48, cl = F.tid & 127, kq = F.tid >> 7;
            const float* W = adaw + (size_t)li * 1024 * 6144 + cg * 128 + cl;
            float acc[17];
#pragma unroll
            for (int b = 0; b < 17; ++b) acc[b] = 0.f;
            for (int k = kq * 256; k < kq * 256 + 256; ++k) { const float w = W[(size_t)k * 6144];
#pragma unroll
                for (int b = 0; b < 17; ++b) acc[b] += sv[b * 1024 + k] * w; }
#pragma unroll
            for (int b = 0; b < 17; ++b) red[(kq * 17 + b) * 128 + cl] = acc[b];
            __syncthreads();
            for (int o = F.tid; o < 17 * 128; o += NTHR) { const int b = o >> 7, c = o & 127;
                const float s = (red[(0 * 17 + b) * 128 + c] + red[(1 * 17 + b) * 128 + c]) + (red[(2 * 17 + b) * 128 + c] + red[(3 * 17 + b) * 128 + c]);
                MOD[((size_t)li * 17 + b) * 6144 + cg * 128 + c] = s + adab[li * 6144 + cg * 128 + c]; }
            __syncthreads();
        }
    }
}

__device__ __forceinline__ void phase_pro0(Frame& F) { WS_DECL; frame_refresh(F);
    phase_mod(F);
    __syncthreads();
    int cursor = 0;
    for (int li = 0; li < DEPTH; ++li) {
        conv_matrix(F, in_ptr(I_WIN) + (size_t)li * D * N_IN, D, N_IN, 0, D_OFF, WSP(bf16, WS_WINT) + (size_t)li * PCOLS * D, 0, 0, cursor);
        conv_matrix(F, in_ptr(I_WIN) + (size_t)li * D * N_IN, D, N_IN, D_OFF, HYC, WSP(bf16, WS_WHYT) + (size_t)li * HYC * D, 0, 0, cursor);
        conv_matrix(F, in_ptr(I_WOUT) + (size_t)li * D * D, D, D, 0, D, WSP(bf16, WS_WOUTT) + (size_t)li * D * D, 0, 0, cursor);
    }
    for (int j = 0; j < 2; ++j) {
        conv_matrix(F, in_ptr(I_FG) + (size_t)j * D * FFD, D, FFD, 0, FFD, (bf16*)(WSP(unsigned char, WS_WGUT) + (size_t)j * 2 * FFD * D), 1, 0, cursor, 64.f);
        conv_matrix(F, in_ptr(I_FU) + (size_t)j * D * FFD, D, FFD, 0, FFD, (bf16*)(WSP(unsigned char, WS_WGUT) + (size_t)j * 2 * FFD * D), 1, 128, cursor, 64.f);
        conv_matrix(F, in_ptr(I_FD) + (size_t)j * FFD * D, FFD, D, 0, D, WSP(bf16, WS_WDT) + (size_t)j * D * FFD, 0, 0, cursor);
    }
    { const int gt = blockIdx.x * NTHR + F.tid, NGT = F.G * NTHR; const int per = (PCOLS - D_OFF) * D / 8;
      for (int i = gt; i < DEPTH * per; i += NGT) { const int li = i / per, r = i % per; *(GAS v4u*)(WSP(bf16, WS_WINT) + (size_t)li * PCOLS * D + (size_t)D_OFF * D + (size_t)r * 8) = (v4u){0u, 0u, 0u, 0u}; } }
}

struct Stream { const float* inl; const float* inc; float* outl; float* outc; };
__device__ __forceinline__ Stream make_stream(unsigned char* ws, int li) { Stream s; s.outl = out_ptr(); s.outc = WSP(float, WS_XC); s.inl = li == 0 ? in_ptr(I_X) : (const float*)s.outl; s.inc = li == 0 ? in_ptr(I_CTX) : (const float*)s.outc; return s; }
__device__ __forceinline__ const float* stream_in(const Stream& s, int m) { return m < NL ? s.inl + (size_t)m * D : s.inc + (size_t)(m - NL) * D; }
__device__ __forceinline__ float* stream_out(const Stream& s, int m) { return m < NL ? s.outl + (size_t)m * D : s.outc + (size_t)(m - NL) * D; }
__device__ __forceinline__ int mod_b(int m) { return m < NL ? (m >> 12) : 16; }
__device__ __forceinline__ const float* mod_vec(unsigned char* ws, int li, int b, int j) { return WSP(float, WS_MOD) + ((size_t)li * 17 + b) * 6144 + j * 1024; }

__device__ __forceinline__ void store_modulated(const f32x4 (&x)[4], const float* shift, const float* scale, bf16* orow, int lane) {
#pragma unroll
    for (int j = 0; j < 4; ++j) { const int c = 4 * lane + 256 * j; const f32x4 sh = *(const GAS f32x4*)(shift + c), sc = *(const GAS f32x4*)(scale + c);
        const f32x4 h = x[j] * (sc + 1.f) + sh; v2u w; w.x = pk2(h.x, h.y); w.y = pk2(h.z, h.w); *(GAS v2u*)(orow + c) = w; }
}
__device__ __forceinline__ void rows_range(const Frame& F, int nrows, int& r0, int& r1) { const int per = (nrows + F.G - 1) / F.G; r0 = blockIdx.x * per; r1 = r0 + per < nrows ? r0 + per : nrows; if (r0 > nrows) r0 = nrows; }

__device__ __forceinline__ void phase_hin0(Frame& F) { WS_DECL; frame_refresh(F);
    int r0, r1; rows_range(F, NT, r0, r1); const Stream st = make_stream(ws, 0);
    for (int m = r0 + F.wave; m < r1; m += NWAVES) {
        const float* xr = stream_in(st, m); f32x4 x[4];
#pragma unroll
        for (int j = 0; j < 4; ++j) x[j] = *(const GAS f32x4*)(xr + 4 * F.lane + 256 * j);
        const int b = mod_b(m);
        store_modulated(x, mod_vec(ws, 0, b, 0), mod_vec(ws, 0, b, 1), WSP(bf16, WS_A1) + (size_t)m * D, F.lane);
    }
}

__device__ __forceinline__ void ln_rows(f32x4 (&v)[4], const float* g, const float* bta, int lane) {
    float s = 0.f;
#pragma unroll
    for (int j = 0; j < 4; ++j) s += (v[j].x + v[j].y) + (v[j].z + v[j].w);
    const float mean = wave_sum(s) * (1.f / D); float s2 = 0.f;
#pragma unroll
    for (int j = 0; j < 4; ++j) { v[j] = v[j] - mean; s2 += (v[j].x * v[j].x + v[j].y * v[j].y) + (v[j].z * v[j].z + v[j].w * v[j].w); }
    const float rstd = __builtin_amdgcn_rsqf(wave_sum(s2) * (1.f / D) + 1e-5f);
#pragma unroll
    for (int j = 0; j < 4; ++j) { const int c = 4 * lane + 256 * j; v[j] = v[j] * rstd * *(const GAS f32x4*)(g + c) + *(const GAS f32x4*)(bta + c); }
}

template <bool HAVE_Y>
__device__ __forceinline__ void phase_ln1(Frame& F, int li) { WS_DECL; frame_refresh(F); constexpr bool DRY_OR_BF16 = false;
    const int nrows = li == DEPTH - 1 ? NL : NT; const bool moe = li & 1; const int lane = F.lane;
    LAS int* hist = (LAS int*)(F.lds + LDS_MOEI) + 56; LAS float* ROUT = (LAS float*)F.lds;
    if (moe) { if (F.tid < 8) hist[F.tid] = 0; const float* router = in_ptr(I_ROUTER) + (size_t)(li >> 1) * D * NE; for (int i = F.tid; i < D * NE / 4; i += NTHR) *(LAS f32x4*)(ROUT + 4 * i) = *(const GAS f32x4*)(router + 4 * i); __syncthreads(); }
    int r0, r1; rows_range(F, nrows, r0, r1);
    const float* g = in_ptr(I_LN1G) + li * D; const float* bt = in_ptr(I_LN1B) + li * D; const Stream st = make_stream(ws, li); const bf16* Y = WSP(bf16, WS_Y);
    f32x4 xn[4]; v2u yn[4];
    { const int m = r0 + F.wave; if (m < r1) { const float* xr = stream_in(st, m);
#pragma unroll
        for (int j = 0; j < 4; ++j) { const int c = 4 * lane + 256 * j; xn[j] = *(const GAS f32x4*)(xr + c); if (HAVE_Y) yn[j] = *(const GAS v2u*)(Y + (size_t)m * D + c); } } }
    for (int m = r0 + F.wave; m < r1; m += NWAVES) {
        const int b = mod_b(m); f32x4 v[4]; v2u yw[4];
#pragma unroll
        for (int j = 0; j < 4; ++j) { v[j] = xn[j]; if (HAVE_Y) yw[j] = yn[j]; }
        if (m + NWAVES < r1) { const float* xr = stream_in(st, m + NWAVES);
#pragma unroll
            for (int j = 0; j < 4; ++j) { const int c = 4 * lane + 256 * j; xn[j] = *(const GAS f32x4*)(xr + c); if (HAVE_Y) yn[j] = *(const GAS v2u*)(Y + (size_t)(m + NWAVES) * D + c); } }
        const float* m2 = mod_vec(ws, li, b, 2);
#pragma unroll
        for (int j = 0; j < 4; ++j) { const int c = 4 * lane + 256 * j; v[j] = v[j] * ALPHA;
            if (HAVE_Y) { const f32x4 mm = *(const GAS f32x4*)(m2 + c); v[j].x += mm.x * bflo(yw[j].x); v[j].y += mm.y * bfhi(yw[j].x); v[j].z += mm.z * bflo(yw[j].y); v[j].w += mm.w * bfhi(yw[j].y); } }
        ln_rows(v, g, bt, lane);
        float* xo = stream_out(st, m);
#pragma unroll
        for (int j = 0; j < 4; ++j) *(GAS f32x4*)(xo + 4 * lane + 256 * j) = v[j];
        const float* sh = mod_vec(ws, li, b, 3); const float* sc = mod_vec(ws, li, b, 4);
        if (moe) {
            float lg[NE];
#pragma unroll
            for (int e = 0; e < NE; ++e) lg[e] = 0.f;
#pragma unroll
            for (int j = 0; j < 4; ++j) { const int c = 4 * lane + 256 * j; const f32x4 s4 = *(const GAS f32x4*)(sh + c), c4 = *(const GAS f32x4*)(sc + c); const f32x4 f = v[j] * (c4 + 1.f) + s4;
#pragma unroll
                for (int q = 0; q < 4; ++q) { const f32x4 ra = *(const LAS f32x4*)(ROUT + (c + q) * NE), rb = *(const LAS f32x4*)(ROUT + (c + q) * NE + 4); const float fq = f[q];
                    lg[0] += fq * ra.x; lg[1] += fq * ra.y; lg[2] += fq * ra.z; lg[3] += fq * ra.w; lg[4] += fq * rb.x; lg[5] += fq * rb.y; lg[6] += fq * rb.z; lg[7] += fq * rb.w; } }
#pragma unroll
            for (int e = 0; e < NE; ++e) lg[e] = wave_sum(lg[e]);
            int e0 = 0; float v0 = lg[0];
#pragma unroll
            for (int e = 1; e < NE; ++e) if (lg[e] > v0) { v0 = lg[e]; e0 = e; }
            int e1 = -1; float v1 = -3.0e38f;
#pragma unroll
            for (int e = 0; e < NE; ++e) if (e != e0 && lg[e] > v1) { v1 = lg[e]; e1 = e; }
            const float ex = __expf(v1 - v0), g0 = 1.f / (1.f + ex), g1 = ex * g0;
            if (lane == 0) { *(GAS v2u*)(WSP(int, WS_TOKE) + 2 * (size_t)m) = (v2u){(unsigned)e0, (unsigned)e1}; *(GAS f32x2*)(WSP(float, WS_TOKG) + 2 * (size_t)m) = (f32x2){g0, g1};
                atomicAdd((int*)(hist + e0), 1); atomicAdd((int*)(hist + e1), 1); }
        }
        if (!DRY_OR_BF16) {
            unsigned char* orow = WSP(unsigned char, WS_A1) + (size_t)m * D;
#pragma unroll
            for (int j = 0; j < 4; ++j) { const int c = 4 * lane + 256 * j; const f32x4 s4 = *(const GAS f32x4*)(sh + c), c4 = *(const GAS f32x4*)(sc + c); const f32x4 f = v[j] * (c4 + 1.f) + s4;
                *(GAS unsigned*)(orow + c) = pk4_fp8(f.x, f.y, f.z, f.w); }
        } else store_modulated(v, sh, sc, WSP(bf16, WS_A1) + (size_t)m * D, lane);
    }
    if (moe) { __syncthreads(); if (F.tid < 8) WSP(int, WS_BLKCNT)[blockIdx.x * 8 + F.tid] = hist[F.tid]; }
}

template <bool HAVE_FFN>
__device__ __forceinline__ void phase_ln2(Frame& F, int li) { WS_DECL; frame_refresh(F);
    const int nrows = li == DEPTH - 1 ? NL : NT; const bool moe = li & 1; const int lane = F.lane;
    int r0, r1; rows_range(F, nrows, r0, r1);
    const float* g = in_ptr(I_LN2G) + li * D; const float* bt = in_ptr(I_LN2B) + li * D; const Stream st = make_stream(ws, 1);
    const bf16* Y = WSP(bf16, WS_Y); const bf16* XS = WSP(bf16, WS_Y2); const int* TOKS = WSP(int, WS_TOKS); const float* TOKG = WSP(float, WS_TOKG);
    f32x4 xn[4]; v2u ya[4], yb[4]; v2u sn = (v2u){0u, 0u}; f32x2 gn = (f32x2){0.f, 0.f}, gc = (f32x2){0.f, 0.f};
    const int mf = r0 + F.wave;
    if (mf < r1) { const float* xr = stream_out(st, mf); v2u s0 = (v2u){0u, 0u};
        if (moe) { s0 = *(const GAS v2u*)(TOKS + 2 * (size_t)mf); gc = *(const GAS f32x2*)(TOKG + 2 * (size_t)mf); if (mf + NWAVES < r1) { sn = *(const GAS v2u*)(TOKS + 2 * (size_t)(mf + NWAVES)); gn = *(const GAS f32x2*)(TOKG + 2 * (size_t)(mf + NWAVES)); } }
#pragma unroll
        for (int j = 0; j < 4; ++j) { const int c = 4 * lane + 256 * j; xn[j] = *(const GAS f32x4*)(xr + c);
            if (HAVE_FFN) { if (moe) { ya[j] = *(const GAS v2u*)(XS + (size_t)s0.x * D + c); yb[j] = *(const GAS v2u*)(XS + (size_t)s0.y * D + c); } else ya[j] = *(const GAS v2u*)(Y + (size_t)mf * D + c); } } }
    for (int m = mf; m < r1; m += NWAVES) {
        const int b = mod_b(m); f32x4 v[4]; v2u wa[4], wb[4]; const f32x2 gg = gc;
#pragma unroll
        for (int j = 0; j < 4; ++j) { v[j] = xn[j]; wa[j] = ya[j]; wb[j] = yb[j]; }
        const int mn = m + NWAVES;
        if (mn < r1) { const float* xr = stream_out(st, mn); const v2u s1 = sn; gc = gn;
            if (moe && mn + NWAVES < r1) { sn = *(const GAS v2u*)(TOKS + 2 * (size_t)(mn + NWAVES)); gn = *(const GAS f32x2*)(TOKG + 2 * (size_t)(mn + NWAVES)); }
#pragma unroll
            for (int j = 0; j < 4; ++j) { const int c = 4 * lane + 256 * j; xn[j] = *(const GAS f32x4*)(xr + c);
                if (HAVE_FFN) { if (moe) { ya[j] = *(const GAS v2u*)(XS + (size_t)s1.x * D + c); yb[j] = *(const GAS v2u*)(XS + (size_t)s1.y * D + c); } else ya[j] = *(const GAS v2u*)(Y + (size_t)mn * D + c); } } }
        const float* m5 = mod_vec(ws, li, b, 5);
#pragma unroll
        for (int j = 0; j < 4; ++j) { const int c = 4 * lane + 256 * j; v[j] = v[j] * ALPHA;
            if (HAVE_FFN) { const f32x4 mm = *(const GAS f32x4*)(m5 + c); f32x4 o;
                if (moe) { o.x = gg.x * bflo(wa[j].x) + gg.y * bflo(wb[j].x); o.y = gg.x * bfhi(wa[j].x) + gg.y * bfhi(wb[j].x); o.z = gg.x * bflo(wa[j].y) + gg.y * bflo(wb[j].y); o.w = gg.x * bfhi(wa[j].y) + gg.y * bfhi(wb[j].y); }
                else { o.x = bflo(wa[j].x); o.y = bfhi(wa[j].x); o.z = bflo(wa[j].y); o.w = bfhi(wa[j].y); }
                v[j] = v[j] + mm * o; } }
        ln_rows(v, g, bt, lane);
        float* xo = stream_out(st, m);
#pragma unroll
        for (int j = 0; j < 4; ++j) *(GAS f32x4*)(xo + 4 * lane + 256 * j) = v[j];
        if (li < DEPTH - 1) store_modulated(v, mod_vec(ws, li + 1, b, 0), mod_vec(ws, li + 1, b, 1), WSP(bf16, WS_A1) + (size_t)m * D, lane);
    }
}

__device__ __forceinline__ void phase_moe_weights(Frame& F, int li) { WS_DECL; frame_refresh(F);
    const int j = li >> 1; int cursor = 0;
    for (int e = 0; e < NE; ++e) {
        conv_matrix(F, in_ptr(I_MG) + ((size_t)j * NE + e) * D * FFE, D, FFE, 0, FFE, (bf16*)(WSP(unsigned char, WS_M8GU) + (size_t)e * 2 * FFE * D), 1, 0, cursor, 64.f);
        conv_matrix(F, in_ptr(I_MU) + ((size_t)j * NE + e) * D * FFE, D, FFE, 0, FFE, (bf16*)(WSP(unsigned char, WS_M8GU) + (size_t)e * 2 * FFE * D), 1, 128, cursor, 64.f);
        conv_matrix(F, in_ptr(I_MD) + ((size_t)j * NE + e) * FFE * D, FFE, D, 0, D, (bf16*)(WSP(unsigned char, WS_M8D) + (size_t)e * D * FFE), 0, 0, cursor, 256.f);
    }
}

__device__ __forceinline__ void phase_moe_slots(Frame& F, int li) { WS_DECL; frame_refresh(F);
    const int nrows = li == DEPTH - 1 ? NL : NT;
    LAS int* mi = (LAS int*)(F.lds + LDS_MOEI); LAS unsigned char* tile_e = (LAS unsigned char*)(F.lds + LDS_TILEE);
    LAS int* slots = (LAS int*)F.lds;
    const int* blkcnt = WSP(int, WS_BLKCNT);
    if (F.tid < 8) { int tot = 0, pre = 0; for (int b = 0; b < F.G; ++b) { const int c = blkcnt[b * 8 + F.tid]; if (b < (int)blockIdx.x) pre += c; tot += c; } mi[16 + F.tid] = tot; mi[32 + F.tid] = pre; }
    __syncthreads();
    if (F.tid == 0) { int s = 0; for (int e = 0; e < NE; ++e) { mi[e] = s; s += (mi[16 + e] + 255) & ~255; } mi[8] = s; mi[48] = s >> 8; }
    __syncthreads();
    for (int t = F.tid; t < MOE_MAX_TILES + 8; t += NTHR) { int e = 0;
#pragma unroll
        for (int q = 1; q < NE; ++q) if (t * 256 >= mi[q]) e = q;
        tile_e[t] = (unsigned char)e; }
    int r0, r1; rows_range(F, nrows, r0, r1);
    const int na = 2 * (r1 - r0);
    if (F.wave == 0) {
        int run[NE];
#pragma unroll
        for (int e = 0; e < NE; ++e) run[e] = mi[e] + mi[32 + e];
        for (int base = 0; base < na; base += 64) { const int ai = base + F.lane; const bool ok = ai < na;
            const int e = ok ? WSP(int, WS_TOKE)[2 * (size_t)r0 + ai] : -1; int slot = 0;
#pragma unroll
            for (int q = 0; q < NE; ++q) { const unsigned long long mk = __ballot(e == q); if (e == q) slot = run[q] + __popcll(mk & ((1ull << F.lane) - 1ull)); run[q] += __popcll(mk); }
            if (ok) { slots[ai] = slot; WSP(int, WS_TOKS)[2 * (size_t)r0 + ai] = slot; } }
    }
    __syncthreads();
    for (int ai = F.wave; ai < na; ai += NWAVES) { const int m = r0 + (ai >> 1), slot = slots[ai];
        const GAS v4u* src = (const GAS v4u*)(WSP(unsigned char, WS_A1) + (size_t)m * D); GAS v4u* dst = (GAS v4u*)(WSP(unsigned char, WS_XS8) + (size_t)slot * D);
        dst[F.lane] = src[F.lane]; }
    { const int gw = blockIdx.x * NWAVES + F.wave, NGW = F.G * NWAVES; int cnt = 0;
      for (int e = 0; e < NE; ++e) { const int p0 = mi[e] + mi[16 + e], p1 = mi[e + 1];
          for (int s = p0; s < p1; ++s, ++cnt) if (cnt % NGW == gw) { GAS v4u* dst = (GAS v4u*)(WSP(unsigned char, WS_XS8) + (size_t)s * D); dst[F.lane] = (v4u){0u, 0u, 0u, 0u}; } } }
    __syncthreads();
}

constexpr float QSCALE = 0.14724319f;
constexpr int MP_CQ_LD = 200, MP_CKV_LD = 136;
__device__ __forceinline__ void phase_mla_prep(Frame& F, int li) { WS_DECL; frame_refresh(F);
    LAS bf16* CQN = (LAS bf16*)F.lds; LAS bf16* CKVN = (LAS bf16*)(F.lds + 64 * MP_CQ_LD * 2);
    const bf16* P = WSP(bf16, WS_P); bf16* QB = WSP(bf16, WS_QB); bf16* KB = WSP(bf16, WS_KB); bf16* VT = WSP(bf16, WS_VT);
    const float* qn = in_ptr(I_QNORM) + li * 192; const float* kvn = in_ptr(I_KVNORM) + li * 128;
    const bf16* WQ = WSP(bf16, WS_WUQT) + (size_t)li * 384 * 192; const bf16* WKV = WSP(bf16, WS_WUKVT) + (size_t)li * 512 * 128;
    const float* RC = WSP(float, WS_ROPE); const float* RS = RC + 4096 * 16;
    const int lane = F.lane, wave = F.wave;
    const int head = wave >> 1, half = wave & 1, fr = lane & 15, kg = lane >> 4;
    for (int item = blockIdx.x; item < NT / 64; item += F.G) {
        const int m0 = item * 64; const bool isctx = m0 >= NL; const int b = isctx ? (m0 - NL) >> 8 : m0 >> 12; const int t0 = isctx ? (m0 - NL) & 255 : m0 & 4095;
        const int ki0 = isctx ? t0 : 256 + t0;
        bf16x8 wq[3][6];
#pragma unroll
        for (int i = 0; i < 3; ++i)
#pragma unroll
            for (int ks = 0; ks < 6; ++ks) wq[i][ks] = *(const GAS bf16x8*)(WQ + (size_t)(96 * head + 16 * (3 * half + i) + fr) * 192 + 32 * ks + 8 * kg);
        v4u rawv[8]; unsigned short kr1[8], kr2[8];
#pragma unroll
        for (int i = 0; i < 8; ++i) { const bf16* pr = P + (size_t)(m0 + wave * 8 + i) * PCOLS; rawv[i] = (v4u){0u, 0u, 0u, 0u}; if (lane < 40) rawv[i] = *(const GAS v4u*)(pr + 8 * lane);
            kr1[i] = 0; kr2[i] = 0; if (lane < 16) { kr1[i] = pr[320 + lane]; kr2[i] = pr[336 + lane]; } }
#pragma unroll
        for (int i = 0; i < 8; ++i) { const int tl = wave * 8 + i; const v4u raw = rawv[i];
            float x[8]; x[0] = bflo(raw.x); x[1] = bfhi(raw.x); x[2] = bflo(raw.y); x[3] = bfhi(raw.y); x[4] = bflo(raw.z); x[5] = bfhi(raw.z); x[6] = bflo(raw.w); x[7] = bfhi(raw.w);
            float ss = 0.f;
#pragma unroll
            for (int j = 0; j < 8; ++j) ss += x[j] * x[j];
            const float sq = wave_sum(lane < 24 ? ss : 0.f), skv = wave_sum((lane >= 24 && lane < 40) ? ss : 0.f);
            const float rq = __builtin_amdgcn_rsqf(sq * (1.f / 192.f) + 1e-6f), rkv = __builtin_amdgcn_rsqf(skv * (1.f / 128.f) + 1e-6f);
            if (lane < 24) { const float* g = qn + 8 * lane; v4u o; o.x = pk2(x[0] * rq * g[0], x[1] * rq * g[1]); o.y = pk2(x[2] * rq * g[2], x[3] * rq * g[3]); o.z = pk2(x[4] * rq * g[4], x[5] * rq * g[5]); o.w = pk2(x[6] * rq * g[6], x[7] * rq * g[7]);
                *(LAS v4u*)(CQN + tl * MP_CQ_LD + 8 * lane) = o; }
            else if (lane < 40) { const int c = 8 * (lane - 24); const float* g = kvn + c; v4u o; o.x = pk2(x[0] * rkv * g[0], x[1] * rkv * g[1]); o.y = pk2(x[2] * rkv * g[2], x[3] * rkv * g[3]); o.z = pk2(x[4] * rkv * g[4], x[5] * rkv * g[5]); o.w = pk2(x[6] * rkv * g[6], x[7] * rkv * g[7]);
                *(LAS v4u*)(CKVN + tl * MP_CKV_LD + c) = o; }
            if (lane < 16) { float x1 = bf2f(kr1[i]), x2 = bf2f(kr2[i]);
                if (!isctx) { const float c = RC[(t0 + tl) * 16 + lane], s = RS[(t0 + tl) * 16 + lane]; const float y1 = x1 * c - x2 * s, y2 = x1 * s + x2 * c; x1 = y1; x2 = y2; }
                const bf16 o1 = (bf16)f2bf(x1), o2 = (bf16)f2bf(x2);
#pragma unroll
                for (int h = 0; h < 4; ++h) { bf16* kr = KB + ((size_t)(b * 4 + h) * KSEQ + ki0 + tl) * 96; kr[64 + lane] = o1; kr[80 + lane] = o2; } }
        }
        __syncthreads();
        const size_t qrow0 = ((size_t)(b * 4 + head) * KSEQ + ki0) * 96;
        { f32x4 acc[3][4];
#pragma unroll
          for (int i = 0; i < 3; ++i)
#pragma unroll
              for (int m = 0; m < 4; ++m) acc[i][m] = (f32x4){0.f, 0.f, 0.f, 0.f};
#pragma unroll
          for (int ks = 0; ks < 6; ++ks)
#pragma unroll
              for (int m = 0; m < 4; ++m) { const bf16x8 xf = *(const LAS bf16x8*)(CQN + (16 * m + fr) * MP_CQ_LD + 32 * ks + 8 * kg);
#pragma unroll
                  for (int i = 0; i < 3; ++i) acc[i][m] = __builtin_amdgcn_mfma_f32_16x16x32_bf16(wq[i][ks], xf, acc[i][m], 0, 0, 0); }
#pragma unroll
          for (int m = 0; m < 4; ++m) { bf16* qr = QB + qrow0 + (size_t)(16 * m + fr) * 96;
              { v2u o; o.x = pk2(acc[0][m][0] * QSCALE, acc[0][m][1] * QSCALE); o.y = pk2(acc[0][m][2] * QSCALE, acc[0][m][3] * QSCALE); *(GAS v2u*)(qr + 48 * half + 4 * kg) = o; }
              f32x4 y1 = acc[1][m], y2 = acc[2][m];
              if (half == 1 && !isctx) { const int t = t0 + 16 * m + fr; const f32x4 c = *(const GAS f32x4*)(RC + t * 16 + 4 * kg), sn = *(const GAS f32x4*)(RS + t * 16 + 4 * kg); y1 = acc[1][m] * c - acc[2][m] * sn; y2 = acc[1][m] * sn + acc[2][m] * c; }
              v2u o1, o2; o1.x = pk2(y1[0] * QSCALE, y1[1] * QSCALE); o1.y = pk2(y1[2] * QSCALE, y1[3] * QSCALE); o2.x = pk2(y2[0] * QSCALE, y2[1] * QSCALE); o2.y = pk2(y2[2] * QSCALE, y2[3] * QSCALE);
              *(GAS v2u*)(qr + 48 * half + 16 + 4 * kg) = o1; *(GAS v2u*)(qr + 48 * half + 32 + 4 * kg) = o2; } }
        bf16x8 wkv[4][4];
#pragma unroll
        for (int nt = 0; nt < 4; ++nt)
#pragma unroll
            for (int ks = 0; ks < 4; ++ks) wkv[nt][ks] = *(const GAS bf16x8*)(WKV + (size_t)(128 * head + 64 * half + 16 * nt + fr) * 128 + 32 * ks + 8 * kg);
        { f32x4 acc[4][4];
#pragma unroll
          for (int nt = 0; nt < 4; ++nt)
#pragma unroll
              for (int m = 0; m < 4; ++m) acc[nt][m] = (f32x4){0.f, 0.f, 0.f, 0.f};
#pragma unroll
          for (int ks = 0; ks < 4; ++ks)
#pragma unroll
              for (int m = 0; m < 4; ++m) { const bf16x8 xf = *(const LAS bf16x8*)(CKVN + (16 * m + fr) * MP_CKV_LD + 32 * ks + 8 * kg);
#pragma unroll
                  for (int nt = 0; nt < 4; ++nt) acc[nt][m] = half == 0 ? __builtin_amdgcn_mfma_f32_16x16x32_bf16(wkv[nt][ks], xf, acc[nt][m], 0, 0, 0) : __builtin_amdgcn_mfma_f32_16x16x32_bf16(xf, wkv[nt][ks], acc[nt][m], 0, 0, 0); }
#pragma unroll
          for (int nt = 0; nt < 4; ++nt)
#pragma unroll
              for (int m = 0; m < 4; ++m) { v2u o; o.x = pk2(acc[nt][m][0], acc[nt][m][1]); o.y = pk2(acc[nt][m][2], acc[nt][m][3]);
                  if (half == 0) *(GAS v2u*)(KB + qrow0 + (size_t)(16 * m + fr) * 96 + 16 * nt + 4 * kg) = o;
                  else *(GAS v2u*)(VT + ((size_t)(b * 4 + head) * 64 + 16 * nt + fr) * KSEQ + ki0 + 16 * m + 4 * kg) = o; } }
        __syncthreads();
    }
}

constexpr int AT_KLD = 104, AT_VLD = 72;
constexpr int AT_KB = 64 * AT_KLD * 2, AT_VB = 64 * AT_VLD * 2, AT_BUF = AT_KB + AT_VB;
__device__ __forceinline__ void phase_attn(Frame& F, int li) { WS_DECL; frame_refresh(F);
    const bf16* QB = WSP(bf16, WS_QB); const bf16* KB = WSP(bf16, WS_KB); const bf16* VT = WSP(bf16, WS_VT); bf16* AO = WSP(bf16, WS_AO);
    const int lane = F.lane, wave = F.wave, tid = F.tid, ql = lane & 31, h2 = lane >> 5;
    const int nunits = 1024 + (li < DEPTH - 1 ? 64 : 0);
    const int c = blockIdx.x, vc = (F.G == 256) ? (c & 7) * 32 + (c >> 3) : c;
    for (int u = vc; u < nunits; u += F.G) {
        int bh, q0, nk; bool isctx = u >= 1024;
        if (!isctx) { bh = u >> 4; q0 = 256 + 256 * (u & 15); nk = KSEQ; } else { bh = u - 1024; q0 = 0; nk = 256; }
        const bf16* Kb = KB + (size_t)bh * KSEQ * 96; const bf16* Vb = VT + (size_t)bh * 64 * KSEQ;
        bf16x8 qf[6];
        { const bf16* qr = QB + ((size_t)bh * KSEQ + q0 + 32 * wave + ql) * 96 + 8 * h2;
#pragma unroll
          for (int ks = 0; ks < 6; ++ks) qf[ks] = *(const GAS bf16x8*)(qr + 16 * ks); }
        f32x16 O0, O1;
#pragma unroll
        for (int r = 0; r < 16; ++r) { O0[r] = 0.f; O1[r] = 0.f; }
        float l_run = 0.f;
        const int kc0 = tid, kc1 = tid + 512; const int vr = tid >> 3, vcn = tid & 7;
        const int ko0 = (kc0 / 12) * (AT_KLD * 2) + (kc0 % 12) * 16, ko1 = (kc1 / 12) * (AT_KLD * 2) + (kc1 % 12) * 16, vo = AT_KB + vr * (AT_VLD * 2) + vcn * 16;
        v4u pk0, pk1 = (v4u){0u, 0u, 0u, 0u}, pv;
#define AT_LOAD(t) do { const GAS v4u* ks_ = (const GAS v4u*)(Kb + (size_t)(t) * 64 * 96); pk0 = ks_[kc0]; if (kc1 < 768) pk1 = ks_[kc1]; pv = *(const GAS v4u*)(Vb + (size_t)vr * KSEQ + (t) * 64 + 8 * vcn); } while (0)
#define AT_STORE(bo) do { LAS unsigned char* b_ = F.lds + (bo); *(LAS v4u*)(b_ + ko0) = pk0; if (kc1 < 768) *(LAS v4u*)(b_ + ko1) = pk1; *(LAS v4u*)(b_ + vo) = pv; } while (0)
#define AT_QK(bo, A0, A1, INIT) do { const LAS unsigned char* b_ = F.lds + (bo); _Pragma("unroll") for (int r = 0; r < 16; ++r) { A0[r] = (INIT); A1[r] = (INIT); } \
            _Pragma("unroll") for (int kh = 0; kh < 2; ++kh) { bf16x8 kf0[3], kf1[3]; \
                _Pragma("unroll") for (int k3 = 0; k3 < 3; ++k3) { const int ks = 3 * kh + k3; kf0[k3] = *(const LAS bf16x8*)(b_ + ql * (AT_KLD * 2) + 32 * ks + 16 * h2); kf1[k3] = *(const LAS bf16x8*)(b_ + (32 + ql) * (AT_KLD * 2) + 32 * ks + 16 * h2); } \
                __builtin_amdgcn_sched_barrier(0); \
                _Pragma("unroll") for (int k3 = 0; k3 < 3; ++k3) { const int ks = 3 * kh + k3; A0 = __builtin_amdgcn_mfma_f32_32x32x16_bf16(kf0[k3], qf[ks], A0, 0, 0, 0); A1 = __builtin_amdgcn_mfma_f32_32x32x16_bf16(kf1[k3], qf[ks], A1, 0, 0, 0); } \
                __builtin_amdgcn_sched_barrier(0); } } while (0)
        const int ntile = nk >> 6;
        v4u qk0, qk1 = (v4u){0u, 0u, 0u, 0u}, qv;
#define AT_LOADB(t) do { const GAS v4u* ks_ = (const GAS v4u*)(Kb + (size_t)(t) * 64 * 96); qk0 = ks_[kc0]; if (kc1 < 768) qk1 = ks_[kc1]; qv = *(const GAS v4u*)(Vb + (size_t)vr * KSEQ + (t) * 64 + 8 * vcn); } while (0)
#define AT_STOREB(bo) do { LAS unsigned char* b_ = F.lds + (bo); *(LAS v4u*)(b_ + ko0) = qk0; if (kc1 < 768) *(LAS v4u*)(b_ + ko1) = qk1; *(LAS v4u*)(b_ + vo) = qv; } while (0)
        AT_LOAD(0); AT_LOADB(1);
        __syncthreads();
        AT_STORE(0); AT_STOREB(AT_BUF);
        AT_LOAD(2); AT_LOADB(3);
        __syncthreads();
        int bo0 = 0, bo1 = AT_BUF, bo2 = 2 * AT_BUF;
        float m_ref = 0.f;
#define AT_BODY(KT, STOREX, LOADX) do { const int kt_ = (KT); \
            if (kt_ + 2 < ntile) STOREX(bo2); if (kt_ + 4 < ntile) LOADX(kt_ + 4); \
            f32x16 S0, S1; AT_QK(bo0, S0, S1, -m_ref); \
            float mxa = fmaxf(fmaxf(S0[0], S0[1]), S0[2]), mxb = fmaxf(fmaxf(S0[3], S0[4]), S0[5]), mxc = fmaxf(fmaxf(S1[0], S1[1]), S1[2]), mxd = fmaxf(fmaxf(S1[3], S1[4]), S1[5]); \
            _Pragma("unroll") for (int r = 6; r < 16; r += 2) { mxa = fmaxf(mxa, S0[r]); mxb = fmaxf(mxb, S0[r + 1]); mxc = fmaxf(mxc, S1[r]); mxd = fmaxf(mxd, S1[r + 1]); } \
            float mx = fmaxf(fmaxf(mxa, mxb), fmaxf(mxc, mxd)); \
            mx = fmaxf(mx, __shfl_xor(mx, 32)); \
            if (__any(mx > 8.f) || kt_ == 0) { const float delta = kt_ == 0 ? mx : fmaxf(mx, 0.f); const float alpha = __builtin_amdgcn_exp2f(-delta); m_ref += delta; l_run *= alpha; \
                _Pragma("unroll") for (int r = 0; r < 16; ++r) { O0[r] *= alpha; O1[r] *= alpha; S0[r] -= delta; S1[r] -= delta; } } \
            float ps0 = 0.f, ps1 = 0.f, ps2 = 0.f, ps3 = 0.f; \
            _Pragma("unroll") for (int r = 0; r < 16; r += 2) { S0[r] = __builtin_amdgcn_exp2f(S0[r]); S1[r] = __builtin_amdgcn_exp2f(S1[r]); S0[r + 1] = __builtin_amdgcn_exp2f(S0[r + 1]); S1[r + 1] = __builtin_amdgcn_exp2f(S1[r + 1]); ps0 += S0[r]; ps1 += S1[r]; ps2 += S0[r + 1]; ps3 += S1[r + 1]; } \
            l_run += (ps0 + ps1) + (ps2 + ps3); \
            union { bf16x8 v; unsigned u[4]; } p00, p01, p10, p11; \
            _Pragma("unroll") for (int j = 0; j < 4; ++j) { p00.u[j] = pk2(S0[2 * j], S0[2 * j + 1]); p01.u[j] = pk2(S0[8 + 2 * j], S0[8 + 2 * j + 1]); p10.u[j] = pk2(S1[2 * j], S1[2 * j + 1]); p11.u[j] = pk2(S1[8 + 2 * j], S1[8 + 2 * j + 1]); } \
            const LAS unsigned char* vb = F.lds + bo0 + AT_KB; \
            _Pragma("unroll") for (int dvt = 0; dvt < 2; ++dvt) { const LAS unsigned char* vrow = vb + (32 * dvt + ql) * (AT_VLD * 2) + 8 * h2; union { bf16x8 v; v2u h[2]; } vf[4]; \
                _Pragma("unroll") for (int ss = 0; ss < 4; ++ss) { vf[ss].h[0] = *(const LAS v2u*)(vrow + 2 * (16 * ss)); vf[ss].h[1] = *(const LAS v2u*)(vrow + 2 * (16 * ss + 8)); } \
                __builtin_amdgcn_sched_barrier(0); \
                if (dvt == 0) { O0 = __builtin_amdgcn_mfma_f32_32x32x16_bf16(vf[0].v, p00.v, O0, 0, 0, 0); O0 = __builtin_amdgcn_mfma_f32_32x32x16_bf16(vf[1].v, p01.v, O0, 0, 0, 0); O0 = __builtin_amdgcn_mfma_f32_32x32x16_bf16(vf[2].v, p10.v, O0, 0, 0, 0); O0 = __builtin_amdgcn_mfma_f32_32x32x16_bf16(vf[3].v, p11.v, O0, 0, 0, 0); } \
                else { O1 = __builtin_amdgcn_mfma_f32_32x32x16_bf16(vf[0].v, p00.v, O1, 0, 0, 0); O1 = __builtin_amdgcn_mfma_f32_32x32x16_bf16(vf[1].v, p01.v, O1, 0, 0, 0); O1 = __builtin_amdgcn_mfma_f32_32x32x16_bf16(vf[2].v, p10.v, O1, 0, 0, 0); O1 = __builtin_amdgcn_mfma_f32_32x32x16_bf16(vf[3].v, p11.v, O1, 0, 0, 0); } \
                __builtin_amdgcn_sched_barrier(0); } \
            __syncthreads(); \
            { const int t_ = bo0; bo0 = bo1; bo1 = bo2; bo2 = t_; } } while (0)
        for (int kt = 0; kt < ntile; kt += 2) {
            AT_BODY(kt, AT_STORE, AT_LOAD);
            AT_BODY(kt + 1, AT_STOREB, AT_LOADB);
        }
#undef AT_BODY
#undef AT_LOADB
#undef AT_STOREB
#undef AT_LOAD
#undef AT_STORE
#undef AT_QK
        const float inv = 1.f / (l_run + __shfl_xor(l_run, 32));
        const int b = bh >> 2, head = bh & 3, qi = q0 + 32 * wave + ql;
        const size_t row = isctx ? (size_t)NL + b * 256 + qi : (size_t)b * 4096 + (qi - 256);
        bf16* orow = AO + row * 256 + head * 64 + 4 * h2;
#pragma unroll
        for (int g = 0; g < 4; ++g) { v2u o0, o1; o0.x = pk2(O0[4 * g] * inv, O0[4 * g + 1] * inv); o0.y = pk2(O0[4 * g + 2] * inv, O0[4 * g + 3] * inv); o1.x = pk2(O1[4 * g] * inv, O1[4 * g + 1] * inv); o1.y = pk2(O1[4 * g + 2] * inv, O1[4 * g + 3] * inv);
            *(GAS v2u*)(orow + 8 * g) = o0; *(GAS v2u*)(orow + 32 + 8 * g) = o1; }
    }
}

__device__ __forceinline__ void phase_fin_mla(Frame& F, int li) { WS_DECL; frame_refresh(F);
    const int nrows = li == DEPTH - 1 ? NL : NT; const float* g = in_ptr(I_MLAON) + li * 256; const bf16* AO = WSP(bf16, WS_AO); bf16* MIX = WSP(bf16, WS_A1);
    const int gw = blockIdx.x * NWAVES + F.wave, NGW = F.G * NWAVES; const f32x4 g4 = *(const GAS f32x4*)(g + 4 * F.lane);
    for (int m = gw; m < nrows; m += NGW) { const v2u w = *(const GAS v2u*)(AO + (size_t)m * 256 + 4 * F.lane);
        f32x4 x; x.x = bflo(w.x); x.y = bfhi(w.x); x.z = bflo(w.y); x.w = bfhi(w.y);
        const float r = __builtin_amdgcn_rsqf(wave_sum(x.x * x.x + x.y * x.y + x.z * x.z + x.w * x.w) * (1.f / 256.f) + 1e-6f);
        v2u o; o.x = pk2(x.x * r * g4.x, x.y * r * g4.y); o.y = pk2(x.z * r * g4.z, x.w * r * g4.w); *(GAS v2u*)(MIX + (size_t)m * D + 4 * F.lane) = o; }
}
__device__ __forceinline__ void phase_fin_zero(Frame& F, int li, int c0) { WS_DECL; frame_refresh(F);
    const int nrows = li == DEPTH - 1 ? NL : NT; bf16* MIX = WSP(bf16, WS_A1); const int gw = blockIdx.x * NWAVES + F.wave, NGW = F.G * NWAVES;
    for (int m = gw; m < nrows; m += NGW) *(GAS v2u*)(MIX + (size_t)m * D + c0 + 4 * F.lane) = (v2u){0u, 0u};
}

__device__ __forceinline__ void phase_pro0b(Frame& F) { WS_DECL; frame_refresh(F);
    const int gt = blockIdx.x * NTHR + F.tid, NGT = F.G * NTHR;
    float* RC = WSP(float, WS_ROPE); float* RS = RC + 4096 * 16;
    for (int i = gt; i < 4096 * 16; i += NGT) { const int t = i >> 4, j = i & 15; const float inv = powf(10000.f, -(float)(j & 7) / 8.f); const float pos = j < 8 ? (float)(t >> 6) : (float)(t & 63);
        const float ang = pos * inv; RC[i] = cosf(ang); RS[i] = sinf(ang); }
    const float* wuq = in_ptr(I_WUQ); const float* wukv = in_ptr(I_WUKV); bf16* WQ = WSP(bf16, WS_WUQT); bf16* WKV = WSP(bf16, WS_WUKVT);
    for (int i = gt; i < DEPTH * 384 * 192; i += NGT) { const int li = i / (384 * 192), r = i % (384 * 192), n = r / 192, k = r % 192; WQ[i] = (bf16)f2bf(wuq[(size_t)li * 192 * 384 + (size_t)k * 384 + n]); }
    for (int i = gt; i < DEPTH * 512 * 128; i += NGT) { const int li = i / (512 * 128), r = i % (512 * 128), n = r / 128, k = r % 128; WKV[i] = (bf16)f2bf(wukv[(size_t)li * 128 * 512 + (size_t)k * 512 + n]); }
}

constexpr int LR_LD = 264;
__device__ __forceinline__ float gelu_tanh(float x) { const float u = 0.7978845608028654f * (x + 0.044715f * x * x * x); const float e = __expf(2.f * u); const float t = 1.f - 2.f / (e + 1.f); return 0.5f * x * (1.f + t); }
template <int PASS>
__device__ __forceinline__ void phase_lru(Frame& F, int li) { WS_DECL; frame_refresh(F);
    LAS bf16* RAW = (LAS bf16*)F.lds; LAS bf16* U = (LAS bf16*)(F.lds + 67 * LR_LD * 2); LAS bf16* HS = (LAS bf16*)(F.lds + 71680);
    const bf16* P = WSP(bf16, WS_P); bf16* MIX = WSP(bf16, WS_A1); f32x2* SUMM = WSP(f32x2, WS_SUMM);
    const float* cw = in_ptr(I_LCW) + li * 4 * 256; const float* cb = in_ptr(I_LCB) + li * 256;
    const float* lam_ = in_ptr(I_LLAM) + li * 512; const float* br_ = in_ptr(I_LBR) + li * 512; const float* bi_ = in_ptr(I_LBI) + li * 512; const float* on_ = in_ptr(I_LON) + li * 256;
    const bf16* LW = WSP(bf16, WS_LRUW) + (size_t)li * 16 * 4096;
    const int lane = F.lane, wave = F.wave, tid = F.tid, fr = lane & 15, kg = lane >> 4;
    const int nitems = (PASS == 3 && li == DEPTH - 1) ? NL / 64 : NT / 64;
    for (int item = blockIdx.x; item < nitems; item += F.G) {
        const int m0 = item * 64; const bool isctx = m0 >= NL; const int b = isctx ? (m0 - NL) >> 8 : m0 >> 12; const int t0 = isctx ? (m0 - NL) & 255 : m0 & 4095; const int Ls = isctx ? 256 : 4096;
        const size_t seg0 = isctx ? (size_t)NL + b * 256 : (size_t)b * 4096;
        for (int c = tid; c < 67 * 32; c += NTHR) { const int r = c >> 5, cc = c & 31, t = t0 - 2 + r; v4u v = (v4u){0u, 0u, 0u, 0u};
            if (t >= 0 && t < Ls) v = *(const GAS v4u*)(P + (seg0 + t) * PCOLS + 352 + 8 * cc);
            *(LAS v4u*)(RAW + r * LR_LD + 8 * cc) = v; }
        __syncthreads();
        { const int c2 = tid & 127, tq = tid >> 7; const int ch = 2 * c2;
          float w0[4], w1[4];
#pragma unroll
          for (int j = 0; j < 4; ++j) { w0[j] = cw[j * 256 + ch]; w1[j] = cw[j * 256 + ch + 1]; }
          const float b0 = cb[ch], b1 = cb[ch + 1];
          for (int t = tq * 16; t < tq * 16 + 16; ++t) { float s0 = b0, s1 = b1;
#pragma unroll
              for (int j = 0; j < 4; ++j) { const unsigned w = *(const LAS unsigned*)(RAW + (t + j) * LR_LD + ch); s0 += w0[j] * bflo(w); s1 += w1[j] * bfhi(w); }
              *(LAS unsigned*)(U + t * LR_LD + ch) = pk2(s0, s1); } }
        __syncthreads();
#pragma unroll 1
        for (int ni = 0; ni < 2; ++ni) {
            float yv[4][4];
            const int nt = 2 * wave + ni, nb = nt >> 2, ch = 16 * nt + fr;
            bf16x8 wfr[2][2][2]; float spc[2], brc[2], bic[2];
#pragma unroll
            for (int d = 0; d < 2; ++d) { spc[d] = lam_[d * 256 + ch]; brc[d] = br_[d * 256 + ch]; bic[d] = bi_[d * 256 + ch];
#pragma unroll
                for (int g = 0; g < 2; ++g)
#pragma unroll
                    for (int ks = 0; ks < 2; ++ks) wfr[d][g][ks] = *(const GAS bf16x8*)(LW + ((size_t)((g * 2 + d) * 4 + nb) * 64 + 16 * (nt & 3) + fr) * 64 + 32 * ks + 8 * kg); }
            float uu[4][4];
#pragma unroll
            for (int m = 0; m < 4; ++m)
#pragma unroll
                for (int r = 0; r < 4; ++r) uu[m][r] = bf2f(U[(16 * m + 4 * kg + r) * LR_LD + ch]);
#pragma unroll
            for (int d = 0; d < 2; ++d) {
                f32x4 ar[4], ai[4];
#pragma unroll
                for (int m = 0; m < 4; ++m) { ar[m] = (f32x4){0.f, 0.f, 0.f, 0.f}; ai[m] = (f32x4){0.f, 0.f, 0.f, 0.f}; }
#pragma unroll
                for (int ks = 0; ks < 2; ++ks) {
                    const bf16x8 wr = wfr[d][0][ks], wi = wfr[d][1][ks];
#pragma unroll
                    for (int m = 0; m < 4; ++m) { const bf16x8 xf = *(const LAS bf16x8*)(U + (16 * m + fr) * LR_LD + 64 * nb + 32 * ks + 8 * kg);
                        ar[m] = __builtin_amdgcn_mfma_f32_16x16x32_bf16(xf, wr, ar[m], 0, 0, 0); ai[m] = __builtin_amdgcn_mfma_f32_16x16x32_bf16(xf, wi, ai[m], 0, 0, 0); } }
                const float sp = __logf(1.f + __expf(-spc[d])), brv = brc[d], biv = bic[d];
#pragma unroll
                for (int m = 0; m < 4; ++m)
#pragma unroll
                    for (int r = 0; r < 4; ++r) { const float rg = __builtin_amdgcn_rcpf(1.f + __expf(-(ar[m][r] + brv))), ig = __builtin_amdgcn_rcpf(1.f + __expf(-(ai[m][r] + biv))); const float av = __expf(-8.f * rg * sp);
                        ar[m][r] = av; ai[m][r] = __builtin_amdgcn_sqrtf(fmaxf(1.f - av * av, 0.f)) * (ig * uu[m][r]); }
                float H = 0.f;
                if (PASS == 3) {
                    const int cj = t0 >> 6, cbase = 1024 + b * 4, lbase = b * 64;
                    const int np = d == 0 ? (isctx ? cj : 4 + cj) : (isctx ? 3 - cj : 4 + 63 - cj);
                    const int q = (np + 3) >> 2, p_lo = kg * q, p_hi = (p_lo + q < np) ? p_lo + q : np;
                    float Aq = 1.f, Bq = 0.f;
                    for (int p0 = p_lo; p0 < p_hi; p0 += 8) { f32x2 sv[8];
#pragma unroll
                        for (int e = 0; e < 8; ++e) { const int p = p0 + e; sv[e] = (f32x2){1.f, 0.f};
                            if (p < p_hi) { int cid; if (d == 0) cid = isctx ? cbase + p : (p < 4 ? cbase + p : lbase + (p - 4)); else cid = isctx ? cbase + 3 - p : (p < 4 ? cbase + 3 - p : lbase + 63 - (p - 4));
                                sv[e] = *(const GAS f32x2*)(SUMM + ((size_t)cid * 2 + d) * 256 + ch); } }
#pragma unroll
                        for (int e = 0; e < 8; ++e) { Bq = sv[e].x * Bq + sv[e].y; Aq = sv[e].x * Aq; } }
#pragma unroll
                    for (int g = 0; g < 4; ++g) { const float Ag_ = __shfl(Aq, fr + 16 * g), Bg_ = __shfl(Bq, fr + 16 * g); H = Ag_ * H + Bg_; }
                }
                float Ac = 1.f, Bc = 0.f;
#pragma unroll
                for (int mi = 0; mi < 4; ++mi) { const int m = d == 0 ? mi : 3 - mi;
                    float Al, Bl;
                    if (d == 0) { Al = ar[m][0] * ar[m][1] * ar[m][2] * ar[m][3]; Bl = ((ai[m][0] * ar[m][1] + ai[m][1]) * ar[m][2] + ai[m][2]) * ar[m][3] + ai[m][3]; }
                    else { Al = ar[m][0] * ar[m][1] * ar[m][2] * ar[m][3]; Bl = ((ai[m][3] * ar[m][2] + ai[m][2]) * ar[m][1] + ai[m][1]) * ar[m][0] + ai[m][0]; }
                    float Ag[4], Bg[4];
#pragma unroll
                    for (int g = 0; g < 4; ++g) { Ag[g] = __shfl(Al, fr + 16 * g); Bg[g] = __shfl(Bl, fr + 16 * g); }
                    if (PASS == 1) {
                        float At = 1.f, Bt = 0.f;
#pragma unroll
                        for (int gi = 0; gi < 4; ++gi) { const int g = d == 0 ? gi : 3 - gi; Bt = Ag[g] * Bt + Bg[g]; At = Ag[g] * At; }
                        Bc = At * Bc + Bt; Ac = At * Ac;
                    } else {
                        float s = H, sin_ = H;
#pragma unroll
                        for (int gi = 0; gi < 4; ++gi) { const int g = d == 0 ? gi : 3 - gi; if (g == kg) sin_ = s; s = Ag[g] * s + Bg[g]; }
                        H = s;
                        float x = sin_;
#pragma unroll
                        for (int ri = 0; ri < 4; ++ri) { const int r = d == 0 ? ri : 3 - ri; x = ar[m][r] * x + ai[m][r]; if (d == 0) yv[m][r] = x; else yv[m][r] += x; }
                    }
                }
                if (PASS == 1 && kg == 0) *(GAS f32x2*)(SUMM + ((size_t)item * 2 + d) * 256 + ch) = (f32x2){Ac, Bc};
            }
            if (PASS == 3) {
#pragma unroll
                for (int m = 0; m < 4; ++m)
#pragma unroll
                    for (int r = 0; r < 4; ++r) HS[(16 * m + 4 * kg + r) * LR_LD + ch] = (bf16)f2bf(yv[m][r]);
            }
        }
        if (PASS == 3) {
            __syncthreads();
            const f32x4 on4 = *(const GAS f32x4*)(on_ + 4 * lane);
            for (int i = 0; i < 8; ++i) { const int tl = wave * 8 + i; const v2u hw = *(const LAS v2u*)(HS + tl * LR_LD + 4 * lane); const v2u gw = *(const GAS v2u*)(P + (size_t)(m0 + tl) * PCOLS + 608 + 4 * lane);
                f32x4 y; y.x = bflo(hw.x) * gelu_tanh(bflo(gw.x)); y.y = bfhi(hw.x) * gelu_tanh(bfhi(gw.x)); y.z = bflo(hw.y) * gelu_tanh(bflo(gw.y)); y.w = bfhi(hw.y) * gelu_tanh(bfhi(gw.y));
                const float rs = __builtin_amdgcn_rsqf(wave_sum(y.x * y.x + y.y * y.y + y.z * y.z + y.w * y.w) * (1.f / 256.f) + 1e-6f);
                v2u o; o.x = pk2(y.x * rs * on4.x, y.y * rs * on4.y); o.y = pk2(y.z * rs * on4.z, y.w * rs * on4.w);
                *(GAS v2u*)(MIX + (size_t)(m0 + tl) * D + 256 + 4 * lane) = o; }
        }
        __syncthreads();
    }
}

__device__ __forceinline__ void phase_pro0c(Frame& F) { WS_DECL; frame_refresh(F);
    const int gt = blockIdx.x * NTHR + F.tid, NGT = F.G * NTHR; const float* wr = in_ptr(I_LWR); const float* wi = in_ptr(I_LWI); bf16* LW = WSP(bf16, WS_LRUW);
    for (int i = gt; i < DEPTH * 16 * 4096; i += NGT) { const int c = i & 63, dd = (i >> 6) & 63, nb = (i >> 12) & 3, d = (i >> 14) & 1, g = (i >> 15) & 1, li = i >> 16;
        const float* src = g == 0 ? wr : wi; LW[i] = (bf16)f2bf(src[((((size_t)li * 2 + d) * 4 + nb) * 64 + c) * 64 + dd]); }
}

template <int CTRL> __device__ __forceinline__ float dpp_f(float x) { return __builtin_bit_cast(float, __builtin_amdgcn_mov_dpp(__builtin_bit_cast(int, x), CTRL, 0xf, 0xf, true)); }
__device__ __forceinline__ float rowsum16(float x) { x += dpp_f<0x128>(x); x += dpp_f<0x124>(x); x += dpp_f<0x122>(x); x += dpp_f<0x121>(x); return x; }
constexpr int RW_C0 = 864;
constexpr size_t WS_RWUP = WS_LRUW + 512 * 1024;
constexpr size_t WS_EA = WS_Y;

__device__ __forceinline__ void phase_pro0e(Frame& F) { WS_DECL; frame_refresh(F);
    const int gt = blockIdx.x * NTHR + F.tid, NGT = F.G * NTHR; const float* wup = in_ptr(I_WUP); const float* aup = in_ptr(I_AUP); bf16* W = WSP(bf16, WS_RWUP);
    for (int i = gt; i < DEPTH * 2 * 2 * 256 * 32; i += NGT) { const int k = i & 31, n = (i >> 5) & 255, wa = (i >> 13) & 1, d = (i >> 14) & 1, li = i >> 15;
        const float* src = wa == 0 ? wup : aup; W[i] = (bf16)f2bf(src[(((size_t)li * 2 + d) * 32 + k) * 256 + n]); }
}

constexpr int R0_LD = 136, R0_ZLD = 72;
__device__ __forceinline__ void phase_rwkv_r0(Frame& F, int li) { WS_DECL; frame_refresh(F);
    LAS bf16* RAWL = (LAS bf16*)F.lds;
    LAS bf16* ZW = (LAS bf16*)(F.lds + 66 * R0_LD * 2);
    LAS bf16* ZA = ZW + 64 * R0_ZLD;
    const bf16* P = WSP(bf16, WS_P); bf16* EA = WSP(bf16, WS_EA); const bf16* W = WSP(bf16, WS_RWUP) + (size_t)li * 2 * 2 * 256 * 32;
    const float* mup = in_ptr(I_MUP) + li * 960 + 768; const float* mun = in_ptr(I_MUN) + li * 960 + 768; const float* w0 = in_ptr(I_W0) + li * 512; const float* a0 = in_ptr(I_A0) + li * 512;
    const int tid = F.tid, lane = F.lane, wave = F.wave, fr = lane & 15, kg = lane >> 4;
    for (int item = blockIdx.x; item < NT / 64; item += F.G) {
        const int m0 = item * 64; const bool isctx = m0 >= NL; const int t0 = isctx ? (m0 - NL) & 255 : m0 & 4095; const int Ls = isctx ? 256 : 4096; const size_t seg0 = (size_t)m0 - t0;
        __syncthreads();
        for (int c = tid; c < 66 * 16; c += NTHR) { const int r = c >> 4, cc = c & 15, t = t0 - 1 + r; v4u v = (v4u){0u, 0u, 0u, 0u};
            if (t >= 0 && t < Ls) v = *(const GAS v4u*)(P + (seg0 + t) * PCOLS + RW_C0 + 768 + 8 * cc);
            *(LAS v4u*)(RAWL + r * R0_LD + 8 * cc) = v; }
        __syncthreads();
        { const int c = tid & 127, tq = tid >> 7; const float mp = mup[c], mn = mun[c];
          for (int tl = tq * 16; tl < tq * 16 + 16; ++tl) { const float x = bf2f(RAWL[(tl + 1) * R0_LD + c]), xp = bf2f(RAWL[tl * R0_LD + c]), xn = bf2f(RAWL[(tl + 2) * R0_LD + c]);
              const float z = x + mp * (xp - x) + mn * (xn - x);
              if (c < 64) { const float e2 = __expf(2.f * z); ZW[tl * R0_ZLD + c] = (bf16)f2bf(1.f - 2.f * __builtin_amdgcn_rcpf(e2 + 1.f)); } else ZA[tl * R0_ZLD + (c - 64)] = (bf16)f2bf(z); } }
        __syncthreads();
        const int d = wave >> 2, hh = wave & 3;
#pragma unroll 1
        for (int nt = 0; nt < 4; ++nt) { const int ch0 = 64 * hh + 16 * nt;
            const bf16x8 wf = *(const GAS bf16x8*)(W + ((size_t)(d * 2 + 0) * 256 + ch0 + fr) * 32 + 8 * kg), af = *(const GAS bf16x8*)(W + ((size_t)(d * 2 + 1) * 256 + ch0 + fr) * 32 + 8 * kg);
            const f32x4 w04 = *(const GAS f32x4*)(w0 + d * 256 + ch0 + 4 * kg), a04 = *(const GAS f32x4*)(a0 + d * 256 + ch0 + 4 * kg);
#pragma unroll
            for (int m = 0; m < 4; ++m) { const bf16x8 zw = *(const LAS bf16x8*)(ZW + (16 * m + fr) * R0_ZLD + 32 * d + 8 * kg), za = *(const LAS bf16x8*)(ZA + (16 * m + fr) * R0_ZLD + 32 * d + 8 * kg);
                f32x4 xw = __builtin_amdgcn_mfma_f32_16x16x32_bf16(wf, zw, (f32x4){0.f, 0.f, 0.f, 0.f}, 0, 0, 0), xa = __builtin_amdgcn_mfma_f32_16x16x32_bf16(af, za, (f32x4){0.f, 0.f, 0.f, 0.f}, 0, 0, 0);
                xw = xw + w04; xa = xa + a04; float e[4], av[4];
#pragma unroll
                for (int r = 0; r < 4; ++r) { e[r] = -0.6065306597126334f * __builtin_amdgcn_rcpf(1.f + __expf(-xw[r])); av[r] = __builtin_amdgcn_rcpf(1.f + __expf(-xa[r])); }
                const size_t tok = (size_t)m0 + 16 * m + fr; v2u oe, oa; oe.x = pk2(e[0], e[1]); oe.y = pk2(e[2], e[3]); oa.x = pk2(av[0], av[1]); oa.y = pk2(av[2], av[3]);
                *(GAS v2u*)(EA + (tok * 4 + d) * 256 + ch0 + 4 * kg) = oe; *(GAS v2u*)(EA + (tok * 4 + 2 + d) * 256 + ch0 + 4 * kg) = oa; } }
    }
    __syncthreads();
}

constexpr int RW_T = 16, RW_NCH = (LCX + SEQ) / RW_T, RW_ROWS = RW_T + 2, RW_LD = 200, RW_P = 72;
constexpr int RW_RAW = 0, RW_RAWB = RW_ROWS * RW_LD * 2;
constexpr int RW_EAB = RW_RAW + 2 * RW_RAWB, RW_EABB = RW_T * 128 * 2;
constexpr int RW_VEC = RW_EAB + 2 * RW_EABB, RW_VECB = RW_T * 4 * 64 * 2 + RW_T * 64 * 4;
constexpr int RW_VV = RW_VEC + 2 * RW_VECB;
constexpr int RW_BON = RW_VV + 8 * 1024;
constexpr int RW_ARA = RW_BON + 8 * 64;
constexpr int RW_KB2 = RW_ARA + 2 * 16 * RW_P * 2;
constexpr int RW_AT2 = RW_KB2 + 2 * 32 * RW_P * 2;
constexpr int RW_ARR = RW_AT2 + 4 * 2048;
constexpr int RW_KT = RW_ARR + 4 * 16 * RW_P * 2;
constexpr int RW_BTN = RW_KT + 4 * 2048;
constexpr int RW_CWT = RW_BTN + 4 * 2048;
constexpr int RW_DO = RW_CWT + 4 * 256;
constexpr int RW_DOB = 16 * RW_P * 2 + 3 * 512;
constexpr int RW_BC = RW_DO + 4 * RW_DOB;
constexpr int RW_END = RW_BC + 9 * 256;
static_assert(RW_END <= RING_BYTES, "rwkv lds map");
typedef LAS bf16* lbf;
__device__ __forceinline__ bf16x8 rw_zero8() { return (bf16x8){0, 0, 0, 0, 0, 0, 0, 0}; }
__device__ __forceinline__ bf16x8 rw_k16(const LAS bf16* rowp, int kg) { bf16x8 r = rw_zero8(); if (kg < 2) r = *(const LAS bf16x8*)(rowp + 8 * kg); return r; }
__device__ __forceinline__ bf16x8 rw_perm4(const LAS bf16* rowp, int kg) { union { bf16x8 v; v2u h[2]; } u; u.h[0] = *(const LAS v2u*)(rowp + 4 * kg); u.h[1] = (v2u){0u, 0u}; return u.v; }
__device__ __forceinline__ bf16x8 rw_permK(const LAS bf16* rowp, int kg, int sp) { union { bf16x8 v; v2u h[2]; } u; u.h[0] = *(const LAS v2u*)(rowp + 32 * sp + 4 * kg); u.h[1] = *(const LAS v2u*)(rowp + 32 * sp + 16 + 4 * kg); return u.v; }
__device__ __forceinline__ bf16x8 rw_c4(f32x4 c) { union { bf16x8 v; unsigned u[4]; } x; x.u[0] = pk2(c[0], c[1]); x.u[1] = pk2(c[2], c[3]); x.u[2] = 0u; x.u[3] = 0u; return x.v; }
__device__ __forceinline__ bf16x8 rw_c8(f32x4 c0, f32x4 c1) { union { bf16x8 v; unsigned u[4]; } x; x.u[0] = pk2(c0[0], c0[1]); x.u[1] = pk2(c0[2], c0[3]); x.u[2] = pk2(c1[0], c1[1]); x.u[3] = pk2(c1[2], c1[3]); return x.v; }
__device__ __forceinline__ void rw_st_rows(lbf M, f32x4 c, int fr, int kg) {
#pragma unroll
    for (int r = 0; r < 4; ++r) M[(4 * kg + r) * 16 + fr] = (bf16)f2bf(c[r]); }
__device__ __forceinline__ void rw_st_cols(lbf M, f32x4 c, int fr, int kg, int pitch) {
    v2u o; o.x = pk2(c[0], c[1]); o.y = pk2(c[2], c[3]); *(LAS v2u*)(M + fr * pitch + 4 * kg) = o; }
#define RW_MFMA(a, b, c) __builtin_amdgcn_mfma_f32_16x16x32_bf16(a, b, c, 0, 0, 0)

__device__ __forceinline__ void phase_rwkv_scan(Frame& F, int li) { WS_DECL; frame_refresh(F);
    const bf16* P = WSP(bf16, WS_P); const bf16* EA = WSP(bf16, WS_EA); float* YR = WSP(float, WS_YR); float* BON = WSP(float, WS_BON);

    const int tid = F.tid, lane = F.lane, wave = F.wave, fr = lane & 15, kg = lane >> 4;
    LAS unsigned char* L = F.lds;
    for (int item = blockIdx.x; item < 256; item += F.G) {
        const int vhalf = item & 1, d = (item >> 1) & 1, h = (item >> 2) & 3, b = item >> 4;
        __syncthreads();
        const int pt = (tid - 128) & 255, ps = pt >> 4, pq = pt & 15;
        const int sk = pt & 63, sq = pt >> 6;
        { LAS float* BC = (LAS float*)(L + RW_BC); const float* mup = in_ptr(I_MUP) + li * 960; const float* mun = in_ptr(I_MUN) + li * 960;
          if (tid < 64) { const int c = 64 * h + tid; BC[tid] = mup[c]; BC[64 + tid] = mup[256 + c]; BC[128 + tid] = mup[512 + c]; BC[192 + tid] = mun[c]; BC[256 + tid] = mun[256 + c]; BC[320 + tid] = mun[512 + c];
              BC[384 + tid] = in_ptr(I_KK)[li * 256 + c]; BC[448 + tid] = in_ptr(I_KA)[li * 256 + c]; BC[512 + tid] = in_ptr(I_RK)[li * 256 + c]; } }
        __syncthreads();
        f32x4 S0 = (f32x4){0.f, 0.f, 0.f, 0.f}, S1 = S0, S2 = S0, S3 = S0;
        v4u ra[11];
#pragma unroll
        for (int q = 0; q < 11; ++q) ra[q] = (v4u){0u, 0u, 0u, 0u};
        if (wave < 2) {
#pragma unroll 1
            for (int it = -8; it <= RW_NCH; ++it) {
                if (it >= 0 && it < RW_NCH) {
                    const lbf VV = (lbf)(L + RW_VV + (it & 7) * 1024), ARR = (lbf)(L + RW_ARR + (it & 3) * (16 * RW_P * 2)), KT = (lbf)(L + RW_KT + (it & 3) * 2048), BTN = (lbf)(L + RW_BTN + (it & 3) * 2048);
                    const LAS float* CWT = (const LAS float*)(L + RW_CWT + (it & 3) * 256);
                    const lbf APT = (lbf)(L + RW_DO + (it & 3) * RW_DOB), AMT = APT + 16 * RW_P, ARKT = AMT + 256, ARBTN = ARKT + 256;
                    const f32x4 Z = (f32x4){0.f, 0.f, 0.f, 0.f};
                    const bf16x8 bvv = rw_k16(VV + (16 * wave + fr) * 16, kg);
                    const bf16x8 sb0 = rw_c8(S0, S1), sb1 = rw_c8(S2, S3);
                    f32x4 UT = RW_MFMA(rw_k16(AMT + fr * 16, kg), bvv, Z);
                    UT = RW_MFMA(rw_permK(APT + fr * RW_P, kg, 0), sb0, UT); UT = RW_MFMA(rw_permK(APT + fr * RW_P, kg, 1), sb1, UT);
                    f32x4 YT = RW_MFMA(rw_k16(ARKT + fr * 16, kg), bvv, Z);
                    YT = RW_MFMA(rw_permK(ARR + fr * RW_P, kg, 0), sb0, YT); YT = RW_MFMA(rw_permK(ARR + fr * RW_P, kg, 1), sb1, YT);
                    const bf16x8 ub = rw_c4(UT);
                    YT = RW_MFMA(rw_perm4(ARBTN + fr * 16, kg), ub, YT);
                    { const bool isctx = it < LCX / RW_T;
                      if (!isctx || li < DEPTH - 1) { const int cl = isctx ? it : it - LCX / RW_T; const int Ls = isctx ? LCX : SEQ; const int tlo = d == 0 ? cl * RW_T : Ls - RW_T - cl * RW_T; const size_t seg0 = isctx ? (size_t)NL + b * LCX : (size_t)b * SEQ;
#pragma unroll
                          for (int r = 0; r < 4; ++r) { const int sidx = 4 * kg + r; const int t = d == 0 ? tlo + sidx : tlo + RW_T - 1 - sidx;
                              YR[((size_t)d * NT + seg0 + t) * 256 + 64 * h + 32 * vhalf + 16 * wave + fr] = YT[r]; }
                          if (vhalf == 0 && wave == 0 && lane < RW_T) { const LAS float* BONS = (const LAS float*)(L + RW_BON) + (it & 7) * RW_T; const int t = d == 0 ? tlo + lane : tlo + RW_T - 1 - lane;
                              BON[((size_t)d * NT + seg0 + t) * 4 + h] = BONS[lane]; } } }
                    { f32x4 q = RW_MFMA(rw_k16(KT + (0 + fr) * 16, kg), bvv, S0); q = RW_MFMA(rw_perm4(BTN + (0 + fr) * 16, kg), ub, q); S0 = q * *(const LAS f32x4*)(CWT + 0 + 4 * kg); }
                    { f32x4 q = RW_MFMA(rw_k16(KT + (16 + fr) * 16, kg), bvv, S1); q = RW_MFMA(rw_perm4(BTN + (16 + fr) * 16, kg), ub, q); S1 = q * *(const LAS f32x4*)(CWT + 16 + 4 * kg); }
                    { f32x4 q = RW_MFMA(rw_k16(KT + (32 + fr) * 16, kg), bvv, S2); q = RW_MFMA(rw_perm4(BTN + (32 + fr) * 16, kg), ub, q); S2 = q * *(const LAS f32x4*)(CWT + 32 + 4 * kg); }
                    { f32x4 q = RW_MFMA(rw_k16(KT + (48 + fr) * 16, kg), bvv, S3); q = RW_MFMA(rw_perm4(BTN + (48 + fr) * 16, kg), ub, q); S3 = q * *(const LAS f32x4*)(CWT + 48 + 4 * kg); }
                }
                __syncthreads();
            }
        } else if (wave < 6) {
            int offq[11], ldq[11];
#pragma unroll
            for (int q = 0; q < 11; ++q) { const int c = lane + 64 * q; int o = 0, l = -1;
                if (c < RW_ROWS * 24) { const int r = c / 24, cc = c % 24; o = r * (PCOLS * 2) + 2 * (RW_C0 + 256 * (cc >> 3) + 64 * h + 8 * (cc & 7)); l = RW_RAW + (r * RW_LD + 8 * cc) * 2; }
                else if (c < RW_ROWS * 24 + RW_T * 16) { const int e = c - RW_ROWS * 24, s = e >> 4, cc = e & 15; o = (((d == 0 ? s : RW_T - 1 - s) * 4 + (cc >> 3) * 2 + d) * 256 + 64 * h + 8 * (cc & 7)) * 2; l = RW_EAB + 16 * e; }
                offq[q] = o; ldq[q] = l; }
#pragma unroll 1
            for (int it = -8; it <= RW_NCH; ++it) {
                { const int ca = it + 5;
                  if (ca >= 0 && ca < RW_NCH && ((ca & 3) == wave - 2)) { const bool isctx = ca < LCX / RW_T; const int cl = isctx ? ca : ca - LCX / RW_T; const int Ls = isctx ? LCX : SEQ; const int tlo = d == 0 ? cl * RW_T : Ls - RW_T - cl * RW_T;
                      const bool edge_lo = tlo == 0, edge_hi = tlo + RW_T == Ls;
#pragma unroll
                      for (int q = 0; q < 11; ++q) { v4u v = ra[q];
                          if (q == 0 && edge_lo && lane < 24) v = (v4u){0u, 0u, 0u, 0u};
                          if (q == 6 && edge_hi && lane >= 24 && lane < 48) v = (v4u){0u, 0u, 0u, 0u};
                          const int bo = (ca & 1) * ((q < 6 || (q == 6 && lane < 48)) ? RW_RAWB : RW_EABB);
                          if (q < 10 || lane < 48) *(LAS v4u*)(L + ldq[q] + bo) = v; } }
                  const int cn = it + 8;
                  if (cn < RW_NCH && ((cn & 3) == wave - 2)) { const bool isctx = cn < LCX / RW_T; const int cl = isctx ? cn : cn - LCX / RW_T; const int Ls = isctx ? LCX : SEQ; const int tlo = d == 0 ? cl * RW_T : Ls - RW_T - cl * RW_T;
                      const long row0 = (long)(isctx ? NL + b * LCX : b * SEQ) + tlo;
                      const char* pb = (const char*)P + (row0 - 1) * (PCOLS * 2);
                      const unsigned delta = (unsigned)(((const char*)EA + row0 * 2048) - pb);
#pragma unroll
                      for (int q = 0; q < 11; ++q) { unsigned o = (unsigned)offq[q]; if (q > 6 || (q == 6 && lane >= 48)) o += delta;
                          ra[q] = *(const GAS v4u*)(pb + o); } } }
                const int cb = it + 4;
                if (cb >= 0 && cb < RW_NCH) {
                    const LAS bf16* RAW = (const LAS bf16*)(L + RW_RAW + (cb & 1) * RW_RAWB); const LAS bf16* EAB = (const LAS bf16*)(L + RW_EAB + (cb & 1) * RW_EABB);
                    const lbf VEC = (lbf)(L + RW_VEC + (cb & 1) * RW_VECB); LAS float* LWF = (LAS float*)(L + RW_VEC + (cb & 1) * RW_VECB + RW_T * 4 * 64 * 2);
                    const lbf VV = (lbf)(L + RW_VV + (cb & 7) * 1024); LAS float* BONS = (LAS float*)(L + RW_BON) + (cb & 7) * RW_T;
                    const int prow = d == 0 ? ps + 1 : RW_T - ps;
                    const LAS float* BC = (const LAS float*)(L + RW_BC) + 4 * pq;
                    const f32x4 mpr = *(const LAS f32x4*)(BC), mpk = *(const LAS f32x4*)(BC + 64), mpv = *(const LAS f32x4*)(BC + 128), mnr = *(const LAS f32x4*)(BC + 192), mnk = *(const LAS f32x4*)(BC + 256), mnv = *(const LAS f32x4*)(BC + 320);
                    const f32x4 kk_c = *(const LAS f32x4*)(BC + 384), ka_c = *(const LAS f32x4*)(BC + 448), rk_c = *(const LAS f32x4*)(BC + 512);
                    f32x4 zr, zk, zv;
                    { const LAS bf16* r0 = RAW + prow * RW_LD + 4 * pq;
#define RW_LD4(p) ({ const v2u w_ = *(const LAS v2u*)(p); (f32x4){bflo(w_.x), bfhi(w_.x), bflo(w_.y), bfhi(w_.y)}; })
                      { const f32x4 x = RW_LD4(r0), xp = RW_LD4(r0 - RW_LD), xn = RW_LD4(r0 + RW_LD); zr = x + mpr * (xp - x) + mnr * (xn - x); }
                      { const f32x4 x = RW_LD4(r0 + 64), xp = RW_LD4(r0 + 64 - RW_LD), xn = RW_LD4(r0 + 64 + RW_LD); zk = x + mpk * (xp - x) + mnk * (xn - x); }
                      { const f32x4 x = RW_LD4(r0 + 128), xp = RW_LD4(r0 + 128 - RW_LD), xn = RW_LD4(r0 + 128 + RW_LD); zv = x + mpv * (xp - x) + mnv * (xn - x); } }
                    const f32x4 lw4 = RW_LD4(EAB + ps * 128 + 4 * pq), a4 = RW_LD4(EAB + ps * 128 + 64 + 4 * pq);
                    const f32x4 kkr = zk * kk_c; const float ss = rowsum16((kkr.x * kkr.x + kkr.y * kkr.y) + (kkr.z * kkr.z + kkr.w * kkr.w));
                    const f32x4 kd = zk * ((a4 - 1.f) * ka_c + 1.f); const f32x4 bq = zr * kd * rk_c; const float bn = rowsum16((bq.x + bq.y) + (bq.z + bq.w));
                    const f32x4 kkn = kkr * __builtin_amdgcn_rsqf(fmaxf(ss, 1e-24f)), kka = kkn * a4;
                    { v2u o; lbf vp = VEC + ps * 256 + 4 * pq;
                      o.x = pk2(kkn.x, kkn.y); o.y = pk2(kkn.z, kkn.w); *(LAS v2u*)(vp) = o; o.x = pk2(kka.x, kka.y); o.y = pk2(kka.z, kka.w); *(LAS v2u*)(vp + 64) = o;
                      o.x = pk2(kd.x, kd.y); o.y = pk2(kd.z, kd.w); *(LAS v2u*)(vp + 128) = o; o.x = pk2(zr.x, zr.y); o.y = pk2(zr.z, zr.w); *(LAS v2u*)(vp + 192) = o; }
                    *(LAS f32x4*)(LWF + ps * 64 + 4 * pq) = lw4;
                    if ((pq >> 3) == vhalf) { const int v0 = 4 * (pq & 7); VV[(v0 + 0) * 16 + ps] = (bf16)f2bf(zv.x); VV[(v0 + 1) * 16 + ps] = (bf16)f2bf(zv.y); VV[(v0 + 2) * 16 + ps] = (bf16)f2bf(zv.z); VV[(v0 + 3) * 16 + ps] = (bf16)f2bf(zv.w); }
                    if (pq == 0) BONS[ps] = bn;
                }
                const int cc3 = it + 3;
                if (cc3 >= 0 && cc3 < RW_NCH) {
                    const LAS bf16* VEC = (const LAS bf16*)(L + RW_VEC + (cc3 & 1) * RW_VECB); const LAS float* LWF = (const LAS float*)(L + RW_VEC + (cc3 & 1) * RW_VECB + RW_T * 4 * 64 * 2);
                    const lbf ARA = (lbf)(L + RW_ARA + (cc3 & 1) * (16 * RW_P * 2)), KB2 = (lbf)(L + RW_KB2 + (cc3 & 1) * (32 * RW_P * 2)), AT2 = (lbf)(L + RW_AT2 + (cc3 & 3) * 2048);
                    const lbf ARR = (lbf)(L + RW_ARR + (cc3 & 3) * (16 * RW_P * 2)), KT = (lbf)(L + RW_KT + (cc3 & 3) * 2048), BTN = (lbf)(L + RW_BTN + (cc3 & 3) * 2048); LAS float* CWT = (LAS float*)(L + RW_CWT + (cc3 & 3) * 256);
                    float cl = 0.f;
#pragma unroll
                    for (int s = 0; s < 12; ++s) { const float v = LWF[s * 64 + sk]; cl += (s < 4 * sq) ? v : 0.f; }
                    float cwm = __expf(cl);
#pragma unroll
                    for (int j = 0; j < 4; ++j) { const int s = 4 * sq + j; cl += LWF[s * 64 + sk]; const float cw = __expf(cl), icw = __builtin_amdgcn_rcpf(cw);
                        const float kkv = bf2f(VEC[s * 256 + sk]), kkav = bf2f(VEC[s * 256 + 64 + sk]), kdv = bf2f(VEC[s * 256 + 128 + sk]), rv = bf2f(VEC[s * 256 + 192 + sk]);
                        const bf16 at = (bf16)f2bf(kkv * cwm), rt = (bf16)f2bf(rv * cw), kt = (bf16)f2bf(kdv * icw), btv = (bf16)f2bf(kkav * icw), btn = (bf16)f2bf(-kkav * icw);
                        ARA[s * RW_P + sk] = at; AT2[sk * 16 + s] = at; ARR[s * RW_P + sk] = rt; KB2[s * RW_P + sk] = kt; KT[sk * 16 + s] = kt; KB2[(16 + s) * RW_P + sk] = btv; BTN[sk * 16 + s] = btn;
                        if (s == RW_T - 1) CWT[sk] = cw;
                        cwm = cw; }
                }
                __syncthreads();
            }
        } else {
#pragma unroll 1
            for (int it = -8; it <= RW_NCH; ++it) {
                const int c = it + 2;
                if (c >= 0 && c < RW_NCH && ((c & 1) == (wave & 1))) {
                    const LAS bf16* ARA = (const LAS bf16*)(L + RW_ARA + (c & 1) * (16 * RW_P * 2)); const LAS bf16* KB2 = (const LAS bf16*)(L + RW_KB2 + (c & 1) * (32 * RW_P * 2));
                    const LAS bf16* ARR = (const LAS bf16*)(L + RW_ARR + (c & 3) * (16 * RW_P * 2)); const LAS bf16* AT2 = (const LAS bf16*)(L + RW_AT2 + (c & 3) * 2048);
                    const lbf APT = (lbf)(L + RW_DO + (c & 3) * RW_DOB), AMT = APT + 16 * RW_P, ARKT = AMT + 256, ARBTN = ARKT + 256;
                    const f32x4 Z = (f32x4){0.f, 0.f, 0.f, 0.f};
                    f32x4 gkk = Z, gkkT = Z, grk = Z, gn = Z, gnT = Z, grb = Z;
#pragma unroll
                    for (int ks = 0; ks < 2; ++ks) { const bf16x8 ak = *(const LAS bf16x8*)(KB2 + fr * RW_P + 32 * ks + 8 * kg), ab = *(const LAS bf16x8*)(KB2 + (16 + fr) * RW_P + 32 * ks + 8 * kg);
                        const bf16x8 ba = *(const LAS bf16x8*)(ARA + fr * RW_P + 32 * ks + 8 * kg), br = *(const LAS bf16x8*)(ARR + fr * RW_P + 32 * ks + 8 * kg);
                        gkk = RW_MFMA(ak, ba, gkk); gkkT = RW_MFMA(ba, ak, gkkT); grk = RW_MFMA(ak, br, grk); gn = RW_MFMA(ab, ba, gn); gnT = RW_MFMA(ba, ab, gnT); grb = RW_MFMA(ab, br, grb); }
                    f32x4 w1, w1T;
#pragma unroll
                    for (int r = 0; r < 4; ++r) { const int row = 4 * kg + r;
                        if (!(row < fr)) { gkk[r] = 0.f; gn[r] = 0.f; } if (!(fr < row)) { gkkT[r] = 0.f; gnT[r] = 0.f; } if (!(row <= fr)) { grk[r] = 0.f; grb[r] = 0.f; }
                        const float idt = row == fr ? 1.f : 0.f; w1[r] = idt - gn[r]; w1T[r] = idt - gnT[r]; }
                    const bf16x8 bn = rw_c4(gn), bnT = rw_c4(gnT);
                    const f32x4 n2 = RW_MFMA(bnT, bn, Z), n2T = RW_MFMA(bn, bnT, Z);
                    const bf16x8 b2 = rw_c4(n2), b2T = rw_c4(n2T);
                    const f32x4 n4 = RW_MFMA(b2T, b2, Z), n4T = RW_MFMA(b2, b2T, Z);
                    const bf16x8 b4 = rw_c4(n4), b4T = rw_c4(n4T);
                    const f32x4 n8 = RW_MFMA(b4T, b4, Z);
                    const bf16x8 bw1T = rw_c4(w1T);
                    const f32x4 w2 = RW_MFMA(bw1T, b2, w1), w2T = RW_MFMA(b2, bw1T, w1T);
                    const bf16x8 bw2T = rw_c4(w2T);
                    const f32x4 w3 = RW_MFMA(bw2T, b4, w2), w3T = RW_MFMA(b4, bw2T, w2T);
                    const f32x4 xi = RW_MFMA(rw_c4(w3T), rw_c4(n8), w3);
                    const bf16x8 bx = rw_c4(xi);
                    const f32x4 am = RW_MFMA(rw_c4(gkkT), bx, Z);
                    rw_st_cols(AMT, am, fr, kg, 16); rw_st_cols(ARKT, grk, fr, kg, 16); { f32x4 nb = Z - grb; rw_st_cols(ARBTN, nb, fr, kg, 16); }
#pragma unroll
                    for (int m = 0; m < 4; ++m) { const f32x4 ap = RW_MFMA(rw_perm4(AT2 + (16 * m + fr) * 16, kg), bx, Z);
                        rw_st_cols(APT + 16 * m, ap, fr, kg, RW_P); }
                }
                __syncthreads();
            }
        }
    }
}

__device__ __forceinline__ void phase_fin_rwkv(Frame& F, int li) { WS_DECL; frame_refresh(F);
    const int nrows = li == DEPTH - 1 ? NL : NT; const int lane = F.lane, wave = F.wave, tid = F.tid;
    LAS float* GUP = (LAS float*)F.lds;
    LAS float* SG = (LAS float*)(F.lds + 65536) + wave * 64;
    const bf16* P = WSP(bf16, WS_P); const float* YR = WSP(float, WS_YR); const float* BON = WSP(float, WS_BON); bf16* MIX = WSP(bf16, WS_A1);
    { const float* gup = in_ptr(I_GUP) + (size_t)li * 64 * 256; for (int i = tid; i < 64 * 256; i += NTHR) GUP[i] = gup[i]; }
    const float* mup = in_ptr(I_MUP) + li * 960; const float* mun = in_ptr(I_MUN) + li * 960;
    const f32x4 mpv = *(const GAS f32x4*)(mup + 512 + 4 * lane), mnv = *(const GAS f32x4*)(mun + 512 + 4 * lane);
    const float mpg = mup[896 + lane], mng = mun[896 + lane];
    const f32x4 lg = *(const GAS f32x4*)(in_ptr(I_LNG) + li * 256 + 4 * lane), lb = *(const GAS f32x4*)(in_ptr(I_LNB) + li * 256 + 4 * lane);
    __syncthreads();
    const int gw = blockIdx.x * NWAVES + wave, NGW = F.G * NWAVES;
    for (int m = gw; m < nrows; m += NGW) {
        const bool isctx = m >= NL; const int t = isctx ? (m - NL) & 255 : m & 4095; const int Ls = isctx ? 256 : 4096;
        const bf16* pr = P + (size_t)m * PCOLS + RW_C0;
        const bool hp = t > 0, hn = t + 1 < Ls;
        f32x4 v;
        { const v2u w = *(const GAS v2u*)(pr + 512 + 4 * lane); v2u wp = (v2u){0u, 0u}, wn = (v2u){0u, 0u};
          if (hp) wp = *(const GAS v2u*)(pr - PCOLS + 512 + 4 * lane); if (hn) wn = *(const GAS v2u*)(pr + PCOLS + 512 + 4 * lane);
          const f32x4 x = (f32x4){bflo(w.x), bfhi(w.x), bflo(w.y), bfhi(w.y)}, xp = (f32x4){bflo(wp.x), bfhi(wp.x), bflo(wp.y), bfhi(wp.y)}, xn = (f32x4){bflo(wn.x), bfhi(wn.x), bflo(wn.y), bfhi(wn.y)};
          v = x + mpv * (xp - x) + mnv * (xn - x); }
        { const float x = bf2f(pr[896 + lane]); const float xp = hp ? bf2f(pr[896 + lane - PCOLS]) : 0.f, xn = hn ? bf2f(pr[896 + lane + PCOLS]) : 0.f;
          SG[lane] = sigmoidf_(x + mpg * (xp - x) + mng * (xn - x)); }
        LDS_WAIT();
        f32x4 g = (f32x4){0.f, 0.f, 0.f, 0.f};
#pragma unroll 8
        for (int j = 0; j < 64; ++j) { const float sj = SG[j]; const f32x4 gu = *(const LAS f32x4*)(GUP + j * 256 + 4 * lane); g = g + gu * sj; }
        const f32x4 y = *(const GAS f32x4*)(YR + (size_t)m * 256 + 4 * lane) + *(const GAS f32x4*)(YR + ((size_t)NT + m) * 256 + 4 * lane);
        const float mean = rowsum16((y.x + y.y) + (y.z + y.w)) * (1.f / 64.f);
        const f32x4 yc = y - mean; const float var = rowsum16((yc.x * yc.x + yc.y * yc.y) + (yc.z * yc.z + yc.w * yc.w)) * (1.f / 64.f);
        const f32x4 yn = yc * __builtin_amdgcn_rsqf(var + 64e-5f) * lg + lb;
        const int hh = lane >> 4; const float bon = BON[(size_t)m * 4 + hh] + BON[((size_t)NT + m) * 4 + hh];
        const f32x4 o = (yn + v * bon) * g;
        v2u ow; ow.x = pk2(o.x, o.y); ow.y = pk2(o.z, o.w); *(GAS v2u*)(MIX + (size_t)m * D + 512 + 4 * lane) = ow;
        LDS_WAIT();
    }
    __syncthreads();
}

constexpr float HY_DMIN = -3.0701134573253945f, HY_DMAX = -15.350567286626973f;
constexpr int HY_X = 0, HY_TW = 65536, HY_W3 = 98304;
__device__ __forceinline__ float hy_delta(int ch) { return -(HY_DMIN + (float)ch * ((HY_DMAX - HY_DMIN) / 255.f)); }

__device__ __forceinline__ void phase_pro0d(Frame& F) { WS_DECL; frame_refresh(F);
    const int lane = F.lane; const int gw = blockIdx.x * NWAVES + F.wave, NGW = F.G * NWAVES;
    const float* w1 = in_ptr(I_HW1); const float* b1 = in_ptr(I_HB1); const float* w2 = in_ptr(I_HW2); const float* b2 = in_ptr(I_HB2);
    for (int it = gw; it < DEPTH * (SEQ + LCX); it += NGW) {
        const int li = it / (SEQ + LCX), r = it % (SEQ + LCX); const bool isctx = r >= SEQ; const int l = isctx ? r - SEQ : r; const int L = isctx ? LCX : SEQ;
        float z = 0.f;
        if (lane == 0) z = (float)l / (float)(L - 1);
        else if (lane < 33) { const int i = (lane - 1) & 15; const float band = 1e-4f + (float)i * ((15.f - 1e-4f) / 15.f); const float ang = band * (6.283185307179586f / (float)L) * (float)l; z = lane < 17 ? cosf(ang) : -sinf(ang); }
        float h1 = b1[li * 64 + lane];
        for (int i = 0; i < 33; ++i) h1 += __shfl(z, i) * w1[(li * 33 + i) * 64 + lane];
        h1 = sinf(h1);
        float h2 = b2[li * 64 + lane];
        for (int i = 0; i < 64; ++i) h2 += __shfl(h1, i) * w2[(li * 64 + i) * 64 + lane];
        h2 = sinf(h2);
        float* dst = isctx ? WSP(float, WS_H2C) + ((size_t)li * LCX + l) * 64 : WSP(float, WS_H2L) + ((size_t)li * SEQ + l) * 64;
        dst[lane] = h2;
    }
}

typedef f32x2 cpx;
__device__ __forceinline__ cpx cmul(cpx a, cpx b) { return (cpx){a.x * b.x - a.y * b.y, a.x * b.y + a.y * b.x}; }
__device__ __forceinline__ cpx cmulc(cpx a, cpx b) { return (cpx){a.x * b.x + a.y * b.y, a.y * b.x - a.x * b.y}; }
__device__ __forceinline__ cpx cmi(cpx z) { return (cpx){z.y, -z.x}; }
__device__ __forceinline__ int hy_p(int n) { return n ^ ((n >> 5) & 7) ^ (((n >> 6) & 3) << 3); }
__device__ __forceinline__ void hy_build_tw(Frame& F) {
    LAS cpx* TW = (LAS cpx*)(F.lds + HY_TW);
    for (int k = F.tid; k < 4096; k += NTHR) { const float rev = (float)k * (1.f / 8192.f); TW[k] = (cpx){__builtin_amdgcn_cosf(rev), -__builtin_amdgcn_sinf(rev)};     }
}
__device__ __forceinline__ void dft4(cpx x0, cpx x1, cpx x2, cpx x3, cpx& X0, cpx& X1, cpx& X2, cpx& X3) {
    const cpx t0 = x0 + x2, t1 = x0 - x2, t2 = x1 + x3, t3 = cmi(x1 - x3); X0 = t0 + t2; X1 = t1 + t3; X2 = t0 - t2; X3 = t1 - t3; }
__device__ __forceinline__ void dft8(cpx (&a)[8]) {
    const float R2 = 0.7071067811865476f; cpx e[4], o[4];
    dft4(a[0] + a[4], a[1] + a[5], a[2] + a[6], a[3] + a[7], e[0], e[1], e[2], e[3]);
    const cpx d1 = a[1] - a[5], d3 = a[3] - a[7];
    dft4(a[0] - a[4], (cpx){(d1.x + d1.y) * R2, (d1.y - d1.x) * R2}, cmi(a[2] - a[6]), (cpx){(d3.y - d3.x) * R2, -(d3.x + d3.y) * R2}, o[0], o[1], o[2], o[3]);
#pragma unroll
    for (int m = 0; m < 4; ++m) { a[2 * m] = e[m]; a[2 * m + 1] = o[m]; }
}
__device__ __forceinline__ void dft16(cpx (&a)[16]) {
    const float C1 = 0.9238795325112867f, S1 = 0.3826834323650898f, R2 = 0.7071067811865476f;
    cpx e[8], o[8];
#pragma unroll
    for (int k = 0; k < 8; ++k) { e[k] = a[k] + a[k + 8]; o[k] = a[k] - a[k + 8]; }
    o[1] = cmul(o[1], (cpx){C1, -S1}); o[2] = cmul(o[2], (cpx){R2, -R2}); o[3] = cmul(o[3], (cpx){S1, -C1}); o[4] = cmi(o[4]);
    o[5] = cmul(o[5], (cpx){-S1, -C1}); o[6] = cmul(o[6], (cpx){-R2, -R2}); o[7] = cmul(o[7], (cpx){-C1, -S1});
    dft8(e); dft8(o);
#pragma unroll
    for (int m = 0; m < 8; ++m) { a[2 * m] = e[m]; a[2 * m + 1] = o[m]; }
}
template <int R> __device__ __forceinline__ void cconj(cpx (&a)[R]) {
#pragma unroll
    for (int k = 0; k < R; ++k) a[k].y = -a[k].y; }
template <bool INV, bool ZU> __device__ __forceinline__ void hy_pass1(LAS cpx* X, const LAS cpx* TW, int tid) {
    cpx a[16]; const cpx w1 = TW[tid];
#pragma unroll
    for (int k = 0; k < 16; ++k) a[k] = (!INV && ZU && k >= 8) ? (cpx){0.f, 0.f} : X[hy_p(tid + 512 * k)];
    if (!INV) { dft16(a); cpx w = w1;
#pragma unroll
        for (int q = 1; q < 16; ++q) { a[q] = cmul(a[q], w); w = cmul(w, w1); }
    } else { cpx w = w1;
#pragma unroll
        for (int q = 1; q < 16; ++q) { a[q] = cmulc(a[q], w); w = cmul(w, w1); }
        cconj<16>(a); dft16(a); cconj<16>(a); }
#pragma unroll
    for (int k = 0; k < 16; ++k) if (!(INV && ZU && k >= 8)) X[hy_p(tid + 512 * k)] = a[k];
}
template <bool INV, int S, int MUL> __device__ __forceinline__ void hy_pass8(LAS cpx* X, const LAS cpx* TW, int tid) {
#pragma unroll
    for (int h = 0; h < 2; ++h) { const int bf = tid + 512 * h, sub = bf / S, j = bf % S, base = 8 * S * sub + j; cpx a[8]; const cpx w1 = TW[MUL * j];
#pragma unroll
        for (int k = 0; k < 8; ++k) a[k] = X[hy_p(base + S * k)];
        if (!INV) { dft8(a); cpx w = w1;
#pragma unroll
            for (int q = 1; q < 8; ++q) { a[q] = cmul(a[q], w); w = cmul(w, w1); }
        } else { cpx w = w1;
#pragma unroll
            for (int q = 1; q < 8; ++q) { a[q] = cmulc(a[q], w); w = cmul(w, w1); }
            cconj<8>(a); dft8(a); cconj<8>(a); }
#pragma unroll
        for (int k = 0; k < 8; ++k) X[hy_p(base + S * k)] = a[k]; }
}
__device__ __forceinline__ void hy_pass4(LAS cpx* X, int tid, const cpx* spec) {
#pragma unroll
    for (int h = 0; h < 2; ++h) { const int g = tid + 512 * h; cpx a[8];
#pragma unroll
        for (int k = 0; k < 8; ++k) a[k] = X[hy_p(8 * g + k)];
        dft8(a);
        if (spec) {
#pragma unroll
            for (int k2 = 0; k2 < 4; ++k2) { const f32x4 s4 = *(const GAS f32x4*)(spec + 8 * g + 2 * k2); a[2 * k2] = cmul(a[2 * k2], (cpx){s4.x, s4.y}); a[2 * k2 + 1] = cmul(a[2 * k2 + 1], (cpx){s4.z, s4.w}); }
            cconj<8>(a); dft8(a); cconj<8>(a); }
#pragma unroll
        for (int k = 0; k < 8; ++k) X[hy_p(8 * g + k)] = a[k]; }
}
__device__ __forceinline__ void hy_conv_fft(LAS cpx* X, const LAS cpx* TW, int tid, const cpx* spec) {
    hy_pass1<false, true>(X, TW, tid); __syncthreads();
    hy_pass8<false, 64, 16>(X, TW, tid); __syncthreads();
    hy_pass8<false, 8, 128>(X, TW, tid); __syncthreads();
    hy_pass4(X, tid, spec); __syncthreads();
    hy_pass8<true, 8, 128>(X, TW, tid); __syncthreads();
    hy_pass8<true, 64, 16>(X, TW, tid); __syncthreads();
    hy_pass1<true, true>(X, TW, tid); __syncthreads();
}

__device__ __forceinline__ void phase_hy_spec(Frame& F, int li) { WS_DECL; frame_refresh(F);
    LAS cpx* X = (LAS cpx*)(F.lds + HY_X); const LAS cpx* TW = (const LAS cpx*)(F.lds + HY_TW); LAS float* W3 = (LAS float*)(F.lds + HY_W3);
    const int tid = F.tid; const float* w3 = in_ptr(I_HW3) + (size_t)li * 64 * 1024; const float* H2 = WSP(float, WS_H2L) + (size_t)li * SEQ * 64; cpx* SPEC = WSP(cpx, WS_SPEC);
    __syncthreads();
    hy_build_tw(F);
    for (int item = blockIdx.x; item < 512; item += F.G) {
        const int o = item >> 8, ch = item & 255;
        __syncthreads();
        if (tid < 128) { const int dir = tid >> 6, j = tid & 63; W3[tid] = w3[(size_t)j * 1024 + o * 512 + dir * 256 + ch]; }
        __syncthreads();
        const float delta = hy_delta(ch);
#pragma unroll 1
        for (int i = 0; i < 8; ++i) { const int l = tid + 512 * i; const float* hr = H2 + (size_t)l * 64; float hf = 0.f, hb = 0.f;
#pragma unroll
            for (int j4 = 0; j4 < 16; ++j4) { const f32x4 h4 = *(const GAS f32x4*)(hr + 4 * j4);
                hf += h4.x * W3[4 * j4] + h4.y * W3[4 * j4 + 1] + h4.z * W3[4 * j4 + 2] + h4.w * W3[4 * j4 + 3]; hb += h4.x * W3[64 + 4 * j4] + h4.y * W3[64 + 4 * j4 + 1] + h4.z * W3[64 + 4 * j4 + 2] + h4.w * W3[64 + 4 * j4 + 3]; }
            const float win = (__expf(-((float)l * (1.f / 4095.f)) * delta) + 0.05f) * (1.f / 8192.f);
            X[hy_p(l)] = (cpx){hf * win, 0.f};
            if (l == 0) X[hy_p(4096)] = (cpx){0.f, 0.f}; else X[hy_p(8192 - l)] = (cpx){hb * win, 0.f}; }
        __syncthreads();
        hy_pass1<false, false>(X, TW, tid); __syncthreads();
        hy_pass8<false, 64, 16>(X, TW, tid); __syncthreads();
        hy_pass8<false, 8, 128>(X, TW, tid); __syncthreads();
        hy_pass4(X, tid, nullptr); __syncthreads();
        cpx* dst = SPEC + (size_t)item * 8192;
#pragma unroll
        for (int i = 0; i < 16; ++i) *(GAS cpx*)(dst + tid + 512 * i) = X[hy_p(tid + 512 * i)];
    }
    __syncthreads();
}

__device__ __forceinline__ void hy_conv8(const bf16* row, int t0, int Ls, float w0, float w1, float w2, float bias, float (&out)[8]) {
    const v4u raw = *(const GAS v4u*)(row + t0); float p[10];
    p[0] = t0 > 0 ? bf2f(row[t0 - 1]) : 0.f; p[9] = t0 + 8 < Ls ? bf2f(row[t0 + 8]) : 0.f;
    p[1] = bflo(raw.x); p[2] = bfhi(raw.x); p[3] = bflo(raw.y); p[4] = bfhi(raw.y); p[5] = bflo(raw.z); p[6] = bfhi(raw.z); p[7] = bflo(raw.w); p[8] = bfhi(raw.w);
#pragma unroll
    for (int e = 0; e < 8; ++e) out[e] = bias + w0 * p[e] + w1 * p[e + 1] + w2 * p[e + 2];
}

__device__ __forceinline__ void phase_hy_conv(Frame& F, int li) { WS_DECL; frame_refresh(F);
    LAS cpx* X = (LAS cpx*)(F.lds + HY_X); const LAS cpx* TW = (const LAS cpx*)(F.lds + HY_TW);
    const int tid = F.tid; const bf16* HT = WSP(bf16, WS_HT); bf16* HOT = WSP(bf16, WS_HOT); const cpx* SPEC = WSP(cpx, WS_SPEC);
    const float* cw = in_ptr(I_HCW) + li * 3 * 768; const float* cb = in_ptr(I_HCB) + li * 768; const float* dsk = in_ptr(I_HD) + li * 512;
    __syncthreads();
    hy_build_tw(F);
    for (int item = blockIdx.x; item < 2048; item += F.G) {
        const int ch = item >> 3, bp = item & 7; const int t0 = 8 * tid;
        float v[2][8], x1[2][8], x2[2][8];
#pragma unroll
        for (int q = 0; q < 2; ++q) { const size_t boff = (size_t)(2 * bp + q) * SEQ;
            hy_conv8(HT + (size_t)ch * NT + boff, t0, SEQ, cw[ch], cw[768 + ch], cw[1536 + ch], cb[ch], v[q]);
            hy_conv8(HT + (size_t)(256 + ch) * NT + boff, t0, SEQ, cw[256 + ch], cw[768 + 256 + ch], cw[1536 + 256 + ch], cb[256 + ch], x1[q]);
            hy_conv8(HT + (size_t)(512 + ch) * NT + boff, t0, SEQ, cw[512 + ch], cw[768 + 512 + ch], cw[1536 + 512 + ch], cb[512 + ch], x2[q]); }
        const float d0 = dsk[ch], d1 = dsk[256 + ch];
        __syncthreads();
#pragma unroll
        for (int e = 0; e < 8; ++e) X[hy_p(t0 + e)] = (cpx){v[0][e], v[1][e]};
        __syncthreads();
        hy_conv_fft(X, TW, tid, SPEC + (size_t)ch * 8192);
        float u[2][8];
#pragma unroll
        for (int e = 0; e < 8; ++e) { const cpx y = X[hy_p(t0 + e)]; u[0][e] = x1[0][e] * (y.x + v[0][e] * d0); u[1][e] = x1[1][e] * (y.y + v[1][e] * d0); X[hy_p(t0 + e)] = (cpx){u[0][e], u[1][e]}; }
        __syncthreads();
        hy_conv_fft(X, TW, tid, SPEC + (size_t)(256 + ch) * 8192);
#pragma unroll
        for (int q = 0; q < 2; ++q) { float o[8];
#pragma unroll
            for (int e = 0; e < 8; ++e) { const cpx y = X[hy_p(t0 + e)]; o[e] = x2[q][e] * ((q == 0 ? y.x : y.y) + u[q][e] * d1); }
            v4u w; w.x = pk2(o[0], o[1]); w.y = pk2(o[2], o[3]); w.z = pk2(o[4], o[5]); w.w = pk2(o[6], o[7]);
            *(GAS v4u*)(HOT + (size_t)ch * NT + (size_t)(2 * bp + q) * SEQ + t0) = w; }
    }
    __syncthreads();
}

__device__ __forceinline__ void phase_hy_ctx(Frame& F, int li) { WS_DECL; frame_refresh(F);
    LAS float* KF = (LAS float*)F.lds;
    LAS float* SIG = KF + 1024;
    LAS float* W3 = KF + 2048;
    const int tid = F.tid; const bf16* HT = WSP(bf16, WS_HT); bf16* HOT = WSP(bf16, WS_HOT);
    const float* w3 = in_ptr(I_HW3) + (size_t)li * 64 * 1024; const float* H2 = WSP(float, WS_H2C) + (size_t)li * LCX * 64;
    const float* cw = in_ptr(I_HCW) + li * 3 * 768; const float* cb = in_ptr(I_HCB) + li * 768; const float* dsk = in_ptr(I_HD) + li * 512;
    for (int ch = blockIdx.x; ch < 256; ch += F.G) {
        __syncthreads();
        if (tid < 256) { const int od = tid >> 6, j = tid & 63; W3[tid] = w3[(size_t)j * 1024 + (od >> 1) * 512 + (od & 1) * 256 + ch]; }
        __syncthreads();
        { const int o = tid >> 8, l = tid & 255; const float* hr = H2 + (size_t)l * 64; float hf = 0.f, hb = 0.f;
          for (int j = 0; j < 64; ++j) { const float hv = hr[j]; hf += hv * W3[(2 * o) * 64 + j]; hb += hv * W3[(2 * o + 1) * 64 + j]; }
          const float win = __expf(-((float)l * (1.f / 255.f)) * hy_delta(ch)) + 0.05f;
          KF[(2 * o) * 256 + l] = hf * win; KF[(2 * o + 1) * 256 + l] = hb * win; }
        __syncthreads();
        const int q = tid >> 8, t = tid & 255; const float d0 = dsk[ch], d1 = dsk[256 + ch];
        for (int bp = 0; bp < 8; ++bp) { const int b = 2 * bp + q; const size_t off = (size_t)NL + (size_t)b * LCX;
            float zz[3];
#pragma unroll
            for (int k = 0; k < 3; ++k) { const int c = 256 * k + ch; const bf16* row = HT + (size_t)c * NT + off;
                const float pm = t > 0 ? bf2f(row[t - 1]) : 0.f, p0 = bf2f(row[t]), pp = t + 1 < LCX ? bf2f(row[t + 1]) : 0.f;
                zz[k] = cb[c] + cw[c] * pm + cw[768 + c] * p0 + cw[1536 + c] * pp; }
            SIG[q * 256 + t] = zz[0];
            __syncthreads();
            float y = 0.f;
            for (int s = 0; s < 256; ++s) { const int lag = t - s; const float kv = lag >= 0 ? KF[lag] : KF[256 - lag]; y += kv * SIG[q * 256 + s]; }
            const float u = zz[1] * (y + zz[0] * d0);
            __syncthreads();
            SIG[q * 256 + t] = u;
            __syncthreads();
            float y2 = 0.f;
            for (int s = 0; s < 256; ++s) { const int lag = t - s; const float kv = lag >= 0 ? KF[512 + lag] : KF[768 - lag]; y2 += kv * SIG[q * 256 + s]; }
            HOT[(size_t)ch * NT + off + t] = (bf16)f2bf(zz[2] * (y2 + u * d1));
            __syncthreads();
        }
    }
    __syncthreads();
}

constexpr int HF_LD = 72;
__device__ __forceinline__ void phase_fin_hyena(Frame& F, int li) { WS_DECL; frame_refresh(F);
    LAS bf16* T = (LAS bf16*)F.lds;
    const int nrows = li == DEPTH - 1 ? NL : NT; const int tid = F.tid, lane = F.lane, wave = F.wave; const bf16* HOT = WSP(bf16, WS_HOT); bf16* MIX = WSP(bf16, WS_A1);
    const f32x4 g4 = *(const GAS f32x4*)(in_ptr(I_HON) + li * 256 + 4 * lane);
    for (int item = blockIdx.x; item < nrows / 64; item += F.G) { const int m0 = item * 64;
        __syncthreads();
        { const int ch = tid >> 1, hf = tid & 1; const bf16* src = HOT + (size_t)ch * NT + m0 + 32 * hf;
#pragma unroll
          for (int k = 0; k < 4; ++k) *(LAS v4u*)(T + ch * HF_LD + 32 * hf + 8 * k) = *(const GAS v4u*)(src + 8 * k); }
        __syncthreads();
        for (int i = 0; i < 8; ++i) { const int tl = wave * 8 + i;
            f32x4 x; x.x = bf2f(T[(4 * lane) * HF_LD + tl]); x.y = bf2f(T[(4 * lane + 1) * HF_LD + tl]); x.z = bf2f(T[(4 * lane + 2) * HF_LD + tl]); x.w = bf2f(T[(4 * lane + 3) * HF_LD + tl]);
            const float r = __builtin_amdgcn_rsqf(wave_sum(x.x * x.x + x.y * x.y + x.z * x.z + x.w * x.w) * (1.f / 256.f) + 1e-6f);
            v2u o; o.x = pk2(x.x * r * g4.x, x.y * r * g4.y); o.y = pk2(x.z * r * g4.z, x.w * r * g4.w); *(GAS v2u*)(MIX + (size_t)(m0 + tl) * D + 768 + 4 * lane) = o; }
    }
    __syncthreads();
}
#define MIX_HYENA 1

#define GRID_BAR() do { XcdBarrier bar_; bar_.leader = (F.wave == 0 && mk_lane() == 0); bar_.bar = (unsigned*)(ws_ptr() + WS_CTL) + CW_BAR; bar_.x = xb_xcc_id(); bar_.st = (volatile LAS unsigned*)(F.lds + LDSCTL_OFF) + 8; xcd_barrier(bar_); } while (0)

template <int li>
__device__ __forceinline__ void layer_fwd(Frame& F) {
        const int nrows = li == DEPTH - 1 ? NL : NT; unsigned char* const ws = ws_ptr();
        phase_hy_spec(F, li);
        { pg8::Gemm g{WSP(bf16, WS_A1), WSP(bf16, WS_WINT) + (size_t)li * PCOLS * D, NT, PCOLS, D, WSP(bf16, WS_WHYT) + (size_t)li * HYC * D, WSP(bf16, WS_A1)};
          pg8::DualOrder S; S.init(NT, PCOLS, HYC, NT, F.G, (int)blockIdx.x);
          pg8::EpiStore2 E{WSP(bf16, WS_P), PCOLS, WSP(bf16, WS_HT), NT};
          pg8::gemm_phase<pg8::EpiStore2, pg8::DualOrder, true, true>(F.lds, g, S, E, F.wave); }
        GRID_BAR();
        phase_rwkv_r0(F, li);
        phase_mla_prep(F, li);
        phase_lru<1>(F, li);
        __syncthreads();
        phase_hy_conv(F, li);
        if (li < DEPTH - 1) phase_hy_ctx(F, li);
        GRID_BAR();
        phase_rwkv_scan(F, li);
        __syncthreads();
        phase_attn(F, li);
        __syncthreads();
        phase_lru<3>(F, li);
        GRID_BAR();
        phase_fin_mla(F, li);
        phase_fin_rwkv(F, li); phase_fin_hyena(F, li);
        GRID_BAR();
        { pg8::Gemm g{WSP(bf16, WS_A1), WSP(bf16, WS_WOUTT) + (size_t)li * D * D, nrows, D, D}; pg8::StaticOrder S; S.init(nrows, D, F.G, (int)blockIdx.x);
          pg8::EpiStore E{WSP(bf16, WS_Y), D, 0, D / 256};
          pg8::gemm_phase<pg8::EpiStore, pg8::StaticOrder, true, true>(F.lds, g, S, E, F.wave); }
        GRID_BAR();
        phase_ln1<true>(F, li);
        if (li & 1) phase_moe_weights(F, li);
        GRID_BAR();
        if (!(li & 1)) {
            const int j = li >> 1;
            { pg8::Gemm g{(const pg8::bf16_t*)WSP(unsigned char, WS_A1), (const pg8::bf16_t*)(WSP(unsigned char, WS_WGUT) + (size_t)j * 2 * FFD * D), nrows, 2 * FFD, D / 2}; pg8::StaticOrder S; S.init(nrows, 2 * FFD, F.G, (int)blockIdx.x);
              pg8::EpiSwiGLU E{WSP(bf16, WS_H), FFD, 0, 2 * FFD / 256};
              pg8::gemm_phase<pg8::EpiSwiGLU, pg8::StaticOrder, true, true, true, 124>(F.lds, g, S, E, F.wave); }
            GRID_BAR();
            { pg8::Gemm g{WSP(bf16, WS_H), WSP(bf16, WS_WDT) + (size_t)j * D * FFD, nrows, D, FFD}; pg8::StaticOrder S; S.init(nrows, D, F.G, (int)blockIdx.x);
              pg8::EpiStore E{WSP(bf16, WS_Y), D, 0, D / 256};
              pg8::gemm_phase<pg8::EpiStore, pg8::StaticOrder, true, true>(F.lds, g, S, E, F.wave); }
            GRID_BAR();
        } else {
            phase_moe_slots(F, li);
            GRID_BAR();
            const int ntiles = __builtin_amdgcn_readfirstlane(((LAS int*)(F.lds + LDS_MOEI))[48]);
            const PG8_LAS unsigned char* tile_e = (const PG8_LAS unsigned char*)(F.lds + LDS_TILEE);
#pragma unroll 1
            for (int ch = 0; ch < MOE_NCHUNK; ++ch) {
                const int t0 = ch * MOE_CHUNK_TILES; int nM = ntiles - t0; nM = nM < 0 ? 0 : (nM > MOE_CHUNK_TILES ? MOE_CHUNK_TILES : nM);
                { pg8::Gemm g{(const pg8::bf16_t*)WSP(unsigned char, WS_XS8), (const pg8::bf16_t*)WSP(unsigned char, WS_M8GU), 0, 0, D / 2}; pg8::MoeOrder S; S.init(nM, 2 * FFE / 256, F.G, (int)blockIdx.x, t0, t0, tile_e);
                  pg8::EpiSwiGLU8 E{WSP(unsigned char, WS_HM8), FFE, t0, 2 * FFE / 256};
                  pg8::gemm_phase<pg8::EpiSwiGLU8, pg8::MoeOrder, true, true, true, 124>(F.lds, g, S, E, F.wave); }
                GRID_BAR();
                { pg8::Gemm g{(const pg8::bf16_t*)WSP(unsigned char, WS_HM8), (const pg8::bf16_t*)WSP(unsigned char, WS_M8D), 0, 0, FFE / 2}; pg8::MoeOrder S; S.init(nM, D / 256, F.G, (int)blockIdx.x, t0, 0, tile_e);
                  pg8::EpiStore E{WSP(bf16, WS_Y2), D, t0, D / 256};
                  pg8::gemm_phase<pg8::EpiStore, pg8::MoeOrder, true, true, true, 123>(F.lds, g, S, E, F.wave); }
                GRID_BAR();
            }
        }
        phase_ln2<true>(F, li);
        if (li < DEPTH - 1) GRID_BAR();
}

__global__ void __launch_bounds__(NTHR, 2) mk_fwd(Args a) {
    extern __shared__ __attribute__((aligned(16))) unsigned char lds_raw[];
    Frame F; F.lds = (LAS unsigned char*)lds_raw; F.tid = threadIdx.x; F.lane = F.tid & 63; F.wave = __builtin_amdgcn_readfirstlane(F.tid >> 6); F.G = gridDim.x;
    for (int u = F.tid; u < (LDS_BYTES - LDSCTL_OFF) / 4; u += NTHR) ((LAS unsigned*)(F.lds + LDSCTL_OFF))[u] = 0u;
    __syncthreads();
    (void)xcd_barrier_post((unsigned*)(ws_ptr() + WS_CTL) + CW_BAR, (volatile LAS unsigned*)(F.lds + LDSCTL_OFF) + 8, F.tid == 0);

    phase_pro0(F);
    phase_pro0b(F);
    phase_pro0c(F);
    phase_pro0d(F);
    phase_pro0e(F);
    GRID_BAR();
    phase_hin0(F);
    GRID_BAR();
    layer_fwd<0>(F); layer_fwd<1>(F); layer_fwd<2>(F); layer_fwd<3>(F);
}

extern "C" void kernel_launch(void* const* d_in, const int* in_sizes, int n_in, void* d_out, int out_size, void* d_ws, size_t ws_size, hipStream_t stream) {
    static int grid = 0;
    if (grid == 0) {
        if (n_in != N_INPUTS || out_size != NL * D || ws_size < WS_END) { fprintf(stderr, "kernel_launch: unexpected shapes (n_in %d out %d ws %zu)\n", n_in, out_size, ws_size); grid = -1; return; }
        int dev = 0, cus = 0, per_cu = 0;
        if (hipGetDevice(&dev) != hipSuccess || hipDeviceGetAttribute(&cus, hipDeviceAttributeMultiprocessorCount, dev) != hipSuccess) { grid = -1; return; }
        if (hipFuncSetAttribute((const void*)mk_fwd, hipFuncAttributeMaxDynamicSharedMemorySize, LDS_BYTES) != hipSuccess) { fprintf(stderr, "kernel_launch: hipFuncSetAttribute failed\n"); grid = -1; return; }
        if (hipOccupancyMaxActiveBlocksPerMultiprocessor(&per_cu, (const void*)mk_fwd, NTHR, LDS_BYTES) != hipSuccess || per_cu < 1) fprintf(stderr, "kernel_launch: occupancy query reports %d\n", per_cu);
        (void)hipGetLastError();
        grid = cus > 256 ? 256 : cus;
    }
    if (grid < 0) return;
    if (hipMemsetAsync((char*)d_ws + WS_CTL, 0, CTL_ZERO_BYTES, stream) != hipSuccess) return;
    Args a{};
    for (int i = 0; i < N_INPUTS; ++i) a.in[i] = (const float*)d_in[i];
    a.out = (float*)d_out; a.ws = (unsigned char*)d_ws;
    hipLaunchKernelGGL(mk_fwd, dim3(grid), dim3(NTHR), LDS_BYTES, stream, a);
    const hipError_t le = hipPeekAtLastError();
    if (le != hipSuccess) fprintf(stderr, "kernel_launch: launch failed: %s\n", hipGetErrorName(le));
}
```

```cpp
#include <hip/hip_runtime.h>
#include <cstdio>
#include <cstdint>
#define GAS __attribute__((address_space(1)))
#define LAS __attribute__((address_space(3)))
__device__ __forceinline__ int mk_lane() { int l; asm volatile("v_mbcnt_lo_u32_b32 %0, -1, 0\n\tv_mbcnt_hi_u32_b32 %0, -1, %0" : "=v"(l)); return l; }
namespace pg8 {
#define PG8_LAS __attribute__((address_space(3)))
typedef unsigned short bf16_t;
typedef short bf16x8 __attribute__((ext_vector_type(8)));
typedef float f32x4 __attribute__((ext_vector_type(4)));
typedef unsigned u32x4 __attribute__((ext_vector_type(4)));
constexpr int BM = 256, BK = 64, HALF = 128, HTB = HALF * BK * 2  , STAGE_BYTES = 8 * HTB, NXCD = 8, WGM = 16;

__host__ __device__ __forceinline__ int lds_byte(int r, int c) { const int st = (r >> 4) * 2 + (c >> 5), rr = r & 15, cc = c & 31, ob = rr * 64 + cc * 2; return st * 1024 + (ob ^ (((ob >> 9) & 1) << 5)); }
__host__ __device__ __forceinline__ void stage_rc(int b, int& R, int& C) { const int st = b / 1024, sb = b % 1024, swz = sb ^ (((sb >> 9) & 1) << 5); R = (st >> 1) * 16 + swz / 64; C = (st & 1) * 32 + (swz % 64) / 2; }
__host__ __device__ __forceinline__ int perm32(int rho) { const int n = rho >> 4, i = rho & 15; return 8 * (i >> 2) + 4 * n + (i & 3); }

struct Unit { int pm, pn, g; };
struct Gemm { const bf16_t* A; const bf16_t* Bt; int M, N, K; const bf16_t* A2 = nullptr; const bf16_t* Bt2 = nullptr; };

struct StaticOrder {
    int nM, nN, nwg, G, c;
    __host__ __device__ void init(int M, int N, int G_, int c_) { nM = M / BM; nN = N / BM; nwg = nM * nN; G = G_; c = c_; }
    __host__ __device__ bool next(int i, Unit& u) const {
        const long L = (long)i * G + c; if (L >= nwg) return false;
        int wgid = (int)L; { const int q = nwg / NXCD, r = nwg % NXCD, xcd = wgid % NXCD, off = wgid / NXCD; wgid = (xcd < r ? xcd * (q + 1) : r * (q + 1) + (xcd - r) * q) + off; }
        const int nig = WGM * nN, gid = wgid / nig, fm = gid * WGM, gsz = (nM - fm) < WGM ? (nM - fm) : WGM;
        u.pm = fm + ((wgid % nig) % gsz); u.pn = (wgid % nig) / gsz; u.g = 0; return true;
    }
    __device__ __forceinline__ void a_ready(const Unit&) const {}
    __device__ __forceinline__ void done(const Unit&) const {}
};

__device__ __forceinline__ unsigned cvt_pk_bf16(float lo, float hi) { unsigned r; asm volatile("v_cvt_pk_bf16_f32 %0, %1, %2" : "=v"(r) : "v"(lo), "v"(hi)); return r; }
typedef float f32x2 __attribute__((ext_vector_type(2)));
__device__ __forceinline__ f32x2 gelu_pk(f32x2 v) {
    const f32x2 av = __builtin_elementwise_abs(v), d = av * 0.2316418882f + 1.0f;
    f32x2 t; t.x = __builtin_amdgcn_rcpf(d.x); t.y = __builtin_amdgcn_rcpf(d.y);
    f32x2 q = t * 0.5307027145f + (-0.7265760135f); q = q * t + 0.7107068705f; q = q * t + (-0.142248368f); q = q * t + 0.127414796f; q = q * t;
    const f32x2 s = (v * v) * (-0.72134752044f);
    f32x2 e; e.x = __builtin_amdgcn_exp2f(s.x); e.y = __builtin_amdgcn_exp2f(s.y);
    const f32x2 m = v * (q * e), r = v - m;
    f32x2 o; o.x = v.x < 0.f ? m.x : r.x; o.y = v.y < 0.f ? m.y : r.y; return o;
}

template <int ACT  > struct EpiBf16 {
    static constexpr bool PERM = true, AFTER_DRAIN = false; static_assert(ACT == 0 || ACT == 1, "EpiBf16: ACT is 0 (none) or 1 (gelu_pk)");
    bf16_t* O; int ldc; const float* bias; int split_cols; size_t split_stride; float scale0;
    __device__ __forceinline__ void operator()(const f32x4 (&acc)[2][2][4][2], const Unit& u, int wr, int wc, int fr, int fq) const {
        const int row0 = u.pm * BM + wr * 64 + fr; int colt = u.pn * BM; bf16_t* base = O;
        float sc = 1.f; if (split_cols) { const int t = colt / split_cols; base += (size_t)t * split_stride; colt -= t * split_cols; if (t == 0) sc = scale0; }
        const int col0 = colt + wc * 32 + 8 * fq, bcol0 = u.pn * BM + wc * 32 + 8 * fq;
        f32x4 bv[2][2];
#pragma unroll
        for (int bj = 0; bj < 2; ++bj)
#pragma unroll
            for (int n = 0; n < 2; ++n) bv[bj][n] = bias ? *(const f32x4*)(bias + bcol0 + bj * HALF + 4 * n) : (f32x4){0.f, 0.f, 0.f, 0.f};
#pragma unroll
        for (int ai = 0; ai < 2; ++ai)
#pragma unroll
            for (int m = 0; m < 4; ++m) { bf16_t* rowp = base + (size_t)(row0 + ai * HALF + m * 16) * ldc + col0;
#pragma unroll
                for (int bj = 0; bj < 2; ++bj) { f32x4 v0 = acc[ai][bj][m][0] + bv[bj][0], v1 = acc[ai][bj][m][1] + bv[bj][1];
                    if (ACT == 1) { f32x2 a = gelu_pk((f32x2){v0[0], v0[1]}), b = gelu_pk((f32x2){v0[2], v0[3]}), c = gelu_pk((f32x2){v1[0], v1[1]}), d = gelu_pk((f32x2){v1[2], v1[3]});
                        v0 = (f32x4){a.x, a.y, b.x, b.y}; v1 = (f32x4){c.x, c.y, d.x, d.y}; }
                    v0 = v0 * sc; v1 = v1 * sc; u32x4 w; w.x = cvt_pk_bf16(v0[0], v0[1]); w.y = cvt_pk_bf16(v0[2], v0[3]); w.z = cvt_pk_bf16(v1[0], v1[1]); w.w = cvt_pk_bf16(v1[2], v1[3]);
                    *(u32x4*)(rowp + bj * HALF) = w; } }
    }
};
typedef int pg8_v8i __attribute__((ext_vector_type(8))); typedef int pg8_v4i __attribute__((ext_vector_type(4)));
__device__ __forceinline__ pg8_v8i pg8_cat8(bf16x8 a, bf16x8 b) { return __builtin_shufflevector(__builtin_bit_cast(pg8_v4i, a), __builtin_bit_cast(pg8_v4i, b), 0, 1, 2, 3, 4, 5, 6, 7); }
template <class Epi, class Sched, bool ALIGN_EPI = false, bool SP2 = false, bool F8 = false, int WSCALE = 127>
__device__ __forceinline__ void gemm_phase(PG8_LAS unsigned char* lds, const Gemm g, const Sched& S, const Epi& E, int wave_idx) {
    int tid_ = wave_idx * 64 + mk_lane(); asm volatile("" : "+v"(tid_));
    const int tid = tid_, wid = __builtin_amdgcn_readfirstlane(tid >> 6), lane = tid & 63, wr = wid >> 2, wc = wid & 3, fr = lane & 15, fq = lane >> 4;
    const int K = g.K, nt = K / BK;
    unsigned voffA[2], voffB[2];
#pragma unroll
    for (int i = 0; i < 2; ++i) { int R, C; stage_rc(tid * 16 + i * 8192, R, C); const int Rb = Epi::PERM ? ((R & ~31) + perm32(R & 31)) : R;
        voffA[i] = (unsigned)(R * K + C) * 2u; voffB[i] = (unsigned)(Rb * K + C) * 2u; }
    const size_t kstep = (size_t)(BK * 2);
    const size_t hstep = (size_t)HALF * K * 2;
    const size_t tstep = 2 * hstep;
    const unsigned ldsw = (unsigned)wid * 1024u;
    int aoffk[2], boffk[2];
    if constexpr (F8) { aoffk[0] = lds_byte(wr * 64 + fr, (2 * (fq & 1)) * 8) + (fq >> 1) * 1024; aoffk[1] = lds_byte(wr * 64 + fr, (2 * (fq & 1) + 1) * 8) + (fq >> 1) * 1024;
        boffk[0] = lds_byte(wc * 32 + fr, (2 * (fq & 1)) * 8) + (fq >> 1) * 1024; boffk[1] = lds_byte(wc * 32 + fr, (2 * (fq & 1) + 1) * 8) + (fq >> 1) * 1024; }
    else { aoffk[0] = lds_byte(wr * 64 + fr, fq * 8); aoffk[1] = aoffk[0] + 1024; boffk[0] = lds_byte(wc * 32 + fr, fq * 8); boffk[1] = boffk[0] + 1024; }
#define PG8_SA(b, h) (((b) * 2 + (h)) * HTB)
#define PG8_SB(b, h) ((4 + (b) * 2 + (h)) * HTB)
#define PG8_STAGE(bufoff, gbase, voff) do { const char* gb_ = (const char*)(gbase); _Pragma("unroll") for (int _i = 0; _i < 2; ++_i) { unsigned keep_; \
        asm volatile("s_mov_b32 %0, m0\n\ts_mov_b32 m0, %2\n\ts_nop 0\n\tglobal_load_lds_dwordx4 %1, %3\n\ts_mov_b32 m0, %0" : "=&s"(keep_) : "v"((voff)[_i]), "s"((unsigned)(size_t)(lds + (bufoff) + ldsw + _i * 8192)), "s"(gb_) : "memory"); } } while (0)
#define PG8_LDA(dst, b, h) do { if constexpr (F8) { _Pragma("unroll") for (int m = 0; m < 4; ++m) dst##8[m] = *(const PG8_LAS pg8_v8i*)(lds + PG8_SA(b, h) + aoffk[0] + m * 2048); } else { _Pragma("unroll") for (int m = 0; m < 4; ++m) _Pragma("unroll") for (int k = 0; k < 2; ++k) dst[m][k] = *(const PG8_LAS bf16x8*)(lds + PG8_SA(b, h) + aoffk[k] + m * 2048); } } while (0)
#define PG8_LDB(dst, b, h) do { if constexpr (F8) { _Pragma("unroll") for (int n = 0; n < 2; ++n) dst##8[n] = *(const PG8_LAS pg8_v8i*)(lds + PG8_SB(b, h) + boffk[0] + n * 2048); } else { _Pragma("unroll") for (int n = 0; n < 2; ++n) _Pragma("unroll") for (int k = 0; k < 2; ++k) dst[n][k] = *(const PG8_LAS bf16x8*)(lds + PG8_SB(b, h) + boffk[k] + n * 2048); } } while (0)
#define PG8_MMA(ai, bj, At, Bt) do { __builtin_amdgcn_s_setprio(1); _Pragma("unroll") for (int m = 0; m < 4; ++m) _Pragma("unroll") for (int n = 0; n < 2; ++n) { \
        if constexpr (F8) acc[ai][bj][m][n] = __builtin_amdgcn_mfma_scale_f32_16x16x128_f8f6f4(Bt##8[n], At##8[m], acc[ai][bj][m][n], 0, 0, 0, wsc_, 0, wsc_);     \
        else { _Pragma("unroll") for (int k = 0; k < 2; ++k) acc[ai][bj][m][n] = __builtin_amdgcn_mfma_f32_16x16x32_bf16(Bt[n][k], At[m][k], acc[ai][bj][m][n], 0, 0, 0); } } __builtin_amdgcn_s_setprio(0); } while (0)
#define PG8_WAIT_V(n) asm volatile("s_waitcnt vmcnt(" #n ")" ::: "memory")
#define PG8_WAIT_L(n) asm volatile("s_waitcnt lgkmcnt(" #n ")" ::: "memory")
#define PG8_BAR __builtin_amdgcn_s_barrier()
#define PG8_SCHED __builtin_amdgcn_sched_barrier(0)
    int wsc_ = WSCALE; asm volatile("" : "+v"(wsc_));
    Unit cur, nxt; int ui = 0;
    if (!S.next(0, cur)) return;
    f32x4 acc[2][2][4][2];
#pragma unroll
    for (int a = 0; a < 2; ++a)
#pragma unroll
        for (int b = 0; b < 2; ++b)
#pragma unroll
            for (int m = 0; m < 4; ++m)
#pragma unroll
                for (int n = 0; n < 2; ++n) acc[a][b][m][n] = (f32x4){0.f, 0.f, 0.f, 0.f};
    bf16x8 At[4][2], B0[2][2], B1[2][2];
    pg8_v8i At8[4], B08[2], B18[2];
    const char* cA = (const char*)(cur.g ? g.A2 : g.A) + (size_t)cur.pm * tstep; const char* cB = (const char*)(cur.g ? g.Bt2 : g.Bt) + (size_t)cur.pn * tstep;
    S.a_ready(cur);
    if constexpr (SP2) {
        PG8_STAGE(PG8_SB(0, 0), cB, voffB); PG8_STAGE(PG8_SB(0, 1), cB + hstep, voffB); PG8_STAGE(PG8_SA(0, 0), cA, voffA); PG8_STAGE(PG8_SA(0, 1), cA + hstep, voffA);
        if (wr == 1) PG8_BAR;
        PG8_WAIT_V(2); PG8_BAR;
        PG8_STAGE(PG8_SB(1, 0), cB + kstep, voffB); PG8_STAGE(PG8_SA(1, 0), cA + kstep, voffA); PG8_STAGE(PG8_SB(1, 1), cB + hstep + kstep, voffB);
        PG8_WAIT_V(6); PG8_BAR;
    } else {
        PG8_STAGE(PG8_SB(0, 0), cB, voffB); PG8_STAGE(PG8_SA(0, 0), cA, voffA); PG8_STAGE(PG8_SB(0, 1), cB + hstep, voffB); PG8_STAGE(PG8_SA(0, 1), cA + hstep, voffA);
        if (wr == 1) PG8_BAR;
        PG8_WAIT_V(4); PG8_BAR;
        PG8_STAGE(PG8_SB(1, 0), cB + kstep, voffB); PG8_STAGE(PG8_SA(1, 0), cA + kstep, voffA); PG8_STAGE(PG8_SB(1, 1), cB + hstep + kstep, voffB);
        PG8_WAIT_V(6); PG8_BAR;
    }
    for (;;) {
        const bool has_next = S.next(ui + 1, nxt);
        const char* nA = has_next ? (const char*)(nxt.g ? g.A2 : g.A) + (size_t)nxt.pm * tstep : cA; const char* nB = has_next ? (const char*)(nxt.g ? g.Bt2 : g.Bt) + (size_t)nxt.pn * tstep : cB;
#pragma unroll 1
        for (int t = 0; t < nt; t += 2) {
            const bool last = (t == nt - 2);
            const char* a1 = cA + (size_t)(t + 1) * kstep;
            const char* a2 = last ? nA : cA + (size_t)(t + 2) * kstep; const char* b2 = last ? nB : cB + (size_t)(t + 2) * kstep;
            const char* a3 = a2 + kstep; const char* b3 = b2 + kstep;
            if (last && has_next) S.a_ready(nxt);
            if constexpr (SP2) {
            PG8_LDB(B0, 0, 0); PG8_LDB(B1, 0, 1); PG8_SCHED; PG8_LDA(At, 0, 0); PG8_STAGE(PG8_SA(1, 1), a1 + hstep, voffA);
            PG8_WAIT_V(8); PG8_WAIT_L(0); PG8_BAR; PG8_MMA(0, 0, At, B0); PG8_MMA(0, 1, At, B1); PG8_BAR; PG8_SCHED;
            PG8_LDA(At, 0, 1); PG8_STAGE(PG8_SB(0, 0), b2, voffB); PG8_STAGE(PG8_SB(0, 1), b2 + hstep, voffB); PG8_STAGE(PG8_SA(0, 0), a2, voffA);
            PG8_WAIT_V(8); PG8_WAIT_L(0); PG8_BAR; PG8_MMA(1, 0, At, B0); PG8_MMA(1, 1, At, B1); PG8_BAR; PG8_SCHED;
            PG8_LDB(B0, 1, 0); PG8_LDB(B1, 1, 1); PG8_SCHED; PG8_LDA(At, 1, 0); PG8_STAGE(PG8_SA(0, 1), a2 + hstep, voffA);
            PG8_WAIT_V(8); PG8_WAIT_L(0); PG8_BAR; PG8_MMA(0, 0, At, B0); PG8_MMA(0, 1, At, B1); PG8_BAR; PG8_SCHED;
            PG8_LDA(At, 1, 1); PG8_STAGE(PG8_SB(1, 0), b3, voffB); PG8_STAGE(PG8_SB(1, 1), b3 + hstep, voffB); PG8_STAGE(PG8_SA(1, 0), a3, voffA);
            PG8_WAIT_V(8); PG8_WAIT_L(0); PG8_BAR; PG8_MMA(1, 0, At, B0); PG8_MMA(1, 1, At, B1); PG8_BAR; PG8_SCHED;
            } else {
            PG8_LDB(B0, 0, 0); PG8_SCHED; PG8_LDA(At, 0, 0); PG8_STAGE(PG8_SA(1, 1), a1 + hstep, voffA);
            PG8_WAIT_L(8); PG8_BAR; PG8_WAIT_L(0); PG8_MMA(0, 0, At, B0); PG8_BAR; PG8_SCHED;
            PG8_LDB(B1, 0, 1); PG8_STAGE(PG8_SB(0, 0), b2, voffB);
            PG8_BAR; PG8_WAIT_L(0); PG8_MMA(0, 1, At, B1); PG8_BAR;
            PG8_LDA(At, 0, 1); PG8_STAGE(PG8_SA(0, 0), a2, voffA);
            PG8_BAR; PG8_WAIT_L(0); PG8_MMA(1, 0, At, B0); PG8_BAR; PG8_SCHED;
            PG8_STAGE(PG8_SB(0, 1), b2 + hstep, voffB);
            PG8_WAIT_V(6); PG8_BAR; PG8_MMA(1, 1, At, B1); PG8_BAR;
            PG8_LDB(B0, 1, 0); PG8_SCHED; PG8_LDA(At, 1, 0); PG8_STAGE(PG8_SA(0, 1), a2 + hstep, voffA);
            PG8_WAIT_L(8); PG8_BAR; PG8_WAIT_L(0); PG8_MMA(0, 0, At, B0); PG8_BAR; PG8_SCHED;
            PG8_LDB(B1, 1, 1); PG8_STAGE(PG8_SB(1, 0), b3, voffB);
            PG8_BAR; PG8_WAIT_L(0); PG8_MMA(0, 1, At, B1); PG8_BAR;
            PG8_LDA(At, 1, 1); PG8_STAGE(PG8_SA(1, 0), a3, voffA);
            PG8_BAR; PG8_WAIT_L(0); PG8_MMA(1, 0, At, B0); PG8_BAR; PG8_SCHED;
            PG8_STAGE(PG8_SB(1, 1), b3 + hstep, voffB);
            PG8_WAIT_V(6); PG8_BAR; PG8_MMA(1, 1, At, B1); PG8_BAR;
            }
        }
        if constexpr (ALIGN_EPI) { if (wr == 0) PG8_BAR; }
        if constexpr (!Epi::AFTER_DRAIN) { { int pm_ = cur.pm, pn_ = cur.pn; asm volatile("" : "+s"(pm_), "+s"(pn_)); cur.pm = pm_; cur.pn = pn_; }
            { int t2_ = mk_lane(); asm volatile("" : "+v"(t2_)); E(acc, cur, wr, wc, t2_ & 15, (t2_ & 63) >> 4); }
            S.done(cur); }
        if (!has_next) break;
#pragma unroll
        for (int a = 0; a < 2; ++a)
#pragma unroll
            for (int b = 0; b < 2; ++b)
#pragma unroll
                for (int m = 0; m < 4; ++m)
#pragma unroll
                    for (int n = 0; n < 2; ++n) acc[a][b][m][n] = (f32x4){0.f, 0.f, 0.f, 0.f};
        cur = nxt; cA = nA; cB = nB; ++ui;
        if constexpr (ALIGN_EPI) { if (wr == 1) PG8_BAR; }
    }
    PG8_WAIT_V(0);
    if constexpr (!ALIGN_EPI) { if (wr == 0) PG8_BAR; }
    PG8_BAR;
    if constexpr (Epi::AFTER_DRAIN) { E.fused(acc, cur, wr, wc, fr, fq, lds, wid, lane); S.done(cur); }
#undef PG8_SA
#undef PG8_SB
#undef PG8_STAGE
#undef PG8_LDA
#undef PG8_LDB
#undef PG8_MMA
#undef PG8_WAIT_V
#undef PG8_WAIT_L
#undef PG8_BAR
#undef PG8_SCHED
}
}

typedef unsigned short bf16;
typedef unsigned v4u __attribute__((ext_vector_type(4)));
typedef unsigned v2u __attribute__((ext_vector_type(2)));
typedef float f32x4 __attribute__((ext_vector_type(4)));
typedef float f32x2 __attribute__((ext_vector_type(2)));
typedef float f32x16 __attribute__((ext_vector_type(16)));
typedef short bf16x8 __attribute__((ext_vector_type(8)));
typedef short s16x4 __attribute__((ext_vector_type(4)));
typedef GAS unsigned gu32;

constexpr int D = 1024, NB = 16, SEQ = 4096, LCX = 256, DEPTH = 4;
constexpr int NL = NB * SEQ, NC = NB * LCX, NT = NL + NC;
constexpr int N_IN = 2592, PCOLS = 2048, D_OFF = 1824, HYC = 768;
constexpr int FFD = 2816, FFE = 3584, NE = 8;
constexpr float ALPHA = 1.6817928305074292f;
constexpr int NWAVES = 8, NTHR = 512;
constexpr int KSEQ = SEQ + LCX;

enum { I_X = 0, I_C, I_CTX, I_CCTX, I_ADAW, I_ADAB, I_WIN, I_QNORM, I_KVNORM, I_WUQ, I_WUKV, I_MLAON, I_LCW, I_LCB, I_LWR, I_LBR, I_LWI, I_LBI, I_LLAM, I_LON,
       I_MUP, I_MUN, I_W0, I_WUP, I_A0, I_AUP, I_GUP, I_KK, I_KA, I_RK, I_LNG, I_LNB, I_HCW, I_HCB, I_HW1, I_HB1, I_HW2, I_HB2, I_HW3, I_HD, I_HON,
       I_WOUT, I_LN1G, I_LN1B, I_LN2G, I_LN2B, I_FG, I_FU, I_FD, I_ROUTER, I_MG, I_MU, I_MD, N_INPUTS };

constexpr size_t MiB = 1u << 20;
constexpr size_t WS_CTL = 0, CTL_ZERO_BYTES = 1 * MiB;
constexpr size_t WS_MOD = 1 * MiB;
constexpr size_t WS_ROPE = 3 * MiB;
constexpr size_t WS_H2L = 4 * MiB;
constexpr size_t WS_H2C = 8 * MiB;
constexpr size_t WS_LRUW = 9 * MiB;
constexpr size_t WS_WUQT = 10 * MiB;
constexpr size_t WS_WUKVT = 11 * MiB;
constexpr size_t WS_SUMM = 12 * MiB;
constexpr size_t WS_BON = 17 * MiB;
constexpr size_t WS_TOKE = 20 * MiB;
constexpr size_t WS_TOKG = 21 * MiB;
constexpr size_t WS_TOKS = 22 * MiB;
constexpr size_t WS_BLKCNT = 23 * MiB;
constexpr size_t WS_SPEC = 24 * MiB;
constexpr size_t WS_WINT = 56 * MiB;
constexpr size_t WS_WHYT = 72 * MiB;
constexpr size_t WS_WOUTT = 78 * MiB;
constexpr size_t WS_WGUT = 86 * MiB;
constexpr size_t WS_WDT = 108 * MiB;
constexpr size_t WS_XC = 120 * MiB;
constexpr size_t WS_A1 = 136 * MiB;
constexpr size_t WS_ARENA = 272 * MiB;
constexpr size_t WS_P = WS_ARENA;
constexpr size_t WS_HT = 544 * MiB;
constexpr size_t WS_QB = 646 * MiB;
constexpr size_t WS_KB = 697 * MiB;
constexpr size_t WS_VT = 748 * MiB;
constexpr size_t WS_AO = 782 * MiB;
constexpr size_t WS_HOT = 816 * MiB;
constexpr size_t WS_YR = 850 * MiB;
constexpr size_t WS_Y = 986 * MiB;
constexpr size_t WS_H = WS_ARENA;
constexpr size_t WS_MGU = WS_ARENA;
constexpr size_t WS_MD = 384 * MiB;
constexpr size_t WS_XS = 440 * MiB;
constexpr size_t WS_HM = 716 * MiB;
constexpr size_t WS_END = 1122 * MiB;
constexpr size_t WS_M8GU = WS_ARENA;
constexpr size_t WS_M8D = 328 * MiB;
constexpr size_t WS_XS8 = 356 * MiB;
constexpr size_t WS_Y2 = 494 * MiB;
constexpr size_t WS_HM8 = 770 * MiB;
constexpr int MOE_MAX_TILES = 552, MOE_NCHUNK = 3, MOE_CHUNK_TILES = 192;
static_assert(WS_HM8 + (size_t)MOE_CHUNK_TILES * 256 * FFE <= WS_END && WS_M8GU + (size_t)8 * 2 * FFE * D <= WS_M8D && WS_M8D + (size_t)8 * D * FFE <= WS_XS8 && WS_XS8 + (size_t)141312 * D <= WS_Y2 && WS_Y2 + (size_t)141312 * D * 2 <= WS_HM8, "moe fp8 map");
static_assert(WS_H + (size_t)NT * FFD * 2 <= WS_QB + 51 * MiB, "dense hidden");

#ifndef DENSE_FFN2_F8
#define DENSE_FFN2_F8 1
#endif
constexpr int CW_DYN = 32768, LN_DYN = 48;
constexpr int CW_BAR = 4096;

constexpr int RING_BYTES = 131072;
constexpr int LDSCTL_OFF = RING_BYTES;
constexpr int LDS_TILEE = LDSCTL_OFF + 256;
constexpr int LDS_MOEI = LDSCTL_OFF + 1024;
constexpr int LDS_BYTES = 147456;

#define LDS_WAIT() asm volatile("s_waitcnt lgkmcnt(0)" ::: "memory")
#define VM_WAIT() asm volatile("s_waitcnt vmcnt(0)" ::: "memory")
typedef __bf16 hwbf16x2 __attribute__((ext_vector_type(2)));
__device__ __forceinline__ unsigned pk2(float lo, float hi) { const f32x2 v = {lo, hi}; const hwbf16x2 b = __builtin_convertvector(v, hwbf16x2); return __builtin_bit_cast(unsigned, b); }
__device__ __forceinline__ unsigned f2bf(float f) { return pk2(f, 0.f) & 0xffffu; }
__device__ __forceinline__ unsigned pk4_fp8(float a, float b, float c, float d) { int w = __builtin_amdgcn_cvt_pk_fp8_f32(a, b, 0, false); w = __builtin_amdgcn_cvt_pk_fp8_f32(c, d, w, true); return (unsigned)w; }
__device__ __forceinline__ float bf2f(unsigned b) { return __builtin_bit_cast(float, b << 16); }
__device__ __forceinline__ float bflo(unsigned w) { return __builtin_bit_cast(float, w << 16); }
__device__ __forceinline__ float bfhi(unsigned w) { return __builtin_bit_cast(float, w & 0xffff0000u); }
__device__ __forceinline__ float wave_sum(float v) {
#pragma unroll
    for (int o = 1; o < 64; o <<= 1) v += __shfl_xor(v, o);
    return v;
}
__device__ __forceinline__ float sigmoidf_(float x) { return 1.f / (1.f + __expf(-x)); }
#define XB_TMO      128
#define XB_XCNT(j)  (256  + 64 * (j))
#define XB_XSUB(j)  (1280 + 64 * (j))
#define XB_XGEN(j)  (2304 + 64 * (j))
#define XB_TOP      3328
#define XB_TOPGEN   3392
#define XCD_BAR_WORDS 3456
#define XB_SPIN_CAP (1u << 18)

__device__ __forceinline__ unsigned xb_ld(unsigned* p)              { return __hip_atomic_load(p, __ATOMIC_RELAXED, __HIP_MEMORY_SCOPE_AGENT); }
__device__ __forceinline__ unsigned xb_add(unsigned* p, unsigned v) { return __hip_atomic_fetch_add(p, v, __ATOMIC_RELAXED, __HIP_MEMORY_SCOPE_AGENT); }
__device__ __forceinline__ unsigned xb_xcc_id() { return (unsigned)__builtin_amdgcn_s_getreg((3 << 11) | 20) & 0xFu; }
#define XB_SPIN(cond, bar) do { unsigned _sp = 0; while (cond) { __builtin_amdgcn_s_sleep(1); \
    if ((++_sp & 255u) == 0u) { if (xb_ld(&(bar)[XB_TMO])) break; if (_sp > XB_SPIN_CAP) { atomicAdd(&(bar)[XB_TMO], 1u); break; } } } } while (0)

struct XcdBarrier {
    int leader; unsigned* bar; unsigned x;
    volatile LAS unsigned* st;
};

__device__ __forceinline__ XcdBarrier xcd_barrier_post(unsigned* bar, volatile LAS unsigned* st, int leader) {
    XcdBarrier b; b.leader = leader; b.bar = bar; b.x = xb_xcc_id(); b.st = st;
    if (leader) (void)xb_add(&bar[XB_XCNT(b.x)], 1u);
    return b;
}
__device__ __forceinline__ void xcd_barrier_complete(unsigned* bar, unsigned x, unsigned& nloc, unsigned& nx) {
    const unsigned G = gridDim.x * gridDim.y * gridDim.z;
    unsigned sum, cnt, mine, sp = 0u;
    for (;;) {
        sum = 0u; cnt = 0u; mine = 0u;
#pragma unroll
        for (unsigned j = 0; j < 16; ++j) { const unsigned c = xb_ld(&bar[XB_XCNT(j)]); sum += c; cnt += (c > 0u) ? 1u : 0u; mine = (j == x) ? c : mine; }
        if (sum == G) break;
        __builtin_amdgcn_s_sleep(1);
        if ((++sp & 255u) == 0u) { if (xb_ld(&bar[XB_TMO])) break; if (sp > XB_SPIN_CAP) { atomicAdd(&bar[XB_TMO], 1u); break; } }
    }
    nloc = mine > 0u ? mine : 1u; nx = cnt > 0u ? cnt : 1u;
}

__device__ __forceinline__ void xcd_barrier(const XcdBarrier& b) {
    asm volatile("s_waitcnt vmcnt(0)" ::: "memory");
    __syncthreads();
    if (b.leader) {
        unsigned* bar = b.bar;
        __builtin_amdgcn_s_waitcnt(0);
        unsigned nloc = b.st[0], nx = b.st[1];
        if (nloc == 0u) { xcd_barrier_complete(bar, b.x, nloc, nx); b.st[0] = nloc; b.st[1] = nx; }
        const unsigned old = xb_add(&bar[XB_XSUB(b.x)], 1u);
        const unsigned gen = old / nloc;
        if (old + 1u == (gen + 1u) * nloc) {
            __builtin_amdgcn_fence(__ATOMIC_RELEASE, "agent");
            asm volatile("s_waitcnt vmcnt(0)" ::: "memory");
            const unsigned og = xb_add(&bar[XB_TOP], 1u);
            const unsigned tg = og / nx;
            if (og + 1u == (tg + 1u) * nx) xb_add(&bar[XB_TOPGEN], 1u);
            else XB_SPIN(xb_ld(&bar[XB_TOPGEN]) == tg, bar);
            __builtin_amdgcn_fence(__ATOMIC_ACQUIRE, "agent");
            xb_add(&bar[XB_XGEN(b.x)], 1u);
            asm volatile("s_waitcnt vmcnt(0)" ::: "memory");
        } else {
            XB_SPIN(xb_ld(&bar[XB_XGEN(b.x)]) == gen, bar);
            __builtin_amdgcn_fence(__ATOMIC_ACQUIRE, "agent");
            asm volatile("s_waitcnt vmcnt(0)" ::: "memory");
        }
    }
    __syncthreads();
}

struct Args { const float* in[N_INPUTS]; float* out; unsigned char* ws; };
struct Frame { LAS unsigned char* lds; int tid, lane, wave, G; };
__device__ __forceinline__ void frame_refresh(Frame& F) { int t = F.wave * 64 + mk_lane(); asm volatile("" : "+v"(t)); F.tid = t; F.lane = t & 63; }
#define CAS __attribute__((address_space(4)))
__device__ __forceinline__ const CAS char* karg() { const CAS char* kp = (const CAS char*)__builtin_amdgcn_kernarg_segment_ptr(); asm volatile("" : "+s"(kp)); return kp; }
__device__ __forceinline__ const float* in_ptr(int i) { return *(const float* const CAS*)(karg() + 8 * i); }
__device__ __forceinline__ float* out_ptr() { return *(float* const CAS*)(karg() + 8 * N_INPUTS); }
__device__ __forceinline__ unsigned char* ws_ptr() { return *(unsigned char* const CAS*)(karg() + 8 * N_INPUTS + 8); }
#define WSP(T, off) ((T*)(ws + (off)))
#define WS_DECL unsigned char* const ws = ws_ptr()

namespace pg8 {
struct EpiStore {
    static constexpr bool PERM = true, AFTER_DRAIN = false;
    bf16_t* O; int ldc; int pm_add; int nN;
    __device__ __forceinline__ void operator()(const f32x4 (&acc)[2][2][4][2], const Unit& u, int wr, int wc, int fr, int fq) const {
        const int row0 = (u.pm + pm_add) * BM + wr * 64 + fr; const int col0 = (u.pn % nN) * BM + wc * 32 + 8 * fq;
#pragma unroll
        for (int ai = 0; ai < 2; ++ai)
#pragma unroll
            for (int m = 0; m < 4; ++m) { bf16_t* rowp = O + (size_t)(row0 + ai * HALF + m * 16) * ldc + col0;
#pragma unroll
                for (int bj = 0; bj < 2; ++bj) { const f32x4 v0 = acc[ai][bj][m][0], v1 = acc[ai][bj][m][1];
                    u32x4 w; w.x = cvt_pk_bf16(v0[0], v0[1]); w.y = cvt_pk_bf16(v0[2], v0[3]); w.z = cvt_pk_bf16(v1[0], v1[1]); w.w = cvt_pk_bf16(v1[2], v1[3]);
                    *(u32x4*)(rowp + bj * HALF) = w; } }
    }
};
__device__ __forceinline__ float silu_mul(float g, float u) { return g * __builtin_amdgcn_rcpf(1.f + __expf(-g)) * u; }
struct EpiSwiGLU {
    static constexpr bool PERM = true, AFTER_DRAIN = false;
    bf16_t* H; int ldh; int pm_sub; int nN;
    __device__ __forceinline__ void operator()(const f32x4 (&acc)[2][2][4][2], const Unit& u, int wr, int wc, int fr, int fq) const {
        const int row0 = (u.pm - pm_sub) * BM + wr * 64 + fr; const int col0 = (u.pn % nN) * HALF + wc * 32 + 8 * fq;
#pragma unroll
        for (int ai = 0; ai < 2; ++ai)
#pragma unroll
            for (int m = 0; m < 4; ++m) { bf16_t* rowp = H + (size_t)(row0 + ai * HALF + m * 16) * ldh + col0;
                const f32x4 g0 = acc[ai][0][m][0], g1 = acc[ai][0][m][1], u0 = acc[ai][1][m][0], u1 = acc[ai][1][m][1];
                u32x4 w; w.x = cvt_pk_bf16(silu_mul(g0[0], u0[0]), silu_mul(g0[1], u0[1])); w.y = cvt_pk_bf16(silu_mul(g0[2], u0[2]), silu_mul(g0[3], u0[3]));
                w.z = cvt_pk_bf16(silu_mul(g1[0], u1[0]), silu_mul(g1[1], u1[1])); w.w = cvt_pk_bf16(silu_mul(g1[2], u1[2]), silu_mul(g1[3], u1[3]));
                *(u32x4*)rowp = w; }
    }
};
struct EpiSwiGLU8 {
    static constexpr bool PERM = true, AFTER_DRAIN = false;
    unsigned char* H; int ldh; int pm_sub; int nN;
    __device__ __forceinline__ void operator()(const f32x4 (&acc)[2][2][4][2], const Unit& u, int wr, int wc, int fr, int fq) const {
        const int row0 = (u.pm - pm_sub) * BM + wr * 64 + fr; const int col0 = (u.pn % nN) * HALF + wc * 32 + 8 * fq;
#pragma unroll
        for (int ai = 0; ai < 2; ++ai)
#pragma unroll
            for (int m = 0; m < 4; ++m) { unsigned char* rowp = H + (size_t)(row0 + ai * HALF + m * 16) * ldh + col0;
                const f32x4 g0 = acc[ai][0][m][0], g1 = acc[ai][0][m][1], u0 = acc[ai][1][m][0], u1 = acc[ai][1][m][1];
                ::v2u w; w.x = ::pk4_fp8(silu_mul(g0[0], u0[0]), silu_mul(g0[1], u0[1]), silu_mul(g0[2], u0[2]), silu_mul(g0[3], u0[3]));
                w.y = ::pk4_fp8(silu_mul(g1[0], u1[0]), silu_mul(g1[1], u1[1]), silu_mul(g1[2], u1[2]), silu_mul(g1[3], u1[3]));
                *(::v2u*)rowp = w; }
    }
};
struct MoeOrder {
    int nM, nN, nwg, G, c, t0, pm_off; const PG8_LAS unsigned char* tile_e;
    __device__ void init(int nM_, int nN_, int G_, int c_, int t0_, int pm_off_, const PG8_LAS unsigned char* te) { nM = nM_; nN = nN_; nwg = nM * nN; G = G_; c = c_; t0 = t0_; pm_off = pm_off_; tile_e = te; }
    __device__ bool next(int i, Unit& u) const {
        const long L = (long)i * G + c; if (L >= nwg) return false;
        int wgid = (int)L; { const int q = nwg / NXCD, r = nwg % NXCD, xcd = wgid % NXCD, off = wgid / NXCD; wgid = (xcd < r ? xcd * (q + 1) : r * (q + 1) + (xcd - r) * q) + off; }
        const int nig = WGM * nN, gid = wgid / nig, fm = gid * WGM, gsz = (nM - fm) < WGM ? (nM - fm) : WGM;
        const int pml = fm + ((wgid % nig) % gsz), pnl = (wgid % nig) / gsz;
        const int e = tile_e[t0 + pml];
        u.pm = pm_off + pml; u.pn = e * nN + pnl; u.g = 0; return true;
    }
    __device__ __forceinline__ void a_ready(const Unit&) const {}
    __device__ __forceinline__ void done(const Unit&) const {}
};
struct DualOrder {
    StaticOrder s0, s1; int G, c;
    __device__ void init(int M0, int N0, int M1, int N1, int G_, int c_) { s0.init(M0, N0, 1, 0); s1.init(M1, N1, 1, 0); G = G_; c = c_; }
    __device__ bool next(int i, Unit& u) const { const long L = (long)i * G + c;
        if (L < s0.nwg) { const bool ok = s0.next((int)L, u); u.g = 0; return ok; }
        const long L1 = L - s0.nwg; if (L1 >= s1.nwg) return false; const bool ok = s1.next((int)L1, u); u.g = 1; return ok; }
    __device__ __forceinline__ void a_ready(const Unit&) const {}
    __device__ __forceinline__ void done(const Unit&) const {}
};
struct EpiStore2 {
    static constexpr bool PERM = true, AFTER_DRAIN = false;
    bf16_t* O0; int ldc0; bf16_t* O1; int ldc1;
    __device__ __forceinline__ void operator()(const f32x4 (&acc)[2][2][4][2], const Unit& u, int wr, int wc, int fr, int fq) const {
        bf16_t* O = u.g ? O1 : O0; const int ldc = u.g ? ldc1 : ldc0;
        const int row0 = u.pm * BM + wr * 64 + fr; const int col0 = u.pn * BM + wc * 32 + 8 * fq;
#pragma unroll
        for (int ai = 0; ai < 2; ++ai)
#pragma unroll
            for (int m = 0; m < 4; ++m) { bf16_t* rowp = O + (size_t)(row0 + ai * HALF + m * 16) * ldc + col0;
#pragma unroll
                for (int bj = 0; bj < 2; ++bj) { const f32x4 v0 = acc[ai][bj][m][0], v1 = acc[ai][bj][m][1];
                    u32x4 w; w.x = cvt_pk_bf16(v0[0], v0[1]); w.y = cvt_pk_bf16(v0[2], v0[3]); w.z = cvt_pk_bf16(v1[0], v1[1]); w.w = cvt_pk_bf16(v1[2], v1[3]);
                    *(u32x4*)(rowp + bj * HALF) = w; } }
    }
};
}

__device__ __forceinline__ void tr_item(const float* W, int ldw, int k0, int c0, bf16* WT, int K, int drow, LAS float* scr, int lane) {
    { f32x4 t_[8];
#pragma unroll
      for (int i = 0; i < 8; ++i) t_[i] = *(const GAS f32x4*)(W + (size_t)(k0 + 8 * i + (lane >> 3)) * ldw + c0 + 4 * (lane & 7));
#pragma unroll
      for (int i = 0; i < 8; ++i) { LAS float* d_ = scr + (8 * i + (lane >> 3)) * 33 + 4 * (lane & 7); d_[0] = t_[i].x; d_[1] = t_[i].y; d_[2] = t_[i].z; d_[3] = t_[i].w; } }
    LDS_WAIT(); asm volatile("" ::: "memory");
    const int c = lane & 7;
#pragma unroll
    for (int j = 0; j < 4; ++j) { const int n = (lane >> 3) + 8 * j; const LAS float* s = scr + (8 * c) * 33 + n;
        v4u o; o.x = pk2(s[0 * 33], s[1 * 33]); o.y = pk2(s[2 * 33], s[3 * 33]); o.z = pk2(s[4 * 33], s[5 * 33]); o.w = pk2(s[6 * 33], s[7 * 33]);
        *(GAS v4u*)(WT + (size_t)(drow + n) * K + k0 + 8 * c) = o; }
    LDS_WAIT(); asm volatile("" ::: "memory");
}
__device__ __forceinline__ void tr_item8(const float* W, int ldw, int k0, int c0, unsigned char* WT, int K, int drow, LAS float* scr, int lane, float scale) {
    { f32x4 t_[8];
#pragma unroll
      for (int i = 0; i < 8; ++i) t_[i] = *(const GAS f32x4*)(W + (size_t)(k0 + 8 * i + (lane >> 3)) * ldw + c0 + 4 * (lane & 7));
#pragma unroll
      for (int i = 0; i < 8; ++i) { LAS float* d_ = scr + (8 * i + (lane >> 3)) * 33 + 4 * (lane & 7); d_[0] = t_[i].x; d_[1] = t_[i].y; d_[2] = t_[i].z; d_[3] = t_[i].w; } }
    LDS_WAIT(); asm volatile("" ::: "memory");
    const int c = lane & 7;
#pragma unroll
    for (int j = 0; j < 4; ++j) { const int n = (lane >> 3) + 8 * j; const LAS float* s = scr + (8 * c) * 33 + n;
        v2u o; o.x = pk4_fp8(s[0 * 33] * scale, s[1 * 33] * scale, s[2 * 33] * scale, s[3 * 33] * scale); o.y = pk4_fp8(s[4 * 33] * scale, s[5 * 33] * scale, s[6 * 33] * scale, s[7 * 33] * scale);
        *(GAS v2u*)(WT + (size_t)(drow + n) * K + k0 + 8 * c) = o; }
    LDS_WAIT(); asm volatile("" ::: "memory");
}
__device__ __forceinline__ void conv_matrix(Frame& F, const float* W, int K, int ldw, int cbeg, int ncols, bf16* WT, int mode, int rowoff, int& cursor, float f8scale = 0.f) {
    const int gw = blockIdx.x * NWAVES + F.wave, NGW = F.G * NWAVES;
    const int nblk = ncols / 32, nit = (K / 64) * nblk;
    LAS float* scr = (LAS float*)(F.lds + F.wave * 16384);
    int first = cursor + (((gw - cursor) % NGW) + NGW) % NGW;
    for (int it = first; it < cursor + nit; it += NGW) {
        const int idx = it - cursor, kb = idx / nblk, nb = idx % nblk, n = 32 * nb;
        const int drow = mode == 0 ? rowoff + n : ((n >> 7) * 256 + (n & 127) + rowoff);
        if (f8scale != 0.f) tr_item8(W, ldw, 64 * kb, cbeg + n, (unsigned char*)WT, K, drow, scr, F.lane, f8scale); else tr_item(W, ldw, 64 * kb, cbeg + n, WT, K, drow, scr, F.lane);
    }
    cursor += nit;
}

__device__ __forceinline__ void phase_mod(Frame& F) { WS_DECL; frame_refresh(F);
    LAS float* sv = (LAS float*)F.lds;
    LAS float* red = (LAS float*)(F.lds + 69632);
    float* MOD = WSP(float, WS_MOD);
    if ((int)blockIdx.x < 192) {
        const float* cl_ = in_ptr(I_C); const float* cc_ = in_ptr(I_CCTX); const float* adab = in_ptr(I_ADAB); const float* adaw = in_ptr(I_ADAW);
        for (int i = F.tid; i < 17 * 1024; i += NTHR) { const int b = i >> 10, k = i & 1023; const float c = b < 16 ? cl_[b * 1024 + k] : cc_[k]; sv[i] = c / (1.f + expf(-c)); }
        __syncthreads();
        for (int item = blockIdx.x; item < 192; item += F.G) {
            const int li = item / 48, cg = item % 48, cl = F.tid & 127, kq = F.tid >> 7;
            const float* W = adaw + (size_t)li * 1024 * 6144 + cg * 128 + cl;
            float acc[17];
#pragma unroll
            for (int b = 0; b < 17; ++b) acc[b] = 0.f;
#pragma unroll 1
            for (int k = kq * 256; k < kq * 256 + 256; k += 8) { float w[8];
#pragma unroll
                for (int j = 0; j < 8; ++j) w[j] = W[(size_t)(k + j) * 6144];
#pragma unroll
                for (int b = 0; b < 17; ++b) { const f32x4 s0 = *(const LAS f32x4*)(sv + b * 1024 + k), s1 = *(const LAS f32x4*)(sv + b * 1024 + k + 4);
                    acc[b] += (s0.x * w[0] + s0.y * w[1]) + (s0.z * w[2] + s0.w * w[3]) + (s1.x * w[4] + s1.y * w[5]) + (s1.z * w[6] + s1.w * w[7]); } }
#pragma unroll
            for (int b = 0; b < 17; ++b) red[(kq * 17 + b) * 128 + cl] = acc[b];
            __syncthreads();
            for (int o = F.tid; o < 17 * 128; o += NTHR) { const int b = o >> 7, c = o & 127;
                const float s = (red[(0 * 17 + b) * 128 + c] + red[(1 * 17 + b) * 128 + c]) + (red[(2 * 17 + b) * 128 + c] + red[(3 * 17 + b) * 128 + c]);
                MOD[((size_t)li * 17 + b) * 6144 + cg * 128 + c] = s + adab[li * 6144 + cg * 128 + c]; }
            __syncthreads();
        }
    }
}

__device__ __forceinline__ void phase_pro0(Frame& F) { WS_DECL; frame_refresh(F);
    phase_mod(F);
    __syncthreads();
    int cursor = 0;
    for (int li = 0; li < DEPTH; ++li) {
        conv_matrix(F, in_ptr(I_WIN) + (size_t)li * D * N_IN, D, N_IN, 0, D_OFF, WSP(bf16, WS_WINT) + (size_t)li * PCOLS * D, 0, 0, cursor);
        conv_matrix(F, in_ptr(I_WIN) + (size_t)li * D * N_IN, D, N_IN, D_OFF, HYC, WSP(bf16, WS_WHYT) + (size_t)li * HYC * D, 0, 0, cursor);
        conv_matrix(F, in_ptr(I_WOUT) + (size_t)li * D * D, D, D, 0, D, WSP(bf16, WS_WOUTT) + (size_t)li * D * D, 0, 0, cursor);
    }
    for (int j = 0; j < 2; ++j) {
        conv_matrix(F, in_ptr(I_FG) + (size_t)j * D * FFD, D, FFD, 0, FFD, (bf16*)(WSP(unsigned char, WS_WGUT) + (size_t)j * 2 * FFD * D), 1, 0, cursor, 64.f);
        conv_matrix(F, in_ptr(I_FU) + (size_t)j * D * FFD, D, FFD, 0, FFD, (bf16*)(WSP(unsigned char, WS_WGUT) + (size_t)j * 2 * FFD * D), 1, 128, cursor, 64.f);
        if (DENSE_FFN2_F8) conv_matrix(F, in_ptr(I_FD) + (size_t)j * FFD * D, FFD, D, 0, D, (bf16*)(WSP(unsigned char, WS_WDT) + (size_t)j * D * FFD), 0, 0, cursor, 256.f);
        else conv_matrix(F, in_ptr(I_FD) + (size_t)j * FFD * D, FFD, D, 0, D, WSP(bf16, WS_WDT) + (size_t)j * D * FFD, 0, 0, cursor);
    }
    { const int gt = blockIdx.x * NTHR + F.tid, NGT = F.G * NTHR; const int per = (PCOLS - D_OFF) * D / 8;
      for (int i = gt; i < DEPTH * per; i += NGT) { const int li = i / per, r = i % per; *(GAS v4u*)(WSP(bf16, WS_WINT) + (size_t)li * PCOLS * D + (size_t)D_OFF * D + (size_t)r * 8) = (v4u){0u, 0u, 0u, 0u}; } }
}

struct Stream { const float* inl; const float* inc; float* outl; float* outc; };
__device__ __forceinline__ Stream make_stream(unsigned char* ws, int li) { Stream s; s.outl = out_ptr(); s.outc = WSP(float, WS_XC); s.inl = li == 0 ? in_ptr(I_X) : (const float*)s.outl; s.inc = li == 0 ? in_ptr(I_CTX) : (const float*)s.outc; return s; }
__device__ __forceinline__ const float* stream_in(const Stream& s, int m) { return m < NL ? s.inl + (size_t)m * D : s.inc + (size_t)(m - NL) * D; }
__device__ __forceinline__ float* stream_out(const Stream& s, int m) { return m < NL ? s.outl + (size_t)m * D : s.outc + (size_t)(m - NL) * D; }
__device__ __forceinline__ int mod_b(int m) { return m < NL ? (m >> 12) : 16; }
__device__ __forceinline__ const float* mod_vec(unsigned char* ws, int li, int b, int j) { return WSP(float, WS_MOD) + ((size_t)li * 17 + b) * 6144 + j * 1024; }

__device__ __forceinline__ void store_modulated(const f32x4 (&x)[4], const float* shift, const float* scale, bf16* orow, int lane) {
#pragma unroll
    for (int j = 0; j < 4; ++j) { const int c = 4 * lane + 256 * j; const f32x4 sh = *(const GAS f32x4*)(shift + c), sc = *(const GAS f32x4*)(scale + c);
        const f32x4 h = x[j] * (sc + 1.f) + sh; v2u w; w.x = pk2(h.x, h.y); w.y = pk2(h.z, h.w); *(GAS v2u*)(orow + c) = w; }
}
__device__ __forceinline__ void rows_range(const Frame& F, int nrows, int& r0, int& r1) { const int per = (nrows + F.G - 1) / F.G; r0 = blockIdx.x * per; r1 = r0 + per < nrows ? r0 + per : nrows; if (r0 > nrows) r0 = nrows; }

__device__ __forceinline__ void phase_hin0(Frame& F) { WS_DECL; frame_refresh(F);
    int r0, r1; rows_range(F, NT, r0, r1); const Stream st = make_stream(ws, 0);
    for (int m = r0 + F.wave; m < r1; m += NWAVES) {
        const float* xr = stream_in(st, m); f32x4 x[4];
#pragma unroll
        for (int j = 0; j < 4; ++j) x[j] = *(const GAS f32x4*)(xr + 4 * F.lane + 256 * j);
        const int b = mod_b(m);
        store_modulated(x, mod_vec(ws, 0, b, 0), mod_vec(ws, 0, b, 1), WSP(bf16, WS_A1) + (size_t)m * D, F.lane);
    }
}

__device__ __forceinline__ void ln_rows(f32x4 (&v)[4], const float* g, const float* bta, int lane) {
    float s = 0.f;
#pragma unroll
    for (int j = 0; j < 4; ++j) s += (v[j].x + v[j].y) + (v[j].z + v[j].w);
    const float mean = wave_sum(s) * (1.f / D); float s2 = 0.f;
#pragma unroll
    for (int j = 0; j < 4; ++j) { v[j] = v[j] - mean; s2 += (v[j].x * v[j].x + v[j].y * v[j].y) + (v[j].z * v[j].z + v[j].w * v[j].w); }
    const float rstd = __builtin_amdgcn_rsqf(wave_sum(s2) * (1.f / D) + 1e-5f);
#pragma unroll
    for (int j = 0; j < 4; ++j) { const int c = 4 * lane + 256 * j; v[j] = v[j] * rstd * *(const GAS f32x4*)(g + c) + *(const GAS f32x4*)(bta + c); }
}

template <bool HAVE_Y>
__device__ __forceinline__ void phase_ln1(Frame& F, int li) { WS_DECL; frame_refresh(F); constexpr bool DRY_OR_BF16 = false;
    const int nrows = li == DEPTH - 1 ? NL : NT; const bool moe = li & 1; const int lane = F.lane;
    LAS int* hist = (LAS int*)(F.lds + LDS_MOEI) + 56; LAS float* ROUT = (LAS float*)F.lds;
    if (moe) { if (F.tid < 8) hist[F.tid] = 0; const float* router = in_ptr(I_ROUTER) + (size_t)(li >> 1) * D * NE; for (int i = F.tid; i < D * NE / 4; i += NTHR) *(LAS f32x4*)(ROUT + 4 * i) = *(const GAS f32x4*)(router + 4 * i); __syncthreads(); }
    int r0, r1; rows_range(F, nrows, r0, r1);
    const float* g = in_ptr(I_LN1G) + li * D; const float* bt = in_ptr(I_LN1B) + li * D; const Stream st = make_stream(ws, li); const bf16* Y = WSP(bf16, WS_Y);
    f32x4 xn[4]; v2u yn[4];
    { const int m = r0 + F.wave; if (m < r1) { const float* xr = stream_in(st, m);
#pragma unroll
        for (int j = 0; j < 4; ++j) { const int c = 4 * lane + 256 * j; xn[j] = __builtin_nontemporal_load((const GAS f32x4*)(xr + c)); if (HAVE_Y) yn[j] = *(const GAS v2u*)(Y + (size_t)m * D + c); } } }
    for (int m = r0 + F.wave; m < r1; m += NWAVES) {
        const int b = mod_b(m); f32x4 v[4]; v2u yw[4];
#pragma unroll
        for (int j = 0; j < 4; ++j) { v[j] = xn[j]; if (HAVE_Y) yw[j] = yn[j]; }
        if (m + NWAVES < r1) { const float* xr = stream_in(st, m + NWAVES);
#pragma unroll
            for (int j = 0; j < 4; ++j) { const int c = 4 * lane + 256 * j; xn[j] = __builtin_nontemporal_load((const GAS f32x4*)(xr + c)); if (HAVE_Y) yn[j] = *(const GAS v2u*)(Y + (size_t)(m + NWAVES) * D + c); } }
        const float* m2 = mod_vec(ws, li, b, 2);
#pragma unroll
        for (int j = 0; j < 4; ++j) { const int c = 4 * lane + 256 * j; v[j] = v[j] * ALPHA;
            if (HAVE_Y) { const f32x4 mm = *(const GAS f32x4*)(m2 + c); v[j].x += mm.x * bflo(yw[j].x); v[j].y += mm.y * bfhi(yw[j].x); v[j].z += mm.z * bflo(yw[j].y); v[j].w += mm.w * bfhi(yw[j].y); } }
        ln_rows(v, g, bt, lane);
        float* xo = stream_out(st, m);
#pragma unroll
        for (int j = 0; j < 4; ++j) __builtin_nontemporal_store(v[j], (GAS f32x4*)(xo + 4 * lane + 256 * j));
        const float* sh = mod_vec(ws, li, b, 3); const float* sc = mod_vec(ws, li, b, 4);
        if (moe) {
            float lg[NE];
#pragma unroll
            for (int e = 0; e < NE; ++e) lg[e] = 0.f;
#pragma unroll
            for (int j = 0; j < 4; ++j) { const int c = 4 * lane + 256 * j; const f32x4 s4 = *(const GAS f32x4*)(sh + c), c4 = *(const GAS f32x4*)(sc + c); const f32x4 f = v[j] * (c4 + 1.f) + s4;
#pragma unroll
                for (int q = 0; q < 4; ++q) { const f32x4 ra = *(const LAS f32x4*)(ROUT + (c + q) * NE), rb = *(const LAS f32x4*)(ROUT + (c + q) * NE + 4); const float fq = f[q];
                    lg[0] += fq * ra.x; lg[1] += fq * ra.y; lg[2] += fq * ra.z; lg[3] += fq * ra.w; lg[4] += fq * rb.x; lg[5] += fq * rb.y; lg[6] += fq * rb.z; lg[7] += fq * rb.w; } }
#pragma unroll
            for (int e = 0; e < NE; ++e) lg[e] = wave_sum(lg[e]);
            int e0 = 0; float v0 = lg[0];
#pragma unroll
            for (int e = 1; e < NE; ++e) if (lg[e] > v0) { v0 = lg[e]; e0 = e; }
            int e1 = -1; float v1 = -3.0e38f;
#pragma unroll
            for (int e = 0; e < NE; ++e) if (e != e0 && lg[e] > v1) { v1 = lg[e]; e1 = e; }
            const float ex = __expf(v1 - v0), g0 = 1.f / (1.f + ex), g1 = ex * g0;
            if (lane == 0) { *(GAS v2u*)(WSP(int, WS_TOKE) + 2 * (size_t)m) = (v2u){(unsigned)e0, (unsigned)e1}; *(GAS f32x2*)(WSP(float, WS_TOKG) + 2 * (size_t)m) = (f32x2){g0, g1};
                atomicAdd((int*)(hist + e0), 1); atomicAdd((int*)(hist + e1), 1); }
        }
        if (!DRY_OR_BF16) {
            unsigned char* orow = WSP(unsigned char, WS_A1) + (size_t)m * D;
#pragma unroll
            for (int j = 0; j < 4; ++j) { const int c = 4 * lane + 256 * j; const f32x4 s4 = *(const GAS f32x4*)(sh + c), c4 = *(const GAS f32x4*)(sc + c); const f32x4 f = v[j] * (c4 + 1.f) + s4;
                *(GAS unsigned*)(orow + c) = pk4_fp8(f.x, f.y, f.z, f.w); }
        } else store_modulated(v, sh, sc, WSP(bf16, WS_A1) + (size_t)m * D, lane);
    }
    if (moe) { __syncthreads(); if (F.tid < 8) WSP(int, WS_BLKCNT)[blockIdx.x * 8 + F.tid] = hist[F.tid]; }
}

template <bool HAVE_FFN>
__device__ __forceinline__ void phase_ln2(Frame& F, int li) { WS_DECL; frame_refresh(F);
    const int nrows = li == DEPTH - 1 ? NL : NT; const bool moe = li & 1; const int lane = F.lane;
    int r0, r1; rows_range(F, nrows, r0, r1);
    const float* g = in_ptr(I_LN2G) + li * D; const float* bt = in_ptr(I_LN2B) + li * D; const Stream st = make_stream(ws, 1);
    const bf16* Y = WSP(bf16, WS_Y); const bf16* XS = WSP(bf16, WS_Y2); const int* TOKS = WSP(int, WS_TOKS); const float* TOKG = WSP(float, WS_TOKG);
    f32x4 xn[4]; v2u ya[4], yb[4]; v2u sn = (v2u){0u, 0u}; f32x2 gn = (f32x2){0.f, 0.f}, gc = (f32x2){0.f, 0.f};
    const int mf = r0 + F.wave;
    if (mf < r1) { const float* xr = stream_out(st, mf); v2u s0 = (v2u){0u, 0u};
        if (moe) { s0 = *(const GAS v2u*)(TOKS + 2 * (size_t)mf); gc = *(const GAS f32x2*)(TOKG + 2 * (size_t)mf); if (mf + NWAVES < r1) { sn = *(const GAS v2u*)(TOKS + 2 * (size_t)(mf + NWAVES)); gn = *(const GAS f32x2*)(TOKG + 2 * (size_t)(mf + NWAVES)); } }
#pragma unroll
        for (int j = 0; j < 4; ++j) { const int c = 4 * lane + 256 * j; xn[j] = __builtin_nontemporal_load((const GAS f32x4*)(xr + c));
            if (HAVE_FFN) { if (moe) { ya[j] = *(const GAS v2u*)(XS + (size_t)s0.x * D + c); yb[j] = *(const GAS v2u*)(XS + (size_t)s0.y * D + c); } else ya[j] = *(const GAS v2u*)(Y + (size_t)mf * D + c); } } }
    for (int m = mf; m < r1; m += NWAVES) {
        const int b = mod_b(m); f32x4 v[4]; v2u wa[4], wb[4]; const f32x2 gg = gc;
#pragma unroll
        for (int j = 0; j < 4; ++j) { v[j] = xn[j]; wa[j] = ya[j]; wb[j] = yb[j]; }
        const int mn = m + NWAVES;
        if (mn < r1) { const float* xr = stream_out(st, mn); const v2u s1 = sn; gc = gn;
            if (moe && mn + NWAVES < r1) { sn = *(const GAS v2u*)(TOKS + 2 * (size_t)(mn + NWAVES)); gn = *(const GAS f32x2*)(TOKG + 2 * (size_t)(mn + NWAVES)); }
#pragma unroll
            for (int j = 0; j < 4; ++j) { const int c = 4 * lane + 256 * j; xn[j] = __builtin_nontemporal_load((const GAS f32x4*)(xr + c));
                if (HAVE_FFN) { if (moe) { ya[j] = *(const GAS v2u*)(XS + (size_t)s1.x * D + c); yb[j] = *(const GAS v2u*)(XS + (size_t)s1.y * D + c); } else ya[j] = *(const GAS v2u*)(Y + (size_t)mn * D + c); } } }
        const float* m5 = mod_vec(ws, li, b, 5);
#pragma unroll
        for (int j = 0; j < 4; ++j) { const int c = 4 * lane + 256 * j; v[j] = v[j] * ALPHA;
            if (HAVE_FFN) { const f32x4 mm = *(const GAS f32x4*)(m5 + c); f32x4 o;
                if (moe) { o.x = gg.x * bflo(wa[j].x) + gg.y * bflo(wb[j].x); o.y = gg.x * bfhi(wa[j].x) + gg.y * bfhi(wb[j].x); o.z = gg.x * bflo(wa[j].y) + gg.y * bflo(wb[j].y); o.w = gg.x * bfhi(wa[j].y) + gg.y * bfhi(wb[j].y); }
                else { o.x = bflo(wa[j].x); o.y = bfhi(wa[j].x); o.z = bflo(wa[j].y); o.w = bfhi(wa[j].y); }
                v[j] = v[j] + mm * o; } }
        ln_rows(v, g, bt, lane);
        float* xo = stream_out(st, m);
#pragma unroll
        for (int j = 0; j < 4; ++j) __builtin_nontemporal_store(v[j], (GAS f32x4*)(xo + 4 * lane + 256 * j));
        if (li < DEPTH - 1) store_modulated(v, mod_vec(ws, li + 1, b, 0), mod_vec(ws, li + 1, b, 1), WSP(bf16, WS_A1) + (size_t)m * D, lane);
    }
}

__device__ __forceinline__ void phase_moe_weights(Frame& F, int li) { WS_DECL; frame_refresh(F);
    const int j = li >> 1; int cursor = 0;
    for (int e = 0; e < NE; ++e) {
        conv_matrix(F, in_ptr(I_MG) + ((size_t)j * NE + e) * D * FFE, D, FFE, 0, FFE, (bf16*)(WSP(unsigned char, WS_M8GU) + (size_t)e * 2 * FFE * D), 1, 0, cursor, 64.f);
        conv_matrix(F, in_ptr(I_MU) + ((size_t)j * NE + e) * D * FFE, D, FFE, 0, FFE, (bf16*)(WSP(unsigned char, WS_M8GU) + (size_t)e * 2 * FFE * D), 1, 128, cursor, 64.f);
        conv_matrix(F, in_ptr(I_MD) + ((size_t)j * NE + e) * FFE * D, FFE, D, 0, D, (bf16*)(WSP(unsigned char, WS_M8D) + (size_t)e * D * FFE), 0, 0, cursor, 256.f);
    }
}

__device__ __forceinline__ void phase_moe_slots(Frame& F, int li) { WS_DECL; frame_refresh(F);
    const int nrows = li == DEPTH - 1 ? NL : NT;
    LAS int* mi = (LAS int*)(F.lds + LDS_MOEI); LAS unsigned char* tile_e = (LAS unsigned char*)(F.lds + LDS_TILEE);
    LAS int* slots = (LAS int*)F.lds;
    const int* blkcnt = WSP(int, WS_BLKCNT);
    { LAS int* cn = (LAS int*)(F.lds + 8192);
      if (F.tid < 8) { mi[16 + F.tid] = 0; mi[32 + F.tid] = 0; }
      { const int b = F.tid >> 1, hf = F.tid & 1; v4u c4 = (v4u){0u, 0u, 0u, 0u}; if (b < F.G) c4 = *(const GAS v4u*)(blkcnt + b * 8 + 4 * hf); *(LAS v4u*)(cn + b * 8 + 4 * hf) = c4; }
      __syncthreads();
      { const int e = F.wave; int tot = 0, pre = 0;
#pragma unroll
        for (int k = 0; k < 4; ++k) { const int b = F.lane + 64 * k; const int c = cn[b * 8 + e]; tot += c; if (b < (int)blockIdx.x) pre += c; }
        atomicAdd((int*)(mi + 16 + e), tot); atomicAdd((int*)(mi + 32 + e), pre); } }
    __syncthreads();
    if (F.tid == 0) { int s = 0; for (int e = 0; e < NE; ++e) { mi[e] = s; s += (mi[16 + e] + 255) & ~255; } mi[8] = s; mi[48] = s >> 8; }
    __syncthreads();
    for (int t = F.tid; t < MOE_MAX_TILES + 8; t += NTHR) { int e = 0;
#pragma unroll
        for (int q = 1; q < NE; ++q) if (t * 256 >= mi[q]) e = q;
        tile_e[t] = (unsigned char)e; }
    int r0, r1; rows_range(F, nrows, r0, r1);
    const int na = 2 * (r1 - r0);
    if (F.wave == 0) {
        int run[NE];
#pragma unroll
        for (int e = 0; e < NE; ++e) run[e] = mi[e] + mi[32 + e];
#pragma unroll 1
        for (int k0 = 0; k0 < 9; k0 += 3) { int ev[3];
#pragma unroll
          for (int k = 0; k < 3; ++k) { const int ai = 64 * (k0 + k) + F.lane; ev[k] = ai < na ? WSP(int, WS_TOKE)[2 * (size_t)r0 + ai] : -1; }
#pragma unroll
          for (int k = 0; k < 3; ++k) { const int base = 64 * (k0 + k); const int ai = base + F.lane; const bool ok = ai < na;
            const int e = ev[k]; int slot = 0;
#pragma unroll
            for (int q = 0; q < NE; ++q) { const unsigned long long mk = __ballot(e == q); if (e == q) slot = run[q] + __popcll(mk & ((1ull << F.lane) - 1ull)); run[q] += __popcll(mk); }
            if (ok) { slots[ai] = slot; WSP(int, WS_TOKS)[2 * (size_t)r0 + ai] = slot; } } }
        for (int base = 576; base < na; base += 64) { const int ai = base + F.lane; const bool ok = ai < na;
            const int e = ok ? WSP(int, WS_TOKE)[2 * (size_t)r0 + ai] : -1; int slot = 0;
#pragma unroll
            for (int q = 0; q < NE; ++q) { const unsigned long long mk = __ballot(e == q); if (e == q) slot = run[q] + __popcll(mk & ((1ull << F.lane) - 1ull)); run[q] += __popcll(mk); }
            if (ok) { slots[ai] = slot; WSP(int, WS_TOKS)[2 * (size_t)r0 + ai] = slot; } }
    }
    __syncthreads();
    for (int a0 = F.wave * 2; a0 < na; a0 += NWAVES * 2) {
        const int s0 = slots[a0], s1 = slots[a0 + 1]; const v4u v = ((const GAS v4u*)(WSP(unsigned char, WS_A1) + (size_t)(r0 + (a0 >> 1)) * D))[F.lane];
        ((GAS v4u*)(WSP(unsigned char, WS_XS8) + (size_t)s0 * D))[F.lane] = v; ((GAS v4u*)(WSP(unsigned char, WS_XS8) + (size_t)s1 * D))[F.lane] = v; }
    { const int gw = blockIdx.x * NWAVES + F.wave, NGW = F.G * NWAVES; int cnt = 0;
      for (int e = 0; e < NE; ++e) { const int p0 = mi[e] + mi[16 + e], p1 = mi[e + 1];
          for (int s = p0; s < p1; ++s, ++cnt) if (cnt % NGW == gw) { GAS v4u* dst = (GAS v4u*)(WSP(unsigned char, WS_XS8) + (size_t)s * D); dst[F.lane] = (v4u){0u, 0u, 0u, 0u}; } } }
    __syncthreads();
}

constexpr float QSCALE = 0.14724319f;
constexpr int MP_CQ_LD = 200, MP_CKV_LD = 136;
__device__ __forceinline__ void phase_mla_prep(Frame& F, int li) { WS_DECL; frame_refresh(F);
    LAS bf16* CQN = (LAS bf16*)F.lds; LAS bf16* CKVN = (LAS bf16*)(F.lds + 64 * MP_CQ_LD * 2);
    const bf16* P = WSP(bf16, WS_P); bf16* QB = WSP(bf16, WS_QB); bf16* KB = WSP(bf16, WS_KB); bf16* VT = WSP(bf16, WS_VT);
    const float* qn = in_ptr(I_QNORM) + li * 192; const float* kvn = in_ptr(I_KVNORM) + li * 128;
    const bf16* WQ = WSP(bf16, WS_WUQT) + (size_t)li * 384 * 192; const bf16* WKV = WSP(bf16, WS_WUKVT) + (size_t)li * 512 * 128;
    const float* RC = WSP(float, WS_ROPE); const float* RS = RC + 4096 * 16;
    const int lane = F.lane, wave = F.wave;
    const int head = wave >> 1, half = wave & 1, fr = lane & 15, kg = lane >> 4;
    for (int item = (blockIdx.x + 64) % F.G; item < NT / 64; item += F.G) {
        const int m0 = item * 64; const bool isctx = m0 >= NL; const int b = isctx ? (m0 - NL) >> 8 : m0 >> 12; const int t0 = isctx ? (m0 - NL) & 255 : m0 & 4095;
        const int ki0 = isctx ? t0 : 256 + t0;
        bf16x8 wq[3][6];
#pragma unroll
        for (int i = 0; i < 3; ++i)
#pragma unroll
            for (int ks = 0; ks < 6; ++ks) wq[i][ks] = *(const GAS bf16x8*)(WQ + (size_t)(96 * head + 16 * (3 * half + i) + fr) * 192 + 32 * ks + 8 * kg);
        v4u rawv[8]; unsigned short kr1[8], kr2[8];
#pragma unroll
        for (int i = 0; i < 8; ++i) { const bf16* pr = P + (size_t)(m0 + wave * 8 + i) * PCOLS; rawv[i] = (v4u){0u, 0u, 0u, 0u}; if (lane < 40) rawv[i] = *(const GAS v4u*)(pr + 8 * lane);
            kr1[i] = 0; kr2[i] = 0; if (lane < 16) { kr1[i] = pr[320 + lane]; kr2[i] = pr[336 + lane]; } }
#pragma unroll
        for (int i = 0; i < 8; ++i) { const int tl = wave * 8 + i; const v4u raw = rawv[i];
            float x[8]; x[0] = bflo(raw.x); x[1] = bfhi(raw.x); x[2] = bflo(raw.y); x[3] = bfhi(raw.y); x[4] = bflo(raw.z); x[5] = bfhi(raw.z); x[6] = bflo(raw.w); x[7] = bfhi(raw.w);
            float ss = 0.f;
#pragma unroll
            for (int j = 0; j < 8; ++j) ss += x[j] * x[j];
            const float sq = wave_sum(lane < 24 ? ss : 0.f), skv = wave_sum((lane >= 24 && lane < 40) ? ss : 0.f);
            const float rq = __builtin_amdgcn_rsqf(sq * (1.f / 192.f) + 1e-6f), rkv = __builtin_amdgcn_rsqf(skv * (1.f / 128.f) + 1e-6f);
            if (lane < 24) { const float* g = qn + 8 * lane; v4u o; o.x = pk2(x[0] * rq * g[0], x[1] * rq * g[1]); o.y = pk2(x[2] * rq * g[2], x[3] * rq * g[3]); o.z = pk2(x[4] * rq * g[4], x[5] * rq * g[5]); o.w = pk2(x[6] * rq * g[6], x[7] * rq * g[7]);
                *(LAS v4u*)(CQN + tl * MP_CQ_LD + 8 * lane) = o; }
            else if (lane < 40) { const int c = 8 * (lane - 24); const float* g = kvn + c; v4u o; o.x = pk2(x[0] * rkv * g[0], x[1] * rkv * g[1]); o.y = pk2(x[2] * rkv * g[2], x[3] * rkv * g[3]); o.z = pk2(x[4] * rkv * g[4], x[5] * rkv * g[5]); o.w = pk2(x[6] * rkv * g[6], x[7] * rkv * g[7]);
                *(LAS v4u*)(CKVN + tl * MP_CKV_LD + c) = o; }
            if (lane < 16) { float x1 = bf2f(kr1[i]), x2 = bf2f(kr2[i]);
                if (!isctx) { const float c = RC[(t0 + tl) * 16 + lane], s = RS[(t0 + tl) * 16 + lane]; const float y1 = x1 * c - x2 * s, y2 = x1 * s + x2 * c; x1 = y1; x2 = y2; }
                const bf16 o1 = (bf16)f2bf(x1), o2 = (bf16)f2bf(x2);
#pragma unroll
                for (int h = 0; h < 4; ++h) { bf16* kr = KB + ((size_t)(b * 4 + h) * KSEQ + ki0 + tl) * 96; kr[64 + lane] = o1; kr[80 + lane] = o2; } }
        }
        __syncthreads();
        const size_t qrow0 = ((size_t)(b * 4 + head) * KSEQ + ki0) * 96;
        { f32x4 acc[3][4];
#pragma unroll
          for (int i = 0; i < 3; ++i)
#pragma unroll
              for (int m = 0; m < 4; ++m) acc[i][m] = (f32x4){0.f, 0.f, 0.f, 0.f};
#pragma unroll
          for (int ks = 0; ks < 6; ++ks)
#pragma unroll
              for (int m = 0; m < 4; ++m) { const bf16x8 xf = *(const LAS bf16x8*)(CQN + (16 * m + fr) * MP_CQ_LD + 32 * ks + 8 * kg);
#pragma unroll
                  for (int i = 0; i < 3; ++i) acc[i][m] = __builtin_amdgcn_mfma_f32_16x16x32_bf16(wq[i][ks], xf, acc[i][m], 0, 0, 0); }
#pragma unroll
          for (int m = 0; m < 4; ++m) { bf16* qr = QB + qrow0 + (size_t)(16 * m + fr) * 96;
              { v2u o; o.x = pk2(acc[0][m][0] * QSCALE, acc[0][m][1] * QSCALE); o.y = pk2(acc[0][m][2] * QSCALE, acc[0][m][3] * QSCALE); *(GAS v2u*)(qr + 48 * half + 4 * kg) = o; }
              f32x4 y1 = acc[1][m], y2 = acc[2][m];
              if (half == 1 && !isctx) { const int t = t0 + 16 * m + fr; const f32x4 c = *(const GAS f32x4*)(RC + t * 16 + 4 * kg), sn = *(const GAS f32x4*)(RS + t * 16 + 4 * kg); y1 = acc[1][m] * c - acc[2][m] * sn; y2 = acc[1][m] * sn + acc[2][m] * c; }
              v2u o1, o2; o1.x = pk2(y1[0] * QSCALE, y1[1] * QSCALE); o1.y = pk2(y1[2] * QSCALE, y1[3] * QSCALE); o2.x = pk2(y2[0] * QSCALE, y2[1] * QSCALE); o2.y = pk2(y2[2] * QSCALE, y2[3] * QSCALE);
              *(GAS v2u*)(qr + 48 * half + 16 + 4 * kg) = o1; *(GAS v2u*)(qr + 48 * half + 32 + 4 * kg) = o2; } }
        bf16x8 wkv[4][4];
#pragma unroll
        for (int nt = 0; nt < 4; ++nt)
#pragma unroll
            for (int ks = 0; ks < 4; ++ks) wkv[nt][ks] = *(const GAS bf16x8*)(WKV + (size_t)(128 * head + 64 * half + 16 * nt + fr) * 128 + 32 * ks + 8 * kg);
        { f32x4 acc[4][4];
#pragma unroll
          for (int nt = 0; nt < 4; ++nt)
#pragma unroll
              for (int m = 0; m < 4; ++m) acc[nt][m] = (f32x4){0.f, 0.f, 0.f, 0.f};
#pragma unroll
          for (int ks = 0; ks < 4; ++ks)
#pragma unroll
              for (int m = 0; m < 4; ++m) { const bf16x8 xf = *(const LAS bf16x8*)(CKVN + (16 * m + fr) * MP_CKV_LD + 32 * ks + 8 * kg);
#pragma unroll
                  for (int nt = 0; nt < 4; ++nt) acc[nt][m] = half == 0 ? __builtin_amdgcn_mfma_f32_16x16x32_bf16(wkv[nt][ks], xf, acc[nt][m], 0, 0, 0) : __builtin_amdgcn_mfma_f32_16x16x32_bf16(xf, wkv[nt][ks], acc[nt][m], 0, 0, 0); }
#pragma unroll
          for (int nt = 0; nt < 4; ++nt)
#pragma unroll
              for (int m = 0; m < 4; ++m) { v2u o; o.x = pk2(acc[nt][m][0], acc[nt][m][1]); o.y = pk2(acc[nt][m][2], acc[nt][m][3]);
                  if (half == 0) *(GAS v2u*)(KB + qrow0 + (size_t)(16 * m + fr) * 96 + 16 * nt + 4 * kg) = o;
                  else *(GAS v2u*)(VT + ((size_t)(b * 4 + head) * 64 + 16 * nt + fr) * KSEQ + ki0 + 16 * m + 4 * kg) = o; } }
        __syncthreads();
    }
}

constexpr int AT_KLD = 104, AT_VLD = 72;
constexpr int AT_KB = 64 * AT_KLD * 2, AT_VB = 64 * AT_VLD * 2, AT_BUF = AT_KB + AT_VB;
__device__ __forceinline__ void phase_attn(Frame& F, int li) { WS_DECL; frame_refresh(F);
    const bf16* QB = WSP(bf16, WS_QB); const bf16* KB = WSP(bf16, WS_KB); const bf16* VT = WSP(bf16, WS_VT); bf16* AO = WSP(bf16, WS_AO);
    const int lane = F.lane, wave = F.wave, tid = F.tid, ql = lane & 31, h2 = lane >> 5;
    const int nunits = 1024 + (li < DEPTH - 1 ? 64 : 0);
    const int c = blockIdx.x, vc = (F.G == 256) ? (c & 7) * 32 + (c >> 3) : c;
    for (int u = vc; u < nunits; u += F.G) {
        int bh, q0, nk; bool isctx = u >= 1024;
        if (!isctx) { bh = u >> 4; q0 = 256 + 256 * (u & 15); nk = KSEQ; } else { bh = u - 1024; q0 = 0; nk = 256; }
        const bf16* Kb = KB + (size_t)bh * KSEQ * 96; const bf16* Vb = VT + (size_t)bh * 64 * KSEQ;
        bf16x8 qf[6];
        { const bf16* qr = QB + ((size_t)bh * KSEQ + q0 + 32 * wave + ql) * 96 + 8 * h2;
#pragma unroll
          for (int ks = 0; ks < 6; ++ks) qf[ks] = *(const GAS bf16x8*)(qr + 16 * ks); }
        f32x16 O0, O1;
#pragma unroll
        for (int r = 0; r < 16; ++r) { O0[r] = 0.f; O1[r] = 0.f; }
        float l_run = 0.f;
        const int kc0 = tid, kc1 = tid + 512; const int vr = tid >> 3, vcn = tid & 7;
        const int ko0 = (kc0 / 12) * (AT_KLD * 2) + (kc0 % 12) * 16, ko1 = (kc1 / 12) * (AT_KLD * 2) + (kc1 % 12) * 16, vo = AT_KB + vr * (AT_VLD * 2) + vcn * 16;
        v4u pk0, pk1 = (v4u){0u, 0u, 0u, 0u}, pv;
#define AT_LOAD(t) do { const GAS v4u* ks_ = (const GAS v4u*)(Kb + (size_t)(t) * 64 * 96); pk0 = ks_[kc0]; if (kc1 < 768) pk1 = ks_[kc1]; pv = *(const GAS v4u*)(Vb + (size_t)vr * KSEQ + (t) * 64 + 8 * vcn); } while (0)
#define AT_STORE(bo) do { LAS unsigned char* b_ = F.lds + (bo); *(LAS v4u*)(b_ + ko0) = pk0; if (kc1 < 768) *(LAS v4u*)(b_ + ko1) = pk1; *(LAS v4u*)(b_ + vo) = pv; } while (0)
#define AT_QK(bo, A0, A1, INIT) do { const LAS unsigned char* b_ = F.lds + (bo); _Pragma("unroll") for (int r = 0; r < 16; ++r) { A0[r] = 0.f; A1[r] = 0.f; } \
            _Pragma("unroll") for (int kh = 0; kh < 2; ++kh) { bf16x8 kf0[3], kf1[3]; \
                _Pragma("unroll") for (int k3 = 0; k3 < 3; ++k3) { const int ks = 3 * kh + k3; kf0[k3] = *(const LAS bf16x8*)(b_ + ql * (AT_KLD * 2) + 32 * ks + 16 * h2); kf1[k3] = *(const LAS bf16x8*)(b_ + (32 + ql) * (AT_KLD * 2) + 32 * ks + 16 * h2); } \
                __builtin_amdgcn_sched_barrier(0); \
                _Pragma("unroll") for (int k3 = 0; k3 < 3; ++k3) { const int ks = 3 * kh + k3; A0 = __builtin_amdgcn_mfma_f32_32x32x16_bf16(kf0[k3], qf[ks], A0, 0, 0, 0); A1 = __builtin_amdgcn_mfma_f32_32x32x16_bf16(kf1[k3], qf[ks], A1, 0, 0, 0); } \
                __builtin_amdgcn_sched_barrier(0); } } while (0)
        const int ntile = nk >> 6;
        v4u qk0, qk1 = (v4u){0u, 0u, 0u, 0u}, qv;
#define AT_LOADB(t) do { const GAS v4u* ks_ = (const GAS v4u*)(Kb + (size_t)(t) * 64 * 96); qk0 = ks_[kc0]; if (kc1 < 768) qk1 = ks_[kc1]; qv = *(const GAS v4u*)(Vb + (size_t)vr * KSEQ + (t) * 64 + 8 * vcn); } while (0)
#define AT_STOREB(bo) do { LAS unsigned char* b_ = F.lds + (bo); *(LAS v4u*)(b_ + ko0) = qk0; if (kc1 < 768) *(LAS v4u*)(b_ + ko1) = qk1; *(LAS v4u*)(b_ + vo) = qv; } while (0)
        AT_LOAD(0); AT_LOADB(1);
        __syncthreads();
        AT_STORE(0); AT_STOREB(AT_BUF);
        AT_LOAD(2); AT_LOADB(3);
        __syncthreads();
        int bo0 = 0, bo1 = AT_BUF, bo2 = 2 * AT_BUF;
        float m_ref = 0.f;
#define AT_BODY(KT, STOREX, LOADX) do { const int kt_ = (KT); \
            if (kt_ + 2 < ntile) STOREX(bo2); if (kt_ + 4 < ntile) LOADX(kt_ + 4); \
            f32x16 S0, S1; AT_QK(bo0, S0, S1, 0); \
            if (__any(m_ref != 0.f)) { _Pragma("unroll") for (int r = 0; r < 16; ++r) { S0[r] -= m_ref; S1[r] -= m_ref; } } \
            float mxa = fmaxf(fmaxf(S0[0], S0[1]), S0[2]), mxb = fmaxf(fmaxf(S0[3], S0[4]), S0[5]), mxc = fmaxf(fmaxf(S1[0], S1[1]), S1[2]), mxd = fmaxf(fmaxf(S1[3], S1[4]), S1[5]); \
            _Pragma("unroll") for (int r = 6; r < 16; r += 2) { mxa = fmaxf(mxa, S0[r]); mxb = fmaxf(mxb, S0[r + 1]); mxc = fmaxf(mxc, S1[r]); mxd = fmaxf(mxd, S1[r + 1]); } \
            float mx = fmaxf(fmaxf(mxa, mxb), fmaxf(mxc, mxd)); \
            if (__any(mx > 64.f || (kt_ == 0 && mx < -64.f))) { mx = fmaxf(mx, __shfl_xor(mx, 32)); const float delta = (mx > 64.f || (kt_ == 0 && mx < -64.f)) ? mx : 0.f; const float alpha = __builtin_amdgcn_exp2f(-delta); m_ref += delta; l_run *= alpha; \
                _Pragma("unroll") for (int r = 0; r < 16; ++r) { O0[r] *= alpha; O1[r] *= alpha; S0[r] -= delta; S1[r] -= delta; } } \
            float ps0 = 0.f, ps1 = 0.f, ps2 = 0.f, ps3 = 0.f; \
            _Pragma("unroll") for (int r = 0; r < 16; r += 2) { S0[r] = __builtin_amdgcn_exp2f(S0[r]); S1[r] = __builtin_amdgcn_exp2f(S1[r]); S0[r + 1] = __builtin_amdgcn_exp2f(S0[r + 1]); S1[r + 1] = __builtin_amdgcn_exp2f(S1[r + 1]); ps0 += S0[r]; ps1 += S1[r]; ps2 += S0[r + 1]; ps3 += S1[r + 1]; } \
            l_run += (ps0 + ps1) + (ps2 + ps3); \
            union { bf16x8 v; unsigned u[4]; } p00, p01, p10, p11; \
            _Pragma("unroll") for (int j = 0; j < 4; ++j) { p00.u[j] = pk2(S0[2 * j], S0[2 * j + 1]); p01.u[j] = pk2(S0[8 + 2 * j], S0[8 + 2 * j + 1]); p10.u[j] = pk2(S1[2 * j], S1[2 * j + 1]); p11.u[j] = pk2(S1[8 + 2 * j], S1[8 + 2 * j + 1]); } \
            const LAS unsigned char* vb = F.lds + bo0 + AT_KB; \
            _Pragma("unroll") for (int dvt = 0; dvt < 2; ++dvt) { const LAS unsigned char* vrow = vb + (32 * dvt + ql) * (AT_VLD * 2) + 8 * h2; union { bf16x8 v; v2u h[2]; } vf[4]; \
                _Pragma("unroll") for (int ss = 0; ss < 4; ++ss) { vf[ss].h[0] = *(const LAS v2u*)(vrow + 2 * (16 * ss)); vf[ss].h[1] = *(const LAS v2u*)(vrow + 2 * (16 * ss + 8)); } \
                __builtin_amdgcn_sched_barrier(0); \
                if (dvt == 0) { O0 = __builtin_amdgcn_mfma_f32_32x32x16_bf16(vf[0].v, p00.v, O0, 0, 0, 0); O0 = __builtin_amdgcn_mfma_f32_32x32x16_bf16(vf[1].v, p01.v, O0, 0, 0, 0); O0 = __builtin_amdgcn_mfma_f32_32x32x16_bf16(vf[2].v, p10.v, O0, 0, 0, 0); O0 = __builtin_amdgcn_mfma_f32_32x32x16_bf16(vf[3].v, p11.v, O0, 0, 0, 0); } \
                else { O1 = __builtin_amdgcn_mfma_f32_32x32x16_bf16(vf[0].v, p00.v, O1, 0, 0, 0); O1 = __builtin_amdgcn_mfma_f32_32x32x16_bf16(vf[1].v, p01.v, O1, 0, 0, 0); O1 = __builtin_amdgcn_mfma_f32_32x32x16_bf16(vf[2].v, p10.v, O1, 0, 0, 0); O1 = __builtin_amdgcn_mfma_f32_32x32x16_bf16(vf[3].v, p11.v, O1, 0, 0, 0); } \
                __builtin_amdgcn_sched_barrier(0); } \
            __syncthreads(); \
            { const int t_ = bo0; bo0 = bo1; bo1 = bo2; bo2 = t_; } } while (0)
        for (int kt = 0; kt < ntile; kt += 2) {
            AT_BODY(kt, AT_STORE, AT_LOAD);
            AT_BODY(kt + 1, AT_STOREB, AT_LOADB);
        }
#undef AT_BODY
#undef AT_LOADB
#undef AT_STOREB
#undef AT_LOAD
#undef AT_STORE
#undef AT_QK
        const float inv = 1.f / (l_run + __shfl_xor(l_run, 32));
        const int b = bh >> 2, head = bh & 3, qi = q0 + 32 * wave + ql;
        const size_t row = isctx ? (size_t)NL + b * 256 + qi : (size_t)b * 4096 + (qi - 256);
        bf16* orow = AO + row * 256 + head * 64 + 4 * h2;
#pragma unroll
        for (int g = 0; g < 4; ++g) { v2u o0, o1; o0.x = pk2(O0[4 * g] * inv, O0[4 * g + 1] * inv); o0.y = pk2(O0[4 * g + 2] * inv, O0[4 * g + 3] * inv); o1.x = pk2(O1[4 * g] * inv, O1[4 * g + 1] * inv); o1.y = pk2(O1[4 * g + 2] * inv, O1[4 * g + 3] * inv);
            *(GAS v2u*)(orow + 8 * g) = o0; *(GAS v2u*)(orow + 32 + 8 * g) = o1; }
    }
}

__device__ __forceinline__ void phase_fin_mla(Frame& F, int li) { WS_DECL; frame_refresh(F);
    const int nrows = li == DEPTH - 1 ? NL : NT; const float* g = in_ptr(I_MLAON) + li * 256; const bf16* AO = WSP(bf16, WS_AO); bf16* MIX = WSP(bf16, WS_A1);
    const int gw = blockIdx.x * NWAVES + F.wave, NGW = F.G * NWAVES; const f32x4 g4 = *(const GAS f32x4*)(g + 4 * F.lane);
    for (int m4 = gw * 4; m4 < nrows; m4 += NGW * 4) { v2u w[4];
#pragma unroll
        for (int i = 0; i < 4; ++i) w[i] = *(const GAS v2u*)(AO + (size_t)(m4 + i) * 256 + 4 * F.lane);
#pragma unroll
        for (int i = 0; i < 4; ++i) { f32x4 x; x.x = bflo(w[i].x); x.y = bfhi(w[i].x); x.z = bflo(w[i].y); x.w = bfhi(w[i].y);
            const float r = __builtin_amdgcn_rsqf(wave_sum(x.x * x.x + x.y * x.y + x.z * x.z + x.w * x.w) * (1.f / 256.f) + 1e-6f);
            v2u o; o.x = pk2(x.x * r * g4.x, x.y * r * g4.y); o.y = pk2(x.z * r * g4.z, x.w * r * g4.w); *(GAS v2u*)(MIX + (size_t)(m4 + i) * D + 4 * F.lane) = o; } }
}
__device__ __forceinline__ void phase_fin_zero(Frame& F, int li, int c0) { WS_DECL; frame_refresh(F);
    const int nrows = li == DEPTH - 1 ? NL : NT; bf16* MIX = WSP(bf16, WS_A1); const int gw = blockIdx.x * NWAVES + F.wave, NGW = F.G * NWAVES;
    for (int m = gw; m < nrows; m += NGW) *(GAS v2u*)(MIX + (size_t)m * D + c0 + 4 * F.lane) = (v2u){0u, 0u};
}

__device__ __forceinline__ void phase_pro0b(Frame& F) { WS_DECL; frame_refresh(F);
    const int gt = blockIdx.x * NTHR + F.tid, NGT = F.G * NTHR;
    float* RC = WSP(float, WS_ROPE); float* RS = RC + 4096 * 16;
    for (int i = gt; i < 4096 * 16; i += NGT) { const int t = i >> 4, j = i & 15; const float inv = powf(10000.f, -(float)(j & 7) / 8.f); const float pos = j < 8 ? (float)(t >> 6) : (float)(t & 63);
        const float ang = pos * inv; RC[i] = cosf(ang); RS[i] = sinf(ang); }
    const float* wuq = in_ptr(I_WUQ); const float* wukv = in_ptr(I_WUKV); bf16* WQ = WSP(bf16, WS_WUQT); bf16* WKV = WSP(bf16, WS_WUKVT);
    for (int i = gt; i < DEPTH * 384 * 192; i += NGT) { const int li = i / (384 * 192), r = i % (384 * 192), n = r / 192, k = r % 192; WQ[i] = (bf16)f2bf(wuq[(size_t)li * 192 * 384 + (size_t)k * 384 + n]); }
    for (int i = gt; i < DEPTH * 512 * 128; i += NGT) { const int li = i / (512 * 128), r = i % (512 * 128), n = r / 128, k = r % 128; WKV[i] = (bf16)f2bf(wukv[(size_t)li * 128 * 512 + (size_t)k * 512 + n]); }
}

constexpr int LR_LD = 264;
__device__ __forceinline__ float gelu_tanh(float x) { const float u = 0.7978845608028654f * (x + 0.044715f * x * x * x); const float e = __expf(2.f * u); const float t = 1.f - 2.f / (e + 1.f); return 0.5f * x * (1.f + t); }
template <int PASS>
__device__ __forceinline__ void phase_lru(Frame& F, int li) { WS_DECL; frame_refresh(F);
    LAS bf16* RAW = (LAS bf16*)F.lds; LAS bf16* U = (LAS bf16*)(F.lds + 67 * LR_LD * 2); LAS bf16* HS = (LAS bf16*)(F.lds + 71680); LAS float* HC = (LAS float*)(F.lds + 106496);
    const bf16* P = WSP(bf16, WS_P); bf16* MIX = WSP(bf16, WS_A1); f32x2* SUMM = WSP(f32x2, WS_SUMM);
    const float* cw = in_ptr(I_LCW) + li * 4 * 256; const float* cb = in_ptr(I_LCB) + li * 256;
    const float* lam_ = in_ptr(I_LLAM) + li * 512; const float* br_ = in_ptr(I_LBR) + li * 512; const float* bi_ = in_ptr(I_LBI) + li * 512; const float* on_ = in_ptr(I_LON) + li * 256;
    const bf16* LW = WSP(bf16, WS_LRUW) + (size_t)li * 16 * 4096;
    const int lane = F.lane, wave = F.wave, tid = F.tid, fr = lane & 15, kg = lane >> 4;
    const int nitems = (PASS == 3 && li == DEPTH - 1) ? NL / 64 : NT / 64;
    const int vb_ = PASS == 1 ? (int)((blockIdx.x + 128) % F.G) : (int)((blockIdx.x + 192) % F.G);
    for (int item = vb_; item < nitems; item += F.G) {
        const int m0 = item * 64; const bool isctx = m0 >= NL; const int b = isctx ? (m0 - NL) >> 8 : m0 >> 12; const int t0 = isctx ? (m0 - NL) & 255 : m0 & 4095; const int Ls = isctx ? 256 : 4096;
        const size_t seg0 = isctx ? (size_t)NL + b * 256 : (size_t)b * 4096;
        v4u sv_[5];
        {
#pragma unroll
          for (int u = 0; u < 5; ++u) { const int c = tid + NTHR * u, r = c >> 5, cc = c & 31, t = t0 - 2 + r; sv_[u] = (v4u){0u, 0u, 0u, 0u};
              if (c < 67 * 32 && t >= 0 && t < Ls) sv_[u] = *(const GAS v4u*)(P + (seg0 + t) * PCOLS + 352 + 8 * cc); } }

        if (PASS == 3) {
            const int dd = tid >> 8, chh = tid & 255; const int cj = t0 >> 6, cbase = 1024 + b * 4, lbase = b * 64;
            const int np = dd == 0 ? (isctx ? cj : 4 + cj) : (isctx ? 3 - cj : 4 + 63 - cj);
            float Hc = 0.f;
#pragma unroll 1
            for (int p0 = 0; p0 < np; p0 += 24) { f32x2 sv[24];
#pragma unroll
                for (int e = 0; e < 24; ++e) { const int p = p0 + e; sv[e] = (f32x2){1.f, 0.f};
                    if (p < np) { int cid; if (dd == 0) cid = isctx ? cbase + p : (p < 4 ? cbase + p : lbase + (p - 4)); else cid = isctx ? cbase + 3 - p : (p < 4 ? cbase + 3 - p : lbase + 63 - (p - 4));
                        sv[e] = *(const GAS f32x2*)(SUMM + ((size_t)cid * 2 + dd) * 256 + chh); } }
#pragma unroll
                for (int e = 0; e < 24; ++e) Hc = sv[e].x * Hc + sv[e].y; }
            HC[dd * 256 + chh] = Hc; }
#pragma unroll
        for (int u = 0; u < 5; ++u) { const int c = tid + NTHR * u, r = c >> 5, cc = c & 31; if (c < 67 * 32) *(LAS v4u*)(RAW + r * LR_LD + 8 * cc) = sv_[u]; }
        __syncthreads();
        { const int c2 = tid & 127, tq = tid >> 7; const int ch = 2 * c2;
          float w0[4], w1[4];
#pragma unroll
          for (int j = 0; j < 4; ++j) { w0[j] = cw[j * 256 + ch]; w1[j] = cw[j * 256 + ch + 1]; }
          const float b0 = cb[ch], b1 = cb[ch + 1];
          for (int t = tq * 16; t < tq * 16 + 16; ++t) { float s0 = b0, s1 = b1;
#pragma unroll
              for (int j = 0; j < 4; ++j) { const unsigned w = *(const LAS unsigned*)(RAW + (t + j) * LR_LD + ch); s0 += w0[j] * bflo(w); s1 += w1[j] * bfhi(w); }
              *(LAS unsigned*)(U + t * LR_LD + ch) = pk2(s0, s1); } }
        __syncthreads();
#pragma unroll 1
        for (int ni = 0; ni < 2; ++ni) {
            float yv[4][4];
            const int nt = 2 * wave + ni, nb = nt >> 2, ch = 16 * nt + fr;
            bf16x8 wfr[2][2][2]; float spc[2], brc[2], bic[2];
#pragma unroll
            for (int d = 0; d < 2; ++d) { spc[d] = lam_[d * 256 + ch]; brc[d] = br_[d * 256 + ch]; bic[d] = bi_[d * 256 + ch];
#pragma unroll
                for (int g = 0; g < 2; ++g)
#pragma unroll
                    for (int ks = 0; ks < 2; ++ks) wfr[d][g][ks] = *(const GAS bf16x8*)(LW + ((size_t)((g * 2 + d) * 4 + nb) * 64 + 16 * (nt & 3) + fr) * 64 + 32 * ks + 8 * kg); }
            float uu[4][4];
#pragma unroll
            for (int m = 0; m < 4; ++m)
#pragma unroll
                for (int r = 0; r < 4; ++r) uu[m][r] = bf2f(U[(16 * m + 4 * kg + r) * LR_LD + ch]);
#pragma unroll
            for (int d = 0; d < 2; ++d) {
                f32x4 ar[4], ai[4];
#pragma unroll
                for (int m = 0; m < 4; ++m) { ar[m] = (f32x4){0.f, 0.f, 0.f, 0.f}; ai[m] = (f32x4){0.f, 0.f, 0.f, 0.f}; }
#pragma unroll
                for (int ks = 0; ks < 2; ++ks) {
                    const bf16x8 wr = wfr[d][0][ks], wi = wfr[d][1][ks];
#pragma unroll
                    for (int m = 0; m < 4; ++m) { const bf16x8 xf = *(const LAS bf16x8*)(U + (16 * m + fr) * LR_LD + 64 * nb + 32 * ks + 8 * kg);
                        ar[m] = __builtin_amdgcn_mfma_f32_16x16x32_bf16(xf, wr, ar[m], 0, 0, 0); ai[m] = __builtin_amdgcn_mfma_f32_16x16x32_bf16(xf, wi, ai[m], 0, 0, 0); } }
                const float sp = __logf(1.f + __expf(-spc[d])), brv = brc[d], biv = bic[d];
#pragma unroll
                for (int m = 0; m < 4; ++m)
#pragma unroll
                    for (int r = 0; r < 4; ++r) { const float rg = __builtin_amdgcn_rcpf(1.f + __expf(-(ar[m][r] + brv))), ig = __builtin_amdgcn_rcpf(1.f + __expf(-(ai[m][r] + biv))); const float av = __expf(-8.f * rg * sp);
                        ar[m][r] = av; ai[m][r] = __builtin_amdgcn_sqrtf(fmaxf(1.f - av * av, 0.f)) * (ig * uu[m][r]); }
                float H = 0.f;
                if (PASS == 3) H = HC[d * 256 + ch];
                float Ac = 1.f, Bc = 0.f;
#pragma unroll
                for (int mi = 0; mi < 4; ++mi) { const int m = d == 0 ? mi : 3 - mi;
                    float Al, Bl;
                    if (d == 0) { Al = ar[m][0] * ar[m][1] * ar[m][2] * ar[m][3]; Bl = ((ai[m][0] * ar[m][1] + ai[m][1]) * ar[m][2] + ai[m][2]) * ar[m][3] + ai[m][3]; }
                    else { Al = ar[m][0] * ar[m][1] * ar[m][2] * ar[m][3]; Bl = ((ai[m][3] * ar[m][2] + ai[m][2]) * ar[m][1] + ai[m][1]) * ar[m][0] + ai[m][0]; }
                    float Ag[4], Bg[4];
#pragma unroll
                    for (int g = 0; g < 4; ++g) { Ag[g] = __shfl(Al, fr + 16 * g); Bg[g] = __shfl(Bl, fr + 16 * g); }
                    if (PASS == 1) {
                        float At = 1.f, Bt = 0.f;
#pragma unroll
                        for (int gi = 0; gi < 4; ++gi) { const int g = d == 0 ? gi : 3 - gi; Bt = Ag[g] * Bt + Bg[g]; At = Ag[g] * At; }
                        Bc = At * Bc + Bt; Ac = At * Ac;
                    } else {
                        float s = H, sin_ = H;
#pragma unroll
                        for (int gi = 0; gi < 4; ++gi) { const int g = d == 0 ? gi : 3 - gi; if (g == kg) sin_ = s; s = Ag[g] * s + Bg[g]; }
                        H = s;
                        float x = sin_;
#pragma unroll
                        for (int ri = 0; ri < 4; ++ri) { const int r = d == 0 ? ri : 3 - ri; x = ar[m][r] * x + ai[m][r]; if (d == 0) yv[m][r] = x; else yv[m][r] += x; }
                    }
                }
                if (PASS == 1 && kg == 0) *(GAS f32x2*)(SUMM + ((size_t)item * 2 + d) * 256 + ch) = (f32x2){Ac, Bc};
            }
            if (PASS == 3) {
#pragma unroll
                for (int m = 0; m < 4; ++m)
#pragma unroll
                    for (int r = 0; r < 4; ++r) HS[(16 * m + 4 * kg + r) * LR_LD + ch] = (bf16)f2bf(yv[m][r]);
            }
        }
        if (PASS == 3) {
            __syncthreads();
            const f32x4 on4 = *(const GAS f32x4*)(on_ + 4 * lane);
            v2u gws[8];
#pragma unroll
            for (int i = 0; i < 8; ++i) gws[i] = *(const GAS v2u*)(P + (size_t)(m0 + wave * 8 + i) * PCOLS + 608 + 4 * lane);
#pragma unroll
            for (int i = 0; i < 8; ++i) { const int tl = wave * 8 + i; const v2u hw = *(const LAS v2u*)(HS + tl * LR_LD + 4 * lane); const v2u gw = gws[i];
                f32x4 y; y.x = bflo(hw.x) * gelu_tanh(bflo(gw.x)); y.y = bfhi(hw.x) * gelu_tanh(bfhi(gw.x)); y.z = bflo(hw.y) * gelu_tanh(bflo(gw.y)); y.w = bfhi(hw.y) * gelu_tanh(bfhi(gw.y));
                const float rs = __builtin_amdgcn_rsqf(wave_sum(y.x * y.x + y.y * y.y + y.z * y.z + y.w * y.w) * (1.f / 256.f) + 1e-6f);
                v2u o; o.x = pk2(y.x * rs * on4.x, y.y * rs * on4.y); o.y = pk2(y.z * rs * on4.z, y.w * rs * on4.w);
                *(GAS v2u*)(MIX + (size_t)(m0 + tl) * D + 256 + 4 * lane) = o; }
        }
        __syncthreads();
    }
}

__device__ __forceinline__ void phase_pro0c(Frame& F) { WS_DECL; frame_refresh(F);
    const int gt = blockIdx.x * NTHR + F.tid, NGT = F.G * NTHR; const float* wr = in_ptr(I_LWR); const float* wi = in_ptr(I_LWI); bf16* LW = WSP(bf16, WS_LRUW);
    for (int i = gt; i < DEPTH * 16 * 4096; i += NGT) { const int c = i & 63, dd = (i >> 6) & 63, nb = (i >> 12) & 3, d = (i >> 14) & 1, g = (i >> 15) & 1, li = i >> 16;
        const float* src = g == 0 ? wr : wi; LW[i] = (bf16)f2bf(src[((((size_t)li * 2 + d) * 4 + nb) * 64 + c) * 64 + dd]); }
}

template <int CTRL> __device__ __forceinline__ float dpp_f(float x) { return __builtin_bit_cast(float, __builtin_amdgcn_mov_dpp(__builtin_bit_cast(int, x), CTRL, 0xf, 0xf, true)); }
__device__ __forceinline__ float rowsum16(float x) { x += dpp_f<0x128>(x); x += dpp_f<0x124>(x); x += dpp_f<0x122>(x); x += dpp_f<0x121>(x); return x; }
constexpr int RW_C0 = 864;
constexpr size_t WS_RWUP = WS_LRUW + 512 * 1024;
constexpr size_t WS_GUPT = WS_LRUW + 768 * 1024;
constexpr size_t WS_EA = WS_Y;

__device__ __forceinline__ void phase_pro0e(Frame& F) { WS_DECL; frame_refresh(F);
    const int gt = blockIdx.x * NTHR + F.tid, NGT = F.G * NTHR; const float* wup = in_ptr(I_WUP); const float* aup = in_ptr(I_AUP); bf16* W = WSP(bf16, WS_RWUP);
    for (int i = gt; i < DEPTH * 2 * 2 * 256 * 32; i += NGT) { const int k = i & 31, n = (i >> 5) & 255, wa = (i >> 13) & 1, d = (i >> 14) & 1, li = i >> 15;
        const float* src = wa == 0 ? wup : aup; W[i] = (bf16)f2bf(src[(((size_t)li * 2 + d) * 32 + k) * 256 + n]); }
    { const float* gup = in_ptr(I_GUP); bf16* GT = WSP(bf16, WS_GUPT);
      for (int i = gt; i < DEPTH * 256 * 64; i += NGT) { const int k = i & 63, n = (i >> 6) & 255, li = i >> 14; GT[i] = (bf16)f2bf(gup[((size_t)li * 64 + k) * 256 + n]); } }
}

constexpr int R0_LD = 136, R0_ZLD = 72;
__device__ __forceinline__ void phase_rwkv_r0(Frame& F, int li) { WS_DECL; frame_refresh(F);
    LAS bf16* RAWL = (LAS bf16*)F.lds;
    LAS bf16* ZW = (LAS bf16*)(F.lds + 66 * R0_LD * 2);
    LAS bf16* ZA = ZW + 64 * R0_ZLD;
    const bf16* P = WSP(bf16, WS_P); bf16* EA = WSP(bf16, WS_EA); const bf16* W = WSP(bf16, WS_RWUP) + (size_t)li * 2 * 2 * 256 * 32;
    const float* mup = in_ptr(I_MUP) + li * 960 + 768; const float* mun = in_ptr(I_MUN) + li * 960 + 768; const float* w0 = in_ptr(I_W0) + li * 512; const float* a0 = in_ptr(I_A0) + li * 512;
    const int tid = F.tid, lane = F.lane, wave = F.wave, fr = lane & 15, kg = lane >> 4;
    for (int item = blockIdx.x; item < NT / 64; item += F.G) {
        const int m0 = item * 64; const bool isctx = m0 >= NL; const int t0 = isctx ? (m0 - NL) & 255 : m0 & 4095; const int Ls = isctx ? 256 : 4096; const size_t seg0 = (size_t)m0 - t0;
        __syncthreads();
        { v4u sv_[3];
#pragma unroll
          for (int u = 0; u < 3; ++u) { const int c = tid + NTHR * u, r = c >> 4, cc = c & 15, t = t0 - 1 + r; sv_[u] = (v4u){0u, 0u, 0u, 0u};
              if (c < 66 * 16 && t >= 0 && t < Ls) sv_[u] = *(const GAS v4u*)(P + (seg0 + t) * PCOLS + RW_C0 + 768 + 8 * cc); }
#pragma unroll
          for (int u = 0; u < 3; ++u) { const int c = tid + NTHR * u, r = c >> 4, cc = c & 15; if (c < 66 * 16) *(LAS v4u*)(RAWL + r * R0_LD + 8 * cc) = sv_[u]; } }
        __syncthreads();
        { const int c = tid & 127, tq = tid >> 7; const float mp = mup[c], mn = mun[c];
          for (int tl = tq * 16; tl < tq * 16 + 16; ++tl) { const float x = bf2f(RAWL[(tl + 1) * R0_LD + c]), xp = bf2f(RAWL[tl * R0_LD + c]), xn = bf2f(RAWL[(tl + 2) * R0_LD + c]);
              const float z = x + mp * (xp - x) + mn * (xn - x);
              if (c < 64) { const float e2 = __expf(2.f * z); ZW[tl * R0_ZLD + c] = (bf16)f2bf(1.f - 2.f * __builtin_amdgcn_rcpf(e2 + 1.f)); } else ZA[tl * R0_ZLD + (c - 64)] = (bf16)f2bf(z); } }
        __syncthreads();
        const int d = wave >> 2, hh = wave & 3;
#pragma unroll 1
        for (int nt = 0; nt < 4; ++nt) { const int ch0 = 64 * hh + 16 * nt;
            const bf16x8 wf = *(const GAS bf16x8*)(W + ((size_t)(d * 2 + 0) * 256 + ch0 + fr) * 32 + 8 * kg), af = *(const GAS bf16x8*)(W + ((size_t)(d * 2 + 1) * 256 + ch0 + fr) * 32 + 8 * kg);
            const f32x4 w04 = *(const GAS f32x4*)(w0 + d * 256 + ch0 + 4 * kg), a04 = *(const GAS f32x4*)(a0 + d * 256 + ch0 + 4 * kg);
#pragma unroll
            for (int m = 0; m < 4; ++m) { const bf16x8 zw = *(const LAS bf16x8*)(ZW + (16 * m + fr) * R0_ZLD + 32 * d + 8 * kg), za = *(const LAS bf16x8*)(ZA + (16 * m + fr) * R0_ZLD + 32 * d + 8 * kg);
                f32x4 xw = __builtin_amdgcn_mfma_f32_16x16x32_bf16(wf, zw, (f32x4){0.f, 0.f, 0.f, 0.f}, 0, 0, 0), xa = __builtin_amdgcn_mfma_f32_16x16x32_bf16(af, za, (f32x4){0.f, 0.f, 0.f, 0.f}, 0, 0, 0);
                xw = xw + w04; xa = xa + a04; float e[4], av[4];
#pragma unroll
                for (int r = 0; r < 4; ++r) { e[r] = -0.6065306597126334f * __builtin_amdgcn_rcpf(1.f + __expf(-xw[r])); av[r] = __builtin_amdgcn_rcpf(1.f + __expf(-xa[r])); }
                const size_t tok = (size_t)m0 + 16 * m + fr; v2u oe, oa; oe.x = pk2(e[0], e[1]); oe.y = pk2(e[2], e[3]); oa.x = pk2(av[0], av[1]); oa.y = pk2(av[2], av[3]);
                *(GAS v2u*)(EA + (tok * 4 + d) * 256 + ch0 + 4 * kg) = oe; *(GAS v2u*)(EA + (tok * 4 + 2 + d) * 256 + ch0 + 4 * kg) = oa; } }
    }
    __syncthreads();
}

constexpr int RW_T = 16, RW_NCH = (LCX + SEQ) / RW_T, RW_ROWS = RW_T + 2, RW_LD = 200, RW_P = 72;
constexpr int RW_RAW = 0, RW_RAWB = RW_ROWS * RW_LD * 2;
constexpr int RW_EAB = RW_RAW + 2 * RW_RAWB, RW_EABB = RW_T * 128 * 2;
constexpr int RW_VPITCH = 260, RW_VLWF = RW_T * RW_VPITCH * 2;
constexpr int RW_LWP = 68;
constexpr int RW_VEC = RW_EAB + 2 * RW_EABB, RW_VECB = RW_VLWF + RW_T * RW_LWP * 4;
constexpr int RW_VV = RW_VEC + 2 * RW_VECB;
constexpr int RW_BON = RW_VV + 8 * 1024;
constexpr int RW_ARA = RW_BON + 8 * 64;
constexpr int RW_KB2 = RW_ARA + 2 * 16 * RW_P * 2;
constexpr int RW_AT2 = RW_KB2 + 2 * 32 * RW_P * 2;
constexpr int RW_ARR = RW_AT2 + 4 * 2048;
constexpr int RW_KT = RW_ARR + 4 * 16 * RW_P * 2;
constexpr int RW_BTN = RW_KT + 4 * 2048;
constexpr int RW_CWT = RW_BTN + 4 * 2048;
constexpr int RW_DO = RW_CWT + 4 * 256;
constexpr int RW_DOB = 16 * RW_P * 2 + 3 * 512;
constexpr int RW_BC = RW_DO + 4 * RW_DOB;
constexpr int RW_END = RW_BC + 9 * 256;
static_assert(RW_END <= RING_BYTES, "rwkv lds map");
typedef LAS bf16* lbf;
__device__ __forceinline__ bf16x8 rw_zero8() { return (bf16x8){0, 0, 0, 0, 0, 0, 0, 0}; }
__device__ __forceinline__ bf16x8 rw_k16(const LAS bf16* rowp, int kg) { bf16x8 r = rw_zero8(); if (kg < 2) r = *(const LAS bf16x8*)(rowp + 8 * kg); return r; }
__device__ __forceinline__ bf16x8 rw_perm4(const LAS bf16* rowp, int kg) { union { bf16x8 v; v2u h[2]; } u; u.h[0] = *(const LAS v2u*)(rowp + 4 * kg); u.h[1] = (v2u){0u, 0u}; return u.v; }
__device__ __forceinline__ bf16x8 rw_permK(const LAS bf16* rowp, int kg, int sp) { union { bf16x8 v; v2u h[2]; } u; u.h[0] = *(const LAS v2u*)(rowp + 32 * sp + 4 * kg); u.h[1] = *(const LAS v2u*)(rowp + 32 * sp + 16 + 4 * kg); return u.v; }
__device__ __forceinline__ bf16x8 rw_c4(f32x4 c) { union { bf16x8 v; unsigned u[4]; } x; x.u[0] = pk2(c[0], c[1]); x.u[1] = pk2(c[2], c[3]); x.u[2] = 0u; x.u[3] = 0u; return x.v; }
__device__ __forceinline__ bf16x8 rw_c8(f32x4 c0, f32x4 c1) { union { bf16x8 v; unsigned u[4]; } x; x.u[0] = pk2(c0[0], c0[1]); x.u[1] = pk2(c0[2], c0[3]); x.u[2] = pk2(c1[0], c1[1]); x.u[3] = pk2(c1[2], c1[3]); return x.v; }
__device__ __forceinline__ void rw_st_rows(lbf M, f32x4 c, int fr, int kg) {
#pragma unroll
    for (int r = 0; r < 4; ++r) M[(4 * kg + r) * 16 + fr] = (bf16)f2bf(c[r]); }
__device__ __forceinline__ void rw_st_cols(lbf M, f32x4 c, int fr, int kg, int pitch) {
    v2u o; o.x = pk2(c[0], c[1]); o.y = pk2(c[2], c[3]); *(LAS v2u*)(M + fr * pitch + 4 * kg) = o; }
#define RW_MFMA(a, b, c) __builtin_amdgcn_mfma_f32_16x16x32_bf16(a, b, c, 0, 0, 0)

__device__ __forceinline__ void phase_rwkv_scan(Frame& F, int li) { WS_DECL; frame_refresh(F);
    const bf16* P = WSP(bf16, WS_P); const bf16* EA = WSP(bf16, WS_EA); float* YR = WSP(float, WS_YR); float* BON = WSP(float, WS_BON);

    const int tid = F.tid, lane = F.lane, wave = F.wave, fr = lane & 15, kg = lane >> 4;
    LAS unsigned char* L = F.lds;
    for (int item = blockIdx.x; item < 256; item += F.G) {
        const int vhalf = item & 1, d = (item >> 1) & 1, h = (item >> 2) & 3, b = item >> 4;
        __syncthreads();
        const int pt = (tid - 128) & 255, ps = pt >> 4, pq = pt & 15;
        const int sk = pt >> 2, sq = pt & 3;
        { LAS float* BC = (LAS float*)(L + RW_BC); const float* mup = in_ptr(I_MUP) + li * 960; const float* mun = in_ptr(I_MUN) + li * 960;
          if (tid < 64) { const int c = 64 * h + tid; BC[tid] = mup[c]; BC[64 + tid] = mup[256 + c]; BC[128 + tid] = mup[512 + c]; BC[192 + tid] = mun[c]; BC[256 + tid] = mun[256 + c]; BC[320 + tid] = mun[512 + c];
              BC[384 + tid] = in_ptr(I_KK)[li * 256 + c]; BC[448 + tid] = in_ptr(I_KA)[li * 256 + c]; BC[512 + tid] = in_ptr(I_RK)[li * 256 + c]; } }
        __syncthreads();
        f32x4 S0 = (f32x4){0.f, 0.f, 0.f, 0.f}, S1 = S0, S2 = S0, S3 = S0;
        v4u ra[11];
#pragma unroll
        for (int q = 0; q < 11; ++q) ra[q] = (v4u){0u, 0u, 0u, 0u};
        if (wave < 2) {
#pragma unroll 1
            for (int it = -8; it <= RW_NCH; ++it) {
                if (it >= 0 && it < RW_NCH) {
                    const lbf VV = (lbf)(L + RW_VV + (it & 7) * 1024), ARR = (lbf)(L + RW_ARR + (it & 3) * (16 * RW_P * 2)), KT = (lbf)(L + RW_KT + (it & 3) * 2048), BTN = (lbf)(L + RW_BTN + (it & 3) * 2048);
                    const LAS float* CWT = (const LAS float*)(L + RW_CWT + (it & 3) * 256);
                    const lbf APT = (lbf)(L + RW_DO + (it & 3) * RW_DOB), AMT = APT + 16 * RW_P, ARKT = AMT + 256, ARBTN = ARKT + 256;
                    const f32x4 Z = (f32x4){0.f, 0.f, 0.f, 0.f};
                    const bf16x8 bvv = rw_k16(VV + (16 * wave + fr) * 16, kg);
                    const bf16x8 sb0 = rw_c8(S0, S1), sb1 = rw_c8(S2, S3);
                    f32x4 UT = RW_MFMA(rw_k16(AMT + fr * 16, kg), bvv, Z);
                    UT = RW_MFMA(rw_permK(APT + fr * RW_P, kg, 0), sb0, UT); UT = RW_MFMA(rw_permK(APT + fr * RW_P, kg, 1), sb1, UT);
                    f32x4 YT = RW_MFMA(rw_k16(ARKT + fr * 16, kg), bvv, Z);
                    YT = RW_MFMA(rw_permK(ARR + fr * RW_P, kg, 0), sb0, YT); YT = RW_MFMA(rw_permK(ARR + fr * RW_P, kg, 1), sb1, YT);
                    const bf16x8 ub = rw_c4(UT);
                    YT = RW_MFMA(rw_perm4(ARBTN + fr * 16, kg), ub, YT);
                    { const bool isctx = it < LCX / RW_T;
                      if (!isctx || li < DEPTH - 1) { const int cl = isctx ? it : it - LCX / RW_T; const int Ls = isctx ? LCX : SEQ; const int tlo = d == 0 ? cl * RW_T : Ls - RW_T - cl * RW_T; const size_t seg0 = isctx ? (size_t)NL + b * LCX : (size_t)b * SEQ;
#pragma unroll
                          for (int r = 0; r < 4; ++r) { const int sidx = 4 * kg + r; const int t = d == 0 ? tlo + sidx : tlo + RW_T - 1 - sidx;
                              YR[((size_t)d * NT + seg0 + t) * 256 + 64 * h + 32 * vhalf + 16 * wave + fr] = YT[r]; }
                          if (vhalf == 0 && wave == 0 && lane < RW_T) { const LAS float* BONS = (const LAS float*)(L + RW_BON) + (it & 7) * RW_T; const int t = d == 0 ? tlo + lane : tlo + RW_T - 1 - lane;
                              BON[((size_t)d * NT + seg0 + t) * 4 + h] = BONS[lane]; } } }
                    { f32x4 q = RW_MFMA(rw_k16(KT + (0 + fr) * 16, kg), bvv, S0); q = RW_MFMA(rw_perm4(BTN + (0 + fr) * 16, kg), ub, q); S0 = q * *(const LAS f32x4*)(CWT + 0 + 4 * kg); }
                    { f32x4 q = RW_MFMA(rw_k16(KT + (16 + fr) * 16, kg), bvv, S1); q = RW_MFMA(rw_perm4(BTN + (16 + fr) * 16, kg), ub, q); S1 = q * *(const LAS f32x4*)(CWT + 16 + 4 * kg); }
                    { f32x4 q = RW_MFMA(rw_k16(KT + (32 + fr) * 16, kg), bvv, S2); q = RW_MFMA(rw_perm4(BTN + (32 + fr) * 16, kg), ub, q); S2 = q * *(const LAS f32x4*)(CWT + 32 + 4 * kg); }
                    { f32x4 q = RW_MFMA(rw_k16(KT + (48 + fr) * 16, kg), bvv, S3); q = RW_MFMA(rw_perm4(BTN + (48 + fr) * 16, kg), ub, q); S3 = q * *(const LAS f32x4*)(CWT + 48 + 4 * kg); }
                }
                __syncthreads();
            }
        } else if (wave < 6) {
            int offq[11], ldq[11];
#pragma unroll
            for (int q = 0; q < 11; ++q) { const int c = lane + 64 * q; int o = 0, l = -1;
                if (c < RW_ROWS * 24) { const int r = c / 24, cc = c % 24; o = r * (PCOLS * 2) + 2 * (RW_C0 + 256 * (cc >> 3) + 64 * h + 8 * (cc & 7)); l = RW_RAW + (r * RW_LD + 8 * cc) * 2; }
                else if (c < RW_ROWS * 24 + RW_T * 16) { const int e = c - RW_ROWS * 24, s = e >> 4, cc = e & 15; o = (((d == 0 ? s : RW_T - 1 - s) * 4 + (cc >> 3) * 2 + d) * 256 + 64 * h + 8 * (cc & 7)) * 2; l = RW_EAB + 16 * e; }
                offq[q] = o; ldq[q] = l; }
            const LAS float* BC = (const LAS float*)(L + RW_BC) + 4 * pq;
            const f32x4 mpr = *(const LAS f32x4*)(BC), mpk = *(const LAS f32x4*)(BC + 64), mpv = *(const LAS f32x4*)(BC + 128), mnr = *(const LAS f32x4*)(BC + 192), mnk = *(const LAS f32x4*)(BC + 256), mnv = *(const LAS f32x4*)(BC + 320);
            const f32x4 kk_c = *(const LAS f32x4*)(BC + 384), ka_c = *(const LAS f32x4*)(BC + 448), rk_c = *(const LAS f32x4*)(BC + 512);
#pragma unroll 1
            for (int it = -8; it <= RW_NCH; ++it) {
                { const int ca = it + 5;
                  if (ca >= 0 && ca < RW_NCH && ((ca & 3) == wave - 2)) { const bool isctx = ca < LCX / RW_T; const int cl = isctx ? ca : ca - LCX / RW_T; const int Ls = isctx ? LCX : SEQ; const int tlo = d == 0 ? cl * RW_T : Ls - RW_T - cl * RW_T;
                      const bool edge_lo = tlo == 0, edge_hi = tlo + RW_T == Ls;
#pragma unroll
                      for (int q = 0; q < 11; ++q) { v4u v = ra[q];
                          if (q == 0 && edge_lo && lane < 24) v = (v4u){0u, 0u, 0u, 0u};
                          if (q == 6 && edge_hi && lane >= 24 && lane < 48) v = (v4u){0u, 0u, 0u, 0u};
                          const int bo = (ca & 1) * ((q < 6 || (q == 6 && lane < 48)) ? RW_RAWB : RW_EABB);
                          if (q < 10 || lane < 48) *(LAS v4u*)(L + ldq[q] + bo) = v; } }
                  const int cn = it + 8;
                  if (cn < RW_NCH && ((cn & 3) == wave - 2)) { const bool isctx = cn < LCX / RW_T; const int cl = isctx ? cn : cn - LCX / RW_T; const int Ls = isctx ? LCX : SEQ; const int tlo = d == 0 ? cl * RW_T : Ls - RW_T - cl * RW_T;
                      const long row0 = (long)(isctx ? NL + b * LCX : b * SEQ) + tlo;
                      const char* pb = (const char*)P + (row0 - 1) * (PCOLS * 2);
                      const unsigned delta = (unsigned)(((const char*)EA + row0 * 2048) - pb);
#pragma unroll
                      for (int q = 0; q < 11; ++q) { unsigned o = (unsigned)offq[q]; if (q > 6 || (q == 6 && lane >= 48)) o += delta;
                          ra[q] = *(const GAS v4u*)(pb + o); } } }
                const int cb = it + 4;
                if (cb >= 0 && cb < RW_NCH) {
                    const LAS bf16* RAW = (const LAS bf16*)(L + RW_RAW + (cb & 1) * RW_RAWB); const LAS bf16* EAB = (const LAS bf16*)(L + RW_EAB + (cb & 1) * RW_EABB);
                    const lbf VEC = (lbf)(L + RW_VEC + (cb & 1) * RW_VECB); LAS float* LWF = (LAS float*)(L + RW_VEC + (cb & 1) * RW_VECB + RW_VLWF);
                    const lbf VV = (lbf)(L + RW_VV + (cb & 7) * 1024); LAS float* BONS = (LAS float*)(L + RW_BON) + (cb & 7) * RW_T;
                    const int prow = d == 0 ? ps + 1 : RW_T - ps;
                    f32x4 zr, zk, zv;
                    { const LAS bf16* r0 = RAW + prow * RW_LD + 4 * pq;
#define RW_LD4(p) ({ const v2u w_ = *(const LAS v2u*)(p); (f32x4){bflo(w_.x), bfhi(w_.x), bflo(w_.y), bfhi(w_.y)}; })
                      { const f32x4 x = RW_LD4(r0), xp = RW_LD4(r0 - RW_LD), xn = RW_LD4(r0 + RW_LD); zr = x + mpr * (xp - x) + mnr * (xn - x); }
                      { const f32x4 x = RW_LD4(r0 + 64), xp = RW_LD4(r0 + 64 - RW_LD), xn = RW_LD4(r0 + 64 + RW_LD); zk = x + mpk * (xp - x) + mnk * (xn - x); }
                      { const f32x4 x = RW_LD4(r0 + 128), xp = RW_LD4(r0 + 128 - RW_LD), xn = RW_LD4(r0 + 128 + RW_LD); zv = x + mpv * (xp - x) + mnv * (xn - x); } }
                    const f32x4 lw4 = RW_LD4(EAB + ps * 128 + 4 * pq), a4 = RW_LD4(EAB + ps * 128 + 64 + 4 * pq);
                    const f32x4 kkr = zk * kk_c; const float ss = rowsum16((kkr.x * kkr.x + kkr.y * kkr.y) + (kkr.z * kkr.z + kkr.w * kkr.w));
                    const f32x4 kd = zk * ((a4 - 1.f) * ka_c + 1.f); const f32x4 bq = zr * kd * rk_c; const float bn = rowsum16((bq.x + bq.y) + (bq.z + bq.w));
                    const f32x4 kkn = kkr * __builtin_amdgcn_rsqf(fmaxf(ss, 1e-24f)), kka = kkn * a4;
                    { lbf vp = VEC + ps * RW_VPITCH + 16 * pq;
#pragma unroll
                      for (int i = 0; i < 4; ++i) { v2u o; o.x = pk2(kkn[i], kka[i]); o.y = pk2(kd[i], zr[i]); *(LAS v2u*)(vp + 4 * i) = o; } }
                    *(LAS f32x4*)(LWF + ps * RW_LWP + 4 * pq) = lw4;
                    if ((pq >> 3) == vhalf) { const int v0 = 4 * (pq & 7); VV[(v0 + 0) * 16 + ps] = (bf16)f2bf(zv.x); VV[(v0 + 1) * 16 + ps] = (bf16)f2bf(zv.y); VV[(v0 + 2) * 16 + ps] = (bf16)f2bf(zv.z); VV[(v0 + 3) * 16 + ps] = (bf16)f2bf(zv.w); }
                    if (pq == 0) BONS[ps] = bn;
                }
                const int cc3 = it + 3;
                if (cc3 >= 0 && cc3 < RW_NCH) {
                    const LAS bf16* VEC = (const LAS bf16*)(L + RW_VEC + (cc3 & 1) * RW_VECB); const LAS float* LWF = (const LAS float*)(L + RW_VEC + (cc3 & 1) * RW_VECB + RW_VLWF);
                    const lbf ARA = (lbf)(L + RW_ARA + (cc3 & 1) * (16 * RW_P * 2)), KB2 = (lbf)(L + RW_KB2 + (cc3 & 1) * (32 * RW_P * 2)), AT2 = (lbf)(L + RW_AT2 + (cc3 & 3) * 2048);
                    const lbf ARR = (lbf)(L + RW_ARR + (cc3 & 3) * (16 * RW_P * 2)), KT = (lbf)(L + RW_KT + (cc3 & 3) * 2048), BTN = (lbf)(L + RW_BTN + (cc3 & 3) * 2048); LAS float* CWT = (LAS float*)(L + RW_CWT + (cc3 & 3) * 256);
                    float l4[4];
#pragma unroll
                    for (int j = 0; j < 4; ++j) l4[j] = LWF[(4 * sq + j) * RW_LWP + sk];
                    float cl;
                    { const int own = __builtin_bit_cast(int, (l4[0] + l4[1]) + (l4[2] + l4[3]));
                      const float a1 = __builtin_bit_cast(float, __builtin_amdgcn_update_dpp(0, own, 0x90, 0xf, 0xf, false));
                      const float a2 = __builtin_bit_cast(float, __builtin_amdgcn_update_dpp(0, own, 0x40, 0xf, 0xf, false));
                      const float a3 = __builtin_bit_cast(float, __builtin_amdgcn_update_dpp(0, own, 0x00, 0xf, 0xf, false));
                      cl = ((sq >= 3 ? a3 : 0.f) + (sq >= 2 ? a2 : 0.f)) + (sq >= 1 ? a1 : 0.f); }
                    float cwm = __expf(cl);
                    float atf[4], rtf[4], ktf[4], btf[4];
#pragma unroll
                    for (int j = 0; j < 4; ++j) { const int s = 4 * sq + j; cl += l4[j]; const float cw = __expf(cl), icw = __builtin_amdgcn_rcpf(cw);
                        const v2u vw = *(const LAS v2u*)(VEC + s * RW_VPITCH + 4 * sk); const float kkv = bflo(vw.x), kkav = bfhi(vw.x), kdv = bflo(vw.y), rv = bfhi(vw.y);
                        atf[j] = kkv * cwm; rtf[j] = rv * cw; ktf[j] = kdv * icw; btf[j] = kkav * icw;
                        if (s == RW_T - 1) CWT[sk] = cw;
                        cwm = cw; }
                    unsigned atp[2], ktp[2], bnp[2];
#pragma unroll
                    for (int jp = 0; jp < 2; ++jp) { const int s0 = 4 * sq + 2 * jp; const unsigned a = pk2(atf[2 * jp], atf[2 * jp + 1]), r = pk2(rtf[2 * jp], rtf[2 * jp + 1]), k = pk2(ktf[2 * jp], ktf[2 * jp + 1]), bp = pk2(btf[2 * jp], btf[2 * jp + 1]);
                        ARA[s0 * RW_P + sk] = (bf16)a; ARA[(s0 + 1) * RW_P + sk] = (bf16)(a >> 16); ARR[s0 * RW_P + sk] = (bf16)r; ARR[(s0 + 1) * RW_P + sk] = (bf16)(r >> 16);
                        KB2[s0 * RW_P + sk] = (bf16)k; KB2[(s0 + 1) * RW_P + sk] = (bf16)(k >> 16); KB2[(16 + s0) * RW_P + sk] = (bf16)bp; KB2[(17 + s0) * RW_P + sk] = (bf16)(bp >> 16);
                        atp[jp] = a; ktp[jp] = k; bnp[jp] = bp ^ 0x80008000u; }
                    *(LAS v2u*)(AT2 + sk * 16 + 4 * sq) = (v2u){atp[0], atp[1]}; *(LAS v2u*)(KT + sk * 16 + 4 * sq) = (v2u){ktp[0], ktp[1]}; *(LAS v2u*)(BTN + sk * 16 + 4 * sq) = (v2u){bnp[0], bnp[1]};
                }
                __syncthreads();
            }
        } else {
#pragma unroll 1
            for (int it = -8; it <= RW_NCH; ++it) {
                const int c = it + 2;
                if (c >= 0 && c < RW_NCH && ((c & 1) == (wave & 1))) {
                    const LAS bf16* ARA = (const LAS bf16*)(L + RW_ARA + (c & 1) * (16 * RW_P * 2)); const LAS bf16* KB2 = (const LAS bf16*)(L + RW_KB2 + (c & 1) * (32 * RW_P * 2));
                    const LAS bf16* ARR = (const LAS bf16*)(L + RW_ARR + (c & 3) * (16 * RW_P * 2)); const LAS bf16* AT2 = (const LAS bf16*)(L + RW_AT2 + (c & 3) * 2048);
                    const lbf APT = (lbf)(L + RW_DO + (c & 3) * RW_DOB), AMT = APT + 16 * RW_P, ARKT = AMT + 256, ARBTN = ARKT + 256;
                    const f32x4 Z = (f32x4){0.f, 0.f, 0.f, 0.f};
                    f32x4 gkk = Z, gkkT = Z, grk = Z, gn = Z, gnT = Z, grb = Z;
#pragma unroll
                    for (int ks = 0; ks < 2; ++ks) { const bf16x8 ak = *(const LAS bf16x8*)(KB2 + fr * RW_P + 32 * ks + 8 * kg), ab = *(const LAS bf16x8*)(KB2 + (16 + fr) * RW_P + 32 * ks + 8 * kg);
                        const bf16x8 ba = *(const LAS bf16x8*)(ARA + fr * RW_P + 32 * ks + 8 * kg), br = *(const LAS bf16x8*)(ARR + fr * RW_P + 32 * ks + 8 * kg);
                        gkk = RW_MFMA(ak, ba, gkk); gkkT = RW_MFMA(ba, ak, gkkT); grk = RW_MFMA(ak, br, grk); gn = RW_MFMA(ab, ba, gn); gnT = RW_MFMA(ba, ab, gnT); grb = RW_MFMA(ab, br, grb); }
                    f32x4 w1, w1T;
#pragma unroll
                    for (int r = 0; r < 4; ++r) { const int row = 4 * kg + r;
                        if (!(row < fr)) { gkk[r] = 0.f; gn[r] = 0.f; } if (!(fr < row)) { gkkT[r] = 0.f; gnT[r] = 0.f; } if (!(row <= fr)) { grk[r] = 0.f; grb[r] = 0.f; }
                        const float idt = row == fr ? 1.f : 0.f; w1[r] = idt - gn[r]; w1T[r] = idt - gnT[r]; }
                    const bf16x8 bn = rw_c4(gn), bnT = rw_c4(gnT);
                    const f32x4 n2 = RW_MFMA(bnT, bn, Z), n2T = RW_MFMA(bn, bnT, Z);
                    const bf16x8 b2 = rw_c4(n2), b2T = rw_c4(n2T);
                    const f32x4 n4 = RW_MFMA(b2T, b2, Z), n4T = RW_MFMA(b2, b2T, Z);
                    const bf16x8 b4 = rw_c4(n4), b4T = rw_c4(n4T);
                    const f32x4 n8 = RW_MFMA(b4T, b4, Z);
                    const bf16x8 bw1T = rw_c4(w1T);
                    const f32x4 w2 = RW_MFMA(bw1T, b2, w1), w2T = RW_MFMA(b2, bw1T, w1T);
                    const bf16x8 bw2T = rw_c4(w2T);
                    const f32x4 w3 = RW_MFMA(bw2T, b4, w2), w3T = RW_MFMA(b4, bw2T, w2T);
                    const f32x4 xi = RW_MFMA(rw_c4(w3T), rw_c4(n8), w3);
                    const bf16x8 bx = rw_c4(xi);
                    const f32x4 am = RW_MFMA(rw_c4(gkkT), bx, Z);
                    rw_st_cols(AMT, am, fr, kg, 16); rw_st_cols(ARKT, grk, fr, kg, 16); { f32x4 nb = Z - grb; rw_st_cols(ARBTN, nb, fr, kg, 16); }
#pragma unroll
                    for (int m = 0; m < 4; ++m) { const f32x4 ap = RW_MFMA(rw_perm4(AT2 + (16 * m + fr) * 16, kg), bx, Z);
                        rw_st_cols(APT + 16 * m, ap, fr, kg, RW_P); }
                }
                __syncthreads();
            }
        }
    }
}
struct RwFinRaw { v4u g[2][3]; f32x4 y[2][4]; float b0, b1; };
__device__ __forceinline__ void rwfin_load(RwFinRaw& R, int it, int fr, int kg, const bf16* P, const float* YR, const float* BON) {
    const int hh = it & 3, m = 16 * (it >> 2) + fr; const bool isctx = m >= NL; const int t = isctx ? (m - NL) & 255 : m & 4095; const int Ls = isctx ? 256 : 4096; const bool hp = t > 0, hn = t + 1 < Ls;
    const bf16* pr = P + (size_t)m * PCOLS + RW_C0; const v4u Z4 = (v4u){0u, 0u, 0u, 0u};
#pragma unroll
    for (int ks = 0; ks < 2; ++ks) { const int c = 896 + 32 * ks + 8 * kg; R.g[ks][0] = *(const GAS v4u*)(pr + c); R.g[ks][1] = Z4; R.g[ks][2] = Z4;
        if (hp) R.g[ks][1] = *(const GAS v4u*)(pr - PCOLS + c); if (hn) R.g[ks][2] = *(const GAS v4u*)(pr + PCOLS + c); }
    const int c0 = 64 * hh + 16 * kg;
#pragma unroll
    for (int q = 0; q < 4; ++q) { R.y[0][q] = __builtin_nontemporal_load((const GAS f32x4*)(YR + (size_t)m * 256 + c0 + 4 * q)); R.y[1][q] = __builtin_nontemporal_load((const GAS f32x4*)(YR + ((size_t)NT + m) * 256 + c0 + 4 * q)); }
    R.b0 = BON[(size_t)m * 4 + hh]; R.b1 = BON[((size_t)NT + m) * 4 + hh];
}
__device__ __forceinline__ void phase_fin_rwkv(Frame& F, int li) { WS_DECL; frame_refresh(F);
    const int nrows = li == DEPTH - 1 ? NL : NT; const int lane = F.lane, wave = F.wave, tid = F.tid, fr = lane & 15, kg = lane >> 4;
    LAS bf16* GT = (LAS bf16*)F.lds;
    LAS float* CV = (LAS float*)(F.lds + 256 * 72 * 2);
    const bf16* P = WSP(bf16, WS_P); const float* YR = WSP(float, WS_YR); const float* BON = WSP(float, WS_BON); bf16* MIX = WSP(bf16, WS_A1);
    const float* mup = in_ptr(I_MUP) + li * 960; const float* mun = in_ptr(I_MUN) + li * 960;
    __syncthreads();
    { const bf16* gsrc = WSP(bf16, WS_GUPT) + (size_t)li * 256 * 64;
#pragma unroll
      for (int u = 0; u < 4; ++u) { const int i = tid + NTHR * u, n = i >> 3, part = i & 7; *(LAS v4u*)(GT + n * 72 + 8 * part) = *(const GAS v4u*)(gsrc + n * 64 + 8 * part); } }
    if (tid < 256) { CV[tid] = mup[512 + tid]; CV[256 + tid] = mun[512 + tid]; CV[512 + tid] = in_ptr(I_LNG)[li * 256 + tid]; CV[768 + tid] = in_ptr(I_LNB)[li * 256 + tid]; }
    if (tid >= 256 && tid < 320) { CV[1024 + tid - 256] = mup[896 + tid - 256]; CV[1088 + tid - 256] = mun[896 + tid - 256]; }
    __syncthreads();
    const int nit = nrows / 4, NGW = F.G * NWAVES;
    int it = blockIdx.x * NWAVES + wave;
    RwFinRaw cur; rwfin_load(cur, it < nit ? it : nit - 1, fr, kg, P, YR, BON);
#pragma unroll 1
    while (it < nit) {
        const int nx = it + NGW; RwFinRaw nxt; rwfin_load(nxt, nx < nit ? nx : nit - 1, fr, kg, P, YR, BON);
        const int hh = it & 3, m = 16 * (it >> 2) + fr, c0 = 64 * hh + 16 * kg;
        v4u vr[2][3];
        { const bool isctx = m >= NL; const int t = isctx ? (m - NL) & 255 : m & 4095; const int Ls = isctx ? 256 : 4096; const bool hp = t > 0, hn = t + 1 < Ls; const bf16* pr = P + (size_t)m * PCOLS + RW_C0; const v4u Z4 = (v4u){0u, 0u, 0u, 0u};
#pragma unroll
          for (int e = 0; e < 2; ++e) { vr[e][0] = *(const GAS v4u*)(pr + 512 + c0 + 8 * e); vr[e][1] = Z4; vr[e][2] = Z4;
              if (hp) vr[e][1] = *(const GAS v4u*)(pr - PCOLS + 512 + c0 + 8 * e); if (hn) vr[e][2] = *(const GAS v4u*)(pr + PCOLS + 512 + c0 + 8 * e); } }
        bf16x8 bg[2];
#pragma unroll
        for (int ks = 0; ks < 2; ++ks) { union { bf16x8 v; unsigned u[4]; } o;
            const LAS float* gm = CV + 1024 + 32 * ks + 8 * kg; const f32x4 mpg0 = *(const LAS f32x4*)(gm), mpg1 = *(const LAS f32x4*)(gm + 4), mng0 = *(const LAS f32x4*)(gm + 64), mng1 = *(const LAS f32x4*)(gm + 68);
#pragma unroll
            for (int j = 0; j < 4; ++j) { const unsigned w = cur.g[ks][0][j], wp = cur.g[ks][1][j], wn = cur.g[ks][2][j]; const float x0 = bflo(w), x1 = bfhi(w), p0 = bflo(wp), p1 = bfhi(wp), n0 = bflo(wn), n1 = bfhi(wn);
                const float a0 = (j >> 1 ? mpg1 : mpg0)[2 * (j & 1)], a1 = (j >> 1 ? mpg1 : mpg0)[2 * (j & 1) + 1], b0 = (j >> 1 ? mng1 : mng0)[2 * (j & 1)], b1 = (j >> 1 ? mng1 : mng0)[2 * (j & 1) + 1];
                o.u[j] = pk2(sigmoidf_(x0 + a0 * (p0 - x0) + b0 * (n0 - x0)), sigmoidf_(x1 + a1 * (p1 - x1) + b1 * (n1 - x1))); }
            bg[ks] = o.v; }
        f32x4 acc[4];
#pragma unroll
        for (int q = 0; q < 4; ++q) { const LAS bf16* ar = GT + (64 * hh + 16 * (fr >> 2) + 4 * q + (fr & 3)) * 72 + 8 * kg; const f32x4 z = (f32x4){0.f, 0.f, 0.f, 0.f};
            acc[q] = __builtin_amdgcn_mfma_f32_16x16x32_bf16(*(const LAS bf16x8*)(ar), bg[0], z, 0, 0, 0);
            acc[q] = __builtin_amdgcn_mfma_f32_16x16x32_bf16(*(const LAS bf16x8*)(ar + 32), bg[1], acc[q], 0, 0, 0); }
        f32x4 y[4]; float s1 = 0.f;
#pragma unroll
        for (int q = 0; q < 4; ++q) { y[q] = cur.y[0][q] + cur.y[1][q]; s1 += (y[q].x + y[q].y) + (y[q].z + y[q].w); }
        s1 += __shfl_xor(s1, 16); s1 += __shfl_xor(s1, 32);
        const float mean = s1 * (1.f / 64.f); float s2 = 0.f;
#pragma unroll
        for (int q = 0; q < 4; ++q) { y[q] = y[q] - mean; s2 += (y[q].x * y[q].x + y[q].y * y[q].y) + (y[q].z * y[q].z + y[q].w * y[q].w); }
        s2 += __shfl_xor(s2, 16); s2 += __shfl_xor(s2, 32);
        const float rs = __builtin_amdgcn_rsqf(s2 * (1.f / 64.f) + 64e-5f);
        const float bon = cur.b0 + cur.b1;
        unsigned ow[8];
#pragma unroll
        for (int q = 0; q < 4; ++q) { const int c = c0 + 4 * q;
            const f32x4 mpv = *(const LAS f32x4*)(CV + c), mnv = *(const LAS f32x4*)(CV + 256 + c), lg = *(const LAS f32x4*)(CV + 512 + c), lb = *(const LAS f32x4*)(CV + 768 + c);
            const unsigned w0 = vr[q >> 1][0][2 * (q & 1)], w1 = vr[q >> 1][0][2 * (q & 1) + 1], p0 = vr[q >> 1][1][2 * (q & 1)], p1 = vr[q >> 1][1][2 * (q & 1) + 1], n0 = vr[q >> 1][2][2 * (q & 1)], n1 = vr[q >> 1][2][2 * (q & 1) + 1];
            const f32x4 x = (f32x4){bflo(w0), bfhi(w0), bflo(w1), bfhi(w1)}, xp = (f32x4){bflo(p0), bfhi(p0), bflo(p1), bfhi(p1)}, xn = (f32x4){bflo(n0), bfhi(n0), bflo(n1), bfhi(n1)};
            const f32x4 v = x + mpv * (xp - x) + mnv * (xn - x);
            const f32x4 yn = y[q] * rs * lg + lb;
            const f32x4 o = (yn + v * bon) * acc[q];
            ow[2 * q] = pk2(o.x, o.y); ow[2 * q + 1] = pk2(o.z, o.w); }
        *(GAS v4u*)(MIX + (size_t)m * D + 512 + c0) = (v4u){ow[0], ow[1], ow[2], ow[3]}; *(GAS v4u*)(MIX + (size_t)m * D + 512 + c0 + 8) = (v4u){ow[4], ow[5], ow[6], ow[7]};
        cur = nxt; it = nx;
    }
    __syncthreads();
}

constexpr float HY_DMIN = -3.0701134573253945f, HY_DMAX = -15.350567286626973f;
constexpr int HY_X = 0, HY_TW = 65536, HY_W3 = 98304;
__device__ __forceinline__ float hy_delta(int ch) { return -(HY_DMIN + (float)ch * ((HY_DMAX - HY_DMIN) / 255.f)); }

__device__ __forceinline__ void phase_pro0d(Frame& F) { WS_DECL; frame_refresh(F);
    const int lane = F.lane; const int gw = blockIdx.x * NWAVES + F.wave, NGW = F.G * NWAVES;
    const float* w1 = in_ptr(I_HW1); const float* b1 = in_ptr(I_HB1); const float* w2 = in_ptr(I_HW2); const float* b2 = in_ptr(I_HB2);
    for (int it = gw; it < DEPTH * (SEQ + LCX); it += NGW) {
        const int li = it / (SEQ + LCX), r = it % (SEQ + LCX); const bool isctx = r >= SEQ; const int l = isctx ? r - SEQ : r; const int L = isctx ? LCX : SEQ;
        float z = 0.f;
        if (lane == 0) z = (float)l / (float)(L - 1);
        else if (lane < 33) { const int i = (lane - 1) & 15; const float band = 1e-4f + (float)i * ((15.f - 1e-4f) / 15.f); const float ang = band * (6.283185307179586f / (float)L) * (float)l; z = lane < 17 ? cosf(ang) : -sinf(ang); }
        float h1 = b1[li * 64 + lane];
        for (int i = 0; i < 33; ++i) h1 += __shfl(z, i) * w1[(li * 33 + i) * 64 + lane];
        h1 = sinf(h1);
        float h2 = b2[li * 64 + lane];
        for (int i = 0; i < 64; ++i) h2 += __shfl(h1, i) * w2[(li * 64 + i) * 64 + lane];
        h2 = sinf(h2);
        if (isctx) WSP(float, WS_H2C)[((size_t)li * LCX + l) * 64 + lane] = h2;
        else WSP(float, WS_H2L)[((size_t)li * 64 + lane) * SEQ + l] = h2;
    }
}

typedef f32x2 cpx;
__device__ __forceinline__ cpx cmul(cpx a, cpx b) { return (cpx){a.x * b.x - a.y * b.y, a.x * b.y + a.y * b.x}; }
__device__ __forceinline__ cpx cmulc(cpx a, cpx b) { return (cpx){a.x * b.x + a.y * b.y, a.y * b.x - a.x * b.y}; }
__device__ __forceinline__ cpx cmi(cpx z) { return (cpx){z.y, -z.x}; }
__device__ __forceinline__ int hy_p(int n) { return n ^ ((n >> 5) & 7) ^ (((n >> 6) & 3) << 3); }
__device__ __forceinline__ void hy_build_tw(Frame& F) {
    LAS cpx* TW = (LAS cpx*)(F.lds + HY_TW);
    for (int k = F.tid; k < 4096; k += NTHR) { const float rev = (float)k * (1.f / 8192.f); TW[k] = (cpx){__builtin_amdgcn_cosf(rev), -__builtin_amdgcn_sinf(rev)};     }
}
__device__ __forceinline__ void dft4(cpx x0, cpx x1, cpx x2, cpx x3, cpx& X0, cpx& X1, cpx& X2, cpx& X3) {
    const cpx t0 = x0 + x2, t1 = x0 - x2, t2 = x1 + x3, t3 = cmi(x1 - x3); X0 = t0 + t2; X1 = t1 + t3; X2 = t0 - t2; X3 = t1 - t3; }
__device__ __forceinline__ void dft8(cpx (&a)[8]) {
    const float R2 = 0.7071067811865476f; cpx e[4], o[4];
    dft4(a[0] + a[4], a[1] + a[5], a[2] + a[6], a[3] + a[7], e[0], e[1], e[2], e[3]);
    const cpx d1 = a[1] - a[5], d3 = a[3] - a[7];
    dft4(a[0] - a[4], (cpx){(d1.x + d1.y) * R2, (d1.y - d1.x) * R2}, cmi(a[2] - a[6]), (cpx){(d3.y - d3.x) * R2, -(d3.x + d3.y) * R2}, o[0], o[1], o[2], o[3]);
#pragma unroll
    for (int m = 0; m < 4; ++m) { a[2 * m] = e[m]; a[2 * m + 1] = o[m]; }
}
__device__ __forceinline__ void dft16(cpx (&a)[16]) {
    const float C1 = 0.9238795325112867f, S1 = 0.3826834323650898f, R2 = 0.7071067811865476f;
    cpx e[8], o[8];
#pragma unroll
    for (int k = 0; k < 8; ++k) { e[k] = a[k] + a[k + 8]; o[k] = a[k] - a[k + 8]; }
    o[1] = cmul(o[1], (cpx){C1, -S1}); o[2] = cmul(o[2], (cpx){R2, -R2}); o[3] = cmul(o[3], (cpx){S1, -C1}); o[4] = cmi(o[4]);
    o[5] = cmul(o[5], (cpx){-S1, -C1}); o[6] = cmul(o[6], (cpx){-R2, -R2}); o[7] = cmul(o[7], (cpx){-C1, -S1});
    dft8(e); dft8(o);
#pragma unroll
    for (int m = 0; m < 8; ++m) { a[2 * m] = e[m]; a[2 * m + 1] = o[m]; }
}
template <int R> __device__ __forceinline__ void cconj(cpx (&a)[R]) {
#pragma unroll
    for (int k = 0; k < R; ++k) a[k].y = -a[k].y; }
template <bool INV, bool ZU> __device__ __forceinline__ void hy_pass1(LAS cpx* X, const LAS cpx* TW, int tid) {
    cpx a[16]; const cpx w1 = TW[tid];
#pragma unroll
    for (int k = 0; k < 16; ++k) a[k] = (!INV && ZU && k >= 8) ? (cpx){0.f, 0.f} : X[hy_p(tid + 512 * k)];
    if (!INV) { dft16(a); cpx w = w1;
#pragma unroll
        for (int q = 1; q < 16; ++q) { a[q] = cmul(a[q], w); w = cmul(w, w1); }
    } else { cpx w = w1;
#pragma unroll
        for (int q = 1; q < 16; ++q) { a[q] = cmulc(a[q], w); w = cmul(w, w1); }
        cconj<16>(a); dft16(a); cconj<16>(a); }
#pragma unroll
    for (int k = 0; k < 16; ++k) if (!(INV && ZU && k >= 8)) X[hy_p(tid + 512 * k)] = a[k];
}
template <bool INV, int S, int MUL> __device__ __forceinline__ void hy_pass8(LAS cpx* X, const LAS cpx* TW, int tid) {
#pragma unroll
    for (int h = 0; h < 2; ++h) { const int bf = tid + 512 * h, sub = bf / S, j = bf % S, base = 8 * S * sub + j; cpx a[8]; const cpx w1 = TW[MUL * j];
#pragma unroll
        for (int k = 0; k < 8; ++k) a[k] = X[hy_p(base + S * k)];
        if (!INV) { dft8(a); cpx w = w1;
#pragma unroll
            for (int q = 1; q < 8; ++q) { a[q] = cmul(a[q], w); w = cmul(w, w1); }
        } else { cpx w = w1;
#pragma unroll
            for (int q = 1; q < 8; ++q) { a[q] = cmulc(a[q], w); w = cmul(w, w1); }
            cconj<8>(a); dft8(a); cconj<8>(a); }
#pragma unroll
        for (int k = 0; k < 8; ++k) X[hy_p(base + S * k)] = a[k]; }
}
__device__ __forceinline__ void hy_pass4(LAS cpx* X, int tid, const cpx* spec) {
#pragma unroll
    for (int h = 0; h < 2; ++h) { const int g = tid + 512 * h; cpx a[8];
#pragma unroll
        for (int k = 0; k < 8; ++k) a[k] = X[hy_p(8 * g + k)];
        dft8(a);
        if (spec) {
#pragma unroll
            for (int k2 = 0; k2 < 4; ++k2) { const f32x4 s4 = *(const GAS f32x4*)(spec + 8 * g + 2 * k2); a[2 * k2] = cmul(a[2 * k2], (cpx){s4.x, s4.y}); a[2 * k2 + 1] = cmul(a[2 * k2 + 1], (cpx){s4.z, s4.w}); }
            cconj<8>(a); dft8(a); cconj<8>(a); }
#pragma unroll
        for (int k = 0; k < 8; ++k) X[hy_p(8 * g + k)] = a[k]; }
}
__device__ __forceinline__ void hy_conv_fft(LAS cpx* X, const LAS cpx* TW, int tid, const cpx* spec) {
    hy_pass1<false, true>(X, TW, tid); __syncthreads();
    hy_pass8<false, 64, 16>(X, TW, tid); __syncthreads();
    hy_pass8<false, 8, 128>(X, TW, tid); __syncthreads();
    hy_pass4(X, tid, spec); __syncthreads();
    hy_pass8<true, 8, 128>(X, TW, tid); __syncthreads();
    hy_pass8<true, 64, 16>(X, TW, tid); __syncthreads();
    hy_pass1<true, true>(X, TW, tid); __syncthreads();
}

__device__ __forceinline__ void phase_hy_spec(Frame& F, int li) { WS_DECL; frame_refresh(F);
    LAS cpx* X = (LAS cpx*)(F.lds + HY_X); const LAS cpx* TW = (const LAS cpx*)(F.lds + HY_TW); LAS float* W3 = (LAS float*)(F.lds + HY_W3);
    const int tid = F.tid; const float* w3 = in_ptr(I_HW3) + (size_t)li * 64 * 1024; const float* H2 = WSP(float, WS_H2L) + (size_t)li * 64 * SEQ; cpx* SPEC = WSP(cpx, WS_SPEC);
    __syncthreads();
    hy_build_tw(F);
    for (int item = blockIdx.x; item < 512; item += F.G) {
        const int o = item >> 8, ch = item & 255;
        __syncthreads();
        if (tid < 128) { const int dir = tid >> 6, j = tid & 63; W3[tid] = w3[(size_t)j * 1024 + o * 512 + dir * 256 + ch]; }
        __syncthreads();
        const float delta = hy_delta(ch);
#pragma unroll 1
        for (int i = 0; i < 2; ++i) { const int l0 = 4 * tid + 2048 * i; f32x4 hf = (f32x4){0.f, 0.f, 0.f, 0.f}, hb = hf;
#pragma unroll 4
            for (int j4 = 0; j4 < 16; ++j4) { const f32x4 wf = *(const LAS f32x4*)(W3 + 4 * j4), wb = *(const LAS f32x4*)(W3 + 64 + 4 * j4);
#pragma unroll
                for (int jj = 0; jj < 4; ++jj) { const f32x4 h4 = *(const GAS f32x4*)(H2 + (size_t)(4 * j4 + jj) * SEQ + l0); hf = hf + h4 * wf[jj]; hb = hb + h4 * wb[jj]; } }
#pragma unroll
            for (int e = 0; e < 4; ++e) { const int l = l0 + e; const float win = (__expf(-((float)l * (1.f / 4095.f)) * delta) + 0.05f) * (1.f / 8192.f);
                X[hy_p(l)] = (cpx){hf[e] * win, 0.f};
                if (l == 0) X[hy_p(4096)] = (cpx){0.f, 0.f}; else X[hy_p(8192 - l)] = (cpx){hb[e] * win, 0.f}; } }
        __syncthreads();
        hy_pass1<false, false>(X, TW, tid); __syncthreads();
        hy_pass8<false, 64, 16>(X, TW, tid); __syncthreads();
        hy_pass8<false, 8, 128>(X, TW, tid); __syncthreads();
        hy_pass4(X, tid, nullptr); __syncthreads();
        cpx* dst = SPEC + (size_t)item * 8192;
#pragma unroll
        for (int i = 0; i < 16; ++i) *(GAS cpx*)(dst + tid + 512 * i) = X[hy_p(tid + 512 * i)];
    }
    __syncthreads();
}

struct HyRaw { v4u r[2][3]; unsigned e[2][3]; };
__device__ __forceinline__ void hy_load_raw(HyRaw& R, const bf16* HT, int item, int t0) { const int ch = item >> 3, bp = item & 7;
#pragma unroll
    for (int q = 0; q < 2; ++q)
#pragma unroll
        for (int k = 0; k < 3; ++k) { const bf16* row = HT + (size_t)(256 * k + ch) * NT + (size_t)(2 * bp + q) * SEQ;
            R.r[q][k] = *(const GAS v4u*)(row + t0); const unsigned pm = t0 > 0 ? (unsigned)row[t0 - 1] : 0u, pn = t0 + 8 < SEQ ? (unsigned)row[t0 + 8] : 0u; R.e[q][k] = pm | (pn << 16); }
}
__device__ __forceinline__ void hy_conv8(const v4u raw, unsigned edge, float w0, float w1, float w2, float bias, float (&out)[8]) {
    float p[10];
    p[0] = bflo(edge); p[9] = bfhi(edge);
    p[1] = bflo(raw.x); p[2] = bfhi(raw.x); p[3] = bflo(raw.y); p[4] = bfhi(raw.y); p[5] = bflo(raw.z); p[6] = bfhi(raw.z); p[7] = bflo(raw.w); p[8] = bfhi(raw.w);
#pragma unroll
    for (int e = 0; e < 8; ++e) out[e] = bias + w0 * p[e] + w1 * p[e + 1] + w2 * p[e + 2];
}

__device__ __forceinline__ void phase_hy_conv(Frame& F, int li) { WS_DECL; frame_refresh(F);
    LAS cpx* X = (LAS cpx*)(F.lds + HY_X); const LAS cpx* TW = (const LAS cpx*)(F.lds + HY_TW);
    const int tid = F.tid; const bf16* HT = WSP(bf16, WS_HT); bf16* HOT = WSP(bf16, WS_HOT); const cpx* SPEC = WSP(cpx, WS_SPEC);
    const float* cw = in_ptr(I_HCW) + li * 3 * 768; const float* cb = in_ptr(I_HCB) + li * 768; const float* dsk = in_ptr(I_HD) + li * 512;
    __syncthreads();
    hy_build_tw(F);
    const int t0 = 8 * tid;
    HyRaw cur; hy_load_raw(cur, HT, blockIdx.x < 2048 ? (int)blockIdx.x : 2047, t0);
#pragma unroll 1
    for (int item = blockIdx.x; item < 2048; item += F.G) {
        const int ch = item >> 3, bp = item & 7;
        HyRaw nxt; hy_load_raw(nxt, HT, item + F.G < 2048 ? item + F.G : item, t0);
        float v[2][8], x1[2][8], x2[2][8];
#pragma unroll
        for (int q = 0; q < 2; ++q) {
            hy_conv8(cur.r[q][0], cur.e[q][0], cw[ch], cw[768 + ch], cw[1536 + ch], cb[ch], v[q]);
            hy_conv8(cur.r[q][1], cur.e[q][1], cw[256 + ch], cw[768 + 256 + ch], cw[1536 + 256 + ch], cb[256 + ch], x1[q]);
            hy_conv8(cur.r[q][2], cur.e[q][2], cw[512 + ch], cw[768 + 512 + ch], cw[1536 + 512 + ch], cb[512 + ch], x2[q]); }
        const float d0 = dsk[ch], d1 = dsk[256 + ch];
        __syncthreads();
#pragma unroll
        for (int e = 0; e < 8; ++e) X[hy_p(t0 + e)] = (cpx){v[0][e], v[1][e]};
        __syncthreads();
        hy_conv_fft(X, TW, tid, SPEC + (size_t)ch * 8192);
        float u[2][8];
#pragma unroll
        for (int e = 0; e < 8; ++e) { const cpx y = X[hy_p(t0 + e)]; u[0][e] = x1[0][e] * (y.x + v[0][e] * d0); u[1][e] = x1[1][e] * (y.y + v[1][e] * d0); X[hy_p(t0 + e)] = (cpx){u[0][e], u[1][e]}; }
        __syncthreads();
        hy_conv_fft(X, TW, tid, SPEC + (size_t)(256 + ch) * 8192);
#pragma unroll
        for (int q = 0; q < 2; ++q) { float o[8];
#pragma unroll
            for (int e = 0; e < 8; ++e) { const cpx y = X[hy_p(t0 + e)]; o[e] = x2[q][e] * ((q == 0 ? y.x : y.y) + u[q][e] * d1); }
            v4u w; w.x = pk2(o[0], o[1]); w.y = pk2(o[2], o[3]); w.z = pk2(o[4], o[5]); w.w = pk2(o[6], o[7]);
            *(GAS v4u*)(HOT + (size_t)ch * NT + (size_t)(2 * bp + q) * SEQ + t0) = w; }
        cur = nxt;
    }
    __syncthreads();
}

__device__ __forceinline__ void phase_hy_ctx(Frame& F, int li) { WS_DECL; frame_refresh(F);
    LAS float* KL = (LAS float*)F.lds;
    LAS float* SIG = KL + 1024;
    LAS float* Z1 = SIG + 4096;
    LAS float* Z2 = Z1 + 4096;
    LAS float* W3 = Z2 + 4096;
    const int tid = F.tid; const bf16* HT = WSP(bf16, WS_HT); bf16* HOT = WSP(bf16, WS_HOT);
    const float* w3 = in_ptr(I_HW3) + (size_t)li * 64 * 1024; const float* H2 = WSP(float, WS_H2C) + (size_t)li * LCX * 64;
    const float* cw = in_ptr(I_HCW) + li * 3 * 768; const float* cb = in_ptr(I_HCB) + li * 768; const float* dsk = in_ptr(I_HD) + li * 512;
    for (int ch = blockIdx.x; ch < 256; ch += F.G) {
        __syncthreads();
        if (tid < 256) { const int od = tid >> 6, j = tid & 63; W3[tid] = w3[(size_t)j * 1024 + (od >> 1) * 512 + (od & 1) * 256 + ch]; }
        __syncthreads();
        { const int o = tid >> 8, l = tid & 255; const float* hr = H2 + (size_t)l * 64; float hf = 0.f, hb = 0.f;
#pragma unroll 4
          for (int j4 = 0; j4 < 16; ++j4) { const f32x4 hv = *(const GAS f32x4*)(hr + 4 * j4); const f32x4 wf = *(const LAS f32x4*)(W3 + (2 * o) * 64 + 4 * j4), wb = *(const LAS f32x4*)(W3 + (2 * o + 1) * 64 + 4 * j4);
              hf += hv.x * wf.x; hb += hv.x * wb.x; hf += hv.y * wf.y; hb += hv.y * wb.y; hf += hv.z * wf.z; hb += hv.z * wb.z; hf += hv.w * wf.w; hb += hv.w * wb.w; }
          const float win = __expf(-((float)l * (1.f / 255.f)) * hy_delta(ch)) + 0.05f;
          KL[o * 512 + 256 + l] = hf * win; if (l > 0) KL[o * 512 + 256 - l] = hb * win; else KL[o * 512] = 0.f; }
        { const int q = tid >> 8, t = tid & 255;
#pragma unroll 2
          for (int bp = 0; bp < 8; ++bp) { const int b = 2 * bp + q; const size_t off = (size_t)NL + (size_t)b * LCX;
            float zz[3];
#pragma unroll
            for (int k = 0; k < 3; ++k) { const int c = 256 * k + ch; const bf16* row = HT + (size_t)c * NT + off;
                const float pm = t > 0 ? bf2f(row[t - 1]) : 0.f, p0 = bf2f(row[t]), pp = t + 1 < LCX ? bf2f(row[t + 1]) : 0.f;
                zz[k] = cb[c] + cw[c] * pm + cw[768 + c] * p0 + cw[1536 + c] * pp; }
            SIG[b * 256 + t] = zz[0]; Z1[b * 256 + t] = zz[1]; Z2[b * 256 + t] = zz[2]; } }
        __syncthreads();
        const float d0 = dsk[ch], d1 = dsk[256 + ch]; const int t0 = 4 * (tid & 63);
#pragma unroll 1
        for (int rd = 0; rd < 2; ++rd) { const int b = 8 * rd + (tid >> 6); const size_t off = (size_t)NL + (size_t)b * LCX;
            f32x4 u;
#pragma unroll 1
            for (int o = 0; o < 2; ++o) { const LAS float* kp = KL + o * 512 + t0 + 252; const LAS float* sp = SIG + b * 256;
                f32x4 acc = (f32x4){0.f, 0.f, 0.f, 0.f};
#pragma unroll 4
                for (int s0 = 0; s0 < 256; s0 += 4) { const f32x4 k0 = *(const LAS f32x4*)(kp - s0), k1 = *(const LAS f32x4*)(kp - s0 + 4), sg = *(const LAS f32x4*)(sp + s0);
                    acc.x += k1.x * sg.x; acc.x += k0.w * sg.y; acc.x += k0.z * sg.z; acc.x += k0.y * sg.w;
                    acc.y += k1.y * sg.x; acc.y += k1.x * sg.y; acc.y += k0.w * sg.z; acc.y += k0.z * sg.w;
                    acc.z += k1.z * sg.x; acc.z += k1.y * sg.y; acc.z += k1.x * sg.z; acc.z += k0.w * sg.w;
                    acc.w += k1.w * sg.x; acc.w += k1.z * sg.y; acc.w += k1.y * sg.z; acc.w += k1.x * sg.w; }
                if (o == 0) { const f32x4 z0 = *(const LAS f32x4*)(SIG + b * 256 + t0), z1 = *(const LAS f32x4*)(Z1 + b * 256 + t0); u = z1 * (acc + z0 * d0);
                    __syncthreads();
                    *(LAS f32x4*)(SIG + b * 256 + t0) = u;
                    __syncthreads(); }
                else { const f32x4 z2 = *(const LAS f32x4*)(Z2 + b * 256 + t0); const f32x4 y = z2 * (acc + u * d1);
                    v2u w; w.x = pk2(y.x, y.y); w.y = pk2(y.z, y.w); *(GAS v2u*)(HOT + (size_t)ch * NT + off + t0) = w; } }
        }
    }
    __syncthreads();
}

constexpr int HF_LD = 72;
__device__ __forceinline__ void phase_fin_hyena(Frame& F, int li) { WS_DECL; frame_refresh(F);
    LAS bf16* T = (LAS bf16*)F.lds;
    const int nrows = li == DEPTH - 1 ? NL : NT; const int tid = F.tid, lane = F.lane, wave = F.wave; const bf16* HOT = WSP(bf16, WS_HOT); bf16* MIX = WSP(bf16, WS_A1);
    const f32x4 g4 = *(const GAS f32x4*)(in_ptr(I_HON) + li * 256 + 4 * lane);
    for (int item = blockIdx.x; item < nrows / 64; item += F.G) { const int m0 = item * 64;
        __syncthreads();
        { const int ch = tid >> 1, hf = tid & 1; const bf16* src = HOT + (size_t)ch * NT + m0 + 32 * hf;
#pragma unroll
          for (int k = 0; k < 4; ++k) *(LAS v4u*)(T + ch * HF_LD + 32 * hf + 8 * k) = *(const GAS v4u*)(src + 8 * k); }
        __syncthreads();
        for (int i = 0; i < 8; ++i) { const int tl = wave * 8 + i;
            f32x4 x; x.x = bf2f(T[(4 * lane) * HF_LD + tl]); x.y = bf2f(T[(4 * lane + 1) * HF_LD + tl]); x.z = bf2f(T[(4 * lane + 2) * HF_LD + tl]); x.w = bf2f(T[(4 * lane + 3) * HF_LD + tl]);
            const float r = __builtin_amdgcn_rsqf(wave_sum(x.x * x.x + x.y * x.y + x.z * x.z + x.w * x.w) * (1.f / 256.f) + 1e-6f);
            v2u o; o.x = pk2(x.x * r * g4.x, x.y * r * g4.y); o.y = pk2(x.z * r * g4.z, x.w * r * g4.w); *(GAS v2u*)(MIX + (size_t)(m0 + tl) * D + 768 + 4 * lane) = o; }
    }
    __syncthreads();
}
#define MIX_HYENA 1

#define GRID_BAR() do { XcdBarrier bar_; bar_.leader = (F.wave == 0 && mk_lane() == 0); bar_.bar = (unsigned*)(ws_ptr() + WS_CTL) + CW_BAR; bar_.x = xb_xcc_id(); bar_.st = (volatile LAS unsigned*)(F.lds + LDSCTL_OFF) + 8; xcd_barrier(bar_); } while (0)

#ifndef PROBE_MASK
#define PROBE_MASK 0
#endif
#define TS_MARK(k) do { if (PROBE_MASK && blockIdx.x == 0 && F.wave == 0 && mk_lane() == 0) { LAS unsigned long long* ts_ = (LAS unsigned long long*)(F.lds + LDSCTL_OFF + 128); const unsigned long long now_ = wall_clock64(); if ((PROBE_MASK >> (k)) & 1) ts_[1] += now_ - ts_[0]; ts_[0] = now_; } } while (0)
template <int li>
__device__ __forceinline__ void layer_fwd(Frame& F) {
        const int nrows = li == DEPTH - 1 ? NL : NT; unsigned char* const ws = ws_ptr();
        phase_hy_spec(F, li);
        TS_MARK(23);
        { pg8::Gemm g{WSP(bf16, WS_A1), WSP(bf16, WS_WINT) + (size_t)li * PCOLS * D, NT, PCOLS, D, WSP(bf16, WS_WHYT) + (size_t)li * HYC * D, WSP(bf16, WS_A1)};
          pg8::DualOrder S; S.init(NT, PCOLS, HYC, NT, F.G, (int)blockIdx.x);
          pg8::EpiStore2 E{WSP(bf16, WS_P), PCOLS, WSP(bf16, WS_HT), NT};
          pg8::gemm_phase<pg8::EpiStore2, pg8::DualOrder, true, true>(F.lds, g, S, E, F.wave); }
        GRID_BAR();
        TS_MARK(0);
        phase_rwkv_r0(F, li);
        TS_MARK(10);
        phase_mla_prep(F, li);
        TS_MARK(11);
        phase_lru<1>(F, li);
        __syncthreads();
        TS_MARK(12);
        phase_hy_conv(F, li);
        TS_MARK(13);
        if (li < DEPTH - 1) phase_hy_ctx(F, li);
        TS_MARK(14);
        GRID_BAR();
        TS_MARK(1);
        phase_rwkv_scan(F, li);
        __syncthreads();
        TS_MARK(15);
        phase_attn(F, li);
        __syncthreads();
        TS_MARK(16);
        phase_lru<3>(F, li);
        TS_MARK(17);
        GRID_BAR();
        TS_MARK(2);
        phase_fin_mla(F, li);
        TS_MARK(18);
        phase_fin_rwkv(F, li);
        TS_MARK(19);
        phase_fin_hyena(F, li);
        TS_MARK(20);
        GRID_BAR();
        TS_MARK(3);
        { pg8::Gemm g{WSP(bf16, WS_A1), WSP(bf16, WS_WOUTT) + (size_t)li * D * D, nrows, D, D}; pg8::StaticOrder S; S.init(nrows, D, F.G, (int)blockIdx.x);
          pg8::EpiStore E{WSP(bf16, WS_Y), D, 0, D / 256};
          pg8::gemm_phase<pg8::EpiStore, pg8::StaticOrder, true, true>(F.lds, g, S, E, F.wave); }
        GRID_BAR();
        TS_MARK(4);
        phase_ln1<true>(F, li);
        TS_MARK(21);
        if (li & 1) phase_moe_weights(F, li);
        TS_MARK(22);
        GRID_BAR();
        TS_MARK(5);
        if (!(li & 1)) {
            const int j = li >> 1;
#if DENSE_FFN2_F8
            { pg8::Gemm g{(const pg8::bf16_t*)WSP(unsigned char, WS_A1), (const pg8::bf16_t*)(WSP(unsigned char, WS_WGUT) + (size_t)j * 2 * FFD * D), nrows, 2 * FFD, D / 2}; pg8::StaticOrder S; S.init(nrows, 2 * FFD, F.G, (int)blockIdx.x);
              pg8::EpiSwiGLU8 E{WSP(unsigned char, WS_H), FFD, 0, 2 * FFD / 256};
              pg8::gemm_phase<pg8::EpiSwiGLU8, pg8::StaticOrder, true, true, true, 124>(F.lds, g, S, E, F.wave); }
            GRID_BAR();
            TS_MARK(6);
            { pg8::Gemm g{(const pg8::bf16_t*)WSP(unsigned char, WS_H), (const pg8::bf16_t*)(WSP(unsigned char, WS_WDT) + (size_t)j * D * FFD), nrows, D, FFD / 2}; pg8::StaticOrder S; S.init(nrows, D, F.G, (int)blockIdx.x);
              pg8::EpiStore E{WSP(bf16, WS_Y), D, 0, D / 256};
              pg8::gemm_phase<pg8::EpiStore, pg8::StaticOrder, true, true, true, 123>(F.lds, g, S, E, F.wave); }
            GRID_BAR();
            TS_MARK(7);
#else
            { pg8::Gemm g{(const pg8::bf16_t*)WSP(unsigned char, WS_A1), (const pg8::bf16_t*)(WSP(unsigned char, WS_WGUT) + (size_t)j * 2 * FFD * D), nrows, 2 * FFD, D / 2}; pg8::StaticOrder S; S.init(nrows, 2 * FFD, F.G, (int)blockIdx.x);
              pg8::EpiSwiGLU E{WSP(bf16, WS_H), FFD, 0, 2 * FFD / 256};
              pg8::gemm_phase<pg8::EpiSwiGLU, pg8::StaticOrder, true, true, true, 124>(F.lds, g, S, E, F.wave); }
            GRID_BAR();
            TS_MARK(6);
            { pg8::Gemm g{WSP(bf16, WS_H), WSP(bf16, WS_WDT) + (size_t)j * D * FFD, nrows, D, FFD}; pg8::StaticOrder S; S.init(nrows, D, F.G, (int)blockIdx.x);
              pg8::EpiStore E{WSP(bf16, WS_Y), D, 0, D / 256};
              pg8::gemm_phase<pg8::EpiStore, pg8::StaticOrder, true, true>(F.lds, g, S, E, F.wave); }
            GRID_BAR();
            TS_MARK(7);
#endif
        } else {
            phase_moe_slots(F, li);
            GRID_BAR();
            TS_MARK(6);
            const int ntiles = __builtin_amdgcn_readfirstlane(((LAS int*)(F.lds + LDS_MOEI))[48]);
            const PG8_LAS unsigned char* tile_e = (const PG8_LAS unsigned char*)(F.lds + LDS_TILEE);
#pragma unroll 1
            for (int ch = 0; ch < MOE_NCHUNK; ++ch) {
                const int t0 = ch * MOE_CHUNK_TILES; int nM = ntiles - t0; nM = nM < 0 ? 0 : (nM > MOE_CHUNK_TILES ? MOE_CHUNK_TILES : nM);
                { pg8::Gemm g{(const pg8::bf16_t*)WSP(unsigned char, WS_XS8), (const pg8::bf16_t*)WSP(unsigned char, WS_M8GU), 0, 0, D / 2}; pg8::MoeOrder S; S.init(nM, 2 * FFE / 256, F.G, (int)blockIdx.x, t0, t0, tile_e);
                  pg8::EpiSwiGLU8 E{WSP(unsigned char, WS_HM8), FFE, t0, 2 * FFE / 256};
                  pg8::gemm_phase<pg8::EpiSwiGLU8, pg8::MoeOrder, true, true, true, 124>(F.lds, g, S, E, F.wave); }
                GRID_BAR();
                TS_MARK(7);
                { pg8::Gemm g{(const pg8::bf16_t*)WSP(unsigned char, WS_HM8), (const pg8::bf16_t*)WSP(unsigned char, WS_M8D), 0, 0, FFE / 2}; pg8::MoeOrder S; S.init(nM, D / 256, F.G, (int)blockIdx.x, t0, 0, tile_e);
                  pg8::EpiStore E{WSP(bf16, WS_Y2), D, t0, D / 256};
                  pg8::gemm_phase<pg8::EpiStore, pg8::MoeOrder, true, true, true, 123>(F.lds, g, S, E, F.wave); }
                GRID_BAR();
                TS_MARK(7);
            }
        }
        phase_ln2<true>(F, li);
        if (li < DEPTH - 1) GRID_BAR();
        TS_MARK(8);
}

__global__ void __launch_bounds__(NTHR, 2) mk_fwd(Args a) {
    extern __shared__ __attribute__((aligned(16))) unsigned char lds_raw[];
    Frame F; F.lds = (LAS unsigned char*)lds_raw; F.tid = threadIdx.x; F.lane = F.tid & 63; F.wave = __builtin_amdgcn_readfirstlane(F.tid >> 6); F.G = gridDim.x;
    for (int u = F.tid; u < (LDS_BYTES - LDSCTL_OFF) / 4; u += NTHR) ((LAS unsigned*)(F.lds + LDSCTL_OFF))[u] = 0u;
    __syncthreads();
    (void)xcd_barrier_post((unsigned*)(ws_ptr() + WS_CTL) + CW_BAR, (volatile LAS unsigned*)(F.lds + LDSCTL_OFF) + 8, F.tid == 0);

    TS_MARK(31);
    phase_pro0(F);
    TS_MARK(24);
    phase_pro0b(F);
    phase_pro0c(F);
    phase_pro0d(F);
    phase_pro0e(F);
    TS_MARK(25);
    GRID_BAR();
    TS_MARK(26);
    phase_hin0(F);
    GRID_BAR();
    TS_MARK(9);
    layer_fwd<0>(F); layer_fwd<1>(F); layer_fwd<2>(F); layer_fwd<3>(F);
    if (PROBE_MASK && blockIdx.x == 0 && F.wave == 0 && mk_lane() == 0) { LAS unsigned long long* ts_ = (LAS unsigned long long*)(F.lds + LDSCTL_OFF + 128); const unsigned long long t0_ = wall_clock64(), w_ = ts_[1]; while (wall_clock64() - t0_ < w_) __builtin_amdgcn_s_sleep(8); }
}

extern "C" void kernel_launch(void* const* d_in, const int* in_sizes, int n_in, void* d_out, int out_size, void* d_ws, size_t ws_size, hipStream_t stream) {
    static int grid = 0;
    if (grid == 0) {
        if (n_in != N_INPUTS || out_size != NL * D || ws_size < WS_END) { fprintf(stderr, "kernel_launch: unexpected shapes (n_in %d out %d ws %zu)\n", n_in, out_size, ws_size); grid = -1; return; }
        int dev = 0, cus = 0, per_cu = 0;
        if (hipGetDevice(&dev) != hipSuccess || hipDeviceGetAttribute(&cus, hipDeviceAttributeMultiprocessorCount, dev) != hipSuccess) { grid = -1; return; }
        if (hipFuncSetAttribute((const void*)mk_fwd, hipFuncAttributeMaxDynamicSharedMemorySize, LDS_BYTES) != hipSuccess) { fprintf(stderr, "kernel_launch: hipFuncSetAttribute failed\n"); grid = -1; return; }
        if (hipOccupancyMaxActiveBlocksPerMultiprocessor(&per_cu, (const void*)mk_fwd, NTHR, LDS_BYTES) != hipSuccess || per_cu < 1) fprintf(stderr, "kernel_launch: occupancy query reports %d\n", per_cu);
        (void)hipGetLastError();
        grid = cus > 256 ? 256 : cus;
    }
    if (grid < 0) return;
    if (hipMemsetAsync((char*)d_ws + WS_CTL, 0, CTL_ZERO_BYTES, stream) != hipSuccess) return;
    Args a{};
    for (int i = 0; i < N_INPUTS; ++i) a.in[i] = (const float*)d_in[i];
    a.out = (float*)d_out; a.ws = (unsigned char*)d_ws;
    hipLaunchKernelGGL(mk_fwd, dim3(grid), dim3(NTHR), LDS_BYTES, stream, a);
    const hipError_t le = hipPeekAtLastError();
    if (le != hipSuccess) fprintf(stderr, "kernel_launch: launch failed: %s\n", hipGetErrorName(le));
}
```

```cpp
#include <hip/hip_runtime.h>
#include <cstdio>
#include <cstdint>
#define GAS __attribute__((address_space(1)))
#define LAS __attribute__((address_space(3)))
__device__ __forceinline__ int mk_lane() { int l; asm volatile("v_mbcnt_lo_u32_b32 %0, -1, 0\n\tv_mbcnt_hi_u32_b32 %0, -1, %0" : "=v"(l)); return l; }
namespace pg8 {
#define PG8_LAS __attribute__((address_space(3)))
typedef unsigned short bf16_t;
typedef short bf16x8 __attribute__((ext_vector_type(8)));
typedef float f32x4 __attribute__((ext_vector_type(4)));
typedef unsigned u32x4 __attribute__((ext_vector_type(4)));
constexpr int BM = 256, BK = 64, HALF = 128, HTB = HALF * BK * 2  , STAGE_BYTES = 8 * HTB, NXCD = 8, WGM = 16;

__host__ __device__ __forceinline__ int lds_byte(int r, int c) { const int st = (r >> 4) * 2 + (c >> 5), rr = r & 15, cc = c & 31, ob = rr * 64 + cc * 2; return st * 1024 + (ob ^ (((ob >> 9) & 1) << 5)); }
__host__ __device__ __forceinline__ void stage_rc(int b, int& R, int& C) { const int st = b / 1024, sb = b % 1024, swz = sb ^ (((sb >> 9) & 1) << 5); R = (st >> 1) * 16 + swz / 64; C = (st & 1) * 32 + (swz % 64) / 2; }
__host__ __device__ __forceinline__ int perm32(int rho) { const int n = rho >> 4, i = rho & 15; return 8 * (i >> 2) + 4 * n + (i & 3); }

struct Unit { int pm, pn, g; };
struct Gemm { const bf16_t* A; const bf16_t* Bt; int M, N, K; const bf16_t* A2 = nullptr; const bf16_t* Bt2 = nullptr; };

struct StaticOrder {
    int nM, nN, nwg, G, c;
    __host__ __device__ void init(int M, int N, int G_, int c_) { nM = M / BM; nN = N / BM; nwg = nM * nN; G = G_; c = c_; }
    __host__ __device__ bool next(int i, Unit& u) const {
        const long L = (long)i * G + c; if (L >= nwg) return false;
        int wgid = (int)L; { const int q = nwg / NXCD, r = nwg % NXCD, xcd = wgid % NXCD, off = wgid / NXCD; wgid = (xcd < r ? xcd * (q + 1) : r * (q + 1) + (xcd - r) * q) + off; }
        const int nig = WGM * nN, gid = wgid / nig, fm = gid * WGM, gsz = (nM - fm) < WGM ? (nM - fm) : WGM;
        u.pm = fm + ((wgid % nig) % gsz); u.pn = (wgid % nig) / gsz; u.g = 0; return true;
    }
    __device__ __forceinline__ void a_ready(const Unit&) const {}
    __device__ __forceinline__ void done(const Unit&) const {}
};

__device__ __forceinline__ unsigned cvt_pk_bf16(float lo, float hi) { unsigned r; asm volatile("v_cvt_pk_bf16_f32 %0, %1, %2" : "=v"(r) : "v"(lo), "v"(hi)); return r; }
typedef float f32x2 __attribute__((ext_vector_type(2)));
__device__ __forceinline__ f32x2 gelu_pk(f32x2 v) {
    const f32x2 av = __builtin_elementwise_abs(v), d = av * 0.2316418882f + 1.0f;
    f32x2 t; t.x = __builtin_amdgcn_rcpf(d.x); t.y = __builtin_amdgcn_rcpf(d.y);
    f32x2 q = t * 0.5307027145f + (-0.7265760135f); q = q * t + 0.7107068705f; q = q * t + (-0.142248368f); q = q * t + 0.127414796f; q = q * t;
    const f32x2 s = (v * v) * (-0.72134752044f);
    f32x2 e; e.x = __builtin_amdgcn_exp2f(s.x); e.y = __builtin_amdgcn_exp2f(s.y);
    const f32x2 m = v * (q * e), r = v - m;
    f32x2 o; o.x = v.x < 0.f ? m.x : r.x; o.y = v.y < 0.f ? m.y : r.y; return o;
}

template <int ACT  > struct EpiBf16 {
    static constexpr bool PERM = true, AFTER_DRAIN = false; static_assert(ACT == 0 || ACT == 1, "EpiBf16: ACT is 0 (none) or 1 (gelu_pk)");
    bf16_t* O; int ldc; const float* bias; int split_cols; size_t split_stride; float scale0;
    __device__ __forceinline__ void operator()(const f32x4 (&acc)[2][2][4][2], const Unit& u, int wr, int wc, int fr, int fq) const {
        const int row0 = u.pm * BM + wr * 64 + fr; int colt = u.pn * BM; bf16_t* base = O;
        float sc = 1.f; if (split_cols) { const int t = colt / split_cols; base += (size_t)t * split_stride; colt -= t * split_cols; if (t == 0) sc = scale0; }
        const int col0 = colt + wc * 32 + 8 * fq, bcol0 = u.pn * BM + wc * 32 + 8 * fq;
        f32x4 bv[2][2];
#pragma unroll
        for (int bj = 0; bj < 2; ++bj)
#pragma unroll
            for (int n = 0; n < 2; ++n) bv[bj][n] = bias ? *(const f32x4*)(bias + bcol0 + bj * HALF + 4 * n) : (f32x4){0.f, 0.f, 0.f, 0.f};
#pragma unroll
        for (int ai = 0; ai < 2; ++ai)
#pragma unroll
            for (int m = 0; m < 4; ++m) { bf16_t* rowp = base + (size_t)(row0 + ai * HALF + m * 16) * ldc + col0;
#pragma unroll
                for (int bj = 0; bj < 2; ++bj) { f32x4 v0 = acc[ai][bj][m][0] + bv[bj][0], v1 = acc[ai][bj][m][1] + bv[bj][1];
                    if (ACT == 1) { f32x2 a = gelu_pk((f32x2){v0[0], v0[1]}), b = gelu_pk((f32x2){v0[2], v0[3]}), c = gelu_pk((f32x2){v1[0], v1[1]}), d = gelu_pk((f32x2){v1[2], v1[3]});
                        v0 = (f32x4){a.x, a.y, b.x, b.y}; v1 = (f32x4){c.x, c.y, d.x, d.y}; }
                    v0 = v0 * sc; v1 = v1 * sc; u32x4 w; w.x = cvt_pk_bf16(v0[0], v0[1]); w.y = cvt_pk_bf16(v0[2], v0[3]); w.z = cvt_pk_bf16(v1[0], v1[1]); w.w = cvt_pk_bf16(v1[2], v1[3]);
                    *(u32x4*)(rowp + bj * HALF) = w; } }
    }
};
typedef int pg8_v8i __attribute__((ext_vector_type(8))); typedef int pg8_v4i __attribute__((ext_vector_type(4)));
__device__ __forceinline__ pg8_v8i pg8_cat8(bf16x8 a, bf16x8 b) { return __builtin_shufflevector(__builtin_bit_cast(pg8_v4i, a), __builtin_bit_cast(pg8_v4i, b), 0, 1, 2, 3, 4, 5, 6, 7); }
template <class Epi, class Sched, bool ALIGN_EPI = false, bool SP2 = false, bool F8 = false, int WSCALE = 127>
__device__ __forceinline__ void gemm_phase(PG8_LAS unsigned char* lds, const Gemm g, const Sched& S, const Epi& E, int wave_idx) {
    int tid_ = wave_idx * 64 + mk_lane(); asm volatile("" : "+v"(tid_));
    const int tid = tid_, wid = __builtin_amdgcn_readfirstlane(tid >> 6), lane = tid & 63, wr = wid >> 2, wc = wid & 3, fr = lane & 15, fq = lane >> 4;
    const int K = g.K, nt = K / BK;
    unsigned voffA[2], voffB[2];
#pragma unroll
    for (int i = 0; i < 2; ++i) { int R, C; stage_rc(tid * 16 + i * 8192, R, C); const int Rb = Epi::PERM ? ((R & ~31) + perm32(R & 31)) : R;
        voffA[i] = (unsigned)(R * K + C) * 2u; voffB[i] = (unsigned)(Rb * K + C) * 2u; }
    const size_t kstep = (size_t)(BK * 2);
    const size_t hstep = (size_t)HALF * K * 2;
    const size_t tstep = 2 * hstep;
    const unsigned ldsw = (unsigned)wid * 1024u;
    int aoffk[2], boffk[2];
    if constexpr (F8) { aoffk[0] = lds_byte(wr * 64 + fr, (2 * (fq & 1)) * 8) + (fq >> 1) * 1024; aoffk[1] = lds_byte(wr * 64 + fr, (2 * (fq & 1) + 1) * 8) + (fq >> 1) * 1024;
        boffk[0] = lds_byte(wc * 32 + fr, (2 * (fq & 1)) * 8) + (fq >> 1) * 1024; boffk[1] = lds_byte(wc * 32 + fr, (2 * (fq & 1) + 1) * 8) + (fq >> 1) * 1024; }
    else { aoffk[0] = lds_byte(wr * 64 + fr, fq * 8); aoffk[1] = aoffk[0] + 1024; boffk[0] = lds_byte(wc * 32 + fr, fq * 8); boffk[1] = boffk[0] + 1024; }
#define PG8_SA(b, h) (((b) * 2 + (h)) * HTB)
#define PG8_SB(b, h) ((4 + (b) * 2 + (h)) * HTB)
#define PG8_STAGE(bufoff, gbase, voff) do { const char* gb_ = (const char*)(gbase); _Pragma("unroll") for (int _i = 0; _i < 2; ++_i) { unsigned keep_; \
        asm volatile("s_mov_b32 %0, m0\n\ts_mov_b32 m0, %2\n\ts_nop 0\n\tglobal_load_lds_dwordx4 %1, %3\n\ts_mov_b32 m0, %0" : "=&s"(keep_) : "v"((voff)[_i]), "s"((unsigned)(size_t)(lds + (bufoff) + ldsw + _i * 8192)), "s"(gb_) : "memory"); } } while (0)
#define PG8_LDA(dst, b, h) do { if constexpr (F8) { _Pragma("unroll") for (int m = 0; m < 4; ++m) dst##8[m] = *(const PG8_LAS pg8_v8i*)(lds + PG8_SA(b, h) + aoffk[0] + m * 2048); } else { _Pragma("unroll") for (int m = 0; m < 4; ++m) _Pragma("unroll") for (int k = 0; k < 2; ++k) dst[m][k] = *(const PG8_LAS bf16x8*)(lds + PG8_SA(b, h) + aoffk[k] + m * 2048); } } while (0)
#define PG8_LDB(dst, b, h) do { if constexpr (F8) { _Pragma("unroll") for (int n = 0; n < 2; ++n) dst##8[n] = *(const PG8_LAS pg8_v8i*)(lds + PG8_SB(b, h) + boffk[0] + n * 2048); } else { _Pragma("unroll") for (int n = 0; n < 2; ++n) _Pragma("unroll") for (int k = 0; k < 2; ++k) dst[n][k] = *(const PG8_LAS bf16x8*)(lds + PG8_SB(b, h) + boffk[k] + n * 2048); } } while (0)
#define PG8_MMA(ai, bj, At, Bt) do { __builtin_amdgcn_s_setprio(1); _Pragma("unroll") for (int m = 0; m < 4; ++m) _Pragma("unroll") for (int n = 0; n < 2; ++n) { \
        if constexpr (F8) acc[ai][bj][m][n] = __builtin_amdgcn_mfma_scale_f32_16x16x128_f8f6f4(Bt##8[n], At##8[m], acc[ai][bj][m][n], 0, 0, 0, wsc_, 0, wsc_);     \
        else { _Pragma("unroll") for (int k = 0; k < 2; ++k) acc[ai][bj][m][n] = __builtin_amdgcn_mfma_f32_16x16x32_bf16(Bt[n][k], At[m][k], acc[ai][bj][m][n], 0, 0, 0); } } __builtin_amdgcn_s_setprio(0); } while (0)
#define PG8_WAIT_V(n) asm volatile("s_waitcnt vmcnt(" #n ")" ::: "memory")
#define PG8_WAIT_L(n) asm volatile("s_waitcnt lgkmcnt(" #n ")" ::: "memory")
#define PG8_BAR __builtin_amdgcn_s_barrier()
#define PG8_SCHED __builtin_amdgcn_sched_barrier(0)
    int wsc_ = WSCALE; asm volatile("" : "+v"(wsc_));
    Unit cur, nxt; int ui = 0;
    if (!S.next(0, cur)) return;
    f32x4 acc[2][2][4][2];
#pragma unroll
    for (int a = 0; a < 2; ++a)
#pragma unroll
        for (int b = 0; b < 2; ++b)
#pragma unroll
            for (int m = 0; m < 4; ++m)
#pragma unroll
                for (int n = 0; n < 2; ++n) acc[a][b][m][n] = (f32x4){0.f, 0.f, 0.f, 0.f};
    bf16x8 At[4][2], B0[2][2], B1[2][2];
    pg8_v8i At8[4], B08[2], B18[2];
    const char* cA = (const char*)(cur.g ? g.A2 : g.A) + (size_t)cur.pm * tstep; const char* cB = (const char*)(cur.g ? g.Bt2 : g.Bt) + (size_t)cur.pn * tstep;
    S.a_ready(cur);
    if constexpr (SP2) {
        PG8_STAGE(PG8_SB(0, 0), cB, voffB); PG8_STAGE(PG8_SB(0, 1), cB + hstep, voffB); PG8_STAGE(PG8_SA(0, 0), cA, voffA); PG8_STAGE(PG8_SA(0, 1), cA + hstep, voffA);
        if (wr == 1) PG8_BAR;
        PG8_WAIT_V(2); PG8_BAR;
        PG8_STAGE(PG8_SB(1, 0), cB + kstep, voffB); PG8_STAGE(PG8_SA(1, 0), cA + kstep, voffA); PG8_STAGE(PG8_SB(1, 1), cB + hstep + kstep, voffB);
        PG8_WAIT_V(6); PG8_BAR;
    } else {
        PG8_STAGE(PG8_SB(0, 0), cB, voffB); PG8_STAGE(PG8_SA(0, 0), cA, voffA); PG8_STAGE(PG8_SB(0, 1), cB + hstep, voffB); PG8_STAGE(PG8_SA(0, 1), cA + hstep, voffA);
        if (wr == 1) PG8_BAR;
        PG8_WAIT_V(4); PG8_BAR;
        PG8_STAGE(PG8_SB(1, 0), cB + kstep, voffB); PG8_STAGE(PG8_SA(1, 0), cA + kstep, voffA); PG8_STAGE(PG8_SB(1, 1), cB + hstep + kstep, voffB);
        PG8_WAIT_V(6); PG8_BAR;
    }
    for (;;) {
        const bool has_next = S.next(ui + 1, nxt);
        const char* nA = has_next ? (const char*)(nxt.g ? g.A2 : g.A) + (size_t)nxt.pm * tstep : cA; const char* nB = has_next ? (const char*)(nxt.g ? g.Bt2 : g.Bt) + (size_t)nxt.pn * tstep : cB;
#pragma unroll 1
        for (int t = 0; t < nt; t += 2) {
            const bool last = (t == nt - 2);
            const char* a1 = cA + (size_t)(t + 1) * kstep;
            const char* a2 = last ? nA : cA + (size_t)(t + 2) * kstep; const char* b2 = last ? nB : cB + (size_t)(t + 2) * kstep;
            const char* a3 = a2 + kstep; const char* b3 = b2 + kstep;
            if (last && has_next) S.a_ready(nxt);
            if constexpr (SP2) {
            PG8_LDB(B0, 0, 0); PG8_LDB(B1, 0, 1); PG8_SCHED; PG8_LDA(At, 0, 0); PG8_STAGE(PG8_SA(1, 1), a1 + hstep, voffA);
            PG8_WAIT_V(8); PG8_WAIT_L(0); PG8_BAR; PG8_MMA(0, 0, At, B0); PG8_MMA(0, 1, At, B1); PG8_BAR; PG8_SCHED;
            PG8_LDA(At, 0, 1); PG8_STAGE(PG8_SB(0, 0), b2, voffB); PG8_STAGE(PG8_SB(0, 1), b2 + hstep, voffB); PG8_STAGE(PG8_SA(0, 0), a2, voffA);
            PG8_WAIT_V(8); PG8_WAIT_L(0); PG8_BAR; PG8_MMA(1, 0, At, B0); PG8_MMA(1, 1, At, B1); PG8_BAR; PG8_SCHED;
            PG8_LDB(B0, 1, 0); PG8_LDB(B1, 1, 1); PG8_SCHED; PG8_LDA(At, 1, 0); PG8_STAGE(PG8_SA(0, 1), a2 + hstep, voffA);
            PG8_WAIT_V(8); PG8_WAIT_L(0); PG8_BAR; PG8_MMA(0, 0, At, B0); PG8_MMA(0, 1, At, B1); PG8_BAR; PG8_SCHED;
            PG8_LDA(At, 1, 1); PG8_STAGE(PG8_SB(1, 0), b3, voffB); PG8_STAGE(PG8_SB(1, 1), b3 + hstep, voffB); PG8_STAGE(PG8_SA(1, 0), a3, voffA);
            PG8_WAIT_V(8); PG8_WAIT_L(0); PG8_BAR; PG8_MMA(1, 0, At, B0); PG8_MMA(1, 1, At, B1); PG8_BAR; PG8_SCHED;
            } else {
            PG8_LDB(B0, 0, 0); PG8_SCHED; PG8_LDA(At, 0, 0); PG8_STAGE(PG8_SA(1, 1), a1 + hstep, voffA);
            PG8_WAIT_L(8); PG8_BAR; PG8_WAIT_L(0); PG8_MMA(0, 0, At, B0); PG8_BAR; PG8_SCHED;
            PG8_LDB(B1, 0, 1); PG8_STAGE(PG8_SB(0, 0), b2, voffB);
            PG8_BAR; PG8_WAIT_L(0); PG8_MMA(0, 1, At, B1); PG8_BAR;
            PG8_LDA(At, 0, 1); PG8_STAGE(PG8_SA(0, 0), a2, voffA);
            PG8_BAR; PG8_WAIT_L(0); PG8_MMA(1, 0, At, B0); PG8_BAR; PG8_SCHED;
            PG8_STAGE(PG8_SB(0, 1), b2 + hstep, voffB);
            PG8_WAIT_V(6); PG8_BAR; PG8_MMA(1, 1, At, B1); PG8_BAR;
            PG8_LDB(B0, 1, 0); PG8_SCHED; PG8_LDA(At, 1, 0); PG8_STAGE(PG8_SA(0, 1), a2 + hstep, voffA);
            PG8_WAIT_L(8); PG8_BAR; PG8_WAIT_L(0); PG8_MMA(0, 0, At, B0); PG8_BAR; PG8_SCHED;
            PG8_LDB(B1, 1, 1); PG8_STAGE(PG8_SB(1, 0), b3, voffB);
            PG8_BAR; PG8_WAIT_L(0); PG8_MMA(0, 1, At, B1); PG8_BAR;
            PG8_LDA(At, 1, 1); PG8_STAGE(PG8_SA(1, 0), a3, voffA);
            PG8_BAR; PG8_WAIT_L(0); PG8_MMA(1, 0, At, B0); PG8_BAR; PG8_SCHED;
            PG8_STAGE(PG8_SB(1, 1), b3 + hstep, voffB);
            PG8_WAIT_V(6); PG8_BAR; PG8_MMA(1, 1, At, B1); PG8_BAR;
            }
        }
        if constexpr (ALIGN_EPI) { if (wr == 0) PG8_BAR; }
        if constexpr (!Epi::AFTER_DRAIN) { { int pm_ = cur.pm, pn_ = cur.pn; asm volatile("" : "+s"(pm_), "+s"(pn_)); cur.pm = pm_; cur.pn = pn_; }
            { int t2_ = mk_lane(); asm volatile("" : "+v"(t2_)); E(acc, cur, wr, wc, t2_ & 15, (t2_ & 63) >> 4); }
            S.done(cur); }
        if (!has_next) break;
#pragma unroll
        for (int a = 0; a < 2; ++a)
#pragma unroll
            for (int b = 0; b < 2; ++b)
#pragma unroll
                for (int m = 0; m < 4; ++m)
#pragma unroll
                    for (int n = 0; n < 2; ++n) acc[a][b][m][n] = (f32x4){0.f, 0.f, 0.f, 0.f};
        cur = nxt; cA = nA; cB = nB; ++ui;
        if constexpr (ALIGN_EPI) { if (wr == 1) PG8_BAR; }
    }
    PG8_WAIT_V(0);
    if constexpr (!ALIGN_EPI) { if (wr == 0) PG8_BAR; }
    PG8_BAR;
    if constexpr (Epi::AFTER_DRAIN) { E.fused(acc, cur, wr, wc, fr, fq, lds, wid, lane); S.done(cur); }
#undef PG8_SA
#undef PG8_SB
#undef PG8_STAGE
#undef PG8_LDA
#undef PG8_LDB
#undef PG8_MMA
#undef PG8_WAIT_V
#undef PG8_WAIT_L
#undef PG8_BAR
#undef PG8_SCHED
}
}

typedef unsigned short bf16;
typedef unsigned v4u __attribute__((ext_vector_type(4)));
typedef unsigned v2u __attribute__((ext_vector_type(2)));
typedef float f32x4 __attribute__((ext_vector_type(4)));
typedef float f32x2 __attribute__((ext_vector_type(2)));
typedef float f32x16 __attribute__((ext_vector_type(16)));
typedef short bf16x8 __attribute__((ext_vector_type(8)));
typedef short s16x4 __attribute__((ext_vector_type(4)));
typedef GAS unsigned gu32;

constexpr int D = 1024, NB = 16, SEQ = 4096, LCX = 256, DEPTH = 4;
constexpr int NL = NB * SEQ, NC = NB * LCX, NT = NL + NC;
constexpr int N_IN = 2592, PCOLS = 2048, D_OFF = 1824, HYC = 768;
constexpr int FFD = 2816, FFE = 3584, NE = 8;
constexpr float ALPHA = 1.6817928305074292f;
constexpr int NWAVES = 8, NTHR = 512;
constexpr int KSEQ = SEQ + LCX;

enum { I_X = 0, I_C, I_CTX, I_CCTX, I_ADAW, I_ADAB, I_WIN, I_QNORM, I_KVNORM, I_WUQ, I_WUKV, I_MLAON, I_LCW, I_LCB, I_LWR, I_LBR, I_LWI, I_LBI, I_LLAM, I_LON,
       I_MUP, I_MUN, I_W0, I_WUP, I_A0, I_AUP, I_GUP, I_KK, I_KA, I_RK, I_LNG, I_LNB, I_HCW, I_HCB, I_HW1, I_HB1, I_HW2, I_HB2, I_HW3, I_HD, I_HON,
       I_WOUT, I_LN1G, I_LN1B, I_LN2G, I_LN2B, I_FG, I_FU, I_FD, I_ROUTER, I_MG, I_MU, I_MD, N_INPUTS };

constexpr size_t MiB = 1u << 20;
constexpr size_t WS_CTL = 0, CTL_ZERO_BYTES = 1 * MiB;
constexpr size_t WS_MOD = 1 * MiB;
constexpr size_t WS_ROPE = 3 * MiB;
constexpr size_t WS_H2L = 4 * MiB;
constexpr size_t WS_H2C = 8 * MiB;
constexpr size_t WS_LRUW = 9 * MiB;
constexpr size_t WS_WUQT = 10 * MiB;
constexpr size_t WS_WUKVT = 11 * MiB;
constexpr size_t WS_SUMM = 12 * MiB;
constexpr size_t WS_BON = 17 * MiB;
constexpr size_t WS_TOKE = 20 * MiB;
constexpr size_t WS_TOKG = 21 * MiB;
constexpr size_t WS_TOKS = 22 * MiB;
constexpr size_t WS_BLKCNT = 23 * MiB;
constexpr size_t WS_SPEC = 24 * MiB;
constexpr size_t WS_WINT = 56 * MiB;
constexpr size_t WS_WHYT = 72 * MiB;
constexpr size_t WS_WOUTT = 78 * MiB;
constexpr size_t WS_WGUT = 86 * MiB;
constexpr size_t WS_WDT = 108 * MiB;
constexpr size_t WS_XC = 120 * MiB;
constexpr size_t WS_A1 = 136 * MiB;
constexpr size_t WS_ARENA = 272 * MiB;
constexpr size_t WS_P = WS_ARENA;
constexpr size_t WS_HT = 544 * MiB;
constexpr size_t WS_QB = 646 * MiB;
constexpr size_t WS_KB = 697 * MiB;
constexpr size_t WS_VT = 748 * MiB;
constexpr size_t WS_AO = 782 * MiB;
constexpr size_t WS_HOT = 816 * MiB;
constexpr size_t WS_YR = 850 * MiB;
constexpr size_t WS_Y = 986 * MiB;
constexpr size_t WS_H = WS_ARENA;
constexpr size_t WS_MGU = WS_ARENA;
constexpr size_t WS_MD = 384 * MiB;
constexpr size_t WS_XS = 440 * MiB;
constexpr size_t WS_HM = 716 * MiB;
constexpr size_t WS_END = 1122 * MiB;
constexpr size_t WS_M8GU = WS_ARENA;
constexpr size_t WS_M8D = 328 * MiB;
constexpr size_t WS_XS8 = 356 * MiB;
constexpr size_t WS_Y2 = 494 * MiB;
constexpr size_t WS_HM8 = 770 * MiB;
constexpr int MOE_MAX_TILES = 552, MOE_NCHUNK = 3, MOE_CHUNK_TILES = 192;
static_assert(WS_HM8 + (size_t)MOE_CHUNK_TILES * 256 * FFE <= WS_END && WS_M8GU + (size_t)8 * 2 * FFE * D <= WS_M8D && WS_M8D + (size_t)8 * D * FFE <= WS_XS8 && WS_XS8 + (size_t)141312 * D <= WS_Y2 && WS_Y2 + (size_t)141312 * D * 2 <= WS_HM8, "moe fp8 map");
static_assert(WS_H + (size_t)NT * FFD * 2 <= WS_QB + 51 * MiB, "dense hidden");

#ifndef DENSE_FFN2_F8
#define DENSE_FFN2_F8 1
#endif
constexpr int CW_DYN = 32768, LN_DYN = 48;
constexpr int CW_BAR = 4096;

constexpr int RING_BYTES = 131072;
constexpr int LDSCTL_OFF = RING_BYTES;
constexpr int LDS_TILEE = LDSCTL_OFF + 256;
constexpr int LDS_MOEI = LDSCTL_OFF + 1024;
constexpr int LDS_BYTES = 147456;

#define LDS_WAIT() asm volatile("s_waitcnt lgkmcnt(0)" ::: "memory")
#define VM_WAIT() asm volatile("s_waitcnt vmcnt(0)" ::: "memory")
typedef __bf16 hwbf16x2 __attribute__((ext_vector_type(2)));
__device__ __forceinline__ unsigned pk2(float lo, float hi) { const f32x2 v = {lo, hi}; const hwbf16x2 b = __builtin_convertvector(v, hwbf16x2); return __builtin_bit_cast(unsigned, b); }
__device__ __forceinline__ unsigned f2bf(float f) { return pk2(f, 0.f) & 0xffffu; }
__device__ __forceinline__ unsigned pk4_fp8(float a, float b, float c, float d) { int w = __builtin_amdgcn_cvt_pk_fp8_f32(a, b, 0, false); w = __builtin_amdgcn_cvt_pk_fp8_f32(c, d, w, true); return (unsigned)w; }
__device__ __forceinline__ float bf2f(unsigned b) { return __builtin_bit_cast(float, b << 16); }
__device__ __forceinline__ float bflo(unsigned w) { return __builtin_bit_cast(float, w << 16); }
__device__ __forceinline__ float bfhi(unsigned w) { return __builtin_bit_cast(float, w & 0xffff0000u); }
__device__ __forceinline__ float wave_sum(float v) {
#pragma unroll
    for (int o = 1; o < 64; o <<= 1) v += __shfl_xor(v, o);
    return v;
}
__device__ __forceinline__ float sigmoidf_(float x) { return 1.f / (1.f + __expf(-x)); }
#define XB_TMO      128
#define XB_XCNT(j)  (256  + 64 * (j))
#define XB_XSUB(j)  (1280 + 64 * (j))
#define XB_XGEN(j)  (2304 + 64 * (j))
#define XB_TOP      3328
#define XB_TOPGEN   3392
#define XCD_BAR_WORDS 3456
#define XB_SPIN_CAP (1u << 18)

__device__ __forceinline__ unsigned xb_ld(unsigned* p)              { return __hip_atomic_load(p, __ATOMIC_RELAXED, __HIP_MEMORY_SCOPE_AGENT); }
__device__ __forceinline__ unsigned xb_add(unsigned* p, unsigned v) { return __hip_atomic_fetch_add(p, v, __ATOMIC_RELAXED, __HIP_MEMORY_SCOPE_AGENT); }
__device__ __forceinline__ unsigned xb_xcc_id() { return (unsigned)__builtin_amdgcn_s_getreg((3 << 11) | 20) & 0xFu; }
#define XB_SPIN(cond, bar) do { unsigned _sp = 0; while (cond) { __builtin_amdgcn_s_sleep(1); \
    if ((++_sp & 255u) == 0u) { if (xb_ld(&(bar)[XB_TMO])) break; if (_sp > XB_SPIN_CAP) { atomicAdd(&(bar)[XB_TMO], 1u); break; } } } } while (0)

struct XcdBarrier {
    int leader; unsigned* bar; unsigned x;
    volatile LAS unsigned* st;
};

__device__ __forceinline__ XcdBarrier xcd_barrier_post(unsigned* bar, volatile LAS unsigned* st, int leader) {
    XcdBarrier b; b.leader = leader; b.bar = bar; b.x = xb_xcc_id(); b.st = st;
    if (leader) (void)xb_add(&bar[XB_XCNT(b.x)], 1u);
    return b;
}
__device__ __forceinline__ void xcd_barrier_complete(unsigned* bar, unsigned x, unsigned& nloc, unsigned& nx) {
    const unsigned G = gridDim.x * gridDim.y * gridDim.z;
    unsigned sum, cnt, mine, sp = 0u;
    for (;;) {
        sum = 0u; cnt = 0u; mine = 0u;
#pragma unroll
        for (unsigned j = 0; j < 16; ++j) { const unsigned c = xb_ld(&bar[XB_XCNT(j)]); sum += c; cnt += (c > 0u) ? 1u : 0u; mine = (j == x) ? c : mine; }
        if (sum == G) break;
        __builtin_amdgcn_s_sleep(1);
        if ((++sp & 255u) == 0u) { if (xb_ld(&bar[XB_TMO])) break; if (sp > XB_SPIN_CAP) { atomicAdd(&bar[XB_TMO], 1u); break; } }
    }
    nloc = mine > 0u ? mine : 1u; nx = cnt > 0u ? cnt : 1u;
}

__device__ __forceinline__ void xcd_barrier(const XcdBarrier& b) {
    asm volatile("s_waitcnt vmcnt(0)" ::: "memory");
    __syncthreads();
    if (b.leader) {
        unsigned* bar = b.bar;
        __builtin_amdgcn_s_waitcnt(0);
        unsigned nloc = b.st[0], nx = b.st[1];
        if (nloc == 0u) { xcd_barrier_complete(bar, b.x, nloc, nx); b.st[0] = nloc; b.st[1] = nx; }
        const unsigned old = xb_add(&bar[XB_XSUB(b.x)], 1u);
        const unsigned gen = old / nloc;
        if (old + 1u == (gen + 1u) * nloc) {
            __builtin_amdgcn_fence(__ATOMIC_RELEASE, "agent");
            asm volatile("s_waitcnt vmcnt(0)" ::: "memory");
            const unsigned og = xb_add(&bar[XB_TOP], 1u);
            const unsigned tg = og / nx;
            if (og + 1u == (tg + 1u) * nx) xb_add(&bar[XB_TOPGEN], 1u);
            else XB_SPIN(xb_ld(&bar[XB_TOPGEN]) == tg, bar);
            __builtin_amdgcn_fence(__ATOMIC_ACQUIRE, "agent");
            xb_add(&bar[XB_XGEN(b.x)], 1u);
            asm volatile("s_waitcnt vmcnt(0)" ::: "memory");
        } else {
            XB_SPIN(xb_ld(&bar[XB_XGEN(b.x)]) == gen, bar);
            __builtin_amdgcn_fence(__ATOMIC_ACQUIRE, "agent");
            asm volatile("s_waitcnt vmcnt(0)" ::: "memory");
        }
    }
    __syncthreads();
}

struct Args { const float* in[N_INPUTS]; float* out; unsigned char* ws; };
struct Frame { LAS unsigned char* lds; int tid, lane, wave, G; };
__device__ __forceinline__ void frame_refresh(Frame& F) { int t = F.wave * 64 + mk_lane(); asm volatile("" : "+v"(t)); F.tid = t; F.lane = t & 63; }
#define CAS __attribute__((address_space(4)))
__device__ __forceinline__ const CAS char* karg() { const CAS char* kp = (const CAS char*)__builtin_amdgcn_kernarg_segment_ptr(); asm volatile("" : "+s"(kp)); return kp; }
__device__ __forceinline__ const float* in_ptr(int i) { return *(const float* const CAS*)(karg() + 8 * i); }
__device__ __forceinline__ float* out_ptr() { return *(float* const CAS*)(karg() + 8 * N_INPUTS); }
__device__ __forceinline__ unsigned char* ws_ptr() { return *(unsigned char* const CAS*)(karg() + 8 * N_INPUTS + 8); }
#define WSP(T, off) ((T*)(ws + (off)))
#define WS_DECL unsigned char* const ws = ws_ptr()

namespace pg8 {
struct EpiStore {
    static constexpr bool PERM = true, AFTER_DRAIN = false;
    bf16_t* O; int ldc; int pm_add; int nN;
    __device__ __forceinline__ void operator()(const f32x4 (&acc)[2][2][4][2], const Unit& u, int wr, int wc, int fr, int fq) const {
        const int row0 = (u.pm + pm_add) * BM + wr * 64 + fr; const int col0 = (u.pn % nN) * BM + wc * 32 + 8 * fq;
#pragma unroll
        for (int ai = 0; ai < 2; ++ai)
#pragma unroll
            for (int m = 0; m < 4; ++m) { bf16_t* rowp = O + (size_t)(row0 + ai * HALF + m * 16) * ldc + col0;
#pragma unroll
                for (int bj = 0; bj < 2; ++bj) { const f32x4 v0 = acc[ai][bj][m][0], v1 = acc[ai][bj][m][1];
                    u32x4 w; w.x = cvt_pk_bf16(v0[0], v0[1]); w.y = cvt_pk_bf16(v0[2], v0[3]); w.z = cvt_pk_bf16(v1[0], v1[1]); w.w = cvt_pk_bf16(v1[2], v1[3]);
                    *(u32x4*)(rowp + bj * HALF) = w; } }
    }
};
__device__ __forceinline__ float silu_mul(float g, float u) { return g * __builtin_amdgcn_rcpf(1.f + __expf(-g)) * u; }
struct EpiSwiGLU {
    static constexpr bool PERM = true, AFTER_DRAIN = false;
    bf16_t* H; int ldh; int pm_sub; int nN;
    __device__ __forceinline__ void operator()(const f32x4 (&acc)[2][2][4][2], const Unit& u, int wr, int wc, int fr, int fq) const {
        const int row0 = (u.pm - pm_sub) * BM + wr * 64 + fr; const int col0 = (u.pn % nN) * HALF + wc * 32 + 8 * fq;
#pragma unroll
        for (int ai = 0; ai < 2; ++ai)
#pragma unroll
            for (int m = 0; m < 4; ++m) { bf16_t* rowp = H + (size_t)(row0 + ai * HALF + m * 16) * ldh + col0;
                const f32x4 g0 = acc[ai][0][m][0], g1 = acc[ai][0][m][1], u0 = acc[ai][1][m][0], u1 = acc[ai][1][m][1];
                u32x4 w; w.x = cvt_pk_bf16(silu_mul(g0[0], u0[0]), silu_mul(g0[1], u0[1])); w.y = cvt_pk_bf16(silu_mul(g0[2], u0[2]), silu_mul(g0[3], u0[3]));
                w.z = cvt_pk_bf16(silu_mul(g1[0], u1[0]), silu_mul(g1[1], u1[1])); w.w = cvt_pk_bf16(silu_mul(g1[2], u1[2]), silu_mul(g1[3], u1[3]));
                *(u32x4*)rowp = w; }
    }
};
struct EpiSwiGLU8 {
    static constexpr bool PERM = true, AFTER_DRAIN = false;
    unsigned char* H; int ldh; int pm_sub; int nN;
    __device__ __forceinline__ void operator()(const f32x4 (&acc)[2][2][4][2], const Unit& u, int wr, int wc, int fr, int fq) const {
        const int row0 = (u.pm - pm_sub) * BM + wr * 64 + fr; const int col0 = (u.pn % nN) * HALF + wc * 32 + 8 * fq;
#pragma unroll
        for (int ai = 0; ai < 2; ++ai)
#pragma unroll
            for (int m = 0; m < 4; ++m) { unsigned char* rowp = H + (size_t)(row0 + ai * HALF + m * 16) * ldh + col0;
                const f32x4 g0 = acc[ai][0][m][0], g1 = acc[ai][0][m][1], u0 = acc[ai][1][m][0], u1 = acc[ai][1][m][1];
                ::v2u w; w.x = ::pk4_fp8(silu_mul(g0[0], u0[0]), silu_mul(g0[1], u0[1]), silu_mul(g0[2], u0[2]), silu_mul(g0[3], u0[3]));
                w.y = ::pk4_fp8(silu_mul(g1[0], u1[0]), silu_mul(g1[1], u1[1]), silu_mul(g1[2], u1[2]), silu_mul(g1[3], u1[3]));
                *(::v2u*)rowp = w; }
    }
};
struct MoeOrder {
    int nM, nN, nwg, G, c, t0, pm_off; const PG8_LAS unsigned char* tile_e;
    __device__ void init(int nM_, int nN_, int G_, int c_, int t0_, int pm_off_, const PG8_LAS unsigned char* te) { nM = nM_; nN = nN_; nwg = nM * nN; G = G_; c = c_; t0 = t0_; pm_off = pm_off_; tile_e = te; }
    __device__ bool next(int i, Unit& u) const {
        const long L = (long)i * G + c; if (L >= nwg) return false;
        int wgid = (int)L; { const int q = nwg / NXCD, r = nwg % NXCD, xcd = wgid % NXCD, off = wgid / NXCD; wgid = (xcd < r ? xcd * (q + 1) : r * (q + 1) + (xcd - r) * q) + off; }
        const int nig = WGM * nN, gid = wgid / nig, fm = gid * WGM, gsz = (nM - fm) < WGM ? (nM - fm) : WGM;
        const int pml = fm + ((wgid % nig) % gsz), pnl = (wgid % nig) / gsz;
        const int e = tile_e[t0 + pml];
        u.pm = pm_off + pml; u.pn = e * nN + pnl; u.g = 0; return true;
    }
    __device__ __forceinline__ void a_ready(const Unit&) const {}
    __device__ __forceinline__ void done(const Unit&) const {}
};
struct DualOrder {
    StaticOrder s0, s1; int G, c;
    __device__ void init(int M0, int N0, int M1, int N1, int G_, int c_) { s0.init(M0, N0, 1, 0); s1.init(M1, N1, 1, 0); G = G_; c = c_; }
    __device__ bool next(int i, Unit& u) const { const long L = (long)i * G + c;
        if (L < s0.nwg) { const bool ok = s0.next((int)L, u); u.g = 0; return ok; }
        const long L1 = L - s0.nwg; if (L1 >= s1.nwg) return false; const bool ok = s1.next((int)L1, u); u.g = 1; return ok; }
    __device__ __forceinline__ void a_ready(const Unit&) const {}
    __device__ __forceinline__ void done(const Unit&) const {}
};
struct EpiStore2 {
    static constexpr bool PERM = true, AFTER_DRAIN = false;
    bf16_t* O0; int ldc0; bf16_t* O1; int ldc1;
    __device__ __forceinline__ void operator()(const f32x4 (&acc)[2][2][4][2], const Unit& u, int wr, int wc, int fr, int fq) const {
        bf16_t* O = u.g ? O1 : O0; const int ldc = u.g ? ldc1 : ldc0;
        const int row0 = u.pm * BM + wr * 64 + fr; const int col0 = u.pn * BM + wc * 32 + 8 * fq;
#pragma unroll
        for (int ai = 0; ai < 2; ++ai)
#pragma unroll
            for (int m = 0; m < 4; ++m) { bf16_t* rowp = O + (size_t)(row0 + ai * HALF + m * 16) * ldc + col0;
#pragma unroll
                for (int bj = 0; bj < 2; ++bj) { const f32x4 v0 = acc[ai][bj][m][0], v1 = acc[ai][bj][m][1];
                    u32x4 w; w.x = cvt_pk_bf16(v0[0], v0[1]); w.y = cvt_pk_bf16(v0[2], v0[3]); w.z = cvt_pk_bf16(v1[0], v1[1]); w.w = cvt_pk_bf16(v1[2], v1[3]);
                    *(u32x4*)(rowp + bj * HALF) = w; } }
    }
};
}

__device__ __forceinline__ void tr_item(const float* W, int ldw, int k0, int c0, bf16* WT, int K, int drow, LAS float* scr, int lane) {
    { f32x4 t_[8];
#pragma unroll
      for (int i = 0; i < 8; ++i) t_[i] = *(const GAS f32x4*)(W + (size_t)(k0 + 8 * i + (lane >> 3)) * ldw + c0 + 4 * (lane & 7));
#pragma unroll
      for (int i = 0; i < 8; ++i) { LAS float* d_ = scr + (8 * i + (lane >> 3)) * 33 + 4 * (lane & 7); d_[0] = t_[i].x; d_[1] = t_[i].y; d_[2] = t_[i].z; d_[3] = t_[i].w; } }
    LDS_WAIT(); asm volatile("" ::: "memory");
    const int c = lane & 7;
#pragma unroll
    for (int j = 0; j < 4; ++j) { const int n = (lane >> 3) + 8 * j; const LAS float* s = scr + (8 * c) * 33 + n;
        v4u o; o.x = pk2(s[0 * 33], s[1 * 33]); o.y = pk2(s[2 * 33], s[3 * 33]); o.z = pk2(s[4 * 33], s[5 * 33]); o.w = pk2(s[6 * 33], s[7 * 33]);
        *(GAS v4u*)(WT + (size_t)(drow + n) * K + k0 + 8 * c) = o; }
    LDS_WAIT(); asm volatile("" ::: "memory");
}
__device__ __forceinline__ void tr_item8(const float* W, int ldw, int k0, int c0, unsigned char* WT, int K, int drow, LAS float* scr, int lane, float scale) {
    { f32x4 t_[8];
#pragma unroll
      for (int i = 0; i < 8; ++i) t_[i] = *(const GAS f32x4*)(W + (size_t)(k0 + 8 * i + (lane >> 3)) * ldw + c0 + 4 * (lane & 7));
#pragma unroll
      for (int i = 0; i < 8; ++i) { LAS float* d_ = scr + (8 * i + (lane >> 3)) * 33 + 4 * (lane & 7); d_[0] = t_[i].x; d_[1] = t_[i].y; d_[2] = t_[i].z; d_[3] = t_[i].w; } }
    LDS_WAIT(); asm volatile("" ::: "memory");
    const int c = lane & 7;
#pragma unroll
    for (int j = 0; j < 4; ++j) { const int n = (lane >> 3) + 8 * j; const LAS float* s = scr + (8 * c) * 33 + n;
        v2u o; o.x = pk4_fp8(s[0 * 33] * scale, s[1 * 33] * scale, s[2 * 33] * scale, s[3 * 33] * scale); o.y = pk4_fp8(s[4 * 33] * scale, s[5 * 33] * scale, s[6 * 33] * scale, s[7 * 33] * scale);
        *(GAS v2u*)(WT + (size_t)(drow + n) * K + k0 + 8 * c) = o; }
    LDS_WAIT(); asm volatile("" ::: "memory");
}
__device__ __forceinline__ void conv_matrix(Frame& F, const float* W, int K, int ldw, int cbeg, int ncols, bf16* WT, int mode, int rowoff, int& cursor, float f8scale = 0.f) {
    const int gw = blockIdx.x * NWAVES + F.wave, NGW = F.G * NWAVES;
    const int nblk = ncols / 32, nit = (K / 64) * nblk;
    LAS float* scr = (LAS float*)(F.lds + F.wave * 16384);
    int first = cursor + (((gw - cursor) % NGW) + NGW) % NGW;
    for (int it = first; it < cursor + nit; it += NGW) {
        const int idx = it - cursor, kb = idx / nblk, nb = idx % nblk, n = 32 * nb;
        const int drow = mode == 0 ? rowoff + n : ((n >> 7) * 256 + (n & 127) + rowoff);
        if (f8scale != 0.f) tr_item8(W, ldw, 64 * kb, cbeg + n, (unsigned char*)WT, K, drow, scr, F.lane, f8scale); else tr_item(W, ldw, 64 * kb, cbeg + n, WT, K, drow, scr, F.lane);
    }
    cursor += nit;
}

__device__ __forceinline__ void phase_mod(Frame& F) { WS_DECL; frame_refresh(F);
    LAS float* sv = (LAS float*)F.lds;
    LAS float* red = (LAS float*)(F.lds + 69632);
    float* MOD = WSP(float, WS_MOD);
    if ((int)blockIdx.x < 192) {
        const float* cl_ = in_ptr(I_C); const float* cc_ = in_ptr(I_CCTX); const float* adab = in_ptr(I_ADAB); const float* adaw = in_ptr(I_ADAW);
        for (int i = F.tid; i < 17 * 1024; i += NTHR) { const int b = i >> 10, k = i & 1023; const float c = b < 16 ? cl_[b * 1024 + k] : cc_[k]; sv[i] = c / (1.f + expf(-c)); }
        __syncthreads();
        for (int item = blockIdx.x; item < 192; item += F.G) {
            const int li = item / 48, cg = item % 48, cl = F.tid & 127, kq = F.tid >> 7;
            const float* W = adaw + (size_t)li * 1024 * 6144 + cg * 128 + cl;
            float acc[17];
#pragma unroll
            for (int b = 0; b < 17; ++b) acc[b] = 0.f;
#pragma unroll 1
            for (int k = kq * 256; k < kq * 256 + 256; k += 8) { float w[8];
#pragma unroll
                for (int j = 0; j < 8; ++j) w[j] = W[(size_t)(k + j) * 6144];
#pragma unroll
                for (int b = 0; b < 17; ++b) { const f32x4 s0 = *(const LAS f32x4*)(sv + b * 1024 + k), s1 = *(const LAS f32x4*)(sv + b * 1024 + k + 4);
                    acc[b] += (s0.x * w[0] + s0.y * w[1]) + (s0.z * w[2] + s0.w * w[3]) + (s1.x * w[4] + s1.y * w[5]) + (s1.z * w[6] + s1.w * w[7]); } }
#pragma unroll
            for (int b = 0; b < 17; ++b) red[(kq * 17 + b) * 128 + cl] = acc[b];
            __syncthreads();
            for (int o = F.tid; o < 17 * 128; o += NTHR) { const int b = o >> 7, c = o & 127;
                const float s = (red[(0 * 17 + b) * 128 + c] + red[(1 * 17 + b) * 128 + c]) + (red[(2 * 17 + b) * 128 + c] + red[(3 * 17 + b) * 128 + c]);
                MOD[((size_t)li * 17 + b) * 6144 + cg * 128 + c] = s + adab[li * 6144 + cg * 128 + c]; }
            __syncthreads();
        }
    }
}

__device__ __forceinline__ void phase_pro0(Frame& F) { WS_DECL; frame_refresh(F);
    phase_mod(F);
    __syncthreads();
    int cursor = 0;
    for (int li = 0; li < DEPTH; ++li) {
        conv_matrix(F, in_ptr(I_WIN) + (size_t)li * D * N_IN, D, N_IN, 0, D_OFF, WSP(bf16, WS_WINT) + (size_t)li * PCOLS * D, 0, 0, cursor);
        conv_matrix(F, in_ptr(I_WIN) + (size_t)li * D * N_IN, D, N_IN, D_OFF, HYC, WSP(bf16, WS_WHYT) + (size_t)li * HYC * D, 0, 0, cursor);
        conv_matrix(F, in_ptr(I_WOUT) + (size_t)li * D * D, D, D, 0, D, WSP(bf16, WS_WOUTT) + (size_t)li * D * D, 0, 0, cursor);
    }
    for (int j = 0; j < 2; ++j) {
        conv_matrix(F, in_ptr(I_FG) + (size_t)j * D * FFD, D, FFD, 0, FFD, (bf16*)(WSP(unsigned char, WS_WGUT) + (size_t)j * 2 * FFD * D), 1, 0, cursor, 64.f);
        conv_matrix(F, in_ptr(I_FU) + (size_t)j * D * FFD, D, FFD, 0, FFD, (bf16*)(WSP(unsigned char, WS_WGUT) + (size_t)j * 2 * FFD * D), 1, 128, cursor, 64.f);
        if (DENSE_FFN2_F8) conv_matrix(F, in_ptr(I_FD) + (size_t)j * FFD * D, FFD, D, 0, D, (bf16*)(WSP(unsigned char, WS_WDT) + (size_t)j * D * FFD), 0, 0, cursor, 256.f);
        else conv_matrix(F, in_ptr(I_FD) + (size_t)j * FFD * D, FFD, D, 0, D, WSP(bf16, WS_WDT) + (size_t)j * D * FFD, 0, 0, cursor);
    }
    { const int gt = blockIdx.x * NTHR + F.tid, NGT = F.G * NTHR; const int per = (PCOLS - D_OFF) * D / 8;
      for (int i = gt; i < DEPTH * per; i += NGT) { const int li = i / per, r = i % per; *(GAS v4u*)(WSP(bf16, WS_WINT) + (size_t)li * PCOLS * D + (size_t)D_OFF * D + (size_t)r * 8) = (v4u){0u, 0u, 0u, 0u}; } }
}

struct Stream { const float* inl; const float* inc; float* outl; float* outc; };
__device__ __forceinline__ Stream make_stream(unsigned char* ws, int li) { Stream s; s.outl = out_ptr(); s.outc = WSP(float, WS_XC); s.inl = li == 0 ? in_ptr(I_X) : (const float*)s.outl; s.inc = li == 0 ? in_ptr(I_CTX) : (const float*)s.outc; return s; }
__device__ __forceinline__ const float* stream_in(const Stream& s, int m) { return m < NL ? s.inl + (size_t)m * D : s.inc + (size_t)(m - NL) * D; }
__device__ __forceinline__ float* stream_out(const Stream& s, int m) { return m < NL ? s.outl + (size_t)m * D : s.outc + (size_t)(m - NL) * D; }
__device__ __forceinline__ int mod_b(int m) { return m < NL ? (m >> 12) : 16; }
__device__ __forceinline__ const float* mod_vec(unsigned char* ws, int li, int b, int j) { return WSP(float, WS_MOD) + ((size_t)li * 17 + b) * 6144 + j * 1024; }

__device__ __forceinline__ void store_modulated(const f32x4 (&x)[4], const float* shift, const float* scale, bf16* orow, int lane) {
#pragma unroll
    for (int j = 0; j < 4; ++j) { const int c = 4 * lane + 256 * j; const f32x4 sh = *(const GAS f32x4*)(shift + c), sc = *(const GAS f32x4*)(scale + c);
        const f32x4 h = x[j] * (sc + 1.f) + sh; v2u w; w.x = pk2(h.x, h.y); w.y = pk2(h.z, h.w); *(GAS v2u*)(orow + c) = w; }
}
__device__ __forceinline__ void rows_range(const Frame& F, int nrows, int& r0, int& r1) { const int per = (nrows + F.G - 1) / F.G; r0 = blockIdx.x * per; r1 = r0 + per < nrows ? r0 + per : nrows; if (r0 > nrows) r0 = nrows; }

__device__ __forceinline__ void phase_hin0(Frame& F) { WS_DECL; frame_refresh(F);
    int r0, r1; rows_range(F, NT, r0, r1); const Stream st = make_stream(ws, 0);
    for (int m = r0 + F.wave; m < r1; m += NWAVES) {
        const float* xr = stream_in(st, m); f32x4 x[4];
#pragma unroll
        for (int j = 0; j < 4; ++j) x[j] = __builtin_nontemporal_load((const GAS f32x4*)(xr + 4 * F.lane + 256 * j));
        const int b = mod_b(m);
        store_modulated(x, mod_vec(ws, 0, b, 0), mod_vec(ws, 0, b, 1), WSP(bf16, WS_A1) + (size_t)m * D, F.lane);
    }
}

__device__ __forceinline__ void ln_rows(f32x4 (&v)[4], const float* g, const float* bta, int lane) {
    float s = 0.f;
#pragma unroll
    for (int j = 0; j < 4; ++j) s += (v[j].x + v[j].y) + (v[j].z + v[j].w);
    const float mean = wave_sum(s) * (1.f / D); float s2 = 0.f;
#pragma unroll
    for (int j = 0; j < 4; ++j) { v[j] = v[j] - mean; s2 += (v[j].x * v[j].x + v[j].y * v[j].y) + (v[j].z * v[j].z + v[j].w * v[j].w); }
    const float rstd = __builtin_amdgcn_rsqf(wave_sum(s2) * (1.f / D) + 1e-5f);
#pragma unroll
    for (int j = 0; j < 4; ++j) { const int c = 4 * lane + 256 * j; v[j] = v[j] * rstd * *(const GAS f32x4*)(g + c) + *(const GAS f32x4*)(bta + c); }
}

template <bool HAVE_Y>
__device__ __forceinline__ void phase_ln1(Frame& F, int li) { WS_DECL; frame_refresh(F); constexpr bool DRY_OR_BF16 = false;
    const int nrows = li == DEPTH - 1 ? NL : NT; const bool moe = li & 1; const int lane = F.lane;
    LAS int* hist = (LAS int*)(F.lds + LDS_MOEI) + 56; LAS float* ROUT = (LAS float*)F.lds;
    if (moe) { if (F.tid < 8) hist[F.tid] = 0; const float* router = in_ptr(I_ROUTER) + (size_t)(li >> 1) * D * NE; for (int i = F.tid; i < D * NE / 4; i += NTHR) *(LAS f32x4*)(ROUT + 4 * i) = *(const GAS f32x4*)(router + 4 * i); __syncthreads(); }
    int r0, r1; rows_range(F, nrows, r0, r1);
    const float* g = in_ptr(I_LN1G) + li * D; const float* bt = in_ptr(I_LN1B) + li * D; const Stream st = make_stream(ws, li); const bf16* Y = WSP(bf16, WS_Y);
    f32x4 xn[4]; v2u yn[4];
    { const int m = r0 + F.wave; if (m < r1) { const float* xr = stream_in(st, m);
#pragma unroll
        for (int j = 0; j < 4; ++j) { const int c = 4 * lane + 256 * j; xn[j] = __builtin_nontemporal_load((const GAS f32x4*)(xr + c)); if (HAVE_Y) yn[j] = __builtin_nontemporal_load((const GAS v2u*)(Y + (size_t)m * D + c)); } } }
    for (int m = r0 + F.wave; m < r1; m += NWAVES) {
        const int b = mod_b(m); f32x4 v[4]; v2u yw[4];
#pragma unroll
        for (int j = 0; j < 4; ++j) { v[j] = xn[j]; if (HAVE_Y) yw[j] = yn[j]; }
        if (m + NWAVES < r1) { const float* xr = stream_in(st, m + NWAVES);
#pragma unroll
            for (int j = 0; j < 4; ++j) { const int c = 4 * lane + 256 * j; xn[j] = __builtin_nontemporal_load((const GAS f32x4*)(xr + c)); if (HAVE_Y) yn[j] = __builtin_nontemporal_load((const GAS v2u*)(Y + (size_t)(m + NWAVES) * D + c)); } }
        const float* m2 = mod_vec(ws, li, b, 2);
#pragma unroll
        for (int j = 0; j < 4; ++j) { const int c = 4 * lane + 256 * j; v[j] = v[j] * ALPHA;
            if (HAVE_Y) { const f32x4 mm = *(const GAS f32x4*)(m2 + c); v[j].x += mm.x * bflo(yw[j].x); v[j].y += mm.y * bfhi(yw[j].x); v[j].z += mm.z * bflo(yw[j].y); v[j].w += mm.w * bfhi(yw[j].y); } }
        ln_rows(v, g, bt, lane);
        float* xo = stream_out(st, m);
#pragma unroll
        for (int j = 0; j < 4; ++j) __builtin_nontemporal_store(v[j], (GAS f32x4*)(xo + 4 * lane + 256 * j));
        const float* sh = mod_vec(ws, li, b, 3); const float* sc = mod_vec(ws, li, b, 4);
        if (moe) {
            float lg[NE];
#pragma unroll
            for (int e = 0; e < NE; ++e) lg[e] = 0.f;
#pragma unroll
            for (int j = 0; j < 4; ++j) { const int c = 4 * lane + 256 * j; const f32x4 s4 = *(const GAS f32x4*)(sh + c), c4 = *(const GAS f32x4*)(sc + c); const f32x4 f = v[j] * (c4 + 1.f) + s4;
#pragma unroll
                for (int q = 0; q < 4; ++q) { const f32x4 ra = *(const LAS f32x4*)(ROUT + (c + q) * NE), rb = *(const LAS f32x4*)(ROUT + (c + q) * NE + 4); const float fq = f[q];
                    lg[0] += fq * ra.x; lg[1] += fq * ra.y; lg[2] += fq * ra.z; lg[3] += fq * ra.w; lg[4] += fq * rb.x; lg[5] += fq * rb.y; lg[6] += fq * rb.z; lg[7] += fq * rb.w; } }
#pragma unroll
            for (int e = 0; e < NE; ++e) lg[e] = wave_sum(lg[e]);
            int e0 = 0; float v0 = lg[0];
#pragma unroll
            for (int e = 1; e < NE; ++e) if (lg[e] > v0) { v0 = lg[e]; e0 = e; }
            int e1 = -1; float v1 = -3.0e38f;
#pragma unroll
            for (int e = 0; e < NE; ++e) if (e != e0 && lg[e] > v1) { v1 = lg[e]; e1 = e; }
            const float ex = __expf(v1 - v0), g0 = 1.f / (1.f + ex), g1 = ex * g0;
            if (lane == 0) { *(GAS v2u*)(WSP(int, WS_TOKE) + 2 * (size_t)m) = (v2u){(unsigned)e0, (unsigned)e1}; *(GAS f32x2*)(WSP(float, WS_TOKG) + 2 * (size_t)m) = (f32x2){g0, g1};
                atomicAdd((int*)(hist + e0), 1); atomicAdd((int*)(hist + e1), 1); }
        }
        if (!DRY_OR_BF16) {
            unsigned char* orow = WSP(unsigned char, WS_A1) + (size_t)m * D;
#pragma unroll
            for (int j = 0; j < 4; ++j) { const int c = 4 * lane + 256 * j; const f32x4 s4 = *(const GAS f32x4*)(sh + c), c4 = *(const GAS f32x4*)(sc + c); const f32x4 f = v[j] * (c4 + 1.f) + s4;
                *(GAS unsigned*)(orow + c) = pk4_fp8(f.x, f.y, f.z, f.w); }
        } else store_modulated(v, sh, sc, WSP(bf16, WS_A1) + (size_t)m * D, lane);
    }
    if (moe) { __syncthreads(); if (F.tid < 8) WSP(int, WS_BLKCNT)[blockIdx.x * 8 + F.tid] = hist[F.tid]; }
}

template <bool HAVE_FFN>
__device__ __forceinline__ void phase_ln2(Frame& F, int li) { WS_DECL; frame_refresh(F);
    const int nrows = li == DEPTH - 1 ? NL : NT; const bool moe = li & 1; const int lane = F.lane;
    int r0, r1; rows_range(F, nrows, r0, r1);
    const float* g = in_ptr(I_LN2G) + li * D; const float* bt = in_ptr(I_LN2B) + li * D; const Stream st = make_stream(ws, 1);
    const bf16* Y = WSP(bf16, WS_Y); const bf16* XS = WSP(bf16, WS_Y2); const int* TOKS = WSP(int, WS_TOKS); const float* TOKG = WSP(float, WS_TOKG);
    f32x4 xn[4]; v2u ya[4], yb[4]; v2u sn = (v2u){0u, 0u}; f32x2 gn = (f32x2){0.f, 0.f}, gc = (f32x2){0.f, 0.f};
    const int mf = r0 + F.wave;
    if (mf < r1) { const float* xr = stream_out(st, mf); v2u s0 = (v2u){0u, 0u};
        if (moe) { s0 = *(const GAS v2u*)(TOKS + 2 * (size_t)mf); gc = *(const GAS f32x2*)(TOKG + 2 * (size_t)mf); if (mf + NWAVES < r1) { sn = *(const GAS v2u*)(TOKS + 2 * (size_t)(mf + NWAVES)); gn = *(const GAS f32x2*)(TOKG + 2 * (size_t)(mf + NWAVES)); } }
#pragma unroll
        for (int j = 0; j < 4; ++j) { const int c = 4 * lane + 256 * j; xn[j] = __builtin_nontemporal_load((const GAS f32x4*)(xr + c));
            if (HAVE_FFN) { if (moe) { ya[j] = __builtin_nontemporal_load((const GAS v2u*)(XS + (size_t)s0.x * D + c)); yb[j] = __builtin_nontemporal_load((const GAS v2u*)(XS + (size_t)s0.y * D + c)); } else ya[j] = __builtin_nontemporal_load((const GAS v2u*)(Y + (size_t)mf * D + c)); } } }
    for (int m = mf; m < r1; m += NWAVES) {
        const int b = mod_b(m); f32x4 v[4]; v2u wa[4], wb[4]; const f32x2 gg = gc;
#pragma unroll
        for (int j = 0; j < 4; ++j) { v[j] = xn[j]; wa[j] = ya[j]; wb[j] = yb[j]; }
        const int mn = m + NWAVES;
        if (mn < r1) { const float* xr = stream_out(st, mn); const v2u s1 = sn; gc = gn;
            if (moe && mn + NWAVES < r1) { sn = *(const GAS v2u*)(TOKS + 2 * (size_t)(mn + NWAVES)); gn = *(const GAS f32x2*)(TOKG + 2 * (size_t)(mn + NWAVES)); }
#pragma unroll
            for (int j = 0; j < 4; ++j) { const int c = 4 * lane + 256 * j; xn[j] = __builtin_nontemporal_load((const GAS f32x4*)(xr + c));
                if (HAVE_FFN) { if (moe) { ya[j] = __builtin_nontemporal_load((const GAS v2u*)(XS + (size_t)s1.x * D + c)); yb[j] = __builtin_nontemporal_load((const GAS v2u*)(XS + (size_t)s1.y * D + c)); } else ya[j] = __builtin_nontemporal_load((const GAS v2u*)(Y + (size_t)mn * D + c)); } } }
        const float* m5 = mod_vec(ws, li, b, 5);
#pragma unroll
        for (int j = 0; j < 4; ++j) { const int c = 4 * lane + 256 * j; v[j] = v[j] * ALPHA;
            if (HAVE_FFN) { const f32x4 mm = *(const GAS f32x4*)(m5 + c); f32x4 o;
                if (moe) { o.x = gg.x * bflo(wa[j].x) + gg.y * bflo(wb[j].x); o.y = gg.x * bfhi(wa[j].x) + gg.y * bfhi(wb[j].x); o.z = gg.x * bflo(wa[j].y) + gg.y * bflo(wb[j].y); o.w = gg.x * bfhi(wa[j].y) + gg.y * bfhi(wb[j].y); }
                else { o.x = bflo(wa[j].x); o.y = bfhi(wa[j].x); o.z = bflo(wa[j].y); o.w = bfhi(wa[j].y); }
                v[j] = v[j] + mm * o; } }
        ln_rows(v, g, bt, lane);
        float* xo = stream_out(st, m);
#pragma unroll
        for (int j = 0; j < 4; ++j) __builtin_nontemporal_store(v[j], (GAS f32x4*)(xo + 4 * lane + 256 * j));
        if (li < DEPTH - 1) store_modulated(v, mod_vec(ws, li + 1, b, 0), mod_vec(ws, li + 1, b, 1), WSP(bf16, WS_A1) + (size_t)m * D, lane);
    }
}

__device__ __forceinline__ void phase_moe_weights(Frame& F, int li) { WS_DECL; frame_refresh(F);
    const int j = li >> 1; int cursor = 0;
    for (int e = 0; e < NE; ++e) {
        conv_matrix(F, in_ptr(I_MG) + ((size_t)j * NE + e) * D * FFE, D, FFE, 0, FFE, (bf16*)(WSP(unsigned char, WS_M8GU) + (size_t)e * 2 * FFE * D), 1, 0, cursor, 64.f);
        conv_matrix(F, in_ptr(I_MU) + ((size_t)j * NE + e) * D * FFE, D, FFE, 0, FFE, (bf16*)(WSP(unsigned char, WS_M8GU) + (size_t)e * 2 * FFE * D), 1, 128, cursor, 64.f);
        conv_matrix(F, in_ptr(I_MD) + ((size_t)j * NE + e) * FFE * D, FFE, D, 0, D, (bf16*)(WSP(unsigned char, WS_M8D) + (size_t)e * D * FFE), 0, 0, cursor, 256.f);
    }
}

__device__ __forceinline__ void phase_moe_slots(Frame& F, int li) { WS_DECL; frame_refresh(F);
    const int nrows = li == DEPTH - 1 ? NL : NT;
    LAS int* mi = (LAS int*)(F.lds + LDS_MOEI); LAS unsigned char* tile_e = (LAS unsigned char*)(F.lds + LDS_TILEE);
    LAS int* slots = (LAS int*)F.lds;
    const int* blkcnt = WSP(int, WS_BLKCNT);
    { LAS int* cn = (LAS int*)(F.lds + 8192);
      if (F.tid < 8) { mi[16 + F.tid] = 0; mi[32 + F.tid] = 0; }
      { const int b = F.tid >> 1, hf = F.tid & 1; v4u c4 = (v4u){0u, 0u, 0u, 0u}; if (b < F.G) c4 = *(const GAS v4u*)(blkcnt + b * 8 + 4 * hf); *(LAS v4u*)(cn + b * 8 + 4 * hf) = c4; }
      __syncthreads();
      { const int e = F.wave; int tot = 0, pre = 0;
#pragma unroll
        for (int k = 0; k < 4; ++k) { const int b = F.lane + 64 * k; const int c = cn[b * 8 + e]; tot += c; if (b < (int)blockIdx.x) pre += c; }
        atomicAdd((int*)(mi + 16 + e), tot); atomicAdd((int*)(mi + 32 + e), pre); } }
    __syncthreads();
    if (F.tid == 0) { int s = 0; for (int e = 0; e < NE; ++e) { mi[e] = s; s += (mi[16 + e] + 255) & ~255; } mi[8] = s; mi[48] = s >> 8; }
    __syncthreads();
    for (int t = F.tid; t < MOE_MAX_TILES + 8; t += NTHR) { int e = 0;
#pragma unroll
        for (int q = 1; q < NE; ++q) if (t * 256 >= mi[q]) e = q;
        tile_e[t] = (unsigned char)e; }
    int r0, r1; rows_range(F, nrows, r0, r1);
    const int na = 2 * (r1 - r0);
    if (F.wave == 0) {
        int run[NE];
#pragma unroll
        for (int e = 0; e < NE; ++e) run[e] = mi[e] + mi[32 + e];
#pragma unroll 1
        for (int k0 = 0; k0 < 9; k0 += 3) { int ev[3];
#pragma unroll
          for (int k = 0; k < 3; ++k) { const int ai = 64 * (k0 + k) + F.lane; ev[k] = ai < na ? WSP(int, WS_TOKE)[2 * (size_t)r0 + ai] : -1; }
#pragma unroll
          for (int k = 0; k < 3; ++k) { const int base = 64 * (k0 + k); const int ai = base + F.lane; const bool ok = ai < na;
            const int e = ev[k]; int slot = 0;
#pragma unroll
            for (int q = 0; q < NE; ++q) { const unsigned long long mk = __ballot(e == q); if (e == q) slot = run[q] + __popcll(mk & ((1ull << F.lane) - 1ull)); run[q] += __popcll(mk); }
            if (ok) { slots[ai] = slot; WSP(int, WS_TOKS)[2 * (size_t)r0 + ai] = slot; } } }
        for (int base = 576; base < na; base += 64) { const int ai = base + F.lane; const bool ok = ai < na;
            const int e = ok ? WSP(int, WS_TOKE)[2 * (size_t)r0 + ai] : -1; int slot = 0;
#pragma unroll
            for (int q = 0; q < NE; ++q) { const unsigned long long mk = __ballot(e == q); if (e == q) slot = run[q] + __popcll(mk & ((1ull << F.lane) - 1ull)); run[q] += __popcll(mk); }
            if (ok) { slots[ai] = slot; WSP(int, WS_TOKS)[2 * (size_t)r0 + ai] = slot; } }
    }
    __syncthreads();
    for (int a0 = F.wave * 2; a0 < na; a0 += NWAVES * 2) {
        const int s0 = slots[a0], s1 = slots[a0 + 1]; const v4u v = ((const GAS v4u*)(WSP(unsigned char, WS_A1) + (size_t)(r0 + (a0 >> 1)) * D))[F.lane];
        ((GAS v4u*)(WSP(unsigned char, WS_XS8) + (size_t)s0 * D))[F.lane] = v; ((GAS v4u*)(WSP(unsigned char, WS_XS8) + (size_t)s1 * D))[F.lane] = v; }
    { const int gw = blockIdx.x * NWAVES + F.wave, NGW = F.G * NWAVES; int cnt = 0;
      for (int e = 0; e < NE; ++e) { const int p0 = mi[e] + mi[16 + e], p1 = mi[e + 1];
          for (int s = p0; s < p1; ++s, ++cnt) if (cnt % NGW == gw) { GAS v4u* dst = (GAS v4u*)(WSP(unsigned char, WS_XS8) + (size_t)s * D); dst[F.lane] = (v4u){0u, 0u, 0u, 0u}; } } }
    __syncthreads();
}

constexpr float QSCALE = 0.14724319f;
constexpr int MP_CQ_LD = 200, MP_CKV_LD = 136;
__device__ __forceinline__ void phase_mla_prep(Frame& F, int li) { WS_DECL; frame_refresh(F);
    LAS bf16* CQN = (LAS bf16*)F.lds; LAS bf16* CKVN = (LAS bf16*)(F.lds + 64 * MP_CQ_LD * 2);
    const bf16* P = WSP(bf16, WS_P); bf16* QB = WSP(bf16, WS_QB); bf16* KB = WSP(bf16, WS_KB); bf16* VT = WSP(bf16, WS_VT);
    const float* qn = in_ptr(I_QNORM) + li * 192; const float* kvn = in_ptr(I_KVNORM) + li * 128;
    const bf16* WQ = WSP(bf16, WS_WUQT) + (size_t)li * 384 * 192; const bf16* WKV = WSP(bf16, WS_WUKVT) + (size_t)li * 512 * 128;
    const float* RC = WSP(float, WS_ROPE); const float* RS = RC + 4096 * 16;
    const int lane = F.lane, wave = F.wave;
    const int head = wave >> 1, half = wave & 1, fr = lane & 15, kg = lane >> 4;
    for (int item = (blockIdx.x + 64) % F.G; item < NT / 64; item += F.G) {
        const int m0 = item * 64; const bool isctx = m0 >= NL; const int b = isctx ? (m0 - NL) >> 8 : m0 >> 12; const int t0 = isctx ? (m0 - NL) & 255 : m0 & 4095;
        const int ki0 = isctx ? t0 : 256 + t0;
        bf16x8 wq[3][6];
#pragma unroll
        for (int i = 0; i < 3; ++i)
#pragma unroll
            for (int ks = 0; ks < 6; ++ks) wq[i][ks] = *(const GAS bf16x8*)(WQ + (size_t)(96 * head + 16 * (3 * half + i) + fr) * 192 + 32 * ks + 8 * kg);
        v4u rawv[8]; unsigned short kr1[8], kr2[8];
#pragma unroll
        for (int i = 0; i < 8; ++i) { const bf16* pr = P + (size_t)(m0 + wave * 8 + i) * PCOLS; rawv[i] = (v4u){0u, 0u, 0u, 0u}; if (lane < 40) rawv[i] = *(const GAS v4u*)(pr + 8 * lane);
            kr1[i] = 0; kr2[i] = 0; if (lane < 16) { kr1[i] = pr[320 + lane]; kr2[i] = pr[336 + lane]; } }
#pragma unroll
        for (int i = 0; i < 8; ++i) { const int tl = wave * 8 + i; const v4u raw = rawv[i];
            float x[8]; x[0] = bflo(raw.x); x[1] = bfhi(raw.x); x[2] = bflo(raw.y); x[3] = bfhi(raw.y); x[4] = bflo(raw.z); x[5] = bfhi(raw.z); x[6] = bflo(raw.w); x[7] = bfhi(raw.w);
            float ss = 0.f;
#pragma unroll
            for (int j = 0; j < 8; ++j) ss += x[j] * x[j];
            const float sq = wave_sum(lane < 24 ? ss : 0.f), skv = wave_sum((lane >= 24 && lane < 40) ? ss : 0.f);
            const float rq = __builtin_amdgcn_rsqf(sq * (1.f / 192.f) + 1e-6f), rkv = __builtin_amdgcn_rsqf(skv * (1.f / 128.f) + 1e-6f);
            if (lane < 24) { const float* g = qn + 8 * lane; v4u o; o.x = pk2(x[0] * rq * g[0], x[1] * rq * g[1]); o.y = pk2(x[2] * rq * g[2], x[3] * rq * g[3]); o.z = pk2(x[4] * rq * g[4], x[5] * rq * g[5]); o.w = pk2(x[6] * rq * g[6], x[7] * rq * g[7]);
                *(LAS v4u*)(CQN + tl * MP_CQ_LD + 8 * lane) = o; }
            else if (lane < 40) { const int c = 8 * (lane - 24); const float* g = kvn + c; v4u o; o.x = pk2(x[0] * rkv * g[0], x[1] * rkv * g[1]); o.y = pk2(x[2] * rkv * g[2], x[3] * rkv * g[3]); o.z = pk2(x[4] * rkv * g[4], x[5] * rkv * g[5]); o.w = pk2(x[6] * rkv * g[6], x[7] * rkv * g[7]);
                *(LAS v4u*)(CKVN + tl * MP_CKV_LD + c) = o; }
            if (lane < 16) { float x1 = bf2f(kr1[i]), x2 = bf2f(kr2[i]);
                if (!isctx) { const float c = RC[(t0 + tl) * 16 + lane], s = RS[(t0 + tl) * 16 + lane]; const float y1 = x1 * c - x2 * s, y2 = x1 * s + x2 * c; x1 = y1; x2 = y2; }
                const bf16 o1 = (bf16)f2bf(x1), o2 = (bf16)f2bf(x2);
#pragma unroll
                for (int h = 0; h < 4; ++h) { bf16* kr = KB + ((size_t)(b * 4 + h) * KSEQ + ki0 + tl) * 96; kr[64 + lane] = o1; kr[80 + lane] = o2; } }
        }
        __syncthreads();
        const size_t qrow0 = ((size_t)(b * 4 + head) * KSEQ + ki0) * 96;
        { f32x4 acc[3][4];
#pragma unroll
          for (int i = 0; i < 3; ++i)
#pragma unroll
              for (int m = 0; m < 4; ++m) acc[i][m] = (f32x4){0.f, 0.f, 0.f, 0.f};
#pragma unroll
          for (int ks = 0; ks < 6; ++ks)
#pragma unroll
              for (int m = 0; m < 4; ++m) { const bf16x8 xf = *(const LAS bf16x8*)(CQN + (16 * m + fr) * MP_CQ_LD + 32 * ks + 8 * kg);
#pragma unroll
                  for (int i = 0; i < 3; ++i) acc[i][m] = __builtin_amdgcn_mfma_f32_16x16x32_bf16(wq[i][ks], xf, acc[i][m], 0, 0, 0); }
#pragma unroll
          for (int m = 0; m < 4; ++m) { bf16* qr = QB + qrow0 + (size_t)(16 * m + fr) * 96;
              { v2u o; o.x = pk2(acc[0][m][0] * QSCALE, acc[0][m][1] * QSCALE); o.y = pk2(acc[0][m][2] * QSCALE, acc[0][m][3] * QSCALE); *(GAS v2u*)(qr + 48 * half + 4 * kg) = o; }
              f32x4 y1 = acc[1][m], y2 = acc[2][m];
              if (half == 1 && !isctx) { const int t = t0 + 16 * m + fr; const f32x4 c = *(const GAS f32x4*)(RC + t * 16 + 4 * kg), sn = *(const GAS f32x4*)(RS + t * 16 + 4 * kg); y1 = acc[1][m] * c - acc[2][m] * sn; y2 = acc[1][m] * sn + acc[2][m] * c; }
              v2u o1, o2; o1.x = pk2(y1[0] * QSCALE, y1[1] * QSCALE); o1.y = pk2(y1[2] * QSCALE, y1[3] * QSCALE); o2.x = pk2(y2[0] * QSCALE, y2[1] * QSCALE); o2.y = pk2(y2[2] * QSCALE, y2[3] * QSCALE);
              *(GAS v2u*)(qr + 48 * half + 16 + 4 * kg) = o1; *(GAS v2u*)(qr + 48 * half + 32 + 4 * kg) = o2; } }
        bf16x8 wkv[4][4];
#pragma unroll
        for (int nt = 0; nt < 4; ++nt)
#pragma unroll
            for (int ks = 0; ks < 4; ++ks) wkv[nt][ks] = *(const GAS bf16x8*)(WKV + (size_t)(128 * head + 64 * half + 16 * nt + fr) * 128 + 32 * ks + 8 * kg);
        { f32x4 acc[4][4];
#pragma unroll
          for (int nt = 0; nt < 4; ++nt)
#pragma unroll
              for (int m = 0; m < 4; ++m) acc[nt][m] = (f32x4){0.f, 0.f, 0.f, 0.f};
#pragma unroll
          for (int ks = 0; ks < 4; ++ks)
#pragma unroll
              for (int m = 0; m < 4; ++m) { const bf16x8 xf = *(const LAS bf16x8*)(CKVN + (16 * m + fr) * MP_CKV_LD + 32 * ks + 8 * kg);
#pragma unroll
                  for (int nt = 0; nt < 4; ++nt) acc[nt][m] = half == 0 ? __builtin_amdgcn_mfma_f32_16x16x32_bf16(wkv[nt][ks], xf, acc[nt][m], 0, 0, 0) : __builtin_amdgcn_mfma_f32_16x16x32_bf16(xf, wkv[nt][ks], acc[nt][m], 0, 0, 0); }
#pragma unroll
          for (int nt = 0; nt < 4; ++nt)
#pragma unroll
              for (int m = 0; m < 4; ++m) { v2u o; o.x = pk2(acc[nt][m][0], acc[nt][m][1]); o.y = pk2(acc[nt][m][2], acc[nt][m][3]);
                  if (half == 0) *(GAS v2u*)(KB + qrow0 + (size_t)(16 * m + fr) * 96 + 16 * nt + 4 * kg) = o;
                  else *(GAS v2u*)(VT + ((size_t)(b * 4 + head) * 64 + 16 * nt + fr) * KSEQ + ki0 + 16 * m + 4 * kg) = o; } }
        __syncthreads();
    }
}

constexpr int AT_KLD = 104, AT_VLD = 72;
constexpr int AT_KB = 64 * AT_KLD * 2, AT_VB = 64 * AT_VLD * 2, AT_BUF = AT_KB + AT_VB;
__device__ __forceinline__ void phase_attn(Frame& F, int li) { WS_DECL; frame_refresh(F);
    const bf16* QB = WSP(bf16, WS_QB); const bf16* KB = WSP(bf16, WS_KB); const bf16* VT = WSP(bf16, WS_VT); bf16* AO = WSP(bf16, WS_AO);
    const int lane = F.lane, wave = F.wave, tid = F.tid, ql = lane & 31, h2 = lane >> 5;
    const int nunits = 1024 + (li < DEPTH - 1 ? 64 : 0);
    const int c = blockIdx.x, vc = (F.G == 256) ? (c & 7) * 32 + (c >> 3) : c;
    for (int u = vc; u < nunits; u += F.G) {
        int bh, q0, nk; bool isctx = u >= 1024;
        if (!isctx) { bh = u >> 4; q0 = 256 + 256 * (u & 15); nk = KSEQ; } else { bh = u - 1024; q0 = 0; nk = 256; }
        const bf16* Kb = KB + (size_t)bh * KSEQ * 96; const bf16* Vb = VT + (size_t)bh * 64 * KSEQ;
        bf16x8 qf[6];
        { const bf16* qr = QB + ((size_t)bh * KSEQ + q0 + 32 * wave + ql) * 96 + 8 * h2;
#pragma unroll
          for (int ks = 0; ks < 6; ++ks) qf[ks] = *(const GAS bf16x8*)(qr + 16 * ks); }
        f32x16 O0, O1;
#pragma unroll
        for (int r = 0; r < 16; ++r) { O0[r] = 0.f; O1[r] = 0.f; }
        float l_run = 0.f;
        const int kc0 = tid, kc1 = tid + 512; const int vr = tid >> 3, vcn = tid & 7;
        const int ko0 = (kc0 / 12) * (AT_KLD * 2) + (kc0 % 12) * 16, ko1 = (kc1 / 12) * (AT_KLD * 2) + (kc1 % 12) * 16, vo = AT_KB + vr * (AT_VLD * 2) + vcn * 16;
        v4u pk0, pk1 = (v4u){0u, 0u, 0u, 0u}, pv;
#define AT_LOAD(t) do { const GAS v4u* ks_ = (const GAS v4u*)(Kb + (size_t)(t) * 64 * 96); pk0 = ks_[kc0]; if (kc1 < 768) pk1 = ks_[kc1]; pv = *(const GAS v4u*)(Vb + (size_t)vr * KSEQ + (t) * 64 + 8 * vcn); } while (0)
#define AT_STORE(bo) do { LAS unsigned char* b_ = F.lds + (bo); *(LAS v4u*)(b_ + ko0) = pk0; if (kc1 < 768) *(LAS v4u*)(b_ + ko1) = pk1; *(LAS v4u*)(b_ + vo) = pv; } while (0)
#define AT_QK(bo, A0, A1, INIT) do { const LAS unsigned char* b_ = F.lds + (bo); _Pragma("unroll") for (int r = 0; r < 16; ++r) { A0[r] = 0.f; A1[r] = 0.f; } \
            _Pragma("unroll") for (int kh = 0; kh < 2; ++kh) { bf16x8 kf0[3], kf1[3]; \
                _Pragma("unroll") for (int k3 = 0; k3 < 3; ++k3) { const int ks = 3 * kh + k3; kf0[k3] = *(const LAS bf16x8*)(b_ + ql * (AT_KLD * 2) + 32 * ks + 16 * h2); kf1[k3] = *(const LAS bf16x8*)(b_ + (32 + ql) * (AT_KLD * 2) + 32 * ks + 16 * h2); } \
                __builtin_amdgcn_sched_barrier(0); \
                _Pragma("unroll") for (int k3 = 0; k3 < 3; ++k3) { const int ks = 3 * kh + k3; A0 = __builtin_amdgcn_mfma_f32_32x32x16_bf16(kf0[k3], qf[ks], A0, 0, 0, 0); A1 = __builtin_amdgcn_mfma_f32_32x32x16_bf16(kf1[k3], qf[ks], A1, 0, 0, 0); } \
                __builtin_amdgcn_sched_barrier(0); } } while (0)
        const int ntile = nk >> 6;
        v4u qk0, qk1 = (v4u){0u, 0u, 0u, 0u}, qv;
#define AT_LOADB(t) do { const GAS v4u* ks_ = (const GAS v4u*)(Kb + (size_t)(t) * 64 * 96); qk0 = ks_[kc0]; if (kc1 < 768) qk1 = ks_[kc1]; qv = *(const GAS v4u*)(Vb + (size_t)vr * KSEQ + (t) * 64 + 8 * vcn); } while (0)
#define AT_STOREB(bo) do { LAS unsigned char* b_ = F.lds + (bo); *(LAS v4u*)(b_ + ko0) = qk0; if (kc1 < 768) *(LAS v4u*)(b_ + ko1) = qk1; *(LAS v4u*)(b_ + vo) = qv; } while (0)
        AT_LOAD(0); AT_LOADB(1);
        __syncthreads();
        AT_STORE(0); AT_STOREB(AT_BUF);
        AT_LOAD(2); AT_LOADB(3);
        __syncthreads();
        int bo0 = 0, bo1 = AT_BUF, bo2 = 2 * AT_BUF;
        float m_ref = 0.f;
#define AT_BODY(KT, STOREX, LOADX) do { const int kt_ = (KT); \
            if (kt_ + 2 < ntile) STOREX(bo2); if (kt_ + 4 < ntile) LOADX(kt_ + 4); \
            f32x16 S0, S1; AT_QK(bo0, S0, S1, 0); \
            if (__any(m_ref != 0.f)) { _Pragma("unroll") for (int r = 0; r < 16; ++r) { S0[r] -= m_ref; S1[r] -= m_ref; } } \
            float mxa = fmaxf(fmaxf(S0[0], S0[1]), S0[2]), mxb = fmaxf(fmaxf(S0[3], S0[4]), S0[5]), mxc = fmaxf(fmaxf(S1[0], S1[1]), S1[2]), mxd = fmaxf(fmaxf(S1[3], S1[4]), S1[5]); \
            _Pragma("unroll") for (int r = 6; r < 16; r += 2) { mxa = fmaxf(mxa, S0[r]); mxb = fmaxf(mxb, S0[r + 1]); mxc = fmaxf(mxc, S1[r]); mxd = fmaxf(mxd, S1[r + 1]); } \
            float mx = fmaxf(fmaxf(mxa, mxb), fmaxf(mxc, mxd)); \
            if (__any(mx > 64.f || (kt_ == 0 && mx < -64.f))) { mx = fmaxf(mx, __shfl_xor(mx, 32)); const float delta = (mx > 64.f || (kt_ == 0 && mx < -64.f)) ? mx : 0.f; const float alpha = __builtin_amdgcn_exp2f(-delta); m_ref += delta; l_run *= alpha; \
                _Pragma("unroll") for (int r = 0; r < 16; ++r) { O0[r] *= alpha; O1[r] *= alpha; S0[r] -= delta; S1[r] -= delta; } } \
            float ps0 = 0.f, ps1 = 0.f, ps2 = 0.f, ps3 = 0.f; \
            _Pragma("unroll") for (int r = 0; r < 16; r += 2) { S0[r] = __builtin_amdgcn_exp2f(S0[r]); S1[r] = __builtin_amdgcn_exp2f(S1[r]); S0[r + 1] = __builtin_amdgcn_exp2f(S0[r + 1]); S1[r + 1] = __builtin_amdgcn_exp2f(S1[r + 1]); ps0 += S0[r]; ps1 += S1[r]; ps2 += S0[r + 1]; ps3 += S1[r + 1]; } \
            l_run += (ps0 + ps1) + (ps2 + ps3); \
            union { bf16x8 v; unsigned u[4]; } p00, p01, p10, p11; \
            _Pragma("unroll") for (int j = 0; j < 4; ++j) { p00.u[j] = pk2(S0[2 * j], S0[2 * j + 1]); p01.u[j] = pk2(S0[8 + 2 * j], S0[8 + 2 * j + 1]); p10.u[j] = pk2(S1[2 * j], S1[2 * j + 1]); p11.u[j] = pk2(S1[8 + 2 * j], S1[8 + 2 * j + 1]); } \
            const LAS unsigned char* vb = F.lds + bo0 + AT_KB; \
            _Pragma("unroll") for (int dvt = 0; dvt < 2; ++dvt) { const LAS unsigned char* vrow = vb + (32 * dvt + ql) * (AT_VLD * 2) + 8 * h2; union { bf16x8 v; v2u h[2]; } vf[4]; \
                _Pragma("unroll") for (int ss = 0; ss < 4; ++ss) { vf[ss].h[0] = *(const LAS v2u*)(vrow + 2 * (16 * ss)); vf[ss].h[1] = *(const LAS v2u*)(vrow + 2 * (16 * ss + 8)); } \
                __builtin_amdgcn_sched_barrier(0); \
                if (dvt == 0) { O0 = __builtin_amdgcn_mfma_f32_32x32x16_bf16(vf[0].v, p00.v, O0, 0, 0, 0); O0 = __builtin_amdgcn_mfma_f32_32x32x16_bf16(vf[1].v, p01.v, O0, 0, 0, 0); O0 = __builtin_amdgcn_mfma_f32_32x32x16_bf16(vf[2].v, p10.v, O0, 0, 0, 0); O0 = __builtin_amdgcn_mfma_f32_32x32x16_bf16(vf[3].v, p11.v, O0, 0, 0, 0); } \
                else { O1 = __builtin_amdgcn_mfma_f32_32x32x16_bf16(vf[0].v, p00.v, O1, 0, 0, 0); O1 = __builtin_amdgcn_mfma_f32_32x32x16_bf16(vf[1].v, p01.v, O1, 0, 0, 0); O1 = __builtin_amdgcn_mfma_f32_32x32x16_bf16(vf[2].v, p10.v, O1, 0, 0, 0); O1 = __builtin_amdgcn_mfma_f32_32x32x16_bf16(vf[3].v, p11.v, O1, 0, 0, 0); } \
                __builtin_amdgcn_sched_barrier(0); } \
            __syncthreads(); \
            { const int t_ = bo0; bo0 = bo1; bo1 = bo2; bo2 = t_; } } while (0)
        for (int kt = 0; kt < ntile; kt += 2) {
            AT_BODY(kt, AT_STORE, AT_LOAD);
            AT_BODY(kt + 1, AT_STOREB, AT_LOADB);
        }
#undef AT_BODY
#undef AT_LOADB
#undef AT_STOREB
#undef AT_LOAD
#undef AT_STORE
#undef AT_QK
        const float inv = 1.f / (l_run + __shfl_xor(l_run, 32));
        const int b = bh >> 2, head = bh & 3, qi = q0 + 32 * wave + ql;
        const size_t row = isctx ? (size_t)NL + b * 256 + qi : (size_t)b * 4096 + (qi - 256);
        bf16* orow = AO + row * 256 + head * 64 + 4 * h2;
#pragma unroll
        for (int g = 0; g < 4; ++g) { v2u o0, o1; o0.x = pk2(O0[4 * g] * inv, O0[4 * g + 1] * inv); o0.y = pk2(O0[4 * g + 2] * inv, O0[4 * g + 3] * inv); o1.x = pk2(O1[4 * g] * inv, O1[4 * g + 1] * inv); o1.y = pk2(O1[4 * g + 2] * inv, O1[4 * g + 3] * inv);
            *(GAS v2u*)(orow + 8 * g) = o0; *(GAS v2u*)(orow + 32 + 8 * g) = o1; }
    }
}

__device__ __forceinline__ void phase_fin_mla(Frame& F, int li) { WS_DECL; frame_refresh(F);
    const int nrows = li == DEPTH - 1 ? NL : NT; const float* g = in_ptr(I_MLAON) + li * 256; const bf16* AO = WSP(bf16, WS_AO); bf16* MIX = WSP(bf16, WS_A1);
    const int gw = blockIdx.x * NWAVES + F.wave, NGW = F.G * NWAVES; const f32x4 g4 = *(const GAS f32x4*)(g + 4 * F.lane);
    for (int m4 = gw * 4; m4 < nrows; m4 += NGW * 4) { v2u w[4];
#pragma unroll
        for (int i = 0; i < 4; ++i) w[i] = __builtin_nontemporal_load((const GAS v2u*)(AO + (size_t)(m4 + i) * 256 + 4 * F.lane));
#pragma unroll
        for (int i = 0; i < 4; ++i) { f32x4 x; x.x = bflo(w[i].x); x.y = bfhi(w[i].x); x.z = bflo(w[i].y); x.w = bfhi(w[i].y);
            const float r = __builtin_amdgcn_rsqf(wave_sum(x.x * x.x + x.y * x.y + x.z * x.z + x.w * x.w) * (1.f / 256.f) + 1e-6f);
            v2u o; o.x = pk2(x.x * r * g4.x, x.y * r * g4.y); o.y = pk2(x.z * r * g4.z, x.w * r * g4.w); *(GAS v2u*)(MIX + (size_t)(m4 + i) * D + 4 * F.lane) = o; } }
}
__device__ __forceinline__ void phase_fin_zero(Frame& F, int li, int c0) { WS_DECL; frame_refresh(F);
    const int nrows = li == DEPTH - 1 ? NL : NT; bf16* MIX = WSP(bf16, WS_A1); const int gw = blockIdx.x * NWAVES + F.wave, NGW = F.G * NWAVES;
    for (int m = gw; m < nrows; m += NGW) *(GAS v2u*)(MIX + (size_t)m * D + c0 + 4 * F.lane) = (v2u){0u, 0u};
}

__device__ __forceinline__ void phase_pro0b(Frame& F) { WS_DECL; frame_refresh(F);
    const int gt = blockIdx.x * NTHR + F.tid, NGT = F.G * NTHR;
    float* RC = WSP(float, WS_ROPE); float* RS = RC + 4096 * 16;
    for (int i = gt; i < 4096 * 16; i += NGT) { const int t = i >> 4, j = i & 15; const float inv = powf(10000.f, -(float)(j & 7) / 8.f); const float pos = j < 8 ? (float)(t >> 6) : (float)(t & 63);
        const float ang = pos * inv; RC[i] = cosf(ang); RS[i] = sinf(ang); }
    const float* wuq = in_ptr(I_WUQ); const float* wukv = in_ptr(I_WUKV); bf16* WQ = WSP(bf16, WS_WUQT); bf16* WKV = WSP(bf16, WS_WUKVT);
    for (int i = gt; i < DEPTH * 384 * 192; i += NGT) { const int li = i / (384 * 192), r = i % (384 * 192), n = r / 192, k = r % 192; WQ[i] = (bf16)f2bf(wuq[(size_t)li * 192 * 384 + (size_t)k * 384 + n]); }
    for (int i = gt; i < DEPTH * 512 * 128; i += NGT) { const int li = i / (512 * 128), r = i % (512 * 128), n = r / 128, k = r % 128; WKV[i] = (bf16)f2bf(wukv[(size_t)li * 128 * 512 + (size_t)k * 512 + n]); }
}

constexpr int LR_LD = 264;
__device__ __forceinline__ float gelu_tanh(float x) { const float u = 0.7978845608028654f * (x + 0.044715f * x * x * x); const float e = __expf(2.f * u); const float t = 1.f - 2.f / (e + 1.f); return 0.5f * x * (1.f + t); }
template <int PASS>
__device__ __forceinline__ void phase_lru(Frame& F, int li) { WS_DECL; frame_refresh(F);
    LAS bf16* RAW = (LAS bf16*)F.lds; LAS bf16* U = (LAS bf16*)(F.lds + 67 * LR_LD * 2); LAS bf16* HS = (LAS bf16*)(F.lds + 71680); LAS float* HC = (LAS float*)(F.lds + 106496);
    const bf16* P = WSP(bf16, WS_P); bf16* MIX = WSP(bf16, WS_A1); f32x2* SUMM = WSP(f32x2, WS_SUMM);
    const float* cw = in_ptr(I_LCW) + li * 4 * 256; const float* cb = in_ptr(I_LCB) + li * 256;
    const float* lam_ = in_ptr(I_LLAM) + li * 512; const float* br_ = in_ptr(I_LBR) + li * 512; const float* bi_ = in_ptr(I_LBI) + li * 512; const float* on_ = in_ptr(I_LON) + li * 256;
    const bf16* LW = WSP(bf16, WS_LRUW) + (size_t)li * 16 * 4096;
    const int lane = F.lane, wave = F.wave, tid = F.tid, fr = lane & 15, kg = lane >> 4;
    const int nitems = (PASS == 3 && li == DEPTH - 1) ? NL / 64 : NT / 64;
    const int vb_ = PASS == 1 ? (int)((blockIdx.x + 128) % F.G) : (int)((blockIdx.x + 192) % F.G);
    for (int item = vb_; item < nitems; item += F.G) {
        const int m0 = item * 64; const bool isctx = m0 >= NL; const int b = isctx ? (m0 - NL) >> 8 : m0 >> 12; const int t0 = isctx ? (m0 - NL) & 255 : m0 & 4095; const int Ls = isctx ? 256 : 4096;
        const size_t seg0 = isctx ? (size_t)NL + b * 256 : (size_t)b * 4096;
        v4u sv_[5];
        {
#pragma unroll
          for (int u = 0; u < 5; ++u) { const int c = tid + NTHR * u, r = c >> 5, cc = c & 31, t = t0 - 2 + r; sv_[u] = (v4u){0u, 0u, 0u, 0u};
              if (c < 67 * 32 && t >= 0 && t < Ls) sv_[u] = *(const GAS v4u*)(P + (seg0 + t) * PCOLS + 352 + 8 * cc); } }

        if (PASS == 3) {
            const int dd = tid >> 8, chh = tid & 255; const int cj = t0 >> 6, cbase = 1024 + b * 4, lbase = b * 64;
            const int np = dd == 0 ? (isctx ? cj : 4 + cj) : (isctx ? 3 - cj : 4 + 63 - cj);
            float Hc = 0.f;
#pragma unroll 1
            for (int p0 = 0; p0 < np; p0 += 24) { f32x2 sv[24];
#pragma unroll
                for (int e = 0; e < 24; ++e) { const int p = p0 + e; sv[e] = (f32x2){1.f, 0.f};
                    if (p < np) { int cid; if (dd == 0) cid = isctx ? cbase + p : (p < 4 ? cbase + p : lbase + (p - 4)); else cid = isctx ? cbase + 3 - p : (p < 4 ? cbase + 3 - p : lbase + 63 - (p - 4));
                        sv[e] = *(const GAS f32x2*)(SUMM + ((size_t)cid * 2 + dd) * 256 + chh); } }
#pragma unroll
                for (int e = 0; e < 24; ++e) Hc = sv[e].x * Hc + sv[e].y; }
            HC[dd * 256 + chh] = Hc; }
#pragma unroll
        for (int u = 0; u < 5; ++u) { const int c = tid + NTHR * u, r = c >> 5, cc = c & 31; if (c < 67 * 32) *(LAS v4u*)(RAW + r * LR_LD + 8 * cc) = sv_[u]; }
        __syncthreads();
        { const int c2 = tid & 127, tq = tid >> 7; const int ch = 2 * c2;
          float w0[4], w1[4];
#pragma unroll
          for (int j = 0; j < 4; ++j) { w0[j] = cw[j * 256 + ch]; w1[j] = cw[j * 256 + ch + 1]; }
          const float b0 = cb[ch], b1 = cb[ch + 1];
          for (int t = tq * 16; t < tq * 16 + 16; ++t) { float s0 = b0, s1 = b1;
#pragma unroll
              for (int j = 0; j < 4; ++j) { const unsigned w = *(const LAS unsigned*)(RAW + (t + j) * LR_LD + ch); s0 += w0[j] * bflo(w); s1 += w1[j] * bfhi(w); }
              *(LAS unsigned*)(U + t * LR_LD + ch) = pk2(s0, s1); } }
        __syncthreads();
#pragma unroll 1
        for (int ni = 0; ni < 2; ++ni) {
            float yv[4][4];
            const int nt = 2 * wave + ni, nb = nt >> 2, ch = 16 * nt + fr;
            bf16x8 wfr[2][2][2]; float spc[2], brc[2], bic[2];
#pragma unroll
            for (int d = 0; d < 2; ++d) { spc[d] = lam_[d * 256 + ch]; brc[d] = br_[d * 256 + ch]; bic[d] = bi_[d * 256 + ch];
#pragma unroll
                for (int g = 0; g < 2; ++g)
#pragma unroll
                    for (int ks = 0; ks < 2; ++ks) wfr[d][g][ks] = *(const GAS bf16x8*)(LW + ((size_t)((g * 2 + d) * 4 + nb) * 64 + 16 * (nt & 3) + fr) * 64 + 32 * ks + 8 * kg); }
            float uu[4][4];
#pragma unroll
            for (int m = 0; m < 4; ++m)
#pragma unroll
                for (int r = 0; r < 4; ++r) uu[m][r] = bf2f(U[(16 * m + 4 * kg + r) * LR_LD + ch]);
#pragma unroll
            for (int d = 0; d < 2; ++d) {
                f32x4 ar[4], ai[4];
#pragma unroll
                for (int m = 0; m < 4; ++m) { ar[m] = (f32x4){0.f, 0.f, 0.f, 0.f}; ai[m] = (f32x4){0.f, 0.f, 0.f, 0.f}; }
#pragma unroll
                for (int ks = 0; ks < 2; ++ks) {
                    const bf16x8 wr = wfr[d][0][ks], wi = wfr[d][1][ks];
#pragma unroll
                    for (int m = 0; m < 4; ++m) { const bf16x8 xf = *(const LAS bf16x8*)(U + (16 * m + fr) * LR_LD + 64 * nb + 32 * ks + 8 * kg);
                        ar[m] = __builtin_amdgcn_mfma_f32_16x16x32_bf16(xf, wr, ar[m], 0, 0, 0); ai[m] = __builtin_amdgcn_mfma_f32_16x16x32_bf16(xf, wi, ai[m], 0, 0, 0); } }
                const float sp = __logf(1.f + __expf(-spc[d])), brv = brc[d], biv = bic[d];
#pragma unroll
                for (int m = 0; m < 4; ++m)
#pragma unroll
                    for (int r = 0; r < 4; ++r) { const float rg = __builtin_amdgcn_rcpf(1.f + __expf(-(ar[m][r] + brv))), ig = __builtin_amdgcn_rcpf(1.f + __expf(-(ai[m][r] + biv))); const float av = __expf(-8.f * rg * sp);
                        ar[m][r] = av; ai[m][r] = __builtin_amdgcn_sqrtf(fmaxf(1.f - av * av, 0.f)) * (ig * uu[m][r]); }
                float H = 0.f;
                if (PASS == 3) H = HC[d * 256 + ch];
                float Ac = 1.f, Bc = 0.f;
#pragma unroll
                for (int mi = 0; mi < 4; ++mi) { const int m = d == 0 ? mi : 3 - mi;
                    float Al, Bl;
                    if (d == 0) { Al = ar[m][0] * ar[m][1] * ar[m][2] * ar[m][3]; Bl = ((ai[m][0] * ar[m][1] + ai[m][1]) * ar[m][2] + ai[m][2]) * ar[m][3] + ai[m][3]; }
                    else { Al = ar[m][0] * ar[m][1] * ar[m][2] * ar[m][3]; Bl = ((ai[m][3] * ar[m][2] + ai[m][2]) * ar[m][1] + ai[m][1]) * ar[m][0] + ai[m][0]; }
                    float Ag[4], Bg[4];
#pragma unroll
                    for (int g = 0; g < 4; ++g) { Ag[g] = __shfl(Al, fr + 16 * g); Bg[g] = __shfl(Bl, fr + 16 * g); }
                    if (PASS == 1) {
                        float At = 1.f, Bt = 0.f;
#pragma unroll
                        for (int gi = 0; gi < 4; ++gi) { const int g = d == 0 ? gi : 3 - gi; Bt = Ag[g] * Bt + Bg[g]; At = Ag[g] * At; }
                        Bc = At * Bc + Bt; Ac = At * Ac;
                    } else {
                        float s = H, sin_ = H;
#pragma unroll
                        for (int gi = 0; gi < 4; ++gi) { const int g = d == 0 ? gi : 3 - gi; if (g == kg) sin_ = s; s = Ag[g] * s + Bg[g]; }
                        H = s;
                        float x = sin_;
#pragma unroll
                        for (int ri = 0; ri < 4; ++ri) { const int r = d == 0 ? ri : 3 - ri; x = ar[m][r] * x + ai[m][r]; if (d == 0) yv[m][r] = x; else yv[m][r] += x; }
                    }
                }
                if (PASS == 1 && kg == 0) *(GAS f32x2*)(SUMM + ((size_t)item * 2 + d) * 256 + ch) = (f32x2){Ac, Bc};
            }
            if (PASS == 3) {
#pragma unroll
                for (int m = 0; m < 4; ++m)
#pragma unroll
                    for (int r = 0; r < 4; ++r) HS[(16 * m + 4 * kg + r) * LR_LD + ch] = (bf16)f2bf(yv[m][r]);
            }
        }
        if (PASS == 3) {
            __syncthreads();
            const f32x4 on4 = *(const GAS f32x4*)(on_ + 4 * lane);
            v2u gws[8];
#pragma unroll
            for (int i = 0; i < 8; ++i) gws[i] = *(const GAS v2u*)(P + (size_t)(m0 + wave * 8 + i) * PCOLS + 608 + 4 * lane);
#pragma unroll
            for (int i = 0; i < 8; ++i) { const int tl = wave * 8 + i; const v2u hw = *(const LAS v2u*)(HS + tl * LR_LD + 4 * lane); const v2u gw = gws[i];
                f32x4 y; y.x = bflo(hw.x) * gelu_tanh(bflo(gw.x)); y.y = bfhi(hw.x) * gelu_tanh(bfhi(gw.x)); y.z = bflo(hw.y) * gelu_tanh(bflo(gw.y)); y.w = bfhi(hw.y) * gelu_tanh(bfhi(gw.y));
                const float rs = __builtin_amdgcn_rsqf(wave_sum(y.x * y.x + y.y * y.y + y.z * y.z + y.w * y.w) * (1.f / 256.f) + 1e-6f);
                v2u o; o.x = pk2(y.x * rs * on4.x, y.y * rs * on4.y); o.y = pk2(y.z * rs * on4.z, y.w * rs * on4.w);
                *(GAS v2u*)(MIX + (size_t)(m0 + tl) * D + 256 + 4 * lane) = o; }
        }
        __syncthreads();
    }
}

__device__ __forceinline__ void phase_pro0c(Frame& F) { WS_DECL; frame_refresh(F);
    const int gt = blockIdx.x * NTHR + F.tid, NGT = F.G * NTHR; const float* wr = in_ptr(I_LWR); const float* wi = in_ptr(I_LWI); bf16* LW = WSP(bf16, WS_LRUW);
    for (int i = gt; i < DEPTH * 16 * 4096; i += NGT) { const int c = i & 63, dd = (i >> 6) & 63, nb = (i >> 12) & 3, d = (i >> 14) & 1, g = (i >> 15) & 1, li = i >> 16;
        const float* src = g == 0 ? wr : wi; LW[i] = (bf16)f2bf(src[((((size_t)li * 2 + d) * 4 + nb) * 64 + c) * 64 + dd]); }
}

template <int CTRL> __device__ __forceinline__ float dpp_f(float x) { return __builtin_bit_cast(float, __builtin_amdgcn_mov_dpp(__builtin_bit_cast(int, x), CTRL, 0xf, 0xf, true)); }
__device__ __forceinline__ float rowsum16(float x) { x += dpp_f<0x128>(x); x += dpp_f<0x124>(x); x += dpp_f<0x122>(x); x += dpp_f<0x121>(x); return x; }
constexpr int RW_C0 = 864;
constexpr size_t WS_RWUP = WS_LRUW + 512 * 1024;
constexpr size_t WS_GUPT = WS_LRUW + 768 * 1024;
constexpr size_t WS_EA = WS_Y;

__device__ __forceinline__ void phase_pro0e(Frame& F) { WS_DECL; frame_refresh(F);
    const int gt = blockIdx.x * NTHR + F.tid, NGT = F.G * NTHR; const float* wup = in_ptr(I_WUP); const float* aup = in_ptr(I_AUP); bf16* W = WSP(bf16, WS_RWUP);
    for (int i = gt; i < DEPTH * 2 * 2 * 256 * 32; i += NGT) { const int k = i & 31, n = (i >> 5) & 255, wa = (i >> 13) & 1, d = (i >> 14) & 1, li = i >> 15;
        const float* src = wa == 0 ? wup : aup; W[i] = (bf16)f2bf(src[(((size_t)li * 2 + d) * 32 + k) * 256 + n]); }
    { const float* gup = in_ptr(I_GUP); bf16* GT = WSP(bf16, WS_GUPT);
      for (int i = gt; i < DEPTH * 256 * 64; i += NGT) { const int k = i & 63, n = (i >> 6) & 255, li = i >> 14; GT[i] = (bf16)f2bf(gup[((size_t)li * 64 + k) * 256 + n]); } }
}

constexpr int R0_LD = 136, R0_ZLD = 72;
__device__ __forceinline__ void phase_rwkv_r0(Frame& F, int li) { WS_DECL; frame_refresh(F);
    LAS bf16* RAWL = (LAS bf16*)F.lds;
    LAS bf16* ZW = (LAS bf16*)(F.lds + 66 * R0_LD * 2);
    LAS bf16* ZA = ZW + 64 * R0_ZLD;
    const bf16* P = WSP(bf16, WS_P); bf16* EA = WSP(bf16, WS_EA); const bf16* W = WSP(bf16, WS_RWUP) + (size_t)li * 2 * 2 * 256 * 32;
    const float* mup = in_ptr(I_MUP) + li * 960 + 768; const float* mun = in_ptr(I_MUN) + li * 960 + 768; const float* w0 = in_ptr(I_W0) + li * 512; const float* a0 = in_ptr(I_A0) + li * 512;
    const int tid = F.tid, lane = F.lane, wave = F.wave, fr = lane & 15, kg = lane >> 4;
    for (int item = blockIdx.x; item < NT / 64; item += F.G) {
        const int m0 = item * 64; const bool isctx = m0 >= NL; const int t0 = isctx ? (m0 - NL) & 255 : m0 & 4095; const int Ls = isctx ? 256 : 4096; const size_t seg0 = (size_t)m0 - t0;
        __syncthreads();
        { v4u sv_[3];
#pragma unroll
          for (int u = 0; u < 3; ++u) { const int c = tid + NTHR * u, r = c >> 4, cc = c & 15, t = t0 - 1 + r; sv_[u] = (v4u){0u, 0u, 0u, 0u};
              if (c < 66 * 16 && t >= 0 && t < Ls) sv_[u] = *(const GAS v4u*)(P + (seg0 + t) * PCOLS + RW_C0 + 768 + 8 * cc); }
#pragma unroll
          for (int u = 0; u < 3; ++u) { const int c = tid + NTHR * u, r = c >> 4, cc = c & 15; if (c < 66 * 16) *(LAS v4u*)(RAWL + r * R0_LD + 8 * cc) = sv_[u]; } }
        __syncthreads();
        { const int c = tid & 127, tq = tid >> 7; const float mp = mup[c], mn = mun[c];
          for (int tl = tq * 16; tl < tq * 16 + 16; ++tl) { const float x = bf2f(RAWL[(tl + 1) * R0_LD + c]), xp = bf2f(RAWL[tl * R0_LD + c]), xn = bf2f(RAWL[(tl + 2) * R0_LD + c]);
              const float z = x + mp * (xp - x) + mn * (xn - x);
              if (c < 64) { const float e2 = __expf(2.f * z); ZW[tl * R0_ZLD + c] = (bf16)f2bf(1.f - 2.f * __builtin_amdgcn_rcpf(e2 + 1.f)); } else ZA[tl * R0_ZLD + (c - 64)] = (bf16)f2bf(z); } }
        __syncthreads();
        const int d = wave >> 2, hh = wave & 3;
#pragma unroll 1
        for (int nt = 0; nt < 4; ++nt) { const int ch0 = 64 * hh + 16 * nt;
            const bf16x8 wf = *(const GAS bf16x8*)(W + ((size_t)(d * 2 + 0) * 256 + ch0 + fr) * 32 + 8 * kg), af = *(const GAS bf16x8*)(W + ((size_t)(d * 2 + 1) * 256 + ch0 + fr) * 32 + 8 * kg);
            const f32x4 w04 = *(const GAS f32x4*)(w0 + d * 256 + ch0 + 4 * kg), a04 = *(const GAS f32x4*)(a0 + d * 256 + ch0 + 4 * kg);
#pragma unroll
            for (int m = 0; m < 4; ++m) { const bf16x8 zw = *(const LAS bf16x8*)(ZW + (16 * m + fr) * R0_ZLD + 32 * d + 8 * kg), za = *(const LAS bf16x8*)(ZA + (16 * m + fr) * R0_ZLD + 32 * d + 8 * kg);
                f32x4 xw = __builtin_amdgcn_mfma_f32_16x16x32_bf16(wf, zw, (f32x4){0.f, 0.f, 0.f, 0.f}, 0, 0, 0), xa = __builtin_amdgcn_mfma_f32_16x16x32_bf16(af, za, (f32x4){0.f, 0.f, 0.f, 0.f}, 0, 0, 0);
                xw = xw + w04; xa = xa + a04; float e[4], av[4];
#pragma unroll
                for (int r = 0; r < 4; ++r) { e[r] = -0.6065306597126334f * __builtin_amdgcn_rcpf(1.f + __expf(-xw[r])); av[r] = __builtin_amdgcn_rcpf(1.f + __expf(-xa[r])); }
                const size_t tok = (size_t)m0 + 16 * m + fr; v2u oe, oa; oe.x = pk2(e[0], e[1]); oe.y = pk2(e[2], e[3]); oa.x = pk2(av[0], av[1]); oa.y = pk2(av[2], av[3]);
                *(GAS v2u*)(EA + (tok * 4 + d) * 256 + ch0 + 4 * kg) = oe; *(GAS v2u*)(EA + (tok * 4 + 2 + d) * 256 + ch0 + 4 * kg) = oa; } }
    }
    __syncthreads();
}

constexpr int RW_T = 16, RW_NCH = (LCX + SEQ) / RW_T, RW_ROWS = RW_T + 2, RW_LD = 200, RW_P = 72;
constexpr int RW_RAW = 0, RW_RAWB = RW_ROWS * RW_LD * 2;
constexpr int RW_EAB = RW_RAW + 2 * RW_RAWB, RW_EABB = RW_T * 128 * 2;
constexpr int RW_VPITCH = 260, RW_VLWF = RW_T * RW_VPITCH * 2;
constexpr int RW_LWP = 68;
constexpr int RW_VEC = RW_EAB + 2 * RW_EABB, RW_VECB = RW_VLWF + RW_T * RW_LWP * 4;
constexpr int RW_VV = RW_VEC + 2 * RW_VECB;
constexpr int RW_BON = RW_VV + 8 * 1024;
constexpr int RW_ARA = RW_BON + 8 * 64;
constexpr int RW_KB2 = RW_ARA + 2 * 16 * RW_P * 2;
constexpr int RW_AT2 = RW_KB2 + 2 * 32 * RW_P * 2;
constexpr int RW_ARR = RW_AT2 + 4 * 2048;
constexpr int RW_KT = RW_ARR + 4 * 16 * RW_P * 2;
constexpr int RW_BTN = RW_KT + 4 * 2048;
constexpr int RW_CWT = RW_BTN + 4 * 2048;
constexpr int RW_DO = RW_CWT + 4 * 256;
constexpr int RW_DOB = 16 * RW_P * 2 + 3 * 512;
constexpr int RW_BC = RW_DO + 4 * RW_DOB;
constexpr int RW_END = RW_BC + 9 * 256;
static_assert(RW_END <= RING_BYTES, "rwkv lds map");
typedef LAS bf16* lbf;
__device__ __forceinline__ bf16x8 rw_zero8() { return (bf16x8){0, 0, 0, 0, 0, 0, 0, 0}; }
__device__ __forceinline__ bf16x8 rw_k16(const LAS bf16* rowp, int kg) { bf16x8 r = rw_zero8(); if (kg < 2) r = *(const LAS bf16x8*)(rowp + 8 * kg); return r; }
__device__ __forceinline__ bf16x8 rw_perm4(const LAS bf16* rowp, int kg) { union { bf16x8 v; v2u h[2]; } u; u.h[0] = *(const LAS v2u*)(rowp + 4 * kg); u.h[1] = (v2u){0u, 0u}; return u.v; }
__device__ __forceinline__ bf16x8 rw_permK(const LAS bf16* rowp, int kg, int sp) { union { bf16x8 v; v2u h[2]; } u; u.h[0] = *(const LAS v2u*)(rowp + 32 * sp + 4 * kg); u.h[1] = *(const LAS v2u*)(rowp + 32 * sp + 16 + 4 * kg); return u.v; }
__device__ __forceinline__ bf16x8 rw_c4(f32x4 c) { union { bf16x8 v; unsigned u[4]; } x; x.u[0] = pk2(c[0], c[1]); x.u[1] = pk2(c[2], c[3]); x.u[2] = 0u; x.u[3] = 0u; return x.v; }
__device__ __forceinline__ bf16x8 rw_c8(f32x4 c0, f32x4 c1) { union { bf16x8 v; unsigned u[4]; } x; x.u[0] = pk2(c0[0], c0[1]); x.u[1] = pk2(c0[2], c0[3]); x.u[2] = pk2(c1[0], c1[1]); x.u[3] = pk2(c1[2], c1[3]); return x.v; }
__device__ __forceinline__ void rw_st_rows(lbf M, f32x4 c, int fr, int kg) {
#pragma unroll
    for (int r = 0; r < 4; ++r) M[(4 * kg + r) * 16 + fr] = (bf16)f2bf(c[r]); }
__device__ __forceinline__ void rw_st_cols(lbf M, f32x4 c, int fr, int kg, int pitch) {
    v2u o; o.x = pk2(c[0], c[1]); o.y = pk2(c[2], c[3]); *(LAS v2u*)(M + fr * pitch + 4 * kg) = o; }
#define RW_MFMA(a, b, c) __builtin_amdgcn_mfma_f32_16x16x32_bf16(a, b, c, 0, 0, 0)

__device__ __forceinline__ void phase_rwkv_scan(Frame& F, int li) { WS_DECL; frame_refresh(F);
    const bf16* P = WSP(bf16, WS_P); const bf16* EA = WSP(bf16, WS_EA); float* YR = WSP(float, WS_YR); float* BON = WSP(float, WS_BON);

    const int tid = F.tid, lane = F.lane, wave = F.wave, fr = lane & 15, kg = lane >> 4;
    LAS unsigned char* L = F.lds;
    for (int item = blockIdx.x; item < 256; item += F.G) {
        const int vhalf = item & 1, d = (item >> 1) & 1, h = (item >> 2) & 3, b = item >> 4;
        __syncthreads();
        const int pt = (tid - 128) & 255, ps = pt >> 4, pq = pt & 15;
        const int sk = pt >> 2, sq = pt & 3;
        { LAS float* BC = (LAS float*)(L + RW_BC); const float* mup = in_ptr(I_MUP) + li * 960; const float* mun = in_ptr(I_MUN) + li * 960;
          if (tid < 64) { const int c = 64 * h + tid; BC[tid] = mup[c]; BC[64 + tid] = mup[256 + c]; BC[128 + tid] = mup[512 + c]; BC[192 + tid] = mun[c]; BC[256 + tid] = mun[256 + c]; BC[320 + tid] = mun[512 + c];
              BC[384 + tid] = in_ptr(I_KK)[li * 256 + c]; BC[448 + tid] = in_ptr(I_KA)[li * 256 + c]; BC[512 + tid] = in_ptr(I_RK)[li * 256 + c]; } }
        __syncthreads();
        f32x4 S0 = (f32x4){0.f, 0.f, 0.f, 0.f}, S1 = S0, S2 = S0, S3 = S0;
        v4u ra[11];
#pragma unroll
        for (int q = 0; q < 11; ++q) ra[q] = (v4u){0u, 0u, 0u, 0u};
        if (wave < 2) {
#pragma unroll 1
            for (int it = -8; it <= RW_NCH; ++it) {
                if (it >= 0 && it < RW_NCH) {
                    const lbf VV = (lbf)(L + RW_VV + (it & 7) * 1024), ARR = (lbf)(L + RW_ARR + (it & 3) * (16 * RW_P * 2)), KT = (lbf)(L + RW_KT + (it & 3) * 2048), BTN = (lbf)(L + RW_BTN + (it & 3) * 2048);
                    const LAS float* CWT = (const LAS float*)(L + RW_CWT + (it & 3) * 256);
                    const lbf APT = (lbf)(L + RW_DO + (it & 3) * RW_DOB), AMT = APT + 16 * RW_P, ARKT = AMT + 256, ARBTN = ARKT + 256;
                    const f32x4 Z = (f32x4){0.f, 0.f, 0.f, 0.f};
                    const bf16x8 bvv = rw_k16(VV + (16 * wave + fr) * 16, kg);
                    const bf16x8 sb0 = rw_c8(S0, S1), sb1 = rw_c8(S2, S3);
                    f32x4 UT = RW_MFMA(rw_k16(AMT + fr * 16, kg), bvv, Z);
                    UT = RW_MFMA(rw_permK(APT + fr * RW_P, kg, 0), sb0, UT); UT = RW_MFMA(rw_permK(APT + fr * RW_P, kg, 1), sb1, UT);
                    f32x4 YT = RW_MFMA(rw_k16(ARKT + fr * 16, kg), bvv, Z);
                    YT = RW_MFMA(rw_permK(ARR + fr * RW_P, kg, 0), sb0, YT); YT = RW_MFMA(rw_permK(ARR + fr * RW_P, kg, 1), sb1, YT);
                    const bf16x8 ub = rw_c4(UT);
                    YT = RW_MFMA(rw_perm4(ARBTN + fr * 16, kg), ub, YT);
                    { const bool isctx = it < LCX / RW_T;
                      if (!isctx || li < DEPTH - 1) { const int cl = isctx ? it : it - LCX / RW_T; const int Ls = isctx ? LCX : SEQ; const int tlo = d == 0 ? cl * RW_T : Ls - RW_T - cl * RW_T; const size_t seg0 = isctx ? (size_t)NL + b * LCX : (size_t)b * SEQ;
#pragma unroll
                          for (int r = 0; r < 4; ++r) { const int sidx = 4 * kg + r; const int t = d == 0 ? tlo + sidx : tlo + RW_T - 1 - sidx;
                              YR[((size_t)d * NT + seg0 + t) * 256 + 64 * h + 32 * vhalf + 16 * wave + fr] = YT[r]; }
                          if (vhalf == 0 && wave == 0 && lane < RW_T) { const LAS float* BONS = (const LAS float*)(L + RW_BON) + (it & 7) * RW_T; const int t = d == 0 ? tlo + lane : tlo + RW_T - 1 - lane;
                              BON[((size_t)d * NT + seg0 + t) * 4 + h] = BONS[lane]; } } }
                    { f32x4 q = RW_MFMA(rw_k16(KT + (0 + fr) * 16, kg), bvv, S0); q = RW_MFMA(rw_perm4(BTN + (0 + fr) * 16, kg), ub, q); S0 = q * *(const LAS f32x4*)(CWT + 0 + 4 * kg); }
                    { f32x4 q = RW_MFMA(rw_k16(KT + (16 + fr) * 16, kg), bvv, S1); q = RW_MFMA(rw_perm4(BTN + (16 + fr) * 16, kg), ub, q); S1 = q * *(const LAS f32x4*)(CWT + 16 + 4 * kg); }
                    { f32x4 q = RW_MFMA(rw_k16(KT + (32 + fr) * 16, kg), bvv, S2); q = RW_MFMA(rw_perm4(BTN + (32 + fr) * 16, kg), ub, q); S2 = q * *(const LAS f32x4*)(CWT + 32 + 4 * kg); }
                    { f32x4 q = RW_MFMA(rw_k16(KT + (48 + fr) * 16, kg), bvv, S3); q = RW_MFMA(rw_perm4(BTN + (48 + fr) * 16, kg), ub, q); S3 = q * *(const LAS f32x4*)(CWT + 48 + 4 * kg); }
                }
                __syncthreads();
            }
        } else if (wave < 6) {
            int offq[11], ldq[11];
#pragma unroll
            for (int q = 0; q < 11; ++q) { const int c = lane + 64 * q; int o = 0, l = -1;
                if (c < RW_ROWS * 24) { const int r = c / 24, cc = c % 24; o = r * (PCOLS * 2) + 2 * (RW_C0 + 256 * (cc >> 3) + 64 * h + 8 * (cc & 7)); l = RW_RAW + (r * RW_LD + 8 * cc) * 2; }
                else if (c < RW_ROWS * 24 + RW_T * 16) { const int e = c - RW_ROWS * 24, s = e >> 4, cc = e & 15; o = (((d == 0 ? s : RW_T - 1 - s) * 4 + (cc >> 3) * 2 + d) * 256 + 64 * h + 8 * (cc & 7)) * 2; l = RW_EAB + 16 * e; }
                offq[q] = o; ldq[q] = l; }
            const LAS float* BC = (const LAS float*)(L + RW_BC) + 4 * pq;
            const f32x4 mpr = *(const LAS f32x4*)(BC), mpk = *(const LAS f32x4*)(BC + 64), mpv = *(const LAS f32x4*)(BC + 128), mnr = *(const LAS f32x4*)(BC + 192), mnk = *(const LAS f32x4*)(BC + 256), mnv = *(const LAS f32x4*)(BC + 320);
            const f32x4 kk_c = *(const LAS f32x4*)(BC + 384), ka_c = *(const LAS f32x4*)(BC + 448), rk_c = *(const LAS f32x4*)(BC + 512);
#pragma unroll 1
            for (int it = -8; it <= RW_NCH; ++it) {
                { const int ca = it + 5;
                  if (ca >= 0 && ca < RW_NCH && ((ca & 3) == wave - 2)) { const bool isctx = ca < LCX / RW_T; const int cl = isctx ? ca : ca - LCX / RW_T; const int Ls = isctx ? LCX : SEQ; const int tlo = d == 0 ? cl * RW_T : Ls - RW_T - cl * RW_T;
                      const bool edge_lo = tlo == 0, edge_hi = tlo + RW_T == Ls;
#pragma unroll
                      for (int q = 0; q < 11; ++q) { v4u v = ra[q];
                          if (q == 0 && edge_lo && lane < 24) v = (v4u){0u, 0u, 0u, 0u};
                          if (q == 6 && edge_hi && lane >= 24 && lane < 48) v = (v4u){0u, 0u, 0u, 0u};
                          const int bo = (ca & 1) * ((q < 6 || (q == 6 && lane < 48)) ? RW_RAWB : RW_EABB);
                          if (q < 10 || lane < 48) *(LAS v4u*)(L + ldq[q] + bo) = v; } }
                  const int cn = it + 8;
                  if (cn < RW_NCH && ((cn & 3) == wave - 2)) { const bool isctx = cn < LCX / RW_T; const int cl = isctx ? cn : cn - LCX / RW_T; const int Ls = isctx ? LCX : SEQ; const int tlo = d == 0 ? cl * RW_T : Ls - RW_T - cl * RW_T;
                      const long row0 = (long)(isctx ? NL + b * LCX : b * SEQ) + tlo;
                      const char* pb = (const char*)P + (row0 - 1) * (PCOLS * 2);
                      const unsigned delta = (unsigned)(((const char*)EA + row0 * 2048) - pb);
#pragma unroll
                      for (int q = 0; q < 11; ++q) { unsigned o = (unsigned)offq[q]; if (q > 6 || (q == 6 && lane >= 48)) o += delta;
                          ra[q] = *(const GAS v4u*)(pb + o); } } }
                const int cb = it + 4;
                if (cb >= 0 && cb < RW_NCH) {
                    const LAS bf16* RAW = (const LAS bf16*)(L + RW_RAW + (cb & 1) * RW_RAWB); const LAS bf16* EAB = (const LAS bf16*)(L + RW_EAB + (cb & 1) * RW_EABB);
                    const lbf VEC = (lbf)(L + RW_VEC + (cb & 1) * RW_VECB); LAS float* LWF = (LAS float*)(L + RW_VEC + (cb & 1) * RW_VECB + RW_VLWF);
                    const lbf VV = (lbf)(L + RW_VV + (cb & 7) * 1024); LAS float* BONS = (LAS float*)(L + RW_BON) + (cb & 7) * RW_T;
                    const int prow = d == 0 ? ps + 1 : RW_T - ps;
                    f32x4 zr, zk, zv;
                    { const LAS bf16* r0 = RAW + prow * RW_LD + 4 * pq;
#define RW_LD4(p) ({ const v2u w_ = *(const LAS v2u*)(p); (f32x4){bflo(w_.x), bfhi(w_.x), bflo(w_.y), bfhi(w_.y)}; })
                      { const f32x4 x = RW_LD4(r0), xp = RW_LD4(r0 - RW_LD), xn = RW_LD4(r0 + RW_LD); zr = x + mpr * (xp - x) + mnr * (xn - x); }
                      { const f32x4 x = RW_LD4(r0 + 64), xp = RW_LD4(r0 + 64 - RW_LD), xn = RW_LD4(r0 + 64 + RW_LD); zk = x + mpk * (xp - x) + mnk * (xn - x); }
                      { const f32x4 x = RW_LD4(r0 + 128), xp = RW_LD4(r0 + 128 - RW_LD), xn = RW_LD4(r0 + 128 + RW_LD); zv = x + mpv * (xp - x) + mnv * (xn - x); } }
                    const f32x4 lw4 = RW_LD4(EAB + ps * 128 + 4 * pq), a4 = RW_LD4(EAB + ps * 128 + 64 + 4 * pq);
                    const f32x4 kkr = zk * kk_c; const float ss = rowsum16((kkr.x * kkr.x + kkr.y * kkr.y) + (kkr.z * kkr.z + kkr.w * kkr.w));
                    const f32x4 kd = zk * ((a4 - 1.f) * ka_c + 1.f); const f32x4 bq = zr * kd * rk_c; const float bn = rowsum16((bq.x + bq.y) + (bq.z + bq.w));
                    const f32x4 kkn = kkr * __builtin_amdgcn_rsqf(fmaxf(ss, 1e-24f)), kka = kkn * a4;
                    { lbf vp = VEC + ps * RW_VPITCH + 16 * pq;
#pragma unroll
                      for (int i = 0; i < 4; ++i) { v2u o; o.x = pk2(kkn[i], kka[i]); o.y = pk2(kd[i], zr[i]); *(LAS v2u*)(vp + 4 * i) = o; } }
                    *(LAS f32x4*)(LWF + ps * RW_LWP + 4 * pq) = lw4;
                    if ((pq >> 3) == vhalf) { const int v0 = 4 * (pq & 7); VV[(v0 + 0) * 16 + ps] = (bf16)f2bf(zv.x); VV[(v0 + 1) * 16 + ps] = (bf16)f2bf(zv.y); VV[(v0 + 2) * 16 + ps] = (bf16)f2bf(zv.z); VV[(v0 + 3) * 16 + ps] = (bf16)f2bf(zv.w); }
                    if (pq == 0) BONS[ps] = bn;
                }
                const int cc3 = it + 3;
                if (cc3 >= 0 && cc3 < RW_NCH) {
                    const LAS bf16* VEC = (const LAS bf16*)(L + RW_VEC + (cc3 & 1) * RW_VECB); const LAS float* LWF = (const LAS float*)(L + RW_VEC + (cc3 & 1) * RW_VECB + RW_VLWF);
                    const lbf ARA = (lbf)(L + RW_ARA + (cc3 & 1) * (16 * RW_P * 2)), KB2 = (lbf)(L + RW_KB2 + (cc3 & 1) * (32 * RW_P * 2)), AT2 = (lbf)(L + RW_AT2 + (cc3 & 3) * 2048);
                    const lbf ARR = (lbf)(L + RW_ARR + (cc3 & 3) * (16 * RW_P * 2)), KT = (lbf)(L + RW_KT + (cc3 & 3) * 2048), BTN = (lbf)(L + RW_BTN + (cc3 & 3) * 2048); LAS float* CWT = (LAS float*)(L + RW_CWT + (cc3 & 3) * 256);
                    float l4[4];
#pragma unroll
                    for (int j = 0; j < 4; ++j) l4[j] = LWF[(4 * sq + j) * RW_LWP + sk];
                    float cl;
                    { const int own = __builtin_bit_cast(int, (l4[0] + l4[1]) + (l4[2] + l4[3]));
                      const float a1 = __builtin_bit_cast(float, __builtin_amdgcn_update_dpp(0, own, 0x90, 0xf, 0xf, false));
                      const float a2 = __builtin_bit_cast(float, __builtin_amdgcn_update_dpp(0, own, 0x40, 0xf, 0xf, false));
                      const float a3 = __builtin_bit_cast(float, __builtin_amdgcn_update_dpp(0, own, 0x00, 0xf, 0xf, false));
                      cl = ((sq >= 3 ? a3 : 0.f) + (sq >= 2 ? a2 : 0.f)) + (sq >= 1 ? a1 : 0.f); }
                    float cwm = __expf(cl);
                    float atf[4], rtf[4], ktf[4], btf[4];
#pragma unroll
                    for (int j = 0; j < 4; ++j) { const int s = 4 * sq + j; cl += l4[j]; const float cw = __expf(cl), icw = __builtin_amdgcn_rcpf(cw);
                        const v2u vw = *(const LAS v2u*)(VEC + s * RW_VPITCH + 4 * sk); const float kkv = bflo(vw.x), kkav = bfhi(vw.x), kdv = bflo(vw.y), rv = bfhi(vw.y);
                        atf[j] = kkv * cwm; rtf[j] = rv * cw; ktf[j] = kdv * icw; btf[j] = kkav * icw;
                        if (s == RW_T - 1) CWT[sk] = cw;
                        cwm = cw; }
                    unsigned atp[2], ktp[2], bnp[2];
#pragma unroll
                    for (int jp = 0; jp < 2; ++jp) { const int s0 = 4 * sq + 2 * jp; const unsigned a = pk2(atf[2 * jp], atf[2 * jp + 1]), r = pk2(rtf[2 * jp], rtf[2 * jp + 1]), k = pk2(ktf[2 * jp], ktf[2 * jp + 1]), bp = pk2(btf[2 * jp], btf[2 * jp + 1]);
                        ARA[s0 * RW_P + sk] = (bf16)a; ARA[(s0 + 1) * RW_P + sk] = (bf16)(a >> 16); ARR[s0 * RW_P + sk] = (bf16)r; ARR[(s0 + 1) * RW_P + sk] = (bf16)(r >> 16);
                        KB2[s0 * RW_P + sk] = (bf16)k; KB2[(s0 + 1) * RW_P + sk] = (bf16)(k >> 16); KB2[(16 + s0) * RW_P + sk] = (bf16)bp; KB2[(17 + s0) * RW_P + sk] = (bf16)(bp >> 16);
                        atp[jp] = a; ktp[jp] = k; bnp[jp] = bp ^ 0x80008000u; }
                    *(LAS v2u*)(AT2 + sk * 16 + 4 * sq) = (v2u){atp[0], atp[1]}; *(LAS v2u*)(KT + sk * 16 + 4 * sq) = (v2u){ktp[0], ktp[1]}; *(LAS v2u*)(BTN + sk * 16 + 4 * sq) = (v2u){bnp[0], bnp[1]};
                }
                __syncthreads();
            }
        } else {
#pragma unroll 1
            for (int it = -8; it <= RW_NCH; ++it) {
                const int c = it + 2;
                if (c >= 0 && c < RW_NCH && ((c & 1) == (wave & 1))) {
                    const LAS bf16* ARA = (const LAS bf16*)(L + RW_ARA + (c & 1) * (16 * RW_P * 2)); const LAS bf16* KB2 = (const LAS bf16*)(L + RW_KB2 + (c & 1) * (32 * RW_P * 2));
                    const LAS bf16* ARR = (const LAS bf16*)(L + RW_ARR + (c & 3) * (16 * RW_P * 2)); const LAS bf16* AT2 = (const LAS bf16*)(L + RW_AT2 + (c & 3) * 2048);
                    const lbf APT = (lbf)(L + RW_DO + (c & 3) * RW_DOB), AMT = APT + 16 * RW_P, ARKT = AMT + 256, ARBTN = ARKT + 256;
                    const f32x4 Z = (f32x4){0.f, 0.f, 0.f, 0.f};
                    f32x4 gkk = Z, gkkT = Z, grk = Z, gn = Z, gnT = Z, grb = Z;
#pragma unroll
                    for (int ks = 0; ks < 2; ++ks) { const bf16x8 ak = *(const LAS bf16x8*)(KB2 + fr * RW_P + 32 * ks + 8 * kg), ab = *(const LAS bf16x8*)(KB2 + (16 + fr) * RW_P + 32 * ks + 8 * kg);
                        const bf16x8 ba = *(const LAS bf16x8*)(ARA + fr * RW_P + 32 * ks + 8 * kg), br = *(const LAS bf16x8*)(ARR + fr * RW_P + 32 * ks + 8 * kg);
                        gkk = RW_MFMA(ak, ba, gkk); gkkT = RW_MFMA(ba, ak, gkkT); grk = RW_MFMA(ak, br, grk); gn = RW_MFMA(ab, ba, gn); gnT = RW_MFMA(ba, ab, gnT); grb = RW_MFMA(ab, br, grb); }
                    f32x4 w1, w1T;
#pragma unroll
                    for (int r = 0; r < 4; ++r) { const int row = 4 * kg + r;
                        if (!(row < fr)) { gkk[r] = 0.f; gn[r] = 0.f; } if (!(fr < row)) { gkkT[r] = 0.f; gnT[r] = 0.f; } if (!(row <= fr)) { grk[r] = 0.f; grb[r] = 0.f; }
                        const float idt = row == fr ? 1.f : 0.f; w1[r] = idt - gn[r]; w1T[r] = idt - gnT[r]; }
                    const bf16x8 bn = rw_c4(gn), bnT = rw_c4(gnT);
                    const f32x4 n2 = RW_MFMA(bnT, bn, Z), n2T = RW_MFMA(bn, bnT, Z);
                    const bf16x8 b2 = rw_c4(n2), b2T = rw_c4(n2T);
                    const f32x4 n4 = RW_MFMA(b2T, b2, Z), n4T = RW_MFMA(b2, b2T, Z);
                    const bf16x8 b4 = rw_c4(n4), b4T = rw_c4(n4T);
                    const f32x4 n8 = RW_MFMA(b4T, b4, Z);
                    const bf16x8 bw1T = rw_c4(w1T);
                    const f32x4 w2 = RW_MFMA(bw1T, b2, w1), w2T = RW_MFMA(b2, bw1T, w1T);
                    const bf16x8 bw2T = rw_c4(w2T);
                    const f32x4 w3 = RW_MFMA(bw2T, b4, w2), w3T = RW_MFMA(b4, bw2T, w2T);
                    const f32x4 xi = RW_MFMA(rw_c4(w3T), rw_c4(n8), w3);
                    const bf16x8 bx = rw_c4(xi);
                    const f32x4 am = RW_MFMA(rw_c4(gkkT), bx, Z);
                    rw_st_cols(AMT, am, fr, kg, 16); rw_st_cols(ARKT, grk, fr, kg, 16); { f32x4 nb = Z - grb; rw_st_cols(ARBTN, nb, fr, kg, 16); }
#pragma unroll
                    for (int m = 0; m < 4; ++m) { const f32x4 ap = RW_MFMA(rw_perm4(AT2 + (16 * m + fr) * 16, kg), bx, Z);
                        rw_st_cols(APT + 16 * m, ap, fr, kg, RW_P); }
                }
                __syncthreads();
            }
        }
    }
}
struct RwFinRaw { v4u g[2][3]; f32x4 y[2][4]; float b0, b1; };
__device__ __forceinline__ void rwfin_load(RwFinRaw& R, int it, int fr, int kg, const bf16* P, const float* YR, const float* BON) {
    const int hh = it & 3, m = 16 * (it >> 2) + fr; const bool isctx = m >= NL; const int t = isctx ? (m - NL) & 255 : m & 4095; const int Ls = isctx ? 256 : 4096; const bool hp = t > 0, hn = t + 1 < Ls;
    const bf16* pr = P + (size_t)m * PCOLS + RW_C0; const v4u Z4 = (v4u){0u, 0u, 0u, 0u};
#pragma unroll
    for (int ks = 0; ks < 2; ++ks) { const int c = 896 + 32 * ks + 8 * kg; R.g[ks][0] = *(const GAS v4u*)(pr + c); R.g[ks][1] = Z4; R.g[ks][2] = Z4;
        if (hp) R.g[ks][1] = *(const GAS v4u*)(pr - PCOLS + c); if (hn) R.g[ks][2] = *(const GAS v4u*)(pr + PCOLS + c); }
    const int c0 = 64 * hh + 16 * kg;
#pragma unroll
    for (int q = 0; q < 4; ++q) { R.y[0][q] = *(const GAS f32x4*)(YR + (size_t)m * 256 + c0 + 4 * q); R.y[1][q] = *(const GAS f32x4*)(YR + ((size_t)NT + m) * 256 + c0 + 4 * q); }
    R.b0 = BON[(size_t)m * 4 + hh]; R.b1 = BON[((size_t)NT + m) * 4 + hh];
}
__device__ __forceinline__ void phase_fin_rwkv(Frame& F, int li) { WS_DECL; frame_refresh(F);
    const int nrows = li == DEPTH - 1 ? NL : NT; const int lane = F.lane, wave = F.wave, tid = F.tid, fr = lane & 15, kg = lane >> 4;
    LAS bf16* GT = (LAS bf16*)F.lds;
    LAS float* CV = (LAS float*)(F.lds + 256 * 72 * 2);
    const bf16* P = WSP(bf16, WS_P); const float* YR = WSP(float, WS_YR); const float* BON = WSP(float, WS_BON); bf16* MIX = WSP(bf16, WS_A1);
    const float* mup = in_ptr(I_MUP) + li * 960; const float* mun = in_ptr(I_MUN) + li * 960;
    __syncthreads();
    { const bf16* gsrc = WSP(bf16, WS_GUPT) + (size_t)li * 256 * 64;
#pragma unroll
      for (int u = 0; u < 4; ++u) { const int i = tid + NTHR * u, n = i >> 3, part = i & 7; *(LAS v4u*)(GT + n * 72 + 8 * part) = *(const GAS v4u*)(gsrc + n * 64 + 8 * part); } }
    if (tid < 256) { CV[tid] = mup[512 + tid]; CV[256 + tid] = mun[512 + tid]; CV[512 + tid] = in_ptr(I_LNG)[li * 256 + tid]; CV[768 + tid] = in_ptr(I_LNB)[li * 256 + tid]; }
    if (tid >= 256 && tid < 320) { CV[1024 + tid - 256] = mup[896 + tid - 256]; CV[1088 + tid - 256] = mun[896 + tid - 256]; }
    __syncthreads();
    const int nit = nrows / 4, NGW = F.G * NWAVES;
    int it = blockIdx.x * NWAVES + wave;
    RwFinRaw cur; rwfin_load(cur, it < nit ? it : nit - 1, fr, kg, P, YR, BON);
#pragma unroll 1
    while (it < nit) {
        const int nx = it + NGW; RwFinRaw nxt; rwfin_load(nxt, nx < nit ? nx : nit - 1, fr, kg, P, YR, BON);
        const int hh = it & 3, m = 16 * (it >> 2) + fr, c0 = 64 * hh + 16 * kg;
        v4u vr[2][3];
        { const bool isctx = m >= NL; const int t = isctx ? (m - NL) & 255 : m & 4095; const int Ls = isctx ? 256 : 4096; const bool hp = t > 0, hn = t + 1 < Ls; const bf16* pr = P + (size_t)m * PCOLS + RW_C0; const v4u Z4 = (v4u){0u, 0u, 0u, 0u};
#pragma unroll
          for (int e = 0; e < 2; ++e) { vr[e][0] = *(const GAS v4u*)(pr + 512 + c0 + 8 * e); vr[e][1] = Z4; vr[e][2] = Z4;
              if (hp) vr[e][1] = *(const GAS v4u*)(pr - PCOLS + 512 + c0 + 8 * e); if (hn) vr[e][2] = *(const GAS v4u*)(pr + PCOLS + 512 + c0 + 8 * e); } }
        bf16x8 bg[2];
#pragma unroll
        for (int ks = 0; ks < 2; ++ks) { union { bf16x8 v; unsigned u[4]; } o;
            const LAS float* gm = CV + 1024 + 32 * ks + 8 * kg; const f32x4 mpg0 = *(const LAS f32x4*)(gm), mpg1 = *(const LAS f32x4*)(gm + 4), mng0 = *(const LAS f32x4*)(gm + 64), mng1 = *(const LAS f32x4*)(gm + 68);
#pragma unroll
            for (int j = 0; j < 4; ++j) { const unsigned w = cur.g[ks][0][j], wp = cur.g[ks][1][j], wn = cur.g[ks][2][j]; const float x0 = bflo(w), x1 = bfhi(w), p0 = bflo(wp), p1 = bfhi(wp), n0 = bflo(wn), n1 = bfhi(wn);
                const float a0 = (j >> 1 ? mpg1 : mpg0)[2 * (j & 1)], a1 = (j >> 1 ? mpg1 : mpg0)[2 * (j & 1) + 1], b0 = (j >> 1 ? mng1 : mng0)[2 * (j & 1)], b1 = (j >> 1 ? mng1 : mng0)[2 * (j & 1) + 1];
                o.u[j] = pk2(sigmoidf_(x0 + a0 * (p0 - x0) + b0 * (n0 - x0)), sigmoidf_(x1 + a1 * (p1 - x1) + b1 * (n1 - x1))); }
            bg[ks] = o.v; }
        f32x4 acc[4];
#pragma unroll
        for (int q = 0; q < 4; ++q) { const LAS bf16* ar = GT + (64 * hh + 16 * (fr >> 2) + 4 * q + (fr & 3)) * 72 + 8 * kg; const f32x4 z = (f32x4){0.f, 0.f, 0.f, 0.f};
            acc[q] = __builtin_amdgcn_mfma_f32_16x16x32_bf16(*(const LAS bf16x8*)(ar), bg[0], z, 0, 0, 0);
            acc[q] = __builtin_amdgcn_mfma_f32_16x16x32_bf16(*(const LAS bf16x8*)(ar + 32), bg[1], acc[q], 0, 0, 0); }
        f32x4 y[4]; float s1 = 0.f;
#pragma unroll
        for (int q = 0; q < 4; ++q) { y[q] = cur.y[0][q] + cur.y[1][q]; s1 += (y[q].x + y[q].y) + (y[q].z + y[q].w); }
        s1 += __shfl_xor(s1, 16); s1 += __shfl_xor(s1, 32);
        const float mean = s1 * (1.f / 64.f); float s2 = 0.f;
#pragma unroll
        for (int q = 0; q < 4; ++q) { y[q] = y[q] - mean; s2 += (y[q].x * y[q].x + y[q].y * y[q].y) + (y[q].z * y[q].z + y[q].w * y[q].w); }
        s2 += __shfl_xor(s2, 16); s2 += __shfl_xor(s2, 32);
        const float rs = __builtin_amdgcn_rsqf(s2 * (1.f / 64.f) + 64e-5f);
        const float bon = cur.b0 + cur.b1;
        unsigned ow[8];
#pragma unroll
        for (int q = 0; q < 4; ++q) { const int c = c0 + 4 * q;
            const f32x4 mpv = *(const LAS f32x4*)(CV + c), mnv = *(const LAS f32x4*)(CV + 256 + c), lg = *(const LAS f32x4*)(CV + 512 + c), lb = *(const LAS f32x4*)(CV + 768 + c);
            const unsigned w0 = vr[q >> 1][0][2 * (q & 1)], w1 = vr[q >> 1][0][2 * (q & 1) + 1], p0 = vr[q >> 1][1][2 * (q & 1)], p1 = vr[q >> 1][1][2 * (q & 1) + 1], n0 = vr[q >> 1][2][2 * (q & 1)], n1 = vr[q >> 1][2][2 * (q & 1) + 1];
            const f32x4 x = (f32x4){bflo(w0), bfhi(w0), bflo(w1), bfhi(w1)}, xp = (f32x4){bflo(p0), bfhi(p0), bflo(p1), bfhi(p1)}, xn = (f32x4){bflo(n0), bfhi(n0), bflo(n1), bfhi(n1)};
            const f32x4 v = x + mpv * (xp - x) + mnv * (xn - x);
            const f32x4 yn = y[q] * rs * lg + lb;
            const f32x4 o = (yn + v * bon) * acc[q];
            ow[2 * q] = pk2(o.x, o.y); ow[2 * q + 1] = pk2(o.z, o.w); }
        *(GAS v4u*)(MIX + (size_t)m * D + 512 + c0) = (v4u){ow[0], ow[1], ow[2], ow[3]}; *(GAS v4u*)(MIX + (size_t)m * D + 512 + c0 + 8) = (v4u){ow[4], ow[5], ow[6], ow[7]};
        cur = nxt; it = nx;
    }
    __syncthreads();
}

constexpr float HY_DMIN = -3.0701134573253945f, HY_DMAX = -15.350567286626973f;
constexpr int HY_X = 0, HY_TW = 65536, HY_W3 = 98304;
__device__ __forceinline__ float hy_delta(int ch) { return -(HY_DMIN + (float)ch * ((HY_DMAX - HY_DMIN) / 255.f)); }

__device__ __forceinline__ void phase_pro0d(Frame& F) { WS_DECL; frame_refresh(F);
    const int lane = F.lane; const int gw = blockIdx.x * NWAVES + F.wave, NGW = F.G * NWAVES;
    const float* w1 = in_ptr(I_HW1); const float* b1 = in_ptr(I_HB1); const float* w2 = in_ptr(I_HW2); const float* b2 = in_ptr(I_HB2);
    for (int it = gw; it < DEPTH * (SEQ + LCX); it += NGW) {
        const int li = it / (SEQ + LCX), r = it % (SEQ + LCX); const bool isctx = r >= SEQ; const int l = isctx ? r - SEQ : r; const int L = isctx ? LCX : SEQ;
        float z = 0.f;
        if (lane == 0) z = (float)l / (float)(L - 1);
        else if (lane < 33) { const int i = (lane - 1) & 15; const float band = 1e-4f + (float)i * ((15.f - 1e-4f) / 15.f); const float ang = band * (6.283185307179586f / (float)L) * (float)l; z = lane < 17 ? cosf(ang) : -sinf(ang); }
        float h1 = b1[li * 64 + lane];
        for (int i = 0; i < 33; ++i) h1 += __shfl(z, i) * w1[(li * 33 + i) * 64 + lane];
        h1 = sinf(h1);
        float h2 = b2[li * 64 + lane];
        for (int i = 0; i < 64; ++i) h2 += __shfl(h1, i) * w2[(li * 64 + i) * 64 + lane];
        h2 = sinf(h2);
        if (isctx) WSP(float, WS_H2C)[((size_t)li * LCX + l) * 64 + lane] = h2;
        else WSP(float, WS_H2L)[((size_t)li * 64 + lane) * SEQ + l] = h2;
    }
}

typedef f32x2 cpx;
__device__ __forceinline__ cpx cmul(cpx a, cpx b) { return (cpx){a.x * b.x - a.y * b.y, a.x * b.y + a.y * b.x}; }
__device__ __forceinline__ cpx cmulc(cpx a, cpx b) { return (cpx){a.x * b.x + a.y * b.y, a.y * b.x - a.x * b.y}; }
__device__ __forceinline__ cpx cmi(cpx z) { return (cpx){z.y, -z.x}; }
__device__ __forceinline__ int hy_p(int n) { return n ^ ((n >> 5) & 7) ^ (((n >> 6) & 3) << 3); }
__device__ __forceinline__ void hy_build_tw(Frame& F) {
    LAS cpx* TW = (LAS cpx*)(F.lds + HY_TW);
    for (int k = F.tid; k < 4096; k += NTHR) { const float rev = (float)k * (1.f / 8192.f); TW[k] = (cpx){__builtin_amdgcn_cosf(rev), -__builtin_amdgcn_sinf(rev)};     }
}
__device__ __forceinline__ void dft4(cpx x0, cpx x1, cpx x2, cpx x3, cpx& X0, cpx& X1, cpx& X2, cpx& X3) {
    const cpx t0 = x0 + x2, t1 = x0 - x2, t2 = x1 + x3, t3 = cmi(x1 - x3); X0 = t0 + t2; X1 = t1 + t3; X2 = t0 - t2; X3 = t1 - t3; }
__device__ __forceinline__ void dft8(cpx (&a)[8]) {
    const float R2 = 0.7071067811865476f; cpx e[4], o[4];
    dft4(a[0] + a[4], a[1] + a[5], a[2] + a[6], a[3] + a[7], e[0], e[1], e[2], e[3]);
    const cpx d1 = a[1] - a[5], d3 = a[3] - a[7];
    dft4(a[0] - a[4], (cpx){(d1.x + d1.y) * R2, (d1.y - d1.x) * R2}, cmi(a[2] - a[6]), (cpx){(d3.y - d3.x) * R2, -(d3.x + d3.y) * R2}, o[0], o[1], o[2], o[3]);
#pragma unroll
    for (int m = 0; m < 4; ++m) { a[2 * m] = e[m]; a[2 * m + 1] = o[m]; }
}
__device__ __forceinline__ void dft16(cpx (&a)[16]) {
    const float C1 = 0.9238795325112867f, S1 = 0.3826834323650898f, R2 = 0.7071067811865476f;
    cpx e[8], o[8];
#pragma unroll
    for (int k = 0; k < 8; ++k) { e[k] = a[k] + a[k + 8]; o[k] = a[k] - a[k + 8]; }
    o[1] = cmul(o[1], (cpx){C1, -S1}); o[2] = cmul(o[2], (cpx){R2, -R2}); o[3] = cmul(o[3], (cpx){S1, -C1}); o[4] = cmi(o[4]);
    o[5] = cmul(o[5], (cpx){-S1, -C1}); o[6] = cmul(o[6], (cpx){-R2, -R2}); o[7] = cmul(o[7], (cpx){-C1, -S1});
    dft8(e); dft8(o);
#pragma unroll
    for (int m = 0; m < 8; ++m) { a[2 * m] = e[m]; a[2 * m + 1] = o[m]; }
}
template <int R> __device__ __forceinline__ void cconj(cpx (&a)[R]) {
#pragma unroll
    for (int k = 0; k < R; ++k) a[k].y = -a[k].y; }
template <bool INV, bool ZU> __device__ __forceinline__ void hy_pass1(LAS cpx* X, const LAS cpx* TW, int tid) {
    cpx a[16]; const cpx w1 = TW[tid];
#pragma unroll
    for (int k = 0; k < 16; ++k) a[k] = (!INV && ZU && k >= 8) ? (cpx){0.f, 0.f} : X[hy_p(tid + 512 * k)];
    if (!INV) { dft16(a); cpx w = w1;
#pragma unroll
        for (int q = 1; q < 16; ++q) { a[q] = cmul(a[q], w); w = cmul(w, w1); }
    } else { cpx w = w1;
#pragma unroll
        for (int q = 1; q < 16; ++q) { a[q] = cmulc(a[q], w); w = cmul(w, w1); }
        cconj<16>(a); dft16(a); cconj<16>(a); }
#pragma unroll
    for (int k = 0; k < 16; ++k) if (!(INV && ZU && k >= 8)) X[hy_p(tid + 512 * k)] = a[k];
}
template <bool INV, int S, int MUL> __device__ __forceinline__ void hy_pass8(LAS cpx* X, const LAS cpx* TW, int tid) {
#pragma unroll
    for (int h = 0; h < 2; ++h) { const int bf = tid + 512 * h, sub = bf / S, j = bf % S, base = 8 * S * sub + j; cpx a[8]; const cpx w1 = TW[MUL * j];
#pragma unroll
        for (int k = 0; k < 8; ++k) a[k] = X[hy_p(base + S * k)];
        if (!INV) { dft8(a); cpx w = w1;
#pragma unroll
            for (int q = 1; q < 8; ++q) { a[q] = cmul(a[q], w); w = cmul(w, w1); }
        } else { cpx w = w1;
#pragma unroll
            for (int q = 1; q < 8; ++q) { a[q] = cmulc(a[q], w); w = cmul(w, w1); }
            cconj<8>(a); dft8(a); cconj<8>(a); }
#pragma unroll
        for (int k = 0; k < 8; ++k) X[hy_p(base + S * k)] = a[k]; }
}
__device__ __forceinline__ void hy_pass4(LAS cpx* X, int tid, const cpx* spec) {
#pragma unroll
    for (int h = 0; h < 2; ++h) { const int g = tid + 512 * h; cpx a[8];
#pragma unroll
        for (int k = 0; k < 8; ++k) a[k] = X[hy_p(8 * g + k)];
        dft8(a);
        if (spec) {
#pragma unroll
            for (int k2 = 0; k2 < 4; ++k2) { const f32x4 s4 = *(const GAS f32x4*)(spec + 8 * g + 2 * k2); a[2 * k2] = cmul(a[2 * k2], (cpx){s4.x, s4.y}); a[2 * k2 + 1] = cmul(a[2 * k2 + 1], (cpx){s4.z, s4.w}); }
            cconj<8>(a); dft8(a); cconj<8>(a); }
#pragma unroll
        for (int k = 0; k < 8; ++k) X[hy_p(8 * g + k)] = a[k]; }
}
__device__ __forceinline__ void hy_conv_fft(LAS cpx* X, const LAS cpx* TW, int tid, const cpx* spec) {
    hy_pass1<false, true>(X, TW, tid); __syncthreads();
    hy_pass8<false, 64, 16>(X, TW, tid); __syncthreads();
    hy_pass8<false, 8, 128>(X, TW, tid); __syncthreads();
    hy_pass4(X, tid, spec); __syncthreads();
    hy_pass8<true, 8, 128>(X, TW, tid); __syncthreads();
    hy_pass8<true, 64, 16>(X, TW, tid); __syncthreads();
    hy_pass1<true, true>(X, TW, tid); __syncthreads();
}

__device__ __forceinline__ void phase_hy_spec(Frame& F, int li) { WS_DECL; frame_refresh(F);
    LAS cpx* X = (LAS cpx*)(F.lds + HY_X); const LAS cpx* TW = (const LAS cpx*)(F.lds + HY_TW); LAS float* W3 = (LAS float*)(F.lds + HY_W3);
    const int tid = F.tid; const float* w3 = in_ptr(I_HW3) + (size_t)li * 64 * 1024; const float* H2 = WSP(float, WS_H2L) + (size_t)li * 64 * SEQ; cpx* SPEC = WSP(cpx, WS_SPEC);
    __syncthreads();
    hy_build_tw(F);
    for (int item = blockIdx.x; item < 512; item += F.G) {
        const int o = item >> 8, ch = item & 255;
        __syncthreads();
        if (tid < 128) { const int dir = tid >> 6, j = tid & 63; W3[tid] = w3[(size_t)j * 1024 + o * 512 + dir * 256 + ch]; }
        __syncthreads();
        const float delta = hy_delta(ch);
#pragma unroll 1
        for (int i = 0; i < 2; ++i) { const int l0 = 4 * tid + 2048 * i; f32x4 hf = (f32x4){0.f, 0.f, 0.f, 0.f}, hb = hf;
#pragma unroll 4
            for (int j4 = 0; j4 < 16; ++j4) { const f32x4 wf = *(const LAS f32x4*)(W3 + 4 * j4), wb = *(const LAS f32x4*)(W3 + 64 + 4 * j4);
#pragma unroll
                for (int jj = 0; jj < 4; ++jj) { const f32x4 h4 = *(const GAS f32x4*)(H2 + (size_t)(4 * j4 + jj) * SEQ + l0); hf = hf + h4 * wf[jj]; hb = hb + h4 * wb[jj]; } }
#pragma unroll
            for (int e = 0; e < 4; ++e) { const int l = l0 + e; const float win = (__expf(-((float)l * (1.f / 4095.f)) * delta) + 0.05f) * (1.f / 8192.f);
                X[hy_p(l)] = (cpx){hf[e] * win, 0.f};
                if (l == 0) X[hy_p(4096)] = (cpx){0.f, 0.f}; else X[hy_p(8192 - l)] = (cpx){hb[e] * win, 0.f}; } }
        __syncthreads();
        hy_pass1<false, false>(X, TW, tid); __syncthreads();
        hy_pass8<false, 64, 16>(X, TW, tid); __syncthreads();
        hy_pass8<false, 8, 128>(X, TW, tid); __syncthreads();
        hy_pass4(X, tid, nullptr); __syncthreads();
        cpx* dst = SPEC + (size_t)item * 8192;
#pragma unroll
        for (int i = 0; i < 16; ++i) *(GAS cpx*)(dst + tid + 512 * i) = X[hy_p(tid + 512 * i)];
    }
    __syncthreads();
}

struct HyRaw { v4u r[2][3]; unsigned e[2][3]; };
__device__ __forceinline__ void hy_load_raw(HyRaw& R, const bf16* HT, int item, int t0) { const int ch = item >> 3, bp = item & 7;
#pragma unroll
    for (int q = 0; q < 2; ++q)
#pragma unroll
        for (int k = 0; k < 3; ++k) { const bf16* row = HT + (size_t)(256 * k + ch) * NT + (size_t)(2 * bp + q) * SEQ;
            R.r[q][k] = *(const GAS v4u*)(row + t0); const unsigned pm = t0 > 0 ? (unsigned)row[t0 - 1] : 0u, pn = t0 + 8 < SEQ ? (unsigned)row[t0 + 8] : 0u; R.e[q][k] = pm | (pn << 16); }
}
__device__ __forceinline__ void hy_conv8(const v4u raw, unsigned edge, float w0, float w1, float w2, float bias, float (&out)[8]) {
    float p[10];
    p[0] = bflo(edge); p[9] = bfhi(edge);
    p[1] = bflo(raw.x); p[2] = bfhi(raw.x); p[3] = bflo(raw.y); p[4] = bfhi(raw.y); p[5] = bflo(raw.z); p[6] = bfhi(raw.z); p[7] = bflo(raw.w); p[8] = bfhi(raw.w);
#pragma unroll
    for (int e = 0; e < 8; ++e) out[e] = bias + w0 * p[e] + w1 * p[e + 1] + w2 * p[e + 2];
}

__device__ __forceinline__ void phase_hy_conv(Frame& F, int li) { WS_DECL; frame_refresh(F);
    LAS cpx* X = (LAS cpx*)(F.lds + HY_X); const LAS cpx* TW = (const LAS cpx*)(F.lds + HY_TW);
    const int tid = F.tid; const bf16* HT = WSP(bf16, WS_HT); bf16* HOT = WSP(bf16, WS_HOT); const cpx* SPEC = WSP(cpx, WS_SPEC);
    const float* cw = in_ptr(I_HCW) + li * 3 * 768; const float* cb = in_ptr(I_HCB) + li * 768; const float* dsk = in_ptr(I_HD) + li * 512;
    __syncthreads();
    hy_build_tw(F);
    const int t0 = 8 * tid;
    HyRaw cur; hy_load_raw(cur, HT, blockIdx.x < 2048 ? (int)blockIdx.x : 2047, t0);
#pragma unroll 1
    for (int item = blockIdx.x; item < 2048; item += F.G) {
        const int ch = item >> 3, bp = item & 7;
        HyRaw nxt; hy_load_raw(nxt, HT, item + F.G < 2048 ? item + F.G : item, t0);
        float v[2][8], x1[2][8], x2[2][8];
#pragma unroll
        for (int q = 0; q < 2; ++q) {
            hy_conv8(cur.r[q][0], cur.e[q][0], cw[ch], cw[768 + ch], cw[1536 + ch], cb[ch], v[q]);
            hy_conv8(cur.r[q][1], cur.e[q][1], cw[256 + ch], cw[768 + 256 + ch], cw[1536 + 256 + ch], cb[256 + ch], x1[q]);
            hy_conv8(cur.r[q][2], cur.e[q][2], cw[512 + ch], cw[768 + 512 + ch], cw[1536 + 512 + ch], cb[512 + ch], x2[q]); }
        const float d0 = dsk[ch], d1 = dsk[256 + ch];
        __syncthreads();
#pragma unroll
        for (int e = 0; e < 8; ++e) X[hy_p(t0 + e)] = (cpx){v[0][e], v[1][e]};
        __syncthreads();
        hy_conv_fft(X, TW, tid, SPEC + (size_t)ch * 8192);
        float u[2][8];
#pragma unroll
        for (int e = 0; e < 8; ++e) { const cpx y = X[hy_p(t0 + e)]; u[0][e] = x1[0][e] * (y.x + v[0][e] * d0); u[1][e] = x1[1][e] * (y.y + v[1][e] * d0); X[hy_p(t0 + e)] = (cpx){u[0][e], u[1][e]}; }
        __syncthreads();
        hy_conv_fft(X, TW, tid, SPEC + (size_t)(256 + ch) * 8192);
#pragma unroll
        for (int q = 0; q < 2; ++q) { float o[8];
#pragma unroll
            for (int e = 0; e < 8; ++e) { const cpx y = X[hy_p(t0 + e)]; o[e] = x2[q][e] * ((q == 0 ? y.x : y.y) + u[q][e] * d1); }
            v4u w; w.x = pk2(o[0], o[1]); w.y = pk2(o[2], o[3]); w.z = pk2(o[4], o[5]); w.w = pk2(o[6], o[7]);
            *(GAS v4u*)(HOT + (size_t)ch * NT + (size_t)(2 * bp + q) * SEQ + t0) = w; }
        cur = nxt;
    }
    __syncthreads();
}

__device__ __forceinline__ void phase_hy_ctx(Frame& F, int li) { WS_DECL; frame_refresh(F);
    LAS float* KL = (LAS float*)F.lds;
    LAS float* SIG = KL + 1024;
    LAS float* Z1 = SIG + 4096;
    LAS float* Z2 = Z1 + 4096;
    LAS float* W3 = Z2 + 4096;
    const int tid = F.tid; const bf16* HT = WSP(bf16, WS_HT); bf16* HOT = WSP(bf16, WS_HOT);
    const float* w3 = in_ptr(I_HW3) + (size_t)li * 64 * 1024; const float* H2 = WSP(float, WS_H2C) + (size_t)li * LCX * 64;
    const float* cw = in_ptr(I_HCW) + li * 3 * 768; const float* cb = in_ptr(I_HCB) + li * 768; const float* dsk = in_ptr(I_HD) + li * 512;
    for (int ch = blockIdx.x; ch < 256; ch += F.G) {
        __syncthreads();
        if (tid < 256) { const int od = tid >> 6, j = tid & 63; W3[tid] = w3[(size_t)j * 1024 + (od >> 1) * 512 + (od & 1) * 256 + ch]; }
        __syncthreads();
        { const int o = tid >> 8, l = tid & 255; const float* hr = H2 + (size_t)l * 64; float hf = 0.f, hb = 0.f;
#pragma unroll 4
          for (int j4 = 0; j4 < 16; ++j4) { const f32x4 hv = *(const GAS f32x4*)(hr + 4 * j4); const f32x4 wf = *(const LAS f32x4*)(W3 + (2 * o) * 64 + 4 * j4), wb = *(const LAS f32x4*)(W3 + (2 * o + 1) * 64 + 4 * j4);
              hf += hv.x * wf.x; hb += hv.x * wb.x; hf += hv.y * wf.y; hb += hv.y * wb.y; hf += hv.z * wf.z; hb += hv.z * wb.z; hf += hv.w * wf.w; hb += hv.w * wb.w; }
          const float win = __expf(-((float)l * (1.f / 255.f)) * hy_delta(ch)) + 0.05f;
          KL[o * 512 + 256 + l] = hf * win; if (l > 0) KL[o * 512 + 256 - l] = hb * win; else KL[o * 512] = 0.f; }
        { const int q = tid >> 8, t = tid & 255;
#pragma unroll 2
          for (int bp = 0; bp < 8; ++bp) { const int b = 2 * bp + q; const size_t off = (size_t)NL + (size_t)b * LCX;
            float zz[3];
#pragma unroll
            for (int k = 0; k < 3; ++k) { const int c = 256 * k + ch; const bf16* row = HT + (size_t)c * NT + off;
                const float pm = t > 0 ? bf2f(row[t - 1]) : 0.f, p0 = bf2f(row[t]), pp = t + 1 < LCX ? bf2f(row[t + 1]) : 0.f;
                zz[k] = cb[c] + cw[c] * pm + cw[768 + c] * p0 + cw[1536 + c] * pp; }
            SIG[b * 256 + t] = zz[0]; Z1[b * 256 + t] = zz[1]; Z2[b * 256 + t] = zz[2]; } }
        __syncthreads();
        const float d0 = dsk[ch], d1 = dsk[256 + ch]; const int t0 = 4 * (tid & 63);
#pragma unroll 1
        for (int rd = 0; rd < 2; ++rd) { const int b = 8 * rd + (tid >> 6); const size_t off = (size_t)NL + (size_t)b * LCX;
            f32x4 u;
#pragma unroll 1
            for (int o = 0; o < 2; ++o) { const LAS float* kp = KL + o * 512 + t0 + 252; const LAS float* sp = SIG + b * 256;
                f32x4 acc = (f32x4){0.f, 0.f, 0.f, 0.f};
#pragma unroll 4
                for (int s0 = 0; s0 < 256; s0 += 4) { const f32x4 k0 = *(const LAS f32x4*)(kp - s0), k1 = *(const LAS f32x4*)(kp - s0 + 4), sg = *(const LAS f32x4*)(sp + s0);
                    acc.x += k1.x * sg.x; acc.x += k0.w * sg.y; acc.x += k0.z * sg.z; acc.x += k0.y * sg.w;
                    acc.y += k1.y * sg.x; acc.y += k1.x * sg.y; acc.y += k0.w * sg.z; acc.y += k0.z * sg.w;
                    acc.z += k1.z * sg.x; acc.z += k1.y * sg.y; acc.z += k1.x * sg.z; acc.z += k0.w * sg.w;
                    acc.w += k1.w * sg.x; acc.w += k1.z * sg.y; acc.w += k1.y * sg.z; acc.w += k1.x * sg.w; }
                if (o == 0) { const f32x4 z0 = *(const LAS f32x4*)(SIG + b * 256 + t0), z1 = *(const LAS f32x4*)(Z1 + b * 256 + t0); u = z1 * (acc + z0 * d0);
                    __syncthreads();
                    *(LAS f32x4*)(SIG + b * 256 + t0) = u;
                    __syncthreads(); }
                else { const f32x4 z2 = *(const LAS f32x4*)(Z2 + b * 256 + t0); const f32x4 y = z2 * (acc + u * d1);
                    v2u w; w.x = pk2(y.x, y.y); w.y = pk2(y.z, y.w); *(GAS v2u*)(HOT + (size_t)ch * NT + off + t0) = w; } }
        }
    }
    __syncthreads();
}

constexpr int HF_LD = 72;
__device__ __forceinline__ void phase_fin_hyena(Frame& F, int li) { WS_DECL; frame_refresh(F);
    LAS bf16* T = (LAS bf16*)F.lds;
    const int nrows = li == DEPTH - 1 ? NL : NT; const int tid = F.tid, lane = F.lane, wave = F.wave; const bf16* HOT = WSP(bf16, WS_HOT); bf16* MIX = WSP(bf16, WS_A1);
    const f32x4 g4 = *(const GAS f32x4*)(in_ptr(I_HON) + li * 256 + 4 * lane);
    for (int item = blockIdx.x; item < nrows / 64; item += F.G) { const int m0 = item * 64;
        __syncthreads();
        { const int ch = tid >> 1, hf = tid & 1; const bf16* src = HOT + (size_t)ch * NT + m0 + 32 * hf;
#pragma unroll
          for (int k = 0; k < 4; ++k) *(LAS v4u*)(T + ch * HF_LD + 32 * hf + 8 * k) = __builtin_nontemporal_load((const GAS v4u*)(src + 8 * k)); }
        __syncthreads();
        for (int i = 0; i < 8; ++i) { const int tl = wave * 8 + i;
            f32x4 x; x.x = bf2f(T[(4 * lane) * HF_LD + tl]); x.y = bf2f(T[(4 * lane + 1) * HF_LD + tl]); x.z = bf2f(T[(4 * lane + 2) * HF_LD + tl]); x.w = bf2f(T[(4 * lane + 3) * HF_LD + tl]);
            const float r = __builtin_amdgcn_rsqf(wave_sum(x.x * x.x + x.y * x.y + x.z * x.z + x.w * x.w) * (1.f / 256.f) + 1e-6f);
            v2u o; o.x = pk2(x.x * r * g4.x, x.y * r * g4.y); o.y = pk2(x.z * r * g4.z, x.w * r * g4.w); *(GAS v2u*)(MIX + (size_t)(m0 + tl) * D + 768 + 4 * lane) = o; }
    }
    __syncthreads();
}
#define MIX_HYENA 1

#define GRID_BAR() do { XcdBarrier bar_; bar_.leader = (F.wave == 0 && mk_lane() == 0); bar_.bar = (unsigned*)(ws_ptr() + WS_CTL) + CW_BAR; bar_.x = xb_xcc_id(); bar_.st = (volatile LAS unsigned*)(F.lds + LDSCTL_OFF) + 8; xcd_barrier(bar_); } while (0)

#ifndef PROBE_MASK
#define PROBE_MASK 0
#endif
#define TS_MARK(k) do { if (PROBE_MASK && blockIdx.x == 0 && F.wave == 0 && mk_lane() == 0) { LAS unsigned long long* ts_ = (LAS unsigned long long*)(F.lds + LDSCTL_OFF + 128); const unsigned long long now_ = wall_clock64(); if ((PROBE_MASK >> (k)) & 1) ts_[1] += now_ - ts_[0]; ts_[0] = now_; } } while (0)
template <int li>
__device__ __forceinline__ void layer_fwd(Frame& F) {
        const int nrows = li == DEPTH - 1 ? NL : NT; unsigned char* const ws = ws_ptr();
        phase_hy_spec(F, li);
        TS_MARK(23);
        { pg8::Gemm g{WSP(bf16, WS_A1), WSP(bf16, WS_WINT) + (size_t)li * PCOLS * D, NT, PCOLS, D, WSP(bf16, WS_WHYT) + (size_t)li * HYC * D, WSP(bf16, WS_A1)};
          pg8::DualOrder S; S.init(NT, PCOLS, HYC, NT, F.G, (int)blockIdx.x);
          pg8::EpiStore2 E{WSP(bf16, WS_P), PCOLS, WSP(bf16, WS_HT), NT};
          pg8::gemm_phase<pg8::EpiStore2, pg8::DualOrder, true, true>(F.lds, g, S, E, F.wave); }
        GRID_BAR();
        TS_MARK(0);
        phase_rwkv_r0(F, li);
        TS_MARK(10);
        phase_mla_prep(F, li);
        TS_MARK(11);
        phase_lru<1>(F, li);
        __syncthreads();
        TS_MARK(12);
        phase_hy_conv(F, li);
        TS_MARK(13);
        if (li < DEPTH - 1) phase_hy_ctx(F, li);
        TS_MARK(14);
        GRID_BAR();
        TS_MARK(1);
        phase_rwkv_scan(F, li);
        __syncthreads();
        TS_MARK(15);
        phase_attn(F, li);
        __syncthreads();
        TS_MARK(16);
        phase_lru<3>(F, li);
        TS_MARK(17);
        GRID_BAR();
        TS_MARK(2);
        phase_fin_mla(F, li);
        TS_MARK(18);
        phase_fin_rwkv(F, li);
        TS_MARK(19);
        phase_fin_hyena(F, li);
        TS_MARK(20);
        GRID_BAR();
        TS_MARK(3);
        { pg8::Gemm g{WSP(bf16, WS_A1), WSP(bf16, WS_WOUTT) + (size_t)li * D * D, nrows, D, D}; pg8::StaticOrder S; S.init(nrows, D, F.G, (int)blockIdx.x);
          pg8::EpiStore E{WSP(bf16, WS_Y), D, 0, D / 256};
          pg8::gemm_phase<pg8::EpiStore, pg8::StaticOrder, true, true>(F.lds, g, S, E, F.wave); }
        GRID_BAR();
        TS_MARK(4);
        phase_ln1<true>(F, li);
        TS_MARK(21);
        if (li & 1) phase_moe_weights(F, li);
        TS_MARK(22);
        GRID_BAR();
        TS_MARK(5);
        if (!(li & 1)) {
            const int j = li >> 1;
#if DENSE_FFN2_F8
            { pg8::Gemm g{(const pg8::bf16_t*)WSP(unsigned char, WS_A1), (const pg8::bf16_t*)(WSP(unsigned char, WS_WGUT) + (size_t)j * 2 * FFD * D), nrows, 2 * FFD, D / 2}; pg8::StaticOrder S; S.init(nrows, 2 * FFD, F.G, (int)blockIdx.x);
              pg8::EpiSwiGLU8 E{WSP(unsigned char, WS_H), FFD, 0, 2 * FFD / 256};
              pg8::gemm_phase<pg8::EpiSwiGLU8, pg8::StaticOrder, true, true, true, 124>(F.lds, g, S, E, F.wave); }
            GRID_BAR();
            TS_MARK(6);
            { pg8::Gemm g{(const pg8::bf16_t*)WSP(unsigned char, WS_H), (const pg8::bf16_t*)(WSP(unsigned char, WS_WDT) + (size_t)j * D * FFD), nrows, D, FFD / 2}; pg8::StaticOrder S; S.init(nrows, D, F.G, (int)blockIdx.x);
              pg8::EpiStore E{WSP(bf16, WS_Y), D, 0, D / 256};
              pg8::gemm_phase<pg8::EpiStore, pg8::StaticOrder, true, true, true, 123>(F.lds, g, S, E, F.wave); }
            GRID_BAR();
            TS_MARK(7);
#else
            { pg8::Gemm g{(const pg8::bf16_t*)WSP(unsigned char, WS_A1), (const pg8::bf16_t*)(WSP(unsigned char, WS_WGUT) + (size_t)j * 2 * FFD * D), nrows, 2 * FFD, D / 2}; pg8::StaticOrder S; S.init(nrows, 2 * FFD, F.G, (int)blockIdx.x);
              pg8::EpiSwiGLU E{WSP(bf16, WS_H), FFD, 0, 2 * FFD / 256};
              pg8::gemm_phase<pg8::EpiSwiGLU, pg8::StaticOrder, true, true, true, 124>(F.lds, g, S, E, F.wave); }
            GRID_BAR();
            TS_MARK(6);
            { pg8::Gemm g{WSP(bf16, WS_H), WSP(bf16, WS_WDT) + (size_t)j * D * FFD, nrows, D, FFD}; pg8::StaticOrder S; S.init(nrows, D, F.G, (int)blockIdx.x);
              pg8::EpiStore E{WSP(bf16, WS_Y), D, 0, D / 256};
              pg8::gemm_phase<pg8::EpiStore, pg8::StaticOrder, true, true>(F.lds, g, S, E, F.wave); }
            GRID_BAR();
            TS_MARK(7);
#endif
        } else {
            phase_moe_slots(F, li);
            GRID_BAR();
            TS_MARK(6);
            const int ntiles = __builtin_amdgcn_readfirstlane(((LAS int*)(F.lds + LDS_MOEI))[48]);
            const PG8_LAS unsigned char* tile_e = (const PG8_LAS unsigned char*)(F.lds + LDS_TILEE);
#pragma unroll 1
            for (int ch = 0; ch < MOE_NCHUNK; ++ch) {
                const int t0 = ch * MOE_CHUNK_TILES; int nM = ntiles - t0; nM = nM < 0 ? 0 : (nM > MOE_CHUNK_TILES ? MOE_CHUNK_TILES : nM);
                { pg8::Gemm g{(const pg8::bf16_t*)WSP(unsigned char, WS_XS8), (const pg8::bf16_t*)WSP(unsigned char, WS_M8GU), 0, 0, D / 2}; pg8::MoeOrder S; S.init(nM, 2 * FFE / 256, F.G, (int)blockIdx.x, t0, t0, tile_e);
                  pg8::EpiSwiGLU8 E{WSP(unsigned char, WS_HM8), FFE, t0, 2 * FFE / 256};
                  pg8::gemm_phase<pg8::EpiSwiGLU8, pg8::MoeOrder, true, true, true, 124>(F.lds, g, S, E, F.wave); }
                GRID_BAR();
                TS_MARK(7);
                { pg8::Gemm g{(const pg8::bf16_t*)WSP(unsigned char, WS_HM8), (const pg8::bf16_t*)WSP(unsigned char, WS_M8D), 0, 0, FFE / 2}; pg8::MoeOrder S; S.init(nM, D / 256, F.G, (int)blockIdx.x, t0, 0, tile_e);
                  pg8::EpiStore E{WSP(bf16, WS_Y2), D, t0, D / 256};
                  pg8::gemm_phase<pg8::EpiStore, pg8::MoeOrder, true, true, true, 123>(F.lds, g, S, E, F.wave); }
                GRID_BAR();
                TS_MARK(7);
            }
        }
        phase_ln2<true>(F, li);
        if (li < DEPTH - 1) GRID_BAR();
        TS_MARK(8);
}

__global__ void __launch_bounds__(NTHR, 2) mk_fwd(Args a) {
    extern __shared__ __attribute__((aligned(16))) unsigned char lds_raw[];
    Frame F; F.lds = (LAS unsigned char*)lds_raw; F.tid = threadIdx.x; F.lane = F.tid & 63; F.wave = __builtin_amdgcn_readfirstlane(F.tid >> 6); F.G = gridDim.x;
    for (int u = F.tid; u < (LDS_BYTES - LDSCTL_OFF) / 4; u += NTHR) ((LAS unsigned*)(F.lds + LDSCTL_OFF))[u] = 0u;
    __syncthreads();
    (void)xcd_barrier_post((unsigned*)(ws_ptr() + WS_CTL) + CW_BAR, (volatile LAS unsigned*)(F.lds + LDSCTL_OFF) + 8, F.tid == 0);

    TS_MARK(31);
    phase_pro0(F);
    TS_MARK(24);
    phase_pro0b(F);
    phase_pro0c(F);
    phase_pro0d(F);
    phase_pro0e(F);
    TS_MARK(25);
    GRID_BAR();
    TS_MARK(26);
    phase_hin0(F);
    GRID_BAR();
    TS_MARK(9);
    layer_fwd<0>(F); layer_fwd<1>(F); layer_fwd<2>(F); layer_fwd<3>(F);
    if (PROBE_MASK && blockIdx.x == 0 && F.wave == 0 && mk_lane() == 0) { LAS unsigned long long* ts_ = (LAS unsigned long long*)(F.lds + LDSCTL_OFF + 128); const unsigned long long t0_ = wall_clock64(), w_ = ts_[1]; while (wall_clock64() - t0_ < w_) __builtin_amdgcn_s_sleep(8); }
}

extern "C" void kernel_launch(void* const* d_in, const int* in_sizes, int n_in, void* d_out, int out_size, void* d_ws, size_t ws_size, hipStream_t stream) {
    static int grid = 0;
    if (grid == 0) {
        if (n_in != N_INPUTS || out_size != NL * D || ws_size < WS_END) { fprintf(stderr, "kernel_launch: unexpected shapes (n_in %d out %d ws %zu)\n", n_in, out_size, ws_size); grid = -1; return; }
        int dev = 0, cus = 0, per_cu = 0;
        if (hipGetDevice(&dev) != hipSuccess || hipDeviceGetAttribute(&cus, hipDeviceAttributeMultiprocessorCount, dev) != hipSuccess) { grid = -1; return; }
        if (hipFuncSetAttribute((const void*)mk_fwd, hipFuncAttributeMaxDynamicSharedMemorySize, LDS_BYTES) != hipSuccess) { fprintf(stderr, "kernel_launch: hipFuncSetAttribute failed\n"); grid = -1; return; }
        if (hipOccupancyMaxActiveBlocksPerMultiprocessor(&per_cu, (const void*)mk_fwd, NTHR, LDS_BYTES) != hipSuccess || per_cu < 1) fprintf(stderr, "kernel_launch: occupancy query reports %d\n", per_cu);
        (void)hipGetLastError();
        grid = cus > 256 ? 256 : cus;
    }
    if (grid < 0) return;
    if (hipMemsetAsync((char*)d_ws + WS_CTL, 0, CTL_ZERO_BYTES, stream) != hipSuccess) return;
    Args a{};
    for (int i = 0; i < N_INPUTS; ++i) a.in[i] = (const float*)d_in[i];
    a.out = (float*)d_out; a.ws = (unsigned char*)d_ws;
    hipLaunchKernelGGL(mk_fwd, dim3(grid), dim3(NTHR), LDS_BYTES, stream, a);
    const hipError_t le = hipPeekAtLastError();
    if (le != hipSuccess) fprintf(stderr, "kernel_launch: launch failed: %s\n", hipGetErrorName(le));
}
```

```cpp
#include <hip/hip_runtime.h>
#include <cstdio>
#include <cstdint>
#define GAS __attribute__((address_space(1)))
#define LAS __attribute__((address_space(3)))
__device__ __forceinline__ int mk_lane() { int l; asm volatile("v_mbcnt_lo_u32_b32 %0, -1, 0\n\tv_mbcnt_hi_u32_b32 %0, -1, %0" : "=v"(l)); return l; }
namespace pg8 {
#define PG8_LAS __attribute__((address_space(3)))
typedef unsigned short bf16_t;
typedef short bf16x8 __attribute__((ext_vector_type(8)));
typedef float f32x4 __attribute__((ext_vector_type(4)));
typedef unsigned u32x4 __attribute__((ext_vector_type(4)));
constexpr int BM = 256, BK = 64, HALF = 128, HTB = HALF * BK * 2  , STAGE_BYTES = 8 * HTB, NXCD = 8, WGM = 16;

__host__ __device__ __forceinline__ int lds_byte(int r, int c) { const int st = (r >> 4) * 2 + (c >> 5), rr = r & 15, cc = c & 31, ob = rr * 64 + cc * 2; return st * 1024 + (ob ^ (((ob >> 9) & 1) << 5)); }
__host__ __device__ __forceinline__ void stage_rc(int b, int& R, int& C) { const int st = b / 1024, sb = b % 1024, swz = sb ^ (((sb >> 9) & 1) << 5); R = (st >> 1) * 16 + swz / 64; C = (st & 1) * 32 + (swz % 64) / 2; }
__host__ __device__ __forceinline__ int perm32(int rho) { const int n = rho >> 4, i = rho & 15; return 8 * (i >> 2) + 4 * n + (i & 3); }

struct Unit { int pm, pn, g; };
struct Gemm { const bf16_t* A; const bf16_t* Bt; int M, N, K; const bf16_t* A2 = nullptr; const bf16_t* Bt2 = nullptr; };

struct StaticOrder {
    int nM, nN, nwg, G, c;
    __host__ __device__ void init(int M, int N, int G_, int c_) { nM = M / BM; nN = N / BM; nwg = nM * nN; G = G_; c = c_; }
    __host__ __device__ bool next(int i, Unit& u) const {
        const long L = (long)i * G + c; if (L >= nwg) return false;
        int wgid = (int)L; { const int q = nwg / NXCD, r = nwg % NXCD, xcd = wgid % NXCD, off = wgid / NXCD; wgid = (xcd < r ? xcd * (q + 1) : r * (q + 1) + (xcd - r) * q) + off; }
        const int nig = WGM * nN, gid = wgid / nig, fm = gid * WGM, gsz = (nM - fm) < WGM ? (nM - fm) : WGM;
        u.pm = fm + ((wgid % nig) % gsz); u.pn = (wgid % nig) / gsz; u.g = 0; return true;
    }
    __device__ __forceinline__ void a_ready(const Unit&) const {}
    __device__ __forceinline__ void done(const Unit&) const {}
};

__device__ __forceinline__ unsigned cvt_pk_bf16(float lo, float hi) { unsigned r; asm volatile("v_cvt_pk_bf16_f32 %0, %1, %2" : "=v"(r) : "v"(lo), "v"(hi)); return r; }
typedef float f32x2 __attribute__((ext_vector_type(2)));
__device__ __forceinline__ f32x2 gelu_pk(f32x2 v) {
    const f32x2 av = __builtin_elementwise_abs(v), d = av * 0.2316418882f + 1.0f;
    f32x2 t; t.x = __builtin_amdgcn_rcpf(d.x); t.y = __builtin_amdgcn_rcpf(d.y);
    f32x2 q = t * 0.5307027145f + (-0.7265760135f); q = q * t + 0.7107068705f; q = q * t + (-0.142248368f); q = q * t + 0.127414796f; q = q * t;
    const f32x2 s = (v * v) * (-0.72134752044f);
    f32x2 e; e.x = __builtin_amdgcn_exp2f(s.x); e.y = __builtin_amdgcn_exp2f(s.y);
    const f32x2 m = v * (q * e), r = v - m;
    f32x2 o; o.x = v.x < 0.f ? m.x : r.x; o.y = v.y < 0.f ? m.y : r.y; return o;
}

template <int ACT  > struct EpiBf16 {
    static constexpr bool PERM = true, AFTER_DRAIN = false; static_assert(ACT == 0 || ACT == 1, "EpiBf16: ACT is 0 (none) or 1 (gelu_pk)");
    bf16_t* O; int ldc; const float* bias; int split_cols; size_t split_stride; float scale0;
    __device__ __forceinline__ void operator()(const f32x4 (&acc)[2][2][4][2], const Unit& u, int wr, int wc, int fr, int fq) const {
        const int row0 = u.pm * BM + wr * 64 + fr; int colt = u.pn * BM; bf16_t* base = O;
        float sc = 1.f; if (split_cols) { const int t = colt / split_cols; base += (size_t)t * split_stride; colt -= t * split_cols; if (t == 0) sc = scale0; }
        const int col0 = colt + wc * 32 + 8 * fq, bcol0 = u.pn * BM + wc * 32 + 8 * fq;
        f32x4 bv[2][2];
#pragma unroll
        for (int bj = 0; bj < 2; ++bj)
#pragma unroll
            for (int n = 0; n < 2; ++n) bv[bj][n] = bias ? *(const f32x4*)(bias + bcol0 + bj * HALF + 4 * n) : (f32x4){0.f, 0.f, 0.f, 0.f};
#pragma unroll
        for (int ai = 0; ai < 2; ++ai)
#pragma unroll
            for (int m = 0; m < 4; ++m) { bf16_t* rowp = base + (size_t)(row0 + ai * HALF + m * 16) * ldc + col0;
#pragma unroll
                for (int bj = 0; bj < 2; ++bj) { f32x4 v0 = acc[ai][bj][m][0] + bv[bj][0], v1 = acc[ai][bj][m][1] + bv[bj][1];
                    if (ACT == 1) { f32x2 a = gelu_pk((f32x2){v0[0], v0[1]}), b = gelu_pk((f32x2){v0[2], v0[3]}), c = gelu_pk((f32x2){v1[0], v1[1]}), d = gelu_pk((f32x2){v1[2], v1[3]});
                        v0 = (f32x4){a.x, a.y, b.x, b.y}; v1 = (f32x4){c.x, c.y, d.x, d.y}; }
                    v0 = v0 * sc; v1 = v1 * sc; u32x4 w; w.x = cvt_pk_bf16(v0[0], v0[1]); w.y = cvt_pk_bf16(v0[2], v0[3]); w.z = cvt_pk_bf16(v1[0], v1[1]); w.w = cvt_pk_bf16(v1[2], v1[3]);
                    *(u32x4*)(rowp + bj * HALF) = w; } }
    }
};
typedef int pg8_v8i __attribute__((ext_vector_type(8))); typedef int pg8_v4i __attribute__((ext_vector_type(4)));
__device__ __forceinline__ pg8_v8i pg8_cat8(bf16x8 a, bf16x8 b) { return __builtin_shufflevector(__builtin_bit_cast(pg8_v4i, a), __builtin_bit_cast(pg8_v4i, b), 0, 1, 2, 3, 4, 5, 6, 7); }
template <class Epi, class Sched, bool ALIGN_EPI = false, bool SP2 = false, bool F8 = false, int WSCALE = 127>
__device__ __forceinline__ void gemm_phase(PG8_LAS unsigned char* lds, const Gemm g, const Sched& S, const Epi& E, int wave_idx) {
    int tid_ = wave_idx * 64 + mk_lane(); asm volatile("" : "+v"(tid_));
    const int tid = tid_, wid = __builtin_amdgcn_readfirstlane(tid >> 6), lane = tid & 63, wr = wid >> 2, wc = wid & 3, fr = lane & 15, fq = lane >> 4;
    const int K = g.K, nt = K / BK;
    unsigned voffA[2], voffB[2];
#pragma unroll
    for (int i = 0; i < 2; ++i) { int R, C; stage_rc(tid * 16 + i * 8192, R, C); const int Rb = Epi::PERM ? ((R & ~31) + perm32(R & 31)) : R;
        voffA[i] = (unsigned)(R * K + C) * 2u; voffB[i] = (unsigned)(Rb * K + C) * 2u; }
    const size_t kstep = (size_t)(BK * 2);
    const size_t hstep = (size_t)HALF * K * 2;
    const size_t tstep = 2 * hstep;
    const unsigned ldsw = (unsigned)wid * 1024u;
    int aoffk[2], boffk[2];
    if constexpr (F8) { aoffk[0] = lds_byte(wr * 64 + fr, (2 * (fq & 1)) * 8) + (fq >> 1) * 1024; aoffk[1] = lds_byte(wr * 64 + fr, (2 * (fq & 1) + 1) * 8) + (fq >> 1) * 1024;
        boffk[0] = lds_byte(wc * 32 + fr, (2 * (fq & 1)) * 8) + (fq >> 1) * 1024; boffk[1] = lds_byte(wc * 32 + fr, (2 * (fq & 1) + 1) * 8) + (fq >> 1) * 1024; }
    else { aoffk[0] = lds_byte(wr * 64 + fr, fq * 8); aoffk[1] = aoffk[0] + 1024; boffk[0] = lds_byte(wc * 32 + fr, fq * 8); boffk[1] = boffk[0] + 1024; }
#define PG8_SA(b, h) (((b) * 2 + (h)) * HTB)
#define PG8_SB(b, h) ((4 + (b) * 2 + (h)) * HTB)
#define PG8_STAGE(bufoff, gbase, voff) do { const char* gb_ = (const char*)(gbase); _Pragma("unroll") for (int _i = 0; _i < 2; ++_i) { unsigned keep_; \
        asm volatile("s_mov_b32 %0, m0\n\ts_mov_b32 m0, %2\n\ts_nop 0\n\tglobal_load_lds_dwordx4 %1, %3\n\ts_mov_b32 m0, %0" : "=&s"(keep_) : "v"((voff)[_i]), "s"((unsigned)(size_t)(lds + (bufoff) + ldsw + _i * 8192)), "s"(gb_) : "memory"); } } while (0)
#define PG8_LDA(dst, b, h) do { if constexpr (F8) { _Pragma("unroll") for (int m = 0; m < 4; ++m) dst##8[m] = *(const PG8_LAS pg8_v8i*)(lds + PG8_SA(b, h) + aoffk[0] + m * 2048); } else { _Pragma("unroll") for (int m = 0; m < 4; ++m) _Pragma("unroll") for (int k = 0; k < 2; ++k) dst[m][k] = *(const PG8_LAS bf16x8*)(lds + PG8_SA(b, h) + aoffk[k] + m * 2048); } } while (0)
#define PG8_LDB(dst, b, h) do { if constexpr (F8) { _Pragma("unroll") for (int n = 0; n < 2; ++n) dst##8[n] = *(const PG8_LAS pg8_v8i*)(lds + PG8_SB(b, h) + boffk[0] + n * 2048); } else { _Pragma("unroll") for (int n = 0; n < 2; ++n) _Pragma("unroll") for (int k = 0; k < 2; ++k) dst[n][k] = *(const PG8_LAS bf16x8*)(lds + PG8_SB(b, h) + boffk[k] + n * 2048); } } while (0)
#define PG8_MMA(ai, bj, At, Bt) do { __builtin_amdgcn_s_setprio(1); _Pragma("unroll") for (int m = 0; m < 4; ++m) _Pragma("unroll") for (int n = 0; n < 2; ++n) { \
        if constexpr (F8) acc[ai][bj][m][n] = __builtin_amdgcn_mfma_scale_f32_16x16x128_f8f6f4(Bt##8[n], At##8[m], acc[ai][bj][m][n], 0, 0, 0, wsc_, 0, wsc_);     \
        else { _Pragma("unroll") for (int k = 0; k < 2; ++k) acc[ai][bj][m][n] = __builtin_amdgcn_mfma_f32_16x16x32_bf16(Bt[n][k], At[m][k], acc[ai][bj][m][n], 0, 0, 0); } } __builtin_amdgcn_s_setprio(0); } while (0)
#define PG8_WAIT_V(n) asm volatile("s_waitcnt vmcnt(" #n ")" ::: "memory")
#define PG8_WAIT_L(n) asm volatile("s_waitcnt lgkmcnt(" #n ")" ::: "memory")
#define PG8_BAR __builtin_amdgcn_s_barrier()
#define PG8_SCHED __builtin_amdgcn_sched_barrier(0)
    int wsc_ = WSCALE; asm volatile("" : "+v"(wsc_));
    Unit cur, nxt; int ui = 0;
    if (!S.next(0, cur)) return;
    f32x4 acc[2][2][4][2];
#pragma unroll
    for (int a = 0; a < 2; ++a)
#pragma unroll
        for (int b = 0; b < 2; ++b)
#pragma unroll
            for (int m = 0; m < 4; ++m)
#pragma unroll
                for (int n = 0; n < 2; ++n) acc[a][b][m][n] = (f32x4){0.f, 0.f, 0.f, 0.f};
    bf16x8 At[4][2], B0[2][2], B1[2][2];
    pg8_v8i At8[4], B08[2], B18[2];
    const char* cA = (const char*)(cur.g ? g.A2 : g.A) + (size_t)cur.pm * tstep; const char* cB = (const char*)(cur.g ? g.Bt2 : g.Bt) + (size_t)cur.pn * tstep;
    S.a_ready(cur);
    if constexpr (SP2) {
        PG8_STAGE(PG8_SB(0, 0), cB, voffB); PG8_STAGE(PG8_SB(0, 1), cB + hstep, voffB); PG8_STAGE(PG8_SA(0, 0), cA, voffA); PG8_STAGE(PG8_SA(0, 1), cA + hstep, voffA);
        if (wr == 1) PG8_BAR;
        PG8_WAIT_V(2); PG8_BAR;
        PG8_STAGE(PG8_SB(1, 0), cB + kstep, voffB); PG8_STAGE(PG8_SA(1, 0), cA + kstep, voffA); PG8_STAGE(PG8_SB(1, 1), cB + hstep + kstep, voffB);
        PG8_WAIT_V(6); PG8_BAR;
    } else {
        PG8_STAGE(PG8_SB(0, 0), cB, voffB); PG8_STAGE(PG8_SA(0, 0), cA, voffA); PG8_STAGE(PG8_SB(0, 1), cB + hstep, voffB); PG8_STAGE(PG8_SA(0, 1), cA + hstep, voffA);
        if (wr == 1) PG8_BAR;
        PG8_WAIT_V(4); PG8_BAR;
        PG8_STAGE(PG8_SB(1, 0), cB + kstep, voffB); PG8_STAGE(PG8_SA(1, 0), cA + kstep, voffA); PG8_STAGE(PG8_SB(1, 1), cB + hstep + kstep, voffB);
        PG8_WAIT_V(6); PG8_BAR;
    }
    for (;;) {
        const bool has_next = S.next(ui + 1, nxt);
        const char* nA = has_next ? (const char*)(nxt.g ? g.A2 : g.A) + (size_t)nxt.pm * tstep : cA; const char* nB = has_next ? (const char*)(nxt.g ? g.Bt2 : g.Bt) + (size_t)nxt.pn * tstep : cB;
#pragma unroll 1
        for (int t = 0; t < nt; t += 2) {
            const bool last = (t == nt - 2);
            const char* a1 = cA + (size_t)(t + 1) * kstep;
            const char* a2 = last ? nA : cA + (size_t)(t + 2) * kstep; const char* b2 = last ? nB : cB + (size_t)(t + 2) * kstep;
            const char* a3 = a2 + kstep; const char* b3 = b2 + kstep;
            if (last && has_next) S.a_ready(nxt);
            if constexpr (SP2) {
            PG8_LDB(B0, 0, 0); PG8_LDB(B1, 0, 1); PG8_SCHED; PG8_LDA(At, 0, 0); PG8_STAGE(PG8_SA(1, 1), a1 + hstep, voffA);
            PG8_WAIT_V(8); PG8_WAIT_L(0); PG8_BAR; PG8_MMA(0, 0, At, B0); PG8_MMA(0, 1, At, B1); PG8_BAR; PG8_SCHED;
            PG8_LDA(At, 0, 1); PG8_STAGE(PG8_SB(0, 0), b2, voffB); PG8_STAGE(PG8_SB(0, 1), b2 + hstep, voffB); PG8_STAGE(PG8_SA(0, 0), a2, voffA);
            PG8_WAIT_V(8); PG8_WAIT_L(0); PG8_BAR; PG8_MMA(1, 0, At, B0); PG8_MMA(1, 1, At, B1); PG8_BAR; PG8_SCHED;
            PG8_LDB(B0, 1, 0); PG8_LDB(B1, 1, 1); PG8_SCHED; PG8_LDA(At, 1, 0); PG8_STAGE(PG8_SA(0, 1), a2 + hstep, voffA);
            PG8_WAIT_V(8); PG8_WAIT_L(0); PG8_BAR; PG8_MMA(0, 0, At, B0); PG8_MMA(0, 1, At, B1); PG8_BAR; PG8_SCHED;
            PG8_LDA(At, 1, 1); PG8_STAGE(PG8_SB(1, 0), b3, voffB); PG8_STAGE(PG8_SB(1, 1), b3 + hstep, voffB); PG8_STAGE(PG8_SA(1, 0), a3, voffA);
            PG8_WAIT_V(8); PG8_WAIT_L(0); PG8_BAR; PG8_MMA(1, 0, At, B0); PG8_MMA(1, 1, At, B1); PG8_BAR; PG8_SCHED;
            } else {
            PG8_LDB(B0, 0, 0); PG8_SCHED; PG8_LDA(At, 0, 0); PG8_STAGE(PG8_SA(1, 1), a1 + hstep, voffA);
            PG8_WAIT_L(8); PG8_BAR; PG8_WAIT_L(0); PG8_MMA(0, 0, At, B0); PG8_BAR; PG8_SCHED;
            PG8_LDB(B1, 0, 1); PG8_STAGE(PG8_SB(0, 0), b2, voffB);
            PG8_BAR; PG8_WAIT_L(0); PG8_MMA(0, 1, At, B1); PG8_BAR;
            PG8_LDA(At, 0, 1); PG8_STAGE(PG8_SA(0, 0), a2, voffA);
            PG8_BAR; PG8_WAIT_L(0); PG8_MMA(1, 0, At, B0); PG8_BAR; PG8_SCHED;
            PG8_STAGE(PG8_SB(0, 1), b2 + hstep, voffB);
            PG8_WAIT_V(6); PG8_BAR; PG8_MMA(1, 1, At, B1); PG8_BAR;
            PG8_LDB(B0, 1, 0); PG8_SCHED; PG8_LDA(At, 1, 0); PG8_STAGE(PG8_SA(0, 1), a2 + hstep, voffA);
            PG8_WAIT_L(8); PG8_BAR; PG8_WAIT_L(0); PG8_MMA(0, 0, At, B0); PG8_BAR; PG8_SCHED;
            PG8_LDB(B1, 1, 1); PG8_STAGE(PG8_SB(1, 0), b3, voffB);
            PG8_BAR; PG8_WAIT_L(0); PG8_MMA(0, 1, At, B1); PG8_BAR;
            PG8_LDA(At, 1, 1); PG8_STAGE(PG8_SA(1, 0), a3, voffA);
            PG8_BAR; PG8_WAIT_L(0); PG8_MMA(1, 0, At, B0); PG8_BAR; PG8_SCHED;
            PG8_STAGE(PG8_SB(1, 1), b3 + hstep, voffB);
            PG8_WAIT_V(6); PG8_BAR; PG8_MMA(1, 1, At, B1); PG8_BAR;
            }
        }
        if constexpr (ALIGN_EPI) { if (wr == 0) PG8_BAR; }
        if constexpr (!Epi::AFTER_DRAIN) { { int pm_ = cur.pm, pn_ = cur.pn; asm volatile("" : "+s"(pm_), "+s"(pn_)); cur.pm = pm_; cur.pn = pn_; }
            { int t2_ = mk_lane(); asm volatile("" : "+v"(t2_)); E(acc, cur, wr, wc, t2_ & 15, (t2_ & 63) >> 4); }
            S.done(cur); }
        if (!has_next) break;
#pragma unroll
        for (int a = 0; a < 2; ++a)
#pragma unroll
            for (int b = 0; b < 2; ++b)
#pragma unroll
                for (int m = 0; m < 4; ++m)
#pragma unroll
                    for (int n = 0; n < 2; ++n) acc[a][b][m][n] = (f32x4){0.f, 0.f, 0.f, 0.f};
        cur = nxt; cA = nA; cB = nB; ++ui;
        if constexpr (ALIGN_EPI) { if (wr == 1) PG8_BAR; }
    }
    PG8_WAIT_V(0);
    if constexpr (!ALIGN_EPI) { if (wr == 0) PG8_BAR; }
    PG8_BAR;
    if constexpr (Epi::AFTER_DRAIN) { E.fused(acc, cur, wr, wc, fr, fq, lds, wid, lane); S.done(cur); }
#undef PG8_SA
#undef PG8_SB
#undef PG8_STAGE
#undef PG8_LDA
#undef PG8_LDB
#undef PG8_MMA
#undef PG8_WAIT_V
#undef PG8_WAIT_L
#undef PG8_BAR
#undef PG8_SCHED
}
}

typedef unsigned short bf16;
typedef unsigned v4u __attribute__((ext_vector_type(4)));
typedef unsigned v2u __attribute__((ext_vector_type(2)));
typedef float f32x4 __attribute__((ext_vector_type(4)));
typedef float f32x2 __attribute__((ext_vector_type(2)));
typedef float f32x16 __attribute__((ext_vector_type(16)));
typedef short bf16x8 __attribute__((ext_vector_type(8)));
typedef short s16x4 __attribute__((ext_vector_type(4)));
typedef GAS unsigned gu32;

constexpr int D = 1024, NB = 16, SEQ = 4096, LCX = 256, DEPTH = 4;
constexpr int NL = NB * SEQ, NC = NB * LCX, NT = NL + NC;
constexpr int N_IN = 2592, PCOLS = 2048, D_OFF = 1824, HYC = 768;
constexpr int FFD = 2816, FFE = 3584, NE = 8;
constexpr float ALPHA = 1.6817928305074292f;
constexpr int NWAVES = 8, NTHR = 512;
constexpr int KSEQ = SEQ + LCX;

enum { I_X = 0, I_C, I_CTX, I_CCTX, I_ADAW, I_ADAB, I_WIN, I_QNORM, I_KVNORM, I_WUQ, I_WUKV, I_MLAON, I_LCW, I_LCB, I_LWR, I_LBR, I_LWI, I_LBI, I_LLAM, I_LON,
       I_MUP, I_MUN, I_W0, I_WUP, I_A0, I_AUP, I_GUP, I_KK, I_KA, I_RK, I_LNG, I_LNB, I_HCW, I_HCB, I_HW1, I_HB1, I_HW2, I_HB2, I_HW3, I_HD, I_HON,
       I_WOUT, I_LN1G, I_LN1B, I_LN2G, I_LN2B, I_FG, I_FU, I_FD, I_ROUTER, I_MG, I_MU, I_MD, N_INPUTS };

constexpr size_t MiB = 1u << 20;
constexpr size_t WS_CTL = 0, CTL_ZERO_BYTES = 1 * MiB;
constexpr size_t WS_MOD = 1 * MiB;
constexpr size_t WS_ROPE = 3 * MiB;
constexpr size_t WS_H2L = 4 * MiB;
constexpr size_t WS_H2C = 8 * MiB;
constexpr size_t WS_LRUW = 9 * MiB;
constexpr size_t WS_WUQT = 10 * MiB;
constexpr size_t WS_WUKVT = 11 * MiB;
constexpr size_t WS_SUMM = 12 * MiB;
constexpr size_t WS_BON = 17 * MiB;
constexpr size_t WS_TOKE = 20 * MiB;
constexpr size_t WS_TOKG = 21 * MiB;
constexpr size_t WS_TOKS = 22 * MiB;
constexpr size_t WS_BLKCNT = 23 * MiB;
constexpr size_t WS_SPEC = 24 * MiB;
constexpr size_t WS_WINT = 56 * MiB;
constexpr size_t WS_WHYT = 72 * MiB;
constexpr size_t WS_WOUTT = 78 * MiB;
constexpr size_t WS_WGUT = 86 * MiB;
constexpr size_t WS_WDT = 108 * MiB;
constexpr size_t WS_XC = 120 * MiB;
constexpr size_t WS_A1 = 136 * MiB;
constexpr size_t WS_ARENA = 272 * MiB;
constexpr size_t WS_P = WS_ARENA;
constexpr size_t WS_HT = 544 * MiB;
constexpr size_t WS_QB = 646 * MiB;
constexpr size_t WS_KB = 697 * MiB;
constexpr size_t WS_VT = 748 * MiB;
constexpr size_t WS_AO = 782 * MiB;
constexpr size_t WS_HOT = 816 * MiB;
constexpr size_t WS_YR = 850 * MiB;
constexpr size_t WS_Y = 986 * MiB;
constexpr size_t WS_H = WS_ARENA;
constexpr size_t WS_MGU = WS_ARENA;
constexpr size_t WS_MD = 384 * MiB;
constexpr size_t WS_XS = 440 * MiB;
constexpr size_t WS_HM = 716 * MiB;
constexpr size_t WS_END = 1122 * MiB;
constexpr size_t WS_M8GU = WS_ARENA;
constexpr size_t WS_M8D = 328 * MiB;
constexpr size_t WS_XS8 = 356 * MiB;
constexpr size_t WS_Y2 = 494 * MiB;
constexpr size_t WS_HM8 = 770 * MiB;
constexpr int MOE_MAX_TILES = 552, MOE_NCHUNK = 3, MOE_CHUNK_TILES = 192;
static_assert(WS_HM8 + (size_t)MOE_CHUNK_TILES * 256 * FFE <= WS_END && WS_M8GU + (size_t)8 * 2 * FFE * D <= WS_M8D && WS_M8D + (size_t)8 * D * FFE <= WS_XS8 && WS_XS8 + (size_t)141312 * D <= WS_Y2 && WS_Y2 + (size_t)141312 * D * 2 <= WS_HM8, "moe fp8 map");
static_assert(WS_H + (size_t)NT * FFD * 2 <= WS_QB + 51 * MiB, "dense hidden");

#ifndef DENSE_FFN2_F8
#define DENSE_FFN2_F8 1
#endif
constexpr int CW_DYN = 32768, LN_DYN = 48;
constexpr int CW_BAR = 4096;

constexpr int RING_BYTES = 131072;
constexpr int LDSCTL_OFF = RING_BYTES;
constexpr int LDS_TILEE = LDSCTL_OFF + 256;
constexpr int LDS_MOEI = LDSCTL_OFF + 1024;
constexpr int LDS_BYTES = 147456;

#define LDS_WAIT() asm volatile("s_waitcnt lgkmcnt(0)" ::: "memory")
#define VM_WAIT() asm volatile("s_waitcnt vmcnt(0)" ::: "memory")
typedef __bf16 hwbf16x2 __attribute__((ext_vector_type(2)));
__device__ __forceinline__ unsigned pk2(float lo, float hi) { const f32x2 v = {lo, hi}; const hwbf16x2 b = __builtin_convertvector(v, hwbf16x2); return __builtin_bit_cast(unsigned, b); }
__device__ __forceinline__ unsigned f2bf(float f) { return pk2(f, 0.f) & 0xffffu; }
__device__ __forceinline__ unsigned pk4_fp8(float a, float b, float c, float d) { int w = __builtin_amdgcn_cvt_pk_fp8_f32(a, b, 0, false); w = __builtin_amdgcn_cvt_pk_fp8_f32(c, d, w, true); return (unsigned)w; }
__device__ __forceinline__ float bf2f(unsigned b) { return __builtin_bit_cast(float, b << 16); }
__device__ __forceinline__ float bflo(unsigned w) { return __builtin_bit_cast(float, w << 16); }
__device__ __forceinline__ float bfhi(unsigned w) { return __builtin_bit_cast(float, w & 0xffff0000u); }
__device__ __forceinline__ float wave_sum(float v) {
#pragma unroll
    for (int o = 1; o < 64; o <<= 1) v += __shfl_xor(v, o);
    return v;
}
__device__ __forceinline__ float sigmoidf_(float x) { return 1.f / (1.f + __expf(-x)); }
#define XB_TMO      128
#define XB_XCNT(j)  (256  + 64 * (j))
#define XB_XSUB(j)  (1280 + 64 * (j))
#define XB_XGEN(j)  (2304 + 64 * (j))
#define XB_TOP      3328
#define XB_TOPGEN   3392
#define XCD_BAR_WORDS 3456
#define XB_SPIN_CAP (1u << 18)

__device__ __forceinline__ unsigned xb_ld(unsigned* p)              { return __hip_atomic_load(p, __ATOMIC_RELAXED, __HIP_MEMORY_SCOPE_AGENT); }
__device__ __forceinline__ unsigned xb_add(unsigned* p, unsigned v) { return __hip_atomic_fetch_add(p, v, __ATOMIC_RELAXED, __HIP_MEMORY_SCOPE_AGENT); }
__device__ __forceinline__ unsigned xb_xcc_id() { return (unsigned)__builtin_amdgcn_s_getreg((3 << 11) | 20) & 0xFu; }
#define XB_SPIN(cond, bar) do { unsigned _sp = 0; while (cond) { __builtin_amdgcn_s_sleep(1); \
    if ((++_sp & 255u) == 0u) { if (xb_ld(&(bar)[XB_TMO])) break; if (_sp > XB_SPIN_CAP) { atomicAdd(&(bar)[XB_TMO], 1u); break; } } } } while (0)

struct XcdBarrier {
    int leader; unsigned* bar; unsigned x;
    volatile LAS unsigned* st;
};

__device__ __forceinline__ XcdBarrier xcd_barrier_post(unsigned* bar, volatile LAS unsigned* st, int leader) {
    XcdBarrier b; b.leader = leader; b.bar = bar; b.x = xb_xcc_id(); b.st = st;
    if (leader) (void)xb_add(&bar[XB_XCNT(b.x)], 1u);
    return b;
}
__device__ __forceinline__ void xcd_barrier_complete(unsigned* bar, unsigned x, unsigned& nloc, unsigned& nx) {
    const unsigned G = gridDim.x * gridDim.y * gridDim.z;
    unsigned sum, cnt, mine, sp = 0u;
    for (;;) {
        sum = 0u; cnt = 0u; mine = 0u;
#pragma unroll
        for (unsigned j = 0; j < 16; ++j) { const unsigned c = xb_ld(&bar[XB_XCNT(j)]); sum += c; cnt += (c > 0u) ? 1u : 0u; mine = (j == x) ? c : mine; }
        if (sum == G) break;
        __builtin_amdgcn_s_sleep(1);
        if ((++sp & 255u) == 0u) { if (xb_ld(&bar[XB_TMO])) break; if (sp > XB_SPIN_CAP) { atomicAdd(&bar[XB_TMO], 1u); break; } }
    }
    nloc = mine > 0u ? mine : 1u; nx = cnt > 0u ? cnt : 1u;
}

__device__ __forceinline__ void xcd_barrier(const XcdBarrier& b) {
    asm volatile("s_waitcnt vmcnt(0)" ::: "memory");
    __syncthreads();
    if (b.leader) {
        unsigned* bar = b.bar;
        __builtin_amdgcn_s_waitcnt(0);
        unsigned nloc = b.st[0], nx = b.st[1];
        if (nloc == 0u) { xcd_barrier_complete(bar, b.x, nloc, nx); b.st[0] = nloc; b.st[1] = nx; }
        const unsigned old = xb_add(&bar[XB_XSUB(b.x)], 1u);
        const unsigned gen = old / nloc;
        if (old + 1u == (gen + 1u) * nloc) {
            __builtin_amdgcn_fence(__ATOMIC_RELEASE, "agent");
            asm volatile("s_waitcnt vmcnt(0)" ::: "memory");
            const unsigned og = xb_add(&bar[XB_TOP], 1u);
            const unsigned tg = og / nx;
            if (og + 1u == (tg + 1u) * nx) xb_add(&bar[XB_TOPGEN], 1u);
            else XB_SPIN(xb_ld(&bar[XB_TOPGEN]) == tg, bar);
            __builtin_amdgcn_fence(__ATOMIC_ACQUIRE, "agent");
            xb_add(&bar[XB_XGEN(b.x)], 1u);
            asm volatile("s_waitcnt vmcnt(0)" ::: "memory");
        } else {
            XB_SPIN(xb_ld(&bar[XB_XGEN(b.x)]) == gen, bar);
            __builtin_amdgcn_fence(__ATOMIC_ACQUIRE, "agent");
            asm volatile("s_waitcnt vmcnt(0)" ::: "memory");
        }
    }
    __syncthreads();
}

struct Args { const float* in[N_INPUTS]; float* out; unsigned char* ws; };
struct Frame { LAS unsigned char* lds; int tid, lane, wave, G; };
__device__ __forceinline__ void frame_refresh(Frame& F) { int t = F.wave * 64 + mk_lane(); asm volatile("" : "+v"(t)); F.tid = t; F.lane = t & 63; }
#define CAS __attribute__((address_space(4)))
__device__ __forceinline__ const CAS char* karg() { const CAS char* kp = (const CAS char*)__builtin_amdgcn_kernarg_segment_ptr(); asm volatile("" : "+s"(kp)); return kp; }
__device__ __forceinline__ const float* in_ptr(int i) { return *(const float* const CAS*)(karg() + 8 * i); }
__device__ __forceinline__ float* out_ptr() { return *(float* const CAS*)(karg() + 8 * N_INPUTS); }
__device__ __forceinline__ unsigned char* ws_ptr() { return *(unsigned char* const CAS*)(karg() + 8 * N_INPUTS + 8); }
#define WSP(T, off) ((T*)(ws + (off)))
#define WS_DECL unsigned char* const ws = ws_ptr()

namespace pg8 {
struct EpiStore {
    static constexpr bool PERM = true, AFTER_DRAIN = false;
    bf16_t* O; int ldc; int pm_add; int nN;
    __device__ __forceinline__ void operator()(const f32x4 (&acc)[2][2][4][2], const Unit& u, int wr, int wc, int fr, int fq) const {
        const int row0 = (u.pm + pm_add) * BM + wr * 64 + fr; const int col0 = (u.pn % nN) * BM + wc * 32 + 8 * fq;
#pragma unroll
        for (int ai = 0; ai < 2; ++ai)
#pragma unroll
            for (int m = 0; m < 4; ++m) { bf16_t* rowp = O + (size_t)(row0 + ai * HALF + m * 16) * ldc + col0;
#pragma unroll
                for (int bj = 0; bj < 2; ++bj) { const f32x4 v0 = acc[ai][bj][m][0], v1 = acc[ai][bj][m][1];
                    u32x4 w; w.x = cvt_pk_bf16(v0[0], v0[1]); w.y = cvt_pk_bf16(v0[2], v0[3]); w.z = cvt_pk_bf16(v1[0], v1[1]); w.w = cvt_pk_bf16(v1[2], v1[3]);
                    *(u32x4*)(rowp + bj * HALF) = w; } }
    }
};
__device__ __forceinline__ float silu_mul(float g, float u) { return g * __builtin_amdgcn_rcpf(1.f + __expf(-g)) * u; }
struct EpiSwiGLU {
    static constexpr bool PERM = true, AFTER_DRAIN = false;
    bf16_t* H; int ldh; int pm_sub; int nN;
    __device__ __forceinline__ void operator()(const f32x4 (&acc)[2][2][4][2], const Unit& u, int wr, int wc, int fr, int fq) const {
        const int row0 = (u.pm - pm_sub) * BM + wr * 64 + fr; const int col0 = (u.pn % nN) * HALF + wc * 32 + 8 * fq;
#pragma unroll
        for (int ai = 0; ai < 2; ++ai)
#pragma unroll
            for (int m = 0; m < 4; ++m) { bf16_t* rowp = H + (size_t)(row0 + ai * HALF + m * 16) * ldh + col0;
                const f32x4 g0 = acc[ai][0][m][0], g1 = acc[ai][0][m][1], u0 = acc[ai][1][m][0], u1 = acc[ai][1][m][1];
                u32x4 w; w.x = cvt_pk_bf16(silu_mul(g0[0], u0[0]), silu_mul(g0[1], u0[1])); w.y = cvt_pk_bf16(silu_mul(g0[2], u0[2]), silu_mul(g0[3], u0[3]));
                w.z = cvt_pk_bf16(silu_mul(g1[0], u1[0]), silu_mul(g1[1], u1[1])); w.w = cvt_pk_bf16(silu_mul(g1[2], u1[2]), silu_mul(g1[3], u1[3]));
                *(u32x4*)rowp = w; }
    }
};
struct EpiSwiGLU8 {
    static constexpr bool PERM = true, AFTER_DRAIN = false;
    unsigned char* H; int ldh; int pm_sub; int nN;
    __device__ __forceinline__ void operator()(const f32x4 (&acc)[2][2][4][2], const Unit& u, int wr, int wc, int fr, int fq) const {
        const int row0 = (u.pm - pm_sub) * BM + wr * 64 + fr; const int col0 = (u.pn % nN) * HALF + wc * 32 + 8 * fq;
#pragma unroll
        for (int ai = 0; ai < 2; ++ai)
#pragma unroll
            for (int m = 0; m < 4; ++m) { unsigned char* rowp = H + (size_t)(row0 + ai * HALF + m * 16) * ldh + col0;
                const f32x4 g0 = acc[ai][0][m][0], g1 = acc[ai][0][m][1], u0 = acc[ai][1][m][0], u1 = acc[ai][1][m][1];
                ::v2u w; w.x = ::pk4_fp8(silu_mul(g0[0], u0[0]), silu_mul(g0[1], u0[1]), silu_mul(g0[2], u0[2]), silu_mul(g0[3], u0[3]));
                w.y = ::pk4_fp8(silu_mul(g1[0], u1[0]), silu_mul(g1[1], u1[1]), silu_mul(g1[2], u1[2]), silu_mul(g1[3], u1[3]));
                *(::v2u*)rowp = w; }
    }
};
struct MoeOrder {
    int nM, nN, nwg, G, c, t0, pm_off; const PG8_LAS unsigned char* tile_e;
    __device__ void init(int nM_, int nN_, int G_, int c_, int t0_, int pm_off_, const PG8_LAS unsigned char* te) { nM = nM_; nN = nN_; nwg = nM * nN; G = G_; c = c_; t0 = t0_; pm_off = pm_off_; tile_e = te; }
    __device__ bool next(int i, Unit& u) const {
        const long L = (long)i * G + c; if (L >= nwg) return false;
        int wgid = (int)L; { const int q = nwg / NXCD, r = nwg % NXCD, xcd = wgid % NXCD, off = wgid / NXCD; wgid = (xcd < r ? xcd * (q + 1) : r * (q + 1) + (xcd - r) * q) + off; }
        const int nig = WGM * nN, gid = wgid / nig, fm = gid * WGM, gsz = (nM - fm) < WGM ? (nM - fm) : WGM;
        const int pml = fm + ((wgid % nig) % gsz), pnl = (wgid % nig) / gsz;
        const int e = tile_e[t0 + pml];
        u.pm = pm_off + pml; u.pn = e * nN + pnl; u.g = 0; return true;
    }
    __device__ __forceinline__ void a_ready(const Unit&) const {}
    __device__ __forceinline__ void done(const Unit&) const {}
};
struct DualOrder {
    StaticOrder s0, s1; int G, c;
    __device__ void init(int M0, int N0, int M1, int N1, int G_, int c_) { s0.init(M0, N0, 1, 0); s1.init(M1, N1, 1, 0); G = G_; c = c_; }
    __device__ bool next(int i, Unit& u) const { const long L = (long)i * G + c;
        if (L < s0.nwg) { const bool ok = s0.next((int)L, u); u.g = 0; return ok; }
        const long L1 = L - s0.nwg; if (L1 >= s1.nwg) return false; const bool ok = s1.next((int)L1, u); u.g = 1; return ok; }
    __device__ __forceinline__ void a_ready(const Unit&) const {}
    __device__ __forceinline__ void done(const Unit&) const {}
};
struct EpiStore2 {
    static constexpr bool PERM = true, AFTER_DRAIN = false;
    bf16_t* O0; int ldc0; bf16_t* O1; int ldc1;
    __device__ __forceinline__ void operator()(const f32x4 (&acc)[2][2][4][2], const Unit& u, int wr, int wc, int fr, int fq) const {
        bf16_t* O = u.g ? O1 : O0; const int ldc = u.g ? ldc1 : ldc0;
        const int row0 = u.pm * BM + wr * 64 + fr; const int col0 = u.pn * BM + wc * 32 + 8 * fq;
#pragma unroll
        for (int ai = 0; ai < 2; ++ai)
#pragma unroll
            for (int m = 0; m < 4; ++m) { bf16_t* rowp = O + (size_t)(row0 + ai * HALF + m * 16) * ldc + col0;
#pragma unroll
                for (int bj = 0; bj < 2; ++bj) { const f32x4 v0 = acc[ai][bj][m][0], v1 = acc[ai][bj][m][1];
                    u32x4 w; w.x = cvt_pk_bf16(v0[0], v0[1]); w.y = cvt_pk_bf16(v0[2], v0[3]); w.z = cvt_pk_bf16(v1[0], v1[1]); w.w = cvt_pk_bf16(v1[2], v1[3]);
                    *(u32x4*)(rowp + bj * HALF) = w; } }
    }
};
}

__device__ __forceinline__ void tr_item(const float* W, int ldw, int k0, int c0, bf16* WT, int K, int drow, LAS float* scr, int lane) {
    { f32x4 t_[8];
#pragma unroll
      for (int i = 0; i < 8; ++i) t_[i] = *(const GAS f32x4*)(W + (size_t)(k0 + 8 * i + (lane >> 3)) * ldw + c0 + 4 * (lane & 7));
#pragma unroll
      for (int i = 0; i < 8; ++i) { LAS float* d_ = scr + (8 * i + (lane >> 3)) * 33 + 4 * (lane & 7); d_[0] = t_[i].x; d_[1] = t_[i].y; d_[2] = t_[i].z; d_[3] = t_[i].w; } }
    LDS_WAIT(); asm volatile("" ::: "memory");
    const int c = lane & 7;
#pragma unroll
    for (int j = 0; j < 4; ++j) { const int n = (lane >> 3) + 8 * j; const LAS float* s = scr + (8 * c) * 33 + n;
        v4u o; o.x = pk2(s[0 * 33], s[1 * 33]); o.y = pk2(s[2 * 33], s[3 * 33]); o.z = pk2(s[4 * 33], s[5 * 33]); o.w = pk2(s[6 * 33], s[7 * 33]);
        *(GAS v4u*)(WT + (size_t)(drow + n) * K + k0 + 8 * c) = o; }
    LDS_WAIT(); asm volatile("" ::: "memory");
}
__device__ __forceinline__ void tr_item8(const float* W, int ldw, int k0, int c0, unsigned char* WT, int K, int drow, LAS float* scr, int lane, float scale) {
    { f32x4 t_[8];
#pragma unroll
      for (int i = 0; i < 8; ++i) t_[i] = *(const GAS f32x4*)(W + (size_t)(k0 + 8 * i + (lane >> 3)) * ldw + c0 + 4 * (lane & 7));
#pragma unroll
      for (int i = 0; i < 8; ++i) { LAS float* d_ = scr + (8 * i + (lane >> 3)) * 33 + 4 * (lane & 7); d_[0] = t_[i].x; d_[1] = t_[i].y; d_[2] = t_[i].z; d_[3] = t_[i].w; } }
    LDS_WAIT(); asm volatile("" ::: "memory");
    const int c = lane & 7;
#pragma unroll
    for (int j = 0; j < 4; ++j) { const int n = (lane >> 3) + 8 * j; const LAS float* s = scr + (8 * c) * 33 + n;
        v2u o; o.x = pk4_fp8(s[0 * 33] * scale, s[1 * 33] * scale, s[2 * 33] * scale, s[3 * 33] * scale); o.y = pk4_fp8(s[4 * 33] * scale, s[5 * 33] * scale, s[6 * 33] * scale, s[7 * 33] * scale);
        *(GAS v2u*)(WT + (size_t)(drow + n) * K + k0 + 8 * c) = o; }
    LDS_WAIT(); asm volatile("" ::: "memory");
}
__device__ __forceinline__ void conv_matrix(Frame& F, const float* W, int K, int ldw, int cbeg, int ncols, bf16* WT, int mode, int rowoff, int& cursor, float f8scale = 0.f) {
    const int gw = blockIdx.x * NWAVES + F.wave, NGW = F.G * NWAVES;
    const int nblk = ncols / 32, nit = (K / 64) * nblk;
    LAS float* scr = (LAS float*)(F.lds + F.wave * 16384);
    int first = cursor + (((gw - cursor) % NGW) + NGW) % NGW;
    for (int it = first; it < cursor + nit; it += NGW) {
        const int idx = it - cursor, kb = idx / nblk, nb = idx % nblk, n = 32 * nb;
        const int drow = mode == 0 ? rowoff + n : ((n >> 7) * 256 + (n & 127) + rowoff);
        if (f8scale != 0.f) tr_item8(W, ldw, 64 * kb, cbeg + n, (unsigned char*)WT, K, drow, scr, F.lane, f8scale); else tr_item(W, ldw, 64 * kb, cbeg + n, WT, K, drow, scr, F.lane);
    }
    cursor += nit;
}

__device__ __forceinline__ void phase_mod(Frame& F) { WS_DECL; frame_refresh(F);
    LAS float* sv = (LAS float*)F.lds;
    LAS float* red = (LAS float*)(F.lds + 69632);
    float* MOD = WSP(float, WS_MOD);
    if ((int)blockIdx.x < 192) {
        const float* cl_ = in_ptr(I_C); const float* cc_ = in_ptr(I_CCTX); const float* adab = in_ptr(I_ADAB); const float* adaw = in_ptr(I_ADAW);
        for (int i = F.tid; i < 17 * 1024; i += NTHR) { const int b = i >> 10, k = i & 1023; const float c = b < 16 ? cl_[b * 1024 + k] : cc_[k]; sv[i] = c / (1.f + expf(-c)); }
        __syncthreads();
        for (int item = blockIdx.x; item < 192; item += F.G) {
            const int li = item / 48, cg = item % 48, cl = F.tid & 127, kq = F.tid >> 7;
            const float* W = adaw + (size_t)li * 1024 * 6144 + cg * 128 + cl;
            float acc[17];
#pragma unroll
            for (int b = 0; b < 17; ++b) acc[b] = 0.f;
#pragma unroll 1
            for (int k = kq * 256; k < kq * 256 + 256; k += 8) { float w[8];
#pragma unroll
                for (int j = 0; j < 8; ++j) w[j] = W[(size_t)(k + j) * 6144];
#pragma unroll
                for (int b = 0; b < 17; ++b) { const f32x4 s0 = *(const LAS f32x4*)(sv + b * 1024 + k), s1 = *(const LAS f32x4*)(sv + b * 1024 + k + 4);
                    acc[b] += (s0.x * w[0] + s0.y * w[1]) + (s0.z * w[2] + s0.w * w[3]) + (s1.x * w[4] + s1.y * w[5]) + (s1.z * w[6] + s1.w * w[7]); } }
#pragma unroll
            for (int b = 0; b < 17; ++b) red[(kq * 17 + b) * 128 + cl] = acc[b];
            __syncthreads();
            for (int o = F.tid; o < 17 * 128; o += NTHR) { const int b = o >> 7, c = o & 127;
                const float s = (red[(0 * 17 + b) * 128 + c] + red[(1 * 17 + b) * 128 + c]) + (red[(2 * 17 + b) * 128 + c] + red[(3 * 17 + b) * 128 + c]);
                MOD[((size_t)li * 17 + b) * 6144 + cg * 128 + c] = s + adab[li * 6144 + cg * 128 + c]; }
            __syncthreads();
        }
    }
}

__device__ __forceinline__ void phase_pro0(Frame& F) { WS_DECL; frame_refresh(F);
    phase_mod(F);
    __syncthreads();
    int cursor = 0;
    for (int li = 0; li < DEPTH; ++li) {
        conv_matrix(F, in_ptr(I_WIN) + (size_t)li * D * N_IN, D, N_IN, 0, D_OFF, WSP(bf16, WS_WINT) + (size_t)li * PCOLS * D, 0, 0, cursor);
        conv_matrix(F, in_ptr(I_WIN) + (size_t)li * D * N_IN, D, N_IN, D_OFF, HYC, WSP(bf16, WS_WHYT) + (size_t)li * HYC * D, 0, 0, cursor);
        conv_matrix(F, in_ptr(I_WOUT) + (size_t)li * D * D, D, D, 0, D, WSP(bf16, WS_WOUTT) + (size_t)li * D * D, 0, 0, cursor);
    }
    for (int j = 0; j < 2; ++j) {
        conv_matrix(F, in_ptr(I_FG) + (size_t)j * D * FFD, D, FFD, 0, FFD, (bf16*)(WSP(unsigned char, WS_WGUT) + (size_t)j * 2 * FFD * D), 1, 0, cursor, 64.f);
        conv_matrix(F, in_ptr(I_FU) + (size_t)j * D * FFD, D, FFD, 0, FFD, (bf16*)(WSP(unsigned char, WS_WGUT) + (size_t)j * 2 * FFD * D), 1, 128, cursor, 64.f);
        if (DENSE_FFN2_F8) conv_matrix(F, in_ptr(I_FD) + (size_t)j * FFD * D, FFD, D, 0, D, (bf16*)(WSP(unsigned char, WS_WDT) + (size_t)j * D * FFD), 0, 0, cursor, 256.f);
        else conv_matrix(F, in_ptr(I_FD) + (size_t)j * FFD * D, FFD, D, 0, D, WSP(bf16, WS_WDT) + (size_t)j * D * FFD, 0, 0, cursor);
    }
    { const int gt = blockIdx.x * NTHR + F.tid, NGT = F.G * NTHR; const int per = (PCOLS - D_OFF) * D / 8;
      for (int i = gt; i < DEPTH * per; i += NGT) { const int li = i / per, r = i % per; *(GAS v4u*)(WSP(bf16, WS_WINT) + (size_t)li * PCOLS * D + (size_t)D_OFF * D + (size_t)r * 8) = (v4u){0u, 0u, 0u, 0u}; } }
}

struct Stream { const float* inl; const float* inc; float* outl; float* outc; };
__device__ __forceinline__ Stream make_stream(unsigned char* ws, int li) { Stream s; s.outl = out_ptr(); s.outc = WSP(float, WS_XC); s.inl = li == 0 ? in_ptr(I_X) : (const float*)s.outl; s.inc = li == 0 ? in_ptr(I_CTX) : (const float*)s.outc; return s; }
__device__ __forceinline__ const float* stream_in(const Stream& s, int m) { return m < NL ? s.inl + (size_t)m * D : s.inc + (size_t)(m - NL) * D; }
__device__ __forceinline__ float* stream_out(const Stream& s, int m) { return m < NL ? s.outl + (size_t)m * D : s.outc + (size_t)(m - NL) * D; }
__device__ __forceinline__ int mod_b(int m) { return m < NL ? (m >> 12) : 16; }
__device__ __forceinline__ const float* mod_vec(unsigned char* ws, int li, int b, int j) { return WSP(float, WS_MOD) + ((size_t)li * 17 + b) * 6144 + j * 1024; }

__device__ __forceinline__ void store_modulated(const f32x4 (&x)[4], const float* shift, const float* scale, bf16* orow, int lane) {
#pragma unroll
    for (int j = 0; j < 4; ++j) { const int c = 4 * lane + 256 * j; const f32x4 sh = *(const GAS f32x4*)(shift + c), sc = *(const GAS f32x4*)(scale + c);
        const f32x4 h = x[j] * (sc + 1.f) + sh; v2u w; w.x = pk2(h.x, h.y); w.y = pk2(h.z, h.w); *(GAS v2u*)(orow + c) = w; }
}
__device__ __forceinline__ void rows_range(const Frame& F, int nrows, int& r0, int& r1) { const int per = (nrows + F.G - 1) / F.G; r0 = blockIdx.x * per; r1 = r0 + per < nrows ? r0 + per : nrows; if (r0 > nrows) r0 = nrows; }

__device__ __forceinline__ void phase_hin0(Frame& F) { WS_DECL; frame_refresh(F);
    int r0, r1; rows_range(F, NT, r0, r1); const Stream st = make_stream(ws, 0);
    for (int m = r0 + F.wave; m < r1; m += NWAVES) {
        const float* xr = stream_in(st, m); f32x4 x[4];
#pragma unroll
        for (int j = 0; j < 4; ++j) x[j] = *(const GAS f32x4*)(xr + 4 * F.lane + 256 * j);
        const int b = mod_b(m);
        store_modulated(x, mod_vec(ws, 0, b, 0), mod_vec(ws, 0, b, 1), WSP(bf16, WS_A1) + (size_t)m * D, F.lane);
    }
}

__device__ __forceinline__ void ln_rows(f32x4 (&v)[4], const float* g, const float* bta, int lane) {
    float s = 0.f;
#pragma unroll
    for (int j = 0; j < 4; ++j) s += (v[j].x + v[j].y) + (v[j].z + v[j].w);
    const float mean = wave_sum(s) * (1.f / D); float s2 = 0.f;
#pragma unroll
    for (int j = 0; j < 4; ++j) { v[j] = v[j] - mean; s2 += (v[j].x * v[j].x + v[j].y * v[j].y) + (v[j].z * v[j].z + v[j].w * v[j].w); }
    const float rstd = __builtin_amdgcn_rsqf(wave_sum(s2) * (1.f / D) + 1e-5f);
#pragma unroll
    for (int j = 0; j < 4; ++j) { const int c = 4 * lane + 256 * j; v[j] = v[j] * rstd * *(const GAS f32x4*)(g + c) + *(const GAS f32x4*)(bta + c); }
}

template <bool HAVE_Y>
__device__ __forceinline__ void phase_ln1(Frame& F, int li) { WS_DECL; frame_refresh(F); constexpr bool DRY_OR_BF16 = false;
    const int nrows = li == DEPTH - 1 ? NL : NT; const bool moe = li & 1; const int lane = F.lane;
    LAS int* hist = (LAS int*)(F.lds + LDS_MOEI) + 56; LAS float* ROUT = (LAS float*)F.lds;
    if (moe) { if (F.tid < 8) hist[F.tid] = 0; const float* router = in_ptr(I_ROUTER) + (size_t)(li >> 1) * D * NE; for (int i = F.tid; i < D * NE / 4; i += NTHR) *(LAS f32x4*)(ROUT + 4 * i) = *(const GAS f32x4*)(router + 4 * i); __syncthreads(); }
    int r0, r1; rows_range(F, nrows, r0, r1);
    const float* g = in_ptr(I_LN1G) + li * D; const float* bt = in_ptr(I_LN1B) + li * D; const Stream st = make_stream(ws, li); const bf16* Y = WSP(bf16, WS_Y);
    f32x4 xn[4]; v2u yn[4];
    { const int m = r0 + F.wave; if (m < r1) { const float* xr = stream_in(st, m);
#pragma unroll
        for (int j = 0; j < 4; ++j) { const int c = 4 * lane + 256 * j; xn[j] = __builtin_nontemporal_load((const GAS f32x4*)(xr + c)); if (HAVE_Y) yn[j] = *(const GAS v2u*)(Y + (size_t)m * D + c); } } }
    for (int m = r0 + F.wave; m < r1; m += NWAVES) {
        const int b = mod_b(m); f32x4 v[4]; v2u yw[4];
#pragma unroll
        for (int j = 0; j < 4; ++j) { v[j] = xn[j]; if (HAVE_Y) yw[j] = yn[j]; }
        if (m + NWAVES < r1) { const float* xr = stream_in(st, m + NWAVES);
#pragma unroll
            for (int j = 0; j < 4; ++j) { const int c = 4 * lane + 256 * j; xn[j] = __builtin_nontemporal_load((const GAS f32x4*)(xr + c)); if (HAVE_Y) yn[j] = *(const GAS v2u*)(Y + (size_t)(m + NWAVES) * D + c); } }
        const float* m2 = mod_vec(ws, li, b, 2);
#pragma unroll
        for (int j = 0; j < 4; ++j) { const int c = 4 * lane + 256 * j; v[j] = v[j] * ALPHA;
            if (HAVE_Y) { const f32x4 mm = *(const GAS f32x4*)(m2 + c); v[j].x += mm.x * bflo(yw[j].x); v[j].y += mm.y * bfhi(yw[j].x); v[j].z += mm.z * bflo(yw[j].y); v[j].w += mm.w * bfhi(yw[j].y); } }
        ln_rows(v, g, bt, lane);
        float* xo = stream_out(st, m);
#pragma unroll
        for (int j = 0; j < 4; ++j) __builtin_nontemporal_store(v[j], (GAS f32x4*)(xo + 4 * lane + 256 * j));
        const float* sh = mod_vec(ws, li, b, 3); const float* sc = mod_vec(ws, li, b, 4);
        if (moe) {
            float lg[NE];
#pragma unroll
            for (int e = 0; e < NE; ++e) lg[e] = 0.f;
#pragma unroll
            for (int j = 0; j < 4; ++j) { const int c = 4 * lane + 256 * j; const f32x4 s4 = *(const GAS f32x4*)(sh + c), c4 = *(const GAS f32x4*)(sc + c); const f32x4 f = v[j] * (c4 + 1.f) + s4;
#pragma unroll
                for (int q = 0; q < 4; ++q) { const f32x4 ra = *(const LAS f32x4*)(ROUT + (c + q) * NE), rb = *(const LAS f32x4*)(ROUT + (c + q) * NE + 4); const float fq = f[q];
                    lg[0] += fq * ra.x; lg[1] += fq * ra.y; lg[2] += fq * ra.z; lg[3] += fq * ra.w; lg[4] += fq * rb.x; lg[5] += fq * rb.y; lg[6] += fq * rb.z; lg[7] += fq * rb.w; } }
#pragma unroll
            for (int e = 0; e < NE; ++e) lg[e] = wave_sum(lg[e]);
            int e0 = 0; float v0 = lg[0];
#pragma unroll
            for (int e = 1; e < NE; ++e) if (lg[e] > v0) { v0 = lg[e]; e0 = e; }
            int e1 = -1; float v1 = -3.0e38f;
#pragma unroll
            for (int e = 0; e < NE; ++e) if (e != e0 && lg[e] > v1) { v1 = lg[e]; e1 = e; }
            const float ex = __expf(v1 - v0), g0 = 1.f / (1.f + ex), g1 = ex * g0;
            if (lane == 0) { *(GAS v2u*)(WSP(int, WS_TOKE) + 2 * (size_t)m) = (v2u){(unsigned)e0, (unsigned)e1}; *(GAS f32x2*)(WSP(float, WS_TOKG) + 2 * (size_t)m) = (f32x2){g0, g1};
                atomicAdd((int*)(hist + e0), 1); atomicAdd((int*)(hist + e1), 1); }
        }
        if (!DRY_OR_BF16) {
            unsigned char* orow = WSP(unsigned char, WS_A1) + (size_t)m * D;
#pragma unroll
            for (int j = 0; j < 4; ++j) { const int c = 4 * lane + 256 * j; const f32x4 s4 = *(const GAS f32x4*)(sh + c), c4 = *(const GAS f32x4*)(sc + c); const f32x4 f = v[j] * (c4 + 1.f) + s4;
                *(GAS unsigned*)(orow + c) = pk4_fp8(f.x, f.y, f.z, f.w); }
        } else store_modulated(v, sh, sc, WSP(bf16, WS_A1) + (size_t)m * D, lane);
    }
    if (moe) { __syncthreads(); if (F.tid < 8) WSP(int, WS_BLKCNT)[blockIdx.x * 8 + F.tid] = hist[F.tid]; }
}

template <bool HAVE_FFN>
__device__ __forceinline__ void phase_ln2(Frame& F, int li) { WS_DECL; frame_refresh(F);
    const int nrows = li == DEPTH - 1 ? NL : NT; const bool moe = li & 1; const int lane = F.lane;
    int r0, r1; rows_range(F, nrows, r0, r1);
    const float* g = in_ptr(I_LN2G) + li * D; const float* bt = in_ptr(I_LN2B) + li * D; const Stream st = make_stream(ws, 1);
    const bf16* Y = WSP(bf16, WS_Y); const bf16* XS = WSP(bf16, WS_Y2); const int* TOKS = WSP(int, WS_TOKS); const float* TOKG = WSP(float, WS_TOKG);
    f32x4 xn[4]; v2u ya[4], yb[4]; v2u sn = (v2u){0u, 0u}; f32x2 gn = (f32x2){0.f, 0.f}, gc = (f32x2){0.f, 0.f};
    const int mf = r0 + F.wave;
    if (mf < r1) { const float* xr = stream_out(st, mf); v2u s0 = (v2u){0u, 0u};
        if (moe) { s0 = *(const GAS v2u*)(TOKS + 2 * (size_t)mf); gc = *(const GAS f32x2*)(TOKG + 2 * (size_t)mf); if (mf + NWAVES < r1) { sn = *(const GAS v2u*)(TOKS + 2 * (size_t)(mf + NWAVES)); gn = *(const GAS f32x2*)(TOKG + 2 * (size_t)(mf + NWAVES)); } }
#pragma unroll
        for (int j = 0; j < 4; ++j) { const int c = 4 * lane + 256 * j; xn[j] = __builtin_nontemporal_load((const GAS f32x4*)(xr + c));
            if (HAVE_FFN) { if (moe) { ya[j] = *(const GAS v2u*)(XS + (size_t)s0.x * D + c); yb[j] = *(const GAS v2u*)(XS + (size_t)s0.y * D + c); } else ya[j] = *(const GAS v2u*)(Y + (size_t)mf * D + c); } } }
    for (int m = mf; m < r1; m += NWAVES) {
        const int b = mod_b(m); f32x4 v[4]; v2u wa[4], wb[4]; const f32x2 gg = gc;
#pragma unroll
        for (int j = 0; j < 4; ++j) { v[j] = xn[j]; wa[j] = ya[j]; wb[j] = yb[j]; }
        const int mn = m + NWAVES;
        if (mn < r1) { const float* xr = stream_out(st, mn); const v2u s1 = sn; gc = gn;
            if (moe && mn + NWAVES < r1) { sn = *(const GAS v2u*)(TOKS + 2 * (size_t)(mn + NWAVES)); gn = *(const GAS f32x2*)(TOKG + 2 * (size_t)(mn + NWAVES)); }
#pragma unroll
            for (int j = 0; j < 4; ++j) { const int c = 4 * lane + 256 * j; xn[j] = __builtin_nontemporal_load((const GAS f32x4*)(xr + c));
                if (HAVE_FFN) { if (moe) { ya[j] = *(const GAS v2u*)(XS + (size_t)s1.x * D + c); yb[j] = *(const GAS v2u*)(XS + (size_t)s1.y * D + c); } else ya[j] = *(const GAS v2u*)(Y + (size_t)mn * D + c); } } }
        const float* m5 = mod_vec(ws, li, b, 5);
#pragma unroll
        for (int j = 0; j < 4; ++j) { const int c = 4 * lane + 256 * j; v[j] = v[j] * ALPHA;
            if (HAVE_FFN) { const f32x4 mm = *(const GAS f32x4*)(m5 + c); f32x4 o;
                if (moe) { o.x = gg.x * bflo(wa[j].x) + gg.y * bflo(wb[j].x); o.y = gg.x * bfhi(wa[j].x) + gg.y * bfhi(wb[j].x); o.z = gg.x * bflo(wa[j].y) + gg.y * bflo(wb[j].y); o.w = gg.x * bfhi(wa[j].y) + gg.y * bfhi(wb[j].y); }
                else { o.x = bflo(wa[j].x); o.y = bfhi(wa[j].x); o.z = bflo(wa[j].y); o.w = bfhi(wa[j].y); }
                v[j] = v[j] + mm * o; } }
        ln_rows(v, g, bt, lane);
        float* xo = stream_out(st, m);
#pragma unroll
        for (int j = 0; j < 4; ++j) __builtin_nontemporal_store(v[j], (GAS f32x4*)(xo + 4 * lane + 256 * j));
        if (li < DEPTH - 1) store_modulated(v, mod_vec(ws, li + 1, b, 0), mod_vec(ws, li + 1, b, 1), WSP(bf16, WS_A1) + (size_t)m * D, lane);
    }
}

__device__ __forceinline__ void phase_moe_weights(Frame& F, int li) { WS_DECL; frame_refresh(F);
    const int j = li >> 1; int cursor = 0;
    for (int e = 0; e < NE; ++e) {
        conv_matrix(F, in_ptr(I_MG) + ((size_t)j * NE + e) * D * FFE, D, FFE, 0, FFE, (bf16*)(WSP(unsigned char, WS_M8GU) + (size_t)e * 2 * FFE * D), 1, 0, cursor, 64.f);
        conv_matrix(F, in_ptr(I_MU) + ((size_t)j * NE + e) * D * FFE, D, FFE, 0, FFE, (bf16*)(WSP(unsigned char, WS_M8GU) + (size_t)e * 2 * FFE * D), 1, 128, cursor, 64.f);
        conv_matrix(F, in_ptr(I_MD) + ((size_t)j * NE + e) * FFE * D, FFE, D, 0, D, (bf16*)(WSP(unsigned char, WS_M8D) + (size_t)e * D * FFE), 0, 0, cursor, 256.f);
    }
}

__device__ __forceinline__ void phase_moe_slots(Frame& F, int li) { WS_DECL; frame_refresh(F);
    const int nrows = li == DEPTH - 1 ? NL : NT;
    LAS int* mi = (LAS int*)(F.lds + LDS_MOEI); LAS unsigned char* tile_e = (LAS unsigned char*)(F.lds + LDS_TILEE);
    LAS int* slots = (LAS int*)F.lds;
    const int* blkcnt = WSP(int, WS_BLKCNT);
    { LAS int* cn = (LAS int*)(F.lds + 8192);
      if (F.tid < 8) { mi[16 + F.tid] = 0; mi[32 + F.tid] = 0; }
      { const int b = F.tid >> 1, hf = F.tid & 1; v4u c4 = (v4u){0u, 0u, 0u, 0u}; if (b < F.G) c4 = *(const GAS v4u*)(blkcnt + b * 8 + 4 * hf); *(LAS v4u*)(cn + b * 8 + 4 * hf) = c4; }
      __syncthreads();
      { const int e = F.wave; int tot = 0, pre = 0;
#pragma unroll
        for (int k = 0; k < 4; ++k) { const int b = F.lane + 64 * k; const int c = cn[b * 8 + e]; tot += c; if (b < (int)blockIdx.x) pre += c; }
        atomicAdd((int*)(mi + 16 + e), tot); atomicAdd((int*)(mi + 32 + e), pre); } }
    __syncthreads();
    if (F.tid == 0) { int s = 0; for (int e = 0; e < NE; ++e) { mi[e] = s; s += (mi[16 + e] + 255) & ~255; } mi[8] = s; mi[48] = s >> 8; }
    __syncthreads();
    for (int t = F.tid; t < MOE_MAX_TILES + 8; t += NTHR) { int e = 0;
#pragma unroll
        for (int q = 1; q < NE; ++q) if (t * 256 >= mi[q]) e = q;
        tile_e[t] = (unsigned char)e; }
    int r0, r1; rows_range(F, nrows, r0, r1);
    const int na = 2 * (r1 - r0);
    if (F.wave == 0) {
        int run[NE];
#pragma unroll
        for (int e = 0; e < NE; ++e) run[e] = mi[e] + mi[32 + e];
#pragma unroll 1
        for (int k0 = 0; k0 < 9; k0 += 3) { int ev[3];
#pragma unroll
          for (int k = 0; k < 3; ++k) { const int ai = 64 * (k0 + k) + F.lane; ev[k] = ai < na ? WSP(int, WS_TOKE)[2 * (size_t)r0 + ai] : -1; }
#pragma unroll
          for (int k = 0; k < 3; ++k) { const int base = 64 * (k0 + k); const int ai = base + F.lane; const bool ok = ai < na;
            const int e = ev[k]; int slot = 0;
#pragma unroll
            for (int q = 0; q < NE; ++q) { const unsigned long long mk = __ballot(e == q); if (e == q) slot = run[q] + __popcll(mk & ((1ull << F.lane) - 1ull)); run[q] += __popcll(mk); }
            if (ok) { slots[ai] = slot; WSP(int, WS_TOKS)[2 * (size_t)r0 + ai] = slot; } } }
        for (int base = 576; base < na; base += 64) { const int ai = base + F.lane; const bool ok = ai < na;
            const int e = ok ? WSP(int, WS_TOKE)[2 * (size_t)r0 + ai] : -1; int slot = 0;
#pragma unroll
            for (int q = 0; q < NE; ++q) { const unsigned long long mk = __ballot(e == q); if (e == q) slot = run[q] + __popcll(mk & ((1ull << F.lane) - 1ull)); run[q] += __popcll(mk); }
            if (ok) { slots[ai] = slot; WSP(int, WS_TOKS)[2 * (size_t)r0 + ai] = slot; } }
    }
    __syncthreads();
    for (int a0 = F.wave * 2; a0 < na; a0 += NWAVES * 2) {
        const int s0 = slots[a0], s1 = slots[a0 + 1]; const v4u v = ((const GAS v4u*)(WSP(unsigned char, WS_A1) + (size_t)(r0 + (a0 >> 1)) * D))[F.lane];
        ((GAS v4u*)(WSP(unsigned char, WS_XS8) + (size_t)s0 * D))[F.lane] = v; ((GAS v4u*)(WSP(unsigned char, WS_XS8) + (size_t)s1 * D))[F.lane] = v; }
    { const int gw = blockIdx.x * NWAVES + F.wave, NGW = F.G * NWAVES; int cnt = 0;
      for (int e = 0; e < NE; ++e) { const int p0 = mi[e] + mi[16 + e], p1 = mi[e + 1];
          for (int s = p0; s < p1; ++s, ++cnt) if (cnt % NGW == gw) { GAS v4u* dst = (GAS v4u*)(WSP(unsigned char, WS_XS8) + (size_t)s * D); dst[F.lane] = (v4u){0u, 0u, 0u, 0u}; } } }
    __syncthreads();
}

constexpr float QSCALE = 0.14724319f;
constexpr int MP_CQ_LD = 200, MP_CKV_LD = 136;
__device__ __forceinline__ void phase_mla_prep(Frame& F, int li) { WS_DECL; frame_refresh(F);
    LAS bf16* CQN = (LAS bf16*)F.lds; LAS bf16* CKVN = (LAS bf16*)(F.lds + 64 * MP_CQ_LD * 2);
    const bf16* P = WSP(bf16, WS_P); bf16* QB = WSP(bf16, WS_QB); bf16* KB = WSP(bf16, WS_KB); bf16* VT = WSP(bf16, WS_VT);
    const float* qn = in_ptr(I_QNORM) + li * 192; const float* kvn = in_ptr(I_KVNORM) + li * 128;
    const bf16* WQ = WSP(bf16, WS_WUQT) + (size_t)li * 384 * 192; const bf16* WKV = WSP(bf16, WS_WUKVT) + (size_t)li * 512 * 128;
    const float* RC = WSP(float, WS_ROPE); const float* RS = RC + 4096 * 16;
    const int lane = F.lane, wave = F.wave;
    const int head = wave >> 1, half = wave & 1, fr = lane & 15, kg = lane >> 4;
    for (int item = (blockIdx.x + 64) % F.G; item < NT / 64; item += F.G) {
        const int m0 = item * 64; const bool isctx = m0 >= NL; const int b = isctx ? (m0 - NL) >> 8 : m0 >> 12; const int t0 = isctx ? (m0 - NL) & 255 : m0 & 4095;
        const int ki0 = isctx ? t0 : 256 + t0;
        bf16x8 wq[3][6];
#pragma unroll
        for (int i = 0; i < 3; ++i)
#pragma unroll
            for (int ks = 0; ks < 6; ++ks) wq[i][ks] = *(const GAS bf16x8*)(WQ + (size_t)(96 * head + 16 * (3 * half + i) + fr) * 192 + 32 * ks + 8 * kg);
        v4u rawv[8]; unsigned short kr1[8], kr2[8];
#pragma unroll
        for (int i = 0; i < 8; ++i) { const bf16* pr = P + (size_t)(m0 + wave * 8 + i) * PCOLS; rawv[i] = (v4u){0u, 0u, 0u, 0u}; if (lane < 40) rawv[i] = *(const GAS v4u*)(pr + 8 * lane);
            kr1[i] = 0; kr2[i] = 0; if (lane < 16) { kr1[i] = pr[320 + lane]; kr2[i] = pr[336 + lane]; } }
#pragma unroll
        for (int i = 0; i < 8; ++i) { const int tl = wave * 8 + i; const v4u raw = rawv[i];
            float x[8]; x[0] = bflo(raw.x); x[1] = bfhi(raw.x); x[2] = bflo(raw.y); x[3] = bfhi(raw.y); x[4] = bflo(raw.z); x[5] = bfhi(raw.z); x[6] = bflo(raw.w); x[7] = bfhi(raw.w);
            float ss = 0.f;
#pragma unroll
            for (int j = 0; j < 8; ++j) ss += x[j] * x[j];
            const float sq = wave_sum(lane < 24 ? ss : 0.f), skv = wave_sum((lane >= 24 && lane < 40) ? ss : 0.f);
            const float rq = __builtin_amdgcn_rsqf(sq * (1.f / 192.f) + 1e-6f), rkv = __builtin_amdgcn_rsqf(skv * (1.f / 128.f) + 1e-6f);
            if (lane < 24) { const float* g = qn + 8 * lane; v4u o; o.x = pk2(x[0] * rq * g[0], x[1] * rq * g[1]); o.y = pk2(x[2] * rq * g[2], x[3] * rq * g[3]); o.z = pk2(x[4] * rq * g[4], x[5] * rq * g[5]); o.w = pk2(x[6] * rq * g[6], x[7] * rq * g[7]);
                *(LAS v4u*)(CQN + tl * MP_CQ_LD + 8 * lane) = o; }
            else if (lane < 40) { const int c = 8 * (lane - 24); const float* g = kvn + c; v4u o; o.x = pk2(x[0] * rkv * g[0], x[1] * rkv * g[1]); o.y = pk2(x[2] * rkv * g[2], x[3] * rkv * g[3]); o.z = pk2(x[4] * rkv * g[4], x[5] * rkv * g[5]); o.w = pk2(x[6] * rkv * g[6], x[7] * rkv * g[7]);
                *(LAS v4u*)(CKVN + tl * MP_CKV_LD + c) = o; }
            if (lane < 16) { float x1 = bf2f(kr1[i]), x2 = bf2f(kr2[i]);
                if (!isctx) { const float c = RC[(t0 + tl) * 16 + lane], s = RS[(t0 + tl) * 16 + lane]; const float y1 = x1 * c - x2 * s, y2 = x1 * s + x2 * c; x1 = y1; x2 = y2; }
                const bf16 o1 = (bf16)f2bf(x1), o2 = (bf16)f2bf(x2);
#pragma unroll
                for (int h = 0; h < 4; ++h) { bf16* kr = KB + ((size_t)(b * 4 + h) * KSEQ + ki0 + tl) * 96; kr[64 + lane] = o1; kr[80 + lane] = o2; } }
        }
        __syncthreads();
        const size_t qrow0 = ((size_t)(b * 4 + head) * KSEQ + ki0) * 96;
        { f32x4 acc[3][4];
#pragma unroll
          for (int i = 0; i < 3; ++i)
#pragma unroll
              for (int m = 0; m < 4; ++m) acc[i][m] = (f32x4){0.f, 0.f, 0.f, 0.f};
#pragma unroll
          for (int ks = 0; ks < 6; ++ks)
#pragma unroll
              for (int m = 0; m < 4; ++m) { const bf16x8 xf = *(const LAS bf16x8*)(CQN + (16 * m + fr) * MP_CQ_LD + 32 * ks + 8 * kg);
#pragma unroll
                  for (int i = 0; i < 3; ++i) acc[i][m] = __builtin_amdgcn_mfma_f32_16x16x32_bf16(wq[i][ks], xf, acc[i][m], 0, 0, 0); }
#pragma unroll
          for (int m = 0; m < 4; ++m) { bf16* qr = QB + qrow0 + (size_t)(16 * m + fr) * 96;
              { v2u o; o.x = pk2(acc[0][m][0] * QSCALE, acc[0][m][1] * QSCALE); o.y = pk2(acc[0][m][2] * QSCALE, acc[0][m][3] * QSCALE); *(GAS v2u*)(qr + 48 * half + 4 * kg) = o; }
              f32x4 y1 = acc[1][m], y2 = acc[2][m];
              if (half == 1 && !isctx) { const int t = t0 + 16 * m + fr; const f32x4 c = *(const GAS f32x4*)(RC + t * 16 + 4 * kg), sn = *(const GAS f32x4*)(RS + t * 16 + 4 * kg); y1 = acc[1][m] * c - acc[2][m] * sn; y2 = acc[1][m] * sn + acc[2][m] * c; }
              v2u o1, o2; o1.x = pk2(y1[0] * QSCALE, y1[1] * QSCALE); o1.y = pk2(y1[2] * QSCALE, y1[3] * QSCALE); o2.x = pk2(y2[0] * QSCALE, y2[1] * QSCALE); o2.y = pk2(y2[2] * QSCALE, y2[3] * QSCALE);
              *(GAS v2u*)(qr + 48 * half + 16 + 4 * kg) = o1; *(GAS v2u*)(qr + 48 * half + 32 + 4 * kg) = o2; } }
        bf16x8 wkv[4][4];
#pragma unroll
        for (int nt = 0; nt < 4; ++nt)
#pragma unroll
            for (int ks = 0; ks < 4; ++ks) wkv[nt][ks] = *(const GAS bf16x8*)(WKV + (size_t)(128 * head + 64 * half + 16 * nt + fr) * 128 + 32 * ks + 8 * kg);
        { f32x4 acc[4][4];
#pragma unroll
          for (int nt = 0; nt < 4; ++nt)
#pragma unroll
              for (int m = 0; m < 4; ++m) acc[nt][m] = (f32x4){0.f, 0.f, 0.f, 0.f};
#pragma unroll
          for (int ks = 0; ks < 4; ++ks)
#pragma unroll
              for (int m = 0; m < 4; ++m) { const bf16x8 xf = *(const LAS bf16x8*)(CKVN + (16 * m + fr) * MP_CKV_LD + 32 * ks + 8 * kg);
#pragma unroll
                  for (int nt = 0; nt < 4; ++nt) acc[nt][m] = half == 0 ? __builtin_amdgcn_mfma_f32_16x16x32_bf16(wkv[nt][ks], xf, acc[nt][m], 0, 0, 0) : __builtin_amdgcn_mfma_f32_16x16x32_bf16(xf, wkv[nt][ks], acc[nt][m], 0, 0, 0); }
#pragma unroll
          for (int nt = 0; nt < 4; ++nt)
#pragma unroll
              for (int m = 0; m < 4; ++m) { v2u o; o.x = pk2(acc[nt][m][0], acc[nt][m][1]); o.y = pk2(acc[nt][m][2], acc[nt][m][3]);
                  if (half == 0) *(GAS v2u*)(KB + qrow0 + (size_t)(16 * m + fr) * 96 + 16 * nt + 4 * kg) = o;
                  else *(GAS v2u*)(VT + ((size_t)(b * 4 + head) * 64 + 16 * nt + fr) * KSEQ + ki0 + 16 * m + 4 * kg) = o; } }
        __syncthreads();
    }
}

constexpr int AT_KLD = 104, AT_VLD = 72;
constexpr int AT_KB = 64 * AT_KLD * 2, AT_VB = 64 * AT_VLD * 2, AT_BUF = AT_KB + AT_VB;
__device__ __forceinline__ void phase_attn(Frame& F, int li) { WS_DECL; frame_refresh(F);
    const bf16* QB = WSP(bf16, WS_QB); const bf16* KB = WSP(bf16, WS_KB); const bf16* VT = WSP(bf16, WS_VT); bf16* AO = WSP(bf16, WS_AO);
    const int lane = F.lane, wave = F.wave, tid = F.tid, ql = lane & 31, h2 = lane >> 5;
    const int nunits = 1024 + (li < DEPTH - 1 ? 64 : 0);
    const int c = blockIdx.x, vc = (F.G == 256) ? (c & 7) * 32 + (c >> 3) : c;
    for (int u = vc; u < nunits; u += F.G) {
        int bh, q0, nk; bool isctx = u >= 1024;
        if (!isctx) { bh = u >> 4; q0 = 256 + 256 * (u & 15); nk = KSEQ; } else { bh = u - 1024; q0 = 0; nk = 256; }
        const bf16* Kb = KB + (size_t)bh * KSEQ * 96; const bf16* Vb = VT + (size_t)bh * 64 * KSEQ;
        bf16x8 qf[6];
        { const bf16* qr = QB + ((size_t)bh * KSEQ + q0 + 32 * wave + ql) * 96 + 8 * h2;
#pragma unroll
          for (int ks = 0; ks < 6; ++ks) qf[ks] = *(const GAS bf16x8*)(qr + 16 * ks); }
        f32x16 O0, O1;
#pragma unroll
        for (int r = 0; r < 16; ++r) { O0[r] = 0.f; O1[r] = 0.f; }
        float l_run = 0.f;
        const int kc0 = tid, kc1 = tid + 512; const int vr = tid >> 3, vcn = tid & 7;
        const int ko0 = (kc0 / 12) * (AT_KLD * 2) + (kc0 % 12) * 16, ko1 = (kc1 / 12) * (AT_KLD * 2) + (kc1 % 12) * 16, vo = AT_KB + vr * (AT_VLD * 2) + vcn * 16;
        v4u pk0, pk1 = (v4u){0u, 0u, 0u, 0u}, pv;
#define AT_LOAD(t) do { const GAS v4u* ks_ = (const GAS v4u*)(Kb + (size_t)(t) * 64 * 96); pk0 = ks_[kc0]; if (kc1 < 768) pk1 = ks_[kc1]; pv = *(const GAS v4u*)(Vb + (size_t)vr * KSEQ + (t) * 64 + 8 * vcn); } while (0)
#define AT_STORE(bo) do { LAS unsigned char* b_ = F.lds + (bo); *(LAS v4u*)(b_ + ko0) = pk0; if (kc1 < 768) *(LAS v4u*)(b_ + ko1) = pk1; *(LAS v4u*)(b_ + vo) = pv; } while (0)
#define AT_QK(bo, A0, A1, INIT) do { const LAS unsigned char* b_ = F.lds + (bo); _Pragma("unroll") for (int r = 0; r < 16; ++r) { A0[r] = 0.f; A1[r] = 0.f; } \
            _Pragma("unroll") for (int kh = 0; kh < 2; ++kh) { bf16x8 kf0[3], kf1[3]; \
                _Pragma("unroll") for (int k3 = 0; k3 < 3; ++k3) { const int ks = 3 * kh + k3; kf0[k3] = *(const LAS bf16x8*)(b_ + ql * (AT_KLD * 2) + 32 * ks + 16 * h2); kf1[k3] = *(const LAS bf16x8*)(b_ + (32 + ql) * (AT_KLD * 2) + 32 * ks + 16 * h2); } \
                __builtin_amdgcn_sched_barrier(0); \
                _Pragma("unroll") for (int k3 = 0; k3 < 3; ++k3) { const int ks = 3 * kh + k3; A0 = __builtin_amdgcn_mfma_f32_32x32x16_bf16(kf0[k3], qf[ks], A0, 0, 0, 0); A1 = __builtin_amdgcn_mfma_f32_32x32x16_bf16(kf1[k3], qf[ks], A1, 0, 0, 0); } \
                __builtin_amdgcn_sched_barrier(0); } } while (0)
        const int ntile = nk >> 6;
        v4u qk0, qk1 = (v4u){0u, 0u, 0u, 0u}, qv;
#define AT_LOADB(t) do { const GAS v4u* ks_ = (const GAS v4u*)(Kb + (size_t)(t) * 64 * 96); qk0 = ks_[kc0]; if (kc1 < 768) qk1 = ks_[kc1]; qv = *(const GAS v4u*)(Vb + (size_t)vr * KSEQ + (t) * 64 + 8 * vcn); } while (0)
#define AT_STOREB(bo) do { LAS unsigned char* b_ = F.lds + (bo); *(LAS v4u*)(b_ + ko0) = qk0; if (kc1 < 768) *(LAS v4u*)(b_ + ko1) = qk1; *(LAS v4u*)(b_ + vo) = qv; } while (0)
        AT_LOAD(0); AT_LOADB(1);
        __syncthreads();
        AT_STORE(0); AT_STOREB(AT_BUF);
        AT_LOAD(2); AT_LOADB(3);
        __syncthreads();
        int bo0 = 0, bo1 = AT_BUF, bo2 = 2 * AT_BUF;
        float m_ref = 0.f;
#define AT_BODY(KT, STOREX, LOADX) do { const int kt_ = (KT); \
            if (kt_ + 2 < ntile) STOREX(bo2); if (kt_ + 4 < ntile) LOADX(kt_ + 4); \
            f32x16 S0, S1; AT_QK(bo0, S0, S1, 0); \
            if (__any(m_ref != 0.f)) { _Pragma("unroll") for (int r = 0; r < 16; ++r) { S0[r] -= m_ref; S1[r] -= m_ref; } } \
            float mxa = fmaxf(fmaxf(S0[0], S0[1]), S0[2]), mxb = fmaxf(fmaxf(S0[3], S0[4]), S0[5]), mxc = fmaxf(fmaxf(S1[0], S1[1]), S1[2]), mxd = fmaxf(fmaxf(S1[3], S1[4]), S1[5]); \
            _Pragma("unroll") for (int r = 6; r < 16; r += 2) { mxa = fmaxf(mxa, S0[r]); mxb = fmaxf(mxb, S0[r + 1]); mxc = fmaxf(mxc, S1[r]); mxd = fmaxf(mxd, S1[r + 1]); } \
            float mx = fmaxf(fmaxf(mxa, mxb), fmaxf(mxc, mxd)); \
            if (__any(mx > 64.f || (kt_ == 0 && mx < -64.f))) { mx = fmaxf(mx, __shfl_xor(mx, 32)); const float delta = (mx > 64.f || (kt_ == 0 && mx < -64.f)) ? mx : 0.f; const float alpha = __builtin_amdgcn_exp2f(-delta); m_ref += delta; l_run *= alpha; \
                _Pragma("unroll") for (int r = 0; r < 16; ++r) { O0[r] *= alpha; O1[r] *= alpha; S0[r] -= delta; S1[r] -= delta; } } \
            float ps0 = 0.f, ps1 = 0.f, ps2 = 0.f, ps3 = 0.f; \
            _Pragma("unroll") for (int r = 0; r < 16; r += 2) { S0[r] = __builtin_amdgcn_exp2f(S0[r]); S1[r] = __builtin_amdgcn_exp2f(S1[r]); S0[r + 1] = __builtin_amdgcn_exp2f(S0[r + 1]); S1[r + 1] = __builtin_amdgcn_exp2f(S1[r + 1]); ps0 += S0[r]; ps1 += S1[r]; ps2 += S0[r + 1]; ps3 += S1[r + 1]; } \
            l_run += (ps0 + ps1) + (ps2 + ps3); \
            union { bf16x8 v; unsigned u[4]; } p00, p01, p10, p11; \
            _Pragma("unroll") for (int j = 0; j < 4; ++j) { p00.u[j] = pk2(S0[2 * j], S0[2 * j + 1]); p01.u[j] = pk2(S0[8 + 2 * j], S0[8 + 2 * j + 1]); p10.u[j] = pk2(S1[2 * j], S1[2 * j + 1]); p11.u[j] = pk2(S1[8 + 2 * j], S1[8 + 2 * j + 1]); } \
            const LAS unsigned char* vb = F.lds + bo0 + AT_KB; \
            _Pragma("unroll") for (int dvt = 0; dvt < 2; ++dvt) { const LAS unsigned char* vrow = vb + (32 * dvt + ql) * (AT_VLD * 2) + 8 * h2; union { bf16x8 v; v2u h[2]; } vf[4]; \
                _Pragma("unroll") for (int ss = 0; ss < 4; ++ss) { vf[ss].h[0] = *(const LAS v2u*)(vrow + 2 * (16 * ss)); vf[ss].h[1] = *(const LAS v2u*)(vrow + 2 * (16 * ss + 8)); } \
                __builtin_amdgcn_sched_barrier(0); \
                if (dvt == 0) { O0 = __builtin_amdgcn_mfma_f32_32x32x16_bf16(vf[0].v, p00.v, O0, 0, 0, 0); O0 = __builtin_amdgcn_mfma_f32_32x32x16_bf16(vf[1].v, p01.v, O0, 0, 0, 0); O0 = __builtin_amdgcn_mfma_f32_32x32x16_bf16(vf[2].v, p10.v, O0, 0, 0, 0); O0 = __builtin_amdgcn_mfma_f32_32x32x16_bf16(vf[3].v, p11.v, O0, 0, 0, 0); } \
                else { O1 = __builtin_amdgcn_mfma_f32_32x32x16_bf16(vf[0].v, p00.v, O1, 0, 0, 0); O1 = __builtin_amdgcn_mfma_f32_32x32x16_bf16(vf[1].v, p01.v, O1, 0, 0, 0); O1 = __builtin_amdgcn_mfma_f32_32x32x16_bf16(vf[2].v, p10.v, O1, 0, 0, 0); O1 = __builtin_amdgcn_mfma_f32_32x32x16_bf16(vf[3].v, p11.v, O1, 0, 0, 0); } \
                __builtin_amdgcn_sched_barrier(0); } \
            __syncthreads(); \
            { const int t_ = bo0; bo0 = bo1; bo1 = bo2; bo2 = t_; } } while (0)
        for (int kt = 0; kt < ntile; kt += 2) {
            AT_BODY(kt, AT_STORE, AT_LOAD);
            AT_BODY(kt + 1, AT_STOREB, AT_LOADB);
        }
#undef AT_BODY
#undef AT_LOADB
#undef AT_STOREB
#undef AT_LOAD
#undef AT_STORE
#undef AT_QK
        const float inv = 1.f / (l_run + __shfl_xor(l_run, 32));
        const int b = bh >> 2, head = bh & 3, qi = q0 + 32 * wave + ql;
        const size_t row = isctx ? (size_t)NL + b * 256 + qi : (size_t)b * 4096 + (qi - 256);
        bf16* orow = AO + row * 256 + head * 64 + 4 * h2;
#pragma unroll
        for (int g = 0; g < 4; ++g) { v2u o0, o1; o0.x = pk2(O0[4 * g] * inv, O0[4 * g + 1] * inv); o0.y = pk2(O0[4 * g + 2] * inv, O0[4 * g + 3] * inv); o1.x = pk2(O1[4 * g] * inv, O1[4 * g + 1] * inv); o1.y = pk2(O1[4 * g + 2] * inv, O1[4 * g + 3] * inv);
            *(GAS v2u*)(orow + 8 * g) = o0; *(GAS v2u*)(orow + 32 + 8 * g) = o1; }
    }
}

__device__ __forceinline__ void phase_fin_mla(Frame& F, int li) { WS_DECL; frame_refresh(F);
    const int nrows = li == DEPTH - 1 ? NL : NT; const float* g = in_ptr(I_MLAON) + li * 256; const bf16* AO = WSP(bf16, WS_AO); bf16* MIX = WSP(bf16, WS_A1);
    const int gw = blockIdx.x * NWAVES + F.wave, NGW = F.G * NWAVES; const f32x4 g4 = *(const GAS f32x4*)(g + 4 * F.lane);
    for (int m4 = gw * 4; m4 < nrows; m4 += NGW * 4) { v2u w[4];
#pragma unroll
        for (int i = 0; i < 4; ++i) w[i] = *(const GAS v2u*)(AO + (size_t)(m4 + i) * 256 + 4 * F.lane);
#pragma unroll
        for (int i = 0; i < 4; ++i) { f32x4 x; x.x = bflo(w[i].x); x.y = bfhi(w[i].x); x.z = bflo(w[i].y); x.w = bfhi(w[i].y);
            const float r = __builtin_amdgcn_rsqf(wave_sum(x.x * x.x + x.y * x.y + x.z * x.z + x.w * x.w) * (1.f / 256.f) + 1e-6f);
            v2u o; o.x = pk2(x.x * r * g4.x, x.y * r * g4.y); o.y = pk2(x.z * r * g4.z, x.w * r * g4.w); *(GAS v2u*)(MIX + (size_t)(m4 + i) * D + 4 * F.lane) = o; } }
}
__device__ __forceinline__ void phase_fin_zero(Frame& F, int li, int c0) { WS_DECL; frame_refresh(F);
    const int nrows = li == DEPTH - 1 ? NL : NT; bf16* MIX = WSP(bf16, WS_A1); const int gw = blockIdx.x * NWAVES + F.wave, NGW = F.G * NWAVES;
    for (int m = gw; m < nrows; m += NGW) *(GAS v2u*)(MIX + (size_t)m * D + c0 + 4 * F.lane) = (v2u){0u, 0u};
}

__device__ __forceinline__ void phase_pro0b(Frame& F) { WS_DECL; frame_refresh(F);
    const int gt = blockIdx.x * NTHR + F.tid, NGT = F.G * NTHR;
    float* RC = WSP(float, WS_ROPE); float* RS = RC + 4096 * 16;
    for (int i = gt; i < 4096 * 16; i += NGT) { const int t = i >> 4, j = i & 15; const float inv = powf(10000.f, -(float)(j & 7) / 8.f); const float pos = j < 8 ? (float)(t >> 6) : (float)(t & 63);
        const float ang = pos * inv; RC[i] = cosf(ang); RS[i] = sinf(ang); }
    const float* wuq = in_ptr(I_WUQ); const float* wukv = in_ptr(I_WUKV); bf16* WQ = WSP(bf16, WS_WUQT); bf16* WKV = WSP(bf16, WS_WUKVT);
    for (int i = gt; i < DEPTH * 384 * 192; i += NGT) { const int li = i / (384 * 192), r = i % (384 * 192), n = r / 192, k = r % 192; WQ[i] = (bf16)f2bf(wuq[(size_t)li * 192 * 384 + (size_t)k * 384 + n]); }
    for (int i = gt; i < DEPTH * 512 * 128; i += NGT) { const int li = i / (512 * 128), r = i % (512 * 128), n = r / 128, k = r % 128; WKV[i] = (bf16)f2bf(wukv[(size_t)li * 128 * 512 + (size_t)k * 512 + n]); }
}

constexpr int LR_LD = 264;
__device__ __forceinline__ float gelu_tanh(float x) { const float u = 0.7978845608028654f * (x + 0.044715f * x * x * x); const float e = __expf(2.f * u); const float t = 1.f - 2.f / (e + 1.f); return 0.5f * x * (1.f + t); }
template <int PASS>
__device__ __forceinline__ void phase_lru(Frame& F, int li) { WS_DECL; frame_refresh(F);
    LAS bf16* RAW = (LAS bf16*)F.lds; LAS bf16* U = (LAS bf16*)(F.lds + 67 * LR_LD * 2); LAS bf16* HS = (LAS bf16*)(F.lds + 71680); LAS float* HC = (LAS float*)(F.lds + 106496);
    const bf16* P = WSP(bf16, WS_P); bf16* MIX = WSP(bf16, WS_A1); f32x2* SUMM = WSP(f32x2, WS_SUMM);
    const float* cw = in_ptr(I_LCW) + li * 4 * 256; const float* cb = in_ptr(I_LCB) + li * 256;
    const float* lam_ = in_ptr(I_LLAM) + li * 512; const float* br_ = in_ptr(I_LBR) + li * 512; const float* bi_ = in_ptr(I_LBI) + li * 512; const float* on_ = in_ptr(I_LON) + li * 256;
    const bf16* LW = WSP(bf16, WS_LRUW) + (size_t)li * 16 * 4096;
    const int lane = F.lane, wave = F.wave, tid = F.tid, fr = lane & 15, kg = lane >> 4;
    const int nitems = (PASS == 3 && li == DEPTH - 1) ? NL / 64 : NT / 64;
    const int vb_ = PASS == 1 ? (int)((blockIdx.x + 128) % F.G) : (int)((blockIdx.x + 192) % F.G);
    for (int item = vb_; item < nitems; item += F.G) {
        const int m0 = item * 64; const bool isctx = m0 >= NL; const int b = isctx ? (m0 - NL) >> 8 : m0 >> 12; const int t0 = isctx ? (m0 - NL) & 255 : m0 & 4095; const int Ls = isctx ? 256 : 4096;
        const size_t seg0 = isctx ? (size_t)NL + b * 256 : (size_t)b * 4096;
        v4u sv_[5];
        {
#pragma unroll
          for (int u = 0; u < 5; ++u) { const int c = tid + NTHR * u, r = c >> 5, cc = c & 31, t = t0 - 2 + r; sv_[u] = (v4u){0u, 0u, 0u, 0u};
              if (c < 67 * 32 && t >= 0 && t < Ls) sv_[u] = *(const GAS v4u*)(P + (seg0 + t) * PCOLS + 352 + 8 * cc); } }

        if (PASS == 3) {
            const int dd = tid >> 8, chh = tid & 255; const int cj = t0 >> 6, cbase = 1024 + b * 4, lbase = b * 64;
            const int np = dd == 0 ? (isctx ? cj : 4 + cj) : (isctx ? 3 - cj : 4 + 63 - cj);
            float Hc = 0.f;
#pragma unroll 1
            for (int p0 = 0; p0 < np; p0 += 24) { f32x2 sv[24];
#pragma unroll
                for (int e = 0; e < 24; ++e) { const int p = p0 + e; sv[e] = (f32x2){1.f, 0.f};
                    if (p < np) { int cid; if (dd == 0) cid = isctx ? cbase + p : (p < 4 ? cbase + p : lbase + (p - 4)); else cid = isctx ? cbase + 3 - p : (p < 4 ? cbase + 3 - p : lbase + 63 - (p - 4));
                        sv[e] = *(const GAS f32x2*)(SUMM + ((size_t)cid * 2 + dd) * 256 + chh); } }
#pragma unroll
                for (int e = 0; e < 24; ++e) Hc = sv[e].x * Hc + sv[e].y; }
            HC[dd * 256 + chh] = Hc; }
#pragma unroll
        for (int u = 0; u < 5; ++u) { const int c = tid + NTHR * u, r = c >> 5, cc = c & 31; if (c < 67 * 32) *(LAS v4u*)(RAW + r * LR_LD + 8 * cc) = sv_[u]; }
        __syncthreads();
        { const int c2 = tid & 127, tq = tid >> 7; const int ch = 2 * c2;
          float w0[4], w1[4];
#pragma unroll
          for (int j = 0; j < 4; ++j) { w0[j] = cw[j * 256 + ch]; w1[j] = cw[j * 256 + ch + 1]; }
          const float b0 = cb[ch], b1 = cb[ch + 1];
          for (int t = tq * 16; t < tq * 16 + 16; ++t) { float s0 = b0, s1 = b1;
#pragma unroll
              for (int j = 0; j < 4; ++j) { const unsigned w = *(const LAS unsigned*)(RAW + (t + j) * LR_LD + ch); s0 += w0[j] * bflo(w); s1 += w1[j] * bfhi(w); }
              *(LAS unsigned*)(U + t * LR_LD + ch) = pk2(s0, s1); } }
        __syncthreads();
#pragma unroll 1
        for (int ni = 0; ni < 2; ++ni) {
            float yv[4][4];
            const int nt = 2 * wave + ni, nb = nt >> 2, ch = 16 * nt + fr;
            bf16x8 wfr[2][2][2]; float spc[2], brc[2], bic[2];
#pragma unroll
            for (int d = 0; d < 2; ++d) { spc[d] = lam_[d * 256 + ch]; brc[d] = br_[d * 256 + ch]; bic[d] = bi_[d * 256 + ch];
#pragma unroll
                for (int g = 0; g < 2; ++g)
#pragma unroll
                    for (int ks = 0; ks < 2; ++ks) wfr[d][g][ks] = *(const GAS bf16x8*)(LW + ((size_t)((g * 2 + d) * 4 + nb) * 64 + 16 * (nt & 3) + fr) * 64 + 32 * ks + 8 * kg); }
            float uu[4][4];
#pragma unroll
            for (int m = 0; m < 4; ++m)
#pragma unroll
                for (int r = 0; r < 4; ++r) uu[m][r] = bf2f(U[(16 * m + 4 * kg + r) * LR_LD + ch]);
#pragma unroll
            for (int d = 0; d < 2; ++d) {
                f32x4 ar[4], ai[4];
#pragma unroll
                for (int m = 0; m < 4; ++m) { ar[m] = (f32x4){0.f, 0.f, 0.f, 0.f}; ai[m] = (f32x4){0.f, 0.f, 0.f, 0.f}; }
#pragma unroll
                for (int ks = 0; ks < 2; ++ks) {
                    const bf16x8 wr = wfr[d][0][ks], wi = wfr[d][1][ks];
#pragma unroll
                    for (int m = 0; m < 4; ++m) { const bf16x8 xf = *(const LAS bf16x8*)(U + (16 * m + fr) * LR_LD + 64 * nb + 32 * ks + 8 * kg);
                        ar[m] = __builtin_amdgcn_mfma_f32_16x16x32_bf16(xf, wr, ar[m], 0, 0, 0); ai[m] = __builtin_amdgcn_mfma_f32_16x16x32_bf16(xf, wi, ai[m], 0, 0, 0); } }
                const float sp = __logf(1.f + __expf(-spc[d])), brv = brc[d], biv = bic[d];
#pragma unroll
                for (int m = 0; m < 4; ++m)
#pragma unroll
                    for (int r = 0; r < 4; ++r) { const float rg = __builtin_amdgcn_rcpf(1.f + __expf(-(ar[m][r] + brv))), ig = __builtin_amdgcn_rcpf(1.f + __expf(-(ai[m][r] + biv))); const float av = __expf(-8.f * rg * sp);
                        ar[m][r] = av; ai[m][r] = __builtin_amdgcn_sqrtf(fmaxf(1.f - av * av, 0.f)) * (ig * uu[m][r]); }
                float H = 0.f;
                if (PASS == 3) H = HC[d * 256 + ch];
                float Ac = 1.f, Bc = 0.f;
#pragma unroll
                for (int mi = 0; mi < 4; ++mi) { const int m = d == 0 ? mi : 3 - mi;
                    float Al, Bl;
                    if (d == 0) { Al = ar[m][0] * ar[m][1] * ar[m][2] * ar[m][3]; Bl = ((ai[m][0] * ar[m][1] + ai[m][1]) * ar[m][2] + ai[m][2]) * ar[m][3] + ai[m][3]; }
                    else { Al = ar[m][0] * ar[m][1] * ar[m][2] * ar[m][3]; Bl = ((ai[m][3] * ar[m][2] + ai[m][2]) * ar[m][1] + ai[m][1]) * ar[m][0] + ai[m][0]; }
                    float Ag[4], Bg[4];
#pragma unroll
                    for (int g = 0; g < 4; ++g) { Ag[g] = __shfl(Al, fr + 16 * g); Bg[g] = __shfl(Bl, fr + 16 * g); }
                    if (PASS == 1) {
                        float At = 1.f, Bt = 0.f;
#pragma unroll
                        for (int gi = 0; gi < 4; ++gi) { const int g = d == 0 ? gi : 3 - gi; Bt = Ag[g] * Bt + Bg[g]; At = Ag[g] * At; }
                        Bc = At * Bc + Bt; Ac = At * Ac;
                    } else {
                        float s = H, sin_ = H;
#pragma unroll
                        for (int gi = 0; gi < 4; ++gi) { const int g = d == 0 ? gi : 3 - gi; if (g == kg) sin_ = s; s = Ag[g] * s + Bg[g]; }
                        H = s;
                        float x = sin_;
#pragma unroll
                        for (int ri = 0; ri < 4; ++ri) { const int r = d == 0 ? ri : 3 - ri; x = ar[m][r] * x + ai[m][r]; if (d == 0) yv[m][r] = x; else yv[m][r] += x; }
                    }
                }
                if (PASS == 1 && kg == 0) *(GAS f32x2*)(SUMM + ((size_t)item * 2 + d) * 256 + ch) = (f32x2){Ac, Bc};
            }
            if (PASS == 3) {
#pragma unroll
                for (int m = 0; m < 4; ++m)
#pragma unroll
                    for (int r = 0; r < 4; ++r) HS[(16 * m + 4 * kg + r) * LR_LD + ch] = (bf16)f2bf(yv[m][r]);
            }
        }
        if (PASS == 3) {
            __syncthreads();
            const f32x4 on4 = *(const GAS f32x4*)(on_ + 4 * lane);
            v2u gws[8];
#pragma unroll
            for (int i = 0; i < 8; ++i) gws[i] = *(const GAS v2u*)(P + (size_t)(m0 + wave * 8 + i) * PCOLS + 608 + 4 * lane);
#pragma unroll
            for (int i = 0; i < 8; ++i) { const int tl = wave * 8 + i; const v2u hw = *(const LAS v2u*)(HS + tl * LR_LD + 4 * lane); const v2u gw = gws[i];
                f32x4 y; y.x = bflo(hw.x) * gelu_tanh(bflo(gw.x)); y.y = bfhi(hw.x) * gelu_tanh(bfhi(gw.x)); y.z = bflo(hw.y) * gelu_tanh(bflo(gw.y)); y.w = bfhi(hw.y) * gelu_tanh(bfhi(gw.y));
                const float rs = __builtin_amdgcn_rsqf(wave_sum(y.x * y.x + y.y * y.y + y.z * y.z + y.w * y.w) * (1.f / 256.f) + 1e-6f);
                v2u o; o.x = pk2(y.x * rs * on4.x, y.y * rs * on4.y); o.y = pk2(y.z * rs * on4.z, y.w * rs * on4.w);
                *(GAS v2u*)(MIX + (size_t)(m0 + tl) * D + 256 + 4 * lane) = o; }
        }
        __syncthreads();
    }
}

__device__ __forceinline__ void phase_pro0c(Frame& F) { WS_DECL; frame_refresh(F);
    const int gt = blockIdx.x * NTHR + F.tid, NGT = F.G * NTHR; const float* wr = in_ptr(I_LWR); const float* wi = in_ptr(I_LWI); bf16* LW = WSP(bf16, WS_LRUW);
    for (int i = gt; i < DEPTH * 16 * 4096; i += NGT) { const int c = i & 63, dd = (i >> 6) & 63, nb = (i >> 12) & 3, d = (i >> 14) & 1, g = (i >> 15) & 1, li = i >> 16;
        const float* src = g == 0 ? wr : wi; LW[i] = (bf16)f2bf(src[((((size_t)li * 2 + d) * 4 + nb) * 64 + c) * 64 + dd]); }
}

template <int CTRL> __device__ __forceinline__ float dpp_f(float x) { return __builtin_bit_cast(float, __builtin_amdgcn_mov_dpp(__builtin_bit_cast(int, x), CTRL, 0xf, 0xf, true)); }
__device__ __forceinline__ float rowsum16(float x) { x += dpp_f<0x128>(x); x += dpp_f<0x124>(x); x += dpp_f<0x122>(x); x += dpp_f<0x121>(x); return x; }
constexpr int RW_C0 = 864;
constexpr size_t WS_RWUP = WS_LRUW + 512 * 1024;
constexpr size_t WS_GUPT = WS_LRUW + 768 * 1024;
constexpr size_t WS_EA = WS_Y;

__device__ __forceinline__ void phase_pro0e(Frame& F) { WS_DECL; frame_refresh(F);
    const int gt = blockIdx.x * NTHR + F.tid, NGT = F.G * NTHR; const float* wup = in_ptr(I_WUP); const float* aup = in_ptr(I_AUP); bf16* W = WSP(bf16, WS_RWUP);
    for (int i = gt; i < DEPTH * 2 * 2 * 256 * 32; i += NGT) { const int k = i & 31, n = (i >> 5) & 255, wa = (i >> 13) & 1, d = (i >> 14) & 1, li = i >> 15;
        const float* src = wa == 0 ? wup : aup; W[i] = (bf16)f2bf(src[(((size_t)li * 2 + d) * 32 + k) * 256 + n]); }
    { const float* gup = in_ptr(I_GUP); bf16* GT = WSP(bf16, WS_GUPT);
      for (int i = gt; i < DEPTH * 256 * 64; i += NGT) { const int k = i & 63, n = (i >> 6) & 255, li = i >> 14; GT[i] = (bf16)f2bf(gup[((size_t)li * 64 + k) * 256 + n]); } }
}

constexpr int R0_LD = 136, R0_ZLD = 72;
__device__ __forceinline__ void phase_rwkv_r0(Frame& F, int li) { WS_DECL; frame_refresh(F);
    LAS bf16* RAWL = (LAS bf16*)F.lds;
    LAS bf16* ZW = (LAS bf16*)(F.lds + 66 * R0_LD * 2);
    LAS bf16* ZA = ZW + 64 * R0_ZLD;
    const bf16* P = WSP(bf16, WS_P); bf16* EA = WSP(bf16, WS_EA); const bf16* W = WSP(bf16, WS_RWUP) + (size_t)li * 2 * 2 * 256 * 32;
    const float* mup = in_ptr(I_MUP) + li * 960 + 768; const float* mun = in_ptr(I_MUN) + li * 960 + 768; const float* w0 = in_ptr(I_W0) + li * 512; const float* a0 = in_ptr(I_A0) + li * 512;
    const int tid = F.tid, lane = F.lane, wave = F.wave, fr = lane & 15, kg = lane >> 4;
    for (int item = blockIdx.x; item < NT / 64; item += F.G) {
        const int m0 = item * 64; const bool isctx = m0 >= NL; const int t0 = isctx ? (m0 - NL) & 255 : m0 & 4095; const int Ls = isctx ? 256 : 4096; const size_t seg0 = (size_t)m0 - t0;
        __syncthreads();
        { v4u sv_[3];
#pragma unroll
          for (int u = 0; u < 3; ++u) { const int c = tid + NTHR * u, r = c >> 4, cc = c & 15, t = t0 - 1 + r; sv_[u] = (v4u){0u, 0u, 0u, 0u};
              if (c < 66 * 16 && t >= 0 && t < Ls) sv_[u] = *(const GAS v4u*)(P + (seg0 + t) * PCOLS + RW_C0 + 768 + 8 * cc); }
#pragma unroll
          for (int u = 0; u < 3; ++u) { const int c = tid + NTHR * u, r = c >> 4, cc = c & 15; if (c < 66 * 16) *(LAS v4u*)(RAWL + r * R0_LD + 8 * cc) = sv_[u]; } }
        __syncthreads();
        { const int c = tid & 127, tq = tid >> 7; const float mp = mup[c], mn = mun[c];
          for (int tl = tq * 16; tl < tq * 16 + 16; ++tl) { const float x = bf2f(RAWL[(tl + 1) * R0_LD + c]), xp = bf2f(RAWL[tl * R0_LD + c]), xn = bf2f(RAWL[(tl + 2) * R0_LD + c]);
              const float z = x + mp * (xp - x) + mn * (xn - x);
              if (c < 64) { const float e2 = __expf(2.f * z); ZW[tl * R0_ZLD + c] = (bf16)f2bf(1.f - 2.f * __builtin_amdgcn_rcpf(e2 + 1.f)); } else ZA[tl * R0_ZLD + (c - 64)] = (bf16)f2bf(z); } }
        __syncthreads();
        const int d = wave >> 2, hh = wave & 3;
#pragma unroll 1
        for (int nt = 0; nt < 4; ++nt) { const int ch0 = 64 * hh + 16 * nt;
            const bf16x8 wf = *(const GAS bf16x8*)(W + ((size_t)(d * 2 + 0) * 256 + ch0 + fr) * 32 + 8 * kg), af = *(const GAS bf16x8*)(W + ((size_t)(d * 2 + 1) * 256 + ch0 + fr) * 32 + 8 * kg);
            const f32x4 w04 = *(const GAS f32x4*)(w0 + d * 256 + ch0 + 4 * kg), a04 = *(const GAS f32x4*)(a0 + d * 256 + ch0 + 4 * kg);
#pragma unroll
            for (int m = 0; m < 4; ++m) { const bf16x8 zw = *(const LAS bf16x8*)(ZW + (16 * m + fr) * R0_ZLD + 32 * d + 8 * kg), za = *(const LAS bf16x8*)(ZA + (16 * m + fr) * R0_ZLD + 32 * d + 8 * kg);
                f32x4 xw = __builtin_amdgcn_mfma_f32_16x16x32_bf16(wf, zw, (f32x4){0.f, 0.f, 0.f, 0.f}, 0, 0, 0), xa = __builtin_amdgcn_mfma_f32_16x16x32_bf16(af, za, (f32x4){0.f, 0.f, 0.f, 0.f}, 0, 0, 0);
                xw = xw + w04; xa = xa + a04; float e[4], av[4];
#pragma unroll
                for (int r = 0; r < 4; ++r) { e[r] = -0.6065306597126334f * __builtin_amdgcn_rcpf(1.f + __expf(-xw[r])); av[r] = __builtin_amdgcn_rcpf(1.f + __expf(-xa[r])); }
                const size_t tok = (size_t)m0 + 16 * m + fr; v2u oe, oa; oe.x = pk2(e[0], e[1]); oe.y = pk2(e[2], e[3]); oa.x = pk2(av[0], av[1]); oa.y = pk2(av[2], av[3]);
                *(GAS v2u*)(EA + (tok * 4 + d) * 256 + ch0 + 4 * kg) = oe; *(GAS v2u*)(EA + (tok * 4 + 2 + d) * 256 + ch0 + 4 * kg) = oa; } }
    }
    __syncthreads();
}

constexpr int RW_T = 16, RW_NCH = (LCX + SEQ) / RW_T, RW_ROWS = RW_T + 2, RW_LD = 200, RW_P = 72;
constexpr int RW_RAW = 0, RW_RAWB = RW_ROWS * RW_LD * 2;
constexpr int RW_EAB = RW_RAW + 2 * RW_RAWB, RW_EABB = RW_T * 128 * 2;
constexpr int RW_VPITCH = 260, RW_VLWF = RW_T * RW_VPITCH * 2;
constexpr int RW_LWP = 68;
constexpr int RW_VEC = RW_EAB + 2 * RW_EABB, RW_VECB = RW_VLWF + RW_T * RW_LWP * 4;
constexpr int RW_VV = RW_VEC + 2 * RW_VECB;
constexpr int RW_BON = RW_VV + 8 * 1024;
constexpr int RW_ARA = RW_BON + 8 * 64;
constexpr int RW_KB2 = RW_ARA + 2 * 16 * RW_P * 2;
constexpr int RW_AT2 = RW_KB2 + 2 * 32 * RW_P * 2;
constexpr int RW_ARR = RW_AT2 + 4 * 2048;
constexpr int RW_KT = RW_ARR + 4 * 16 * RW_P * 2;
constexpr int RW_BTN = RW_KT + 4 * 2048;
constexpr int RW_CWT = RW_BTN + 4 * 2048;
constexpr int RW_DO = RW_CWT + 4 * 256;
constexpr int RW_DOB = 16 * RW_P * 2 + 3 * 512;
constexpr int RW_BC = RW_DO + 4 * RW_DOB;
constexpr int RW_END = RW_BC + 9 * 256;
static_assert(RW_END <= RING_BYTES, "rwkv lds map");
typedef LAS bf16* lbf;
__device__ __forceinline__ bf16x8 rw_zero8() { return (bf16x8){0, 0, 0, 0, 0, 0, 0, 0}; }
__device__ __forceinline__ bf16x8 rw_k16(const LAS bf16* rowp, int kg) { bf16x8 r = rw_zero8(); if (kg < 2) r = *(const LAS bf16x8*)(rowp + 8 * kg); return r; }
__device__ __forceinline__ bf16x8 rw_perm4(const LAS bf16* rowp, int kg) { union { bf16x8 v; v2u h[2]; } u; u.h[0] = *(const LAS v2u*)(rowp + 4 * kg); u.h[1] = (v2u){0u, 0u}; return u.v; }
__device__ __forceinline__ bf16x8 rw_permK(const LAS bf16* rowp, int kg, int sp) { union { bf16x8 v; v2u h[2]; } u; u.h[0] = *(const LAS v2u*)(rowp + 32 * sp + 4 * kg); u.h[1] = *(const LAS v2u*)(rowp + 32 * sp + 16 + 4 * kg); return u.v; }
__device__ __forceinline__ bf16x8 rw_c4(f32x4 c) { union { bf16x8 v; unsigned u[4]; } x; x.u[0] = pk2(c[0], c[1]); x.u[1] = pk2(c[2], c[3]); x.u[2] = 0u; x.u[3] = 0u; return x.v; }
__device__ __forceinline__ bf16x8 rw_c8(f32x4 c0, f32x4 c1) { union { bf16x8 v; unsigned u[4]; } x; x.u[0] = pk2(c0[0], c0[1]); x.u[1] = pk2(c0[2], c0[3]); x.u[2] = pk2(c1[0], c1[1]); x.u[3] = pk2(c1[2], c1[3]); return x.v; }
__device__ __forceinline__ void rw_st_rows(lbf M, f32x4 c, int fr, int kg) {
#pragma unroll
    for (int r = 0; r < 4; ++r) M[(4 * kg + r) * 16 + fr] = (bf16)f2bf(c[r]); }
__device__ __forceinline__ void rw_st_cols(lbf M, f32x4 c, int fr, int kg, int pitch) {
    v2u o; o.x = pk2(c[0], c[1]); o.y = pk2(c[2], c[3]); *(LAS v2u*)(M + fr * pitch + 4 * kg) = o; }
#define RW_MFMA(a, b, c) __builtin_amdgcn_mfma_f32_16x16x32_bf16(a, b, c, 0, 0, 0)

__device__ __forceinline__ void phase_rwkv_scan(Frame& F, int li) { WS_DECL; frame_refresh(F);
    const bf16* P = WSP(bf16, WS_P); const bf16* EA = WSP(bf16, WS_EA); float* YR = WSP(float, WS_YR); float* BON = WSP(float, WS_BON);

    const int tid = F.tid, lane = F.lane, wave = F.wave, fr = lane & 15, kg = lane >> 4;
    LAS unsigned char* L = F.lds;
    for (int item = blockIdx.x; item < 256; item += F.G) {
        const int vhalf = item & 1, d = (item >> 1) & 1, h = (item >> 2) & 3, b = item >> 4;
        __syncthreads();
        const int pt = (tid - 128) & 255, ps = pt >> 4, pq = pt & 15;
        const int sk = pt >> 2, sq = pt & 3;
        { LAS float* BC = (LAS float*)(L + RW_BC); const float* mup = in_ptr(I_MUP) + li * 960; const float* mun = in_ptr(I_MUN) + li * 960;
          if (tid < 64) { const int c = 64 * h + tid; BC[tid] = mup[c]; BC[64 + tid] = mup[256 + c]; BC[128 + tid] = mup[512 + c]; BC[192 + tid] = mun[c]; BC[256 + tid] = mun[256 + c]; BC[320 + tid] = mun[512 + c];
              BC[384 + tid] = in_ptr(I_KK)[li * 256 + c]; BC[448 + tid] = in_ptr(I_KA)[li * 256 + c]; BC[512 + tid] = in_ptr(I_RK)[li * 256 + c]; } }
        __syncthreads();
        f32x4 S0 = (f32x4){0.f, 0.f, 0.f, 0.f}, S1 = S0, S2 = S0, S3 = S0;
        v4u ra[11];
#pragma unroll
        for (int q = 0; q < 11; ++q) ra[q] = (v4u){0u, 0u, 0u, 0u};
        if (wave < 2) {
            __builtin_amdgcn_s_setprio(2);
#pragma unroll 1
            for (int it = -8; it <= RW_NCH; ++it) {
                if (it >= 0 && it < RW_NCH) {
                    const lbf VV = (lbf)(L + RW_VV + (it & 7) * 1024), ARR = (lbf)(L + RW_ARR + (it & 3) * (16 * RW_P * 2)), KTB = (lbf)(L + RW_KT + (it & 3) * 4096);
                    const LAS float* CWT = (const LAS float*)(L + RW_CWT + (it & 3) * 256);
                    const lbf APT = (lbf)(L + RW_DO + (it & 3) * RW_DOB), AMT = APT + 16 * RW_P, ARKB = AMT + 256;
                    const f32x4 Z = (f32x4){0.f, 0.f, 0.f, 0.f};
                    union { bf16x8 v; v2u h[2]; } bv; bv.h[0] = *(const LAS v2u*)(VV + (16 * wave + fr) * 16 + 4 * kg); bv.h[1] = (v2u){0u, 0u};
                    const bf16x8 sb0 = rw_c8(S0, S1), sb1 = rw_c8(S2, S3);
                    f32x4 UT = RW_MFMA(rw_perm4(AMT + fr * 16, kg), bv.v, Z);
                    UT = RW_MFMA(rw_permK(APT + fr * RW_P, kg, 0), sb0, UT); UT = RW_MFMA(rw_permK(APT + fr * RW_P, kg, 1), sb1, UT);
                    f32x4 YT = RW_MFMA(rw_permK(ARR + fr * RW_P, kg, 0), sb0, Z); YT = RW_MFMA(rw_permK(ARR + fr * RW_P, kg, 1), sb1, YT);
                    bv.h[1] = (v2u){pk2(UT[0], UT[1]), pk2(UT[2], UT[3])};
                    YT = RW_MFMA(*(const LAS bf16x8*)(ARKB + fr * 32 + 8 * kg), bv.v, YT);
                    { const bool isctx = it < LCX / RW_T;
                      if (!isctx || li < DEPTH - 1) { const int cl = isctx ? it : it - LCX / RW_T; const int Ls = isctx ? LCX : SEQ; const int tlo = d == 0 ? cl * RW_T : Ls - RW_T - cl * RW_T; const size_t seg0 = isctx ? (size_t)NL + b * LCX : (size_t)b * SEQ;
#pragma unroll
                          for (int r = 0; r < 4; ++r) { const int sidx = 4 * kg + r; const int t = d == 0 ? tlo + sidx : tlo + RW_T - 1 - sidx;
                              YR[((size_t)d * NT + seg0 + t) * 256 + 64 * h + 32 * vhalf + 16 * wave + fr] = YT[r]; }
                          if (vhalf == 0 && wave == 0 && lane < RW_T) { const LAS float* BONS = (const LAS float*)(L + RW_BON) + (it & 7) * RW_T; const int t = d == 0 ? tlo + lane : tlo + RW_T - 1 - lane;
                              BON[((size_t)d * NT + seg0 + t) * 4 + h] = BONS[lane]; } } }
                    S0 = RW_MFMA(*(const LAS bf16x8*)(KTB + (0 + fr) * 32 + 8 * kg), bv.v, S0) * *(const LAS f32x4*)(CWT + 0 + 4 * kg);
                    S1 = RW_MFMA(*(const LAS bf16x8*)(KTB + (16 + fr) * 32 + 8 * kg), bv.v, S1) * *(const LAS f32x4*)(CWT + 16 + 4 * kg);
                    S2 = RW_MFMA(*(const LAS bf16x8*)(KTB + (32 + fr) * 32 + 8 * kg), bv.v, S2) * *(const LAS f32x4*)(CWT + 32 + 4 * kg);
                    S3 = RW_MFMA(*(const LAS bf16x8*)(KTB + (48 + fr) * 32 + 8 * kg), bv.v, S3) * *(const LAS f32x4*)(CWT + 48 + 4 * kg);
                }
                __syncthreads();
            }
            __builtin_amdgcn_s_setprio(0);
        } else if (wave < 6) {
            int offq[11], ldq[11];
#pragma unroll
            for (int q = 0; q < 11; ++q) { const int c = lane + 64 * q; int o = 0, l = -1;
                if (c < RW_ROWS * 24) { const int r = c / 24, cc = c % 24; o = r * (PCOLS * 2) + 2 * (RW_C0 + 256 * (cc >> 3) + 64 * h + 8 * (cc & 7)); l = RW_RAW + (r * RW_LD + 8 * cc) * 2; }
                else if (c < RW_ROWS * 24 + RW_T * 16) { const int e = c - RW_ROWS * 24, s = e >> 4, cc = e & 15; o = (((d == 0 ? s : RW_T - 1 - s) * 4 + (cc >> 3) * 2 + d) * 256 + 64 * h + 8 * (cc & 7)) * 2; l = RW_EAB + 16 * e; }
                offq[q] = o; ldq[q] = l; }
            const LAS float* BC = (const LAS float*)(L + RW_BC) + 4 * pq;
            const f32x4 mpr = *(const LAS f32x4*)(BC), mpk = *(const LAS f32x4*)(BC + 64), mpv = *(const LAS f32x4*)(BC + 128), mnr = *(const LAS f32x4*)(BC + 192), mnk = *(const LAS f32x4*)(BC + 256), mnv = *(const LAS f32x4*)(BC + 320);
            const f32x4 kk_c = *(const LAS f32x4*)(BC + 384), ka_c = *(const LAS f32x4*)(BC + 448), rk_c = *(const LAS f32x4*)(BC + 512);
#pragma unroll 1
            for (int it = -8; it <= RW_NCH; ++it) {
                { const int ca = it + 5;
                  if (ca >= 0 && ca < RW_NCH && ((ca & 3) == wave - 2)) { const bool isctx = ca < LCX / RW_T; const int cl = isctx ? ca : ca - LCX / RW_T; const int Ls = isctx ? LCX : SEQ; const int tlo = d == 0 ? cl * RW_T : Ls - RW_T - cl * RW_T;
                      const bool edge_lo = tlo == 0, edge_hi = tlo + RW_T == Ls;
#pragma unroll
                      for (int q = 0; q < 11; ++q) { v4u v = ra[q];
                          if (q == 0 && edge_lo && lane < 24) v = (v4u){0u, 0u, 0u, 0u};
                          if (q == 6 && edge_hi && lane >= 24 && lane < 48) v = (v4u){0u, 0u, 0u, 0u};
                          const int bo = (ca & 1) * ((q < 6 || (q == 6 && lane < 48)) ? RW_RAWB : RW_EABB);
                          if (q < 10 || lane < 48) *(LAS v4u*)(L + ldq[q] + bo) = v; } }
                  const int cn = it + 8;
                  if (cn < RW_NCH && ((cn & 3) == wave - 2)) { const bool isctx = cn < LCX / RW_T; const int cl = isctx ? cn : cn - LCX / RW_T; const int Ls = isctx ? LCX : SEQ; const int tlo = d == 0 ? cl * RW_T : Ls - RW_T - cl * RW_T;
                      const long row0 = (long)(isctx ? NL + b * LCX : b * SEQ) + tlo;
                      const char* pb = (const char*)P + (row0 - 1) * (PCOLS * 2);
                      const unsigned delta = (unsigned)(((const char*)EA + row0 * 2048) - pb);
#pragma unroll
                      for (int q = 0; q < 11; ++q) { unsigned o = (unsigned)offq[q]; if (q > 6 || (q == 6 && lane >= 48)) o += delta;
                          ra[q] = *(const GAS v4u*)(pb + o); } } }
                const int cb = it + 4;
                if (cb >= 0 && cb < RW_NCH) {
                    const LAS bf16* RAW = (const LAS bf16*)(L + RW_RAW + (cb & 1) * RW_RAWB); const LAS bf16* EAB = (const LAS bf16*)(L + RW_EAB + (cb & 1) * RW_EABB);
                    const lbf VEC = (lbf)(L + RW_VEC + (cb & 1) * RW_VECB); LAS float* LWF = (LAS float*)(L + RW_VEC + (cb & 1) * RW_VECB + RW_VLWF);
                    const lbf VV = (lbf)(L + RW_VV + (cb & 7) * 1024); LAS float* BONS = (LAS float*)(L + RW_BON) + (cb & 7) * RW_T;
                    const int prow = d == 0 ? ps + 1 : RW_T - ps;
                    f32x4 zr, zk, zv;
                    { const LAS bf16* r0 = RAW + prow * RW_LD + 4 * pq;
#define RW_LD4(p) ({ const v2u w_ = *(const LAS v2u*)(p); (f32x4){bflo(w_.x), bfhi(w_.x), bflo(w_.y), bfhi(w_.y)}; })
                      { const f32x4 x = RW_LD4(r0), xp = RW_LD4(r0 - RW_LD), xn = RW_LD4(r0 + RW_LD); zr = x + mpr * (xp - x) + mnr * (xn - x); }
                      { const f32x4 x = RW_LD4(r0 + 64), xp = RW_LD4(r0 + 64 - RW_LD), xn = RW_LD4(r0 + 64 + RW_LD); zk = x + mpk * (xp - x) + mnk * (xn - x); }
                      { const f32x4 x = RW_LD4(r0 + 128), xp = RW_LD4(r0 + 128 - RW_LD), xn = RW_LD4(r0 + 128 + RW_LD); zv = x + mpv * (xp - x) + mnv * (xn - x); } }
                    const f32x4 lw4 = RW_LD4(EAB + ps * 128 + 4 * pq), a4 = RW_LD4(EAB + ps * 128 + 64 + 4 * pq);
                    const f32x4 kkr = zk * kk_c; const float ss = rowsum16((kkr.x * kkr.x + kkr.y * kkr.y) + (kkr.z * kkr.z + kkr.w * kkr.w));
                    const f32x4 kd = zk * ((a4 - 1.f) * ka_c + 1.f); const f32x4 bq = zr * kd * rk_c; const float bn = rowsum16((bq.x + bq.y) + (bq.z + bq.w));
                    const f32x4 kkn = kkr * __builtin_amdgcn_rsqf(fmaxf(ss, 1e-24f)), kka = kkn * a4;
                    { lbf vp = VEC + ps * RW_VPITCH + 16 * pq;
#pragma unroll
                      for (int i = 0; i < 4; ++i) { v2u o; o.x = pk2(kkn[i], kka[i]); o.y = pk2(kd[i], zr[i]); *(LAS v2u*)(vp + 4 * i) = o; } }
                    *(LAS f32x4*)(LWF + ps * RW_LWP + 4 * pq) = lw4;
                    if ((pq >> 3) == vhalf) { const int v0 = 4 * (pq & 7); VV[(v0 + 0) * 16 + ps] = (bf16)f2bf(zv.x); VV[(v0 + 1) * 16 + ps] = (bf16)f2bf(zv.y); VV[(v0 + 2) * 16 + ps] = (bf16)f2bf(zv.z); VV[(v0 + 3) * 16 + ps] = (bf16)f2bf(zv.w); }
                    if (pq == 0) BONS[ps] = bn;
                }
                const int cc3 = it + 3;
                if (cc3 >= 0 && cc3 < RW_NCH) {
                    const LAS bf16* VEC = (const LAS bf16*)(L + RW_VEC + (cc3 & 1) * RW_VECB); const LAS float* LWF = (const LAS float*)(L + RW_VEC + (cc3 & 1) * RW_VECB + RW_VLWF);
                    const lbf ARA = (lbf)(L + RW_ARA + (cc3 & 1) * (16 * RW_P * 2)), KB2 = (lbf)(L + RW_KB2 + (cc3 & 1) * (32 * RW_P * 2)), AT2 = (lbf)(L + RW_AT2 + (cc3 & 3) * 2048);
                    const lbf ARR = (lbf)(L + RW_ARR + (cc3 & 3) * (16 * RW_P * 2)), KTB = (lbf)(L + RW_KT + (cc3 & 3) * 4096); LAS float* CWT = (LAS float*)(L + RW_CWT + (cc3 & 3) * 256);
                    float l4[4];
#pragma unroll
                    for (int j = 0; j < 4; ++j) l4[j] = LWF[(4 * sq + j) * RW_LWP + sk];
                    float cl;
                    { const int own = __builtin_bit_cast(int, (l4[0] + l4[1]) + (l4[2] + l4[3]));
                      const float a1 = __builtin_bit_cast(float, __builtin_amdgcn_update_dpp(0, own, 0x90, 0xf, 0xf, false));
                      const float a2 = __builtin_bit_cast(float, __builtin_amdgcn_update_dpp(0, own, 0x40, 0xf, 0xf, false));
                      const float a3 = __builtin_bit_cast(float, __builtin_amdgcn_update_dpp(0, own, 0x00, 0xf, 0xf, false));
                      cl = ((sq >= 3 ? a3 : 0.f) + (sq >= 2 ? a2 : 0.f)) + (sq >= 1 ? a1 : 0.f); }
                    float cwm = __expf(cl);
                    float atf[4], rtf[4], ktf[4], btf[4];
#pragma unroll
                    for (int j = 0; j < 4; ++j) { const int s = 4 * sq + j; cl += l4[j]; const float cw = __expf(cl), icw = __builtin_amdgcn_rcpf(cw);
                        const v2u vw = *(const LAS v2u*)(VEC + s * RW_VPITCH + 4 * sk); const float kkv = bflo(vw.x), kkav = bfhi(vw.x), kdv = bflo(vw.y), rv = bfhi(vw.y);
                        atf[j] = kkv * cwm; rtf[j] = rv * cw; ktf[j] = kdv * icw; btf[j] = kkav * icw;
                        if (s == RW_T - 1) CWT[sk] = cw;
                        cwm = cw; }
                    unsigned atp[2], ktp[2], bnp[2];
#pragma unroll
                    for (int jp = 0; jp < 2; ++jp) { const int s0 = 4 * sq + 2 * jp; const unsigned a = pk2(atf[2 * jp], atf[2 * jp + 1]), r = pk2(rtf[2 * jp], rtf[2 * jp + 1]), k = pk2(ktf[2 * jp], ktf[2 * jp + 1]), bp = pk2(btf[2 * jp], btf[2 * jp + 1]);
                        ARA[s0 * RW_P + sk] = (bf16)a; ARA[(s0 + 1) * RW_P + sk] = (bf16)(a >> 16); ARR[s0 * RW_P + sk] = (bf16)r; ARR[(s0 + 1) * RW_P + sk] = (bf16)(r >> 16);
                        KB2[s0 * RW_P + sk] = (bf16)k; KB2[(s0 + 1) * RW_P + sk] = (bf16)(k >> 16); KB2[(16 + s0) * RW_P + sk] = (bf16)bp; KB2[(17 + s0) * RW_P + sk] = (bf16)(bp >> 16);
                        atp[jp] = a; ktp[jp] = k; bnp[jp] = bp ^ 0x80008000u; }
                    *(LAS v2u*)(AT2 + sk * 16 + 4 * sq) = (v2u){atp[0], atp[1]}; *(LAS v4u*)(KTB + sk * 32 + 8 * sq) = (v4u){ktp[0], ktp[1], bnp[0], bnp[1]};
                }
                __syncthreads();
            }
        } else {
#pragma unroll 1
            for (int it = -8; it <= RW_NCH; ++it) {
                const int c = it + 2;
                if (c >= 0 && c < RW_NCH && ((c & 1) == (wave & 1))) {
                    const LAS bf16* ARA = (const LAS bf16*)(L + RW_ARA + (c & 1) * (16 * RW_P * 2)); const LAS bf16* KB2 = (const LAS bf16*)(L + RW_KB2 + (c & 1) * (32 * RW_P * 2));
                    const LAS bf16* ARR = (const LAS bf16*)(L + RW_ARR + (c & 3) * (16 * RW_P * 2)); const LAS bf16* AT2 = (const LAS bf16*)(L + RW_AT2 + (c & 3) * 2048);
                    const lbf APT = (lbf)(L + RW_DO + (c & 3) * RW_DOB), AMT = APT + 16 * RW_P, ARKB = AMT + 256;
                    const f32x4 Z = (f32x4){0.f, 0.f, 0.f, 0.f};
                    f32x4 gkk = Z, gkkT = Z, grk = Z, gn = Z, gnT = Z, grb = Z;
#pragma unroll
                    for (int ks = 0; ks < 2; ++ks) { const bf16x8 ak = *(const LAS bf16x8*)(KB2 + fr * RW_P + 32 * ks + 8 * kg), ab = *(const LAS bf16x8*)(KB2 + (16 + fr) * RW_P + 32 * ks + 8 * kg);
                        const bf16x8 ba = *(const LAS bf16x8*)(ARA + fr * RW_P + 32 * ks + 8 * kg), br = *(const LAS bf16x8*)(ARR + fr * RW_P + 32 * ks + 8 * kg);
                        gkk = RW_MFMA(ak, ba, gkk); gkkT = RW_MFMA(ba, ak, gkkT); grk = RW_MFMA(ak, br, grk); gn = RW_MFMA(ab, ba, gn); gnT = RW_MFMA(ba, ab, gnT); grb = RW_MFMA(ab, br, grb); }
                    f32x4 w1, w1T;
#pragma unroll
                    for (int r = 0; r < 4; ++r) { const int row = 4 * kg + r;
                        if (!(row < fr)) { gkk[r] = 0.f; gn[r] = 0.f; } if (!(fr < row)) { gkkT[r] = 0.f; gnT[r] = 0.f; } if (!(row <= fr)) { grk[r] = 0.f; grb[r] = 0.f; }
                        const float idt = row == fr ? 1.f : 0.f; w1[r] = idt - gn[r]; w1T[r] = idt - gnT[r]; }
                    const bf16x8 bn = rw_c4(gn), bnT = rw_c4(gnT);
                    const f32x4 n2 = RW_MFMA(bnT, bn, Z), n2T = RW_MFMA(bn, bnT, Z);
                    const bf16x8 b2 = rw_c4(n2), b2T = rw_c4(n2T);
                    const f32x4 n4 = RW_MFMA(b2T, b2, Z), n4T = RW_MFMA(b2, b2T, Z);
                    const bf16x8 b4 = rw_c4(n4), b4T = rw_c4(n4T);
                    const f32x4 n8 = RW_MFMA(b4T, b4, Z);
                    const bf16x8 bw1T = rw_c4(w1T);
                    const f32x4 w2 = RW_MFMA(bw1T, b2, w1), w2T = RW_MFMA(b2, bw1T, w1T);
                    const bf16x8 bw2T = rw_c4(w2T);
                    const f32x4 w3 = RW_MFMA(bw2T, b4, w2), w3T = RW_MFMA(b4, bw2T, w2T);
                    const f32x4 xi = RW_MFMA(rw_c4(w3T), rw_c4(n8), w3);
                    const bf16x8 bx = rw_c4(xi);
                    const f32x4 am = RW_MFMA(rw_c4(gkkT), bx, Z);
                    rw_st_cols(AMT, am, fr, kg, 16); { const f32x4 nb = Z - grb; *(LAS v4u*)(ARKB + fr * 32 + 8 * kg) = (v4u){pk2(grk[0], grk[1]), pk2(grk[2], grk[3]), pk2(nb[0], nb[1]), pk2(nb[2], nb[3])}; }
#pragma unroll
                    for (int m = 0; m < 4; ++m) { const f32x4 ap = RW_MFMA(rw_perm4(AT2 + (16 * m + fr) * 16, kg), bx, Z);
                        rw_st_cols(APT + 16 * m, ap, fr, kg, RW_P); }
                }
                __syncthreads();
            }
        }
    }
}
struct RwFinRaw { v4u g[2][3]; f32x4 y[2][4]; float b0, b1; };
__device__ __forceinline__ void rwfin_load(RwFinRaw& R, int it, int fr, int kg, const bf16* P, const float* YR, const float* BON) {
    const int hh = it & 3, m = 16 * (it >> 2) + fr; const bool isctx = m >= NL; const int t = isctx ? (m - NL) & 255 : m & 4095; const int Ls = isctx ? 256 : 4096; const bool hp = t > 0, hn = t + 1 < Ls;
    const bf16* pr = P + (size_t)m * PCOLS + RW_C0; const v4u Z4 = (v4u){0u, 0u, 0u, 0u};
#pragma unroll
    for (int ks = 0; ks < 2; ++ks) { const int c = 896 + 32 * ks + 8 * kg; R.g[ks][0] = *(const GAS v4u*)(pr + c); R.g[ks][1] = Z4; R.g[ks][2] = Z4;
        if (hp) R.g[ks][1] = *(const GAS v4u*)(pr - PCOLS + c); if (hn) R.g[ks][2] = *(const GAS v4u*)(pr + PCOLS + c); }
    const int c0 = 64 * hh + 16 * kg;
#pragma unroll
    for (int q = 0; q < 4; ++q) { R.y[0][q] = *(const GAS f32x4*)(YR + (size_t)m * 256 + c0 + 4 * q); R.y[1][q] = *(const GAS f32x4*)(YR + ((size_t)NT + m) * 256 + c0 + 4 * q); }
    R.b0 = BON[(size_t)m * 4 + hh]; R.b1 = BON[((size_t)NT + m) * 4 + hh];
}
__device__ __forceinline__ void phase_fin_rwkv(Frame& F, int li) { WS_DECL; frame_refresh(F);
    const int nrows = li == DEPTH - 1 ? NL : NT; const int lane = F.lane, wave = F.wave, tid = F.tid, fr = lane & 15, kg = lane >> 4;
    LAS bf16* GT = (LAS bf16*)F.lds;
    LAS float* CV = (LAS float*)(F.lds + 256 * 72 * 2);
    const bf16* P = WSP(bf16, WS_P); const float* YR = WSP(float, WS_YR); const float* BON = WSP(float, WS_BON); bf16* MIX = WSP(bf16, WS_A1);
    const float* mup = in_ptr(I_MUP) + li * 960; const float* mun = in_ptr(I_MUN) + li * 960;
    __syncthreads();
    { const bf16* gsrc = WSP(bf16, WS_GUPT) + (size_t)li * 256 * 64;
#pragma unroll
      for (int u = 0; u < 4; ++u) { const int i = tid + NTHR * u, n = i >> 3, part = i & 7; *(LAS v4u*)(GT + n * 72 + 8 * part) = *(const GAS v4u*)(gsrc + n * 64 + 8 * part); } }
    if (tid < 256) { CV[tid] = mup[512 + tid]; CV[256 + tid] = mun[512 + tid]; CV[512 + tid] = in_ptr(I_LNG)[li * 256 + tid]; CV[768 + tid] = in_ptr(I_LNB)[li * 256 + tid]; }
    if (tid >= 256 && tid < 320) { CV[1024 + tid - 256] = mup[896 + tid - 256]; CV[1088 + tid - 256] = mun[896 + tid - 256]; }
    __syncthreads();
    const int nit = nrows / 4, NGW = F.G * NWAVES;
    int it = blockIdx.x * NWAVES + wave;
    RwFinRaw cur; rwfin_load(cur, it < nit ? it : nit - 1, fr, kg, P, YR, BON);
#pragma unroll 1
    while (it < nit) {
        const int nx = it + NGW; RwFinRaw nxt; rwfin_load(nxt, nx < nit ? nx : nit - 1, fr, kg, P, YR, BON);
        const int hh = it & 3, m = 16 * (it >> 2) + fr, c0 = 64 * hh + 16 * kg;
        v4u vr[2][3];
        { const bool isctx = m >= NL; const int t = isctx ? (m - NL) & 255 : m & 4095; const int Ls = isctx ? 256 : 4096; const bool hp = t > 0, hn = t + 1 < Ls; const bf16* pr = P + (size_t)m * PCOLS + RW_C0; const v4u Z4 = (v4u){0u, 0u, 0u, 0u};
#pragma unroll
          for (int e = 0; e < 2; ++e) { vr[e][0] = *(const GAS v4u*)(pr + 512 + c0 + 8 * e); vr[e][1] = Z4; vr[e][2] = Z4;
              if (hp) vr[e][1] = *(const GAS v4u*)(pr - PCOLS + 512 + c0 + 8 * e); if (hn) vr[e][2] = *(const GAS v4u*)(pr + PCOLS + 512 + c0 + 8 * e); } }
        bf16x8 bg[2];
#pragma unroll
        for (int ks = 0; ks < 2; ++ks) { union { bf16x8 v; unsigned u[4]; } o;
            const LAS float* gm = CV + 1024 + 32 * ks + 8 * kg; const f32x4 mpg0 = *(const LAS f32x4*)(gm), mpg1 = *(const LAS f32x4*)(gm + 4), mng0 = *(const LAS f32x4*)(gm + 64), mng1 = *(const LAS f32x4*)(gm + 68);
#pragma unroll
            for (int j = 0; j < 4; ++j) { const unsigned w = cur.g[ks][0][j], wp = cur.g[ks][1][j], wn = cur.g[ks][2][j]; const float x0 = bflo(w), x1 = bfhi(w), p0 = bflo(wp), p1 = bfhi(wp), n0 = bflo(wn), n1 = bfhi(wn);
                const float a0 = (j >> 1 ? mpg1 : mpg0)[2 * (j & 1)], a1 = (j >> 1 ? mpg1 : mpg0)[2 * (j & 1) + 1], b0 = (j >> 1 ? mng1 : mng0)[2 * (j & 1)], b1 = (j >> 1 ? mng1 : mng0)[2 * (j & 1) + 1];
                o.u[j] = pk2(sigmoidf_(x0 + a0 * (p0 - x0) + b0 * (n0 - x0)), sigmoidf_(x1 + a1 * (p1 - x1) + b1 * (n1 - x1))); }
            bg[ks] = o.v; }
        f32x4 acc[4];
#pragma unroll
        for (int q = 0; q < 4; ++q) { const LAS bf16* ar = GT + (64 * hh + 16 * (fr >> 2) + 4 * q + (fr & 3)) * 72 + 8 * kg; const f32x4 z = (f32x4){0.f, 0.f, 0.f, 0.f};
            acc[q] = __builtin_amdgcn_mfma_f32_16x16x32_bf16(*(const LAS bf16x8*)(ar), bg[0], z, 0, 0, 0);
            acc[q] = __builtin_amdgcn_mfma_f32_16x16x32_bf16(*(const LAS bf16x8*)(ar + 32), bg[1], acc[q], 0, 0, 0); }
        f32x4 y[4]; float s1 = 0.f;
#pragma unroll
        for (int q = 0; q < 4; ++q) { y[q] = cur.y[0][q] + cur.y[1][q]; s1 += (y[q].x + y[q].y) + (y[q].z + y[q].w); }
        s1 += __shfl_xor(s1, 16); s1 += __shfl_xor(s1, 32);
        const float mean = s1 * (1.f / 64.f); float s2 = 0.f;
#pragma unroll
        for (int q = 0; q < 4; ++q) { y[q] = y[q] - mean; s2 += (y[q].x * y[q].x + y[q].y * y[q].y) + (y[q].z * y[q].z + y[q].w * y[q].w); }
        s2 += __shfl_xor(s2, 16); s2 += __shfl_xor(s2, 32);
        const float rs = __builtin_amdgcn_rsqf(s2 * (1.f / 64.f) + 64e-5f);
        const float bon = cur.b0 + cur.b1;
        unsigned ow[8];
#pragma unroll
        for (int q = 0; q < 4; ++q) { const int c = c0 + 4 * q;
            const f32x4 mpv = *(const LAS f32x4*)(CV + c), mnv = *(const LAS f32x4*)(CV + 256 + c), lg = *(const LAS f32x4*)(CV + 512 + c), lb = *(const LAS f32x4*)(CV + 768 + c);
            const unsigned w0 = vr[q >> 1][0][2 * (q & 1)], w1 = vr[q >> 1][0][2 * (q & 1) + 1], p0 = vr[q >> 1][1][2 * (q & 1)], p1 = vr[q >> 1][1][2 * (q & 1) + 1], n0 = vr[q >> 1][2][2 * (q & 1)], n1 = vr[q >> 1][2][2 * (q & 1) + 1];
            const f32x4 x = (f32x4){bflo(w0), bfhi(w0), bflo(w1), bfhi(w1)}, xp = (f32x4){bflo(p0), bfhi(p0), bflo(p1), bfhi(p1)}, xn = (f32x4){bflo(n0), bfhi(n0), bflo(n1), bfhi(n1)};
            const f32x4 v = x + mpv * (xp - x) + mnv * (xn - x);
            const f32x4 yn = y[q] * rs * lg + lb;
            const f32x4 o = (yn + v * bon) * acc[q];
            ow[2 * q] = pk2(o.x, o.y); ow[2 * q + 1] = pk2(o.z, o.w); }
        *(GAS v4u*)(MIX + (size_t)m * D + 512 + c0) = (v4u){ow[0], ow[1], ow[2], ow[3]}; *(GAS v4u*)(MIX + (size_t)m * D + 512 + c0 + 8) = (v4u){ow[4], ow[5], ow[6], ow[7]};
        cur = nxt; it = nx;
    }
    __syncthreads();
}

constexpr float HY_DMIN = -3.0701134573253945f, HY_DMAX = -15.350567286626973f;
constexpr int HY_X = 0, HY_TW = 65536, HY_W3 = 98304;
__device__ __forceinline__ float hy_delta(int ch) { return -(HY_DMIN + (float)ch * ((HY_DMAX - HY_DMIN) / 255.f)); }

__device__ __forceinline__ void phase_pro0d(Frame& F) { WS_DECL; frame_refresh(F);
    const int lane = F.lane; const int gw = blockIdx.x * NWAVES + F.wave, NGW = F.G * NWAVES;
    const float* w1 = in_ptr(I_HW1); const float* b1 = in_ptr(I_HB1); const float* w2 = in_ptr(I_HW2); const float* b2 = in_ptr(I_HB2);
    for (int it = gw; it < DEPTH * (SEQ + LCX); it += NGW) {
        const int li = it / (SEQ + LCX), r = it % (SEQ + LCX); const bool isctx = r >= SEQ; const int l = isctx ? r - SEQ : r; const int L = isctx ? LCX : SEQ;
        float z = 0.f;
        if (lane == 0) z = (float)l / (float)(L - 1);
        else if (lane < 33) { const int i = (lane - 1) & 15; const float band = 1e-4f + (float)i * ((15.f - 1e-4f) / 15.f); const float ang = band * (6.283185307179586f / (float)L) * (float)l; z = lane < 17 ? cosf(ang) : -sinf(ang); }
        float h1 = b1[li * 64 + lane];
        for (int i = 0; i < 33; ++i) h1 += __shfl(z, i) * w1[(li * 33 + i) * 64 + lane];
        h1 = sinf(h1);
        float h2 = b2[li * 64 + lane];
        for (int i = 0; i < 64; ++i) h2 += __shfl(h1, i) * w2[(li * 64 + i) * 64 + lane];
        h2 = sinf(h2);
        if (isctx) WSP(float, WS_H2C)[((size_t)li * LCX + l) * 64 + lane] = h2;
        else WSP(float, WS_H2L)[((size_t)li * 64 + lane) * SEQ + l] = h2;
    }
}

typedef f32x2 cpx;
__device__ __forceinline__ cpx cmul(cpx a, cpx b) { return (cpx){a.x * b.x - a.y * b.y, a.x * b.y + a.y * b.x}; }
__device__ __forceinline__ cpx cmulc(cpx a, cpx b) { return (cpx){a.x * b.x + a.y * b.y, a.y * b.x - a.x * b.y}; }
__device__ __forceinline__ cpx cmi(cpx z) { return (cpx){z.y, -z.x}; }
__device__ __forceinline__ int hy_p(int n) { return n ^ ((n >> 5) & 7) ^ (((n >> 6) & 3) << 3); }
__device__ __forceinline__ void hy_build_tw(Frame& F) {
    LAS cpx* TW = (LAS cpx*)(F.lds + HY_TW);
    for (int k = F.tid; k < 4096; k += NTHR) { const float rev = (float)k * (1.f / 8192.f); TW[k] = (cpx){__builtin_amdgcn_cosf(rev), -__builtin_amdgcn_sinf(rev)};     }
}
__device__ __forceinline__ void dft4(cpx x0, cpx x1, cpx x2, cpx x3, cpx& X0, cpx& X1, cpx& X2, cpx& X3) {
    const cpx t0 = x0 + x2, t1 = x0 - x2, t2 = x1 + x3, t3 = cmi(x1 - x3); X0 = t0 + t2; X1 = t1 + t3; X2 = t0 - t2; X3 = t1 - t3; }
__device__ __forceinline__ void dft8(cpx (&a)[8]) {
    const float R2 = 0.7071067811865476f; cpx e[4], o[4];
    dft4(a[0] + a[4], a[1] + a[5], a[2] + a[6], a[3] + a[7], e[0], e[1], e[2], e[3]);
    const cpx d1 = a[1] - a[5], d3 = a[3] - a[7];
    dft4(a[0] - a[4], (cpx){(d1.x + d1.y) * R2, (d1.y - d1.x) * R2}, cmi(a[2] - a[6]), (cpx){(d3.y - d3.x) * R2, -(d3.x + d3.y) * R2}, o[0], o[1], o[2], o[3]);
#pragma unroll
    for (int m = 0; m < 4; ++m) { a[2 * m] = e[m]; a[2 * m + 1] = o[m]; }
}
__device__ __forceinline__ void dft16(cpx (&a)[16]) {
    const float C1 = 0.9238795325112867f, S1 = 0.3826834323650898f, R2 = 0.7071067811865476f;
    cpx e[8], o[8];
#pragma unroll
    for (int k = 0; k < 8; ++k) { e[k] = a[k] + a[k + 8]; o[k] = a[k] - a[k + 8]; }
    o[1] = cmul(o[1], (cpx){C1, -S1}); o[2] = cmul(o[2], (cpx){R2, -R2}); o[3] = cmul(o[3], (cpx){S1, -C1}); o[4] = cmi(o[4]);
    o[5] = cmul(o[5], (cpx){-S1, -C1}); o[6] = cmul(o[6], (cpx){-R2, -R2}); o[7] = cmul(o[7], (cpx){-C1, -S1});
    dft8(e); dft8(o);
#pragma unroll
    for (int m = 0; m < 8; ++m) { a[2 * m] = e[m]; a[2 * m + 1] = o[m]; }
}
template <int R> __device__ __forceinline__ void cconj(cpx (&a)[R]) {
#pragma unroll
    for (int k = 0; k < R; ++k) a[k].y = -a[k].y; }
template <bool INV, bool ZU> __device__ __forceinline__ void hy_pass1(LAS cpx* X, const LAS cpx* TW, int tid) {
    cpx a[16]; const cpx w1 = TW[tid];
#pragma unroll
    for (int k = 0; k < 16; ++k) a[k] = (!INV && ZU && k >= 8) ? (cpx){0.f, 0.f} : X[hy_p(tid + 512 * k)];
    if (!INV) { dft16(a); cpx w = w1;
#pragma unroll
        for (int q = 1; q < 16; ++q) { a[q] = cmul(a[q], w); w = cmul(w, w1); }
    } else { cpx w = w1;
#pragma unroll
        for (int q = 1; q < 16; ++q) { a[q] = cmulc(a[q], w); w = cmul(w, w1); }
        cconj<16>(a); dft16(a); cconj<16>(a); }
#pragma unroll
    for (int k = 0; k < 16; ++k) if (!(INV && ZU && k >= 8)) X[hy_p(tid + 512 * k)] = a[k];
}
template <bool INV, int S, int MUL> __device__ __forceinline__ void hy_pass8(LAS cpx* X, const LAS cpx* TW, int tid) {
#pragma unroll
    for (int h = 0; h < 2; ++h) { const int bf = tid + 512 * h, sub = bf / S, j = bf % S, base = 8 * S * sub + j; cpx a[8]; const cpx w1 = TW[MUL * j];
#pragma unroll
        for (int k = 0; k < 8; ++k) a[k] = X[hy_p(base + S * k)];
        if (!INV) { dft8(a); cpx w = w1;
#pragma unroll
            for (int q = 1; q < 8; ++q) { a[q] = cmul(a[q], w); w = cmul(w, w1); }
        } else { cpx w = w1;
#pragma unroll
            for (int q = 1; q < 8; ++q) { a[q] = cmulc(a[q], w); w = cmul(w, w1); }
            cconj<8>(a); dft8(a); cconj<8>(a); }
#pragma unroll
        for (int k = 0; k < 8; ++k) X[hy_p(base + S * k)] = a[k]; }
}
__device__ __forceinline__ void hy_pass4(LAS cpx* X, int tid, const cpx* spec) {
#pragma unroll
    for (int h = 0; h < 2; ++h) { const int g = tid + 512 * h; cpx a[8];
#pragma unroll
        for (int k = 0; k < 8; ++k) a[k] = X[hy_p(8 * g + k)];
        dft8(a);
        if (spec) {
#pragma unroll
            for (int k2 = 0; k2 < 4; ++k2) { const f32x4 s4 = *(const GAS f32x4*)(spec + 8 * g + 2 * k2); a[2 * k2] = cmul(a[2 * k2], (cpx){s4.x, s4.y}); a[2 * k2 + 1] = cmul(a[2 * k2 + 1], (cpx){s4.z, s4.w}); }
            cconj<8>(a); dft8(a); cconj<8>(a); }
#pragma unroll
        for (int k = 0; k < 8; ++k) X[hy_p(8 * g + k)] = a[k]; }
}
__device__ __forceinline__ void hy_conv_fft(LAS cpx* X, const LAS cpx* TW, int tid, const cpx* spec) {
    hy_pass1<false, true>(X, TW, tid); __syncthreads();
    hy_pass8<false, 64, 16>(X, TW, tid); __syncthreads();
    hy_pass8<false, 8, 128>(X, TW, tid); __syncthreads();
    hy_pass4(X, tid, spec); __syncthreads();
    hy_pass8<true, 8, 128>(X, TW, tid); __syncthreads();
    hy_pass8<true, 64, 16>(X, TW, tid); __syncthreads();
    hy_pass1<true, true>(X, TW, tid); __syncthreads();
}

__device__ __forceinline__ void phase_hy_spec(Frame& F, int li) { WS_DECL; frame_refresh(F);
    LAS cpx* X = (LAS cpx*)(F.lds + HY_X); const LAS cpx* TW = (const LAS cpx*)(F.lds + HY_TW); LAS float* W3 = (LAS float*)(F.lds + HY_W3);
    const int tid = F.tid; const float* w3 = in_ptr(I_HW3) + (size_t)li * 64 * 1024; const float* H2 = WSP(float, WS_H2L) + (size_t)li * 64 * SEQ; cpx* SPEC = WSP(cpx, WS_SPEC);
    __syncthreads();
    hy_build_tw(F);
    for (int item = blockIdx.x; item < 512; item += F.G) {
        const int o = item >> 8, ch = item & 255;
        __syncthreads();
        if (tid < 128) { const int dir = tid >> 6, j = tid & 63; W3[tid] = w3[(size_t)j * 1024 + o * 512 + dir * 256 + ch]; }
        __syncthreads();
        const float delta = hy_delta(ch);
#pragma unroll 1
        for (int i = 0; i < 2; ++i) { const int l0 = 4 * tid + 2048 * i; f32x4 hf = (f32x4){0.f, 0.f, 0.f, 0.f}, hb = hf;
#pragma unroll 4
            for (int j4 = 0; j4 < 16; ++j4) { const f32x4 wf = *(const LAS f32x4*)(W3 + 4 * j4), wb = *(const LAS f32x4*)(W3 + 64 + 4 * j4);
#pragma unroll
                for (int jj = 0; jj < 4; ++jj) { const f32x4 h4 = *(const GAS f32x4*)(H2 + (size_t)(4 * j4 + jj) * SEQ + l0); hf = hf + h4 * wf[jj]; hb = hb + h4 * wb[jj]; } }
#pragma unroll
            for (int e = 0; e < 4; ++e) { const int l = l0 + e; const float win = (__expf(-((float)l * (1.f / 4095.f)) * delta) + 0.05f) * (1.f / 8192.f);
                X[hy_p(l)] = (cpx){hf[e] * win, 0.f};
                if (l == 0) X[hy_p(4096)] = (cpx){0.f, 0.f}; else X[hy_p(8192 - l)] = (cpx){hb[e] * win, 0.f}; } }
        __syncthreads();
        hy_pass1<false, false>(X, TW, tid); __syncthreads();
        hy_pass8<false, 64, 16>(X, TW, tid); __syncthreads();
        hy_pass8<false, 8, 128>(X, TW, tid); __syncthreads();
        hy_pass4(X, tid, nullptr); __syncthreads();
        cpx* dst = SPEC + (size_t)item * 8192;
#pragma unroll
        for (int i = 0; i < 16; ++i) *(GAS cpx*)(dst + tid + 512 * i) = X[hy_p(tid + 512 * i)];
    }
    __syncthreads();
}

struct HyRaw { v4u r[2][3]; unsigned e[2][3]; };
__device__ __forceinline__ void hy_load_raw(HyRaw& R, const bf16* HT, int item, int t0) { const int ch = item >> 3, bp = item & 7;
#pragma unroll
    for (int q = 0; q < 2; ++q)
#pragma unroll
        for (int k = 0; k < 3; ++k) { const bf16* row = HT + (size_t)(256 * k + ch) * NT + (size_t)(2 * bp + q) * SEQ;
            R.r[q][k] = *(const GAS v4u*)(row + t0); const unsigned pm = t0 > 0 ? (unsigned)row[t0 - 1] : 0u, pn = t0 + 8 < SEQ ? (unsigned)row[t0 + 8] : 0u; R.e[q][k] = pm | (pn << 16); }
}
__device__ __forceinline__ void hy_conv8(const v4u raw, unsigned edge, float w0, float w1, float w2, float bias, float (&out)[8]) {
    float p[10];
    p[0] = bflo(edge); p[9] = bfhi(edge);
    p[1] = bflo(raw.x); p[2] = bfhi(raw.x); p[3] = bflo(raw.y); p[4] = bfhi(raw.y); p[5] = bflo(raw.z); p[6] = bfhi(raw.z); p[7] = bflo(raw.w); p[8] = bfhi(raw.w);
#pragma unroll
    for (int e = 0; e < 8; ++e) out[e] = bias + w0 * p[e] + w1 * p[e + 1] + w2 * p[e + 2];
}

__device__ __forceinline__ void phase_hy_conv(Frame& F, int li) { WS_DECL; frame_refresh(F);
    LAS cpx* X = (LAS cpx*)(F.lds + HY_X); const LAS cpx* TW = (const LAS cpx*)(F.lds + HY_TW);
    const int tid = F.tid; const bf16* HT = WSP(bf16, WS_HT); bf16* HOT = WSP(bf16, WS_HOT); const cpx* SPEC = WSP(cpx, WS_SPEC);
    const float* cw = in_ptr(I_HCW) + li * 3 * 768; const float* cb = in_ptr(I_HCB) + li * 768; const float* dsk = in_ptr(I_HD) + li * 512;
    __syncthreads();
    hy_build_tw(F);
    const int t0 = 8 * tid;
    HyRaw cur; hy_load_raw(cur, HT, blockIdx.x < 2048 ? (int)blockIdx.x : 2047, t0);
#pragma unroll 1
    for (int item = blockIdx.x; item < 2048; item += F.G) {
        const int ch = item >> 3, bp = item & 7;
        HyRaw nxt; hy_load_raw(nxt, HT, item + F.G < 2048 ? item + F.G : item, t0);
        float v[2][8], x1[2][8], x2[2][8];
#pragma unroll
        for (int q = 0; q < 2; ++q) {
            hy_conv8(cur.r[q][0], cur.e[q][0], cw[ch], cw[768 + ch], cw[1536 + ch], cb[ch], v[q]);
            hy_conv8(cur.r[q][1], cur.e[q][1], cw[256 + ch], cw[768 + 256 + ch], cw[1536 + 256 + ch], cb[256 + ch], x1[q]);
            hy_conv8(cur.r[q][2], cur.e[q][2], cw[512 + ch], cw[768 + 512 + ch], cw[1536 + 512 + ch], cb[512 + ch], x2[q]); }
        const float d0 = dsk[ch], d1 = dsk[256 + ch];
        __syncthreads();
#pragma unroll
        for (int e = 0; e < 8; ++e) X[hy_p(t0 + e)] = (cpx){v[0][e], v[1][e]};
        __syncthreads();
        hy_conv_fft(X, TW, tid, SPEC + (size_t)ch * 8192);
        float u[2][8];
#pragma unroll
        for (int e = 0; e < 8; ++e) { const cpx y = X[hy_p(t0 + e)]; u[0][e] = x1[0][e] * (y.x + v[0][e] * d0); u[1][e] = x1[1][e] * (y.y + v[1][e] * d0); X[hy_p(t0 + e)] = (cpx){u[0][e], u[1][e]}; }
        __syncthreads();
        hy_conv_fft(X, TW, tid, SPEC + (size_t)(256 + ch) * 8192);
#pragma unroll
        for (int q = 0; q < 2; ++q) { float o[8];
#pragma unroll
            for (int e = 0; e < 8; ++e) { const cpx y = X[hy_p(t0 + e)]; o[e] = x2[q][e] * ((q == 0 ? y.x : y.y) + u[q][e] * d1); }
            v4u w; w.x = pk2(o[0], o[1]); w.y = pk2(o[2], o[3]); w.z = pk2(o[4], o[5]); w.w = pk2(o[6], o[7]);
            *(GAS v4u*)(HOT + (size_t)ch * NT + (size_t)(2 * bp + q) * SEQ + t0) = w; }
        cur = nxt;
    }
    __syncthreads();
}

__device__ __forceinline__ void phase_hy_ctx(Frame& F, int li) { WS_DECL; frame_refresh(F);
    LAS float* KL = (LAS float*)F.lds;
    LAS float* SIG = KL + 1024;
    LAS float* Z1 = SIG + 4096;
    LAS float* Z2 = Z1 + 4096;
    LAS float* W3 = Z2 + 4096;
    const int tid = F.tid; const bf16* HT = WSP(bf16, WS_HT); bf16* HOT = WSP(bf16, WS_HOT);
    const float* w3 = in_ptr(I_HW3) + (size_t)li * 64 * 1024; const float* H2 = WSP(float, WS_H2C) + (size_t)li * LCX * 64;
    const float* cw = in_ptr(I_HCW) + li * 3 * 768; const float* cb = in_ptr(I_HCB) + li * 768; const float* dsk = in_ptr(I_HD) + li * 512;
    for (int ch = blockIdx.x; ch < 256; ch += F.G) {
        __syncthreads();
        if (tid < 256) { const int od = tid >> 6, j = tid & 63; W3[tid] = w3[(size_t)j * 1024 + (od >> 1) * 512 + (od & 1) * 256 + ch]; }
        __syncthreads();
        { const int o = tid >> 8, l = tid & 255; const float* hr = H2 + (size_t)l * 64; float hf = 0.f, hb = 0.f;
#pragma unroll 4
          for (int j4 = 0; j4 < 16; ++j4) { const f32x4 hv = *(const GAS f32x4*)(hr + 4 * j4); const f32x4 wf = *(const LAS f32x4*)(W3 + (2 * o) * 64 + 4 * j4), wb = *(const LAS f32x4*)(W3 + (2 * o + 1) * 64 + 4 * j4);
              hf += hv.x * wf.x; hb += hv.x * wb.x; hf += hv.y * wf.y; hb += hv.y * wb.y; hf += hv.z * wf.z; hb += hv.z * wb.z; hf += hv.w * wf.w; hb += hv.w * wb.w; }
          const float win = __expf(-((float)l * (1.f / 255.f)) * hy_delta(ch)) + 0.05f;
          KL[o * 512 + 256 + l] = hf * win; if (l > 0) KL[o * 512 + 256 - l] = hb * win; else KL[o * 512] = 0.f; }
        { const int q = tid >> 8, t = tid & 255;
#pragma unroll 2
          for (int bp = 0; bp < 8; ++bp) { const int b = 2 * bp + q; const size_t off = (size_t)NL + (size_t)b * LCX;
            float zz[3];
#pragma unroll
            for (int k = 0; k < 3; ++k) { const int c = 256 * k + ch; const bf16* row = HT + (size_t)c * NT + off;
                const float pm = t > 0 ? bf2f(row[t - 1]) : 0.f, p0 = bf2f(row[t]), pp = t + 1 < LCX ? bf2f(row[t + 1]) : 0.f;
                zz[k] = cb[c] + cw[c] * pm + cw[768 + c] * p0 + cw[1536 + c] * pp; }
            SIG[b * 256 + t] = zz[0]; Z1[b * 256 + t] = zz[1]; Z2[b * 256 + t] = zz[2]; } }
        __syncthreads();
        const float d0 = dsk[ch], d1 = dsk[256 + ch]; const int t0 = 4 * (tid & 63);
#pragma unroll 1
        for (int rd = 0; rd < 2; ++rd) { const int b = 8 * rd + (tid >> 6); const size_t off = (size_t)NL + (size_t)b * LCX;
            f32x4 u;
#pragma unroll 1
            for (int o = 0; o < 2; ++o) { const LAS float* kp = KL + o * 512 + t0 + 252; const LAS float* sp = SIG + b * 256;
                f32x4 acc = (f32x4){0.f, 0.f, 0.f, 0.f};
#pragma unroll 4
                for (int s0 = 0; s0 < 256; s0 += 4) { const f32x4 k0 = *(const LAS f32x4*)(kp - s0), k1 = *(const LAS f32x4*)(kp - s0 + 4), sg = *(const LAS f32x4*)(sp + s0);
                    acc.x += k1.x * sg.x; acc.x += k0.w * sg.y; acc.x += k0.z * sg.z; acc.x += k0.y * sg.w;
                    acc.y += k1.y * sg.x; acc.y += k1.x * sg.y; acc.y += k0.w * sg.z; acc.y += k0.z * sg.w;
                    acc.z += k1.z * sg.x; acc.z += k1.y * sg.y; acc.z += k1.x * sg.z; acc.z += k0.w * sg.w;
                    acc.w += k1.w * sg.x; acc.w += k1.z * sg.y; acc.w += k1.y * sg.z; acc.w += k1.x * sg.w; }
                if (o == 0) { const f32x4 z0 = *(const LAS f32x4*)(SIG + b * 256 + t0), z1 = *(const LAS f32x4*)(Z1 + b * 256 + t0); u = z1 * (acc + z0 * d0);
                    __syncthreads();
                    *(LAS f32x4*)(SIG + b * 256 + t0) = u;
                    __syncthreads(); }
                else { const f32x4 z2 = *(const LAS f32x4*)(Z2 + b * 256 + t0); const f32x4 y = z2 * (acc + u * d1);
                    v2u w; w.x = pk2(y.x, y.y); w.y = pk2(y.z, y.w); *(GAS v2u*)(HOT + (size_t)ch * NT + off + t0) = w; } }
        }
    }
    __syncthreads();
}

constexpr int HF_LD = 72;
__device__ __forceinline__ void phase_fin_hyena(Frame& F, int li) { WS_DECL; frame_refresh(F);
    LAS bf16* T = (LAS bf16*)F.lds;
    const int nrows = li == DEPTH - 1 ? NL : NT; const int tid = F.tid, lane = F.lane, wave = F.wave; const bf16* HOT = WSP(bf16, WS_HOT); bf16* MIX = WSP(bf16, WS_A1);
    const f32x4 g4 = *(const GAS f32x4*)(in_ptr(I_HON) + li * 256 + 4 * lane);
    for (int item = blockIdx.x; item < nrows / 64; item += F.G) { const int m0 = item * 64;
        __syncthreads();
        { const int ch = tid >> 1, hf = tid & 1; const bf16* src = HOT + (size_t)ch * NT + m0 + 32 * hf;
#pragma unroll
          for (int k = 0; k < 4; ++k) *(LAS v4u*)(T + ch * HF_LD + 32 * hf + 8 * k) = *(const GAS v4u*)(src + 8 * k); }
        __syncthreads();
        for (int i = 0; i < 8; ++i) { const int tl = wave * 8 + i;
            f32x4 x; x.x = bf2f(T[(4 * lane) * HF_LD + tl]); x.y = bf2f(T[(4 * lane + 1) * HF_LD + tl]); x.z = bf2f(T[(4 * lane + 2) * HF_LD + tl]); x.w = bf2f(T[(4 * lane + 3) * HF_LD + tl]);
            const float r = __builtin_amdgcn_rsqf(wave_sum(x.x * x.x + x.y * x.y + x.z * x.z + x.w * x.w) * (1.f / 256.f) + 1e-6f);
            v2u o; o.x = pk2(x.x * r * g4.x, x.y * r * g4.y); o.y = pk2(x.z * r * g4.z, x.w * r * g4.w); *(GAS v2u*)(MIX + (size_t)(m0 + tl) * D + 768 + 4 * lane) = o; }
    }
    __syncthreads();
}
#define MIX_HYENA 1

#define GRID_BAR() do { XcdBarrier bar_; bar_.leader = (F.wave == 0 && mk_lane() == 0); bar_.bar = (unsigned*)(ws_ptr() + WS_CTL) + CW_BAR; bar_.x = xb_xcc_id(); bar_.st = (volatile LAS unsigned*)(F.lds + LDSCTL_OFF) + 8; xcd_barrier(bar_); } while (0)

#ifndef PROBE_MASK
#define PROBE_MASK 0
#endif
#define TS_MARK(k) do { if (PROBE_MASK && blockIdx.x == 0 && F.wave == 0 && mk_lane() == 0) { LAS unsigned long long* ts_ = (LAS unsigned long long*)(F.lds + LDSCTL_OFF + 128); const unsigned long long now_ = wall_clock64(); if ((PROBE_MASK >> (k)) & 1) ts_[1] += now_ - ts_[0]; ts_[0] = now_; } } while (0)
template <int li>
__device__ __forceinline__ void layer_fwd(Frame& F) {
        const int nrows = li == DEPTH - 1 ? NL : NT; unsigned char* const ws = ws_ptr();
        phase_hy_spec(F, li);
        TS_MARK(23);
        { pg8::Gemm g{WSP(bf16, WS_A1), WSP(bf16, WS_WINT) + (size_t)li * PCOLS * D, NT, PCOLS, D, WSP(bf16, WS_WHYT) + (size_t)li * HYC * D, WSP(bf16, WS_A1)};
          pg8::DualOrder S; S.init(NT, PCOLS, HYC, NT, F.G, (int)blockIdx.x);
          pg8::EpiStore2 E{WSP(bf16, WS_P), PCOLS, WSP(bf16, WS_HT), NT};
          pg8::gemm_phase<pg8::EpiStore2, pg8::DualOrder, true, true>(F.lds, g, S, E, F.wave); }
        GRID_BAR();
        TS_MARK(0);
        phase_rwkv_r0(F, li);
        TS_MARK(10);
        phase_mla_prep(F, li);
        TS_MARK(11);
        phase_lru<1>(F, li);
        __syncthreads();
        TS_MARK(12);
        phase_hy_conv(F, li);
        TS_MARK(13);
        if (li < DEPTH - 1) phase_hy_ctx(F, li);
        TS_MARK(14);
        GRID_BAR();
        TS_MARK(1);
        phase_rwkv_scan(F, li);
        __syncthreads();
        TS_MARK(15);
        phase_attn(F, li);
        __syncthreads();
        TS_MARK(16);
        phase_lru<3>(F, li);
        TS_MARK(17);
        GRID_BAR();
        TS_MARK(2);
        phase_fin_mla(F, li);
        TS_MARK(18);
        phase_fin_rwkv(F, li);
        TS_MARK(19);
        phase_fin_hyena(F, li);
        TS_MARK(20);
        GRID_BAR();
        TS_MARK(3);
        { pg8::Gemm g{WSP(bf16, WS_A1), WSP(bf16, WS_WOUTT) + (size_t)li * D * D, nrows, D, D}; pg8::StaticOrder S; S.init(nrows, D, F.G, (int)blockIdx.x);
          pg8::EpiStore E{WSP(bf16, WS_Y), D, 0, D / 256};
          pg8::gemm_phase<pg8::EpiStore, pg8::StaticOrder, true, true>(F.lds, g, S, E, F.wave); }
        GRID_BAR();
        TS_MARK(4);
        phase_ln1<true>(F, li);
        TS_MARK(21);
        if (li & 1) phase_moe_weights(F, li);
        TS_MARK(22);
        GRID_BAR();
        TS_MARK(5);
        if (!(li & 1)) {
            const int j = li >> 1;
#if DENSE_FFN2_F8
            { pg8::Gemm g{(const pg8::bf16_t*)WSP(unsigned char, WS_A1), (const pg8::bf16_t*)(WSP(unsigned char, WS_WGUT) + (size_t)j * 2 * FFD * D), nrows, 2 * FFD, D / 2}; pg8::StaticOrder S; S.init(nrows, 2 * FFD, F.G, (int)blockIdx.x);
              pg8::EpiSwiGLU8 E{WSP(unsigned char, WS_H), FFD, 0, 2 * FFD / 256};
              pg8::gemm_phase<pg8::EpiSwiGLU8, pg8::StaticOrder, true, true, true, 124>(F.lds, g, S, E, F.wave); }
            GRID_BAR();
            TS_MARK(6);
            { pg8::Gemm g{(const pg8::bf16_t*)WSP(unsigned char, WS_H), (const pg8::bf16_t*)(WSP(unsigned char, WS_WDT) + (size_t)j * D * FFD), nrows, D, FFD / 2}; pg8::StaticOrder S; S.init(nrows, D, F.G, (int)blockIdx.x);
              pg8::EpiStore E{WSP(bf16, WS_Y), D, 0, D / 256};
              pg8::gemm_phase<pg8::EpiStore, pg8::StaticOrder, true, true, true, 123>(F.lds, g, S, E, F.wave); }
            GRID_BAR();
            TS_MARK(7);
#else
            { pg8::Gemm g{(const pg8::bf16_t*)WSP(unsigned char, WS_A1), (const pg8::bf16_t*)(WSP(unsigned char, WS_WGUT) + (size_t)j * 2 * FFD * D), nrows, 2 * FFD, D / 2}; pg8::StaticOrder S; S.init(nrows, 2 * FFD, F.G, (int)blockIdx.x);
              pg8::EpiSwiGLU E{WSP(bf16, WS_H), FFD, 0, 2 * FFD / 256};
              pg8::gemm_phase<pg8::EpiSwiGLU, pg8::StaticOrder, true, true, true, 124>(F.lds, g, S, E, F.wave); }
            GRID_BAR();
            TS_MARK(6);
            { pg8::Gemm g{WSP(bf16, WS_H), WSP(bf16, WS_WDT) + (size_t)j * D * FFD, nrows, D, FFD}; pg8::StaticOrder S; S.init(nrows, D, F.G, (int)blockIdx.x);
              pg8::EpiStore E{WSP(bf16, WS_Y), D, 0, D / 256};
              pg8::gemm_phase<pg8::EpiStore, pg8::StaticOrder, true, true>(F.lds, g, S, E, F.wave); }
            GRID_BAR();
            TS_MARK(7);
#endif
        } else {
            phase_moe_slots(F, li);
            GRID_BAR();
            TS_MARK(6);
            const int ntiles = __builtin_amdgcn_readfirstlane(((LAS int*)(F.lds + LDS_MOEI))[48]);
            const PG8_LAS unsigned char* tile_e = (const PG8_LAS unsigned char*)(F.lds + LDS_TILEE);
#pragma unroll 1
            for (int ch = 0; ch < MOE_NCHUNK; ++ch) {
                const int t0 = ch * MOE_CHUNK_TILES; int nM = ntiles - t0; nM = nM < 0 ? 0 : (nM > MOE_CHUNK_TILES ? MOE_CHUNK_TILES : nM);
                { pg8::Gemm g{(const pg8::bf16_t*)WSP(unsigned char, WS_XS8), (const pg8::bf16_t*)WSP(unsigned char, WS_M8GU), 0, 0, D / 2}; pg8::MoeOrder S; S.init(nM, 2 * FFE / 256, F.G, (int)blockIdx.x, t0, t0, tile_e);
                  pg8::EpiSwiGLU8 E{WSP(unsigned char, WS_HM8), FFE, t0, 2 * FFE / 256};
                  pg8::gemm_phase<pg8::EpiSwiGLU8, pg8::MoeOrder, true, true, true, 124>(F.lds, g, S, E, F.wave); }
                GRID_BAR();
                TS_MARK(7);
                { pg8::Gemm g{(const pg8::bf16_t*)WSP(unsigned char, WS_HM8), (const pg8::bf16_t*)WSP(unsigned char, WS_M8D), 0, 0, FFE / 2}; pg8::MoeOrder S; S.init(nM, D / 256, F.G, (int)blockIdx.x, t0, 0, tile_e);
                  pg8::EpiStore E{WSP(bf16, WS_Y2), D, t0, D / 256};
                  pg8::gemm_phase<pg8::EpiStore, pg8::MoeOrder, true, true, true, 123>(F.lds, g, S, E, F.wave); }
                GRID_BAR();
                TS_MARK(7);
            }
        }
        phase_ln2<true>(F, li);
        if (li < DEPTH - 1) GRID_BAR();
        TS_MARK(8);
}

__global__ void __launch_bounds__(NTHR, 2) mk_fwd(Args a) {
    extern __shared__ __attribute__((aligned(16))) unsigned char lds_raw[];
    Frame F; F.lds = (LAS unsigned char*)lds_raw; F.tid = threadIdx.x; F.lane = F.tid & 63; F.wave = __builtin_amdgcn_readfirstlane(F.tid >> 6); F.G = gridDim.x;
    for (int u = F.tid; u < (LDS_BYTES - LDSCTL_OFF) / 4; u += NTHR) ((LAS unsigned*)(F.lds + LDSCTL_OFF))[u] = 0u;
    __syncthreads();
    (void)xcd_barrier_post((unsigned*)(ws_ptr() + WS_CTL) + CW_BAR, (volatile LAS unsigned*)(F.lds + LDSCTL_OFF) + 8, F.tid == 0);

    TS_MARK(31);
    phase_pro0(F);
    TS_MARK(24);
    phase_pro0b(F);
    phase_pro0c(F);
    phase_pro0d(F);
    phase_pro0e(F);
    TS_MARK(25);
    GRID_BAR();
    TS_MARK(26);
    phase_hin0(F);
    GRID_BAR();
    TS_MARK(9);
    layer_fwd<0>(F); layer_fwd<1>(F); layer_fwd<2>(F); layer_fwd<3>(F);
    if (PROBE_MASK && blockIdx.x == 0 && F.wave == 0 && mk_lane() == 0) { LAS unsigned long long* ts_ = (LAS unsigned long long*)(F.lds + LDSCTL_OFF + 128); const unsigned long long t0_ = wall_clock64(), w_ = ts_[1]; while (wall_clock64() - t0_ < w_) __builtin_amdgcn_s_sleep(8); }
}

extern "C" void kernel_launch(void* const* d_in, const int* in_sizes, int n_in, void* d_out, int out_size, void* d_ws, size_t ws_size, hipStream_t stream) {
    static int grid = 0;
    if (grid == 0) {
        if (n_in != N_INPUTS || out_size != NL * D || ws_size < WS_END) { fprintf(stderr, "kernel_launch: unexpected shapes (n_in %d out %d ws %zu)\n", n_in, out_size, ws_size); grid = -1; return; }
        int dev = 0, cus = 0, per_cu = 0;
        if (hipGetDevice(&dev) != hipSuccess || hipDeviceGetAttribute(&cus, hipDeviceAttributeMultiprocessorCount, dev) != hipSuccess) { grid = -1; return; }
        if (hipFuncSetAttribute((const void*)mk_fwd, hipFuncAttributeMaxDynamicSharedMemorySize, LDS_BYTES) != hipSuccess) { fprintf(stderr, "kernel_launch: hipFuncSetAttribute failed\n"); grid = -1; return; }
        if (hipOccupancyMaxActiveBlocksPerMultiprocessor(&per_cu, (const void*)mk_fwd, NTHR, LDS_BYTES) != hipSuccess || per_cu < 1) fprintf(stderr, "kernel_launch: occupancy query reports %d\n", per_cu);
        (void)hipGetLastError();
        grid = cus > 256 ? 256 : cus;
    }
    if (grid < 0) return;
    if (hipMemsetAsync((char*)d_ws + WS_CTL, 0, CTL_ZERO_BYTES, stream) != hipSuccess) return;
    Args a{};
    for (int i = 0; i < N_INPUTS; ++i) a.in[i] = (const float*)d_in[i];
    a.out = (float*)d_out; a.ws = (unsigned char*)d_ws;
    hipLaunchKernelGGL(mk_fwd, dim3(grid), dim3(NTHR), LDS_BYTES, stream, a);
    const hipError_t le = hipPeekAtLastError();
    if (le != hipSuccess) fprintf(stderr, "kernel_launch: launch failed: %s\n", hipGetErrorName(le));
}
```
